# Optimizing an MI355X kernel written in HIP

```python
import math
import jax, jax.numpy as jnp
from jax import lax
import numpy as np

D_MODEL = 1024
BATCH = 1
SEQ = 16384
DEPTH = 2

GRID_W = 64
CTX_LEN = 256
MIX_W = D_MODEL // 2
N_BRANCH = 3
IN_WIDTH = 6 * MIX_W
S5_GROUP = 16
S5_GROUPS = MIX_W // S5_GROUP
S5_STATE = 64
SG_CHUNK = 128
SG_GROUPS = 4
SG_GROUP_W = MIX_W // SG_GROUPS
CONV_K = 3
N_EXP_GROUPS = 4
EXPERTS_PER_GROUP = 8
N_EXPERTS = N_EXP_GROUPS * EXPERTS_PER_GROUP
TOP_K = 2
D_FF_EXPERT = D_MODEL // 4
NORM_EPS = 1e-6

kernel_name = "hybrid_s5_gmlp_conv_hmoe_dit"


def rms_norm(x, g):
    xf = x.astype(jnp.float32)
    y = xf * lax.rsqrt(jnp.mean(xf * xf, axis=-1, keepdims=True) + NORM_EPS) * g.astype(jnp.float32)
    return y.astype(x.dtype)


def layer_norm(x, g, b):
    xf = x.astype(jnp.float32)
    mu = jnp.mean(xf, axis=-1, keepdims=True)
    var = jnp.mean(jnp.square(xf - mu), axis=-1, keepdims=True)
    y = (xf - mu) * lax.rsqrt(var + NORM_EPS) * g.astype(jnp.float32) + b.astype(jnp.float32)
    return y.astype(x.dtype)


def modulate(h, shift, scale):
    return h * (1.0 + scale) + shift


def _lin_comb(e1, e2):
    a1, b1 = e1
    a2, b2 = e2
    return a1 * a2, a2 * b1 + b2


def s5_discretise(p, d):
    f32 = jnp.float32
    lam = lax.complex(p["lam_re"][d].astype(f32), p["lam_im"][d].astype(f32))
    dt = jnp.exp(p["log_dt"][d].astype(f32))[:, None]
    a_bar = jnp.exp(lam * dt)
    bmat = lax.complex(p["b_re"][d].astype(f32), p["b_im"][d].astype(f32))
    b_bar = ((a_bar - 1.0) / lam)[:, :, None] * bmat
    return a_bar, b_bar


def s5_scan(u, a_bar, b_bar, h0, reverse):
    bu = jnp.einsum("blgh,gph->blgp", u.astype(jnp.float32).astype(jnp.complex64), b_bar)
    a = jnp.broadcast_to(a_bar, bu.shape)
    a_cum, hs = lax.associative_scan(_lin_comb, (a, bu), reverse=reverse, axis=1)
    return hs + a_cum * h0[:, None]


def s5_readout(u, hf, hb, p):
    f32 = jnp.float32
    bsz, length = u.shape[0], u.shape[1]
    cf = lax.complex(p["c_re"][0].astype(f32), p["c_im"][0].astype(f32))
    cb = lax.complex(p["c_re"][1].astype(f32), p["c_im"][1].astype(f32))
    y = (jnp.einsum("blgp,ghp->blgh", hf, cf) + jnp.einsum("blgp,ghp->blgh", hb, cb)).real
    y = y.reshape(bsz, length, MIX_W) + p["d_skip"].astype(f32) * u.astype(f32)
    yg = jax.nn.gelu(y).astype(u.dtype)
    return yg * jax.nn.sigmoid(yg @ p["w_glu"])


def spatial_gate(u, v, p):
    bsz, length, _ = v.shape
    vn = layer_norm(v, p["sg_ln_g"], p["sg_ln_b"])
    v5 = vn.reshape(bsz, length // SG_CHUNK, SG_CHUNK, SG_GROUPS, SG_GROUP_W)
    s = jnp.einsum("bnpgc,gqp->bnqgc", v5, p["w_sg"]) + p["b_sg"].T[None, None, :, :, None]
    return u * s.reshape(bsz, length, MIX_W)


def short_conv(z, w, n_rows):
    bsz, length, ch = z.shape
    row_len = length // n_rows
    zr = z.reshape(bsz, n_rows, row_len, ch)
    half = CONV_K // 2
    zp = jnp.pad(zr, ((0, 0), (0, 0), (half, half), (0, 0)))
    y = w[0] * zp[:, :, 0:row_len]
    for k in range(1, CONV_K):
        y = y + w[k] * zp[:, :, k:k + row_len]
    return y.reshape(bsz, length, ch)


def mix_sequence(h, proj, hf, hb, p, n_rows):
    bsz, length, _ = h.shape
    ua, su, sv, cgb, cgc, chh = jnp.split(proj, 6, axis=-1)
    y_a = s5_readout(ua, hf, hb, p)
    y_b = spatial_gate(jax.nn.gelu(su), jax.nn.gelu(sv), p)
    y_c = cgb * short_conv(cgc * chh, p["w_conv"], n_rows)
    ys = jnp.stack([y_a, y_b, y_c], axis=2)
    br = jnp.einsum("blkm,kmd->blkd", ys, p["w_branch"])
    gates = jax.nn.sigmoid((h @ p["w_merge"] + p["b_merge"]).reshape(bsz, length, N_BRANCH, D_MODEL))
    return jnp.sum(gates * br, axis=2) @ p["w_o"]


def token_mix(h, hc, p, rows, need_ctx):
    bsz = h.shape[0]
    proj = h @ p["w_in"]
    projc = hc @ p["w_in"]
    u = proj[..., :MIX_W].reshape(bsz, h.shape[1], S5_GROUPS, S5_GROUP)
    uc = projc[..., :MIX_W].reshape(bsz, hc.shape[1], S5_GROUPS, S5_GROUP)
    a_f, b_f = s5_discretise(p, 0)
    a_b, b_b = s5_discretise(p, 1)
    z0 = jnp.zeros((bsz, S5_GROUPS, S5_STATE), jnp.complex64)
    hcf = s5_scan(uc, a_f, b_f, z0, False)
    hcb = s5_scan(uc, a_b, b_b, z0, True)
    hf = s5_scan(u, a_f, b_f, hcf[:, -1], False)
    hb = s5_scan(u, a_b, b_b, hcb[:, 0], True)
    out = mix_sequence(h, proj, hf, hb, p, rows)
    out_c = mix_sequence(hc, projc, hcf, hcb, p, 1) if need_ctx else None
    return out, out_c


def hier_moe(h, p):
    f32 = jnp.float32
    grp_prob = jax.nn.softmax((h @ p["w_grp"]).astype(f32) + p["b_grp"].astype(f32), axis=-1)
    g_p, g_idx = lax.top_k(grp_prob, 1)
    exp_logits = ((h @ p["w_exp"]).astype(f32) + p["b_exp"].astype(f32)).reshape(
        h.shape[:-1] + (N_EXP_GROUPS, EXPERTS_PER_GROUP))
    in_grp = jnp.take_along_axis(exp_logits, g_idx[..., None], axis=-2)[..., 0, :]
    e_prob = jax.nn.softmax(in_grp, axis=-1)
    e_p, e_idx = lax.top_k(e_prob, TOP_K)
    e_p = e_p / jnp.sum(e_p, axis=-1, keepdims=True)
    expert_id = g_idx * EXPERTS_PER_GROUP + e_idx
    combine = jnp.sum(jax.nn.one_hot(expert_id, N_EXPERTS, dtype=f32) * (g_p * e_p)[..., None], axis=-2)
    combine = combine.astype(h.dtype)
    out = jnp.zeros_like(h)
    for grp in range(N_EXP_GROUPS):
        sl = slice(grp * EXPERTS_PER_GROUP, (grp + 1) * EXPERTS_PER_GROUP)
        a = jnp.einsum("bld,edf->blef", h, p["w1"][sl])
        b = jnp.einsum("bld,edf->blef", h, p["w3"][sl])
        act = jax.nn.silu(a) * b * combine[..., sl, None]
        out = out + jnp.einsum("blef,efd->bld", act, p["w2"][sl])
    return out


def setup_inputs(seed: int = 0) -> dict:
    key = jax.random.key(seed)
    ks = jax.random.split(key, 40)
    f32 = jnp.float32
    D, L_, G, P, H = D_MODEL, DEPTH, S5_GROUPS, S5_STATE, S5_GROUP

    def nrm(k, shape, scale):
        return jax.random.normal(k, shape, f32) * scale

    lam_im = jnp.broadcast_to(jnp.pi * jnp.arange(P, dtype=f32), (L_, 2, G, P)) + nrm(ks[9], (L_, 2, G, P), 0.01)
    return {
        "x": nrm(ks[0], (BATCH, SEQ, D), 1.0),
        "c": nrm(ks[1], (BATCH, D), 1.0),
        "ctx": nrm(ks[2], (BATCH, CTX_LEN, D), 1.0),
        "c_ctx": nrm(ks[3], (D,), 1.0),
        "w_ada": nrm(ks[4], (L_, D, 6 * D), 0.5 * D ** -0.5),
        "b_ada": nrm(ks[5], (L_, 6 * D), 0.02),
        "g_mix": 1.0 + nrm(ks[6], (L_, D), 0.05),
        "g_ffn": 1.0 + nrm(ks[7], (L_, D), 0.05),
        "w_in": nrm(ks[8], (L_, D, IN_WIDTH), D ** -0.5),
        "lam_re": -0.5 + nrm(ks[10], (L_, 2, G, P), 0.01),
        "lam_im": lam_im,
        "log_dt": jax.random.uniform(ks[11], (L_, 2, G), f32, math.log(1e-3), math.log(1e-1)),
        "b_re": nrm(ks[12], (L_, 2, G, P, H), (2 * H) ** -0.5),
        "b_im": nrm(ks[13], (L_, 2, G, P, H), (2 * H) ** -0.5),
        "c_re": nrm(ks[14], (L_, 2, G, H, P), P ** -0.5),
        "c_im": nrm(ks[15], (L_, 2, G, H, P), P ** -0.5),
        "d_skip": nrm(ks[16], (L_, MIX_W), 1.0),
        "w_glu": nrm(ks[17], (L_, MIX_W, MIX_W), MIX_W ** -0.5),
        "sg_ln_g": 1.0 + nrm(ks[18], (L_, MIX_W), 0.05),
        "sg_ln_b": nrm(ks[19], (L_, MIX_W), 0.02),
        "w_sg": nrm(ks[20], (L_, SG_GROUPS, SG_CHUNK, SG_CHUNK), SG_CHUNK ** -0.5),
        "b_sg": 1.0 + nrm(ks[21], (L_, SG_GROUPS, SG_CHUNK), 0.1),
        "w_conv": nrm(ks[22], (L_, CONV_K, MIX_W), CONV_K ** -0.5),
        "w_branch": nrm(ks[23], (L_, N_BRANCH, MIX_W, D), MIX_W ** -0.5),
        "w_merge": nrm(ks[24], (L_, D, N_BRANCH * D), D ** -0.5),
        "b_merge": nrm(ks[25], (L_, N_BRANCH * D), 0.02),
        "w_o": nrm(ks[26], (L_, D, D), D ** -0.5),
        "w_grp": nrm(ks[27], (L_, D, N_EXP_GROUPS), D ** -0.5),
        "b_grp": nrm(ks[28], (L_, N_EXP_GROUPS), 0.01),
        "w_exp": nrm(ks[29], (L_, D, N_EXPERTS), D ** -0.5),
        "b_exp": nrm(ks[30], (L_, N_EXPERTS), 0.01),
        "w1": nrm(ks[31], (L_, N_EXPERTS, D, D_FF_EXPERT), D ** -0.5),
        "w3": nrm(ks[32], (L_, N_EXPERTS, D, D_FF_EXPERT), D ** -0.5),
        "w2": nrm(ks[33], (L_, N_EXPERTS, D_FF_EXPERT, D), D_FF_EXPERT ** -0.5),
        "g_final": 1.0 + nrm(ks[34], (D,), 0.05),
    }


def reference(x, c, ctx, c_ctx, w_ada, b_ada, g_mix, g_ffn, w_in, lam_re, lam_im, log_dt,
              b_re, b_im, c_re, c_im, d_skip, w_glu, sg_ln_g, sg_ln_b, w_sg, b_sg, w_conv,
              w_branch, w_merge, b_merge, w_o, w_grp, b_grp, w_exp, b_exp, w1, w3, w2, g_final):
    rows = x.shape[1] // GRID_W
    xc = ctx
    for l in range(DEPTH):
        need_ctx = l < DEPTH - 1
        p = dict(w_in=w_in[l], lam_re=lam_re[l], lam_im=lam_im[l], log_dt=log_dt[l],
                 b_re=b_re[l], b_im=b_im[l], c_re=c_re[l], c_im=c_im[l], d_skip=d_skip[l],
                 w_glu=w_glu[l], sg_ln_g=sg_ln_g[l], sg_ln_b=sg_ln_b[l], w_sg=w_sg[l], b_sg=b_sg[l],
                 w_conv=w_conv[l], w_branch=w_branch[l], w_merge=w_merge[l], b_merge=b_merge[l],
                 w_o=w_o[l], w_grp=w_grp[l], b_grp=b_grp[l], w_exp=w_exp[l], b_exp=b_exp[l],
                 w1=w1[l], w3=w3[l], w2=w2[l])
        sh1, sc1, ga1, sh2, sc2, ga2 = jnp.split(jax.nn.silu(c) @ w_ada[l] + b_ada[l], 6, axis=-1)
        csh1, csc1, cga1, csh2, csc2, cga2 = jnp.split(jax.nn.silu(c_ctx) @ w_ada[l] + b_ada[l], 6, axis=-1)
        h = modulate(rms_norm(x, g_mix[l]), sh1[:, None], sc1[:, None])
        hc = modulate(rms_norm(xc, g_mix[l]), csh1, csc1)
        out, out_c = token_mix(h, hc, p, rows, need_ctx)
        x = x + ga1[:, None] * out
        h2 = modulate(rms_norm(x, g_ffn[l]), sh2[:, None], sc2[:, None])
        x = x + ga2[:, None] * hier_moe(h2, p)
        if need_ctx:
            xc = xc + cga1 * out_c
            hc2 = modulate(rms_norm(xc, g_ffn[l]), csh2, csc2)
            xc = xc + cga2 * hier_moe(hc2, p)
    return rms_norm(x, g_final)
```

```cpp
#include <hip/hip_runtime.h>
#include <stdint.h>

namespace nv {
constexpr int D = 1024, SEQ = 16384, CTX = 256, MT = SEQ + CTX;
constexpr int MIXW = 512, INW = 3072, G5 = 32, P5 = 64, H5 = 16;
constexpr int NE = 32, DFF = 256;
constexpr int MAXSLOT = 2 * MT + NE * 256;
constexpr float EPS = 1e-6f;

__device__ __forceinline__ float sigmoidf_(float x) { return 1.f / (1.f + expf(-x)); }
__device__ __forceinline__ float siluf_(float x) { return x / (1.f + expf(-x)); }
__device__ __forceinline__ float geluf_(float x) { return 0.5f * x * (1.f + tanhf(0.7978845608028654f * (x + 0.044715f * x * x * x))); }
__device__ __forceinline__ float wave_sum(float v) {
#pragma unroll
    for (int o = 1; o < 64; o <<= 1) v += __shfl_xor(v, o);
    return v;
}

__global__ void k_ada(const float* c, const float* cctx, const float* w_ada, const float* b_ada, float* mod) {
    int idx = blockIdx.x * blockDim.x + threadIdx.x;
    if (idx >= 2 * 6144) return;
    int l = idx / 6144, j = idx % 6144;
    const float* W = w_ada + (size_t)l * D * 6144 + j;
    float a0 = 0.f, a1 = 0.f;
    for (int k = 0; k < D; ++k) { float w = W[(size_t)k * 6144]; a0 += siluf_(c[k]) * w; a1 += siluf_(cctx[k]) * w; }
    float b = b_ada[l * 6144 + j];
    mod[(size_t)(l * 2 + 0) * 6144 + j] = a0 + b;
    mod[(size_t)(l * 2 + 1) * 6144 + j] = a1 + b;
}

__global__ void k_hprep(const float* X, const float* g, const float* mod_l  , int sh_off, int sc_off, float* H) {
    int row = blockIdx.x * (blockDim.x >> 6) + (threadIdx.x >> 6), lane = threadIdx.x & 63;
    if (row >= MT) return;
    const float* m = mod_l + (row >= SEQ ? 6144 : 0);
    const float* xr = X + (size_t)row * D;
    float v[16]; float s = 0.f;
#pragma unroll
    for (int j = 0; j < 16; ++j) { v[j] = xr[lane + 64 * j]; s += v[j] * v[j]; }
    float rstd = rsqrtf(wave_sum(s) * (1.f / D) + EPS);
#pragma unroll
    for (int j = 0; j < 16; ++j) { int cidx = lane + 64 * j; H[(size_t)row * D + cidx] = v[j] * rstd * g[cidx] * (1.f + m[sc_off + cidx]) + m[sh_off + cidx]; }
}

struct Smem { float As[16][68]; float Bs[16][68]; };
template <class AF>
__device__ __forceinline__ void gemm_acc(float (&acc)[4][4], AF arow, const float* B, int ldb, int K, Smem& s) {
    const int t = threadIdx.x, ty = t >> 4, tx = t & 15;
    const int lr = t >> 2, lk = (t & 3) * 4; const float* ap = arow(lr);
    const int bk = t >> 4, bn = (t & 15) * 4;
    for (int k0 = 0; k0 < K; k0 += 16) {
        float4 av = ap ? *(const float4*)(ap + k0 + lk) : make_float4(0.f, 0.f, 0.f, 0.f);
        float4 bv = *(const float4*)(B + (size_t)(k0 + bk) * ldb + bn);
        __syncthreads();
        s.As[lk + 0][lr] = av.x; s.As[lk + 1][lr] = av.y; s.As[lk + 2][lr] = av.z; s.As[lk + 3][lr] = av.w;
        *(float4*)&s.Bs[bk][bn] = bv;
        __syncthreads();
#pragma unroll
        for (int k = 0; k < 16; ++k) {
            float4 a = *(const float4*)&s.As[k][ty * 4]; float4 b = *(const float4*)&s.Bs[k][tx * 4];
            float aa[4] = {a.x, a.y, a.z, a.w}, bb[4] = {b.x, b.y, b.z, b.w};
#pragma unroll
            for (int i = 0; i < 4; ++i)
#pragma unroll
                for (int j = 0; j < 4; ++j) acc[i][j] += aa[i] * bb[j];
        }
    }
}
struct RowsPlain { const float* A; int lda; __device__ const float* operator()(int r) const { return A + (size_t)r * lda; } };

template <class EF>
__global__ void __launch_bounds__(256) k_gemm(const float* A, const float* B, size_t strideA, size_t strideB, int lda, int ldb, int K, int pad, EF ef) {
    __shared__ Smem s;
    const int m0 = blockIdx.y * 64, n0 = blockIdx.x * 64, z = blockIdx.z;
    float acc[4][4] = {};
    RowsPlain rp{A + z * strideA + (size_t)m0 * lda, lda};
    gemm_acc(acc, rp, B + z * strideB + n0, ldb, K, s);
    const int ty = threadIdx.x >> 4, tx = threadIdx.x & 15;
#pragma unroll
    for (int i = 0; i < 4; ++i)
#pragma unroll
        for (int j = 0; j < 4; ++j) ef(z, m0 + ty * 4 + i, n0 + tx * 4 + j, acc[i][j]);
}
struct EpiStore { float* C; int ldc; int pad; __device__ void operator()(int, int m, int n, float v) const { C[(size_t)m * ldc + n] = v; } };
struct EpiGelu { float* C; int ldc; int pad; __device__ void operator()(int, int m, int n, float v) const { C[(size_t)m * ldc + n] = geluf_(v); } };
struct EpiGlu { const float* YG; float* YA; __device__ void operator()(int, int m, int n, float v) const { YA[(size_t)m * MIXW + n] = YG[(size_t)m * MIXW + n] * sigmoidf_(v); } };
struct EpiSg1 { const float* GU; const float* bsg; float* YB; int gg; int pad; __device__ void operator()(int z, int m, int n, float v) const {
    size_t row = (size_t)z * 128 + m; int col = gg * 128 + n; YB[row * MIXW + col] = GU[row * 1024 + col] * (v + bsg[gg * 128 + m]); } };
struct EpiWo { float* X; const float* mod_l; int ga_off; int pad; __device__ void operator()(int, int m, int n, float v) const {
    const float* mm = mod_l + (m >= SEQ ? 6144 : 0); X[(size_t)m * D + n] += mm[ga_off + n] * v; } };

__global__ void __launch_bounds__(64) k_s5(const float* UA  , const float* lam_re, const float* lam_im, const float* log_dt,
                                           const float* b_re, const float* b_im, const float* c_re, const float* c_im, float* YD  , int l, int pad) {
    const int g = blockIdx.x >> 1, dir = blockIdx.x & 1, p = threadIdx.x;
    __shared__ float Cr[16][64], Ci[16][64];
    __shared__ float Sr[32][64], Si[32][64];
    const int ldg = ((l * 2 + dir) * G5 + g);
    const float lr = lam_re[ldg * P5 + p], li = lam_im[ldg * P5 + p], dt = expf(log_dt[ldg]);
    const float er = expf(lr * dt), ar = er * cosf(li * dt), ai = er * sinf(li * dt);
    const float nr = ar - 1.f, ni = ai, den = lr * lr + li * li;
    const float qr = (nr * lr + ni * li) / den, qi = (ni * lr - nr * li) / den;
    float br[16], bi[16];
#pragma unroll
    for (int h = 0; h < 16; ++h) { float x = b_re[((size_t)ldg * P5 + p) * H5 + h], y = b_im[((size_t)ldg * P5 + p) * H5 + h]; br[h] = qr * x - qi * y; bi[h] = qr * y + qi * x; }
    for (int h = 0; h < 16; ++h) { Cr[h][p] = c_re[((size_t)ldg * H5 + h) * P5 + p]; Ci[h][p] = c_im[((size_t)ldg * H5 + h) * P5 + p]; }
    __syncthreads();
    float sr = 0.f, si = 0.f;
    float* Y = YD + (size_t)dir * MT * MIXW;
    for (int blk = 0; blk < MT / 32; ++blk) {
        for (int t = 0; t < 32; ++t) {
            int pos = blk * 32 + t;
            int row = dir == 0 ? (pos < CTX ? SEQ + pos : pos - CTX) : (pos < CTX ? SEQ + CTX - 1 - pos : SEQ - 1 - (pos - CTX));
            const float* u = UA + (size_t)row * MIXW + g * 16;
            float xr = 0.f, xi = 0.f;
#pragma unroll
            for (int h = 0; h < 16; ++h) { float uv = u[h]; xr += br[h] * uv; xi += bi[h] * uv; }
            float nsr = ar * sr - ai * si + xr, nsi = ar * si + ai * sr + xi;
            sr = nsr; si = nsi;
            Sr[t][p] = sr; Si[t][p] = si;
        }
        __syncthreads();
        for (int o = p; o < 512; o += 64) {
            int t = o >> 4, h = o & 15; float acc = 0.f;
            for (int q = 0; q < 64; ++q) acc += Cr[h][q] * Sr[t][q] - Ci[h][q] * Si[t][q];
            int pos = blk * 32 + t;
            int row = dir == 0 ? (pos < CTX ? SEQ + pos : pos - CTX) : (pos < CTX ? SEQ + CTX - 1 - pos : SEQ - 1 - (pos - CTX));
            Y[(size_t)row * MIXW + g * 16 + h] = acc;
        }
        __syncthreads();
    }
}
__global__ void k_s5fin(float* UA, const float* YD, const float* dskip_l) {
    size_t i = (size_t)blockIdx.x * blockDim.x + threadIdx.x; if (i >= (size_t)MT * MIXW) return;
    int cidx = (int)(i % MIXW);
    UA[i] = geluf_(YD[i] + YD[(size_t)MT * MIXW + i] + dskip_l[cidx] * UA[i]);
}
__global__ void k_ln(float* SUV, const float* gam, const float* bet) {
    int row = blockIdx.x * (blockDim.x >> 6) + (threadIdx.x >> 6), lane = threadIdx.x & 63; if (row >= MT) return;
    float* v = SUV + (size_t)row * 1024 + 512; float x[8]; float s = 0.f;
#pragma unroll
    for (int j = 0; j < 8; ++j) { x[j] = v[lane + 64 * j]; s += x[j]; }
    float mu = wave_sum(s) * (1.f / 512.f); float q = 0.f;
#pragma unroll
    for (int j = 0; j < 8; ++j) { x[j] -= mu; q += x[j] * x[j]; }
    float rstd = rsqrtf(wave_sum(q) * (1.f / 512.f) + EPS);
#pragma unroll
    for (int j = 0; j < 8; ++j) v[lane + 64 * j] = x[j] * rstd * gam[lane + 64 * j] + bet[lane + 64 * j];
}
__global__ void k_conv(const float* CG, const float* wconv_l  , float* YC) {
    size_t i = (size_t)blockIdx.x * blockDim.x + threadIdx.x; if (i >= (size_t)MT * MIXW) return;
    int row = (int)(i / MIXW), c = (int)(i % MIXW);
    int pos, rl; if (row < SEQ) { pos = row & 63; rl = 64; } else { pos = row - SEQ; rl = 256; }
    const float* r0 = CG + (size_t)row * 1536;
    float z0 = r0[512 + c] * r0[1024 + c];
    float zm = pos > 0 ? (r0 - 1536)[512 + c] * (r0 - 1536)[1024 + c] : 0.f;
    float zp = pos < rl - 1 ? (r0 + 1536)[512 + c] * (r0 + 1536)[1024 + c] : 0.f;
    YC[i] = r0[c] * (wconv_l[c] * zm + wconv_l[512 + c] * z0 + wconv_l[1024 + c] * zp);
}
__global__ void __launch_bounds__(256) k_outpre(const float* H, const float* YS  , const float* wm_l, const float* bm_l, const float* wb_l, float* OP) {
    __shared__ Smem s;
    const int m0 = blockIdx.y * 64, n0 = blockIdx.x * 64; const int ty = threadIdx.x >> 4, tx = threadIdx.x & 15;
    float out[4][4] = {};
    for (int k = 0; k < 3; ++k) {
        float ag[4][4] = {}, ab[4][4] = {};
        gemm_acc(ag, RowsPlain{H + (size_t)m0 * D, D}, wm_l + k * 1024 + n0, 3072, D, s);
        gemm_acc(ab, RowsPlain{YS + (size_t)k * MT * MIXW + (size_t)m0 * MIXW, MIXW}, wb_l + (size_t)k * MIXW * D + n0, D, MIXW, s);
#pragma unroll
        for (int i = 0; i < 4; ++i)
#pragma unroll
            for (int j = 0; j < 4; ++j) out[i][j] += sigmoidf_(ag[i][j] + bm_l[k * 1024 + n0 + tx * 4 + j]) * ab[i][j];
    }
#pragma unroll
    for (int i = 0; i < 4; ++i)
#pragma unroll
        for (int j = 0; j < 4; ++j) OP[(size_t)(m0 + ty * 4 + i) * D + n0 + tx * 4 + j] = out[i][j];
}
__global__ void k_route(const float* H2, const float* wg_l, const float* bg_l, const float* we_l, const float* be_l, int* EID, float* EW, int* cnt) {
    int row = blockIdx.x * (blockDim.x >> 6) + (threadIdx.x >> 6), lane = threadIdx.x & 63; if (row >= MT) return;
    const float* hr = H2 + (size_t)row * D;
    float acc[36];
#pragma unroll
    for (int o = 0; o < 36; ++o) acc[o] = 0.f;
    for (int j = 0; j < 16; ++j) { int k = lane + 64 * j; float hv = hr[k];
#pragma unroll
        for (int o = 0; o < 4; ++o) acc[o] += hv * wg_l[k * 4 + o];
#pragma unroll
        for (int o = 0; o < 32; ++o) acc[4 + o] += hv * we_l[k * 32 + o]; }
#pragma unroll
    for (int o = 0; o < 36; ++o) acc[o] = wave_sum(acc[o]);
    __shared__ float sl[4][40];
    float* L = sl[threadIdx.x >> 6];
    if (lane == 0) {
#pragma unroll
        for (int o = 0; o < 4; ++o) L[o] = acc[o] + bg_l[o];
#pragma unroll
        for (int o = 0; o < 32; ++o) L[4 + o] = acc[4 + o] + be_l[o];
        int gi = 0; float gm = L[0]; for (int o = 1; o < 4; ++o) if (L[o] > gm) { gm = L[o]; gi = o; }
        float den = 0.f; for (int o = 0; o < 4; ++o) den += expf(L[o] - gm);
        float gp = 1.f / den;
        const float* el = L + 4 + gi * 8;
        int i1 = 0; float m1 = el[0]; for (int o = 1; o < 8; ++o) if (el[o] > m1) { m1 = el[o]; i1 = o; }
        int i2 = -1; float m2 = 0.f; for (int o = 0; o < 8; ++o) if (o != i1 && (i2 < 0 || el[o] > m2)) { m2 = el[o]; i2 = o; }
        float e2 = expf(m2 - m1); float w1 = 1.f / (1.f + e2), w2 = e2 / (1.f + e2);
        int e1i = gi * 8 + i1, e2i = gi * 8 + i2;
        EID[row * 2] = e1i; EID[row * 2 + 1] = e2i; EW[row * 2] = gp * w1; EW[row * 2 + 1] = gp * w2;
        atomicAdd(&cnt[e1i], 1); atomicAdd(&cnt[e2i], 1);
    }
}
__device__ __forceinline__ int expert_off(const int* cnt, int e) { int o = 0; for (int i = 0; i < e; ++i) o += (cnt[i] + 255) & ~255; return o; }
__global__ void k_fill(const int* EID, const float* EW, const int* cnt, int* fill, int* slot_tok, float* slot_w) {
    int i = blockIdx.x * blockDim.x + threadIdx.x; if (i >= MT * 2) return;
    int e = EID[i]; int pos = atomicAdd(&fill[e], 1); int slot = expert_off(cnt, e) + pos;
    slot_tok[slot] = i >> 1; slot_w[slot] = EW[i];
}
struct RowsGather { const float* H; const int* tok; int nvalid; __device__ const float* operator()(int r) const { return r < nvalid ? H + (size_t)tok[r] * D : nullptr; } };
__global__ void __launch_bounds__(256) k_moe_up(const float* H2, const int* cnt, const int* slot_tok, const float* slot_w, const float* w1_l, const float* w3_l, float* ACT) {
    __shared__ Smem s;
    const int e = blockIdx.z, n_e = cnt[e], r0 = blockIdx.y * 64; if (r0 >= n_e) return;
    const int off = expert_off(cnt, e) + r0, n0 = blockIdx.x * 64; const int ty = threadIdx.x >> 4, tx = threadIdx.x & 15;
    float aa[4][4] = {}, ab[4][4] = {};
    RowsGather rg{H2, slot_tok + off, n_e - r0};
    gemm_acc(aa, rg, w1_l + (size_t)e * D * DFF + n0, DFF, D, s);
    gemm_acc(ab, rg, w3_l + (size_t)e * D * DFF + n0, DFF, D, s);
#pragma unroll
    for (int i = 0; i < 4; ++i) { int r = ty * 4 + i; if (r0 + r < n_e) { float w = slot_w[off + r];
#pragma unroll
        for (int j = 0; j < 4; ++j) ACT[(size_t)(off + r) * DFF + n0 + tx * 4 + j] = siluf_(aa[i][j]) * ab[i][j] * w; } }
}
struct RowsAct { const float* A; int nvalid; __device__ const float* operator()(int r) const { return r < nvalid ? A + (size_t)r * DFF : nullptr; } };
__global__ void __launch_bounds__(256) k_moe_down(const float* ACT, const int* cnt, const int* slot_tok, const float* w2_l, const float* mod_l, float* X, int ga_off, int pad) {
    __shared__ Smem s;
    const int e = blockIdx.z, n_e = cnt[e], r0 = blockIdx.y * 64; if (r0 >= n_e) return;
    const int off = expert_off(cnt, e) + r0, n0 = blockIdx.x * 64; const int ty = threadIdx.x >> 4, tx = threadIdx.x & 15;
    float acc[4][4] = {};
    gemm_acc(acc, RowsAct{ACT + (size_t)off * DFF, n_e - r0}, w2_l + (size_t)e * DFF * D + n0, D, DFF, s);
#pragma unroll
    for (int i = 0; i < 4; ++i) { int r = ty * 4 + i; if (r0 + r < n_e) { int tok = slot_tok[off + r]; const float* mm = mod_l + (tok >= SEQ ? 6144 : 0);
#pragma unroll
        for (int j = 0; j < 4; ++j) { int n = n0 + tx * 4 + j; atomicAdd(&X[(size_t)tok * D + n], mm[ga_off + n] * acc[i][j]); } } }
}
__global__ void k_final(const float* X, const float* gf, float* out) {
    int row = blockIdx.x * (blockDim.x >> 6) + (threadIdx.x >> 6), lane = threadIdx.x & 63; if (row >= SEQ) return;
    const float* xr = X + (size_t)row * D; float v[16]; float s = 0.f;
#pragma unroll
    for (int j = 0; j < 16; ++j) { v[j] = xr[lane + 64 * j]; s += v[j] * v[j]; }
    float rstd = rsqrtf(wave_sum(s) * (1.f / D) + EPS);
#pragma unroll
    for (int j = 0; j < 16; ++j) out[(size_t)row * D + lane + 64 * j] = v[j] * rstd * gf[lane + 64 * j];
}
}

extern "C" void kernel_launch(void* const* d_in, const int* in_sizes, int n_in, void* d_out, int out_size, void* d_ws, size_t ws_size, hipStream_t stream) {
    using namespace nv;
    const float* x = (const float*)d_in[0]; const float* c = (const float*)d_in[1]; const float* ctx = (const float*)d_in[2]; const float* cctx = (const float*)d_in[3];
    const float* w_ada = (const float*)d_in[4]; const float* b_ada = (const float*)d_in[5]; const float* g_mix = (const float*)d_in[6]; const float* g_ffn = (const float*)d_in[7];
    const float* w_in = (const float*)d_in[8]; const float* lam_re = (const float*)d_in[9]; const float* lam_im = (const float*)d_in[10]; const float* log_dt = (const float*)d_in[11];
    const float* b_re = (const float*)d_in[12]; const float* b_im = (const float*)d_in[13]; const float* c_re = (const float*)d_in[14]; const float* c_im = (const float*)d_in[15];
    const float* d_skip = (const float*)d_in[16]; const float* w_glu = (const float*)d_in[17]; const float* sg_ln_g = (const float*)d_in[18]; const float* sg_ln_b = (const float*)d_in[19];
    const float* w_sg = (const float*)d_in[20]; const float* b_sg = (const float*)d_in[21]; const float* w_conv = (const float*)d_in[22]; const float* w_branch = (const float*)d_in[23];
    const float* w_merge = (const float*)d_in[24]; const float* b_merge = (const float*)d_in[25]; const float* w_o = (const float*)d_in[26]; const float* w_grp = (const float*)d_in[27];
    const float* b_grp = (const float*)d_in[28]; const float* w_exp = (const float*)d_in[29]; const float* b_exp = (const float*)d_in[30]; const float* w1 = (const float*)d_in[31];
    const float* w3 = (const float*)d_in[32]; const float* w2 = (const float*)d_in[33]; const float* g_final = (const float*)d_in[34];
    float* out = (float*)d_out;
    char* ws = (char*)d_ws; size_t o = 0;
    auto take = [&](size_t bytes) { char* p = ws + o; o += (bytes + 255) & ~(size_t)255; return p; };
    float* X = (float*)take((size_t)MT * D * 4);
    float* H = (float*)take((size_t)MT * D * 4);
    float* YS = (float*)take((size_t)3 * MT * MIXW * 4);
    float* TMP = (float*)take((size_t)MT * 1536 * 4);
    float* MOD = (float*)take((size_t)2 * 2 * 6144 * 4);
    int* EID = (int*)take((size_t)MT * 2 * 4); float* EW = (float*)take((size_t)MT * 2 * 4);
    int* CNT = (int*)take(256);
    int* SLOT_TOK = (int*)take((size_t)MAXSLOT * 4); float* SLOT_W = (float*)take((size_t)MAXSLOT * 4);
    if (o > ws_size) return;
    hipMemcpyAsync(X, x, (size_t)SEQ * D * 4, hipMemcpyDeviceToDevice, stream);
    hipMemcpyAsync(X + (size_t)SEQ * D, ctx, (size_t)CTX * D * 4, hipMemcpyDeviceToDevice, stream);
    k_ada<<<(2 * 6144 + 255) / 256, 256, 0, stream>>>(c, cctx, w_ada, b_ada, MOD);
    const int rowblocks = (MT + 3) / 4;
    for (int l = 0; l < 2; ++l) {
        const float* mod_l = MOD + (size_t)l * 2 * 6144;
        const float* win_l = w_in + (size_t)l * D * INW;
        k_hprep<<<rowblocks, 256, 0, stream>>>(X, g_mix + l * D, mod_l, 0, 1024, H);
        float* UA = TMP; float* YD = TMP + (size_t)MT * MIXW;
        k_gemm<<<dim3(MIXW / 64, MT / 64, 1), 256, 0, stream>>>(H, win_l, 0, 0, D, INW, D, 0, EpiStore{UA, MIXW, 0});
        k_s5<<<64, 64, 0, stream>>>(UA, lam_re, lam_im, log_dt, b_re, b_im, c_re, c_im, YD, l, 0);
        k_s5fin<<<(MT * MIXW + 255) / 256, 256, 0, stream>>>(UA, YD, d_skip + l * MIXW);
        k_gemm<<<dim3(MIXW / 64, MT / 64, 1), 256, 0, stream>>>(UA, w_glu + (size_t)l * MIXW * MIXW, 0, 0, MIXW, MIXW, MIXW, 0, EpiGlu{UA, YS});
        float* SUV = TMP;
        k_gemm<<<dim3(1024 / 64, MT / 64, 1), 256, 0, stream>>>(H, win_l + 512, 0, 0, D, INW, D, 0, EpiGelu{SUV, 1024, 0});
        k_ln<<<rowblocks, 256, 0, stream>>>(SUV, sg_ln_g + l * MIXW, sg_ln_b + l * MIXW);
        for (int gg = 0; gg < 4; ++gg)
            k_gemm<<<dim3(2, 2, MT / 128), 256, 0, stream>>>(w_sg + ((size_t)l * 4 + gg) * 128 * 128, SUV + 512 + gg * 128, 0, (size_t)128 * 1024, 128, 1024, 128, 0,
                                                           EpiSg1{SUV, b_sg + l * 512, YS + (size_t)MT * MIXW, gg, 0});
        float* CG = TMP;
        k_gemm<<<dim3(1536 / 64, MT / 64, 1), 256, 0, stream>>>(H, win_l + 1536, 0, 0, D, INW, D, 0, EpiStore{CG, 1536, 0});
        k_conv<<<(MT * MIXW + 255) / 256, 256, 0, stream>>>(CG, w_conv + l * 3 * MIXW, YS + (size_t)2 * MT * MIXW);
        float* OP = TMP;
        k_outpre<<<dim3(D / 64, MT / 64), 256, 0, stream>>>(H, YS, w_merge + (size_t)l * D * 3072, b_merge + l * 3072, w_branch + (size_t)l * 3 * MIXW * D, OP);
        k_gemm<<<dim3(D / 64, MT / 64, 1), 256, 0, stream>>>(OP, w_o + (size_t)l * D * D, 0, 0, D, D, D, 0, EpiWo{X, mod_l, 2048, 0});
        k_hprep<<<rowblocks, 256, 0, stream>>>(X, g_ffn + l * D, mod_l, 3072, 4096, H);
        hipMemsetAsync(CNT, 0, 256, stream);
        hipMemsetAsync(SLOT_TOK, 0xFF, (size_t)MAXSLOT * 4, stream);
        k_route<<<rowblocks, 256, 0, stream>>>(H, w_grp + l * D * 4, b_grp + l * 4, w_exp + l * D * 32, b_exp + l * 32, EID, EW, CNT);
        k_fill<<<(MT * 2 + 255) / 256, 256, 0, stream>>>(EID, EW, CNT, CNT + 32, SLOT_TOK, SLOT_W);
        float* ACT = TMP;
        k_moe_up<<<dim3(DFF / 64, (2 * MT + 63) / 64, NE), 256, 0, stream>>>(H, CNT, SLOT_TOK, SLOT_W, w1 + (size_t)l * NE * D * DFF, w3 + (size_t)l * NE * D * DFF, ACT);
        k_moe_down<<<dim3(D / 64, (2 * MT + 63) / 64, NE), 256, 0, stream>>>(ACT, CNT, SLOT_TOK, w2 + (size_t)l * NE * DFF * D, mod_l, X, 5120, 0);
    }
    k_final<<<(SEQ + 3) / 4, 256, 0, stream>>>(X, g_final, out);
}
```

```cpp
#include <hip/hip_runtime.h>
#include <stdint.h>
#include <cstdio>

#define GAS __attribute__((address_space(1)))
#define LAS __attribute__((address_space(3)))
typedef unsigned short bf16;
typedef unsigned v4u __attribute__((ext_vector_type(4)));
typedef unsigned v2u __attribute__((ext_vector_type(2)));
typedef float f32x4 __attribute__((ext_vector_type(4)));

constexpr int D = 1024, SEQ = 16384, CTX = 256, MT = SEQ + CTX;
constexpr int MIXW = 512, INW = 3072, G5 = 32, P5 = 64, H5 = 16;
constexpr int NE = 32, DFF = 256;
constexpr int MAXSLOT = 2 * MT + NE * 256;
constexpr float EPS = 1e-6f;
constexpr int NT = 512;

constexpr size_t MiB = 1u << 20;
constexpr size_t WS_CTL = 0, CTL_ZERO_BYTES = 1 * MiB;
constexpr size_t WS_MOD = 1 * MiB;
constexpr size_t WS_XC = 2 * MiB;
constexpr size_t WS_EID = 3 * MiB;
constexpr size_t WS_EW = WS_EID + (size_t)MT * 8;
constexpr size_t WS_STOK = WS_EW + (size_t)MT * 8;
constexpr size_t WS_SW = WS_STOK + (size_t)MAXSLOT * 4;
constexpr size_t WS_TSLOT = WS_SW + (size_t)MAXSLOT * 4;
constexpr size_t WS_H = 4 * MiB;
constexpr size_t WS_PROJ = 37 * MiB;
constexpr size_t WS_YS = 135 * MiB;
constexpr size_t WS_YG = 184 * MiB;
constexpr size_t WS_PM = 201 * MiB;
constexpr size_t WS_S5 = 234 * MiB;
constexpr size_t WS_END = 300 * MiB;
constexpr size_t WS_HS = WS_PROJ;
constexpr size_t WS_ACT = WS_YS;
constexpr size_t WS_YS2 = WS_YG;
static_assert(WS_HS + (size_t)MAXSLOT * 2048 <= WS_YS && WS_ACT + (size_t)MAXSLOT * 512 <= WS_YG && WS_YS2 + (size_t)MAXSLOT * 2048 <= WS_END, "moe overlays");
static_assert(WS_TSLOT + (size_t)MT * 8 <= WS_H && WS_H + (size_t)MT * 2048 <= WS_PROJ && WS_PROJ + (size_t)MT * 6144 <= WS_YS && WS_YS + (size_t)3 * MT * 1024 <= WS_YG &&
              WS_YG + (size_t)MT * 1024 <= WS_PM && WS_PM + (size_t)MT * 2048 <= WS_S5 && WS_S5 + (size_t)2 * MT * 512 * 4 <= WS_END, "ws map");
constexpr int CW_CNT = 64;
constexpr int CW_BAR = 4096;

constexpr int LDS_BYTES = 147456;
constexpr int MISC_OFF = 131072 + 320;
constexpr int TAB_OFF = 131072 + 1024;

__device__ __forceinline__ float bf2f(unsigned short b) { return __builtin_bit_cast(float, ((unsigned)b) << 16); }
__device__ __forceinline__ unsigned f2bf(float f) { unsigned u = __builtin_bit_cast(unsigned, f); return (u + 0x7fffu + ((u >> 16) & 1u)) >> 16; }
__device__ __forceinline__ unsigned pk2(float lo, float hi) { return f2bf(lo) | (f2bf(hi) << 16); }
__device__ __forceinline__ float sigmoidf_(float x) { return 1.f / (1.f + __expf(-x)); }
__device__ __forceinline__ float siluf_(float x) { return x / (1.f + __expf(-x)); }
__device__ __forceinline__ float geluf_(float x) { const float u = 0.7978845608028654f * (x + 0.044715f * x * x * x); return x / (1.f + __expf(-2.f * u)); }
__device__ __forceinline__ float wave_sum(float v) {
#pragma unroll
    for (int o = 1; o < 64; o <<= 1) v += __shfl_xor(v, o);
    return v;
}

#define XB_TMO      128
#define XB_XCNT(j)  (256  + 64 * (j))
#define XB_XSUB(j)  (1280 + 64 * (j))
#define XB_XGEN(j)  (2304 + 64 * (j))
#define XB_TOP      3328
#define XB_TOPGEN   3392
#define XCD_BAR_WORDS 3456
#define XB_SPIN_CAP (1u << 24)
__device__ __forceinline__ unsigned xb_ld(unsigned* p)              { return __hip_atomic_load(p, __ATOMIC_RELAXED, __HIP_MEMORY_SCOPE_AGENT); }
__device__ __forceinline__ unsigned xb_add(unsigned* p, unsigned v) { return __hip_atomic_fetch_add(p, v, __ATOMIC_RELAXED, __HIP_MEMORY_SCOPE_AGENT); }
__device__ __forceinline__ unsigned xb_xcc_id() { return (unsigned)__builtin_amdgcn_s_getreg((3 << 11) | 20) & 0xFu; }
#define XB_SPIN(cond, bar) do { unsigned _sp = 0; while (cond) { __builtin_amdgcn_s_sleep(1); \
    if ((++_sp & 255u) == 0u) { if (xb_ld(&(bar)[XB_TMO])) break; if (_sp > XB_SPIN_CAP) { atomicAdd(&(bar)[XB_TMO], 1u); break; } } } } while (0)
struct XcdBarrier { unsigned* bar; unsigned x; volatile LAS unsigned* st; };
__device__ __forceinline__ XcdBarrier xcd_barrier_post(unsigned* bar, volatile LAS unsigned* st) {
    XcdBarrier b; b.bar = bar; b.x = xb_xcc_id(); b.st = st;
    if (threadIdx.x == 0) (void)xb_add(&bar[XB_XCNT(b.x)], 1u);
    return b;
}
__device__ __forceinline__ void xcd_barrier_complete(unsigned* bar, unsigned x, unsigned& nloc, unsigned& nx) {
    const unsigned G = gridDim.x * gridDim.y * gridDim.z;
    unsigned sum, cnt, mine, sp = 0u;
    for (;;) {
        sum = 0u; cnt = 0u; mine = 0u;
#pragma unroll
        for (unsigned j = 0; j < 16; ++j) { const unsigned c = xb_ld(&bar[XB_XCNT(j)]); sum += c; cnt += (c > 0u) ? 1u : 0u; mine = (j == x) ? c : mine; }
        if (sum == G) break;
        __builtin_amdgcn_s_sleep(1);
        if ((++sp & 255u) == 0u) { if (xb_ld(&bar[XB_TMO])) break; if (sp > XB_SPIN_CAP) { atomicAdd(&bar[XB_TMO], 1u); break; } }
    }
    nloc = mine > 0u ? mine : 1u; nx = cnt > 0u ? cnt : 1u;
}
__device__ __forceinline__ void xcd_barrier(const XcdBarrier& b) {
    asm volatile("s_waitcnt vmcnt(0)" ::: "memory");
    __syncthreads();
    if (threadIdx.x == 0) {
        unsigned* bar = b.bar;
        __builtin_amdgcn_s_waitcnt(0);
        unsigned nloc = b.st[0], nx = b.st[1];
        if (nloc == 0u) { xcd_barrier_complete(bar, b.x, nloc, nx); b.st[0] = nloc; b.st[1] = nx; }
        const unsigned old = xb_add(&bar[XB_XSUB(b.x)], 1u);
        const unsigned gen = old / nloc;
        if (old + 1u == (gen + 1u) * nloc) {
            __builtin_amdgcn_fence(__ATOMIC_RELEASE, "agent");
            asm volatile("s_waitcnt vmcnt(0)" ::: "memory");
            const unsigned og = xb_add(&bar[XB_TOP], 1u);
            const unsigned tg = og / nx;
            if (og + 1u == (tg + 1u) * nx) xb_add(&bar[XB_TOPGEN], 1u);
            else XB_SPIN(xb_ld(&bar[XB_TOPGEN]) == tg, bar);
            __builtin_amdgcn_fence(__ATOMIC_ACQUIRE, "agent");
            xb_add(&bar[XB_XGEN(b.x)], 1u);
            asm volatile("s_waitcnt vmcnt(0)" ::: "memory");
        } else {
            XB_SPIN(xb_ld(&bar[XB_XGEN(b.x)]) == gen, bar);
            __builtin_amdgcn_fence(__ATOMIC_ACQUIRE, "agent");
            asm volatile("s_waitcnt vmcnt(0)" ::: "memory");
        }
    }
    __syncthreads();
}

struct Args { const float* in[35]; float* out; unsigned char* ws; int ph_lo, ph_hi; };
struct Frame {
    LAS unsigned char* lds; unsigned char* ws; unsigned* ctl;
    int tid, lane, wave, bid, G;
    const float* LAS* tab; float* out;
};
#define IN_(k) (F.tab[k])
enum { I_X = 0, I_C, I_CTX, I_CCTX, I_WADA, I_BADA, I_GMIX, I_GFFN, I_WIN, I_LRE, I_LIM, I_LDT, I_BRE, I_BIM, I_CRE, I_CIM, I_DSKIP, I_WGLU, I_SGG, I_SGB, I_WSG, I_BSG,
       I_WCONV, I_WBR, I_WMG, I_BMG, I_WO, I_WGRP, I_BGRP, I_WEXP, I_BEXP, I_W1, I_W3, I_W2, I_GF };

__device__ __forceinline__ const float* mod_ptr(const Frame& F, int l, int row) { return (const float*)(F.ws + WS_MOD) + (size_t)(l * 2 + (row >= SEQ ? 1 : 0)) * 6144; }
__device__ __forceinline__ const float* xsrc_row(const Frame& F, int l, int row) {
    if (l == 0) return row < SEQ ? IN_(I_X) + (size_t)row * D : IN_(I_CTX) + (size_t)(row - SEQ) * D;
    return row < SEQ ? F.out + (size_t)row * D : (const float*)(F.ws + WS_XC) + (size_t)(row - SEQ) * D;
}
__device__ __forceinline__ float* xrun_row(const Frame& F, int row) { return row < SEQ ? F.out + (size_t)row * D : (float*)(F.ws + WS_XC) + (size_t)(row - SEQ) * D; }

struct NSmem { float As[16][68]; float Bs[16][68]; };
template <class AF>
__device__ __forceinline__ void ngemm_acc(float (&acc)[4][4], const AF& af, const float* B, int ldb, int K, LAS NSmem* s, int t) {
    const int ty = t >> 4, tx = t & 15, lr = t >> 2, lk = (t & 3) * 4, bk = t >> 4, bn = (t & 15) * 4;
    for (int k0 = 0; k0 < K; k0 += 16) {
        const float4 av = af.load4(lr, k0 + lk);
        const float4 bv = *(const float4*)(B + (size_t)(k0 + bk) * ldb + bn);
        __syncthreads();
        s->As[lk + 0][lr] = av.x; s->As[lk + 1][lr] = av.y; s->As[lk + 2][lr] = av.z; s->As[lk + 3][lr] = av.w;
        *(LAS f32x4*)&s->Bs[bk][bn] = (f32x4){bv.x, bv.y, bv.z, bv.w};
        __syncthreads();
#pragma unroll
        for (int k = 0; k < 16; ++k) {
            const f32x4 a = *(const LAS f32x4*)&s->As[k][ty * 4]; const f32x4 b = *(const LAS f32x4*)&s->Bs[k][tx * 4];
            const float aa[4] = {a.x, a.y, a.z, a.w}, bb[4] = {b.x, b.y, b.z, b.w};
#pragma unroll
            for (int i = 0; i < 4; ++i)
#pragma unroll
                for (int j = 0; j < 4; ++j) acc[i][j] += aa[i] * bb[j];
        }
    }
}
struct ABf { const bf16* A; int lda; __device__ __forceinline__ float4 load4(int r, int k) const { const v2u w = *(const v2u*)(A + (size_t)r * lda + k);
    return make_float4(bf2f((unsigned short)(w.x & 0xffff)), bf2f((unsigned short)(w.x >> 16)), bf2f((unsigned short)(w.y & 0xffff)), bf2f((unsigned short)(w.y >> 16))); } };
#define NTILE_BEGIN(ntiles) { const int _half = F.tid >> 8, t = F.tid & 255, ty = t >> 4, tx = t & 15; LAS NSmem* sm = (LAS NSmem*)F.lds + _half; (void)ty; (void)tx; \
    const int _nt = (ntiles), _nit = (_nt + 2 * F.G - 1) / (2 * F.G); \
    for (int _it = 0; _it < _nit; ++_it) { int T = (_it * F.G + F.bid) * 2 + _half; const bool valid = T < _nt; if (!valid) T = _nt - 1;
#define NTILE_END } }

__device__ __forceinline__ void ph0_prologue(Frame& F) {
    float* mod = (float*)(F.ws + WS_MOD);
    const int gt = F.bid * NT + F.tid, ngt = F.G * NT;
    for (int idx = gt; idx < 2 * 6144; idx += ngt) {
        const int l = idx / 6144, j = idx % 6144;
        const float* W = IN_(I_WADA) + (size_t)l * D * 6144 + j;
        float a0 = 0.f, a1 = 0.f;
        for (int k = 0; k < D; ++k) { const float w = W[(size_t)k * 6144]; a0 += siluf_(IN_(I_C)[k]) * w; a1 += siluf_(IN_(I_CCTX)[k]) * w; }
        const float b = IN_(I_BADA)[l * 6144 + j];
        mod[(size_t)(l * 2 + 0) * 6144 + j] = a0 + b; mod[(size_t)(l * 2 + 1) * 6144 + j] = a1 + b;
    }
}
__device__ __forceinline__ void hprep_rows(Frame& F, int l) {
    bf16* H = (bf16*)(F.ws + WS_H); const float* g = IN_(I_GMIX) + l * D;
    const int gw = F.bid * (NT / 64) + F.wave, ngw = F.G * (NT / 64);
    for (int row = gw; row < MT; row += ngw) {
        const float* m = mod_ptr(F, l, row); const float* xr = xsrc_row(F, l, row);
        f32x4 v[4]; float s = 0.f;
#pragma unroll
        for (int j = 0; j < 4; ++j) { v[j] = *(const f32x4*)(xr + 4 * F.lane + 256 * j); s += v[j].x * v[j].x + v[j].y * v[j].y + v[j].z * v[j].z + v[j].w * v[j].w; }
        const float rstd = rsqrtf(wave_sum(s) * (1.f / D) + EPS);
#pragma unroll
        for (int j = 0; j < 4; ++j) { const int c = 4 * F.lane + 256 * j; const f32x4 gg = *(const f32x4*)(g + c), sc = *(const f32x4*)(m + 1024 + c), sh = *(const f32x4*)(m + c);
            const f32x4 o = v[j] * rstd * gg * (1.f + sc) + sh; v2u w; w.x = pk2(o.x, o.y); w.y = pk2(o.z, o.w); *(v2u*)(H + (size_t)row * D + c) = w; }
    }
}
__device__ __forceinline__ void ph2_naive(Frame& F, int l) {
    const bf16* H = (const bf16*)(F.ws + WS_H); bf16* PROJ = (bf16*)(F.ws + WS_PROJ); const float* W = IN_(I_WIN) + (size_t)l * D * INW;
    NTILE_BEGIN((MT / 64) * (INW / 64))
        const int m0 = (T / (INW / 64)) * 64, n0 = (T % (INW / 64)) * 64;
        float acc[4][4] = {};
        ngemm_acc(acc, ABf{H + (size_t)m0 * D, D}, W + n0, INW, D, sm, t);
        if (valid) {
#pragma unroll
            for (int i = 0; i < 4; ++i) { float o[4];
#pragma unroll
                for (int j = 0; j < 4; ++j) { o[j] = acc[i][j]; if (n0 >= 512 && n0 < 1536) o[j] = geluf_(o[j]); }
                v2u w; w.x = pk2(o[0], o[1]); w.y = pk2(o[2], o[3]); *(v2u*)(PROJ + (size_t)(m0 + ty * 4 + i) * INW + n0 + tx * 4) = w; }
        }
    NTILE_END
}
__device__ __forceinline__ int chain_row(int dir, int pos) { return dir == 0 ? (pos < CTX ? SEQ + pos : pos - CTX) : (pos < CTX ? SEQ + CTX - 1 - pos : SEQ - 1 - (pos - CTX)); }
__device__ __forceinline__ void ph3_s5_naive(Frame& F, int l) {
    LAS float* Cr = (LAS float*)(F.lds + 32768); LAS float* Ci = Cr + 1024; LAS float* Sr = Ci + 1024; LAS float* Si = Sr + 2048;
    const bf16* PROJ = (const bf16*)(F.ws + WS_PROJ); float* YD = (float*)(F.ws + WS_S5);
    for (int item = F.bid; item < 64; item += F.G) {
        if (F.wave == 0) {
            const int g = item >> 1, dir = item & 1, p = F.lane;
            const int ldg = ((l * 2 + dir) * G5 + g);
            const float lr = IN_(I_LRE)[ldg * P5 + p], li = IN_(I_LIM)[ldg * P5 + p], dt = expf(IN_(I_LDT)[ldg]);
            const float er = expf(lr * dt), ar = er * cosf(li * dt), ai = er * sinf(li * dt);
            const float nr = ar - 1.f, ni = ai, den = lr * lr + li * li;
            const float qr = (nr * lr + ni * li) / den, qi = (ni * lr - nr * li) / den;
            float br[16], bi[16];
#pragma unroll
            for (int h = 0; h < 16; ++h) { const float x = IN_(I_BRE)[((size_t)ldg * P5 + p) * H5 + h], y = IN_(I_BIM)[((size_t)ldg * P5 + p) * H5 + h]; br[h] = qr * x - qi * y; bi[h] = qr * y + qi * x; }
            for (int h = 0; h < 16; ++h) { Cr[h * 64 + p] = IN_(I_CRE)[((size_t)ldg * H5 + h) * P5 + p]; Ci[h * 64 + p] = IN_(I_CIM)[((size_t)ldg * H5 + h) * P5 + p]; }
            float sr = 0.f, si = 0.f;
            float* Y = YD + (size_t)dir * MT * MIXW;
#pragma unroll 1
            for (int blk = 0; blk < MT / 32; ++blk) {
#pragma unroll 1
                for (int tt = 0; tt < 32; ++tt) {
                    const int row = chain_row(dir, blk * 32 + tt);
                    const v4u u0 = *(const v4u*)(PROJ + (size_t)row * INW + g * 16), u1 = *(const v4u*)(PROJ + (size_t)row * INW + g * 16 + 8);
                    const unsigned uw[8] = {u0.x, u0.y, u0.z, u0.w, u1.x, u1.y, u1.z, u1.w};
                    float xr = 0.f, xi = 0.f;
#pragma unroll
                    for (int h = 0; h < 8; ++h) { const float ua = bf2f((unsigned short)(uw[h] & 0xffff)), ub = bf2f((unsigned short)(uw[h] >> 16));
                        xr += br[2 * h] * ua + br[2 * h + 1] * ub; xi += bi[2 * h] * ua + bi[2 * h + 1] * ub; }
                    const float nsr = ar * sr - ai * si + xr, nsi = ar * si + ai * sr + xi;
                    sr = nsr; si = nsi; Sr[tt * 64 + p] = sr; Si[tt * 64 + p] = si;
                }
                asm volatile("s_waitcnt lgkmcnt(0)" ::: "memory");
#pragma unroll 1
                for (int o = p; o < 512; o += 64) {
                    const int tt = o >> 4, h = o & 15; float a = 0.f;
#pragma unroll 4
                    for (int q = 0; q < 64; ++q) a += Cr[h * 64 + q] * Sr[tt * 64 + q] - Ci[h * 64 + q] * Si[tt * 64 + q];
                    Y[(size_t)chain_row(dir, blk * 32 + tt) * MIXW + g * 16 + h] = a;
                }
                asm volatile("s_waitcnt lgkmcnt(0)" ::: "memory");
            }
        }
    }
}
__device__ __forceinline__ void ph3_sg_naive(Frame& F, int l) {
    const bf16* PROJ = (const bf16*)(F.ws + WS_PROJ); bf16* YB = (bf16*)(F.ws + WS_YS) + (size_t)MT * MIXW;
    LAS float* stat = (LAS float*)(F.lds + 32768);
    const float* lg = IN_(I_SGG) + l * MIXW; const float* lb = IN_(I_SGB) + l * MIXW;
    NTILE_BEGIN((MT / 128) * 16)
        const int chunk = T >> 4, gg = (T >> 2) & 3, q0 = ((T >> 1) & 1) * 64, c0 = (T & 1) * 64;
        LAS float* st = stat + _half * 256;
        __syncthreads();
        if (t < 128) { const bf16* vr = PROJ + (size_t)(chunk * 128 + t) * INW + 1024; float s = 0.f;
            for (int c = 0; c < 512; c += 2) { const unsigned w = *(const unsigned*)(vr + c); s += bf2f((unsigned short)(w & 0xffff)) + bf2f((unsigned short)(w >> 16)); }
            const float mu = s * (1.f / 512.f); float q = 0.f;
            for (int c = 0; c < 512; c += 2) { const unsigned w = *(const unsigned*)(vr + c); const float a = bf2f((unsigned short)(w & 0xffff)) - mu, b = bf2f((unsigned short)(w >> 16)) - mu; q += a * a + b * b; }
            st[t * 2] = mu; st[t * 2 + 1] = rsqrtf(q * (1.f / 512.f) + EPS); }
        __syncthreads();
        float acc[4][4] = {};
        {
            const float* A = IN_(I_WSG) + ((size_t)(l * 4 + gg) * 128 + q0) * 128;
            const int lr = t >> 2, lk = (t & 3) * 4, bk = t >> 4, bn = (t & 15) * 4;
            for (int k0 = 0; k0 < 128; k0 += 16) {
                const float4 av = *(const float4*)(A + (size_t)lr * 128 + k0 + lk);
                const int p = k0 + bk; const int col = gg * 128 + c0 + bn;
                const v2u w = *(const v2u*)(PROJ + (size_t)(chunk * 128 + p) * INW + 1024 + col);
                const float mu = st[p * 2], rs = st[p * 2 + 1];
                float4 bv; bv.x = (bf2f((unsigned short)(w.x & 0xffff)) - mu) * rs * lg[col] + lb[col]; bv.y = (bf2f((unsigned short)(w.x >> 16)) - mu) * rs * lg[col + 1] + lb[col + 1];
                bv.z = (bf2f((unsigned short)(w.y & 0xffff)) - mu) * rs * lg[col + 2] + lb[col + 2]; bv.w = (bf2f((unsigned short)(w.y >> 16)) - mu) * rs * lg[col + 3] + lb[col + 3];
                __syncthreads();
                sm->As[lk + 0][lr] = av.x; sm->As[lk + 1][lr] = av.y; sm->As[lk + 2][lr] = av.z; sm->As[lk + 3][lr] = av.w;
                *(LAS f32x4*)&sm->Bs[bk][bn] = (f32x4){bv.x, bv.y, bv.z, bv.w};
                __syncthreads();
#pragma unroll
                for (int k = 0; k < 16; ++k) { const f32x4 a = *(const LAS f32x4*)&sm->As[k][ty * 4]; const f32x4 b = *(const LAS f32x4*)&sm->Bs[k][tx * 4];
                    const float aa[4] = {a.x, a.y, a.z, a.w}, bb[4] = {b.x, b.y, b.z, b.w};
#pragma unroll
                    for (int i = 0; i < 4; ++i)
#pragma unroll
                        for (int j = 0; j < 4; ++j) acc[i][j] += aa[i] * bb[j]; }
            }
        }
        if (valid) {
#pragma unroll
            for (int i = 0; i < 4; ++i) { const int q = q0 + ty * 4 + i; const size_t row = (size_t)chunk * 128 + q; const int col = gg * 128 + c0 + tx * 4;
                const float bq = IN_(I_BSG)[l * 512 + gg * 128 + q];
                const v2u gu = *(const v2u*)(PROJ + row * INW + 512 + col);
                v2u w; w.x = pk2(bf2f((unsigned short)(gu.x & 0xffff)) * (acc[i][0] + bq), bf2f((unsigned short)(gu.x >> 16)) * (acc[i][1] + bq));
                w.y = pk2(bf2f((unsigned short)(gu.y & 0xffff)) * (acc[i][2] + bq), bf2f((unsigned short)(gu.y >> 16)) * (acc[i][3] + bq));
                *(v2u*)(YB + row * MIXW + col) = w; }
        }
    NTILE_END
}
__device__ __forceinline__ void ph3_conv(Frame& F, int l) {
    const bf16* PROJ = (const bf16*)(F.ws + WS_PROJ); bf16* YC = (bf16*)(F.ws + WS_YS) + (size_t)2 * MT * MIXW; const float* wc = IN_(I_WCONV) + l * 3 * MIXW;
    const size_t gt = (size_t)F.bid * NT + F.tid, ngt = (size_t)F.G * NT;
    for (size_t i = gt; i < (size_t)MT * (MIXW / 2); i += ngt) {
        const int row = (int)(i / (MIXW / 2)), c = (int)(i % (MIXW / 2)) * 2;
        int pos, rl; if (row < SEQ) { pos = row & 63; rl = 64; } else { pos = row - SEQ; rl = 256; }
        const bf16* r0 = PROJ + (size_t)row * INW + 1536;
        const unsigned b0 = *(const unsigned*)(r0 + c), c0 = *(const unsigned*)(r0 + 512 + c), h0 = *(const unsigned*)(r0 + 1024 + c);
        float zm0 = 0.f, zm1 = 0.f, zp0 = 0.f, zp1 = 0.f;
        if (pos > 0) { const unsigned cc = *(const unsigned*)(r0 - INW + 512 + c), hh = *(const unsigned*)(r0 - INW + 1024 + c); zm0 = bf2f((unsigned short)(cc & 0xffff)) * bf2f((unsigned short)(hh & 0xffff)); zm1 = bf2f((unsigned short)(cc >> 16)) * bf2f((unsigned short)(hh >> 16)); }
        if (pos < rl - 1) { const unsigned cc = *(const unsigned*)(r0 + INW + 512 + c), hh = *(const unsigned*)(r0 + INW + 1024 + c); zp0 = bf2f((unsigned short)(cc & 0xffff)) * bf2f((unsigned short)(hh & 0xffff)); zp1 = bf2f((unsigned short)(cc >> 16)) * bf2f((unsigned short)(hh >> 16)); }
        const float z00 = bf2f((unsigned short)(c0 & 0xffff)) * bf2f((unsigned short)(h0 & 0xffff)), z01 = bf2f((unsigned short)(c0 >> 16)) * bf2f((unsigned short)(h0 >> 16));
        const float y0 = bf2f((unsigned short)(b0 & 0xffff)) * (wc[c] * zm0 + wc[512 + c] * z00 + wc[1024 + c] * zp0);
        const float y1 = bf2f((unsigned short)(b0 >> 16)) * (wc[c + 1] * zm1 + wc[512 + c + 1] * z01 + wc[1024 + c + 1] * zp1);
        *(unsigned*)(YC + (size_t)row * MIXW + c) = pk2(y0, y1);
    }
}
__device__ __forceinline__ void ph5_naive(Frame& F, int l) {
    const bf16* PROJ = (const bf16*)(F.ws + WS_PROJ); const float* YD = (const float*)(F.ws + WS_S5); bf16* YG = (bf16*)(F.ws + WS_YG); const float* ds = IN_(I_DSKIP) + l * MIXW;
    const size_t gt = (size_t)F.bid * NT + F.tid, ngt = (size_t)F.G * NT;
    for (size_t i = gt; i < (size_t)MT * (MIXW / 2); i += ngt) {
        const int row = (int)(i / (MIXW / 2)), c = (int)(i % (MIXW / 2)) * 2;
        const unsigned u = *(const unsigned*)(PROJ + (size_t)row * INW + c); const size_t o = (size_t)row * MIXW + c;
        const float y0 = YD[o] + YD[(size_t)MT * MIXW + o] + ds[c] * bf2f((unsigned short)(u & 0xffff)), y1 = YD[o + 1] + YD[(size_t)MT * MIXW + o + 1] + ds[c + 1] * bf2f((unsigned short)(u >> 16));
        *(unsigned*)(YG + o) = pk2(geluf_(y0), geluf_(y1));
    }
}
__device__ __forceinline__ void ph6_naive(Frame& F, int l) {
    const bf16* YG = (const bf16*)(F.ws + WS_YG); bf16* YA = (bf16*)(F.ws + WS_YS); const float* W = IN_(I_WGLU) + (size_t)l * MIXW * MIXW;
    NTILE_BEGIN((MT / 64) * (MIXW / 64))
        const int m0 = (T / (MIXW / 64)) * 64, n0 = (T % (MIXW / 64)) * 64;
        float acc[4][4] = {};
        ngemm_acc(acc, ABf{YG + (size_t)m0 * MIXW, MIXW}, W + n0, MIXW, MIXW, sm, t);
        if (valid) {
#pragma unroll
            for (int i = 0; i < 4; ++i) { const size_t o = (size_t)(m0 + ty * 4 + i) * MIXW + n0 + tx * 4; const v2u g = *(const v2u*)(YG + o);
                v2u w; w.x = pk2(bf2f((unsigned short)(g.x & 0xffff)) * sigmoidf_(acc[i][0]), bf2f((unsigned short)(g.x >> 16)) * sigmoidf_(acc[i][1]));
                w.y = pk2(bf2f((unsigned short)(g.y & 0xffff)) * sigmoidf_(acc[i][2]), bf2f((unsigned short)(g.y >> 16)) * sigmoidf_(acc[i][3])); *(v2u*)(YA + o) = w; }
        }
    NTILE_END
}
__device__ __forceinline__ void ph7_naive(Frame& F, int l) {
    const bf16* YS = (const bf16*)(F.ws + WS_YS); bf16* BR = (bf16*)(F.ws + WS_PROJ); const float* W = IN_(I_WBR) + (size_t)l * 3 * MIXW * D;
    NTILE_BEGIN((MT / 64) * (INW / 64))
        const int m0 = (T / (INW / 64)) * 64, n0 = (T % (INW / 64)) * 64, k = n0 / 1024, d0 = n0 % 1024;
        float acc[4][4] = {};
        ngemm_acc(acc, ABf{YS + (size_t)k * MT * MIXW + (size_t)m0 * MIXW, MIXW}, W + (size_t)k * MIXW * D + d0, D, MIXW, sm, t);
        if (valid) {
#pragma unroll
            for (int i = 0; i < 4; ++i) { v2u w; w.x = pk2(acc[i][0], acc[i][1]); w.y = pk2(acc[i][2], acc[i][3]); *(v2u*)(BR + (size_t)(m0 + ty * 4 + i) * INW + n0 + tx * 4) = w; }
        }
    NTILE_END
}
__device__ __forceinline__ void ph8_naive(Frame& F, int l) {
    const bf16* H = (const bf16*)(F.ws + WS_H); const bf16* BR = (const bf16*)(F.ws + WS_PROJ); bf16* PM = (bf16*)(F.ws + WS_PM);
    const float* W = IN_(I_WMG) + (size_t)l * D * INW; const float* bm = IN_(I_BMG) + l * INW;
    NTILE_BEGIN((MT / 64) * (D / 64))
        const int m0 = (T / (D / 64)) * 64, n0 = (T % (D / 64)) * 64;
        float out[4][4] = {};
        for (int k = 0; k < 3; ++k) {
            float acc[4][4] = {};
            ngemm_acc(acc, ABf{H + (size_t)m0 * D, D}, W + k * 1024 + n0, INW, D, sm, t);
#pragma unroll
            for (int i = 0; i < 4; ++i) { const v2u b = *(const v2u*)(BR + (size_t)(m0 + ty * 4 + i) * INW + k * 1024 + n0 + tx * 4);
                const float bb[4] = {bf2f((unsigned short)(b.x & 0xffff)), bf2f((unsigned short)(b.x >> 16)), bf2f((unsigned short)(b.y & 0xffff)), bf2f((unsigned short)(b.y >> 16))};
#pragma unroll
                for (int j = 0; j < 4; ++j) out[i][j] += sigmoidf_(acc[i][j] + bm[k * 1024 + n0 + tx * 4 + j]) * bb[j]; }
        }
        if (valid) {
#pragma unroll
            for (int i = 0; i < 4; ++i) { v2u w; w.x = pk2(out[i][0], out[i][1]); w.y = pk2(out[i][2], out[i][3]); *(v2u*)(PM + (size_t)(m0 + ty * 4 + i) * D + n0 + tx * 4) = w; }
        }
    NTILE_END
}
__device__ __forceinline__ void ph9_naive(Frame& F, int l) {
    const bf16* PM = (const bf16*)(F.ws + WS_PM); const float* W = IN_(I_WO) + (size_t)l * D * D;
    NTILE_BEGIN((MT / 64) * (D / 64))
        const int m0 = (T / (D / 64)) * 64, n0 = (T % (D / 64)) * 64;
        float acc[4][4] = {};
        ngemm_acc(acc, ABf{PM + (size_t)m0 * D, D}, W + n0, D, D, sm, t);
        if (valid) {
#pragma unroll
            for (int i = 0; i < 4; ++i) { const int row = m0 + ty * 4 + i, c = n0 + tx * 4; const float* m = mod_ptr(F, l, row) + 2048 + c;
                const f32x4 xs = *(const f32x4*)(xsrc_row(F, l, row) + c);
                f32x4 o; o.x = xs.x + m[0] * acc[i][0]; o.y = xs.y + m[1] * acc[i][1]; o.z = xs.z + m[2] * acc[i][2]; o.w = xs.w + m[3] * acc[i][3];
                *(f32x4*)(xrun_row(F, row) + c) = o; }
        }
    NTILE_END
}
__device__ __forceinline__ void ph10_route(Frame& F, int l) {
    bf16* H = (bf16*)(F.ws + WS_H); const float* g = IN_(I_GFFN) + l * D;
    const float* wg = IN_(I_WGRP) + (size_t)l * D * 4; const float* we = IN_(I_WEXP) + (size_t)l * D * 32; const float* bg = IN_(I_BGRP) + l * 4; const float* be = IN_(I_BEXP) + l * 32;
    int* EID = (int*)(F.ws + WS_EID); float* EW = (float*)(F.ws + WS_EW); unsigned* cnt = F.ctl + CW_CNT + l * 128;
    LAS float* L = (LAS float*)(F.lds + 65536) + F.wave * 40;
    const int gw = F.bid * (NT / 64) + F.wave, ngw = F.G * (NT / 64);
    for (int row = gw; row < MT; row += ngw) {
        const float* m = mod_ptr(F, l, row); const float* xr = xrun_row(F, row);
        float s = 0.f;
#pragma unroll
        for (int j = 0; j < 4; ++j) { const f32x4 x = *(const f32x4*)(xr + 4 * F.lane + 256 * j); s += x.x * x.x + x.y * x.y + x.z * x.z + x.w * x.w; }
        const float rstd = rsqrtf(wave_sum(s) * (1.f / D) + EPS);
        float acc[36];
#pragma unroll
        for (int o = 0; o < 36; ++o) acc[o] = 0.f;
#pragma unroll 1
        for (int j = 0; j < 4; ++j) { const int c = 4 * F.lane + 256 * j; const f32x4 x = *(const f32x4*)(xr + c); const f32x4 gg = *(const f32x4*)(g + c), sc = *(const f32x4*)(m + 4096 + c), sh = *(const f32x4*)(m + 3072 + c);
            const f32x4 o = x * rstd * gg * (1.f + sc) + sh; v2u w; w.x = pk2(o.x, o.y); w.y = pk2(o.z, o.w); *(v2u*)(H + (size_t)row * D + c) = w;
            const float hv[4] = {o.x, o.y, o.z, o.w};
#pragma unroll
            for (int e = 0; e < 4; ++e) { const float* wgr = wg + (size_t)(c + e) * 4; const float* wer = we + (size_t)(c + e) * 32;
#pragma unroll
                for (int q = 0; q < 4; ++q) acc[q] += hv[e] * wgr[q];
#pragma unroll
                for (int q = 0; q < 32; ++q) acc[4 + q] += hv[e] * wer[q]; } }
#pragma unroll
        for (int o = 0; o < 36; ++o) acc[o] = wave_sum(acc[o]);
        if (F.lane == 0) {
#pragma unroll
            for (int o = 0; o < 4; ++o) L[o] = acc[o] + bg[o];
#pragma unroll
            for (int o = 0; o < 32; ++o) L[4 + o] = acc[4 + o] + be[o];
            int gi = 0; float gm = L[0]; for (int o = 1; o < 4; ++o) if (L[o] > gm) { gm = L[o]; gi = o; }
            float den = 0.f; for (int o = 0; o < 4; ++o) den += expf(L[o] - gm);
            const float gp = 1.f / den;
            const LAS float* el = L + 4 + gi * 8;
            int i1 = 0; float m1 = el[0]; for (int o = 1; o < 8; ++o) if (el[o] > m1) { m1 = el[o]; i1 = o; }
            int i2 = -1; float m2 = 0.f; for (int o = 0; o < 8; ++o) if (o != i1 && (i2 < 0 || el[o] > m2)) { m2 = el[o]; i2 = o; }
            const float e2 = expf(m2 - m1); const float w1 = 1.f / (1.f + e2), w2 = e2 / (1.f + e2);
            const int e1i = gi * 8 + i1, e2i = gi * 8 + i2;
            EID[row * 2] = e1i; EID[row * 2 + 1] = e2i; EW[row * 2] = gp * w1; EW[row * 2 + 1] = gp * w2;
            atomicAdd(&cnt[e1i], 1u); atomicAdd(&cnt[e2i], 1u);
        }
    }
}
__device__ __forceinline__ int expert_off(const unsigned* cnt, int e) { int o = 0; for (int i = 0; i < e; ++i) o += ((int)cnt[i] + 255) & ~255; return o; }
__device__ __forceinline__ void ph11_scatter(Frame& F, int l) {
    const bf16* H = (const bf16*)(F.ws + WS_H); bf16* HS = (bf16*)(F.ws + WS_HS);
    const int* EID = (const int*)(F.ws + WS_EID); const float* EW = (const float*)(F.ws + WS_EW); int* STOK = (int*)(F.ws + WS_STOK); float* SW = (float*)(F.ws + WS_SW); int* TSLOT = (int*)(F.ws + WS_TSLOT);
    unsigned* cnt = F.ctl + CW_CNT + l * 128; unsigned* fill = cnt + 64;
    const int gw = F.bid * (NT / 64) + F.wave, ngw = F.G * (NT / 64);
    for (int i = gw; i < MT * 2; i += ngw) {
        int slot = 0;
        if (F.lane == 0) { const int e = EID[i]; const int pos = (int)atomicAdd(&fill[e], 1u); slot = expert_off(cnt, e) + pos; STOK[slot] = i >> 1; SW[slot] = EW[i]; TSLOT[i] = slot; }
        slot = __shfl(slot, 0);
        const v4u* src = (const v4u*)(H + (size_t)(i >> 1) * D); v4u* dst = (v4u*)(HS + (size_t)slot * D);
        dst[F.lane] = src[F.lane]; dst[F.lane + 64] = src[F.lane + 64];
    }
}
__device__ __forceinline__ int slot_expert(const unsigned* cnt, int slot0, int& seg_off, int& n_e) { int o = 0; for (int e = 0; e < NE; ++e) { const int n = (int)cnt[e], pn = (n + 255) & ~255; if (slot0 < o + pn) { seg_off = o; n_e = n; return e; } o += pn; } seg_off = o; n_e = 0; return 0; }
__device__ __forceinline__ void ph12_naive(Frame& F, int l) {
    const bf16* HS = (const bf16*)(F.ws + WS_HS); bf16* ACT = (bf16*)(F.ws + WS_ACT); const float* SW = (const float*)(F.ws + WS_SW);
    const unsigned* cnt = F.ctl + CW_CNT + l * 128; const int total = expert_off(cnt, NE);
    NTILE_BEGIN((total / 64) * (DFF / 64))
        const int s0 = (T / (DFF / 64)) * 64, n0 = (T % (DFF / 64)) * 64; int seg, n_e; const int e = slot_expert(cnt, s0, seg, n_e);
        float aa[4][4] = {}, ab[4][4] = {};
        ngemm_acc(aa, ABf{HS + (size_t)s0 * D, D}, IN_(I_W1) + ((size_t)l * NE + e) * D * DFF + n0, DFF, D, sm, t);
        ngemm_acc(ab, ABf{HS + (size_t)s0 * D, D}, IN_(I_W3) + ((size_t)l * NE + e) * D * DFF + n0, DFF, D, sm, t);
        if (valid) {
#pragma unroll
            for (int i = 0; i < 4; ++i) { const int slot = s0 + ty * 4 + i; if (slot - seg < n_e) { const float w = SW[slot];
                v2u o; o.x = pk2(siluf_(aa[i][0]) * ab[i][0] * w, siluf_(aa[i][1]) * ab[i][1] * w); o.y = pk2(siluf_(aa[i][2]) * ab[i][2] * w, siluf_(aa[i][3]) * ab[i][3] * w);
                *(v2u*)(ACT + (size_t)slot * DFF + n0 + tx * 4) = o; } }
        }
    NTILE_END
}
__device__ __forceinline__ void ph13_naive(Frame& F, int l) {
    const bf16* ACT = (const bf16*)(F.ws + WS_ACT); bf16* YS2 = (bf16*)(F.ws + WS_YS2);
    const unsigned* cnt = F.ctl + CW_CNT + l * 128; const int total = expert_off(cnt, NE);
    NTILE_BEGIN((total / 64) * (D / 64))
        const int s0 = (T / (D / 64)) * 64, n0 = (T % (D / 64)) * 64; int seg, n_e; const int e = slot_expert(cnt, s0, seg, n_e);
        float acc[4][4] = {};
        ngemm_acc(acc, ABf{ACT + (size_t)s0 * DFF, DFF}, IN_(I_W2) + ((size_t)l * NE + e) * DFF * D + n0, D, DFF, sm, t);
        if (valid) {
#pragma unroll
            for (int i = 0; i < 4; ++i) { const int slot = s0 + ty * 4 + i; if (slot - seg < n_e) { v2u o; o.x = pk2(acc[i][0], acc[i][1]); o.y = pk2(acc[i][2], acc[i][3]); *(v2u*)(YS2 + (size_t)slot * D + n0 + tx * 4) = o; } }
        }
    NTILE_END
}
__device__ __forceinline__ void ph14_combine(Frame& F, int l) {
    const bf16* YS2 = (const bf16*)(F.ws + WS_YS2); const int* TSLOT = (const int*)(F.ws + WS_TSLOT); bf16* H = (bf16*)(F.ws + WS_H);
    const int gw = F.bid * (NT / 64) + F.wave, ngw = F.G * (NT / 64);
    const int nrows = l == 0 ? MT : SEQ;
    for (int row = gw; row < nrows; row += ngw) {
        const float* m = mod_ptr(F, l, row); float* xr = xrun_row(F, row);
        const int s0 = TSLOT[row * 2], s1 = TSLOT[row * 2 + 1];
        f32x4 v[4]; float s = 0.f;
#pragma unroll
        for (int j = 0; j < 4; ++j) { const int c = 4 * F.lane + 256 * j; const f32x4 x = *(const f32x4*)(xr + c); const f32x4 ga = *(const f32x4*)(m + 5120 + c);
            const v2u a = *(const v2u*)(YS2 + (size_t)s0 * D + c), b = *(const v2u*)(YS2 + (size_t)s1 * D + c);
            f32x4 y; y.x = bf2f((unsigned short)(a.x & 0xffff)) + bf2f((unsigned short)(b.x & 0xffff)); y.y = bf2f((unsigned short)(a.x >> 16)) + bf2f((unsigned short)(b.x >> 16));
            y.z = bf2f((unsigned short)(a.y & 0xffff)) + bf2f((unsigned short)(b.y & 0xffff)); y.w = bf2f((unsigned short)(a.y >> 16)) + bf2f((unsigned short)(b.y >> 16));
            v[j] = x + ga * y; s += v[j].x * v[j].x + v[j].y * v[j].y + v[j].z * v[j].z + v[j].w * v[j].w; }
        const float rstd = rsqrtf(wave_sum(s) * (1.f / D) + EPS);
        if (l == 0) {
            const float* m1 = mod_ptr(F, 1, row); const float* g = IN_(I_GMIX) + D;
#pragma unroll
            for (int j = 0; j < 4; ++j) { const int c = 4 * F.lane + 256 * j; *(f32x4*)(xr + c) = v[j];
                const f32x4 gg = *(const f32x4*)(g + c), sc = *(const f32x4*)(m1 + 1024 + c), sh = *(const f32x4*)(m1 + c);
                const f32x4 o = v[j] * rstd * gg * (1.f + sc) + sh; v2u w; w.x = pk2(o.x, o.y); w.y = pk2(o.z, o.w); *(v2u*)(H + (size_t)row * D + c) = w; }
        } else {
            const float* g = IN_(I_GF);
#pragma unroll
            for (int j = 0; j < 4; ++j) { const int c = 4 * F.lane + 256 * j; const f32x4 gg = *(const f32x4*)(g + c); *(f32x4*)(xr + c) = v[j] * rstd * gg; }
        }
    }
}

constexpr int NPH = 2 + 13 * 2;
__global__ void __launch_bounds__(NT, 2) mega_fwd(Args args) {
    extern __shared__ __attribute__((aligned(16))) unsigned char lds_raw[];
    Frame F0;
    { Frame& F = F0;
    F.lds = (LAS unsigned char*)lds_raw; F.ws = args.ws; F.ctl = (unsigned*)(args.ws + WS_CTL);
    F.tid = threadIdx.x; F.lane = F.tid & 63; F.wave = __builtin_amdgcn_readfirstlane(F.tid >> 6); F.bid = blockIdx.x; F.G = gridDim.x;
    F.out = args.out; F.tab = (const float* LAS*)(F.lds + TAB_OFF);
    if (F.tid == 0) {
#pragma unroll
        for (int i = 0; i < 35; ++i) F.tab[i] = args.in[i];
    } }
    const Frame& F = F0;
    volatile LAS unsigned* MISC = (volatile LAS unsigned*)(F.lds + MISC_OFF);
    for (int u = F.tid; u < 1024 / 4; u += NT) ((LAS unsigned*)(F.lds + 131072))[u] = 0u;
    __syncthreads();
    XcdBarrier bar = xcd_barrier_post(F.ctl + CW_BAR, MISC + 8);
    const int lo = args.ph_lo, hi = args.ph_hi; int ph = 0;
#define PHASE(...) do { if (lo <= ph && ph < hi) { { Frame F = F0; asm volatile("" : "+v"(F.tid)); F.lane = F.tid & 63; __VA_ARGS__; } if (ph + 1 < hi) xcd_barrier(bar); } ++ph; } while (0)
    PHASE({ ph0_prologue(F); { const f32x4* s = (const f32x4*)IN_(I_CTX); f32x4* d = (f32x4*)(F.ws + WS_XC); for (int i = F.bid * NT + F.tid; i < CTX * D / 4; i += F.G * NT) d[i] = s[i]; } });
    PHASE(hprep_rows(F, 0));
#pragma unroll 1
    for (int l = 0; l < 2; ++l) {
        PHASE(ph2_naive(F, l));
        PHASE({ ph3_s5_naive(F, l); if (F.bid >= 64) { Frame F2 = F; F2.bid -= 64; F2.G -= 64; ph3_sg_naive(F2, l); ph3_conv(F2, l); } });
        PHASE({});
        PHASE(ph5_naive(F, l));
        PHASE(ph6_naive(F, l));
        PHASE(ph7_naive(F, l));
        PHASE(ph8_naive(F, l));
        PHASE(ph9_naive(F, l));
        PHASE(ph10_route(F, l));
        PHASE(ph11_scatter(F, l));
        PHASE(ph12_naive(F, l));
        PHASE(ph13_naive(F, l));
        PHASE(ph14_combine(F, l));
    }
#undef PHASE
}

extern "C" void kernel_launch(void* const* d_in, const int* in_sizes, int n_in, void* d_out, int out_size, void* d_ws, size_t ws_size, hipStream_t stream) {
    static int grid = 0;
    if (grid == 0) {
        int dev = 0, cus = 0, per_cu = 0;
        if (n_in != 35 || out_size != SEQ * D || ws_size < WS_END) { fprintf(stderr, "kernel_launch: unexpected shapes (n_in %d out %d ws %zu)\n", n_in, out_size, ws_size); grid = -1; return; }
        if (hipGetDevice(&dev) != hipSuccess || hipDeviceGetAttribute(&cus, hipDeviceAttributeMultiprocessorCount, dev) != hipSuccess) { grid = -1; return; }
        if (hipFuncSetAttribute((const void*)mega_fwd, hipFuncAttributeMaxDynamicSharedMemorySize, LDS_BYTES) != hipSuccess) { fprintf(stderr, "kernel_launch: hipFuncSetAttribute failed\n"); grid = -1; return; }
        if (hipOccupancyMaxActiveBlocksPerMultiprocessor(&per_cu, (const void*)mega_fwd, NT, LDS_BYTES) != hipSuccess || per_cu < 1) { fprintf(stderr, "kernel_launch: occupancy query says %d blocks per CU\n", per_cu); grid = -1; return; }
        grid = cus;
    }
    if (grid < 0) return;
    (void)hipMemsetAsync((char*)d_ws + WS_CTL, 0, CTL_ZERO_BYTES, stream);
    Args a{};
    for (int i = 0; i < 35; ++i) a.in[i] = (const float*)d_in[i];
    a.out = (float*)d_out; a.ws = (unsigned char*)d_ws; a.ph_lo = 0; a.ph_hi = NPH;
    void* kargs[] = {&a};
    hipError_t e = hipLaunchCooperativeKernel((const void*)mega_fwd, dim3(grid), dim3(NT), kargs, LDS_BYTES, stream);
    if (e != hipSuccess) fprintf(stderr, "kernel_launch: cooperative launch failed: %s (grid %d)\n", hipGetErrorString(e), grid);
}
```

```cpp
#include <hip/hip_runtime.h>
#include <stdint.h>
#include <cstdio>

#define GAS __attribute__((address_space(1)))
#define LAS __attribute__((address_space(3)))
typedef unsigned short bf16;
typedef unsigned v4u __attribute__((ext_vector_type(4)));
typedef unsigned v2u __attribute__((ext_vector_type(2)));
typedef float f32x4 __attribute__((ext_vector_type(4)));

constexpr int D = 1024, SEQ = 16384, CTX = 256, MT = SEQ + CTX;
constexpr int MIXW = 512, INW = 3072, G5 = 32, P5 = 64, H5 = 16;
constexpr int NE = 32, DFF = 256;
constexpr int MAXSLOT = 2 * MT + NE * 256;
constexpr float EPS = 1e-6f;
constexpr int NT = 512;

constexpr size_t MiB = 1u << 20;
constexpr size_t WS_CTL = 0, CTL_ZERO_BYTES = 1 * MiB;
constexpr size_t WS_MOD = 1 * MiB;
constexpr size_t WS_XC = 2 * MiB;
constexpr size_t WS_EID = 3 * MiB;
constexpr size_t WS_EW = WS_EID + (size_t)MT * 8;
constexpr size_t WS_STOK = WS_EW + (size_t)MT * 8;
constexpr size_t WS_SW = WS_STOK + (size_t)MAXSLOT * 4;
constexpr size_t WS_TSLOT = WS_SW + (size_t)MAXSLOT * 4;
constexpr size_t WS_H = 4 * MiB;
constexpr size_t WS_PROJ = WS_H + (size_t)MT * 2048;
constexpr size_t WS_YS = WS_PROJ + (size_t)MT * 6144;
constexpr size_t WS_YG = WS_YS + (size_t)3 * MT * 1024;
constexpr size_t WS_PM = WS_YG + (size_t)MT * 1024;
constexpr size_t WS_S5 = WS_PM + (size_t)MT * 2048;
constexpr size_t WS_W = WS_S5 + (size_t)2 * MT * 512 * 4;
constexpr size_t WS_WIN = WS_W;
constexpr size_t WS_WMG = WS_WIN + (size_t)3072 * 1024 * 2;
constexpr size_t WS_WGLU = WS_WMG + (size_t)3072 * 1024 * 2;
constexpr size_t WS_WBR = WS_WGLU + (size_t)512 * 512 * 2;
constexpr size_t WS_WO = WS_WBR + (size_t)3 * 1024 * 512 * 2;
constexpr size_t WS_W13 = WS_WO + (size_t)1024 * 1024 * 2;
constexpr size_t WS_W2 = WS_W13 + (size_t)32 * 512 * 1024 * 2;
constexpr size_t WS_WSG = WS_W2 + (size_t)32 * 1024 * 256 * 2;
constexpr size_t WS_END = WS_WSG + (size_t)4 * 128 * 128 * 2;
static_assert(WS_END <= (size_t)377 * MiB, "workspace budget");
constexpr size_t WS_HS = WS_PROJ;
constexpr size_t WS_ACT = WS_YS;
constexpr size_t WS_YS2 = WS_YG;
static_assert(WS_HS + (size_t)MAXSLOT * 2048 <= WS_YS && WS_ACT + (size_t)MAXSLOT * 512 <= WS_YG && WS_YS2 + (size_t)MAXSLOT * 2048 <= WS_W, "moe overlays");
static_assert(WS_TSLOT + (size_t)MT * 8 <= WS_H, "ws map");
constexpr int CW_CNT = 64;
constexpr int CW_BAR = 4096;

constexpr int LDS_BYTES = 147456;
constexpr int MISC_OFF = 131072 + 320;
constexpr int TAB_OFF = 131072 + 1024;

__device__ __forceinline__ float bf2f(unsigned short b) { return __builtin_bit_cast(float, ((unsigned)b) << 16); }
__device__ __forceinline__ unsigned f2bf(float f) { unsigned u = __builtin_bit_cast(unsigned, f); return (u + 0x7fffu + ((u >> 16) & 1u)) >> 16; }
__device__ __forceinline__ unsigned pk2(float lo, float hi) { return f2bf(lo) | (f2bf(hi) << 16); }
__device__ __forceinline__ float sigmoidf_(float x) { return 1.f / (1.f + __expf(-x)); }
__device__ __forceinline__ float siluf_(float x) { return x / (1.f + __expf(-x)); }
__device__ __forceinline__ float geluf_(float x) { const float u = 0.7978845608028654f * (x + 0.044715f * x * x * x); return x / (1.f + __expf(-2.f * u)); }
__device__ __forceinline__ float wave_sum(float v) {
#pragma unroll
    for (int o = 1; o < 64; o <<= 1) v += __shfl_xor(v, o);
    return v;
}

#define XB_TMO      128
#define XB_XCNT(j)  (256  + 64 * (j))
#define XB_XSUB(j)  (1280 + 64 * (j))
#define XB_XGEN(j)  (2304 + 64 * (j))
#define XB_TOP      3328
#define XB_TOPGEN   3392
#define XCD_BAR_WORDS 3456
#define XB_SPIN_CAP (1u << 24)
__device__ __forceinline__ unsigned xb_ld(unsigned* p)              { return __hip_atomic_load(p, __ATOMIC_RELAXED, __HIP_MEMORY_SCOPE_AGENT); }
__device__ __forceinline__ unsigned xb_add(unsigned* p, unsigned v) { return __hip_atomic_fetch_add(p, v, __ATOMIC_RELAXED, __HIP_MEMORY_SCOPE_AGENT); }
__device__ __forceinline__ unsigned xb_xcc_id() { return (unsigned)__builtin_amdgcn_s_getreg((3 << 11) | 20) & 0xFu; }
#define XB_SPIN(cond, bar) do { unsigned _sp = 0; while (cond) { __builtin_amdgcn_s_sleep(1); \
    if ((++_sp & 255u) == 0u) { if (xb_ld(&(bar)[XB_TMO])) break; if (_sp > XB_SPIN_CAP) { atomicAdd(&(bar)[XB_TMO], 1u); break; } } } } while (0)
struct XcdBarrier { unsigned* bar; unsigned x; volatile LAS unsigned* st; };
__device__ __forceinline__ XcdBarrier xcd_barrier_post(unsigned* bar, volatile LAS unsigned* st) {
    XcdBarrier b; b.bar = bar; b.x = xb_xcc_id(); b.st = st;
    if (threadIdx.x == 0) (void)xb_add(&bar[XB_XCNT(b.x)], 1u);
    return b;
}
__device__ __forceinline__ void xcd_barrier_complete(unsigned* bar, unsigned x, unsigned& nloc, unsigned& nx) {
    const unsigned G = gridDim.x * gridDim.y * gridDim.z;
    unsigned sum, cnt, mine, sp = 0u;
    for (;;) {
        sum = 0u; cnt = 0u; mine = 0u;
#pragma unroll
        for (unsigned j = 0; j < 16; ++j) { const unsigned c = xb_ld(&bar[XB_XCNT(j)]); sum += c; cnt += (c > 0u) ? 1u : 0u; mine = (j == x) ? c : mine; }
        if (sum == G) break;
        __builtin_amdgcn_s_sleep(1);
        if ((++sp & 255u) == 0u) { if (xb_ld(&bar[XB_TMO])) break; if (sp > XB_SPIN_CAP) { atomicAdd(&bar[XB_TMO], 1u); break; } }
    }
    nloc = mine > 0u ? mine : 1u; nx = cnt > 0u ? cnt : 1u;
}
__device__ __forceinline__ void xcd_barrier(const XcdBarrier& b) {
    asm volatile("s_waitcnt vmcnt(0)" ::: "memory");
    __syncthreads();
    if (threadIdx.x == 0) {
        unsigned* bar = b.bar;
        __builtin_amdgcn_s_waitcnt(0);
        unsigned nloc = b.st[0], nx = b.st[1];
        if (nloc == 0u) { xcd_barrier_complete(bar, b.x, nloc, nx); b.st[0] = nloc; b.st[1] = nx; }
        const unsigned old = xb_add(&bar[XB_XSUB(b.x)], 1u);
        const unsigned gen = old / nloc;
        if (old + 1u == (gen + 1u) * nloc) {
            __builtin_amdgcn_fence(__ATOMIC_RELEASE, "agent");
            asm volatile("s_waitcnt vmcnt(0)" ::: "memory");
            const unsigned og = xb_add(&bar[XB_TOP], 1u);
            const unsigned tg = og / nx;
            if (og + 1u == (tg + 1u) * nx) xb_add(&bar[XB_TOPGEN], 1u);
            else XB_SPIN(xb_ld(&bar[XB_TOPGEN]) == tg, bar);
            __builtin_amdgcn_fence(__ATOMIC_ACQUIRE, "agent");
            xb_add(&bar[XB_XGEN(b.x)], 1u);
            asm volatile("s_waitcnt vmcnt(0)" ::: "memory");
        } else {
            XB_SPIN(xb_ld(&bar[XB_XGEN(b.x)]) == gen, bar);
            __builtin_amdgcn_fence(__ATOMIC_ACQUIRE, "agent");
            asm volatile("s_waitcnt vmcnt(0)" ::: "memory");
        }
    }
    __syncthreads();
}

struct Args { const float* in[35]; float* out; unsigned char* ws; int ph_lo, ph_hi; };
struct Frame {
    LAS unsigned char* lds; unsigned char* ws; unsigned* ctl;
    int tid, lane, wave, bid, G;
    const unsigned long long LAS* tab; float* out;
};
__device__ __forceinline__ unsigned long long uni64(unsigned long long v) { const unsigned lo = __builtin_amdgcn_readfirstlane((unsigned)v), hi = __builtin_amdgcn_readfirstlane((unsigned)(v >> 32)); return ((unsigned long long)hi << 32) | lo; }
#define IN_(k) ((const float*)uni64(F.tab[k]))
enum { I_X = 0, I_C, I_CTX, I_CCTX, I_WADA, I_BADA, I_GMIX, I_GFFN, I_WIN, I_LRE, I_LIM, I_LDT, I_BRE, I_BIM, I_CRE, I_CIM, I_DSKIP, I_WGLU, I_SGG, I_SGB, I_WSG, I_BSG,
       I_WCONV, I_WBR, I_WMG, I_BMG, I_WO, I_WGRP, I_BGRP, I_WEXP, I_BEXP, I_W1, I_W3, I_W2, I_GF };

__device__ __forceinline__ const float* mod_ptr(const Frame& F, int l, int row) { return (const float*)(F.ws + WS_MOD) + (size_t)(l * 2 + (row >= SEQ ? 1 : 0)) * 6144; }
__device__ __forceinline__ const float* xsrc_row(const Frame& F, int l, int row) {
    if (l == 0) return row < SEQ ? IN_(I_X) + (size_t)row * D : IN_(I_CTX) + (size_t)(row - SEQ) * D;
    return row < SEQ ? F.out + (size_t)row * D : (const float*)(F.ws + WS_XC) + (size_t)(row - SEQ) * D;
}
__device__ __forceinline__ float* xrun_row(const Frame& F, int row) { return row < SEQ ? F.out + (size_t)row * D : (float*)(F.ws + WS_XC) + (size_t)(row - SEQ) * D; }


namespace pg8 {
#define PG8_LAS __attribute__((address_space(3)))
typedef unsigned short bf16_t;
typedef short bf16x8 __attribute__((ext_vector_type(8)));
typedef float f32x4 __attribute__((ext_vector_type(4)));
typedef unsigned u32x4 __attribute__((ext_vector_type(4)));
constexpr int BM = 256, BK = 64, HALF = 128, HTB = HALF * BK * 2  , STAGE_BYTES = 8 * HTB, NXCD = 8, WGM = 8;

__host__ __device__ __forceinline__ int lds_byte(int r, int c) { const int st = (r >> 4) * 2 + (c >> 5), rr = r & 15, cc = c & 31, ob = rr * 64 + cc * 2; return st * 1024 + (ob ^ (((ob >> 9) & 1) << 5)); }
__host__ __device__ __forceinline__ void stage_rc(int b, int& R, int& C) { const int st = b / 1024, sb = b % 1024, swz = sb ^ (((sb >> 9) & 1) << 5); R = (st >> 1) * 16 + swz / 64; C = (st & 1) * 32 + (swz % 64) / 2; }
__host__ __device__ __forceinline__ int perm32(int rho) { const int n = rho >> 4, i = rho & 15; return 8 * (i >> 2) + 4 * n + (i & 3); }

struct Unit { int pm, pn; };
struct Gemm { const bf16_t* A; const bf16_t* Bt; int M, N, K; };

struct StaticOrder {
    int nM, nN, nwg, G, c;
    __host__ __device__ void init(int M, int N, int G_, int c_) { nM = M / BM; nN = N / BM; nwg = nM * nN; G = G_; c = c_; }
    __host__ __device__ bool next(int i, Unit& u) const {
        const long L = (long)i * G + c; if (L >= nwg) return false;
        int wgid = (int)L; { const int q = nwg / NXCD, r = nwg % NXCD, xcd = wgid % NXCD, off = wgid / NXCD; wgid = (xcd < r ? xcd * (q + 1) : r * (q + 1) + (xcd - r) * q) + off; }
        const int nig = WGM * nN, gid = wgid / nig, fm = gid * WGM, gsz = (nM - fm) < WGM ? (nM - fm) : WGM;
        u.pm = fm + ((wgid % nig) % gsz); u.pn = (wgid % nig) / gsz; return true;
    }
    __device__ __forceinline__ void a_ready(const Unit&) const {}
    __device__ __forceinline__ void done(const Unit&) const {}
};
__device__ __forceinline__ unsigned cvt_pk_bf16(float lo, float hi) { unsigned r; asm volatile("v_cvt_pk_bf16_f32 %0, %1, %2" : "=v"(r) : "v"(lo), "v"(hi)); return r; }
template <class Epi, class Sched, bool ALIGN_EPI = false, bool SP2 = false>
__device__ __forceinline__ void gemm_phase(PG8_LAS unsigned char* lds, const Gemm g, const Sched& S, const Epi& E) {
    int tid_ = threadIdx.x; asm volatile("" : "+v"(tid_));
    const int tid = tid_, wid = __builtin_amdgcn_readfirstlane(tid >> 6), lane = tid & 63, wr = wid >> 2, wc = wid & 3, fr = lane & 15, fq = lane >> 4;
    const int K = g.K, nt = K / BK;
    unsigned voffA[2], voffB[2];
#pragma unroll
    for (int i = 0; i < 2; ++i) { int R, C; stage_rc(tid * 16 + i * 8192, R, C); const int Rb = Epi::PERM ? ((R & ~31) + perm32(R & 31)) : R;
        voffA[i] = (unsigned)(R * K + C) * 2u; voffB[i] = (unsigned)(Rb * K + C) * 2u; }
    const size_t kstep = (size_t)(BK * 2);
    const size_t hstep = (size_t)HALF * K * 2;
    const size_t tstep = 2 * hstep;
    const unsigned ldsw = (unsigned)wid * 1024u;
    const int aoff = lds_byte(wr * 64 + fr, fq * 8), boff = lds_byte(wc * 32 + fr, fq * 8);
#define PG8_SA(b, h) (((b) * 2 + (h)) * HTB)
#define PG8_SB(b, h) ((4 + (b) * 2 + (h)) * HTB)
#define PG8_STAGE(bufoff, gbase, voff) do { _Pragma("unroll") for (int _i = 0; _i < 2; ++_i) \
        __builtin_amdgcn_global_load_lds((const unsigned*)((const char*)(gbase) + (voff)[_i]), (PG8_LAS unsigned*)(lds + (bufoff) + ldsw + _i * 8192), 16, 0, 0); } while (0)
#define PG8_LDA(dst, b, h) do { _Pragma("unroll") for (int m = 0; m < 4; ++m) _Pragma("unroll") for (int k = 0; k < 2; ++k) dst[m][k] = *(const PG8_LAS bf16x8*)(lds + PG8_SA(b, h) + aoff + m * 2048 + k * 1024); } while (0)
#define PG8_LDB(dst, b, h) do { _Pragma("unroll") for (int n = 0; n < 2; ++n) _Pragma("unroll") for (int k = 0; k < 2; ++k) dst[n][k] = *(const PG8_LAS bf16x8*)(lds + PG8_SB(b, h) + boff + n * 2048 + k * 1024); } while (0)
#define PG8_MMA(ai, bj, At, Bt) do { __builtin_amdgcn_s_setprio(1); _Pragma("unroll") for (int m = 0; m < 4; ++m) _Pragma("unroll") for (int n = 0; n < 2; ++n) _Pragma("unroll") for (int k = 0; k < 2; ++k) \
        acc[ai][bj][m][n] = __builtin_amdgcn_mfma_f32_16x16x32_bf16(Bt[n][k], At[m][k], acc[ai][bj][m][n], 0, 0, 0); __builtin_amdgcn_s_setprio(0); } while (0)
#define PG8_WAIT_V(n) asm volatile("s_waitcnt vmcnt(" #n ")" ::: "memory")
#define PG8_WAIT_L(n) asm volatile("s_waitcnt lgkmcnt(" #n ")" ::: "memory")
#define PG8_BAR __builtin_amdgcn_s_barrier()
#define PG8_SCHED __builtin_amdgcn_sched_barrier(0)
    Unit cur, nxt; int ui = 0;
    if (!S.next(0, cur)) return;
    f32x4 acc[2][2][4][2];
#pragma unroll
    for (int a = 0; a < 2; ++a)
#pragma unroll
        for (int b = 0; b < 2; ++b)
#pragma unroll
            for (int m = 0; m < 4; ++m)
#pragma unroll
                for (int n = 0; n < 2; ++n) acc[a][b][m][n] = (f32x4){0.f, 0.f, 0.f, 0.f};
    bf16x8 At[4][2], B0[2][2], B1[2][2];
    const char* cA = (const char*)g.A + (size_t)cur.pm * tstep; const char* cB = (const char*)g.Bt + (size_t)cur.pn * tstep;
    S.a_ready(cur);
    if constexpr (SP2) {
        PG8_STAGE(PG8_SB(0, 0), cB, voffB); PG8_STAGE(PG8_SB(0, 1), cB + hstep, voffB); PG8_STAGE(PG8_SA(0, 0), cA, voffA); PG8_STAGE(PG8_SA(0, 1), cA + hstep, voffA);
        if (wr == 1) PG8_BAR;
        PG8_WAIT_V(2); PG8_BAR;
        PG8_STAGE(PG8_SB(1, 0), cB + kstep, voffB); PG8_STAGE(PG8_SA(1, 0), cA + kstep, voffA); PG8_STAGE(PG8_SB(1, 1), cB + hstep + kstep, voffB);
        PG8_WAIT_V(6); PG8_BAR;
    } else {
        PG8_STAGE(PG8_SB(0, 0), cB, voffB); PG8_STAGE(PG8_SA(0, 0), cA, voffA); PG8_STAGE(PG8_SB(0, 1), cB + hstep, voffB); PG8_STAGE(PG8_SA(0, 1), cA + hstep, voffA);
        if (wr == 1) PG8_BAR;
        PG8_WAIT_V(4); PG8_BAR;
        PG8_STAGE(PG8_SB(1, 0), cB + kstep, voffB); PG8_STAGE(PG8_SA(1, 0), cA + kstep, voffA); PG8_STAGE(PG8_SB(1, 1), cB + hstep + kstep, voffB);
        PG8_WAIT_V(6); PG8_BAR;
    }
    for (;;) {
        const bool has_next = S.next(ui + 1, nxt);
        const char* nA = has_next ? (const char*)g.A + (size_t)nxt.pm * tstep : cA; const char* nB = has_next ? (const char*)g.Bt + (size_t)nxt.pn * tstep : cB;
#pragma unroll 1
        for (int t = 0; t < nt; t += 2) {
            const bool last = (t == nt - 2);
            const char* a1 = cA + (size_t)(t + 1) * kstep;
            const char* a2 = last ? nA : cA + (size_t)(t + 2) * kstep; const char* b2 = last ? nB : cB + (size_t)(t + 2) * kstep;
            const char* a3 = a2 + kstep; const char* b3 = b2 + kstep;
            if (last && has_next) S.a_ready(nxt);
            if constexpr (SP2) {
            PG8_LDB(B0, 0, 0); PG8_LDB(B1, 0, 1); PG8_SCHED; PG8_LDA(At, 0, 0); PG8_STAGE(PG8_SA(1, 1), a1 + hstep, voffA);
            PG8_WAIT_V(8); PG8_WAIT_L(0); PG8_BAR; PG8_MMA(0, 0, At, B0); PG8_MMA(0, 1, At, B1); PG8_BAR; PG8_SCHED;
            PG8_LDA(At, 0, 1); PG8_STAGE(PG8_SB(0, 0), b2, voffB); PG8_STAGE(PG8_SB(0, 1), b2 + hstep, voffB); PG8_STAGE(PG8_SA(0, 0), a2, voffA);
            PG8_WAIT_V(8); PG8_WAIT_L(0); PG8_BAR; PG8_MMA(1, 0, At, B0); PG8_MMA(1, 1, At, B1); PG8_BAR; PG8_SCHED;
            PG8_LDB(B0, 1, 0); PG8_LDB(B1, 1, 1); PG8_SCHED; PG8_LDA(At, 1, 0); PG8_STAGE(PG8_SA(0, 1), a2 + hstep, voffA);
            PG8_WAIT_V(8); PG8_WAIT_L(0); PG8_BAR; PG8_MMA(0, 0, At, B0); PG8_MMA(0, 1, At, B1); PG8_BAR; PG8_SCHED;
            PG8_LDA(At, 1, 1); PG8_STAGE(PG8_SB(1, 0), b3, voffB); PG8_STAGE(PG8_SB(1, 1), b3 + hstep, voffB); PG8_STAGE(PG8_SA(1, 0), a3, voffA);
            PG8_WAIT_V(8); PG8_WAIT_L(0); PG8_BAR; PG8_MMA(1, 0, At, B0); PG8_MMA(1, 1, At, B1); PG8_BAR; PG8_SCHED;
            } else {
            PG8_LDB(B0, 0, 0); PG8_SCHED; PG8_LDA(At, 0, 0); PG8_STAGE(PG8_SA(1, 1), a1 + hstep, voffA);
            PG8_WAIT_L(8); PG8_BAR; PG8_WAIT_L(0); PG8_MMA(0, 0, At, B0); PG8_BAR; PG8_SCHED;
            PG8_LDB(B1, 0, 1); PG8_STAGE(PG8_SB(0, 0), b2, voffB);
            PG8_BAR; PG8_WAIT_L(0); PG8_MMA(0, 1, At, B1); PG8_BAR;
            PG8_LDA(At, 0, 1); PG8_STAGE(PG8_SA(0, 0), a2, voffA);
            PG8_BAR; PG8_WAIT_L(0); PG8_MMA(1, 0, At, B0); PG8_BAR; PG8_SCHED;
            PG8_STAGE(PG8_SB(0, 1), b2 + hstep, voffB);
            PG8_WAIT_V(6); PG8_BAR; PG8_MMA(1, 1, At, B1); PG8_BAR;
            PG8_LDB(B0, 1, 0); PG8_SCHED; PG8_LDA(At, 1, 0); PG8_STAGE(PG8_SA(0, 1), a2 + hstep, voffA);
            PG8_WAIT_L(8); PG8_BAR; PG8_WAIT_L(0); PG8_MMA(0, 0, At, B0); PG8_BAR; PG8_SCHED;
            PG8_LDB(B1, 1, 1); PG8_STAGE(PG8_SB(1, 0), b3, voffB);
            PG8_BAR; PG8_WAIT_L(0); PG8_MMA(0, 1, At, B1); PG8_BAR;
            PG8_LDA(At, 1, 1); PG8_STAGE(PG8_SA(1, 0), a3, voffA);
            PG8_BAR; PG8_WAIT_L(0); PG8_MMA(1, 0, At, B0); PG8_BAR; PG8_SCHED;
            PG8_STAGE(PG8_SB(1, 1), b3 + hstep, voffB);
            PG8_WAIT_V(6); PG8_BAR; PG8_MMA(1, 1, At, B1); PG8_BAR;
            }
        }
        if constexpr (ALIGN_EPI) { if (wr == 0) PG8_BAR; }
        if constexpr (!Epi::AFTER_DRAIN) { E(acc, cur, wr, wc, fr, fq); S.done(cur); }
        if (!has_next) break;
#pragma unroll
        for (int a = 0; a < 2; ++a)
#pragma unroll
            for (int b = 0; b < 2; ++b)
#pragma unroll
                for (int m = 0; m < 4; ++m)
#pragma unroll
                    for (int n = 0; n < 2; ++n) acc[a][b][m][n] = (f32x4){0.f, 0.f, 0.f, 0.f};
        cur = nxt; cA = nA; cB = nB; ++ui;
        if constexpr (ALIGN_EPI) { if (wr == 1) PG8_BAR; }
    }
    PG8_WAIT_V(0);
    if constexpr (!ALIGN_EPI) { if (wr == 0) PG8_BAR; }
    PG8_BAR;
    if constexpr (Epi::AFTER_DRAIN) { E.fused(acc, cur, wr, wc, fr, fq, lds, wid, lane); S.done(cur); }
#undef PG8_SA
#undef PG8_SB
#undef PG8_STAGE
#undef PG8_LDA
#undef PG8_LDB
#undef PG8_MMA
#undef PG8_WAIT_V
#undef PG8_WAIT_L
#undef PG8_BAR
#undef PG8_SCHED
}
}

constexpr bool PG_ALIGN = true, PG_SP2 = true;
__device__ __forceinline__ float bflo(unsigned w) { return __builtin_bit_cast(float, w << 16); }
__device__ __forceinline__ float bfhi(unsigned w) { return __builtin_bit_cast(float, w & 0xffff0000u); }
__device__ __forceinline__ unsigned cvtpk(float lo, float hi) { return pg8::cvt_pk_bf16(lo, hi); }

__device__ __forceinline__ void transpose_item(const float* W, int N, int k0, int n0, bf16* WT, int K, size_t dst_row0, LAS float* scr, int lane) {
#pragma unroll 8
    for (int i = 0; i < 32; ++i) { const int kk = 2 * i + (lane >> 5); scr[kk * 33 + (lane & 31)] = W[(size_t)(k0 + kk) * N + n0 + (lane & 31)]; }
    asm volatile("s_waitcnt lgkmcnt(0)" ::: "memory");
    const int c = lane & 7;
#pragma unroll
    for (int j = 0; j < 4; ++j) { const int n = (lane >> 3) + 8 * j; const LAS float* s = scr + (8 * c) * 33 + n;
        v4u o; o.x = pk2(s[0 * 33], s[1 * 33]); o.y = pk2(s[2 * 33], s[3 * 33]); o.z = pk2(s[4 * 33], s[5 * 33]); o.w = pk2(s[6 * 33], s[7 * 33]);
        *(v4u*)(WT + (dst_row0 + n) * K + k0 + 8 * c) = o; }
    asm volatile("s_waitcnt lgkmcnt(0)" ::: "memory");
}
__device__ __forceinline__ void convert_weights(Frame& F, int l) {
    LAS float* scr = (LAS float*)(F.lds + F.wave * 16384);
    const int gw = F.bid * (NT / 64) + F.wave, ngw = F.G * (NT / 64);
    constexpr int I_IN = 16 * 96, I_MG = 16 * 96, I_GLU = 8 * 16, I_BR = 3 * 8 * 32, I_O = 16 * 32, I_1 = 32 * 16 * 8, I_3 = I_1, I_2 = 32 * 4 * 32;
    constexpr int NITEMS = I_IN + I_MG + I_GLU + I_BR + I_O + I_1 + I_3 + I_2;
    for (int it = gw; it < NITEMS; it += ngw) {
        int r = it;
        if (r < I_IN) { const int kb = r / 96, nb = r % 96; transpose_item(IN_(I_WIN) + (size_t)l * D * INW, INW, 64 * kb, 32 * nb, (bf16*)(F.ws + WS_WIN), 1024, 32 * nb, scr, F.lane); continue; } r -= I_IN;
        if (r < I_MG) { const int kb = r / 96, nb = r % 96; transpose_item(IN_(I_WMG) + (size_t)l * D * INW, INW, 64 * kb, 32 * nb, (bf16*)(F.ws + WS_WMG), 1024, 32 * nb, scr, F.lane); continue; } r -= I_MG;
        if (r < I_GLU) { const int kb = r / 16, nb = r % 16; transpose_item(IN_(I_WGLU) + (size_t)l * MIXW * MIXW, MIXW, 64 * kb, 32 * nb, (bf16*)(F.ws + WS_WGLU), 512, 32 * nb, scr, F.lane); continue; } r -= I_GLU;
        if (r < I_BR) { const int kk = r / 256, q = r % 256, kb = q / 32, nb = q % 32; transpose_item(IN_(I_WBR) + ((size_t)l * 3 + kk) * MIXW * D, D, 64 * kb, 32 * nb, (bf16*)(F.ws + WS_WBR), 512, (size_t)kk * 1024 + 32 * nb, scr, F.lane); continue; } r -= I_BR;
        if (r < I_O) { const int kb = r / 32, nb = r % 32; transpose_item(IN_(I_WO) + (size_t)l * D * D, D, 64 * kb, 32 * nb, (bf16*)(F.ws + WS_WO), 1024, 32 * nb, scr, F.lane); continue; } r -= I_O;
        if (r < I_1 + I_3) { const int which = r / I_1, q = r % I_1, e = q / 128, q2 = q % 128, kb = q2 / 8, nb = q2 % 8;
            const float* W = IN_(which ? I_W3 : I_W1) + ((size_t)l * NE + e) * D * DFF; const int n0 = 32 * nb;
            transpose_item(W, DFF, 64 * kb, n0, (bf16*)(F.ws + WS_W13), 1024, (size_t)e * 512 + (n0 / 128) * 256 + which * 128 + (n0 % 128), scr, F.lane); continue; } r -= I_1 + I_3;
        { const int e = r / 128, q = r % 128, kb = q / 32, nb = q % 32; transpose_item(IN_(I_W2) + ((size_t)l * NE + e) * DFF * D, D, 64 * kb, 32 * nb, (bf16*)(F.ws + WS_W2), 256, (size_t)e * 1024 + 32 * nb, scr, F.lane); }
    }
    { const float* s = IN_(I_WSG) + (size_t)l * 4 * 128 * 128; bf16* d = (bf16*)(F.ws + WS_WSG);
      for (int i = (F.bid * NT + F.tid) * 2; i < 4 * 128 * 128; i += F.G * NT * 2) *(unsigned*)(d + i) = pk2(s[i], s[i + 1]); }
}

struct EpiProj { static constexpr bool PERM = true, AFTER_DRAIN = false; bf16* O;
    __device__ __forceinline__ void operator()(const pg8::f32x4 (&acc)[2][2][4][2], const pg8::Unit& u, int wr, int wc, int fr, int fq) const {
        const int row0 = u.pm * 256 + wr * 64 + fr, col0 = u.pn * 256 + wc * 32 + 8 * fq; const bool act = (u.pn >= 2 && u.pn < 6);
#pragma unroll
        for (int ai = 0; ai < 2; ++ai)
#pragma unroll
            for (int m = 0; m < 4; ++m) { bf16* rowp = O + (size_t)(row0 + ai * 128 + m * 16) * INW + col0;
#pragma unroll
                for (int bj = 0; bj < 2; ++bj) { pg8::f32x4 v0 = acc[ai][bj][m][0], v1 = acc[ai][bj][m][1];
                    if (act) {
#pragma unroll
                        for (int j = 0; j < 4; ++j) { v0[j] = geluf_(v0[j]); v1[j] = geluf_(v1[j]); } }
                    v4u w; w.x = cvtpk(v0[0], v0[1]); w.y = cvtpk(v0[2], v0[3]); w.z = cvtpk(v1[0], v1[1]); w.w = cvtpk(v1[2], v1[3]); *(v4u*)(rowp + bj * 128) = w; } }
    } };
struct EpiGlu { static constexpr bool PERM = true, AFTER_DRAIN = false; const bf16* YG; bf16* YA;
    __device__ __forceinline__ void operator()(const pg8::f32x4 (&acc)[2][2][4][2], const pg8::Unit& u, int wr, int wc, int fr, int fq) const {
        const int row0 = u.pm * 256 + wr * 64 + fr, col0 = u.pn * 256 + wc * 32 + 8 * fq;
#pragma unroll
        for (int ai = 0; ai < 2; ++ai)
#pragma unroll
            for (int m = 0; m < 4; ++m) { const size_t off = (size_t)(row0 + ai * 128 + m * 16) * MIXW + col0;
#pragma unroll
                for (int bj = 0; bj < 2; ++bj) { const pg8::f32x4 v0 = acc[ai][bj][m][0], v1 = acc[ai][bj][m][1]; const v4u g = *(const v4u*)(YG + off + bj * 128);
                    v4u w; w.x = cvtpk(bflo(g.x) * sigmoidf_(v0[0]), bfhi(g.x) * sigmoidf_(v0[1])); w.y = cvtpk(bflo(g.y) * sigmoidf_(v0[2]), bfhi(g.y) * sigmoidf_(v0[3]));
                    w.z = cvtpk(bflo(g.z) * sigmoidf_(v1[0]), bfhi(g.z) * sigmoidf_(v1[1])); w.w = cvtpk(bflo(g.w) * sigmoidf_(v1[2]), bfhi(g.w) * sigmoidf_(v1[3])); *(v4u*)(YA + off + bj * 128) = w; } }
    } };
struct EpiBr { static constexpr bool PERM = true, AFTER_DRAIN = false; bf16* BR;
    __device__ __forceinline__ void operator()(const pg8::f32x4 (&acc)[2][2][4][2], const pg8::Unit& u, int wr, int wc, int fr, int fq) const {
        const int pm = u.pm % (MT / 256); const int row0 = pm * 256 + wr * 64 + fr, col0 = u.pn * 256 + wc * 32 + 8 * fq;
#pragma unroll
        for (int ai = 0; ai < 2; ++ai)
#pragma unroll
            for (int m = 0; m < 4; ++m) { bf16* rowp = BR + (size_t)(row0 + ai * 128 + m * 16) * INW + col0;
#pragma unroll
                for (int bj = 0; bj < 2; ++bj) { const pg8::f32x4 v0 = acc[ai][bj][m][0], v1 = acc[ai][bj][m][1];
                    v4u w; w.x = cvtpk(v0[0], v0[1]); w.y = cvtpk(v0[2], v0[3]); w.z = cvtpk(v1[0], v1[1]); w.w = cvtpk(v1[2], v1[3]); *(v4u*)(rowp + bj * 128) = w; } }
    } };
struct SchedBr { int G, c;
    __device__ __forceinline__ bool next(int i, pg8::Unit& u) const { const int Lq = i * G + c; if (Lq >= 3 * (MT / 256) * 4) return false; const int k = Lq / ((MT / 256) * 4), r = Lq % ((MT / 256) * 4);
        u.pm = k * (MT / 256) + r / 4; u.pn = k * 4 + r % 4; return true; }
    __device__ __forceinline__ void a_ready(const pg8::Unit&) const {}
    __device__ __forceinline__ void done(const pg8::Unit&) const {} };
struct EpiMerge { static constexpr bool PERM = true, AFTER_DRAIN = false; const bf16* BR; bf16* PM; const float* bm;
    __device__ __forceinline__ void operator()(const pg8::f32x4 (&acc)[2][2][4][2], const pg8::Unit& u, int wr, int wc, int fr, int fq) const {
        const int k = u.pn >> 2, dt = u.pn & 3; const int row0 = u.pm * 256 + wr * 64 + fr, col0 = dt * 256 + wc * 32 + 8 * fq;
#pragma unroll
        for (int bj = 0; bj < 2; ++bj) { const pg8::f32x4 b0 = *(const pg8::f32x4*)(bm + k * 1024 + col0 + bj * 128), b1 = *(const pg8::f32x4*)(bm + k * 1024 + col0 + bj * 128 + 4);
#pragma unroll
            for (int ai = 0; ai < 2; ++ai)
#pragma unroll
                for (int m = 0; m < 4; ++m) { const size_t r = (size_t)(row0 + ai * 128 + m * 16); const v4u br = *(const v4u*)(BR + r * INW + k * 1024 + col0 + bj * 128);
                    const pg8::f32x4 v0 = acc[ai][bj][m][0] + b0, v1 = acc[ai][bj][m][1] + b1;
                    float p[8] = {sigmoidf_(v0[0]) * bflo(br.x), sigmoidf_(v0[1]) * bfhi(br.x), sigmoidf_(v0[2]) * bflo(br.y), sigmoidf_(v0[3]) * bfhi(br.y),
                                  sigmoidf_(v1[0]) * bflo(br.z), sigmoidf_(v1[1]) * bfhi(br.z), sigmoidf_(v1[2]) * bflo(br.w), sigmoidf_(v1[3]) * bfhi(br.w)};
                    bf16* dst = PM + r * D + col0 + bj * 128;
                    if (k > 0) { const v4u o = *(const v4u*)dst; p[0] += bflo(o.x); p[1] += bfhi(o.x); p[2] += bflo(o.y); p[3] += bfhi(o.y); p[4] += bflo(o.z); p[5] += bfhi(o.z); p[6] += bflo(o.w); p[7] += bfhi(o.w); }
                    v4u w; w.x = cvtpk(p[0], p[1]); w.y = cvtpk(p[2], p[3]); w.z = cvtpk(p[4], p[5]); w.w = cvtpk(p[6], p[7]); *(v4u*)dst = w; } }
    } };
struct SchedMerge { int G, c;
    __device__ __forceinline__ bool next(int i, pg8::Unit& u) const { const int v = (i / 3) * G + c, k = i % 3; if (v >= (MT / 256) * 4) return false; u.pm = v >> 2; u.pn = k * 4 + (v & 3); return true; }
    __device__ __forceinline__ void a_ready(const pg8::Unit&) const {}
    __device__ __forceinline__ void done(const pg8::Unit&) const {} };
struct EpiWo { static constexpr bool PERM = false, AFTER_DRAIN = false; const float* xs_lat; const float* xs_ctx; float* out; float* xc; const float* mod_l;
    __device__ __forceinline__ void operator()(const pg8::f32x4 (&acc)[2][2][4][2], const pg8::Unit& u, int wr, int wc, int fr, int fq) const {
        const int row0 = u.pm * 256 + wr * 64 + fr, col0 = u.pn * 256 + wc * 32 + 4 * fq; const bool isctx = u.pm >= SEQ / 256;
        const float* ga = mod_l + (isctx ? 6144 : 0) + 2048;
#pragma unroll
        for (int ai = 0; ai < 2; ++ai)
#pragma unroll
            for (int m = 0; m < 4; ++m) { const int row = row0 + ai * 128 + m * 16; const size_t off = (size_t)(isctx ? row - SEQ : row) * D + col0;
                const float* src = (isctx ? xs_ctx : xs_lat) + off; float* dst = (isctx ? xc : out) + off;
#pragma unroll
                for (int bj = 0; bj < 2; ++bj)
#pragma unroll
                    for (int n = 0; n < 2; ++n) { const pg8::f32x4 g = *(const pg8::f32x4*)(ga + col0 + bj * 128 + n * 16); const pg8::f32x4 x = *(const pg8::f32x4*)(src + bj * 128 + n * 16);
                        *(pg8::f32x4*)(dst + bj * 128 + n * 16) = x + g * acc[ai][bj][m][n]; } }
    } };
constexpr int MOETAB_OFF = 131072 + 2048;
template <int NPN> __device__ __forceinline__ int moe_build_table(Frame& F, const unsigned* cnt) {
    LAS unsigned* tabw = (LAS unsigned*)(F.lds + MOETAB_OFF);
    int total = 0, rowtile0 = 0;
    for (int e = 0; e < NE; ++e) { const int nt_e = ((int)cnt[e] + 255) >> 8;
        for (int q = F.tid; q < nt_e * NPN; q += NT) tabw[total + q] = ((unsigned)(rowtile0 + q / NPN) << 16) | (unsigned)(e * NPN + q % NPN);
        total += nt_e * NPN; rowtile0 += nt_e; }
    __syncthreads();
    return total;
}
struct SchedMoe { int G, c, total; const LAS unsigned* tabw;
    __device__ __forceinline__ bool next(int i, pg8::Unit& u) const { const int Lq = i * G + c; if (Lq >= total) return false; const unsigned w = (unsigned)__builtin_amdgcn_readfirstlane((int)tabw[Lq]); u.pm = (int)(w >> 16); u.pn = (int)(w & 0xffffu); return true; }
    __device__ __forceinline__ void a_ready(const pg8::Unit&) const {}
    __device__ __forceinline__ void done(const pg8::Unit&) const {} };
struct EpiUp { static constexpr bool PERM = true, AFTER_DRAIN = false; bf16* ACT; const float* SW;
    __device__ __forceinline__ void operator()(const pg8::f32x4 (&acc)[2][2][4][2], const pg8::Unit& u, int wr, int wc, int fr, int fq) const {
        const int row0 = u.pm * 256 + wr * 64 + fr, f0 = (u.pn & 1) * 128 + wc * 32 + 8 * fq;
#pragma unroll
        for (int ai = 0; ai < 2; ++ai)
#pragma unroll
            for (int m = 0; m < 4; ++m) { const int slot = row0 + ai * 128 + m * 16; const float w = SW[slot];
                const pg8::f32x4 a0 = acc[ai][0][m][0], a1 = acc[ai][0][m][1], b0 = acc[ai][1][m][0], b1 = acc[ai][1][m][1];
                v4u o; o.x = cvtpk(siluf_(a0[0]) * b0[0] * w, siluf_(a0[1]) * b0[1] * w); o.y = cvtpk(siluf_(a0[2]) * b0[2] * w, siluf_(a0[3]) * b0[3] * w);
                o.z = cvtpk(siluf_(a1[0]) * b1[0] * w, siluf_(a1[1]) * b1[1] * w); o.w = cvtpk(siluf_(a1[2]) * b1[2] * w, siluf_(a1[3]) * b1[3] * w);
                *(v4u*)(ACT + (size_t)slot * DFF + f0) = o; }
    } };
struct EpiDown { static constexpr bool PERM = true, AFTER_DRAIN = false; bf16* YS2;
    __device__ __forceinline__ void operator()(const pg8::f32x4 (&acc)[2][2][4][2], const pg8::Unit& u, int wr, int wc, int fr, int fq) const {
        const int row0 = u.pm * 256 + wr * 64 + fr, col0 = (u.pn & 3) * 256 + wc * 32 + 8 * fq;
#pragma unroll
        for (int ai = 0; ai < 2; ++ai)
#pragma unroll
            for (int m = 0; m < 4; ++m) { bf16* rowp = YS2 + (size_t)(row0 + ai * 128 + m * 16) * D + col0;
#pragma unroll
                for (int bj = 0; bj < 2; ++bj) { const pg8::f32x4 v0 = acc[ai][bj][m][0], v1 = acc[ai][bj][m][1];
                    v4u w; w.x = cvtpk(v0[0], v0[1]); w.y = cvtpk(v0[2], v0[3]); w.z = cvtpk(v1[0], v1[1]); w.w = cvtpk(v1[2], v1[3]); *(v4u*)(rowp + bj * 128) = w; } }
    } };

__device__ __forceinline__ void ph2_fast(Frame& F, int l) {
    pg8::Gemm g{(const bf16*)(F.ws + WS_H), (const bf16*)(F.ws + WS_WIN), MT, INW, D}; pg8::StaticOrder S; S.init(MT, INW, F.G, F.bid);
    EpiProj E{(bf16*)(F.ws + WS_PROJ)}; pg8::gemm_phase<EpiProj, pg8::StaticOrder, PG_ALIGN, PG_SP2>(F.lds, g, S, E);
}
__device__ __forceinline__ void ph6_fast(Frame& F, int l) {
    pg8::Gemm g{(const bf16*)(F.ws + WS_YG), (const bf16*)(F.ws + WS_WGLU), MT, MIXW, MIXW}; pg8::StaticOrder S; S.init(MT, MIXW, F.G, F.bid);
    EpiGlu E{(const bf16*)(F.ws + WS_YG), (bf16*)(F.ws + WS_YS)}; pg8::gemm_phase<EpiGlu, pg8::StaticOrder, PG_ALIGN, PG_SP2>(F.lds, g, S, E);
}
__device__ __forceinline__ void ph7_fast(Frame& F, int l) {
    pg8::Gemm g{(const bf16*)(F.ws + WS_YS), (const bf16*)(F.ws + WS_WBR), 3 * MT, 3 * D, MIXW}; SchedBr S{F.G, F.bid};
    EpiBr E{(bf16*)(F.ws + WS_PROJ)}; pg8::gemm_phase<EpiBr, SchedBr, PG_ALIGN, PG_SP2>(F.lds, g, S, E);
}
__device__ __forceinline__ void ph8_fast(Frame& F, int l) {
    pg8::Gemm g{(const bf16*)(F.ws + WS_H), (const bf16*)(F.ws + WS_WMG), MT, INW, D}; SchedMerge S{F.G, F.bid};
    EpiMerge E{(const bf16*)(F.ws + WS_PROJ), (bf16*)(F.ws + WS_PM), IN_(I_BMG) + l * INW}; pg8::gemm_phase<EpiMerge, SchedMerge, PG_ALIGN, PG_SP2>(F.lds, g, S, E);
}
__device__ __forceinline__ void ph9_fast(Frame& F, int l) {
    pg8::Gemm g{(const bf16*)(F.ws + WS_PM), (const bf16*)(F.ws + WS_WO), MT, D, D}; pg8::StaticOrder S; S.init(MT, D, F.G, F.bid);
    EpiWo E{l == 0 ? IN_(I_X) : F.out, l == 0 ? IN_(I_CTX) : (const float*)(F.ws + WS_XC), F.out, (float*)(F.ws + WS_XC), (const float*)(F.ws + WS_MOD) + (size_t)l * 2 * 6144};
    pg8::gemm_phase<EpiWo, pg8::StaticOrder, PG_ALIGN, PG_SP2>(F.lds, g, S, E);
}
__device__ __forceinline__ void ph12_fast(Frame& F, int l) {
    pg8::Gemm g{(const bf16*)(F.ws + WS_HS), (const bf16*)(F.ws + WS_W13), MAXSLOT, NE * 512, D}; const int total = moe_build_table<2>(F, F.ctl + CW_CNT + l * 128); SchedMoe S{F.G, F.bid, total, (const LAS unsigned*)(F.lds + MOETAB_OFF)};
    EpiUp E{(bf16*)(F.ws + WS_ACT), (const float*)(F.ws + WS_SW)}; pg8::gemm_phase<EpiUp, SchedMoe, PG_ALIGN, PG_SP2>(F.lds, g, S, E);
}
__device__ __forceinline__ void ph13_fast(Frame& F, int l) {
    pg8::Gemm g{(const bf16*)(F.ws + WS_ACT), (const bf16*)(F.ws + WS_W2), MAXSLOT, NE * D, DFF}; const int total = moe_build_table<4>(F, F.ctl + CW_CNT + l * 128); SchedMoe S{F.G, F.bid, total, (const LAS unsigned*)(F.lds + MOETAB_OFF)};
    EpiDown E{(bf16*)(F.ws + WS_YS2)}; pg8::gemm_phase<EpiDown, SchedMoe, PG_ALIGN, PG_SP2>(F.lds, g, S, E);
}

struct NSmem { float As[16][68]; float Bs[16][68]; };
template <class AF>
__device__ __forceinline__ void ngemm_acc(float (&acc)[4][4], const AF& af, const float* B, int ldb, int K, LAS NSmem* s, int t) {
    const int ty = t >> 4, tx = t & 15, lr = t >> 2, lk = (t & 3) * 4, bk = t >> 4, bn = (t & 15) * 4;
    for (int k0 = 0; k0 < K; k0 += 16) {
        const float4 av = af.load4(lr, k0 + lk);
        const float4 bv = *(const float4*)(B + (size_t)(k0 + bk) * ldb + bn);
        __syncthreads();
        s->As[lk + 0][lr] = av.x; s->As[lk + 1][lr] = av.y; s->As[lk + 2][lr] = av.z; s->As[lk + 3][lr] = av.w;
        *(LAS f32x4*)&s->Bs[bk][bn] = (f32x4){bv.x, bv.y, bv.z, bv.w};
        __syncthreads();
#pragma unroll
        for (int k = 0; k < 16; ++k) {
            const f32x4 a = *(const LAS f32x4*)&s->As[k][ty * 4]; const f32x4 b = *(const LAS f32x4*)&s->Bs[k][tx * 4];
            const float aa[4] = {a.x, a.y, a.z, a.w}, bb[4] = {b.x, b.y, b.z, b.w};
#pragma unroll
            for (int i = 0; i < 4; ++i)
#pragma unroll
                for (int j = 0; j < 4; ++j) acc[i][j] += aa[i] * bb[j];
        }
    }
}
struct ABf { const bf16* A; int lda; __device__ __forceinline__ float4 load4(int r, int k) const { const v2u w = *(const v2u*)(A + (size_t)r * lda + k);
    return make_float4(bf2f((unsigned short)(w.x & 0xffff)), bf2f((unsigned short)(w.x >> 16)), bf2f((unsigned short)(w.y & 0xffff)), bf2f((unsigned short)(w.y >> 16))); } };
#define NTILE_BEGIN(ntiles) { const int _half = F.tid >> 8, t = F.tid & 255, ty = t >> 4, tx = t & 15; LAS NSmem* sm = (LAS NSmem*)F.lds + _half; (void)ty; (void)tx; \
    const int _nt = (ntiles), _nit = (_nt + 2 * F.G - 1) / (2 * F.G); \
    for (int _it = 0; _it < _nit; ++_it) { int T = (_it * F.G + F.bid) * 2 + _half; const bool valid = T < _nt; if (!valid) T = _nt - 1;
#define NTILE_END } }

__device__ __forceinline__ void ph0_prologue(Frame& F) {
    float* mod = (float*)(F.ws + WS_MOD);
    const int gt = F.bid * NT + F.tid, ngt = F.G * NT;
    for (int idx = gt; idx < 2 * 6144; idx += ngt) {
        const int l = idx / 6144, j = idx % 6144;
        const float* W = IN_(I_WADA) + (size_t)l * D * 6144 + j;
        float a0 = 0.f, a1 = 0.f;
        for (int k = 0; k < D; ++k) { const float w = W[(size_t)k * 6144]; a0 += siluf_(IN_(I_C)[k]) * w; a1 += siluf_(IN_(I_CCTX)[k]) * w; }
        const float b = IN_(I_BADA)[l * 6144 + j];
        mod[(size_t)(l * 2 + 0) * 6144 + j] = a0 + b; mod[(size_t)(l * 2 + 1) * 6144 + j] = a1 + b;
    }
}
__device__ __forceinline__ void hprep_rows(Frame& F, int l) {
    bf16* H = (bf16*)(F.ws + WS_H); const float* g = IN_(I_GMIX) + l * D;
    const int gw = F.bid * (NT / 64) + F.wave, ngw = F.G * (NT / 64);
    for (int row = gw; row < MT; row += ngw) {
        const float* m = mod_ptr(F, l, row); const float* xr = xsrc_row(F, l, row);
        f32x4 v[4]; float s = 0.f;
#pragma unroll
        for (int j = 0; j < 4; ++j) { v[j] = *(const f32x4*)(xr + 4 * F.lane + 256 * j); s += v[j].x * v[j].x + v[j].y * v[j].y + v[j].z * v[j].z + v[j].w * v[j].w; }
        const float rstd = rsqrtf(wave_sum(s) * (1.f / D) + EPS);
#pragma unroll
        for (int j = 0; j < 4; ++j) { const int c = 4 * F.lane + 256 * j; const f32x4 gg = *(const f32x4*)(g + c), sc = *(const f32x4*)(m + 1024 + c), sh = *(const f32x4*)(m + c);
            const f32x4 o = v[j] * rstd * gg * (1.f + sc) + sh; v2u w; w.x = pk2(o.x, o.y); w.y = pk2(o.z, o.w); *(v2u*)(H + (size_t)row * D + c) = w; }
    }
}
__device__ __forceinline__ void ph2_naive(Frame& F, int l) {
    const bf16* H = (const bf16*)(F.ws + WS_H); bf16* PROJ = (bf16*)(F.ws + WS_PROJ); const float* W = IN_(I_WIN) + (size_t)l * D * INW;
    NTILE_BEGIN((MT / 64) * (INW / 64))
        const int m0 = (T / (INW / 64)) * 64, n0 = (T % (INW / 64)) * 64;
        float acc[4][4] = {};
        ngemm_acc(acc, ABf{H + (size_t)m0 * D, D}, W + n0, INW, D, sm, t);
        if (valid) {
#pragma unroll
            for (int i = 0; i < 4; ++i) { float o[4];
#pragma unroll
                for (int j = 0; j < 4; ++j) { o[j] = acc[i][j]; if (n0 >= 512 && n0 < 1536) o[j] = geluf_(o[j]); }
                v2u w; w.x = pk2(o[0], o[1]); w.y = pk2(o[2], o[3]); *(v2u*)(PROJ + (size_t)(m0 + ty * 4 + i) * INW + n0 + tx * 4) = w; }
        }
    NTILE_END
}
__device__ __forceinline__ int chain_row(int dir, int pos) { return dir == 0 ? (pos < CTX ? SEQ + pos : pos - CTX) : (pos < CTX ? SEQ + CTX - 1 - pos : SEQ - 1 - (pos - CTX)); }
__device__ __forceinline__ void ph3_s5_naive(Frame& F, int l) {
    LAS float* Cr = (LAS float*)(F.lds + 32768); LAS float* Ci = Cr + 1024; LAS float* Sr = Ci + 1024; LAS float* Si = Sr + 2048;
    const bf16* PROJ = (const bf16*)(F.ws + WS_PROJ); float* YD = (float*)(F.ws + WS_S5);
    for (int item = F.bid; item < 64; item += F.G) {
        if (F.wave == 0) {
            const int g = item >> 1, dir = item & 1, p = F.lane;
            const int ldg = ((l * 2 + dir) * G5 + g);
            const float lr = IN_(I_LRE)[ldg * P5 + p], li = IN_(I_LIM)[ldg * P5 + p], dt = expf(IN_(I_LDT)[ldg]);
            const float er = expf(lr * dt), ar = er * cosf(li * dt), ai = er * sinf(li * dt);
            const float nr = ar - 1.f, ni = ai, den = lr * lr + li * li;
            const float qr = (nr * lr + ni * li) / den, qi = (ni * lr - nr * li) / den;
            float br[16], bi[16];
#pragma unroll
            for (int h = 0; h < 16; ++h) { const float x = IN_(I_BRE)[((size_t)ldg * P5 + p) * H5 + h], y = IN_(I_BIM)[((size_t)ldg * P5 + p) * H5 + h]; br[h] = qr * x - qi * y; bi[h] = qr * y + qi * x; }
            for (int h = 0; h < 16; ++h) { Cr[h * 64 + p] = IN_(I_CRE)[((size_t)ldg * H5 + h) * P5 + p]; Ci[h * 64 + p] = IN_(I_CIM)[((size_t)ldg * H5 + h) * P5 + p]; }
            float sr = 0.f, si = 0.f;
            float* Y = YD + (size_t)dir * MT * MIXW;
#pragma unroll 1
            for (int blk = 0; blk < MT / 32; ++blk) {
#pragma unroll 1
                for (int tt = 0; tt < 32; ++tt) {
                    const int row = chain_row(dir, blk * 32 + tt);
                    const v4u u0 = *(const v4u*)(PROJ + (size_t)row * INW + g * 16), u1 = *(const v4u*)(PROJ + (size_t)row * INW + g * 16 + 8);
                    const unsigned uw[8] = {u0.x, u0.y, u0.z, u0.w, u1.x, u1.y, u1.z, u1.w};
                    float xr = 0.f, xi = 0.f;
#pragma unroll
                    for (int h = 0; h < 8; ++h) { const float ua = bf2f((unsigned short)(uw[h] & 0xffff)), ub = bf2f((unsigned short)(uw[h] >> 16));
                        xr += br[2 * h] * ua + br[2 * h + 1] * ub; xi += bi[2 * h] * ua + bi[2 * h + 1] * ub; }
                    const float nsr = ar * sr - ai * si + xr, nsi = ar * si + ai * sr + xi;
                    sr = nsr; si = nsi; Sr[tt * 64 + p] = sr; Si[tt * 64 + p] = si;
                }
                asm volatile("s_waitcnt lgkmcnt(0)" ::: "memory");
#pragma unroll 1
                for (int o = p; o < 512; o += 64) {
                    const int tt = o >> 4, h = o & 15; float a = 0.f;
#pragma unroll 4
                    for (int q = 0; q < 64; ++q) a += Cr[h * 64 + q] * Sr[tt * 64 + q] - Ci[h * 64 + q] * Si[tt * 64 + q];
                    Y[(size_t)chain_row(dir, blk * 32 + tt) * MIXW + g * 16 + h] = a;
                }
                asm volatile("s_waitcnt lgkmcnt(0)" ::: "memory");
            }
        }
    }
}
__device__ __forceinline__ void ph3_sg_naive(Frame& F, int l) {
    const bf16* PROJ = (const bf16*)(F.ws + WS_PROJ); bf16* YB = (bf16*)(F.ws + WS_YS) + (size_t)MT * MIXW;
    LAS float* stat = (LAS float*)(F.lds + 32768);
    const float* lg = IN_(I_SGG) + l * MIXW; const float* lb = IN_(I_SGB) + l * MIXW;
    NTILE_BEGIN((MT / 128) * 16)
        const int chunk = T >> 4, gg = (T >> 2) & 3, q0 = ((T >> 1) & 1) * 64, c0 = (T & 1) * 64;
        LAS float* st = stat + _half * 256;
        __syncthreads();
        if (t < 128) { const bf16* vr = PROJ + (size_t)(chunk * 128 + t) * INW + 1024; float s = 0.f;
            for (int c = 0; c < 512; c += 2) { const unsigned w = *(const unsigned*)(vr + c); s += bf2f((unsigned short)(w & 0xffff)) + bf2f((unsigned short)(w >> 16)); }
            const float mu = s * (1.f / 512.f); float q = 0.f;
            for (int c = 0; c < 512; c += 2) { const unsigned w = *(const unsigned*)(vr + c); const float a = bf2f((unsigned short)(w & 0xffff)) - mu, b = bf2f((unsigned short)(w >> 16)) - mu; q += a * a + b * b; }
            st[t * 2] = mu; st[t * 2 + 1] = rsqrtf(q * (1.f / 512.f) + EPS); }
        __syncthreads();
        float acc[4][4] = {};
        {
            const float* A = IN_(I_WSG) + ((size_t)(l * 4 + gg) * 128 + q0) * 128;
            const int lr = t >> 2, lk = (t & 3) * 4, bk = t >> 4, bn = (t & 15) * 4;
            for (int k0 = 0; k0 < 128; k0 += 16) {
                const float4 av = *(const float4*)(A + (size_t)lr * 128 + k0 + lk);
                const int p = k0 + bk; const int col = gg * 128 + c0 + bn;
                const v2u w = *(const v2u*)(PROJ + (size_t)(chunk * 128 + p) * INW + 1024 + col);
                const float mu = st[p * 2], rs = st[p * 2 + 1];
                float4 bv; bv.x = (bf2f((unsigned short)(w.x & 0xffff)) - mu) * rs * lg[col] + lb[col]; bv.y = (bf2f((unsigned short)(w.x >> 16)) - mu) * rs * lg[col + 1] + lb[col + 1];
                bv.z = (bf2f((unsigned short)(w.y & 0xffff)) - mu) * rs * lg[col + 2] + lb[col + 2]; bv.w = (bf2f((unsigned short)(w.y >> 16)) - mu) * rs * lg[col + 3] + lb[col + 3];
                __syncthreads();
                sm->As[lk + 0][lr] = av.x; sm->As[lk + 1][lr] = av.y; sm->As[lk + 2][lr] = av.z; sm->As[lk + 3][lr] = av.w;
                *(LAS f32x4*)&sm->Bs[bk][bn] = (f32x4){bv.x, bv.y, bv.z, bv.w};
                __syncthreads();
#pragma unroll
                for (int k = 0; k < 16; ++k) { const f32x4 a = *(const LAS f32x4*)&sm->As[k][ty * 4]; const f32x4 b = *(const LAS f32x4*)&sm->Bs[k][tx * 4];
                    const float aa[4] = {a.x, a.y, a.z, a.w}, bb[4] = {b.x, b.y, b.z, b.w};
#pragma unroll
                    for (int i = 0; i < 4; ++i)
#pragma unroll
                        for (int j = 0; j < 4; ++j) acc[i][j] += aa[i] * bb[j]; }
            }
        }
        if (valid) {
#pragma unroll
            for (int i = 0; i < 4; ++i) { const int q = q0 + ty * 4 + i; const size_t row = (size_t)chunk * 128 + q; const int col = gg * 128 + c0 + tx * 4;
                const float bq = IN_(I_BSG)[l * 512 + gg * 128 + q];
                const v2u gu = *(const v2u*)(PROJ + row * INW + 512 + col);
                v2u w; w.x = pk2(bf2f((unsigned short)(gu.x & 0xffff)) * (acc[i][0] + bq), bf2f((unsigned short)(gu.x >> 16)) * (acc[i][1] + bq));
                w.y = pk2(bf2f((unsigned short)(gu.y & 0xffff)) * (acc[i][2] + bq), bf2f((unsigned short)(gu.y >> 16)) * (acc[i][3] + bq));
                *(v2u*)(YB + row * MIXW + col) = w; }
        }
    NTILE_END
}
__device__ __forceinline__ void ph3_conv(Frame& F, int l) {
    const bf16* PROJ = (const bf16*)(F.ws + WS_PROJ); bf16* YC = (bf16*)(F.ws + WS_YS) + (size_t)2 * MT * MIXW; const float* wc = IN_(I_WCONV) + l * 3 * MIXW;
    const size_t gt = (size_t)F.bid * NT + F.tid, ngt = (size_t)F.G * NT;
    for (size_t i = gt; i < (size_t)MT * (MIXW / 2); i += ngt) {
        const int row = (int)(i / (MIXW / 2)), c = (int)(i % (MIXW / 2)) * 2;
        int pos, rl; if (row < SEQ) { pos = row & 63; rl = 64; } else { pos = row - SEQ; rl = 256; }
        const bf16* r0 = PROJ + (size_t)row * INW + 1536;
        const unsigned b0 = *(const unsigned*)(r0 + c), c0 = *(const unsigned*)(r0 + 512 + c), h0 = *(const unsigned*)(r0 + 1024 + c);
        float zm0 = 0.f, zm1 = 0.f, zp0 = 0.f, zp1 = 0.f;
        if (pos > 0) { const unsigned cc = *(const unsigned*)(r0 - INW + 512 + c), hh = *(const unsigned*)(r0 - INW + 1024 + c); zm0 = bf2f((unsigned short)(cc & 0xffff)) * bf2f((unsigned short)(hh & 0xffff)); zm1 = bf2f((unsigned short)(cc >> 16)) * bf2f((unsigned short)(hh >> 16)); }
        if (pos < rl - 1) { const unsigned cc = *(const unsigned*)(r0 + INW + 512 + c), hh = *(const unsigned*)(r0 + INW + 1024 + c); zp0 = bf2f((unsigned short)(cc & 0xffff)) * bf2f((unsigned short)(hh & 0xffff)); zp1 = bf2f((unsigned short)(cc >> 16)) * bf2f((unsigned short)(hh >> 16)); }
        const float z00 = bf2f((unsigned short)(c0 & 0xffff)) * bf2f((unsigned short)(h0 & 0xffff)), z01 = bf2f((unsigned short)(c0 >> 16)) * bf2f((unsigned short)(h0 >> 16));
        const float y0 = bf2f((unsigned short)(b0 & 0xffff)) * (wc[c] * zm0 + wc[512 + c] * z00 + wc[1024 + c] * zp0);
        const float y1 = bf2f((unsigned short)(b0 >> 16)) * (wc[c + 1] * zm1 + wc[512 + c + 1] * z01 + wc[1024 + c + 1] * zp1);
        *(unsigned*)(YC + (size_t)row * MIXW + c) = pk2(y0, y1);
    }
}
__device__ __forceinline__ void ph5_naive(Frame& F, int l) {
    const bf16* PROJ = (const bf16*)(F.ws + WS_PROJ); const float* YD = (const float*)(F.ws + WS_S5); bf16* YG = (bf16*)(F.ws + WS_YG); const float* ds = IN_(I_DSKIP) + l * MIXW;
    const size_t gt = (size_t)F.bid * NT + F.tid, ngt = (size_t)F.G * NT;
    for (size_t i = gt; i < (size_t)MT * (MIXW / 2); i += ngt) {
        const int row = (int)(i / (MIXW / 2)), c = (int)(i % (MIXW / 2)) * 2;
        const unsigned u = *(const unsigned*)(PROJ + (size_t)row * INW + c); const size_t o = (size_t)row * MIXW + c;
        const float y0 = YD[o] + YD[(size_t)MT * MIXW + o] + ds[c] * bf2f((unsigned short)(u & 0xffff)), y1 = YD[o + 1] + YD[(size_t)MT * MIXW + o + 1] + ds[c + 1] * bf2f((unsigned short)(u >> 16));
        *(unsigned*)(YG + o) = pk2(geluf_(y0), geluf_(y1));
    }
}
__device__ __forceinline__ void ph6_naive(Frame& F, int l) {
    const bf16* YG = (const bf16*)(F.ws + WS_YG); bf16* YA = (bf16*)(F.ws + WS_YS); const float* W = IN_(I_WGLU) + (size_t)l * MIXW * MIXW;
    NTILE_BEGIN((MT / 64) * (MIXW / 64))
        const int m0 = (T / (MIXW / 64)) * 64, n0 = (T % (MIXW / 64)) * 64;
        float acc[4][4] = {};
        ngemm_acc(acc, ABf{YG + (size_t)m0 * MIXW, MIXW}, W + n0, MIXW, MIXW, sm, t);
        if (valid) {
#pragma unroll
            for (int i = 0; i < 4; ++i) { const size_t o = (size_t)(m0 + ty * 4 + i) * MIXW + n0 + tx * 4; const v2u g = *(const v2u*)(YG + o);
                v2u w; w.x = pk2(bf2f((unsigned short)(g.x & 0xffff)) * sigmoidf_(acc[i][0]), bf2f((unsigned short)(g.x >> 16)) * sigmoidf_(acc[i][1]));
                w.y = pk2(bf2f((unsigned short)(g.y & 0xffff)) * sigmoidf_(acc[i][2]), bf2f((unsigned short)(g.y >> 16)) * sigmoidf_(acc[i][3])); *(v2u*)(YA + o) = w; }
        }
    NTILE_END
}
__device__ __forceinline__ void ph7_naive(Frame& F, int l) {
    const bf16* YS = (const bf16*)(F.ws + WS_YS); bf16* BR = (bf16*)(F.ws + WS_PROJ); const float* W = IN_(I_WBR) + (size_t)l * 3 * MIXW * D;
    NTILE_BEGIN((MT / 64) * (INW / 64))
        const int m0 = (T / (INW / 64)) * 64, n0 = (T % (INW / 64)) * 64, k = n0 / 1024, d0 = n0 % 1024;
        float acc[4][4] = {};
        ngemm_acc(acc, ABf{YS + (size_t)k * MT * MIXW + (size_t)m0 * MIXW, MIXW}, W + (size_t)k * MIXW * D + d0, D, MIXW, sm, t);
        if (valid) {
#pragma unroll
            for (int i = 0; i < 4; ++i) { v2u w; w.x = pk2(acc[i][0], acc[i][1]); w.y = pk2(acc[i][2], acc[i][3]); *(v2u*)(BR + (size_t)(m0 + ty * 4 + i) * INW + n0 + tx * 4) = w; }
        }
    NTILE_END
}
__device__ __forceinline__ void ph8_naive(Frame& F, int l) {
    const bf16* H = (const bf16*)(F.ws + WS_H); const bf16* BR = (const bf16*)(F.ws + WS_PROJ); bf16* PM = (bf16*)(F.ws + WS_PM);
    const float* W = IN_(I_WMG) + (size_t)l * D * INW; const float* bm = IN_(I_BMG) + l * INW;
    NTILE_BEGIN((MT / 64) * (D / 64))
        const int m0 = (T / (D / 64)) * 64, n0 = (T % (D / 64)) * 64;
        float out[4][4] = {};
        for (int k = 0; k < 3; ++k) {
            float acc[4][4] = {};
            ngemm_acc(acc, ABf{H + (size_t)m0 * D, D}, W + k * 1024 + n0, INW, D, sm, t);
#pragma unroll
            for (int i = 0; i < 4; ++i) { const v2u b = *(const v2u*)(BR + (size_t)(m0 + ty * 4 + i) * INW + k * 1024 + n0 + tx * 4);
                const float bb[4] = {bf2f((unsigned short)(b.x & 0xffff)), bf2f((unsigned short)(b.x >> 16)), bf2f((unsigned short)(b.y & 0xffff)), bf2f((unsigned short)(b.y >> 16))};
#pragma unroll
                for (int j = 0; j < 4; ++j) out[i][j] += sigmoidf_(acc[i][j] + bm[k * 1024 + n0 + tx * 4 + j]) * bb[j]; }
        }
        if (valid) {
#pragma unroll
            for (int i = 0; i < 4; ++i) { v2u w; w.x = pk2(out[i][0], out[i][1]); w.y = pk2(out[i][2], out[i][3]); *(v2u*)(PM + (size_t)(m0 + ty * 4 + i) * D + n0 + tx * 4) = w; }
        }
    NTILE_END
}
__device__ __forceinline__ void ph9_naive(Frame& F, int l) {
    const bf16* PM = (const bf16*)(F.ws + WS_PM); const float* W = IN_(I_WO) + (size_t)l * D * D;
    NTILE_BEGIN((MT / 64) * (D / 64))
        const int m0 = (T / (D / 64)) * 64, n0 = (T % (D / 64)) * 64;
        float acc[4][4] = {};
        ngemm_acc(acc, ABf{PM + (size_t)m0 * D, D}, W + n0, D, D, sm, t);
        if (valid) {
#pragma unroll
            for (int i = 0; i < 4; ++i) { const int row = m0 + ty * 4 + i, c = n0 + tx * 4; const float* m = mod_ptr(F, l, row) + 2048 + c;
                const f32x4 xs = *(const f32x4*)(xsrc_row(F, l, row) + c);
                f32x4 o; o.x = xs.x + m[0] * acc[i][0]; o.y = xs.y + m[1] * acc[i][1]; o.z = xs.z + m[2] * acc[i][2]; o.w = xs.w + m[3] * acc[i][3];
                *(f32x4*)(xrun_row(F, row) + c) = o; }
        }
    NTILE_END
}
__device__ __forceinline__ void ph10_route(Frame& F, int l) {
    bf16* H = (bf16*)(F.ws + WS_H); const float* g = IN_(I_GFFN) + l * D;
    const float* wg = IN_(I_WGRP) + (size_t)l * D * 4; const float* we = IN_(I_WEXP) + (size_t)l * D * 32; const float* bg = IN_(I_BGRP) + l * 4; const float* be = IN_(I_BEXP) + l * 32;
    int* EID = (int*)(F.ws + WS_EID); float* EW = (float*)(F.ws + WS_EW); unsigned* cnt = F.ctl + CW_CNT + l * 128;
    LAS float* L = (LAS float*)(F.lds + 65536) + F.wave * 40;
    const int gw = F.bid * (NT / 64) + F.wave, ngw = F.G * (NT / 64);
    for (int row = gw; row < MT; row += ngw) {
        const float* m = mod_ptr(F, l, row); const float* xr = xrun_row(F, row);
        float s = 0.f;
#pragma unroll
        for (int j = 0; j < 4; ++j) { const f32x4 x = *(const f32x4*)(xr + 4 * F.lane + 256 * j); s += x.x * x.x + x.y * x.y + x.z * x.z + x.w * x.w; }
        const float rstd = rsqrtf(wave_sum(s) * (1.f / D) + EPS);
        float acc[36];
#pragma unroll
        for (int o = 0; o < 36; ++o) acc[o] = 0.f;
#pragma unroll 1
        for (int j = 0; j < 4; ++j) { const int c = 4 * F.lane + 256 * j; const f32x4 x = *(const f32x4*)(xr + c); const f32x4 gg = *(const f32x4*)(g + c), sc = *(const f32x4*)(m + 4096 + c), sh = *(const f32x4*)(m + 3072 + c);
            const f32x4 o = x * rstd * gg * (1.f + sc) + sh; v2u w; w.x = pk2(o.x, o.y); w.y = pk2(o.z, o.w); *(v2u*)(H + (size_t)row * D + c) = w;
            const float hv[4] = {o.x, o.y, o.z, o.w};
#pragma unroll
            for (int e = 0; e < 4; ++e) { const float* wgr = wg + (size_t)(c + e) * 4; const float* wer = we + (size_t)(c + e) * 32;
#pragma unroll
                for (int q = 0; q < 4; ++q) acc[q] += hv[e] * wgr[q];
#pragma unroll
                for (int q = 0; q < 32; ++q) acc[4 + q] += hv[e] * wer[q]; } }
#pragma unroll
        for (int o = 0; o < 36; ++o) acc[o] = wave_sum(acc[o]);
        if (F.lane == 0) {
#pragma unroll
            for (int o = 0; o < 4; ++o) L[o] = acc[o] + bg[o];
#pragma unroll
            for (int o = 0; o < 32; ++o) L[4 + o] = acc[4 + o] + be[o];
            int gi = 0; float gm = L[0]; for (int o = 1; o < 4; ++o) if (L[o] > gm) { gm = L[o]; gi = o; }
            float den = 0.f; for (int o = 0; o < 4; ++o) den += expf(L[o] - gm);
            const float gp = 1.f / den;
            const LAS float* el = L + 4 + gi * 8;
            int i1 = 0; float m1 = el[0]; for (int o = 1; o < 8; ++o) if (el[o] > m1) { m1 = el[o]; i1 = o; }
            int i2 = -1; float m2 = 0.f; for (int o = 0; o < 8; ++o) if (o != i1 && (i2 < 0 || el[o] > m2)) { m2 = el[o]; i2 = o; }
            const float e2 = expf(m2 - m1); const float w1 = 1.f / (1.f + e2), w2 = e2 / (1.f + e2);
            const int e1i = gi * 8 + i1, e2i = gi * 8 + i2;
            EID[row * 2] = e1i; EID[row * 2 + 1] = e2i; EW[row * 2] = gp * w1; EW[row * 2 + 1] = gp * w2;
            atomicAdd(&cnt[e1i], 1u); atomicAdd(&cnt[e2i], 1u);
        }
    }
}
__device__ __forceinline__ int expert_off(const unsigned* cnt, int e) { int o = 0; for (int i = 0; i < e; ++i) o += ((int)cnt[i] + 255) & ~255; return o; }
__device__ __forceinline__ void ph11_scatter(Frame& F, int l) {
    const bf16* H = (const bf16*)(F.ws + WS_H); bf16* HS = (bf16*)(F.ws + WS_HS);
    const int* EID = (const int*)(F.ws + WS_EID); const float* EW = (const float*)(F.ws + WS_EW); int* STOK = (int*)(F.ws + WS_STOK); float* SW = (float*)(F.ws + WS_SW); int* TSLOT = (int*)(F.ws + WS_TSLOT);
    unsigned* cnt = F.ctl + CW_CNT + l * 128; unsigned* fill = cnt + 64;
    const int gw = F.bid * (NT / 64) + F.wave, ngw = F.G * (NT / 64);
    for (int i = gw; i < MT * 2; i += ngw) {
        int slot = 0;
        if (F.lane == 0) { const int e = EID[i]; const int pos = (int)atomicAdd(&fill[e], 1u); slot = expert_off(cnt, e) + pos; STOK[slot] = i >> 1; SW[slot] = EW[i]; TSLOT[i] = slot; }
        slot = __shfl(slot, 0);
        const v4u* src = (const v4u*)(H + (size_t)(i >> 1) * D); v4u* dst = (v4u*)(HS + (size_t)slot * D);
        dst[F.lane] = src[F.lane]; dst[F.lane + 64] = src[F.lane + 64];
    }
}
__device__ __forceinline__ int slot_expert(const unsigned* cnt, int slot0, int& seg_off, int& n_e) { int o = 0; for (int e = 0; e < NE; ++e) { const int n = (int)cnt[e], pn = (n + 255) & ~255; if (slot0 < o + pn) { seg_off = o; n_e = n; return e; } o += pn; } seg_off = o; n_e = 0; return 0; }
__device__ __forceinline__ void ph12_naive(Frame& F, int l) {
    const bf16* HS = (const bf16*)(F.ws + WS_HS); bf16* ACT = (bf16*)(F.ws + WS_ACT); const float* SW = (const float*)(F.ws + WS_SW);
    const unsigned* cnt = F.ctl + CW_CNT + l * 128; const int total = expert_off(cnt, NE);
    NTILE_BEGIN((total / 64) * (DFF / 64))
        const int s0 = (T / (DFF / 64)) * 64, n0 = (T % (DFF / 64)) * 64; int seg, n_e; const int e = slot_expert(cnt, s0, seg, n_e);
        float aa[4][4] = {}, ab[4][4] = {};
        ngemm_acc(aa, ABf{HS + (size_t)s0 * D, D}, IN_(I_W1) + ((size_t)l * NE + e) * D * DFF + n0, DFF, D, sm, t);
        ngemm_acc(ab, ABf{HS + (size_t)s0 * D, D}, IN_(I_W3) + ((size_t)l * NE + e) * D * DFF + n0, DFF, D, sm, t);
        if (valid) {
#pragma unroll
            for (int i = 0; i < 4; ++i) { const int slot = s0 + ty * 4 + i; if (slot - seg < n_e) { const float w = SW[slot];
                v2u o; o.x = pk2(siluf_(aa[i][0]) * ab[i][0] * w, siluf_(aa[i][1]) * ab[i][1] * w); o.y = pk2(siluf_(aa[i][2]) * ab[i][2] * w, siluf_(aa[i][3]) * ab[i][3] * w);
                *(v2u*)(ACT + (size_t)slot * DFF + n0 + tx * 4) = o; } }
        }
    NTILE_END
}
__device__ __forceinline__ void ph13_naive(Frame& F, int l) {
    const bf16* ACT = (const bf16*)(F.ws + WS_ACT); bf16* YS2 = (bf16*)(F.ws + WS_YS2);
    const unsigned* cnt = F.ctl + CW_CNT + l * 128; const int total = expert_off(cnt, NE);
    NTILE_BEGIN((total / 64) * (D / 64))
        const int s0 = (T / (D / 64)) * 64, n0 = (T % (D / 64)) * 64; int seg, n_e; const int e = slot_expert(cnt, s0, seg, n_e);
        float acc[4][4] = {};
        ngemm_acc(acc, ABf{ACT + (size_t)s0 * DFF, DFF}, IN_(I_W2) + ((size_t)l * NE + e) * DFF * D + n0, D, DFF, sm, t);
        if (valid) {
#pragma unroll
            for (int i = 0; i < 4; ++i) { const int slot = s0 + ty * 4 + i; if (slot - seg < n_e) { v2u o; o.x = pk2(acc[i][0], acc[i][1]); o.y = pk2(acc[i][2], acc[i][3]); *(v2u*)(YS2 + (size_t)slot * D + n0 + tx * 4) = o; } }
        }
    NTILE_END
}
__device__ __forceinline__ void ph14_combine(Frame& F, int l) {
    const bf16* YS2 = (const bf16*)(F.ws + WS_YS2); const int* TSLOT = (const int*)(F.ws + WS_TSLOT); bf16* H = (bf16*)(F.ws + WS_H);
    const int gw = F.bid * (NT / 64) + F.wave, ngw = F.G * (NT / 64);
    const int nrows = l == 0 ? MT : SEQ;
    for (int row = gw; row < nrows; row += ngw) {
        const float* m = mod_ptr(F, l, row); float* xr = xrun_row(F, row);
        const int s0 = TSLOT[row * 2], s1 = TSLOT[row * 2 + 1];
        f32x4 v[4]; float s = 0.f;
#pragma unroll
        for (int j = 0; j < 4; ++j) { const int c = 4 * F.lane + 256 * j; const f32x4 x = *(const f32x4*)(xr + c); const f32x4 ga = *(const f32x4*)(m + 5120 + c);
            const v2u a = *(const v2u*)(YS2 + (size_t)s0 * D + c), b = *(const v2u*)(YS2 + (size_t)s1 * D + c);
            f32x4 y; y.x = bf2f((unsigned short)(a.x & 0xffff)) + bf2f((unsigned short)(b.x & 0xffff)); y.y = bf2f((unsigned short)(a.x >> 16)) + bf2f((unsigned short)(b.x >> 16));
            y.z = bf2f((unsigned short)(a.y & 0xffff)) + bf2f((unsigned short)(b.y & 0xffff)); y.w = bf2f((unsigned short)(a.y >> 16)) + bf2f((unsigned short)(b.y >> 16));
            v[j] = x + ga * y; s += v[j].x * v[j].x + v[j].y * v[j].y + v[j].z * v[j].z + v[j].w * v[j].w; }
        const float rstd = rsqrtf(wave_sum(s) * (1.f / D) + EPS);
        if (l == 0) {
            const float* m1 = mod_ptr(F, 1, row); const float* g = IN_(I_GMIX) + D;
#pragma unroll
            for (int j = 0; j < 4; ++j) { const int c = 4 * F.lane + 256 * j; *(f32x4*)(xr + c) = v[j];
                const f32x4 gg = *(const f32x4*)(g + c), sc = *(const f32x4*)(m1 + 1024 + c), sh = *(const f32x4*)(m1 + c);
                const f32x4 o = v[j] * rstd * gg * (1.f + sc) + sh; v2u w; w.x = pk2(o.x, o.y); w.y = pk2(o.z, o.w); *(v2u*)(H + (size_t)row * D + c) = w; }
        } else {
            const float* g = IN_(I_GF);
#pragma unroll
            for (int j = 0; j < 4; ++j) { const int c = 4 * F.lane + 256 * j; const f32x4 gg = *(const f32x4*)(g + c); *(f32x4*)(xr + c) = v[j] * rstd * gg; }
        }
    }
}

#ifndef FASTMASK
#define FASTMASK 0xffff
#endif
constexpr unsigned FM = FASTMASK;
constexpr int NPH = 2 + 13 * 2;
__device__ __forceinline__ Frame make_frame(LAS unsigned char* lds) {
    Frame F; F.lds = lds; F.tid = threadIdx.x; asm volatile("" : "+v"(F.tid)); F.lane = F.tid & 63; F.wave = __builtin_amdgcn_readfirstlane(F.tid >> 6); F.bid = blockIdx.x; F.G = gridDim.x; asm volatile("" : "+s"(F.G), "+s"(F.bid));
    F.tab = (const unsigned long long LAS*)(lds + TAB_OFF);
    volatile LAS unsigned long long* t = (volatile LAS unsigned long long*)(lds + TAB_OFF);
    F.ws = (unsigned char*)uni64(t[35]); F.out = (float*)uni64(t[36]); F.ctl = (unsigned*)(F.ws + WS_CTL);
    return F;
}
__global__ void __launch_bounds__(NT, 2) mega_fwd(Args args) {
    extern __shared__ __attribute__((aligned(16))) unsigned char lds_raw[];
    LAS unsigned char* const lds = (LAS unsigned char*)lds_raw;
    for (int u = threadIdx.x; u < 1024 / 4; u += NT) ((LAS unsigned*)(lds + 131072))[u] = 0u;
    if (threadIdx.x == 0) { LAS unsigned long long* t = (LAS unsigned long long*)(lds + TAB_OFF);
#pragma unroll
        for (int i = 0; i < 35; ++i) t[i] = (unsigned long long)args.in[i];
        t[35] = (unsigned long long)args.ws; t[36] = (unsigned long long)args.out; }
    __syncthreads();
    { Frame F = make_frame(lds); (void)xcd_barrier_post(F.ctl + CW_BAR, (volatile LAS unsigned*)(lds + MISC_OFF) + 8); }
    const int lo = args.ph_lo, hi = args.ph_hi; int ph = 0;
#define GRIDBAR() do { Frame Fb = make_frame(lds); XcdBarrier bar; bar.bar = Fb.ctl + CW_BAR; bar.x = xb_xcc_id(); bar.st = (volatile LAS unsigned*)(lds + MISC_OFF) + 8; xcd_barrier(bar); } while (0)
#define PHASE(...) do { if (lo <= ph && ph < hi) { { Frame F = make_frame(lds); __VA_ARGS__; } if (ph + 1 < hi) GRIDBAR(); } ++ph; } while (0)
    PHASE({ ph0_prologue(F); convert_weights(F, 0); { const f32x4* s = (const f32x4*)IN_(I_CTX); f32x4* d = (f32x4*)(F.ws + WS_XC); for (int i = F.bid * NT + F.tid; i < CTX * D / 4; i += F.G * NT) d[i] = s[i]; } });
    PHASE(hprep_rows(F, 0));
#pragma unroll 1
    for (int l = 0; l < 2; ++l) {
        PHASE({ if (FM >> 2 & 1) ph2_fast(F, l); else ph2_naive(F, l); });
        PHASE({ ph3_s5_naive(F, l); if (F.bid >= 64) { Frame F2 = F; F2.bid -= 64; F2.G -= 64; ph3_sg_naive(F2, l); ph3_conv(F2, l); } });
        PHASE({});
        PHASE(ph5_naive(F, l));
        PHASE({ if (FM >> 6 & 1) ph6_fast(F, l); else ph6_naive(F, l); });
        PHASE({ if (FM >> 7 & 1) ph7_fast(F, l); else ph7_naive(F, l); });
        PHASE({ if (FM >> 8 & 1) ph8_fast(F, l); else ph8_naive(F, l); });
        PHASE({ if (FM >> 9 & 1) ph9_fast(F, l); else ph9_naive(F, l); });
        PHASE(ph10_route(F, l));
        PHASE(ph11_scatter(F, l));
        PHASE({ if (FM >> 12 & 1) ph12_fast(F, l); else ph12_naive(F, l); });
        PHASE({ if (FM >> 13 & 1) ph13_fast(F, l); else ph13_naive(F, l); });
        PHASE({ ph14_combine(F, l); if (l == 0) convert_weights(F, 1); });
    }
#undef PHASE
}

extern "C" void kernel_launch(void* const* d_in, const int* in_sizes, int n_in, void* d_out, int out_size, void* d_ws, size_t ws_size, hipStream_t stream) {
    static int grid = 0;
    if (grid == 0) {
        int dev = 0, cus = 0, per_cu = 0;
        if (n_in != 35 || out_size != SEQ * D || ws_size < WS_END) { fprintf(stderr, "kernel_launch: unexpected shapes (n_in %d out %d ws %zu)\n", n_in, out_size, ws_size); grid = -1; return; }
        if (hipGetDevice(&dev) != hipSuccess || hipDeviceGetAttribute(&cus, hipDeviceAttributeMultiprocessorCount, dev) != hipSuccess) { grid = -1; return; }
        if (hipFuncSetAttribute((const void*)mega_fwd, hipFuncAttributeMaxDynamicSharedMemorySize, LDS_BYTES) != hipSuccess) { fprintf(stderr, "kernel_launch: hipFuncSetAttribute failed\n"); grid = -1; return; }
        if (hipOccupancyMaxActiveBlocksPerMultiprocessor(&per_cu, (const void*)mega_fwd, NT, LDS_BYTES) != hipSuccess || per_cu < 1) { fprintf(stderr, "kernel_launch: occupancy query says %d blocks per CU\n", per_cu); grid = -1; return; }
        grid = cus;
    }
    if (grid < 0) return;
    (void)hipMemsetAsync((char*)d_ws + WS_CTL, 0, CTL_ZERO_BYTES, stream);
    Args a{};
    for (int i = 0; i < 35; ++i) a.in[i] = (const float*)d_in[i];
    a.out = (float*)d_out; a.ws = (unsigned char*)d_ws; a.ph_lo = 0; a.ph_hi = NPH;
    void* kargs[] = {&a};
    hipError_t e = hipLaunchCooperativeKernel((const void*)mega_fwd, dim3(grid), dim3(NT), kargs, LDS_BYTES, stream);
    if (e != hipSuccess) fprintf(stderr, "kernel_launch: cooperative launch failed: %s (grid %d)\n", hipGetErrorString(e), grid);
}
```

```cpp
#include <hip/hip_runtime.h>
#include <stdint.h>
#include <cstdio>

#define GAS __attribute__((address_space(1)))
#define LAS __attribute__((address_space(3)))
typedef unsigned short bf16;
typedef unsigned v4u __attribute__((ext_vector_type(4)));
typedef unsigned v2u __attribute__((ext_vector_type(2)));
typedef float f32x4 __attribute__((ext_vector_type(4)));

constexpr int D = 1024, SEQ = 16384, CTX = 256, MT = SEQ + CTX;
constexpr int MIXW = 512, INW = 3072, G5 = 32, P5 = 64, H5 = 16;
constexpr int NE = 32, DFF = 256;
constexpr int MAXSLOT = 2 * MT + NE * 256;
constexpr float EPS = 1e-6f;
constexpr int NT = 512;

constexpr size_t MiB = 1u << 20;
constexpr size_t WS_CTL = 0, CTL_ZERO_BYTES = 1 * MiB;
constexpr size_t WS_MOD = 1 * MiB;
constexpr size_t WS_XC = 2 * MiB;
constexpr size_t WS_EID = 3 * MiB;
constexpr size_t WS_EW = WS_EID + (size_t)MT * 8;
constexpr size_t WS_STOK = WS_EW + (size_t)MT * 8;
constexpr size_t WS_SW = WS_STOK + (size_t)MAXSLOT * 4;
constexpr size_t WS_TSLOT = WS_SW + (size_t)MAXSLOT * 4;
constexpr size_t WS_H = 4 * MiB;
constexpr size_t WS_PROJ = WS_H + (size_t)MT * 2048;
constexpr size_t WS_YS = WS_PROJ + (size_t)MT * 6144;
constexpr size_t WS_YG = WS_YS + (size_t)3 * MT * 1024;
constexpr size_t WS_PM = WS_YG + (size_t)MT * 1024;
constexpr size_t WS_S5 = WS_PM + (size_t)MT * 2048;
constexpr size_t WS_Z = WS_S5;
constexpr size_t WS_SS = WS_Z + (size_t)1040 * 32 * 256 * 4;
constexpr size_t WS_S5M = WS_SS + (size_t)1040 * 32 * 256 * 2;
constexpr size_t WS_A16 = WS_S5M + (size_t)2 * 32 * 3 * 65536 * 2;
constexpr size_t WS_W = WS_A16 + (size_t)2 * 32 * 2 * 64 * 2 * 4 > WS_S5 + (size_t)2 * MT * 512 * 4 ? WS_A16 + (size_t)2 * 32 * 2 * 64 * 2 * 4 : WS_S5 + (size_t)2 * MT * 512 * 4;
constexpr size_t WS_WIN = WS_W;
constexpr size_t WS_WMG = WS_WIN + (size_t)3072 * 1024 * 2;
constexpr size_t WS_WGLU = WS_WMG + (size_t)3072 * 1024 * 2;
constexpr size_t WS_WBR = WS_WGLU + (size_t)512 * 512 * 2;
constexpr size_t WS_WO = WS_WBR + (size_t)3 * 1024 * 512 * 2;
constexpr size_t WS_W13 = WS_WO + (size_t)1024 * 1024 * 2;
constexpr size_t WS_W2 = WS_W13 + (size_t)32 * 512 * 1024 * 2;
constexpr size_t WS_WSG = WS_W2 + (size_t)32 * 1024 * 256 * 2;
constexpr size_t WS_END = WS_WSG + (size_t)4 * 128 * 128 * 2;
static_assert(WS_END <= (size_t)377 * MiB, "workspace budget");
constexpr size_t WS_HS = WS_PROJ;
constexpr size_t WS_ACT = WS_YS;
constexpr size_t WS_YS2 = WS_YG;
static_assert(WS_HS + (size_t)MAXSLOT * 2048 <= WS_YS && WS_ACT + (size_t)MAXSLOT * 512 <= WS_YG && WS_YS2 + (size_t)MAXSLOT * 2048 <= WS_W, "moe overlays");
static_assert(WS_TSLOT + (size_t)MT * 8 <= WS_H, "ws map");
constexpr int CW_CNT = 64;
constexpr int CW_BAR = 4096;

constexpr int LDS_BYTES = 147456;
constexpr int MISC_OFF = 131072 + 320;
constexpr int TAB_OFF = 131072 + 1024;

__device__ __forceinline__ float bf2f(unsigned short b) { return __builtin_bit_cast(float, ((unsigned)b) << 16); }
__device__ __forceinline__ unsigned f2bf(float f) { unsigned u = __builtin_bit_cast(unsigned, f); return (u + 0x7fffu + ((u >> 16) & 1u)) >> 16; }
__device__ __forceinline__ unsigned pk2(float lo, float hi) { return f2bf(lo) | (f2bf(hi) << 16); }
__device__ __forceinline__ float sigmoidf_(float x) { return 1.f / (1.f + __expf(-x)); }
__device__ __forceinline__ float siluf_(float x) { return x / (1.f + __expf(-x)); }
__device__ __forceinline__ float geluf_(float x) { const float u = 0.7978845608028654f * (x + 0.044715f * x * x * x); return x / (1.f + __expf(-2.f * u)); }
__device__ __forceinline__ float wave_sum(float v) {
#pragma unroll
    for (int o = 1; o < 64; o <<= 1) v += __shfl_xor(v, o);
    return v;
}

#define XB_TMO      128
#define XB_XCNT(j)  (256  + 64 * (j))
#define XB_XSUB(j)  (1280 + 64 * (j))
#define XB_XGEN(j)  (2304 + 64 * (j))
#define XB_TOP      3328
#define XB_TOPGEN   3392
#define XCD_BAR_WORDS 3456
#define XB_SPIN_CAP (1u << 24)
__device__ __forceinline__ unsigned xb_ld(unsigned* p)              { return __hip_atomic_load(p, __ATOMIC_RELAXED, __HIP_MEMORY_SCOPE_AGENT); }
__device__ __forceinline__ unsigned xb_add(unsigned* p, unsigned v) { return __hip_atomic_fetch_add(p, v, __ATOMIC_RELAXED, __HIP_MEMORY_SCOPE_AGENT); }
__device__ __forceinline__ unsigned xb_xcc_id() { return (unsigned)__builtin_amdgcn_s_getreg((3 << 11) | 20) & 0xFu; }
#define XB_SPIN(cond, bar) do { unsigned _sp = 0; while (cond) { __builtin_amdgcn_s_sleep(1); \
    if ((++_sp & 255u) == 0u) { if (xb_ld(&(bar)[XB_TMO])) break; if (_sp > XB_SPIN_CAP) { atomicAdd(&(bar)[XB_TMO], 1u); break; } } } } while (0)
struct XcdBarrier { unsigned* bar; unsigned x; volatile LAS unsigned* st; };
__device__ __forceinline__ XcdBarrier xcd_barrier_post(unsigned* bar, volatile LAS unsigned* st) {
    XcdBarrier b; b.bar = bar; b.x = xb_xcc_id(); b.st = st;
    if (threadIdx.x == 0) (void)xb_add(&bar[XB_XCNT(b.x)], 1u);
    return b;
}
__device__ __forceinline__ void xcd_barrier_complete(unsigned* bar, unsigned x, unsigned& nloc, unsigned& nx) {
    const unsigned G = gridDim.x * gridDim.y * gridDim.z;
    unsigned sum, cnt, mine, sp = 0u;
    for (;;) {
        sum = 0u; cnt = 0u; mine = 0u;
#pragma unroll
        for (unsigned j = 0; j < 16; ++j) { const unsigned c = xb_ld(&bar[XB_XCNT(j)]); sum += c; cnt += (c > 0u) ? 1u : 0u; mine = (j == x) ? c : mine; }
        if (sum == G) break;
        __builtin_amdgcn_s_sleep(1);
        if ((++sp & 255u) == 0u) { if (xb_ld(&bar[XB_TMO])) break; if (sp > XB_SPIN_CAP) { atomicAdd(&bar[XB_TMO], 1u); break; } }
    }
    nloc = mine > 0u ? mine : 1u; nx = cnt > 0u ? cnt : 1u;
}
__device__ __forceinline__ void xcd_barrier(const XcdBarrier& b) {
    asm volatile("s_waitcnt vmcnt(0)" ::: "memory");
    __syncthreads();
    if (threadIdx.x == 0) {
        unsigned* bar = b.bar;
        __builtin_amdgcn_s_waitcnt(0);
        unsigned nloc = b.st[0], nx = b.st[1];
        if (nloc == 0u) { xcd_barrier_complete(bar, b.x, nloc, nx); b.st[0] = nloc; b.st[1] = nx; }
        const unsigned old = xb_add(&bar[XB_XSUB(b.x)], 1u);
        const unsigned gen = old / nloc;
        if (old + 1u == (gen + 1u) * nloc) {
            __builtin_amdgcn_fence(__ATOMIC_RELEASE, "agent");
            asm volatile("s_waitcnt vmcnt(0)" ::: "memory");
            const unsigned og = xb_add(&bar[XB_TOP], 1u);
            const unsigned tg = og / nx;
            if (og + 1u == (tg + 1u) * nx) xb_add(&bar[XB_TOPGEN], 1u);
            else XB_SPIN(xb_ld(&bar[XB_TOPGEN]) == tg, bar);
            __builtin_amdgcn_fence(__ATOMIC_ACQUIRE, "agent");
            xb_add(&bar[XB_XGEN(b.x)], 1u);
            asm volatile("s_waitcnt vmcnt(0)" ::: "memory");
        } else {
            XB_SPIN(xb_ld(&bar[XB_XGEN(b.x)]) == gen, bar);
            __builtin_amdgcn_fence(__ATOMIC_ACQUIRE, "agent");
            asm volatile("s_waitcnt vmcnt(0)" ::: "memory");
        }
    }
    __syncthreads();
}

struct Args { const float* in[35]; float* out; unsigned char* ws; int ph_lo, ph_hi; };
struct Frame {
    LAS unsigned char* lds; unsigned char* ws; unsigned* ctl;
    int tid, lane, wave, bid, G;
    const unsigned long long LAS* tab; float* out;
};
__device__ __forceinline__ unsigned long long uni64(unsigned long long v) { const unsigned lo = __builtin_amdgcn_readfirstlane((unsigned)v), hi = __builtin_amdgcn_readfirstlane((unsigned)(v >> 32)); return ((unsigned long long)hi << 32) | lo; }
#define IN_(k) ((const float*)uni64(F.tab[k]))
enum { I_X = 0, I_C, I_CTX, I_CCTX, I_WADA, I_BADA, I_GMIX, I_GFFN, I_WIN, I_LRE, I_LIM, I_LDT, I_BRE, I_BIM, I_CRE, I_CIM, I_DSKIP, I_WGLU, I_SGG, I_SGB, I_WSG, I_BSG,
       I_WCONV, I_WBR, I_WMG, I_BMG, I_WO, I_WGRP, I_BGRP, I_WEXP, I_BEXP, I_W1, I_W3, I_W2, I_GF };

__device__ __forceinline__ const float* mod_ptr(const Frame& F, int l, int row) { return (const float*)(F.ws + WS_MOD) + (size_t)(l * 2 + (row >= SEQ ? 1 : 0)) * 6144; }
__device__ __forceinline__ const float* xsrc_row(const Frame& F, int l, int row) {
    if (l == 0) return row < SEQ ? IN_(I_X) + (size_t)row * D : IN_(I_CTX) + (size_t)(row - SEQ) * D;
    return row < SEQ ? F.out + (size_t)row * D : (const float*)(F.ws + WS_XC) + (size_t)(row - SEQ) * D;
}
__device__ __forceinline__ float* xrun_row(const Frame& F, int row) { return row < SEQ ? F.out + (size_t)row * D : (float*)(F.ws + WS_XC) + (size_t)(row - SEQ) * D; }


namespace pg8 {
#define PG8_LAS __attribute__((address_space(3)))
typedef unsigned short bf16_t;
typedef short bf16x8 __attribute__((ext_vector_type(8)));
typedef float f32x4 __attribute__((ext_vector_type(4)));
typedef unsigned u32x4 __attribute__((ext_vector_type(4)));
constexpr int BM = 256, BK = 64, HALF = 128, HTB = HALF * BK * 2  , STAGE_BYTES = 8 * HTB, NXCD = 8, WGM = 8;

__host__ __device__ __forceinline__ int lds_byte(int r, int c) { const int st = (r >> 4) * 2 + (c >> 5), rr = r & 15, cc = c & 31, ob = rr * 64 + cc * 2; return st * 1024 + (ob ^ (((ob >> 9) & 1) << 5)); }
__host__ __device__ __forceinline__ void stage_rc(int b, int& R, int& C) { const int st = b / 1024, sb = b % 1024, swz = sb ^ (((sb >> 9) & 1) << 5); R = (st >> 1) * 16 + swz / 64; C = (st & 1) * 32 + (swz % 64) / 2; }
__host__ __device__ __forceinline__ int perm32(int rho) { const int n = rho >> 4, i = rho & 15; return 8 * (i >> 2) + 4 * n + (i & 3); }

struct Unit { int pm, pn; };
struct Gemm { const bf16_t* A; const bf16_t* Bt; int M, N, K; };

struct StaticOrder {
    int nM, nN, nwg, G, c;
    __host__ __device__ void init(int M, int N, int G_, int c_) { nM = M / BM; nN = N / BM; nwg = nM * nN; G = G_; c = c_; }
    __host__ __device__ bool next(int i, Unit& u) const {
        const long L = (long)i * G + c; if (L >= nwg) return false;
        int wgid = (int)L; { const int q = nwg / NXCD, r = nwg % NXCD, xcd = wgid % NXCD, off = wgid / NXCD; wgid = (xcd < r ? xcd * (q + 1) : r * (q + 1) + (xcd - r) * q) + off; }
        const int nig = WGM * nN, gid = wgid / nig, fm = gid * WGM, gsz = (nM - fm) < WGM ? (nM - fm) : WGM;
        u.pm = fm + ((wgid % nig) % gsz); u.pn = (wgid % nig) / gsz; return true;
    }
    __device__ __forceinline__ void a_ready(const Unit&) const {}
    __device__ __forceinline__ void done(const Unit&) const {}
};
__device__ __forceinline__ unsigned cvt_pk_bf16(float lo, float hi) { unsigned r; asm volatile("v_cvt_pk_bf16_f32 %0, %1, %2" : "=v"(r) : "v"(lo), "v"(hi)); return r; }
template <class Epi, class Sched, bool ALIGN_EPI = false, bool SP2 = false>
__device__ __forceinline__ void gemm_phase(PG8_LAS unsigned char* lds, const Gemm g, const Sched& S, const Epi& E) {
    int tid_ = threadIdx.x; asm volatile("" : "+v"(tid_));
    const int tid = tid_, wid = __builtin_amdgcn_readfirstlane(tid >> 6), lane = tid & 63, wr = wid >> 2, wc = wid & 3, fr = lane & 15, fq = lane >> 4;
    const int K = g.K, nt = K / BK;
    unsigned voffA[2], voffB[2];
#pragma unroll
    for (int i = 0; i < 2; ++i) { int R, C; stage_rc(tid * 16 + i * 8192, R, C); const int Rb = Epi::PERM ? ((R & ~31) + perm32(R & 31)) : R;
        voffA[i] = (unsigned)(R * K + C) * 2u; voffB[i] = (unsigned)(Rb * K + C) * 2u; }
    const size_t kstep = (size_t)(BK * 2);
    const size_t hstep = (size_t)HALF * K * 2;
    const size_t tstep = 2 * hstep;
    const unsigned ldsw = (unsigned)wid * 1024u;
    const int aoff = lds_byte(wr * 64 + fr, fq * 8), boff = lds_byte(wc * 32 + fr, fq * 8);
#define PG8_SA(b, h) (((b) * 2 + (h)) * HTB)
#define PG8_SB(b, h) ((4 + (b) * 2 + (h)) * HTB)
#define PG8_STAGE(bufoff, gbase, voff) do { _Pragma("unroll") for (int _i = 0; _i < 2; ++_i) \
        __builtin_amdgcn_global_load_lds((const unsigned*)((const char*)(gbase) + (voff)[_i]), (PG8_LAS unsigned*)(lds + (bufoff) + ldsw + _i * 8192), 16, 0, 0); } while (0)
#define PG8_LDA(dst, b, h) do { _Pragma("unroll") for (int m = 0; m < 4; ++m) _Pragma("unroll") for (int k = 0; k < 2; ++k) dst[m][k] = *(const PG8_LAS bf16x8*)(lds + PG8_SA(b, h) + aoff + m * 2048 + k * 1024); } while (0)
#define PG8_LDB(dst, b, h) do { _Pragma("unroll") for (int n = 0; n < 2; ++n) _Pragma("unroll") for (int k = 0; k < 2; ++k) dst[n][k] = *(const PG8_LAS bf16x8*)(lds + PG8_SB(b, h) + boff + n * 2048 + k * 1024); } while (0)
#define PG8_MMA(ai, bj, At, Bt) do { __builtin_amdgcn_s_setprio(1); _Pragma("unroll") for (int m = 0; m < 4; ++m) _Pragma("unroll") for (int n = 0; n < 2; ++n) _Pragma("unroll") for (int k = 0; k < 2; ++k) \
        acc[ai][bj][m][n] = __builtin_amdgcn_mfma_f32_16x16x32_bf16(Bt[n][k], At[m][k], acc[ai][bj][m][n], 0, 0, 0); __builtin_amdgcn_s_setprio(0); } while (0)
#define PG8_WAIT_V(n) asm volatile("s_waitcnt vmcnt(" #n ")" ::: "memory")
#define PG8_WAIT_L(n) asm volatile("s_waitcnt lgkmcnt(" #n ")" ::: "memory")
#define PG8_BAR __builtin_amdgcn_s_barrier()
#define PG8_SCHED __builtin_amdgcn_sched_barrier(0)
    Unit cur, nxt; int ui = 0;
    if (!S.next(0, cur)) return;
    f32x4 acc[2][2][4][2];
#pragma unroll
    for (int a = 0; a < 2; ++a)
#pragma unroll
        for (int b = 0; b < 2; ++b)
#pragma unroll
            for (int m = 0; m < 4; ++m)
#pragma unroll
                for (int n = 0; n < 2; ++n) acc[a][b][m][n] = (f32x4){0.f, 0.f, 0.f, 0.f};
    bf16x8 At[4][2], B0[2][2], B1[2][2];
    const char* cA = (const char*)g.A + (size_t)cur.pm * tstep; const char* cB = (const char*)g.Bt + (size_t)cur.pn * tstep;
    S.a_ready(cur);
    if constexpr (SP2) {
        PG8_STAGE(PG8_SB(0, 0), cB, voffB); PG8_STAGE(PG8_SB(0, 1), cB + hstep, voffB); PG8_STAGE(PG8_SA(0, 0), cA, voffA); PG8_STAGE(PG8_SA(0, 1), cA + hstep, voffA);
        if (wr == 1) PG8_BAR;
        PG8_WAIT_V(2); PG8_BAR;
        PG8_STAGE(PG8_SB(1, 0), cB + kstep, voffB); PG8_STAGE(PG8_SA(1, 0), cA + kstep, voffA); PG8_STAGE(PG8_SB(1, 1), cB + hstep + kstep, voffB);
        PG8_WAIT_V(6); PG8_BAR;
    } else {
        PG8_STAGE(PG8_SB(0, 0), cB, voffB); PG8_STAGE(PG8_SA(0, 0), cA, voffA); PG8_STAGE(PG8_SB(0, 1), cB + hstep, voffB); PG8_STAGE(PG8_SA(0, 1), cA + hstep, voffA);
        if (wr == 1) PG8_BAR;
        PG8_WAIT_V(4); PG8_BAR;
        PG8_STAGE(PG8_SB(1, 0), cB + kstep, voffB); PG8_STAGE(PG8_SA(1, 0), cA + kstep, voffA); PG8_STAGE(PG8_SB(1, 1), cB + hstep + kstep, voffB);
        PG8_WAIT_V(6); PG8_BAR;
    }
    for (;;) {
        const bool has_next = S.next(ui + 1, nxt);
        const char* nA = has_next ? (const char*)g.A + (size_t)nxt.pm * tstep : cA; const char* nB = has_next ? (const char*)g.Bt + (size_t)nxt.pn * tstep : cB;
#pragma unroll 1
        for (int t = 0; t < nt; t += 2) {
            const bool last = (t == nt - 2);
            const char* a1 = cA + (size_t)(t + 1) * kstep;
            const char* a2 = last ? nA : cA + (size_t)(t + 2) * kstep; const char* b2 = last ? nB : cB + (size_t)(t + 2) * kstep;
            const char* a3 = a2 + kstep; const char* b3 = b2 + kstep;
            if (last && has_next) S.a_ready(nxt);
            if constexpr (SP2) {
            PG8_LDB(B0, 0, 0); PG8_LDB(B1, 0, 1); PG8_SCHED; PG8_LDA(At, 0, 0); PG8_STAGE(PG8_SA(1, 1), a1 + hstep, voffA);
            PG8_WAIT_V(8); PG8_WAIT_L(0); PG8_BAR; PG8_MMA(0, 0, At, B0); PG8_MMA(0, 1, At, B1); PG8_BAR; PG8_SCHED;
            PG8_LDA(At, 0, 1); PG8_STAGE(PG8_SB(0, 0), b2, voffB); PG8_STAGE(PG8_SB(0, 1), b2 + hstep, voffB); PG8_STAGE(PG8_SA(0, 0), a2, voffA);
            PG8_WAIT_V(8); PG8_WAIT_L(0); PG8_BAR; PG8_MMA(1, 0, At, B0); PG8_MMA(1, 1, At, B1); PG8_BAR; PG8_SCHED;
            PG8_LDB(B0, 1, 0); PG8_LDB(B1, 1, 1); PG8_SCHED; PG8_LDA(At, 1, 0); PG8_STAGE(PG8_SA(0, 1), a2 + hstep, voffA);
            PG8_WAIT_V(8); PG8_WAIT_L(0); PG8_BAR; PG8_MMA(0, 0, At, B0); PG8_MMA(0, 1, At, B1); PG8_BAR; PG8_SCHED;
            PG8_LDA(At, 1, 1); PG8_STAGE(PG8_SB(1, 0), b3, voffB); PG8_STAGE(PG8_SB(1, 1), b3 + hstep, voffB); PG8_STAGE(PG8_SA(1, 0), a3, voffA);
            PG8_WAIT_V(8); PG8_WAIT_L(0); PG8_BAR; PG8_MMA(1, 0, At, B0); PG8_MMA(1, 1, At, B1); PG8_BAR; PG8_SCHED;
            } else {
            PG8_LDB(B0, 0, 0); PG8_SCHED; PG8_LDA(At, 0, 0); PG8_STAGE(PG8_SA(1, 1), a1 + hstep, voffA);
            PG8_WAIT_L(8); PG8_BAR; PG8_WAIT_L(0); PG8_MMA(0, 0, At, B0); PG8_BAR; PG8_SCHED;
            PG8_LDB(B1, 0, 1); PG8_STAGE(PG8_SB(0, 0), b2, voffB);
            PG8_BAR; PG8_WAIT_L(0); PG8_MMA(0, 1, At, B1); PG8_BAR;
            PG8_LDA(At, 0, 1); PG8_STAGE(PG8_SA(0, 0), a2, voffA);
            PG8_BAR; PG8_WAIT_L(0); PG8_MMA(1, 0, At, B0); PG8_BAR; PG8_SCHED;
            PG8_STAGE(PG8_SB(0, 1), b2 + hstep, voffB);
            PG8_WAIT_V(6); PG8_BAR; PG8_MMA(1, 1, At, B1); PG8_BAR;
            PG8_LDB(B0, 1, 0); PG8_SCHED; PG8_LDA(At, 1, 0); PG8_STAGE(PG8_SA(0, 1), a2 + hstep, voffA);
            PG8_WAIT_L(8); PG8_BAR; PG8_WAIT_L(0); PG8_MMA(0, 0, At, B0); PG8_BAR; PG8_SCHED;
            PG8_LDB(B1, 1, 1); PG8_STAGE(PG8_SB(1, 0), b3, voffB);
            PG8_BAR; PG8_WAIT_L(0); PG8_MMA(0, 1, At, B1); PG8_BAR;
            PG8_LDA(At, 1, 1); PG8_STAGE(PG8_SA(1, 0), a3, voffA);
            PG8_BAR; PG8_WAIT_L(0); PG8_MMA(1, 0, At, B0); PG8_BAR; PG8_SCHED;
            PG8_STAGE(PG8_SB(1, 1), b3 + hstep, voffB);
            PG8_WAIT_V(6); PG8_BAR; PG8_MMA(1, 1, At, B1); PG8_BAR;
            }
        }
        if constexpr (ALIGN_EPI) { if (wr == 0) PG8_BAR; }
        if constexpr (!Epi::AFTER_DRAIN) { E(acc, cur, wr, wc, fr, fq); S.done(cur); }
        if (!has_next) break;
#pragma unroll
        for (int a = 0; a < 2; ++a)
#pragma unroll
            for (int b = 0; b < 2; ++b)
#pragma unroll
                for (int m = 0; m < 4; ++m)
#pragma unroll
                    for (int n = 0; n < 2; ++n) acc[a][b][m][n] = (f32x4){0.f, 0.f, 0.f, 0.f};
        cur = nxt; cA = nA; cB = nB; ++ui;
        if constexpr (ALIGN_EPI) { if (wr == 1) PG8_BAR; }
    }
    PG8_WAIT_V(0);
    if constexpr (!ALIGN_EPI) { if (wr == 0) PG8_BAR; }
    PG8_BAR;
    if constexpr (Epi::AFTER_DRAIN) { E.fused(acc, cur, wr, wc, fr, fq, lds, wid, lane); S.done(cur); }
#undef PG8_SA
#undef PG8_SB
#undef PG8_STAGE
#undef PG8_LDA
#undef PG8_LDB
#undef PG8_MMA
#undef PG8_WAIT_V
#undef PG8_WAIT_L
#undef PG8_BAR
#undef PG8_SCHED
}
}

constexpr bool PG_ALIGN = true, PG_SP2 = true;
__device__ __forceinline__ float bflo(unsigned w) { return __builtin_bit_cast(float, w << 16); }
__device__ __forceinline__ float bfhi(unsigned w) { return __builtin_bit_cast(float, w & 0xffff0000u); }
__device__ __forceinline__ unsigned cvtpk(float lo, float hi) { return pg8::cvt_pk_bf16(lo, hi); }

__device__ __forceinline__ void transpose_item(const float* W, int N, int k0, int n0, bf16* WT, int K, size_t dst_row0, LAS float* scr, int lane) {
#pragma unroll 8
    for (int i = 0; i < 32; ++i) { const int kk = 2 * i + (lane >> 5); scr[kk * 33 + (lane & 31)] = W[(size_t)(k0 + kk) * N + n0 + (lane & 31)]; }
    asm volatile("s_waitcnt lgkmcnt(0)" ::: "memory");
    const int c = lane & 7;
#pragma unroll
    for (int j = 0; j < 4; ++j) { const int n = (lane >> 3) + 8 * j; const LAS float* s = scr + (8 * c) * 33 + n;
        v4u o; o.x = pk2(s[0 * 33], s[1 * 33]); o.y = pk2(s[2 * 33], s[3 * 33]); o.z = pk2(s[4 * 33], s[5 * 33]); o.w = pk2(s[6 * 33], s[7 * 33]);
        *(v4u*)(WT + (dst_row0 + n) * K + k0 + 8 * c) = o; }
    asm volatile("s_waitcnt lgkmcnt(0)" ::: "memory");
}
__device__ __forceinline__ void convert_weights(Frame& F, int l) {
    LAS float* scr = (LAS float*)(F.lds + F.wave * 16384);
    const int gw = F.bid * (NT / 64) + F.wave, ngw = F.G * (NT / 64);
    constexpr int I_IN = 16 * 96, I_MG = 16 * 96, I_GLU = 8 * 16, I_BR = 3 * 8 * 32, I_O = 16 * 32, I_1 = 32 * 16 * 8, I_3 = I_1, I_2 = 32 * 4 * 32;
    constexpr int NITEMS = I_IN + I_MG + I_GLU + I_BR + I_O + I_1 + I_3 + I_2;
    for (int it = gw; it < NITEMS; it += ngw) {
        int r = it;
        if (r < I_IN) { const int kb = r / 96, nb = r % 96; transpose_item(IN_(I_WIN) + (size_t)l * D * INW, INW, 64 * kb, 32 * nb, (bf16*)(F.ws + WS_WIN), 1024, 32 * nb, scr, F.lane); continue; } r -= I_IN;
        if (r < I_MG) { const int kb = r / 96, nb = r % 96; transpose_item(IN_(I_WMG) + (size_t)l * D * INW, INW, 64 * kb, 32 * nb, (bf16*)(F.ws + WS_WMG), 1024, 32 * nb, scr, F.lane); continue; } r -= I_MG;
        if (r < I_GLU) { const int kb = r / 16, nb = r % 16; transpose_item(IN_(I_WGLU) + (size_t)l * MIXW * MIXW, MIXW, 64 * kb, 32 * nb, (bf16*)(F.ws + WS_WGLU), 512, 32 * nb, scr, F.lane); continue; } r -= I_GLU;
        if (r < I_BR) { const int kk = r / 256, q = r % 256, kb = q / 32, nb = q % 32; transpose_item(IN_(I_WBR) + ((size_t)l * 3 + kk) * MIXW * D, D, 64 * kb, 32 * nb, (bf16*)(F.ws + WS_WBR), 512, (size_t)kk * 1024 + 32 * nb, scr, F.lane); continue; } r -= I_BR;
        if (r < I_O) { const int kb = r / 32, nb = r % 32; transpose_item(IN_(I_WO) + (size_t)l * D * D, D, 64 * kb, 32 * nb, (bf16*)(F.ws + WS_WO), 1024, 32 * nb, scr, F.lane); continue; } r -= I_O;
        if (r < I_1 + I_3) { const int which = r / I_1, q = r % I_1, e = q / 128, q2 = q % 128, kb = q2 / 8, nb = q2 % 8;
            const float* W = IN_(which ? I_W3 : I_W1) + ((size_t)l * NE + e) * D * DFF; const int n0 = 32 * nb;
            transpose_item(W, DFF, 64 * kb, n0, (bf16*)(F.ws + WS_W13), 1024, (size_t)e * 512 + (n0 / 128) * 256 + which * 128 + (n0 % 128), scr, F.lane); continue; } r -= I_1 + I_3;
        { const int e = r / 128, q = r % 128, kb = q / 32, nb = q % 32; transpose_item(IN_(I_W2) + ((size_t)l * NE + e) * DFF * D, D, 64 * kb, 32 * nb, (bf16*)(F.ws + WS_W2), 256, (size_t)e * 1024 + 32 * nb, scr, F.lane); }
    }
    { const float* s = IN_(I_WSG) + (size_t)l * 4 * 128 * 128; bf16* d = (bf16*)(F.ws + WS_WSG);
      for (int i = (F.bid * NT + F.tid) * 2; i < 4 * 128 * 128; i += F.G * NT * 2) *(unsigned*)(d + i) = pk2(s[i], s[i + 1]); }
}

struct EpiProj { static constexpr bool PERM = true, AFTER_DRAIN = false; bf16* O;
    __device__ __forceinline__ void operator()(const pg8::f32x4 (&acc)[2][2][4][2], const pg8::Unit& u, int wr, int wc, int fr, int fq) const {
        const int row0 = u.pm * 256 + wr * 64 + fr, col0 = u.pn * 256 + wc * 32 + 8 * fq; const bool act = (u.pn >= 2 && u.pn < 6);
#pragma unroll
        for (int ai = 0; ai < 2; ++ai)
#pragma unroll
            for (int m = 0; m < 4; ++m) { bf16* rowp = O + (size_t)(row0 + ai * 128 + m * 16) * INW + col0;
#pragma unroll
                for (int bj = 0; bj < 2; ++bj) { pg8::f32x4 v0 = acc[ai][bj][m][0], v1 = acc[ai][bj][m][1];
                    if (act) {
#pragma unroll
                        for (int j = 0; j < 4; ++j) { v0[j] = geluf_(v0[j]); v1[j] = geluf_(v1[j]); } }
                    v4u w; w.x = cvtpk(v0[0], v0[1]); w.y = cvtpk(v0[2], v0[3]); w.z = cvtpk(v1[0], v1[1]); w.w = cvtpk(v1[2], v1[3]); *(v4u*)(rowp + bj * 128) = w; } }
    } };
struct EpiGlu { static constexpr bool PERM = true, AFTER_DRAIN = false; const bf16* YG; bf16* YA;
    __device__ __forceinline__ void operator()(const pg8::f32x4 (&acc)[2][2][4][2], const pg8::Unit& u, int wr, int wc, int fr, int fq) const {
        const int row0 = u.pm * 256 + wr * 64 + fr, col0 = u.pn * 256 + wc * 32 + 8 * fq;
#pragma unroll
        for (int ai = 0; ai < 2; ++ai)
#pragma unroll
            for (int m = 0; m < 4; ++m) { const size_t off = (size_t)(row0 + ai * 128 + m * 16) * MIXW + col0;
#pragma unroll
                for (int bj = 0; bj < 2; ++bj) { const pg8::f32x4 v0 = acc[ai][bj][m][0], v1 = acc[ai][bj][m][1]; const v4u g = *(const v4u*)(YG + off + bj * 128);
                    v4u w; w.x = cvtpk(bflo(g.x) * sigmoidf_(v0[0]), bfhi(g.x) * sigmoidf_(v0[1])); w.y = cvtpk(bflo(g.y) * sigmoidf_(v0[2]), bfhi(g.y) * sigmoidf_(v0[3]));
                    w.z = cvtpk(bflo(g.z) * sigmoidf_(v1[0]), bfhi(g.z) * sigmoidf_(v1[1])); w.w = cvtpk(bflo(g.w) * sigmoidf_(v1[2]), bfhi(g.w) * sigmoidf_(v1[3])); *(v4u*)(YA + off + bj * 128) = w; } }
    } };
struct EpiBr { static constexpr bool PERM = true, AFTER_DRAIN = false; bf16* BR;
    __device__ __forceinline__ void operator()(const pg8::f32x4 (&acc)[2][2][4][2], const pg8::Unit& u, int wr, int wc, int fr, int fq) const {
        const int pm = u.pm % (MT / 256); const int row0 = pm * 256 + wr * 64 + fr, col0 = u.pn * 256 + wc * 32 + 8 * fq;
#pragma unroll
        for (int ai = 0; ai < 2; ++ai)
#pragma unroll
            for (int m = 0; m < 4; ++m) { bf16* rowp = BR + (size_t)(row0 + ai * 128 + m * 16) * INW + col0;
#pragma unroll
                for (int bj = 0; bj < 2; ++bj) { const pg8::f32x4 v0 = acc[ai][bj][m][0], v1 = acc[ai][bj][m][1];
                    v4u w; w.x = cvtpk(v0[0], v0[1]); w.y = cvtpk(v0[2], v0[3]); w.z = cvtpk(v1[0], v1[1]); w.w = cvtpk(v1[2], v1[3]); *(v4u*)(rowp + bj * 128) = w; } }
    } };
struct SchedBr { int G, c;
    __device__ __forceinline__ bool next(int i, pg8::Unit& u) const { const int Lq = i * G + c; if (Lq >= 3 * (MT / 256) * 4) return false; const int k = Lq / ((MT / 256) * 4), r = Lq % ((MT / 256) * 4);
        u.pm = k * (MT / 256) + r / 4; u.pn = k * 4 + r % 4; return true; }
    __device__ __forceinline__ void a_ready(const pg8::Unit&) const {}
    __device__ __forceinline__ void done(const pg8::Unit&) const {} };
struct EpiMerge { static constexpr bool PERM = true, AFTER_DRAIN = false; const bf16* BR; bf16* PM; const float* bm;
    __device__ __forceinline__ void operator()(const pg8::f32x4 (&acc)[2][2][4][2], const pg8::Unit& u, int wr, int wc, int fr, int fq) const {
        const int k = u.pn >> 2, dt = u.pn & 3; const int row0 = u.pm * 256 + wr * 64 + fr, col0 = dt * 256 + wc * 32 + 8 * fq;
#pragma unroll
        for (int bj = 0; bj < 2; ++bj) { const pg8::f32x4 b0 = *(const pg8::f32x4*)(bm + k * 1024 + col0 + bj * 128), b1 = *(const pg8::f32x4*)(bm + k * 1024 + col0 + bj * 128 + 4);
#pragma unroll
            for (int ai = 0; ai < 2; ++ai)
#pragma unroll
                for (int m = 0; m < 4; ++m) { const size_t r = (size_t)(row0 + ai * 128 + m * 16); const v4u br = *(const v4u*)(BR + r * INW + k * 1024 + col0 + bj * 128);
                    const pg8::f32x4 v0 = acc[ai][bj][m][0] + b0, v1 = acc[ai][bj][m][1] + b1;
                    float p[8] = {sigmoidf_(v0[0]) * bflo(br.x), sigmoidf_(v0[1]) * bfhi(br.x), sigmoidf_(v0[2]) * bflo(br.y), sigmoidf_(v0[3]) * bfhi(br.y),
                                  sigmoidf_(v1[0]) * bflo(br.z), sigmoidf_(v1[1]) * bfhi(br.z), sigmoidf_(v1[2]) * bflo(br.w), sigmoidf_(v1[3]) * bfhi(br.w)};
                    bf16* dst = PM + r * D + col0 + bj * 128;
                    if (k > 0) { const v4u o = *(const v4u*)dst; p[0] += bflo(o.x); p[1] += bfhi(o.x); p[2] += bflo(o.y); p[3] += bfhi(o.y); p[4] += bflo(o.z); p[5] += bfhi(o.z); p[6] += bflo(o.w); p[7] += bfhi(o.w); }
                    v4u w; w.x = cvtpk(p[0], p[1]); w.y = cvtpk(p[2], p[3]); w.z = cvtpk(p[4], p[5]); w.w = cvtpk(p[6], p[7]); *(v4u*)dst = w; } }
    } };
struct SchedMerge { int G, c;
    __device__ __forceinline__ bool next(int i, pg8::Unit& u) const { const int v = (i / 3) * G + c, k = i % 3; if (v >= (MT / 256) * 4) return false; u.pm = v >> 2; u.pn = k * 4 + (v & 3); return true; }
    __device__ __forceinline__ void a_ready(const pg8::Unit&) const {}
    __device__ __forceinline__ void done(const pg8::Unit&) const {} };
struct EpiWo { static constexpr bool PERM = false, AFTER_DRAIN = false; const float* xs_lat; const float* xs_ctx; float* out; float* xc; const float* mod_l;
    __device__ __forceinline__ void operator()(const pg8::f32x4 (&acc)[2][2][4][2], const pg8::Unit& u, int wr, int wc, int fr, int fq) const {
        const int row0 = u.pm * 256 + wr * 64 + fr, col0 = u.pn * 256 + wc * 32 + 4 * fq; const bool isctx = u.pm >= SEQ / 256;
        const float* ga = mod_l + (isctx ? 6144 : 0) + 2048;
#pragma unroll
        for (int ai = 0; ai < 2; ++ai)
#pragma unroll
            for (int m = 0; m < 4; ++m) { const int row = row0 + ai * 128 + m * 16; const size_t off = (size_t)(isctx ? row - SEQ : row) * D + col0;
                const float* src = (isctx ? xs_ctx : xs_lat) + off; float* dst = (isctx ? xc : out) + off;
#pragma unroll
                for (int bj = 0; bj < 2; ++bj)
#pragma unroll
                    for (int n = 0; n < 2; ++n) { const pg8::f32x4 g = *(const pg8::f32x4*)(ga + col0 + bj * 128 + n * 16); const pg8::f32x4 x = *(const pg8::f32x4*)(src + bj * 128 + n * 16);
                        *(pg8::f32x4*)(dst + bj * 128 + n * 16) = x + g * acc[ai][bj][m][n]; } }
    } };
constexpr int MOETAB_OFF = 131072 + 2048;
template <int NPN> __device__ __forceinline__ int moe_build_table(Frame& F, const unsigned* cnt) {
    LAS unsigned* tabw = (LAS unsigned*)(F.lds + MOETAB_OFF);
    int total = 0, rowtile0 = 0;
    for (int e = 0; e < NE; ++e) { const int nt_e = ((int)cnt[e] + 255) >> 8;
        for (int q = F.tid; q < nt_e * NPN; q += NT) tabw[total + q] = ((unsigned)(rowtile0 + q / NPN) << 16) | (unsigned)(e * NPN + q % NPN);
        total += nt_e * NPN; rowtile0 += nt_e; }
    __syncthreads();
    return total;
}
struct SchedMoe { int G, c, total; const LAS unsigned* tabw;
    __device__ __forceinline__ bool next(int i, pg8::Unit& u) const { const int Lq = i * G + c; if (Lq >= total) return false; const unsigned w = (unsigned)__builtin_amdgcn_readfirstlane((int)tabw[Lq]); u.pm = (int)(w >> 16); u.pn = (int)(w & 0xffffu); return true; }
    __device__ __forceinline__ void a_ready(const pg8::Unit&) const {}
    __device__ __forceinline__ void done(const pg8::Unit&) const {} };
struct EpiUp { static constexpr bool PERM = true, AFTER_DRAIN = false; bf16* ACT; const float* SW;
    __device__ __forceinline__ void operator()(const pg8::f32x4 (&acc)[2][2][4][2], const pg8::Unit& u, int wr, int wc, int fr, int fq) const {
        const int row0 = u.pm * 256 + wr * 64 + fr, f0 = (u.pn & 1) * 128 + wc * 32 + 8 * fq;
#pragma unroll
        for (int ai = 0; ai < 2; ++ai)
#pragma unroll
            for (int m = 0; m < 4; ++m) { const int slot = row0 + ai * 128 + m * 16; const float w = SW[slot];
                const pg8::f32x4 a0 = acc[ai][0][m][0], a1 = acc[ai][0][m][1], b0 = acc[ai][1][m][0], b1 = acc[ai][1][m][1];
                v4u o; o.x = cvtpk(siluf_(a0[0]) * b0[0] * w, siluf_(a0[1]) * b0[1] * w); o.y = cvtpk(siluf_(a0[2]) * b0[2] * w, siluf_(a0[3]) * b0[3] * w);
                o.z = cvtpk(siluf_(a1[0]) * b1[0] * w, siluf_(a1[1]) * b1[1] * w); o.w = cvtpk(siluf_(a1[2]) * b1[2] * w, siluf_(a1[3]) * b1[3] * w);
                *(v4u*)(ACT + (size_t)slot * DFF + f0) = o; }
    } };
struct EpiDown { static constexpr bool PERM = true, AFTER_DRAIN = false; bf16* YS2;
    __device__ __forceinline__ void operator()(const pg8::f32x4 (&acc)[2][2][4][2], const pg8::Unit& u, int wr, int wc, int fr, int fq) const {
        const int row0 = u.pm * 256 + wr * 64 + fr, col0 = (u.pn & 3) * 256 + wc * 32 + 8 * fq;
#pragma unroll
        for (int ai = 0; ai < 2; ++ai)
#pragma unroll
            for (int m = 0; m < 4; ++m) { bf16* rowp = YS2 + (size_t)(row0 + ai * 128 + m * 16) * D + col0;
#pragma unroll
                for (int bj = 0; bj < 2; ++bj) { const pg8::f32x4 v0 = acc[ai][bj][m][0], v1 = acc[ai][bj][m][1];
                    v4u w; w.x = cvtpk(v0[0], v0[1]); w.y = cvtpk(v0[2], v0[3]); w.z = cvtpk(v1[0], v1[1]); w.w = cvtpk(v1[2], v1[3]); *(v4u*)(rowp + bj * 128) = w; } }
    } };

__device__ __forceinline__ void ph2_fast(Frame& F, int l) {
    pg8::Gemm g{(const bf16*)(F.ws + WS_H), (const bf16*)(F.ws + WS_WIN), MT, INW, D}; pg8::StaticOrder S; S.init(MT, INW, F.G, F.bid);
    EpiProj E{(bf16*)(F.ws + WS_PROJ)}; pg8::gemm_phase<EpiProj, pg8::StaticOrder, PG_ALIGN, PG_SP2>(F.lds, g, S, E);
}
__device__ __forceinline__ void ph6_fast(Frame& F, int l) {
    pg8::Gemm g{(const bf16*)(F.ws + WS_YG), (const bf16*)(F.ws + WS_WGLU), MT, MIXW, MIXW}; pg8::StaticOrder S; S.init(MT, MIXW, F.G, F.bid);
    EpiGlu E{(const bf16*)(F.ws + WS_YG), (bf16*)(F.ws + WS_YS)}; pg8::gemm_phase<EpiGlu, pg8::StaticOrder, PG_ALIGN, PG_SP2>(F.lds, g, S, E);
}
__device__ __forceinline__ void ph7_fast(Frame& F, int l) {
    pg8::Gemm g{(const bf16*)(F.ws + WS_YS), (const bf16*)(F.ws + WS_WBR), 3 * MT, 3 * D, MIXW}; SchedBr S{F.G, F.bid};
    EpiBr E{(bf16*)(F.ws + WS_PROJ)}; pg8::gemm_phase<EpiBr, SchedBr, PG_ALIGN, PG_SP2>(F.lds, g, S, E);
}
__device__ __forceinline__ void ph8_fast(Frame& F, int l) {
    pg8::Gemm g{(const bf16*)(F.ws + WS_H), (const bf16*)(F.ws + WS_WMG), MT, INW, D}; SchedMerge S{F.G, F.bid};
    EpiMerge E{(const bf16*)(F.ws + WS_PROJ), (bf16*)(F.ws + WS_PM), IN_(I_BMG) + l * INW}; pg8::gemm_phase<EpiMerge, SchedMerge, PG_ALIGN, PG_SP2>(F.lds, g, S, E);
}
__device__ __forceinline__ void ph9_fast(Frame& F, int l) {
    pg8::Gemm g{(const bf16*)(F.ws + WS_PM), (const bf16*)(F.ws + WS_WO), MT, D, D}; pg8::StaticOrder S; S.init(MT, D, F.G, F.bid);
    EpiWo E{l == 0 ? IN_(I_X) : F.out, l == 0 ? IN_(I_CTX) : (const float*)(F.ws + WS_XC), F.out, (float*)(F.ws + WS_XC), (const float*)(F.ws + WS_MOD) + (size_t)l * 2 * 6144};
    pg8::gemm_phase<EpiWo, pg8::StaticOrder, PG_ALIGN, PG_SP2>(F.lds, g, S, E);
}
__device__ __forceinline__ void ph12_fast(Frame& F, int l) {
    pg8::Gemm g{(const bf16*)(F.ws + WS_HS), (const bf16*)(F.ws + WS_W13), MAXSLOT, NE * 512, D}; const int total = moe_build_table<2>(F, F.ctl + CW_CNT + l * 128); SchedMoe S{F.G, F.bid, total, (const LAS unsigned*)(F.lds + MOETAB_OFF)};
    EpiUp E{(bf16*)(F.ws + WS_ACT), (const float*)(F.ws + WS_SW)}; pg8::gemm_phase<EpiUp, SchedMoe, PG_ALIGN, PG_SP2>(F.lds, g, S, E);
}
__device__ __forceinline__ void ph13_fast(Frame& F, int l) {
    pg8::Gemm g{(const bf16*)(F.ws + WS_ACT), (const bf16*)(F.ws + WS_W2), MAXSLOT, NE * D, DFF}; const int total = moe_build_table<4>(F, F.ctl + CW_CNT + l * 128); SchedMoe S{F.G, F.bid, total, (const LAS unsigned*)(F.lds + MOETAB_OFF)};
    EpiDown E{(bf16*)(F.ws + WS_YS2)}; pg8::gemm_phase<EpiDown, SchedMoe, PG_ALIGN, PG_SP2>(F.lds, g, S, E);
}


typedef short bf16x8 __attribute__((ext_vector_type(8)));
constexpr int NSB = MT / 16;
__device__ __forceinline__ void s5_precompute(Frame& F) {
    LAS float* APr = (LAS float*)F.lds; LAS float* APi = APr + 2176; LAS float* BBr = APi + 2176; LAS float* BBi = BBr + 2048; LAS float* CCr = BBi + 2048; LAS float* CCi = CCr + 2048; LAS float* KK = CCi + 2048;
    for (int item = F.bid; item < 2 * G5; item += F.G) { const int l = item >> 5, g = item & 31;
        __syncthreads();
        if (F.tid < 128) { const int d = F.tid >> 6, p = F.tid & 63; const int ldg = (l * 2 + d) * G5 + g;
            const double lr = IN_(I_LRE)[ldg * P5 + p], li = IN_(I_LIM)[ldg * P5 + p], dt = exp((double)IN_(I_LDT)[ldg]);
            for (int e = 0; e <= 16; ++e) { const double m = exp(lr * dt * e), ang = li * dt * e; APr[(d * 64 + p) * 17 + e] = (float)(m * cos(ang)); APi[(d * 64 + p) * 17 + e] = (float)(m * sin(ang)); }
            { const double m16 = exp(lr * dt * 16.0), a16 = li * dt * 16.0; float* A16 = (float*)(F.ws + WS_A16) + ((size_t)((l * 32 + g) * 2 + d) * 64 + p) * 2; A16[0] = (float)(m16 * cos(a16)); A16[1] = (float)(m16 * sin(a16)); }
            const double m1 = exp(lr * dt), ar = m1 * cos(li * dt), ai = m1 * sin(li * dt); const double nr = ar - 1.0, ni = ai, den = lr * lr + li * li;
            const double qr = (nr * lr + ni * li) / den, qi = (ni * lr - nr * li) / den;
            for (int h = 0; h < 16; ++h) { const double x = IN_(I_BRE)[((size_t)ldg * P5 + p) * H5 + h], y = IN_(I_BIM)[((size_t)ldg * P5 + p) * H5 + h];
                BBr[(d * 64 + p) * 16 + h] = (float)(qr * x - qi * y); BBi[(d * 64 + p) * 16 + h] = (float)(qr * y + qi * x);
                CCr[(d * 16 + h) * 64 + p] = IN_(I_CRE)[((size_t)ldg * H5 + h) * P5 + p]; CCi[(d * 16 + h) * 64 + p] = IN_(I_CIM)[((size_t)ldg * H5 + h) * P5 + p]; } }
        __syncthreads();
        for (int idx = F.tid; idx < 8192; idx += NT) { const int d = idx >> 12, e = (idx >> 8) & 15, h = (idx >> 4) & 15, hp = idx & 15; float a = 0.f;
            for (int p = 0; p < 64; ++p) { const float pr = APr[(d * 64 + p) * 17 + e], pi = APi[(d * 64 + p) * 17 + e], br = BBr[(d * 64 + p) * 16 + hp], bi = BBi[(d * 64 + p) * 16 + hp];
                const float wr = pr * br - pi * bi, wi = pr * bi + pi * br; a += CCr[(d * 16 + h) * 64 + p] * wr - CCi[(d * 16 + h) * 64 + p] * wi; }
            KK[idx] = a; }
        __syncthreads();
        bf16* M = (bf16*)(F.ws + WS_S5M) + (size_t)(l * 32 + g) * 3 * 65536;
        for (int idx = F.tid; idx < 32768; idx += NT) {
            const int r = idx >> 7, k0 = (idx & 127) * 2; float v[3][2];
#pragma unroll
            for (int q = 0; q < 2; ++q) { const int kk = k0 + q;
                { const int d = r >> 7, p = (r >> 1) & 63, c = r & 1, sg = kk >> 4, hp = kk & 15, e = d == 0 ? 15 - sg : sg;
                  const float pr = APr[(d * 64 + p) * 17 + e], pi = APi[(d * 64 + p) * 17 + e], br = BBr[(d * 64 + p) * 16 + hp], bi = BBi[(d * 64 + p) * 16 + hp];
                  v[0][q] = c == 0 ? pr * br - pi * bi : pr * bi + pi * br; }
                { const int tau = r >> 4, h = r & 15, sg = kk >> 4, hp = kk & 15; float t = 0.f;
                  if (sg <= tau) t += KK[(0 * 16 + (tau - sg)) * 256 + h * 16 + hp]; if (sg >= tau) t += KK[(1 * 16 + (sg - tau)) * 256 + h * 16 + hp]; v[1][q] = t; }
                { const int tau = r >> 4, h = r & 15, d = kk >> 7, p = (kk >> 1) & 63, c = kk & 1, e = d == 0 ? tau + 1 : 16 - tau;
                  const float cr = CCr[(d * 16 + h) * 64 + p], ci = CCi[(d * 16 + h) * 64 + p], pr = APr[(d * 64 + p) * 17 + e], pi = APi[(d * 64 + p) * 17 + e];
                  v[2][q] = c == 0 ? cr * pr - ci * pi : -(cr * pi + ci * pr); } }
#pragma unroll
            for (int m = 0; m < 3; ++m) *(unsigned*)(M + (size_t)m * 65536 + r * 256 + k0) = pk2(v[m][0], v[m][1]);
        }
    }
}
__device__ __forceinline__ void s5_z_phase(Frame& F, int l) {
    const bf16* PROJ = (const bf16*)(F.ws + WS_PROJ); float* Z = (float*)(F.ws + WS_Z);
    const int l15 = F.lane & 15, lq = F.lane >> 4;
    for (int item = F.bid; item < 256; item += F.G) {
        const int g = item >> 3, part = item & 7; const bf16* Fm = (const bf16*)(F.ws + WS_S5M) + (size_t)(l * 32 + g) * 3 * 65536;
        bf16x8 Af[2][8];
#pragma unroll
        for (int j = 0; j < 2; ++j)
#pragma unroll
            for (int ks = 0; ks < 8; ++ks) Af[j][ks] = *(const bf16x8*)(Fm + (size_t)(16 * (2 * F.wave + j) + l15) * 256 + 32 * ks + 8 * lq);
#pragma unroll 1
        for (int tl = part; tl < MT / 256; tl += 8) {
            bf16x8 V[8];
#pragma unroll
            for (int ks = 0; ks < 8; ++ks) V[ks] = *(const bf16x8*)(PROJ + (size_t)(tl * 256 + 16 * l15 + 2 * ks + (lq >> 1)) * INW + 16 * g + 8 * (lq & 1));
            f32x4 acc[2] = {{0.f, 0.f, 0.f, 0.f}, {0.f, 0.f, 0.f, 0.f}};
#pragma unroll
            for (int ks = 0; ks < 8; ++ks)
#pragma unroll
                for (int j = 0; j < 2; ++j) acc[j] = __builtin_amdgcn_mfma_f32_16x16x32_bf16(Af[j][ks], V[ks], acc[j], 0, 0, 0);
#pragma unroll
            for (int j = 0; j < 2; ++j) *(f32x4*)(Z + ((size_t)(tl * 16 + l15) * 32 + g) * 256 + 16 * (2 * F.wave + j) + 4 * lq) = acc[j];
        }
    }
}
__device__ __forceinline__ int s5_chain_sb(int d, int i) { return d == 0 ? (i < 16 ? 1024 + i : i - 16) : (i < 16 ? 1039 - i : 1023 - (i - 16)); }
__device__ __forceinline__ void s5_scan_phase(Frame& F, int l) {
    const int cid = F.bid * NT + F.tid; if (cid >= 4096) return;
    const int g = cid >> 7, d = (cid >> 6) & 1, p = cid & 63;
    const float* A16 = (const float*)(F.ws + WS_A16) + ((size_t)((l * 32 + g) * 2 + d) * 64 + p) * 2; const float ar = A16[0], ai = A16[1];
    const float* Z = (const float*)(F.ws + WS_Z) + (size_t)g * 256 + d * 128 + 2 * p; bf16* SS = (bf16*)(F.ws + WS_SS) + (size_t)g * 256 + d * 128 + 2 * p;
    float hr = 0.f, hi = 0.f;
#pragma unroll 1
    for (int i0 = 0; i0 < NSB; i0 += 8) {
        float2 z[8];
#pragma unroll
        for (int q = 0; q < 8; ++q) z[q] = *(const float2*)(Z + (size_t)s5_chain_sb(d, i0 + q) * 8192);
#pragma unroll
        for (int q = 0; q < 8; ++q) { *(unsigned*)(SS + (size_t)s5_chain_sb(d, i0 + q) * 8192) = pk2(hr, hi);
            const float nr = ar * hr - ai * hi + z[q].x, ni = ar * hi + ai * hr + z[q].y; hr = nr; hi = ni; }
    }
}
__device__ __forceinline__ void s5_y_phase(Frame& F, int l) {
    const bf16* PROJ = (const bf16*)(F.ws + WS_PROJ); const bf16* SS = (const bf16*)(F.ws + WS_SS); bf16* YG = (bf16*)(F.ws + WS_YG); const float* ds = IN_(I_DSKIP) + l * MIXW;
    const int l15 = F.lane & 15, lq = F.lane >> 4;
    for (int item = F.bid; item < 256; item += F.G) {
        const int g = item >> 3, part = item & 7; const bf16* Tm = (const bf16*)(F.ws + WS_S5M) + ((size_t)(l * 32 + g) * 3 + 1) * 65536; const bf16* Em = Tm + 65536;
        bf16x8 At[2][8], Ae[2][8];
#pragma unroll
        for (int j = 0; j < 2; ++j)
#pragma unroll
            for (int ks = 0; ks < 8; ++ks) { const size_t o = (size_t)(16 * (2 * F.wave + j) + l15) * 256 + 32 * ks + 8 * lq; At[j][ks] = *(const bf16x8*)(Tm + o); Ae[j][ks] = *(const bf16x8*)(Em + o); }
        const f32x4 dsk = *(const f32x4*)(ds + 16 * g + 4 * lq);
#pragma unroll 1
        for (int tl = part; tl < MT / 256; tl += 8) {
            bf16x8 V[8], S[8];
#pragma unroll
            for (int ks = 0; ks < 8; ++ks) { V[ks] = *(const bf16x8*)(PROJ + (size_t)(tl * 256 + 16 * l15 + 2 * ks + (lq >> 1)) * INW + 16 * g + 8 * (lq & 1));
                S[ks] = *(const bf16x8*)(SS + ((size_t)(tl * 16 + l15) * 32 + g) * 256 + 32 * ks + 8 * lq); }
            f32x4 acc[2] = {{0.f, 0.f, 0.f, 0.f}, {0.f, 0.f, 0.f, 0.f}};
#pragma unroll
            for (int ks = 0; ks < 8; ++ks)
#pragma unroll
                for (int j = 0; j < 2; ++j) { acc[j] = __builtin_amdgcn_mfma_f32_16x16x32_bf16(At[j][ks], V[ks], acc[j], 0, 0, 0); acc[j] = __builtin_amdgcn_mfma_f32_16x16x32_bf16(Ae[j][ks], S[ks], acc[j], 0, 0, 0); }
#pragma unroll
            for (int j = 0; j < 2; ++j) { const size_t row = (size_t)tl * 256 + 16 * l15 + (2 * F.wave + j); const int ch = 16 * g + 4 * lq;
                const v2u u = *(const v2u*)(PROJ + row * INW + ch);
                const float y0 = acc[j][0] + dsk[0] * bflo(u.x), y1 = acc[j][1] + dsk[1] * bfhi(u.x), y2 = acc[j][2] + dsk[2] * bflo(u.y), y3 = acc[j][3] + dsk[3] * bfhi(u.y);
                v2u w; w.x = cvtpk(geluf_(y0), geluf_(y1)); w.y = cvtpk(geluf_(y2), geluf_(y3)); *(v2u*)(YG + row * MIXW + ch) = w; }
        }
    }
}

struct NSmem { float As[16][68]; float Bs[16][68]; };
template <class AF>
__device__ __forceinline__ void ngemm_acc(float (&acc)[4][4], const AF& af, const float* B, int ldb, int K, LAS NSmem* s, int t) {
    const int ty = t >> 4, tx = t & 15, lr = t >> 2, lk = (t & 3) * 4, bk = t >> 4, bn = (t & 15) * 4;
    for (int k0 = 0; k0 < K; k0 += 16) {
        const float4 av = af.load4(lr, k0 + lk);
        const float4 bv = *(const float4*)(B + (size_t)(k0 + bk) * ldb + bn);
        __syncthreads();
        s->As[lk + 0][lr] = av.x; s->As[lk + 1][lr] = av.y; s->As[lk + 2][lr] = av.z; s->As[lk + 3][lr] = av.w;
        *(LAS f32x4*)&s->Bs[bk][bn] = (f32x4){bv.x, bv.y, bv.z, bv.w};
        __syncthreads();
#pragma unroll
        for (int k = 0; k < 16; ++k) {
            const f32x4 a = *(const LAS f32x4*)&s->As[k][ty * 4]; const f32x4 b = *(const LAS f32x4*)&s->Bs[k][tx * 4];
            const float aa[4] = {a.x, a.y, a.z, a.w}, bb[4] = {b.x, b.y, b.z, b.w};
#pragma unroll
            for (int i = 0; i < 4; ++i)
#pragma unroll
                for (int j = 0; j < 4; ++j) acc[i][j] += aa[i] * bb[j];
        }
    }
}
struct ABf { const bf16* A; int lda; __device__ __forceinline__ float4 load4(int r, int k) const { const v2u w = *(const v2u*)(A + (size_t)r * lda + k);
    return make_float4(bf2f((unsigned short)(w.x & 0xffff)), bf2f((unsigned short)(w.x >> 16)), bf2f((unsigned short)(w.y & 0xffff)), bf2f((unsigned short)(w.y >> 16))); } };
#define NTILE_BEGIN(ntiles) { const int _half = F.tid >> 8, t = F.tid & 255, ty = t >> 4, tx = t & 15; LAS NSmem* sm = (LAS NSmem*)F.lds + _half; (void)ty; (void)tx; \
    const int _nt = (ntiles), _nit = (_nt + 2 * F.G - 1) / (2 * F.G); \
    for (int _it = 0; _it < _nit; ++_it) { int T = (_it * F.G + F.bid) * 2 + _half; const bool valid = T < _nt; if (!valid) T = _nt - 1;
#define NTILE_END } }

__device__ __forceinline__ void ph0_prologue(Frame& F) {
    float* mod = (float*)(F.ws + WS_MOD);
    const int gt = F.bid * NT + F.tid, ngt = F.G * NT;
    for (int idx = gt; idx < 2 * 6144; idx += ngt) {
        const int l = idx / 6144, j = idx % 6144;
        const float* W = IN_(I_WADA) + (size_t)l * D * 6144 + j;
        float a0 = 0.f, a1 = 0.f;
        for (int k = 0; k < D; ++k) { const float w = W[(size_t)k * 6144]; a0 += siluf_(IN_(I_C)[k]) * w; a1 += siluf_(IN_(I_CCTX)[k]) * w; }
        const float b = IN_(I_BADA)[l * 6144 + j];
        mod[(size_t)(l * 2 + 0) * 6144 + j] = a0 + b; mod[(size_t)(l * 2 + 1) * 6144 + j] = a1 + b;
    }
}
__device__ __forceinline__ void hprep_rows(Frame& F, int l) {
    bf16* H = (bf16*)(F.ws + WS_H); const float* g = IN_(I_GMIX) + l * D;
    const int gw = F.bid * (NT / 64) + F.wave, ngw = F.G * (NT / 64);
    for (int row = gw; row < MT; row += ngw) {
        const float* m = mod_ptr(F, l, row); const float* xr = xsrc_row(F, l, row);
        f32x4 v[4]; float s = 0.f;
#pragma unroll
        for (int j = 0; j < 4; ++j) { v[j] = *(const f32x4*)(xr + 4 * F.lane + 256 * j); s += v[j].x * v[j].x + v[j].y * v[j].y + v[j].z * v[j].z + v[j].w * v[j].w; }
        const float rstd = rsqrtf(wave_sum(s) * (1.f / D) + EPS);
#pragma unroll
        for (int j = 0; j < 4; ++j) { const int c = 4 * F.lane + 256 * j; const f32x4 gg = *(const f32x4*)(g + c), sc = *(const f32x4*)(m + 1024 + c), sh = *(const f32x4*)(m + c);
            const f32x4 o = v[j] * rstd * gg * (1.f + sc) + sh; v2u w; w.x = pk2(o.x, o.y); w.y = pk2(o.z, o.w); *(v2u*)(H + (size_t)row * D + c) = w; }
    }
}
__device__ __forceinline__ void ph2_naive(Frame& F, int l) {
    const bf16* H = (const bf16*)(F.ws + WS_H); bf16* PROJ = (bf16*)(F.ws + WS_PROJ); const float* W = IN_(I_WIN) + (size_t)l * D * INW;
    NTILE_BEGIN((MT / 64) * (INW / 64))
        const int m0 = (T / (INW / 64)) * 64, n0 = (T % (INW / 64)) * 64;
        float acc[4][4] = {};
        ngemm_acc(acc, ABf{H + (size_t)m0 * D, D}, W + n0, INW, D, sm, t);
        if (valid) {
#pragma unroll
            for (int i = 0; i < 4; ++i) { float o[4];
#pragma unroll
                for (int j = 0; j < 4; ++j) { o[j] = acc[i][j]; if (n0 >= 512 && n0 < 1536) o[j] = geluf_(o[j]); }
                v2u w; w.x = pk2(o[0], o[1]); w.y = pk2(o[2], o[3]); *(v2u*)(PROJ + (size_t)(m0 + ty * 4 + i) * INW + n0 + tx * 4) = w; }
        }
    NTILE_END
}
__device__ __forceinline__ int chain_row(int dir, int pos) { return dir == 0 ? (pos < CTX ? SEQ + pos : pos - CTX) : (pos < CTX ? SEQ + CTX - 1 - pos : SEQ - 1 - (pos - CTX)); }
__device__ __forceinline__ void ph3_s5_naive(Frame& F, int l) {
    LAS float* Cr = (LAS float*)(F.lds + 32768); LAS float* Ci = Cr + 1024; LAS float* Sr = Ci + 1024; LAS float* Si = Sr + 2048;
    const bf16* PROJ = (const bf16*)(F.ws + WS_PROJ); float* YD = (float*)(F.ws + WS_S5);
    for (int item = F.bid; item < 64; item += F.G) {
        if (F.wave == 0) {
            const int g = item >> 1, dir = item & 1, p = F.lane;
            const int ldg = ((l * 2 + dir) * G5 + g);
            const float lr = IN_(I_LRE)[ldg * P5 + p], li = IN_(I_LIM)[ldg * P5 + p], dt = expf(IN_(I_LDT)[ldg]);
            const float er = expf(lr * dt), ar = er * cosf(li * dt), ai = er * sinf(li * dt);
            const float nr = ar - 1.f, ni = ai, den = lr * lr + li * li;
            const float qr = (nr * lr + ni * li) / den, qi = (ni * lr - nr * li) / den;
            float br[16], bi[16];
#pragma unroll
            for (int h = 0; h < 16; ++h) { const float x = IN_(I_BRE)[((size_t)ldg * P5 + p) * H5 + h], y = IN_(I_BIM)[((size_t)ldg * P5 + p) * H5 + h]; br[h] = qr * x - qi * y; bi[h] = qr * y + qi * x; }
            for (int h = 0; h < 16; ++h) { Cr[h * 64 + p] = IN_(I_CRE)[((size_t)ldg * H5 + h) * P5 + p]; Ci[h * 64 + p] = IN_(I_CIM)[((size_t)ldg * H5 + h) * P5 + p]; }
            float sr = 0.f, si = 0.f;
            float* Y = YD + (size_t)dir * MT * MIXW;
#pragma unroll 1
            for (int blk = 0; blk < MT / 32; ++blk) {
#pragma unroll 1
                for (int tt = 0; tt < 32; ++tt) {
                    const int row = chain_row(dir, blk * 32 + tt);
                    const v4u u0 = *(const v4u*)(PROJ + (size_t)row * INW + g * 16), u1 = *(const v4u*)(PROJ + (size_t)row * INW + g * 16 + 8);
                    const unsigned uw[8] = {u0.x, u0.y, u0.z, u0.w, u1.x, u1.y, u1.z, u1.w};
                    float xr = 0.f, xi = 0.f;
#pragma unroll
                    for (int h = 0; h < 8; ++h) { const float ua = bf2f((unsigned short)(uw[h] & 0xffff)), ub = bf2f((unsigned short)(uw[h] >> 16));
                        xr += br[2 * h] * ua + br[2 * h + 1] * ub; xi += bi[2 * h] * ua + bi[2 * h + 1] * ub; }
                    const float nsr = ar * sr - ai * si + xr, nsi = ar * si + ai * sr + xi;
                    sr = nsr; si = nsi; Sr[tt * 64 + p] = sr; Si[tt * 64 + p] = si;
                }
                asm volatile("s_waitcnt lgkmcnt(0)" ::: "memory");
#pragma unroll 1
                for (int o = p; o < 512; o += 64) {
                    const int tt = o >> 4, h = o & 15; float a = 0.f;
#pragma unroll 4
                    for (int q = 0; q < 64; ++q) a += Cr[h * 64 + q] * Sr[tt * 64 + q] - Ci[h * 64 + q] * Si[tt * 64 + q];
                    Y[(size_t)chain_row(dir, blk * 32 + tt) * MIXW + g * 16 + h] = a;
                }
                asm volatile("s_waitcnt lgkmcnt(0)" ::: "memory");
            }
        }
    }
}
__device__ __forceinline__ void ph3_sg_naive(Frame& F, int l) {
    const bf16* PROJ = (const bf16*)(F.ws + WS_PROJ); bf16* YB = (bf16*)(F.ws + WS_YS) + (size_t)MT * MIXW;
    LAS float* stat = (LAS float*)(F.lds + 32768);
    const float* lg = IN_(I_SGG) + l * MIXW; const float* lb = IN_(I_SGB) + l * MIXW;
    NTILE_BEGIN((MT / 128) * 16)
        const int chunk = T >> 4, gg = (T >> 2) & 3, q0 = ((T >> 1) & 1) * 64, c0 = (T & 1) * 64;
        LAS float* st = stat + _half * 256;
        __syncthreads();
        if (t < 128) { const bf16* vr = PROJ + (size_t)(chunk * 128 + t) * INW + 1024; float s = 0.f;
            for (int c = 0; c < 512; c += 2) { const unsigned w = *(const unsigned*)(vr + c); s += bf2f((unsigned short)(w & 0xffff)) + bf2f((unsigned short)(w >> 16)); }
            const float mu = s * (1.f / 512.f); float q = 0.f;
            for (int c = 0; c < 512; c += 2) { const unsigned w = *(const unsigned*)(vr + c); const float a = bf2f((unsigned short)(w & 0xffff)) - mu, b = bf2f((unsigned short)(w >> 16)) - mu; q += a * a + b * b; }
            st[t * 2] = mu; st[t * 2 + 1] = rsqrtf(q * (1.f / 512.f) + EPS); }
        __syncthreads();
        float acc[4][4] = {};
        {
            const float* A = IN_(I_WSG) + ((size_t)(l * 4 + gg) * 128 + q0) * 128;
            const int lr = t >> 2, lk = (t & 3) * 4, bk = t >> 4, bn = (t & 15) * 4;
            for (int k0 = 0; k0 < 128; k0 += 16) {
                const float4 av = *(const float4*)(A + (size_t)lr * 128 + k0 + lk);
                const int p = k0 + bk; const int col = gg * 128 + c0 + bn;
                const v2u w = *(const v2u*)(PROJ + (size_t)(chunk * 128 + p) * INW + 1024 + col);
                const float mu = st[p * 2], rs = st[p * 2 + 1];
                float4 bv; bv.x = (bf2f((unsigned short)(w.x & 0xffff)) - mu) * rs * lg[col] + lb[col]; bv.y = (bf2f((unsigned short)(w.x >> 16)) - mu) * rs * lg[col + 1] + lb[col + 1];
                bv.z = (bf2f((unsigned short)(w.y & 0xffff)) - mu) * rs * lg[col + 2] + lb[col + 2]; bv.w = (bf2f((unsigned short)(w.y >> 16)) - mu) * rs * lg[col + 3] + lb[col + 3];
                __syncthreads();
                sm->As[lk + 0][lr] = av.x; sm->As[lk + 1][lr] = av.y; sm->As[lk + 2][lr] = av.z; sm->As[lk + 3][lr] = av.w;
                *(LAS f32x4*)&sm->Bs[bk][bn] = (f32x4){bv.x, bv.y, bv.z, bv.w};
                __syncthreads();
#pragma unroll
                for (int k = 0; k < 16; ++k) { const f32x4 a = *(const LAS f32x4*)&sm->As[k][ty * 4]; const f32x4 b = *(const LAS f32x4*)&sm->Bs[k][tx * 4];
                    const float aa[4] = {a.x, a.y, a.z, a.w}, bb[4] = {b.x, b.y, b.z, b.w};
#pragma unroll
                    for (int i = 0; i < 4; ++i)
#pragma unroll
                        for (int j = 0; j < 4; ++j) acc[i][j] += aa[i] * bb[j]; }
            }
        }
        if (valid) {
#pragma unroll
            for (int i = 0; i < 4; ++i) { const int q = q0 + ty * 4 + i; const size_t row = (size_t)chunk * 128 + q; const int col = gg * 128 + c0 + tx * 4;
                const float bq = IN_(I_BSG)[l * 512 + gg * 128 + q];
                const v2u gu = *(const v2u*)(PROJ + row * INW + 512 + col);
                v2u w; w.x = pk2(bf2f((unsigned short)(gu.x & 0xffff)) * (acc[i][0] + bq), bf2f((unsigned short)(gu.x >> 16)) * (acc[i][1] + bq));
                w.y = pk2(bf2f((unsigned short)(gu.y & 0xffff)) * (acc[i][2] + bq), bf2f((unsigned short)(gu.y >> 16)) * (acc[i][3] + bq));
                *(v2u*)(YB + row * MIXW + col) = w; }
        }
    NTILE_END
}
__device__ __forceinline__ void ph3_conv(Frame& F, int l) {
    const bf16* PROJ = (const bf16*)(F.ws + WS_PROJ); bf16* YC = (bf16*)(F.ws + WS_YS) + (size_t)2 * MT * MIXW; const float* wc = IN_(I_WCONV) + l * 3 * MIXW;
    const size_t gt = (size_t)F.bid * NT + F.tid, ngt = (size_t)F.G * NT;
    for (size_t i = gt; i < (size_t)MT * (MIXW / 2); i += ngt) {
        const int row = (int)(i / (MIXW / 2)), c = (int)(i % (MIXW / 2)) * 2;
        int pos, rl; if (row < SEQ) { pos = row & 63; rl = 64; } else { pos = row - SEQ; rl = 256; }
        const bf16* r0 = PROJ + (size_t)row * INW + 1536;
        const unsigned b0 = *(const unsigned*)(r0 + c), c0 = *(const unsigned*)(r0 + 512 + c), h0 = *(const unsigned*)(r0 + 1024 + c);
        float zm0 = 0.f, zm1 = 0.f, zp0 = 0.f, zp1 = 0.f;
        if (pos > 0) { const unsigned cc = *(const unsigned*)(r0 - INW + 512 + c), hh = *(const unsigned*)(r0 - INW + 1024 + c); zm0 = bf2f((unsigned short)(cc & 0xffff)) * bf2f((unsigned short)(hh & 0xffff)); zm1 = bf2f((unsigned short)(cc >> 16)) * bf2f((unsigned short)(hh >> 16)); }
        if (pos < rl - 1) { const unsigned cc = *(const unsigned*)(r0 + INW + 512 + c), hh = *(const unsigned*)(r0 + INW + 1024 + c); zp0 = bf2f((unsigned short)(cc & 0xffff)) * bf2f((unsigned short)(hh & 0xffff)); zp1 = bf2f((unsigned short)(cc >> 16)) * bf2f((unsigned short)(hh >> 16)); }
        const float z00 = bf2f((unsigned short)(c0 & 0xffff)) * bf2f((unsigned short)(h0 & 0xffff)), z01 = bf2f((unsigned short)(c0 >> 16)) * bf2f((unsigned short)(h0 >> 16));
        const float y0 = bf2f((unsigned short)(b0 & 0xffff)) * (wc[c] * zm0 + wc[512 + c] * z00 + wc[1024 + c] * zp0);
        const float y1 = bf2f((unsigned short)(b0 >> 16)) * (wc[c + 1] * zm1 + wc[512 + c + 1] * z01 + wc[1024 + c + 1] * zp1);
        *(unsigned*)(YC + (size_t)row * MIXW + c) = pk2(y0, y1);
    }
}
__device__ __forceinline__ void ph5_naive(Frame& F, int l) {
    const bf16* PROJ = (const bf16*)(F.ws + WS_PROJ); const float* YD = (const float*)(F.ws + WS_S5); bf16* YG = (bf16*)(F.ws + WS_YG); const float* ds = IN_(I_DSKIP) + l * MIXW;
    const size_t gt = (size_t)F.bid * NT + F.tid, ngt = (size_t)F.G * NT;
    for (size_t i = gt; i < (size_t)MT * (MIXW / 2); i += ngt) {
        const int row = (int)(i / (MIXW / 2)), c = (int)(i % (MIXW / 2)) * 2;
        const unsigned u = *(const unsigned*)(PROJ + (size_t)row * INW + c); const size_t o = (size_t)row * MIXW + c;
        const float y0 = YD[o] + YD[(size_t)MT * MIXW + o] + ds[c] * bf2f((unsigned short)(u & 0xffff)), y1 = YD[o + 1] + YD[(size_t)MT * MIXW + o + 1] + ds[c + 1] * bf2f((unsigned short)(u >> 16));
        *(unsigned*)(YG + o) = pk2(geluf_(y0), geluf_(y1));
    }
}
__device__ __forceinline__ void ph6_naive(Frame& F, int l) {
    const bf16* YG = (const bf16*)(F.ws + WS_YG); bf16* YA = (bf16*)(F.ws + WS_YS); const float* W = IN_(I_WGLU) + (size_t)l * MIXW * MIXW;
    NTILE_BEGIN((MT / 64) * (MIXW / 64))
        const int m0 = (T / (MIXW / 64)) * 64, n0 = (T % (MIXW / 64)) * 64;
        float acc[4][4] = {};
        ngemm_acc(acc, ABf{YG + (size_t)m0 * MIXW, MIXW}, W + n0, MIXW, MIXW, sm, t);
        if (valid) {
#pragma unroll
            for (int i = 0; i < 4; ++i) { const size_t o = (size_t)(m0 + ty * 4 + i) * MIXW + n0 + tx * 4; const v2u g = *(const v2u*)(YG + o);
                v2u w; w.x = pk2(bf2f((unsigned short)(g.x & 0xffff)) * sigmoidf_(acc[i][0]), bf2f((unsigned short)(g.x >> 16)) * sigmoidf_(acc[i][1]));
                w.y = pk2(bf2f((unsigned short)(g.y & 0xffff)) * sigmoidf_(acc[i][2]), bf2f((unsigned short)(g.y >> 16)) * sigmoidf_(acc[i][3])); *(v2u*)(YA + o) = w; }
        }
    NTILE_END
}
__device__ __forceinline__ void ph7_naive(Frame& F, int l) {
    const bf16* YS = (const bf16*)(F.ws + WS_YS); bf16* BR = (bf16*)(F.ws + WS_PROJ); const float* W = IN_(I_WBR) + (size_t)l * 3 * MIXW * D;
    NTILE_BEGIN((MT / 64) * (INW / 64))
        const int m0 = (T / (INW / 64)) * 64, n0 = (T % (INW / 64)) * 64, k = n0 / 1024, d0 = n0 % 1024;
        float acc[4][4] = {};
        ngemm_acc(acc, ABf{YS + (size_t)k * MT * MIXW + (size_t)m0 * MIXW, MIXW}, W + (size_t)k * MIXW * D + d0, D, MIXW, sm, t);
        if (valid) {
#pragma unroll
            for (int i = 0; i < 4; ++i) { v2u w; w.x = pk2(acc[i][0], acc[i][1]); w.y = pk2(acc[i][2], acc[i][3]); *(v2u*)(BR + (size_t)(m0 + ty * 4 + i) * INW + n0 + tx * 4) = w; }
        }
    NTILE_END
}
__device__ __forceinline__ void ph8_naive(Frame& F, int l) {
    const bf16* H = (const bf16*)(F.ws + WS_H); const bf16* BR = (const bf16*)(F.ws + WS_PROJ); bf16* PM = (bf16*)(F.ws + WS_PM);
    const float* W = IN_(I_WMG) + (size_t)l * D * INW; const float* bm = IN_(I_BMG) + l * INW;
    NTILE_BEGIN((MT / 64) * (D / 64))
        const int m0 = (T / (D / 64)) * 64, n0 = (T % (D / 64)) * 64;
        float out[4][4] = {};
        for (int k = 0; k < 3; ++k) {
            float acc[4][4] = {};
            ngemm_acc(acc, ABf{H + (size_t)m0 * D, D}, W + k * 1024 + n0, INW, D, sm, t);
#pragma unroll
            for (int i = 0; i < 4; ++i) { const v2u b = *(const v2u*)(BR + (size_t)(m0 + ty * 4 + i) * INW + k * 1024 + n0 + tx * 4);
                const float bb[4] = {bf2f((unsigned short)(b.x & 0xffff)), bf2f((unsigned short)(b.x >> 16)), bf2f((unsigned short)(b.y & 0xffff)), bf2f((unsigned short)(b.y >> 16))};
#pragma unroll
                for (int j = 0; j < 4; ++j) out[i][j] += sigmoidf_(acc[i][j] + bm[k * 1024 + n0 + tx * 4 + j]) * bb[j]; }
        }
        if (valid) {
#pragma unroll
            for (int i = 0; i < 4; ++i) { v2u w; w.x = pk2(out[i][0], out[i][1]); w.y = pk2(out[i][2], out[i][3]); *(v2u*)(PM + (size_t)(m0 + ty * 4 + i) * D + n0 + tx * 4) = w; }
        }
    NTILE_END
}
__device__ __forceinline__ void ph9_naive(Frame& F, int l) {
    const bf16* PM = (const bf16*)(F.ws + WS_PM); const float* W = IN_(I_WO) + (size_t)l * D * D;
    NTILE_BEGIN((MT / 64) * (D / 64))
        const int m0 = (T / (D / 64)) * 64, n0 = (T % (D / 64)) * 64;
        float acc[4][4] = {};
        ngemm_acc(acc, ABf{PM + (size_t)m0 * D, D}, W + n0, D, D, sm, t);
        if (valid) {
#pragma unroll
            for (int i = 0; i < 4; ++i) { const int row = m0 + ty * 4 + i, c = n0 + tx * 4; const float* m = mod_ptr(F, l, row) + 2048 + c;
                const f32x4 xs = *(const f32x4*)(xsrc_row(F, l, row) + c);
                f32x4 o; o.x = xs.x + m[0] * acc[i][0]; o.y = xs.y + m[1] * acc[i][1]; o.z = xs.z + m[2] * acc[i][2]; o.w = xs.w + m[3] * acc[i][3];
                *(f32x4*)(xrun_row(F, row) + c) = o; }
        }
    NTILE_END
}
__device__ __forceinline__ void ph10_route(Frame& F, int l) {
    bf16* H = (bf16*)(F.ws + WS_H); const float* g = IN_(I_GFFN) + l * D;
    const float* wg = IN_(I_WGRP) + (size_t)l * D * 4; const float* we = IN_(I_WEXP) + (size_t)l * D * 32; const float* bg = IN_(I_BGRP) + l * 4; const float* be = IN_(I_BEXP) + l * 32;
    int* EID = (int*)(F.ws + WS_EID); float* EW = (float*)(F.ws + WS_EW); unsigned* cnt = F.ctl + CW_CNT + l * 128;
    LAS float* L = (LAS float*)(F.lds + 122880) + F.wave * 40;
    const int gw = F.bid * (NT / 64) + F.wave, ngw = F.G * (NT / 64);
    for (int row = gw; row < MT; row += ngw) {
        const float* m = mod_ptr(F, l, row); const float* xr = xrun_row(F, row);
        float s = 0.f;
#pragma unroll
        for (int j = 0; j < 4; ++j) { const f32x4 x = *(const f32x4*)(xr + 4 * F.lane + 256 * j); s += x.x * x.x + x.y * x.y + x.z * x.z + x.w * x.w; }
        const float rstd = rsqrtf(wave_sum(s) * (1.f / D) + EPS);
        float acc[36];
#pragma unroll
        for (int o = 0; o < 36; ++o) acc[o] = 0.f;
#pragma unroll 1
        for (int j = 0; j < 4; ++j) { const int c = 4 * F.lane + 256 * j; const f32x4 x = *(const f32x4*)(xr + c); const f32x4 gg = *(const f32x4*)(g + c), sc = *(const f32x4*)(m + 4096 + c), sh = *(const f32x4*)(m + 3072 + c);
            const f32x4 o = x * rstd * gg * (1.f + sc) + sh; v2u w; w.x = pk2(o.x, o.y); w.y = pk2(o.z, o.w); *(v2u*)(H + (size_t)row * D + c) = w;
            const float hv[4] = {o.x, o.y, o.z, o.w};
#pragma unroll
            for (int e = 0; e < 4; ++e) { const float* wgr = wg + (size_t)(c + e) * 4; const float* wer = we + (size_t)(c + e) * 32;
#pragma unroll
                for (int q = 0; q < 4; ++q) acc[q] += hv[e] * wgr[q];
#pragma unroll
                for (int q = 0; q < 32; ++q) acc[4 + q] += hv[e] * wer[q]; } }
#pragma unroll
        for (int o = 0; o < 36; ++o) acc[o] = wave_sum(acc[o]);
        if (F.lane == 0) {
#pragma unroll
            for (int o = 0; o < 4; ++o) L[o] = acc[o] + bg[o];
#pragma unroll
            for (int o = 0; o < 32; ++o) L[4 + o] = acc[4 + o] + be[o];
            int gi = 0; float gm = L[0]; for (int o = 1; o < 4; ++o) if (L[o] > gm) { gm = L[o]; gi = o; }
            float den = 0.f; for (int o = 0; o < 4; ++o) den += expf(L[o] - gm);
            const float gp = 1.f / den;
            const LAS float* el = L + 4 + gi * 8;
            int i1 = 0; float m1 = el[0]; for (int o = 1; o < 8; ++o) if (el[o] > m1) { m1 = el[o]; i1 = o; }
            int i2 = -1; float m2 = 0.f; for (int o = 0; o < 8; ++o) if (o != i1 && (i2 < 0 || el[o] > m2)) { m2 = el[o]; i2 = o; }
            const float e2 = expf(m2 - m1); const float w1 = 1.f / (1.f + e2), w2 = e2 / (1.f + e2);
            const int e1i = gi * 8 + i1, e2i = gi * 8 + i2;
            EID[row * 2] = e1i; EID[row * 2 + 1] = e2i; EW[row * 2] = gp * w1; EW[row * 2 + 1] = gp * w2;
            atomicAdd(&cnt[e1i], 1u); atomicAdd(&cnt[e2i], 1u);
        }
    }
}
__device__ __forceinline__ int expert_off(const unsigned* cnt, int e) { int o = 0; for (int i = 0; i < e; ++i) o += ((int)cnt[i] + 255) & ~255; return o; }
__device__ __forceinline__ void ph11_scatter(Frame& F, int l) {
    const bf16* H = (const bf16*)(F.ws + WS_H); bf16* HS = (bf16*)(F.ws + WS_HS);
    const int* EID = (const int*)(F.ws + WS_EID); const float* EW = (const float*)(F.ws + WS_EW); int* STOK = (int*)(F.ws + WS_STOK); float* SW = (float*)(F.ws + WS_SW); int* TSLOT = (int*)(F.ws + WS_TSLOT);
    unsigned* cnt = F.ctl + CW_CNT + l * 128; unsigned* fill = cnt + 64;
    const int gw = F.bid * (NT / 64) + F.wave, ngw = F.G * (NT / 64);
    for (int i = gw; i < MT * 2; i += ngw) {
        int slot = 0;
        if (F.lane == 0) { const int e = EID[i]; const int pos = (int)atomicAdd(&fill[e], 1u); slot = expert_off(cnt, e) + pos; STOK[slot] = i >> 1; SW[slot] = EW[i]; TSLOT[i] = slot; }
        slot = __shfl(slot, 0);
        const v4u* src = (const v4u*)(H + (size_t)(i >> 1) * D); v4u* dst = (v4u*)(HS + (size_t)slot * D);
        dst[F.lane] = src[F.lane]; dst[F.lane + 64] = src[F.lane + 64];
    }
}
__device__ __forceinline__ int slot_expert(const unsigned* cnt, int slot0, int& seg_off, int& n_e) { int o = 0; for (int e = 0; e < NE; ++e) { const int n = (int)cnt[e], pn = (n + 255) & ~255; if (slot0 < o + pn) { seg_off = o; n_e = n; return e; } o += pn; } seg_off = o; n_e = 0; return 0; }
__device__ __forceinline__ void ph12_naive(Frame& F, int l) {
    const bf16* HS = (const bf16*)(F.ws + WS_HS); bf16* ACT = (bf16*)(F.ws + WS_ACT); const float* SW = (const float*)(F.ws + WS_SW);
    const unsigned* cnt = F.ctl + CW_CNT + l * 128; const int total = expert_off(cnt, NE);
    NTILE_BEGIN((total / 64) * (DFF / 64))
        const int s0 = (T / (DFF / 64)) * 64, n0 = (T % (DFF / 64)) * 64; int seg, n_e; const int e = slot_expert(cnt, s0, seg, n_e);
        float aa[4][4] = {}, ab[4][4] = {};
        ngemm_acc(aa, ABf{HS + (size_t)s0 * D, D}, IN_(I_W1) + ((size_t)l * NE + e) * D * DFF + n0, DFF, D, sm, t);
        ngemm_acc(ab, ABf{HS + (size_t)s0 * D, D}, IN_(I_W3) + ((size_t)l * NE + e) * D * DFF + n0, DFF, D, sm, t);
        if (valid) {
#pragma unroll
            for (int i = 0; i < 4; ++i) { const int slot = s0 + ty * 4 + i; if (slot - seg < n_e) { const float w = SW[slot];
                v2u o; o.x = pk2(siluf_(aa[i][0]) * ab[i][0] * w, siluf_(aa[i][1]) * ab[i][1] * w); o.y = pk2(siluf_(aa[i][2]) * ab[i][2] * w, siluf_(aa[i][3]) * ab[i][3] * w);
                *(v2u*)(ACT + (size_t)slot * DFF + n0 + tx * 4) = o; } }
        }
    NTILE_END
}
__device__ __forceinline__ void ph13_naive(Frame& F, int l) {
    const bf16* ACT = (const bf16*)(F.ws + WS_ACT); bf16* YS2 = (bf16*)(F.ws + WS_YS2);
    const unsigned* cnt = F.ctl + CW_CNT + l * 128; const int total = expert_off(cnt, NE);
    NTILE_BEGIN((total / 64) * (D / 64))
        const int s0 = (T / (D / 64)) * 64, n0 = (T % (D / 64)) * 64; int seg, n_e; const int e = slot_expert(cnt, s0, seg, n_e);
        float acc[4][4] = {};
        ngemm_acc(acc, ABf{ACT + (size_t)s0 * DFF, DFF}, IN_(I_W2) + ((size_t)l * NE + e) * DFF * D + n0, D, DFF, sm, t);
        if (valid) {
#pragma unroll
            for (int i = 0; i < 4; ++i) { const int slot = s0 + ty * 4 + i; if (slot - seg < n_e) { v2u o; o.x = pk2(acc[i][0], acc[i][1]); o.y = pk2(acc[i][2], acc[i][3]); *(v2u*)(YS2 + (size_t)slot * D + n0 + tx * 4) = o; } }
        }
    NTILE_END
}
__device__ __forceinline__ void ph14_combine(Frame& F, int l) {
    const bf16* YS2 = (const bf16*)(F.ws + WS_YS2); const int* TSLOT = (const int*)(F.ws + WS_TSLOT); bf16* H = (bf16*)(F.ws + WS_H);
    const int gw = F.bid * (NT / 64) + F.wave, ngw = F.G * (NT / 64);
    const int nrows = l == 0 ? MT : SEQ;
    for (int row = gw; row < nrows; row += ngw) {
        const float* m = mod_ptr(F, l, row); float* xr = xrun_row(F, row);
        const int s0 = TSLOT[row * 2], s1 = TSLOT[row * 2 + 1];
        f32x4 v[4]; float s = 0.f;
#pragma unroll
        for (int j = 0; j < 4; ++j) { const int c = 4 * F.lane + 256 * j; const f32x4 x = *(const f32x4*)(xr + c); const f32x4 ga = *(const f32x4*)(m + 5120 + c);
            const v2u a = *(const v2u*)(YS2 + (size_t)s0 * D + c), b = *(const v2u*)(YS2 + (size_t)s1 * D + c);
            f32x4 y; y.x = bf2f((unsigned short)(a.x & 0xffff)) + bf2f((unsigned short)(b.x & 0xffff)); y.y = bf2f((unsigned short)(a.x >> 16)) + bf2f((unsigned short)(b.x >> 16));
            y.z = bf2f((unsigned short)(a.y & 0xffff)) + bf2f((unsigned short)(b.y & 0xffff)); y.w = bf2f((unsigned short)(a.y >> 16)) + bf2f((unsigned short)(b.y >> 16));
            v[j] = x + ga * y; s += v[j].x * v[j].x + v[j].y * v[j].y + v[j].z * v[j].z + v[j].w * v[j].w; }
        const float rstd = rsqrtf(wave_sum(s) * (1.f / D) + EPS);
        if (l == 0) {
            const float* m1 = mod_ptr(F, 1, row); const float* g = IN_(I_GMIX) + D;
#pragma unroll
            for (int j = 0; j < 4; ++j) { const int c = 4 * F.lane + 256 * j; *(f32x4*)(xr + c) = v[j];
                const f32x4 gg = *(const f32x4*)(g + c), sc = *(const f32x4*)(m1 + 1024 + c), sh = *(const f32x4*)(m1 + c);
                const f32x4 o = v[j] * rstd * gg * (1.f + sc) + sh; v2u w; w.x = pk2(o.x, o.y); w.y = pk2(o.z, o.w); *(v2u*)(H + (size_t)row * D + c) = w; }
        } else {
            const float* g = IN_(I_GF);
#pragma unroll
            for (int j = 0; j < 4; ++j) { const int c = 4 * F.lane + 256 * j; const f32x4 gg = *(const f32x4*)(g + c); *(f32x4*)(xr + c) = v[j] * rstd * gg; }
        }
    }
}

#ifndef FASTMASK
#define FASTMASK 0xffff
#endif
constexpr unsigned FM = FASTMASK;
constexpr int NPH = 2 + 13 * 2;
__device__ __forceinline__ Frame make_frame(LAS unsigned char* lds) {
    Frame F; F.lds = lds; F.tid = threadIdx.x; asm volatile("" : "+v"(F.tid)); F.lane = F.tid & 63; F.wave = __builtin_amdgcn_readfirstlane(F.tid >> 6); F.bid = blockIdx.x; F.G = gridDim.x; asm volatile("" : "+s"(F.G), "+s"(F.bid));
    F.tab = (const unsigned long long LAS*)(lds + TAB_OFF);
    volatile LAS unsigned long long* t = (volatile LAS unsigned long long*)(lds + TAB_OFF);
    F.ws = (unsigned char*)uni64(t[35]); F.out = (float*)uni64(t[36]); F.ctl = (unsigned*)(F.ws + WS_CTL);
    return F;
}
__global__ void __launch_bounds__(NT, 2) mega_fwd(Args args) {
    extern __shared__ __attribute__((aligned(16))) unsigned char lds_raw[];
    LAS unsigned char* const lds = (LAS unsigned char*)lds_raw;
    for (int u = threadIdx.x; u < 1024 / 4; u += NT) ((LAS unsigned*)(lds + 131072))[u] = 0u;
    if (threadIdx.x == 0) { LAS unsigned long long* t = (LAS unsigned long long*)(lds + TAB_OFF);
#pragma unroll
        for (int i = 0; i < 35; ++i) t[i] = (unsigned long long)args.in[i];
        t[35] = (unsigned long long)args.ws; t[36] = (unsigned long long)args.out; }
    __syncthreads();
    { Frame F = make_frame(lds); (void)xcd_barrier_post(F.ctl + CW_BAR, (volatile LAS unsigned*)(lds + MISC_OFF) + 8); }
    const int lo = args.ph_lo, hi = args.ph_hi; int ph = 0;
#define GRIDBAR() do { Frame Fb = make_frame(lds); XcdBarrier bar; bar.bar = Fb.ctl + CW_BAR; bar.x = xb_xcc_id(); bar.st = (volatile LAS unsigned*)(lds + MISC_OFF) + 8; xcd_barrier(bar); } while (0)
#define PHASE(...) do { if (lo <= ph && ph < hi) { { Frame F = make_frame(lds); __VA_ARGS__; } if (ph + 1 < hi) GRIDBAR(); } ++ph; } while (0)
    PHASE({ ph0_prologue(F); convert_weights(F, 0); { const f32x4* s = (const f32x4*)IN_(I_CTX); f32x4* d = (f32x4*)(F.ws + WS_XC); for (int i = F.bid * NT + F.tid; i < CTX * D / 4; i += F.G * NT) d[i] = s[i]; } });
    PHASE({ hprep_rows(F, 0); if (FM >> 3 & 1) s5_precompute(F); });
#pragma unroll 1
    for (int l = 0; l < 2; ++l) {
        PHASE({ if (FM >> 2 & 1) ph2_fast(F, l); else ph2_naive(F, l); });
        PHASE({ if (FM >> 3 & 1) { s5_z_phase(F, l); ph3_sg_naive(F, l); ph3_conv(F, l); } else { ph3_s5_naive(F, l); if (F.bid >= 64) { Frame F2 = F; F2.bid -= 64; F2.G -= 64; ph3_sg_naive(F2, l); ph3_conv(F2, l); } } });
        PHASE({ if (FM >> 3 & 1) s5_scan_phase(F, l); });
        PHASE({ if (FM >> 3 & 1) s5_y_phase(F, l); else ph5_naive(F, l); });
        PHASE({ if (FM >> 6 & 1) ph6_fast(F, l); else ph6_naive(F, l); });
        PHASE({ if (FM >> 7 & 1) ph7_fast(F, l); else ph7_naive(F, l); });
        PHASE({ if (FM >> 8 & 1) ph8_fast(F, l); else ph8_naive(F, l); });
        PHASE({ if (FM >> 9 & 1) ph9_fast(F, l); else ph9_naive(F, l); });
        PHASE(ph10_route(F, l));
        PHASE(ph11_scatter(F, l));
        PHASE({ if (FM >> 12 & 1) ph12_fast(F, l); else ph12_naive(F, l); });
        PHASE({ if (FM >> 13 & 1) ph13_fast(F, l); else ph13_naive(F, l); });
        PHASE({ ph14_combine(F, l); if (l == 0) convert_weights(F, 1); });
    }
#undef PHASE
}

extern "C" void kernel_launch(void* const* d_in, const int* in_sizes, int n_in, void* d_out, int out_size, void* d_ws, size_t ws_size, hipStream_t stream) {
    static int grid = 0;
    if (grid == 0) {
        int dev = 0, cus = 0, per_cu = 0;
        if (n_in != 35 || out_size != SEQ * D || ws_size < WS_END) { fprintf(stderr, "kernel_launch: unexpected shapes (n_in %d out %d ws %zu)\n", n_in, out_size, ws_size); grid = -1; return; }
        if (hipGetDevice(&dev) != hipSuccess || hipDeviceGetAttribute(&cus, hipDeviceAttributeMultiprocessorCount, dev) != hipSuccess) { grid = -1; return; }
        if (hipFuncSetAttribute((const void*)mega_fwd, hipFuncAttributeMaxDynamicSharedMemorySize, LDS_BYTES) != hipSuccess) { fprintf(stderr, "kernel_launch: hipFuncSetAttribute failed\n"); grid = -1; return; }
        if (hipOccupancyMaxActiveBlocksPerMultiprocessor(&per_cu, (const void*)mega_fwd, NT, LDS_BYTES) != hipSuccess || per_cu < 1) { fprintf(stderr, "kernel_launch: occupancy query says %d blocks per CU\n", per_cu); grid = -1; return; }
        grid = cus;
    }
    if (grid < 0) return;
    (void)hipMemsetAsync((char*)d_ws + WS_CTL, 0, CTL_ZERO_BYTES, stream);
    Args a{};
    for (int i = 0; i < 35; ++i) a.in[i] = (const float*)d_in[i];
    a.out = (float*)d_out; a.ws = (unsigned char*)d_ws; a.ph_lo = 0; a.ph_hi = NPH;
    void* kargs[] = {&a};
    hipError_t e = hipLaunchCooperativeKernel((const void*)mega_fwd, dim3(grid), dim3(NT), kargs, LDS_BYTES, stream);
    if (e != hipSuccess) fprintf(stderr, "kernel_launch: cooperative launch failed: %s (grid %d)\n", hipGetErrorString(e), grid);
}
```

```cpp
#include <hip/hip_runtime.h>
#include <stdint.h>
#include <cstdio>

#define GAS __attribute__((address_space(1)))
#define LAS __attribute__((address_space(3)))
typedef unsigned short bf16;
typedef unsigned v4u __attribute__((ext_vector_type(4)));
typedef unsigned v2u __attribute__((ext_vector_type(2)));
typedef float f32x4 __attribute__((ext_vector_type(4)));

constexpr int D = 1024, SEQ = 16384, CTX = 256, MT = SEQ + CTX;
constexpr int MIXW = 512, INW = 3072, G5 = 32, P5 = 64, H5 = 16;
constexpr int NE = 32, DFF = 256;
constexpr int MAXSLOT = 2 * MT + NE * 256;
constexpr float EPS = 1e-6f;
constexpr int NT = 512;

constexpr size_t MiB = 1u << 20;
constexpr size_t WS_CTL = 0, CTL_ZERO_BYTES = 1 * MiB;
constexpr size_t WS_MOD = 1 * MiB;
constexpr size_t WS_XC = 2 * MiB;
constexpr size_t WS_EID = 3 * MiB;
constexpr size_t WS_EW = WS_EID + (size_t)MT * 8;
constexpr size_t WS_STOK = WS_EW + (size_t)MT * 8;
constexpr size_t WS_SW = WS_STOK + (size_t)MAXSLOT * 4;
constexpr size_t WS_TSLOT = WS_SW + (size_t)MAXSLOT * 4;
constexpr size_t WS_H = 4 * MiB;
constexpr size_t WS_PROJ = WS_H + (size_t)MT * 2048;
constexpr size_t WS_YS = WS_PROJ + (size_t)MT * 6144;
constexpr size_t WS_YG = WS_YS + (size_t)3 * MT * 1024;
constexpr size_t WS_PM = WS_YG + (size_t)MT * 1024;
constexpr size_t WS_S5 = WS_PM + (size_t)MT * 2048;
constexpr size_t WS_Z = WS_S5;
constexpr size_t WS_SS = WS_Z + (size_t)1040 * 32 * 256 * 4;
constexpr size_t WS_S5M = WS_SS + (size_t)1040 * 32 * 256 * 2;
constexpr size_t WS_A16 = WS_S5M + (size_t)2 * 32 * 3 * 65536 * 2;
constexpr size_t WS_W = WS_A16 + (size_t)2 * 32 * 2 * 64 * 2 * 4 > WS_S5 + (size_t)2 * MT * 512 * 4 ? WS_A16 + (size_t)2 * 32 * 2 * 64 * 2 * 4 : WS_S5 + (size_t)2 * MT * 512 * 4;
constexpr size_t WS_WIN = WS_W;
constexpr size_t WS_WMG = WS_WIN + (size_t)3072 * 1024 * 2;
constexpr size_t WS_WGLU = WS_WMG + (size_t)3072 * 1024 * 2;
constexpr size_t WS_WBR = WS_WGLU + (size_t)512 * 512 * 2;
constexpr size_t WS_WO = WS_WBR + (size_t)3 * 1024 * 512 * 2;
constexpr size_t WS_W13 = WS_WO + (size_t)1024 * 1024 * 2;
constexpr size_t WS_W2 = WS_W13 + (size_t)32 * 512 * 1024 * 2;
constexpr size_t WS_WSG = WS_W2 + (size_t)32 * 1024 * 256 * 2;
constexpr size_t WS_END = WS_WSG + (size_t)4 * 128 * 128 * 2;
static_assert(WS_END <= (size_t)377 * MiB, "workspace budget");
constexpr size_t WS_HS = WS_PROJ;
constexpr size_t WS_ACT = WS_YS;
constexpr size_t WS_YS2 = WS_YG;
static_assert(WS_HS + (size_t)MAXSLOT * 2048 <= WS_YS && WS_ACT + (size_t)MAXSLOT * 512 <= WS_YG && WS_YS2 + (size_t)MAXSLOT * 2048 <= WS_W, "moe overlays");
static_assert(WS_TSLOT + (size_t)MT * 8 <= WS_H, "ws map");
constexpr int CW_CNT = 64;
constexpr int CW_BAR = 4096;

constexpr int LDS_BYTES = 147456;
constexpr int MISC_OFF = 131072 + 320;
constexpr int TAB_OFF = 131072 + 1024;

__device__ __forceinline__ float bf2f(unsigned short b) { return __builtin_bit_cast(float, ((unsigned)b) << 16); }
__device__ __forceinline__ unsigned f2bf(float f) { unsigned u = __builtin_bit_cast(unsigned, f); return (u + 0x7fffu + ((u >> 16) & 1u)) >> 16; }
__device__ __forceinline__ unsigned pk2(float lo, float hi) { return f2bf(lo) | (f2bf(hi) << 16); }
__device__ __forceinline__ float sigmoidf_(float x) { return 1.f / (1.f + __expf(-x)); }
__device__ __forceinline__ float siluf_(float x) { return x / (1.f + __expf(-x)); }
__device__ __forceinline__ float geluf_(float x) { const float u = 0.7978845608028654f * (x + 0.044715f * x * x * x); return x / (1.f + __expf(-2.f * u)); }
__device__ __forceinline__ float wave_sum(float v) {
#pragma unroll
    for (int o = 1; o < 64; o <<= 1) v += __shfl_xor(v, o);
    return v;
}

#define XB_TMO      128
#define XB_XCNT(j)  (256  + 64 * (j))
#define XB_XSUB(j)  (1280 + 64 * (j))
#define XB_XGEN(j)  (2304 + 64 * (j))
#define XB_TOP      3328
#define XB_TOPGEN   3392
#define XCD_BAR_WORDS 3456
#define XB_SPIN_CAP (1u << 24)
__device__ __forceinline__ unsigned xb_ld(unsigned* p)              { return __hip_atomic_load(p, __ATOMIC_RELAXED, __HIP_MEMORY_SCOPE_AGENT); }
__device__ __forceinline__ unsigned xb_add(unsigned* p, unsigned v) { return __hip_atomic_fetch_add(p, v, __ATOMIC_RELAXED, __HIP_MEMORY_SCOPE_AGENT); }
__device__ __forceinline__ unsigned xb_xcc_id() { return (unsigned)__builtin_amdgcn_s_getreg((3 << 11) | 20) & 0xFu; }
#define XB_SPIN(cond, bar) do { unsigned _sp = 0; while (cond) { __builtin_amdgcn_s_sleep(1); \
    if ((++_sp & 255u) == 0u) { if (xb_ld(&(bar)[XB_TMO])) break; if (_sp > XB_SPIN_CAP) { atomicAdd(&(bar)[XB_TMO], 1u); break; } } } } while (0)
struct XcdBarrier { unsigned* bar; unsigned x; volatile LAS unsigned* st; };
__device__ __forceinline__ XcdBarrier xcd_barrier_post(unsigned* bar, volatile LAS unsigned* st) {
    XcdBarrier b; b.bar = bar; b.x = xb_xcc_id(); b.st = st;
    if (threadIdx.x == 0) (void)xb_add(&bar[XB_XCNT(b.x)], 1u);
    return b;
}
__device__ __forceinline__ void xcd_barrier_complete(unsigned* bar, unsigned x, unsigned& nloc, unsigned& nx) {
    const unsigned G = gridDim.x * gridDim.y * gridDim.z;
    unsigned sum, cnt, mine, sp = 0u;
    for (;;) {
        sum = 0u; cnt = 0u; mine = 0u;
#pragma unroll
        for (unsigned j = 0; j < 16; ++j) { const unsigned c = xb_ld(&bar[XB_XCNT(j)]); sum += c; cnt += (c > 0u) ? 1u : 0u; mine = (j == x) ? c : mine; }
        if (sum == G) break;
        __builtin_amdgcn_s_sleep(1);
        if ((++sp & 255u) == 0u) { if (xb_ld(&bar[XB_TMO])) break; if (sp > XB_SPIN_CAP) { atomicAdd(&bar[XB_TMO], 1u); break; } }
    }
    nloc = mine > 0u ? mine : 1u; nx = cnt > 0u ? cnt : 1u;
}
__device__ __forceinline__ void xcd_barrier(const XcdBarrier& b, bool leader) {
    asm volatile("s_waitcnt vmcnt(0)" ::: "memory");
    __syncthreads();
    if (leader) {
        unsigned* bar = b.bar;
        __builtin_amdgcn_s_waitcnt(0);
        unsigned nloc = b.st[0], nx = b.st[1];
        if (nloc == 0u) { xcd_barrier_complete(bar, b.x, nloc, nx); b.st[0] = nloc; b.st[1] = nx; }
        const unsigned old = xb_add(&bar[XB_XSUB(b.x)], 1u);
        const unsigned gen = old / nloc;
        if (old + 1u == (gen + 1u) * nloc) {
            __builtin_amdgcn_fence(__ATOMIC_RELEASE, "agent");
            asm volatile("s_waitcnt vmcnt(0)" ::: "memory");
            const unsigned og = xb_add(&bar[XB_TOP], 1u);
            const unsigned tg = og / nx;
            if (og + 1u == (tg + 1u) * nx) xb_add(&bar[XB_TOPGEN], 1u);
            else XB_SPIN(xb_ld(&bar[XB_TOPGEN]) == tg, bar);
            __builtin_amdgcn_fence(__ATOMIC_ACQUIRE, "agent");
            xb_add(&bar[XB_XGEN(b.x)], 1u);
            asm volatile("s_waitcnt vmcnt(0)" ::: "memory");
        } else {
            XB_SPIN(xb_ld(&bar[XB_XGEN(b.x)]) == gen, bar);
            __builtin_amdgcn_fence(__ATOMIC_ACQUIRE, "agent");
            asm volatile("s_waitcnt vmcnt(0)" ::: "memory");
        }
    }
    __syncthreads();
}

struct Args { const float* in[35]; float* out; unsigned char* ws; int ph_lo, ph_hi; };
struct Frame {
    LAS unsigned char* lds; unsigned char* ws; unsigned* ctl;
    int tid, lane, wave, bid, G;
    const unsigned long long LAS* tab; float* out;
};
__device__ __forceinline__ unsigned long long uni64(unsigned long long v) { const unsigned lo = __builtin_amdgcn_readfirstlane((unsigned)v), hi = __builtin_amdgcn_readfirstlane((unsigned)(v >> 32)); return ((unsigned long long)hi << 32) | lo; }
#define IN_(k) ((const float*)uni64(F.tab[k]))
enum { I_X = 0, I_C, I_CTX, I_CCTX, I_WADA, I_BADA, I_GMIX, I_GFFN, I_WIN, I_LRE, I_LIM, I_LDT, I_BRE, I_BIM, I_CRE, I_CIM, I_DSKIP, I_WGLU, I_SGG, I_SGB, I_WSG, I_BSG,
       I_WCONV, I_WBR, I_WMG, I_BMG, I_WO, I_WGRP, I_BGRP, I_WEXP, I_BEXP, I_W1, I_W3, I_W2, I_GF };

__device__ __forceinline__ const float* mod_ptr(const Frame& F, int l, int row) { return (const float*)(F.ws + WS_MOD) + (size_t)(l * 2 + (row >= SEQ ? 1 : 0)) * 6144; }
__device__ __forceinline__ const float* xsrc_row(const Frame& F, int l, int row) {
    if (l == 0) return row < SEQ ? IN_(I_X) + (size_t)row * D : IN_(I_CTX) + (size_t)(row - SEQ) * D;
    return row < SEQ ? F.out + (size_t)row * D : (const float*)(F.ws + WS_XC) + (size_t)(row - SEQ) * D;
}
__device__ __forceinline__ float* xrun_row(const Frame& F, int row) { return row < SEQ ? F.out + (size_t)row * D : (float*)(F.ws + WS_XC) + (size_t)(row - SEQ) * D; }


namespace pg8 {
#define PG8_LAS __attribute__((address_space(3)))
typedef unsigned short bf16_t;
typedef short bf16x8 __attribute__((ext_vector_type(8)));
typedef float f32x4 __attribute__((ext_vector_type(4)));
typedef unsigned u32x4 __attribute__((ext_vector_type(4)));
constexpr int BM = 256, BK = 64, HALF = 128, HTB = HALF * BK * 2  , STAGE_BYTES = 8 * HTB, NXCD = 8, WGM = 8;

__host__ __device__ __forceinline__ int lds_byte(int r, int c) { const int st = (r >> 4) * 2 + (c >> 5), rr = r & 15, cc = c & 31, ob = rr * 64 + cc * 2; return st * 1024 + (ob ^ (((ob >> 9) & 1) << 5)); }
__host__ __device__ __forceinline__ void stage_rc(int b, int& R, int& C) { const int st = b / 1024, sb = b % 1024, swz = sb ^ (((sb >> 9) & 1) << 5); R = (st >> 1) * 16 + swz / 64; C = (st & 1) * 32 + (swz % 64) / 2; }
__host__ __device__ __forceinline__ int perm32(int rho) { const int n = rho >> 4, i = rho & 15; return 8 * (i >> 2) + 4 * n + (i & 3); }

struct Unit { int pm, pn; };
struct Gemm { const bf16_t* A; const bf16_t* Bt; int M, N, K; };

struct StaticOrder {
    int nM, nN, nwg, G, c;
    __host__ __device__ void init(int M, int N, int G_, int c_) { nM = M / BM; nN = N / BM; nwg = nM * nN; G = G_; c = c_; }
    __host__ __device__ bool next(int i, Unit& u) const {
        const long L = (long)i * G + c; if (L >= nwg) return false;
        int wgid = (int)L; { const int q = nwg / NXCD, r = nwg % NXCD, xcd = wgid % NXCD, off = wgid / NXCD; wgid = (xcd < r ? xcd * (q + 1) : r * (q + 1) + (xcd - r) * q) + off; }
        const int nig = WGM * nN, gid = wgid / nig, fm = gid * WGM, gsz = (nM - fm) < WGM ? (nM - fm) : WGM;
        u.pm = fm + ((wgid % nig) % gsz); u.pn = (wgid % nig) / gsz; return true;
    }
    __device__ __forceinline__ void a_ready(const Unit&) const {}
    __device__ __forceinline__ void done(const Unit&) const {}
};
__device__ __forceinline__ unsigned cvt_pk_bf16(float lo, float hi) { unsigned r; asm volatile("v_cvt_pk_bf16_f32 %0, %1, %2" : "=v"(r) : "v"(lo), "v"(hi)); return r; }
template <class Epi, class Sched, bool ALIGN_EPI = false, bool SP2 = false>
__device__ __forceinline__ void gemm_phase(PG8_LAS unsigned char* lds, const Gemm g, const Sched& S, const Epi& E, int tid_in) {
    int tid_ = tid_in; asm volatile("" : "+v"(tid_));
    const int tid = tid_, wid = __builtin_amdgcn_readfirstlane(tid >> 6), lane = tid & 63, wr = wid >> 2, wc = wid & 3, fr = lane & 15, fq = lane >> 4;
    const int K = g.K, nt = K / BK;
    unsigned voffA[2], voffB[2];
#pragma unroll
    for (int i = 0; i < 2; ++i) { int R, C; stage_rc(tid * 16 + i * 8192, R, C); const int Rb = Epi::PERM ? ((R & ~31) + perm32(R & 31)) : R;
        voffA[i] = (unsigned)(R * K + C) * 2u; voffB[i] = (unsigned)(Rb * K + C) * 2u; }
    const size_t kstep = (size_t)(BK * 2);
    const size_t hstep = (size_t)HALF * K * 2;
    const size_t tstep = 2 * hstep;
    const unsigned ldsw = (unsigned)wid * 1024u;
    const int aoff = lds_byte(wr * 64 + fr, fq * 8), boff = lds_byte(wc * 32 + fr, fq * 8);
#define PG8_SA(b, h) (((b) * 2 + (h)) * HTB)
#define PG8_SB(b, h) ((4 + (b) * 2 + (h)) * HTB)
#define PG8_STAGE(bufoff, gbase, voff) do { _Pragma("unroll") for (int _i = 0; _i < 2; ++_i) \
        __builtin_amdgcn_global_load_lds((const unsigned*)((const char*)(gbase) + (voff)[_i]), (PG8_LAS unsigned*)(lds + (bufoff) + ldsw + _i * 8192), 16, 0, 0); } while (0)
#define PG8_LDA(dst, b, h) do { _Pragma("unroll") for (int m = 0; m < 4; ++m) _Pragma("unroll") for (int k = 0; k < 2; ++k) dst[m][k] = *(const PG8_LAS bf16x8*)(lds + PG8_SA(b, h) + aoff + m * 2048 + k * 1024); } while (0)
#define PG8_LDB(dst, b, h) do { _Pragma("unroll") for (int n = 0; n < 2; ++n) _Pragma("unroll") for (int k = 0; k < 2; ++k) dst[n][k] = *(const PG8_LAS bf16x8*)(lds + PG8_SB(b, h) + boff + n * 2048 + k * 1024); } while (0)
#define PG8_MMA(ai, bj, At, Bt) do { __builtin_amdgcn_s_setprio(1); _Pragma("unroll") for (int m = 0; m < 4; ++m) _Pragma("unroll") for (int n = 0; n < 2; ++n) _Pragma("unroll") for (int k = 0; k < 2; ++k) \
        acc[ai][bj][m][n] = __builtin_amdgcn_mfma_f32_16x16x32_bf16(Bt[n][k], At[m][k], acc[ai][bj][m][n], 0, 0, 0); __builtin_amdgcn_s_setprio(0); } while (0)
#define PG8_WAIT_V(n) asm volatile("s_waitcnt vmcnt(" #n ")" ::: "memory")
#define PG8_WAIT_L(n) asm volatile("s_waitcnt lgkmcnt(" #n ")" ::: "memory")
#define PG8_BAR __builtin_amdgcn_s_barrier()
#define PG8_SCHED __builtin_amdgcn_sched_barrier(0)
    Unit cur, nxt; int ui = 0;
    if (!S.next(0, cur)) return;
    f32x4 acc[2][2][4][2];
#pragma unroll
    for (int a = 0; a < 2; ++a)
#pragma unroll
        for (int b = 0; b < 2; ++b)
#pragma unroll
            for (int m = 0; m < 4; ++m)
#pragma unroll
                for (int n = 0; n < 2; ++n) acc[a][b][m][n] = (f32x4){0.f, 0.f, 0.f, 0.f};
    bf16x8 At[4][2], B0[2][2], B1[2][2];
    const char* cA = (const char*)g.A + (size_t)cur.pm * tstep; const char* cB = (const char*)g.Bt + (size_t)cur.pn * tstep;
    S.a_ready(cur);
    if constexpr (SP2) {
        PG8_STAGE(PG8_SB(0, 0), cB, voffB); PG8_STAGE(PG8_SB(0, 1), cB + hstep, voffB); PG8_STAGE(PG8_SA(0, 0), cA, voffA); PG8_STAGE(PG8_SA(0, 1), cA + hstep, voffA);
        if (wr == 1) PG8_BAR;
        PG8_WAIT_V(2); PG8_BAR;
        PG8_STAGE(PG8_SB(1, 0), cB + kstep, voffB); PG8_STAGE(PG8_SA(1, 0), cA + kstep, voffA); PG8_STAGE(PG8_SB(1, 1), cB + hstep + kstep, voffB);
        PG8_WAIT_V(6); PG8_BAR;
    } else {
        PG8_STAGE(PG8_SB(0, 0), cB, voffB); PG8_STAGE(PG8_SA(0, 0), cA, voffA); PG8_STAGE(PG8_SB(0, 1), cB + hstep, voffB); PG8_STAGE(PG8_SA(0, 1), cA + hstep, voffA);
        if (wr == 1) PG8_BAR;
        PG8_WAIT_V(4); PG8_BAR;
        PG8_STAGE(PG8_SB(1, 0), cB + kstep, voffB); PG8_STAGE(PG8_SA(1, 0), cA + kstep, voffA); PG8_STAGE(PG8_SB(1, 1), cB + hstep + kstep, voffB);
        PG8_WAIT_V(6); PG8_BAR;
    }
    for (;;) {
        const bool has_next = S.next(ui + 1, nxt);
        const char* nA = has_next ? (const char*)g.A + (size_t)nxt.pm * tstep : cA; const char* nB = has_next ? (const char*)g.Bt + (size_t)nxt.pn * tstep : cB;
#pragma unroll 1
        for (int t = 0; t < nt; t += 2) {
            const bool last = (t == nt - 2);
            const char* a1 = cA + (size_t)(t + 1) * kstep;
            const char* a2 = last ? nA : cA + (size_t)(t + 2) * kstep; const char* b2 = last ? nB : cB + (size_t)(t + 2) * kstep;
            const char* a3 = a2 + kstep; const char* b3 = b2 + kstep;
            if (last && has_next) S.a_ready(nxt);
            if constexpr (SP2) {
            PG8_LDB(B0, 0, 0); PG8_LDB(B1, 0, 1); PG8_SCHED; PG8_LDA(At, 0, 0); PG8_STAGE(PG8_SA(1, 1), a1 + hstep, voffA);
            PG8_WAIT_V(8); PG8_WAIT_L(0); PG8_BAR; PG8_MMA(0, 0, At, B0); PG8_MMA(0, 1, At, B1); PG8_BAR; PG8_SCHED;
            PG8_LDA(At, 0, 1); PG8_STAGE(PG8_SB(0, 0), b2, voffB); PG8_STAGE(PG8_SB(0, 1), b2 + hstep, voffB); PG8_STAGE(PG8_SA(0, 0), a2, voffA);
            PG8_WAIT_V(8); PG8_WAIT_L(0); PG8_BAR; PG8_MMA(1, 0, At, B0); PG8_MMA(1, 1, At, B1); PG8_BAR; PG8_SCHED;
            PG8_LDB(B0, 1, 0); PG8_LDB(B1, 1, 1); PG8_SCHED; PG8_LDA(At, 1, 0); PG8_STAGE(PG8_SA(0, 1), a2 + hstep, voffA);
            PG8_WAIT_V(8); PG8_WAIT_L(0); PG8_BAR; PG8_MMA(0, 0, At, B0); PG8_MMA(0, 1, At, B1); PG8_BAR; PG8_SCHED;
            PG8_LDA(At, 1, 1); PG8_STAGE(PG8_SB(1, 0), b3, voffB); PG8_STAGE(PG8_SB(1, 1), b3 + hstep, voffB); PG8_STAGE(PG8_SA(1, 0), a3, voffA);
            PG8_WAIT_V(8); PG8_WAIT_L(0); PG8_BAR; PG8_MMA(1, 0, At, B0); PG8_MMA(1, 1, At, B1); PG8_BAR; PG8_SCHED;
            } else {
            PG8_LDB(B0, 0, 0); PG8_SCHED; PG8_LDA(At, 0, 0); PG8_STAGE(PG8_SA(1, 1), a1 + hstep, voffA);
            PG8_WAIT_L(8); PG8_BAR; PG8_WAIT_L(0); PG8_MMA(0, 0, At, B0); PG8_BAR; PG8_SCHED;
            PG8_LDB(B1, 0, 1); PG8_STAGE(PG8_SB(0, 0), b2, voffB);
            PG8_BAR; PG8_WAIT_L(0); PG8_MMA(0, 1, At, B1); PG8_BAR;
            PG8_LDA(At, 0, 1); PG8_STAGE(PG8_SA(0, 0), a2, voffA);
            PG8_BAR; PG8_WAIT_L(0); PG8_MMA(1, 0, At, B0); PG8_BAR; PG8_SCHED;
            PG8_STAGE(PG8_SB(0, 1), b2 + hstep, voffB);
            PG8_WAIT_V(6); PG8_BAR; PG8_MMA(1, 1, At, B1); PG8_BAR;
            PG8_LDB(B0, 1, 0); PG8_SCHED; PG8_LDA(At, 1, 0); PG8_STAGE(PG8_SA(0, 1), a2 + hstep, voffA);
            PG8_WAIT_L(8); PG8_BAR; PG8_WAIT_L(0); PG8_MMA(0, 0, At, B0); PG8_BAR; PG8_SCHED;
            PG8_LDB(B1, 1, 1); PG8_STAGE(PG8_SB(1, 0), b3, voffB);
            PG8_BAR; PG8_WAIT_L(0); PG8_MMA(0, 1, At, B1); PG8_BAR;
            PG8_LDA(At, 1, 1); PG8_STAGE(PG8_SA(1, 0), a3, voffA);
            PG8_BAR; PG8_WAIT_L(0); PG8_MMA(1, 0, At, B0); PG8_BAR; PG8_SCHED;
            PG8_STAGE(PG8_SB(1, 1), b3 + hstep, voffB);
            PG8_WAIT_V(6); PG8_BAR; PG8_MMA(1, 1, At, B1); PG8_BAR;
            }
        }
        if constexpr (ALIGN_EPI) { if (wr == 0) PG8_BAR; }
        if constexpr (!Epi::AFTER_DRAIN) { E(acc, cur, wr, wc, fr, fq); S.done(cur); }
        if (!has_next) break;
#pragma unroll
        for (int a = 0; a < 2; ++a)
#pragma unroll
            for (int b = 0; b < 2; ++b)
#pragma unroll
                for (int m = 0; m < 4; ++m)
#pragma unroll
                    for (int n = 0; n < 2; ++n) acc[a][b][m][n] = (f32x4){0.f, 0.f, 0.f, 0.f};
        cur = nxt; cA = nA; cB = nB; ++ui;
        if constexpr (ALIGN_EPI) { if (wr == 1) PG8_BAR; }
    }
    PG8_WAIT_V(0);
    if constexpr (!ALIGN_EPI) { if (wr == 0) PG8_BAR; }
    PG8_BAR;
    if constexpr (Epi::AFTER_DRAIN) { E.fused(acc, cur, wr, wc, fr, fq, lds, wid, lane); S.done(cur); }
#undef PG8_SA
#undef PG8_SB
#undef PG8_STAGE
#undef PG8_LDA
#undef PG8_LDB
#undef PG8_MMA
#undef PG8_WAIT_V
#undef PG8_WAIT_L
#undef PG8_BAR
#undef PG8_SCHED
}
}

constexpr bool PG_ALIGN = true, PG_SP2 = true;
__device__ __forceinline__ float bflo(unsigned w) { return __builtin_bit_cast(float, w << 16); }
__device__ __forceinline__ float bfhi(unsigned w) { return __builtin_bit_cast(float, w & 0xffff0000u); }
__device__ __forceinline__ unsigned cvtpk(float lo, float hi) { return pg8::cvt_pk_bf16(lo, hi); }

__device__ __forceinline__ void transpose_item(const float* W, int N, int k0, int n0, bf16* WT, int K, size_t dst_row0, LAS float* scr, int lane) {
#pragma unroll 8
    for (int i = 0; i < 32; ++i) { const int kk = 2 * i + (lane >> 5); scr[kk * 33 + (lane & 31)] = W[(size_t)(k0 + kk) * N + n0 + (lane & 31)]; }
    asm volatile("s_waitcnt lgkmcnt(0)" ::: "memory");
    const int c = lane & 7;
#pragma unroll
    for (int j = 0; j < 4; ++j) { const int n = (lane >> 3) + 8 * j; const LAS float* s = scr + (8 * c) * 33 + n;
        v4u o; o.x = pk2(s[0 * 33], s[1 * 33]); o.y = pk2(s[2 * 33], s[3 * 33]); o.z = pk2(s[4 * 33], s[5 * 33]); o.w = pk2(s[6 * 33], s[7 * 33]);
        *(v4u*)(WT + (dst_row0 + n) * K + k0 + 8 * c) = o; }
    asm volatile("s_waitcnt lgkmcnt(0)" ::: "memory");
}
__device__ __forceinline__ void convert_weights(Frame& F, int l) {
    LAS float* scr = (LAS float*)(F.lds + F.wave * 16384);
    const int gw = F.bid * (NT / 64) + F.wave, ngw = F.G * (NT / 64);
    constexpr int I_IN = 16 * 96, I_MG = 16 * 96, I_GLU = 8 * 16, I_BR = 3 * 8 * 32, I_O = 16 * 32, I_1 = 32 * 16 * 8, I_3 = I_1, I_2 = 32 * 4 * 32;
    constexpr int NITEMS = I_IN + I_MG + I_GLU + I_BR + I_O + I_1 + I_3 + I_2;
    for (int it = gw; it < NITEMS; it += ngw) {
        int r = it;
        if (r < I_IN) { const int kb = r / 96, nb = r % 96; transpose_item(IN_(I_WIN) + (size_t)l * D * INW, INW, 64 * kb, 32 * nb, (bf16*)(F.ws + WS_WIN), 1024, 32 * nb, scr, F.lane); continue; } r -= I_IN;
        if (r < I_MG) { const int kb = r / 96, nb = r % 96; transpose_item(IN_(I_WMG) + (size_t)l * D * INW, INW, 64 * kb, 32 * nb, (bf16*)(F.ws + WS_WMG), 1024, 32 * nb, scr, F.lane); continue; } r -= I_MG;
        if (r < I_GLU) { const int kb = r / 16, nb = r % 16; transpose_item(IN_(I_WGLU) + (size_t)l * MIXW * MIXW, MIXW, 64 * kb, 32 * nb, (bf16*)(F.ws + WS_WGLU), 512, 32 * nb, scr, F.lane); continue; } r -= I_GLU;
        if (r < I_BR) { const int kk = r / 256, q = r % 256, kb = q / 32, nb = q % 32; transpose_item(IN_(I_WBR) + ((size_t)l * 3 + kk) * MIXW * D, D, 64 * kb, 32 * nb, (bf16*)(F.ws + WS_WBR), 512, (size_t)kk * 1024 + 32 * nb, scr, F.lane); continue; } r -= I_BR;
        if (r < I_O) { const int kb = r / 32, nb = r % 32; transpose_item(IN_(I_WO) + (size_t)l * D * D, D, 64 * kb, 32 * nb, (bf16*)(F.ws + WS_WO), 1024, 32 * nb, scr, F.lane); continue; } r -= I_O;
        if (r < I_1 + I_3) { const int which = r / I_1, q = r % I_1, e = q / 128, q2 = q % 128, kb = q2 / 8, nb = q2 % 8;
            const float* W = IN_(which ? I_W3 : I_W1) + ((size_t)l * NE + e) * D * DFF; const int n0 = 32 * nb;
            transpose_item(W, DFF, 64 * kb, n0, (bf16*)(F.ws + WS_W13), 1024, (size_t)e * 512 + (n0 / 128) * 256 + which * 128 + (n0 % 128), scr, F.lane); continue; } r -= I_1 + I_3;
        { const int e = r / 128, q = r % 128, kb = q / 32, nb = q % 32; transpose_item(IN_(I_W2) + ((size_t)l * NE + e) * DFF * D, D, 64 * kb, 32 * nb, (bf16*)(F.ws + WS_W2), 256, (size_t)e * 1024 + 32 * nb, scr, F.lane); }
    }
    { const float* s = IN_(I_WSG) + (size_t)l * 4 * 128 * 128; bf16* d = (bf16*)(F.ws + WS_WSG);
      for (int i = (F.bid * NT + F.tid) * 2; i < 4 * 128 * 128; i += F.G * NT * 2) *(unsigned*)(d + i) = pk2(s[i], s[i + 1]); }
}

struct EpiProj { static constexpr bool PERM = true, AFTER_DRAIN = false; bf16* O;
    __device__ __forceinline__ void operator()(const pg8::f32x4 (&acc)[2][2][4][2], const pg8::Unit& u, int wr, int wc, int fr, int fq) const {
        const int row0 = u.pm * 256 + wr * 64 + fr, col0 = u.pn * 256 + wc * 32 + 8 * fq; const bool act = (u.pn >= 2 && u.pn < 6);
#pragma unroll
        for (int ai = 0; ai < 2; ++ai)
#pragma unroll
            for (int m = 0; m < 4; ++m) { bf16* rowp = O + (size_t)(row0 + ai * 128 + m * 16) * INW + col0;
#pragma unroll
                for (int bj = 0; bj < 2; ++bj) { pg8::f32x4 v0 = acc[ai][bj][m][0], v1 = acc[ai][bj][m][1];
                    if (act) {
#pragma unroll
                        for (int j = 0; j < 4; ++j) { v0[j] = geluf_(v0[j]); v1[j] = geluf_(v1[j]); } }
                    v4u w; w.x = cvtpk(v0[0], v0[1]); w.y = cvtpk(v0[2], v0[3]); w.z = cvtpk(v1[0], v1[1]); w.w = cvtpk(v1[2], v1[3]); *(v4u*)(rowp + bj * 128) = w; } }
    } };
struct EpiGlu { static constexpr bool PERM = true, AFTER_DRAIN = false; const bf16* YG; bf16* YA;
    __device__ __forceinline__ void operator()(const pg8::f32x4 (&acc)[2][2][4][2], const pg8::Unit& u, int wr, int wc, int fr, int fq) const {
        const int row0 = u.pm * 256 + wr * 64 + fr, col0 = u.pn * 256 + wc * 32 + 8 * fq;
#pragma unroll
        for (int ai = 0; ai < 2; ++ai)
#pragma unroll
            for (int m = 0; m < 4; ++m) { const size_t off = (size_t)(row0 + ai * 128 + m * 16) * MIXW + col0;
#pragma unroll
                for (int bj = 0; bj < 2; ++bj) { const pg8::f32x4 v0 = acc[ai][bj][m][0], v1 = acc[ai][bj][m][1]; const v4u g = *(const v4u*)(YG + off + bj * 128);
                    v4u w; w.x = cvtpk(bflo(g.x) * sigmoidf_(v0[0]), bfhi(g.x) * sigmoidf_(v0[1])); w.y = cvtpk(bflo(g.y) * sigmoidf_(v0[2]), bfhi(g.y) * sigmoidf_(v0[3]));
                    w.z = cvtpk(bflo(g.z) * sigmoidf_(v1[0]), bfhi(g.z) * sigmoidf_(v1[1])); w.w = cvtpk(bflo(g.w) * sigmoidf_(v1[2]), bfhi(g.w) * sigmoidf_(v1[3])); *(v4u*)(YA + off + bj * 128) = w; } }
    } };
struct EpiBr { static constexpr bool PERM = true, AFTER_DRAIN = false; bf16* BR;
    __device__ __forceinline__ void operator()(const pg8::f32x4 (&acc)[2][2][4][2], const pg8::Unit& u, int wr, int wc, int fr, int fq) const {
        const int pm = u.pm % (MT / 256); const int row0 = pm * 256 + wr * 64 + fr, col0 = u.pn * 256 + wc * 32 + 8 * fq;
#pragma unroll
        for (int ai = 0; ai < 2; ++ai)
#pragma unroll
            for (int m = 0; m < 4; ++m) { bf16* rowp = BR + (size_t)(row0 + ai * 128 + m * 16) * INW + col0;
#pragma unroll
                for (int bj = 0; bj < 2; ++bj) { const pg8::f32x4 v0 = acc[ai][bj][m][0], v1 = acc[ai][bj][m][1];
                    v4u w; w.x = cvtpk(v0[0], v0[1]); w.y = cvtpk(v0[2], v0[3]); w.z = cvtpk(v1[0], v1[1]); w.w = cvtpk(v1[2], v1[3]); *(v4u*)(rowp + bj * 128) = w; } }
    } };
struct SchedBr { int G, c, nM;
    __device__ __forceinline__ bool next(int i, pg8::Unit& u) const { const int Lq = i * G + c; if (Lq >= 3 * nM * 4) return false; const int k = Lq / (nM * 4), r = Lq % (nM * 4);
        u.pm = k * (MT / 256) + r / 4; u.pn = k * 4 + r % 4; return true; }
    __device__ __forceinline__ void a_ready(const pg8::Unit&) const {}
    __device__ __forceinline__ void done(const pg8::Unit&) const {} };
struct EpiMerge { static constexpr bool PERM = true, AFTER_DRAIN = false; const bf16* BR; bf16* PM; const float* bm;
    __device__ __forceinline__ void operator()(const pg8::f32x4 (&acc)[2][2][4][2], const pg8::Unit& u, int wr, int wc, int fr, int fq) const {
        const int k = u.pn >> 2, dt = u.pn & 3; const int row0 = u.pm * 256 + wr * 64 + fr, col0 = dt * 256 + wc * 32 + 8 * fq;
#pragma unroll
        for (int bj = 0; bj < 2; ++bj) { const pg8::f32x4 b0 = *(const pg8::f32x4*)(bm + k * 1024 + col0 + bj * 128), b1 = *(const pg8::f32x4*)(bm + k * 1024 + col0 + bj * 128 + 4);
#pragma unroll
            for (int ai = 0; ai < 2; ++ai)
#pragma unroll
                for (int m = 0; m < 4; ++m) { const size_t r = (size_t)(row0 + ai * 128 + m * 16); const v4u br = *(const v4u*)(BR + r * INW + k * 1024 + col0 + bj * 128);
                    const pg8::f32x4 v0 = acc[ai][bj][m][0] + b0, v1 = acc[ai][bj][m][1] + b1;
                    float p[8] = {sigmoidf_(v0[0]) * bflo(br.x), sigmoidf_(v0[1]) * bfhi(br.x), sigmoidf_(v0[2]) * bflo(br.y), sigmoidf_(v0[3]) * bfhi(br.y),
                                  sigmoidf_(v1[0]) * bflo(br.z), sigmoidf_(v1[1]) * bfhi(br.z), sigmoidf_(v1[2]) * bflo(br.w), sigmoidf_(v1[3]) * bfhi(br.w)};
                    bf16* dst = PM + r * D + col0 + bj * 128;
                    if (k > 0) { const v4u o = *(const v4u*)dst; p[0] += bflo(o.x); p[1] += bfhi(o.x); p[2] += bflo(o.y); p[3] += bfhi(o.y); p[4] += bflo(o.z); p[5] += bfhi(o.z); p[6] += bflo(o.w); p[7] += bfhi(o.w); }
                    v4u w; w.x = cvtpk(p[0], p[1]); w.y = cvtpk(p[2], p[3]); w.z = cvtpk(p[4], p[5]); w.w = cvtpk(p[6], p[7]); *(v4u*)dst = w; } }
    } };
struct SchedMerge { int G, c, nM;
    __device__ __forceinline__ bool next(int i, pg8::Unit& u) const { const int v = (i / 3) * G + c, k = i % 3; if (v >= nM * 4) return false; u.pm = v >> 2; u.pn = k * 4 + (v & 3); return true; }
    __device__ __forceinline__ void a_ready(const pg8::Unit&) const {}
    __device__ __forceinline__ void done(const pg8::Unit&) const {} };
struct EpiWo { static constexpr bool PERM = false, AFTER_DRAIN = false; const float* xs_lat; const float* xs_ctx; float* out; float* xc; const float* mod_l;
    __device__ __forceinline__ void operator()(const pg8::f32x4 (&acc)[2][2][4][2], const pg8::Unit& u, int wr, int wc, int fr, int fq) const {
        const int row0 = u.pm * 256 + wr * 64 + fr, col0 = u.pn * 256 + wc * 32 + 4 * fq; const bool isctx = u.pm >= SEQ / 256;
        const float* ga = mod_l + (isctx ? 6144 : 0) + 2048;
#pragma unroll
        for (int ai = 0; ai < 2; ++ai)
#pragma unroll
            for (int m = 0; m < 4; ++m) { const int row = row0 + ai * 128 + m * 16; const size_t off = (size_t)(isctx ? row - SEQ : row) * D + col0;
                const float* src = (isctx ? xs_ctx : xs_lat) + off; float* dst = (isctx ? xc : out) + off;
#pragma unroll
                for (int bj = 0; bj < 2; ++bj)
#pragma unroll
                    for (int n = 0; n < 2; ++n) { const pg8::f32x4 g = *(const pg8::f32x4*)(ga + col0 + bj * 128 + n * 16); const pg8::f32x4 x = *(const pg8::f32x4*)(src + bj * 128 + n * 16);
                        *(pg8::f32x4*)(dst + bj * 128 + n * 16) = x + g * acc[ai][bj][m][n]; } }
    } };
constexpr int MOETAB_OFF = 131072 + 2048;
template <int NPN> __device__ __forceinline__ int moe_build_table(Frame& F, const unsigned* cnt) {
    LAS unsigned* tabw = (LAS unsigned*)(F.lds + MOETAB_OFF);
    int total = 0, rowtile0 = 0;
    for (int e = 0; e < NE; ++e) { const int nt_e = ((int)cnt[e] + 255) >> 8;
        for (int q = F.tid; q < nt_e * NPN; q += NT) tabw[total + q] = ((unsigned)(rowtile0 + q / NPN) << 16) | (unsigned)(e * NPN + q % NPN);
        total += nt_e * NPN; rowtile0 += nt_e; }
    __syncthreads();
    return total;
}
struct SchedMoe { int G, c, total; const LAS unsigned* tabw;
    __device__ __forceinline__ bool next(int i, pg8::Unit& u) const { const int Lq = i * G + c; if (Lq >= total) return false; const unsigned w = (unsigned)__builtin_amdgcn_readfirstlane((int)tabw[Lq]); u.pm = (int)(w >> 16); u.pn = (int)(w & 0xffffu); return true; }
    __device__ __forceinline__ void a_ready(const pg8::Unit&) const {}
    __device__ __forceinline__ void done(const pg8::Unit&) const {} };
struct EpiUp { static constexpr bool PERM = true, AFTER_DRAIN = false; bf16* ACT; const float* SW;
    __device__ __forceinline__ void operator()(const pg8::f32x4 (&acc)[2][2][4][2], const pg8::Unit& u, int wr, int wc, int fr, int fq) const {
        const int row0 = u.pm * 256 + wr * 64 + fr, f0 = (u.pn & 1) * 128 + wc * 32 + 8 * fq;
#pragma unroll
        for (int ai = 0; ai < 2; ++ai)
#pragma unroll
            for (int m = 0; m < 4; ++m) { const int slot = row0 + ai * 128 + m * 16; const float w = SW[slot];
                const pg8::f32x4 a0 = acc[ai][0][m][0], a1 = acc[ai][0][m][1], b0 = acc[ai][1][m][0], b1 = acc[ai][1][m][1];
                v4u o; o.x = cvtpk(siluf_(a0[0]) * b0[0] * w, siluf_(a0[1]) * b0[1] * w); o.y = cvtpk(siluf_(a0[2]) * b0[2] * w, siluf_(a0[3]) * b0[3] * w);
                o.z = cvtpk(siluf_(a1[0]) * b1[0] * w, siluf_(a1[1]) * b1[1] * w); o.w = cvtpk(siluf_(a1[2]) * b1[2] * w, siluf_(a1[3]) * b1[3] * w);
                *(v4u*)(ACT + (size_t)slot * DFF + f0) = o; }
    } };
struct EpiDown { static constexpr bool PERM = true, AFTER_DRAIN = false; bf16* YS2;
    __device__ __forceinline__ void operator()(const pg8::f32x4 (&acc)[2][2][4][2], const pg8::Unit& u, int wr, int wc, int fr, int fq) const {
        const int row0 = u.pm * 256 + wr * 64 + fr, col0 = (u.pn & 3) * 256 + wc * 32 + 8 * fq;
#pragma unroll
        for (int ai = 0; ai < 2; ++ai)
#pragma unroll
            for (int m = 0; m < 4; ++m) { bf16* rowp = YS2 + (size_t)(row0 + ai * 128 + m * 16) * D + col0;
#pragma unroll
                for (int bj = 0; bj < 2; ++bj) { const pg8::f32x4 v0 = acc[ai][bj][m][0], v1 = acc[ai][bj][m][1];
                    v4u w; w.x = cvtpk(v0[0], v0[1]); w.y = cvtpk(v0[2], v0[3]); w.z = cvtpk(v1[0], v1[1]); w.w = cvtpk(v1[2], v1[3]); *(v4u*)(rowp + bj * 128) = w; } }
    } };

__device__ __forceinline__ void ph2_fast(Frame& F, int l) {
    pg8::Gemm g{(const bf16*)(F.ws + WS_H), (const bf16*)(F.ws + WS_WIN), MT, INW, D}; pg8::StaticOrder S; S.init(MT, INW, F.G, F.bid);
    EpiProj E{(bf16*)(F.ws + WS_PROJ)}; pg8::gemm_phase<EpiProj, pg8::StaticOrder, PG_ALIGN, PG_SP2>(F.lds, g, S, E, F.tid);
}
__device__ __forceinline__ void ph6_fast(Frame& F, int l) {
    pg8::Gemm g{(const bf16*)(F.ws + WS_YG), (const bf16*)(F.ws + WS_WGLU), MT, MIXW, MIXW}; pg8::StaticOrder S; S.init(l == 0 ? MT : SEQ, MIXW, F.G, F.bid);
    EpiGlu E{(const bf16*)(F.ws + WS_YG), (bf16*)(F.ws + WS_YS)}; pg8::gemm_phase<EpiGlu, pg8::StaticOrder, PG_ALIGN, PG_SP2>(F.lds, g, S, E, F.tid);
}
__device__ __forceinline__ void ph7_fast(Frame& F, int l) {
    pg8::Gemm g{(const bf16*)(F.ws + WS_YS), (const bf16*)(F.ws + WS_WBR), 3 * MT, 3 * D, MIXW}; SchedBr S{F.G, F.bid, l == 0 ? MT / 256 : SEQ / 256};
    EpiBr E{(bf16*)(F.ws + WS_PROJ)}; pg8::gemm_phase<EpiBr, SchedBr, PG_ALIGN, PG_SP2>(F.lds, g, S, E, F.tid);
}
__device__ __forceinline__ void ph8_fast(Frame& F, int l) {
    pg8::Gemm g{(const bf16*)(F.ws + WS_H), (const bf16*)(F.ws + WS_WMG), MT, INW, D}; SchedMerge S{F.G, F.bid, l == 0 ? MT / 256 : SEQ / 256};
    EpiMerge E{(const bf16*)(F.ws + WS_PROJ), (bf16*)(F.ws + WS_PM), IN_(I_BMG) + l * INW}; pg8::gemm_phase<EpiMerge, SchedMerge, PG_ALIGN, PG_SP2>(F.lds, g, S, E, F.tid);
}
__device__ __forceinline__ void ph9_fast(Frame& F, int l) {
    pg8::Gemm g{(const bf16*)(F.ws + WS_PM), (const bf16*)(F.ws + WS_WO), MT, D, D}; pg8::StaticOrder S; S.init(l == 0 ? MT : SEQ, D, F.G, F.bid);
    EpiWo E{l == 0 ? IN_(I_X) : F.out, l == 0 ? IN_(I_CTX) : (const float*)(F.ws + WS_XC), F.out, (float*)(F.ws + WS_XC), (const float*)(F.ws + WS_MOD) + (size_t)l * 2 * 6144};
    pg8::gemm_phase<EpiWo, pg8::StaticOrder, PG_ALIGN, PG_SP2>(F.lds, g, S, E, F.tid);
}
__device__ __forceinline__ void ph12_fast(Frame& F, int l) {
    pg8::Gemm g{(const bf16*)(F.ws + WS_HS), (const bf16*)(F.ws + WS_W13), MAXSLOT, NE * 512, D}; const int total = moe_build_table<2>(F, F.ctl + CW_CNT + l * 128); SchedMoe S{F.G, F.bid, total, (const LAS unsigned*)(F.lds + MOETAB_OFF)};
    EpiUp E{(bf16*)(F.ws + WS_ACT), (const float*)(F.ws + WS_SW)}; pg8::gemm_phase<EpiUp, SchedMoe, PG_ALIGN, PG_SP2>(F.lds, g, S, E, F.tid);
}
__device__ __forceinline__ void ph13_fast(Frame& F, int l) {
    pg8::Gemm g{(const bf16*)(F.ws + WS_ACT), (const bf16*)(F.ws + WS_W2), MAXSLOT, NE * D, DFF}; const int total = moe_build_table<4>(F, F.ctl + CW_CNT + l * 128); SchedMoe S{F.G, F.bid, total, (const LAS unsigned*)(F.lds + MOETAB_OFF)};
    EpiDown E{(bf16*)(F.ws + WS_YS2)}; pg8::gemm_phase<EpiDown, SchedMoe, PG_ALIGN, PG_SP2>(F.lds, g, S, E, F.tid);
}


typedef short bf16x8 __attribute__((ext_vector_type(8)));
constexpr int NSB = MT / 16;
__device__ __forceinline__ void s5_precompute(Frame& F) {
    LAS float* APr = (LAS float*)F.lds; LAS float* APi = APr + 2176; LAS float* BBr = APi + 2176; LAS float* BBi = BBr + 2048; LAS float* CCr = BBi + 2048; LAS float* CCi = CCr + 2048; LAS float* KK = CCi + 2048;
    for (int item = F.bid; item < 2 * G5; item += F.G) { const int l = item >> 5, g = item & 31;
        __syncthreads();
        if (F.tid < 128) { const int d = F.tid >> 6, p = F.tid & 63; const int ldg = (l * 2 + d) * G5 + g;
            const double lr = IN_(I_LRE)[ldg * P5 + p], li = IN_(I_LIM)[ldg * P5 + p], dt = exp((double)IN_(I_LDT)[ldg]);
            for (int e = 0; e <= 16; ++e) { const double m = exp(lr * dt * e), ang = li * dt * e; APr[(d * 64 + p) * 17 + e] = (float)(m * cos(ang)); APi[(d * 64 + p) * 17 + e] = (float)(m * sin(ang)); }
            { const double m16 = exp(lr * dt * 16.0), a16 = li * dt * 16.0; float* A16 = (float*)(F.ws + WS_A16) + ((size_t)((l * 32 + g) * 2 + d) * 64 + p) * 2; A16[0] = (float)(m16 * cos(a16)); A16[1] = (float)(m16 * sin(a16)); }
            const double m1 = exp(lr * dt), ar = m1 * cos(li * dt), ai = m1 * sin(li * dt); const double nr = ar - 1.0, ni = ai, den = lr * lr + li * li;
            const double qr = (nr * lr + ni * li) / den, qi = (ni * lr - nr * li) / den;
            for (int h = 0; h < 16; ++h) { const double x = IN_(I_BRE)[((size_t)ldg * P5 + p) * H5 + h], y = IN_(I_BIM)[((size_t)ldg * P5 + p) * H5 + h];
                BBr[(d * 64 + p) * 16 + h] = (float)(qr * x - qi * y); BBi[(d * 64 + p) * 16 + h] = (float)(qr * y + qi * x);
                CCr[(d * 16 + h) * 64 + p] = IN_(I_CRE)[((size_t)ldg * H5 + h) * P5 + p]; CCi[(d * 16 + h) * 64 + p] = IN_(I_CIM)[((size_t)ldg * H5 + h) * P5 + p]; } }
        __syncthreads();
        for (int idx = F.tid; idx < 8192; idx += NT) { const int d = idx >> 12, e = (idx >> 8) & 15, h = (idx >> 4) & 15, hp = idx & 15; float a = 0.f;
            for (int p = 0; p < 64; ++p) { const float pr = APr[(d * 64 + p) * 17 + e], pi = APi[(d * 64 + p) * 17 + e], br = BBr[(d * 64 + p) * 16 + hp], bi = BBi[(d * 64 + p) * 16 + hp];
                const float wr = pr * br - pi * bi, wi = pr * bi + pi * br; a += CCr[(d * 16 + h) * 64 + p] * wr - CCi[(d * 16 + h) * 64 + p] * wi; }
            KK[idx] = a; }
        __syncthreads();
        bf16* M = (bf16*)(F.ws + WS_S5M) + (size_t)(l * 32 + g) * 3 * 65536;
        for (int idx = F.tid; idx < 32768; idx += NT) {
            const int r = idx >> 7, k0 = (idx & 127) * 2; float v[3][2];
#pragma unroll
            for (int q = 0; q < 2; ++q) { const int kk = k0 + q;
                { const int d = r >> 7, p = (r >> 1) & 63, c = r & 1, sg = kk >> 4, hp = kk & 15, e = d == 0 ? 15 - sg : sg;
                  const float pr = APr[(d * 64 + p) * 17 + e], pi = APi[(d * 64 + p) * 17 + e], br = BBr[(d * 64 + p) * 16 + hp], bi = BBi[(d * 64 + p) * 16 + hp];
                  v[0][q] = c == 0 ? pr * br - pi * bi : pr * bi + pi * br; }
                { const int tau = r >> 4, h = r & 15, sg = kk >> 4, hp = kk & 15; float t = 0.f;
                  if (sg <= tau) t += KK[(0 * 16 + (tau - sg)) * 256 + h * 16 + hp]; if (sg >= tau) t += KK[(1 * 16 + (sg - tau)) * 256 + h * 16 + hp]; v[1][q] = t; }
                { const int tau = r >> 4, h = r & 15, d = kk >> 7, p = (kk >> 1) & 63, c = kk & 1, e = d == 0 ? tau + 1 : 16 - tau;
                  const float cr = CCr[(d * 16 + h) * 64 + p], ci = CCi[(d * 16 + h) * 64 + p], pr = APr[(d * 64 + p) * 17 + e], pi = APi[(d * 64 + p) * 17 + e];
                  v[2][q] = c == 0 ? cr * pr - ci * pi : -(cr * pi + ci * pr); } }
#pragma unroll
            for (int m = 0; m < 3; ++m) *(unsigned*)(M + (size_t)m * 65536 + r * 256 + k0) = pk2(v[m][0], v[m][1]);
        }
    }
}
__device__ __forceinline__ void s5_z_phase(Frame& F, int l) {
    const bf16* PROJ = (const bf16*)(F.ws + WS_PROJ); float* Z = (float*)(F.ws + WS_Z);
    const int l15 = F.lane & 15, lq = F.lane >> 4;
    for (int item = F.bid; item < 256; item += F.G) {
        const int g = item >> 3, part = item & 7; const bf16* Fm = (const bf16*)(F.ws + WS_S5M) + (size_t)(l * 32 + g) * 3 * 65536;
        bf16x8 Af[2][8];
#pragma unroll
        for (int j = 0; j < 2; ++j)
#pragma unroll
            for (int ks = 0; ks < 8; ++ks) Af[j][ks] = *(const bf16x8*)(Fm + (size_t)(16 * (2 * F.wave + j) + l15) * 256 + 32 * ks + 8 * lq);
#pragma unroll 1
        for (int tl = part; tl < MT / 256; tl += 8) {
            bf16x8 V[8];
#pragma unroll
            for (int ks = 0; ks < 8; ++ks) V[ks] = *(const bf16x8*)(PROJ + (size_t)(tl * 256 + 16 * l15 + 2 * ks + (lq >> 1)) * INW + 16 * g + 8 * (lq & 1));
            f32x4 acc[2] = {{0.f, 0.f, 0.f, 0.f}, {0.f, 0.f, 0.f, 0.f}};
#pragma unroll
            for (int ks = 0; ks < 8; ++ks)
#pragma unroll
                for (int j = 0; j < 2; ++j) acc[j] = __builtin_amdgcn_mfma_f32_16x16x32_bf16(Af[j][ks], V[ks], acc[j], 0, 0, 0);
#pragma unroll
            for (int j = 0; j < 2; ++j) *(f32x4*)(Z + ((size_t)(tl * 16 + l15) * 32 + g) * 256 + 16 * (2 * F.wave + j) + 4 * lq) = acc[j];
        }
    }
}
__device__ __forceinline__ int s5_chain_sb(int d, int i) { return d == 0 ? (i < 16 ? 1024 + i : i - 16) : (i < 16 ? 1039 - i : 1023 - (i - 16)); }
__device__ __forceinline__ void s5_scan_phase(Frame& F, int l) {
    LAS float* EX = (LAS float*)F.lds;
    for (int item = F.bid; item < 256; item += F.G) {
        const int cid = item * 16 + (F.tid & 15), j = F.tid >> 4;
        const int g = cid >> 7, d = (cid >> 6) & 1, p = cid & 63;
        const float* A16 = (const float*)(F.ws + WS_A16) + ((size_t)((l * 32 + g) * 2 + d) * 64 + p) * 2; const float ar = A16[0], ai = A16[1];
        const float* Z = (const float*)(F.ws + WS_Z) + (size_t)g * 256 + d * 128 + 2 * p; bf16* SS = (bf16*)(F.ws + WS_SS) + (size_t)g * 256 + d * 128 + 2 * p;
        float2 z[33];
#pragma unroll
        for (int q = 0; q < 33; ++q) { const int i = 33 * j + q; z[q] = i < NSB ? *(const float2*)(Z + (size_t)s5_chain_sb(d, i) * 8192) : make_float2(0.f, 0.f); }
        float hr = 0.f, hi = 0.f, pr = 1.f, pi = 0.f;
#pragma unroll
        for (int q = 0; q < 33; ++q) { if (33 * j + q < NSB) { const float nr = ar * hr - ai * hi + z[q].x, ni = ar * hi + ai * hr + z[q].y; hr = nr; hi = ni; const float qr = pr * ar - pi * ai, qi = pr * ai + pi * ar; pr = qr; pi = qi; } }
        __syncthreads();
        EX[(j * 16 + (F.tid & 15)) * 4 + 0] = hr; EX[(j * 16 + (F.tid & 15)) * 4 + 1] = hi; EX[(j * 16 + (F.tid & 15)) * 4 + 2] = pr; EX[(j * 16 + (F.tid & 15)) * 4 + 3] = pi;
        __syncthreads();
        float cr = 0.f, ci = 0.f;
        for (int i = 0; i < j; ++i) { const float er = EX[(i * 16 + (F.tid & 15)) * 4 + 0], ei = EX[(i * 16 + (F.tid & 15)) * 4 + 1], qr = EX[(i * 16 + (F.tid & 15)) * 4 + 2], qi = EX[(i * 16 + (F.tid & 15)) * 4 + 3];
            const float nr = qr * cr - qi * ci + er, ni = qr * ci + qi * cr + ei; cr = nr; ci = ni; }
        hr = cr; hi = ci;
#pragma unroll
        for (int q = 0; q < 33; ++q) { const int i = 33 * j + q; if (i < NSB) { *(unsigned*)(SS + (size_t)s5_chain_sb(d, i) * 8192) = pk2(hr, hi);
            const float nr = ar * hr - ai * hi + z[q].x, ni = ar * hi + ai * hr + z[q].y; hr = nr; hi = ni; } }
    }
}
__device__ __forceinline__ void s5_y_phase(Frame& F, int l) {
    const bf16* PROJ = (const bf16*)(F.ws + WS_PROJ); const bf16* SS = (const bf16*)(F.ws + WS_SS); bf16* YG = (bf16*)(F.ws + WS_YG); const float* ds = IN_(I_DSKIP) + l * MIXW;
    const int l15 = F.lane & 15, lq = F.lane >> 4;
    for (int item = F.bid; item < 256; item += F.G) {
        const int g = item >> 3, part = item & 7; const bf16* Tm = (const bf16*)(F.ws + WS_S5M) + ((size_t)(l * 32 + g) * 3 + 1) * 65536; const bf16* Em = Tm + 65536;
        bf16x8 At[2][8], Ae[2][8];
#pragma unroll
        for (int j = 0; j < 2; ++j)
#pragma unroll
            for (int ks = 0; ks < 8; ++ks) { const size_t o = (size_t)(16 * (2 * F.wave + j) + l15) * 256 + 32 * ks + 8 * lq; At[j][ks] = *(const bf16x8*)(Tm + o); Ae[j][ks] = *(const bf16x8*)(Em + o); }
        const f32x4 dsk = *(const f32x4*)(ds + 16 * g + 4 * lq);
        const int ntl = l == 0 ? MT / 256 : SEQ / 256;
#pragma unroll 1
        for (int tl = part; tl < ntl; tl += 8) {
            bf16x8 V[8], S[8];
#pragma unroll
            for (int ks = 0; ks < 8; ++ks) { V[ks] = *(const bf16x8*)(PROJ + (size_t)(tl * 256 + 16 * l15 + 2 * ks + (lq >> 1)) * INW + 16 * g + 8 * (lq & 1));
                S[ks] = *(const bf16x8*)(SS + ((size_t)(tl * 16 + l15) * 32 + g) * 256 + 32 * ks + 8 * lq); }
            f32x4 acc[2] = {{0.f, 0.f, 0.f, 0.f}, {0.f, 0.f, 0.f, 0.f}};
#pragma unroll
            for (int ks = 0; ks < 8; ++ks)
#pragma unroll
                for (int j = 0; j < 2; ++j) { acc[j] = __builtin_amdgcn_mfma_f32_16x16x32_bf16(At[j][ks], V[ks], acc[j], 0, 0, 0); acc[j] = __builtin_amdgcn_mfma_f32_16x16x32_bf16(Ae[j][ks], S[ks], acc[j], 0, 0, 0); }
#pragma unroll
            for (int j = 0; j < 2; ++j) { const size_t row = (size_t)tl * 256 + 16 * l15 + (2 * F.wave + j); const int ch = 16 * g + 4 * lq;
                const v2u u = *(const v2u*)(PROJ + row * INW + ch);
                const float y0 = acc[j][0] + dsk[0] * bflo(u.x), y1 = acc[j][1] + dsk[1] * bfhi(u.x), y2 = acc[j][2] + dsk[2] * bflo(u.y), y3 = acc[j][3] + dsk[3] * bfhi(u.y);
                v2u w; w.x = cvtpk(geluf_(y0), geluf_(y1)); w.y = cvtpk(geluf_(y2), geluf_(y3)); *(v2u*)(YG + row * MIXW + ch) = w; }
        }
    }
}


constexpr int SG_STRIDE = 272, SG_IMG = 256 * SG_STRIDE, SG_STAT = SG_IMG;
__device__ __forceinline__ void sg_fast_chunk(Frame& F, int l, int chunk) {
    const bf16* PROJ = (const bf16*)(F.ws + WS_PROJ); bf16* YB = (bf16*)(F.ws + WS_YS) + (size_t)MT * MIXW; const bf16* WSG = (const bf16*)(F.ws + WS_WSG);
    const float* lg = IN_(I_SGG) + l * MIXW; const float* lb = IN_(I_SGB) + l * MIXW; const float* bsg = IN_(I_BSG) + l * 512;
    LAS float* st = (LAS float*)(F.lds + SG_STAT);
    __syncthreads();
    {
        const int p = F.tid >> 2, part = F.tid & 3; const bf16* vr = PROJ + (size_t)(chunk * 128 + p) * INW + 1024 + part * 128; float s = 0.f, q = 0.f;
#pragma unroll 4
        for (int c = 0; c < 128; c += 8) { const v4u w = *(const v4u*)(vr + c); const float x[8] = {bflo(w.x), bfhi(w.x), bflo(w.y), bfhi(w.y), bflo(w.z), bfhi(w.z), bflo(w.w), bfhi(w.w)};
#pragma unroll
            for (int i = 0; i < 8; ++i) { s += x[i]; q += x[i] * x[i]; } }
        s += __shfl_xor(s, 1); q += __shfl_xor(q, 1); s += __shfl_xor(s, 2); q += __shfl_xor(q, 2);
        const float mu = s * (1.f / 512.f), var = fmaxf(q * (1.f / 512.f) - mu * mu, 0.f);
        if (part == 0) { st[p * 2] = mu; st[p * 2 + 1] = rsqrtf(var + EPS); }
    }
    const int l15 = F.lane & 15, lq = F.lane >> 4;
#pragma unroll 1
    for (int pass = 0; pass < 2; ++pass) {
        __syncthreads();
#pragma unroll 1
        for (int it = F.tid; it < 2048; it += NT) { const int tp = it & 63, cg = it >> 6; const int p0 = tp * 2, ch = pass * 256 + cg * 8;
            const v4u w0 = *(const v4u*)(PROJ + (size_t)(chunk * 128 + p0) * INW + 1024 + ch), w1 = *(const v4u*)(PROJ + (size_t)(chunk * 128 + p0 + 1) * INW + 1024 + ch);
            const float mu0 = st[p0 * 2], rs0 = st[p0 * 2 + 1], mu1 = st[p0 * 2 + 2], rs1 = st[p0 * 2 + 3];
            const float x0[8] = {bflo(w0.x), bfhi(w0.x), bflo(w0.y), bfhi(w0.y), bflo(w0.z), bfhi(w0.z), bflo(w0.w), bfhi(w0.w)};
            const float x1[8] = {bflo(w1.x), bfhi(w1.x), bflo(w1.y), bfhi(w1.y), bflo(w1.z), bfhi(w1.z), bflo(w1.w), bfhi(w1.w)};
#pragma unroll
            for (int i = 0; i < 8; ++i) { const float gm = lg[ch + i], bt = lb[ch + i];
                *(LAS unsigned*)(F.lds + (cg * 8 + i) * SG_STRIDE + p0 * 2) = pk2((x0[i] - mu0) * rs0 * gm + bt, (x1[i] - mu1) * rs1 * gm + bt); } }
        __syncthreads();
        const int ggl = F.wave >> 2, gg = pass * 2 + ggl, rb0 = (F.wave & 3) * 2;
        bf16x8 A[2][4];
#pragma unroll
        for (int j = 0; j < 2; ++j)
#pragma unroll
            for (int ks = 0; ks < 4; ++ks) A[j][ks] = *(const LAS bf16x8*)(F.lds + (ggl * 128 + (rb0 + j) * 16 + l15) * SG_STRIDE + (32 * ks + 8 * lq) * 2);
        f32x4 acc[2][8];
#pragma unroll
        for (int j = 0; j < 2; ++j)
#pragma unroll
            for (int cb = 0; cb < 8; ++cb) acc[j][cb] = (f32x4){0.f, 0.f, 0.f, 0.f};
#pragma unroll
        for (int cb = 0; cb < 8; ++cb) {
            bf16x8 B[4];
#pragma unroll
            for (int ks = 0; ks < 4; ++ks) B[ks] = *(const bf16x8*)(WSG + ((size_t)gg * 128 + cb * 16 + l15) * 128 + 32 * ks + 8 * lq);
#pragma unroll
            for (int ks = 0; ks < 4; ++ks)
#pragma unroll
                for (int j = 0; j < 2; ++j) acc[j][cb] = __builtin_amdgcn_mfma_f32_16x16x32_bf16(A[j][ks], B[ks], acc[j][cb], 0, 0, 0);
        }
#pragma unroll
        for (int cb = 0; cb < 8; ++cb) { const int q = cb * 16 + l15; const size_t row = (size_t)chunk * 128 + q; const float bq = bsg[gg * 128 + q];
#pragma unroll
            for (int j = 0; j < 2; ++j) { const int col = gg * 128 + (rb0 + j) * 16 + 4 * lq; const v2u gu = *(const v2u*)(PROJ + row * INW + 512 + col);
                v2u w; w.x = cvtpk(bflo(gu.x) * (acc[j][cb][0] + bq), bfhi(gu.x) * (acc[j][cb][1] + bq)); w.y = cvtpk(bflo(gu.y) * (acc[j][cb][2] + bq), bfhi(gu.y) * (acc[j][cb][3] + bq));
                *(v2u*)(YB + row * MIXW + col) = w; } }
    }
}

struct NSmem { float As[16][68]; float Bs[16][68]; };
template <class AF>
__device__ __forceinline__ void ngemm_acc(float (&acc)[4][4], const AF& af, const float* B, int ldb, int K, LAS NSmem* s, int t) {
    const int ty = t >> 4, tx = t & 15, lr = t >> 2, lk = (t & 3) * 4, bk = t >> 4, bn = (t & 15) * 4;
    for (int k0 = 0; k0 < K; k0 += 16) {
        const float4 av = af.load4(lr, k0 + lk);
        const float4 bv = *(const float4*)(B + (size_t)(k0 + bk) * ldb + bn);
        __syncthreads();
        s->As[lk + 0][lr] = av.x; s->As[lk + 1][lr] = av.y; s->As[lk + 2][lr] = av.z; s->As[lk + 3][lr] = av.w;
        *(LAS f32x4*)&s->Bs[bk][bn] = (f32x4){bv.x, bv.y, bv.z, bv.w};
        __syncthreads();
#pragma unroll
        for (int k = 0; k < 16; ++k) {
            const f32x4 a = *(const LAS f32x4*)&s->As[k][ty * 4]; const f32x4 b = *(const LAS f32x4*)&s->Bs[k][tx * 4];
            const float aa[4] = {a.x, a.y, a.z, a.w}, bb[4] = {b.x, b.y, b.z, b.w};
#pragma unroll
            for (int i = 0; i < 4; ++i)
#pragma unroll
                for (int j = 0; j < 4; ++j) acc[i][j] += aa[i] * bb[j];
        }
    }
}
struct ABf { const bf16* A; int lda; __device__ __forceinline__ float4 load4(int r, int k) const { const v2u w = *(const v2u*)(A + (size_t)r * lda + k);
    return make_float4(bf2f((unsigned short)(w.x & 0xffff)), bf2f((unsigned short)(w.x >> 16)), bf2f((unsigned short)(w.y & 0xffff)), bf2f((unsigned short)(w.y >> 16))); } };
#define NTILE_BEGIN(ntiles) { const int _half = F.tid >> 8, t = F.tid & 255, ty = t >> 4, tx = t & 15; LAS NSmem* sm = (LAS NSmem*)F.lds + _half; (void)ty; (void)tx; \
    const int _nt = (ntiles), _nit = (_nt + 2 * F.G - 1) / (2 * F.G); \
    for (int _it = 0; _it < _nit; ++_it) { int T = (_it * F.G + F.bid) * 2 + _half; const bool valid = T < _nt; if (!valid) T = _nt - 1;
#define NTILE_END } }

__device__ __forceinline__ void ph0_prologue(Frame& F) {
    float* mod = (float*)(F.ws + WS_MOD);
    LAS float* SV = (LAS float*)(F.lds + 131072 + 4096);
    for (int i = F.tid; i < 2048; i += NT) SV[i] = siluf_(i < 1024 ? IN_(I_C)[i] : IN_(I_CCTX)[i - 1024]);
    __syncthreads();
    const int gw = F.bid * (NT / 64) + F.wave, ngw = F.G * (NT / 64);
    for (int it = gw; it < 2 * 96; it += ngw) { const int l = it / 96, j = (it % 96) * 64 + F.lane;
        const float* W = IN_(I_WADA) + (size_t)l * D * 6144 + j;
        float a0 = 0.f, a1 = 0.f;
#pragma unroll 16
        for (int kk = 0; kk < D; ++kk) { const float w = W[(size_t)kk * 6144]; a0 += SV[kk] * w; a1 += SV[1024 + kk] * w; }
        const float b = IN_(I_BADA)[l * 6144 + j];
        mod[(size_t)(l * 2 + 0) * 6144 + j] = a0 + b; mod[(size_t)(l * 2 + 1) * 6144 + j] = a1 + b;
    }
}
__device__ __forceinline__ void hprep_rows(Frame& F, int l) {
    bf16* H = (bf16*)(F.ws + WS_H); const float* g = IN_(I_GMIX) + l * D;
    const int gw = F.bid * (NT / 64) + F.wave, ngw = F.G * (NT / 64);
    for (int row = gw; row < MT; row += ngw) {
        const float* m = mod_ptr(F, l, row); const float* xr = xsrc_row(F, l, row);
        f32x4 v[4]; float s = 0.f;
#pragma unroll
        for (int j = 0; j < 4; ++j) { v[j] = *(const f32x4*)(xr + 4 * F.lane + 256 * j); s += v[j].x * v[j].x + v[j].y * v[j].y + v[j].z * v[j].z + v[j].w * v[j].w; }
        const float rstd = rsqrtf(wave_sum(s) * (1.f / D) + EPS);
#pragma unroll
        for (int j = 0; j < 4; ++j) { const int c = 4 * F.lane + 256 * j; const f32x4 gg = *(const f32x4*)(g + c), sc = *(const f32x4*)(m + 1024 + c), sh = *(const f32x4*)(m + c);
            const f32x4 o = v[j] * rstd * gg * (1.f + sc) + sh; v2u w; w.x = pk2(o.x, o.y); w.y = pk2(o.z, o.w); *(v2u*)(H + (size_t)row * D + c) = w; }
    }
}
__device__ __forceinline__ void ph2_naive(Frame& F, int l) {
    const bf16* H = (const bf16*)(F.ws + WS_H); bf16* PROJ = (bf16*)(F.ws + WS_PROJ); const float* W = IN_(I_WIN) + (size_t)l * D * INW;
    NTILE_BEGIN((MT / 64) * (INW / 64))
        const int m0 = (T / (INW / 64)) * 64, n0 = (T % (INW / 64)) * 64;
        float acc[4][4] = {};
        ngemm_acc(acc, ABf{H + (size_t)m0 * D, D}, W + n0, INW, D, sm, t);
        if (valid) {
#pragma unroll
            for (int i = 0; i < 4; ++i) { float o[4];
#pragma unroll
                for (int j = 0; j < 4; ++j) { o[j] = acc[i][j]; if (n0 >= 512 && n0 < 1536) o[j] = geluf_(o[j]); }
                v2u w; w.x = pk2(o[0], o[1]); w.y = pk2(o[2], o[3]); *(v2u*)(PROJ + (size_t)(m0 + ty * 4 + i) * INW + n0 + tx * 4) = w; }
        }
    NTILE_END
}
__device__ __forceinline__ int chain_row(int dir, int pos) { return dir == 0 ? (pos < CTX ? SEQ + pos : pos - CTX) : (pos < CTX ? SEQ + CTX - 1 - pos : SEQ - 1 - (pos - CTX)); }
__device__ __forceinline__ void ph3_s5_naive(Frame& F, int l) {
    LAS float* Cr = (LAS float*)(F.lds + 32768); LAS float* Ci = Cr + 1024; LAS float* Sr = Ci + 1024; LAS float* Si = Sr + 2048;
    const bf16* PROJ = (const bf16*)(F.ws + WS_PROJ); float* YD = (float*)(F.ws + WS_S5);
    for (int item = F.bid; item < 64; item += F.G) {
        if (F.wave == 0) {
            const int g = item >> 1, dir = item & 1, p = F.lane;
            const int ldg = ((l * 2 + dir) * G5 + g);
            const float lr = IN_(I_LRE)[ldg * P5 + p], li = IN_(I_LIM)[ldg * P5 + p], dt = expf(IN_(I_LDT)[ldg]);
            const float er = expf(lr * dt), ar = er * cosf(li * dt), ai = er * sinf(li * dt);
            const float nr = ar - 1.f, ni = ai, den = lr * lr + li * li;
            const float qr = (nr * lr + ni * li) / den, qi = (ni * lr - nr * li) / den;
            float br[16], bi[16];
#pragma unroll
            for (int h = 0; h < 16; ++h) { const float x = IN_(I_BRE)[((size_t)ldg * P5 + p) * H5 + h], y = IN_(I_BIM)[((size_t)ldg * P5 + p) * H5 + h]; br[h] = qr * x - qi * y; bi[h] = qr * y + qi * x; }
            for (int h = 0; h < 16; ++h) { Cr[h * 64 + p] = IN_(I_CRE)[((size_t)ldg * H5 + h) * P5 + p]; Ci[h * 64 + p] = IN_(I_CIM)[((size_t)ldg * H5 + h) * P5 + p]; }
            float sr = 0.f, si = 0.f;
            float* Y = YD + (size_t)dir * MT * MIXW;
#pragma unroll 1
            for (int blk = 0; blk < MT / 32; ++blk) {
#pragma unroll 1
                for (int tt = 0; tt < 32; ++tt) {
                    const int row = chain_row(dir, blk * 32 + tt);
                    const v4u u0 = *(const v4u*)(PROJ + (size_t)row * INW + g * 16), u1 = *(const v4u*)(PROJ + (size_t)row * INW + g * 16 + 8);
                    const unsigned uw[8] = {u0.x, u0.y, u0.z, u0.w, u1.x, u1.y, u1.z, u1.w};
                    float xr = 0.f, xi = 0.f;
#pragma unroll
                    for (int h = 0; h < 8; ++h) { const float ua = bf2f((unsigned short)(uw[h] & 0xffff)), ub = bf2f((unsigned short)(uw[h] >> 16));
                        xr += br[2 * h] * ua + br[2 * h + 1] * ub; xi += bi[2 * h] * ua + bi[2 * h + 1] * ub; }
                    const float nsr = ar * sr - ai * si + xr, nsi = ar * si + ai * sr + xi;
                    sr = nsr; si = nsi; Sr[tt * 64 + p] = sr; Si[tt * 64 + p] = si;
                }
                asm volatile("s_waitcnt lgkmcnt(0)" ::: "memory");
#pragma unroll 1
                for (int o = p; o < 512; o += 64) {
                    const int tt = o >> 4, h = o & 15; float a = 0.f;
#pragma unroll 4
                    for (int q = 0; q < 64; ++q) a += Cr[h * 64 + q] * Sr[tt * 64 + q] - Ci[h * 64 + q] * Si[tt * 64 + q];
                    Y[(size_t)chain_row(dir, blk * 32 + tt) * MIXW + g * 16 + h] = a;
                }
                asm volatile("s_waitcnt lgkmcnt(0)" ::: "memory");
            }
        }
    }
}
__device__ __forceinline__ void ph3_sg_naive(Frame& F, int l) {
    const bf16* PROJ = (const bf16*)(F.ws + WS_PROJ); bf16* YB = (bf16*)(F.ws + WS_YS) + (size_t)MT * MIXW;
    LAS float* stat = (LAS float*)(F.lds + 32768);
    const float* lg = IN_(I_SGG) + l * MIXW; const float* lb = IN_(I_SGB) + l * MIXW;
    NTILE_BEGIN((MT / 128) * 16)
        const int chunk = T >> 4, gg = (T >> 2) & 3, q0 = ((T >> 1) & 1) * 64, c0 = (T & 1) * 64;
        LAS float* st = stat + _half * 256;
        __syncthreads();
        if (t < 128) { const bf16* vr = PROJ + (size_t)(chunk * 128 + t) * INW + 1024; float s = 0.f;
            for (int c = 0; c < 512; c += 2) { const unsigned w = *(const unsigned*)(vr + c); s += bf2f((unsigned short)(w & 0xffff)) + bf2f((unsigned short)(w >> 16)); }
            const float mu = s * (1.f / 512.f); float q = 0.f;
            for (int c = 0; c < 512; c += 2) { const unsigned w = *(const unsigned*)(vr + c); const float a = bf2f((unsigned short)(w & 0xffff)) - mu, b = bf2f((unsigned short)(w >> 16)) - mu; q += a * a + b * b; }
            st[t * 2] = mu; st[t * 2 + 1] = rsqrtf(q * (1.f / 512.f) + EPS); }
        __syncthreads();
        float acc[4][4] = {};
        {
            const float* A = IN_(I_WSG) + ((size_t)(l * 4 + gg) * 128 + q0) * 128;
            const int lr = t >> 2, lk = (t & 3) * 4, bk = t >> 4, bn = (t & 15) * 4;
            for (int k0 = 0; k0 < 128; k0 += 16) {
                const float4 av = *(const float4*)(A + (size_t)lr * 128 + k0 + lk);
                const int p = k0 + bk; const int col = gg * 128 + c0 + bn;
                const v2u w = *(const v2u*)(PROJ + (size_t)(chunk * 128 + p) * INW + 1024 + col);
                const float mu = st[p * 2], rs = st[p * 2 + 1];
                float4 bv; bv.x = (bf2f((unsigned short)(w.x & 0xffff)) - mu) * rs * lg[col] + lb[col]; bv.y = (bf2f((unsigned short)(w.x >> 16)) - mu) * rs * lg[col + 1] + lb[col + 1];
                bv.z = (bf2f((unsigned short)(w.y & 0xffff)) - mu) * rs * lg[col + 2] + lb[col + 2]; bv.w = (bf2f((unsigned short)(w.y >> 16)) - mu) * rs * lg[col + 3] + lb[col + 3];
                __syncthreads();
                sm->As[lk + 0][lr] = av.x; sm->As[lk + 1][lr] = av.y; sm->As[lk + 2][lr] = av.z; sm->As[lk + 3][lr] = av.w;
                *(LAS f32x4*)&sm->Bs[bk][bn] = (f32x4){bv.x, bv.y, bv.z, bv.w};
                __syncthreads();
#pragma unroll
                for (int k = 0; k < 16; ++k) { const f32x4 a = *(const LAS f32x4*)&sm->As[k][ty * 4]; const f32x4 b = *(const LAS f32x4*)&sm->Bs[k][tx * 4];
                    const float aa[4] = {a.x, a.y, a.z, a.w}, bb[4] = {b.x, b.y, b.z, b.w};
#pragma unroll
                    for (int i = 0; i < 4; ++i)
#pragma unroll
                        for (int j = 0; j < 4; ++j) acc[i][j] += aa[i] * bb[j]; }
            }
        }
        if (valid) {
#pragma unroll
            for (int i = 0; i < 4; ++i) { const int q = q0 + ty * 4 + i; const size_t row = (size_t)chunk * 128 + q; const int col = gg * 128 + c0 + tx * 4;
                const float bq = IN_(I_BSG)[l * 512 + gg * 128 + q];
                const v2u gu = *(const v2u*)(PROJ + row * INW + 512 + col);
                v2u w; w.x = pk2(bf2f((unsigned short)(gu.x & 0xffff)) * (acc[i][0] + bq), bf2f((unsigned short)(gu.x >> 16)) * (acc[i][1] + bq));
                w.y = pk2(bf2f((unsigned short)(gu.y & 0xffff)) * (acc[i][2] + bq), bf2f((unsigned short)(gu.y >> 16)) * (acc[i][3] + bq));
                *(v2u*)(YB + row * MIXW + col) = w; }
        }
    NTILE_END
}
__device__ __forceinline__ void ph3_conv(Frame& F, int l, int nrows) {
    const bf16* PROJ = (const bf16*)(F.ws + WS_PROJ); bf16* YC = (bf16*)(F.ws + WS_YS) + (size_t)2 * MT * MIXW; const float* wc = IN_(I_WCONV) + l * 3 * MIXW;
    const size_t gt = (size_t)F.bid * NT + F.tid, ngt = (size_t)F.G * NT;
    for (size_t i = gt; i < (size_t)nrows * (MIXW / 2); i += ngt) {
        const int row = (int)(i / (MIXW / 2)), c = (int)(i % (MIXW / 2)) * 2;
        int pos, rl; if (row < SEQ) { pos = row & 63; rl = 64; } else { pos = row - SEQ; rl = 256; }
        const bf16* r0 = PROJ + (size_t)row * INW + 1536;
        const unsigned b0 = *(const unsigned*)(r0 + c), c0 = *(const unsigned*)(r0 + 512 + c), h0 = *(const unsigned*)(r0 + 1024 + c);
        float zm0 = 0.f, zm1 = 0.f, zp0 = 0.f, zp1 = 0.f;
        if (pos > 0) { const unsigned cc = *(const unsigned*)(r0 - INW + 512 + c), hh = *(const unsigned*)(r0 - INW + 1024 + c); zm0 = bf2f((unsigned short)(cc & 0xffff)) * bf2f((unsigned short)(hh & 0xffff)); zm1 = bf2f((unsigned short)(cc >> 16)) * bf2f((unsigned short)(hh >> 16)); }
        if (pos < rl - 1) { const unsigned cc = *(const unsigned*)(r0 + INW + 512 + c), hh = *(const unsigned*)(r0 + INW + 1024 + c); zp0 = bf2f((unsigned short)(cc & 0xffff)) * bf2f((unsigned short)(hh & 0xffff)); zp1 = bf2f((unsigned short)(cc >> 16)) * bf2f((unsigned short)(hh >> 16)); }
        const float z00 = bf2f((unsigned short)(c0 & 0xffff)) * bf2f((unsigned short)(h0 & 0xffff)), z01 = bf2f((unsigned short)(c0 >> 16)) * bf2f((unsigned short)(h0 >> 16));
        const float y0 = bf2f((unsigned short)(b0 & 0xffff)) * (wc[c] * zm0 + wc[512 + c] * z00 + wc[1024 + c] * zp0);
        const float y1 = bf2f((unsigned short)(b0 >> 16)) * (wc[c + 1] * zm1 + wc[512 + c + 1] * z01 + wc[1024 + c + 1] * zp1);
        *(unsigned*)(YC + (size_t)row * MIXW + c) = pk2(y0, y1);
    }
}
__device__ __forceinline__ void ph5_naive(Frame& F, int l) {
    const bf16* PROJ = (const bf16*)(F.ws + WS_PROJ); const float* YD = (const float*)(F.ws + WS_S5); bf16* YG = (bf16*)(F.ws + WS_YG); const float* ds = IN_(I_DSKIP) + l * MIXW;
    const size_t gt = (size_t)F.bid * NT + F.tid, ngt = (size_t)F.G * NT;
    for (size_t i = gt; i < (size_t)MT * (MIXW / 2); i += ngt) {
        const int row = (int)(i / (MIXW / 2)), c = (int)(i % (MIXW / 2)) * 2;
        const unsigned u = *(const unsigned*)(PROJ + (size_t)row * INW + c); const size_t o = (size_t)row * MIXW + c;
        const float y0 = YD[o] + YD[(size_t)MT * MIXW + o] + ds[c] * bf2f((unsigned short)(u & 0xffff)), y1 = YD[o + 1] + YD[(size_t)MT * MIXW + o + 1] + ds[c + 1] * bf2f((unsigned short)(u >> 16));
        *(unsigned*)(YG + o) = pk2(geluf_(y0), geluf_(y1));
    }
}
__device__ __forceinline__ void ph6_naive(Frame& F, int l) {
    const bf16* YG = (const bf16*)(F.ws + WS_YG); bf16* YA = (bf16*)(F.ws + WS_YS); const float* W = IN_(I_WGLU) + (size_t)l * MIXW * MIXW;
    NTILE_BEGIN((MT / 64) * (MIXW / 64))
        const int m0 = (T / (MIXW / 64)) * 64, n0 = (T % (MIXW / 64)) * 64;
        float acc[4][4] = {};
        ngemm_acc(acc, ABf{YG + (size_t)m0 * MIXW, MIXW}, W + n0, MIXW, MIXW, sm, t);
        if (valid) {
#pragma unroll
            for (int i = 0; i < 4; ++i) { const size_t o = (size_t)(m0 + ty * 4 + i) * MIXW + n0 + tx * 4; const v2u g = *(const v2u*)(YG + o);
                v2u w; w.x = pk2(bf2f((unsigned short)(g.x & 0xffff)) * sigmoidf_(acc[i][0]), bf2f((unsigned short)(g.x >> 16)) * sigmoidf_(acc[i][1]));
                w.y = pk2(bf2f((unsigned short)(g.y & 0xffff)) * sigmoidf_(acc[i][2]), bf2f((unsigned short)(g.y >> 16)) * sigmoidf_(acc[i][3])); *(v2u*)(YA + o) = w; }
        }
    NTILE_END
}
__device__ __forceinline__ void ph7_naive(Frame& F, int l) {
    const bf16* YS = (const bf16*)(F.ws + WS_YS); bf16* BR = (bf16*)(F.ws + WS_PROJ); const float* W = IN_(I_WBR) + (size_t)l * 3 * MIXW * D;
    NTILE_BEGIN((MT / 64) * (INW / 64))
        const int m0 = (T / (INW / 64)) * 64, n0 = (T % (INW / 64)) * 64, k = n0 / 1024, d0 = n0 % 1024;
        float acc[4][4] = {};
        ngemm_acc(acc, ABf{YS + (size_t)k * MT * MIXW + (size_t)m0 * MIXW, MIXW}, W + (size_t)k * MIXW * D + d0, D, MIXW, sm, t);
        if (valid) {
#pragma unroll
            for (int i = 0; i < 4; ++i) { v2u w; w.x = pk2(acc[i][0], acc[i][1]); w.y = pk2(acc[i][2], acc[i][3]); *(v2u*)(BR + (size_t)(m0 + ty * 4 + i) * INW + n0 + tx * 4) = w; }
        }
    NTILE_END
}
__device__ __forceinline__ void ph8_naive(Frame& F, int l) {
    const bf16* H = (const bf16*)(F.ws + WS_H); const bf16* BR = (const bf16*)(F.ws + WS_PROJ); bf16* PM = (bf16*)(F.ws + WS_PM);
    const float* W = IN_(I_WMG) + (size_t)l * D * INW; const float* bm = IN_(I_BMG) + l * INW;
    NTILE_BEGIN((MT / 64) * (D / 64))
        const int m0 = (T / (D / 64)) * 64, n0 = (T % (D / 64)) * 64;
        float out[4][4] = {};
        for (int k = 0; k < 3; ++k) {
            float acc[4][4] = {};
            ngemm_acc(acc, ABf{H + (size_t)m0 * D, D}, W + k * 1024 + n0, INW, D, sm, t);
#pragma unroll
            for (int i = 0; i < 4; ++i) { const v2u b = *(const v2u*)(BR + (size_t)(m0 + ty * 4 + i) * INW + k * 1024 + n0 + tx * 4);
                const float bb[4] = {bf2f((unsigned short)(b.x & 0xffff)), bf2f((unsigned short)(b.x >> 16)), bf2f((unsigned short)(b.y & 0xffff)), bf2f((unsigned short)(b.y >> 16))};
#pragma unroll
                for (int j = 0; j < 4; ++j) out[i][j] += sigmoidf_(acc[i][j] + bm[k * 1024 + n0 + tx * 4 + j]) * bb[j]; }
        }
        if (valid) {
#pragma unroll
            for (int i = 0; i < 4; ++i) { v2u w; w.x = pk2(out[i][0], out[i][1]); w.y = pk2(out[i][2], out[i][3]); *(v2u*)(PM + (size_t)(m0 + ty * 4 + i) * D + n0 + tx * 4) = w; }
        }
    NTILE_END
}
__device__ __forceinline__ void ph9_naive(Frame& F, int l) {
    const bf16* PM = (const bf16*)(F.ws + WS_PM); const float* W = IN_(I_WO) + (size_t)l * D * D;
    NTILE_BEGIN((MT / 64) * (D / 64))
        const int m0 = (T / (D / 64)) * 64, n0 = (T % (D / 64)) * 64;
        float acc[4][4] = {};
        ngemm_acc(acc, ABf{PM + (size_t)m0 * D, D}, W + n0, D, D, sm, t);
        if (valid) {
#pragma unroll
            for (int i = 0; i < 4; ++i) { const int row = m0 + ty * 4 + i, c = n0 + tx * 4; const float* m = mod_ptr(F, l, row) + 2048 + c;
                const f32x4 xs = *(const f32x4*)(xsrc_row(F, l, row) + c);
                f32x4 o; o.x = xs.x + m[0] * acc[i][0]; o.y = xs.y + m[1] * acc[i][1]; o.z = xs.z + m[2] * acc[i][2]; o.w = xs.w + m[3] * acc[i][3];
                *(f32x4*)(xrun_row(F, row) + c) = o; }
        }
    NTILE_END
}
__device__ __forceinline__ void ph10_route(Frame& F, int l) {
    bf16* H = (bf16*)(F.ws + WS_H); const float* g = IN_(I_GFFN) + l * D;
    const float* wg = IN_(I_WGRP) + (size_t)l * D * 4; const float* we = IN_(I_WEXP) + (size_t)l * D * 32; const float* bg = IN_(I_BGRP) + l * 4; const float* be = IN_(I_BEXP) + l * 32;
    int* EID = (int*)(F.ws + WS_EID); float* EW = (float*)(F.ws + WS_EW); unsigned* cnt = F.ctl + CW_CNT + l * 128;
    LAS float* WL = (LAS float*)F.lds;
    LAS float* LG = (LAS float*)(F.lds + 73728);
    LAS float* RS = LG + 80 * 40;
    const int nrows = l == 0 ? MT : SEQ; const int nmine = (nrows - F.bid + F.G - 1) / F.G;
    for (int i = F.wave; i < nmine; i += NT / 64) { const int row = F.bid + i * F.G; const float* xr = xrun_row(F, row); const float* m = mod_ptr(F, l, row);
        f32x4 v[4]; float s = 0.f;
#pragma unroll
        for (int j = 0; j < 4; ++j) { v[j] = *(const f32x4*)(xr + 4 * F.lane + 256 * j); s += v[j].x * v[j].x + v[j].y * v[j].y + v[j].z * v[j].z + v[j].w * v[j].w; }
        const float rstd = rsqrtf(wave_sum(s) * (1.f / D) + EPS); if (F.lane == 0) RS[i] = rstd;
#pragma unroll
        for (int j = 0; j < 4; ++j) { const int c = 4 * F.lane + 256 * j; const f32x4 gg = *(const f32x4*)(g + c), sc = *(const f32x4*)(m + 4096 + c), sh = *(const f32x4*)(m + 3072 + c);
            const f32x4 o = v[j] * rstd * gg * (1.f + sc) + sh; v2u w; w.x = pk2(o.x, o.y); w.y = pk2(o.z, o.w); *(v2u*)(H + (size_t)row * D + c) = w; } }
#pragma unroll 1
    for (int half = 0; half < 2; ++half) {
        __syncthreads();
        for (int idx = F.tid; idx < 512 * 36; idx += NT) { const int kk = idx / 36, o = idx % 36; const int kg = half * 512 + kk; WL[idx] = o < 4 ? wg[kg * 4 + o] : we[kg * 32 + (o - 4)]; }
        __syncthreads();
        for (int i = F.wave; i < nmine; i += NT / 64) { const int row = F.bid + i * F.G; const float* xr = xrun_row(F, row); const float* m = mod_ptr(F, l, row); const float rstd = RS[i];
            float hv[8];
#pragma unroll
            for (int e = 0; e < 8; ++e) { const int c = half * 512 + F.lane + 64 * e; hv[e] = xr[c] * rstd * g[c] * (1.f + m[4096 + c]) + m[3072 + c]; }
            float acc[36];
#pragma unroll
            for (int o = 0; o < 36; ++o) acc[o] = 0.f;
#pragma unroll
            for (int e = 0; e < 8; ++e) { const LAS f32x4* wr = (const LAS f32x4*)(WL + (F.lane + 64 * e) * 36);
#pragma unroll
                for (int q = 0; q < 9; ++q) { const f32x4 w = wr[q]; acc[4 * q] += hv[e] * w.x; acc[4 * q + 1] += hv[e] * w.y; acc[4 * q + 2] += hv[e] * w.z; acc[4 * q + 3] += hv[e] * w.w; } }
#pragma unroll
            for (int o = 0; o < 36; ++o) acc[o] = wave_sum(acc[o]);
            if (F.lane == 0) {
#pragma unroll
                for (int o = 0; o < 36; ++o) LG[i * 40 + o] = half == 0 ? acc[o] : LG[i * 40 + o] + acc[o]; }
        }
    }
    __syncthreads();
    for (int i = F.tid; i < nmine; i += NT) { const int row = F.bid + i * F.G; LAS float* L = LG + i * 40;
        for (int o = 0; o < 4; ++o) L[o] += bg[o];
        for (int o = 0; o < 32; ++o) L[4 + o] += be[o];
        int gi = 0; float gm = L[0]; for (int o = 1; o < 4; ++o) if (L[o] > gm) { gm = L[o]; gi = o; }
        float den = 0.f; for (int o = 0; o < 4; ++o) den += expf(L[o] - gm);
        const float gp = 1.f / den;
        const LAS float* el = L + 4 + gi * 8;
        int i1 = 0; float m1 = el[0]; for (int o = 1; o < 8; ++o) if (el[o] > m1) { m1 = el[o]; i1 = o; }
        int i2 = -1; float m2 = 0.f; for (int o = 0; o < 8; ++o) if (o != i1 && (i2 < 0 || el[o] > m2)) { m2 = el[o]; i2 = o; }
        const float e2 = expf(m2 - m1); const float w1 = 1.f / (1.f + e2), w2 = e2 / (1.f + e2);
        const int e1i = gi * 8 + i1, e2i = gi * 8 + i2;
        EID[row * 2] = e1i; EID[row * 2 + 1] = e2i; EW[row * 2] = gp * w1; EW[row * 2 + 1] = gp * w2;
        atomicAdd(&cnt[e1i], 1u); atomicAdd(&cnt[e2i], 1u);
    }
}
__device__ __forceinline__ int expert_off(const unsigned* cnt, int e) { int o = 0; for (int i = 0; i < e; ++i) o += ((int)cnt[i] + 255) & ~255; return o; }
__device__ __forceinline__ void ph11_scatter(Frame& F, int l) {
    const bf16* H = (const bf16*)(F.ws + WS_H); bf16* HS = (bf16*)(F.ws + WS_HS);
    const int* EID = (const int*)(F.ws + WS_EID); const float* EW = (const float*)(F.ws + WS_EW); int* STOK = (int*)(F.ws + WS_STOK); float* SW = (float*)(F.ws + WS_SW); int* TSLOT = (int*)(F.ws + WS_TSLOT);
    unsigned* cnt = F.ctl + CW_CNT + l * 128; unsigned* fill = cnt + 64;
    LAS int* OFF = (LAS int*)F.lds;
    __syncthreads();
    if (F.tid < NE) OFF[F.tid] = expert_off(cnt, F.tid);
    __syncthreads();
    const int gw = F.bid * (NT / 64) + F.wave, ngw = F.G * (NT / 64);
    for (int i = gw; i < (l == 0 ? MT : SEQ) * 2; i += ngw) {
        int slot = 0;
        if (F.lane == 0) { const int e = EID[i]; const int pos = (int)atomicAdd(&fill[e], 1u); slot = OFF[e] + pos; STOK[slot] = i >> 1; SW[slot] = EW[i]; TSLOT[i] = slot; }
        slot = __shfl(slot, 0);
        const v4u* src = (const v4u*)(H + (size_t)(i >> 1) * D); v4u* dst = (v4u*)(HS + (size_t)slot * D);
        dst[F.lane] = src[F.lane]; dst[F.lane + 64] = src[F.lane + 64];
    }
}
__device__ __forceinline__ int slot_expert(const unsigned* cnt, int slot0, int& seg_off, int& n_e) { int o = 0; for (int e = 0; e < NE; ++e) { const int n = (int)cnt[e], pn = (n + 255) & ~255; if (slot0 < o + pn) { seg_off = o; n_e = n; return e; } o += pn; } seg_off = o; n_e = 0; return 0; }
__device__ __forceinline__ void ph12_naive(Frame& F, int l) {
    const bf16* HS = (const bf16*)(F.ws + WS_HS); bf16* ACT = (bf16*)(F.ws + WS_ACT); const float* SW = (const float*)(F.ws + WS_SW);
    const unsigned* cnt = F.ctl + CW_CNT + l * 128; const int total = expert_off(cnt, NE);
    NTILE_BEGIN((total / 64) * (DFF / 64))
        const int s0 = (T / (DFF / 64)) * 64, n0 = (T % (DFF / 64)) * 64; int seg, n_e; const int e = slot_expert(cnt, s0, seg, n_e);
        float aa[4][4] = {}, ab[4][4] = {};
        ngemm_acc(aa, ABf{HS + (size_t)s0 * D, D}, IN_(I_W1) + ((size_t)l * NE + e) * D * DFF + n0, DFF, D, sm, t);
        ngemm_acc(ab, ABf{HS + (size_t)s0 * D, D}, IN_(I_W3) + ((size_t)l * NE + e) * D * DFF + n0, DFF, D, sm, t);
        if (valid) {
#pragma unroll
            for (int i = 0; i < 4; ++i) { const int slot = s0 + ty * 4 + i; if (slot - seg < n_e) { const float w = SW[slot];
                v2u o; o.x = pk2(siluf_(aa[i][0]) * ab[i][0] * w, siluf_(aa[i][1]) * ab[i][1] * w); o.y = pk2(siluf_(aa[i][2]) * ab[i][2] * w, siluf_(aa[i][3]) * ab[i][3] * w);
                *(v2u*)(ACT + (size_t)slot * DFF + n0 + tx * 4) = o; } }
        }
    NTILE_END
}
__device__ __forceinline__ void ph13_naive(Frame& F, int l) {
    const bf16* ACT = (const bf16*)(F.ws + WS_ACT); bf16* YS2 = (bf16*)(F.ws + WS_YS2);
    const unsigned* cnt = F.ctl + CW_CNT + l * 128; const int total = expert_off(cnt, NE);
    NTILE_BEGIN((total / 64) * (D / 64))
        const int s0 = (T / (D / 64)) * 64, n0 = (T % (D / 64)) * 64; int seg, n_e; const int e = slot_expert(cnt, s0, seg, n_e);
        float acc[4][4] = {};
        ngemm_acc(acc, ABf{ACT + (size_t)s0 * DFF, DFF}, IN_(I_W2) + ((size_t)l * NE + e) * DFF * D + n0, D, DFF, sm, t);
        if (valid) {
#pragma unroll
            for (int i = 0; i < 4; ++i) { const int slot = s0 + ty * 4 + i; if (slot - seg < n_e) { v2u o; o.x = pk2(acc[i][0], acc[i][1]); o.y = pk2(acc[i][2], acc[i][3]); *(v2u*)(YS2 + (size_t)slot * D + n0 + tx * 4) = o; } }
        }
    NTILE_END
}
__device__ __forceinline__ void ph14_combine(Frame& F, int l) {
    const bf16* YS2 = (const bf16*)(F.ws + WS_YS2); const int* TSLOT = (const int*)(F.ws + WS_TSLOT); bf16* H = (bf16*)(F.ws + WS_H);
    const int gw = F.bid * (NT / 64) + F.wave, ngw = F.G * (NT / 64);
    const int nrows = l == 0 ? MT : SEQ;
    for (int row = gw; row < nrows; row += ngw) {
        const float* m = mod_ptr(F, l, row); float* xr = xrun_row(F, row);
        const int s0 = TSLOT[row * 2], s1 = TSLOT[row * 2 + 1];
        f32x4 v[4]; float s = 0.f;
#pragma unroll
        for (int j = 0; j < 4; ++j) { const int c = 4 * F.lane + 256 * j; const f32x4 x = *(const f32x4*)(xr + c); const f32x4 ga = *(const f32x4*)(m + 5120 + c);
            const v2u a = *(const v2u*)(YS2 + (size_t)s0 * D + c), b = *(const v2u*)(YS2 + (size_t)s1 * D + c);
            f32x4 y; y.x = bf2f((unsigned short)(a.x & 0xffff)) + bf2f((unsigned short)(b.x & 0xffff)); y.y = bf2f((unsigned short)(a.x >> 16)) + bf2f((unsigned short)(b.x >> 16));
            y.z = bf2f((unsigned short)(a.y & 0xffff)) + bf2f((unsigned short)(b.y & 0xffff)); y.w = bf2f((unsigned short)(a.y >> 16)) + bf2f((unsigned short)(b.y >> 16));
            v[j] = x + ga * y; s += v[j].x * v[j].x + v[j].y * v[j].y + v[j].z * v[j].z + v[j].w * v[j].w; }
        const float rstd = rsqrtf(wave_sum(s) * (1.f / D) + EPS);
        if (l == 0) {
            const float* m1 = mod_ptr(F, 1, row); const float* g = IN_(I_GMIX) + D;
#pragma unroll
            for (int j = 0; j < 4; ++j) { const int c = 4 * F.lane + 256 * j; *(f32x4*)(xr + c) = v[j];
                const f32x4 gg = *(const f32x4*)(g + c), sc = *(const f32x4*)(m1 + 1024 + c), sh = *(const f32x4*)(m1 + c);
                const f32x4 o = v[j] * rstd * gg * (1.f + sc) + sh; v2u w; w.x = pk2(o.x, o.y); w.y = pk2(o.z, o.w); *(v2u*)(H + (size_t)row * D + c) = w; }
        } else {
            const float* g = IN_(I_GF);
#pragma unroll
            for (int j = 0; j < 4; ++j) { const int c = 4 * F.lane + 256 * j; const f32x4 gg = *(const f32x4*)(g + c); *(f32x4*)(xr + c) = v[j] * rstd * gg; }
        }
    }
}

#ifndef FASTMASK
#define FASTMASK 0xffff
#endif
constexpr unsigned FM = FASTMASK;
constexpr int NPH = 2 + 13 * 2;
__device__ __forceinline__ Frame make_frame(LAS unsigned char* lds, int wave0) {
    Frame F; F.lds = lds; F.wave = wave0; F.lane = (int)__builtin_amdgcn_mbcnt_hi(~0u, __builtin_amdgcn_mbcnt_lo(~0u, 0u)); asm volatile("" : "+v"(F.lane)); F.tid = F.wave * 64 + F.lane; F.bid = blockIdx.x; F.G = gridDim.x; asm volatile("" : "+s"(F.G), "+s"(F.bid));
    F.tab = (const unsigned long long LAS*)(lds + TAB_OFF);
    volatile LAS unsigned long long* t = (volatile LAS unsigned long long*)(lds + TAB_OFF);
    F.ws = (unsigned char*)uni64(t[35]); F.out = (float*)uni64(t[36]); F.ctl = (unsigned*)(F.ws + WS_CTL);
    return F;
}
__global__ void __launch_bounds__(NT, 2) mega_fwd(Args args) {
    extern __shared__ __attribute__((aligned(16))) unsigned char lds_raw[];
    LAS unsigned char* const lds = (LAS unsigned char*)lds_raw;
    const int wave0 = __builtin_amdgcn_readfirstlane((int)threadIdx.x >> 6);
    for (int u = threadIdx.x; u < 1024 / 4; u += NT) ((LAS unsigned*)(lds + 131072))[u] = 0u;
    if (threadIdx.x == 0) { LAS unsigned long long* t = (LAS unsigned long long*)(lds + TAB_OFF);
#pragma unroll
        for (int i = 0; i < 35; ++i) t[i] = (unsigned long long)args.in[i];
        t[35] = (unsigned long long)args.ws; t[36] = (unsigned long long)args.out; }
    __syncthreads();
    { Frame F = make_frame(lds, wave0); (void)xcd_barrier_post(F.ctl + CW_BAR, (volatile LAS unsigned*)(lds + MISC_OFF) + 8); }
    const int lo = args.ph_lo, hi = args.ph_hi; int ph = 0;
#define GRIDBAR() do { Frame Fb = make_frame(lds, wave0); XcdBarrier bar; bar.bar = Fb.ctl + CW_BAR; bar.x = xb_xcc_id(); bar.st = (volatile LAS unsigned*)(lds + MISC_OFF) + 8; xcd_barrier(bar, Fb.tid == 0); } while (0)
#define PHASE(...) do { if (lo <= ph && ph < hi) { { Frame F = make_frame(lds, wave0); __VA_ARGS__; } if (ph + 1 < hi) GRIDBAR(); } ++ph; } while (0)
    PHASE({ ph0_prologue(F); convert_weights(F, 0); { const f32x4* s = (const f32x4*)IN_(I_CTX); f32x4* d = (f32x4*)(F.ws + WS_XC); for (int i = F.bid * NT + F.tid; i < CTX * D / 4; i += F.G * NT) d[i] = s[i]; } });
    PHASE({ hprep_rows(F, 0); if (FM >> 3 & 1) s5_precompute(F); });
#pragma unroll 1
    for (int l = 0; l < 2; ++l) {
        PHASE({ if (FM >> 2 & 1) ph2_fast(F, l); else ph2_naive(F, l); });
        PHASE({ if (FM >> 3 & 1) { s5_z_phase(F, l); const int nch = (l == 0 ? MT : SEQ) / 128; if (F.G > nch) { if (F.bid < nch) sg_fast_chunk(F, l, F.bid); else { Frame F2 = F; F2.bid -= nch; F2.G -= nch; ph3_conv(F2, l, l == 0 ? MT : SEQ); } } else { for (int c = F.bid; c < nch; c += F.G) sg_fast_chunk(F, l, c); ph3_conv(F, l, l == 0 ? MT : SEQ); } } else { ph3_s5_naive(F, l); if (F.bid >= 64) { Frame F2 = F; F2.bid -= 64; F2.G -= 64; ph3_sg_naive(F2, l); ph3_conv(F2, l, MT); } } });
        PHASE({ if (FM >> 3 & 1) s5_scan_phase(F, l); });
        PHASE({ if (FM >> 3 & 1) s5_y_phase(F, l); else ph5_naive(F, l); });
        PHASE({ if (FM >> 6 & 1) ph6_fast(F, l); else ph6_naive(F, l); });
        PHASE({ if (FM >> 7 & 1) ph7_fast(F, l); else ph7_naive(F, l); });
        PHASE({ if (FM >> 8 & 1) ph8_fast(F, l); else ph8_naive(F, l); });
        PHASE({ if (FM >> 9 & 1) ph9_fast(F, l); else ph9_naive(F, l); });
        PHASE(ph10_route(F, l));
        PHASE(ph11_scatter(F, l));
        PHASE({ if (FM >> 12 & 1) ph12_fast(F, l); else ph12_naive(F, l); });
        PHASE({ if (FM >> 13 & 1) ph13_fast(F, l); else ph13_naive(F, l); });
        PHASE({ ph14_combine(F, l); if (l == 0) convert_weights(F, 1); });
    }
#undef PHASE
}

extern "C" void kernel_launch(void* const* d_in, const int* in_sizes, int n_in, void* d_out, int out_size, void* d_ws, size_t ws_size, hipStream_t stream) {
    static int grid = 0;
    if (grid == 0) {
        int dev = 0, cus = 0, per_cu = 0;
        if (n_in != 35 || out_size != SEQ * D || ws_size < WS_END) { fprintf(stderr, "kernel_launch: unexpected shapes (n_in %d out %d ws %zu)\n", n_in, out_size, ws_size); grid = -1; return; }
        if (hipGetDevice(&dev) != hipSuccess || hipDeviceGetAttribute(&cus, hipDeviceAttributeMultiprocessorCount, dev) != hipSuccess) { grid = -1; return; }
        if (hipFuncSetAttribute((const void*)mega_fwd, hipFuncAttributeMaxDynamicSharedMemorySize, LDS_BYTES) != hipSuccess) { fprintf(stderr, "kernel_launch: hipFuncSetAttribute failed\n"); grid = -1; return; }
        if (hipOccupancyMaxActiveBlocksPerMultiprocessor(&per_cu, (const void*)mega_fwd, NT, LDS_BYTES) != hipSuccess || per_cu < 1) { fprintf(stderr, "kernel_launch: occupancy query says %d blocks per CU\n", per_cu); grid = -1; return; }
        grid = cus;
    }
    if (grid < 0) return;
    (void)hipMemsetAsync((char*)d_ws + WS_CTL, 0, CTL_ZERO_BYTES, stream);
    Args a{};
    for (int i = 0; i < 35; ++i) a.in[i] = (const float*)d_in[i];
    a.out = (float*)d_out; a.ws = (unsigned char*)d_ws; a.ph_lo = 0; a.ph_hi = NPH;
    void* kargs[] = {&a};
    hipError_t e = hipLaunchCooperativeKernel((const void*)mega_fwd, dim3(grid), dim3(NT), kargs, LDS_BYTES, stream);
    if (e != hipSuccess) fprintf(stderr, "kernel_launch: cooperative launch failed: %s (grid %d)\n", hipGetErrorString(e), grid);
}
```

```cpp
#include <hip/hip_runtime.h>
#include <stdint.h>
#include <cstdio>

#define GAS __attribute__((address_space(1)))
#define LAS __attribute__((address_space(3)))
typedef unsigned short bf16;
typedef unsigned v4u __attribute__((ext_vector_type(4)));
typedef unsigned v2u __attribute__((ext_vector_type(2)));
typedef float f32x4 __attribute__((ext_vector_type(4)));

constexpr int D = 1024, SEQ = 16384, CTX = 256, MT = SEQ + CTX;
constexpr int MIXW = 512, INW = 3072, G5 = 32, P5 = 64, H5 = 16;
constexpr int NE = 32, DFF = 256;
constexpr int MAXSLOT = 2 * MT + NE * 256;
constexpr float EPS = 1e-6f;
constexpr int NT = 512;

constexpr size_t MiB = 1u << 20;
constexpr size_t WS_CTL = 0, CTL_ZERO_BYTES = 1 * MiB;
constexpr size_t WS_MOD = 1 * MiB;
constexpr size_t WS_XC = 2 * MiB;
constexpr size_t WS_EID = 3 * MiB;
constexpr size_t WS_EW = WS_EID + (size_t)MT * 8;
constexpr size_t WS_STOK = WS_EW + (size_t)MT * 8;
constexpr size_t WS_SW = WS_STOK + (size_t)MAXSLOT * 4;
constexpr size_t WS_TSLOT = WS_SW + (size_t)MAXSLOT * 4;
constexpr size_t WS_H = 4 * MiB;
constexpr size_t WS_PROJ = WS_H + (size_t)MT * 2048;
constexpr size_t WS_YS = WS_PROJ + (size_t)MT * 6144;
constexpr size_t WS_YG = WS_YS + (size_t)3 * MT * 1024;
constexpr size_t WS_PM = WS_YG + (size_t)MT * 1024;
constexpr size_t WS_S5 = WS_PM + (size_t)MT * 2048;
constexpr size_t WS_Z = WS_S5;
constexpr size_t WS_SS = WS_Z + (size_t)1040 * 32 * 256 * 4;
constexpr size_t WS_S5M = WS_SS + (size_t)1040 * 32 * 256 * 2;
constexpr size_t WS_A16 = WS_S5M + (size_t)2 * 32 * 3 * 65536 * 2;
constexpr size_t WS_W = WS_A16 + (size_t)2 * 32 * 2 * 64 * 2 * 4 > WS_S5 + (size_t)2 * MT * 512 * 4 ? WS_A16 + (size_t)2 * 32 * 2 * 64 * 2 * 4 : WS_S5 + (size_t)2 * MT * 512 * 4;
constexpr size_t WS_WIN = WS_W;
constexpr size_t WS_WMG = WS_WIN + (size_t)3072 * 1024 * 2;
constexpr size_t WS_WGLU = WS_WMG + (size_t)3072 * 1024 * 2;
constexpr size_t WS_WBR = WS_WGLU + (size_t)512 * 512 * 2;
constexpr size_t WS_WO = WS_WBR + (size_t)3 * 1024 * 512 * 2;
constexpr size_t WS_W13 = WS_WO + (size_t)1024 * 1024 * 2;
constexpr size_t WS_W2 = WS_W13 + (size_t)32 * 512 * 1024 * 2;
constexpr size_t WS_WSG = WS_W2 + (size_t)32 * 1024 * 256 * 2;
constexpr size_t WS_WR = WS_WSG + (size_t)4 * 128 * 128 * 2;
constexpr size_t WS_END = WS_WR + (size_t)2 * 48 * 1024 * 2;
static_assert(WS_END <= (size_t)377 * MiB, "workspace budget");
constexpr size_t WS_HS = WS_PROJ;
constexpr size_t WS_ACT = WS_YS;
constexpr size_t WS_YS2 = WS_YG;
static_assert(WS_HS + (size_t)MAXSLOT * 2048 <= WS_YS && WS_ACT + (size_t)MAXSLOT * 512 <= WS_YG && WS_YS2 + (size_t)MAXSLOT * 2048 <= WS_W, "moe overlays");
static_assert(WS_TSLOT + (size_t)MT * 8 <= WS_H, "ws map");
constexpr int CW_CNT = 64;
constexpr int CW_BAR = 4096;

#ifndef PROBE_A
#define PROBE_A -1
#endif
#ifndef PROBE_B
#define PROBE_B -1
#endif
constexpr int TS_OFF = 131072 + 512;
constexpr int LDS_BYTES = 147456;
constexpr int MISC_OFF = 131072 + 320;
constexpr int TAB_OFF = 131072 + 1024;

__device__ __forceinline__ float bf2f(unsigned short b) { return __builtin_bit_cast(float, ((unsigned)b) << 16); }
__device__ __forceinline__ unsigned f2bf(float f) { unsigned u = __builtin_bit_cast(unsigned, f); return (u + 0x7fffu + ((u >> 16) & 1u)) >> 16; }
__device__ __forceinline__ unsigned pk2(float lo, float hi) { return f2bf(lo) | (f2bf(hi) << 16); }
__device__ __forceinline__ float sigmoidf_(float x) { return 1.f / (1.f + __expf(-x)); }
__device__ __forceinline__ float siluf_(float x) { return x / (1.f + __expf(-x)); }
__device__ __forceinline__ float geluf_(float x) { const float u = 0.7978845608028654f * (x + 0.044715f * x * x * x); return x / (1.f + __expf(-2.f * u)); }
__device__ __forceinline__ float wave_sum(float v) {
#pragma unroll
    for (int o = 1; o < 64; o <<= 1) v += __shfl_xor(v, o);
    return v;
}

#define XB_TMO      128
#define XB_XCNT(j)  (256  + 64 * (j))
#define XB_XSUB(j)  (1280 + 64 * (j))
#define XB_XGEN(j)  (2304 + 64 * (j))
#define XB_TOP      3328
#define XB_TOPGEN   3392
#define XCD_BAR_WORDS 3456
#define XB_SPIN_CAP (1u << 24)
__device__ __forceinline__ unsigned xb_ld(unsigned* p)              { return __hip_atomic_load(p, __ATOMIC_RELAXED, __HIP_MEMORY_SCOPE_AGENT); }
__device__ __forceinline__ unsigned xb_add(unsigned* p, unsigned v) { return __hip_atomic_fetch_add(p, v, __ATOMIC_RELAXED, __HIP_MEMORY_SCOPE_AGENT); }
__device__ __forceinline__ unsigned xb_xcc_id() { return (unsigned)__builtin_amdgcn_s_getreg((3 << 11) | 20) & 0xFu; }
#define XB_SPIN(cond, bar) do { unsigned _sp = 0; while (cond) { __builtin_amdgcn_s_sleep(1); \
    if ((++_sp & 255u) == 0u) { if (xb_ld(&(bar)[XB_TMO])) break; if (_sp > XB_SPIN_CAP) { atomicAdd(&(bar)[XB_TMO], 1u); break; } } } } while (0)
struct XcdBarrier { unsigned* bar; unsigned x; volatile LAS unsigned* st; };
__device__ __forceinline__ XcdBarrier xcd_barrier_post(unsigned* bar, volatile LAS unsigned* st) {
    XcdBarrier b; b.bar = bar; b.x = xb_xcc_id(); b.st = st;
    if (threadIdx.x == 0) (void)xb_add(&bar[XB_XCNT(b.x)], 1u);
    return b;
}
__device__ __forceinline__ void xcd_barrier_complete(unsigned* bar, unsigned x, unsigned& nloc, unsigned& nx) {
    const unsigned G = gridDim.x * gridDim.y * gridDim.z;
    unsigned sum, cnt, mine, sp = 0u;
    for (;;) {
        sum = 0u; cnt = 0u; mine = 0u;
#pragma unroll
        for (unsigned j = 0; j < 16; ++j) { const unsigned c = xb_ld(&bar[XB_XCNT(j)]); sum += c; cnt += (c > 0u) ? 1u : 0u; mine = (j == x) ? c : mine; }
        if (sum == G) break;
        __builtin_amdgcn_s_sleep(1);
        if ((++sp & 255u) == 0u) { if (xb_ld(&bar[XB_TMO])) break; if (sp > XB_SPIN_CAP) { atomicAdd(&bar[XB_TMO], 1u); break; } }
    }
    nloc = mine > 0u ? mine : 1u; nx = cnt > 0u ? cnt : 1u;
}
__device__ __forceinline__ void xcd_barrier(const XcdBarrier& b, bool leader) {
    asm volatile("s_waitcnt vmcnt(0)" ::: "memory");
    __syncthreads();
    if (leader) {
        unsigned* bar = b.bar;
        __builtin_amdgcn_s_waitcnt(0);
        unsigned nloc = b.st[0], nx = b.st[1];
        if (nloc == 0u) { xcd_barrier_complete(bar, b.x, nloc, nx); b.st[0] = nloc; b.st[1] = nx; }
        const unsigned old = xb_add(&bar[XB_XSUB(b.x)], 1u);
        const unsigned gen = old / nloc;
        if (old + 1u == (gen + 1u) * nloc) {
            __builtin_amdgcn_fence(__ATOMIC_RELEASE, "agent");
            asm volatile("s_waitcnt vmcnt(0)" ::: "memory");
            const unsigned og = xb_add(&bar[XB_TOP], 1u);
            const unsigned tg = og / nx;
            if (og + 1u == (tg + 1u) * nx) xb_add(&bar[XB_TOPGEN], 1u);
            else XB_SPIN(xb_ld(&bar[XB_TOPGEN]) == tg, bar);
            __builtin_amdgcn_fence(__ATOMIC_ACQUIRE, "agent");
            xb_add(&bar[XB_XGEN(b.x)], 1u);
            asm volatile("s_waitcnt vmcnt(0)" ::: "memory");
        } else {
            XB_SPIN(xb_ld(&bar[XB_XGEN(b.x)]) == gen, bar);
            __builtin_amdgcn_fence(__ATOMIC_ACQUIRE, "agent");
            asm volatile("s_waitcnt vmcnt(0)" ::: "memory");
        }
    }
    __syncthreads();
}

struct Args { const float* in[35]; float* out; unsigned char* ws; int ph_lo, ph_hi; };
struct Frame {
    LAS unsigned char* lds; unsigned char* ws; unsigned* ctl;
    int tid, lane, wave, bid, G;
    const unsigned long long LAS* tab; float* out;
};
__device__ __forceinline__ unsigned long long uni64(unsigned long long v) { const unsigned lo = __builtin_amdgcn_readfirstlane((unsigned)v), hi = __builtin_amdgcn_readfirstlane((unsigned)(v >> 32)); return ((unsigned long long)hi << 32) | lo; }
#define IN_(k) ((const float*)uni64(F.tab[k]))
enum { I_X = 0, I_C, I_CTX, I_CCTX, I_WADA, I_BADA, I_GMIX, I_GFFN, I_WIN, I_LRE, I_LIM, I_LDT, I_BRE, I_BIM, I_CRE, I_CIM, I_DSKIP, I_WGLU, I_SGG, I_SGB, I_WSG, I_BSG,
       I_WCONV, I_WBR, I_WMG, I_BMG, I_WO, I_WGRP, I_BGRP, I_WEXP, I_BEXP, I_W1, I_W3, I_W2, I_GF };

__device__ __forceinline__ const float* mod_ptr(const Frame& F, int l, int row) { return (const float*)(F.ws + WS_MOD) + (size_t)(l * 2 + (row >= SEQ ? 1 : 0)) * 6144; }
__device__ __forceinline__ const float* xsrc_row(const Frame& F, int l, int row) {
    if (l == 0) return row < SEQ ? IN_(I_X) + (size_t)row * D : IN_(I_CTX) + (size_t)(row - SEQ) * D;
    return row < SEQ ? F.out + (size_t)row * D : (const float*)(F.ws + WS_XC) + (size_t)(row - SEQ) * D;
}
__device__ __forceinline__ float* xrun_row(const Frame& F, int row) { return row < SEQ ? F.out + (size_t)row * D : (float*)(F.ws + WS_XC) + (size_t)(row - SEQ) * D; }


namespace pg8 {
#define PG8_LAS __attribute__((address_space(3)))
typedef unsigned short bf16_t;
typedef short bf16x8 __attribute__((ext_vector_type(8)));
typedef float f32x4 __attribute__((ext_vector_type(4)));
typedef unsigned u32x4 __attribute__((ext_vector_type(4)));
constexpr int BM = 256, BK = 64, HALF = 128, HTB = HALF * BK * 2  , STAGE_BYTES = 8 * HTB, NXCD = 8, WGM = 8;

__host__ __device__ __forceinline__ int lds_byte(int r, int c) { const int st = (r >> 4) * 2 + (c >> 5), rr = r & 15, cc = c & 31, ob = rr * 64 + cc * 2; return st * 1024 + (ob ^ (((ob >> 9) & 1) << 5)); }
__host__ __device__ __forceinline__ void stage_rc(int b, int& R, int& C) { const int st = b / 1024, sb = b % 1024, swz = sb ^ (((sb >> 9) & 1) << 5); R = (st >> 1) * 16 + swz / 64; C = (st & 1) * 32 + (swz % 64) / 2; }
__host__ __device__ __forceinline__ int perm32(int rho) { const int n = rho >> 4, i = rho & 15; return 8 * (i >> 2) + 4 * n + (i & 3); }

struct Unit { int pm, pn; };
struct Gemm { const bf16_t* A; const bf16_t* Bt; int M, N, K; };

struct StaticOrder {
    int nM, nN, nwg, G, c;
    __host__ __device__ void init(int M, int N, int G_, int c_) { nM = M / BM; nN = N / BM; nwg = nM * nN; G = G_; c = c_; }
    __host__ __device__ bool next(int i, Unit& u) const {
        const long L = (long)i * G + c; if (L >= nwg) return false;
        int wgid = (int)L; { const int q = nwg / NXCD, r = nwg % NXCD, xcd = wgid % NXCD, off = wgid / NXCD; wgid = (xcd < r ? xcd * (q + 1) : r * (q + 1) + (xcd - r) * q) + off; }
        const int nig = WGM * nN, gid = wgid / nig, fm = gid * WGM, gsz = (nM - fm) < WGM ? (nM - fm) : WGM;
        u.pm = fm + ((wgid % nig) % gsz); u.pn = (wgid % nig) / gsz; return true;
    }
    __device__ __forceinline__ void a_ready(const Unit&) const {}
    __device__ __forceinline__ void done(const Unit&) const {}
};
__device__ __forceinline__ unsigned cvt_pk_bf16(float lo, float hi) { unsigned r; asm volatile("v_cvt_pk_bf16_f32 %0, %1, %2" : "=v"(r) : "v"(lo), "v"(hi)); return r; }
template <class Epi, class Sched, bool ALIGN_EPI = false, bool SP2 = false>
__device__ __forceinline__ void gemm_phase(PG8_LAS unsigned char* lds, const Gemm g, const Sched& S, const Epi& E, int tid_in) {
    int tid_ = tid_in; asm volatile("" : "+v"(tid_));
    const int tid = tid_, wid = __builtin_amdgcn_readfirstlane(tid >> 6), lane = tid & 63, wr = wid >> 2, wc = wid & 3, fr = lane & 15, fq = lane >> 4;
    const int K = g.K, nt = K / BK;
    unsigned voffA[2], voffB[2];
#pragma unroll
    for (int i = 0; i < 2; ++i) { int R, C; stage_rc(tid * 16 + i * 8192, R, C); const int Rb = Epi::PERM ? ((R & ~31) + perm32(R & 31)) : R;
        voffA[i] = (unsigned)(R * K + C) * 2u; voffB[i] = (unsigned)(Rb * K + C) * 2u; }
    const size_t kstep = (size_t)(BK * 2);
    const size_t hstep = (size_t)HALF * K * 2;
    const size_t tstep = 2 * hstep;
    const unsigned ldsw = (unsigned)wid * 1024u;
    const int aoff = lds_byte(wr * 64 + fr, fq * 8), boff = lds_byte(wc * 32 + fr, fq * 8);
#define PG8_SA(b, h) (((b) * 2 + (h)) * HTB)
#define PG8_SB(b, h) ((4 + (b) * 2 + (h)) * HTB)
#define PG8_STAGE(bufoff, gbase, voff) do { _Pragma("unroll") for (int _i = 0; _i < 2; ++_i) \
        __builtin_amdgcn_global_load_lds((const unsigned*)((const char*)(gbase) + (voff)[_i]), (PG8_LAS unsigned*)(lds + (bufoff) + ldsw + _i * 8192), 16, 0, 0); } while (0)
#define PG8_LDA(dst, b, h) do { _Pragma("unroll") for (int m = 0; m < 4; ++m) _Pragma("unroll") for (int k = 0; k < 2; ++k) dst[m][k] = *(const PG8_LAS bf16x8*)(lds + PG8_SA(b, h) + aoff + m * 2048 + k * 1024); } while (0)
#define PG8_LDB(dst, b, h) do { _Pragma("unroll") for (int n = 0; n < 2; ++n) _Pragma("unroll") for (int k = 0; k < 2; ++k) dst[n][k] = *(const PG8_LAS bf16x8*)(lds + PG8_SB(b, h) + boff + n * 2048 + k * 1024); } while (0)
#define PG8_MMA(ai, bj, At, Bt) do { __builtin_amdgcn_s_setprio(1); _Pragma("unroll") for (int m = 0; m < 4; ++m) _Pragma("unroll") for (int n = 0; n < 2; ++n) _Pragma("unroll") for (int k = 0; k < 2; ++k) \
        acc[ai][bj][m][n] = __builtin_amdgcn_mfma_f32_16x16x32_bf16(Bt[n][k], At[m][k], acc[ai][bj][m][n], 0, 0, 0); __builtin_amdgcn_s_setprio(0); } while (0)
#define PG8_WAIT_V(n) asm volatile("s_waitcnt vmcnt(" #n ")" ::: "memory")
#define PG8_WAIT_L(n) asm volatile("s_waitcnt lgkmcnt(" #n ")" ::: "memory")
#define PG8_BAR __builtin_amdgcn_s_barrier()
#define PG8_SCHED __builtin_amdgcn_sched_barrier(0)
    Unit cur, nxt; int ui = 0;
    if (!S.next(0, cur)) return;
    f32x4 acc[2][2][4][2];
#pragma unroll
    for (int a = 0; a < 2; ++a)
#pragma unroll
        for (int b = 0; b < 2; ++b)
#pragma unroll
            for (int m = 0; m < 4; ++m)
#pragma unroll
                for (int n = 0; n < 2; ++n) acc[a][b][m][n] = (f32x4){0.f, 0.f, 0.f, 0.f};
    bf16x8 At[4][2], B0[2][2], B1[2][2];
    const char* cA = (const char*)g.A + (size_t)cur.pm * tstep; const char* cB = (const char*)g.Bt + (size_t)cur.pn * tstep;
    S.a_ready(cur);
    if constexpr (SP2) {
        PG8_STAGE(PG8_SB(0, 0), cB, voffB); PG8_STAGE(PG8_SB(0, 1), cB + hstep, voffB); PG8_STAGE(PG8_SA(0, 0), cA, voffA); PG8_STAGE(PG8_SA(0, 1), cA + hstep, voffA);
        if (wr == 1) PG8_BAR;
        PG8_WAIT_V(2); PG8_BAR;
        PG8_STAGE(PG8_SB(1, 0), cB + kstep, voffB); PG8_STAGE(PG8_SA(1, 0), cA + kstep, voffA); PG8_STAGE(PG8_SB(1, 1), cB + hstep + kstep, voffB);
        PG8_WAIT_V(6); PG8_BAR;
    } else {
        PG8_STAGE(PG8_SB(0, 0), cB, voffB); PG8_STAGE(PG8_SA(0, 0), cA, voffA); PG8_STAGE(PG8_SB(0, 1), cB + hstep, voffB); PG8_STAGE(PG8_SA(0, 1), cA + hstep, voffA);
        if (wr == 1) PG8_BAR;
        PG8_WAIT_V(4); PG8_BAR;
        PG8_STAGE(PG8_SB(1, 0), cB + kstep, voffB); PG8_STAGE(PG8_SA(1, 0), cA + kstep, voffA); PG8_STAGE(PG8_SB(1, 1), cB + hstep + kstep, voffB);
        PG8_WAIT_V(6); PG8_BAR;
    }
    for (;;) {
        const bool has_next = S.next(ui + 1, nxt);
        const char* nA = has_next ? (const char*)g.A + (size_t)nxt.pm * tstep : cA; const char* nB = has_next ? (const char*)g.Bt + (size_t)nxt.pn * tstep : cB;
#pragma unroll 1
        for (int t = 0; t < nt; t += 2) {
            const bool last = (t == nt - 2);
            const char* a1 = cA + (size_t)(t + 1) * kstep;
            const char* a2 = last ? nA : cA + (size_t)(t + 2) * kstep; const char* b2 = last ? nB : cB + (size_t)(t + 2) * kstep;
            const char* a3 = a2 + kstep; const char* b3 = b2 + kstep;
            if (last && has_next) S.a_ready(nxt);
            if constexpr (SP2) {
            PG8_LDB(B0, 0, 0); PG8_LDB(B1, 0, 1); PG8_SCHED; PG8_LDA(At, 0, 0); PG8_STAGE(PG8_SA(1, 1), a1 + hstep, voffA);
            PG8_WAIT_V(8); PG8_WAIT_L(0); PG8_BAR; PG8_MMA(0, 0, At, B0); PG8_MMA(0, 1, At, B1); PG8_BAR; PG8_SCHED;
            PG8_LDA(At, 0, 1); PG8_STAGE(PG8_SB(0, 0), b2, voffB); PG8_STAGE(PG8_SB(0, 1), b2 + hstep, voffB); PG8_STAGE(PG8_SA(0, 0), a2, voffA);
            PG8_WAIT_V(8); PG8_WAIT_L(0); PG8_BAR; PG8_MMA(1, 0, At, B0); PG8_MMA(1, 1, At, B1); PG8_BAR; PG8_SCHED;
            PG8_LDB(B0, 1, 0); PG8_LDB(B1, 1, 1); PG8_SCHED; PG8_LDA(At, 1, 0); PG8_STAGE(PG8_SA(0, 1), a2 + hstep, voffA);
            PG8_WAIT_V(8); PG8_WAIT_L(0); PG8_BAR; PG8_MMA(0, 0, At, B0); PG8_MMA(0, 1, At, B1); PG8_BAR; PG8_SCHED;
            PG8_LDA(At, 1, 1); PG8_STAGE(PG8_SB(1, 0), b3, voffB); PG8_STAGE(PG8_SB(1, 1), b3 + hstep, voffB); PG8_STAGE(PG8_SA(1, 0), a3, voffA);
            PG8_WAIT_V(8); PG8_WAIT_L(0); PG8_BAR; PG8_MMA(1, 0, At, B0); PG8_MMA(1, 1, At, B1); PG8_BAR; PG8_SCHED;
            } else {
            PG8_LDB(B0, 0, 0); PG8_SCHED; PG8_LDA(At, 0, 0); PG8_STAGE(PG8_SA(1, 1), a1 + hstep, voffA);
            PG8_WAIT_L(8); PG8_BAR; PG8_WAIT_L(0); PG8_MMA(0, 0, At, B0); PG8_BAR; PG8_SCHED;
            PG8_LDB(B1, 0, 1); PG8_STAGE(PG8_SB(0, 0), b2, voffB);
            PG8_BAR; PG8_WAIT_L(0); PG8_MMA(0, 1, At, B1); PG8_BAR;
            PG8_LDA(At, 0, 1); PG8_STAGE(PG8_SA(0, 0), a2, voffA);
            PG8_BAR; PG8_WAIT_L(0); PG8_MMA(1, 0, At, B0); PG8_BAR; PG8_SCHED;
            PG8_STAGE(PG8_SB(0, 1), b2 + hstep, voffB);
            PG8_WAIT_V(6); PG8_BAR; PG8_MMA(1, 1, At, B1); PG8_BAR;
            PG8_LDB(B0, 1, 0); PG8_SCHED; PG8_LDA(At, 1, 0); PG8_STAGE(PG8_SA(0, 1), a2 + hstep, voffA);
            PG8_WAIT_L(8); PG8_BAR; PG8_WAIT_L(0); PG8_MMA(0, 0, At, B0); PG8_BAR; PG8_SCHED;
            PG8_LDB(B1, 1, 1); PG8_STAGE(PG8_SB(1, 0), b3, voffB);
            PG8_BAR; PG8_WAIT_L(0); PG8_MMA(0, 1, At, B1); PG8_BAR;
            PG8_LDA(At, 1, 1); PG8_STAGE(PG8_SA(1, 0), a3, voffA);
            PG8_BAR; PG8_WAIT_L(0); PG8_MMA(1, 0, At, B0); PG8_BAR; PG8_SCHED;
            PG8_STAGE(PG8_SB(1, 1), b3 + hstep, voffB);
            PG8_WAIT_V(6); PG8_BAR; PG8_MMA(1, 1, At, B1); PG8_BAR;
            }
        }
        if constexpr (ALIGN_EPI) { if (wr == 0) PG8_BAR; }
        if constexpr (!Epi::AFTER_DRAIN) { E(acc, cur, wr, wc, fr, fq); S.done(cur); }
        if (!has_next) break;
#pragma unroll
        for (int a = 0; a < 2; ++a)
#pragma unroll
            for (int b = 0; b < 2; ++b)
#pragma unroll
                for (int m = 0; m < 4; ++m)
#pragma unroll
                    for (int n = 0; n < 2; ++n) acc[a][b][m][n] = (f32x4){0.f, 0.f, 0.f, 0.f};
        cur = nxt; cA = nA; cB = nB; ++ui;
        if constexpr (ALIGN_EPI) { if (wr == 1) PG8_BAR; }
    }
    PG8_WAIT_V(0);
    if constexpr (!ALIGN_EPI) { if (wr == 0) PG8_BAR; }
    PG8_BAR;
    if constexpr (Epi::AFTER_DRAIN) { E.fused(acc, cur, wr, wc, fr, fq, lds, wid, lane); S.done(cur); }
#undef PG8_SA
#undef PG8_SB
#undef PG8_STAGE
#undef PG8_LDA
#undef PG8_LDB
#undef PG8_MMA
#undef PG8_WAIT_V
#undef PG8_WAIT_L
#undef PG8_BAR
#undef PG8_SCHED
}
}

constexpr bool PG_ALIGN = true, PG_SP2 = true;
__device__ __forceinline__ float bflo(unsigned w) { return __builtin_bit_cast(float, w << 16); }
__device__ __forceinline__ float bfhi(unsigned w) { return __builtin_bit_cast(float, w & 0xffff0000u); }
__device__ __forceinline__ unsigned cvtpk(float lo, float hi) { return pg8::cvt_pk_bf16(lo, hi); }

__device__ __forceinline__ void transpose_item(const float* W, int N, int k0, int n0, bf16* WT, int K, size_t dst_row0, LAS float* scr, int lane) {
#pragma unroll 8
    for (int i = 0; i < 32; ++i) { const int kk = 2 * i + (lane >> 5); scr[kk * 33 + (lane & 31)] = W[(size_t)(k0 + kk) * N + n0 + (lane & 31)]; }
    asm volatile("s_waitcnt lgkmcnt(0)" ::: "memory");
    const int c = lane & 7;
#pragma unroll
    for (int j = 0; j < 4; ++j) { const int n = (lane >> 3) + 8 * j; const LAS float* s = scr + (8 * c) * 33 + n;
        v4u o; o.x = pk2(s[0 * 33], s[1 * 33]); o.y = pk2(s[2 * 33], s[3 * 33]); o.z = pk2(s[4 * 33], s[5 * 33]); o.w = pk2(s[6 * 33], s[7 * 33]);
        *(v4u*)(WT + (dst_row0 + n) * K + k0 + 8 * c) = o; }
    asm volatile("s_waitcnt lgkmcnt(0)" ::: "memory");
}
__device__ __forceinline__ void convert_weights(Frame& F, int l) {
    LAS float* scr = (LAS float*)(F.lds + F.wave * 16384);
    const int gw = F.bid * (NT / 64) + F.wave, ngw = F.G * (NT / 64);
    constexpr int I_IN = 16 * 96, I_MG = 16 * 96, I_GLU = 8 * 16, I_BR = 3 * 8 * 32, I_O = 16 * 32, I_1 = 32 * 16 * 8, I_3 = I_1, I_2 = 32 * 4 * 32;
    constexpr int NITEMS = I_IN + I_MG + I_GLU + I_BR + I_O + I_1 + I_3 + I_2;
    for (int it = gw; it < NITEMS; it += ngw) {
        int r = it;
        if (r < I_IN) { const int kb = r / 96, nb = r % 96; transpose_item(IN_(I_WIN) + (size_t)l * D * INW, INW, 64 * kb, 32 * nb, (bf16*)(F.ws + WS_WIN), 1024, 32 * nb, scr, F.lane); continue; } r -= I_IN;
        if (r < I_MG) { const int kb = r / 96, nb = r % 96; transpose_item(IN_(I_WMG) + (size_t)l * D * INW, INW, 64 * kb, 32 * nb, (bf16*)(F.ws + WS_WMG), 1024, 32 * nb, scr, F.lane); continue; } r -= I_MG;
        if (r < I_GLU) { const int kb = r / 16, nb = r % 16; transpose_item(IN_(I_WGLU) + (size_t)l * MIXW * MIXW, MIXW, 64 * kb, 32 * nb, (bf16*)(F.ws + WS_WGLU), 512, 32 * nb, scr, F.lane); continue; } r -= I_GLU;
        if (r < I_BR) { const int kk = r / 256, q = r % 256, kb = q / 32, nb = q % 32; transpose_item(IN_(I_WBR) + ((size_t)l * 3 + kk) * MIXW * D, D, 64 * kb, 32 * nb, (bf16*)(F.ws + WS_WBR), 512, (size_t)kk * 1024 + 32 * nb, scr, F.lane); continue; } r -= I_BR;
        if (r < I_O) { const int kb = r / 32, nb = r % 32; transpose_item(IN_(I_WO) + (size_t)l * D * D, D, 64 * kb, 32 * nb, (bf16*)(F.ws + WS_WO), 1024, 32 * nb, scr, F.lane); continue; } r -= I_O;
        if (r < I_1 + I_3) { const int which = r / I_1, q = r % I_1, e = q / 128, q2 = q % 128, kb = q2 / 8, nb = q2 % 8;
            const float* W = IN_(which ? I_W3 : I_W1) + ((size_t)l * NE + e) * D * DFF; const int n0 = 32 * nb;
            transpose_item(W, DFF, 64 * kb, n0, (bf16*)(F.ws + WS_W13), 1024, (size_t)e * 512 + (n0 / 128) * 256 + which * 128 + (n0 % 128), scr, F.lane); continue; } r -= I_1 + I_3;
        { const int e = r / 128, q = r % 128, kb = q / 32, nb = q % 32; transpose_item(IN_(I_W2) + ((size_t)l * NE + e) * DFF * D, D, 64 * kb, 32 * nb, (bf16*)(F.ws + WS_W2), 256, (size_t)e * 1024 + 32 * nb, scr, F.lane); }
    }
    { bf16* wr = (bf16*)(F.ws + WS_WR); const float* wg = IN_(I_WGRP) + (size_t)l * D * 4; const float* we = IN_(I_WEXP) + (size_t)l * D * 32;
      for (int i = F.bid * NT + F.tid; i < 48 * 1024; i += F.G * NT) { const int n = i >> 10, kk = i & 1023; const float w = n < 4 ? wg[kk * 4 + n] : (n < 36 ? we[kk * 32 + n - 4] : 0.f);
          const unsigned hi = f2bf(w); const float lo = w - __builtin_bit_cast(float, hi << 16); wr[i] = (bf16)hi; wr[48 * 1024 + i] = (bf16)f2bf(lo); } }
    { const float* s = IN_(I_WSG) + (size_t)l * 4 * 128 * 128; bf16* d = (bf16*)(F.ws + WS_WSG);
      for (int i = (F.bid * NT + F.tid) * 2; i < 4 * 128 * 128; i += F.G * NT * 2) *(unsigned*)(d + i) = pk2(s[i], s[i + 1]); }
}

struct EpiProj { static constexpr bool PERM = true, AFTER_DRAIN = false; bf16* O;
    __device__ __forceinline__ void operator()(const pg8::f32x4 (&acc)[2][2][4][2], const pg8::Unit& u, int wr, int wc, int fr, int fq) const {
        const int row0 = u.pm * 256 + wr * 64 + fr, col0 = u.pn * 256 + wc * 32 + 8 * fq; const bool act = (u.pn >= 2 && u.pn < 6);
#pragma unroll
        for (int ai = 0; ai < 2; ++ai)
#pragma unroll
            for (int m = 0; m < 4; ++m) { bf16* rowp = O + (size_t)(row0 + ai * 128 + m * 16) * INW + col0;
#pragma unroll
                for (int bj = 0; bj < 2; ++bj) { pg8::f32x4 v0 = acc[ai][bj][m][0], v1 = acc[ai][bj][m][1];
                    if (act) {
#pragma unroll
                        for (int j = 0; j < 4; ++j) { v0[j] = geluf_(v0[j]); v1[j] = geluf_(v1[j]); } }
                    v4u w; w.x = cvtpk(v0[0], v0[1]); w.y = cvtpk(v0[2], v0[3]); w.z = cvtpk(v1[0], v1[1]); w.w = cvtpk(v1[2], v1[3]); *(v4u*)(rowp + bj * 128) = w; } }
    } };
struct EpiGlu { static constexpr bool PERM = true, AFTER_DRAIN = false; const bf16* YG; bf16* YA;
    __device__ __forceinline__ void operator()(const pg8::f32x4 (&acc)[2][2][4][2], const pg8::Unit& u, int wr, int wc, int fr, int fq) const {
        const int row0 = u.pm * 256 + wr * 64 + fr, col0 = u.pn * 256 + wc * 32 + 8 * fq;
#pragma unroll
        for (int ai = 0; ai < 2; ++ai)
#pragma unroll
            for (int m = 0; m < 4; ++m) { const size_t off = (size_t)(row0 + ai * 128 + m * 16) * MIXW + col0;
#pragma unroll
                for (int bj = 0; bj < 2; ++bj) { const pg8::f32x4 v0 = acc[ai][bj][m][0], v1 = acc[ai][bj][m][1]; const v4u g = *(const v4u*)(YG + off + bj * 128);
                    v4u w; w.x = cvtpk(bflo(g.x) * sigmoidf_(v0[0]), bfhi(g.x) * sigmoidf_(v0[1])); w.y = cvtpk(bflo(g.y) * sigmoidf_(v0[2]), bfhi(g.y) * sigmoidf_(v0[3]));
                    w.z = cvtpk(bflo(g.z) * sigmoidf_(v1[0]), bfhi(g.z) * sigmoidf_(v1[1])); w.w = cvtpk(bflo(g.w) * sigmoidf_(v1[2]), bfhi(g.w) * sigmoidf_(v1[3])); *(v4u*)(YA + off + bj * 128) = w; } }
    } };
struct EpiBr { static constexpr bool PERM = true, AFTER_DRAIN = false; bf16* BR;
    __device__ __forceinline__ void operator()(const pg8::f32x4 (&acc)[2][2][4][2], const pg8::Unit& u, int wr, int wc, int fr, int fq) const {
        const int pm = u.pm % (MT / 256); const int row0 = pm * 256 + wr * 64 + fr, col0 = u.pn * 256 + wc * 32 + 8 * fq;
#pragma unroll
        for (int ai = 0; ai < 2; ++ai)
#pragma unroll
            for (int m = 0; m < 4; ++m) { bf16* rowp = BR + (size_t)(row0 + ai * 128 + m * 16) * INW + col0;
#pragma unroll
                for (int bj = 0; bj < 2; ++bj) { const pg8::f32x4 v0 = acc[ai][bj][m][0], v1 = acc[ai][bj][m][1];
                    v4u w; w.x = cvtpk(v0[0], v0[1]); w.y = cvtpk(v0[2], v0[3]); w.z = cvtpk(v1[0], v1[1]); w.w = cvtpk(v1[2], v1[3]); *(v4u*)(rowp + bj * 128) = w; } }
    } };
struct SchedBr { int G, c, nM;
    __device__ __forceinline__ bool next(int i, pg8::Unit& u) const { const int Lq = i * G + c; if (Lq >= 3 * nM * 4) return false; const int k = Lq / (nM * 4), r = Lq % (nM * 4);
        u.pm = k * (MT / 256) + r / 4; u.pn = k * 4 + r % 4; return true; }
    __device__ __forceinline__ void a_ready(const pg8::Unit&) const {}
    __device__ __forceinline__ void done(const pg8::Unit&) const {} };
struct EpiMerge { static constexpr bool PERM = true, AFTER_DRAIN = false; const bf16* BR; bf16* PM; const float* bm;
    __device__ __forceinline__ void operator()(const pg8::f32x4 (&acc)[2][2][4][2], const pg8::Unit& u, int wr, int wc, int fr, int fq) const {
        const int k = u.pn >> 2, dt = u.pn & 3; const int row0 = u.pm * 256 + wr * 64 + fr, col0 = dt * 256 + wc * 32 + 8 * fq;
#pragma unroll
        for (int bj = 0; bj < 2; ++bj) { const pg8::f32x4 b0 = *(const pg8::f32x4*)(bm + k * 1024 + col0 + bj * 128), b1 = *(const pg8::f32x4*)(bm + k * 1024 + col0 + bj * 128 + 4);
#pragma unroll
            for (int ai = 0; ai < 2; ++ai)
#pragma unroll
                for (int m = 0; m < 4; ++m) { const size_t r = (size_t)(row0 + ai * 128 + m * 16); const v4u br = *(const v4u*)(BR + r * INW + k * 1024 + col0 + bj * 128);
                    const pg8::f32x4 v0 = acc[ai][bj][m][0] + b0, v1 = acc[ai][bj][m][1] + b1;
                    float p[8] = {sigmoidf_(v0[0]) * bflo(br.x), sigmoidf_(v0[1]) * bfhi(br.x), sigmoidf_(v0[2]) * bflo(br.y), sigmoidf_(v0[3]) * bfhi(br.y),
                                  sigmoidf_(v1[0]) * bflo(br.z), sigmoidf_(v1[1]) * bfhi(br.z), sigmoidf_(v1[2]) * bflo(br.w), sigmoidf_(v1[3]) * bfhi(br.w)};
                    bf16* dst = PM + r * D + col0 + bj * 128;
                    if (k > 0) { const v4u o = *(const v4u*)dst; p[0] += bflo(o.x); p[1] += bfhi(o.x); p[2] += bflo(o.y); p[3] += bfhi(o.y); p[4] += bflo(o.z); p[5] += bfhi(o.z); p[6] += bflo(o.w); p[7] += bfhi(o.w); }
                    v4u w; w.x = cvtpk(p[0], p[1]); w.y = cvtpk(p[2], p[3]); w.z = cvtpk(p[4], p[5]); w.w = cvtpk(p[6], p[7]); *(v4u*)dst = w; } }
    } };
struct SchedMerge { int G, c, nM;
    __device__ __forceinline__ bool next(int i, pg8::Unit& u) const { const int v = (i / 3) * G + c, k = i % 3; if (v >= nM * 4) return false; u.pm = v >> 2; u.pn = k * 4 + (v & 3); return true; }
    __device__ __forceinline__ void a_ready(const pg8::Unit&) const {}
    __device__ __forceinline__ void done(const pg8::Unit&) const {} };
struct EpiWo { static constexpr bool PERM = false, AFTER_DRAIN = false; const float* xs_lat; const float* xs_ctx; float* out; float* xc; const float* mod_l;
    __device__ __forceinline__ void operator()(const pg8::f32x4 (&acc)[2][2][4][2], const pg8::Unit& u, int wr, int wc, int fr, int fq) const {
        const int row0 = u.pm * 256 + wr * 64 + fr, col0 = u.pn * 256 + wc * 32 + 4 * fq; const bool isctx = u.pm >= SEQ / 256;
        const float* ga = mod_l + (isctx ? 6144 : 0) + 2048;
#pragma unroll
        for (int ai = 0; ai < 2; ++ai)
#pragma unroll
            for (int m = 0; m < 4; ++m) { const int row = row0 + ai * 128 + m * 16; const size_t off = (size_t)(isctx ? row - SEQ : row) * D + col0;
                const float* src = (isctx ? xs_ctx : xs_lat) + off; float* dst = (isctx ? xc : out) + off;
#pragma unroll
                for (int bj = 0; bj < 2; ++bj)
#pragma unroll
                    for (int n = 0; n < 2; ++n) { const pg8::f32x4 g = *(const pg8::f32x4*)(ga + col0 + bj * 128 + n * 16); const pg8::f32x4 x = *(const pg8::f32x4*)(src + bj * 128 + n * 16);
                        *(pg8::f32x4*)(dst + bj * 128 + n * 16) = x + g * acc[ai][bj][m][n]; } }
    } };
constexpr int MOETAB_OFF = 131072 + 2048;
template <int NPN> __device__ __forceinline__ int moe_build_table(Frame& F, const unsigned* cnt) {
    LAS unsigned* tabw = (LAS unsigned*)(F.lds + MOETAB_OFF);
    int total = 0, rowtile0 = 0;
    for (int e = 0; e < NE; ++e) { const int nt_e = ((int)cnt[e] + 255) >> 8;
        for (int q = F.tid; q < nt_e * NPN; q += NT) tabw[total + q] = ((unsigned)(rowtile0 + q / NPN) << 16) | (unsigned)(e * NPN + q % NPN);
        total += nt_e * NPN; rowtile0 += nt_e; }
    __syncthreads();
    return total;
}
struct SchedMoe { int G, c, total; const LAS unsigned* tabw;
    __device__ __forceinline__ bool next(int i, pg8::Unit& u) const { const int Lq = i * G + c; if (Lq >= total) return false; const unsigned w = (unsigned)__builtin_amdgcn_readfirstlane((int)tabw[Lq]); u.pm = (int)(w >> 16); u.pn = (int)(w & 0xffffu); return true; }
    __device__ __forceinline__ void a_ready(const pg8::Unit&) const {}
    __device__ __forceinline__ void done(const pg8::Unit&) const {} };
struct EpiUp { static constexpr bool PERM = true, AFTER_DRAIN = false; bf16* ACT; const float* SW;
    __device__ __forceinline__ void operator()(const pg8::f32x4 (&acc)[2][2][4][2], const pg8::Unit& u, int wr, int wc, int fr, int fq) const {
        const int row0 = u.pm * 256 + wr * 64 + fr, f0 = (u.pn & 1) * 128 + wc * 32 + 8 * fq;
#pragma unroll
        for (int ai = 0; ai < 2; ++ai)
#pragma unroll
            for (int m = 0; m < 4; ++m) { const int slot = row0 + ai * 128 + m * 16; const float w = SW[slot];
                const pg8::f32x4 a0 = acc[ai][0][m][0], a1 = acc[ai][0][m][1], b0 = acc[ai][1][m][0], b1 = acc[ai][1][m][1];
                v4u o; o.x = cvtpk(siluf_(a0[0]) * b0[0] * w, siluf_(a0[1]) * b0[1] * w); o.y = cvtpk(siluf_(a0[2]) * b0[2] * w, siluf_(a0[3]) * b0[3] * w);
                o.z = cvtpk(siluf_(a1[0]) * b1[0] * w, siluf_(a1[1]) * b1[1] * w); o.w = cvtpk(siluf_(a1[2]) * b1[2] * w, siluf_(a1[3]) * b1[3] * w);
                *(v4u*)(ACT + (size_t)slot * DFF + f0) = o; }
    } };
struct EpiDown { static constexpr bool PERM = true, AFTER_DRAIN = false; bf16* YS2;
    __device__ __forceinline__ void operator()(const pg8::f32x4 (&acc)[2][2][4][2], const pg8::Unit& u, int wr, int wc, int fr, int fq) const {
        const int row0 = u.pm * 256 + wr * 64 + fr, col0 = (u.pn & 3) * 256 + wc * 32 + 8 * fq;
#pragma unroll
        for (int ai = 0; ai < 2; ++ai)
#pragma unroll
            for (int m = 0; m < 4; ++m) { bf16* rowp = YS2 + (size_t)(row0 + ai * 128 + m * 16) * D + col0;
#pragma unroll
                for (int bj = 0; bj < 2; ++bj) { const pg8::f32x4 v0 = acc[ai][bj][m][0], v1 = acc[ai][bj][m][1];
                    v4u w; w.x = cvtpk(v0[0], v0[1]); w.y = cvtpk(v0[2], v0[3]); w.z = cvtpk(v1[0], v1[1]); w.w = cvtpk(v1[2], v1[3]); *(v4u*)(rowp + bj * 128) = w; } }
    } };

__device__ __forceinline__ void ph2_fast(Frame& F, int l) {
    pg8::Gemm g{(const bf16*)(F.ws + WS_H), (const bf16*)(F.ws + WS_WIN), MT, INW, D}; pg8::StaticOrder S; S.init(MT, INW, F.G, F.bid);
    EpiProj E{(bf16*)(F.ws + WS_PROJ)}; pg8::gemm_phase<EpiProj, pg8::StaticOrder, PG_ALIGN, PG_SP2>(F.lds, g, S, E, F.tid);
}
__device__ __forceinline__ void ph6_fast(Frame& F, int l) {
    pg8::Gemm g{(const bf16*)(F.ws + WS_YG), (const bf16*)(F.ws + WS_WGLU), MT, MIXW, MIXW}; pg8::StaticOrder S; S.init(l == 0 ? MT : SEQ, MIXW, F.G, F.bid);
    EpiGlu E{(const bf16*)(F.ws + WS_YG), (bf16*)(F.ws + WS_YS)}; pg8::gemm_phase<EpiGlu, pg8::StaticOrder, PG_ALIGN, PG_SP2>(F.lds, g, S, E, F.tid);
}
__device__ __forceinline__ void ph7_fast(Frame& F, int l) {
    pg8::Gemm g{(const bf16*)(F.ws + WS_YS), (const bf16*)(F.ws + WS_WBR), 3 * MT, 3 * D, MIXW}; SchedBr S{F.G, F.bid, l == 0 ? MT / 256 : SEQ / 256};
    EpiBr E{(bf16*)(F.ws + WS_PROJ)}; pg8::gemm_phase<EpiBr, SchedBr, PG_ALIGN, PG_SP2>(F.lds, g, S, E, F.tid);
}
__device__ __forceinline__ void ph8_fast(Frame& F, int l) {
    pg8::Gemm g{(const bf16*)(F.ws + WS_H), (const bf16*)(F.ws + WS_WMG), MT, INW, D}; SchedMerge S{F.G, F.bid, l == 0 ? MT / 256 : SEQ / 256};
    EpiMerge E{(const bf16*)(F.ws + WS_PROJ), (bf16*)(F.ws + WS_PM), IN_(I_BMG) + l * INW}; pg8::gemm_phase<EpiMerge, SchedMerge, PG_ALIGN, PG_SP2>(F.lds, g, S, E, F.tid);
}
__device__ __forceinline__ void ph9_fast(Frame& F, int l) {
    pg8::Gemm g{(const bf16*)(F.ws + WS_PM), (const bf16*)(F.ws + WS_WO), MT, D, D}; pg8::StaticOrder S; S.init(l == 0 ? MT : SEQ, D, F.G, F.bid);
    EpiWo E{l == 0 ? IN_(I_X) : F.out, l == 0 ? IN_(I_CTX) : (const float*)(F.ws + WS_XC), F.out, (float*)(F.ws + WS_XC), (const float*)(F.ws + WS_MOD) + (size_t)l * 2 * 6144};
    pg8::gemm_phase<EpiWo, pg8::StaticOrder, PG_ALIGN, PG_SP2>(F.lds, g, S, E, F.tid);
}
__device__ __forceinline__ void ph12_fast(Frame& F, int l) {
    pg8::Gemm g{(const bf16*)(F.ws + WS_HS), (const bf16*)(F.ws + WS_W13), MAXSLOT, NE * 512, D}; const int total = moe_build_table<2>(F, F.ctl + CW_CNT + l * 128); SchedMoe S{F.G, F.bid, total, (const LAS unsigned*)(F.lds + MOETAB_OFF)};
    EpiUp E{(bf16*)(F.ws + WS_ACT), (const float*)(F.ws + WS_SW)}; pg8::gemm_phase<EpiUp, SchedMoe, PG_ALIGN, PG_SP2>(F.lds, g, S, E, F.tid);
}
__device__ __forceinline__ void ph13_fast(Frame& F, int l) {
    pg8::Gemm g{(const bf16*)(F.ws + WS_ACT), (const bf16*)(F.ws + WS_W2), MAXSLOT, NE * D, DFF}; const int total = moe_build_table<4>(F, F.ctl + CW_CNT + l * 128); SchedMoe S{F.G, F.bid, total, (const LAS unsigned*)(F.lds + MOETAB_OFF)};
    EpiDown E{(bf16*)(F.ws + WS_YS2)}; pg8::gemm_phase<EpiDown, SchedMoe, PG_ALIGN, PG_SP2>(F.lds, g, S, E, F.tid);
}


typedef short bf16x8 __attribute__((ext_vector_type(8)));
constexpr int NSB = MT / 16;
__device__ __forceinline__ void s5_precompute(Frame& F) {
    LAS float* APr = (LAS float*)F.lds; LAS float* APi = APr + 2176; LAS float* BBr = APi + 2176; LAS float* BBi = BBr + 2048; LAS float* CCr = BBi + 2048; LAS float* CCi = CCr + 2048; LAS float* KK = CCi + 2048;
    for (int item = F.bid; item < 2 * G5; item += F.G) { const int l = item >> 5, g = item & 31;
        __syncthreads();
        if (F.tid < 128) { const int d = F.tid >> 6, p = F.tid & 63; const int ldg = (l * 2 + d) * G5 + g;
            const double lr = IN_(I_LRE)[ldg * P5 + p], li = IN_(I_LIM)[ldg * P5 + p], dt = exp((double)IN_(I_LDT)[ldg]);
            for (int e = 0; e <= 16; ++e) { const double m = exp(lr * dt * e), ang = li * dt * e; APr[(d * 64 + p) * 17 + e] = (float)(m * cos(ang)); APi[(d * 64 + p) * 17 + e] = (float)(m * sin(ang)); }
            { const double m16 = exp(lr * dt * 16.0), a16 = li * dt * 16.0; float* A16 = (float*)(F.ws + WS_A16) + ((size_t)((l * 32 + g) * 2 + d) * 64 + p) * 2; A16[0] = (float)(m16 * cos(a16)); A16[1] = (float)(m16 * sin(a16)); }
            const double m1 = exp(lr * dt), ar = m1 * cos(li * dt), ai = m1 * sin(li * dt); const double nr = ar - 1.0, ni = ai, den = lr * lr + li * li;
            const double qr = (nr * lr + ni * li) / den, qi = (ni * lr - nr * li) / den;
            for (int h = 0; h < 16; ++h) { const double x = IN_(I_BRE)[((size_t)ldg * P5 + p) * H5 + h], y = IN_(I_BIM)[((size_t)ldg * P5 + p) * H5 + h];
                BBr[(d * 64 + p) * 16 + h] = (float)(qr * x - qi * y); BBi[(d * 64 + p) * 16 + h] = (float)(qr * y + qi * x);
                CCr[(d * 16 + h) * 64 + p] = IN_(I_CRE)[((size_t)ldg * H5 + h) * P5 + p]; CCi[(d * 16 + h) * 64 + p] = IN_(I_CIM)[((size_t)ldg * H5 + h) * P5 + p]; } }
        __syncthreads();
        for (int idx = F.tid; idx < 8192; idx += NT) { const int d = idx >> 12, e = (idx >> 8) & 15, h = (idx >> 4) & 15, hp = idx & 15; float a = 0.f;
            for (int p = 0; p < 64; ++p) { const float pr = APr[(d * 64 + p) * 17 + e], pi = APi[(d * 64 + p) * 17 + e], br = BBr[(d * 64 + p) * 16 + hp], bi = BBi[(d * 64 + p) * 16 + hp];
                const float wr = pr * br - pi * bi, wi = pr * bi + pi * br; a += CCr[(d * 16 + h) * 64 + p] * wr - CCi[(d * 16 + h) * 64 + p] * wi; }
            KK[idx] = a; }
        __syncthreads();
        bf16* M = (bf16*)(F.ws + WS_S5M) + (size_t)(l * 32 + g) * 3 * 65536;
        for (int idx = F.tid; idx < 32768; idx += NT) {
            const int r = idx >> 7, k0 = (idx & 127) * 2; float v[3][2];
#pragma unroll
            for (int q = 0; q < 2; ++q) { const int kk = k0 + q;
                { const int d = r >> 7, p = (r >> 1) & 63, c = r & 1, sg = kk >> 4, hp = kk & 15, e = d == 0 ? 15 - sg : sg;
                  const float pr = APr[(d * 64 + p) * 17 + e], pi = APi[(d * 64 + p) * 17 + e], br = BBr[(d * 64 + p) * 16 + hp], bi = BBi[(d * 64 + p) * 16 + hp];
                  v[0][q] = c == 0 ? pr * br - pi * bi : pr * bi + pi * br; }
                { const int tau = r >> 4, h = r & 15, sg = kk >> 4, hp = kk & 15; float t = 0.f;
                  if (sg <= tau) t += KK[(0 * 16 + (tau - sg)) * 256 + h * 16 + hp]; if (sg >= tau) t += KK[(1 * 16 + (sg - tau)) * 256 + h * 16 + hp]; v[1][q] = t; }
                { const int tau = r >> 4, h = r & 15, d = kk >> 7, p = (kk >> 1) & 63, c = kk & 1, e = d == 0 ? tau + 1 : 16 - tau;
                  const float cr = CCr[(d * 16 + h) * 64 + p], ci = CCi[(d * 16 + h) * 64 + p], pr = APr[(d * 64 + p) * 17 + e], pi = APi[(d * 64 + p) * 17 + e];
                  v[2][q] = c == 0 ? cr * pr - ci * pi : -(cr * pi + ci * pr); } }
#pragma unroll
            for (int m = 0; m < 3; ++m) *(unsigned*)(M + (size_t)m * 65536 + r * 256 + k0) = pk2(v[m][0], v[m][1]);
        }
    }
}
__device__ __forceinline__ void s5_z_phase(Frame& F, int l) {
    const bf16* PROJ = (const bf16*)(F.ws + WS_PROJ); float* Z = (float*)(F.ws + WS_Z);
    const int l15 = F.lane & 15, lq = F.lane >> 4;
    for (int item = F.bid; item < 256; item += F.G) {
        const int g = item >> 3, part = item & 7; const bf16* Fm = (const bf16*)(F.ws + WS_S5M) + (size_t)(l * 32 + g) * 3 * 65536;
        bf16x8 Af[2][8];
#pragma unroll
        for (int j = 0; j < 2; ++j)
#pragma unroll
            for (int ks = 0; ks < 8; ++ks) Af[j][ks] = *(const bf16x8*)(Fm + (size_t)(16 * (2 * F.wave + j) + l15) * 256 + 32 * ks + 8 * lq);
#pragma unroll 1
        for (int tl = part; tl < MT / 256; tl += 8) {
            bf16x8 V[8];
#pragma unroll
            for (int ks = 0; ks < 8; ++ks) V[ks] = *(const bf16x8*)(PROJ + (size_t)(tl * 256 + 16 * l15 + 2 * ks + (lq >> 1)) * INW + 16 * g + 8 * (lq & 1));
            f32x4 acc[2] = {{0.f, 0.f, 0.f, 0.f}, {0.f, 0.f, 0.f, 0.f}};
#pragma unroll
            for (int ks = 0; ks < 8; ++ks)
#pragma unroll
                for (int j = 0; j < 2; ++j) acc[j] = __builtin_amdgcn_mfma_f32_16x16x32_bf16(Af[j][ks], V[ks], acc[j], 0, 0, 0);
#pragma unroll
            for (int j = 0; j < 2; ++j) *(f32x4*)(Z + ((size_t)(tl * 16 + l15) * 32 + g) * 256 + 16 * (2 * F.wave + j) + 4 * lq) = acc[j];
        }
    }
}
__device__ __forceinline__ int s5_chain_sb(int d, int i) { return d == 0 ? (i < 16 ? 1024 + i : i - 16) : (i < 16 ? 1039 - i : 1023 - (i - 16)); }
__device__ __forceinline__ void s5_scan_phase(Frame& F, int l) {
    LAS float* EX = (LAS float*)F.lds;
    for (int item = F.bid; item < 256; item += F.G) {
        const int cid = item * 16 + (F.tid & 15), j = F.tid >> 4;
        const int g = cid >> 7, d = (cid >> 6) & 1, p = cid & 63;
        const float* A16 = (const float*)(F.ws + WS_A16) + ((size_t)((l * 32 + g) * 2 + d) * 64 + p) * 2; const float ar = A16[0], ai = A16[1];
        const float* Z = (const float*)(F.ws + WS_Z) + (size_t)g * 256 + d * 128 + 2 * p; bf16* SS = (bf16*)(F.ws + WS_SS) + (size_t)g * 256 + d * 128 + 2 * p;
        float2 z[33];
#pragma unroll
        for (int q = 0; q < 33; ++q) { const int i = 33 * j + q; z[q] = i < NSB ? *(const float2*)(Z + (size_t)s5_chain_sb(d, i) * 8192) : make_float2(0.f, 0.f); }
        float hr = 0.f, hi = 0.f, pr = 1.f, pi = 0.f;
#pragma unroll
        for (int q = 0; q < 33; ++q) { if (33 * j + q < NSB) { const float nr = ar * hr - ai * hi + z[q].x, ni = ar * hi + ai * hr + z[q].y; hr = nr; hi = ni; const float qr = pr * ar - pi * ai, qi = pr * ai + pi * ar; pr = qr; pi = qi; } }
        __syncthreads();
        EX[(j * 16 + (F.tid & 15)) * 4 + 0] = hr; EX[(j * 16 + (F.tid & 15)) * 4 + 1] = hi; EX[(j * 16 + (F.tid & 15)) * 4 + 2] = pr; EX[(j * 16 + (F.tid & 15)) * 4 + 3] = pi;
        __syncthreads();
        float cr = 0.f, ci = 0.f;
        for (int i = 0; i < j; ++i) { const float er = EX[(i * 16 + (F.tid & 15)) * 4 + 0], ei = EX[(i * 16 + (F.tid & 15)) * 4 + 1], qr = EX[(i * 16 + (F.tid & 15)) * 4 + 2], qi = EX[(i * 16 + (F.tid & 15)) * 4 + 3];
            const float nr = qr * cr - qi * ci + er, ni = qr * ci + qi * cr + ei; cr = nr; ci = ni; }
        hr = cr; hi = ci;
#pragma unroll
        for (int q = 0; q < 33; ++q) { const int i = 33 * j + q; if (i < NSB) { *(unsigned*)(SS + (size_t)s5_chain_sb(d, i) * 8192) = pk2(hr, hi);
            const float nr = ar * hr - ai * hi + z[q].x, ni = ar * hi + ai * hr + z[q].y; hr = nr; hi = ni; } }
    }
}
__device__ __forceinline__ void s5_y_phase(Frame& F, int l) {
    const bf16* PROJ = (const bf16*)(F.ws + WS_PROJ); const bf16* SS = (const bf16*)(F.ws + WS_SS); bf16* YG = (bf16*)(F.ws + WS_YG); const float* ds = IN_(I_DSKIP) + l * MIXW;
    const int l15 = F.lane & 15, lq = F.lane >> 4;
    for (int item = F.bid; item < 256; item += F.G) {
        const int g = item >> 3, part = item & 7; const bf16* Tm = (const bf16*)(F.ws + WS_S5M) + ((size_t)(l * 32 + g) * 3 + 1) * 65536; const bf16* Em = Tm + 65536;
        bf16x8 At[2][8], Ae[2][8];
#pragma unroll
        for (int j = 0; j < 2; ++j)
#pragma unroll
            for (int ks = 0; ks < 8; ++ks) { const size_t o = (size_t)(16 * (2 * F.wave + j) + l15) * 256 + 32 * ks + 8 * lq; At[j][ks] = *(const bf16x8*)(Tm + o); Ae[j][ks] = *(const bf16x8*)(Em + o); }
        const f32x4 dsk = *(const f32x4*)(ds + 16 * g + 4 * lq);
        const int ntl = l == 0 ? MT / 256 : SEQ / 256;
#pragma unroll 1
        for (int tl = part; tl < ntl; tl += 8) {
            bf16x8 V[8], S[8];
#pragma unroll
            for (int ks = 0; ks < 8; ++ks) { V[ks] = *(const bf16x8*)(PROJ + (size_t)(tl * 256 + 16 * l15 + 2 * ks + (lq >> 1)) * INW + 16 * g + 8 * (lq & 1));
                S[ks] = *(const bf16x8*)(SS + ((size_t)(tl * 16 + l15) * 32 + g) * 256 + 32 * ks + 8 * lq); }
            f32x4 acc[2] = {{0.f, 0.f, 0.f, 0.f}, {0.f, 0.f, 0.f, 0.f}};
#pragma unroll
            for (int ks = 0; ks < 8; ++ks)
#pragma unroll
                for (int j = 0; j < 2; ++j) { acc[j] = __builtin_amdgcn_mfma_f32_16x16x32_bf16(At[j][ks], V[ks], acc[j], 0, 0, 0); acc[j] = __builtin_amdgcn_mfma_f32_16x16x32_bf16(Ae[j][ks], S[ks], acc[j], 0, 0, 0); }
#pragma unroll
            for (int j = 0; j < 2; ++j) { const size_t row = (size_t)tl * 256 + 16 * l15 + (2 * F.wave + j); const int ch = 16 * g + 4 * lq;
                const v2u u = *(const v2u*)(PROJ + row * INW + ch);
                const float y0 = acc[j][0] + dsk[0] * bflo(u.x), y1 = acc[j][1] + dsk[1] * bfhi(u.x), y2 = acc[j][2] + dsk[2] * bflo(u.y), y3 = acc[j][3] + dsk[3] * bfhi(u.y);
                v2u w; w.x = cvtpk(geluf_(y0), geluf_(y1)); w.y = cvtpk(geluf_(y2), geluf_(y3)); *(v2u*)(YG + row * MIXW + ch) = w; }
        }
    }
}


constexpr int SG_STRIDE = 272, SG_IMG = 256 * SG_STRIDE, SG_STAT = SG_IMG;
__device__ __forceinline__ void sg_fast_chunk(Frame& F, int l, int chunk) {
    const bf16* PROJ = (const bf16*)(F.ws + WS_PROJ); bf16* YB = (bf16*)(F.ws + WS_YS) + (size_t)MT * MIXW; const bf16* WSG = (const bf16*)(F.ws + WS_WSG);
    const float* lg = IN_(I_SGG) + l * MIXW; const float* lb = IN_(I_SGB) + l * MIXW; const float* bsg = IN_(I_BSG) + l * 512;
    LAS float* st = (LAS float*)(F.lds + SG_STAT);
    __syncthreads();
    {
        const int p = F.tid >> 2, part = F.tid & 3; const bf16* vr = PROJ + (size_t)(chunk * 128 + p) * INW + 1024 + part * 128; float s = 0.f, q = 0.f;
#pragma unroll 4
        for (int c = 0; c < 128; c += 8) { const v4u w = *(const v4u*)(vr + c); const float x[8] = {bflo(w.x), bfhi(w.x), bflo(w.y), bfhi(w.y), bflo(w.z), bfhi(w.z), bflo(w.w), bfhi(w.w)};
#pragma unroll
            for (int i = 0; i < 8; ++i) { s += x[i]; q += x[i] * x[i]; } }
        s += __shfl_xor(s, 1); q += __shfl_xor(q, 1); s += __shfl_xor(s, 2); q += __shfl_xor(q, 2);
        const float mu = s * (1.f / 512.f), var = fmaxf(q * (1.f / 512.f) - mu * mu, 0.f);
        if (part == 0) { st[p * 2] = mu; st[p * 2 + 1] = rsqrtf(var + EPS); }
    }
    const int l15 = F.lane & 15, lq = F.lane >> 4;
#pragma unroll 1
    for (int pass = 0; pass < 2; ++pass) {
        __syncthreads();
#pragma unroll 1
        for (int it = F.tid; it < 2048; it += NT) { const int tp = it & 63, cg = it >> 6; const int p0 = tp * 2, ch = pass * 256 + cg * 8;
            const v4u w0 = *(const v4u*)(PROJ + (size_t)(chunk * 128 + p0) * INW + 1024 + ch), w1 = *(const v4u*)(PROJ + (size_t)(chunk * 128 + p0 + 1) * INW + 1024 + ch);
            const float mu0 = st[p0 * 2], rs0 = st[p0 * 2 + 1], mu1 = st[p0 * 2 + 2], rs1 = st[p0 * 2 + 3];
            const float x0[8] = {bflo(w0.x), bfhi(w0.x), bflo(w0.y), bfhi(w0.y), bflo(w0.z), bfhi(w0.z), bflo(w0.w), bfhi(w0.w)};
            const float x1[8] = {bflo(w1.x), bfhi(w1.x), bflo(w1.y), bfhi(w1.y), bflo(w1.z), bfhi(w1.z), bflo(w1.w), bfhi(w1.w)};
#pragma unroll
            for (int i = 0; i < 8; ++i) { const float gm = lg[ch + i], bt = lb[ch + i];
                *(LAS unsigned*)(F.lds + (cg * 8 + i) * SG_STRIDE + p0 * 2) = pk2((x0[i] - mu0) * rs0 * gm + bt, (x1[i] - mu1) * rs1 * gm + bt); } }
        __syncthreads();
        const int ggl = F.wave >> 2, gg = pass * 2 + ggl, rb0 = (F.wave & 3) * 2;
        bf16x8 A[2][4];
#pragma unroll
        for (int j = 0; j < 2; ++j)
#pragma unroll
            for (int ks = 0; ks < 4; ++ks) A[j][ks] = *(const LAS bf16x8*)(F.lds + (ggl * 128 + (rb0 + j) * 16 + l15) * SG_STRIDE + (32 * ks + 8 * lq) * 2);
        f32x4 acc[2][8];
#pragma unroll
        for (int j = 0; j < 2; ++j)
#pragma unroll
            for (int cb = 0; cb < 8; ++cb) acc[j][cb] = (f32x4){0.f, 0.f, 0.f, 0.f};
#pragma unroll
        for (int cb = 0; cb < 8; ++cb) {
            bf16x8 B[4];
#pragma unroll
            for (int ks = 0; ks < 4; ++ks) B[ks] = *(const bf16x8*)(WSG + ((size_t)gg * 128 + cb * 16 + l15) * 128 + 32 * ks + 8 * lq);
#pragma unroll
            for (int ks = 0; ks < 4; ++ks)
#pragma unroll
                for (int j = 0; j < 2; ++j) acc[j][cb] = __builtin_amdgcn_mfma_f32_16x16x32_bf16(A[j][ks], B[ks], acc[j][cb], 0, 0, 0);
        }
#pragma unroll
        for (int cb = 0; cb < 8; ++cb) { const int q = cb * 16 + l15; const size_t row = (size_t)chunk * 128 + q; const float bq = bsg[gg * 128 + q];
#pragma unroll
            for (int j = 0; j < 2; ++j) { const int col = gg * 128 + (rb0 + j) * 16 + 4 * lq; const v2u gu = *(const v2u*)(PROJ + row * INW + 512 + col);
                v2u w; w.x = cvtpk(bflo(gu.x) * (acc[j][cb][0] + bq), bfhi(gu.x) * (acc[j][cb][1] + bq)); w.y = cvtpk(bflo(gu.y) * (acc[j][cb][2] + bq), bfhi(gu.y) * (acc[j][cb][3] + bq));
                *(v2u*)(YB + row * MIXW + col) = w; } }
    }
}

struct NSmem { float As[16][68]; float Bs[16][68]; };
template <class AF>
__device__ __forceinline__ void ngemm_acc(float (&acc)[4][4], const AF& af, const float* B, int ldb, int K, LAS NSmem* s, int t) {
    const int ty = t >> 4, tx = t & 15, lr = t >> 2, lk = (t & 3) * 4, bk = t >> 4, bn = (t & 15) * 4;
    for (int k0 = 0; k0 < K; k0 += 16) {
        const float4 av = af.load4(lr, k0 + lk);
        const float4 bv = *(const float4*)(B + (size_t)(k0 + bk) * ldb + bn);
        __syncthreads();
        s->As[lk + 0][lr] = av.x; s->As[lk + 1][lr] = av.y; s->As[lk + 2][lr] = av.z; s->As[lk + 3][lr] = av.w;
        *(LAS f32x4*)&s->Bs[bk][bn] = (f32x4){bv.x, bv.y, bv.z, bv.w};
        __syncthreads();
#pragma unroll
        for (int k = 0; k < 16; ++k) {
            const f32x4 a = *(const LAS f32x4*)&s->As[k][ty * 4]; const f32x4 b = *(const LAS f32x4*)&s->Bs[k][tx * 4];
            const float aa[4] = {a.x, a.y, a.z, a.w}, bb[4] = {b.x, b.y, b.z, b.w};
#pragma unroll
            for (int i = 0; i < 4; ++i)
#pragma unroll
                for (int j = 0; j < 4; ++j) acc[i][j] += aa[i] * bb[j];
        }
    }
}
struct ABf { const bf16* A; int lda; __device__ __forceinline__ float4 load4(int r, int k) const { const v2u w = *(const v2u*)(A + (size_t)r * lda + k);
    return make_float4(bf2f((unsigned short)(w.x & 0xffff)), bf2f((unsigned short)(w.x >> 16)), bf2f((unsigned short)(w.y & 0xffff)), bf2f((unsigned short)(w.y >> 16))); } };
#define NTILE_BEGIN(ntiles) { const int _half = F.tid >> 8, t = F.tid & 255, ty = t >> 4, tx = t & 15; LAS NSmem* sm = (LAS NSmem*)F.lds + _half; (void)ty; (void)tx; \
    const int _nt = (ntiles), _nit = (_nt + 2 * F.G - 1) / (2 * F.G); \
    for (int _it = 0; _it < _nit; ++_it) { int T = (_it * F.G + F.bid) * 2 + _half; const bool valid = T < _nt; if (!valid) T = _nt - 1;
#define NTILE_END } }

__device__ __forceinline__ void ph0_prologue(Frame& F) {
    float* mod = (float*)(F.ws + WS_MOD);
    LAS float* SV = (LAS float*)(F.lds + 131072 + 4096);
    for (int i = F.tid; i < 2048; i += NT) SV[i] = siluf_(i < 1024 ? IN_(I_C)[i] : IN_(I_CCTX)[i - 1024]);
    __syncthreads();
    const int gw = F.bid * (NT / 64) + F.wave, ngw = F.G * (NT / 64);
    for (int it = gw; it < 2 * 96; it += ngw) { const int l = it / 96, j = (it % 96) * 64 + F.lane;
        const float* W = IN_(I_WADA) + (size_t)l * D * 6144 + j;
        float a0 = 0.f, a1 = 0.f;
#pragma unroll 16
        for (int kk = 0; kk < D; ++kk) { const float w = W[(size_t)kk * 6144]; a0 += SV[kk] * w; a1 += SV[1024 + kk] * w; }
        const float b = IN_(I_BADA)[l * 6144 + j];
        mod[(size_t)(l * 2 + 0) * 6144 + j] = a0 + b; mod[(size_t)(l * 2 + 1) * 6144 + j] = a1 + b;
    }
}
__device__ __forceinline__ void hprep_rows(Frame& F, int l) {
    bf16* H = (bf16*)(F.ws + WS_H); const float* g = IN_(I_GMIX) + l * D;
    const int gw = F.bid * (NT / 64) + F.wave, ngw = F.G * (NT / 64);
    for (int row = gw; row < MT; row += ngw) {
        const float* m = mod_ptr(F, l, row); const float* xr = xsrc_row(F, l, row);
        f32x4 v[4]; float s = 0.f;
#pragma unroll
        for (int j = 0; j < 4; ++j) { v[j] = *(const f32x4*)(xr + 4 * F.lane + 256 * j); s += v[j].x * v[j].x + v[j].y * v[j].y + v[j].z * v[j].z + v[j].w * v[j].w; }
        const float rstd = rsqrtf(wave_sum(s) * (1.f / D) + EPS);
#pragma unroll
        for (int j = 0; j < 4; ++j) { const int c = 4 * F.lane + 256 * j; const f32x4 gg = *(const f32x4*)(g + c), sc = *(const f32x4*)(m + 1024 + c), sh = *(const f32x4*)(m + c);
            const f32x4 o = v[j] * rstd * gg * (1.f + sc) + sh; v2u w; w.x = pk2(o.x, o.y); w.y = pk2(o.z, o.w); *(v2u*)(H + (size_t)row * D + c) = w; }
    }
}
__device__ __forceinline__ void ph2_naive(Frame& F, int l) {
    const bf16* H = (const bf16*)(F.ws + WS_H); bf16* PROJ = (bf16*)(F.ws + WS_PROJ); const float* W = IN_(I_WIN) + (size_t)l * D * INW;
    NTILE_BEGIN((MT / 64) * (INW / 64))
        const int m0 = (T / (INW / 64)) * 64, n0 = (T % (INW / 64)) * 64;
        float acc[4][4] = {};
        ngemm_acc(acc, ABf{H + (size_t)m0 * D, D}, W + n0, INW, D, sm, t);
        if (valid) {
#pragma unroll
            for (int i = 0; i < 4; ++i) { float o[4];
#pragma unroll
                for (int j = 0; j < 4; ++j) { o[j] = acc[i][j]; if (n0 >= 512 && n0 < 1536) o[j] = geluf_(o[j]); }
                v2u w; w.x = pk2(o[0], o[1]); w.y = pk2(o[2], o[3]); *(v2u*)(PROJ + (size_t)(m0 + ty * 4 + i) * INW + n0 + tx * 4) = w; }
        }
    NTILE_END
}
__device__ __forceinline__ int chain_row(int dir, int pos) { return dir == 0 ? (pos < CTX ? SEQ + pos : pos - CTX) : (pos < CTX ? SEQ + CTX - 1 - pos : SEQ - 1 - (pos - CTX)); }
__device__ __forceinline__ void ph3_s5_naive(Frame& F, int l) {
    LAS float* Cr = (LAS float*)(F.lds + 32768); LAS float* Ci = Cr + 1024; LAS float* Sr = Ci + 1024; LAS float* Si = Sr + 2048;
    const bf16* PROJ = (const bf16*)(F.ws + WS_PROJ); float* YD = (float*)(F.ws + WS_S5);
    for (int item = F.bid; item < 64; item += F.G) {
        if (F.wave == 0) {
            const int g = item >> 1, dir = item & 1, p = F.lane;
            const int ldg = ((l * 2 + dir) * G5 + g);
            const float lr = IN_(I_LRE)[ldg * P5 + p], li = IN_(I_LIM)[ldg * P5 + p], dt = expf(IN_(I_LDT)[ldg]);
            const float er = expf(lr * dt), ar = er * cosf(li * dt), ai = er * sinf(li * dt);
            const float nr = ar - 1.f, ni = ai, den = lr * lr + li * li;
            const float qr = (nr * lr + ni * li) / den, qi = (ni * lr - nr * li) / den;
            float br[16], bi[16];
#pragma unroll
            for (int h = 0; h < 16; ++h) { const float x = IN_(I_BRE)[((size_t)ldg * P5 + p) * H5 + h], y = IN_(I_BIM)[((size_t)ldg * P5 + p) * H5 + h]; br[h] = qr * x - qi * y; bi[h] = qr * y + qi * x; }
            for (int h = 0; h < 16; ++h) { Cr[h * 64 + p] = IN_(I_CRE)[((size_t)ldg * H5 + h) * P5 + p]; Ci[h * 64 + p] = IN_(I_CIM)[((size_t)ldg * H5 + h) * P5 + p]; }
            float sr = 0.f, si = 0.f;
            float* Y = YD + (size_t)dir * MT * MIXW;
#pragma unroll 1
            for (int blk = 0; blk < MT / 32; ++blk) {
#pragma unroll 1
                for (int tt = 0; tt < 32; ++tt) {
                    const int row = chain_row(dir, blk * 32 + tt);
                    const v4u u0 = *(const v4u*)(PROJ + (size_t)row * INW + g * 16), u1 = *(const v4u*)(PROJ + (size_t)row * INW + g * 16 + 8);
                    const unsigned uw[8] = {u0.x, u0.y, u0.z, u0.w, u1.x, u1.y, u1.z, u1.w};
                    float xr = 0.f, xi = 0.f;
#pragma unroll
                    for (int h = 0; h < 8; ++h) { const float ua = bf2f((unsigned short)(uw[h] & 0xffff)), ub = bf2f((unsigned short)(uw[h] >> 16));
                        xr += br[2 * h] * ua + br[2 * h + 1] * ub; xi += bi[2 * h] * ua + bi[2 * h + 1] * ub; }
                    const float nsr = ar * sr - ai * si + xr, nsi = ar * si + ai * sr + xi;
                    sr = nsr; si = nsi; Sr[tt * 64 + p] = sr; Si[tt * 64 + p] = si;
                }
                asm volatile("s_waitcnt lgkmcnt(0)" ::: "memory");
#pragma unroll 1
                for (int o = p; o < 512; o += 64) {
                    const int tt = o >> 4, h = o & 15; float a = 0.f;
#pragma unroll 4
                    for (int q = 0; q < 64; ++q) a += Cr[h * 64 + q] * Sr[tt * 64 + q] - Ci[h * 64 + q] * Si[tt * 64 + q];
                    Y[(size_t)chain_row(dir, blk * 32 + tt) * MIXW + g * 16 + h] = a;
                }
                asm volatile("s_waitcnt lgkmcnt(0)" ::: "memory");
            }
        }
    }
}
__device__ __forceinline__ void ph3_sg_naive(Frame& F, int l) {
    const bf16* PROJ = (const bf16*)(F.ws + WS_PROJ); bf16* YB = (bf16*)(F.ws + WS_YS) + (size_t)MT * MIXW;
    LAS float* stat = (LAS float*)(F.lds + 32768);
    const float* lg = IN_(I_SGG) + l * MIXW; const float* lb = IN_(I_SGB) + l * MIXW;
    NTILE_BEGIN((MT / 128) * 16)
        const int chunk = T >> 4, gg = (T >> 2) & 3, q0 = ((T >> 1) & 1) * 64, c0 = (T & 1) * 64;
        LAS float* st = stat + _half * 256;
        __syncthreads();
        if (t < 128) { const bf16* vr = PROJ + (size_t)(chunk * 128 + t) * INW + 1024; float s = 0.f;
            for (int c = 0; c < 512; c += 2) { const unsigned w = *(const unsigned*)(vr + c); s += bf2f((unsigned short)(w & 0xffff)) + bf2f((unsigned short)(w >> 16)); }
            const float mu = s * (1.f / 512.f); float q = 0.f;
            for (int c = 0; c < 512; c += 2) { const unsigned w = *(const unsigned*)(vr + c); const float a = bf2f((unsigned short)(w & 0xffff)) - mu, b = bf2f((unsigned short)(w >> 16)) - mu; q += a * a + b * b; }
            st[t * 2] = mu; st[t * 2 + 1] = rsqrtf(q * (1.f / 512.f) + EPS); }
        __syncthreads();
        float acc[4][4] = {};
        {
            const float* A = IN_(I_WSG) + ((size_t)(l * 4 + gg) * 128 + q0) * 128;
            const int lr = t >> 2, lk = (t & 3) * 4, bk = t >> 4, bn = (t & 15) * 4;
            for (int k0 = 0; k0 < 128; k0 += 16) {
                const float4 av = *(const float4*)(A + (size_t)lr * 128 + k0 + lk);
                const int p = k0 + bk; const int col = gg * 128 + c0 + bn;
                const v2u w = *(const v2u*)(PROJ + (size_t)(chunk * 128 + p) * INW + 1024 + col);
                const float mu = st[p * 2], rs = st[p * 2 + 1];
                float4 bv; bv.x = (bf2f((unsigned short)(w.x & 0xffff)) - mu) * rs * lg[col] + lb[col]; bv.y = (bf2f((unsigned short)(w.x >> 16)) - mu) * rs * lg[col + 1] + lb[col + 1];
                bv.z = (bf2f((unsigned short)(w.y & 0xffff)) - mu) * rs * lg[col + 2] + lb[col + 2]; bv.w = (bf2f((unsigned short)(w.y >> 16)) - mu) * rs * lg[col + 3] + lb[col + 3];
                __syncthreads();
                sm->As[lk + 0][lr] = av.x; sm->As[lk + 1][lr] = av.y; sm->As[lk + 2][lr] = av.z; sm->As[lk + 3][lr] = av.w;
                *(LAS f32x4*)&sm->Bs[bk][bn] = (f32x4){bv.x, bv.y, bv.z, bv.w};
                __syncthreads();
#pragma unroll
                for (int k = 0; k < 16; ++k) { const f32x4 a = *(const LAS f32x4*)&sm->As[k][ty * 4]; const f32x4 b = *(const LAS f32x4*)&sm->Bs[k][tx * 4];
                    const float aa[4] = {a.x, a.y, a.z, a.w}, bb[4] = {b.x, b.y, b.z, b.w};
#pragma unroll
                    for (int i = 0; i < 4; ++i)
#pragma unroll
                        for (int j = 0; j < 4; ++j) acc[i][j] += aa[i] * bb[j]; }
            }
        }
        if (valid) {
#pragma unroll
            for (int i = 0; i < 4; ++i) { const int q = q0 + ty * 4 + i; const size_t row = (size_t)chunk * 128 + q; const int col = gg * 128 + c0 + tx * 4;
                const float bq = IN_(I_BSG)[l * 512 + gg * 128 + q];
                const v2u gu = *(const v2u*)(PROJ + row * INW + 512 + col);
                v2u w; w.x = pk2(bf2f((unsigned short)(gu.x & 0xffff)) * (acc[i][0] + bq), bf2f((unsigned short)(gu.x >> 16)) * (acc[i][1] + bq));
                w.y = pk2(bf2f((unsigned short)(gu.y & 0xffff)) * (acc[i][2] + bq), bf2f((unsigned short)(gu.y >> 16)) * (acc[i][3] + bq));
                *(v2u*)(YB + row * MIXW + col) = w; }
        }
    NTILE_END
}
__device__ __forceinline__ void ph3_conv(Frame& F, int l, int nrows) {
    const bf16* PROJ = (const bf16*)(F.ws + WS_PROJ); bf16* YC = (bf16*)(F.ws + WS_YS) + (size_t)2 * MT * MIXW; const float* wc = IN_(I_WCONV) + l * 3 * MIXW;
    const size_t gt = (size_t)F.bid * NT + F.tid, ngt = (size_t)F.G * NT;
    for (size_t i = gt; i < (size_t)nrows * (MIXW / 2); i += ngt) {
        const int row = (int)(i / (MIXW / 2)), c = (int)(i % (MIXW / 2)) * 2;
        int pos, rl; if (row < SEQ) { pos = row & 63; rl = 64; } else { pos = row - SEQ; rl = 256; }
        const bf16* r0 = PROJ + (size_t)row * INW + 1536;
        const unsigned b0 = *(const unsigned*)(r0 + c), c0 = *(const unsigned*)(r0 + 512 + c), h0 = *(const unsigned*)(r0 + 1024 + c);
        float zm0 = 0.f, zm1 = 0.f, zp0 = 0.f, zp1 = 0.f;
        if (pos > 0) { const unsigned cc = *(const unsigned*)(r0 - INW + 512 + c), hh = *(const unsigned*)(r0 - INW + 1024 + c); zm0 = bf2f((unsigned short)(cc & 0xffff)) * bf2f((unsigned short)(hh & 0xffff)); zm1 = bf2f((unsigned short)(cc >> 16)) * bf2f((unsigned short)(hh >> 16)); }
        if (pos < rl - 1) { const unsigned cc = *(const unsigned*)(r0 + INW + 512 + c), hh = *(const unsigned*)(r0 + INW + 1024 + c); zp0 = bf2f((unsigned short)(cc & 0xffff)) * bf2f((unsigned short)(hh & 0xffff)); zp1 = bf2f((unsigned short)(cc >> 16)) * bf2f((unsigned short)(hh >> 16)); }
        const float z00 = bf2f((unsigned short)(c0 & 0xffff)) * bf2f((unsigned short)(h0 & 0xffff)), z01 = bf2f((unsigned short)(c0 >> 16)) * bf2f((unsigned short)(h0 >> 16));
        const float y0 = bf2f((unsigned short)(b0 & 0xffff)) * (wc[c] * zm0 + wc[512 + c] * z00 + wc[1024 + c] * zp0);
        const float y1 = bf2f((unsigned short)(b0 >> 16)) * (wc[c + 1] * zm1 + wc[512 + c + 1] * z01 + wc[1024 + c + 1] * zp1);
        *(unsigned*)(YC + (size_t)row * MIXW + c) = pk2(y0, y1);
    }
}
__device__ __forceinline__ void ph5_naive(Frame& F, int l) {
    const bf16* PROJ = (const bf16*)(F.ws + WS_PROJ); const float* YD = (const float*)(F.ws + WS_S5); bf16* YG = (bf16*)(F.ws + WS_YG); const float* ds = IN_(I_DSKIP) + l * MIXW;
    const size_t gt = (size_t)F.bid * NT + F.tid, ngt = (size_t)F.G * NT;
    for (size_t i = gt; i < (size_t)MT * (MIXW / 2); i += ngt) {
        const int row = (int)(i / (MIXW / 2)), c = (int)(i % (MIXW / 2)) * 2;
        const unsigned u = *(const unsigned*)(PROJ + (size_t)row * INW + c); const size_t o = (size_t)row * MIXW + c;
        const float y0 = YD[o] + YD[(size_t)MT * MIXW + o] + ds[c] * bf2f((unsigned short)(u & 0xffff)), y1 = YD[o + 1] + YD[(size_t)MT * MIXW + o + 1] + ds[c + 1] * bf2f((unsigned short)(u >> 16));
        *(unsigned*)(YG + o) = pk2(geluf_(y0), geluf_(y1));
    }
}
__device__ __forceinline__ void ph6_naive(Frame& F, int l) {
    const bf16* YG = (const bf16*)(F.ws + WS_YG); bf16* YA = (bf16*)(F.ws + WS_YS); const float* W = IN_(I_WGLU) + (size_t)l * MIXW * MIXW;
    NTILE_BEGIN((MT / 64) * (MIXW / 64))
        const int m0 = (T / (MIXW / 64)) * 64, n0 = (T % (MIXW / 64)) * 64;
        float acc[4][4] = {};
        ngemm_acc(acc, ABf{YG + (size_t)m0 * MIXW, MIXW}, W + n0, MIXW, MIXW, sm, t);
        if (valid) {
#pragma unroll
            for (int i = 0; i < 4; ++i) { const size_t o = (size_t)(m0 + ty * 4 + i) * MIXW + n0 + tx * 4; const v2u g = *(const v2u*)(YG + o);
                v2u w; w.x = pk2(bf2f((unsigned short)(g.x & 0xffff)) * sigmoidf_(acc[i][0]), bf2f((unsigned short)(g.x >> 16)) * sigmoidf_(acc[i][1]));
                w.y = pk2(bf2f((unsigned short)(g.y & 0xffff)) * sigmoidf_(acc[i][2]), bf2f((unsigned short)(g.y >> 16)) * sigmoidf_(acc[i][3])); *(v2u*)(YA + o) = w; }
        }
    NTILE_END
}
__device__ __forceinline__ void ph7_naive(Frame& F, int l) {
    const bf16* YS = (const bf16*)(F.ws + WS_YS); bf16* BR = (bf16*)(F.ws + WS_PROJ); const float* W = IN_(I_WBR) + (size_t)l * 3 * MIXW * D;
    NTILE_BEGIN((MT / 64) * (INW / 64))
        const int m0 = (T / (INW / 64)) * 64, n0 = (T % (INW / 64)) * 64, k = n0 / 1024, d0 = n0 % 1024;
        float acc[4][4] = {};
        ngemm_acc(acc, ABf{YS + (size_t)k * MT * MIXW + (size_t)m0 * MIXW, MIXW}, W + (size_t)k * MIXW * D + d0, D, MIXW, sm, t);
        if (valid) {
#pragma unroll
            for (int i = 0; i < 4; ++i) { v2u w; w.x = pk2(acc[i][0], acc[i][1]); w.y = pk2(acc[i][2], acc[i][3]); *(v2u*)(BR + (size_t)(m0 + ty * 4 + i) * INW + n0 + tx * 4) = w; }
        }
    NTILE_END
}
__device__ __forceinline__ void ph8_naive(Frame& F, int l) {
    const bf16* H = (const bf16*)(F.ws + WS_H); const bf16* BR = (const bf16*)(F.ws + WS_PROJ); bf16* PM = (bf16*)(F.ws + WS_PM);
    const float* W = IN_(I_WMG) + (size_t)l * D * INW; const float* bm = IN_(I_BMG) + l * INW;
    NTILE_BEGIN((MT / 64) * (D / 64))
        const int m0 = (T / (D / 64)) * 64, n0 = (T % (D / 64)) * 64;
        float out[4][4] = {};
        for (int k = 0; k < 3; ++k) {
            float acc[4][4] = {};
            ngemm_acc(acc, ABf{H + (size_t)m0 * D, D}, W + k * 1024 + n0, INW, D, sm, t);
#pragma unroll
            for (int i = 0; i < 4; ++i) { const v2u b = *(const v2u*)(BR + (size_t)(m0 + ty * 4 + i) * INW + k * 1024 + n0 + tx * 4);
                const float bb[4] = {bf2f((unsigned short)(b.x & 0xffff)), bf2f((unsigned short)(b.x >> 16)), bf2f((unsigned short)(b.y & 0xffff)), bf2f((unsigned short)(b.y >> 16))};
#pragma unroll
                for (int j = 0; j < 4; ++j) out[i][j] += sigmoidf_(acc[i][j] + bm[k * 1024 + n0 + tx * 4 + j]) * bb[j]; }
        }
        if (valid) {
#pragma unroll
            for (int i = 0; i < 4; ++i) { v2u w; w.x = pk2(out[i][0], out[i][1]); w.y = pk2(out[i][2], out[i][3]); *(v2u*)(PM + (size_t)(m0 + ty * 4 + i) * D + n0 + tx * 4) = w; }
        }
    NTILE_END
}
__device__ __forceinline__ void ph9_naive(Frame& F, int l) {
    const bf16* PM = (const bf16*)(F.ws + WS_PM); const float* W = IN_(I_WO) + (size_t)l * D * D;
    NTILE_BEGIN((MT / 64) * (D / 64))
        const int m0 = (T / (D / 64)) * 64, n0 = (T % (D / 64)) * 64;
        float acc[4][4] = {};
        ngemm_acc(acc, ABf{PM + (size_t)m0 * D, D}, W + n0, D, D, sm, t);
        if (valid) {
#pragma unroll
            for (int i = 0; i < 4; ++i) { const int row = m0 + ty * 4 + i, c = n0 + tx * 4; const float* m = mod_ptr(F, l, row) + 2048 + c;
                const f32x4 xs = *(const f32x4*)(xsrc_row(F, l, row) + c);
                f32x4 o; o.x = xs.x + m[0] * acc[i][0]; o.y = xs.y + m[1] * acc[i][1]; o.z = xs.z + m[2] * acc[i][2]; o.w = xs.w + m[3] * acc[i][3];
                *(f32x4*)(xrun_row(F, row) + c) = o; }
        }
    NTILE_END
}
__device__ __forceinline__ void ph10_route(Frame& F, int l) {
    bf16* H = (bf16*)(F.ws + WS_H); const float* g = IN_(I_GFFN) + l * D; const bf16* WRh = (const bf16*)(F.ws + WS_WR); const bf16* WRl = WRh + 48 * 1024;
    const float* bg = IN_(I_BGRP) + l * 4; const float* be = IN_(I_BEXP) + l * 32;
    int* EID = (int*)(F.ws + WS_EID); float* EW = (float*)(F.ws + WS_EW); unsigned* cnt = F.ctl + CW_CNT + l * 128;
    LAS float* LG = (LAS float*)F.lds + F.wave * (16 * 52);
    const int nunits = (l == 0 ? MT : SEQ) / 16; const int r = F.lane & 15, q = F.lane >> 4;
    for (int u = F.bid + F.wave * F.G; u < nunits; u += F.G * (NT / 64)) {
        const int row = u * 16 + r; const float* xr = xrun_row(F, row) + 8 * q; const float* m = mod_ptr(F, l, row) + 8 * q; const float* gq = g + 8 * q;
        float s = 0.f;
#pragma unroll 8
        for (int ks = 0; ks < 32; ++ks) { const f32x4 a = *(const f32x4*)(xr + 32 * ks), b = *(const f32x4*)(xr + 32 * ks + 4); s += a.x * a.x + a.y * a.y + a.z * a.z + a.w * a.w + b.x * b.x + b.y * b.y + b.z * b.z + b.w * b.w; }
        s += __shfl_xor(s, 16); s += __shfl_xor(s, 32);
        const float rstd = rsqrtf(s * (1.f / D) + EPS);
        f32x4 acc[3] = {{0.f, 0.f, 0.f, 0.f}, {0.f, 0.f, 0.f, 0.f}, {0.f, 0.f, 0.f, 0.f}};
#pragma unroll 2
        for (int ks = 0; ks < 32; ++ks) {
            const int c = 32 * ks;
            const f32x4 x0 = *(const f32x4*)(xr + c), x1 = *(const f32x4*)(xr + c + 4), g0 = *(const f32x4*)(gq + c), g1 = *(const f32x4*)(gq + c + 4);
            const f32x4 sc0 = *(const f32x4*)(m + 4096 + c), sc1 = *(const f32x4*)(m + 4096 + c + 4), sh0 = *(const f32x4*)(m + 3072 + c), sh1 = *(const f32x4*)(m + 3072 + c + 4);
            const f32x4 h0 = x0 * rstd * g0 * (1.f + sc0) + sh0, h1 = x1 * rstd * g1 * (1.f + sc1) + sh1;
            v4u hi; hi.x = pk2(h0.x, h0.y); hi.y = pk2(h0.z, h0.w); hi.z = pk2(h1.x, h1.y); hi.w = pk2(h1.z, h1.w);
            *(v4u*)(H + (size_t)row * D + 8 * q + c) = hi;
            v4u lo; lo.x = pk2(h0.x - bflo(hi.x), h0.y - bfhi(hi.x)); lo.y = pk2(h0.z - bflo(hi.y), h0.w - bfhi(hi.y)); lo.z = pk2(h1.x - bflo(hi.z), h1.y - bfhi(hi.z)); lo.w = pk2(h1.z - bflo(hi.w), h1.w - bfhi(hi.w));
            const bf16x8 Ah = __builtin_bit_cast(bf16x8, hi), Al = __builtin_bit_cast(bf16x8, lo);
#pragma unroll
            for (int cb = 0; cb < 3; ++cb) { const bf16x8 Bh = *(const bf16x8*)(WRh + (size_t)(cb * 16 + r) * 1024 + c + 8 * q), Bl = *(const bf16x8*)(WRl + (size_t)(cb * 16 + r) * 1024 + c + 8 * q);
                acc[cb] = __builtin_amdgcn_mfma_f32_16x16x32_bf16(Ah, Bh, acc[cb], 0, 0, 0); acc[cb] = __builtin_amdgcn_mfma_f32_16x16x32_bf16(Al, Bh, acc[cb], 0, 0, 0); acc[cb] = __builtin_amdgcn_mfma_f32_16x16x32_bf16(Ah, Bl, acc[cb], 0, 0, 0); }
        }
#pragma unroll
        for (int cb = 0; cb < 3; ++cb)
#pragma unroll
            for (int i = 0; i < 4; ++i) LG[(4 * q + i) * 52 + cb * 16 + r] = acc[cb][i];
        asm volatile("s_waitcnt lgkmcnt(0)" ::: "memory");
        if (F.lane < 16) { LAS float* L = LG + F.lane * 52; const int rw = u * 16 + F.lane;
            float gl[4];
#pragma unroll
            for (int o = 0; o < 4; ++o) gl[o] = L[o] + bg[o];
            int gi = 0; float gm = gl[0];
#pragma unroll
            for (int o = 1; o < 4; ++o) if (gl[o] > gm) { gm = gl[o]; gi = o; }
            float den = 0.f;
#pragma unroll
            for (int o = 0; o < 4; ++o) den += expf(gl[o] - gm);
            const float gp = 1.f / den;
            const LAS float* el = L + 4 + gi * 8; const float* bel = be + gi * 8;
            int i1 = 0; float m1 = el[0] + bel[0]; for (int o = 1; o < 8; ++o) { const float v = el[o] + bel[o]; if (v > m1) { m1 = v; i1 = o; } }
            int i2 = -1; float m2 = 0.f; for (int o = 0; o < 8; ++o) { const float v = el[o] + bel[o]; if (o != i1 && (i2 < 0 || v > m2)) { m2 = v; i2 = o; } }
            const float e2 = expf(m2 - m1); const float w1 = 1.f / (1.f + e2), w2 = e2 / (1.f + e2);
            const int e1i = gi * 8 + i1, e2i = gi * 8 + i2;
            EID[rw * 2] = e1i; EID[rw * 2 + 1] = e2i; EW[rw * 2] = gp * w1; EW[rw * 2 + 1] = gp * w2;
            atomicAdd(&cnt[e1i], 1u); atomicAdd(&cnt[e2i], 1u);
        }
        asm volatile("s_waitcnt lgkmcnt(0)" ::: "memory");
    }
}
__device__ __forceinline__ int expert_off(const unsigned* cnt, int e) { int o = 0; for (int i = 0; i < e; ++i) o += ((int)cnt[i] + 255) & ~255; return o; }
__device__ __forceinline__ void ph11_scatter(Frame& F, int l) {
    const bf16* H = (const bf16*)(F.ws + WS_H); bf16* HS = (bf16*)(F.ws + WS_HS);
    const int* EID = (const int*)(F.ws + WS_EID); const float* EW = (const float*)(F.ws + WS_EW); int* STOK = (int*)(F.ws + WS_STOK); float* SW = (float*)(F.ws + WS_SW); int* TSLOT = (int*)(F.ws + WS_TSLOT);
    unsigned* cnt = F.ctl + CW_CNT + l * 128; unsigned* fill = cnt + 64;
    LAS int* HIST = (LAS int*)F.lds; LAS int* BASE = HIST + 32; LAS int* ISLOT = BASE + 32; LAS int* IROW = ISLOT + 512;
    const int nunits = (l == 0 ? MT : SEQ) / 16;
    __syncthreads();
    if (F.tid < 32) HIST[F.tid] = 0;
    __syncthreads();
    const int w = F.tid >> 5, u = F.bid + w * F.G; const bool valid = u < nunits; const int row = u * 16 + ((F.tid >> 1) & 15), kk = F.tid & 1;
    int e = 0, rank = 0; if (valid) { e = EID[row * 2 + kk]; rank = __hip_atomic_fetch_add(&HIST[e], 1, __ATOMIC_RELAXED, __HIP_MEMORY_SCOPE_WORKGROUP); }
    __syncthreads();
    if (F.tid < 32) { const int h = HIST[F.tid]; BASE[F.tid] = expert_off(cnt, F.tid) + (h > 0 ? (int)atomicAdd(&fill[F.tid], (unsigned)h) : 0); }
    __syncthreads();
    int slot = -1; if (valid) { slot = BASE[e] + rank; STOK[slot] = row; SW[slot] = EW[row * 2 + kk]; TSLOT[row * 2 + kk] = slot; }
    ISLOT[F.tid] = slot; IROW[F.tid] = row;
    __syncthreads();
#pragma unroll 4
    for (int it = F.wave; it < NT; it += NT / 64) { const int sl = ISLOT[it]; if (sl >= 0) { const v4u* src = (const v4u*)(H + (size_t)IROW[it] * D); v4u* dst = (v4u*)(HS + (size_t)sl * D);
        dst[F.lane] = src[F.lane]; dst[F.lane + 64] = src[F.lane + 64]; } }
}
__device__ __forceinline__ int slot_expert(const unsigned* cnt, int slot0, int& seg_off, int& n_e) { int o = 0; for (int e = 0; e < NE; ++e) { const int n = (int)cnt[e], pn = (n + 255) & ~255; if (slot0 < o + pn) { seg_off = o; n_e = n; return e; } o += pn; } seg_off = o; n_e = 0; return 0; }
__device__ __forceinline__ void ph12_naive(Frame& F, int l) {
    const bf16* HS = (const bf16*)(F.ws + WS_HS); bf16* ACT = (bf16*)(F.ws + WS_ACT); const float* SW = (const float*)(F.ws + WS_SW);
    const unsigned* cnt = F.ctl + CW_CNT + l * 128; const int total = expert_off(cnt, NE);
    NTILE_BEGIN((total / 64) * (DFF / 64))
        const int s0 = (T / (DFF / 64)) * 64, n0 = (T % (DFF / 64)) * 64; int seg, n_e; const int e = slot_expert(cnt, s0, seg, n_e);
        float aa[4][4] = {}, ab[4][4] = {};
        ngemm_acc(aa, ABf{HS + (size_t)s0 * D, D}, IN_(I_W1) + ((size_t)l * NE + e) * D * DFF + n0, DFF, D, sm, t);
        ngemm_acc(ab, ABf{HS + (size_t)s0 * D, D}, IN_(I_W3) + ((size_t)l * NE + e) * D * DFF + n0, DFF, D, sm, t);
        if (valid) {
#pragma unroll
            for (int i = 0; i < 4; ++i) { const int slot = s0 + ty * 4 + i; if (slot - seg < n_e) { const float w = SW[slot];
                v2u o; o.x = pk2(siluf_(aa[i][0]) * ab[i][0] * w, siluf_(aa[i][1]) * ab[i][1] * w); o.y = pk2(siluf_(aa[i][2]) * ab[i][2] * w, siluf_(aa[i][3]) * ab[i][3] * w);
                *(v2u*)(ACT + (size_t)slot * DFF + n0 + tx * 4) = o; } }
        }
    NTILE_END
}
__device__ __forceinline__ void ph13_naive(Frame& F, int l) {
    const bf16* ACT = (const bf16*)(F.ws + WS_ACT); bf16* YS2 = (bf16*)(F.ws + WS_YS2);
    const unsigned* cnt = F.ctl + CW_CNT + l * 128; const int total = expert_off(cnt, NE);
    NTILE_BEGIN((total / 64) * (D / 64))
        const int s0 = (T / (D / 64)) * 64, n0 = (T % (D / 64)) * 64; int seg, n_e; const int e = slot_expert(cnt, s0, seg, n_e);
        float acc[4][4] = {};
        ngemm_acc(acc, ABf{ACT + (size_t)s0 * DFF, DFF}, IN_(I_W2) + ((size_t)l * NE + e) * DFF * D + n0, D, DFF, sm, t);
        if (valid) {
#pragma unroll
            for (int i = 0; i < 4; ++i) { const int slot = s0 + ty * 4 + i; if (slot - seg < n_e) { v2u o; o.x = pk2(acc[i][0], acc[i][1]); o.y = pk2(acc[i][2], acc[i][3]); *(v2u*)(YS2 + (size_t)slot * D + n0 + tx * 4) = o; } }
        }
    NTILE_END
}
__device__ __forceinline__ void ph14_combine(Frame& F, int l) {
    const bf16* YS2 = (const bf16*)(F.ws + WS_YS2); const int* TSLOT = (const int*)(F.ws + WS_TSLOT); bf16* H = (bf16*)(F.ws + WS_H);
    const int gw = F.bid * (NT / 64) + F.wave, ngw = F.G * (NT / 64);
    const int nrows = l == 0 ? MT : SEQ;
    for (int row = gw; row < nrows; row += ngw) {
        const float* m = mod_ptr(F, l, row); float* xr = xrun_row(F, row);
        const int s0 = TSLOT[row * 2], s1 = TSLOT[row * 2 + 1];
        f32x4 v[4]; float s = 0.f;
#pragma unroll
        for (int j = 0; j < 4; ++j) { const int c = 4 * F.lane + 256 * j; const f32x4 x = *(const f32x4*)(xr + c); const f32x4 ga = *(const f32x4*)(m + 5120 + c);
            const v2u a = *(const v2u*)(YS2 + (size_t)s0 * D + c), b = *(const v2u*)(YS2 + (size_t)s1 * D + c);
            f32x4 y; y.x = bf2f((unsigned short)(a.x & 0xffff)) + bf2f((unsigned short)(b.x & 0xffff)); y.y = bf2f((unsigned short)(a.x >> 16)) + bf2f((unsigned short)(b.x >> 16));
            y.z = bf2f((unsigned short)(a.y & 0xffff)) + bf2f((unsigned short)(b.y & 0xffff)); y.w = bf2f((unsigned short)(a.y >> 16)) + bf2f((unsigned short)(b.y >> 16));
            v[j] = x + ga * y; s += v[j].x * v[j].x + v[j].y * v[j].y + v[j].z * v[j].z + v[j].w * v[j].w; }
        const float rstd = rsqrtf(wave_sum(s) * (1.f / D) + EPS);
        if (l == 0) {
            const float* m1 = mod_ptr(F, 1, row); const float* g = IN_(I_GMIX) + D;
#pragma unroll
            for (int j = 0; j < 4; ++j) { const int c = 4 * F.lane + 256 * j; *(f32x4*)(xr + c) = v[j];
                const f32x4 gg = *(const f32x4*)(g + c), sc = *(const f32x4*)(m1 + 1024 + c), sh = *(const f32x4*)(m1 + c);
                const f32x4 o = v[j] * rstd * gg * (1.f + sc) + sh; v2u w; w.x = pk2(o.x, o.y); w.y = pk2(o.z, o.w); *(v2u*)(H + (size_t)row * D + c) = w; }
        } else {
            const float* g = IN_(I_GF);
#pragma unroll
            for (int j = 0; j < 4; ++j) { const int c = 4 * F.lane + 256 * j; const f32x4 gg = *(const f32x4*)(g + c); f32x4 o = v[j] * rstd * gg;
                if (PROBE_B >= 0 && row < 3906) { volatile LAS unsigned long long* TS = (volatile LAS unsigned long long*)(F.lds + TS_OFF); o = o + (0.1f + 0.00001f * (float)(TS[1 + PROBE_B] - TS[PROBE_B])); }
                if (PROBE_A >= 0 && row == 0 && j == 0 && F.lane == 0) { volatile LAS unsigned long long* TS = (volatile LAS unsigned long long*)(F.lds + TS_OFF); o.x += 1.f + 0.001f * (float)(TS[1 + PROBE_A] - TS[PROBE_A]); }
                *(f32x4*)(xr + c) = o; }
        }
    }
}

#ifndef FASTMASK
#define FASTMASK 0xffff
#endif
constexpr unsigned FM = FASTMASK;
constexpr int NPH = 2 + 13 * 2;
__device__ __forceinline__ Frame make_frame(LAS unsigned char* lds, int wave0) {
    Frame F; F.lds = lds; F.wave = wave0; F.lane = (int)__builtin_amdgcn_mbcnt_hi(~0u, __builtin_amdgcn_mbcnt_lo(~0u, 0u)); asm volatile("" : "+v"(F.lane)); F.tid = F.wave * 64 + F.lane; F.bid = blockIdx.x; F.G = gridDim.x; asm volatile("" : "+s"(F.G), "+s"(F.bid));
    F.tab = (const unsigned long long LAS*)(lds + TAB_OFF);
    volatile LAS unsigned long long* t = (volatile LAS unsigned long long*)(lds + TAB_OFF);
    F.ws = (unsigned char*)uni64(t[35]); F.out = (float*)uni64(t[36]); F.ctl = (unsigned*)(F.ws + WS_CTL);
    return F;
}
__global__ void __launch_bounds__(NT, 2) mega_fwd(Args args) {
    extern __shared__ __attribute__((aligned(16))) unsigned char lds_raw[];
    LAS unsigned char* const lds = (LAS unsigned char*)lds_raw;
    const int wave0 = __builtin_amdgcn_readfirstlane((int)threadIdx.x >> 6);
    for (int u = threadIdx.x; u < 1024 / 4; u += NT) ((LAS unsigned*)(lds + 131072))[u] = 0u;
    if (threadIdx.x == 0) { LAS unsigned long long* t = (LAS unsigned long long*)(lds + TAB_OFF);
#pragma unroll
        for (int i = 0; i < 35; ++i) t[i] = (unsigned long long)args.in[i];
        t[35] = (unsigned long long)args.ws; t[36] = (unsigned long long)args.out; }
    __syncthreads();
    { Frame F = make_frame(lds, wave0); (void)xcd_barrier_post(F.ctl + CW_BAR, (volatile LAS unsigned*)(lds + MISC_OFF) + 8); }
    if ((PROBE_A >= 0 || PROBE_B >= 0) && threadIdx.x == 0) ((volatile LAS unsigned long long*)(lds + TS_OFF))[0] = __builtin_amdgcn_s_memrealtime();
    const int lo = args.ph_lo, hi = args.ph_hi; int ph = 0;
#define GRIDBAR() do { Frame Fb = make_frame(lds, wave0); XcdBarrier bar; bar.bar = Fb.ctl + CW_BAR; bar.x = xb_xcc_id(); bar.st = (volatile LAS unsigned*)(lds + MISC_OFF) + 8; xcd_barrier(bar, Fb.tid == 0); } while (0)
#ifndef REPBAR
#define REPBAR 0
#endif
#ifndef REPMASK
#define REPMASK 0
#endif
#define PHASE(...) do { if (lo <= ph && ph < hi) { const int _pl = ph < 2 ? ph : 2 + (ph - 2) % 13; for (int _rep = 0; _rep <= ((REPMASK >> _pl) & 1); ++_rep) { Frame F = make_frame(lds, wave0); __VA_ARGS__; } if (ph + 1 < hi) { GRIDBAR(); if (REPBAR) GRIDBAR(); } if ((PROBE_A >= 0 || PROBE_B >= 0) && threadIdx.x == 0) ((volatile LAS unsigned long long*)(lds + TS_OFF))[1 + ph] = __builtin_amdgcn_s_memrealtime(); } ++ph; } while (0)
    PHASE({ ph0_prologue(F); convert_weights(F, 0); { const f32x4* s = (const f32x4*)IN_(I_CTX); f32x4* d = (f32x4*)(F.ws + WS_XC); for (int i = F.bid * NT + F.tid; i < CTX * D / 4; i += F.G * NT) d[i] = s[i]; } });
    PHASE({ hprep_rows(F, 0); if (FM >> 3 & 1) s5_precompute(F); });
#pragma unroll 1
    for (int l = 0; l < 2; ++l) {
        PHASE({ if (FM >> 2 & 1) ph2_fast(F, l); else ph2_naive(F, l); });
        PHASE({ if (FM >> 3 & 1) { s5_z_phase(F, l); const int nch = (l == 0 ? MT : SEQ) / 128; if (F.G > nch) { if (F.bid < nch) sg_fast_chunk(F, l, F.bid); else { Frame F2 = F; F2.bid -= nch; F2.G -= nch; ph3_conv(F2, l, l == 0 ? MT : SEQ); } } else { for (int c = F.bid; c < nch; c += F.G) sg_fast_chunk(F, l, c); ph3_conv(F, l, l == 0 ? MT : SEQ); } } else { ph3_s5_naive(F, l); if (F.bid >= 64) { Frame F2 = F; F2.bid -= 64; F2.G -= 64; ph3_sg_naive(F2, l); ph3_conv(F2, l, MT); } } });
        PHASE({ if (FM >> 3 & 1) s5_scan_phase(F, l); });
        PHASE({ if (FM >> 3 & 1) s5_y_phase(F, l); else ph5_naive(F, l); });
        PHASE({ if (FM >> 6 & 1) ph6_fast(F, l); else ph6_naive(F, l); });
        PHASE({ if (FM >> 7 & 1) ph7_fast(F, l); else ph7_naive(F, l); });
        PHASE({ if (FM >> 8 & 1) ph8_fast(F, l); else ph8_naive(F, l); });
        PHASE({ if (FM >> 9 & 1) ph9_fast(F, l); else ph9_naive(F, l); });
        PHASE(ph10_route(F, l));
        PHASE(ph11_scatter(F, l));
        PHASE({ if (FM >> 12 & 1) ph12_fast(F, l); else ph12_naive(F, l); });
        PHASE({ if (FM >> 13 & 1) ph13_fast(F, l); else ph13_naive(F, l); });
        PHASE({ ph14_combine(F, l); if (l == 0) convert_weights(F, 1); });
    }
#undef PHASE
}

extern "C" void kernel_launch(void* const* d_in, const int* in_sizes, int n_in, void* d_out, int out_size, void* d_ws, size_t ws_size, hipStream_t stream) {
    static int grid = 0;
    if (grid == 0) {
        int dev = 0, cus = 0, per_cu = 0;
        if (n_in != 35 || out_size != SEQ * D || ws_size < WS_END) { fprintf(stderr, "kernel_launch: unexpected shapes (n_in %d out %d ws %zu)\n", n_in, out_size, ws_size); grid = -1; return; }
        if (hipGetDevice(&dev) != hipSuccess || hipDeviceGetAttribute(&cus, hipDeviceAttributeMultiprocessorCount, dev) != hipSuccess) { grid = -1; return; }
        if (hipFuncSetAttribute((const void*)mega_fwd, hipFuncAttributeMaxDynamicSharedMemorySize, LDS_BYTES) != hipSuccess) { fprintf(stderr, "kernel_launch: hipFuncSetAttribute failed\n"); grid = -1; return; }
        if (hipOccupancyMaxActiveBlocksPerMultiprocessor(&per_cu, (const void*)mega_fwd, NT, LDS_BYTES) != hipSuccess || per_cu < 1) { fprintf(stderr, "kernel_launch: occupancy query says %d blocks per CU\n", per_cu); grid = -1; return; }
        grid = cus;
    }
    if (grid < 0) return;
    (void)hipMemsetAsync((char*)d_ws + WS_CTL, 0, CTL_ZERO_BYTES, stream);
    Args a{};
    for (int i = 0; i < 35; ++i) a.in[i] = (const float*)d_in[i];
    a.out = (float*)d_out; a.ws = (unsigned char*)d_ws; a.ph_lo = 0; a.ph_hi = NPH;
    void* kargs[] = {&a};
    hipError_t e = hipLaunchCooperativeKernel((const void*)mega_fwd, dim3(grid), dim3(NT), kargs, LDS_BYTES, stream);
    if (e != hipSuccess) fprintf(stderr, "kernel_launch: cooperative launch failed: %s (grid %d)\n", hipGetErrorString(e), grid);
}
```

```cpp
#include <hip/hip_runtime.h>
#include <stdint.h>
#include <cstdio>

#define GAS __attribute__((address_space(1)))
#define LAS __attribute__((address_space(3)))
typedef unsigned short bf16;
typedef unsigned v4u __attribute__((ext_vector_type(4)));
typedef unsigned v2u __attribute__((ext_vector_type(2)));
typedef float f32x4 __attribute__((ext_vector_type(4)));

constexpr int D = 1024, SEQ = 16384, CTX = 256, MT = SEQ + CTX;
constexpr int MIXW = 512, INW = 3072, G5 = 32, P5 = 64, H5 = 16;
constexpr int NE = 32, DFF = 256;
constexpr int MAXSLOT = 2 * MT + NE * 256;
constexpr float EPS = 1e-6f;
constexpr int NT = 512;

constexpr size_t MiB = 1u << 20;
constexpr size_t WS_CTL = 0, CTL_ZERO_BYTES = 1 * MiB;
constexpr size_t WS_MOD = 1 * MiB;
constexpr size_t WS_XC = 2 * MiB;
constexpr size_t WS_EID = 3 * MiB;
constexpr size_t WS_EW = WS_EID + (size_t)MT * 8;
constexpr size_t WS_STOK = WS_EW + (size_t)MT * 8;
constexpr size_t WS_SW = WS_STOK + (size_t)MAXSLOT * 4;
constexpr size_t WS_TSLOT = WS_SW + (size_t)MAXSLOT * 4;
constexpr size_t WS_H = 4 * MiB;
constexpr size_t WS_PROJ = WS_H + (size_t)MT * 2048;
constexpr size_t WS_YS = WS_PROJ + (size_t)MT * 6144;
constexpr size_t WS_YG = WS_YS + (size_t)3 * MT * 1024;
constexpr size_t WS_PM = WS_YG + (size_t)MT * 1024;
constexpr size_t WS_S5 = WS_PM + (size_t)MT * 2048;
constexpr size_t WS_Z = WS_S5;
constexpr size_t WS_SS = WS_Z + (size_t)1040 * 32 * 256 * 4;
constexpr size_t WS_S5M = WS_SS + (size_t)1040 * 32 * 256 * 2;
constexpr size_t WS_A16 = WS_S5M + (size_t)2 * 32 * 3 * 65536 * 2;
constexpr size_t WS_W = WS_A16 + (size_t)2 * 32 * 2 * 64 * 2 * 4 > WS_S5 + (size_t)2 * MT * 512 * 4 ? WS_A16 + (size_t)2 * 32 * 2 * 64 * 2 * 4 : WS_S5 + (size_t)2 * MT * 512 * 4;
constexpr size_t WS_WIN = WS_W;
constexpr size_t WS_WMG = WS_WIN + (size_t)3072 * 1024 * 2;
constexpr size_t WS_WGLU = WS_WMG + (size_t)3072 * 1024 * 2;
constexpr size_t WS_WBR = WS_WGLU + (size_t)512 * 512 * 2;
constexpr size_t WS_WO = WS_WBR + (size_t)3 * 1024 * 512 * 2;
constexpr size_t WS_W13 = WS_WO + (size_t)1024 * 1024 * 2;
constexpr size_t WS_W2 = WS_W13 + (size_t)32 * 512 * 1024 * 2;
constexpr size_t WS_WSG = WS_W2 + (size_t)32 * 1024 * 256 * 2;
constexpr size_t WS_WR = WS_WSG + (size_t)4 * 128 * 128 * 2;
constexpr size_t WS_END = WS_WR + (size_t)2 * 48 * 1024 * 2;
static_assert(WS_END <= (size_t)377 * MiB, "workspace budget");
constexpr size_t WS_HS = WS_PROJ;
constexpr size_t WS_ACT = WS_YS;
constexpr size_t WS_YS2 = WS_YG;
static_assert(WS_HS + (size_t)MAXSLOT * 2048 <= WS_YS && WS_ACT + (size_t)MAXSLOT * 512 <= WS_YG && WS_YS2 + (size_t)MAXSLOT * 2048 <= WS_W, "moe overlays");
static_assert(WS_TSLOT + (size_t)MT * 8 <= WS_H, "ws map");
constexpr int CW_CNT = 64;
constexpr int CW_BAR = 4096;

#ifndef PROBE_A
#define PROBE_A -1
#endif
#ifndef PROBE_B
#define PROBE_B -1
#endif
constexpr int TS_OFF = 131072 + 512;
constexpr int LDS_BYTES = 147456;
constexpr int MISC_OFF = 131072 + 320;
constexpr int TAB_OFF = 131072 + 1024;

__device__ __forceinline__ float bf2f(unsigned short b) { return __builtin_bit_cast(float, ((unsigned)b) << 16); }
__device__ __forceinline__ unsigned f2bf(float f) { unsigned u = __builtin_bit_cast(unsigned, f); return (u + 0x7fffu + ((u >> 16) & 1u)) >> 16; }
__device__ __forceinline__ unsigned pk2(float lo, float hi) { return f2bf(lo) | (f2bf(hi) << 16); }
__device__ __forceinline__ float sigmoidf_(float x) { return 1.f / (1.f + __expf(-x)); }
__device__ __forceinline__ float siluf_(float x) { return x / (1.f + __expf(-x)); }
__device__ __forceinline__ float geluf_(float x) { const float u = 0.7978845608028654f * (x + 0.044715f * x * x * x); return x / (1.f + __expf(-2.f * u)); }
__device__ __forceinline__ float wave_sum(float v) {
#pragma unroll
    for (int o = 1; o < 64; o <<= 1) v += __shfl_xor(v, o);
    return v;
}

#define XB_TMO      128
#define XB_XCNT(j)  (256  + 64 * (j))
#define XB_XSUB(j)  (1280 + 64 * (j))
#define XB_XGEN(j)  (2304 + 64 * (j))
#define XB_TOP      3328
#define XB_TOPGEN   3392
#define XCD_BAR_WORDS 3456
#define XB_SPIN_CAP (1u << 24)
__device__ __forceinline__ unsigned xb_ld(unsigned* p)              { return __hip_atomic_load(p, __ATOMIC_RELAXED, __HIP_MEMORY_SCOPE_AGENT); }
__device__ __forceinline__ unsigned xb_add(unsigned* p, unsigned v) { return __hip_atomic_fetch_add(p, v, __ATOMIC_RELAXED, __HIP_MEMORY_SCOPE_AGENT); }
__device__ __forceinline__ unsigned xb_xcc_id() { return (unsigned)__builtin_amdgcn_s_getreg((3 << 11) | 20) & 0xFu; }
#define XB_SPIN(cond, bar) do { unsigned _sp = 0; while (cond) { __builtin_amdgcn_s_sleep(1); \
    if ((++_sp & 255u) == 0u) { if (xb_ld(&(bar)[XB_TMO])) break; if (_sp > XB_SPIN_CAP) { atomicAdd(&(bar)[XB_TMO], 1u); break; } } } } while (0)
struct XcdBarrier { unsigned* bar; unsigned x; volatile LAS unsigned* st; };
__device__ __forceinline__ XcdBarrier xcd_barrier_post(unsigned* bar, volatile LAS unsigned* st) {
    XcdBarrier b; b.bar = bar; b.x = xb_xcc_id(); b.st = st;
    if (threadIdx.x == 0) (void)xb_add(&bar[XB_XCNT(b.x)], 1u);
    return b;
}
__device__ __forceinline__ void xcd_barrier_complete(unsigned* bar, unsigned x, unsigned& nloc, unsigned& nx) {
    const unsigned G = gridDim.x * gridDim.y * gridDim.z;
    unsigned sum, cnt, mine, sp = 0u;
    for (;;) {
        sum = 0u; cnt = 0u; mine = 0u;
#pragma unroll
        for (unsigned j = 0; j < 16; ++j) { const unsigned c = xb_ld(&bar[XB_XCNT(j)]); sum += c; cnt += (c > 0u) ? 1u : 0u; mine = (j == x) ? c : mine; }
        if (sum == G) break;
        __builtin_amdgcn_s_sleep(1);
        if ((++sp & 255u) == 0u) { if (xb_ld(&bar[XB_TMO])) break; if (sp > XB_SPIN_CAP) { atomicAdd(&bar[XB_TMO], 1u); break; } }
    }
    nloc = mine > 0u ? mine : 1u; nx = cnt > 0u ? cnt : 1u;
}
__device__ __forceinline__ void xcd_barrier(const XcdBarrier& b, bool leader) {
    asm volatile("s_waitcnt vmcnt(0)" ::: "memory");
    __syncthreads();
    if (leader) {
        unsigned* bar = b.bar;
        __builtin_amdgcn_s_waitcnt(0);
        unsigned nloc = b.st[0], nx = b.st[1];
        if (nloc == 0u) { xcd_barrier_complete(bar, b.x, nloc, nx); b.st[0] = nloc; b.st[1] = nx; }
        const unsigned old = xb_add(&bar[XB_XSUB(b.x)], 1u);
        const unsigned gen = old / nloc;
        if (old + 1u == (gen + 1u) * nloc) {
            __builtin_amdgcn_fence(__ATOMIC_RELEASE, "agent");
            asm volatile("s_waitcnt vmcnt(0)" ::: "memory");
            const unsigned og = xb_add(&bar[XB_TOP], 1u);
            const unsigned tg = og / nx;
            if (og + 1u == (tg + 1u) * nx) xb_add(&bar[XB_TOPGEN], 1u);
            else XB_SPIN(xb_ld(&bar[XB_TOPGEN]) == tg, bar);
            __builtin_amdgcn_fence(__ATOMIC_ACQUIRE, "agent");
            xb_add(&bar[XB_XGEN(b.x)], 1u);
            asm volatile("s_waitcnt vmcnt(0)" ::: "memory");
        } else {
            XB_SPIN(xb_ld(&bar[XB_XGEN(b.x)]) == gen, bar);
            __builtin_amdgcn_fence(__ATOMIC_ACQUIRE, "agent");
            asm volatile("s_waitcnt vmcnt(0)" ::: "memory");
        }
    }
    __syncthreads();
}

struct Args { const float* in[35]; float* out; unsigned char* ws; int ph_lo, ph_hi; };
struct Frame {
    LAS unsigned char* lds; unsigned char* ws; unsigned* ctl;
    int tid, lane, wave, bid, G;
    const unsigned long long LAS* tab; float* out;
};
__device__ __forceinline__ unsigned long long uni64(unsigned long long v) { const unsigned lo = __builtin_amdgcn_readfirstlane((unsigned)v), hi = __builtin_amdgcn_readfirstlane((unsigned)(v >> 32)); return ((unsigned long long)hi << 32) | lo; }
#define IN_(k) ((const float*)uni64(F.tab[k]))
enum { I_X = 0, I_C, I_CTX, I_CCTX, I_WADA, I_BADA, I_GMIX, I_GFFN, I_WIN, I_LRE, I_LIM, I_LDT, I_BRE, I_BIM, I_CRE, I_CIM, I_DSKIP, I_WGLU, I_SGG, I_SGB, I_WSG, I_BSG,
       I_WCONV, I_WBR, I_WMG, I_BMG, I_WO, I_WGRP, I_BGRP, I_WEXP, I_BEXP, I_W1, I_W3, I_W2, I_GF };

__device__ __forceinline__ const float* mod_ptr(const Frame& F, int l, int row) { return (const float*)(F.ws + WS_MOD) + (size_t)(l * 2 + (row >= SEQ ? 1 : 0)) * 6144; }
__device__ __forceinline__ const float* xsrc_row(const Frame& F, int l, int row) {
    if (l == 0) return row < SEQ ? IN_(I_X) + (size_t)row * D : IN_(I_CTX) + (size_t)(row - SEQ) * D;
    return row < SEQ ? F.out + (size_t)row * D : (const float*)(F.ws + WS_XC) + (size_t)(row - SEQ) * D;
}
__device__ __forceinline__ float* xrun_row(const Frame& F, int row) { return row < SEQ ? F.out + (size_t)row * D : (float*)(F.ws + WS_XC) + (size_t)(row - SEQ) * D; }


namespace pg8 {
#define PG8_LAS __attribute__((address_space(3)))
typedef unsigned short bf16_t;
typedef short bf16x8 __attribute__((ext_vector_type(8)));
typedef float f32x4 __attribute__((ext_vector_type(4)));
typedef unsigned u32x4 __attribute__((ext_vector_type(4)));
constexpr int BM = 256, BK = 64, HALF = 128, HTB = HALF * BK * 2  , STAGE_BYTES = 8 * HTB, NXCD = 8, WGM = 8;

__host__ __device__ __forceinline__ int lds_byte(int r, int c) { const int st = (r >> 4) * 2 + (c >> 5), rr = r & 15, cc = c & 31, ob = rr * 64 + cc * 2; return st * 1024 + (ob ^ (((ob >> 9) & 1) << 5)); }
__host__ __device__ __forceinline__ void stage_rc(int b, int& R, int& C) { const int st = b / 1024, sb = b % 1024, swz = sb ^ (((sb >> 9) & 1) << 5); R = (st >> 1) * 16 + swz / 64; C = (st & 1) * 32 + (swz % 64) / 2; }
__host__ __device__ __forceinline__ int perm32(int rho) { const int n = rho >> 4, i = rho & 15; return 8 * (i >> 2) + 4 * n + (i & 3); }

struct Unit { int pm, pn; };
struct Gemm { const bf16_t* A; const bf16_t* Bt; int M, N, K; };

struct StaticOrder {
    int nM, nN, nwg, G, c;
    __host__ __device__ void init(int M, int N, int G_, int c_) { nM = M / BM; nN = N / BM; nwg = nM * nN; G = G_; c = c_; }
    __host__ __device__ bool next(int i, Unit& u) const {
        const long L = (long)i * G + c; if (L >= nwg) return false;
        int wgid = (int)L; { const int q = nwg / NXCD, r = nwg % NXCD, xcd = wgid % NXCD, off = wgid / NXCD; wgid = (xcd < r ? xcd * (q + 1) : r * (q + 1) + (xcd - r) * q) + off; }
        const int nig = WGM * nN, gid = wgid / nig, fm = gid * WGM, gsz = (nM - fm) < WGM ? (nM - fm) : WGM;
        u.pm = fm + ((wgid % nig) % gsz); u.pn = (wgid % nig) / gsz; return true;
    }
    __device__ __forceinline__ void a_ready(const Unit&) const {}
    __device__ __forceinline__ void done(const Unit&) const {}
};
__device__ __forceinline__ unsigned cvt_pk_bf16(float lo, float hi) { unsigned r; asm volatile("v_cvt_pk_bf16_f32 %0, %1, %2" : "=v"(r) : "v"(lo), "v"(hi)); return r; }
template <class Epi, class Sched, bool ALIGN_EPI = false, bool SP2 = false>
__device__ __forceinline__ void gemm_phase(PG8_LAS unsigned char* lds, const Gemm g, const Sched& S, const Epi& E, int tid_in) {
    int tid_ = tid_in; asm volatile("" : "+v"(tid_));
    const int tid = tid_, wid = __builtin_amdgcn_readfirstlane(tid >> 6), lane = tid & 63, wr = wid >> 2, wc = wid & 3, fr = lane & 15, fq = lane >> 4;
    const int K = g.K, nt = K / BK;
    unsigned voffA[2], voffB[2];
#pragma unroll
    for (int i = 0; i < 2; ++i) { int R, C; stage_rc(tid * 16 + i * 8192, R, C); const int Rb = Epi::PERM ? ((R & ~31) + perm32(R & 31)) : R;
        voffA[i] = (unsigned)(R * K + C) * 2u; voffB[i] = (unsigned)(Rb * K + C) * 2u; }
    const size_t kstep = (size_t)(BK * 2);
    const size_t hstep = (size_t)HALF * K * 2;
    const size_t tstep = 2 * hstep;
    const unsigned ldsw = (unsigned)wid * 1024u;
    const int aoff = lds_byte(wr * 64 + fr, fq * 8), boff = lds_byte(wc * 32 + fr, fq * 8);
#define PG8_SA(b, h) (((b) * 2 + (h)) * HTB)
#define PG8_SB(b, h) ((4 + (b) * 2 + (h)) * HTB)
#define PG8_STAGE(bufoff, gbase, voff) do { _Pragma("unroll") for (int _i = 0; _i < 2; ++_i) \
        __builtin_amdgcn_global_load_lds((const unsigned*)((const char*)(gbase) + (voff)[_i]), (PG8_LAS unsigned*)(lds + (bufoff) + ldsw + _i * 8192), 16, 0, 0); } while (0)
#define PG8_LDA(dst, b, h) do { _Pragma("unroll") for (int m = 0; m < 4; ++m) _Pragma("unroll") for (int k = 0; k < 2; ++k) dst[m][k] = *(const PG8_LAS bf16x8*)(lds + PG8_SA(b, h) + aoff + m * 2048 + k * 1024); } while (0)
#define PG8_LDB(dst, b, h) do { _Pragma("unroll") for (int n = 0; n < 2; ++n) _Pragma("unroll") for (int k = 0; k < 2; ++k) dst[n][k] = *(const PG8_LAS bf16x8*)(lds + PG8_SB(b, h) + boff + n * 2048 + k * 1024); } while (0)
#define PG8_MMA(ai, bj, At, Bt) do { __builtin_amdgcn_s_setprio(1); _Pragma("unroll") for (int m = 0; m < 4; ++m) _Pragma("unroll") for (int n = 0; n < 2; ++n) _Pragma("unroll") for (int k = 0; k < 2; ++k) \
        acc[ai][bj][m][n] = __builtin_amdgcn_mfma_f32_16x16x32_bf16(Bt[n][k], At[m][k], acc[ai][bj][m][n], 0, 0, 0); __builtin_amdgcn_s_setprio(0); } while (0)
#define PG8_WAIT_V(n) asm volatile("s_waitcnt vmcnt(" #n ")" ::: "memory")
#define PG8_WAIT_L(n) asm volatile("s_waitcnt lgkmcnt(" #n ")" ::: "memory")
#define PG8_BAR __builtin_amdgcn_s_barrier()
#define PG8_SCHED __builtin_amdgcn_sched_barrier(0)
    Unit cur, nxt; int ui = 0;
    if (!S.next(0, cur)) return;
    f32x4 acc[2][2][4][2];
#pragma unroll
    for (int a = 0; a < 2; ++a)
#pragma unroll
        for (int b = 0; b < 2; ++b)
#pragma unroll
            for (int m = 0; m < 4; ++m)
#pragma unroll
                for (int n = 0; n < 2; ++n) acc[a][b][m][n] = (f32x4){0.f, 0.f, 0.f, 0.f};
    bf16x8 At[4][2], B0[2][2], B1[2][2];
    const char* cA = (const char*)g.A + (size_t)cur.pm * tstep; const char* cB = (const char*)g.Bt + (size_t)cur.pn * tstep;
    S.a_ready(cur);
    if constexpr (SP2) {
        PG8_STAGE(PG8_SB(0, 0), cB, voffB); PG8_STAGE(PG8_SB(0, 1), cB + hstep, voffB); PG8_STAGE(PG8_SA(0, 0), cA, voffA); PG8_STAGE(PG8_SA(0, 1), cA + hstep, voffA);
        if (wr == 1) PG8_BAR;
        PG8_WAIT_V(2); PG8_BAR;
        PG8_STAGE(PG8_SB(1, 0), cB + kstep, voffB); PG8_STAGE(PG8_SA(1, 0), cA + kstep, voffA); PG8_STAGE(PG8_SB(1, 1), cB + hstep + kstep, voffB);
        PG8_WAIT_V(6); PG8_BAR;
    } else {
        PG8_STAGE(PG8_SB(0, 0), cB, voffB); PG8_STAGE(PG8_SA(0, 0), cA, voffA); PG8_STAGE(PG8_SB(0, 1), cB + hstep, voffB); PG8_STAGE(PG8_SA(0, 1), cA + hstep, voffA);
        if (wr == 1) PG8_BAR;
        PG8_WAIT_V(4); PG8_BAR;
        PG8_STAGE(PG8_SB(1, 0), cB + kstep, voffB); PG8_STAGE(PG8_SA(1, 0), cA + kstep, voffA); PG8_STAGE(PG8_SB(1, 1), cB + hstep + kstep, voffB);
        PG8_WAIT_V(6); PG8_BAR;
    }
    for (;;) {
        const bool has_next = S.next(ui + 1, nxt);
        const char* nA = has_next ? (const char*)g.A + (size_t)nxt.pm * tstep : cA; const char* nB = has_next ? (const char*)g.Bt + (size_t)nxt.pn * tstep : cB;
#pragma unroll 1
        for (int t = 0; t < nt; t += 2) {
            const bool last = (t == nt - 2);
            const char* a1 = cA + (size_t)(t + 1) * kstep;
            const char* a2 = last ? nA : cA + (size_t)(t + 2) * kstep; const char* b2 = last ? nB : cB + (size_t)(t + 2) * kstep;
            const char* a3 = a2 + kstep; const char* b3 = b2 + kstep;
            if (last && has_next) S.a_ready(nxt);
            if constexpr (SP2) {
            PG8_LDB(B0, 0, 0); PG8_LDB(B1, 0, 1); PG8_SCHED; PG8_LDA(At, 0, 0); PG8_STAGE(PG8_SA(1, 1), a1 + hstep, voffA);
            PG8_WAIT_V(8); PG8_WAIT_L(0); PG8_BAR; PG8_MMA(0, 0, At, B0); PG8_MMA(0, 1, At, B1); PG8_BAR; PG8_SCHED;
            PG8_LDA(At, 0, 1); PG8_STAGE(PG8_SB(0, 0), b2, voffB); PG8_STAGE(PG8_SB(0, 1), b2 + hstep, voffB); PG8_STAGE(PG8_SA(0, 0), a2, voffA);
            PG8_WAIT_V(8); PG8_WAIT_L(0); PG8_BAR; PG8_MMA(1, 0, At, B0); PG8_MMA(1, 1, At, B1); PG8_BAR; PG8_SCHED;
            PG8_LDB(B0, 1, 0); PG8_LDB(B1, 1, 1); PG8_SCHED; PG8_LDA(At, 1, 0); PG8_STAGE(PG8_SA(0, 1), a2 + hstep, voffA);
            PG8_WAIT_V(8); PG8_WAIT_L(0); PG8_BAR; PG8_MMA(0, 0, At, B0); PG8_MMA(0, 1, At, B1); PG8_BAR; PG8_SCHED;
            PG8_LDA(At, 1, 1); PG8_STAGE(PG8_SB(1, 0), b3, voffB); PG8_STAGE(PG8_SB(1, 1), b3 + hstep, voffB); PG8_STAGE(PG8_SA(1, 0), a3, voffA);
            PG8_WAIT_V(8); PG8_WAIT_L(0); PG8_BAR; PG8_MMA(1, 0, At, B0); PG8_MMA(1, 1, At, B1); PG8_BAR; PG8_SCHED;
            } else {
            PG8_LDB(B0, 0, 0); PG8_SCHED; PG8_LDA(At, 0, 0); PG8_STAGE(PG8_SA(1, 1), a1 + hstep, voffA);
            PG8_WAIT_L(8); PG8_BAR; PG8_WAIT_L(0); PG8_MMA(0, 0, At, B0); PG8_BAR; PG8_SCHED;
            PG8_LDB(B1, 0, 1); PG8_STAGE(PG8_SB(0, 0), b2, voffB);
            PG8_BAR; PG8_WAIT_L(0); PG8_MMA(0, 1, At, B1); PG8_BAR;
            PG8_LDA(At, 0, 1); PG8_STAGE(PG8_SA(0, 0), a2, voffA);
            PG8_BAR; PG8_WAIT_L(0); PG8_MMA(1, 0, At, B0); PG8_BAR; PG8_SCHED;
            PG8_STAGE(PG8_SB(0, 1), b2 + hstep, voffB);
            PG8_WAIT_V(6); PG8_BAR; PG8_MMA(1, 1, At, B1); PG8_BAR;
            PG8_LDB(B0, 1, 0); PG8_SCHED; PG8_LDA(At, 1, 0); PG8_STAGE(PG8_SA(0, 1), a2 + hstep, voffA);
            PG8_WAIT_L(8); PG8_BAR; PG8_WAIT_L(0); PG8_MMA(0, 0, At, B0); PG8_BAR; PG8_SCHED;
            PG8_LDB(B1, 1, 1); PG8_STAGE(PG8_SB(1, 0), b3, voffB);
            PG8_BAR; PG8_WAIT_L(0); PG8_MMA(0, 1, At, B1); PG8_BAR;
            PG8_LDA(At, 1, 1); PG8_STAGE(PG8_SA(1, 0), a3, voffA);
            PG8_BAR; PG8_WAIT_L(0); PG8_MMA(1, 0, At, B0); PG8_BAR; PG8_SCHED;
            PG8_STAGE(PG8_SB(1, 1), b3 + hstep, voffB);
            PG8_WAIT_V(6); PG8_BAR; PG8_MMA(1, 1, At, B1); PG8_BAR;
            }
        }
        if constexpr (ALIGN_EPI) { if (wr == 0) PG8_BAR; }
        if constexpr (!Epi::AFTER_DRAIN) { E(acc, cur, wr, wc, fr, fq); S.done(cur); }
        if (!has_next) break;
#pragma unroll
        for (int a = 0; a < 2; ++a)
#pragma unroll
            for (int b = 0; b < 2; ++b)
#pragma unroll
                for (int m = 0; m < 4; ++m)
#pragma unroll
                    for (int n = 0; n < 2; ++n) acc[a][b][m][n] = (f32x4){0.f, 0.f, 0.f, 0.f};
        cur = nxt; cA = nA; cB = nB; ++ui;
        if constexpr (ALIGN_EPI) { if (wr == 1) PG8_BAR; }
    }
    PG8_WAIT_V(0);
    if constexpr (!ALIGN_EPI) { if (wr == 0) PG8_BAR; }
    PG8_BAR;
    if constexpr (Epi::AFTER_DRAIN) { E.fused(acc, cur, wr, wc, fr, fq, lds, wid, lane); S.done(cur); }
#undef PG8_SA
#undef PG8_SB
#undef PG8_STAGE
#undef PG8_LDA
#undef PG8_LDB
#undef PG8_MMA
#undef PG8_WAIT_V
#undef PG8_WAIT_L
#undef PG8_BAR
#undef PG8_SCHED
}
}

constexpr bool PG_ALIGN = true, PG_SP2 = true;
__device__ __forceinline__ float bflo(unsigned w) { return __builtin_bit_cast(float, w << 16); }
__device__ __forceinline__ float bfhi(unsigned w) { return __builtin_bit_cast(float, w & 0xffff0000u); }
__device__ __forceinline__ unsigned cvtpk(float lo, float hi) { return pg8::cvt_pk_bf16(lo, hi); }

__device__ __forceinline__ void transpose_item(const float* W, int N, int k0, int n0, bf16* WT, int K, size_t dst_row0, LAS float* scr, int lane) {
    float v[32];
#pragma unroll
    for (int i = 0; i < 32; ++i) v[i] = W[(size_t)(k0 + 2 * i + (lane >> 5)) * N + n0 + (lane & 31)];
#pragma unroll
    for (int i = 0; i < 32; ++i) scr[(2 * i + (lane >> 5)) * 33 + (lane & 31)] = v[i];
    asm volatile("s_waitcnt lgkmcnt(0)" ::: "memory");
    const int c = lane & 7;
#pragma unroll
    for (int j = 0; j < 4; ++j) { const int n = (lane >> 3) + 8 * j; const LAS float* s = scr + (8 * c) * 33 + n;
        v4u o; o.x = pk2(s[0 * 33], s[1 * 33]); o.y = pk2(s[2 * 33], s[3 * 33]); o.z = pk2(s[4 * 33], s[5 * 33]); o.w = pk2(s[6 * 33], s[7 * 33]);
        *(v4u*)(WT + (dst_row0 + n) * K + k0 + 8 * c) = o; }
    asm volatile("s_waitcnt lgkmcnt(0)" ::: "memory");
}
__device__ __forceinline__ void convert_weights(Frame& F, int l) {
    LAS float* scr = (LAS float*)(F.lds + F.wave * 16384);
    const int gw = F.bid * (NT / 64) + F.wave, ngw = F.G * (NT / 64);
    constexpr int I_IN = 16 * 96, I_MG = 16 * 96, I_GLU = 8 * 16, I_BR = 3 * 8 * 32, I_O = 16 * 32, I_1 = 32 * 16 * 8, I_3 = I_1, I_2 = 32 * 4 * 32;
    constexpr int NITEMS = I_IN + I_MG + I_GLU + I_BR + I_O + I_1 + I_3 + I_2;
    for (int it = gw; it < NITEMS; it += ngw) {
        int r = it;
        if (r < I_IN) { const int kb = r / 96, nb = r % 96; transpose_item(IN_(I_WIN) + (size_t)l * D * INW, INW, 64 * kb, 32 * nb, (bf16*)(F.ws + WS_WIN), 1024, 32 * nb, scr, F.lane); continue; } r -= I_IN;
        if (r < I_MG) { const int kb = r / 96, nb = r % 96; transpose_item(IN_(I_WMG) + (size_t)l * D * INW, INW, 64 * kb, 32 * nb, (bf16*)(F.ws + WS_WMG), 1024, 32 * nb, scr, F.lane); continue; } r -= I_MG;
        if (r < I_GLU) { const int kb = r / 16, nb = r % 16; transpose_item(IN_(I_WGLU) + (size_t)l * MIXW * MIXW, MIXW, 64 * kb, 32 * nb, (bf16*)(F.ws + WS_WGLU), 512, 32 * nb, scr, F.lane); continue; } r -= I_GLU;
        if (r < I_BR) { const int kk = r / 256, q = r % 256, kb = q / 32, nb = q % 32; transpose_item(IN_(I_WBR) + ((size_t)l * 3 + kk) * MIXW * D, D, 64 * kb, 32 * nb, (bf16*)(F.ws + WS_WBR), 512, (size_t)kk * 1024 + 32 * nb, scr, F.lane); continue; } r -= I_BR;
        if (r < I_O) { const int kb = r / 32, nb = r % 32; transpose_item(IN_(I_WO) + (size_t)l * D * D, D, 64 * kb, 32 * nb, (bf16*)(F.ws + WS_WO), 1024, 32 * nb, scr, F.lane); continue; } r -= I_O;
        if (r < I_1 + I_3) { const int which = r / I_1, q = r % I_1, e = q / 128, q2 = q % 128, kb = q2 / 8, nb = q2 % 8;
            const float* W = IN_(which ? I_W3 : I_W1) + ((size_t)l * NE + e) * D * DFF; const int n0 = 32 * nb;
            transpose_item(W, DFF, 64 * kb, n0, (bf16*)(F.ws + WS_W13), 1024, (size_t)e * 512 + (n0 / 128) * 256 + which * 128 + (n0 % 128), scr, F.lane); continue; } r -= I_1 + I_3;
        { const int e = r / 128, q = r % 128, kb = q / 32, nb = q % 32; transpose_item(IN_(I_W2) + ((size_t)l * NE + e) * DFF * D, D, 64 * kb, 32 * nb, (bf16*)(F.ws + WS_W2), 256, (size_t)e * 1024 + 32 * nb, scr, F.lane); }
    }
    { bf16* wr = (bf16*)(F.ws + WS_WR); const float* wg = IN_(I_WGRP) + (size_t)l * D * 4; const float* we = IN_(I_WEXP) + (size_t)l * D * 32;
      for (int i = F.bid * NT + F.tid; i < 48 * 1024; i += F.G * NT) { const int n = i >> 10, kk = i & 1023; const float w = n < 4 ? wg[kk * 4 + n] : (n < 36 ? we[kk * 32 + n - 4] : 0.f);
          const unsigned hi = f2bf(w); const float lo = w - __builtin_bit_cast(float, hi << 16); wr[i] = (bf16)hi; wr[48 * 1024 + i] = (bf16)f2bf(lo); } }
    { const float* s = IN_(I_WSG) + (size_t)l * 4 * 128 * 128; bf16* d = (bf16*)(F.ws + WS_WSG);
      for (int i = (F.bid * NT + F.tid) * 2; i < 4 * 128 * 128; i += F.G * NT * 2) *(unsigned*)(d + i) = pk2(s[i], s[i + 1]); }
}

struct EpiProj { static constexpr bool PERM = true, AFTER_DRAIN = false; bf16* O;
    __device__ __forceinline__ void operator()(const pg8::f32x4 (&acc)[2][2][4][2], const pg8::Unit& u, int wr, int wc, int fr, int fq) const {
        const int row0 = u.pm * 256 + wr * 64 + fr, col0 = u.pn * 256 + wc * 32 + 8 * fq; const bool act = (u.pn >= 2 && u.pn < 6);
#pragma unroll
        for (int ai = 0; ai < 2; ++ai)
#pragma unroll
            for (int m = 0; m < 4; ++m) { bf16* rowp = O + (size_t)(row0 + ai * 128 + m * 16) * INW + col0;
#pragma unroll
                for (int bj = 0; bj < 2; ++bj) { pg8::f32x4 v0 = acc[ai][bj][m][0], v1 = acc[ai][bj][m][1];
                    if (act) {
#pragma unroll
                        for (int j = 0; j < 4; ++j) { v0[j] = geluf_(v0[j]); v1[j] = geluf_(v1[j]); } }
                    v4u w; w.x = cvtpk(v0[0], v0[1]); w.y = cvtpk(v0[2], v0[3]); w.z = cvtpk(v1[0], v1[1]); w.w = cvtpk(v1[2], v1[3]); *(v4u*)(rowp + bj * 128) = w; } }
    } };
struct EpiGlu { static constexpr bool PERM = true, AFTER_DRAIN = false; const bf16* YG; bf16* YA;
    __device__ __forceinline__ void operator()(const pg8::f32x4 (&acc)[2][2][4][2], const pg8::Unit& u, int wr, int wc, int fr, int fq) const {
        const int row0 = u.pm * 256 + wr * 64 + fr, col0 = u.pn * 256 + wc * 32 + 8 * fq;
#pragma unroll
        for (int ai = 0; ai < 2; ++ai)
#pragma unroll
            for (int m = 0; m < 4; ++m) { const size_t off = (size_t)(row0 + ai * 128 + m * 16) * MIXW + col0;
#pragma unroll
                for (int bj = 0; bj < 2; ++bj) { const pg8::f32x4 v0 = acc[ai][bj][m][0], v1 = acc[ai][bj][m][1]; const v4u g = *(const v4u*)(YG + off + bj * 128);
                    v4u w; w.x = cvtpk(bflo(g.x) * sigmoidf_(v0[0]), bfhi(g.x) * sigmoidf_(v0[1])); w.y = cvtpk(bflo(g.y) * sigmoidf_(v0[2]), bfhi(g.y) * sigmoidf_(v0[3]));
                    w.z = cvtpk(bflo(g.z) * sigmoidf_(v1[0]), bfhi(g.z) * sigmoidf_(v1[1])); w.w = cvtpk(bflo(g.w) * sigmoidf_(v1[2]), bfhi(g.w) * sigmoidf_(v1[3])); *(v4u*)(YA + off + bj * 128) = w; } }
    } };
struct EpiBr { static constexpr bool PERM = true, AFTER_DRAIN = false; bf16* BR;
    __device__ __forceinline__ void operator()(const pg8::f32x4 (&acc)[2][2][4][2], const pg8::Unit& u, int wr, int wc, int fr, int fq) const {
        const int pm = u.pm % (MT / 256); const int row0 = pm * 256 + wr * 64 + fr, col0 = u.pn * 256 + wc * 32 + 8 * fq;
#pragma unroll
        for (int ai = 0; ai < 2; ++ai)
#pragma unroll
            for (int m = 0; m < 4; ++m) { bf16* rowp = BR + (size_t)(row0 + ai * 128 + m * 16) * INW + col0;
#pragma unroll
                for (int bj = 0; bj < 2; ++bj) { const pg8::f32x4 v0 = acc[ai][bj][m][0], v1 = acc[ai][bj][m][1];
                    v4u w; w.x = cvtpk(v0[0], v0[1]); w.y = cvtpk(v0[2], v0[3]); w.z = cvtpk(v1[0], v1[1]); w.w = cvtpk(v1[2], v1[3]); *(v4u*)(rowp + bj * 128) = w; } }
    } };
struct SchedBr { int G, c, nM;
    __device__ __forceinline__ bool next(int i, pg8::Unit& u) const { const int Lq = i * G + c; if (Lq >= 3 * nM * 4) return false; const int k = Lq / (nM * 4), r = Lq % (nM * 4);
        u.pm = k * (MT / 256) + r / 4; u.pn = k * 4 + r % 4; return true; }
    __device__ __forceinline__ void a_ready(const pg8::Unit&) const {}
    __device__ __forceinline__ void done(const pg8::Unit&) const {} };
struct EpiMerge { static constexpr bool PERM = true, AFTER_DRAIN = false; const bf16* BR; bf16* PM; const float* bm;
    __device__ __forceinline__ void operator()(const pg8::f32x4 (&acc)[2][2][4][2], const pg8::Unit& u, int wr, int wc, int fr, int fq) const {
        const int k = u.pn >> 2, dt = u.pn & 3; const int row0 = u.pm * 256 + wr * 64 + fr, col0 = dt * 256 + wc * 32 + 8 * fq;
#pragma unroll
        for (int bj = 0; bj < 2; ++bj) { const pg8::f32x4 b0 = *(const pg8::f32x4*)(bm + k * 1024 + col0 + bj * 128), b1 = *(const pg8::f32x4*)(bm + k * 1024 + col0 + bj * 128 + 4);
#pragma unroll
            for (int ai = 0; ai < 2; ++ai)
#pragma unroll
                for (int m = 0; m < 4; ++m) { const size_t r = (size_t)(row0 + ai * 128 + m * 16); const v4u br = *(const v4u*)(BR + r * INW + k * 1024 + col0 + bj * 128);
                    const pg8::f32x4 v0 = acc[ai][bj][m][0] + b0, v1 = acc[ai][bj][m][1] + b1;
                    float p[8] = {sigmoidf_(v0[0]) * bflo(br.x), sigmoidf_(v0[1]) * bfhi(br.x), sigmoidf_(v0[2]) * bflo(br.y), sigmoidf_(v0[3]) * bfhi(br.y),
                                  sigmoidf_(v1[0]) * bflo(br.z), sigmoidf_(v1[1]) * bfhi(br.z), sigmoidf_(v1[2]) * bflo(br.w), sigmoidf_(v1[3]) * bfhi(br.w)};
                    bf16* dst = PM + r * D + col0 + bj * 128;
                    if (k > 0) { const v4u o = *(const v4u*)dst; p[0] += bflo(o.x); p[1] += bfhi(o.x); p[2] += bflo(o.y); p[3] += bfhi(o.y); p[4] += bflo(o.z); p[5] += bfhi(o.z); p[6] += bflo(o.w); p[7] += bfhi(o.w); }
                    v4u w; w.x = cvtpk(p[0], p[1]); w.y = cvtpk(p[2], p[3]); w.z = cvtpk(p[4], p[5]); w.w = cvtpk(p[6], p[7]); *(v4u*)dst = w; } }
    } };
struct SchedMerge { int G, c, nM;
    __device__ __forceinline__ bool next(int i, pg8::Unit& u) const { const int v = (i / 3) * G + c, k = i % 3; if (v >= nM * 4) return false; u.pm = v >> 2; u.pn = k * 4 + (v & 3); return true; }
    __device__ __forceinline__ void a_ready(const pg8::Unit&) const {}
    __device__ __forceinline__ void done(const pg8::Unit&) const {} };
struct EpiWo { static constexpr bool PERM = false, AFTER_DRAIN = false; const float* xs_lat; const float* xs_ctx; float* out; float* xc; const float* mod_l;
    __device__ __forceinline__ void operator()(const pg8::f32x4 (&acc)[2][2][4][2], const pg8::Unit& u, int wr, int wc, int fr, int fq) const {
        const int row0 = u.pm * 256 + wr * 64 + fr, col0 = u.pn * 256 + wc * 32 + 4 * fq; const bool isctx = u.pm >= SEQ / 256;
        const float* ga = mod_l + (isctx ? 6144 : 0) + 2048;
#pragma unroll
        for (int ai = 0; ai < 2; ++ai)
#pragma unroll
            for (int m = 0; m < 4; ++m) { const int row = row0 + ai * 128 + m * 16; const size_t off = (size_t)(isctx ? row - SEQ : row) * D + col0;
                const float* src = (isctx ? xs_ctx : xs_lat) + off; float* dst = (isctx ? xc : out) + off;
#pragma unroll
                for (int bj = 0; bj < 2; ++bj)
#pragma unroll
                    for (int n = 0; n < 2; ++n) { const pg8::f32x4 g = *(const pg8::f32x4*)(ga + col0 + bj * 128 + n * 16); const pg8::f32x4 x = *(const pg8::f32x4*)(src + bj * 128 + n * 16);
                        *(pg8::f32x4*)(dst + bj * 128 + n * 16) = x + g * acc[ai][bj][m][n]; } }
    } };
constexpr int MOETAB_OFF = 131072 + 2048;
template <int NPN> __device__ __forceinline__ int moe_build_table(Frame& F, const unsigned* cnt) {
    LAS unsigned* tabw = (LAS unsigned*)(F.lds + MOETAB_OFF);
    int total = 0, rowtile0 = 0;
    for (int e = 0; e < NE; ++e) { const int nt_e = ((int)cnt[e] + 255) >> 8;
        for (int q = F.tid; q < nt_e * NPN; q += NT) tabw[total + q] = ((unsigned)(rowtile0 + q / NPN) << 16) | (unsigned)(e * NPN + q % NPN);
        total += nt_e * NPN; rowtile0 += nt_e; }
    __syncthreads();
    return total;
}
struct SchedMoe { int G, c, total; const LAS unsigned* tabw;
    __device__ __forceinline__ bool next(int i, pg8::Unit& u) const { const int Lq = i * G + c; if (Lq >= total) return false; const unsigned w = (unsigned)__builtin_amdgcn_readfirstlane((int)tabw[Lq]); u.pm = (int)(w >> 16); u.pn = (int)(w & 0xffffu); return true; }
    __device__ __forceinline__ void a_ready(const pg8::Unit&) const {}
    __device__ __forceinline__ void done(const pg8::Unit&) const {} };
struct EpiUp { static constexpr bool PERM = true, AFTER_DRAIN = false; bf16* ACT; const float* SW;
    __device__ __forceinline__ void operator()(const pg8::f32x4 (&acc)[2][2][4][2], const pg8::Unit& u, int wr, int wc, int fr, int fq) const {
        const int row0 = u.pm * 256 + wr * 64 + fr, f0 = (u.pn & 1) * 128 + wc * 32 + 8 * fq;
#pragma unroll
        for (int ai = 0; ai < 2; ++ai)
#pragma unroll
            for (int m = 0; m < 4; ++m) { const int slot = row0 + ai * 128 + m * 16; const float w = SW[slot];
                const pg8::f32x4 a0 = acc[ai][0][m][0], a1 = acc[ai][0][m][1], b0 = acc[ai][1][m][0], b1 = acc[ai][1][m][1];
                v4u o; o.x = cvtpk(siluf_(a0[0]) * b0[0] * w, siluf_(a0[1]) * b0[1] * w); o.y = cvtpk(siluf_(a0[2]) * b0[2] * w, siluf_(a0[3]) * b0[3] * w);
                o.z = cvtpk(siluf_(a1[0]) * b1[0] * w, siluf_(a1[1]) * b1[1] * w); o.w = cvtpk(siluf_(a1[2]) * b1[2] * w, siluf_(a1[3]) * b1[3] * w);
                *(v4u*)(ACT + (size_t)slot * DFF + f0) = o; }
    } };
struct EpiDown { static constexpr bool PERM = true, AFTER_DRAIN = false; bf16* YS2;
    __device__ __forceinline__ void operator()(const pg8::f32x4 (&acc)[2][2][4][2], const pg8::Unit& u, int wr, int wc, int fr, int fq) const {
        const int row0 = u.pm * 256 + wr * 64 + fr, col0 = (u.pn & 3) * 256 + wc * 32 + 8 * fq;
#pragma unroll
        for (int ai = 0; ai < 2; ++ai)
#pragma unroll
            for (int m = 0; m < 4; ++m) { bf16* rowp = YS2 + (size_t)(row0 + ai * 128 + m * 16) * D + col0;
#pragma unroll
                for (int bj = 0; bj < 2; ++bj) { const pg8::f32x4 v0 = acc[ai][bj][m][0], v1 = acc[ai][bj][m][1];
                    v4u w; w.x = cvtpk(v0[0], v0[1]); w.y = cvtpk(v0[2], v0[3]); w.z = cvtpk(v1[0], v1[1]); w.w = cvtpk(v1[2], v1[3]); *(v4u*)(rowp + bj * 128) = w; } }
    } };

__device__ __forceinline__ void ph2_fast(Frame& F, int l) {
    pg8::Gemm g{(const bf16*)(F.ws + WS_H), (const bf16*)(F.ws + WS_WIN), MT, INW, D}; pg8::StaticOrder S; S.init(MT, INW, F.G, F.bid);
    EpiProj E{(bf16*)(F.ws + WS_PROJ)}; pg8::gemm_phase<EpiProj, pg8::StaticOrder, PG_ALIGN, PG_SP2>(F.lds, g, S, E, F.tid);
}
__device__ __forceinline__ void ph6_fast(Frame& F, int l) {
    pg8::Gemm g{(const bf16*)(F.ws + WS_YG), (const bf16*)(F.ws + WS_WGLU), MT, MIXW, MIXW}; pg8::StaticOrder S; S.init(l == 0 ? MT : SEQ, MIXW, F.G, F.bid);
    EpiGlu E{(const bf16*)(F.ws + WS_YG), (bf16*)(F.ws + WS_YS)}; pg8::gemm_phase<EpiGlu, pg8::StaticOrder, PG_ALIGN, PG_SP2>(F.lds, g, S, E, F.tid);
}
__device__ __forceinline__ void ph7_fast(Frame& F, int l) {
    pg8::Gemm g{(const bf16*)(F.ws + WS_YS), (const bf16*)(F.ws + WS_WBR), 3 * MT, 3 * D, MIXW}; SchedBr S{F.G, F.bid, l == 0 ? MT / 256 : SEQ / 256};
    EpiBr E{(bf16*)(F.ws + WS_PROJ)}; pg8::gemm_phase<EpiBr, SchedBr, PG_ALIGN, PG_SP2>(F.lds, g, S, E, F.tid);
}
__device__ __forceinline__ void ph8_fast(Frame& F, int l) {
    pg8::Gemm g{(const bf16*)(F.ws + WS_H), (const bf16*)(F.ws + WS_WMG), MT, INW, D}; SchedMerge S{F.G, F.bid, l == 0 ? MT / 256 : SEQ / 256};
    EpiMerge E{(const bf16*)(F.ws + WS_PROJ), (bf16*)(F.ws + WS_PM), IN_(I_BMG) + l * INW}; pg8::gemm_phase<EpiMerge, SchedMerge, PG_ALIGN, PG_SP2>(F.lds, g, S, E, F.tid);
}
__device__ __forceinline__ void ph9_fast(Frame& F, int l) {
    pg8::Gemm g{(const bf16*)(F.ws + WS_PM), (const bf16*)(F.ws + WS_WO), MT, D, D}; pg8::StaticOrder S; S.init(l == 0 ? MT : SEQ, D, F.G, F.bid);
    EpiWo E{l == 0 ? IN_(I_X) : F.out, l == 0 ? IN_(I_CTX) : (const float*)(F.ws + WS_XC), F.out, (float*)(F.ws + WS_XC), (const float*)(F.ws + WS_MOD) + (size_t)l * 2 * 6144};
    pg8::gemm_phase<EpiWo, pg8::StaticOrder, PG_ALIGN, PG_SP2>(F.lds, g, S, E, F.tid);
}
__device__ __forceinline__ void ph12_fast(Frame& F, int l) {
    pg8::Gemm g{(const bf16*)(F.ws + WS_HS), (const bf16*)(F.ws + WS_W13), MAXSLOT, NE * 512, D}; const int total = moe_build_table<2>(F, F.ctl + CW_CNT + l * 128); SchedMoe S{F.G, F.bid, total, (const LAS unsigned*)(F.lds + MOETAB_OFF)};
    EpiUp E{(bf16*)(F.ws + WS_ACT), (const float*)(F.ws + WS_SW)}; pg8::gemm_phase<EpiUp, SchedMoe, PG_ALIGN, PG_SP2>(F.lds, g, S, E, F.tid);
}
__device__ __forceinline__ void ph13_fast(Frame& F, int l) {
    pg8::Gemm g{(const bf16*)(F.ws + WS_ACT), (const bf16*)(F.ws + WS_W2), MAXSLOT, NE * D, DFF}; const int total = moe_build_table<4>(F, F.ctl + CW_CNT + l * 128); SchedMoe S{F.G, F.bid, total, (const LAS unsigned*)(F.lds + MOETAB_OFF)};
    EpiDown E{(bf16*)(F.ws + WS_YS2)}; pg8::gemm_phase<EpiDown, SchedMoe, PG_ALIGN, PG_SP2>(F.lds, g, S, E, F.tid);
}


typedef short bf16x8 __attribute__((ext_vector_type(8)));
constexpr int NSB = MT / 16;
__device__ __forceinline__ void s5_precompute(Frame& F) {
    LAS float* APr = (LAS float*)F.lds; LAS float* APi = APr + 2176; LAS float* BBr = APi + 2176; LAS float* BBi = BBr + 2048; LAS float* CCr = BBi + 2048; LAS float* CCi = CCr + 2048; LAS float* KK = CCi + 2048;
    for (int item = F.bid; item < 2 * G5; item += F.G) { const int l = item >> 5, g = item & 31;
        __syncthreads();
        if (F.tid < 128) { const int d = F.tid >> 6, p = F.tid & 63; const int ldg = (l * 2 + d) * G5 + g;
            const double lr = IN_(I_LRE)[ldg * P5 + p], li = IN_(I_LIM)[ldg * P5 + p], dt = exp((double)IN_(I_LDT)[ldg]);
            for (int e = 0; e <= 16; ++e) { const double m = exp(lr * dt * e), ang = li * dt * e; APr[(d * 64 + p) * 17 + e] = (float)(m * cos(ang)); APi[(d * 64 + p) * 17 + e] = (float)(m * sin(ang)); }
            { const double m16 = exp(lr * dt * 16.0), a16 = li * dt * 16.0; float* A16 = (float*)(F.ws + WS_A16) + ((size_t)((l * 32 + g) * 2 + d) * 64 + p) * 2; A16[0] = (float)(m16 * cos(a16)); A16[1] = (float)(m16 * sin(a16)); }
            const double m1 = exp(lr * dt), ar = m1 * cos(li * dt), ai = m1 * sin(li * dt); const double nr = ar - 1.0, ni = ai, den = lr * lr + li * li;
            const double qr = (nr * lr + ni * li) / den, qi = (ni * lr - nr * li) / den;
            for (int h = 0; h < 16; ++h) { const double x = IN_(I_BRE)[((size_t)ldg * P5 + p) * H5 + h], y = IN_(I_BIM)[((size_t)ldg * P5 + p) * H5 + h];
                BBr[(d * 64 + p) * 16 + h] = (float)(qr * x - qi * y); BBi[(d * 64 + p) * 16 + h] = (float)(qr * y + qi * x);
                CCr[(d * 16 + h) * 64 + p] = IN_(I_CRE)[((size_t)ldg * H5 + h) * P5 + p]; CCi[(d * 16 + h) * 64 + p] = IN_(I_CIM)[((size_t)ldg * H5 + h) * P5 + p]; } }
        __syncthreads();
        for (int idx = F.tid; idx < 8192; idx += NT) { const int d = idx >> 12, e = (idx >> 8) & 15, h = (idx >> 4) & 15, hp = idx & 15; float a = 0.f;
            for (int p = 0; p < 64; ++p) { const float pr = APr[(d * 64 + p) * 17 + e], pi = APi[(d * 64 + p) * 17 + e], br = BBr[(d * 64 + p) * 16 + hp], bi = BBi[(d * 64 + p) * 16 + hp];
                const float wr = pr * br - pi * bi, wi = pr * bi + pi * br; a += CCr[(d * 16 + h) * 64 + p] * wr - CCi[(d * 16 + h) * 64 + p] * wi; }
            KK[idx] = a; }
        __syncthreads();
        bf16* M = (bf16*)(F.ws + WS_S5M) + (size_t)(l * 32 + g) * 3 * 65536;
        for (int idx = F.tid; idx < 32768; idx += NT) {
            const int r = idx >> 7, k0 = (idx & 127) * 2; float v[3][2];
#pragma unroll
            for (int q = 0; q < 2; ++q) { const int kk = k0 + q;
                { const int d = r >> 7, p = (r >> 1) & 63, c = r & 1, sg = kk >> 4, hp = kk & 15, e = d == 0 ? 15 - sg : sg;
                  const float pr = APr[(d * 64 + p) * 17 + e], pi = APi[(d * 64 + p) * 17 + e], br = BBr[(d * 64 + p) * 16 + hp], bi = BBi[(d * 64 + p) * 16 + hp];
                  v[0][q] = c == 0 ? pr * br - pi * bi : pr * bi + pi * br; }
                { const int tau = r >> 4, h = r & 15, sg = kk >> 4, hp = kk & 15; float t = 0.f;
                  if (sg <= tau) t += KK[(0 * 16 + (tau - sg)) * 256 + h * 16 + hp]; if (sg >= tau) t += KK[(1 * 16 + (sg - tau)) * 256 + h * 16 + hp]; v[1][q] = t; }
                { const int tau = r >> 4, h = r & 15, d = kk >> 7, p = (kk >> 1) & 63, c = kk & 1, e = d == 0 ? tau + 1 : 16 - tau;
                  const float cr = CCr[(d * 16 + h) * 64 + p], ci = CCi[(d * 16 + h) * 64 + p], pr = APr[(d * 64 + p) * 17 + e], pi = APi[(d * 64 + p) * 17 + e];
                  v[2][q] = c == 0 ? cr * pr - ci * pi : -(cr * pi + ci * pr); } }
#pragma unroll
            for (int m = 0; m < 3; ++m) *(unsigned*)(M + (size_t)m * 65536 + r * 256 + k0) = pk2(v[m][0], v[m][1]);
        }
    }
}
__device__ __forceinline__ void s5_z_phase(Frame& F, int l) {
    const bf16* PROJ = (const bf16*)(F.ws + WS_PROJ); float* Z = (float*)(F.ws + WS_Z);
    const int l15 = F.lane & 15, lq = F.lane >> 4;
    for (int item = F.bid; item < 256; item += F.G) {
        const int g = item >> 3, part = item & 7; const bf16* Fm = (const bf16*)(F.ws + WS_S5M) + (size_t)(l * 32 + g) * 3 * 65536;
        bf16x8 Af[2][8];
#pragma unroll
        for (int j = 0; j < 2; ++j)
#pragma unroll
            for (int ks = 0; ks < 8; ++ks) Af[j][ks] = *(const bf16x8*)(Fm + (size_t)(16 * (2 * F.wave + j) + l15) * 256 + 32 * ks + 8 * lq);
#pragma unroll 1
        for (int tl = part; tl < MT / 256; tl += 8) {
            bf16x8 V[8];
#pragma unroll
            for (int ks = 0; ks < 8; ++ks) V[ks] = *(const bf16x8*)(PROJ + (size_t)(tl * 256 + 16 * l15 + 2 * ks + (lq >> 1)) * INW + 16 * g + 8 * (lq & 1));
            f32x4 acc[2] = {{0.f, 0.f, 0.f, 0.f}, {0.f, 0.f, 0.f, 0.f}};
#pragma unroll
            for (int ks = 0; ks < 8; ++ks)
#pragma unroll
                for (int j = 0; j < 2; ++j) acc[j] = __builtin_amdgcn_mfma_f32_16x16x32_bf16(Af[j][ks], V[ks], acc[j], 0, 0, 0);
#pragma unroll
            for (int j = 0; j < 2; ++j) *(f32x4*)(Z + ((size_t)(tl * 16 + l15) * 32 + g) * 256 + 16 * (2 * F.wave + j) + 4 * lq) = acc[j];
        }
    }
}
__device__ __forceinline__ int s5_chain_sb(int d, int i) { return d == 0 ? (i < 16 ? 1024 + i : i - 16) : (i < 16 ? 1039 - i : 1023 - (i - 16)); }
__device__ __forceinline__ void s5_scan_phase(Frame& F, int l) {
    LAS float* EX = (LAS float*)F.lds;
    for (int item = F.bid; item < 256; item += F.G) {
        const int cid = item * 16 + (F.tid & 15), j = F.tid >> 4;
        const int g = cid >> 7, d = (cid >> 6) & 1, p = cid & 63;
        const float* A16 = (const float*)(F.ws + WS_A16) + ((size_t)((l * 32 + g) * 2 + d) * 64 + p) * 2; const float ar = A16[0], ai = A16[1];
        const float* Z = (const float*)(F.ws + WS_Z) + (size_t)g * 256 + d * 128 + 2 * p; bf16* SS = (bf16*)(F.ws + WS_SS) + (size_t)g * 256 + d * 128 + 2 * p;
        float2 z[33];
#pragma unroll
        for (int q = 0; q < 33; ++q) { const int i = 33 * j + q; z[q] = i < NSB ? *(const float2*)(Z + (size_t)s5_chain_sb(d, i) * 8192) : make_float2(0.f, 0.f); }
        float hr = 0.f, hi = 0.f, pr = 1.f, pi = 0.f;
#pragma unroll
        for (int q = 0; q < 33; ++q) { if (33 * j + q < NSB) { const float nr = ar * hr - ai * hi + z[q].x, ni = ar * hi + ai * hr + z[q].y; hr = nr; hi = ni; const float qr = pr * ar - pi * ai, qi = pr * ai + pi * ar; pr = qr; pi = qi; } }
        __syncthreads();
        EX[(j * 16 + (F.tid & 15)) * 4 + 0] = hr; EX[(j * 16 + (F.tid & 15)) * 4 + 1] = hi; EX[(j * 16 + (F.tid & 15)) * 4 + 2] = pr; EX[(j * 16 + (F.tid & 15)) * 4 + 3] = pi;
        __syncthreads();
        float cr = 0.f, ci = 0.f;
        for (int i = 0; i < j; ++i) { const float er = EX[(i * 16 + (F.tid & 15)) * 4 + 0], ei = EX[(i * 16 + (F.tid & 15)) * 4 + 1], qr = EX[(i * 16 + (F.tid & 15)) * 4 + 2], qi = EX[(i * 16 + (F.tid & 15)) * 4 + 3];
            const float nr = qr * cr - qi * ci + er, ni = qr * ci + qi * cr + ei; cr = nr; ci = ni; }
        hr = cr; hi = ci;
#pragma unroll
        for (int q = 0; q < 33; ++q) { const int i = 33 * j + q; if (i < NSB) { *(unsigned*)(SS + (size_t)s5_chain_sb(d, i) * 8192) = pk2(hr, hi);
            const float nr = ar * hr - ai * hi + z[q].x, ni = ar * hi + ai * hr + z[q].y; hr = nr; hi = ni; } }
    }
}
__device__ __forceinline__ void s5_y_phase(Frame& F, int l) {
    const bf16* PROJ = (const bf16*)(F.ws + WS_PROJ); const bf16* SS = (const bf16*)(F.ws + WS_SS); bf16* YG = (bf16*)(F.ws + WS_YG); const float* ds = IN_(I_DSKIP) + l * MIXW;
    const int l15 = F.lane & 15, lq = F.lane >> 4;
    for (int item = F.bid; item < 256; item += F.G) {
        const int g = item >> 3, part = item & 7; const bf16* Tm = (const bf16*)(F.ws + WS_S5M) + ((size_t)(l * 32 + g) * 3 + 1) * 65536; const bf16* Em = Tm + 65536;
        bf16x8 At[2][8], Ae[2][8];
#pragma unroll
        for (int j = 0; j < 2; ++j)
#pragma unroll
            for (int ks = 0; ks < 8; ++ks) { const size_t o = (size_t)(16 * (2 * F.wave + j) + l15) * 256 + 32 * ks + 8 * lq; At[j][ks] = *(const bf16x8*)(Tm + o); Ae[j][ks] = *(const bf16x8*)(Em + o); }
        const f32x4 dsk = *(const f32x4*)(ds + 16 * g + 4 * lq);
        const int ntl = l == 0 ? MT / 256 : SEQ / 256;
#pragma unroll 1
        for (int tl = part; tl < ntl; tl += 8) {
            bf16x8 V[8], S[8];
#pragma unroll
            for (int ks = 0; ks < 8; ++ks) { V[ks] = *(const bf16x8*)(PROJ + (size_t)(tl * 256 + 16 * l15 + 2 * ks + (lq >> 1)) * INW + 16 * g + 8 * (lq & 1));
                S[ks] = *(const bf16x8*)(SS + ((size_t)(tl * 16 + l15) * 32 + g) * 256 + 32 * ks + 8 * lq); }
            f32x4 acc[2] = {{0.f, 0.f, 0.f, 0.f}, {0.f, 0.f, 0.f, 0.f}};
#pragma unroll
            for (int ks = 0; ks < 8; ++ks)
#pragma unroll
                for (int j = 0; j < 2; ++j) { acc[j] = __builtin_amdgcn_mfma_f32_16x16x32_bf16(At[j][ks], V[ks], acc[j], 0, 0, 0); acc[j] = __builtin_amdgcn_mfma_f32_16x16x32_bf16(Ae[j][ks], S[ks], acc[j], 0, 0, 0); }
#pragma unroll
            for (int j = 0; j < 2; ++j) { const size_t row = (size_t)tl * 256 + 16 * l15 + (2 * F.wave + j); const int ch = 16 * g + 4 * lq;
                const v2u u = *(const v2u*)(PROJ + row * INW + ch);
                const float y0 = acc[j][0] + dsk[0] * bflo(u.x), y1 = acc[j][1] + dsk[1] * bfhi(u.x), y2 = acc[j][2] + dsk[2] * bflo(u.y), y3 = acc[j][3] + dsk[3] * bfhi(u.y);
                v2u w; w.x = cvtpk(geluf_(y0), geluf_(y1)); w.y = cvtpk(geluf_(y2), geluf_(y3)); *(v2u*)(YG + row * MIXW + ch) = w; }
        }
    }
}


constexpr int SG_STRIDE = 272, SG_IMG = 256 * SG_STRIDE, SG_STAT = SG_IMG;
__device__ __forceinline__ void sg_fast_chunk(Frame& F, int l, int chunk) {
    const bf16* PROJ = (const bf16*)(F.ws + WS_PROJ); bf16* YB = (bf16*)(F.ws + WS_YS) + (size_t)MT * MIXW; const bf16* WSG = (const bf16*)(F.ws + WS_WSG);
    const float* lg = IN_(I_SGG) + l * MIXW; const float* lb = IN_(I_SGB) + l * MIXW; const float* bsg = IN_(I_BSG) + l * 512;
    LAS float* st = (LAS float*)(F.lds + SG_STAT);
    __syncthreads();
    {
        const int p = F.tid >> 2, part = F.tid & 3; const bf16* vr = PROJ + (size_t)(chunk * 128 + p) * INW + 1024 + part * 128; float s = 0.f, q = 0.f;
#pragma unroll 4
        for (int c = 0; c < 128; c += 8) { const v4u w = *(const v4u*)(vr + c); const float x[8] = {bflo(w.x), bfhi(w.x), bflo(w.y), bfhi(w.y), bflo(w.z), bfhi(w.z), bflo(w.w), bfhi(w.w)};
#pragma unroll
            for (int i = 0; i < 8; ++i) { s += x[i]; q += x[i] * x[i]; } }
        s += __shfl_xor(s, 1); q += __shfl_xor(q, 1); s += __shfl_xor(s, 2); q += __shfl_xor(q, 2);
        const float mu = s * (1.f / 512.f), var = fmaxf(q * (1.f / 512.f) - mu * mu, 0.f);
        if (part == 0) { st[p * 2] = mu; st[p * 2 + 1] = rsqrtf(var + EPS); }
    }
    const int l15 = F.lane & 15, lq = F.lane >> 4;
#pragma unroll 1
    for (int pass = 0; pass < 2; ++pass) {
        __syncthreads();
#pragma unroll 1
        for (int it = F.tid; it < 2048; it += NT) { const int tp = it & 63, cg = it >> 6; const int p0 = tp * 2, ch = pass * 256 + cg * 8;
            const v4u w0 = *(const v4u*)(PROJ + (size_t)(chunk * 128 + p0) * INW + 1024 + ch), w1 = *(const v4u*)(PROJ + (size_t)(chunk * 128 + p0 + 1) * INW + 1024 + ch);
            const float mu0 = st[p0 * 2], rs0 = st[p0 * 2 + 1], mu1 = st[p0 * 2 + 2], rs1 = st[p0 * 2 + 3];
            const float x0[8] = {bflo(w0.x), bfhi(w0.x), bflo(w0.y), bfhi(w0.y), bflo(w0.z), bfhi(w0.z), bflo(w0.w), bfhi(w0.w)};
            const float x1[8] = {bflo(w1.x), bfhi(w1.x), bflo(w1.y), bfhi(w1.y), bflo(w1.z), bfhi(w1.z), bflo(w1.w), bfhi(w1.w)};
#pragma unroll
            for (int i = 0; i < 8; ++i) { const float gm = lg[ch + i], bt = lb[ch + i];
                *(LAS unsigned*)(F.lds + (cg * 8 + i) * SG_STRIDE + p0 * 2) = pk2((x0[i] - mu0) * rs0 * gm + bt, (x1[i] - mu1) * rs1 * gm + bt); } }
        __syncthreads();
        const int ggl = F.wave >> 2, gg = pass * 2 + ggl, rb0 = (F.wave & 3) * 2;
        bf16x8 A[2][4];
#pragma unroll
        for (int j = 0; j < 2; ++j)
#pragma unroll
            for (int ks = 0; ks < 4; ++ks) A[j][ks] = *(const LAS bf16x8*)(F.lds + (ggl * 128 + (rb0 + j) * 16 + l15) * SG_STRIDE + (32 * ks + 8 * lq) * 2);
        f32x4 acc[2][8];
#pragma unroll
        for (int j = 0; j < 2; ++j)
#pragma unroll
            for (int cb = 0; cb < 8; ++cb) acc[j][cb] = (f32x4){0.f, 0.f, 0.f, 0.f};
#pragma unroll
        for (int cb = 0; cb < 8; ++cb) {
            bf16x8 B[4];
#pragma unroll
            for (int ks = 0; ks < 4; ++ks) B[ks] = *(const bf16x8*)(WSG + ((size_t)gg * 128 + cb * 16 + l15) * 128 + 32 * ks + 8 * lq);
#pragma unroll
            for (int ks = 0; ks < 4; ++ks)
#pragma unroll
                for (int j = 0; j < 2; ++j) acc[j][cb] = __builtin_amdgcn_mfma_f32_16x16x32_bf16(A[j][ks], B[ks], acc[j][cb], 0, 0, 0);
        }
#pragma unroll
        for (int cb = 0; cb < 8; ++cb) { const int q = cb * 16 + l15; const size_t row = (size_t)chunk * 128 + q; const float bq = bsg[gg * 128 + q];
#pragma unroll
            for (int j = 0; j < 2; ++j) { const int col = gg * 128 + (rb0 + j) * 16 + 4 * lq; const v2u gu = *(const v2u*)(PROJ + row * INW + 512 + col);
                v2u w; w.x = cvtpk(bflo(gu.x) * (acc[j][cb][0] + bq), bfhi(gu.x) * (acc[j][cb][1] + bq)); w.y = cvtpk(bflo(gu.y) * (acc[j][cb][2] + bq), bfhi(gu.y) * (acc[j][cb][3] + bq));
                *(v2u*)(YB + row * MIXW + col) = w; } }
    }
}

struct NSmem { float As[16][68]; float Bs[16][68]; };
template <class AF>
__device__ __forceinline__ void ngemm_acc(float (&acc)[4][4], const AF& af, const float* B, int ldb, int K, LAS NSmem* s, int t) {
    const int ty = t >> 4, tx = t & 15, lr = t >> 2, lk = (t & 3) * 4, bk = t >> 4, bn = (t & 15) * 4;
    for (int k0 = 0; k0 < K; k0 += 16) {
        const float4 av = af.load4(lr, k0 + lk);
        const float4 bv = *(const float4*)(B + (size_t)(k0 + bk) * ldb + bn);
        __syncthreads();
        s->As[lk + 0][lr] = av.x; s->As[lk + 1][lr] = av.y; s->As[lk + 2][lr] = av.z; s->As[lk + 3][lr] = av.w;
        *(LAS f32x4*)&s->Bs[bk][bn] = (f32x4){bv.x, bv.y, bv.z, bv.w};
        __syncthreads();
#pragma unroll
        for (int k = 0; k < 16; ++k) {
            const f32x4 a = *(const LAS f32x4*)&s->As[k][ty * 4]; const f32x4 b = *(const LAS f32x4*)&s->Bs[k][tx * 4];
            const float aa[4] = {a.x, a.y, a.z, a.w}, bb[4] = {b.x, b.y, b.z, b.w};
#pragma unroll
            for (int i = 0; i < 4; ++i)
#pragma unroll
                for (int j = 0; j < 4; ++j) acc[i][j] += aa[i] * bb[j];
        }
    }
}
struct ABf { const bf16* A; int lda; __device__ __forceinline__ float4 load4(int r, int k) const { const v2u w = *(const v2u*)(A + (size_t)r * lda + k);
    return make_float4(bf2f((unsigned short)(w.x & 0xffff)), bf2f((unsigned short)(w.x >> 16)), bf2f((unsigned short)(w.y & 0xffff)), bf2f((unsigned short)(w.y >> 16))); } };
#define NTILE_BEGIN(ntiles) { const int _half = F.tid >> 8, t = F.tid & 255, ty = t >> 4, tx = t & 15; LAS NSmem* sm = (LAS NSmem*)F.lds + _half; (void)ty; (void)tx; \
    const int _nt = (ntiles), _nit = (_nt + 2 * F.G - 1) / (2 * F.G); \
    for (int _it = 0; _it < _nit; ++_it) { int T = (_it * F.G + F.bid) * 2 + _half; const bool valid = T < _nt; if (!valid) T = _nt - 1;
#define NTILE_END } }

__device__ __forceinline__ void ph0_prologue(Frame& F) {
    float* mod = (float*)(F.ws + WS_MOD);
    LAS float* SV = (LAS float*)(F.lds + 131072 + 4096);
    for (int i = F.tid; i < 2048; i += NT) SV[i] = siluf_(i < 1024 ? IN_(I_C)[i] : IN_(I_CCTX)[i - 1024]);
    __syncthreads();
    LAS float* RED = (LAS float*)(F.lds + 131072 + 4096 + 8192);
    for (int it = F.bid; it < 2 * 96; it += F.G) { const int l = it / 96, j = (it % 96) * 64 + F.lane;
        const float* W = IN_(I_WADA) + (size_t)l * D * 6144 + j + (size_t)(F.wave * 128) * 6144;
        float a0 = 0.f, a1 = 0.f;
#pragma unroll 32
        for (int kk = 0; kk < 128; ++kk) { const float w = W[(size_t)kk * 6144]; a0 += SV[F.wave * 128 + kk] * w; a1 += SV[1024 + F.wave * 128 + kk] * w; }
        __syncthreads();
        RED[(F.wave * 2 + 0) * 64 + F.lane] = a0; RED[(F.wave * 2 + 1) * 64 + F.lane] = a1;
        __syncthreads();
        if (F.wave < 2) { float s = 0.f;
#pragma unroll
            for (int w8 = 0; w8 < 8; ++w8) s += RED[(w8 * 2 + F.wave) * 64 + F.lane];
            mod[(size_t)(l * 2 + F.wave) * 6144 + j] = s + IN_(I_BADA)[l * 6144 + j]; }
    }
}
__device__ __forceinline__ void hprep_rows(Frame& F, int l) {
    bf16* H = (bf16*)(F.ws + WS_H); const float* g = IN_(I_GMIX) + l * D;
    const int gw = F.bid * (NT / 64) + F.wave, ngw = F.G * (NT / 64);
    for (int row = gw; row < MT; row += ngw) {
        const float* m = mod_ptr(F, l, row); const float* xr = xsrc_row(F, l, row);
        f32x4 v[4]; float s = 0.f;
#pragma unroll
        for (int j = 0; j < 4; ++j) { v[j] = *(const f32x4*)(xr + 4 * F.lane + 256 * j); s += v[j].x * v[j].x + v[j].y * v[j].y + v[j].z * v[j].z + v[j].w * v[j].w; }
        const float rstd = rsqrtf(wave_sum(s) * (1.f / D) + EPS);
#pragma unroll
        for (int j = 0; j < 4; ++j) { const int c = 4 * F.lane + 256 * j; const f32x4 gg = *(const f32x4*)(g + c), sc = *(const f32x4*)(m + 1024 + c), sh = *(const f32x4*)(m + c);
            const f32x4 o = v[j] * rstd * gg * (1.f + sc) + sh; v2u w; w.x = pk2(o.x, o.y); w.y = pk2(o.z, o.w); *(v2u*)(H + (size_t)row * D + c) = w; }
    }
}
__device__ __forceinline__ void ph2_naive(Frame& F, int l) {
    const bf16* H = (const bf16*)(F.ws + WS_H); bf16* PROJ = (bf16*)(F.ws + WS_PROJ); const float* W = IN_(I_WIN) + (size_t)l * D * INW;
    NTILE_BEGIN((MT / 64) * (INW / 64))
        const int m0 = (T / (INW / 64)) * 64, n0 = (T % (INW / 64)) * 64;
        float acc[4][4] = {};
        ngemm_acc(acc, ABf{H + (size_t)m0 * D, D}, W + n0, INW, D, sm, t);
        if (valid) {
#pragma unroll
            for (int i = 0; i < 4; ++i) { float o[4];
#pragma unroll
                for (int j = 0; j < 4; ++j) { o[j] = acc[i][j]; if (n0 >= 512 && n0 < 1536) o[j] = geluf_(o[j]); }
                v2u w; w.x = pk2(o[0], o[1]); w.y = pk2(o[2], o[3]); *(v2u*)(PROJ + (size_t)(m0 + ty * 4 + i) * INW + n0 + tx * 4) = w; }
        }
    NTILE_END
}
__device__ __forceinline__ int chain_row(int dir, int pos) { return dir == 0 ? (pos < CTX ? SEQ + pos : pos - CTX) : (pos < CTX ? SEQ + CTX - 1 - pos : SEQ - 1 - (pos - CTX)); }
__device__ __forceinline__ void ph3_s5_naive(Frame& F, int l) {
    LAS float* Cr = (LAS float*)(F.lds + 32768); LAS float* Ci = Cr + 1024; LAS float* Sr = Ci + 1024; LAS float* Si = Sr + 2048;
    const bf16* PROJ = (const bf16*)(F.ws + WS_PROJ); float* YD = (float*)(F.ws + WS_S5);
    for (int item = F.bid; item < 64; item += F.G) {
        if (F.wave == 0) {
            const int g = item >> 1, dir = item & 1, p = F.lane;
            const int ldg = ((l * 2 + dir) * G5 + g);
            const float lr = IN_(I_LRE)[ldg * P5 + p], li = IN_(I_LIM)[ldg * P5 + p], dt = expf(IN_(I_LDT)[ldg]);
            const float er = expf(lr * dt), ar = er * cosf(li * dt), ai = er * sinf(li * dt);
            const float nr = ar - 1.f, ni = ai, den = lr * lr + li * li;
            const float qr = (nr * lr + ni * li) / den, qi = (ni * lr - nr * li) / den;
            float br[16], bi[16];
#pragma unroll
            for (int h = 0; h < 16; ++h) { const float x = IN_(I_BRE)[((size_t)ldg * P5 + p) * H5 + h], y = IN_(I_BIM)[((size_t)ldg * P5 + p) * H5 + h]; br[h] = qr * x - qi * y; bi[h] = qr * y + qi * x; }
            for (int h = 0; h < 16; ++h) { Cr[h * 64 + p] = IN_(I_CRE)[((size_t)ldg * H5 + h) * P5 + p]; Ci[h * 64 + p] = IN_(I_CIM)[((size_t)ldg * H5 + h) * P5 + p]; }
            float sr = 0.f, si = 0.f;
            float* Y = YD + (size_t)dir * MT * MIXW;
#pragma unroll 1
            for (int blk = 0; blk < MT / 32; ++blk) {
#pragma unroll 1
                for (int tt = 0; tt < 32; ++tt) {
                    const int row = chain_row(dir, blk * 32 + tt);
                    const v4u u0 = *(const v4u*)(PROJ + (size_t)row * INW + g * 16), u1 = *(const v4u*)(PROJ + (size_t)row * INW + g * 16 + 8);
                    const unsigned uw[8] = {u0.x, u0.y, u0.z, u0.w, u1.x, u1.y, u1.z, u1.w};
                    float xr = 0.f, xi = 0.f;
#pragma unroll
                    for (int h = 0; h < 8; ++h) { const float ua = bf2f((unsigned short)(uw[h] & 0xffff)), ub = bf2f((unsigned short)(uw[h] >> 16));
                        xr += br[2 * h] * ua + br[2 * h + 1] * ub; xi += bi[2 * h] * ua + bi[2 * h + 1] * ub; }
                    const float nsr = ar * sr - ai * si + xr, nsi = ar * si + ai * sr + xi;
                    sr = nsr; si = nsi; Sr[tt * 64 + p] = sr; Si[tt * 64 + p] = si;
                }
                asm volatile("s_waitcnt lgkmcnt(0)" ::: "memory");
#pragma unroll 1
                for (int o = p; o < 512; o += 64) {
                    const int tt = o >> 4, h = o & 15; float a = 0.f;
#pragma unroll 4
                    for (int q = 0; q < 64; ++q) a += Cr[h * 64 + q] * Sr[tt * 64 + q] - Ci[h * 64 + q] * Si[tt * 64 + q];
                    Y[(size_t)chain_row(dir, blk * 32 + tt) * MIXW + g * 16 + h] = a;
                }
                asm volatile("s_waitcnt lgkmcnt(0)" ::: "memory");
            }
        }
    }
}
__device__ __forceinline__ void ph3_sg_naive(Frame& F, int l) {
    const bf16* PROJ = (const bf16*)(F.ws + WS_PROJ); bf16* YB = (bf16*)(F.ws + WS_YS) + (size_t)MT * MIXW;
    LAS float* stat = (LAS float*)(F.lds + 32768);
    const float* lg = IN_(I_SGG) + l * MIXW; const float* lb = IN_(I_SGB) + l * MIXW;
    NTILE_BEGIN((MT / 128) * 16)
        const int chunk = T >> 4, gg = (T >> 2) & 3, q0 = ((T >> 1) & 1) * 64, c0 = (T & 1) * 64;
        LAS float* st = stat + _half * 256;
        __syncthreads();
        if (t < 128) { const bf16* vr = PROJ + (size_t)(chunk * 128 + t) * INW + 1024; float s = 0.f;
            for (int c = 0; c < 512; c += 2) { const unsigned w = *(const unsigned*)(vr + c); s += bf2f((unsigned short)(w & 0xffff)) + bf2f((unsigned short)(w >> 16)); }
            const float mu = s * (1.f / 512.f); float q = 0.f;
            for (int c = 0; c < 512; c += 2) { const unsigned w = *(const unsigned*)(vr + c); const float a = bf2f((unsigned short)(w & 0xffff)) - mu, b = bf2f((unsigned short)(w >> 16)) - mu; q += a * a + b * b; }
            st[t * 2] = mu; st[t * 2 + 1] = rsqrtf(q * (1.f / 512.f) + EPS); }
        __syncthreads();
        float acc[4][4] = {};
        {
            const float* A = IN_(I_WSG) + ((size_t)(l * 4 + gg) * 128 + q0) * 128;
            const int lr = t >> 2, lk = (t & 3) * 4, bk = t >> 4, bn = (t & 15) * 4;
            for (int k0 = 0; k0 < 128; k0 += 16) {
                const float4 av = *(const float4*)(A + (size_t)lr * 128 + k0 + lk);
                const int p = k0 + bk; const int col = gg * 128 + c0 + bn;
                const v2u w = *(const v2u*)(PROJ + (size_t)(chunk * 128 + p) * INW + 1024 + col);
                const float mu = st[p * 2], rs = st[p * 2 + 1];
                float4 bv; bv.x = (bf2f((unsigned short)(w.x & 0xffff)) - mu) * rs * lg[col] + lb[col]; bv.y = (bf2f((unsigned short)(w.x >> 16)) - mu) * rs * lg[col + 1] + lb[col + 1];
                bv.z = (bf2f((unsigned short)(w.y & 0xffff)) - mu) * rs * lg[col + 2] + lb[col + 2]; bv.w = (bf2f((unsigned short)(w.y >> 16)) - mu) * rs * lg[col + 3] + lb[col + 3];
                __syncthreads();
                sm->As[lk + 0][lr] = av.x; sm->As[lk + 1][lr] = av.y; sm->As[lk + 2][lr] = av.z; sm->As[lk + 3][lr] = av.w;
                *(LAS f32x4*)&sm->Bs[bk][bn] = (f32x4){bv.x, bv.y, bv.z, bv.w};
                __syncthreads();
#pragma unroll
                for (int k = 0; k < 16; ++k) { const f32x4 a = *(const LAS f32x4*)&sm->As[k][ty * 4]; const f32x4 b = *(const LAS f32x4*)&sm->Bs[k][tx * 4];
                    const float aa[4] = {a.x, a.y, a.z, a.w}, bb[4] = {b.x, b.y, b.z, b.w};
#pragma unroll
                    for (int i = 0; i < 4; ++i)
#pragma unroll
                        for (int j = 0; j < 4; ++j) acc[i][j] += aa[i] * bb[j]; }
            }
        }
        if (valid) {
#pragma unroll
            for (int i = 0; i < 4; ++i) { const int q = q0 + ty * 4 + i; const size_t row = (size_t)chunk * 128 + q; const int col = gg * 128 + c0 + tx * 4;
                const float bq = IN_(I_BSG)[l * 512 + gg * 128 + q];
                const v2u gu = *(const v2u*)(PROJ + row * INW + 512 + col);
                v2u w; w.x = pk2(bf2f((unsigned short)(gu.x & 0xffff)) * (acc[i][0] + bq), bf2f((unsigned short)(gu.x >> 16)) * (acc[i][1] + bq));
                w.y = pk2(bf2f((unsigned short)(gu.y & 0xffff)) * (acc[i][2] + bq), bf2f((unsigned short)(gu.y >> 16)) * (acc[i][3] + bq));
                *(v2u*)(YB + row * MIXW + col) = w; }
        }
    NTILE_END
}
__device__ __forceinline__ void ph3_conv(Frame& F, int l, int nrows) {
    const bf16* PROJ = (const bf16*)(F.ws + WS_PROJ); bf16* YC = (bf16*)(F.ws + WS_YS) + (size_t)2 * MT * MIXW; const float* wc = IN_(I_WCONV) + l * 3 * MIXW;
    const size_t gt = (size_t)F.bid * NT + F.tid, ngt = (size_t)F.G * NT;
    for (size_t i = gt; i < (size_t)nrows * (MIXW / 2); i += ngt) {
        const int row = (int)(i / (MIXW / 2)), c = (int)(i % (MIXW / 2)) * 2;
        int pos, rl; if (row < SEQ) { pos = row & 63; rl = 64; } else { pos = row - SEQ; rl = 256; }
        const bf16* r0 = PROJ + (size_t)row * INW + 1536;
        const unsigned b0 = *(const unsigned*)(r0 + c), c0 = *(const unsigned*)(r0 + 512 + c), h0 = *(const unsigned*)(r0 + 1024 + c);
        float zm0 = 0.f, zm1 = 0.f, zp0 = 0.f, zp1 = 0.f;
        if (pos > 0) { const unsigned cc = *(const unsigned*)(r0 - INW + 512 + c), hh = *(const unsigned*)(r0 - INW + 1024 + c); zm0 = bf2f((unsigned short)(cc & 0xffff)) * bf2f((unsigned short)(hh & 0xffff)); zm1 = bf2f((unsigned short)(cc >> 16)) * bf2f((unsigned short)(hh >> 16)); }
        if (pos < rl - 1) { const unsigned cc = *(const unsigned*)(r0 + INW + 512 + c), hh = *(const unsigned*)(r0 + INW + 1024 + c); zp0 = bf2f((unsigned short)(cc & 0xffff)) * bf2f((unsigned short)(hh & 0xffff)); zp1 = bf2f((unsigned short)(cc >> 16)) * bf2f((unsigned short)(hh >> 16)); }
        const float z00 = bf2f((unsigned short)(c0 & 0xffff)) * bf2f((unsigned short)(h0 & 0xffff)), z01 = bf2f((unsigned short)(c0 >> 16)) * bf2f((unsigned short)(h0 >> 16));
        const float y0 = bf2f((unsigned short)(b0 & 0xffff)) * (wc[c] * zm0 + wc[512 + c] * z00 + wc[1024 + c] * zp0);
        const float y1 = bf2f((unsigned short)(b0 >> 16)) * (wc[c + 1] * zm1 + wc[512 + c + 1] * z01 + wc[1024 + c + 1] * zp1);
        *(unsigned*)(YC + (size_t)row * MIXW + c) = pk2(y0, y1);
    }
}
__device__ __forceinline__ void ph5_naive(Frame& F, int l) {
    const bf16* PROJ = (const bf16*)(F.ws + WS_PROJ); const float* YD = (const float*)(F.ws + WS_S5); bf16* YG = (bf16*)(F.ws + WS_YG); const float* ds = IN_(I_DSKIP) + l * MIXW;
    const size_t gt = (size_t)F.bid * NT + F.tid, ngt = (size_t)F.G * NT;
    for (size_t i = gt; i < (size_t)MT * (MIXW / 2); i += ngt) {
        const int row = (int)(i / (MIXW / 2)), c = (int)(i % (MIXW / 2)) * 2;
        const unsigned u = *(const unsigned*)(PROJ + (size_t)row * INW + c); const size_t o = (size_t)row * MIXW + c;
        const float y0 = YD[o] + YD[(size_t)MT * MIXW + o] + ds[c] * bf2f((unsigned short)(u & 0xffff)), y1 = YD[o + 1] + YD[(size_t)MT * MIXW + o + 1] + ds[c + 1] * bf2f((unsigned short)(u >> 16));
        *(unsigned*)(YG + o) = pk2(geluf_(y0), geluf_(y1));
    }
}
__device__ __forceinline__ void ph6_naive(Frame& F, int l) {
    const bf16* YG = (const bf16*)(F.ws + WS_YG); bf16* YA = (bf16*)(F.ws + WS_YS); const float* W = IN_(I_WGLU) + (size_t)l * MIXW * MIXW;
    NTILE_BEGIN((MT / 64) * (MIXW / 64))
        const int m0 = (T / (MIXW / 64)) * 64, n0 = (T % (MIXW / 64)) * 64;
        float acc[4][4] = {};
        ngemm_acc(acc, ABf{YG + (size_t)m0 * MIXW, MIXW}, W + n0, MIXW, MIXW, sm, t);
        if (valid) {
#pragma unroll
            for (int i = 0; i < 4; ++i) { const size_t o = (size_t)(m0 + ty * 4 + i) * MIXW + n0 + tx * 4; const v2u g = *(const v2u*)(YG + o);
                v2u w; w.x = pk2(bf2f((unsigned short)(g.x & 0xffff)) * sigmoidf_(acc[i][0]), bf2f((unsigned short)(g.x >> 16)) * sigmoidf_(acc[i][1]));
                w.y = pk2(bf2f((unsigned short)(g.y & 0xffff)) * sigmoidf_(acc[i][2]), bf2f((unsigned short)(g.y >> 16)) * sigmoidf_(acc[i][3])); *(v2u*)(YA + o) = w; }
        }
    NTILE_END
}
__device__ __forceinline__ void ph7_naive(Frame& F, int l) {
    const bf16* YS = (const bf16*)(F.ws + WS_YS); bf16* BR = (bf16*)(F.ws + WS_PROJ); const float* W = IN_(I_WBR) + (size_t)l * 3 * MIXW * D;
    NTILE_BEGIN((MT / 64) * (INW / 64))
        const int m0 = (T / (INW / 64)) * 64, n0 = (T % (INW / 64)) * 64, k = n0 / 1024, d0 = n0 % 1024;
        float acc[4][4] = {};
        ngemm_acc(acc, ABf{YS + (size_t)k * MT * MIXW + (size_t)m0 * MIXW, MIXW}, W + (size_t)k * MIXW * D + d0, D, MIXW, sm, t);
        if (valid) {
#pragma unroll
            for (int i = 0; i < 4; ++i) { v2u w; w.x = pk2(acc[i][0], acc[i][1]); w.y = pk2(acc[i][2], acc[i][3]); *(v2u*)(BR + (size_t)(m0 + ty * 4 + i) * INW + n0 + tx * 4) = w; }
        }
    NTILE_END
}
__device__ __forceinline__ void ph8_naive(Frame& F, int l) {
    const bf16* H = (const bf16*)(F.ws + WS_H); const bf16* BR = (const bf16*)(F.ws + WS_PROJ); bf16* PM = (bf16*)(F.ws + WS_PM);
    const float* W = IN_(I_WMG) + (size_t)l * D * INW; const float* bm = IN_(I_BMG) + l * INW;
    NTILE_BEGIN((MT / 64) * (D / 64))
        const int m0 = (T / (D / 64)) * 64, n0 = (T % (D / 64)) * 64;
        float out[4][4] = {};
        for (int k = 0; k < 3; ++k) {
            float acc[4][4] = {};
            ngemm_acc(acc, ABf{H + (size_t)m0 * D, D}, W + k * 1024 + n0, INW, D, sm, t);
#pragma unroll
            for (int i = 0; i < 4; ++i) { const v2u b = *(const v2u*)(BR + (size_t)(m0 + ty * 4 + i) * INW + k * 1024 + n0 + tx * 4);
                const float bb[4] = {bf2f((unsigned short)(b.x & 0xffff)), bf2f((unsigned short)(b.x >> 16)), bf2f((unsigned short)(b.y & 0xffff)), bf2f((unsigned short)(b.y >> 16))};
#pragma unroll
                for (int j = 0; j < 4; ++j) out[i][j] += sigmoidf_(acc[i][j] + bm[k * 1024 + n0 + tx * 4 + j]) * bb[j]; }
        }
        if (valid) {
#pragma unroll
            for (int i = 0; i < 4; ++i) { v2u w; w.x = pk2(out[i][0], out[i][1]); w.y = pk2(out[i][2], out[i][3]); *(v2u*)(PM + (size_t)(m0 + ty * 4 + i) * D + n0 + tx * 4) = w; }
        }
    NTILE_END
}
__device__ __forceinline__ void ph9_naive(Frame& F, int l) {
    const bf16* PM = (const bf16*)(F.ws + WS_PM); const float* W = IN_(I_WO) + (size_t)l * D * D;
    NTILE_BEGIN((MT / 64) * (D / 64))
        const int m0 = (T / (D / 64)) * 64, n0 = (T % (D / 64)) * 64;
        float acc[4][4] = {};
        ngemm_acc(acc, ABf{PM + (size_t)m0 * D, D}, W + n0, D, D, sm, t);
        if (valid) {
#pragma unroll
            for (int i = 0; i < 4; ++i) { const int row = m0 + ty * 4 + i, c = n0 + tx * 4; const float* m = mod_ptr(F, l, row) + 2048 + c;
                const f32x4 xs = *(const f32x4*)(xsrc_row(F, l, row) + c);
                f32x4 o; o.x = xs.x + m[0] * acc[i][0]; o.y = xs.y + m[1] * acc[i][1]; o.z = xs.z + m[2] * acc[i][2]; o.w = xs.w + m[3] * acc[i][3];
                *(f32x4*)(xrun_row(F, row) + c) = o; }
        }
    NTILE_END
}
__device__ __forceinline__ void ph10_route(Frame& F, int l) {
    bf16* H = (bf16*)(F.ws + WS_H); const float* g = IN_(I_GFFN) + l * D; const bf16* WRh = (const bf16*)(F.ws + WS_WR); const bf16* WRl = WRh + 48 * 1024;
    const float* bg = IN_(I_BGRP) + l * 4; const float* be = IN_(I_BEXP) + l * 32;
    int* EID = (int*)(F.ws + WS_EID); float* EW = (float*)(F.ws + WS_EW); unsigned* cnt = F.ctl + CW_CNT + l * 128;
    LAS float* LG = (LAS float*)F.lds + F.wave * (16 * 52);
    const int nunits = (l == 0 ? MT : SEQ) / 16; const int r = F.lane & 15, q = F.lane >> 4;
    for (int u = F.bid + F.wave * F.G; u < nunits; u += F.G * (NT / 64)) {
        const int row = u * 16 + r; const float* xr = xrun_row(F, row) + 8 * q; const float* m = mod_ptr(F, l, row) + 8 * q; const float* gq = g + 8 * q;
        float s = 0.f;
#pragma unroll 8
        for (int ks = 0; ks < 32; ++ks) { const f32x4 a = *(const f32x4*)(xr + 32 * ks), b = *(const f32x4*)(xr + 32 * ks + 4); s += a.x * a.x + a.y * a.y + a.z * a.z + a.w * a.w + b.x * b.x + b.y * b.y + b.z * b.z + b.w * b.w; }
        s += __shfl_xor(s, 16); s += __shfl_xor(s, 32);
        const float rstd = rsqrtf(s * (1.f / D) + EPS);
        f32x4 acc[3] = {{0.f, 0.f, 0.f, 0.f}, {0.f, 0.f, 0.f, 0.f}, {0.f, 0.f, 0.f, 0.f}};
#pragma unroll 2
        for (int ks = 0; ks < 32; ++ks) {
            const int c = 32 * ks;
            const f32x4 x0 = *(const f32x4*)(xr + c), x1 = *(const f32x4*)(xr + c + 4), g0 = *(const f32x4*)(gq + c), g1 = *(const f32x4*)(gq + c + 4);
            const f32x4 sc0 = *(const f32x4*)(m + 4096 + c), sc1 = *(const f32x4*)(m + 4096 + c + 4), sh0 = *(const f32x4*)(m + 3072 + c), sh1 = *(const f32x4*)(m + 3072 + c + 4);
            const f32x4 h0 = x0 * rstd * g0 * (1.f + sc0) + sh0, h1 = x1 * rstd * g1 * (1.f + sc1) + sh1;
            v4u hi; hi.x = pk2(h0.x, h0.y); hi.y = pk2(h0.z, h0.w); hi.z = pk2(h1.x, h1.y); hi.w = pk2(h1.z, h1.w);
            *(v4u*)(H + (size_t)row * D + 8 * q + c) = hi;
            v4u lo; lo.x = pk2(h0.x - bflo(hi.x), h0.y - bfhi(hi.x)); lo.y = pk2(h0.z - bflo(hi.y), h0.w - bfhi(hi.y)); lo.z = pk2(h1.x - bflo(hi.z), h1.y - bfhi(hi.z)); lo.w = pk2(h1.z - bflo(hi.w), h1.w - bfhi(hi.w));
            const bf16x8 Ah = __builtin_bit_cast(bf16x8, hi), Al = __builtin_bit_cast(bf16x8, lo);
#pragma unroll
            for (int cb = 0; cb < 3; ++cb) { const bf16x8 Bh = *(const bf16x8*)(WRh + (size_t)(cb * 16 + r) * 1024 + c + 8 * q), Bl = *(const bf16x8*)(WRl + (size_t)(cb * 16 + r) * 1024 + c + 8 * q);
                acc[cb] = __builtin_amdgcn_mfma_f32_16x16x32_bf16(Ah, Bh, acc[cb], 0, 0, 0); acc[cb] = __builtin_amdgcn_mfma_f32_16x16x32_bf16(Al, Bh, acc[cb], 0, 0, 0); acc[cb] = __builtin_amdgcn_mfma_f32_16x16x32_bf16(Ah, Bl, acc[cb], 0, 0, 0); }
        }
#pragma unroll
        for (int cb = 0; cb < 3; ++cb)
#pragma unroll
            for (int i = 0; i < 4; ++i) LG[(4 * q + i) * 52 + cb * 16 + r] = acc[cb][i];
        asm volatile("s_waitcnt lgkmcnt(0)" ::: "memory");
        if (F.lane < 16) { LAS float* L = LG + F.lane * 52; const int rw = u * 16 + F.lane;
            float gl[4];
#pragma unroll
            for (int o = 0; o < 4; ++o) gl[o] = L[o] + bg[o];
            int gi = 0; float gm = gl[0];
#pragma unroll
            for (int o = 1; o < 4; ++o) if (gl[o] > gm) { gm = gl[o]; gi = o; }
            float den = 0.f;
#pragma unroll
            for (int o = 0; o < 4; ++o) den += expf(gl[o] - gm);
            const float gp = 1.f / den;
            const LAS float* el = L + 4 + gi * 8; const float* bel = be + gi * 8;
            int i1 = 0; float m1 = el[0] + bel[0]; for (int o = 1; o < 8; ++o) { const float v = el[o] + bel[o]; if (v > m1) { m1 = v; i1 = o; } }
            int i2 = -1; float m2 = 0.f; for (int o = 0; o < 8; ++o) { const float v = el[o] + bel[o]; if (o != i1 && (i2 < 0 || v > m2)) { m2 = v; i2 = o; } }
            const float e2 = expf(m2 - m1); const float w1 = 1.f / (1.f + e2), w2 = e2 / (1.f + e2);
            const int e1i = gi * 8 + i1, e2i = gi * 8 + i2;
            EID[rw * 2] = e1i; EID[rw * 2 + 1] = e2i; EW[rw * 2] = gp * w1; EW[rw * 2 + 1] = gp * w2;
            atomicAdd(&cnt[e1i], 1u); atomicAdd(&cnt[e2i], 1u);
        }
        asm volatile("s_waitcnt lgkmcnt(0)" ::: "memory");
    }
}
__device__ __forceinline__ int expert_off(const unsigned* cnt, int e) { int o = 0; for (int i = 0; i < e; ++i) o += ((int)cnt[i] + 255) & ~255; return o; }
__device__ __forceinline__ void ph11_scatter(Frame& F, int l) {
    const bf16* H = (const bf16*)(F.ws + WS_H); bf16* HS = (bf16*)(F.ws + WS_HS);
    const int* EID = (const int*)(F.ws + WS_EID); const float* EW = (const float*)(F.ws + WS_EW); int* STOK = (int*)(F.ws + WS_STOK); float* SW = (float*)(F.ws + WS_SW); int* TSLOT = (int*)(F.ws + WS_TSLOT);
    unsigned* cnt = F.ctl + CW_CNT + l * 128; unsigned* fill = cnt + 64;
    LAS int* HIST = (LAS int*)F.lds; LAS int* BASE = HIST + 32; LAS int* ISLOT = BASE + 32; LAS int* IROW = ISLOT + 512;
    const int nunits = (l == 0 ? MT : SEQ) / 16;
    __syncthreads();
    if (F.tid < 32) HIST[F.tid] = 0;
    __syncthreads();
    const int w = F.tid >> 5, u = F.bid + w * F.G; const bool valid = u < nunits; const int row = u * 16 + ((F.tid >> 1) & 15), kk = F.tid & 1;
    int e = 0, rank = 0; if (valid) { e = EID[row * 2 + kk]; rank = __hip_atomic_fetch_add(&HIST[e], 1, __ATOMIC_RELAXED, __HIP_MEMORY_SCOPE_WORKGROUP); }
    __syncthreads();
    if (F.tid < 32) { const int h = HIST[F.tid]; BASE[F.tid] = expert_off(cnt, F.tid) + (h > 0 ? (int)atomicAdd(&fill[F.tid], (unsigned)h) : 0); }
    __syncthreads();
    int slot = -1; if (valid) { slot = BASE[e] + rank; STOK[slot] = row; SW[slot] = EW[row * 2 + kk]; TSLOT[row * 2 + kk] = slot; }
    ISLOT[F.tid] = slot; IROW[F.tid] = row;
    __syncthreads();
#pragma unroll 4
    for (int it = F.wave; it < NT; it += NT / 64) { const int sl = ISLOT[it]; if (sl >= 0) { const v4u* src = (const v4u*)(H + (size_t)IROW[it] * D); v4u* dst = (v4u*)(HS + (size_t)sl * D);
        dst[F.lane] = src[F.lane]; dst[F.lane + 64] = src[F.lane + 64]; } }
}
__device__ __forceinline__ int slot_expert(const unsigned* cnt, int slot0, int& seg_off, int& n_e) { int o = 0; for (int e = 0; e < NE; ++e) { const int n = (int)cnt[e], pn = (n + 255) & ~255; if (slot0 < o + pn) { seg_off = o; n_e = n; return e; } o += pn; } seg_off = o; n_e = 0; return 0; }
__device__ __forceinline__ void ph12_naive(Frame& F, int l) {
    const bf16* HS = (const bf16*)(F.ws + WS_HS); bf16* ACT = (bf16*)(F.ws + WS_ACT); const float* SW = (const float*)(F.ws + WS_SW);
    const unsigned* cnt = F.ctl + CW_CNT + l * 128; const int total = expert_off(cnt, NE);
    NTILE_BEGIN((total / 64) * (DFF / 64))
        const int s0 = (T / (DFF / 64)) * 64, n0 = (T % (DFF / 64)) * 64; int seg, n_e; const int e = slot_expert(cnt, s0, seg, n_e);
        float aa[4][4] = {}, ab[4][4] = {};
        ngemm_acc(aa, ABf{HS + (size_t)s0 * D, D}, IN_(I_W1) + ((size_t)l * NE + e) * D * DFF + n0, DFF, D, sm, t);
        ngemm_acc(ab, ABf{HS + (size_t)s0 * D, D}, IN_(I_W3) + ((size_t)l * NE + e) * D * DFF + n0, DFF, D, sm, t);
        if (valid) {
#pragma unroll
            for (int i = 0; i < 4; ++i) { const int slot = s0 + ty * 4 + i; if (slot - seg < n_e) { const float w = SW[slot];
                v2u o; o.x = pk2(siluf_(aa[i][0]) * ab[i][0] * w, siluf_(aa[i][1]) * ab[i][1] * w); o.y = pk2(siluf_(aa[i][2]) * ab[i][2] * w, siluf_(aa[i][3]) * ab[i][3] * w);
                *(v2u*)(ACT + (size_t)slot * DFF + n0 + tx * 4) = o; } }
        }
    NTILE_END
}
__device__ __forceinline__ void ph13_naive(Frame& F, int l) {
    const bf16* ACT = (const bf16*)(F.ws + WS_ACT); bf16* YS2 = (bf16*)(F.ws + WS_YS2);
    const unsigned* cnt = F.ctl + CW_CNT + l * 128; const int total = expert_off(cnt, NE);
    NTILE_BEGIN((total / 64) * (D / 64))
        const int s0 = (T / (D / 64)) * 64, n0 = (T % (D / 64)) * 64; int seg, n_e; const int e = slot_expert(cnt, s0, seg, n_e);
        float acc[4][4] = {};
        ngemm_acc(acc, ABf{ACT + (size_t)s0 * DFF, DFF}, IN_(I_W2) + ((size_t)l * NE + e) * DFF * D + n0, D, DFF, sm, t);
        if (valid) {
#pragma unroll
            for (int i = 0; i < 4; ++i) { const int slot = s0 + ty * 4 + i; if (slot - seg < n_e) { v2u o; o.x = pk2(acc[i][0], acc[i][1]); o.y = pk2(acc[i][2], acc[i][3]); *(v2u*)(YS2 + (size_t)slot * D + n0 + tx * 4) = o; } }
        }
    NTILE_END
}
__device__ __forceinline__ void ph14_combine(Frame& F, int l) {
    const bf16* YS2 = (const bf16*)(F.ws + WS_YS2); const int* TSLOT = (const int*)(F.ws + WS_TSLOT); bf16* H = (bf16*)(F.ws + WS_H);
    const int gw = F.bid * (NT / 64) + F.wave, ngw = F.G * (NT / 64);
    const int nrows = l == 0 ? MT : SEQ;
    for (int row0 = gw; row0 < nrows; row0 += 2 * ngw) {
        f32x4 v[2][4]; float s[2] = {0.f, 0.f}; int rows[2]; bool ok[2];
#pragma unroll
        for (int t = 0; t < 2; ++t) { rows[t] = row0 + t * ngw; ok[t] = rows[t] < nrows; if (!ok[t]) rows[t] = row0; }
        int sl[2][2];
#pragma unroll
        for (int t = 0; t < 2; ++t) { sl[t][0] = TSLOT[rows[t] * 2]; sl[t][1] = TSLOT[rows[t] * 2 + 1]; }
#pragma unroll
        for (int t = 0; t < 2; ++t) { const float* m = mod_ptr(F, l, rows[t]); const float* xr = xrun_row(F, rows[t]);
#pragma unroll
            for (int j = 0; j < 4; ++j) { const int c = 4 * F.lane + 256 * j; const f32x4 x = *(const f32x4*)(xr + c); const f32x4 ga = *(const f32x4*)(m + 5120 + c);
                const v2u a = *(const v2u*)(YS2 + (size_t)sl[t][0] * D + c), b = *(const v2u*)(YS2 + (size_t)sl[t][1] * D + c);
                f32x4 y; y.x = bflo(a.x) + bflo(b.x); y.y = bfhi(a.x) + bfhi(b.x); y.z = bflo(a.y) + bflo(b.y); y.w = bfhi(a.y) + bfhi(b.y);
                v[t][j] = x + ga * y; s[t] += v[t][j].x * v[t][j].x + v[t][j].y * v[t][j].y + v[t][j].z * v[t][j].z + v[t][j].w * v[t][j].w; } }
#pragma unroll
        for (int t = 0; t < 2; ++t) { if (!ok[t]) continue;
            const float rstd = rsqrtf(wave_sum(s[t]) * (1.f / D) + EPS); float* xr = xrun_row(F, rows[t]);
            if (l == 0) {
                const float* m1 = mod_ptr(F, 1, rows[t]); const float* g = IN_(I_GMIX) + D;
#pragma unroll
                for (int j = 0; j < 4; ++j) { const int c = 4 * F.lane + 256 * j; *(f32x4*)(xr + c) = v[t][j];
                    const f32x4 gg = *(const f32x4*)(g + c), sc = *(const f32x4*)(m1 + 1024 + c), sh = *(const f32x4*)(m1 + c);
                    const f32x4 o = v[t][j] * rstd * gg * (1.f + sc) + sh; v2u w; w.x = pk2(o.x, o.y); w.y = pk2(o.z, o.w); *(v2u*)(H + (size_t)rows[t] * D + c) = w; }
            } else {
                const float* g = IN_(I_GF);
#pragma unroll
                for (int j = 0; j < 4; ++j) { const int c = 4 * F.lane + 256 * j; const f32x4 gg = *(const f32x4*)(g + c); f32x4 o = v[t][j] * rstd * gg;
                    if (PROBE_B >= 0 && rows[t] < 3906) { volatile LAS unsigned long long* TS = (volatile LAS unsigned long long*)(F.lds + TS_OFF); o = o + (0.1f + 0.00001f * (float)(TS[1 + PROBE_B] - TS[PROBE_B])); }
                    if (PROBE_A >= 0 && rows[t] == 0 && j == 0 && F.lane == 0) { volatile LAS unsigned long long* TS = (volatile LAS unsigned long long*)(F.lds + TS_OFF); o.x += 1.f + 0.001f * (float)(TS[1 + PROBE_A] - TS[PROBE_A]); }
                    *(f32x4*)(xr + c) = o; }
            }
        }
    }
}

#ifndef FASTMASK
#define FASTMASK 0xffff
#endif
constexpr unsigned FM = FASTMASK;
constexpr int NPH = 2 + 13 * 2;
__device__ __forceinline__ Frame make_frame(LAS unsigned char* lds, int wave0) {
    Frame F; F.lds = lds; F.wave = wave0; F.lane = (int)__builtin_amdgcn_mbcnt_hi(~0u, __builtin_amdgcn_mbcnt_lo(~0u, 0u)); asm volatile("" : "+v"(F.lane)); F.tid = F.wave * 64 + F.lane; F.bid = blockIdx.x; F.G = gridDim.x; asm volatile("" : "+s"(F.G), "+s"(F.bid));
    F.tab = (const unsigned long long LAS*)(lds + TAB_OFF);
    volatile LAS unsigned long long* t = (volatile LAS unsigned long long*)(lds + TAB_OFF);
    F.ws = (unsigned char*)uni64(t[35]); F.out = (float*)uni64(t[36]); F.ctl = (unsigned*)(F.ws + WS_CTL);
    return F;
}
__global__ void __launch_bounds__(NT, 2) mega_fwd(Args args) {
    extern __shared__ __attribute__((aligned(16))) unsigned char lds_raw[];
    LAS unsigned char* const lds = (LAS unsigned char*)lds_raw;
    const int wave0 = __builtin_amdgcn_readfirstlane((int)threadIdx.x >> 6);
    for (int u = threadIdx.x; u < 1024 / 4; u += NT) ((LAS unsigned*)(lds + 131072))[u] = 0u;
    if (threadIdx.x == 0) { LAS unsigned long long* t = (LAS unsigned long long*)(lds + TAB_OFF);
#pragma unroll
        for (int i = 0; i < 35; ++i) t[i] = (unsigned long long)args.in[i];
        t[35] = (unsigned long long)args.ws; t[36] = (unsigned long long)args.out; }
    __syncthreads();
    { Frame F = make_frame(lds, wave0); (void)xcd_barrier_post(F.ctl + CW_BAR, (volatile LAS unsigned*)(lds + MISC_OFF) + 8); }
    if ((PROBE_A >= 0 || PROBE_B >= 0) && threadIdx.x == 0) ((volatile LAS unsigned long long*)(lds + TS_OFF))[0] = __builtin_amdgcn_s_memrealtime();
    const int lo = args.ph_lo, hi = args.ph_hi; int ph = 0;
#define GRIDBAR() do { Frame Fb = make_frame(lds, wave0); XcdBarrier bar; bar.bar = Fb.ctl + CW_BAR; bar.x = xb_xcc_id(); bar.st = (volatile LAS unsigned*)(lds + MISC_OFF) + 8; xcd_barrier(bar, Fb.tid == 0); } while (0)
#ifndef REPBAR
#define REPBAR 0
#endif
#ifndef REPMASK
#define REPMASK 0
#endif
#define PHASE(...) do { if (lo <= ph && ph < hi) { const int _pl = ph < 2 ? ph : 2 + (ph - 2) % 13; for (int _rep = 0; _rep <= ((REPMASK >> _pl) & 1); ++_rep) { Frame F = make_frame(lds, wave0); __VA_ARGS__; } if (ph + 1 < hi) { GRIDBAR(); if (REPBAR) GRIDBAR(); } if ((PROBE_A >= 0 || PROBE_B >= 0) && threadIdx.x == 0) ((volatile LAS unsigned long long*)(lds + TS_OFF))[1 + ph] = __builtin_amdgcn_s_memrealtime(); } ++ph; } while (0)
    PHASE({ ph0_prologue(F); convert_weights(F, 0); { const f32x4* s = (const f32x4*)IN_(I_CTX); f32x4* d = (f32x4*)(F.ws + WS_XC); for (int i = F.bid * NT + F.tid; i < CTX * D / 4; i += F.G * NT) d[i] = s[i]; } });
    PHASE({ hprep_rows(F, 0); if (FM >> 3 & 1) s5_precompute(F); });
#pragma unroll 1
    for (int l = 0; l < 2; ++l) {
        PHASE({ if (FM >> 2 & 1) ph2_fast(F, l); else ph2_naive(F, l); });
        PHASE({ if (FM >> 3 & 1) { s5_z_phase(F, l); const int nch = (l == 0 ? MT : SEQ) / 128; if (F.G > nch) { if (F.bid < nch) sg_fast_chunk(F, l, F.bid); else { Frame F2 = F; F2.bid -= nch; F2.G -= nch; ph3_conv(F2, l, l == 0 ? MT : SEQ); } } else { for (int c = F.bid; c < nch; c += F.G) sg_fast_chunk(F, l, c); ph3_conv(F, l, l == 0 ? MT : SEQ); } } else { ph3_s5_naive(F, l); if (F.bid >= 64) { Frame F2 = F; F2.bid -= 64; F2.G -= 64; ph3_sg_naive(F2, l); ph3_conv(F2, l, MT); } } });
        PHASE({ if (FM >> 3 & 1) s5_scan_phase(F, l); });
        PHASE({ if (FM >> 3 & 1) s5_y_phase(F, l); else ph5_naive(F, l); });
        PHASE({ if (FM >> 6 & 1) ph6_fast(F, l); else ph6_naive(F, l); });
        PHASE({ if (FM >> 7 & 1) ph7_fast(F, l); else ph7_naive(F, l); });
        PHASE({ if (FM >> 8 & 1) ph8_fast(F, l); else ph8_naive(F, l); });
        PHASE({ if (FM >> 9 & 1) ph9_fast(F, l); else ph9_naive(F, l); });
        PHASE(ph10_route(F, l));
        PHASE(ph11_scatter(F, l));
        PHASE({ if (FM >> 12 & 1) ph12_fast(F, l); else ph12_naive(F, l); });
        PHASE({ if (FM >> 13 & 1) ph13_fast(F, l); else ph13_naive(F, l); });
        PHASE({ ph14_combine(F, l); if (l == 0) convert_weights(F, 1); });
    }
#undef PHASE
}

extern "C" void kernel_launch(void* const* d_in, const int* in_sizes, int n_in, void* d_out, int out_size, void* d_ws, size_t ws_size, hipStream_t stream) {
    static int grid = 0;
    if (grid == 0) {
        int dev = 0, cus = 0, per_cu = 0;
        if (n_in != 35 || out_size != SEQ * D || ws_size < WS_END) { fprintf(stderr, "kernel_launch: unexpected shapes (n_in %d out %d ws %zu)\n", n_in, out_size, ws_size); grid = -1; return; }
        if (hipGetDevice(&dev) != hipSuccess || hipDeviceGetAttribute(&cus, hipDeviceAttributeMultiprocessorCount, dev) != hipSuccess) { grid = -1; return; }
        if (hipFuncSetAttribute((const void*)mega_fwd, hipFuncAttributeMaxDynamicSharedMemorySize, LDS_BYTES) != hipSuccess) { fprintf(stderr, "kernel_launch: hipFuncSetAttribute failed\n"); grid = -1; return; }
        if (hipOccupancyMaxActiveBlocksPerMultiprocessor(&per_cu, (const void*)mega_fwd, NT, LDS_BYTES) != hipSuccess || per_cu < 1) { fprintf(stderr, "kernel_launch: occupancy query says %d blocks per CU\n", per_cu); grid = -1; return; }
        grid = cus;
    }
    if (grid < 0) return;
    (void)hipMemsetAsync((char*)d_ws + WS_CTL, 0, CTL_ZERO_BYTES, stream);
    Args a{};
    for (int i = 0; i < 35; ++i) a.in[i] = (const float*)d_in[i];
    a.out = (float*)d_out; a.ws = (unsigned char*)d_ws; a.ph_lo = 0; a.ph_hi = NPH;
    void* kargs[] = {&a};
    hipError_t e = hipLaunchCooperativeKernel((const void*)mega_fwd, dim3(grid), dim3(NT), kargs, LDS_BYTES, stream);
    if (e != hipSuccess) fprintf(stderr, "kernel_launch: cooperative launch failed: %s (grid %d)\n", hipGetErrorString(e), grid);
}
```

```cpp
#include <hip/hip_runtime.h>
#include <stdint.h>
#include <cstdio>

#define GAS __attribute__((address_space(1)))
#define LAS __attribute__((address_space(3)))
typedef unsigned short bf16;
typedef unsigned v4u __attribute__((ext_vector_type(4)));
typedef unsigned v2u __attribute__((ext_vector_type(2)));
typedef float f32x4 __attribute__((ext_vector_type(4)));

constexpr int D = 1024, SEQ = 16384, CTX = 256, MT = SEQ + CTX;
constexpr int MIXW = 512, INW = 3072, G5 = 32, P5 = 64, H5 = 16;
constexpr int NE = 32, DFF = 256;
constexpr int MAXSLOT = 2 * MT + NE * 256;
constexpr float EPS = 1e-6f;
constexpr int NT = 512;

constexpr size_t MiB = 1u << 20;
constexpr size_t WS_CTL = 0, CTL_ZERO_BYTES = 1 * MiB;
constexpr size_t WS_MOD = 1 * MiB;
constexpr size_t WS_XC = 2 * MiB;
constexpr size_t WS_EID = 3 * MiB;
constexpr size_t WS_EW = WS_EID + (size_t)MT * 8;
constexpr size_t WS_STOK = WS_EW + (size_t)MT * 8;
constexpr size_t WS_SW = WS_STOK + (size_t)MAXSLOT * 4;
constexpr size_t WS_TSLOT = WS_SW + (size_t)MAXSLOT * 4;
constexpr size_t WS_HISTG = WS_TSLOT + (size_t)MT * 8;
constexpr size_t WS_H = 4 * MiB;
constexpr size_t WS_PROJ = WS_H + (size_t)MT * 2048;
constexpr size_t WS_YS = WS_PROJ + (size_t)MT * 6144;
constexpr size_t WS_YG = WS_YS + (size_t)3 * MT * 1024;
constexpr size_t WS_PM = WS_YG + (size_t)MT * 1024;
constexpr size_t WS_S5 = WS_PM + (size_t)MT * 2048;
constexpr size_t WS_Z = WS_S5;
constexpr size_t WS_SS = WS_Z + (size_t)1040 * 32 * 256 * 4;
constexpr size_t WS_S5M = WS_SS + (size_t)1040 * 32 * 256 * 2;
constexpr size_t WS_A16 = WS_S5M + (size_t)2 * 32 * 3 * 65536 * 2;
constexpr size_t WS_W = WS_A16 + (size_t)2 * 32 * 2 * 64 * 2 * 4 > WS_S5 + (size_t)2 * MT * 512 * 4 ? WS_A16 + (size_t)2 * 32 * 2 * 64 * 2 * 4 : WS_S5 + (size_t)2 * MT * 512 * 4;
constexpr size_t WS_WIN = WS_W;
constexpr size_t WS_WMG = WS_WIN + (size_t)3072 * 1024 * 2;
constexpr size_t WS_WGLU = WS_WMG + (size_t)3072 * 1024 * 2;
constexpr size_t WS_WBR = WS_WGLU + (size_t)512 * 512 * 2;
constexpr size_t WS_WO = WS_WBR + (size_t)3 * 1024 * 512 * 2;
constexpr size_t WS_W13 = WS_WO + (size_t)1024 * 1024 * 2;
constexpr size_t WS_W2 = WS_W13 + (size_t)32 * 512 * 1024 * 2;
constexpr size_t WS_WSG = WS_W2 + (size_t)32 * 1024 * 256 * 2;
constexpr size_t WS_WR = WS_WSG + (size_t)4 * 128 * 128 * 2;
constexpr size_t WS_END = WS_WR + (size_t)2 * 48 * 1024 * 2;
static_assert(WS_END <= (size_t)377 * MiB, "workspace budget");
constexpr size_t WS_HS = WS_PROJ;
constexpr size_t WS_ACT = WS_YS;
constexpr size_t WS_YS2 = WS_YG;
static_assert(WS_HS + (size_t)MAXSLOT * 2048 <= WS_YS && WS_ACT + (size_t)MAXSLOT * 512 <= WS_YG && WS_YS2 + (size_t)MAXSLOT * 2048 <= WS_W, "moe overlays");
static_assert(WS_HISTG + (size_t)1024 * 32 * 4 <= WS_H, "ws map");
constexpr int CW_CNT = 64;
constexpr int CW_BAR = 4096;

#ifndef PROBE_A
#define PROBE_A -1
#endif
#ifndef PROBE_B
#define PROBE_B -1
#endif
constexpr int TS_OFF = 131072 + 512;
constexpr int LDS_BYTES = 147456;
constexpr int MISC_OFF = 131072 + 320;
constexpr int TAB_OFF = 131072 + 1024;

__device__ __forceinline__ float bf2f(unsigned short b) { return __builtin_bit_cast(float, ((unsigned)b) << 16); }
__device__ __forceinline__ unsigned f2bf(float f) { unsigned u = __builtin_bit_cast(unsigned, f); return (u + 0x7fffu + ((u >> 16) & 1u)) >> 16; }
__device__ __forceinline__ unsigned pk2(float lo, float hi) { return f2bf(lo) | (f2bf(hi) << 16); }
__device__ __forceinline__ float sigmoidf_(float x) { return 1.f / (1.f + __expf(-x)); }
__device__ __forceinline__ float siluf_(float x) { return x / (1.f + __expf(-x)); }
__device__ __forceinline__ float geluf_(float x) { const float u = 0.7978845608028654f * (x + 0.044715f * x * x * x); return x / (1.f + __expf(-2.f * u)); }
__device__ __forceinline__ float wave_sum(float v) {
#pragma unroll
    for (int o = 1; o < 64; o <<= 1) v += __shfl_xor(v, o);
    return v;
}

#define XB_TMO      128
#define XB_XCNT(j)  (256  + 64 * (j))
#define XB_XSUB(j)  (1280 + 64 * (j))
#define XB_XGEN(j)  (2304 + 64 * (j))
#define XB_TOP      3328
#define XB_TOPGEN   3392
#define XCD_BAR_WORDS 3456
#define XB_SPIN_CAP (1u << 24)
__device__ __forceinline__ unsigned xb_ld(unsigned* p)              { return __hip_atomic_load(p, __ATOMIC_RELAXED, __HIP_MEMORY_SCOPE_AGENT); }
__device__ __forceinline__ unsigned xb_add(unsigned* p, unsigned v) { return __hip_atomic_fetch_add(p, v, __ATOMIC_RELAXED, __HIP_MEMORY_SCOPE_AGENT); }
__device__ __forceinline__ unsigned xb_xcc_id() { return (unsigned)__builtin_amdgcn_s_getreg((3 << 11) | 20) & 0xFu; }
#define XB_SPIN(cond, bar) do { unsigned _sp = 0; while (cond) { __builtin_amdgcn_s_sleep(1); \
    if ((++_sp & 255u) == 0u) { if (xb_ld(&(bar)[XB_TMO])) break; if (_sp > XB_SPIN_CAP) { atomicAdd(&(bar)[XB_TMO], 1u); break; } } } } while (0)
struct XcdBarrier { unsigned* bar; unsigned x; volatile LAS unsigned* st; };
__device__ __forceinline__ XcdBarrier xcd_barrier_post(unsigned* bar, volatile LAS unsigned* st) {
    XcdBarrier b; b.bar = bar; b.x = xb_xcc_id(); b.st = st;
    if (threadIdx.x == 0) (void)xb_add(&bar[XB_XCNT(b.x)], 1u);
    return b;
}
__device__ __forceinline__ void xcd_barrier_complete(unsigned* bar, unsigned x, unsigned& nloc, unsigned& nx) {
    const unsigned G = gridDim.x * gridDim.y * gridDim.z;
    unsigned sum, cnt, mine, sp = 0u;
    for (;;) {
        sum = 0u; cnt = 0u; mine = 0u;
#pragma unroll
        for (unsigned j = 0; j < 16; ++j) { const unsigned c = xb_ld(&bar[XB_XCNT(j)]); sum += c; cnt += (c > 0u) ? 1u : 0u; mine = (j == x) ? c : mine; }
        if (sum == G) break;
        __builtin_amdgcn_s_sleep(1);
        if ((++sp & 255u) == 0u) { if (xb_ld(&bar[XB_TMO])) break; if (sp > XB_SPIN_CAP) { atomicAdd(&bar[XB_TMO], 1u); break; } }
    }
    nloc = mine > 0u ? mine : 1u; nx = cnt > 0u ? cnt : 1u;
}
__device__ __forceinline__ void xcd_barrier(const XcdBarrier& b, bool leader) {
    asm volatile("s_waitcnt vmcnt(0)" ::: "memory");
    __syncthreads();
    if (leader) {
        unsigned* bar = b.bar;
        __builtin_amdgcn_s_waitcnt(0);
        unsigned nloc = b.st[0], nx = b.st[1];
        if (nloc == 0u) { xcd_barrier_complete(bar, b.x, nloc, nx); b.st[0] = nloc; b.st[1] = nx; }
        const unsigned old = xb_add(&bar[XB_XSUB(b.x)], 1u);
        const unsigned gen = old / nloc;
        if (old + 1u == (gen + 1u) * nloc) {
            __builtin_amdgcn_fence(__ATOMIC_RELEASE, "agent");
            asm volatile("s_waitcnt vmcnt(0)" ::: "memory");
            const unsigned og = xb_add(&bar[XB_TOP], 1u);
            const unsigned tg = og / nx;
            if (og + 1u == (tg + 1u) * nx) xb_add(&bar[XB_TOPGEN], 1u);
            else XB_SPIN(xb_ld(&bar[XB_TOPGEN]) == tg, bar);
            __builtin_amdgcn_fence(__ATOMIC_ACQUIRE, "agent");
            xb_add(&bar[XB_XGEN(b.x)], 1u);
            asm volatile("s_waitcnt vmcnt(0)" ::: "memory");
        } else {
            XB_SPIN(xb_ld(&bar[XB_XGEN(b.x)]) == gen, bar);
            __builtin_amdgcn_fence(__ATOMIC_ACQUIRE, "agent");
            asm volatile("s_waitcnt vmcnt(0)" ::: "memory");
        }
    }
    __syncthreads();
}

struct Args { const float* in[35]; float* out; unsigned char* ws; int ph_lo, ph_hi; };
struct Frame {
    LAS unsigned char* lds; unsigned char* ws; unsigned* ctl;
    int tid, lane, wave, bid, G;
    const unsigned long long LAS* tab; float* out;
};
__device__ __forceinline__ unsigned long long uni64(unsigned long long v) { const unsigned lo = __builtin_amdgcn_readfirstlane((unsigned)v), hi = __builtin_amdgcn_readfirstlane((unsigned)(v >> 32)); return ((unsigned long long)hi << 32) | lo; }
#define IN_(k) ((const float*)uni64(F.tab[k]))
enum { I_X = 0, I_C, I_CTX, I_CCTX, I_WADA, I_BADA, I_GMIX, I_GFFN, I_WIN, I_LRE, I_LIM, I_LDT, I_BRE, I_BIM, I_CRE, I_CIM, I_DSKIP, I_WGLU, I_SGG, I_SGB, I_WSG, I_BSG,
       I_WCONV, I_WBR, I_WMG, I_BMG, I_WO, I_WGRP, I_BGRP, I_WEXP, I_BEXP, I_W1, I_W3, I_W2, I_GF };

__device__ __forceinline__ const float* mod_ptr(const Frame& F, int l, int row) { return (const float*)(F.ws + WS_MOD) + (size_t)(l * 2 + (row >= SEQ ? 1 : 0)) * 6144; }
__device__ __forceinline__ const float* xsrc_row(const Frame& F, int l, int row) {
    if (l == 0) return row < SEQ ? IN_(I_X) + (size_t)row * D : IN_(I_CTX) + (size_t)(row - SEQ) * D;
    return row < SEQ ? F.out + (size_t)row * D : (const float*)(F.ws + WS_XC) + (size_t)(row - SEQ) * D;
}
__device__ __forceinline__ float* xrun_row(const Frame& F, int row) { return row < SEQ ? F.out + (size_t)row * D : (float*)(F.ws + WS_XC) + (size_t)(row - SEQ) * D; }


namespace pg8 {
#define PG8_LAS __attribute__((address_space(3)))
typedef unsigned short bf16_t;
typedef short bf16x8 __attribute__((ext_vector_type(8)));
typedef float f32x4 __attribute__((ext_vector_type(4)));
typedef unsigned u32x4 __attribute__((ext_vector_type(4)));
constexpr int BM = 256, BK = 64, HALF = 128, HTB = HALF * BK * 2  , STAGE_BYTES = 8 * HTB, NXCD = 8, WGM = 8;

__host__ __device__ __forceinline__ int lds_byte(int r, int c) { const int st = (r >> 4) * 2 + (c >> 5), rr = r & 15, cc = c & 31, ob = rr * 64 + cc * 2; return st * 1024 + (ob ^ (((ob >> 9) & 1) << 5)); }
__host__ __device__ __forceinline__ void stage_rc(int b, int& R, int& C) { const int st = b / 1024, sb = b % 1024, swz = sb ^ (((sb >> 9) & 1) << 5); R = (st >> 1) * 16 + swz / 64; C = (st & 1) * 32 + (swz % 64) / 2; }
__host__ __device__ __forceinline__ int perm32(int rho) { const int n = rho >> 4, i = rho & 15; return 8 * (i >> 2) + 4 * n + (i & 3); }

struct Unit { int pm, pn; };
struct Gemm { const bf16_t* A; const bf16_t* Bt; int M, N, K; };

struct StaticOrder {
    int nM, nN, nwg, G, c;
    __host__ __device__ void init(int M, int N, int G_, int c_) { nM = M / BM; nN = N / BM; nwg = nM * nN; G = G_; c = c_; }
    __host__ __device__ bool next(int i, Unit& u) const {
        const long L = (long)i * G + c; if (L >= nwg) return false;
        int wgid = (int)L; { const int q = nwg / NXCD, r = nwg % NXCD, xcd = wgid % NXCD, off = wgid / NXCD; wgid = (xcd < r ? xcd * (q + 1) : r * (q + 1) + (xcd - r) * q) + off; }
        const int nig = WGM * nN, gid = wgid / nig, fm = gid * WGM, gsz = (nM - fm) < WGM ? (nM - fm) : WGM;
        u.pm = fm + ((wgid % nig) % gsz); u.pn = (wgid % nig) / gsz; return true;
    }
    __device__ __forceinline__ void a_ready(const Unit&) const {}
    __device__ __forceinline__ void done(const Unit&) const {}
};
__device__ __forceinline__ unsigned cvt_pk_bf16(float lo, float hi) { unsigned r; asm volatile("v_cvt_pk_bf16_f32 %0, %1, %2" : "=v"(r) : "v"(lo), "v"(hi)); return r; }
template <class Epi, class Sched, bool ALIGN_EPI = false, bool SP2 = false>
__device__ __forceinline__ void gemm_phase(PG8_LAS unsigned char* lds, const Gemm g, const Sched& S, const Epi& E, int tid_in) {
    int tid_ = tid_in; asm volatile("" : "+v"(tid_));
    const int tid = tid_, wid = __builtin_amdgcn_readfirstlane(tid >> 6), lane = tid & 63, wr = wid >> 2, wc = wid & 3, fr = lane & 15, fq = lane >> 4;
    const int K = g.K, nt = K / BK;
    unsigned voffA[2], voffB[2];
#pragma unroll
    for (int i = 0; i < 2; ++i) { int R, C; stage_rc(tid * 16 + i * 8192, R, C); const int Rb = Epi::PERM ? ((R & ~31) + perm32(R & 31)) : R;
        voffA[i] = (unsigned)(R * K + C) * 2u; voffB[i] = (unsigned)(Rb * K + C) * 2u; }
    const size_t kstep = (size_t)(BK * 2);
    const size_t hstep = (size_t)HALF * K * 2;
    const size_t tstep = 2 * hstep;
    const unsigned ldsw = (unsigned)wid * 1024u;
    const int aoff = lds_byte(wr * 64 + fr, fq * 8), boff = lds_byte(wc * 32 + fr, fq * 8);
#define PG8_SA(b, h) (((b) * 2 + (h)) * HTB)
#define PG8_SB(b, h) ((4 + (b) * 2 + (h)) * HTB)
#define PG8_STAGE(bufoff, gbase, voff) do { _Pragma("unroll") for (int _i = 0; _i < 2; ++_i) \
        __builtin_amdgcn_global_load_lds((const unsigned*)((const char*)(gbase) + (voff)[_i]), (PG8_LAS unsigned*)(lds + (bufoff) + ldsw + _i * 8192), 16, 0, 0); } while (0)
#define PG8_LDA(dst, b, h) do { _Pragma("unroll") for (int m = 0; m < 4; ++m) _Pragma("unroll") for (int k = 0; k < 2; ++k) dst[m][k] = *(const PG8_LAS bf16x8*)(lds + PG8_SA(b, h) + aoff + m * 2048 + k * 1024); } while (0)
#define PG8_LDB(dst, b, h) do { _Pragma("unroll") for (int n = 0; n < 2; ++n) _Pragma("unroll") for (int k = 0; k < 2; ++k) dst[n][k] = *(const PG8_LAS bf16x8*)(lds + PG8_SB(b, h) + boff + n * 2048 + k * 1024); } while (0)
#define PG8_MMA(ai, bj, At, Bt) do { __builtin_amdgcn_s_setprio(1); _Pragma("unroll") for (int m = 0; m < 4; ++m) _Pragma("unroll") for (int n = 0; n < 2; ++n) _Pragma("unroll") for (int k = 0; k < 2; ++k) \
        acc[ai][bj][m][n] = __builtin_amdgcn_mfma_f32_16x16x32_bf16(Bt[n][k], At[m][k], acc[ai][bj][m][n], 0, 0, 0); __builtin_amdgcn_s_setprio(0); } while (0)
#define PG8_WAIT_V(n) asm volatile("s_waitcnt vmcnt(" #n ")" ::: "memory")
#define PG8_WAIT_L(n) asm volatile("s_waitcnt lgkmcnt(" #n ")" ::: "memory")
#define PG8_BAR __builtin_amdgcn_s_barrier()
#define PG8_SCHED __builtin_amdgcn_sched_barrier(0)
    Unit cur, nxt; int ui = 0;
    if (!S.next(0, cur)) return;
    f32x4 acc[2][2][4][2];
#pragma unroll
    for (int a = 0; a < 2; ++a)
#pragma unroll
        for (int b = 0; b < 2; ++b)
#pragma unroll
            for (int m = 0; m < 4; ++m)
#pragma unroll
                for (int n = 0; n < 2; ++n) acc[a][b][m][n] = (f32x4){0.f, 0.f, 0.f, 0.f};
    bf16x8 At[4][2], B0[2][2], B1[2][2];
    const char* cA = (const char*)g.A + (size_t)cur.pm * tstep; const char* cB = (const char*)g.Bt + (size_t)cur.pn * tstep;
    S.a_ready(cur);
    if constexpr (SP2) {
        PG8_STAGE(PG8_SB(0, 0), cB, voffB); PG8_STAGE(PG8_SB(0, 1), cB + hstep, voffB); PG8_STAGE(PG8_SA(0, 0), cA, voffA); PG8_STAGE(PG8_SA(0, 1), cA + hstep, voffA);
        if (wr == 1) PG8_BAR;
        PG8_WAIT_V(2); PG8_BAR;
        PG8_STAGE(PG8_SB(1, 0), cB + kstep, voffB); PG8_STAGE(PG8_SA(1, 0), cA + kstep, voffA); PG8_STAGE(PG8_SB(1, 1), cB + hstep + kstep, voffB);
        PG8_WAIT_V(6); PG8_BAR;
    } else {
        PG8_STAGE(PG8_SB(0, 0), cB, voffB); PG8_STAGE(PG8_SA(0, 0), cA, voffA); PG8_STAGE(PG8_SB(0, 1), cB + hstep, voffB); PG8_STAGE(PG8_SA(0, 1), cA + hstep, voffA);
        if (wr == 1) PG8_BAR;
        PG8_WAIT_V(4); PG8_BAR;
        PG8_STAGE(PG8_SB(1, 0), cB + kstep, voffB); PG8_STAGE(PG8_SA(1, 0), cA + kstep, voffA); PG8_STAGE(PG8_SB(1, 1), cB + hstep + kstep, voffB);
        PG8_WAIT_V(6); PG8_BAR;
    }
    for (;;) {
        const bool has_next = S.next(ui + 1, nxt);
        const char* nA = has_next ? (const char*)g.A + (size_t)nxt.pm * tstep : cA; const char* nB = has_next ? (const char*)g.Bt + (size_t)nxt.pn * tstep : cB;
#pragma unroll 1
        for (int t = 0; t < nt; t += 2) {
            const bool last = (t == nt - 2);
            const char* a1 = cA + (size_t)(t + 1) * kstep;
            const char* a2 = last ? nA : cA + (size_t)(t + 2) * kstep; const char* b2 = last ? nB : cB + (size_t)(t + 2) * kstep;
            const char* a3 = a2 + kstep; const char* b3 = b2 + kstep;
            if (last && has_next) S.a_ready(nxt);
            if constexpr (SP2) {
            PG8_LDB(B0, 0, 0); PG8_LDB(B1, 0, 1); PG8_SCHED; PG8_LDA(At, 0, 0); PG8_STAGE(PG8_SA(1, 1), a1 + hstep, voffA);
            PG8_WAIT_V(8); PG8_WAIT_L(0); PG8_BAR; PG8_MMA(0, 0, At, B0); PG8_MMA(0, 1, At, B1); PG8_BAR; PG8_SCHED;
            PG8_LDA(At, 0, 1); PG8_STAGE(PG8_SB(0, 0), b2, voffB); PG8_STAGE(PG8_SB(0, 1), b2 + hstep, voffB); PG8_STAGE(PG8_SA(0, 0), a2, voffA);
            PG8_WAIT_V(8); PG8_WAIT_L(0); PG8_BAR; PG8_MMA(1, 0, At, B0); PG8_MMA(1, 1, At, B1); PG8_BAR; PG8_SCHED;
            PG8_LDB(B0, 1, 0); PG8_LDB(B1, 1, 1); PG8_SCHED; PG8_LDA(At, 1, 0); PG8_STAGE(PG8_SA(0, 1), a2 + hstep, voffA);
            PG8_WAIT_V(8); PG8_WAIT_L(0); PG8_BAR; PG8_MMA(0, 0, At, B0); PG8_MMA(0, 1, At, B1); PG8_BAR; PG8_SCHED;
            PG8_LDA(At, 1, 1); PG8_STAGE(PG8_SB(1, 0), b3, voffB); PG8_STAGE(PG8_SB(1, 1), b3 + hstep, voffB); PG8_STAGE(PG8_SA(1, 0), a3, voffA);
            PG8_WAIT_V(8); PG8_WAIT_L(0); PG8_BAR; PG8_MMA(1, 0, At, B0); PG8_MMA(1, 1, At, B1); PG8_BAR; PG8_SCHED;
            } else {
            PG8_LDB(B0, 0, 0); PG8_SCHED; PG8_LDA(At, 0, 0); PG8_STAGE(PG8_SA(1, 1), a1 + hstep, voffA);
            PG8_WAIT_L(8); PG8_BAR; PG8_WAIT_L(0); PG8_MMA(0, 0, At, B0); PG8_BAR; PG8_SCHED;
            PG8_LDB(B1, 0, 1); PG8_STAGE(PG8_SB(0, 0), b2, voffB);
            PG8_BAR; PG8_WAIT_L(0); PG8_MMA(0, 1, At, B1); PG8_BAR;
            PG8_LDA(At, 0, 1); PG8_STAGE(PG8_SA(0, 0), a2, voffA);
            PG8_BAR; PG8_WAIT_L(0); PG8_MMA(1, 0, At, B0); PG8_BAR; PG8_SCHED;
            PG8_STAGE(PG8_SB(0, 1), b2 + hstep, voffB);
            PG8_WAIT_V(6); PG8_BAR; PG8_MMA(1, 1, At, B1); PG8_BAR;
            PG8_LDB(B0, 1, 0); PG8_SCHED; PG8_LDA(At, 1, 0); PG8_STAGE(PG8_SA(0, 1), a2 + hstep, voffA);
            PG8_WAIT_L(8); PG8_BAR; PG8_WAIT_L(0); PG8_MMA(0, 0, At, B0); PG8_BAR; PG8_SCHED;
            PG8_LDB(B1, 1, 1); PG8_STAGE(PG8_SB(1, 0), b3, voffB);
            PG8_BAR; PG8_WAIT_L(0); PG8_MMA(0, 1, At, B1); PG8_BAR;
            PG8_LDA(At, 1, 1); PG8_STAGE(PG8_SA(1, 0), a3, voffA);
            PG8_BAR; PG8_WAIT_L(0); PG8_MMA(1, 0, At, B0); PG8_BAR; PG8_SCHED;
            PG8_STAGE(PG8_SB(1, 1), b3 + hstep, voffB);
            PG8_WAIT_V(6); PG8_BAR; PG8_MMA(1, 1, At, B1); PG8_BAR;
            }
        }
        if constexpr (ALIGN_EPI) { if (wr == 0) PG8_BAR; }
        if constexpr (!Epi::AFTER_DRAIN) { E(acc, cur, wr, wc, fr, fq); S.done(cur); }
        if (!has_next) break;
#pragma unroll
        for (int a = 0; a < 2; ++a)
#pragma unroll
            for (int b = 0; b < 2; ++b)
#pragma unroll
                for (int m = 0; m < 4; ++m)
#pragma unroll
                    for (int n = 0; n < 2; ++n) acc[a][b][m][n] = (f32x4){0.f, 0.f, 0.f, 0.f};
        cur = nxt; cA = nA; cB = nB; ++ui;
        if constexpr (ALIGN_EPI) { if (wr == 1) PG8_BAR; }
    }
    PG8_WAIT_V(0);
    if constexpr (!ALIGN_EPI) { if (wr == 0) PG8_BAR; }
    PG8_BAR;
    if constexpr (Epi::AFTER_DRAIN) { E.fused(acc, cur, wr, wc, fr, fq, lds, wid, lane); S.done(cur); }
#undef PG8_SA
#undef PG8_SB
#undef PG8_STAGE
#undef PG8_LDA
#undef PG8_LDB
#undef PG8_MMA
#undef PG8_WAIT_V
#undef PG8_WAIT_L
#undef PG8_BAR
#undef PG8_SCHED
}
}

constexpr bool PG_ALIGN = true, PG_SP2 = true;
__device__ __forceinline__ float bflo(unsigned w) { return __builtin_bit_cast(float, w << 16); }
__device__ __forceinline__ float bfhi(unsigned w) { return __builtin_bit_cast(float, w & 0xffff0000u); }
__device__ __forceinline__ unsigned cvtpk(float lo, float hi) { return pg8::cvt_pk_bf16(lo, hi); }

__device__ __forceinline__ void transpose_item(const float* W, int N, int k0, int n0, bf16* WT, int K, size_t dst_row0, LAS float* scr, int lane) {
    float v[32];
#pragma unroll
    for (int i = 0; i < 32; ++i) v[i] = W[(size_t)(k0 + 2 * i + (lane >> 5)) * N + n0 + (lane & 31)];
#pragma unroll
    for (int i = 0; i < 32; ++i) scr[(2 * i + (lane >> 5)) * 33 + (lane & 31)] = v[i];
    asm volatile("s_waitcnt lgkmcnt(0)" ::: "memory");
    const int c = lane & 7;
#pragma unroll
    for (int j = 0; j < 4; ++j) { const int n = (lane >> 3) + 8 * j; const LAS float* s = scr + (8 * c) * 33 + n;
        v4u o; o.x = pk2(s[0 * 33], s[1 * 33]); o.y = pk2(s[2 * 33], s[3 * 33]); o.z = pk2(s[4 * 33], s[5 * 33]); o.w = pk2(s[6 * 33], s[7 * 33]);
        *(v4u*)(WT + (dst_row0 + n) * K + k0 + 8 * c) = o; }
    asm volatile("s_waitcnt lgkmcnt(0)" ::: "memory");
}
__device__ __forceinline__ void convert_weights(Frame& F, int l) {
    LAS float* scr = (LAS float*)(F.lds + F.wave * 16384);
    const int gw = F.bid * (NT / 64) + F.wave, ngw = F.G * (NT / 64);
    constexpr int I_IN = 16 * 96, I_MG = 16 * 96, I_GLU = 8 * 16, I_BR = 3 * 8 * 32, I_O = 16 * 32, I_1 = 32 * 16 * 8, I_3 = I_1, I_2 = 32 * 4 * 32;
    constexpr int NITEMS = I_IN + I_MG + I_GLU + I_BR + I_O + I_1 + I_3 + I_2;
    for (int it = gw; it < NITEMS; it += ngw) {
        int r = it;
        if (r < I_IN) { const int kb = r / 96, nb = r % 96; transpose_item(IN_(I_WIN) + (size_t)l * D * INW, INW, 64 * kb, 32 * nb, (bf16*)(F.ws + WS_WIN), 1024, 32 * nb, scr, F.lane); continue; } r -= I_IN;
        if (r < I_MG) { const int kb = r / 96, nb = r % 96; transpose_item(IN_(I_WMG) + (size_t)l * D * INW, INW, 64 * kb, 32 * nb, (bf16*)(F.ws + WS_WMG), 1024, 32 * nb, scr, F.lane); continue; } r -= I_MG;
        if (r < I_GLU) { const int kb = r / 16, nb = r % 16; transpose_item(IN_(I_WGLU) + (size_t)l * MIXW * MIXW, MIXW, 64 * kb, 32 * nb, (bf16*)(F.ws + WS_WGLU), 512, 32 * nb, scr, F.lane); continue; } r -= I_GLU;
        if (r < I_BR) { const int kk = r / 256, q = r % 256, kb = q / 32, nb = q % 32; transpose_item(IN_(I_WBR) + ((size_t)l * 3 + kk) * MIXW * D, D, 64 * kb, 32 * nb, (bf16*)(F.ws + WS_WBR), 512, (size_t)kk * 1024 + 32 * nb, scr, F.lane); continue; } r -= I_BR;
        if (r < I_O) { const int kb = r / 32, nb = r % 32; transpose_item(IN_(I_WO) + (size_t)l * D * D, D, 64 * kb, 32 * nb, (bf16*)(F.ws + WS_WO), 1024, 32 * nb, scr, F.lane); continue; } r -= I_O;
        if (r < I_1 + I_3) { const int which = r / I_1, q = r % I_1, e = q / 128, q2 = q % 128, kb = q2 / 8, nb = q2 % 8;
            const float* W = IN_(which ? I_W3 : I_W1) + ((size_t)l * NE + e) * D * DFF; const int n0 = 32 * nb;
            transpose_item(W, DFF, 64 * kb, n0, (bf16*)(F.ws + WS_W13), 1024, (size_t)e * 512 + (n0 / 128) * 256 + which * 128 + (n0 % 128), scr, F.lane); continue; } r -= I_1 + I_3;
        { const int e = r / 128, q = r % 128, kb = q / 32, nb = q % 32; transpose_item(IN_(I_W2) + ((size_t)l * NE + e) * DFF * D, D, 64 * kb, 32 * nb, (bf16*)(F.ws + WS_W2), 256, (size_t)e * 1024 + 32 * nb, scr, F.lane); }
    }
    { bf16* wr = (bf16*)(F.ws + WS_WR); const float* wg = IN_(I_WGRP) + (size_t)l * D * 4; const float* we = IN_(I_WEXP) + (size_t)l * D * 32;
      for (int i = F.bid * NT + F.tid; i < 48 * 1024; i += F.G * NT) { const int n = i >> 10, kk = i & 1023; const float w = n < 4 ? wg[kk * 4 + n] : (n < 36 ? we[kk * 32 + n - 4] : 0.f);
          const unsigned hi = f2bf(w); const float lo = w - __builtin_bit_cast(float, hi << 16); wr[i] = (bf16)hi; wr[48 * 1024 + i] = (bf16)f2bf(lo); } }
    { const float* s = IN_(I_WSG) + (size_t)l * 4 * 128 * 128; bf16* d = (bf16*)(F.ws + WS_WSG);
      for (int i = (F.bid * NT + F.tid) * 2; i < 4 * 128 * 128; i += F.G * NT * 2) *(unsigned*)(d + i) = pk2(s[i], s[i + 1]); }
}

struct EpiProj { static constexpr bool PERM = true, AFTER_DRAIN = false; bf16* O;
    __device__ __forceinline__ void operator()(const pg8::f32x4 (&acc)[2][2][4][2], const pg8::Unit& u, int wr, int wc, int fr, int fq) const {
        const int row0 = u.pm * 256 + wr * 64 + fr, col0 = u.pn * 256 + wc * 32 + 8 * fq; const bool act = (u.pn >= 2 && u.pn < 6);
#pragma unroll
        for (int ai = 0; ai < 2; ++ai)
#pragma unroll
            for (int m = 0; m < 4; ++m) { bf16* rowp = O + (size_t)(row0 + ai * 128 + m * 16) * INW + col0;
#pragma unroll
                for (int bj = 0; bj < 2; ++bj) { pg8::f32x4 v0 = acc[ai][bj][m][0], v1 = acc[ai][bj][m][1];
                    if (act) {
#pragma unroll
                        for (int j = 0; j < 4; ++j) { v0[j] = geluf_(v0[j]); v1[j] = geluf_(v1[j]); } }
                    v4u w; w.x = cvtpk(v0[0], v0[1]); w.y = cvtpk(v0[2], v0[3]); w.z = cvtpk(v1[0], v1[1]); w.w = cvtpk(v1[2], v1[3]); *(v4u*)(rowp + bj * 128) = w; } }
    } };
struct EpiGlu { static constexpr bool PERM = true, AFTER_DRAIN = false; const bf16* YG; bf16* YA;
    __device__ __forceinline__ void operator()(const pg8::f32x4 (&acc)[2][2][4][2], const pg8::Unit& u, int wr, int wc, int fr, int fq) const {
        const int row0 = u.pm * 256 + wr * 64 + fr, col0 = u.pn * 256 + wc * 32 + 8 * fq;
#pragma unroll
        for (int ai = 0; ai < 2; ++ai)
#pragma unroll
            for (int m = 0; m < 4; ++m) { const size_t off = (size_t)(row0 + ai * 128 + m * 16) * MIXW + col0;
#pragma unroll
                for (int bj = 0; bj < 2; ++bj) { const pg8::f32x4 v0 = acc[ai][bj][m][0], v1 = acc[ai][bj][m][1]; const v4u g = *(const v4u*)(YG + off + bj * 128);
                    v4u w; w.x = cvtpk(bflo(g.x) * sigmoidf_(v0[0]), bfhi(g.x) * sigmoidf_(v0[1])); w.y = cvtpk(bflo(g.y) * sigmoidf_(v0[2]), bfhi(g.y) * sigmoidf_(v0[3]));
                    w.z = cvtpk(bflo(g.z) * sigmoidf_(v1[0]), bfhi(g.z) * sigmoidf_(v1[1])); w.w = cvtpk(bflo(g.w) * sigmoidf_(v1[2]), bfhi(g.w) * sigmoidf_(v1[3])); *(v4u*)(YA + off + bj * 128) = w; } }
    } };
struct EpiBr { static constexpr bool PERM = true, AFTER_DRAIN = false; bf16* BR;
    __device__ __forceinline__ void operator()(const pg8::f32x4 (&acc)[2][2][4][2], const pg8::Unit& u, int wr, int wc, int fr, int fq) const {
        const int pm = u.pm % (MT / 256); const int row0 = pm * 256 + wr * 64 + fr, col0 = u.pn * 256 + wc * 32 + 8 * fq;
#pragma unroll
        for (int ai = 0; ai < 2; ++ai)
#pragma unroll
            for (int m = 0; m < 4; ++m) { bf16* rowp = BR + (size_t)(row0 + ai * 128 + m * 16) * INW + col0;
#pragma unroll
                for (int bj = 0; bj < 2; ++bj) { const pg8::f32x4 v0 = acc[ai][bj][m][0], v1 = acc[ai][bj][m][1];
                    v4u w; w.x = cvtpk(v0[0], v0[1]); w.y = cvtpk(v0[2], v0[3]); w.z = cvtpk(v1[0], v1[1]); w.w = cvtpk(v1[2], v1[3]); *(v4u*)(rowp + bj * 128) = w; } }
    } };
struct SchedBr { int G, c, nM;
    __device__ __forceinline__ bool next(int i, pg8::Unit& u) const { const int Lq = i * G + c; if (Lq >= 3 * nM * 4) return false; const int k = Lq / (nM * 4), r = Lq % (nM * 4);
        u.pm = k * (MT / 256) + r / 4; u.pn = k * 4 + r % 4; return true; }
    __device__ __forceinline__ void a_ready(const pg8::Unit&) const {}
    __device__ __forceinline__ void done(const pg8::Unit&) const {} };
struct EpiMerge { static constexpr bool PERM = true, AFTER_DRAIN = false; const bf16* BR; bf16* PM; const float* bm;
    __device__ __forceinline__ void operator()(const pg8::f32x4 (&acc)[2][2][4][2], const pg8::Unit& u, int wr, int wc, int fr, int fq) const {
        const int k = u.pn >> 2, dt = u.pn & 3; const int row0 = u.pm * 256 + wr * 64 + fr, col0 = dt * 256 + wc * 32 + 8 * fq;
#pragma unroll
        for (int bj = 0; bj < 2; ++bj) { const pg8::f32x4 b0 = *(const pg8::f32x4*)(bm + k * 1024 + col0 + bj * 128), b1 = *(const pg8::f32x4*)(bm + k * 1024 + col0 + bj * 128 + 4);
#pragma unroll
            for (int ai = 0; ai < 2; ++ai)
#pragma unroll
                for (int m = 0; m < 4; ++m) { const size_t r = (size_t)(row0 + ai * 128 + m * 16); const v4u br = *(const v4u*)(BR + r * INW + k * 1024 + col0 + bj * 128);
                    const pg8::f32x4 v0 = acc[ai][bj][m][0] + b0, v1 = acc[ai][bj][m][1] + b1;
                    float p[8] = {sigmoidf_(v0[0]) * bflo(br.x), sigmoidf_(v0[1]) * bfhi(br.x), sigmoidf_(v0[2]) * bflo(br.y), sigmoidf_(v0[3]) * bfhi(br.y),
                                  sigmoidf_(v1[0]) * bflo(br.z), sigmoidf_(v1[1]) * bfhi(br.z), sigmoidf_(v1[2]) * bflo(br.w), sigmoidf_(v1[3]) * bfhi(br.w)};
                    bf16* dst = PM + r * D + col0 + bj * 128;
                    if (k > 0) { const v4u o = *(const v4u*)dst; p[0] += bflo(o.x); p[1] += bfhi(o.x); p[2] += bflo(o.y); p[3] += bfhi(o.y); p[4] += bflo(o.z); p[5] += bfhi(o.z); p[6] += bflo(o.w); p[7] += bfhi(o.w); }
                    v4u w; w.x = cvtpk(p[0], p[1]); w.y = cvtpk(p[2], p[3]); w.z = cvtpk(p[4], p[5]); w.w = cvtpk(p[6], p[7]); *(v4u*)dst = w; } }
    } };
struct SchedMerge { int G, c, nM;
    __device__ __forceinline__ bool next(int i, pg8::Unit& u) const { const int v = (i / 3) * G + c, k = i % 3; if (v >= nM * 4) return false; u.pm = v >> 2; u.pn = k * 4 + (v & 3); return true; }
    __device__ __forceinline__ void a_ready(const pg8::Unit&) const {}
    __device__ __forceinline__ void done(const pg8::Unit&) const {} };
struct EpiWo { static constexpr bool PERM = false, AFTER_DRAIN = false; const float* xs_lat; const float* xs_ctx; float* out; float* xc; const float* mod_l;
    __device__ __forceinline__ void operator()(const pg8::f32x4 (&acc)[2][2][4][2], const pg8::Unit& u, int wr, int wc, int fr, int fq) const {
        const int row0 = u.pm * 256 + wr * 64 + fr, col0 = u.pn * 256 + wc * 32 + 4 * fq; const bool isctx = u.pm >= SEQ / 256;
        const float* ga = mod_l + (isctx ? 6144 : 0) + 2048;
#pragma unroll
        for (int ai = 0; ai < 2; ++ai)
#pragma unroll
            for (int m = 0; m < 4; ++m) { const int row = row0 + ai * 128 + m * 16; const size_t off = (size_t)(isctx ? row - SEQ : row) * D + col0;
                const float* src = (isctx ? xs_ctx : xs_lat) + off; float* dst = (isctx ? xc : out) + off;
#pragma unroll
                for (int bj = 0; bj < 2; ++bj)
#pragma unroll
                    for (int n = 0; n < 2; ++n) { const pg8::f32x4 g = *(const pg8::f32x4*)(ga + col0 + bj * 128 + n * 16); const pg8::f32x4 x = *(const pg8::f32x4*)(src + bj * 128 + n * 16);
                        *(pg8::f32x4*)(dst + bj * 128 + n * 16) = x + g * acc[ai][bj][m][n]; } }
    } };
constexpr int MOETAB_OFF = 131072 + 2048;
template <int NPN> __device__ __forceinline__ int moe_build_table(Frame& F, const unsigned* cnt) {
    LAS unsigned* tabw = (LAS unsigned*)(F.lds + MOETAB_OFF);
    int total = 0, rowtile0 = 0;
    for (int e = 0; e < NE; ++e) { const int nt_e = ((int)cnt[e] + 255) >> 8;
        for (int q = F.tid; q < nt_e * NPN; q += NT) tabw[total + q] = ((unsigned)(rowtile0 + q / NPN) << 16) | (unsigned)(e * NPN + q % NPN);
        total += nt_e * NPN; rowtile0 += nt_e; }
    __syncthreads();
    return total;
}
struct SchedMoe { int G, c, total; const LAS unsigned* tabw;
    __device__ __forceinline__ bool next(int i, pg8::Unit& u) const { const int Lq = i * G + c; if (Lq >= total) return false; const unsigned w = (unsigned)__builtin_amdgcn_readfirstlane((int)tabw[Lq]); u.pm = (int)(w >> 16); u.pn = (int)(w & 0xffffu); return true; }
    __device__ __forceinline__ void a_ready(const pg8::Unit&) const {}
    __device__ __forceinline__ void done(const pg8::Unit&) const {} };
struct EpiUp { static constexpr bool PERM = true, AFTER_DRAIN = false; bf16* ACT; const float* SW;
    __device__ __forceinline__ void operator()(const pg8::f32x4 (&acc)[2][2][4][2], const pg8::Unit& u, int wr, int wc, int fr, int fq) const {
        const int row0 = u.pm * 256 + wr * 64 + fr, f0 = (u.pn & 1) * 128 + wc * 32 + 8 * fq;
#pragma unroll
        for (int ai = 0; ai < 2; ++ai)
#pragma unroll
            for (int m = 0; m < 4; ++m) { const int slot = row0 + ai * 128 + m * 16; const float w = SW[slot];
                const pg8::f32x4 a0 = acc[ai][0][m][0], a1 = acc[ai][0][m][1], b0 = acc[ai][1][m][0], b1 = acc[ai][1][m][1];
                v4u o; o.x = cvtpk(siluf_(a0[0]) * b0[0] * w, siluf_(a0[1]) * b0[1] * w); o.y = cvtpk(siluf_(a0[2]) * b0[2] * w, siluf_(a0[3]) * b0[3] * w);
                o.z = cvtpk(siluf_(a1[0]) * b1[0] * w, siluf_(a1[1]) * b1[1] * w); o.w = cvtpk(siluf_(a1[2]) * b1[2] * w, siluf_(a1[3]) * b1[3] * w);
                *(v4u*)(ACT + (size_t)slot * DFF + f0) = o; }
    } };
struct EpiDown { static constexpr bool PERM = true, AFTER_DRAIN = false; bf16* YS2;
    __device__ __forceinline__ void operator()(const pg8::f32x4 (&acc)[2][2][4][2], const pg8::Unit& u, int wr, int wc, int fr, int fq) const {
        const int row0 = u.pm * 256 + wr * 64 + fr, col0 = (u.pn & 3) * 256 + wc * 32 + 8 * fq;
#pragma unroll
        for (int ai = 0; ai < 2; ++ai)
#pragma unroll
            for (int m = 0; m < 4; ++m) { bf16* rowp = YS2 + (size_t)(row0 + ai * 128 + m * 16) * D + col0;
#pragma unroll
                for (int bj = 0; bj < 2; ++bj) { const pg8::f32x4 v0 = acc[ai][bj][m][0], v1 = acc[ai][bj][m][1];
                    v4u w; w.x = cvtpk(v0[0], v0[1]); w.y = cvtpk(v0[2], v0[3]); w.z = cvtpk(v1[0], v1[1]); w.w = cvtpk(v1[2], v1[3]); *(v4u*)(rowp + bj * 128) = w; } }
    } };

__device__ __forceinline__ void ph2_fast(Frame& F, int l) {
    pg8::Gemm g{(const bf16*)(F.ws + WS_H), (const bf16*)(F.ws + WS_WIN), MT, INW, D}; pg8::StaticOrder S; S.init(MT, INW, F.G, F.bid);
    EpiProj E{(bf16*)(F.ws + WS_PROJ)}; pg8::gemm_phase<EpiProj, pg8::StaticOrder, PG_ALIGN, PG_SP2>(F.lds, g, S, E, F.tid);
}
__device__ __forceinline__ void ph6_fast(Frame& F, int l) {
    pg8::Gemm g{(const bf16*)(F.ws + WS_YG), (const bf16*)(F.ws + WS_WGLU), MT, MIXW, MIXW}; pg8::StaticOrder S; S.init(l == 0 ? MT : SEQ, MIXW, F.G, F.bid);
    EpiGlu E{(const bf16*)(F.ws + WS_YG), (bf16*)(F.ws + WS_YS)}; pg8::gemm_phase<EpiGlu, pg8::StaticOrder, PG_ALIGN, PG_SP2>(F.lds, g, S, E, F.tid);
}
__device__ __forceinline__ void ph7_fast(Frame& F, int l) {
    pg8::Gemm g{(const bf16*)(F.ws + WS_YS), (const bf16*)(F.ws + WS_WBR), 3 * MT, 3 * D, MIXW}; SchedBr S{F.G, F.bid, l == 0 ? MT / 256 : SEQ / 256};
    EpiBr E{(bf16*)(F.ws + WS_PROJ)}; pg8::gemm_phase<EpiBr, SchedBr, PG_ALIGN, PG_SP2>(F.lds, g, S, E, F.tid);
}
__device__ __forceinline__ void ph8_fast(Frame& F, int l) {
    pg8::Gemm g{(const bf16*)(F.ws + WS_H), (const bf16*)(F.ws + WS_WMG), MT, INW, D}; SchedMerge S{F.G, F.bid, l == 0 ? MT / 256 : SEQ / 256};
    EpiMerge E{(const bf16*)(F.ws + WS_PROJ), (bf16*)(F.ws + WS_PM), IN_(I_BMG) + l * INW}; pg8::gemm_phase<EpiMerge, SchedMerge, PG_ALIGN, PG_SP2>(F.lds, g, S, E, F.tid);
}
__device__ __forceinline__ void ph9_fast(Frame& F, int l) {
    pg8::Gemm g{(const bf16*)(F.ws + WS_PM), (const bf16*)(F.ws + WS_WO), MT, D, D}; pg8::StaticOrder S; S.init(l == 0 ? MT : SEQ, D, F.G, F.bid);
    EpiWo E{l == 0 ? IN_(I_X) : F.out, l == 0 ? IN_(I_CTX) : (const float*)(F.ws + WS_XC), F.out, (float*)(F.ws + WS_XC), (const float*)(F.ws + WS_MOD) + (size_t)l * 2 * 6144};
    pg8::gemm_phase<EpiWo, pg8::StaticOrder, PG_ALIGN, PG_SP2>(F.lds, g, S, E, F.tid);
}
__device__ __forceinline__ void ph12_fast(Frame& F, int l) {
    pg8::Gemm g{(const bf16*)(F.ws + WS_HS), (const bf16*)(F.ws + WS_W13), MAXSLOT, NE * 512, D}; const int total = moe_build_table<2>(F, F.ctl + CW_CNT + l * 128); SchedMoe S{F.G, F.bid, total, (const LAS unsigned*)(F.lds + MOETAB_OFF)};
    EpiUp E{(bf16*)(F.ws + WS_ACT), (const float*)(F.ws + WS_SW)}; pg8::gemm_phase<EpiUp, SchedMoe, PG_ALIGN, PG_SP2>(F.lds, g, S, E, F.tid);
}
__device__ __forceinline__ void ph13_fast(Frame& F, int l) {
    pg8::Gemm g{(const bf16*)(F.ws + WS_ACT), (const bf16*)(F.ws + WS_W2), MAXSLOT, NE * D, DFF}; const int total = moe_build_table<4>(F, F.ctl + CW_CNT + l * 128); SchedMoe S{F.G, F.bid, total, (const LAS unsigned*)(F.lds + MOETAB_OFF)};
    EpiDown E{(bf16*)(F.ws + WS_YS2)}; pg8::gemm_phase<EpiDown, SchedMoe, PG_ALIGN, PG_SP2>(F.lds, g, S, E, F.tid);
}


typedef short bf16x8 __attribute__((ext_vector_type(8)));
constexpr int NSB = MT / 16;
__device__ __forceinline__ void s5_precompute(Frame& F) {
    LAS float* APr = (LAS float*)F.lds; LAS float* APi = APr + 2176; LAS float* BBr = APi + 2176; LAS float* BBi = BBr + 2048; LAS float* CCr = BBi + 2048; LAS float* CCi = CCr + 2048; LAS float* KK = CCi + 2048;
    for (int item = F.bid; item < 2 * G5; item += F.G) { const int l = item >> 5, g = item & 31;
        __syncthreads();
        if (F.tid < 128) { const int d = F.tid >> 6, p = F.tid & 63; const int ldg = (l * 2 + d) * G5 + g;
            const double lr = IN_(I_LRE)[ldg * P5 + p], li = IN_(I_LIM)[ldg * P5 + p], dt = exp((double)IN_(I_LDT)[ldg]);
            for (int e = 0; e <= 16; ++e) { const double m = exp(lr * dt * e), ang = li * dt * e; APr[(d * 64 + p) * 17 + e] = (float)(m * cos(ang)); APi[(d * 64 + p) * 17 + e] = (float)(m * sin(ang)); }
            { const double m16 = exp(lr * dt * 16.0), a16 = li * dt * 16.0; float* A16 = (float*)(F.ws + WS_A16) + ((size_t)((l * 32 + g) * 2 + d) * 64 + p) * 2; A16[0] = (float)(m16 * cos(a16)); A16[1] = (float)(m16 * sin(a16)); }
            const double m1 = exp(lr * dt), ar = m1 * cos(li * dt), ai = m1 * sin(li * dt); const double nr = ar - 1.0, ni = ai, den = lr * lr + li * li;
            const double qr = (nr * lr + ni * li) / den, qi = (ni * lr - nr * li) / den;
            for (int h = 0; h < 16; ++h) { const double x = IN_(I_BRE)[((size_t)ldg * P5 + p) * H5 + h], y = IN_(I_BIM)[((size_t)ldg * P5 + p) * H5 + h];
                BBr[(d * 64 + p) * 16 + h] = (float)(qr * x - qi * y); BBi[(d * 64 + p) * 16 + h] = (float)(qr * y + qi * x);
                CCr[(d * 16 + h) * 64 + p] = IN_(I_CRE)[((size_t)ldg * H5 + h) * P5 + p]; CCi[(d * 16 + h) * 64 + p] = IN_(I_CIM)[((size_t)ldg * H5 + h) * P5 + p]; } }
        __syncthreads();
        for (int idx = F.tid; idx < 8192; idx += NT) { const int d = idx >> 12, e = (idx >> 8) & 15, h = (idx >> 4) & 15, hp = idx & 15; float a = 0.f;
            for (int p = 0; p < 64; ++p) { const float pr = APr[(d * 64 + p) * 17 + e], pi = APi[(d * 64 + p) * 17 + e], br = BBr[(d * 64 + p) * 16 + hp], bi = BBi[(d * 64 + p) * 16 + hp];
                const float wr = pr * br - pi * bi, wi = pr * bi + pi * br; a += CCr[(d * 16 + h) * 64 + p] * wr - CCi[(d * 16 + h) * 64 + p] * wi; }
            KK[idx] = a; }
        __syncthreads();
        bf16* M = (bf16*)(F.ws + WS_S5M) + (size_t)(l * 32 + g) * 3 * 65536;
        for (int idx = F.tid; idx < 32768; idx += NT) {
            const int r = idx >> 7, k0 = (idx & 127) * 2; float v[3][2];
#pragma unroll
            for (int q = 0; q < 2; ++q) { const int kk = k0 + q;
                { const int d = r >> 7, p = (r >> 1) & 63, c = r & 1, sg = kk >> 4, hp = kk & 15, e = d == 0 ? 15 - sg : sg;
                  const float pr = APr[(d * 64 + p) * 17 + e], pi = APi[(d * 64 + p) * 17 + e], br = BBr[(d * 64 + p) * 16 + hp], bi = BBi[(d * 64 + p) * 16 + hp];
                  v[0][q] = c == 0 ? pr * br - pi * bi : pr * bi + pi * br; }
                { const int tau = r >> 4, h = r & 15, sg = kk >> 4, hp = kk & 15; float t = 0.f;
                  if (sg <= tau) t += KK[(0 * 16 + (tau - sg)) * 256 + h * 16 + hp]; if (sg >= tau) t += KK[(1 * 16 + (sg - tau)) * 256 + h * 16 + hp]; v[1][q] = t; }
                { const int tau = r >> 4, h = r & 15, d = kk >> 7, p = (kk >> 1) & 63, c = kk & 1, e = d == 0 ? tau + 1 : 16 - tau;
                  const float cr = CCr[(d * 16 + h) * 64 + p], ci = CCi[(d * 16 + h) * 64 + p], pr = APr[(d * 64 + p) * 17 + e], pi = APi[(d * 64 + p) * 17 + e];
                  v[2][q] = c == 0 ? cr * pr - ci * pi : -(cr * pi + ci * pr); } }
#pragma unroll
            for (int m = 0; m < 3; ++m) *(unsigned*)(M + (size_t)m * 65536 + r * 256 + k0) = pk2(v[m][0], v[m][1]);
        }
    }
}
__device__ __forceinline__ void s5_z_phase(Frame& F, int l) {
    const bf16* PROJ = (const bf16*)(F.ws + WS_PROJ); float* Z = (float*)(F.ws + WS_Z);
    const int l15 = F.lane & 15, lq = F.lane >> 4;
    for (int item = F.bid; item < 256; item += F.G) {
        const int g = item >> 3, part = item & 7; const bf16* Fm = (const bf16*)(F.ws + WS_S5M) + (size_t)(l * 32 + g) * 3 * 65536;
        bf16x8 Af[2][8];
#pragma unroll
        for (int j = 0; j < 2; ++j)
#pragma unroll
            for (int ks = 0; ks < 8; ++ks) Af[j][ks] = *(const bf16x8*)(Fm + (size_t)(16 * (2 * F.wave + j) + l15) * 256 + 32 * ks + 8 * lq);
#pragma unroll 1
        for (int tl = part; tl < MT / 256; tl += 8) {
            bf16x8 V[8];
#pragma unroll
            for (int ks = 0; ks < 8; ++ks) V[ks] = *(const bf16x8*)(PROJ + (size_t)(tl * 256 + 16 * l15 + 2 * ks + (lq >> 1)) * INW + 16 * g + 8 * (lq & 1));
            f32x4 acc[2] = {{0.f, 0.f, 0.f, 0.f}, {0.f, 0.f, 0.f, 0.f}};
#pragma unroll
            for (int ks = 0; ks < 8; ++ks)
#pragma unroll
                for (int j = 0; j < 2; ++j) acc[j] = __builtin_amdgcn_mfma_f32_16x16x32_bf16(Af[j][ks], V[ks], acc[j], 0, 0, 0);
#pragma unroll
            for (int j = 0; j < 2; ++j) *(f32x4*)(Z + ((size_t)(tl * 16 + l15) * 32 + g) * 256 + 16 * (2 * F.wave + j) + 4 * lq) = acc[j];
        }
    }
}
__device__ __forceinline__ int s5_chain_sb(int d, int i) { return d == 0 ? (i < 16 ? 1024 + i : i - 16) : (i < 16 ? 1039 - i : 1023 - (i - 16)); }
__device__ __forceinline__ void s5_scan_phase(Frame& F, int l) {
    LAS float* EX = (LAS float*)F.lds;
    for (int item = F.bid; item < 256; item += F.G) {
        const int cid = item * 16 + (F.tid & 15), j = F.tid >> 4;
        const int g = cid >> 7, d = (cid >> 6) & 1, p = cid & 63;
        const float* A16 = (const float*)(F.ws + WS_A16) + ((size_t)((l * 32 + g) * 2 + d) * 64 + p) * 2; const float ar = A16[0], ai = A16[1];
        const float* Z = (const float*)(F.ws + WS_Z) + (size_t)g * 256 + d * 128 + 2 * p; bf16* SS = (bf16*)(F.ws + WS_SS) + (size_t)g * 256 + d * 128 + 2 * p;
        float2 z[33];
#pragma unroll
        for (int q = 0; q < 33; ++q) { const int i = 33 * j + q; z[q] = i < NSB ? *(const float2*)(Z + (size_t)s5_chain_sb(d, i) * 8192) : make_float2(0.f, 0.f); }
        float hr = 0.f, hi = 0.f, pr = 1.f, pi = 0.f;
#pragma unroll
        for (int q = 0; q < 33; ++q) { if (33 * j + q < NSB) { const float nr = ar * hr - ai * hi + z[q].x, ni = ar * hi + ai * hr + z[q].y; hr = nr; hi = ni; const float qr = pr * ar - pi * ai, qi = pr * ai + pi * ar; pr = qr; pi = qi; } }
        __syncthreads();
        EX[(j * 16 + (F.tid & 15)) * 4 + 0] = hr; EX[(j * 16 + (F.tid & 15)) * 4 + 1] = hi; EX[(j * 16 + (F.tid & 15)) * 4 + 2] = pr; EX[(j * 16 + (F.tid & 15)) * 4 + 3] = pi;
        __syncthreads();
        float cr = 0.f, ci = 0.f;
        for (int i = 0; i < j; ++i) { const float er = EX[(i * 16 + (F.tid & 15)) * 4 + 0], ei = EX[(i * 16 + (F.tid & 15)) * 4 + 1], qr = EX[(i * 16 + (F.tid & 15)) * 4 + 2], qi = EX[(i * 16 + (F.tid & 15)) * 4 + 3];
            const float nr = qr * cr - qi * ci + er, ni = qr * ci + qi * cr + ei; cr = nr; ci = ni; }
        hr = cr; hi = ci;
#pragma unroll
        for (int q = 0; q < 33; ++q) { const int i = 33 * j + q; if (i < NSB) { *(unsigned*)(SS + (size_t)s5_chain_sb(d, i) * 8192) = pk2(hr, hi);
            const float nr = ar * hr - ai * hi + z[q].x, ni = ar * hi + ai * hr + z[q].y; hr = nr; hi = ni; } }
    }
}
__device__ __forceinline__ void s5_y_phase(Frame& F, int l) {
    const bf16* PROJ = (const bf16*)(F.ws + WS_PROJ); const bf16* SS = (const bf16*)(F.ws + WS_SS); bf16* YG = (bf16*)(F.ws + WS_YG); const float* ds = IN_(I_DSKIP) + l * MIXW;
    const int l15 = F.lane & 15, lq = F.lane >> 4;
    for (int item = F.bid; item < 256; item += F.G) {
        const int g = item >> 3, part = item & 7; const bf16* Tm = (const bf16*)(F.ws + WS_S5M) + ((size_t)(l * 32 + g) * 3 + 1) * 65536; const bf16* Em = Tm + 65536;
        bf16x8 At[2][8], Ae[2][8];
#pragma unroll
        for (int j = 0; j < 2; ++j)
#pragma unroll
            for (int ks = 0; ks < 8; ++ks) { const size_t o = (size_t)(16 * (2 * F.wave + j) + l15) * 256 + 32 * ks + 8 * lq; At[j][ks] = *(const bf16x8*)(Tm + o); Ae[j][ks] = *(const bf16x8*)(Em + o); }
        const f32x4 dsk = *(const f32x4*)(ds + 16 * g + 4 * lq);
        const int ntl = l == 0 ? MT / 256 : SEQ / 256;
#pragma unroll 1
        for (int tl = part; tl < ntl; tl += 8) {
            bf16x8 V[8], S[8];
#pragma unroll
            for (int ks = 0; ks < 8; ++ks) { V[ks] = *(const bf16x8*)(PROJ + (size_t)(tl * 256 + 16 * l15 + 2 * ks + (lq >> 1)) * INW + 16 * g + 8 * (lq & 1));
                S[ks] = *(const bf16x8*)(SS + ((size_t)(tl * 16 + l15) * 32 + g) * 256 + 32 * ks + 8 * lq); }
            f32x4 acc[2] = {{0.f, 0.f, 0.f, 0.f}, {0.f, 0.f, 0.f, 0.f}};
#pragma unroll
            for (int ks = 0; ks < 8; ++ks)
#pragma unroll
                for (int j = 0; j < 2; ++j) { acc[j] = __builtin_amdgcn_mfma_f32_16x16x32_bf16(At[j][ks], V[ks], acc[j], 0, 0, 0); acc[j] = __builtin_amdgcn_mfma_f32_16x16x32_bf16(Ae[j][ks], S[ks], acc[j], 0, 0, 0); }
#pragma unroll
            for (int j = 0; j < 2; ++j) { const size_t row = (size_t)tl * 256 + 16 * l15 + (2 * F.wave + j); const int ch = 16 * g + 4 * lq;
                const v2u u = *(const v2u*)(PROJ + row * INW + ch);
                const float y0 = acc[j][0] + dsk[0] * bflo(u.x), y1 = acc[j][1] + dsk[1] * bfhi(u.x), y2 = acc[j][2] + dsk[2] * bflo(u.y), y3 = acc[j][3] + dsk[3] * bfhi(u.y);
                v2u w; w.x = cvtpk(geluf_(y0), geluf_(y1)); w.y = cvtpk(geluf_(y2), geluf_(y3)); *(v2u*)(YG + row * MIXW + ch) = w; }
        }
    }
}


constexpr int SG_STRIDE = 272, SG_IMG = 256 * SG_STRIDE, SG_STAT = SG_IMG;
__device__ __forceinline__ void sg_fast_chunk(Frame& F, int l, int chunk) {
    const bf16* PROJ = (const bf16*)(F.ws + WS_PROJ); bf16* YB = (bf16*)(F.ws + WS_YS) + (size_t)MT * MIXW; const bf16* WSG = (const bf16*)(F.ws + WS_WSG);
    const float* lg = IN_(I_SGG) + l * MIXW; const float* lb = IN_(I_SGB) + l * MIXW; const float* bsg = IN_(I_BSG) + l * 512;
    LAS float* st = (LAS float*)(F.lds + SG_STAT);
    __syncthreads();
    {
        const int p = F.tid >> 2, part = F.tid & 3; const bf16* vr = PROJ + (size_t)(chunk * 128 + p) * INW + 1024 + part * 128; float s = 0.f, q = 0.f;
#pragma unroll 4
        for (int c = 0; c < 128; c += 8) { const v4u w = *(const v4u*)(vr + c); const float x[8] = {bflo(w.x), bfhi(w.x), bflo(w.y), bfhi(w.y), bflo(w.z), bfhi(w.z), bflo(w.w), bfhi(w.w)};
#pragma unroll
            for (int i = 0; i < 8; ++i) { s += x[i]; q += x[i] * x[i]; } }
        s += __shfl_xor(s, 1); q += __shfl_xor(q, 1); s += __shfl_xor(s, 2); q += __shfl_xor(q, 2);
        const float mu = s * (1.f / 512.f), var = fmaxf(q * (1.f / 512.f) - mu * mu, 0.f);
        if (part == 0) { st[p * 2] = mu; st[p * 2 + 1] = rsqrtf(var + EPS); }
    }
    const int l15 = F.lane & 15, lq = F.lane >> 4;
#pragma unroll 1
    for (int pass = 0; pass < 2; ++pass) {
        __syncthreads();
#pragma unroll 1
        for (int it = F.tid; it < 2048; it += NT) { const int tp = it & 63, cg = it >> 6; const int p0 = tp * 2, ch = pass * 256 + cg * 8;
            const v4u w0 = *(const v4u*)(PROJ + (size_t)(chunk * 128 + p0) * INW + 1024 + ch), w1 = *(const v4u*)(PROJ + (size_t)(chunk * 128 + p0 + 1) * INW + 1024 + ch);
            const float mu0 = st[p0 * 2], rs0 = st[p0 * 2 + 1], mu1 = st[p0 * 2 + 2], rs1 = st[p0 * 2 + 3];
            const float x0[8] = {bflo(w0.x), bfhi(w0.x), bflo(w0.y), bfhi(w0.y), bflo(w0.z), bfhi(w0.z), bflo(w0.w), bfhi(w0.w)};
            const float x1[8] = {bflo(w1.x), bfhi(w1.x), bflo(w1.y), bfhi(w1.y), bflo(w1.z), bfhi(w1.z), bflo(w1.w), bfhi(w1.w)};
#pragma unroll
            for (int i = 0; i < 8; ++i) { const float gm = lg[ch + i], bt = lb[ch + i];
                *(LAS unsigned*)(F.lds + (cg * 8 + i) * SG_STRIDE + p0 * 2) = pk2((x0[i] - mu0) * rs0 * gm + bt, (x1[i] - mu1) * rs1 * gm + bt); } }
        __syncthreads();
        const int ggl = F.wave >> 2, gg = pass * 2 + ggl, rb0 = (F.wave & 3) * 2;
        bf16x8 A[2][4];
#pragma unroll
        for (int j = 0; j < 2; ++j)
#pragma unroll
            for (int ks = 0; ks < 4; ++ks) A[j][ks] = *(const LAS bf16x8*)(F.lds + (ggl * 128 + (rb0 + j) * 16 + l15) * SG_STRIDE + (32 * ks + 8 * lq) * 2);
        f32x4 acc[2][8];
#pragma unroll
        for (int j = 0; j < 2; ++j)
#pragma unroll
            for (int cb = 0; cb < 8; ++cb) acc[j][cb] = (f32x4){0.f, 0.f, 0.f, 0.f};
#pragma unroll
        for (int cb = 0; cb < 8; ++cb) {
            bf16x8 B[4];
#pragma unroll
            for (int ks = 0; ks < 4; ++ks) B[ks] = *(const bf16x8*)(WSG + ((size_t)gg * 128 + cb * 16 + l15) * 128 + 32 * ks + 8 * lq);
#pragma unroll
            for (int ks = 0; ks < 4; ++ks)
#pragma unroll
                for (int j = 0; j < 2; ++j) acc[j][cb] = __builtin_amdgcn_mfma_f32_16x16x32_bf16(A[j][ks], B[ks], acc[j][cb], 0, 0, 0);
        }
#pragma unroll
        for (int cb = 0; cb < 8; ++cb) { const int q = cb * 16 + l15; const size_t row = (size_t)chunk * 128 + q; const float bq = bsg[gg * 128 + q];
#pragma unroll
            for (int j = 0; j < 2; ++j) { const int col = gg * 128 + (rb0 + j) * 16 + 4 * lq; const v2u gu = *(const v2u*)(PROJ + row * INW + 512 + col);
                v2u w; w.x = cvtpk(bflo(gu.x) * (acc[j][cb][0] + bq), bfhi(gu.x) * (acc[j][cb][1] + bq)); w.y = cvtpk(bflo(gu.y) * (acc[j][cb][2] + bq), bfhi(gu.y) * (acc[j][cb][3] + bq));
                *(v2u*)(YB + row * MIXW + col) = w; } }
    }
}

struct NSmem { float As[16][68]; float Bs[16][68]; };
template <class AF>
__device__ __forceinline__ void ngemm_acc(float (&acc)[4][4], const AF& af, const float* B, int ldb, int K, LAS NSmem* s, int t) {
    const int ty = t >> 4, tx = t & 15, lr = t >> 2, lk = (t & 3) * 4, bk = t >> 4, bn = (t & 15) * 4;
    for (int k0 = 0; k0 < K; k0 += 16) {
        const float4 av = af.load4(lr, k0 + lk);
        const float4 bv = *(const float4*)(B + (size_t)(k0 + bk) * ldb + bn);
        __syncthreads();
        s->As[lk + 0][lr] = av.x; s->As[lk + 1][lr] = av.y; s->As[lk + 2][lr] = av.z; s->As[lk + 3][lr] = av.w;
        *(LAS f32x4*)&s->Bs[bk][bn] = (f32x4){bv.x, bv.y, bv.z, bv.w};
        __syncthreads();
#pragma unroll
        for (int k = 0; k < 16; ++k) {
            const f32x4 a = *(const LAS f32x4*)&s->As[k][ty * 4]; const f32x4 b = *(const LAS f32x4*)&s->Bs[k][tx * 4];
            const float aa[4] = {a.x, a.y, a.z, a.w}, bb[4] = {b.x, b.y, b.z, b.w};
#pragma unroll
            for (int i = 0; i < 4; ++i)
#pragma unroll
                for (int j = 0; j < 4; ++j) acc[i][j] += aa[i] * bb[j];
        }
    }
}
struct ABf { const bf16* A; int lda; __device__ __forceinline__ float4 load4(int r, int k) const { const v2u w = *(const v2u*)(A + (size_t)r * lda + k);
    return make_float4(bf2f((unsigned short)(w.x & 0xffff)), bf2f((unsigned short)(w.x >> 16)), bf2f((unsigned short)(w.y & 0xffff)), bf2f((unsigned short)(w.y >> 16))); } };
#define NTILE_BEGIN(ntiles) { const int _half = F.tid >> 8, t = F.tid & 255, ty = t >> 4, tx = t & 15; LAS NSmem* sm = (LAS NSmem*)F.lds + _half; (void)ty; (void)tx; \
    const int _nt = (ntiles), _nit = (_nt + 2 * F.G - 1) / (2 * F.G); \
    for (int _it = 0; _it < _nit; ++_it) { int T = (_it * F.G + F.bid) * 2 + _half; const bool valid = T < _nt; if (!valid) T = _nt - 1;
#define NTILE_END } }

__device__ __forceinline__ void ph0_prologue(Frame& F) {
    float* mod = (float*)(F.ws + WS_MOD);
    LAS float* SV = (LAS float*)(F.lds + 131072 + 4096);
    for (int i = F.tid; i < 2048; i += NT) SV[i] = siluf_(i < 1024 ? IN_(I_C)[i] : IN_(I_CCTX)[i - 1024]);
    __syncthreads();
    LAS float* RED = (LAS float*)(F.lds + 131072 + 4096 + 8192);
    for (int it = F.bid; it < 2 * 96; it += F.G) { const int l = it / 96, j = (it % 96) * 64 + F.lane;
        const float* W = IN_(I_WADA) + (size_t)l * D * 6144 + j + (size_t)(F.wave * 128) * 6144;
        float a0 = 0.f, a1 = 0.f;
#pragma unroll 32
        for (int kk = 0; kk < 128; ++kk) { const float w = W[(size_t)kk * 6144]; a0 += SV[F.wave * 128 + kk] * w; a1 += SV[1024 + F.wave * 128 + kk] * w; }
        __syncthreads();
        RED[(F.wave * 2 + 0) * 64 + F.lane] = a0; RED[(F.wave * 2 + 1) * 64 + F.lane] = a1;
        __syncthreads();
        if (F.wave < 2) { float s = 0.f;
#pragma unroll
            for (int w8 = 0; w8 < 8; ++w8) s += RED[(w8 * 2 + F.wave) * 64 + F.lane];
            mod[(size_t)(l * 2 + F.wave) * 6144 + j] = s + IN_(I_BADA)[l * 6144 + j]; }
    }
}
__device__ __forceinline__ void hprep_rows(Frame& F, int l) {
    bf16* H = (bf16*)(F.ws + WS_H); const float* g = IN_(I_GMIX) + l * D;
    const int gw = F.bid * (NT / 64) + F.wave, ngw = F.G * (NT / 64);
    for (int row = gw; row < MT; row += ngw) {
        const float* m = mod_ptr(F, l, row); const float* xr = xsrc_row(F, l, row);
        f32x4 v[4]; float s = 0.f;
#pragma unroll
        for (int j = 0; j < 4; ++j) { v[j] = *(const f32x4*)(xr + 4 * F.lane + 256 * j); s += v[j].x * v[j].x + v[j].y * v[j].y + v[j].z * v[j].z + v[j].w * v[j].w; }
        const float rstd = rsqrtf(wave_sum(s) * (1.f / D) + EPS);
#pragma unroll
        for (int j = 0; j < 4; ++j) { const int c = 4 * F.lane + 256 * j; const f32x4 gg = *(const f32x4*)(g + c), sc = *(const f32x4*)(m + 1024 + c), sh = *(const f32x4*)(m + c);
            const f32x4 o = v[j] * rstd * gg * (1.f + sc) + sh; v2u w; w.x = pk2(o.x, o.y); w.y = pk2(o.z, o.w); *(v2u*)(H + (size_t)row * D + c) = w; }
    }
}
__device__ __forceinline__ void ph2_naive(Frame& F, int l) {
    const bf16* H = (const bf16*)(F.ws + WS_H); bf16* PROJ = (bf16*)(F.ws + WS_PROJ); const float* W = IN_(I_WIN) + (size_t)l * D * INW;
    NTILE_BEGIN((MT / 64) * (INW / 64))
        const int m0 = (T / (INW / 64)) * 64, n0 = (T % (INW / 64)) * 64;
        float acc[4][4] = {};
        ngemm_acc(acc, ABf{H + (size_t)m0 * D, D}, W + n0, INW, D, sm, t);
        if (valid) {
#pragma unroll
            for (int i = 0; i < 4; ++i) { float o[4];
#pragma unroll
                for (int j = 0; j < 4; ++j) { o[j] = acc[i][j]; if (n0 >= 512 && n0 < 1536) o[j] = geluf_(o[j]); }
                v2u w; w.x = pk2(o[0], o[1]); w.y = pk2(o[2], o[3]); *(v2u*)(PROJ + (size_t)(m0 + ty * 4 + i) * INW + n0 + tx * 4) = w; }
        }
    NTILE_END
}
__device__ __forceinline__ int chain_row(int dir, int pos) { return dir == 0 ? (pos < CTX ? SEQ + pos : pos - CTX) : (pos < CTX ? SEQ + CTX - 1 - pos : SEQ - 1 - (pos - CTX)); }
__device__ __forceinline__ void ph3_s5_naive(Frame& F, int l) {
    LAS float* Cr = (LAS float*)(F.lds + 32768); LAS float* Ci = Cr + 1024; LAS float* Sr = Ci + 1024; LAS float* Si = Sr + 2048;
    const bf16* PROJ = (const bf16*)(F.ws + WS_PROJ); float* YD = (float*)(F.ws + WS_S5);
    for (int item = F.bid; item < 64; item += F.G) {
        if (F.wave == 0) {
            const int g = item >> 1, dir = item & 1, p = F.lane;
            const int ldg = ((l * 2 + dir) * G5 + g);
            const float lr = IN_(I_LRE)[ldg * P5 + p], li = IN_(I_LIM)[ldg * P5 + p], dt = expf(IN_(I_LDT)[ldg]);
            const float er = expf(lr * dt), ar = er * cosf(li * dt), ai = er * sinf(li * dt);
            const float nr = ar - 1.f, ni = ai, den = lr * lr + li * li;
            const float qr = (nr * lr + ni * li) / den, qi = (ni * lr - nr * li) / den;
            float br[16], bi[16];
#pragma unroll
            for (int h = 0; h < 16; ++h) { const float x = IN_(I_BRE)[((size_t)ldg * P5 + p) * H5 + h], y = IN_(I_BIM)[((size_t)ldg * P5 + p) * H5 + h]; br[h] = qr * x - qi * y; bi[h] = qr * y + qi * x; }
            for (int h = 0; h < 16; ++h) { Cr[h * 64 + p] = IN_(I_CRE)[((size_t)ldg * H5 + h) * P5 + p]; Ci[h * 64 + p] = IN_(I_CIM)[((size_t)ldg * H5 + h) * P5 + p]; }
            float sr = 0.f, si = 0.f;
            float* Y = YD + (size_t)dir * MT * MIXW;
#pragma unroll 1
            for (int blk = 0; blk < MT / 32; ++blk) {
#pragma unroll 1
                for (int tt = 0; tt < 32; ++tt) {
                    const int row = chain_row(dir, blk * 32 + tt);
                    const v4u u0 = *(const v4u*)(PROJ + (size_t)row * INW + g * 16), u1 = *(const v4u*)(PROJ + (size_t)row * INW + g * 16 + 8);
                    const unsigned uw[8] = {u0.x, u0.y, u0.z, u0.w, u1.x, u1.y, u1.z, u1.w};
                    float xr = 0.f, xi = 0.f;
#pragma unroll
                    for (int h = 0; h < 8; ++h) { const float ua = bf2f((unsigned short)(uw[h] & 0xffff)), ub = bf2f((unsigned short)(uw[h] >> 16));
                        xr += br[2 * h] * ua + br[2 * h + 1] * ub; xi += bi[2 * h] * ua + bi[2 * h + 1] * ub; }
                    const float nsr = ar * sr - ai * si + xr, nsi = ar * si + ai * sr + xi;
                    sr = nsr; si = nsi; Sr[tt * 64 + p] = sr; Si[tt * 64 + p] = si;
                }
                asm volatile("s_waitcnt lgkmcnt(0)" ::: "memory");
#pragma unroll 1
                for (int o = p; o < 512; o += 64) {
                    const int tt = o >> 4, h = o & 15; float a = 0.f;
#pragma unroll 4
                    for (int q = 0; q < 64; ++q) a += Cr[h * 64 + q] * Sr[tt * 64 + q] - Ci[h * 64 + q] * Si[tt * 64 + q];
                    Y[(size_t)chain_row(dir, blk * 32 + tt) * MIXW + g * 16 + h] = a;
                }
                asm volatile("s_waitcnt lgkmcnt(0)" ::: "memory");
            }
        }
    }
}
__device__ __forceinline__ void ph3_sg_naive(Frame& F, int l) {
    const bf16* PROJ = (const bf16*)(F.ws + WS_PROJ); bf16* YB = (bf16*)(F.ws + WS_YS) + (size_t)MT * MIXW;
    LAS float* stat = (LAS float*)(F.lds + 32768);
    const float* lg = IN_(I_SGG) + l * MIXW; const float* lb = IN_(I_SGB) + l * MIXW;
    NTILE_BEGIN((MT / 128) * 16)
        const int chunk = T >> 4, gg = (T >> 2) & 3, q0 = ((T >> 1) & 1) * 64, c0 = (T & 1) * 64;
        LAS float* st = stat + _half * 256;
        __syncthreads();
        if (t < 128) { const bf16* vr = PROJ + (size_t)(chunk * 128 + t) * INW + 1024; float s = 0.f;
            for (int c = 0; c < 512; c += 2) { const unsigned w = *(const unsigned*)(vr + c); s += bf2f((unsigned short)(w & 0xffff)) + bf2f((unsigned short)(w >> 16)); }
            const float mu = s * (1.f / 512.f); float q = 0.f;
            for (int c = 0; c < 512; c += 2) { const unsigned w = *(const unsigned*)(vr + c); const float a = bf2f((unsigned short)(w & 0xffff)) - mu, b = bf2f((unsigned short)(w >> 16)) - mu; q += a * a + b * b; }
            st[t * 2] = mu; st[t * 2 + 1] = rsqrtf(q * (1.f / 512.f) + EPS); }
        __syncthreads();
        float acc[4][4] = {};
        {
            const float* A = IN_(I_WSG) + ((size_t)(l * 4 + gg) * 128 + q0) * 128;
            const int lr = t >> 2, lk = (t & 3) * 4, bk = t >> 4, bn = (t & 15) * 4;
            for (int k0 = 0; k0 < 128; k0 += 16) {
                const float4 av = *(const float4*)(A + (size_t)lr * 128 + k0 + lk);
                const int p = k0 + bk; const int col = gg * 128 + c0 + bn;
                const v2u w = *(const v2u*)(PROJ + (size_t)(chunk * 128 + p) * INW + 1024 + col);
                const float mu = st[p * 2], rs = st[p * 2 + 1];
                float4 bv; bv.x = (bf2f((unsigned short)(w.x & 0xffff)) - mu) * rs * lg[col] + lb[col]; bv.y = (bf2f((unsigned short)(w.x >> 16)) - mu) * rs * lg[col + 1] + lb[col + 1];
                bv.z = (bf2f((unsigned short)(w.y & 0xffff)) - mu) * rs * lg[col + 2] + lb[col + 2]; bv.w = (bf2f((unsigned short)(w.y >> 16)) - mu) * rs * lg[col + 3] + lb[col + 3];
                __syncthreads();
                sm->As[lk + 0][lr] = av.x; sm->As[lk + 1][lr] = av.y; sm->As[lk + 2][lr] = av.z; sm->As[lk + 3][lr] = av.w;
                *(LAS f32x4*)&sm->Bs[bk][bn] = (f32x4){bv.x, bv.y, bv.z, bv.w};
                __syncthreads();
#pragma unroll
                for (int k = 0; k < 16; ++k) { const f32x4 a = *(const LAS f32x4*)&sm->As[k][ty * 4]; const f32x4 b = *(const LAS f32x4*)&sm->Bs[k][tx * 4];
                    const float aa[4] = {a.x, a.y, a.z, a.w}, bb[4] = {b.x, b.y, b.z, b.w};
#pragma unroll
                    for (int i = 0; i < 4; ++i)
#pragma unroll
                        for (int j = 0; j < 4; ++j) acc[i][j] += aa[i] * bb[j]; }
            }
        }
        if (valid) {
#pragma unroll
            for (int i = 0; i < 4; ++i) { const int q = q0 + ty * 4 + i; const size_t row = (size_t)chunk * 128 + q; const int col = gg * 128 + c0 + tx * 4;
                const float bq = IN_(I_BSG)[l * 512 + gg * 128 + q];
                const v2u gu = *(const v2u*)(PROJ + row * INW + 512 + col);
                v2u w; w.x = pk2(bf2f((unsigned short)(gu.x & 0xffff)) * (acc[i][0] + bq), bf2f((unsigned short)(gu.x >> 16)) * (acc[i][1] + bq));
                w.y = pk2(bf2f((unsigned short)(gu.y & 0xffff)) * (acc[i][2] + bq), bf2f((unsigned short)(gu.y >> 16)) * (acc[i][3] + bq));
                *(v2u*)(YB + row * MIXW + col) = w; }
        }
    NTILE_END
}
__device__ __forceinline__ void ph3_conv(Frame& F, int l, int nrows) {
    const bf16* PROJ = (const bf16*)(F.ws + WS_PROJ); bf16* YC = (bf16*)(F.ws + WS_YS) + (size_t)2 * MT * MIXW; const float* wc = IN_(I_WCONV) + l * 3 * MIXW;
    const size_t gt = (size_t)F.bid * NT + F.tid, ngt = (size_t)F.G * NT;
    for (size_t i = gt; i < (size_t)nrows * (MIXW / 2); i += ngt) {
        const int row = (int)(i / (MIXW / 2)), c = (int)(i % (MIXW / 2)) * 2;
        int pos, rl; if (row < SEQ) { pos = row & 63; rl = 64; } else { pos = row - SEQ; rl = 256; }
        const bf16* r0 = PROJ + (size_t)row * INW + 1536;
        const unsigned b0 = *(const unsigned*)(r0 + c), c0 = *(const unsigned*)(r0 + 512 + c), h0 = *(const unsigned*)(r0 + 1024 + c);
        float zm0 = 0.f, zm1 = 0.f, zp0 = 0.f, zp1 = 0.f;
        if (pos > 0) { const unsigned cc = *(const unsigned*)(r0 - INW + 512 + c), hh = *(const unsigned*)(r0 - INW + 1024 + c); zm0 = bf2f((unsigned short)(cc & 0xffff)) * bf2f((unsigned short)(hh & 0xffff)); zm1 = bf2f((unsigned short)(cc >> 16)) * bf2f((unsigned short)(hh >> 16)); }
        if (pos < rl - 1) { const unsigned cc = *(const unsigned*)(r0 + INW + 512 + c), hh = *(const unsigned*)(r0 + INW + 1024 + c); zp0 = bf2f((unsigned short)(cc & 0xffff)) * bf2f((unsigned short)(hh & 0xffff)); zp1 = bf2f((unsigned short)(cc >> 16)) * bf2f((unsigned short)(hh >> 16)); }
        const float z00 = bf2f((unsigned short)(c0 & 0xffff)) * bf2f((unsigned short)(h0 & 0xffff)), z01 = bf2f((unsigned short)(c0 >> 16)) * bf2f((unsigned short)(h0 >> 16));
        const float y0 = bf2f((unsigned short)(b0 & 0xffff)) * (wc[c] * zm0 + wc[512 + c] * z00 + wc[1024 + c] * zp0);
        const float y1 = bf2f((unsigned short)(b0 >> 16)) * (wc[c + 1] * zm1 + wc[512 + c + 1] * z01 + wc[1024 + c + 1] * zp1);
        *(unsigned*)(YC + (size_t)row * MIXW + c) = pk2(y0, y1);
    }
}
__device__ __forceinline__ void ph5_naive(Frame& F, int l) {
    const bf16* PROJ = (const bf16*)(F.ws + WS_PROJ); const float* YD = (const float*)(F.ws + WS_S5); bf16* YG = (bf16*)(F.ws + WS_YG); const float* ds = IN_(I_DSKIP) + l * MIXW;
    const size_t gt = (size_t)F.bid * NT + F.tid, ngt = (size_t)F.G * NT;
    for (size_t i = gt; i < (size_t)MT * (MIXW / 2); i += ngt) {
        const int row = (int)(i / (MIXW / 2)), c = (int)(i % (MIXW / 2)) * 2;
        const unsigned u = *(const unsigned*)(PROJ + (size_t)row * INW + c); const size_t o = (size_t)row * MIXW + c;
        const float y0 = YD[o] + YD[(size_t)MT * MIXW + o] + ds[c] * bf2f((unsigned short)(u & 0xffff)), y1 = YD[o + 1] + YD[(size_t)MT * MIXW + o + 1] + ds[c + 1] * bf2f((unsigned short)(u >> 16));
        *(unsigned*)(YG + o) = pk2(geluf_(y0), geluf_(y1));
    }
}
__device__ __forceinline__ void ph6_naive(Frame& F, int l) {
    const bf16* YG = (const bf16*)(F.ws + WS_YG); bf16* YA = (bf16*)(F.ws + WS_YS); const float* W = IN_(I_WGLU) + (size_t)l * MIXW * MIXW;
    NTILE_BEGIN((MT / 64) * (MIXW / 64))
        const int m0 = (T / (MIXW / 64)) * 64, n0 = (T % (MIXW / 64)) * 64;
        float acc[4][4] = {};
        ngemm_acc(acc, ABf{YG + (size_t)m0 * MIXW, MIXW}, W + n0, MIXW, MIXW, sm, t);
        if (valid) {
#pragma unroll
            for (int i = 0; i < 4; ++i) { const size_t o = (size_t)(m0 + ty * 4 + i) * MIXW + n0 + tx * 4; const v2u g = *(const v2u*)(YG + o);
                v2u w; w.x = pk2(bf2f((unsigned short)(g.x & 0xffff)) * sigmoidf_(acc[i][0]), bf2f((unsigned short)(g.x >> 16)) * sigmoidf_(acc[i][1]));
                w.y = pk2(bf2f((unsigned short)(g.y & 0xffff)) * sigmoidf_(acc[i][2]), bf2f((unsigned short)(g.y >> 16)) * sigmoidf_(acc[i][3])); *(v2u*)(YA + o) = w; }
        }
    NTILE_END
}
__device__ __forceinline__ void ph7_naive(Frame& F, int l) {
    const bf16* YS = (const bf16*)(F.ws + WS_YS); bf16* BR = (bf16*)(F.ws + WS_PROJ); const float* W = IN_(I_WBR) + (size_t)l * 3 * MIXW * D;
    NTILE_BEGIN((MT / 64) * (INW / 64))
        const int m0 = (T / (INW / 64)) * 64, n0 = (T % (INW / 64)) * 64, k = n0 / 1024, d0 = n0 % 1024;
        float acc[4][4] = {};
        ngemm_acc(acc, ABf{YS + (size_t)k * MT * MIXW + (size_t)m0 * MIXW, MIXW}, W + (size_t)k * MIXW * D + d0, D, MIXW, sm, t);
        if (valid) {
#pragma unroll
            for (int i = 0; i < 4; ++i) { v2u w; w.x = pk2(acc[i][0], acc[i][1]); w.y = pk2(acc[i][2], acc[i][3]); *(v2u*)(BR + (size_t)(m0 + ty * 4 + i) * INW + n0 + tx * 4) = w; }
        }
    NTILE_END
}
__device__ __forceinline__ void ph8_naive(Frame& F, int l) {
    const bf16* H = (const bf16*)(F.ws + WS_H); const bf16* BR = (const bf16*)(F.ws + WS_PROJ); bf16* PM = (bf16*)(F.ws + WS_PM);
    const float* W = IN_(I_WMG) + (size_t)l * D * INW; const float* bm = IN_(I_BMG) + l * INW;
    NTILE_BEGIN((MT / 64) * (D / 64))
        const int m0 = (T / (D / 64)) * 64, n0 = (T % (D / 64)) * 64;
        float out[4][4] = {};
        for (int k = 0; k < 3; ++k) {
            float acc[4][4] = {};
            ngemm_acc(acc, ABf{H + (size_t)m0 * D, D}, W + k * 1024 + n0, INW, D, sm, t);
#pragma unroll
            for (int i = 0; i < 4; ++i) { const v2u b = *(const v2u*)(BR + (size_t)(m0 + ty * 4 + i) * INW + k * 1024 + n0 + tx * 4);
                const float bb[4] = {bf2f((unsigned short)(b.x & 0xffff)), bf2f((unsigned short)(b.x >> 16)), bf2f((unsigned short)(b.y & 0xffff)), bf2f((unsigned short)(b.y >> 16))};
#pragma unroll
                for (int j = 0; j < 4; ++j) out[i][j] += sigmoidf_(acc[i][j] + bm[k * 1024 + n0 + tx * 4 + j]) * bb[j]; }
        }
        if (valid) {
#pragma unroll
            for (int i = 0; i < 4; ++i) { v2u w; w.x = pk2(out[i][0], out[i][1]); w.y = pk2(out[i][2], out[i][3]); *(v2u*)(PM + (size_t)(m0 + ty * 4 + i) * D + n0 + tx * 4) = w; }
        }
    NTILE_END
}
__device__ __forceinline__ void ph9_naive(Frame& F, int l) {
    const bf16* PM = (const bf16*)(F.ws + WS_PM); const float* W = IN_(I_WO) + (size_t)l * D * D;
    NTILE_BEGIN((MT / 64) * (D / 64))
        const int m0 = (T / (D / 64)) * 64, n0 = (T % (D / 64)) * 64;
        float acc[4][4] = {};
        ngemm_acc(acc, ABf{PM + (size_t)m0 * D, D}, W + n0, D, D, sm, t);
        if (valid) {
#pragma unroll
            for (int i = 0; i < 4; ++i) { const int row = m0 + ty * 4 + i, c = n0 + tx * 4; const float* m = mod_ptr(F, l, row) + 2048 + c;
                const f32x4 xs = *(const f32x4*)(xsrc_row(F, l, row) + c);
                f32x4 o; o.x = xs.x + m[0] * acc[i][0]; o.y = xs.y + m[1] * acc[i][1]; o.z = xs.z + m[2] * acc[i][2]; o.w = xs.w + m[3] * acc[i][3];
                *(f32x4*)(xrun_row(F, row) + c) = o; }
        }
    NTILE_END
}
template <int KS>
__device__ __forceinline__ void route_pass(Frame& F, int l, int u, bool valid, int kh, int sl, LAS float* GC, LAS float* SH, LAS float* SSQ, LAS float* LG, LAS int* HISTL) {
    bf16* H = (bf16*)(F.ws + WS_H); const bf16* WRh = (const bf16*)(F.ws + WS_WR); const bf16* WRl = WRh + 48 * 1024;
    const float* bg = IN_(I_BGRP) + l * 4; const float* be = IN_(I_BEXP) + l * 32;
    int* EID = (int*)(F.ws + WS_EID); float* EW = (float*)(F.ws + WS_EW);
    constexpr int NK = 32 / KS, KW = 1024 / KS;
    const int r = F.lane & 15, q = F.lane >> 4;
    const int uu = valid ? u : 0; const int row = uu * 16 + r; const float* xr = xrun_row(F, row) + kh * KW + 8 * q; const int pv = (row >= SEQ ? 1024 : 0) + kh * KW + 8 * q;
    float s = 0.f;
#pragma unroll
    for (int ks = 0; ks < NK; ++ks) { const f32x4 a = *(const f32x4*)(xr + 32 * ks), b = *(const f32x4*)(xr + 32 * ks + 4); s += a.x * a.x + a.y * a.y + a.z * a.z + a.w * a.w + b.x * b.x + b.y * b.y + b.z * b.z + b.w * b.w; }
    s += __shfl_xor(s, 16); s += __shfl_xor(s, 32);
    __syncthreads();
    if (q == 0) SSQ[(sl * KS + kh) * 16 + r] = s;
    __syncthreads();
    float tot = 0.f;
#pragma unroll
    for (int i = 0; i < KS; ++i) tot += SSQ[(sl * KS + i) * 16 + r];
    const float rstd = rsqrtf(tot * (1.f / D) + EPS);
    f32x4 acc[3] = {{0.f, 0.f, 0.f, 0.f}, {0.f, 0.f, 0.f, 0.f}, {0.f, 0.f, 0.f, 0.f}};
#pragma unroll 4
    for (int ks = 0; ks < NK; ++ks) {
        const int c = 32 * ks;
        const f32x4 x0 = *(const f32x4*)(xr + c), x1 = *(const f32x4*)(xr + c + 4);
        const f32x4 g0 = *(const LAS f32x4*)(GC + pv + c), g1 = *(const LAS f32x4*)(GC + pv + c + 4), sh0 = *(const LAS f32x4*)(SH + pv + c), sh1 = *(const LAS f32x4*)(SH + pv + c + 4);
        const f32x4 h0 = x0 * rstd * g0 + sh0, h1 = x1 * rstd * g1 + sh1;
        v4u hi; hi.x = pk2(h0.x, h0.y); hi.y = pk2(h0.z, h0.w); hi.z = pk2(h1.x, h1.y); hi.w = pk2(h1.z, h1.w);
        if (valid) *(v4u*)(H + (size_t)row * D + kh * KW + 8 * q + c) = hi;
        v4u lo; lo.x = pk2(h0.x - bflo(hi.x), h0.y - bfhi(hi.x)); lo.y = pk2(h0.z - bflo(hi.y), h0.w - bfhi(hi.y)); lo.z = pk2(h1.x - bflo(hi.z), h1.y - bfhi(hi.z)); lo.w = pk2(h1.z - bflo(hi.w), h1.w - bfhi(hi.w));
        const bf16x8 Ah = __builtin_bit_cast(bf16x8, hi), Al = __builtin_bit_cast(bf16x8, lo);
#pragma unroll
        for (int cb = 0; cb < 3; ++cb) { const size_t wo = (size_t)(cb * 16 + r) * 1024 + kh * KW + c + 8 * q; const bf16x8 Bh = *(const bf16x8*)(WRh + wo), Bl = *(const bf16x8*)(WRl + wo);
            acc[cb] = __builtin_amdgcn_mfma_f32_16x16x32_bf16(Ah, Bh, acc[cb], 0, 0, 0); acc[cb] = __builtin_amdgcn_mfma_f32_16x16x32_bf16(Al, Bh, acc[cb], 0, 0, 0); acc[cb] = __builtin_amdgcn_mfma_f32_16x16x32_bf16(Ah, Bl, acc[cb], 0, 0, 0); }
    }
    LAS float* LGw = LG + (sl * KS + kh) * (16 * 52);
#pragma unroll
    for (int cb = 0; cb < 3; ++cb)
#pragma unroll
        for (int i = 0; i < 4; ++i) LGw[(4 * q + i) * 52 + cb * 16 + r] = acc[cb][i];
    __syncthreads();
    if (kh == 0 && valid && F.lane < 16) { const LAS float* L0 = LG + (sl * KS) * (16 * 52) + F.lane * 52; const int rw = u * 16 + F.lane;
        float lg[36];
#pragma unroll
        for (int o = 0; o < 36; ++o) { float t = 0.f;
#pragma unroll
            for (int i = 0; i < KS; ++i) t += L0[i * (16 * 52) + o]; lg[o] = t + (o < 4 ? bg[o] : be[o - 4]); }
        LAS float* LW = LG + (sl * KS) * (16 * 52) + F.lane * 52;
#pragma unroll
        for (int o = 0; o < 36; ++o) LW[o] = lg[o];
        int gi = 0; float gm = lg[0];
#pragma unroll
        for (int o = 1; o < 4; ++o) if (lg[o] > gm) { gm = lg[o]; gi = o; }
        float den = 0.f;
#pragma unroll
        for (int o = 0; o < 4; ++o) den += expf(lg[o] - gm);
        const float gp = 1.f / den;
        const LAS float* el = LW + 4 + gi * 8;
        int i1 = 0; float m1 = el[0]; for (int o = 1; o < 8; ++o) { const float v = el[o]; if (v > m1) { m1 = v; i1 = o; } }
        int i2 = -1; float m2 = 0.f; for (int o = 0; o < 8; ++o) { const float v = el[o]; if (o != i1 && (i2 < 0 || v > m2)) { m2 = v; i2 = o; } }
        const float e2 = expf(m2 - m1); const float w1 = 1.f / (1.f + e2), w2 = e2 / (1.f + e2);
        const int e1i = gi * 8 + i1, e2i = gi * 8 + i2;
        EID[rw * 2] = e1i; EID[rw * 2 + 1] = e2i; EW[rw * 2] = gp * w1; EW[rw * 2 + 1] = gp * w2;
        __hip_atomic_fetch_add(&HISTL[e1i], 1, __ATOMIC_RELAXED, __HIP_MEMORY_SCOPE_WORKGROUP); __hip_atomic_fetch_add(&HISTL[e2i], 1, __ATOMIC_RELAXED, __HIP_MEMORY_SCOPE_WORKGROUP);
    }
}
__device__ __forceinline__ void ph10_route(Frame& F, int l) {
    const float* g = IN_(I_GFFN) + l * D;
    LAS float* GC = (LAS float*)F.lds;
    LAS float* SH = GC + 2048;
    LAS float* SSQ = SH + 2048;
    LAS float* LG = SSQ + 128;
    LAS int* HISTL = (LAS int*)(LG + 8 * 16 * 52);
    __syncthreads();
    if (F.tid < 32) HISTL[F.tid] = 0;
    for (int i = F.tid; i < 2048; i += NT) { const int w = i >> 10, c = i & 1023; const float* m = (const float*)(F.ws + WS_MOD) + (size_t)(l * 2 + w) * 6144; GC[i] = g[c] * (1.f + m[4096 + c]); SH[i] = m[3072 + c]; }
#pragma unroll 1
    for (int u0 = F.bid; u0 < SEQ / 16; u0 += 4 * F.G) { const int u = u0 + (F.wave >> 1) * F.G; route_pass<2>(F, l, u, u < SEQ / 16, F.wave & 1, F.wave >> 1, GC, SH, SSQ, LG, HISTL); }
    if (l == 0) {
#pragma unroll 1
        for (int u0 = SEQ / 16 + F.bid; u0 < MT / 16; u0 += F.G) route_pass<8>(F, l, u0, true, F.wave, 0, GC, SH, SSQ, LG, HISTL);
    }
    __syncthreads();
    if (F.tid < 32) ((int*)(F.ws + WS_HISTG))[F.bid * 32 + F.tid] = HISTL[F.tid];
}
__device__ __forceinline__ int expert_off(const unsigned* cnt, int e) { int o = 0; for (int i = 0; i < e; ++i) o += ((int)cnt[i] + 255) & ~255; return o; }
__device__ __forceinline__ void ph11_scatter(Frame& F, int l) {
    const bf16* H = (const bf16*)(F.ws + WS_H); bf16* HS = (bf16*)(F.ws + WS_HS);
    const int* EID = (const int*)(F.ws + WS_EID); const float* EW = (const float*)(F.ws + WS_EW); int* STOK = (int*)(F.ws + WS_STOK); float* SW = (float*)(F.ws + WS_SW); int* TSLOT = (int*)(F.ws + WS_TSLOT);
    unsigned* cnt = F.ctl + CW_CNT + l * 128; const int* HISTG = (const int*)(F.ws + WS_HISTG);
    LAS int* HIST = (LAS int*)F.lds; LAS int* BASE = HIST + 32; LAS int* ISLOT = BASE + 32; LAS int* IROW = ISLOT + 512; LAS int* PT = IROW + 512; LAS int* PB = PT + 512;
    const int nunits = (l == 0 ? MT : SEQ) / 16;
    __syncthreads();
    { const int e = F.tid & 31, ch = F.tid >> 5; int tot = 0, bas = 0;
      for (int b = ch; b < F.G; b += 16) { const int h = HISTG[b * 32 + e]; tot += h; if (b < F.bid) bas += h; }
      PT[F.tid] = tot; PB[F.tid] = bas; }
    __syncthreads();
    if (F.tid < 32) { int tot = 0, bas = 0; for (int ch = 0; ch < 16; ++ch) { tot += PT[ch * 32 + F.tid]; bas += PB[ch * 32 + F.tid]; } HIST[F.tid] = 0; PT[F.tid] = tot; PB[F.tid] = bas; if (F.bid == 0) cnt[F.tid] = (unsigned)tot; }
    __syncthreads();
    if (F.tid < 32) { int off = 0; for (int i = 0; i < F.tid; ++i) off += (PT[i] + 255) & ~255; BASE[F.tid] = off + PB[F.tid]; }
    __syncthreads();
    const int w = F.tid >> 5; int u = F.bid + w * F.G; bool valid = u < SEQ / 16;
    if (w == 15) { u = SEQ / 16 + F.bid; valid = u < nunits; }
    const int row = u * 16 + ((F.tid >> 1) & 15), kk = F.tid & 1;
    int e = 0, rank = 0; if (valid) { e = EID[row * 2 + kk]; rank = __hip_atomic_fetch_add(&HIST[e], 1, __ATOMIC_RELAXED, __HIP_MEMORY_SCOPE_WORKGROUP); }
    __syncthreads();
    int slot = -1; if (valid) { slot = BASE[e] + rank; STOK[slot] = row; SW[slot] = EW[row * 2 + kk]; TSLOT[row * 2 + kk] = slot; }
    ISLOT[F.tid] = slot; IROW[F.tid] = row;
    __syncthreads();
#pragma unroll 4
    for (int it = F.wave; it < NT; it += NT / 64) { const int sl = ISLOT[it]; if (sl >= 0) { const v4u* src = (const v4u*)(H + (size_t)IROW[it] * D); v4u* dst = (v4u*)(HS + (size_t)sl * D);
        dst[F.lane] = src[F.lane]; dst[F.lane + 64] = src[F.lane + 64]; } }
}
__device__ __forceinline__ int slot_expert(const unsigned* cnt, int slot0, int& seg_off, int& n_e) { int o = 0; for (int e = 0; e < NE; ++e) { const int n = (int)cnt[e], pn = (n + 255) & ~255; if (slot0 < o + pn) { seg_off = o; n_e = n; return e; } o += pn; } seg_off = o; n_e = 0; return 0; }
__device__ __forceinline__ void ph12_naive(Frame& F, int l) {
    const bf16* HS = (const bf16*)(F.ws + WS_HS); bf16* ACT = (bf16*)(F.ws + WS_ACT); const float* SW = (const float*)(F.ws + WS_SW);
    const unsigned* cnt = F.ctl + CW_CNT + l * 128; const int total = expert_off(cnt, NE);
    NTILE_BEGIN((total / 64) * (DFF / 64))
        const int s0 = (T / (DFF / 64)) * 64, n0 = (T % (DFF / 64)) * 64; int seg, n_e; const int e = slot_expert(cnt, s0, seg, n_e);
        float aa[4][4] = {}, ab[4][4] = {};
        ngemm_acc(aa, ABf{HS + (size_t)s0 * D, D}, IN_(I_W1) + ((size_t)l * NE + e) * D * DFF + n0, DFF, D, sm, t);
        ngemm_acc(ab, ABf{HS + (size_t)s0 * D, D}, IN_(I_W3) + ((size_t)l * NE + e) * D * DFF + n0, DFF, D, sm, t);
        if (valid) {
#pragma unroll
            for (int i = 0; i < 4; ++i) { const int slot = s0 + ty * 4 + i; if (slot - seg < n_e) { const float w = SW[slot];
                v2u o; o.x = pk2(siluf_(aa[i][0]) * ab[i][0] * w, siluf_(aa[i][1]) * ab[i][1] * w); o.y = pk2(siluf_(aa[i][2]) * ab[i][2] * w, siluf_(aa[i][3]) * ab[i][3] * w);
                *(v2u*)(ACT + (size_t)slot * DFF + n0 + tx * 4) = o; } }
        }
    NTILE_END
}
__device__ __forceinline__ void ph13_naive(Frame& F, int l) {
    const bf16* ACT = (const bf16*)(F.ws + WS_ACT); bf16* YS2 = (bf16*)(F.ws + WS_YS2);
    const unsigned* cnt = F.ctl + CW_CNT + l * 128; const int total = expert_off(cnt, NE);
    NTILE_BEGIN((total / 64) * (D / 64))
        const int s0 = (T / (D / 64)) * 64, n0 = (T % (D / 64)) * 64; int seg, n_e; const int e = slot_expert(cnt, s0, seg, n_e);
        float acc[4][4] = {};
        ngemm_acc(acc, ABf{ACT + (size_t)s0 * DFF, DFF}, IN_(I_W2) + ((size_t)l * NE + e) * DFF * D + n0, D, DFF, sm, t);
        if (valid) {
#pragma unroll
            for (int i = 0; i < 4; ++i) { const int slot = s0 + ty * 4 + i; if (slot - seg < n_e) { v2u o; o.x = pk2(acc[i][0], acc[i][1]); o.y = pk2(acc[i][2], acc[i][3]); *(v2u*)(YS2 + (size_t)slot * D + n0 + tx * 4) = o; } }
        }
    NTILE_END
}
__device__ __forceinline__ void ph14_combine(Frame& F, int l) {
    const bf16* YS2 = (const bf16*)(F.ws + WS_YS2); const int* TSLOT = (const int*)(F.ws + WS_TSLOT); bf16* H = (bf16*)(F.ws + WS_H);
    const int gw = F.bid * (NT / 64) + F.wave, ngw = F.G * (NT / 64);
    const int nrows = l == 0 ? MT : SEQ;
    for (int row0 = gw; row0 < nrows; row0 += 2 * ngw) {
        f32x4 v[2][4]; float s[2] = {0.f, 0.f}; int rows[2]; bool ok[2];
#pragma unroll
        for (int t = 0; t < 2; ++t) { rows[t] = row0 + t * ngw; ok[t] = rows[t] < nrows; if (!ok[t]) rows[t] = row0; }
        int sl[2][2];
#pragma unroll
        for (int t = 0; t < 2; ++t) { sl[t][0] = TSLOT[rows[t] * 2]; sl[t][1] = TSLOT[rows[t] * 2 + 1]; }
#pragma unroll
        for (int t = 0; t < 2; ++t) { const float* m = mod_ptr(F, l, rows[t]); const float* xr = xrun_row(F, rows[t]);
#pragma unroll
            for (int j = 0; j < 4; ++j) { const int c = 4 * F.lane + 256 * j; const f32x4 x = *(const f32x4*)(xr + c); const f32x4 ga = *(const f32x4*)(m + 5120 + c);
                const v2u a = *(const v2u*)(YS2 + (size_t)sl[t][0] * D + c), b = *(const v2u*)(YS2 + (size_t)sl[t][1] * D + c);
                f32x4 y; y.x = bflo(a.x) + bflo(b.x); y.y = bfhi(a.x) + bfhi(b.x); y.z = bflo(a.y) + bflo(b.y); y.w = bfhi(a.y) + bfhi(b.y);
                v[t][j] = x + ga * y; s[t] += v[t][j].x * v[t][j].x + v[t][j].y * v[t][j].y + v[t][j].z * v[t][j].z + v[t][j].w * v[t][j].w; } }
#pragma unroll
        for (int t = 0; t < 2; ++t) { if (!ok[t]) continue;
            const float rstd = rsqrtf(wave_sum(s[t]) * (1.f / D) + EPS); float* xr = xrun_row(F, rows[t]);
            if (l == 0) {
                const float* m1 = mod_ptr(F, 1, rows[t]); const float* g = IN_(I_GMIX) + D;
#pragma unroll
                for (int j = 0; j < 4; ++j) { const int c = 4 * F.lane + 256 * j; *(f32x4*)(xr + c) = v[t][j];
                    const f32x4 gg = *(const f32x4*)(g + c), sc = *(const f32x4*)(m1 + 1024 + c), sh = *(const f32x4*)(m1 + c);
                    const f32x4 o = v[t][j] * rstd * gg * (1.f + sc) + sh; v2u w; w.x = pk2(o.x, o.y); w.y = pk2(o.z, o.w); *(v2u*)(H + (size_t)rows[t] * D + c) = w; }
            } else {
                const float* g = IN_(I_GF);
#pragma unroll
                for (int j = 0; j < 4; ++j) { const int c = 4 * F.lane + 256 * j; const f32x4 gg = *(const f32x4*)(g + c); f32x4 o = v[t][j] * rstd * gg;
                    if (PROBE_B >= 0 && rows[t] < 3906) { volatile LAS unsigned long long* TS = (volatile LAS unsigned long long*)(F.lds + TS_OFF); o = o + (0.1f + 0.00001f * (float)(TS[1 + PROBE_B] - TS[PROBE_B])); }
                    if (PROBE_A >= 0 && rows[t] == 0 && j == 0 && F.lane == 0) { volatile LAS unsigned long long* TS = (volatile LAS unsigned long long*)(F.lds + TS_OFF); o.x += 1.f + 0.001f * (float)(TS[1 + PROBE_A] - TS[PROBE_A]); }
                    *(f32x4*)(xr + c) = o; }
            }
        }
    }
}

#ifndef FASTMASK
#define FASTMASK 0xffff
#endif
constexpr unsigned FM = FASTMASK;
constexpr int NPH = 2 + 13 * 2;
__device__ __forceinline__ Frame make_frame(LAS unsigned char* lds, int wave0) {
    Frame F; F.lds = lds; F.wave = wave0; F.lane = (int)__builtin_amdgcn_mbcnt_hi(~0u, __builtin_amdgcn_mbcnt_lo(~0u, 0u)); asm volatile("" : "+v"(F.lane)); F.tid = F.wave * 64 + F.lane; F.bid = blockIdx.x; F.G = gridDim.x; asm volatile("" : "+s"(F.G), "+s"(F.bid));
    F.tab = (const unsigned long long LAS*)(lds + TAB_OFF);
    volatile LAS unsigned long long* t = (volatile LAS unsigned long long*)(lds + TAB_OFF);
    F.ws = (unsigned char*)uni64(t[35]); F.out = (float*)uni64(t[36]); F.ctl = (unsigned*)(F.ws + WS_CTL);
    return F;
}
__global__ void __launch_bounds__(NT, 2) mega_fwd(Args args) {
    extern __shared__ __attribute__((aligned(16))) unsigned char lds_raw[];
    LAS unsigned char* const lds = (LAS unsigned char*)lds_raw;
    const int wave0 = __builtin_amdgcn_readfirstlane((int)threadIdx.x >> 6);
    for (int u = threadIdx.x; u < 1024 / 4; u += NT) ((LAS unsigned*)(lds + 131072))[u] = 0u;
    if (threadIdx.x == 0) { LAS unsigned long long* t = (LAS unsigned long long*)(lds + TAB_OFF);
#pragma unroll
        for (int i = 0; i < 35; ++i) t[i] = (unsigned long long)args.in[i];
        t[35] = (unsigned long long)args.ws; t[36] = (unsigned long long)args.out; }
    __syncthreads();
    { Frame F = make_frame(lds, wave0); (void)xcd_barrier_post(F.ctl + CW_BAR, (volatile LAS unsigned*)(lds + MISC_OFF) + 8); }
    if ((PROBE_A >= 0 || PROBE_B >= 0) && threadIdx.x == 0) ((volatile LAS unsigned long long*)(lds + TS_OFF))[0] = __builtin_amdgcn_s_memrealtime();
    const int lo = args.ph_lo, hi = args.ph_hi; int ph = 0;
#define GRIDBAR() do { Frame Fb = make_frame(lds, wave0); XcdBarrier bar; bar.bar = Fb.ctl + CW_BAR; bar.x = xb_xcc_id(); bar.st = (volatile LAS unsigned*)(lds + MISC_OFF) + 8; xcd_barrier(bar, Fb.tid == 0); } while (0)
#ifndef REPBAR
#define REPBAR 0
#endif
#ifndef REPMASK
#define REPMASK 0
#endif
#define PHASE(...) do { if (lo <= ph && ph < hi) { const int _pl = ph < 2 ? ph : 2 + (ph - 2) % 13; for (int _rep = 0; _rep <= ((REPMASK >> _pl) & 1); ++_rep) { Frame F = make_frame(lds, wave0); __VA_ARGS__; } if (ph + 1 < hi) { GRIDBAR(); if (REPBAR) GRIDBAR(); } if ((PROBE_A >= 0 || PROBE_B >= 0) && threadIdx.x == 0) ((volatile LAS unsigned long long*)(lds + TS_OFF))[1 + ph] = __builtin_amdgcn_s_memrealtime(); } ++ph; } while (0)
    PHASE({ ph0_prologue(F); convert_weights(F, 0); { const f32x4* s = (const f32x4*)IN_(I_CTX); f32x4* d = (f32x4*)(F.ws + WS_XC); for (int i = F.bid * NT + F.tid; i < CTX * D / 4; i += F.G * NT) d[i] = s[i]; } });
    PHASE({ hprep_rows(F, 0); if (FM >> 3 & 1) s5_precompute(F); });
#pragma unroll 1
    for (int l = 0; l < 2; ++l) {
        PHASE({ if (FM >> 2 & 1) ph2_fast(F, l); else ph2_naive(F, l); });
        PHASE({ if (FM >> 3 & 1) { s5_z_phase(F, l); const int nch = (l == 0 ? MT : SEQ) / 128; if (F.G > nch) { if (F.bid < nch) sg_fast_chunk(F, l, F.bid); else { Frame F2 = F; F2.bid -= nch; F2.G -= nch; ph3_conv(F2, l, l == 0 ? MT : SEQ); } } else { for (int c = F.bid; c < nch; c += F.G) sg_fast_chunk(F, l, c); ph3_conv(F, l, l == 0 ? MT : SEQ); } } else { ph3_s5_naive(F, l); if (F.bid >= 64) { Frame F2 = F; F2.bid -= 64; F2.G -= 64; ph3_sg_naive(F2, l); ph3_conv(F2, l, MT); } } });
        PHASE({ if (FM >> 3 & 1) s5_scan_phase(F, l); });
        PHASE({ if (FM >> 3 & 1) s5_y_phase(F, l); else ph5_naive(F, l); });
        PHASE({ if (FM >> 6 & 1) ph6_fast(F, l); else ph6_naive(F, l); });
        PHASE({ if (FM >> 7 & 1) ph7_fast(F, l); else ph7_naive(F, l); });
        PHASE({ if (FM >> 8 & 1) ph8_fast(F, l); else ph8_naive(F, l); });
        PHASE({ if (FM >> 9 & 1) ph9_fast(F, l); else ph9_naive(F, l); });
        PHASE(ph10_route(F, l));
        PHASE(ph11_scatter(F, l));
        PHASE({ if (FM >> 12 & 1) ph12_fast(F, l); else ph12_naive(F, l); });
        PHASE({ if (FM >> 13 & 1) ph13_fast(F, l); else ph13_naive(F, l); });
        PHASE({ ph14_combine(F, l); if (l == 0) convert_weights(F, 1); });
    }
#undef PHASE
}

extern "C" void kernel_launch(void* const* d_in, const int* in_sizes, int n_in, void* d_out, int out_size, void* d_ws, size_t ws_size, hipStream_t stream) {
    static int grid = 0;
    if (grid == 0) {
        int dev = 0, cus = 0, per_cu = 0;
        if (n_in != 35 || out_size != SEQ * D || ws_size < WS_END) { fprintf(stderr, "kernel_launch: unexpected shapes (n_in %d out %d ws %zu)\n", n_in, out_size, ws_size); grid = -1; return; }
        if (hipGetDevice(&dev) != hipSuccess || hipDeviceGetAttribute(&cus, hipDeviceAttributeMultiprocessorCount, dev) != hipSuccess) { grid = -1; return; }
        if (hipFuncSetAttribute((const void*)mega_fwd, hipFuncAttributeMaxDynamicSharedMemorySize, LDS_BYTES) != hipSuccess) { fprintf(stderr, "kernel_launch: hipFuncSetAttribute failed\n"); grid = -1; return; }
        if (hipOccupancyMaxActiveBlocksPerMultiprocessor(&per_cu, (const void*)mega_fwd, NT, LDS_BYTES) != hipSuccess || per_cu < 1) { fprintf(stderr, "kernel_launch: occupancy query says %d blocks per CU\n", per_cu); grid = -1; return; }
        grid = cus;
    }
    if (grid < 0) return;
    (void)hipMemsetAsync((char*)d_ws + WS_CTL, 0, CTL_ZERO_BYTES, stream);
    Args a{};
    for (int i = 0; i < 35; ++i) a.in[i] = (const float*)d_in[i];
    a.out = (float*)d_out; a.ws = (unsigned char*)d_ws; a.ph_lo = 0; a.ph_hi = NPH;
    void* kargs[] = {&a};
    hipError_t e = hipLaunchCooperativeKernel((const void*)mega_fwd, dim3(grid), dim3(NT), kargs, LDS_BYTES, stream);
    if (e != hipSuccess) fprintf(stderr, "kernel_launch: cooperative launch failed: %s (grid %d)\n", hipGetErrorString(e), grid);
}
```

```cpp
#include <hip/hip_runtime.h>
#include <stdint.h>
#include <cstdio>

#define GAS __attribute__((address_space(1)))
#define LAS __attribute__((address_space(3)))
typedef unsigned short bf16;
typedef unsigned v4u __attribute__((ext_vector_type(4)));
typedef unsigned v2u __attribute__((ext_vector_type(2)));
typedef float f32x4 __attribute__((ext_vector_type(4)));

constexpr int D = 1024, SEQ = 16384, CTX = 256, MT = SEQ + CTX;
constexpr int MIXW = 512, INW = 3072, G5 = 32, P5 = 64, H5 = 16;
constexpr int NE = 32, DFF = 256;
constexpr int MAXSLOT = 2 * MT + NE * 256;
constexpr float EPS = 1e-6f;
constexpr int NT = 512;

constexpr size_t MiB = 1u << 20;
constexpr size_t WS_CTL = 0, CTL_ZERO_BYTES = 1 * MiB;
constexpr size_t WS_MOD = 1 * MiB;
constexpr size_t WS_XC = 2 * MiB;
constexpr size_t WS_EID = 3 * MiB;
constexpr size_t WS_EW = WS_EID + (size_t)MT * 8;
constexpr size_t WS_STOK = WS_EW + (size_t)MT * 8;
constexpr size_t WS_SW = WS_STOK + (size_t)MAXSLOT * 4;
constexpr size_t WS_TSLOT = WS_SW + (size_t)MAXSLOT * 4;
constexpr size_t WS_HISTG = WS_TSLOT + (size_t)MT * 8;
constexpr size_t WS_H = 4 * MiB;
constexpr size_t WS_PROJ = WS_H + (size_t)MT * 2048;
constexpr size_t WS_YS = WS_PROJ + (size_t)MT * 6144;
constexpr size_t WS_YG = WS_YS + (size_t)3 * MT * 1024;
constexpr size_t WS_PM = WS_YG + (size_t)MT * 1024;
constexpr size_t WS_S5 = WS_PM + (size_t)MT * 2048;
constexpr size_t WS_Z = WS_S5;
constexpr size_t WS_SS = WS_Z + (size_t)1040 * 32 * 256 * 4;
constexpr size_t WS_S5M = WS_SS + (size_t)1040 * 32 * 256 * 2;
constexpr size_t WS_A16 = WS_S5M + (size_t)2 * 32 * 3 * 65536 * 2;
constexpr size_t WS_W = WS_A16 + (size_t)2 * 32 * 2 * 64 * 2 * 4 > WS_S5 + (size_t)2 * MT * 512 * 4 ? WS_A16 + (size_t)2 * 32 * 2 * 64 * 2 * 4 : WS_S5 + (size_t)2 * MT * 512 * 4;
constexpr size_t WS_WIN = WS_W;
constexpr size_t WS_WMG = WS_WIN + (size_t)3072 * 1024 * 2;
constexpr size_t WS_WGLU = WS_WMG + (size_t)3072 * 1024 * 2;
constexpr size_t WS_WBR = WS_WGLU + (size_t)512 * 512 * 2;
constexpr size_t WS_WO = WS_WBR + (size_t)3 * 1024 * 512 * 2;
constexpr size_t WS_W13 = WS_WO + (size_t)1024 * 1024 * 2;
constexpr size_t WS_W2 = WS_W13 + (size_t)32 * 512 * 1024 * 2;
constexpr size_t WS_WSG = WS_W2 + (size_t)32 * 1024 * 256 * 2;
constexpr size_t WS_WR = WS_WSG + (size_t)4 * 128 * 128 * 2;
constexpr size_t WS_END = WS_WR + (size_t)2 * 48 * 1024 * 2;
static_assert(WS_END <= (size_t)377 * MiB, "workspace budget");
constexpr size_t WS_HS = WS_PROJ;
constexpr size_t WS_ACT = WS_YS;
constexpr size_t WS_YS2 = WS_YG;
static_assert(WS_HS + (size_t)MAXSLOT * 2048 <= WS_YS && WS_ACT + (size_t)MAXSLOT * 512 <= WS_YG && WS_YS2 + (size_t)MAXSLOT * 2048 <= WS_W, "moe overlays");
static_assert(WS_HISTG + (size_t)1024 * 32 * 4 <= WS_H, "ws map");
constexpr int CW_CNT = 64;
constexpr int CW_BAR = 4096;

#ifndef PROBE_A
#define PROBE_A -1
#endif
#ifndef PROBE_B
#define PROBE_B -1
#endif
constexpr int TS_OFF = 131072 + 512;
constexpr int LDS_BYTES = 147456;
constexpr int MISC_OFF = 131072 + 320;
constexpr int TAB_OFF = 131072 + 1024;

__device__ __forceinline__ float bf2f(unsigned short b) { return __builtin_bit_cast(float, ((unsigned)b) << 16); }
__device__ __forceinline__ unsigned f2bf(float f) { unsigned u = __builtin_bit_cast(unsigned, f); return (u + 0x7fffu + ((u >> 16) & 1u)) >> 16; }
__device__ __forceinline__ unsigned pk2(float lo, float hi) { return f2bf(lo) | (f2bf(hi) << 16); }
__device__ __forceinline__ float sigmoidf_(float x) { return 1.f / (1.f + __expf(-x)); }
__device__ __forceinline__ float siluf_(float x) { return x / (1.f + __expf(-x)); }
__device__ __forceinline__ float geluf_(float x) { const float u = 0.7978845608028654f * (x + 0.044715f * x * x * x); return x / (1.f + __expf(-2.f * u)); }
__device__ __forceinline__ float wave_sum(float v) {
#pragma unroll
    for (int o = 1; o < 64; o <<= 1) v += __shfl_xor(v, o);
    return v;
}

#define XB_TMO      128
#define XB_XCNT(j)  (256  + 64 * (j))
#define XB_XSUB(j)  (1280 + 64 * (j))
#define XB_XGEN(j)  (2304 + 64 * (j))
#define XB_TOP      3328
#define XB_TOPGEN   3392
#define XCD_BAR_WORDS 3456
#define XB_SPIN_CAP (1u << 24)
__device__ __forceinline__ unsigned xb_ld(unsigned* p)              { return __hip_atomic_load(p, __ATOMIC_RELAXED, __HIP_MEMORY_SCOPE_AGENT); }
__device__ __forceinline__ unsigned xb_add(unsigned* p, unsigned v) { return __hip_atomic_fetch_add(p, v, __ATOMIC_RELAXED, __HIP_MEMORY_SCOPE_AGENT); }
__device__ __forceinline__ unsigned xb_xcc_id() { return (unsigned)__builtin_amdgcn_s_getreg((3 << 11) | 20) & 0xFu; }
#define XB_SPIN(cond, bar) do { unsigned _sp = 0; while (cond) { __builtin_amdgcn_s_sleep(1); \
    if ((++_sp & 255u) == 0u) { if (xb_ld(&(bar)[XB_TMO])) break; if (_sp > XB_SPIN_CAP) { atomicAdd(&(bar)[XB_TMO], 1u); break; } } } } while (0)
struct XcdBarrier { unsigned* bar; unsigned x; volatile LAS unsigned* st; };
__device__ __forceinline__ XcdBarrier xcd_barrier_post(unsigned* bar, volatile LAS unsigned* st) {
    XcdBarrier b; b.bar = bar; b.x = xb_xcc_id(); b.st = st;
    if (threadIdx.x == 0) (void)xb_add(&bar[XB_XCNT(b.x)], 1u);
    return b;
}
__device__ __forceinline__ void xcd_barrier_complete(unsigned* bar, unsigned x, unsigned& nloc, unsigned& nx) {
    const unsigned G = gridDim.x * gridDim.y * gridDim.z;
    unsigned sum, cnt, mine, sp = 0u;
    for (;;) {
        sum = 0u; cnt = 0u; mine = 0u;
#pragma unroll
        for (unsigned j = 0; j < 16; ++j) { const unsigned c = xb_ld(&bar[XB_XCNT(j)]); sum += c; cnt += (c > 0u) ? 1u : 0u; mine = (j == x) ? c : mine; }
        if (sum == G) break;
        __builtin_amdgcn_s_sleep(1);
        if ((++sp & 255u) == 0u) { if (xb_ld(&bar[XB_TMO])) break; if (sp > XB_SPIN_CAP) { atomicAdd(&bar[XB_TMO], 1u); break; } }
    }
    nloc = mine > 0u ? mine : 1u; nx = cnt > 0u ? cnt : 1u;
}
__device__ __forceinline__ void xcd_barrier(const XcdBarrier& b, bool leader) {
    asm volatile("s_waitcnt vmcnt(0)" ::: "memory");
    __syncthreads();
    if (leader) {
        unsigned* bar = b.bar;
        __builtin_amdgcn_s_waitcnt(0);
        unsigned nloc = b.st[0], nx = b.st[1];
        if (nloc == 0u) { xcd_barrier_complete(bar, b.x, nloc, nx); b.st[0] = nloc; b.st[1] = nx; }
        const unsigned old = xb_add(&bar[XB_XSUB(b.x)], 1u);
        const unsigned gen = old / nloc;
        if (old + 1u == (gen + 1u) * nloc) {
            __builtin_amdgcn_fence(__ATOMIC_RELEASE, "agent");
            asm volatile("s_waitcnt vmcnt(0)" ::: "memory");
            const unsigned og = xb_add(&bar[XB_TOP], 1u);
            const unsigned tg = og / nx;
            if (og + 1u == (tg + 1u) * nx) xb_add(&bar[XB_TOPGEN], 1u);
            else XB_SPIN(xb_ld(&bar[XB_TOPGEN]) == tg, bar);
            __builtin_amdgcn_fence(__ATOMIC_ACQUIRE, "agent");
            xb_add(&bar[XB_XGEN(b.x)], 1u);
            asm volatile("s_waitcnt vmcnt(0)" ::: "memory");
        } else {
            XB_SPIN(xb_ld(&bar[XB_XGEN(b.x)]) == gen, bar);
            __builtin_amdgcn_fence(__ATOMIC_ACQUIRE, "agent");
            asm volatile("s_waitcnt vmcnt(0)" ::: "memory");
        }
    }
    __syncthreads();
}

struct Args { const float* in[35]; float* out; unsigned char* ws; int ph_lo, ph_hi; };
struct Frame {
    LAS unsigned char* lds; unsigned char* ws; unsigned* ctl;
    int tid, lane, wave, bid, G;
    const unsigned long long LAS* tab; float* out;
};
__device__ __forceinline__ unsigned long long uni64(unsigned long long v) { const unsigned lo = __builtin_amdgcn_readfirstlane((unsigned)v), hi = __builtin_amdgcn_readfirstlane((unsigned)(v >> 32)); return ((unsigned long long)hi << 32) | lo; }
#define IN_(k) ((const float*)uni64(F.tab[k]))
enum { I_X = 0, I_C, I_CTX, I_CCTX, I_WADA, I_BADA, I_GMIX, I_GFFN, I_WIN, I_LRE, I_LIM, I_LDT, I_BRE, I_BIM, I_CRE, I_CIM, I_DSKIP, I_WGLU, I_SGG, I_SGB, I_WSG, I_BSG,
       I_WCONV, I_WBR, I_WMG, I_BMG, I_WO, I_WGRP, I_BGRP, I_WEXP, I_BEXP, I_W1, I_W3, I_W2, I_GF };

__device__ __forceinline__ const float* mod_ptr(const Frame& F, int l, int row) { return (const float*)(F.ws + WS_MOD) + (size_t)(l * 2 + (row >= SEQ ? 1 : 0)) * 6144; }
__device__ __forceinline__ const float* xsrc_row(const Frame& F, int l, int row) {
    if (l == 0) return row < SEQ ? IN_(I_X) + (size_t)row * D : IN_(I_CTX) + (size_t)(row - SEQ) * D;
    return row < SEQ ? F.out + (size_t)row * D : (const float*)(F.ws + WS_XC) + (size_t)(row - SEQ) * D;
}
__device__ __forceinline__ float* xrun_row(const Frame& F, int row) { return row < SEQ ? F.out + (size_t)row * D : (float*)(F.ws + WS_XC) + (size_t)(row - SEQ) * D; }


namespace pg8 {
#define PG8_LAS __attribute__((address_space(3)))
typedef unsigned short bf16_t;
typedef short bf16x8 __attribute__((ext_vector_type(8)));
typedef float f32x4 __attribute__((ext_vector_type(4)));
typedef unsigned u32x4 __attribute__((ext_vector_type(4)));
constexpr int BM = 256, BK = 64, HALF = 128, HTB = HALF * BK * 2  , STAGE_BYTES = 8 * HTB, NXCD = 8, WGM = 8;

__host__ __device__ __forceinline__ int lds_byte(int r, int c) { const int st = (r >> 4) * 2 + (c >> 5), rr = r & 15, cc = c & 31, ob = rr * 64 + cc * 2; return st * 1024 + (ob ^ (((ob >> 9) & 1) << 5)); }
__host__ __device__ __forceinline__ void stage_rc(int b, int& R, int& C) { const int st = b / 1024, sb = b % 1024, swz = sb ^ (((sb >> 9) & 1) << 5); R = (st >> 1) * 16 + swz / 64; C = (st & 1) * 32 + (swz % 64) / 2; }
__host__ __device__ __forceinline__ int perm32(int rho) { const int n = rho >> 4, i = rho & 15; return 8 * (i >> 2) + 4 * n + (i & 3); }

struct Unit { int pm, pn; };
struct Gemm { const bf16_t* A; const bf16_t* Bt; int M, N, K; };

struct StaticOrder {
    int nM, nN, nwg, G, c;
    __host__ __device__ void init(int M, int N, int G_, int c_) { nM = M / BM; nN = N / BM; nwg = nM * nN; G = G_; c = c_; }
    __host__ __device__ bool next(int i, Unit& u) const {
        const long L = (long)i * G + c; if (L >= nwg) return false;
        int wgid = (int)L; { const int q = nwg / NXCD, r = nwg % NXCD, xcd = wgid % NXCD, off = wgid / NXCD; wgid = (xcd < r ? xcd * (q + 1) : r * (q + 1) + (xcd - r) * q) + off; }
        const int nig = WGM * nN, gid = wgid / nig, fm = gid * WGM, gsz = (nM - fm) < WGM ? (nM - fm) : WGM;
        u.pm = fm + ((wgid % nig) % gsz); u.pn = (wgid % nig) / gsz; return true;
    }
    __device__ __forceinline__ void a_ready(const Unit&) const {}
    __device__ __forceinline__ void done(const Unit&) const {}
};
__device__ __forceinline__ unsigned cvt_pk_bf16(float lo, float hi) { unsigned r; asm volatile("v_cvt_pk_bf16_f32 %0, %1, %2" : "=v"(r) : "v"(lo), "v"(hi)); return r; }
template <class Epi, class Sched, bool ALIGN_EPI = false, bool SP2 = false>
__device__ __forceinline__ void gemm_phase(PG8_LAS unsigned char* lds, const Gemm g, const Sched& S, const Epi& E, int tid_in) {
    int tid_ = tid_in; asm volatile("" : "+v"(tid_));
    const int tid = tid_, wid = __builtin_amdgcn_readfirstlane(tid >> 6), lane = tid & 63, wr = wid >> 2, wc = wid & 3, fr = lane & 15, fq = lane >> 4;
    const int K = g.K, nt = K / BK;
    unsigned voffA[2], voffB[2];
#pragma unroll
    for (int i = 0; i < 2; ++i) { int R, C; stage_rc(tid * 16 + i * 8192, R, C); const int Rb = Epi::PERM ? ((R & ~31) + perm32(R & 31)) : R;
        voffA[i] = (unsigned)(R * K + C) * 2u; voffB[i] = (unsigned)(Rb * K + C) * 2u; }
    const size_t kstep = (size_t)(BK * 2);
    const size_t hstep = (size_t)HALF * K * 2;
    const size_t tstep = 2 * hstep;
    const unsigned ldsw = (unsigned)wid * 1024u;
    const int aoff = lds_byte(wr * 64 + fr, fq * 8), boff = lds_byte(wc * 32 + fr, fq * 8);
#define PG8_SA(b, h) (((b) * 2 + (h)) * HTB)
#define PG8_SB(b, h) ((4 + (b) * 2 + (h)) * HTB)
#define PG8_STAGE(bufoff, gbase, voff) do { _Pragma("unroll") for (int _i = 0; _i < 2; ++_i) \
        __builtin_amdgcn_global_load_lds((const unsigned*)((const char*)(gbase) + (voff)[_i]), (PG8_LAS unsigned*)(lds + (bufoff) + ldsw + _i * 8192), 16, 0, 0); } while (0)
#define PG8_LDA(dst, b, h) do { _Pragma("unroll") for (int m = 0; m < 4; ++m) _Pragma("unroll") for (int k = 0; k < 2; ++k) dst[m][k] = *(const PG8_LAS bf16x8*)(lds + PG8_SA(b, h) + aoff + m * 2048 + k * 1024); } while (0)
#define PG8_LDB(dst, b, h) do { _Pragma("unroll") for (int n = 0; n < 2; ++n) _Pragma("unroll") for (int k = 0; k < 2; ++k) dst[n][k] = *(const PG8_LAS bf16x8*)(lds + PG8_SB(b, h) + boff + n * 2048 + k * 1024); } while (0)
#define PG8_MMA(ai, bj, At, Bt) do { __builtin_amdgcn_s_setprio(1); _Pragma("unroll") for (int m = 0; m < 4; ++m) _Pragma("unroll") for (int n = 0; n < 2; ++n) _Pragma("unroll") for (int k = 0; k < 2; ++k) \
        acc[ai][bj][m][n] = __builtin_amdgcn_mfma_f32_16x16x32_bf16(Bt[n][k], At[m][k], acc[ai][bj][m][n], 0, 0, 0); __builtin_amdgcn_s_setprio(0); } while (0)
#define PG8_WAIT_V(n) asm volatile("s_waitcnt vmcnt(" #n ")" ::: "memory")
#define PG8_WAIT_L(n) asm volatile("s_waitcnt lgkmcnt(" #n ")" ::: "memory")
#define PG8_BAR __builtin_amdgcn_s_barrier()
#define PG8_SCHED __builtin_amdgcn_sched_barrier(0)
    Unit cur, nxt; int ui = 0;
    if (!S.next(0, cur)) return;
    f32x4 acc[2][2][4][2];
#pragma unroll
    for (int a = 0; a < 2; ++a)
#pragma unroll
        for (int b = 0; b < 2; ++b)
#pragma unroll
            for (int m = 0; m < 4; ++m)
#pragma unroll
                for (int n = 0; n < 2; ++n) acc[a][b][m][n] = (f32x4){0.f, 0.f, 0.f, 0.f};
    bf16x8 At[4][2], B0[2][2], B1[2][2];
    const char* cA = (const char*)g.A + (size_t)cur.pm * tstep; const char* cB = (const char*)g.Bt + (size_t)cur.pn * tstep;
    S.a_ready(cur);
    if constexpr (SP2) {
        PG8_STAGE(PG8_SB(0, 0), cB, voffB); PG8_STAGE(PG8_SB(0, 1), cB + hstep, voffB); PG8_STAGE(PG8_SA(0, 0), cA, voffA); PG8_STAGE(PG8_SA(0, 1), cA + hstep, voffA);
        if (wr == 1) PG8_BAR;
        PG8_WAIT_V(2); PG8_BAR;
        PG8_STAGE(PG8_SB(1, 0), cB + kstep, voffB); PG8_STAGE(PG8_SA(1, 0), cA + kstep, voffA); PG8_STAGE(PG8_SB(1, 1), cB + hstep + kstep, voffB);
        PG8_WAIT_V(6); PG8_BAR;
    } else {
        PG8_STAGE(PG8_SB(0, 0), cB, voffB); PG8_STAGE(PG8_SA(0, 0), cA, voffA); PG8_STAGE(PG8_SB(0, 1), cB + hstep, voffB); PG8_STAGE(PG8_SA(0, 1), cA + hstep, voffA);
        if (wr == 1) PG8_BAR;
        PG8_WAIT_V(4); PG8_BAR;
        PG8_STAGE(PG8_SB(1, 0), cB + kstep, voffB); PG8_STAGE(PG8_SA(1, 0), cA + kstep, voffA); PG8_STAGE(PG8_SB(1, 1), cB + hstep + kstep, voffB);
        PG8_WAIT_V(6); PG8_BAR;
    }
    for (;;) {
        const bool has_next = S.next(ui + 1, nxt);
        const char* nA = has_next ? (const char*)g.A + (size_t)nxt.pm * tstep : cA; const char* nB = has_next ? (const char*)g.Bt + (size_t)nxt.pn * tstep : cB;
#pragma unroll 1
        for (int t = 0; t < nt; t += 2) {
            const bool last = (t == nt - 2);
            const char* a1 = cA + (size_t)(t + 1) * kstep;
            const char* a2 = last ? nA : cA + (size_t)(t + 2) * kstep; const char* b2 = last ? nB : cB + (size_t)(t + 2) * kstep;
            const char* a3 = a2 + kstep; const char* b3 = b2 + kstep;
            if (last && has_next) S.a_ready(nxt);
            if constexpr (SP2) {
            PG8_LDB(B0, 0, 0); PG8_LDB(B1, 0, 1); PG8_SCHED; PG8_LDA(At, 0, 0); PG8_STAGE(PG8_SA(1, 1), a1 + hstep, voffA);
            PG8_WAIT_V(8); PG8_WAIT_L(0); PG8_BAR; PG8_MMA(0, 0, At, B0); PG8_MMA(0, 1, At, B1); PG8_BAR; PG8_SCHED;
            PG8_LDA(At, 0, 1); PG8_STAGE(PG8_SB(0, 0), b2, voffB); PG8_STAGE(PG8_SB(0, 1), b2 + hstep, voffB); PG8_STAGE(PG8_SA(0, 0), a2, voffA);
            PG8_WAIT_V(8); PG8_WAIT_L(0); PG8_BAR; PG8_MMA(1, 0, At, B0); PG8_MMA(1, 1, At, B1); PG8_BAR; PG8_SCHED;
            PG8_LDB(B0, 1, 0); PG8_LDB(B1, 1, 1); PG8_SCHED; PG8_LDA(At, 1, 0); PG8_STAGE(PG8_SA(0, 1), a2 + hstep, voffA);
            PG8_WAIT_V(8); PG8_WAIT_L(0); PG8_BAR; PG8_MMA(0, 0, At, B0); PG8_MMA(0, 1, At, B1); PG8_BAR; PG8_SCHED;
            PG8_LDA(At, 1, 1); PG8_STAGE(PG8_SB(1, 0), b3, voffB); PG8_STAGE(PG8_SB(1, 1), b3 + hstep, voffB); PG8_STAGE(PG8_SA(1, 0), a3, voffA);
            PG8_WAIT_V(8); PG8_WAIT_L(0); PG8_BAR; PG8_MMA(1, 0, At, B0); PG8_MMA(1, 1, At, B1); PG8_BAR; PG8_SCHED;
            } else {
            PG8_LDB(B0, 0, 0); PG8_SCHED; PG8_LDA(At, 0, 0); PG8_STAGE(PG8_SA(1, 1), a1 + hstep, voffA);
            PG8_WAIT_L(8); PG8_BAR; PG8_WAIT_L(0); PG8_MMA(0, 0, At, B0); PG8_BAR; PG8_SCHED;
            PG8_LDB(B1, 0, 1); PG8_STAGE(PG8_SB(0, 0), b2, voffB);
            PG8_BAR; PG8_WAIT_L(0); PG8_MMA(0, 1, At, B1); PG8_BAR;
            PG8_LDA(At, 0, 1); PG8_STAGE(PG8_SA(0, 0), a2, voffA);
            PG8_BAR; PG8_WAIT_L(0); PG8_MMA(1, 0, At, B0); PG8_BAR; PG8_SCHED;
            PG8_STAGE(PG8_SB(0, 1), b2 + hstep, voffB);
            PG8_WAIT_V(6); PG8_BAR; PG8_MMA(1, 1, At, B1); PG8_BAR;
            PG8_LDB(B0, 1, 0); PG8_SCHED; PG8_LDA(At, 1, 0); PG8_STAGE(PG8_SA(0, 1), a2 + hstep, voffA);
            PG8_WAIT_L(8); PG8_BAR; PG8_WAIT_L(0); PG8_MMA(0, 0, At, B0); PG8_BAR; PG8_SCHED;
            PG8_LDB(B1, 1, 1); PG8_STAGE(PG8_SB(1, 0), b3, voffB);
            PG8_BAR; PG8_WAIT_L(0); PG8_MMA(0, 1, At, B1); PG8_BAR;
            PG8_LDA(At, 1, 1); PG8_STAGE(PG8_SA(1, 0), a3, voffA);
            PG8_BAR; PG8_WAIT_L(0); PG8_MMA(1, 0, At, B0); PG8_BAR; PG8_SCHED;
            PG8_STAGE(PG8_SB(1, 1), b3 + hstep, voffB);
            PG8_WAIT_V(6); PG8_BAR; PG8_MMA(1, 1, At, B1); PG8_BAR;
            }
        }
        if constexpr (ALIGN_EPI) { if (wr == 0) PG8_BAR; }
        if constexpr (!Epi::AFTER_DRAIN) { E(acc, cur, wr, wc, fr, fq); S.done(cur); }
        if (!has_next) break;
#pragma unroll
        for (int a = 0; a < 2; ++a)
#pragma unroll
            for (int b = 0; b < 2; ++b)
#pragma unroll
                for (int m = 0; m < 4; ++m)
#pragma unroll
                    for (int n = 0; n < 2; ++n) acc[a][b][m][n] = (f32x4){0.f, 0.f, 0.f, 0.f};
        cur = nxt; cA = nA; cB = nB; ++ui;
        if constexpr (ALIGN_EPI) { if (wr == 1) PG8_BAR; }
    }
    PG8_WAIT_V(0);
    if constexpr (!ALIGN_EPI) { if (wr == 0) PG8_BAR; }
    PG8_BAR;
    if constexpr (Epi::AFTER_DRAIN) { E.fused(acc, cur, wr, wc, fr, fq, lds, wid, lane); S.done(cur); }
#undef PG8_SA
#undef PG8_SB
#undef PG8_STAGE
#undef PG8_LDA
#undef PG8_LDB
#undef PG8_MMA
#undef PG8_WAIT_V
#undef PG8_WAIT_L
#undef PG8_BAR
#undef PG8_SCHED
}
}

constexpr bool PG_ALIGN = true, PG_SP2 = true;
__device__ __forceinline__ float bflo(unsigned w) { return __builtin_bit_cast(float, w << 16); }
__device__ __forceinline__ float bfhi(unsigned w) { return __builtin_bit_cast(float, w & 0xffff0000u); }
__device__ __forceinline__ unsigned cvtpk(float lo, float hi) { return pg8::cvt_pk_bf16(lo, hi); }

__device__ __forceinline__ void transpose_item(const float* W, int N, int k0, int n0, bf16* WT, int K, size_t dst_row0, LAS float* scr, int lane) {
    float v[32];
#pragma unroll
    for (int i = 0; i < 32; ++i) v[i] = W[(size_t)(k0 + 2 * i + (lane >> 5)) * N + n0 + (lane & 31)];
#pragma unroll
    for (int i = 0; i < 32; ++i) scr[(2 * i + (lane >> 5)) * 33 + (lane & 31)] = v[i];
    asm volatile("s_waitcnt lgkmcnt(0)" ::: "memory");
    const int c = lane & 7;
#pragma unroll
    for (int j = 0; j < 4; ++j) { const int n = (lane >> 3) + 8 * j; const LAS float* s = scr + (8 * c) * 33 + n;
        v4u o; o.x = pk2(s[0 * 33], s[1 * 33]); o.y = pk2(s[2 * 33], s[3 * 33]); o.z = pk2(s[4 * 33], s[5 * 33]); o.w = pk2(s[6 * 33], s[7 * 33]);
        *(v4u*)(WT + (dst_row0 + n) * K + k0 + 8 * c) = o; }
    asm volatile("s_waitcnt lgkmcnt(0)" ::: "memory");
}
__device__ __forceinline__ void convert_weights(Frame& F, int l) {
    LAS float* scr = (LAS float*)(F.lds + F.wave * 16384);
    const int gw = F.bid * (NT / 64) + F.wave, ngw = F.G * (NT / 64);
    constexpr int I_IN = 16 * 96, I_MG = 16 * 96, I_GLU = 8 * 16, I_BR = 3 * 8 * 32, I_O = 16 * 32, I_1 = 32 * 16 * 8, I_3 = I_1, I_2 = 32 * 4 * 32;
    constexpr int NITEMS = I_IN + I_MG + I_GLU + I_BR + I_O + I_1 + I_3 + I_2;
    for (int it = gw; it < NITEMS; it += ngw) {
        int r = it;
        if (r < I_IN) { const int kb = r / 96, nb = r % 96; transpose_item(IN_(I_WIN) + (size_t)l * D * INW, INW, 64 * kb, 32 * nb, (bf16*)(F.ws + WS_WIN), 1024, 32 * nb, scr, F.lane); continue; } r -= I_IN;
        if (r < I_MG) { const int kb = r / 96, nb = r % 96; transpose_item(IN_(I_WMG) + (size_t)l * D * INW, INW, 64 * kb, 32 * nb, (bf16*)(F.ws + WS_WMG), 1024, 32 * nb, scr, F.lane); continue; } r -= I_MG;
        if (r < I_GLU) { const int kb = r / 16, nb = r % 16; transpose_item(IN_(I_WGLU) + (size_t)l * MIXW * MIXW, MIXW, 64 * kb, 32 * nb, (bf16*)(F.ws + WS_WGLU), 512, 32 * nb, scr, F.lane); continue; } r -= I_GLU;
        if (r < I_BR) { const int kk = r / 256, q = r % 256, kb = q / 32, nb = q % 32; transpose_item(IN_(I_WBR) + ((size_t)l * 3 + kk) * MIXW * D, D, 64 * kb, 32 * nb, (bf16*)(F.ws + WS_WBR), 512, (size_t)kk * 1024 + 32 * nb, scr, F.lane); continue; } r -= I_BR;
        if (r < I_O) { const int kb = r / 32, nb = r % 32; transpose_item(IN_(I_WO) + (size_t)l * D * D, D, 64 * kb, 32 * nb, (bf16*)(F.ws + WS_WO), 1024, 32 * nb, scr, F.lane); continue; } r -= I_O;
        if (r < I_1 + I_3) { const int which = r / I_1, q = r % I_1, e = q / 128, q2 = q % 128, kb = q2 / 8, nb = q2 % 8;
            const float* W = IN_(which ? I_W3 : I_W1) + ((size_t)l * NE + e) * D * DFF; const int n0 = 32 * nb;
            transpose_item(W, DFF, 64 * kb, n0, (bf16*)(F.ws + WS_W13), 1024, (size_t)e * 512 + (n0 / 128) * 256 + which * 128 + (n0 % 128), scr, F.lane); continue; } r -= I_1 + I_3;
        { const int e = r / 128, q = r % 128, kb = q / 32, nb = q % 32; transpose_item(IN_(I_W2) + ((size_t)l * NE + e) * DFF * D, D, 64 * kb, 32 * nb, (bf16*)(F.ws + WS_W2), 256, (size_t)e * 1024 + 32 * nb, scr, F.lane); }
    }
    { bf16* wr = (bf16*)(F.ws + WS_WR); const float* wg = IN_(I_WGRP) + (size_t)l * D * 4; const float* we = IN_(I_WEXP) + (size_t)l * D * 32;
      for (int i = F.bid * NT + F.tid; i < 48 * 1024; i += F.G * NT) { const int n = i >> 10, kk = i & 1023; const float w = n < 4 ? wg[kk * 4 + n] : (n < 36 ? we[kk * 32 + n - 4] : 0.f);
          const unsigned hi = f2bf(w); const float lo = w - __builtin_bit_cast(float, hi << 16); wr[i] = (bf16)hi; wr[48 * 1024 + i] = (bf16)f2bf(lo); } }
    { const float* s = IN_(I_WSG) + (size_t)l * 4 * 128 * 128; bf16* d = (bf16*)(F.ws + WS_WSG);
      for (int i = (F.bid * NT + F.tid) * 2; i < 4 * 128 * 128; i += F.G * NT * 2) *(unsigned*)(d + i) = pk2(s[i], s[i + 1]); }
}

struct EpiProj { static constexpr bool PERM = true, AFTER_DRAIN = false; bf16* O;
    __device__ __forceinline__ void operator()(const pg8::f32x4 (&acc)[2][2][4][2], const pg8::Unit& u, int wr, int wc, int fr, int fq) const {
        const int row0 = u.pm * 256 + wr * 64 + fr, col0 = u.pn * 256 + wc * 32 + 8 * fq; const bool act = (u.pn >= 2 && u.pn < 6);
#pragma unroll
        for (int ai = 0; ai < 2; ++ai)
#pragma unroll
            for (int m = 0; m < 4; ++m) { bf16* rowp = O + (size_t)(row0 + ai * 128 + m * 16) * INW + col0;
#pragma unroll
                for (int bj = 0; bj < 2; ++bj) { pg8::f32x4 v0 = acc[ai][bj][m][0], v1 = acc[ai][bj][m][1];
                    if (act) {
#pragma unroll
                        for (int j = 0; j < 4; ++j) { v0[j] = geluf_(v0[j]); v1[j] = geluf_(v1[j]); } }
                    v4u w; w.x = cvtpk(v0[0], v0[1]); w.y = cvtpk(v0[2], v0[3]); w.z = cvtpk(v1[0], v1[1]); w.w = cvtpk(v1[2], v1[3]); *(v4u*)(rowp + bj * 128) = w; } }
    } };
struct EpiGlu { static constexpr bool PERM = true, AFTER_DRAIN = false; const bf16* YG; bf16* YA;
    __device__ __forceinline__ void operator()(const pg8::f32x4 (&acc)[2][2][4][2], const pg8::Unit& u, int wr, int wc, int fr, int fq) const {
        const int row0 = u.pm * 256 + wr * 64 + fr, col0 = u.pn * 256 + wc * 32 + 8 * fq;
#pragma unroll
        for (int ai = 0; ai < 2; ++ai) {
        v4u gv[4][2];
#pragma unroll
            for (int m = 0; m < 4; ++m)
#pragma unroll
                for (int bj = 0; bj < 2; ++bj) gv[m][bj] = *(const v4u*)(YG + (size_t)(row0 + ai * 128 + m * 16) * MIXW + col0 + bj * 128);
        asm volatile("" ::: "memory");
#pragma unroll
            for (int m = 0; m < 4; ++m) { const size_t off = (size_t)(row0 + ai * 128 + m * 16) * MIXW + col0;
#pragma unroll
                for (int bj = 0; bj < 2; ++bj) { const pg8::f32x4 v0 = acc[ai][bj][m][0], v1 = acc[ai][bj][m][1]; const v4u g = gv[m][bj];
                    v4u w; w.x = cvtpk(bflo(g.x) * sigmoidf_(v0[0]), bfhi(g.x) * sigmoidf_(v0[1])); w.y = cvtpk(bflo(g.y) * sigmoidf_(v0[2]), bfhi(g.y) * sigmoidf_(v0[3]));
                    w.z = cvtpk(bflo(g.z) * sigmoidf_(v1[0]), bfhi(g.z) * sigmoidf_(v1[1])); w.w = cvtpk(bflo(g.w) * sigmoidf_(v1[2]), bfhi(g.w) * sigmoidf_(v1[3])); *(v4u*)(YA + off + bj * 128) = w; } }
        asm volatile("" ::: "memory"); }
    } };
struct EpiBr { static constexpr bool PERM = true, AFTER_DRAIN = false; bf16* BR;
    __device__ __forceinline__ void operator()(const pg8::f32x4 (&acc)[2][2][4][2], const pg8::Unit& u, int wr, int wc, int fr, int fq) const {
        const int pm = u.pm % (MT / 256); const int row0 = pm * 256 + wr * 64 + fr, col0 = u.pn * 256 + wc * 32 + 8 * fq;
#pragma unroll
        for (int ai = 0; ai < 2; ++ai)
#pragma unroll
            for (int m = 0; m < 4; ++m) { bf16* rowp = BR + (size_t)(row0 + ai * 128 + m * 16) * INW + col0;
#pragma unroll
                for (int bj = 0; bj < 2; ++bj) { const pg8::f32x4 v0 = acc[ai][bj][m][0], v1 = acc[ai][bj][m][1];
                    v4u w; w.x = cvtpk(v0[0], v0[1]); w.y = cvtpk(v0[2], v0[3]); w.z = cvtpk(v1[0], v1[1]); w.w = cvtpk(v1[2], v1[3]); *(v4u*)(rowp + bj * 128) = w; } }
    } };
struct SchedBr { int G, c, nM;
    __device__ __forceinline__ bool next(int i, pg8::Unit& u) const { const int Lq = i * G + c; if (Lq >= 3 * nM * 4) return false; const int k = Lq / (nM * 4), r = Lq % (nM * 4);
        u.pm = k * (MT / 256) + r / 4; u.pn = k * 4 + r % 4; return true; }
    __device__ __forceinline__ void a_ready(const pg8::Unit&) const {}
    __device__ __forceinline__ void done(const pg8::Unit&) const {} };
struct EpiMerge { static constexpr bool PERM = true, AFTER_DRAIN = false; const bf16* BR; bf16* PM; const float* bm;
    __device__ __forceinline__ void operator()(const pg8::f32x4 (&acc)[2][2][4][2], const pg8::Unit& u, int wr, int wc, int fr, int fq) const {
        const int k = u.pn >> 2, dt = u.pn & 3; const int row0 = u.pm * 256 + wr * 64 + fr, col0 = dt * 256 + wc * 32 + 8 * fq;
#pragma unroll
        for (int bj = 0; bj < 2; ++bj) { const pg8::f32x4 b0 = *(const pg8::f32x4*)(bm + k * 1024 + col0 + bj * 128), b1 = *(const pg8::f32x4*)(bm + k * 1024 + col0 + bj * 128 + 4);
#pragma unroll
            for (int ai = 0; ai < 2; ++ai) {
            v4u brv[4], pmv[4];
#pragma unroll
                for (int m = 0; m < 4; ++m) { const size_t r = (size_t)(row0 + ai * 128 + m * 16); brv[m] = *(const v4u*)(BR + r * INW + k * 1024 + col0 + bj * 128);
                    pmv[m] = k > 0 ? *(const v4u*)(PM + r * D + col0 + bj * 128) : (v4u){0u, 0u, 0u, 0u}; }
                asm volatile("" ::: "memory");
#pragma unroll
                for (int m = 0; m < 4; ++m) { const size_t r = (size_t)(row0 + ai * 128 + m * 16); const v4u br = brv[m], o = pmv[m];
                    const pg8::f32x4 v0 = acc[ai][bj][m][0] + b0, v1 = acc[ai][bj][m][1] + b1;
                    float p[8] = {sigmoidf_(v0[0]) * bflo(br.x), sigmoidf_(v0[1]) * bfhi(br.x), sigmoidf_(v0[2]) * bflo(br.y), sigmoidf_(v0[3]) * bfhi(br.y),
                                  sigmoidf_(v1[0]) * bflo(br.z), sigmoidf_(v1[1]) * bfhi(br.z), sigmoidf_(v1[2]) * bflo(br.w), sigmoidf_(v1[3]) * bfhi(br.w)};
                    if (k > 0) { p[0] += bflo(o.x); p[1] += bfhi(o.x); p[2] += bflo(o.y); p[3] += bfhi(o.y); p[4] += bflo(o.z); p[5] += bfhi(o.z); p[6] += bflo(o.w); p[7] += bfhi(o.w); }
                    v4u w; w.x = cvtpk(p[0], p[1]); w.y = cvtpk(p[2], p[3]); w.z = cvtpk(p[4], p[5]); w.w = cvtpk(p[6], p[7]); *(v4u*)(PM + r * D + col0 + bj * 128) = w; }
                asm volatile("" ::: "memory"); } }
    } };
struct SchedMerge { int G, c, nM;
    __device__ __forceinline__ bool next(int i, pg8::Unit& u) const { const int v = (i / 3) * G + c, k = i % 3; if (v >= nM * 4) return false; u.pm = v >> 2; u.pn = k * 4 + (v & 3); return true; }
    __device__ __forceinline__ void a_ready(const pg8::Unit&) const {}
    __device__ __forceinline__ void done(const pg8::Unit&) const {} };
struct EpiWo { static constexpr bool PERM = false, AFTER_DRAIN = false; const float* xs_lat; const float* xs_ctx; float* out; float* xc; const float* mod_l;
    __device__ __forceinline__ void operator()(const pg8::f32x4 (&acc)[2][2][4][2], const pg8::Unit& u, int wr, int wc, int fr, int fq) const {
        const int row0 = u.pm * 256 + wr * 64 + fr, col0 = u.pn * 256 + wc * 32 + 4 * fq;
        const float* ga = mod_l + 2048;
        pg8::f32x4 gv[2][2];
#pragma unroll
        for (int bj = 0; bj < 2; ++bj)
#pragma unroll
            for (int n = 0; n < 2; ++n) gv[bj][n] = *(const pg8::f32x4*)(ga + col0 + bj * 128 + n * 16);
#pragma unroll
        for (int ai = 0; ai < 2; ++ai) {
#pragma unroll
            for (int mp = 0; mp < 2; ++mp) {
            pg8::f32x4 xv[2][2][2];
#pragma unroll
            for (int m = 0; m < 2; ++m) { const size_t off = (size_t)(row0 + ai * 128 + (mp * 2 + m) * 16) * D + col0;
#pragma unroll
                for (int bj = 0; bj < 2; ++bj)
#pragma unroll
                    for (int n = 0; n < 2; ++n) xv[m][bj][n] = *(const pg8::f32x4*)(xs_lat + off + bj * 128 + n * 16); }
            asm volatile("" ::: "memory");
#pragma unroll
            for (int m = 0; m < 2; ++m) { const size_t off = (size_t)(row0 + ai * 128 + (mp * 2 + m) * 16) * D + col0;
#pragma unroll
                for (int bj = 0; bj < 2; ++bj)
#pragma unroll
                    for (int n = 0; n < 2; ++n) *(pg8::f32x4*)(out + off + bj * 128 + n * 16) = xv[m][bj][n] + gv[bj][n] * acc[ai][bj][m + mp * 2][n]; }
            asm volatile("" ::: "memory"); }
        }
    } };
constexpr int MOETAB_OFF = 131072 + 2048;
template <int NPN> __device__ __forceinline__ int moe_build_table(Frame& F, const unsigned* cnt) {
    LAS unsigned* tabw = (LAS unsigned*)(F.lds + MOETAB_OFF);
    int total = 0, rowtile0 = 0;
    for (int e = 0; e < NE; ++e) { const int nt_e = ((int)cnt[e] + 255) >> 8;
        for (int q = F.tid; q < nt_e * NPN; q += NT) tabw[total + q] = ((unsigned)(rowtile0 + q / NPN) << 16) | (unsigned)(e * NPN + q % NPN);
        total += nt_e * NPN; rowtile0 += nt_e; }
    __syncthreads();
    return total;
}
struct SchedMoe { int G, c, total; const LAS unsigned* tabw;
    __device__ __forceinline__ bool next(int i, pg8::Unit& u) const { const int Lq = i * G + c; if (Lq >= total) return false; const unsigned w = (unsigned)__builtin_amdgcn_readfirstlane((int)tabw[Lq]); u.pm = (int)(w >> 16); u.pn = (int)(w & 0xffffu); return true; }
    __device__ __forceinline__ void a_ready(const pg8::Unit&) const {}
    __device__ __forceinline__ void done(const pg8::Unit&) const {} };
struct EpiUp { static constexpr bool PERM = true, AFTER_DRAIN = false; bf16* ACT; const float* SW;
    __device__ __forceinline__ void operator()(const pg8::f32x4 (&acc)[2][2][4][2], const pg8::Unit& u, int wr, int wc, int fr, int fq) const {
        const int row0 = u.pm * 256 + wr * 64 + fr, f0 = (u.pn & 1) * 128 + wc * 32 + 8 * fq;
#pragma unroll
        for (int ai = 0; ai < 2; ++ai)
#pragma unroll
            for (int m = 0; m < 4; ++m) { const int slot = row0 + ai * 128 + m * 16; const float w = SW[slot];
                const pg8::f32x4 a0 = acc[ai][0][m][0], a1 = acc[ai][0][m][1], b0 = acc[ai][1][m][0], b1 = acc[ai][1][m][1];
                v4u o; o.x = cvtpk(siluf_(a0[0]) * b0[0] * w, siluf_(a0[1]) * b0[1] * w); o.y = cvtpk(siluf_(a0[2]) * b0[2] * w, siluf_(a0[3]) * b0[3] * w);
                o.z = cvtpk(siluf_(a1[0]) * b1[0] * w, siluf_(a1[1]) * b1[1] * w); o.w = cvtpk(siluf_(a1[2]) * b1[2] * w, siluf_(a1[3]) * b1[3] * w);
                *(v4u*)(ACT + (size_t)slot * DFF + f0) = o; }
    } };
struct EpiDown { static constexpr bool PERM = true, AFTER_DRAIN = false; bf16* YS2;
    __device__ __forceinline__ void operator()(const pg8::f32x4 (&acc)[2][2][4][2], const pg8::Unit& u, int wr, int wc, int fr, int fq) const {
        const int row0 = u.pm * 256 + wr * 64 + fr, col0 = (u.pn & 3) * 256 + wc * 32 + 8 * fq;
#pragma unroll
        for (int ai = 0; ai < 2; ++ai)
#pragma unroll
            for (int m = 0; m < 4; ++m) { bf16* rowp = YS2 + (size_t)(row0 + ai * 128 + m * 16) * D + col0;
#pragma unroll
                for (int bj = 0; bj < 2; ++bj) { const pg8::f32x4 v0 = acc[ai][bj][m][0], v1 = acc[ai][bj][m][1];
                    v4u w; w.x = cvtpk(v0[0], v0[1]); w.y = cvtpk(v0[2], v0[3]); w.z = cvtpk(v1[0], v1[1]); w.w = cvtpk(v1[2], v1[3]); *(v4u*)(rowp + bj * 128) = w; } }
    } };

__device__ __forceinline__ void ph2_fast(Frame& F, int l) {
    pg8::Gemm g{(const bf16*)(F.ws + WS_H), (const bf16*)(F.ws + WS_WIN), SEQ, INW, D}; pg8::StaticOrder S; S.init(SEQ, INW, F.G, F.bid);
    EpiProj E{(bf16*)(F.ws + WS_PROJ)}; pg8::gemm_phase<EpiProj, pg8::StaticOrder, PG_ALIGN, PG_SP2>(F.lds, g, S, E, F.tid);
}
__device__ __forceinline__ void ph6_fast(Frame& F, int l) {
    pg8::Gemm g{(const bf16*)(F.ws + WS_YG), (const bf16*)(F.ws + WS_WGLU), MT, MIXW, MIXW}; pg8::StaticOrder S; S.init(SEQ, MIXW, F.G, F.bid);
    EpiGlu E{(const bf16*)(F.ws + WS_YG), (bf16*)(F.ws + WS_YS)}; pg8::gemm_phase<EpiGlu, pg8::StaticOrder, PG_ALIGN, PG_SP2>(F.lds, g, S, E, F.tid);
}
__device__ __forceinline__ void ph7_fast(Frame& F, int l) {
    pg8::Gemm g{(const bf16*)(F.ws + WS_YS), (const bf16*)(F.ws + WS_WBR), 3 * MT, 3 * D, MIXW}; SchedBr S{F.G, F.bid, SEQ / 256};
    EpiBr E{(bf16*)(F.ws + WS_PROJ)}; pg8::gemm_phase<EpiBr, SchedBr, PG_ALIGN, PG_SP2>(F.lds, g, S, E, F.tid);
}
__device__ __forceinline__ void ph8_fast(Frame& F, int l) {
    pg8::Gemm g{(const bf16*)(F.ws + WS_H), (const bf16*)(F.ws + WS_WMG), MT, INW, D}; SchedMerge S{F.G, F.bid, SEQ / 256};
    EpiMerge E{(const bf16*)(F.ws + WS_PROJ), (bf16*)(F.ws + WS_PM), IN_(I_BMG) + l * INW}; pg8::gemm_phase<EpiMerge, SchedMerge, PG_ALIGN, PG_SP2>(F.lds, g, S, E, F.tid);
}
__device__ __forceinline__ void ph9_fast(Frame& F, int l) {
    pg8::Gemm g{(const bf16*)(F.ws + WS_PM), (const bf16*)(F.ws + WS_WO), MT, D, D}; pg8::StaticOrder S; S.init(SEQ, D, F.G, F.bid);
    EpiWo E{l == 0 ? IN_(I_X) : F.out, l == 0 ? IN_(I_CTX) : (const float*)(F.ws + WS_XC), F.out, (float*)(F.ws + WS_XC), (const float*)(F.ws + WS_MOD) + (size_t)l * 2 * 6144};
    pg8::gemm_phase<EpiWo, pg8::StaticOrder, PG_ALIGN, PG_SP2>(F.lds, g, S, E, F.tid);
}
__device__ __forceinline__ void ph12_fast(Frame& F, int l) {
    pg8::Gemm g{(const bf16*)(F.ws + WS_HS), (const bf16*)(F.ws + WS_W13), MAXSLOT, NE * 512, D}; const int total = moe_build_table<2>(F, F.ctl + CW_CNT + l * 128); SchedMoe S{F.G, F.bid, total, (const LAS unsigned*)(F.lds + MOETAB_OFF)};
    EpiUp E{(bf16*)(F.ws + WS_ACT), (const float*)(F.ws + WS_SW)}; pg8::gemm_phase<EpiUp, SchedMoe, PG_ALIGN, PG_SP2>(F.lds, g, S, E, F.tid);
}
__device__ __forceinline__ void ph13_fast(Frame& F, int l) {
    pg8::Gemm g{(const bf16*)(F.ws + WS_ACT), (const bf16*)(F.ws + WS_W2), MAXSLOT, NE * D, DFF}; const int total = moe_build_table<4>(F, F.ctl + CW_CNT + l * 128); SchedMoe S{F.G, F.bid, total, (const LAS unsigned*)(F.lds + MOETAB_OFF)};
    EpiDown E{(bf16*)(F.ws + WS_YS2)}; pg8::gemm_phase<EpiDown, SchedMoe, PG_ALIGN, PG_SP2>(F.lds, g, S, E, F.tid);
}


typedef short bf16x8 __attribute__((ext_vector_type(8)));
constexpr int NSB = MT / 16;
__device__ __forceinline__ void s5_precompute(Frame& F) {
    LAS float* APr = (LAS float*)F.lds; LAS float* APi = APr + 2176; LAS float* BBr = APi + 2176; LAS float* BBi = BBr + 2048; LAS float* CCr = BBi + 2048; LAS float* CCi = CCr + 2048; LAS float* KK = CCi + 2048;
    for (int item = F.bid; item < 2 * G5; item += F.G) { const int l = item >> 5, g = item & 31;
        __syncthreads();
        if (F.tid < 128) { const int d = F.tid >> 6, p = F.tid & 63; const int ldg = (l * 2 + d) * G5 + g;
            const double lr = IN_(I_LRE)[ldg * P5 + p], li = IN_(I_LIM)[ldg * P5 + p], dt = exp((double)IN_(I_LDT)[ldg]);
            for (int e = 0; e <= 16; ++e) { const double m = exp(lr * dt * e), ang = li * dt * e; APr[(d * 64 + p) * 17 + e] = (float)(m * cos(ang)); APi[(d * 64 + p) * 17 + e] = (float)(m * sin(ang)); }
            { const double m16 = exp(lr * dt * 16.0), a16 = li * dt * 16.0; float* A16 = (float*)(F.ws + WS_A16) + ((size_t)((l * 32 + g) * 2 + d) * 64 + p) * 2; A16[0] = (float)(m16 * cos(a16)); A16[1] = (float)(m16 * sin(a16)); }
            const double m1 = exp(lr * dt), ar = m1 * cos(li * dt), ai = m1 * sin(li * dt); const double nr = ar - 1.0, ni = ai, den = lr * lr + li * li;
            const double qr = (nr * lr + ni * li) / den, qi = (ni * lr - nr * li) / den;
            for (int h = 0; h < 16; ++h) { const double x = IN_(I_BRE)[((size_t)ldg * P5 + p) * H5 + h], y = IN_(I_BIM)[((size_t)ldg * P5 + p) * H5 + h];
                BBr[(d * 64 + p) * 16 + h] = (float)(qr * x - qi * y); BBi[(d * 64 + p) * 16 + h] = (float)(qr * y + qi * x);
                CCr[(d * 16 + h) * 64 + p] = IN_(I_CRE)[((size_t)ldg * H5 + h) * P5 + p]; CCi[(d * 16 + h) * 64 + p] = IN_(I_CIM)[((size_t)ldg * H5 + h) * P5 + p]; } }
        __syncthreads();
        for (int idx = F.tid; idx < 8192; idx += NT) { const int d = idx >> 12, e = (idx >> 8) & 15, h = (idx >> 4) & 15, hp = idx & 15; float a = 0.f;
            for (int p = 0; p < 64; ++p) { const float pr = APr[(d * 64 + p) * 17 + e], pi = APi[(d * 64 + p) * 17 + e], br = BBr[(d * 64 + p) * 16 + hp], bi = BBi[(d * 64 + p) * 16 + hp];
                const float wr = pr * br - pi * bi, wi = pr * bi + pi * br; a += CCr[(d * 16 + h) * 64 + p] * wr - CCi[(d * 16 + h) * 64 + p] * wi; }
            KK[idx] = a; }
        __syncthreads();
        bf16* M = (bf16*)(F.ws + WS_S5M) + (size_t)(l * 32 + g) * 3 * 65536;
        for (int idx = F.tid; idx < 32768; idx += NT) {
            const int r = idx >> 7, k0 = (idx & 127) * 2; float v[3][2];
#pragma unroll
            for (int q = 0; q < 2; ++q) { const int kk = k0 + q;
                { const int d = r >> 7, p = (r >> 1) & 63, c = r & 1, sg = kk >> 4, hp = kk & 15, e = d == 0 ? 15 - sg : sg;
                  const float pr = APr[(d * 64 + p) * 17 + e], pi = APi[(d * 64 + p) * 17 + e], br = BBr[(d * 64 + p) * 16 + hp], bi = BBi[(d * 64 + p) * 16 + hp];
                  v[0][q] = c == 0 ? pr * br - pi * bi : pr * bi + pi * br; }
                { const int tau = r >> 4, h = r & 15, sg = kk >> 4, hp = kk & 15; float t = 0.f;
                  if (sg <= tau) t += KK[(0 * 16 + (tau - sg)) * 256 + h * 16 + hp]; if (sg >= tau) t += KK[(1 * 16 + (sg - tau)) * 256 + h * 16 + hp]; v[1][q] = t; }
                { const int tau = r >> 4, h = r & 15, d = kk >> 7, p = (kk >> 1) & 63, c = kk & 1, e = d == 0 ? tau + 1 : 16 - tau;
                  const float cr = CCr[(d * 16 + h) * 64 + p], ci = CCi[(d * 16 + h) * 64 + p], pr = APr[(d * 64 + p) * 17 + e], pi = APi[(d * 64 + p) * 17 + e];
                  v[2][q] = c == 0 ? cr * pr - ci * pi : -(cr * pi + ci * pr); } }
#pragma unroll
            for (int m = 0; m < 3; ++m) *(unsigned*)(M + (size_t)m * 65536 + r * 256 + k0) = pk2(v[m][0], v[m][1]);
        }
    }
}
__device__ __forceinline__ void s5_z_phase(Frame& F, int l) {
    const bf16* PROJ = (const bf16*)(F.ws + WS_PROJ); float* Z = (float*)(F.ws + WS_Z);
    const int l15 = F.lane & 15, lq = F.lane >> 4;
    for (int item = F.bid; item < 256; item += F.G) {
        const int g = item >> 3, part = item & 7; const bf16* Fm = (const bf16*)(F.ws + WS_S5M) + (size_t)(l * 32 + g) * 3 * 65536;
        bf16x8 Af[2][8];
#pragma unroll
        for (int j = 0; j < 2; ++j)
#pragma unroll
            for (int ks = 0; ks < 8; ++ks) Af[j][ks] = *(const bf16x8*)(Fm + (size_t)(16 * (2 * F.wave + j) + l15) * 256 + 32 * ks + 8 * lq);
#pragma unroll 1
        for (int tl = part; tl < MT / 256; tl += 8) {
            bf16x8 V[8];
#pragma unroll
            for (int ks = 0; ks < 8; ++ks) V[ks] = *(const bf16x8*)(PROJ + (size_t)(tl * 256 + 16 * l15 + 2 * ks + (lq >> 1)) * INW + 16 * g + 8 * (lq & 1));
            f32x4 acc[2] = {{0.f, 0.f, 0.f, 0.f}, {0.f, 0.f, 0.f, 0.f}};
#pragma unroll
            for (int ks = 0; ks < 8; ++ks)
#pragma unroll
                for (int j = 0; j < 2; ++j) acc[j] = __builtin_amdgcn_mfma_f32_16x16x32_bf16(Af[j][ks], V[ks], acc[j], 0, 0, 0);
#pragma unroll
            for (int j = 0; j < 2; ++j) *(f32x4*)(Z + ((size_t)(tl * 16 + l15) * 32 + g) * 256 + 16 * (2 * F.wave + j) + 4 * lq) = acc[j];
        }
    }
}
__device__ __forceinline__ int s5_chain_sb(int d, int i) { return d == 0 ? (i < 16 ? 1024 + i : i - 16) : (i < 16 ? 1039 - i : 1023 - (i - 16)); }
__device__ __forceinline__ void s5_scan_phase(Frame& F, int l) {
    LAS float* EX = (LAS float*)F.lds;
    for (int item = F.bid; item < 256; item += F.G) {
        const int cid = item * 16 + (F.tid & 15), j = F.tid >> 4;
        const int g = cid >> 7, d = (cid >> 6) & 1, p = cid & 63;
        const float* A16 = (const float*)(F.ws + WS_A16) + ((size_t)((l * 32 + g) * 2 + d) * 64 + p) * 2; const float ar = A16[0], ai = A16[1];
        const float* Z = (const float*)(F.ws + WS_Z) + (size_t)g * 256 + d * 128 + 2 * p; bf16* SS = (bf16*)(F.ws + WS_SS) + (size_t)g * 256 + d * 128 + 2 * p;
        float2 z[33];
#pragma unroll
        for (int q = 0; q < 33; ++q) { const int i = 33 * j + q; z[q] = i < NSB ? *(const float2*)(Z + (size_t)s5_chain_sb(d, i) * 8192) : make_float2(0.f, 0.f); }
        float hr = 0.f, hi = 0.f, pr = 1.f, pi = 0.f;
#pragma unroll
        for (int q = 0; q < 33; ++q) { if (33 * j + q < NSB) { const float nr = ar * hr - ai * hi + z[q].x, ni = ar * hi + ai * hr + z[q].y; hr = nr; hi = ni; const float qr = pr * ar - pi * ai, qi = pr * ai + pi * ar; pr = qr; pi = qi; } }
        __syncthreads();
        EX[(j * 16 + (F.tid & 15)) * 4 + 0] = hr; EX[(j * 16 + (F.tid & 15)) * 4 + 1] = hi; EX[(j * 16 + (F.tid & 15)) * 4 + 2] = pr; EX[(j * 16 + (F.tid & 15)) * 4 + 3] = pi;
        __syncthreads();
        float cr = 0.f, ci = 0.f;
        for (int i = 0; i < j; ++i) { const float er = EX[(i * 16 + (F.tid & 15)) * 4 + 0], ei = EX[(i * 16 + (F.tid & 15)) * 4 + 1], qr = EX[(i * 16 + (F.tid & 15)) * 4 + 2], qi = EX[(i * 16 + (F.tid & 15)) * 4 + 3];
            const float nr = qr * cr - qi * ci + er, ni = qr * ci + qi * cr + ei; cr = nr; ci = ni; }
        hr = cr; hi = ci;
#pragma unroll
        for (int q = 0; q < 33; ++q) { const int i = 33 * j + q; if (i < NSB) { *(unsigned*)(SS + (size_t)s5_chain_sb(d, i) * 8192) = pk2(hr, hi);
            const float nr = ar * hr - ai * hi + z[q].x, ni = ar * hi + ai * hr + z[q].y; hr = nr; hi = ni; } }
    }
}
__device__ __forceinline__ void s5_y_phase(Frame& F, int l) {
    const bf16* PROJ = (const bf16*)(F.ws + WS_PROJ); const bf16* SS = (const bf16*)(F.ws + WS_SS); bf16* YG = (bf16*)(F.ws + WS_YG); const float* ds = IN_(I_DSKIP) + l * MIXW;
    const int l15 = F.lane & 15, lq = F.lane >> 4;
    for (int item = F.bid; item < 256; item += F.G) {
        const int g = item >> 3, part = item & 7; const bf16* Tm = (const bf16*)(F.ws + WS_S5M) + ((size_t)(l * 32 + g) * 3 + 1) * 65536; const bf16* Em = Tm + 65536;
        bf16x8 At[2][8], Ae[2][8];
#pragma unroll
        for (int j = 0; j < 2; ++j)
#pragma unroll
            for (int ks = 0; ks < 8; ++ks) { const size_t o = (size_t)(16 * (2 * F.wave + j) + l15) * 256 + 32 * ks + 8 * lq; At[j][ks] = *(const bf16x8*)(Tm + o); Ae[j][ks] = *(const bf16x8*)(Em + o); }
        const f32x4 dsk = *(const f32x4*)(ds + 16 * g + 4 * lq);
        const int ntl = l == 0 ? MT / 256 : SEQ / 256;
#pragma unroll 1
        for (int tl = part; tl < ntl; tl += 8) {
            bf16x8 V[8], S[8];
#pragma unroll
            for (int ks = 0; ks < 8; ++ks) { V[ks] = *(const bf16x8*)(PROJ + (size_t)(tl * 256 + 16 * l15 + 2 * ks + (lq >> 1)) * INW + 16 * g + 8 * (lq & 1));
                S[ks] = *(const bf16x8*)(SS + ((size_t)(tl * 16 + l15) * 32 + g) * 256 + 32 * ks + 8 * lq); }
            f32x4 acc[2] = {{0.f, 0.f, 0.f, 0.f}, {0.f, 0.f, 0.f, 0.f}};
#pragma unroll
            for (int ks = 0; ks < 8; ++ks)
#pragma unroll
                for (int j = 0; j < 2; ++j) { acc[j] = __builtin_amdgcn_mfma_f32_16x16x32_bf16(At[j][ks], V[ks], acc[j], 0, 0, 0); acc[j] = __builtin_amdgcn_mfma_f32_16x16x32_bf16(Ae[j][ks], S[ks], acc[j], 0, 0, 0); }
#pragma unroll
            for (int j = 0; j < 2; ++j) { const size_t row = (size_t)tl * 256 + 16 * l15 + (2 * F.wave + j); const int ch = 16 * g + 4 * lq;
                const v2u u = *(const v2u*)(PROJ + row * INW + ch);
                const float y0 = acc[j][0] + dsk[0] * bflo(u.x), y1 = acc[j][1] + dsk[1] * bfhi(u.x), y2 = acc[j][2] + dsk[2] * bflo(u.y), y3 = acc[j][3] + dsk[3] * bfhi(u.y);
                v2u w; w.x = cvtpk(geluf_(y0), geluf_(y1)); w.y = cvtpk(geluf_(y2), geluf_(y3)); *(v2u*)(YG + row * MIXW + ch) = w; }
        }
    }
}


constexpr int SG_STRIDE = 272, SG_IMG = 256 * SG_STRIDE, SG_STAT = SG_IMG;
__device__ __forceinline__ void sg_fast_chunk(Frame& F, int l, int chunk) {
    const bf16* PROJ = (const bf16*)(F.ws + WS_PROJ); bf16* YB = (bf16*)(F.ws + WS_YS) + (size_t)MT * MIXW; const bf16* WSG = (const bf16*)(F.ws + WS_WSG);
    const float* lg = IN_(I_SGG) + l * MIXW; const float* lb = IN_(I_SGB) + l * MIXW; const float* bsg = IN_(I_BSG) + l * 512;
    LAS float* st = (LAS float*)(F.lds + SG_STAT);
    __syncthreads();
    {
        const int p = F.tid >> 2, part = F.tid & 3; const bf16* vr = PROJ + (size_t)(chunk * 128 + p) * INW + 1024 + part * 128; float s = 0.f, q = 0.f;
#pragma unroll 4
        for (int c = 0; c < 128; c += 8) { const v4u w = *(const v4u*)(vr + c); const float x[8] = {bflo(w.x), bfhi(w.x), bflo(w.y), bfhi(w.y), bflo(w.z), bfhi(w.z), bflo(w.w), bfhi(w.w)};
#pragma unroll
            for (int i = 0; i < 8; ++i) { s += x[i]; q += x[i] * x[i]; } }
        s += __shfl_xor(s, 1); q += __shfl_xor(q, 1); s += __shfl_xor(s, 2); q += __shfl_xor(q, 2);
        const float mu = s * (1.f / 512.f), var = fmaxf(q * (1.f / 512.f) - mu * mu, 0.f);
        if (part == 0) { st[p * 2] = mu; st[p * 2 + 1] = rsqrtf(var + EPS); }
    }
    const int l15 = F.lane & 15, lq = F.lane >> 4;
#pragma unroll 1
    for (int pass = 0; pass < 2; ++pass) {
        __syncthreads();
#pragma unroll 1
        for (int it = F.tid; it < 2048; it += NT) { const int tp = it & 63, cg = it >> 6; const int p0 = tp * 2, ch = pass * 256 + cg * 8;
            const v4u w0 = *(const v4u*)(PROJ + (size_t)(chunk * 128 + p0) * INW + 1024 + ch), w1 = *(const v4u*)(PROJ + (size_t)(chunk * 128 + p0 + 1) * INW + 1024 + ch);
            const float mu0 = st[p0 * 2], rs0 = st[p0 * 2 + 1], mu1 = st[p0 * 2 + 2], rs1 = st[p0 * 2 + 3];
            const float x0[8] = {bflo(w0.x), bfhi(w0.x), bflo(w0.y), bfhi(w0.y), bflo(w0.z), bfhi(w0.z), bflo(w0.w), bfhi(w0.w)};
            const float x1[8] = {bflo(w1.x), bfhi(w1.x), bflo(w1.y), bfhi(w1.y), bflo(w1.z), bfhi(w1.z), bflo(w1.w), bfhi(w1.w)};
#pragma unroll
            for (int i = 0; i < 8; ++i) { const float gm = lg[ch + i], bt = lb[ch + i];
                *(LAS unsigned*)(F.lds + (cg * 8 + i) * SG_STRIDE + p0 * 2) = pk2((x0[i] - mu0) * rs0 * gm + bt, (x1[i] - mu1) * rs1 * gm + bt); } }
        __syncthreads();
        const int ggl = F.wave >> 2, gg = pass * 2 + ggl, rb0 = (F.wave & 3) * 2;
        bf16x8 A[2][4];
#pragma unroll
        for (int j = 0; j < 2; ++j)
#pragma unroll
            for (int ks = 0; ks < 4; ++ks) A[j][ks] = *(const LAS bf16x8*)(F.lds + (ggl * 128 + (rb0 + j) * 16 + l15) * SG_STRIDE + (32 * ks + 8 * lq) * 2);
        f32x4 acc[2][8];
#pragma unroll
        for (int j = 0; j < 2; ++j)
#pragma unroll
            for (int cb = 0; cb < 8; ++cb) acc[j][cb] = (f32x4){0.f, 0.f, 0.f, 0.f};
#pragma unroll
        for (int cb = 0; cb < 8; ++cb) {
            bf16x8 B[4];
#pragma unroll
            for (int ks = 0; ks < 4; ++ks) B[ks] = *(const bf16x8*)(WSG + ((size_t)gg * 128 + cb * 16 + l15) * 128 + 32 * ks + 8 * lq);
#pragma unroll
            for (int ks = 0; ks < 4; ++ks)
#pragma unroll
                for (int j = 0; j < 2; ++j) acc[j][cb] = __builtin_amdgcn_mfma_f32_16x16x32_bf16(A[j][ks], B[ks], acc[j][cb], 0, 0, 0);
        }
#pragma unroll
        for (int cb = 0; cb < 8; ++cb) { const int q = cb * 16 + l15; const size_t row = (size_t)chunk * 128 + q; const float bq = bsg[gg * 128 + q];
#pragma unroll
            for (int j = 0; j < 2; ++j) { const int col = gg * 128 + (rb0 + j) * 16 + 4 * lq; const v2u gu = *(const v2u*)(PROJ + row * INW + 512 + col);
                v2u w; w.x = cvtpk(bflo(gu.x) * (acc[j][cb][0] + bq), bfhi(gu.x) * (acc[j][cb][1] + bq)); w.y = cvtpk(bflo(gu.y) * (acc[j][cb][2] + bq), bfhi(gu.y) * (acc[j][cb][3] + bq));
                *(v2u*)(YB + row * MIXW + col) = w; } }
    }
}


__device__ __forceinline__ void thin_acc(f32x4 (&acc)[2], const bf16* A, int lda, const bf16* Bt, int K, int wave, int lane) {
    const int r = lane & 15, q = lane >> 4; const bf16* a0 = A + (size_t)(32 * wave + r) * lda + 8 * q; const bf16* a1 = a0 + (size_t)16 * lda; const bf16* b = Bt + (size_t)r * K + 8 * q;
#pragma unroll 8
    for (int ks = 0; ks < K / 32; ++ks) { const bf16x8 x0 = *(const bf16x8*)(a0 + 32 * ks), x1 = *(const bf16x8*)(a1 + 32 * ks), w = *(const bf16x8*)(b + 32 * ks);
        acc[0] = __builtin_amdgcn_mfma_f32_16x16x32_bf16(x0, w, acc[0], 0, 0, 0); acc[1] = __builtin_amdgcn_mfma_f32_16x16x32_bf16(x1, w, acc[1], 0, 0, 0); }
}
#define THIN_FOREACH(acc, body) _Pragma("unroll") for (int _j = 0; _j < 2; ++_j) _Pragma("unroll") for (int _i = 0; _i < 4; ++_i) { const int crow = 32 * F.wave + 16 * _j + 4 * (F.lane >> 4) + _i; const float v = acc[_j][_i]; body }
__device__ __forceinline__ void ph2_ctx(Frame& F, int ncols) {
    const bf16* Hc = (const bf16*)(F.ws + WS_H) + (size_t)SEQ * D; bf16* P = (bf16*)(F.ws + WS_PROJ) + (size_t)SEQ * INW; const bf16* W = (const bf16*)(F.ws + WS_WIN);
    for (int it = F.bid; it < ncols / 16; it += F.G) { const int col = it * 16 + (F.lane & 15); f32x4 acc[2] = {{0.f, 0.f, 0.f, 0.f}, {0.f, 0.f, 0.f, 0.f}};
        thin_acc(acc, Hc, D, W + (size_t)it * 16 * D, D, F.wave, F.lane);
        THIN_FOREACH(acc, { const float o = (col >= 512 && col < 1536) ? geluf_(v) : v; P[(size_t)crow * INW + col] = (bf16)f2bf(o); }) }
}
__device__ __forceinline__ void ph6_ctx(Frame& F) {
    const bf16* YGc = (const bf16*)(F.ws + WS_YG) + (size_t)SEQ * MIXW; bf16* YA = (bf16*)(F.ws + WS_YS) + (size_t)SEQ * MIXW; const bf16* W = (const bf16*)(F.ws + WS_WGLU);
    for (int it = F.bid; it < MIXW / 16; it += F.G) { const int col = it * 16 + (F.lane & 15); f32x4 acc[2] = {{0.f, 0.f, 0.f, 0.f}, {0.f, 0.f, 0.f, 0.f}};
        thin_acc(acc, YGc, MIXW, W + (size_t)it * 16 * MIXW, MIXW, F.wave, F.lane);
        THIN_FOREACH(acc, { YA[(size_t)crow * MIXW + col] = (bf16)f2bf(bf2f(YGc[(size_t)crow * MIXW + col]) * sigmoidf_(v)); }) }
}
__device__ __forceinline__ void ph7_ctx(Frame& F) {
    bf16* BR = (bf16*)(F.ws + WS_PROJ) + (size_t)SEQ * INW;
    for (int it = F.bid; it < 3 * (D / 16); it += F.G) { const int kk = it / (D / 16), cb = it % (D / 16); const int col = cb * 16 + (F.lane & 15); f32x4 acc[2] = {{0.f, 0.f, 0.f, 0.f}, {0.f, 0.f, 0.f, 0.f}};
        thin_acc(acc, (const bf16*)(F.ws + WS_YS) + ((size_t)kk * MT + SEQ) * MIXW, MIXW, (const bf16*)(F.ws + WS_WBR) + ((size_t)kk * 1024 + cb * 16) * MIXW, MIXW, F.wave, F.lane);
        THIN_FOREACH(acc, { BR[(size_t)crow * INW + kk * 1024 + col] = (bf16)f2bf(v); }) }
}
__device__ __forceinline__ void ph8_ctx(Frame& F, int l) {
    const bf16* Hc = (const bf16*)(F.ws + WS_H) + (size_t)SEQ * D; const bf16* BR = (const bf16*)(F.ws + WS_PROJ) + (size_t)SEQ * INW; bf16* PM = (bf16*)(F.ws + WS_PM) + (size_t)SEQ * D; const float* bm = IN_(I_BMG) + l * INW;
    for (int it = F.bid; it < D / 16; it += F.G) { const int col = it * 16 + (F.lane & 15); float p[2][4] = {};
#pragma unroll 1
        for (int kk = 0; kk < 3; ++kk) { f32x4 acc[2] = {{0.f, 0.f, 0.f, 0.f}, {0.f, 0.f, 0.f, 0.f}};
            thin_acc(acc, Hc, D, (const bf16*)(F.ws + WS_WMG) + ((size_t)kk * 1024 + it * 16) * D, D, F.wave, F.lane);
            const float bb = bm[kk * 1024 + col];
            THIN_FOREACH(acc, { p[_j][_i] += sigmoidf_(v + bb) * bf2f(BR[(size_t)crow * INW + kk * 1024 + col]); }) }
#pragma unroll
        for (int j = 0; j < 2; ++j)
#pragma unroll
            for (int i = 0; i < 4; ++i) PM[(size_t)(32 * F.wave + 16 * j + 4 * (F.lane >> 4) + i) * D + col] = (bf16)f2bf(p[j][i]); }
}
__device__ __forceinline__ void ph9_ctx(Frame& F, int l) {
    const bf16* PMc = (const bf16*)(F.ws + WS_PM) + (size_t)SEQ * D; float* XC = (float*)(F.ws + WS_XC); const float* xs = l == 0 ? IN_(I_CTX) : (const float*)(F.ws + WS_XC);
    const float* ga = (const float*)(F.ws + WS_MOD) + (size_t)(l * 2 + 1) * 6144 + 2048;
    for (int it = F.bid; it < D / 16; it += F.G) { const int col = it * 16 + (F.lane & 15); f32x4 acc[2] = {{0.f, 0.f, 0.f, 0.f}, {0.f, 0.f, 0.f, 0.f}};
        thin_acc(acc, PMc, D, (const bf16*)(F.ws + WS_WO) + (size_t)it * 16 * D, D, F.wave, F.lane);
        const float gc = ga[col];
        THIN_FOREACH(acc, { XC[(size_t)crow * D + col] = xs[(size_t)crow * D + col] + gc * v; }) }
}

struct NSmem { float As[16][68]; float Bs[16][68]; };
template <class AF>
__device__ __forceinline__ void ngemm_acc(float (&acc)[4][4], const AF& af, const float* B, int ldb, int K, LAS NSmem* s, int t) {
    const int ty = t >> 4, tx = t & 15, lr = t >> 2, lk = (t & 3) * 4, bk = t >> 4, bn = (t & 15) * 4;
    for (int k0 = 0; k0 < K; k0 += 16) {
        const float4 av = af.load4(lr, k0 + lk);
        const float4 bv = *(const float4*)(B + (size_t)(k0 + bk) * ldb + bn);
        __syncthreads();
        s->As[lk + 0][lr] = av.x; s->As[lk + 1][lr] = av.y; s->As[lk + 2][lr] = av.z; s->As[lk + 3][lr] = av.w;
        *(LAS f32x4*)&s->Bs[bk][bn] = (f32x4){bv.x, bv.y, bv.z, bv.w};
        __syncthreads();
#pragma unroll
        for (int k = 0; k < 16; ++k) {
            const f32x4 a = *(const LAS f32x4*)&s->As[k][ty * 4]; const f32x4 b = *(const LAS f32x4*)&s->Bs[k][tx * 4];
            const float aa[4] = {a.x, a.y, a.z, a.w}, bb[4] = {b.x, b.y, b.z, b.w};
#pragma unroll
            for (int i = 0; i < 4; ++i)
#pragma unroll
                for (int j = 0; j < 4; ++j) acc[i][j] += aa[i] * bb[j];
        }
    }
}
struct ABf { const bf16* A; int lda; __device__ __forceinline__ float4 load4(int r, int k) const { const v2u w = *(const v2u*)(A + (size_t)r * lda + k);
    return make_float4(bf2f((unsigned short)(w.x & 0xffff)), bf2f((unsigned short)(w.x >> 16)), bf2f((unsigned short)(w.y & 0xffff)), bf2f((unsigned short)(w.y >> 16))); } };
#define NTILE_BEGIN(ntiles) { const int _half = F.tid >> 8, t = F.tid & 255, ty = t >> 4, tx = t & 15; LAS NSmem* sm = (LAS NSmem*)F.lds + _half; (void)ty; (void)tx; \
    const int _nt = (ntiles), _nit = (_nt + 2 * F.G - 1) / (2 * F.G); \
    for (int _it = 0; _it < _nit; ++_it) { int T = (_it * F.G + F.bid) * 2 + _half; const bool valid = T < _nt; if (!valid) T = _nt - 1;
#define NTILE_END } }

__device__ __forceinline__ void ph0_prologue(Frame& F) {
    float* mod = (float*)(F.ws + WS_MOD);
    LAS float* SV = (LAS float*)(F.lds + 131072 + 4096);
    for (int i = F.tid; i < 2048; i += NT) SV[i] = siluf_(i < 1024 ? IN_(I_C)[i] : IN_(I_CCTX)[i - 1024]);
    __syncthreads();
    LAS float* RED = (LAS float*)(F.lds + 131072 + 4096 + 8192);
    for (int it = F.bid; it < 2 * 96; it += F.G) { const int l = it / 96, j = (it % 96) * 64 + F.lane;
        const float* W = IN_(I_WADA) + (size_t)l * D * 6144 + j + (size_t)(F.wave * 128) * 6144;
        float a0 = 0.f, a1 = 0.f;
#pragma unroll 32
        for (int kk = 0; kk < 128; ++kk) { const float w = W[(size_t)kk * 6144]; a0 += SV[F.wave * 128 + kk] * w; a1 += SV[1024 + F.wave * 128 + kk] * w; }
        __syncthreads();
        RED[(F.wave * 2 + 0) * 64 + F.lane] = a0; RED[(F.wave * 2 + 1) * 64 + F.lane] = a1;
        __syncthreads();
        if (F.wave < 2) { float s = 0.f;
#pragma unroll
            for (int w8 = 0; w8 < 8; ++w8) s += RED[(w8 * 2 + F.wave) * 64 + F.lane];
            mod[(size_t)(l * 2 + F.wave) * 6144 + j] = s + IN_(I_BADA)[l * 6144 + j]; }
    }
}
__device__ __forceinline__ void hprep_rows(Frame& F, int l) {
    bf16* H = (bf16*)(F.ws + WS_H); const float* g = IN_(I_GMIX) + l * D;
    const int gw = F.bid * (NT / 64) + F.wave, ngw = F.G * (NT / 64);
    for (int row = gw; row < MT; row += ngw) {
        const float* m = mod_ptr(F, l, row); const float* xr = xsrc_row(F, l, row);
        f32x4 v[4]; float s = 0.f;
#pragma unroll
        for (int j = 0; j < 4; ++j) { v[j] = *(const f32x4*)(xr + 4 * F.lane + 256 * j); s += v[j].x * v[j].x + v[j].y * v[j].y + v[j].z * v[j].z + v[j].w * v[j].w; }
        const float rstd = rsqrtf(wave_sum(s) * (1.f / D) + EPS);
#pragma unroll
        for (int j = 0; j < 4; ++j) { const int c = 4 * F.lane + 256 * j; const f32x4 gg = *(const f32x4*)(g + c), sc = *(const f32x4*)(m + 1024 + c), sh = *(const f32x4*)(m + c);
            const f32x4 o = v[j] * rstd * gg * (1.f + sc) + sh; v2u w; w.x = pk2(o.x, o.y); w.y = pk2(o.z, o.w); *(v2u*)(H + (size_t)row * D + c) = w; }
    }
}
__device__ __forceinline__ void ph2_naive(Frame& F, int l) {
    const bf16* H = (const bf16*)(F.ws + WS_H); bf16* PROJ = (bf16*)(F.ws + WS_PROJ); const float* W = IN_(I_WIN) + (size_t)l * D * INW;
    NTILE_BEGIN((MT / 64) * (INW / 64))
        const int m0 = (T / (INW / 64)) * 64, n0 = (T % (INW / 64)) * 64;
        float acc[4][4] = {};
        ngemm_acc(acc, ABf{H + (size_t)m0 * D, D}, W + n0, INW, D, sm, t);
        if (valid) {
#pragma unroll
            for (int i = 0; i < 4; ++i) { float o[4];
#pragma unroll
                for (int j = 0; j < 4; ++j) { o[j] = acc[i][j]; if (n0 >= 512 && n0 < 1536) o[j] = geluf_(o[j]); }
                v2u w; w.x = pk2(o[0], o[1]); w.y = pk2(o[2], o[3]); *(v2u*)(PROJ + (size_t)(m0 + ty * 4 + i) * INW + n0 + tx * 4) = w; }
        }
    NTILE_END
}
__device__ __forceinline__ int chain_row(int dir, int pos) { return dir == 0 ? (pos < CTX ? SEQ + pos : pos - CTX) : (pos < CTX ? SEQ + CTX - 1 - pos : SEQ - 1 - (pos - CTX)); }
__device__ __forceinline__ void ph3_s5_naive(Frame& F, int l) {
    LAS float* Cr = (LAS float*)(F.lds + 32768); LAS float* Ci = Cr + 1024; LAS float* Sr = Ci + 1024; LAS float* Si = Sr + 2048;
    const bf16* PROJ = (const bf16*)(F.ws + WS_PROJ); float* YD = (float*)(F.ws + WS_S5);
    for (int item = F.bid; item < 64; item += F.G) {
        if (F.wave == 0) {
            const int g = item >> 1, dir = item & 1, p = F.lane;
            const int ldg = ((l * 2 + dir) * G5 + g);
            const float lr = IN_(I_LRE)[ldg * P5 + p], li = IN_(I_LIM)[ldg * P5 + p], dt = expf(IN_(I_LDT)[ldg]);
            const float er = expf(lr * dt), ar = er * cosf(li * dt), ai = er * sinf(li * dt);
            const float nr = ar - 1.f, ni = ai, den = lr * lr + li * li;
            const float qr = (nr * lr + ni * li) / den, qi = (ni * lr - nr * li) / den;
            float br[16], bi[16];
#pragma unroll
            for (int h = 0; h < 16; ++h) { const float x = IN_(I_BRE)[((size_t)ldg * P5 + p) * H5 + h], y = IN_(I_BIM)[((size_t)ldg * P5 + p) * H5 + h]; br[h] = qr * x - qi * y; bi[h] = qr * y + qi * x; }
            for (int h = 0; h < 16; ++h) { Cr[h * 64 + p] = IN_(I_CRE)[((size_t)ldg * H5 + h) * P5 + p]; Ci[h * 64 + p] = IN_(I_CIM)[((size_t)ldg * H5 + h) * P5 + p]; }
            float sr = 0.f, si = 0.f;
            float* Y = YD + (size_t)dir * MT * MIXW;
#pragma unroll 1
            for (int blk = 0; blk < MT / 32; ++blk) {
#pragma unroll 1
                for (int tt = 0; tt < 32; ++tt) {
                    const int row = chain_row(dir, blk * 32 + tt);
                    const v4u u0 = *(const v4u*)(PROJ + (size_t)row * INW + g * 16), u1 = *(const v4u*)(PROJ + (size_t)row * INW + g * 16 + 8);
                    const unsigned uw[8] = {u0.x, u0.y, u0.z, u0.w, u1.x, u1.y, u1.z, u1.w};
                    float xr = 0.f, xi = 0.f;
#pragma unroll
                    for (int h = 0; h < 8; ++h) { const float ua = bf2f((unsigned short)(uw[h] & 0xffff)), ub = bf2f((unsigned short)(uw[h] >> 16));
                        xr += br[2 * h] * ua + br[2 * h + 1] * ub; xi += bi[2 * h] * ua + bi[2 * h + 1] * ub; }
                    const float nsr = ar * sr - ai * si + xr, nsi = ar * si + ai * sr + xi;
                    sr = nsr; si = nsi; Sr[tt * 64 + p] = sr; Si[tt * 64 + p] = si;
                }
                asm volatile("s_waitcnt lgkmcnt(0)" ::: "memory");
#pragma unroll 1
                for (int o = p; o < 512; o += 64) {
                    const int tt = o >> 4, h = o & 15; float a = 0.f;
#pragma unroll 4
                    for (int q = 0; q < 64; ++q) a += Cr[h * 64 + q] * Sr[tt * 64 + q] - Ci[h * 64 + q] * Si[tt * 64 + q];
                    Y[(size_t)chain_row(dir, blk * 32 + tt) * MIXW + g * 16 + h] = a;
                }
                asm volatile("s_waitcnt lgkmcnt(0)" ::: "memory");
            }
        }
    }
}
__device__ __forceinline__ void ph3_sg_naive(Frame& F, int l) {
    const bf16* PROJ = (const bf16*)(F.ws + WS_PROJ); bf16* YB = (bf16*)(F.ws + WS_YS) + (size_t)MT * MIXW;
    LAS float* stat = (LAS float*)(F.lds + 32768);
    const float* lg = IN_(I_SGG) + l * MIXW; const float* lb = IN_(I_SGB) + l * MIXW;
    NTILE_BEGIN((MT / 128) * 16)
        const int chunk = T >> 4, gg = (T >> 2) & 3, q0 = ((T >> 1) & 1) * 64, c0 = (T & 1) * 64;
        LAS float* st = stat + _half * 256;
        __syncthreads();
        if (t < 128) { const bf16* vr = PROJ + (size_t)(chunk * 128 + t) * INW + 1024; float s = 0.f;
            for (int c = 0; c < 512; c += 2) { const unsigned w = *(const unsigned*)(vr + c); s += bf2f((unsigned short)(w & 0xffff)) + bf2f((unsigned short)(w >> 16)); }
            const float mu = s * (1.f / 512.f); float q = 0.f;
            for (int c = 0; c < 512; c += 2) { const unsigned w = *(const unsigned*)(vr + c); const float a = bf2f((unsigned short)(w & 0xffff)) - mu, b = bf2f((unsigned short)(w >> 16)) - mu; q += a * a + b * b; }
            st[t * 2] = mu; st[t * 2 + 1] = rsqrtf(q * (1.f / 512.f) + EPS); }
        __syncthreads();
        float acc[4][4] = {};
        {
            const float* A = IN_(I_WSG) + ((size_t)(l * 4 + gg) * 128 + q0) * 128;
            const int lr = t >> 2, lk = (t & 3) * 4, bk = t >> 4, bn = (t & 15) * 4;
            for (int k0 = 0; k0 < 128; k0 += 16) {
                const float4 av = *(const float4*)(A + (size_t)lr * 128 + k0 + lk);
                const int p = k0 + bk; const int col = gg * 128 + c0 + bn;
                const v2u w = *(const v2u*)(PROJ + (size_t)(chunk * 128 + p) * INW + 1024 + col);
                const float mu = st[p * 2], rs = st[p * 2 + 1];
                float4 bv; bv.x = (bf2f((unsigned short)(w.x & 0xffff)) - mu) * rs * lg[col] + lb[col]; bv.y = (bf2f((unsigned short)(w.x >> 16)) - mu) * rs * lg[col + 1] + lb[col + 1];
                bv.z = (bf2f((unsigned short)(w.y & 0xffff)) - mu) * rs * lg[col + 2] + lb[col + 2]; bv.w = (bf2f((unsigned short)(w.y >> 16)) - mu) * rs * lg[col + 3] + lb[col + 3];
                __syncthreads();
                sm->As[lk + 0][lr] = av.x; sm->As[lk + 1][lr] = av.y; sm->As[lk + 2][lr] = av.z; sm->As[lk + 3][lr] = av.w;
                *(LAS f32x4*)&sm->Bs[bk][bn] = (f32x4){bv.x, bv.y, bv.z, bv.w};
                __syncthreads();
#pragma unroll
                for (int k = 0; k < 16; ++k) { const f32x4 a = *(const LAS f32x4*)&sm->As[k][ty * 4]; const f32x4 b = *(const LAS f32x4*)&sm->Bs[k][tx * 4];
                    const float aa[4] = {a.x, a.y, a.z, a.w}, bb[4] = {b.x, b.y, b.z, b.w};
#pragma unroll
                    for (int i = 0; i < 4; ++i)
#pragma unroll
                        for (int j = 0; j < 4; ++j) acc[i][j] += aa[i] * bb[j]; }
            }
        }
        if (valid) {
#pragma unroll
            for (int i = 0; i < 4; ++i) { const int q = q0 + ty * 4 + i; const size_t row = (size_t)chunk * 128 + q; const int col = gg * 128 + c0 + tx * 4;
                const float bq = IN_(I_BSG)[l * 512 + gg * 128 + q];
                const v2u gu = *(const v2u*)(PROJ + row * INW + 512 + col);
                v2u w; w.x = pk2(bf2f((unsigned short)(gu.x & 0xffff)) * (acc[i][0] + bq), bf2f((unsigned short)(gu.x >> 16)) * (acc[i][1] + bq));
                w.y = pk2(bf2f((unsigned short)(gu.y & 0xffff)) * (acc[i][2] + bq), bf2f((unsigned short)(gu.y >> 16)) * (acc[i][3] + bq));
                *(v2u*)(YB + row * MIXW + col) = w; }
        }
    NTILE_END
}
__device__ __forceinline__ void ph3_conv(Frame& F, int l, int nrows) {
    const bf16* PROJ = (const bf16*)(F.ws + WS_PROJ); bf16* YC = (bf16*)(F.ws + WS_YS) + (size_t)2 * MT * MIXW; const float* wc = IN_(I_WCONV) + l * 3 * MIXW;
    const size_t gt = (size_t)F.bid * NT + F.tid, ngt = (size_t)F.G * NT;
#pragma unroll 2
    for (size_t i = gt; i < (size_t)nrows * (MIXW / 8); i += ngt) {
        const int row = (int)(i / (MIXW / 8)), c = (int)(i % (MIXW / 8)) * 8;
        int pos, rl; if (row < SEQ) { pos = row & 63; rl = 64; } else { pos = row - SEQ; rl = 256; }
        const bf16* r0 = PROJ + (size_t)row * INW + 1536 + c;
        const v4u zero = {0u, 0u, 0u, 0u};
        const v4u b0 = *(const v4u*)(r0), c0 = *(const v4u*)(r0 + 512), h0 = *(const v4u*)(r0 + 1024);
        const v4u cm = pos > 0 ? *(const v4u*)(r0 - INW + 512) : zero, hm = pos > 0 ? *(const v4u*)(r0 - INW + 1024) : zero;
        const v4u cp = pos < rl - 1 ? *(const v4u*)(r0 + INW + 512) : zero, hp = pos < rl - 1 ? *(const v4u*)(r0 + INW + 1024) : zero;
        const f32x4 w0a = *(const f32x4*)(wc + c), w0b = *(const f32x4*)(wc + c + 4), w1a = *(const f32x4*)(wc + 512 + c), w1b = *(const f32x4*)(wc + 512 + c + 4), w2a = *(const f32x4*)(wc + 1024 + c), w2b = *(const f32x4*)(wc + 1024 + c + 4);
        const float w0[8] = {w0a.x, w0a.y, w0a.z, w0a.w, w0b.x, w0b.y, w0b.z, w0b.w}, w1[8] = {w1a.x, w1a.y, w1a.z, w1a.w, w1b.x, w1b.y, w1b.z, w1b.w}, w2[8] = {w2a.x, w2a.y, w2a.z, w2a.w, w2b.x, w2b.y, w2b.z, w2b.w};
        const unsigned bb[4] = {b0.x, b0.y, b0.z, b0.w}, cc[4] = {c0.x, c0.y, c0.z, c0.w}, hh[4] = {h0.x, h0.y, h0.z, h0.w}, cmv[4] = {cm.x, cm.y, cm.z, cm.w}, hmv[4] = {hm.x, hm.y, hm.z, hm.w}, cpv[4] = {cp.x, cp.y, cp.z, cp.w}, hpv[4] = {hp.x, hp.y, hp.z, hp.w};
        unsigned o[4];
#pragma unroll
        for (int j = 0; j < 4; ++j) {
            const float ylo = bflo(bb[j]) * (w0[2 * j] * (bflo(cmv[j]) * bflo(hmv[j])) + w1[2 * j] * (bflo(cc[j]) * bflo(hh[j])) + w2[2 * j] * (bflo(cpv[j]) * bflo(hpv[j])));
            const float yhi = bfhi(bb[j]) * (w0[2 * j + 1] * (bfhi(cmv[j]) * bfhi(hmv[j])) + w1[2 * j + 1] * (bfhi(cc[j]) * bfhi(hh[j])) + w2[2 * j + 1] * (bfhi(cpv[j]) * bfhi(hpv[j])));
            o[j] = pk2(ylo, yhi); }
        v4u ov; ov.x = o[0]; ov.y = o[1]; ov.z = o[2]; ov.w = o[3]; *(v4u*)(YC + (size_t)row * MIXW + c) = ov;
    }
}
__device__ __forceinline__ void ph5_naive(Frame& F, int l) {
    const bf16* PROJ = (const bf16*)(F.ws + WS_PROJ); const float* YD = (const float*)(F.ws + WS_S5); bf16* YG = (bf16*)(F.ws + WS_YG); const float* ds = IN_(I_DSKIP) + l * MIXW;
    const size_t gt = (size_t)F.bid * NT + F.tid, ngt = (size_t)F.G * NT;
    for (size_t i = gt; i < (size_t)MT * (MIXW / 2); i += ngt) {
        const int row = (int)(i / (MIXW / 2)), c = (int)(i % (MIXW / 2)) * 2;
        const unsigned u = *(const unsigned*)(PROJ + (size_t)row * INW + c); const size_t o = (size_t)row * MIXW + c;
        const float y0 = YD[o] + YD[(size_t)MT * MIXW + o] + ds[c] * bf2f((unsigned short)(u & 0xffff)), y1 = YD[o + 1] + YD[(size_t)MT * MIXW + o + 1] + ds[c + 1] * bf2f((unsigned short)(u >> 16));
        *(unsigned*)(YG + o) = pk2(geluf_(y0), geluf_(y1));
    }
}
__device__ __forceinline__ void ph6_naive(Frame& F, int l) {
    const bf16* YG = (const bf16*)(F.ws + WS_YG); bf16* YA = (bf16*)(F.ws + WS_YS); const float* W = IN_(I_WGLU) + (size_t)l * MIXW * MIXW;
    NTILE_BEGIN((MT / 64) * (MIXW / 64))
        const int m0 = (T / (MIXW / 64)) * 64, n0 = (T % (MIXW / 64)) * 64;
        float acc[4][4] = {};
        ngemm_acc(acc, ABf{YG + (size_t)m0 * MIXW, MIXW}, W + n0, MIXW, MIXW, sm, t);
        if (valid) {
#pragma unroll
            for (int i = 0; i < 4; ++i) { const size_t o = (size_t)(m0 + ty * 4 + i) * MIXW + n0 + tx * 4; const v2u g = *(const v2u*)(YG + o);
                v2u w; w.x = pk2(bf2f((unsigned short)(g.x & 0xffff)) * sigmoidf_(acc[i][0]), bf2f((unsigned short)(g.x >> 16)) * sigmoidf_(acc[i][1]));
                w.y = pk2(bf2f((unsigned short)(g.y & 0xffff)) * sigmoidf_(acc[i][2]), bf2f((unsigned short)(g.y >> 16)) * sigmoidf_(acc[i][3])); *(v2u*)(YA + o) = w; }
        }
    NTILE_END
}
__device__ __forceinline__ void ph7_naive(Frame& F, int l) {
    const bf16* YS = (const bf16*)(F.ws + WS_YS); bf16* BR = (bf16*)(F.ws + WS_PROJ); const float* W = IN_(I_WBR) + (size_t)l * 3 * MIXW * D;
    NTILE_BEGIN((MT / 64) * (INW / 64))
        const int m0 = (T / (INW / 64)) * 64, n0 = (T % (INW / 64)) * 64, k = n0 / 1024, d0 = n0 % 1024;
        float acc[4][4] = {};
        ngemm_acc(acc, ABf{YS + (size_t)k * MT * MIXW + (size_t)m0 * MIXW, MIXW}, W + (size_t)k * MIXW * D + d0, D, MIXW, sm, t);
        if (valid) {
#pragma unroll
            for (int i = 0; i < 4; ++i) { v2u w; w.x = pk2(acc[i][0], acc[i][1]); w.y = pk2(acc[i][2], acc[i][3]); *(v2u*)(BR + (size_t)(m0 + ty * 4 + i) * INW + n0 + tx * 4) = w; }
        }
    NTILE_END
}
__device__ __forceinline__ void ph8_naive(Frame& F, int l) {
    const bf16* H = (const bf16*)(F.ws + WS_H); const bf16* BR = (const bf16*)(F.ws + WS_PROJ); bf16* PM = (bf16*)(F.ws + WS_PM);
    const float* W = IN_(I_WMG) + (size_t)l * D * INW; const float* bm = IN_(I_BMG) + l * INW;
    NTILE_BEGIN((MT / 64) * (D / 64))
        const int m0 = (T / (D / 64)) * 64, n0 = (T % (D / 64)) * 64;
        float out[4][4] = {};
        for (int k = 0; k < 3; ++k) {
            float acc[4][4] = {};
            ngemm_acc(acc, ABf{H + (size_t)m0 * D, D}, W + k * 1024 + n0, INW, D, sm, t);
#pragma unroll
            for (int i = 0; i < 4; ++i) { const v2u b = *(const v2u*)(BR + (size_t)(m0 + ty * 4 + i) * INW + k * 1024 + n0 + tx * 4);
                const float bb[4] = {bf2f((unsigned short)(b.x & 0xffff)), bf2f((unsigned short)(b.x >> 16)), bf2f((unsigned short)(b.y & 0xffff)), bf2f((unsigned short)(b.y >> 16))};
#pragma unroll
                for (int j = 0; j < 4; ++j) out[i][j] += sigmoidf_(acc[i][j] + bm[k * 1024 + n0 + tx * 4 + j]) * bb[j]; }
        }
        if (valid) {
#pragma unroll
            for (int i = 0; i < 4; ++i) { v2u w; w.x = pk2(out[i][0], out[i][1]); w.y = pk2(out[i][2], out[i][3]); *(v2u*)(PM + (size_t)(m0 + ty * 4 + i) * D + n0 + tx * 4) = w; }
        }
    NTILE_END
}
__device__ __forceinline__ void ph9_naive(Frame& F, int l) {
    const bf16* PM = (const bf16*)(F.ws + WS_PM); const float* W = IN_(I_WO) + (size_t)l * D * D;
    NTILE_BEGIN((MT / 64) * (D / 64))
        const int m0 = (T / (D / 64)) * 64, n0 = (T % (D / 64)) * 64;
        float acc[4][4] = {};
        ngemm_acc(acc, ABf{PM + (size_t)m0 * D, D}, W + n0, D, D, sm, t);
        if (valid) {
#pragma unroll
            for (int i = 0; i < 4; ++i) { const int row = m0 + ty * 4 + i, c = n0 + tx * 4; const float* m = mod_ptr(F, l, row) + 2048 + c;
                const f32x4 xs = *(const f32x4*)(xsrc_row(F, l, row) + c);
                f32x4 o; o.x = xs.x + m[0] * acc[i][0]; o.y = xs.y + m[1] * acc[i][1]; o.z = xs.z + m[2] * acc[i][2]; o.w = xs.w + m[3] * acc[i][3];
                *(f32x4*)(xrun_row(F, row) + c) = o; }
        }
    NTILE_END
}
template <int KS>
__device__ __forceinline__ void route_pass(Frame& F, int l, int u, bool valid, int kh, int sl, LAS float* GC, LAS float* SH, LAS float* SSQ, LAS float* LG, LAS int* HISTL) {
    bf16* H = (bf16*)(F.ws + WS_H); const bf16* WRh = (const bf16*)(F.ws + WS_WR); const bf16* WRl = WRh + 48 * 1024;
    const float* bg = IN_(I_BGRP) + l * 4; const float* be = IN_(I_BEXP) + l * 32;
    int* EID = (int*)(F.ws + WS_EID); float* EW = (float*)(F.ws + WS_EW);
    constexpr int NK = 32 / KS, KW = 1024 / KS;
    const int r = F.lane & 15, q = F.lane >> 4;
    const int uu = valid ? u : 0; const int row = uu * 16 + r; const float* xr = xrun_row(F, row) + kh * KW + 8 * q; const int pv = (row >= SEQ ? 1024 : 0) + kh * KW + 8 * q;
    float s = 0.f;
#pragma unroll
    for (int ks = 0; ks < NK; ++ks) { const f32x4 a = *(const f32x4*)(xr + 32 * ks), b = *(const f32x4*)(xr + 32 * ks + 4); s += a.x * a.x + a.y * a.y + a.z * a.z + a.w * a.w + b.x * b.x + b.y * b.y + b.z * b.z + b.w * b.w; }
    s += __shfl_xor(s, 16); s += __shfl_xor(s, 32);
    __syncthreads();
    if (q == 0) SSQ[(sl * KS + kh) * 16 + r] = s;
    __syncthreads();
    float tot = 0.f;
#pragma unroll
    for (int i = 0; i < KS; ++i) tot += SSQ[(sl * KS + i) * 16 + r];
    const float rstd = rsqrtf(tot * (1.f / D) + EPS);
    f32x4 acc[3] = {{0.f, 0.f, 0.f, 0.f}, {0.f, 0.f, 0.f, 0.f}, {0.f, 0.f, 0.f, 0.f}};
#pragma unroll 4
    for (int ks = 0; ks < NK; ++ks) {
        const int c = 32 * ks;
        const f32x4 x0 = *(const f32x4*)(xr + c), x1 = *(const f32x4*)(xr + c + 4);
        const f32x4 g0 = *(const LAS f32x4*)(GC + pv + c), g1 = *(const LAS f32x4*)(GC + pv + c + 4), sh0 = *(const LAS f32x4*)(SH + pv + c), sh1 = *(const LAS f32x4*)(SH + pv + c + 4);
        const f32x4 h0 = x0 * rstd * g0 + sh0, h1 = x1 * rstd * g1 + sh1;
        v4u hi; hi.x = pk2(h0.x, h0.y); hi.y = pk2(h0.z, h0.w); hi.z = pk2(h1.x, h1.y); hi.w = pk2(h1.z, h1.w);
        if (valid) *(v4u*)(H + (size_t)row * D + kh * KW + 8 * q + c) = hi;
        v4u lo; lo.x = pk2(h0.x - bflo(hi.x), h0.y - bfhi(hi.x)); lo.y = pk2(h0.z - bflo(hi.y), h0.w - bfhi(hi.y)); lo.z = pk2(h1.x - bflo(hi.z), h1.y - bfhi(hi.z)); lo.w = pk2(h1.z - bflo(hi.w), h1.w - bfhi(hi.w));
        const bf16x8 Ah = __builtin_bit_cast(bf16x8, hi), Al = __builtin_bit_cast(bf16x8, lo);
#pragma unroll
        for (int cb = 0; cb < 3; ++cb) { const size_t wo = (size_t)(cb * 16 + r) * 1024 + kh * KW + c + 8 * q; const bf16x8 Bh = *(const bf16x8*)(WRh + wo), Bl = *(const bf16x8*)(WRl + wo);
            acc[cb] = __builtin_amdgcn_mfma_f32_16x16x32_bf16(Ah, Bh, acc[cb], 0, 0, 0); acc[cb] = __builtin_amdgcn_mfma_f32_16x16x32_bf16(Al, Bh, acc[cb], 0, 0, 0); acc[cb] = __builtin_amdgcn_mfma_f32_16x16x32_bf16(Ah, Bl, acc[cb], 0, 0, 0); }
    }
    LAS float* LGw = LG + (sl * KS + kh) * (16 * 52);
#pragma unroll
    for (int cb = 0; cb < 3; ++cb)
#pragma unroll
        for (int i = 0; i < 4; ++i) LGw[(4 * q + i) * 52 + cb * 16 + r] = acc[cb][i];
    __syncthreads();
    if (kh == 0 && valid && F.lane < 16) { const LAS float* L0 = LG + (sl * KS) * (16 * 52) + F.lane * 52; const int rw = u * 16 + F.lane;
        float lg[36];
#pragma unroll
        for (int o = 0; o < 36; ++o) { float t = 0.f;
#pragma unroll
            for (int i = 0; i < KS; ++i) t += L0[i * (16 * 52) + o]; lg[o] = t + (o < 4 ? bg[o] : be[o - 4]); }
        LAS float* LW = LG + (sl * KS) * (16 * 52) + F.lane * 52;
#pragma unroll
        for (int o = 0; o < 36; ++o) LW[o] = lg[o];
        int gi = 0; float gm = lg[0];
#pragma unroll
        for (int o = 1; o < 4; ++o) if (lg[o] > gm) { gm = lg[o]; gi = o; }
        float den = 0.f;
#pragma unroll
        for (int o = 0; o < 4; ++o) den += expf(lg[o] - gm);
        const float gp = 1.f / den;
        const LAS float* el = LW + 4 + gi * 8;
        int i1 = 0; float m1 = el[0]; for (int o = 1; o < 8; ++o) { const float v = el[o]; if (v > m1) { m1 = v; i1 = o; } }
        int i2 = -1; float m2 = 0.f; for (int o = 0; o < 8; ++o) { const float v = el[o]; if (o != i1 && (i2 < 0 || v > m2)) { m2 = v; i2 = o; } }
        const float e2 = expf(m2 - m1); const float w1 = 1.f / (1.f + e2), w2 = e2 / (1.f + e2);
        const int e1i = gi * 8 + i1, e2i = gi * 8 + i2;
        EID[rw * 2] = e1i; EID[rw * 2 + 1] = e2i; EW[rw * 2] = gp * w1; EW[rw * 2 + 1] = gp * w2;
        __hip_atomic_fetch_add(&HISTL[e1i], 1, __ATOMIC_RELAXED, __HIP_MEMORY_SCOPE_WORKGROUP); __hip_atomic_fetch_add(&HISTL[e2i], 1, __ATOMIC_RELAXED, __HIP_MEMORY_SCOPE_WORKGROUP);
    }
}
__device__ __forceinline__ void ph10_route(Frame& F, int l) {
    const float* g = IN_(I_GFFN) + l * D;
    LAS float* GC = (LAS float*)F.lds;
    LAS float* SH = GC + 2048;
    LAS float* SSQ = SH + 2048;
    LAS float* LG = SSQ + 128;
    LAS int* HISTL = (LAS int*)(LG + 8 * 16 * 52);
    __syncthreads();
    if (F.tid < 32) HISTL[F.tid] = 0;
    for (int i = F.tid; i < 2048; i += NT) { const int w = i >> 10, c = i & 1023; const float* m = (const float*)(F.ws + WS_MOD) + (size_t)(l * 2 + w) * 6144; GC[i] = g[c] * (1.f + m[4096 + c]); SH[i] = m[3072 + c]; }
#pragma unroll 1
    for (int u0 = F.bid; u0 < SEQ / 16; u0 += 4 * F.G) { const int u = u0 + (F.wave >> 1) * F.G; route_pass<2>(F, l, u, u < SEQ / 16, F.wave & 1, F.wave >> 1, GC, SH, SSQ, LG, HISTL); }
    if (l == 0) {
#pragma unroll 1
        for (int u0 = SEQ / 16 + F.bid; u0 < MT / 16; u0 += F.G) route_pass<8>(F, l, u0, true, F.wave, 0, GC, SH, SSQ, LG, HISTL);
    }
    __syncthreads();
    if (F.tid < 32) ((int*)(F.ws + WS_HISTG))[F.bid * 32 + F.tid] = HISTL[F.tid];
}
__device__ __forceinline__ int expert_off(const unsigned* cnt, int e) { int o = 0; for (int i = 0; i < e; ++i) o += ((int)cnt[i] + 255) & ~255; return o; }
__device__ __forceinline__ void ph11_scatter(Frame& F, int l) {
    const bf16* H = (const bf16*)(F.ws + WS_H); bf16* HS = (bf16*)(F.ws + WS_HS);
    const int* EID = (const int*)(F.ws + WS_EID); const float* EW = (const float*)(F.ws + WS_EW); int* STOK = (int*)(F.ws + WS_STOK); float* SW = (float*)(F.ws + WS_SW); int* TSLOT = (int*)(F.ws + WS_TSLOT);
    unsigned* cnt = F.ctl + CW_CNT + l * 128; const int* HISTG = (const int*)(F.ws + WS_HISTG);
    LAS int* HIST = (LAS int*)F.lds; LAS int* BASE = HIST + 32; LAS int* ISLOT = BASE + 32; LAS int* IROW = ISLOT + 512; LAS int* PT = IROW + 512; LAS int* PB = PT + 512;
    const int nunits = (l == 0 ? MT : SEQ) / 16;
    __syncthreads();
    { const int e = F.tid & 31, ch = F.tid >> 5; int tot = 0, bas = 0;
      for (int b = ch; b < F.G; b += 16) { const int h = HISTG[b * 32 + e]; tot += h; if (b < F.bid) bas += h; }
      PT[F.tid] = tot; PB[F.tid] = bas; }
    __syncthreads();
    if (F.tid < 32) { int tot = 0, bas = 0; for (int ch = 0; ch < 16; ++ch) { tot += PT[ch * 32 + F.tid]; bas += PB[ch * 32 + F.tid]; } HIST[F.tid] = 0; PT[F.tid] = tot; PB[F.tid] = bas; if (F.bid == 0) cnt[F.tid] = (unsigned)tot; }
    __syncthreads();
    if (F.tid < 32) { int off = 0; for (int i = 0; i < F.tid; ++i) off += (PT[i] + 255) & ~255; BASE[F.tid] = off + PB[F.tid]; }
    __syncthreads();
    const int w = F.tid >> 5; int u = F.bid + w * F.G; bool valid = u < SEQ / 16;
    if (w == 15) { u = SEQ / 16 + F.bid; valid = u < nunits; }
    const int row = u * 16 + ((F.tid >> 1) & 15), kk = F.tid & 1;
    int e = 0, rank = 0; if (valid) { e = EID[row * 2 + kk]; rank = __hip_atomic_fetch_add(&HIST[e], 1, __ATOMIC_RELAXED, __HIP_MEMORY_SCOPE_WORKGROUP); }
    __syncthreads();
    int slot = -1; if (valid) { slot = BASE[e] + rank; STOK[slot] = row; SW[slot] = EW[row * 2 + kk]; TSLOT[row * 2 + kk] = slot; }
    ISLOT[F.tid] = slot; IROW[F.tid] = row;
    __syncthreads();
#pragma unroll 4
    for (int it = F.wave; it < NT; it += NT / 64) { const int sl = ISLOT[it]; if (sl >= 0) { const v4u* src = (const v4u*)(H + (size_t)IROW[it] * D); v4u* dst = (v4u*)(HS + (size_t)sl * D);
        dst[F.lane] = src[F.lane]; dst[F.lane + 64] = src[F.lane + 64]; } }
}
__device__ __forceinline__ int slot_expert(const unsigned* cnt, int slot0, int& seg_off, int& n_e) { int o = 0; for (int e = 0; e < NE; ++e) { const int n = (int)cnt[e], pn = (n + 255) & ~255; if (slot0 < o + pn) { seg_off = o; n_e = n; return e; } o += pn; } seg_off = o; n_e = 0; return 0; }
__device__ __forceinline__ void ph12_naive(Frame& F, int l) {
    const bf16* HS = (const bf16*)(F.ws + WS_HS); bf16* ACT = (bf16*)(F.ws + WS_ACT); const float* SW = (const float*)(F.ws + WS_SW);
    const unsigned* cnt = F.ctl + CW_CNT + l * 128; const int total = expert_off(cnt, NE);
    NTILE_BEGIN((total / 64) * (DFF / 64))
        const int s0 = (T / (DFF / 64)) * 64, n0 = (T % (DFF / 64)) * 64; int seg, n_e; const int e = slot_expert(cnt, s0, seg, n_e);
        float aa[4][4] = {}, ab[4][4] = {};
        ngemm_acc(aa, ABf{HS + (size_t)s0 * D, D}, IN_(I_W1) + ((size_t)l * NE + e) * D * DFF + n0, DFF, D, sm, t);
        ngemm_acc(ab, ABf{HS + (size_t)s0 * D, D}, IN_(I_W3) + ((size_t)l * NE + e) * D * DFF + n0, DFF, D, sm, t);
        if (valid) {
#pragma unroll
            for (int i = 0; i < 4; ++i) { const int slot = s0 + ty * 4 + i; if (slot - seg < n_e) { const float w = SW[slot];
                v2u o; o.x = pk2(siluf_(aa[i][0]) * ab[i][0] * w, siluf_(aa[i][1]) * ab[i][1] * w); o.y = pk2(siluf_(aa[i][2]) * ab[i][2] * w, siluf_(aa[i][3]) * ab[i][3] * w);
                *(v2u*)(ACT + (size_t)slot * DFF + n0 + tx * 4) = o; } }
        }
    NTILE_END
}
__device__ __forceinline__ void ph13_naive(Frame& F, int l) {
    const bf16* ACT = (const bf16*)(F.ws + WS_ACT); bf16* YS2 = (bf16*)(F.ws + WS_YS2);
    const unsigned* cnt = F.ctl + CW_CNT + l * 128; const int total = expert_off(cnt, NE);
    NTILE_BEGIN((total / 64) * (D / 64))
        const int s0 = (T / (D / 64)) * 64, n0 = (T % (D / 64)) * 64; int seg, n_e; const int e = slot_expert(cnt, s0, seg, n_e);
        float acc[4][4] = {};
        ngemm_acc(acc, ABf{ACT + (size_t)s0 * DFF, DFF}, IN_(I_W2) + ((size_t)l * NE + e) * DFF * D + n0, D, DFF, sm, t);
        if (valid) {
#pragma unroll
            for (int i = 0; i < 4; ++i) { const int slot = s0 + ty * 4 + i; if (slot - seg < n_e) { v2u o; o.x = pk2(acc[i][0], acc[i][1]); o.y = pk2(acc[i][2], acc[i][3]); *(v2u*)(YS2 + (size_t)slot * D + n0 + tx * 4) = o; } }
        }
    NTILE_END
}
__device__ __forceinline__ void ph14_combine(Frame& F, int l) {
    const bf16* YS2 = (const bf16*)(F.ws + WS_YS2); const int* TSLOT = (const int*)(F.ws + WS_TSLOT); bf16* H = (bf16*)(F.ws + WS_H);
    const int gw = F.bid * (NT / 64) + F.wave, ngw = F.G * (NT / 64);
    const int nrows = l == 0 ? MT : SEQ;
    for (int row0 = gw; row0 < nrows; row0 += 2 * ngw) {
        f32x4 v[2][4]; float s[2] = {0.f, 0.f}; int rows[2]; bool ok[2];
#pragma unroll
        for (int t = 0; t < 2; ++t) { rows[t] = row0 + t * ngw; ok[t] = rows[t] < nrows; if (!ok[t]) rows[t] = row0; }
        int sl[2][2];
#pragma unroll
        for (int t = 0; t < 2; ++t) { sl[t][0] = TSLOT[rows[t] * 2]; sl[t][1] = TSLOT[rows[t] * 2 + 1]; }
#pragma unroll
        for (int t = 0; t < 2; ++t) { const float* m = mod_ptr(F, l, rows[t]); const float* xr = xrun_row(F, rows[t]);
#pragma unroll
            for (int j = 0; j < 4; ++j) { const int c = 4 * F.lane + 256 * j; const f32x4 x = *(const f32x4*)(xr + c); const f32x4 ga = *(const f32x4*)(m + 5120 + c);
                const v2u a = *(const v2u*)(YS2 + (size_t)sl[t][0] * D + c), b = *(const v2u*)(YS2 + (size_t)sl[t][1] * D + c);
                f32x4 y; y.x = bflo(a.x) + bflo(b.x); y.y = bfhi(a.x) + bfhi(b.x); y.z = bflo(a.y) + bflo(b.y); y.w = bfhi(a.y) + bfhi(b.y);
                v[t][j] = x + ga * y; s[t] += v[t][j].x * v[t][j].x + v[t][j].y * v[t][j].y + v[t][j].z * v[t][j].z + v[t][j].w * v[t][j].w; } }
#pragma unroll
        for (int t = 0; t < 2; ++t) { if (!ok[t]) continue;
            const float rstd = rsqrtf(wave_sum(s[t]) * (1.f / D) + EPS); float* xr = xrun_row(F, rows[t]);
            if (l == 0) {
                const float* m1 = mod_ptr(F, 1, rows[t]); const float* g = IN_(I_GMIX) + D;
#pragma unroll
                for (int j = 0; j < 4; ++j) { const int c = 4 * F.lane + 256 * j; *(f32x4*)(xr + c) = v[t][j];
                    const f32x4 gg = *(const f32x4*)(g + c), sc = *(const f32x4*)(m1 + 1024 + c), sh = *(const f32x4*)(m1 + c);
                    const f32x4 o = v[t][j] * rstd * gg * (1.f + sc) + sh; v2u w; w.x = pk2(o.x, o.y); w.y = pk2(o.z, o.w); *(v2u*)(H + (size_t)rows[t] * D + c) = w; }
            } else {
                const float* g = IN_(I_GF);
#pragma unroll
                for (int j = 0; j < 4; ++j) { const int c = 4 * F.lane + 256 * j; const f32x4 gg = *(const f32x4*)(g + c); f32x4 o = v[t][j] * rstd * gg;
                    if (PROBE_B >= 0 && rows[t] < 3906) { volatile LAS unsigned long long* TS = (volatile LAS unsigned long long*)(F.lds + TS_OFF); o = o + (0.1f + 0.00001f * (float)(TS[1 + PROBE_B] - TS[PROBE_B])); }
                    if (PROBE_A >= 0 && rows[t] == 0 && j == 0 && F.lane == 0) { volatile LAS unsigned long long* TS = (volatile LAS unsigned long long*)(F.lds + TS_OFF); o.x += 1.f + 0.001f * (float)(TS[1 + PROBE_A] - TS[PROBE_A]); }
                    *(f32x4*)(xr + c) = o; }
            }
        }
    }
}

#ifndef FASTMASK
#define FASTMASK 0xffff
#endif
constexpr unsigned FM = FASTMASK;
constexpr int NPH = 2 + 13 * 2;
__device__ __forceinline__ Frame make_frame(LAS unsigned char* lds, int wave0) {
    Frame F; F.lds = lds; F.wave = wave0; F.lane = (int)__builtin_amdgcn_mbcnt_hi(~0u, __builtin_amdgcn_mbcnt_lo(~0u, 0u)); asm volatile("" : "+v"(F.lane)); F.tid = F.wave * 64 + F.lane; F.bid = blockIdx.x; F.G = gridDim.x; asm volatile("" : "+s"(F.G), "+s"(F.bid));
    F.tab = (const unsigned long long LAS*)(lds + TAB_OFF);
    volatile LAS unsigned long long* t = (volatile LAS unsigned long long*)(lds + TAB_OFF);
    F.ws = (unsigned char*)uni64(t[35]); F.out = (float*)uni64(t[36]); F.ctl = (unsigned*)(F.ws + WS_CTL);
    return F;
}
__global__ void __launch_bounds__(NT, 2) mega_fwd(Args args) {
    extern __shared__ __attribute__((aligned(16))) unsigned char lds_raw[];
    LAS unsigned char* const lds = (LAS unsigned char*)lds_raw;
    const int wave0 = __builtin_amdgcn_readfirstlane((int)threadIdx.x >> 6);
    for (int u = threadIdx.x; u < 1024 / 4; u += NT) ((LAS unsigned*)(lds + 131072))[u] = 0u;
    if (threadIdx.x == 0) { LAS unsigned long long* t = (LAS unsigned long long*)(lds + TAB_OFF);
#pragma unroll
        for (int i = 0; i < 35; ++i) t[i] = (unsigned long long)args.in[i];
        t[35] = (unsigned long long)args.ws; t[36] = (unsigned long long)args.out; }
    __syncthreads();
    { Frame F = make_frame(lds, wave0); (void)xcd_barrier_post(F.ctl + CW_BAR, (volatile LAS unsigned*)(lds + MISC_OFF) + 8); }
    if ((PROBE_A >= 0 || PROBE_B >= 0) && threadIdx.x == 0) ((volatile LAS unsigned long long*)(lds + TS_OFF))[0] = __builtin_amdgcn_s_memrealtime();
    const int lo = args.ph_lo, hi = args.ph_hi; int ph = 0;
#define GRIDBAR() do { Frame Fb = make_frame(lds, wave0); XcdBarrier bar; bar.bar = Fb.ctl + CW_BAR; bar.x = xb_xcc_id(); bar.st = (volatile LAS unsigned*)(lds + MISC_OFF) + 8; xcd_barrier(bar, Fb.tid == 0); } while (0)
#ifndef REPBAR
#define REPBAR 0
#endif
#ifndef REPMASK
#define REPMASK 0
#endif
#define PHASE(...) do { if (lo <= ph && ph < hi) { const int _pl = ph < 2 ? ph : 2 + (ph - 2) % 13; for (int _rep = 0; _rep <= ((REPMASK >> _pl) & 1); ++_rep) { Frame F = make_frame(lds, wave0); __VA_ARGS__; } if (ph + 1 < hi) { GRIDBAR(); if (REPBAR) GRIDBAR(); } if ((PROBE_A >= 0 || PROBE_B >= 0) && threadIdx.x == 0) ((volatile LAS unsigned long long*)(lds + TS_OFF))[1 + ph] = __builtin_amdgcn_s_memrealtime(); } ++ph; } while (0)
    PHASE({ ph0_prologue(F); convert_weights(F, 0); { const f32x4* s = (const f32x4*)IN_(I_CTX); f32x4* d = (f32x4*)(F.ws + WS_XC); for (int i = F.bid * NT + F.tid; i < CTX * D / 4; i += F.G * NT) d[i] = s[i]; } });
    PHASE({ hprep_rows(F, 0); if (FM >> 3 & 1) s5_precompute(F); });
#pragma unroll 1
    for (int l = 0; l < 2; ++l) {
        PHASE({ if (FM >> 2 & 1) { ph2_fast(F, l); ph2_ctx(F, l == 0 ? INW : MIXW); } else ph2_naive(F, l); });
        PHASE({ if (FM >> 3 & 1) { s5_z_phase(F, l); const int nch = (l == 0 ? MT : SEQ) / 128; if (F.G > nch) { if (F.bid < nch) sg_fast_chunk(F, l, F.bid); else { Frame F2 = F; F2.bid -= nch; F2.G -= nch; ph3_conv(F2, l, l == 0 ? MT : SEQ); } } else { for (int c = F.bid; c < nch; c += F.G) sg_fast_chunk(F, l, c); ph3_conv(F, l, l == 0 ? MT : SEQ); } } else { ph3_s5_naive(F, l); if (F.bid >= 64) { Frame F2 = F; F2.bid -= 64; F2.G -= 64; ph3_sg_naive(F2, l); ph3_conv(F2, l, MT); } } });
        PHASE({ if (FM >> 3 & 1) s5_scan_phase(F, l); });
        PHASE({ if (FM >> 3 & 1) s5_y_phase(F, l); else ph5_naive(F, l); });
        PHASE({ if (FM >> 6 & 1) { ph6_fast(F, l); if (l == 0) ph6_ctx(F); } else ph6_naive(F, l); });
        PHASE({ if (FM >> 7 & 1) { ph7_fast(F, l); if (l == 0) ph7_ctx(F); } else ph7_naive(F, l); });
        PHASE({ if (FM >> 8 & 1) { ph8_fast(F, l); if (l == 0) ph8_ctx(F, l); } else ph8_naive(F, l); });
        PHASE({ if (FM >> 9 & 1) { ph9_fast(F, l); if (l == 0) ph9_ctx(F, l); } else ph9_naive(F, l); });
        PHASE(ph10_route(F, l));
        PHASE(ph11_scatter(F, l));
        PHASE({ if (FM >> 12 & 1) ph12_fast(F, l); else ph12_naive(F, l); });
        PHASE({ if (FM >> 13 & 1) ph13_fast(F, l); else ph13_naive(F, l); });
        PHASE({ ph14_combine(F, l); if (l == 0) convert_weights(F, 1); });
    }
#undef PHASE
}

extern "C" void kernel_launch(void* const* d_in, const int* in_sizes, int n_in, void* d_out, int out_size, void* d_ws, size_t ws_size, hipStream_t stream) {
    static int grid = 0;
    if (grid == 0) {
        int dev = 0, cus = 0, per_cu = 0;
        if (n_in != 35 || out_size != SEQ * D || ws_size < WS_END) { fprintf(stderr, "kernel_launch: unexpected shapes (n_in %d out %d ws %zu)\n", n_in, out_size, ws_size); grid = -1; return; }
        if (hipGetDevice(&dev) != hipSuccess || hipDeviceGetAttribute(&cus, hipDeviceAttributeMultiprocessorCount, dev) != hipSuccess) { grid = -1; return; }
        if (hipFuncSetAttribute((const void*)mega_fwd, hipFuncAttributeMaxDynamicSharedMemorySize, LDS_BYTES) != hipSuccess) { fprintf(stderr, "kernel_launch: hipFuncSetAttribute failed\n"); grid = -1; return; }
        if (hipOccupancyMaxActiveBlocksPerMultiprocessor(&per_cu, (const void*)mega_fwd, NT, LDS_BYTES) != hipSuccess || per_cu < 1) { fprintf(stderr, "kernel_launch: occupancy query says %d blocks per CU\n", per_cu); grid = -1; return; }
        grid = cus;
    }
    if (grid < 0) return;
    (void)hipMemsetAsync((char*)d_ws + WS_CTL, 0, CTL_ZERO_BYTES, stream);
    Args a{};
    for (int i = 0; i < 35; ++i) a.in[i] = (const float*)d_in[i];
    a.out = (float*)d_out; a.ws = (unsigned char*)d_ws; a.ph_lo = 0; a.ph_hi = NPH;
    void* kargs[] = {&a};
    hipError_t e = hipLaunchCooperativeKernel((const void*)mega_fwd, dim3(grid), dim3(NT), kargs, LDS_BYTES, stream);
    if (e != hipSuccess) fprintf(stderr, "kernel_launch: cooperative launch failed: %s (grid %d)\n", hipGetErrorString(e), grid);
}
```

```cpp
#include <hip/hip_runtime.h>
#include <stdint.h>
#include <cstdio>

#define GAS __attribute__((address_space(1)))
#define LAS __attribute__((address_space(3)))
typedef unsigned short bf16;
typedef unsigned v4u __attribute__((ext_vector_type(4)));
typedef unsigned v2u __attribute__((ext_vector_type(2)));
typedef float f32x4 __attribute__((ext_vector_type(4)));

constexpr int D = 1024, SEQ = 16384, CTX = 256, MT = SEQ + CTX;
constexpr int MIXW = 512, INW = 3072, G5 = 32, P5 = 64, H5 = 16;
constexpr int NE = 32, DFF = 256;
constexpr int MAXSLOT = 2 * MT + NE * 256;
constexpr float EPS = 1e-6f;
constexpr int NT = 512;

constexpr size_t MiB = 1u << 20;
constexpr size_t WS_CTL = 0, CTL_ZERO_BYTES = 1 * MiB;
constexpr size_t WS_MOD = 1 * MiB;
constexpr size_t WS_XC = 2 * MiB;
constexpr size_t WS_EID = 3 * MiB;
constexpr size_t WS_EW = WS_EID + (size_t)MT * 8;
constexpr size_t WS_STOK = WS_EW + (size_t)MT * 8;
constexpr size_t WS_SW = WS_STOK + (size_t)MAXSLOT * 4;
constexpr size_t WS_TSLOT = WS_SW + (size_t)MAXSLOT * 4;
constexpr size_t WS_HISTG = WS_TSLOT + (size_t)MT * 8;
constexpr size_t WS_H = 4 * MiB;
constexpr size_t WS_PROJ = WS_H + (size_t)MT * 2048;
constexpr size_t WS_YS = WS_PROJ + (size_t)MT * 6144;
constexpr size_t WS_YG = WS_YS + (size_t)3 * MT * 1024;
constexpr size_t WS_PM = WS_YG + (size_t)MT * 1024;
constexpr size_t WS_S5 = WS_PM + (size_t)MT * 2048;
constexpr size_t WS_Z = WS_S5;
constexpr size_t WS_SS = WS_Z + (size_t)1040 * 32 * 256 * 4;
constexpr size_t WS_S5M = WS_SS + (size_t)1040 * 32 * 256 * 2;
constexpr size_t WS_A16 = WS_S5M + (size_t)2 * 32 * 3 * 65536 * 2;
constexpr size_t WS_W = WS_A16 + (size_t)2 * 32 * 2 * 64 * 2 * 4 > WS_S5 + (size_t)2 * MT * 512 * 4 ? WS_A16 + (size_t)2 * 32 * 2 * 64 * 2 * 4 : WS_S5 + (size_t)2 * MT * 512 * 4;
constexpr size_t WS_WIN = WS_W;
constexpr size_t WS_WMG = WS_WIN + (size_t)3072 * 1024 * 2;
constexpr size_t WS_WGLU = WS_WMG + (size_t)3072 * 1024 * 2;
constexpr size_t WS_WBR = WS_WGLU + (size_t)512 * 512 * 2;
constexpr size_t WS_WO = WS_WBR + (size_t)3 * 1024 * 512 * 2;
constexpr size_t WS_W13 = WS_WO + (size_t)1024 * 1024 * 2;
constexpr size_t WS_W2 = WS_W13 + (size_t)32 * 512 * 1024 * 2;
constexpr size_t WS_WSG = WS_W2 + (size_t)32 * 1024 * 256 * 2;
constexpr size_t WS_WR = WS_WSG + (size_t)4 * 128 * 128 * 2;
constexpr size_t WS_END = WS_WR + (size_t)2 * 48 * 1024 * 2;
static_assert(WS_END <= (size_t)377 * MiB, "workspace budget");
constexpr size_t WS_HS = WS_PROJ;
constexpr size_t WS_ACT = WS_YS;
constexpr size_t WS_YS2 = WS_YG;
static_assert(WS_HS + (size_t)MAXSLOT * 2048 <= WS_YS && WS_ACT + (size_t)MAXSLOT * 512 <= WS_YG && WS_YS2 + (size_t)MAXSLOT * 2048 <= WS_W, "moe overlays");
static_assert(WS_HISTG + (size_t)1024 * 32 * 4 <= WS_H, "ws map");
constexpr int CW_CNT = 64;
constexpr int CW_BAR = 4096;

#ifndef PROBE_A
#define PROBE_A -1
#endif
#ifndef PROBE_B
#define PROBE_B -1
#endif
constexpr int TS_OFF = 131072 + 512;
constexpr int LDS_BYTES = 147456;
constexpr int MISC_OFF = 131072 + 320;
constexpr int TAB_OFF = 131072 + 1024;

__device__ __forceinline__ float bf2f(unsigned short b) { return __builtin_bit_cast(float, ((unsigned)b) << 16); }
__device__ __forceinline__ unsigned f2bf(float f) { unsigned u = __builtin_bit_cast(unsigned, f); return (u + 0x7fffu + ((u >> 16) & 1u)) >> 16; }
__device__ __forceinline__ unsigned pk2(float lo, float hi) { return f2bf(lo) | (f2bf(hi) << 16); }
__device__ __forceinline__ float sigmoidf_(float x) { return __builtin_amdgcn_rcpf(1.f + __expf(-x)); }
__device__ __forceinline__ float siluf_(float x) { return x * __builtin_amdgcn_rcpf(1.f + __expf(-x)); }
__device__ __forceinline__ float geluf_(float x) { const float u = 0.7978845608028654f * (x + 0.044715f * x * x * x); return x * __builtin_amdgcn_rcpf(1.f + __expf(-2.f * u)); }
__device__ __forceinline__ float wave_sum(float v) {
#pragma unroll
    for (int o = 1; o < 64; o <<= 1) v += __shfl_xor(v, o);
    return v;
}

#define XB_TMO      128
#define XB_XCNT(j)  (256  + 64 * (j))
#define XB_XSUB(j)  (1280 + 64 * (j))
#define XB_XGEN(j)  (2304 + 64 * (j))
#define XB_TOP      3328
#define XB_TOPGEN   3392
#define XCD_BAR_WORDS 3456
#define XB_SPIN_CAP (1u << 24)
__device__ __forceinline__ unsigned xb_ld(unsigned* p)              { return __hip_atomic_load(p, __ATOMIC_RELAXED, __HIP_MEMORY_SCOPE_AGENT); }
__device__ __forceinline__ unsigned xb_add(unsigned* p, unsigned v) { return __hip_atomic_fetch_add(p, v, __ATOMIC_RELAXED, __HIP_MEMORY_SCOPE_AGENT); }
__device__ __forceinline__ unsigned xb_xcc_id() { return (unsigned)__builtin_amdgcn_s_getreg((3 << 11) | 20) & 0xFu; }
#define XB_SPIN(cond, bar) do { unsigned _sp = 0; while (cond) { __builtin_amdgcn_s_sleep(1); \
    if ((++_sp & 255u) == 0u) { if (xb_ld(&(bar)[XB_TMO])) break; if (_sp > XB_SPIN_CAP) { atomicAdd(&(bar)[XB_TMO], 1u); break; } } } } while (0)
struct XcdBarrier { unsigned* bar; unsigned x; volatile LAS unsigned* st; };
__device__ __forceinline__ XcdBarrier xcd_barrier_post(unsigned* bar, volatile LAS unsigned* st) {
    XcdBarrier b; b.bar = bar; b.x = xb_xcc_id(); b.st = st;
    if (threadIdx.x == 0) (void)xb_add(&bar[XB_XCNT(b.x)], 1u);
    return b;
}
__device__ __forceinline__ void xcd_barrier_complete(unsigned* bar, unsigned x, unsigned& nloc, unsigned& nx) {
    const unsigned G = gridDim.x * gridDim.y * gridDim.z;
    unsigned sum, cnt, mine, sp = 0u;
    for (;;) {
        sum = 0u; cnt = 0u; mine = 0u;
#pragma unroll
        for (unsigned j = 0; j < 16; ++j) { const unsigned c = xb_ld(&bar[XB_XCNT(j)]); sum += c; cnt += (c > 0u) ? 1u : 0u; mine = (j == x) ? c : mine; }
        if (sum == G) break;
        __builtin_amdgcn_s_sleep(1);
        if ((++sp & 255u) == 0u) { if (xb_ld(&bar[XB_TMO])) break; if (sp > XB_SPIN_CAP) { atomicAdd(&bar[XB_TMO], 1u); break; } }
    }
    nloc = mine > 0u ? mine : 1u; nx = cnt > 0u ? cnt : 1u;
}
__device__ __forceinline__ void xcd_barrier(const XcdBarrier& b, bool leader) {
    asm volatile("s_waitcnt vmcnt(0)" ::: "memory");
    __syncthreads();
    if (leader) {
        unsigned* bar = b.bar;
        __builtin_amdgcn_s_waitcnt(0);
        unsigned nloc = b.st[0], nx = b.st[1];
        if (nloc == 0u) { xcd_barrier_complete(bar, b.x, nloc, nx); b.st[0] = nloc; b.st[1] = nx; }
        const unsigned old = xb_add(&bar[XB_XSUB(b.x)], 1u);
        const unsigned gen = old / nloc;
        if (old + 1u == (gen + 1u) * nloc) {
            __builtin_amdgcn_fence(__ATOMIC_RELEASE, "agent");
            asm volatile("s_waitcnt vmcnt(0)" ::: "memory");
            const unsigned og = xb_add(&bar[XB_TOP], 1u);
            const unsigned tg = og / nx;
            if (og + 1u == (tg + 1u) * nx) xb_add(&bar[XB_TOPGEN], 1u);
            else XB_SPIN(xb_ld(&bar[XB_TOPGEN]) == tg, bar);
            __builtin_amdgcn_fence(__ATOMIC_ACQUIRE, "agent");
            xb_add(&bar[XB_XGEN(b.x)], 1u);
            asm volatile("s_waitcnt vmcnt(0)" ::: "memory");
        } else {
            XB_SPIN(xb_ld(&bar[XB_XGEN(b.x)]) == gen, bar);
            __builtin_amdgcn_fence(__ATOMIC_ACQUIRE, "agent");
            asm volatile("s_waitcnt vmcnt(0)" ::: "memory");
        }
    }
    __syncthreads();
}

struct Args { const float* in[35]; float* out; unsigned char* ws; int ph_lo, ph_hi; };
struct Frame {
    LAS unsigned char* lds; unsigned char* ws; unsigned* ctl;
    int tid, lane, wave, bid, G;
    const unsigned long long LAS* tab; float* out;
};
__device__ __forceinline__ unsigned long long uni64(unsigned long long v) { const unsigned lo = __builtin_amdgcn_readfirstlane((unsigned)v), hi = __builtin_amdgcn_readfirstlane((unsigned)(v >> 32)); return ((unsigned long long)hi << 32) | lo; }
#define IN_(k) ((const float*)uni64(F.tab[k]))
enum { I_X = 0, I_C, I_CTX, I_CCTX, I_WADA, I_BADA, I_GMIX, I_GFFN, I_WIN, I_LRE, I_LIM, I_LDT, I_BRE, I_BIM, I_CRE, I_CIM, I_DSKIP, I_WGLU, I_SGG, I_SGB, I_WSG, I_BSG,
       I_WCONV, I_WBR, I_WMG, I_BMG, I_WO, I_WGRP, I_BGRP, I_WEXP, I_BEXP, I_W1, I_W3, I_W2, I_GF };

__device__ __forceinline__ const float* mod_ptr(const Frame& F, int l, int row) { return (const float*)(F.ws + WS_MOD) + (size_t)(l * 2 + (row >= SEQ ? 1 : 0)) * 6144; }
__device__ __forceinline__ const float* xsrc_row(const Frame& F, int l, int row) {
    if (l == 0) return row < SEQ ? IN_(I_X) + (size_t)row * D : IN_(I_CTX) + (size_t)(row - SEQ) * D;
    return row < SEQ ? F.out + (size_t)row * D : (const float*)(F.ws + WS_XC) + (size_t)(row - SEQ) * D;
}
__device__ __forceinline__ float* xrun_row(const Frame& F, int row) { return row < SEQ ? F.out + (size_t)row * D : (float*)(F.ws + WS_XC) + (size_t)(row - SEQ) * D; }


namespace pg8 {
#define PG8_LAS __attribute__((address_space(3)))
typedef unsigned short bf16_t;
typedef short bf16x8 __attribute__((ext_vector_type(8)));
typedef float f32x4 __attribute__((ext_vector_type(4)));
typedef unsigned u32x4 __attribute__((ext_vector_type(4)));
constexpr int BM = 256, BK = 64, HALF = 128, HTB = HALF * BK * 2  , STAGE_BYTES = 8 * HTB, NXCD = 8, WGM = 8;

__host__ __device__ __forceinline__ int lds_byte(int r, int c) { const int st = (r >> 4) * 2 + (c >> 5), rr = r & 15, cc = c & 31, ob = rr * 64 + cc * 2; return st * 1024 + (ob ^ (((ob >> 9) & 1) << 5)); }
__host__ __device__ __forceinline__ void stage_rc(int b, int& R, int& C) { const int st = b / 1024, sb = b % 1024, swz = sb ^ (((sb >> 9) & 1) << 5); R = (st >> 1) * 16 + swz / 64; C = (st & 1) * 32 + (swz % 64) / 2; }
__host__ __device__ __forceinline__ int perm32(int rho) { const int n = rho >> 4, i = rho & 15; return 8 * (i >> 2) + 4 * n + (i & 3); }

struct Unit { int pm, pn; };
struct Gemm { const bf16_t* A; const bf16_t* Bt; int M, N, K; };

struct StaticOrder {
    int nM, nN, nwg, G, c;
    __host__ __device__ void init(int M, int N, int G_, int c_) { nM = M / BM; nN = N / BM; nwg = nM * nN; G = G_; c = c_; }
    __host__ __device__ bool next(int i, Unit& u) const {
        const long L = (long)i * G + c; if (L >= nwg) return false;
        int wgid = (int)L; { const int q = nwg / NXCD, r = nwg % NXCD, xcd = wgid % NXCD, off = wgid / NXCD; wgid = (xcd < r ? xcd * (q + 1) : r * (q + 1) + (xcd - r) * q) + off; }
        const int nig = WGM * nN, gid = wgid / nig, fm = gid * WGM, gsz = (nM - fm) < WGM ? (nM - fm) : WGM;
        u.pm = fm + ((wgid % nig) % gsz); u.pn = (wgid % nig) / gsz; return true;
    }
    __device__ __forceinline__ void a_ready(const Unit&) const {}
    __device__ __forceinline__ void done(const Unit&) const {}
};
__device__ __forceinline__ unsigned cvt_pk_bf16(float lo, float hi) { unsigned r; asm volatile("v_cvt_pk_bf16_f32 %0, %1, %2" : "=v"(r) : "v"(lo), "v"(hi)); return r; }
template <class Epi, class Sched, bool ALIGN_EPI = false, bool SP2 = false>
__device__ __forceinline__ void gemm_phase(PG8_LAS unsigned char* lds, const Gemm g, const Sched& S, const Epi& E, int tid_in) {
    int tid_ = tid_in; asm volatile("" : "+v"(tid_));
    const int tid = tid_, wid = __builtin_amdgcn_readfirstlane(tid >> 6), lane = tid & 63, wr = wid >> 2, wc = wid & 3, fr = lane & 15, fq = lane >> 4;
    const int K = g.K, nt = K / BK;
    unsigned voffA[2], voffB[2];
#pragma unroll
    for (int i = 0; i < 2; ++i) { int R, C; stage_rc(tid * 16 + i * 8192, R, C); const int Rb = Epi::PERM ? ((R & ~31) + perm32(R & 31)) : R;
        voffA[i] = (unsigned)(R * K + C) * 2u; voffB[i] = (unsigned)(Rb * K + C) * 2u; }
    const size_t kstep = (size_t)(BK * 2);
    const size_t hstep = (size_t)HALF * K * 2;
    const size_t tstep = 2 * hstep;
    const unsigned ldsw = (unsigned)wid * 1024u;
    const int aoff = lds_byte(wr * 64 + fr, fq * 8), boff = lds_byte(wc * 32 + fr, fq * 8);
#define PG8_SA(b, h) (((b) * 2 + (h)) * HTB)
#define PG8_SB(b, h) ((4 + (b) * 2 + (h)) * HTB)
#define PG8_STAGE(bufoff, gbase, voff) do { _Pragma("unroll") for (int _i = 0; _i < 2; ++_i) \
        __builtin_amdgcn_global_load_lds((const unsigned*)((const char*)(gbase) + (voff)[_i]), (PG8_LAS unsigned*)(lds + (bufoff) + ldsw + _i * 8192), 16, 0, 0); } while (0)
#define PG8_LDA(dst, b, h) do { _Pragma("unroll") for (int m = 0; m < 4; ++m) _Pragma("unroll") for (int k = 0; k < 2; ++k) dst[m][k] = *(const PG8_LAS bf16x8*)(lds + PG8_SA(b, h) + aoff + m * 2048 + k * 1024); } while (0)
#define PG8_LDB(dst, b, h) do { _Pragma("unroll") for (int n = 0; n < 2; ++n) _Pragma("unroll") for (int k = 0; k < 2; ++k) dst[n][k] = *(const PG8_LAS bf16x8*)(lds + PG8_SB(b, h) + boff + n * 2048 + k * 1024); } while (0)
#define PG8_MMA(ai, bj, At, Bt) do { __builtin_amdgcn_s_setprio(1); _Pragma("unroll") for (int m = 0; m < 4; ++m) _Pragma("unroll") for (int n = 0; n < 2; ++n) _Pragma("unroll") for (int k = 0; k < 2; ++k) \
        acc[ai][bj][m][n] = __builtin_amdgcn_mfma_f32_16x16x32_bf16(Bt[n][k], At[m][k], acc[ai][bj][m][n], 0, 0, 0); __builtin_amdgcn_s_setprio(0); } while (0)
#define PG8_WAIT_V(n) asm volatile("s_waitcnt vmcnt(" #n ")" ::: "memory")
#define PG8_WAIT_L(n) asm volatile("s_waitcnt lgkmcnt(" #n ")" ::: "memory")
#define PG8_BAR __builtin_amdgcn_s_barrier()
#define PG8_SCHED __builtin_amdgcn_sched_barrier(0)
    Unit cur, nxt; int ui = 0;
    if (!S.next(0, cur)) return;
    f32x4 acc[2][2][4][2];
#pragma unroll
    for (int a = 0; a < 2; ++a)
#pragma unroll
        for (int b = 0; b < 2; ++b)
#pragma unroll
            for (int m = 0; m < 4; ++m)
#pragma unroll
                for (int n = 0; n < 2; ++n) acc[a][b][m][n] = (f32x4){0.f, 0.f, 0.f, 0.f};
    bf16x8 At[4][2], B0[2][2], B1[2][2];
    const char* cA = (const char*)g.A + (size_t)cur.pm * tstep; const char* cB = (const char*)g.Bt + (size_t)cur.pn * tstep;
    S.a_ready(cur);
    if constexpr (SP2) {
        PG8_STAGE(PG8_SB(0, 0), cB, voffB); PG8_STAGE(PG8_SB(0, 1), cB + hstep, voffB); PG8_STAGE(PG8_SA(0, 0), cA, voffA); PG8_STAGE(PG8_SA(0, 1), cA + hstep, voffA);
        if (wr == 1) PG8_BAR;
        PG8_WAIT_V(2); PG8_BAR;
        PG8_STAGE(PG8_SB(1, 0), cB + kstep, voffB); PG8_STAGE(PG8_SA(1, 0), cA + kstep, voffA); PG8_STAGE(PG8_SB(1, 1), cB + hstep + kstep, voffB);
        PG8_WAIT_V(6); PG8_BAR;
    } else {
        PG8_STAGE(PG8_SB(0, 0), cB, voffB); PG8_STAGE(PG8_SA(0, 0), cA, voffA); PG8_STAGE(PG8_SB(0, 1), cB + hstep, voffB); PG8_STAGE(PG8_SA(0, 1), cA + hstep, voffA);
        if (wr == 1) PG8_BAR;
        PG8_WAIT_V(4); PG8_BAR;
        PG8_STAGE(PG8_SB(1, 0), cB + kstep, voffB); PG8_STAGE(PG8_SA(1, 0), cA + kstep, voffA); PG8_STAGE(PG8_SB(1, 1), cB + hstep + kstep, voffB);
        PG8_WAIT_V(6); PG8_BAR;
    }
    for (;;) {
        const bool has_next = S.next(ui + 1, nxt);
        const char* nA = has_next ? (const char*)g.A + (size_t)nxt.pm * tstep : cA; const char* nB = has_next ? (const char*)g.Bt + (size_t)nxt.pn * tstep : cB;
#pragma unroll 1
        for (int t = 0; t < nt; t += 2) {
            const bool last = (t == nt - 2);
            const char* a1 = cA + (size_t)(t + 1) * kstep;
            const char* a2 = last ? nA : cA + (size_t)(t + 2) * kstep; const char* b2 = last ? nB : cB + (size_t)(t + 2) * kstep;
            const char* a3 = a2 + kstep; const char* b3 = b2 + kstep;
            if (last && has_next) S.a_ready(nxt);
            if constexpr (SP2) {
            PG8_LDB(B0, 0, 0); PG8_LDB(B1, 0, 1); PG8_SCHED; PG8_LDA(At, 0, 0); PG8_STAGE(PG8_SA(1, 1), a1 + hstep, voffA);
            PG8_WAIT_V(8); PG8_WAIT_L(0); PG8_BAR; PG8_MMA(0, 0, At, B0); PG8_MMA(0, 1, At, B1); PG8_BAR; PG8_SCHED;
            PG8_LDA(At, 0, 1); PG8_STAGE(PG8_SB(0, 0), b2, voffB); PG8_STAGE(PG8_SB(0, 1), b2 + hstep, voffB); PG8_STAGE(PG8_SA(0, 0), a2, voffA);
            PG8_WAIT_V(8); PG8_WAIT_L(0); PG8_BAR; PG8_MMA(1, 0, At, B0); PG8_MMA(1, 1, At, B1); PG8_BAR; PG8_SCHED;
            PG8_LDB(B0, 1, 0); PG8_LDB(B1, 1, 1); PG8_SCHED; PG8_LDA(At, 1, 0); PG8_STAGE(PG8_SA(0, 1), a2 + hstep, voffA);
            PG8_WAIT_V(8); PG8_WAIT_L(0); PG8_BAR; PG8_MMA(0, 0, At, B0); PG8_MMA(0, 1, At, B1); PG8_BAR; PG8_SCHED;
            PG8_LDA(At, 1, 1); PG8_STAGE(PG8_SB(1, 0), b3, voffB); PG8_STAGE(PG8_SB(1, 1), b3 + hstep, voffB); PG8_STAGE(PG8_SA(1, 0), a3, voffA);
            PG8_WAIT_V(8); PG8_WAIT_L(0); PG8_BAR; PG8_MMA(1, 0, At, B0); PG8_MMA(1, 1, At, B1); PG8_BAR; PG8_SCHED;
            } else {
            PG8_LDB(B0, 0, 0); PG8_SCHED; PG8_LDA(At, 0, 0); PG8_STAGE(PG8_SA(1, 1), a1 + hstep, voffA);
            PG8_WAIT_L(8); PG8_BAR; PG8_WAIT_L(0); PG8_MMA(0, 0, At, B0); PG8_BAR; PG8_SCHED;
            PG8_LDB(B1, 0, 1); PG8_STAGE(PG8_SB(0, 0), b2, voffB);
            PG8_BAR; PG8_WAIT_L(0); PG8_MMA(0, 1, At, B1); PG8_BAR;
            PG8_LDA(At, 0, 1); PG8_STAGE(PG8_SA(0, 0), a2, voffA);
            PG8_BAR; PG8_WAIT_L(0); PG8_MMA(1, 0, At, B0); PG8_BAR; PG8_SCHED;
            PG8_STAGE(PG8_SB(0, 1), b2 + hstep, voffB);
            PG8_WAIT_V(6); PG8_BAR; PG8_MMA(1, 1, At, B1); PG8_BAR;
            PG8_LDB(B0, 1, 0); PG8_SCHED; PG8_LDA(At, 1, 0); PG8_STAGE(PG8_SA(0, 1), a2 + hstep, voffA);
            PG8_WAIT_L(8); PG8_BAR; PG8_WAIT_L(0); PG8_MMA(0, 0, At, B0); PG8_BAR; PG8_SCHED;
            PG8_LDB(B1, 1, 1); PG8_STAGE(PG8_SB(1, 0), b3, voffB);
            PG8_BAR; PG8_WAIT_L(0); PG8_MMA(0, 1, At, B1); PG8_BAR;
            PG8_LDA(At, 1, 1); PG8_STAGE(PG8_SA(1, 0), a3, voffA);
            PG8_BAR; PG8_WAIT_L(0); PG8_MMA(1, 0, At, B0); PG8_BAR; PG8_SCHED;
            PG8_STAGE(PG8_SB(1, 1), b3 + hstep, voffB);
            PG8_WAIT_V(6); PG8_BAR; PG8_MMA(1, 1, At, B1); PG8_BAR;
            }
        }
        if constexpr (ALIGN_EPI) { if (wr == 0) PG8_BAR; }
        if constexpr (!Epi::AFTER_DRAIN) { E(acc, cur, wr, wc, fr, fq); S.done(cur); }
        if (!has_next) break;
#pragma unroll
        for (int a = 0; a < 2; ++a)
#pragma unroll
            for (int b = 0; b < 2; ++b)
#pragma unroll
                for (int m = 0; m < 4; ++m)
#pragma unroll
                    for (int n = 0; n < 2; ++n) acc[a][b][m][n] = (f32x4){0.f, 0.f, 0.f, 0.f};
        cur = nxt; cA = nA; cB = nB; ++ui;
        if constexpr (ALIGN_EPI) { if (wr == 1) PG8_BAR; }
    }
    PG8_WAIT_V(0);
    if constexpr (!ALIGN_EPI) { if (wr == 0) PG8_BAR; }
    PG8_BAR;
    if constexpr (Epi::AFTER_DRAIN) { E.fused(acc, cur, wr, wc, fr, fq, lds, wid, lane); S.done(cur); }
#undef PG8_SA
#undef PG8_SB
#undef PG8_STAGE
#undef PG8_LDA
#undef PG8_LDB
#undef PG8_MMA
#undef PG8_WAIT_V
#undef PG8_WAIT_L
#undef PG8_BAR
#undef PG8_SCHED
}
}

constexpr bool PG_ALIGN = true, PG_SP2 = true;
__device__ __forceinline__ float bflo(unsigned w) { return __builtin_bit_cast(float, w << 16); }
__device__ __forceinline__ float bfhi(unsigned w) { return __builtin_bit_cast(float, w & 0xffff0000u); }
__device__ __forceinline__ unsigned cvtpk(float lo, float hi) { return pg8::cvt_pk_bf16(lo, hi); }

__device__ __forceinline__ void transpose_item(const float* W, int N, int k0, int n0, bf16* WT, int K, size_t dst_row0, LAS float* scr, int lane) {
    float v[32];
#pragma unroll
    for (int i = 0; i < 32; ++i) v[i] = W[(size_t)(k0 + 2 * i + (lane >> 5)) * N + n0 + (lane & 31)];
#pragma unroll
    for (int i = 0; i < 32; ++i) scr[(2 * i + (lane >> 5)) * 33 + (lane & 31)] = v[i];
    asm volatile("s_waitcnt lgkmcnt(0)" ::: "memory");
    const int c = lane & 7;
#pragma unroll
    for (int j = 0; j < 4; ++j) { const int n = (lane >> 3) + 8 * j; const LAS float* s = scr + (8 * c) * 33 + n;
        v4u o; o.x = pk2(s[0 * 33], s[1 * 33]); o.y = pk2(s[2 * 33], s[3 * 33]); o.z = pk2(s[4 * 33], s[5 * 33]); o.w = pk2(s[6 * 33], s[7 * 33]);
        *(v4u*)(WT + (dst_row0 + n) * K + k0 + 8 * c) = o; }
    asm volatile("s_waitcnt lgkmcnt(0)" ::: "memory");
}
__device__ __forceinline__ void convert_weights(Frame& F, int l) {
    LAS float* scr = (LAS float*)(F.lds + F.wave * 16384);
    const int gw = F.bid * (NT / 64) + F.wave, ngw = F.G * (NT / 64);
    constexpr int I_IN = 16 * 96, I_MG = 16 * 96, I_GLU = 8 * 16, I_BR = 3 * 8 * 32, I_O = 16 * 32, I_1 = 32 * 16 * 8, I_3 = I_1, I_2 = 32 * 4 * 32;
    constexpr int NITEMS = I_IN + I_MG + I_GLU + I_BR + I_O + I_1 + I_3 + I_2;
    for (int it = gw; it < NITEMS; it += ngw) {
        int r = it;
        if (r < I_IN) { const int kb = r / 96, nb = r % 96; transpose_item(IN_(I_WIN) + (size_t)l * D * INW, INW, 64 * kb, 32 * nb, (bf16*)(F.ws + WS_WIN), 1024, 32 * nb, scr, F.lane); continue; } r -= I_IN;
        if (r < I_MG) { const int kb = r / 96, nb = r % 96; transpose_item(IN_(I_WMG) + (size_t)l * D * INW, INW, 64 * kb, 32 * nb, (bf16*)(F.ws + WS_WMG), 1024, 32 * nb, scr, F.lane); continue; } r -= I_MG;
        if (r < I_GLU) { const int kb = r / 16, nb = r % 16; transpose_item(IN_(I_WGLU) + (size_t)l * MIXW * MIXW, MIXW, 64 * kb, 32 * nb, (bf16*)(F.ws + WS_WGLU), 512, 32 * nb, scr, F.lane); continue; } r -= I_GLU;
        if (r < I_BR) { const int kk = r / 256, q = r % 256, kb = q / 32, nb = q % 32; transpose_item(IN_(I_WBR) + ((size_t)l * 3 + kk) * MIXW * D, D, 64 * kb, 32 * nb, (bf16*)(F.ws + WS_WBR), 512, (size_t)kk * 1024 + 32 * nb, scr, F.lane); continue; } r -= I_BR;
        if (r < I_O) { const int kb = r / 32, nb = r % 32; transpose_item(IN_(I_WO) + (size_t)l * D * D, D, 64 * kb, 32 * nb, (bf16*)(F.ws + WS_WO), 1024, 32 * nb, scr, F.lane); continue; } r -= I_O;
        if (r < I_1 + I_3) { const int which = r / I_1, q = r % I_1, e = q / 128, q2 = q % 128, kb = q2 / 8, nb = q2 % 8;
            const float* W = IN_(which ? I_W3 : I_W1) + ((size_t)l * NE + e) * D * DFF; const int n0 = 32 * nb;
            transpose_item(W, DFF, 64 * kb, n0, (bf16*)(F.ws + WS_W13), 1024, (size_t)e * 512 + (n0 / 128) * 256 + which * 128 + (n0 % 128), scr, F.lane); continue; } r -= I_1 + I_3;
        { const int e = r / 128, q = r % 128, kb = q / 32, nb = q % 32; transpose_item(IN_(I_W2) + ((size_t)l * NE + e) * DFF * D, D, 64 * kb, 32 * nb, (bf16*)(F.ws + WS_W2), 256, (size_t)e * 1024 + 32 * nb, scr, F.lane); }
    }
    { bf16* wr = (bf16*)(F.ws + WS_WR); const float* wg = IN_(I_WGRP) + (size_t)l * D * 4; const float* we = IN_(I_WEXP) + (size_t)l * D * 32;
      for (int i = F.bid * NT + F.tid; i < 48 * 1024; i += F.G * NT) { const int n = i >> 10, kk = i & 1023; const float w = n < 4 ? wg[kk * 4 + n] : (n < 36 ? we[kk * 32 + n - 4] : 0.f);
          const unsigned hi = f2bf(w); const float lo = w - __builtin_bit_cast(float, hi << 16); wr[i] = (bf16)hi; wr[48 * 1024 + i] = (bf16)f2bf(lo); } }
    { const float* s = IN_(I_WSG) + (size_t)l * 4 * 128 * 128; bf16* d = (bf16*)(F.ws + WS_WSG);
      for (int i = (F.bid * NT + F.tid) * 2; i < 4 * 128 * 128; i += F.G * NT * 2) *(unsigned*)(d + i) = pk2(s[i], s[i + 1]); }
}

struct EpiProj { static constexpr bool PERM = true, AFTER_DRAIN = false; bf16* O;
    __device__ __forceinline__ void operator()(const pg8::f32x4 (&acc)[2][2][4][2], const pg8::Unit& u, int wr, int wc, int fr, int fq) const {
        const int row0 = u.pm * 256 + wr * 64 + fr, col0 = u.pn * 256 + wc * 32 + 8 * fq; const bool act = (u.pn >= 2 && u.pn < 6);
#pragma unroll
        for (int ai = 0; ai < 2; ++ai)
#pragma unroll
            for (int m = 0; m < 4; ++m) { bf16* rowp = O + (size_t)(row0 + ai * 128 + m * 16) * INW + col0;
#pragma unroll
                for (int bj = 0; bj < 2; ++bj) { pg8::f32x4 v0 = acc[ai][bj][m][0], v1 = acc[ai][bj][m][1];
                    if (act) {
#pragma unroll
                        for (int j = 0; j < 4; ++j) { v0[j] = geluf_(v0[j]); v1[j] = geluf_(v1[j]); } }
                    v4u w; w.x = cvtpk(v0[0], v0[1]); w.y = cvtpk(v0[2], v0[3]); w.z = cvtpk(v1[0], v1[1]); w.w = cvtpk(v1[2], v1[3]); *(v4u*)(rowp + bj * 128) = w; } }
    } };
struct EpiGlu { static constexpr bool PERM = true, AFTER_DRAIN = false; const bf16* YG; bf16* YA;
    __device__ __forceinline__ void operator()(const pg8::f32x4 (&acc)[2][2][4][2], const pg8::Unit& u, int wr, int wc, int fr, int fq) const {
        const int row0 = u.pm * 256 + wr * 64 + fr, col0 = u.pn * 256 + wc * 32 + 8 * fq;
#pragma unroll
        for (int ai = 0; ai < 2; ++ai) {
        v4u gv[4][2];
#pragma unroll
            for (int m = 0; m < 4; ++m)
#pragma unroll
                for (int bj = 0; bj < 2; ++bj) gv[m][bj] = *(const v4u*)(YG + (size_t)(row0 + ai * 128 + m * 16) * MIXW + col0 + bj * 128);
        asm volatile("" ::: "memory");
#pragma unroll
            for (int m = 0; m < 4; ++m) { const size_t off = (size_t)(row0 + ai * 128 + m * 16) * MIXW + col0;
#pragma unroll
                for (int bj = 0; bj < 2; ++bj) { const pg8::f32x4 v0 = acc[ai][bj][m][0], v1 = acc[ai][bj][m][1]; const v4u g = gv[m][bj];
                    v4u w; w.x = cvtpk(bflo(g.x) * sigmoidf_(v0[0]), bfhi(g.x) * sigmoidf_(v0[1])); w.y = cvtpk(bflo(g.y) * sigmoidf_(v0[2]), bfhi(g.y) * sigmoidf_(v0[3]));
                    w.z = cvtpk(bflo(g.z) * sigmoidf_(v1[0]), bfhi(g.z) * sigmoidf_(v1[1])); w.w = cvtpk(bflo(g.w) * sigmoidf_(v1[2]), bfhi(g.w) * sigmoidf_(v1[3])); *(v4u*)(YA + off + bj * 128) = w; } }
        asm volatile("" ::: "memory"); }
    } };
struct EpiBr { static constexpr bool PERM = true, AFTER_DRAIN = false; bf16* BR;
    __device__ __forceinline__ void operator()(const pg8::f32x4 (&acc)[2][2][4][2], const pg8::Unit& u, int wr, int wc, int fr, int fq) const {
        const int pm = u.pm % (MT / 256); const int row0 = pm * 256 + wr * 64 + fr, col0 = u.pn * 256 + wc * 32 + 8 * fq;
#pragma unroll
        for (int ai = 0; ai < 2; ++ai)
#pragma unroll
            for (int m = 0; m < 4; ++m) { bf16* rowp = BR + (size_t)(row0 + ai * 128 + m * 16) * INW + col0;
#pragma unroll
                for (int bj = 0; bj < 2; ++bj) { const pg8::f32x4 v0 = acc[ai][bj][m][0], v1 = acc[ai][bj][m][1];
                    v4u w; w.x = cvtpk(v0[0], v0[1]); w.y = cvtpk(v0[2], v0[3]); w.z = cvtpk(v1[0], v1[1]); w.w = cvtpk(v1[2], v1[3]); *(v4u*)(rowp + bj * 128) = w; } }
    } };
struct SchedBr { int G, c, nM;
    __device__ __forceinline__ bool next(int i, pg8::Unit& u) const { const int Lq = i * G + c; if (Lq >= 3 * nM * 4) return false; const int k = Lq / (nM * 4), r = Lq % (nM * 4);
        u.pm = k * (MT / 256) + r / 4; u.pn = k * 4 + r % 4; return true; }
    __device__ __forceinline__ void a_ready(const pg8::Unit&) const {}
    __device__ __forceinline__ void done(const pg8::Unit&) const {} };
struct EpiMerge { static constexpr bool PERM = true, AFTER_DRAIN = false; const bf16* BR; bf16* PM; const float* bm;
    __device__ __forceinline__ void operator()(const pg8::f32x4 (&acc)[2][2][4][2], const pg8::Unit& u, int wr, int wc, int fr, int fq) const {
        const int k = u.pn >> 2, dt = u.pn & 3; const int row0 = u.pm * 256 + wr * 64 + fr, col0 = dt * 256 + wc * 32 + 8 * fq;
#pragma unroll
        for (int bj = 0; bj < 2; ++bj) { const pg8::f32x4 b0 = *(const pg8::f32x4*)(bm + k * 1024 + col0 + bj * 128), b1 = *(const pg8::f32x4*)(bm + k * 1024 + col0 + bj * 128 + 4);
#pragma unroll
            for (int ai = 0; ai < 2; ++ai) {
            v4u brv[4], pmv[4];
#pragma unroll
                for (int m = 0; m < 4; ++m) { const size_t r = (size_t)(row0 + ai * 128 + m * 16); brv[m] = *(const v4u*)(BR + r * INW + k * 1024 + col0 + bj * 128);
                    pmv[m] = k > 0 ? *(const v4u*)(PM + r * D + col0 + bj * 128) : (v4u){0u, 0u, 0u, 0u}; }
                asm volatile("" ::: "memory");
#pragma unroll
                for (int m = 0; m < 4; ++m) { const size_t r = (size_t)(row0 + ai * 128 + m * 16); const v4u br = brv[m], o = pmv[m];
                    const pg8::f32x4 v0 = acc[ai][bj][m][0] + b0, v1 = acc[ai][bj][m][1] + b1;
                    float p[8] = {sigmoidf_(v0[0]) * bflo(br.x), sigmoidf_(v0[1]) * bfhi(br.x), sigmoidf_(v0[2]) * bflo(br.y), sigmoidf_(v0[3]) * bfhi(br.y),
                                  sigmoidf_(v1[0]) * bflo(br.z), sigmoidf_(v1[1]) * bfhi(br.z), sigmoidf_(v1[2]) * bflo(br.w), sigmoidf_(v1[3]) * bfhi(br.w)};
                    if (k > 0) { p[0] += bflo(o.x); p[1] += bfhi(o.x); p[2] += bflo(o.y); p[3] += bfhi(o.y); p[4] += bflo(o.z); p[5] += bfhi(o.z); p[6] += bflo(o.w); p[7] += bfhi(o.w); }
                    v4u w; w.x = cvtpk(p[0], p[1]); w.y = cvtpk(p[2], p[3]); w.z = cvtpk(p[4], p[5]); w.w = cvtpk(p[6], p[7]); *(v4u*)(PM + r * D + col0 + bj * 128) = w; }
                asm volatile("" ::: "memory"); } }
    } };
struct SchedMerge { int G, c, nM;
    __device__ __forceinline__ bool next(int i, pg8::Unit& u) const { const int v = (i / 3) * G + c, k = i % 3; if (v >= nM * 4) return false; u.pm = v >> 2; u.pn = k * 4 + (v & 3); return true; }
    __device__ __forceinline__ void a_ready(const pg8::Unit&) const {}
    __device__ __forceinline__ void done(const pg8::Unit&) const {} };
struct EpiWo { static constexpr bool PERM = false, AFTER_DRAIN = false; const float* xs_lat; const float* xs_ctx; float* out; float* xc; const float* mod_l;
    __device__ __forceinline__ void operator()(const pg8::f32x4 (&acc)[2][2][4][2], const pg8::Unit& u, int wr, int wc, int fr, int fq) const {
        const int row0 = u.pm * 256 + wr * 64 + fr, col0 = u.pn * 256 + wc * 32 + 4 * fq;
        const float* ga = mod_l + 2048;
        pg8::f32x4 gv[2][2];
#pragma unroll
        for (int bj = 0; bj < 2; ++bj)
#pragma unroll
            for (int n = 0; n < 2; ++n) gv[bj][n] = *(const pg8::f32x4*)(ga + col0 + bj * 128 + n * 16);
#pragma unroll
        for (int ai = 0; ai < 2; ++ai) {
#pragma unroll
            for (int mp = 0; mp < 2; ++mp) {
            pg8::f32x4 xv[2][2][2];
#pragma unroll
            for (int m = 0; m < 2; ++m) { const size_t off = (size_t)(row0 + ai * 128 + (mp * 2 + m) * 16) * D + col0;
#pragma unroll
                for (int bj = 0; bj < 2; ++bj)
#pragma unroll
                    for (int n = 0; n < 2; ++n) xv[m][bj][n] = *(const pg8::f32x4*)(xs_lat + off + bj * 128 + n * 16); }
            asm volatile("" ::: "memory");
#pragma unroll
            for (int m = 0; m < 2; ++m) { const size_t off = (size_t)(row0 + ai * 128 + (mp * 2 + m) * 16) * D + col0;
#pragma unroll
                for (int bj = 0; bj < 2; ++bj)
#pragma unroll
                    for (int n = 0; n < 2; ++n) *(pg8::f32x4*)(out + off + bj * 128 + n * 16) = xv[m][bj][n] + gv[bj][n] * acc[ai][bj][m + mp * 2][n]; }
            asm volatile("" ::: "memory"); }
        }
    } };
constexpr int MOETAB_OFF = 131072 + 2048;
template <int NPN> __device__ __forceinline__ int moe_build_table(Frame& F, const unsigned* cnt) {
    LAS unsigned* tabw = (LAS unsigned*)(F.lds + MOETAB_OFF);
    int total = 0, rowtile0 = 0;
    for (int e = 0; e < NE; ++e) { const int nt_e = ((int)cnt[e] + 255) >> 8;
        for (int q = F.tid; q < nt_e * NPN; q += NT) tabw[total + q] = ((unsigned)(rowtile0 + q / NPN) << 16) | (unsigned)(e * NPN + q % NPN);
        total += nt_e * NPN; rowtile0 += nt_e; }
    __syncthreads();
    return total;
}
struct SchedMoe { int G, c, total; const LAS unsigned* tabw;
    __device__ __forceinline__ bool next(int i, pg8::Unit& u) const { const int Lq = i * G + c; if (Lq >= total) return false; const unsigned w = (unsigned)__builtin_amdgcn_readfirstlane((int)tabw[Lq]); u.pm = (int)(w >> 16); u.pn = (int)(w & 0xffffu); return true; }
    __device__ __forceinline__ void a_ready(const pg8::Unit&) const {}
    __device__ __forceinline__ void done(const pg8::Unit&) const {} };
struct EpiUp { static constexpr bool PERM = true, AFTER_DRAIN = false; bf16* ACT; const float* SW;
    __device__ __forceinline__ void operator()(const pg8::f32x4 (&acc)[2][2][4][2], const pg8::Unit& u, int wr, int wc, int fr, int fq) const {
        const int row0 = u.pm * 256 + wr * 64 + fr, f0 = (u.pn & 1) * 128 + wc * 32 + 8 * fq;
#pragma unroll
        for (int ai = 0; ai < 2; ++ai)
#pragma unroll
            for (int m = 0; m < 4; ++m) { const int slot = row0 + ai * 128 + m * 16; const float w = SW[slot];
                const pg8::f32x4 a0 = acc[ai][0][m][0], a1 = acc[ai][0][m][1], b0 = acc[ai][1][m][0], b1 = acc[ai][1][m][1];
                v4u o; o.x = cvtpk(siluf_(a0[0]) * b0[0] * w, siluf_(a0[1]) * b0[1] * w); o.y = cvtpk(siluf_(a0[2]) * b0[2] * w, siluf_(a0[3]) * b0[3] * w);
                o.z = cvtpk(siluf_(a1[0]) * b1[0] * w, siluf_(a1[1]) * b1[1] * w); o.w = cvtpk(siluf_(a1[2]) * b1[2] * w, siluf_(a1[3]) * b1[3] * w);
                *(v4u*)(ACT + (size_t)slot * DFF + f0) = o; }
    } };
struct EpiDown { static constexpr bool PERM = true, AFTER_DRAIN = false; bf16* YS2;
    __device__ __forceinline__ void operator()(const pg8::f32x4 (&acc)[2][2][4][2], const pg8::Unit& u, int wr, int wc, int fr, int fq) const {
        const int row0 = u.pm * 256 + wr * 64 + fr, col0 = (u.pn & 3) * 256 + wc * 32 + 8 * fq;
#pragma unroll
        for (int ai = 0; ai < 2; ++ai)
#pragma unroll
            for (int m = 0; m < 4; ++m) { bf16* rowp = YS2 + (size_t)(row0 + ai * 128 + m * 16) * D + col0;
#pragma unroll
                for (int bj = 0; bj < 2; ++bj) { const pg8::f32x4 v0 = acc[ai][bj][m][0], v1 = acc[ai][bj][m][1];
                    v4u w; w.x = cvtpk(v0[0], v0[1]); w.y = cvtpk(v0[2], v0[3]); w.z = cvtpk(v1[0], v1[1]); w.w = cvtpk(v1[2], v1[3]); *(v4u*)(rowp + bj * 128) = w; } }
    } };

__device__ __forceinline__ void ph2_fast(Frame& F, int l) {
    pg8::Gemm g{(const bf16*)(F.ws + WS_H), (const bf16*)(F.ws + WS_WIN), SEQ, INW, D}; pg8::StaticOrder S; S.init(SEQ, INW, F.G, F.bid);
    EpiProj E{(bf16*)(F.ws + WS_PROJ)}; pg8::gemm_phase<EpiProj, pg8::StaticOrder, PG_ALIGN, PG_SP2>(F.lds, g, S, E, F.tid);
}
__device__ __forceinline__ void ph6_fast(Frame& F, int l) {
    pg8::Gemm g{(const bf16*)(F.ws + WS_YG), (const bf16*)(F.ws + WS_WGLU), MT, MIXW, MIXW}; pg8::StaticOrder S; S.init(SEQ, MIXW, F.G, F.bid);
    EpiGlu E{(const bf16*)(F.ws + WS_YG), (bf16*)(F.ws + WS_YS)}; pg8::gemm_phase<EpiGlu, pg8::StaticOrder, PG_ALIGN, PG_SP2>(F.lds, g, S, E, F.tid);
}
__device__ __forceinline__ void ph7_fast(Frame& F, int l) {
    pg8::Gemm g{(const bf16*)(F.ws + WS_YS), (const bf16*)(F.ws + WS_WBR), 3 * MT, 3 * D, MIXW}; SchedBr S{F.G, F.bid, SEQ / 256};
    EpiBr E{(bf16*)(F.ws + WS_PROJ)}; pg8::gemm_phase<EpiBr, SchedBr, PG_ALIGN, PG_SP2>(F.lds, g, S, E, F.tid);
}
__device__ __forceinline__ void ph8_fast(Frame& F, int l) {
    pg8::Gemm g{(const bf16*)(F.ws + WS_H), (const bf16*)(F.ws + WS_WMG), MT, INW, D}; SchedMerge S{F.G, F.bid, SEQ / 256};
    EpiMerge E{(const bf16*)(F.ws + WS_PROJ), (bf16*)(F.ws + WS_PM), IN_(I_BMG) + l * INW}; pg8::gemm_phase<EpiMerge, SchedMerge, PG_ALIGN, PG_SP2>(F.lds, g, S, E, F.tid);
}
__device__ __forceinline__ void ph9_fast(Frame& F, int l) {
    pg8::Gemm g{(const bf16*)(F.ws + WS_PM), (const bf16*)(F.ws + WS_WO), MT, D, D}; pg8::StaticOrder S; S.init(SEQ, D, F.G, F.bid);
    EpiWo E{l == 0 ? IN_(I_X) : F.out, l == 0 ? IN_(I_CTX) : (const float*)(F.ws + WS_XC), F.out, (float*)(F.ws + WS_XC), (const float*)(F.ws + WS_MOD) + (size_t)l * 2 * 6144};
    pg8::gemm_phase<EpiWo, pg8::StaticOrder, PG_ALIGN, PG_SP2>(F.lds, g, S, E, F.tid);
}
__device__ __forceinline__ void ph12_fast(Frame& F, int l) {
    pg8::Gemm g{(const bf16*)(F.ws + WS_HS), (const bf16*)(F.ws + WS_W13), MAXSLOT, NE * 512, D}; const int total = moe_build_table<2>(F, F.ctl + CW_CNT + l * 128); SchedMoe S{F.G, F.bid, total, (const LAS unsigned*)(F.lds + MOETAB_OFF)};
    EpiUp E{(bf16*)(F.ws + WS_ACT), (const float*)(F.ws + WS_SW)}; pg8::gemm_phase<EpiUp, SchedMoe, PG_ALIGN, PG_SP2>(F.lds, g, S, E, F.tid);
}
__device__ __forceinline__ void ph13_fast(Frame& F, int l) {
    pg8::Gemm g{(const bf16*)(F.ws + WS_ACT), (const bf16*)(F.ws + WS_W2), MAXSLOT, NE * D, DFF}; const int total = moe_build_table<4>(F, F.ctl + CW_CNT + l * 128); SchedMoe S{F.G, F.bid, total, (const LAS unsigned*)(F.lds + MOETAB_OFF)};
    EpiDown E{(bf16*)(F.ws + WS_YS2)}; pg8::gemm_phase<EpiDown, SchedMoe, PG_ALIGN, PG_SP2>(F.lds, g, S, E, F.tid);
}


typedef short bf16x8 __attribute__((ext_vector_type(8)));
constexpr int NSB = MT / 16;
__device__ __forceinline__ void s5_precompute(Frame& F) {
    LAS float* APr = (LAS float*)F.lds; LAS float* APi = APr + 2176; LAS float* BBr = APi + 2176; LAS float* BBi = BBr + 2048; LAS float* CCr = BBi + 2048; LAS float* CCi = CCr + 2048; LAS float* KK = CCi + 2048;
    for (int item = F.G - 1 - F.bid; item < 2 * G5; item += F.G) { const int l = item >> 5, g = item & 31;
        __syncthreads();
        if (F.tid < 128) { const int d = F.tid >> 6, p = F.tid & 63; const int ldg = (l * 2 + d) * G5 + g;
            const double lr = IN_(I_LRE)[ldg * P5 + p], li = IN_(I_LIM)[ldg * P5 + p], dt = exp((double)IN_(I_LDT)[ldg]);
            for (int e = 0; e <= 16; ++e) { const double m = exp(lr * dt * e), ang = li * dt * e; APr[(d * 64 + p) * 17 + e] = (float)(m * cos(ang)); APi[(d * 64 + p) * 17 + e] = (float)(m * sin(ang)); }
            { const double m16 = exp(lr * dt * 16.0), a16 = li * dt * 16.0; float* A16 = (float*)(F.ws + WS_A16) + ((size_t)((l * 32 + g) * 2 + d) * 64 + p) * 2; A16[0] = (float)(m16 * cos(a16)); A16[1] = (float)(m16 * sin(a16)); }
            const double m1 = exp(lr * dt), ar = m1 * cos(li * dt), ai = m1 * sin(li * dt); const double nr = ar - 1.0, ni = ai, den = lr * lr + li * li;
            const double qr = (nr * lr + ni * li) / den, qi = (ni * lr - nr * li) / den;
            for (int h = 0; h < 16; ++h) { const double x = IN_(I_BRE)[((size_t)ldg * P5 + p) * H5 + h], y = IN_(I_BIM)[((size_t)ldg * P5 + p) * H5 + h];
                BBr[(d * 64 + p) * 16 + h] = (float)(qr * x - qi * y); BBi[(d * 64 + p) * 16 + h] = (float)(qr * y + qi * x);
                CCr[(d * 16 + h) * 64 + p] = IN_(I_CRE)[((size_t)ldg * H5 + h) * P5 + p]; CCi[(d * 16 + h) * 64 + p] = IN_(I_CIM)[((size_t)ldg * H5 + h) * P5 + p]; } }
        __syncthreads();
        for (int idx = F.tid; idx < 8192; idx += NT) { const int d = idx >> 12, e = (idx >> 8) & 15, h = (idx >> 4) & 15, hp = idx & 15; float a = 0.f;
            for (int p = 0; p < 64; ++p) { const float pr = APr[(d * 64 + p) * 17 + e], pi = APi[(d * 64 + p) * 17 + e], br = BBr[(d * 64 + p) * 16 + hp], bi = BBi[(d * 64 + p) * 16 + hp];
                const float wr = pr * br - pi * bi, wi = pr * bi + pi * br; a += CCr[(d * 16 + h) * 64 + p] * wr - CCi[(d * 16 + h) * 64 + p] * wi; }
            KK[idx] = a; }
        __syncthreads();
        bf16* M = (bf16*)(F.ws + WS_S5M) + (size_t)(l * 32 + g) * 3 * 65536;
        for (int idx = F.tid; idx < 32768; idx += NT) {
            const int r = idx >> 7, k0 = (idx & 127) * 2; float v[3][2];
#pragma unroll
            for (int q = 0; q < 2; ++q) { const int kk = k0 + q;
                { const int d = r >> 7, p = (r >> 1) & 63, c = r & 1, sg = kk >> 4, hp = kk & 15, e = d == 0 ? 15 - sg : sg;
                  const float pr = APr[(d * 64 + p) * 17 + e], pi = APi[(d * 64 + p) * 17 + e], br = BBr[(d * 64 + p) * 16 + hp], bi = BBi[(d * 64 + p) * 16 + hp];
                  v[0][q] = c == 0 ? pr * br - pi * bi : pr * bi + pi * br; }
                { const int tau = r >> 4, h = r & 15, sg = kk >> 4, hp = kk & 15; float t = 0.f;
                  if (sg <= tau) t += KK[(0 * 16 + (tau - sg)) * 256 + h * 16 + hp]; if (sg >= tau) t += KK[(1 * 16 + (sg - tau)) * 256 + h * 16 + hp]; v[1][q] = t; }
                { const int tau = r >> 4, h = r & 15, d = kk >> 7, p = (kk >> 1) & 63, c = kk & 1, e = d == 0 ? tau + 1 : 16 - tau;
                  const float cr = CCr[(d * 16 + h) * 64 + p], ci = CCi[(d * 16 + h) * 64 + p], pr = APr[(d * 64 + p) * 17 + e], pi = APi[(d * 64 + p) * 17 + e];
                  v[2][q] = c == 0 ? cr * pr - ci * pi : -(cr * pi + ci * pr); } }
#pragma unroll
            for (int m = 0; m < 3; ++m) *(unsigned*)(M + (size_t)m * 65536 + r * 256 + k0) = pk2(v[m][0], v[m][1]);
        }
    }
}
__device__ __forceinline__ void s5_z_phase(Frame& F, int l) {
    const bf16* PROJ = (const bf16*)(F.ws + WS_PROJ); float* Z = (float*)(F.ws + WS_Z);
    const int l15 = F.lane & 15, lq = F.lane >> 4;
    for (int item = F.bid; item < 256; item += F.G) {
        const int g = item >> 3, part = item & 7; const bf16* Fm = (const bf16*)(F.ws + WS_S5M) + (size_t)(l * 32 + g) * 3 * 65536;
        bf16x8 Af[2][8];
#pragma unroll
        for (int j = 0; j < 2; ++j)
#pragma unroll
            for (int ks = 0; ks < 8; ++ks) Af[j][ks] = *(const bf16x8*)(Fm + (size_t)(16 * (2 * F.wave + j) + l15) * 256 + 32 * ks + 8 * lq);
        const bf16* vsrc = PROJ + (size_t)(16 * l15 + 2 * F.wave + (lq >> 1)) * INW + 16 * g + 8 * (lq & 1);
        __syncthreads();
        bf16x8 nv = *(const bf16x8*)(vsrc + (size_t)part * 256 * INW);
        *(LAS bf16x8*)(F.lds + (F.wave * 64 + F.lane) * 16) = nv;
        __syncthreads();
        int cur = 0;
#pragma unroll 1
        for (int tl = part; tl < MT / 256; tl += 8) {
            const bool more = tl + 8 < MT / 256;
            if (more) nv = *(const bf16x8*)(vsrc + (size_t)(tl + 8) * 256 * INW);
            f32x4 acc[2] = {{0.f, 0.f, 0.f, 0.f}, {0.f, 0.f, 0.f, 0.f}};
#pragma unroll
            for (int ks = 0; ks < 8; ++ks) { const bf16x8 V = *(const LAS bf16x8*)(F.lds + cur * 8192 + (ks * 64 + F.lane) * 16);
#pragma unroll
                for (int j = 0; j < 2; ++j) acc[j] = __builtin_amdgcn_mfma_f32_16x16x32_bf16(Af[j][ks], V, acc[j], 0, 0, 0); }
#pragma unroll
            for (int j = 0; j < 2; ++j) *(f32x4*)(Z + ((size_t)(tl * 16 + l15) * 32 + g) * 256 + 16 * (2 * F.wave + j) + 4 * lq) = acc[j];
            if (more) *(LAS bf16x8*)(F.lds + (cur ^ 1) * 8192 + (F.wave * 64 + F.lane) * 16) = nv;
            __syncthreads();
            cur ^= 1;
        }
    }
}
__device__ __forceinline__ int s5_chain_sb(int d, int i) { return d == 0 ? (i < 16 ? 1024 + i : i - 16) : (i < 16 ? 1039 - i : 1023 - (i - 16)); }
__device__ __forceinline__ void s5_scan_phase(Frame& F, int l) {
    LAS float* EX = (LAS float*)F.lds;
    for (int item = F.bid; item < 256; item += F.G) {
        const int cid = item * 16 + (F.tid & 15), j = F.tid >> 4;
        const int g = cid >> 7, d = (cid >> 6) & 1, p = cid & 63;
        const float* A16 = (const float*)(F.ws + WS_A16) + ((size_t)((l * 32 + g) * 2 + d) * 64 + p) * 2; const float ar = A16[0], ai = A16[1];
        const float* Z = (const float*)(F.ws + WS_Z) + (size_t)g * 256 + d * 128 + 2 * p; bf16* SS = (bf16*)(F.ws + WS_SS) + (size_t)g * 256 + d * 128 + 2 * p;
        float2 z[33];
#pragma unroll
        for (int q = 0; q < 33; ++q) { const int i = 33 * j + q; z[q] = i < NSB ? *(const float2*)(Z + (size_t)s5_chain_sb(d, i) * 8192) : make_float2(0.f, 0.f); }
        float hr = 0.f, hi = 0.f, pr = 1.f, pi = 0.f;
#pragma unroll
        for (int q = 0; q < 33; ++q) { if (33 * j + q < NSB) { const float nr = ar * hr - ai * hi + z[q].x, ni = ar * hi + ai * hr + z[q].y; hr = nr; hi = ni; const float qr = pr * ar - pi * ai, qi = pr * ai + pi * ar; pr = qr; pi = qi; } }
        __syncthreads();
        EX[(j * 16 + (F.tid & 15)) * 4 + 0] = hr; EX[(j * 16 + (F.tid & 15)) * 4 + 1] = hi; EX[(j * 16 + (F.tid & 15)) * 4 + 2] = pr; EX[(j * 16 + (F.tid & 15)) * 4 + 3] = pi;
        __syncthreads();
        float cr = 0.f, ci = 0.f;
        for (int i = 0; i < j; ++i) { const float er = EX[(i * 16 + (F.tid & 15)) * 4 + 0], ei = EX[(i * 16 + (F.tid & 15)) * 4 + 1], qr = EX[(i * 16 + (F.tid & 15)) * 4 + 2], qi = EX[(i * 16 + (F.tid & 15)) * 4 + 3];
            const float nr = qr * cr - qi * ci + er, ni = qr * ci + qi * cr + ei; cr = nr; ci = ni; }
        hr = cr; hi = ci;
#pragma unroll
        for (int q = 0; q < 33; ++q) { const int i = 33 * j + q; if (i < NSB) { *(unsigned*)(SS + (size_t)s5_chain_sb(d, i) * 8192) = pk2(hr, hi);
            const float nr = ar * hr - ai * hi + z[q].x, ni = ar * hi + ai * hr + z[q].y; hr = nr; hi = ni; } }
    }
}
__device__ __forceinline__ void s5_y_phase(Frame& F, int l) {
    const bf16* PROJ = (const bf16*)(F.ws + WS_PROJ); const bf16* SS = (const bf16*)(F.ws + WS_SS); bf16* YG = (bf16*)(F.ws + WS_YG); const float* ds = IN_(I_DSKIP) + l * MIXW;
    const int l15 = F.lane & 15, lq = F.lane >> 4;
    for (int item = F.bid; item < 256; item += F.G) {
        const int g = item >> 3, part = item & 7; const bf16* Tm = (const bf16*)(F.ws + WS_S5M) + ((size_t)(l * 32 + g) * 3 + 1) * 65536; const bf16* Em = Tm + 65536;
        bf16x8 At[2][8], Ae[2][8];
#pragma unroll
        for (int j = 0; j < 2; ++j)
#pragma unroll
            for (int ks = 0; ks < 8; ++ks) { const size_t o = (size_t)(16 * (2 * F.wave + j) + l15) * 256 + 32 * ks + 8 * lq; At[j][ks] = *(const bf16x8*)(Tm + o); Ae[j][ks] = *(const bf16x8*)(Em + o); }
        const f32x4 dsk = *(const f32x4*)(ds + 16 * g + 4 * lq);
        const int ntl = l == 0 ? MT / 256 : SEQ / 256;
        const bf16* vsrc = PROJ + (size_t)(16 * l15 + 2 * F.wave + (lq >> 1)) * INW + 16 * g + 8 * (lq & 1);
        const bf16* ssrc = SS + ((size_t)l15 * 32 + g) * 256 + 32 * F.wave + 8 * lq;
        __syncthreads();
        bf16x8 nv = *(const bf16x8*)(vsrc + (size_t)part * 256 * INW), ns = *(const bf16x8*)(ssrc + (size_t)part * 16 * 8192);
        *(LAS bf16x8*)(F.lds + (F.wave * 64 + F.lane) * 16) = nv; *(LAS bf16x8*)(F.lds + 8192 + (F.wave * 64 + F.lane) * 16) = ns;
        __syncthreads();
        int cur = 0;
#pragma unroll 1
        for (int tl = part; tl < ntl; tl += 8) {
            const bool more = tl + 8 < ntl;
            if (more) { nv = *(const bf16x8*)(vsrc + (size_t)(tl + 8) * 256 * INW); ns = *(const bf16x8*)(ssrc + (size_t)(tl + 8) * 16 * 8192); }
            v2u uu[2];
#pragma unroll
            for (int j = 0; j < 2; ++j) uu[j] = *(const v2u*)(PROJ + ((size_t)tl * 256 + 16 * l15 + (2 * F.wave + j)) * INW + 16 * g + 4 * lq);
            f32x4 acc[2] = {{0.f, 0.f, 0.f, 0.f}, {0.f, 0.f, 0.f, 0.f}};
#pragma unroll
            for (int ks = 0; ks < 8; ++ks) { const bf16x8 V = *(const LAS bf16x8*)(F.lds + cur * 16384 + (ks * 64 + F.lane) * 16), S = *(const LAS bf16x8*)(F.lds + cur * 16384 + 8192 + (ks * 64 + F.lane) * 16);
#pragma unroll
                for (int j = 0; j < 2; ++j) { acc[j] = __builtin_amdgcn_mfma_f32_16x16x32_bf16(At[j][ks], V, acc[j], 0, 0, 0); acc[j] = __builtin_amdgcn_mfma_f32_16x16x32_bf16(Ae[j][ks], S, acc[j], 0, 0, 0); } }
#pragma unroll
            for (int j = 0; j < 2; ++j) { const size_t row = (size_t)tl * 256 + 16 * l15 + (2 * F.wave + j); const int ch = 16 * g + 4 * lq; const v2u u = uu[j];
                const float y0 = acc[j][0] + dsk[0] * bflo(u.x), y1 = acc[j][1] + dsk[1] * bfhi(u.x), y2 = acc[j][2] + dsk[2] * bflo(u.y), y3 = acc[j][3] + dsk[3] * bfhi(u.y);
                v2u w; w.x = cvtpk(geluf_(y0), geluf_(y1)); w.y = cvtpk(geluf_(y2), geluf_(y3)); *(v2u*)(YG + row * MIXW + ch) = w; }
            if (more) { *(LAS bf16x8*)(F.lds + (cur ^ 1) * 16384 + (F.wave * 64 + F.lane) * 16) = nv; *(LAS bf16x8*)(F.lds + (cur ^ 1) * 16384 + 8192 + (F.wave * 64 + F.lane) * 16) = ns; }
            __syncthreads();
            cur ^= 1;
        }
    }
}
constexpr int SG_STRIDE = 272, SG_IMG = 256 * SG_STRIDE, SG_STAT = SG_IMG;
__device__ __forceinline__ void sg_fast_chunk(Frame& F, int l, int chunk) {
    const bf16* PROJ = (const bf16*)(F.ws + WS_PROJ); bf16* YB = (bf16*)(F.ws + WS_YS) + (size_t)MT * MIXW; const bf16* WSG = (const bf16*)(F.ws + WS_WSG);
    const float* lg = IN_(I_SGG) + l * MIXW; const float* lb = IN_(I_SGB) + l * MIXW; const float* bsg = IN_(I_BSG) + l * 512;
    LAS float* st = (LAS float*)(F.lds + SG_STAT);
    __syncthreads();
    {
        const int p = F.tid >> 2, part = F.tid & 3; const bf16* vr = PROJ + (size_t)(chunk * 128 + p) * INW + 1024 + part * 128; float s = 0.f, q = 0.f;
#pragma unroll 4
        for (int c = 0; c < 128; c += 8) { const v4u w = *(const v4u*)(vr + c); const float x[8] = {bflo(w.x), bfhi(w.x), bflo(w.y), bfhi(w.y), bflo(w.z), bfhi(w.z), bflo(w.w), bfhi(w.w)};
#pragma unroll
            for (int i = 0; i < 8; ++i) { s += x[i]; q += x[i] * x[i]; } }
        s += __shfl_xor(s, 1); q += __shfl_xor(q, 1); s += __shfl_xor(s, 2); q += __shfl_xor(q, 2);
        const float mu = s * (1.f / 512.f), var = fmaxf(q * (1.f / 512.f) - mu * mu, 0.f);
        if (part == 0) { st[p * 2] = mu; st[p * 2 + 1] = rsqrtf(var + EPS); }
    }
    const int l15 = F.lane & 15, lq = F.lane >> 4;
#pragma unroll 1
    for (int pass = 0; pass < 2; ++pass) {
        __syncthreads();
#pragma unroll 1
        for (int it = F.tid; it < 2048; it += NT) { const int tp = it & 63, cg = it >> 6; const int p0 = tp * 2, ch = pass * 256 + cg * 8;
            const v4u w0 = *(const v4u*)(PROJ + (size_t)(chunk * 128 + p0) * INW + 1024 + ch), w1 = *(const v4u*)(PROJ + (size_t)(chunk * 128 + p0 + 1) * INW + 1024 + ch);
            const float mu0 = st[p0 * 2], rs0 = st[p0 * 2 + 1], mu1 = st[p0 * 2 + 2], rs1 = st[p0 * 2 + 3];
            const float x0[8] = {bflo(w0.x), bfhi(w0.x), bflo(w0.y), bfhi(w0.y), bflo(w0.z), bfhi(w0.z), bflo(w0.w), bfhi(w0.w)};
            const float x1[8] = {bflo(w1.x), bfhi(w1.x), bflo(w1.y), bfhi(w1.y), bflo(w1.z), bfhi(w1.z), bflo(w1.w), bfhi(w1.w)};
#pragma unroll
            for (int i = 0; i < 8; ++i) { const float gm = lg[ch + i], bt = lb[ch + i];
                *(LAS unsigned*)(F.lds + (cg * 8 + i) * SG_STRIDE + p0 * 2) = pk2((x0[i] - mu0) * rs0 * gm + bt, (x1[i] - mu1) * rs1 * gm + bt); } }
        __syncthreads();
        const int ggl = F.wave >> 2, gg = pass * 2 + ggl, rb0 = (F.wave & 3) * 2;
        bf16x8 A[2][4];
#pragma unroll
        for (int j = 0; j < 2; ++j)
#pragma unroll
            for (int ks = 0; ks < 4; ++ks) A[j][ks] = *(const LAS bf16x8*)(F.lds + (ggl * 128 + (rb0 + j) * 16 + l15) * SG_STRIDE + (32 * ks + 8 * lq) * 2);
        f32x4 acc[2][8];
#pragma unroll
        for (int j = 0; j < 2; ++j)
#pragma unroll
            for (int cb = 0; cb < 8; ++cb) acc[j][cb] = (f32x4){0.f, 0.f, 0.f, 0.f};
#pragma unroll
        for (int cb = 0; cb < 8; ++cb) {
            bf16x8 B[4];
#pragma unroll
            for (int ks = 0; ks < 4; ++ks) B[ks] = *(const bf16x8*)(WSG + ((size_t)gg * 128 + cb * 16 + l15) * 128 + 32 * ks + 8 * lq);
#pragma unroll
            for (int ks = 0; ks < 4; ++ks)
#pragma unroll
                for (int j = 0; j < 2; ++j) acc[j][cb] = __builtin_amdgcn_mfma_f32_16x16x32_bf16(A[j][ks], B[ks], acc[j][cb], 0, 0, 0);
        }
#pragma unroll
        for (int cb = 0; cb < 8; ++cb) { const int q = cb * 16 + l15; const size_t row = (size_t)chunk * 128 + q; const float bq = bsg[gg * 128 + q];
#pragma unroll
            for (int j = 0; j < 2; ++j) { const int col = gg * 128 + (rb0 + j) * 16 + 4 * lq; const v2u gu = *(const v2u*)(PROJ + row * INW + 512 + col);
                v2u w; w.x = cvtpk(bflo(gu.x) * (acc[j][cb][0] + bq), bfhi(gu.x) * (acc[j][cb][1] + bq)); w.y = cvtpk(bflo(gu.y) * (acc[j][cb][2] + bq), bfhi(gu.y) * (acc[j][cb][3] + bq));
                *(v2u*)(YB + row * MIXW + col) = w; } }
    }
}


__device__ __forceinline__ void thin_acc(f32x4 (&acc)[2], const bf16* A, int lda, const bf16* Bt, int K, int wave, int lane) {
    const int r = lane & 15, q = lane >> 4; const bf16* a0 = A + (size_t)(32 * wave + r) * lda + 8 * q; const bf16* a1 = a0 + (size_t)16 * lda; const bf16* b = Bt + (size_t)r * K + 8 * q;
#pragma unroll 8
    for (int ks = 0; ks < K / 32; ++ks) { const bf16x8 x0 = *(const bf16x8*)(a0 + 32 * ks), x1 = *(const bf16x8*)(a1 + 32 * ks), w = *(const bf16x8*)(b + 32 * ks);
        acc[0] = __builtin_amdgcn_mfma_f32_16x16x32_bf16(x0, w, acc[0], 0, 0, 0); acc[1] = __builtin_amdgcn_mfma_f32_16x16x32_bf16(x1, w, acc[1], 0, 0, 0); }
}
#define THIN_FOREACH(acc, body) _Pragma("unroll") for (int _j = 0; _j < 2; ++_j) _Pragma("unroll") for (int _i = 0; _i < 4; ++_i) { const int crow = 32 * F.wave + 16 * _j + 4 * (F.lane >> 4) + _i; const float v = acc[_j][_i]; body }
__device__ __forceinline__ void ph2_ctx(Frame& F, int ncols) {
    const bf16* Hc = (const bf16*)(F.ws + WS_H) + (size_t)SEQ * D; bf16* P = (bf16*)(F.ws + WS_PROJ) + (size_t)SEQ * INW; const bf16* W = (const bf16*)(F.ws + WS_WIN);
    for (int it = F.bid; it < ncols / 16; it += F.G) { const int col = it * 16 + (F.lane & 15); f32x4 acc[2] = {{0.f, 0.f, 0.f, 0.f}, {0.f, 0.f, 0.f, 0.f}};
        thin_acc(acc, Hc, D, W + (size_t)it * 16 * D, D, F.wave, F.lane);
        THIN_FOREACH(acc, { const float o = (col >= 512 && col < 1536) ? geluf_(v) : v; P[(size_t)crow * INW + col] = (bf16)f2bf(o); }) }
}
__device__ __forceinline__ void ph6_ctx(Frame& F) {
    const bf16* YGc = (const bf16*)(F.ws + WS_YG) + (size_t)SEQ * MIXW; bf16* YA = (bf16*)(F.ws + WS_YS) + (size_t)SEQ * MIXW; const bf16* W = (const bf16*)(F.ws + WS_WGLU);
    for (int it = F.bid; it < MIXW / 16; it += F.G) { const int col = it * 16 + (F.lane & 15); f32x4 acc[2] = {{0.f, 0.f, 0.f, 0.f}, {0.f, 0.f, 0.f, 0.f}};
        thin_acc(acc, YGc, MIXW, W + (size_t)it * 16 * MIXW, MIXW, F.wave, F.lane);
        THIN_FOREACH(acc, { YA[(size_t)crow * MIXW + col] = (bf16)f2bf(bf2f(YGc[(size_t)crow * MIXW + col]) * sigmoidf_(v)); }) }
}
__device__ __forceinline__ void ph7_ctx(Frame& F) {
    bf16* BR = (bf16*)(F.ws + WS_PROJ) + (size_t)SEQ * INW;
    for (int it = F.bid; it < 3 * (D / 16); it += F.G) { const int kk = it / (D / 16), cb = it % (D / 16); const int col = cb * 16 + (F.lane & 15); f32x4 acc[2] = {{0.f, 0.f, 0.f, 0.f}, {0.f, 0.f, 0.f, 0.f}};
        thin_acc(acc, (const bf16*)(F.ws + WS_YS) + ((size_t)kk * MT + SEQ) * MIXW, MIXW, (const bf16*)(F.ws + WS_WBR) + ((size_t)kk * 1024 + cb * 16) * MIXW, MIXW, F.wave, F.lane);
        THIN_FOREACH(acc, { BR[(size_t)crow * INW + kk * 1024 + col] = (bf16)f2bf(v); }) }
}
__device__ __forceinline__ void ph8_ctx(Frame& F, int l) {
    const bf16* Hc = (const bf16*)(F.ws + WS_H) + (size_t)SEQ * D; const bf16* BR = (const bf16*)(F.ws + WS_PROJ) + (size_t)SEQ * INW; bf16* PM = (bf16*)(F.ws + WS_PM) + (size_t)SEQ * D; const float* bm = IN_(I_BMG) + l * INW;
    for (int it = F.bid; it < D / 16; it += F.G) { const int col = it * 16 + (F.lane & 15); float p[2][4] = {};
#pragma unroll 1
        for (int kk = 0; kk < 3; ++kk) { f32x4 acc[2] = {{0.f, 0.f, 0.f, 0.f}, {0.f, 0.f, 0.f, 0.f}};
            thin_acc(acc, Hc, D, (const bf16*)(F.ws + WS_WMG) + ((size_t)kk * 1024 + it * 16) * D, D, F.wave, F.lane);
            const float bb = bm[kk * 1024 + col];
            THIN_FOREACH(acc, { p[_j][_i] += sigmoidf_(v + bb) * bf2f(BR[(size_t)crow * INW + kk * 1024 + col]); }) }
#pragma unroll
        for (int j = 0; j < 2; ++j)
#pragma unroll
            for (int i = 0; i < 4; ++i) PM[(size_t)(32 * F.wave + 16 * j + 4 * (F.lane >> 4) + i) * D + col] = (bf16)f2bf(p[j][i]); }
}
__device__ __forceinline__ void ph9_ctx(Frame& F, int l) {
    const bf16* PMc = (const bf16*)(F.ws + WS_PM) + (size_t)SEQ * D; float* XC = (float*)(F.ws + WS_XC); const float* xs = l == 0 ? IN_(I_CTX) : (const float*)(F.ws + WS_XC);
    const float* ga = (const float*)(F.ws + WS_MOD) + (size_t)(l * 2 + 1) * 6144 + 2048;
    for (int it = F.bid; it < D / 16; it += F.G) { const int col = it * 16 + (F.lane & 15); f32x4 acc[2] = {{0.f, 0.f, 0.f, 0.f}, {0.f, 0.f, 0.f, 0.f}};
        thin_acc(acc, PMc, D, (const bf16*)(F.ws + WS_WO) + (size_t)it * 16 * D, D, F.wave, F.lane);
        const float gc = ga[col];
        THIN_FOREACH(acc, { XC[(size_t)crow * D + col] = xs[(size_t)crow * D + col] + gc * v; }) }
}

struct NSmem { float As[16][68]; float Bs[16][68]; };
template <class AF>
__device__ __forceinline__ void ngemm_acc(float (&acc)[4][4], const AF& af, const float* B, int ldb, int K, LAS NSmem* s, int t) {
    const int ty = t >> 4, tx = t & 15, lr = t >> 2, lk = (t & 3) * 4, bk = t >> 4, bn = (t & 15) * 4;
    for (int k0 = 0; k0 < K; k0 += 16) {
        const float4 av = af.load4(lr, k0 + lk);
        const float4 bv = *(const float4*)(B + (size_t)(k0 + bk) * ldb + bn);
        __syncthreads();
        s->As[lk + 0][lr] = av.x; s->As[lk + 1][lr] = av.y; s->As[lk + 2][lr] = av.z; s->As[lk + 3][lr] = av.w;
        *(LAS f32x4*)&s->Bs[bk][bn] = (f32x4){bv.x, bv.y, bv.z, bv.w};
        __syncthreads();
#pragma unroll
        for (int k = 0; k < 16; ++k) {
            const f32x4 a = *(const LAS f32x4*)&s->As[k][ty * 4]; const f32x4 b = *(const LAS f32x4*)&s->Bs[k][tx * 4];
            const float aa[4] = {a.x, a.y, a.z, a.w}, bb[4] = {b.x, b.y, b.z, b.w};
#pragma unroll
            for (int i = 0; i < 4; ++i)
#pragma unroll
                for (int j = 0; j < 4; ++j) acc[i][j] += aa[i] * bb[j];
        }
    }
}
struct ABf { const bf16* A; int lda; __device__ __forceinline__ float4 load4(int r, int k) const { const v2u w = *(const v2u*)(A + (size_t)r * lda + k);
    return make_float4(bf2f((unsigned short)(w.x & 0xffff)), bf2f((unsigned short)(w.x >> 16)), bf2f((unsigned short)(w.y & 0xffff)), bf2f((unsigned short)(w.y >> 16))); } };
#define NTILE_BEGIN(ntiles) { const int _half = F.tid >> 8, t = F.tid & 255, ty = t >> 4, tx = t & 15; LAS NSmem* sm = (LAS NSmem*)F.lds + _half; (void)ty; (void)tx; \
    const int _nt = (ntiles), _nit = (_nt + 2 * F.G - 1) / (2 * F.G); \
    for (int _it = 0; _it < _nit; ++_it) { int T = (_it * F.G + F.bid) * 2 + _half; const bool valid = T < _nt; if (!valid) T = _nt - 1;
#define NTILE_END } }

__device__ __forceinline__ void ph0_prologue(Frame& F) {
    float* mod = (float*)(F.ws + WS_MOD);
    LAS float* SV = (LAS float*)(F.lds + 131072 + 4096);
    for (int i = F.tid; i < 2048; i += NT) SV[i] = siluf_(i < 1024 ? IN_(I_C)[i] : IN_(I_CCTX)[i - 1024]);
    __syncthreads();
    LAS float* RED = (LAS float*)(F.lds + 131072 + 4096 + 8192);
    for (int it = F.bid; it < 2 * 96; it += F.G) { const int l = it / 96, j = (it % 96) * 64 + F.lane;
        const float* W = IN_(I_WADA) + (size_t)l * D * 6144 + j + (size_t)(F.wave * 128) * 6144;
        float a0 = 0.f, a1 = 0.f;
#pragma unroll 32
        for (int kk = 0; kk < 128; ++kk) { const float w = W[(size_t)kk * 6144]; a0 += SV[F.wave * 128 + kk] * w; a1 += SV[1024 + F.wave * 128 + kk] * w; }
        __syncthreads();
        RED[(F.wave * 2 + 0) * 64 + F.lane] = a0; RED[(F.wave * 2 + 1) * 64 + F.lane] = a1;
        __syncthreads();
        if (F.wave < 2) { float s = 0.f;
#pragma unroll
            for (int w8 = 0; w8 < 8; ++w8) s += RED[(w8 * 2 + F.wave) * 64 + F.lane];
            mod[(size_t)(l * 2 + F.wave) * 6144 + j] = s + IN_(I_BADA)[l * 6144 + j]; }
    }
}
__device__ __forceinline__ void hprep_rows(Frame& F, int l) {
    bf16* H = (bf16*)(F.ws + WS_H); const float* g = IN_(I_GMIX) + l * D;
    const int gw = F.bid * (NT / 64) + F.wave, ngw = F.G * (NT / 64);
    for (int row = gw; row < MT; row += ngw) {
        const float* m = mod_ptr(F, l, row); const float* xr = xsrc_row(F, l, row);
        f32x4 v[4]; float s = 0.f;
#pragma unroll
        for (int j = 0; j < 4; ++j) { v[j] = *(const f32x4*)(xr + 4 * F.lane + 256 * j); s += v[j].x * v[j].x + v[j].y * v[j].y + v[j].z * v[j].z + v[j].w * v[j].w; }
        const float rstd = rsqrtf(wave_sum(s) * (1.f / D) + EPS);
#pragma unroll
        for (int j = 0; j < 4; ++j) { const int c = 4 * F.lane + 256 * j; const f32x4 gg = *(const f32x4*)(g + c), sc = *(const f32x4*)(m + 1024 + c), sh = *(const f32x4*)(m + c);
            const f32x4 o = v[j] * rstd * gg * (1.f + sc) + sh; v2u w; w.x = pk2(o.x, o.y); w.y = pk2(o.z, o.w); *(v2u*)(H + (size_t)row * D + c) = w; }
    }
}
__device__ __forceinline__ void ph2_naive(Frame& F, int l) {
    const bf16* H = (const bf16*)(F.ws + WS_H); bf16* PROJ = (bf16*)(F.ws + WS_PROJ); const float* W = IN_(I_WIN) + (size_t)l * D * INW;
    NTILE_BEGIN((MT / 64) * (INW / 64))
        const int m0 = (T / (INW / 64)) * 64, n0 = (T % (INW / 64)) * 64;
        float acc[4][4] = {};
        ngemm_acc(acc, ABf{H + (size_t)m0 * D, D}, W + n0, INW, D, sm, t);
        if (valid) {
#pragma unroll
            for (int i = 0; i < 4; ++i) { float o[4];
#pragma unroll
                for (int j = 0; j < 4; ++j) { o[j] = acc[i][j]; if (n0 >= 512 && n0 < 1536) o[j] = geluf_(o[j]); }
                v2u w; w.x = pk2(o[0], o[1]); w.y = pk2(o[2], o[3]); *(v2u*)(PROJ + (size_t)(m0 + ty * 4 + i) * INW + n0 + tx * 4) = w; }
        }
    NTILE_END
}
__device__ __forceinline__ int chain_row(int dir, int pos) { return dir == 0 ? (pos < CTX ? SEQ + pos : pos - CTX) : (pos < CTX ? SEQ + CTX - 1 - pos : SEQ - 1 - (pos - CTX)); }
__device__ __forceinline__ void ph3_s5_naive(Frame& F, int l) {
    LAS float* Cr = (LAS float*)(F.lds + 32768); LAS float* Ci = Cr + 1024; LAS float* Sr = Ci + 1024; LAS float* Si = Sr + 2048;
    const bf16* PROJ = (const bf16*)(F.ws + WS_PROJ); float* YD = (float*)(F.ws + WS_S5);
    for (int item = F.bid; item < 64; item += F.G) {
        if (F.wave == 0) {
            const int g = item >> 1, dir = item & 1, p = F.lane;
            const int ldg = ((l * 2 + dir) * G5 + g);
            const float lr = IN_(I_LRE)[ldg * P5 + p], li = IN_(I_LIM)[ldg * P5 + p], dt = expf(IN_(I_LDT)[ldg]);
            const float er = expf(lr * dt), ar = er * cosf(li * dt), ai = er * sinf(li * dt);
            const float nr = ar - 1.f, ni = ai, den = lr * lr + li * li;
            const float qr = (nr * lr + ni * li) / den, qi = (ni * lr - nr * li) / den;
            float br[16], bi[16];
#pragma unroll
            for (int h = 0; h < 16; ++h) { const float x = IN_(I_BRE)[((size_t)ldg * P5 + p) * H5 + h], y = IN_(I_BIM)[((size_t)ldg * P5 + p) * H5 + h]; br[h] = qr * x - qi * y; bi[h] = qr * y + qi * x; }
            for (int h = 0; h < 16; ++h) { Cr[h * 64 + p] = IN_(I_CRE)[((size_t)ldg * H5 + h) * P5 + p]; Ci[h * 64 + p] = IN_(I_CIM)[((size_t)ldg * H5 + h) * P5 + p]; }
            float sr = 0.f, si = 0.f;
            float* Y = YD + (size_t)dir * MT * MIXW;
#pragma unroll 1
            for (int blk = 0; blk < MT / 32; ++blk) {
#pragma unroll 1
                for (int tt = 0; tt < 32; ++tt) {
                    const int row = chain_row(dir, blk * 32 + tt);
                    const v4u u0 = *(const v4u*)(PROJ + (size_t)row * INW + g * 16), u1 = *(const v4u*)(PROJ + (size_t)row * INW + g * 16 + 8);
                    const unsigned uw[8] = {u0.x, u0.y, u0.z, u0.w, u1.x, u1.y, u1.z, u1.w};
                    float xr = 0.f, xi = 0.f;
#pragma unroll
                    for (int h = 0; h < 8; ++h) { const float ua = bf2f((unsigned short)(uw[h] & 0xffff)), ub = bf2f((unsigned short)(uw[h] >> 16));
                        xr += br[2 * h] * ua + br[2 * h + 1] * ub; xi += bi[2 * h] * ua + bi[2 * h + 1] * ub; }
                    const float nsr = ar * sr - ai * si + xr, nsi = ar * si + ai * sr + xi;
                    sr = nsr; si = nsi; Sr[tt * 64 + p] = sr; Si[tt * 64 + p] = si;
                }
                asm volatile("s_waitcnt lgkmcnt(0)" ::: "memory");
#pragma unroll 1
                for (int o = p; o < 512; o += 64) {
                    const int tt = o >> 4, h = o & 15; float a = 0.f;
#pragma unroll 4
                    for (int q = 0; q < 64; ++q) a += Cr[h * 64 + q] * Sr[tt * 64 + q] - Ci[h * 64 + q] * Si[tt * 64 + q];
                    Y[(size_t)chain_row(dir, blk * 32 + tt) * MIXW + g * 16 + h] = a;
                }
                asm volatile("s_waitcnt lgkmcnt(0)" ::: "memory");
            }
        }
    }
}
__device__ __forceinline__ void ph3_sg_naive(Frame& F, int l) {
    const bf16* PROJ = (const bf16*)(F.ws + WS_PROJ); bf16* YB = (bf16*)(F.ws + WS_YS) + (size_t)MT * MIXW;
    LAS float* stat = (LAS float*)(F.lds + 32768);
    const float* lg = IN_(I_SGG) + l * MIXW; const float* lb = IN_(I_SGB) + l * MIXW;
    NTILE_BEGIN((MT / 128) * 16)
        const int chunk = T >> 4, gg = (T >> 2) & 3, q0 = ((T >> 1) & 1) * 64, c0 = (T & 1) * 64;
        LAS float* st = stat + _half * 256;
        __syncthreads();
        if (t < 128) { const bf16* vr = PROJ + (size_t)(chunk * 128 + t) * INW + 1024; float s = 0.f;
            for (int c = 0; c < 512; c += 2) { const unsigned w = *(const unsigned*)(vr + c); s += bf2f((unsigned short)(w & 0xffff)) + bf2f((unsigned short)(w >> 16)); }
            const float mu = s * (1.f / 512.f); float q = 0.f;
            for (int c = 0; c < 512; c += 2) { const unsigned w = *(const unsigned*)(vr + c); const float a = bf2f((unsigned short)(w & 0xffff)) - mu, b = bf2f((unsigned short)(w >> 16)) - mu; q += a * a + b * b; }
            st[t * 2] = mu; st[t * 2 + 1] = rsqrtf(q * (1.f / 512.f) + EPS); }
        __syncthreads();
        float acc[4][4] = {};
        {
            const float* A = IN_(I_WSG) + ((size_t)(l * 4 + gg) * 128 + q0) * 128;
            const int lr = t >> 2, lk = (t & 3) * 4, bk = t >> 4, bn = (t & 15) * 4;
            for (int k0 = 0; k0 < 128; k0 += 16) {
                const float4 av = *(const float4*)(A + (size_t)lr * 128 + k0 + lk);
                const int p = k0 + bk; const int col = gg * 128 + c0 + bn;
                const v2u w = *(const v2u*)(PROJ + (size_t)(chunk * 128 + p) * INW + 1024 + col);
                const float mu = st[p * 2], rs = st[p * 2 + 1];
                float4 bv; bv.x = (bf2f((unsigned short)(w.x & 0xffff)) - mu) * rs * lg[col] + lb[col]; bv.y = (bf2f((unsigned short)(w.x >> 16)) - mu) * rs * lg[col + 1] + lb[col + 1];
                bv.z = (bf2f((unsigned short)(w.y & 0xffff)) - mu) * rs * lg[col + 2] + lb[col + 2]; bv.w = (bf2f((unsigned short)(w.y >> 16)) - mu) * rs * lg[col + 3] + lb[col + 3];
                __syncthreads();
                sm->As[lk + 0][lr] = av.x; sm->As[lk + 1][lr] = av.y; sm->As[lk + 2][lr] = av.z; sm->As[lk + 3][lr] = av.w;
                *(LAS f32x4*)&sm->Bs[bk][bn] = (f32x4){bv.x, bv.y, bv.z, bv.w};
                __syncthreads();
#pragma unroll
                for (int k = 0; k < 16; ++k) { const f32x4 a = *(const LAS f32x4*)&sm->As[k][ty * 4]; const f32x4 b = *(const LAS f32x4*)&sm->Bs[k][tx * 4];
                    const float aa[4] = {a.x, a.y, a.z, a.w}, bb[4] = {b.x, b.y, b.z, b.w};
#pragma unroll
                    for (int i = 0; i < 4; ++i)
#pragma unroll
                        for (int j = 0; j < 4; ++j) acc[i][j] += aa[i] * bb[j]; }
            }
        }
        if (valid) {
#pragma unroll
            for (int i = 0; i < 4; ++i) { const int q = q0 + ty * 4 + i; const size_t row = (size_t)chunk * 128 + q; const int col = gg * 128 + c0 + tx * 4;
                const float bq = IN_(I_BSG)[l * 512 + gg * 128 + q];
                const v2u gu = *(const v2u*)(PROJ + row * INW + 512 + col);
                v2u w; w.x = pk2(bf2f((unsigned short)(gu.x & 0xffff)) * (acc[i][0] + bq), bf2f((unsigned short)(gu.x >> 16)) * (acc[i][1] + bq));
                w.y = pk2(bf2f((unsigned short)(gu.y & 0xffff)) * (acc[i][2] + bq), bf2f((unsigned short)(gu.y >> 16)) * (acc[i][3] + bq));
                *(v2u*)(YB + row * MIXW + col) = w; }
        }
    NTILE_END
}
__device__ __forceinline__ void ph3_conv(Frame& F, int l, int nrows) {
    const bf16* PROJ = (const bf16*)(F.ws + WS_PROJ); bf16* YC = (bf16*)(F.ws + WS_YS) + (size_t)2 * MT * MIXW; const float* wc = IN_(I_WCONV) + l * 3 * MIXW;
    const size_t gt = (size_t)F.bid * NT + F.tid, ngt = (size_t)F.G * NT;
#pragma unroll 2
    for (size_t i = gt; i < (size_t)nrows * (MIXW / 8); i += ngt) {
        const int row = (int)(i / (MIXW / 8)), c = (int)(i % (MIXW / 8)) * 8;
        int pos, rl; if (row < SEQ) { pos = row & 63; rl = 64; } else { pos = row - SEQ; rl = 256; }
        const bf16* r0 = PROJ + (size_t)row * INW + 1536 + c;
        const v4u zero = {0u, 0u, 0u, 0u};
        const v4u b0 = *(const v4u*)(r0), c0 = *(const v4u*)(r0 + 512), h0 = *(const v4u*)(r0 + 1024);
        const v4u cm = pos > 0 ? *(const v4u*)(r0 - INW + 512) : zero, hm = pos > 0 ? *(const v4u*)(r0 - INW + 1024) : zero;
        const v4u cp = pos < rl - 1 ? *(const v4u*)(r0 + INW + 512) : zero, hp = pos < rl - 1 ? *(const v4u*)(r0 + INW + 1024) : zero;
        const f32x4 w0a = *(const f32x4*)(wc + c), w0b = *(const f32x4*)(wc + c + 4), w1a = *(const f32x4*)(wc + 512 + c), w1b = *(const f32x4*)(wc + 512 + c + 4), w2a = *(const f32x4*)(wc + 1024 + c), w2b = *(const f32x4*)(wc + 1024 + c + 4);
        const float w0[8] = {w0a.x, w0a.y, w0a.z, w0a.w, w0b.x, w0b.y, w0b.z, w0b.w}, w1[8] = {w1a.x, w1a.y, w1a.z, w1a.w, w1b.x, w1b.y, w1b.z, w1b.w}, w2[8] = {w2a.x, w2a.y, w2a.z, w2a.w, w2b.x, w2b.y, w2b.z, w2b.w};
        const unsigned bb[4] = {b0.x, b0.y, b0.z, b0.w}, cc[4] = {c0.x, c0.y, c0.z, c0.w}, hh[4] = {h0.x, h0.y, h0.z, h0.w}, cmv[4] = {cm.x, cm.y, cm.z, cm.w}, hmv[4] = {hm.x, hm.y, hm.z, hm.w}, cpv[4] = {cp.x, cp.y, cp.z, cp.w}, hpv[4] = {hp.x, hp.y, hp.z, hp.w};
        unsigned o[4];
#pragma unroll
        for (int j = 0; j < 4; ++j) {
            const float ylo = bflo(bb[j]) * (w0[2 * j] * (bflo(cmv[j]) * bflo(hmv[j])) + w1[2 * j] * (bflo(cc[j]) * bflo(hh[j])) + w2[2 * j] * (bflo(cpv[j]) * bflo(hpv[j])));
            const float yhi = bfhi(bb[j]) * (w0[2 * j + 1] * (bfhi(cmv[j]) * bfhi(hmv[j])) + w1[2 * j + 1] * (bfhi(cc[j]) * bfhi(hh[j])) + w2[2 * j + 1] * (bfhi(cpv[j]) * bfhi(hpv[j])));
            o[j] = pk2(ylo, yhi); }
        v4u ov; ov.x = o[0]; ov.y = o[1]; ov.z = o[2]; ov.w = o[3]; *(v4u*)(YC + (size_t)row * MIXW + c) = ov;
    }
}
__device__ __forceinline__ void ph5_naive(Frame& F, int l) {
    const bf16* PROJ = (const bf16*)(F.ws + WS_PROJ); const float* YD = (const float*)(F.ws + WS_S5); bf16* YG = (bf16*)(F.ws + WS_YG); const float* ds = IN_(I_DSKIP) + l * MIXW;
    const size_t gt = (size_t)F.bid * NT + F.tid, ngt = (size_t)F.G * NT;
    for (size_t i = gt; i < (size_t)MT * (MIXW / 2); i += ngt) {
        const int row = (int)(i / (MIXW / 2)), c = (int)(i % (MIXW / 2)) * 2;
        const unsigned u = *(const unsigned*)(PROJ + (size_t)row * INW + c); const size_t o = (size_t)row * MIXW + c;
        const float y0 = YD[o] + YD[(size_t)MT * MIXW + o] + ds[c] * bf2f((unsigned short)(u & 0xffff)), y1 = YD[o + 1] + YD[(size_t)MT * MIXW + o + 1] + ds[c + 1] * bf2f((unsigned short)(u >> 16));
        *(unsigned*)(YG + o) = pk2(geluf_(y0), geluf_(y1));
    }
}
__device__ __forceinline__ void ph6_naive(Frame& F, int l) {
    const bf16* YG = (const bf16*)(F.ws + WS_YG); bf16* YA = (bf16*)(F.ws + WS_YS); const float* W = IN_(I_WGLU) + (size_t)l * MIXW * MIXW;
    NTILE_BEGIN((MT / 64) * (MIXW / 64))
        const int m0 = (T / (MIXW / 64)) * 64, n0 = (T % (MIXW / 64)) * 64;
        float acc[4][4] = {};
        ngemm_acc(acc, ABf{YG + (size_t)m0 * MIXW, MIXW}, W + n0, MIXW, MIXW, sm, t);
        if (valid) {
#pragma unroll
            for (int i = 0; i < 4; ++i) { const size_t o = (size_t)(m0 + ty * 4 + i) * MIXW + n0 + tx * 4; const v2u g = *(const v2u*)(YG + o);
                v2u w; w.x = pk2(bf2f((unsigned short)(g.x & 0xffff)) * sigmoidf_(acc[i][0]), bf2f((unsigned short)(g.x >> 16)) * sigmoidf_(acc[i][1]));
                w.y = pk2(bf2f((unsigned short)(g.y & 0xffff)) * sigmoidf_(acc[i][2]), bf2f((unsigned short)(g.y >> 16)) * sigmoidf_(acc[i][3])); *(v2u*)(YA + o) = w; }
        }
    NTILE_END
}
__device__ __forceinline__ void ph7_naive(Frame& F, int l) {
    const bf16* YS = (const bf16*)(F.ws + WS_YS); bf16* BR = (bf16*)(F.ws + WS_PROJ); const float* W = IN_(I_WBR) + (size_t)l * 3 * MIXW * D;
    NTILE_BEGIN((MT / 64) * (INW / 64))
        const int m0 = (T / (INW / 64)) * 64, n0 = (T % (INW / 64)) * 64, k = n0 / 1024, d0 = n0 % 1024;
        float acc[4][4] = {};
        ngemm_acc(acc, ABf{YS + (size_t)k * MT * MIXW + (size_t)m0 * MIXW, MIXW}, W + (size_t)k * MIXW * D + d0, D, MIXW, sm, t);
        if (valid) {
#pragma unroll
            for (int i = 0; i < 4; ++i) { v2u w; w.x = pk2(acc[i][0], acc[i][1]); w.y = pk2(acc[i][2], acc[i][3]); *(v2u*)(BR + (size_t)(m0 + ty * 4 + i) * INW + n0 + tx * 4) = w; }
        }
    NTILE_END
}
__device__ __forceinline__ void ph8_naive(Frame& F, int l) {
    const bf16* H = (const bf16*)(F.ws + WS_H); const bf16* BR = (const bf16*)(F.ws + WS_PROJ); bf16* PM = (bf16*)(F.ws + WS_PM);
    const float* W = IN_(I_WMG) + (size_t)l * D * INW; const float* bm = IN_(I_BMG) + l * INW;
    NTILE_BEGIN((MT / 64) * (D / 64))
        const int m0 = (T / (D / 64)) * 64, n0 = (T % (D / 64)) * 64;
        float out[4][4] = {};
        for (int k = 0; k < 3; ++k) {
            float acc[4][4] = {};
            ngemm_acc(acc, ABf{H + (size_t)m0 * D, D}, W + k * 1024 + n0, INW, D, sm, t);
#pragma unroll
            for (int i = 0; i < 4; ++i) { const v2u b = *(const v2u*)(BR + (size_t)(m0 + ty * 4 + i) * INW + k * 1024 + n0 + tx * 4);
                const float bb[4] = {bf2f((unsigned short)(b.x & 0xffff)), bf2f((unsigned short)(b.x >> 16)), bf2f((unsigned short)(b.y & 0xffff)), bf2f((unsigned short)(b.y >> 16))};
#pragma unroll
                for (int j = 0; j < 4; ++j) out[i][j] += sigmoidf_(acc[i][j] + bm[k * 1024 + n0 + tx * 4 + j]) * bb[j]; }
        }
        if (valid) {
#pragma unroll
            for (int i = 0; i < 4; ++i) { v2u w; w.x = pk2(out[i][0], out[i][1]); w.y = pk2(out[i][2], out[i][3]); *(v2u*)(PM + (size_t)(m0 + ty * 4 + i) * D + n0 + tx * 4) = w; }
        }
    NTILE_END
}
__device__ __forceinline__ void ph9_naive(Frame& F, int l) {
    const bf16* PM = (const bf16*)(F.ws + WS_PM); const float* W = IN_(I_WO) + (size_t)l * D * D;
    NTILE_BEGIN((MT / 64) * (D / 64))
        const int m0 = (T / (D / 64)) * 64, n0 = (T % (D / 64)) * 64;
        float acc[4][4] = {};
        ngemm_acc(acc, ABf{PM + (size_t)m0 * D, D}, W + n0, D, D, sm, t);
        if (valid) {
#pragma unroll
            for (int i = 0; i < 4; ++i) { const int row = m0 + ty * 4 + i, c = n0 + tx * 4; const float* m = mod_ptr(F, l, row) + 2048 + c;
                const f32x4 xs = *(const f32x4*)(xsrc_row(F, l, row) + c);
                f32x4 o; o.x = xs.x + m[0] * acc[i][0]; o.y = xs.y + m[1] * acc[i][1]; o.z = xs.z + m[2] * acc[i][2]; o.w = xs.w + m[3] * acc[i][3];
                *(f32x4*)(xrun_row(F, row) + c) = o; }
        }
    NTILE_END
}
template <int KS>
__device__ __forceinline__ void route_pass(Frame& F, int l, int u, bool valid, int kh, int sl, LAS float* GC, LAS float* SH, LAS float* SSQ, LAS float* LG, LAS int* HISTL) {
    bf16* H = (bf16*)(F.ws + WS_H); const bf16* WRh = (const bf16*)(F.ws + WS_WR); const bf16* WRl = WRh + 48 * 1024;
    const float* bg = IN_(I_BGRP) + l * 4; const float* be = IN_(I_BEXP) + l * 32;
    int* EID = (int*)(F.ws + WS_EID); float* EW = (float*)(F.ws + WS_EW);
    constexpr int NK = 32 / KS, KW = 1024 / KS;
    const int r = F.lane & 15, q = F.lane >> 4;
    const int uu = valid ? u : 0; const int row = uu * 16 + r; const float* xr = xrun_row(F, row) + kh * KW + 8 * q; const int pv = (row >= SEQ ? 1024 : 0) + kh * KW + 8 * q;
    float s = 0.f;
#pragma unroll
    for (int ks = 0; ks < NK; ++ks) { const f32x4 a = *(const f32x4*)(xr + 32 * ks), b = *(const f32x4*)(xr + 32 * ks + 4); s += a.x * a.x + a.y * a.y + a.z * a.z + a.w * a.w + b.x * b.x + b.y * b.y + b.z * b.z + b.w * b.w; }
    s += __shfl_xor(s, 16); s += __shfl_xor(s, 32);
    __syncthreads();
    if (q == 0) SSQ[(sl * KS + kh) * 16 + r] = s;
    __syncthreads();
    float tot = 0.f;
#pragma unroll
    for (int i = 0; i < KS; ++i) tot += SSQ[(sl * KS + i) * 16 + r];
    const float rstd = rsqrtf(tot * (1.f / D) + EPS);
    f32x4 acc[3] = {{0.f, 0.f, 0.f, 0.f}, {0.f, 0.f, 0.f, 0.f}, {0.f, 0.f, 0.f, 0.f}};
#pragma unroll 4
    for (int ks = 0; ks < NK; ++ks) {
        const int c = 32 * ks;
        const f32x4 x0 = *(const f32x4*)(xr + c), x1 = *(const f32x4*)(xr + c + 4);
        const f32x4 g0 = *(const LAS f32x4*)(GC + pv + c), g1 = *(const LAS f32x4*)(GC + pv + c + 4), sh0 = *(const LAS f32x4*)(SH + pv + c), sh1 = *(const LAS f32x4*)(SH + pv + c + 4);
        const f32x4 h0 = x0 * rstd * g0 + sh0, h1 = x1 * rstd * g1 + sh1;
        v4u hi; hi.x = pk2(h0.x, h0.y); hi.y = pk2(h0.z, h0.w); hi.z = pk2(h1.x, h1.y); hi.w = pk2(h1.z, h1.w);
        if (valid) *(v4u*)(H + (size_t)row * D + kh * KW + 8 * q + c) = hi;
        v4u lo; lo.x = pk2(h0.x - bflo(hi.x), h0.y - bfhi(hi.x)); lo.y = pk2(h0.z - bflo(hi.y), h0.w - bfhi(hi.y)); lo.z = pk2(h1.x - bflo(hi.z), h1.y - bfhi(hi.z)); lo.w = pk2(h1.z - bflo(hi.w), h1.w - bfhi(hi.w));
        const bf16x8 Ah = __builtin_bit_cast(bf16x8, hi), Al = __builtin_bit_cast(bf16x8, lo);
#pragma unroll
        for (int cb = 0; cb < 3; ++cb) { const size_t wo = (size_t)(cb * 16 + r) * 1024 + kh * KW + c + 8 * q; const bf16x8 Bh = *(const bf16x8*)(WRh + wo), Bl = *(const bf16x8*)(WRl + wo);
            acc[cb] = __builtin_amdgcn_mfma_f32_16x16x32_bf16(Ah, Bh, acc[cb], 0, 0, 0); acc[cb] = __builtin_amdgcn_mfma_f32_16x16x32_bf16(Al, Bh, acc[cb], 0, 0, 0); acc[cb] = __builtin_amdgcn_mfma_f32_16x16x32_bf16(Ah, Bl, acc[cb], 0, 0, 0); }
    }
    LAS float* LGw = LG + (sl * KS + kh) * (16 * 52);
#pragma unroll
    for (int cb = 0; cb < 3; ++cb)
#pragma unroll
        for (int i = 0; i < 4; ++i) LGw[(4 * q + i) * 52 + cb * 16 + r] = acc[cb][i];
    __syncthreads();
    if (kh == 0 && valid && F.lane < 16) { const LAS float* L0 = LG + (sl * KS) * (16 * 52) + F.lane * 52; const int rw = u * 16 + F.lane;
        float lg[36];
#pragma unroll
        for (int o = 0; o < 36; ++o) { float t = 0.f;
#pragma unroll
            for (int i = 0; i < KS; ++i) t += L0[i * (16 * 52) + o]; lg[o] = t + (o < 4 ? bg[o] : be[o - 4]); }
        LAS float* LW = LG + (sl * KS) * (16 * 52) + F.lane * 52;
#pragma unroll
        for (int o = 0; o < 36; ++o) LW[o] = lg[o];
        int gi = 0; float gm = lg[0];
#pragma unroll
        for (int o = 1; o < 4; ++o) if (lg[o] > gm) { gm = lg[o]; gi = o; }
        float den = 0.f;
#pragma unroll
        for (int o = 0; o < 4; ++o) den += expf(lg[o] - gm);
        const float gp = 1.f / den;
        const LAS float* el = LW + 4 + gi * 8;
        int i1 = 0; float m1 = el[0]; for (int o = 1; o < 8; ++o) { const float v = el[o]; if (v > m1) { m1 = v; i1 = o; } }
        int i2 = -1; float m2 = 0.f; for (int o = 0; o < 8; ++o) { const float v = el[o]; if (o != i1 && (i2 < 0 || v > m2)) { m2 = v; i2 = o; } }
        const float e2 = expf(m2 - m1); const float w1 = 1.f / (1.f + e2), w2 = e2 / (1.f + e2);
        const int e1i = gi * 8 + i1, e2i = gi * 8 + i2;
        EID[rw * 2] = e1i; EID[rw * 2 + 1] = e2i; EW[rw * 2] = gp * w1; EW[rw * 2 + 1] = gp * w2;
        __hip_atomic_fetch_add(&HISTL[e1i], 1, __ATOMIC_RELAXED, __HIP_MEMORY_SCOPE_WORKGROUP); __hip_atomic_fetch_add(&HISTL[e2i], 1, __ATOMIC_RELAXED, __HIP_MEMORY_SCOPE_WORKGROUP);
    }
}
__device__ __forceinline__ void ph10_route(Frame& F, int l) {
    const float* g = IN_(I_GFFN) + l * D;
    LAS float* GC = (LAS float*)F.lds;
    LAS float* SH = GC + 2048;
    LAS float* SSQ = SH + 2048;
    LAS float* LG = SSQ + 128;
    LAS int* HISTL = (LAS int*)(LG + 8 * 16 * 52);
    __syncthreads();
    if (F.tid < 32) HISTL[F.tid] = 0;
    for (int i = F.tid; i < 2048; i += NT) { const int w = i >> 10, c = i & 1023; const float* m = (const float*)(F.ws + WS_MOD) + (size_t)(l * 2 + w) * 6144; GC[i] = g[c] * (1.f + m[4096 + c]); SH[i] = m[3072 + c]; }
#pragma unroll 1
    for (int u0 = F.bid; u0 < SEQ / 16; u0 += 4 * F.G) { const int u = u0 + (F.wave >> 1) * F.G; route_pass<2>(F, l, u, u < SEQ / 16, F.wave & 1, F.wave >> 1, GC, SH, SSQ, LG, HISTL); }
    if (l == 0) {
#pragma unroll 1
        for (int u0 = SEQ / 16 + F.bid; u0 < MT / 16; u0 += F.G) route_pass<8>(F, l, u0, true, F.wave, 0, GC, SH, SSQ, LG, HISTL);
    }
    __syncthreads();
    if (F.tid < 32) ((int*)(F.ws + WS_HISTG))[F.bid * 32 + F.tid] = HISTL[F.tid];
}
__device__ __forceinline__ int expert_off(const unsigned* cnt, int e) { int o = 0; for (int i = 0; i < e; ++i) o += ((int)cnt[i] + 255) & ~255; return o; }
__device__ __forceinline__ void ph11_scatter(Frame& F, int l) {
    const bf16* H = (const bf16*)(F.ws + WS_H); bf16* HS = (bf16*)(F.ws + WS_HS);
    const int* EID = (const int*)(F.ws + WS_EID); const float* EW = (const float*)(F.ws + WS_EW); int* STOK = (int*)(F.ws + WS_STOK); float* SW = (float*)(F.ws + WS_SW); int* TSLOT = (int*)(F.ws + WS_TSLOT);
    unsigned* cnt = F.ctl + CW_CNT + l * 128; const int* HISTG = (const int*)(F.ws + WS_HISTG);
    LAS int* HIST = (LAS int*)F.lds; LAS int* BASE = HIST + 32; LAS int* ISLOT = BASE + 32; LAS int* IROW = ISLOT + 512; LAS int* PT = IROW + 512; LAS int* PB = PT + 512;
    const int nunits = (l == 0 ? MT : SEQ) / 16;
    __syncthreads();
    { const int e = F.tid & 31, ch = F.tid >> 5; int tot = 0, bas = 0;
      for (int b = ch; b < F.G; b += 16) { const int h = HISTG[b * 32 + e]; tot += h; if (b < F.bid) bas += h; }
      PT[F.tid] = tot; PB[F.tid] = bas; }
    __syncthreads();
    if (F.tid < 32) { int tot = 0, bas = 0; for (int ch = 0; ch < 16; ++ch) { tot += PT[ch * 32 + F.tid]; bas += PB[ch * 32 + F.tid]; } HIST[F.tid] = 0; PT[F.tid] = tot; PB[F.tid] = bas; if (F.bid == 0) cnt[F.tid] = (unsigned)tot; }
    __syncthreads();
    if (F.tid < 32) { int off = 0; for (int i = 0; i < F.tid; ++i) off += (PT[i] + 255) & ~255; BASE[F.tid] = off + PB[F.tid]; }
    __syncthreads();
    const int w = F.tid >> 5; int u = F.bid + w * F.G; bool valid = u < SEQ / 16;
    if (w == 15) { u = SEQ / 16 + F.bid; valid = u < nunits; }
    const int row = u * 16 + ((F.tid >> 1) & 15), kk = F.tid & 1;
    int e = 0, rank = 0; if (valid) { e = EID[row * 2 + kk]; rank = __hip_atomic_fetch_add(&HIST[e], 1, __ATOMIC_RELAXED, __HIP_MEMORY_SCOPE_WORKGROUP); }
    __syncthreads();
    int slot = -1; if (valid) { slot = BASE[e] + rank; STOK[slot] = row; SW[slot] = EW[row * 2 + kk]; TSLOT[row * 2 + kk] = slot; }
    ISLOT[F.tid] = slot; IROW[F.tid] = row;
    __syncthreads();
#pragma unroll 4
    for (int it = F.wave; it < NT; it += NT / 64) { const int sl = ISLOT[it]; if (sl >= 0) { const v4u* src = (const v4u*)(H + (size_t)IROW[it] * D); v4u* dst = (v4u*)(HS + (size_t)sl * D);
        dst[F.lane] = src[F.lane]; dst[F.lane + 64] = src[F.lane + 64]; } }
}
__device__ __forceinline__ int slot_expert(const unsigned* cnt, int slot0, int& seg_off, int& n_e) { int o = 0; for (int e = 0; e < NE; ++e) { const int n = (int)cnt[e], pn = (n + 255) & ~255; if (slot0 < o + pn) { seg_off = o; n_e = n; return e; } o += pn; } seg_off = o; n_e = 0; return 0; }
__device__ __forceinline__ void ph12_naive(Frame& F, int l) {
    const bf16* HS = (const bf16*)(F.ws + WS_HS); bf16* ACT = (bf16*)(F.ws + WS_ACT); const float* SW = (const float*)(F.ws + WS_SW);
    const unsigned* cnt = F.ctl + CW_CNT + l * 128; const int total = expert_off(cnt, NE);
    NTILE_BEGIN((total / 64) * (DFF / 64))
        const int s0 = (T / (DFF / 64)) * 64, n0 = (T % (DFF / 64)) * 64; int seg, n_e; const int e = slot_expert(cnt, s0, seg, n_e);
        float aa[4][4] = {}, ab[4][4] = {};
        ngemm_acc(aa, ABf{HS + (size_t)s0 * D, D}, IN_(I_W1) + ((size_t)l * NE + e) * D * DFF + n0, DFF, D, sm, t);
        ngemm_acc(ab, ABf{HS + (size_t)s0 * D, D}, IN_(I_W3) + ((size_t)l * NE + e) * D * DFF + n0, DFF, D, sm, t);
        if (valid) {
#pragma unroll
            for (int i = 0; i < 4; ++i) { const int slot = s0 + ty * 4 + i; if (slot - seg < n_e) { const float w = SW[slot];
                v2u o; o.x = pk2(siluf_(aa[i][0]) * ab[i][0] * w, siluf_(aa[i][1]) * ab[i][1] * w); o.y = pk2(siluf_(aa[i][2]) * ab[i][2] * w, siluf_(aa[i][3]) * ab[i][3] * w);
                *(v2u*)(ACT + (size_t)slot * DFF + n0 + tx * 4) = o; } }
        }
    NTILE_END
}
__device__ __forceinline__ void ph13_naive(Frame& F, int l) {
    const bf16* ACT = (const bf16*)(F.ws + WS_ACT); bf16* YS2 = (bf16*)(F.ws + WS_YS2);
    const unsigned* cnt = F.ctl + CW_CNT + l * 128; const int total = expert_off(cnt, NE);
    NTILE_BEGIN((total / 64) * (D / 64))
        const int s0 = (T / (D / 64)) * 64, n0 = (T % (D / 64)) * 64; int seg, n_e; const int e = slot_expert(cnt, s0, seg, n_e);
        float acc[4][4] = {};
        ngemm_acc(acc, ABf{ACT + (size_t)s0 * DFF, DFF}, IN_(I_W2) + ((size_t)l * NE + e) * DFF * D + n0, D, DFF, sm, t);
        if (valid) {
#pragma unroll
            for (int i = 0; i < 4; ++i) { const int slot = s0 + ty * 4 + i; if (slot - seg < n_e) { v2u o; o.x = pk2(acc[i][0], acc[i][1]); o.y = pk2(acc[i][2], acc[i][3]); *(v2u*)(YS2 + (size_t)slot * D + n0 + tx * 4) = o; } }
        }
    NTILE_END
}
__device__ __forceinline__ void ph14_combine(Frame& F, int l) {
    const bf16* YS2 = (const bf16*)(F.ws + WS_YS2); const int* TSLOT = (const int*)(F.ws + WS_TSLOT); bf16* H = (bf16*)(F.ws + WS_H);
    const int gw = F.bid * (NT / 64) + F.wave, ngw = F.G * (NT / 64);
    const int nrows = l == 0 ? MT : SEQ;
    for (int row0 = gw; row0 < nrows; row0 += 2 * ngw) {
        f32x4 v[2][4]; float s[2] = {0.f, 0.f}; int rows[2]; bool ok[2];
#pragma unroll
        for (int t = 0; t < 2; ++t) { rows[t] = row0 + t * ngw; ok[t] = rows[t] < nrows; if (!ok[t]) rows[t] = row0; }
        int sl[2][2];
#pragma unroll
        for (int t = 0; t < 2; ++t) { sl[t][0] = TSLOT[rows[t] * 2]; sl[t][1] = TSLOT[rows[t] * 2 + 1]; }
#pragma unroll
        for (int t = 0; t < 2; ++t) { const float* m = mod_ptr(F, l, rows[t]); const float* xr = xrun_row(F, rows[t]);
#pragma unroll
            for (int j = 0; j < 4; ++j) { const int c = 4 * F.lane + 256 * j; const f32x4 x = *(const f32x4*)(xr + c); const f32x4 ga = *(const f32x4*)(m + 5120 + c);
                const v2u a = *(const v2u*)(YS2 + (size_t)sl[t][0] * D + c), b = *(const v2u*)(YS2 + (size_t)sl[t][1] * D + c);
                f32x4 y; y.x = bflo(a.x) + bflo(b.x); y.y = bfhi(a.x) + bfhi(b.x); y.z = bflo(a.y) + bflo(b.y); y.w = bfhi(a.y) + bfhi(b.y);
                v[t][j] = x + ga * y; s[t] += v[t][j].x * v[t][j].x + v[t][j].y * v[t][j].y + v[t][j].z * v[t][j].z + v[t][j].w * v[t][j].w; } }
#pragma unroll
        for (int t = 0; t < 2; ++t) { if (!ok[t]) continue;
            const float rstd = rsqrtf(wave_sum(s[t]) * (1.f / D) + EPS); float* xr = xrun_row(F, rows[t]);
            if (l == 0) {
                const float* m1 = mod_ptr(F, 1, rows[t]); const float* g = IN_(I_GMIX) + D;
#pragma unroll
                for (int j = 0; j < 4; ++j) { const int c = 4 * F.lane + 256 * j; *(f32x4*)(xr + c) = v[t][j];
                    const f32x4 gg = *(const f32x4*)(g + c), sc = *(const f32x4*)(m1 + 1024 + c), sh = *(const f32x4*)(m1 + c);
                    const f32x4 o = v[t][j] * rstd * gg * (1.f + sc) + sh; v2u w; w.x = pk2(o.x, o.y); w.y = pk2(o.z, o.w); *(v2u*)(H + (size_t)rows[t] * D + c) = w; }
            } else {
                const float* g = IN_(I_GF);
#pragma unroll
                for (int j = 0; j < 4; ++j) { const int c = 4 * F.lane + 256 * j; const f32x4 gg = *(const f32x4*)(g + c); f32x4 o = v[t][j] * rstd * gg;
                    if (PROBE_B >= 0 && rows[t] < 3906) { volatile LAS unsigned long long* TS = (volatile LAS unsigned long long*)(F.lds + TS_OFF); o = o + (0.1f + 0.00001f * (float)(TS[1 + PROBE_B] - TS[PROBE_B])); }
                    if (PROBE_A >= 0 && rows[t] == 0 && j == 0 && F.lane == 0) { volatile LAS unsigned long long* TS = (volatile LAS unsigned long long*)(F.lds + TS_OFF); o.x += 1.f + 0.001f * (float)(TS[1 + PROBE_A] - TS[PROBE_A]); }
                    *(f32x4*)(xr + c) = o; }
            }
        }
    }
}

#ifndef FASTMASK
#define FASTMASK 0xffff
#endif
constexpr unsigned FM = FASTMASK;
constexpr int NPH = 2 + 13 * 2;
__device__ __forceinline__ Frame make_frame(LAS unsigned char* lds, int wave0) {
    Frame F; F.lds = lds; F.wave = wave0; F.lane = (int)__builtin_amdgcn_mbcnt_hi(~0u, __builtin_amdgcn_mbcnt_lo(~0u, 0u)); asm volatile("" : "+v"(F.lane)); F.tid = F.wave * 64 + F.lane; F.bid = blockIdx.x; F.G = gridDim.x; asm volatile("" : "+s"(F.G), "+s"(F.bid));
    F.tab = (const unsigned long long LAS*)(lds + TAB_OFF);
    volatile LAS unsigned long long* t = (volatile LAS unsigned long long*)(lds + TAB_OFF);
    F.ws = (unsigned char*)uni64(t[35]); F.out = (float*)uni64(t[36]); F.ctl = (unsigned*)(F.ws + WS_CTL);
    return F;
}
__global__ void __launch_bounds__(NT, 2) mega_fwd(Args args) {
    extern __shared__ __attribute__((aligned(16))) unsigned char lds_raw[];
    LAS unsigned char* const lds = (LAS unsigned char*)lds_raw;
    const int wave0 = __builtin_amdgcn_readfirstlane((int)threadIdx.x >> 6);
    for (int u = threadIdx.x; u < 1024 / 4; u += NT) ((LAS unsigned*)(lds + 131072))[u] = 0u;
    if (threadIdx.x == 0) { LAS unsigned long long* t = (LAS unsigned long long*)(lds + TAB_OFF);
#pragma unroll
        for (int i = 0; i < 35; ++i) t[i] = (unsigned long long)args.in[i];
        t[35] = (unsigned long long)args.ws; t[36] = (unsigned long long)args.out; }
    __syncthreads();
    { Frame F = make_frame(lds, wave0); (void)xcd_barrier_post(F.ctl + CW_BAR, (volatile LAS unsigned*)(lds + MISC_OFF) + 8); }
    if ((PROBE_A >= 0 || PROBE_B >= 0) && threadIdx.x == 0) ((volatile LAS unsigned long long*)(lds + TS_OFF))[0] = __builtin_amdgcn_s_memrealtime();
    const int lo = args.ph_lo, hi = args.ph_hi; int ph = 0;
#define GRIDBAR() do { Frame Fb = make_frame(lds, wave0); XcdBarrier bar; bar.bar = Fb.ctl + CW_BAR; bar.x = xb_xcc_id(); bar.st = (volatile LAS unsigned*)(lds + MISC_OFF) + 8; xcd_barrier(bar, Fb.tid == 0); } while (0)
#ifndef REPBAR
#define REPBAR 0
#endif
#ifndef REPMASK
#define REPMASK 0
#endif
#define PHASE(...) do { if (lo <= ph && ph < hi) { const int _pl = ph < 2 ? ph : 2 + (ph - 2) % 13; for (int _rep = 0; _rep <= ((REPMASK >> _pl) & 1); ++_rep) { Frame F = make_frame(lds, wave0); __VA_ARGS__; } if (ph + 1 < hi) { GRIDBAR(); if (REPBAR) GRIDBAR(); } if ((PROBE_A >= 0 || PROBE_B >= 0) && threadIdx.x == 0) ((volatile LAS unsigned long long*)(lds + TS_OFF))[1 + ph] = __builtin_amdgcn_s_memrealtime(); } ++ph; } while (0)
    PHASE({ ph0_prologue(F); if (FM >> 3 & 1) s5_precompute(F); __syncthreads(); convert_weights(F, 0); { const f32x4* s = (const f32x4*)IN_(I_CTX); f32x4* d = (f32x4*)(F.ws + WS_XC); for (int i = F.bid * NT + F.tid; i < CTX * D / 4; i += F.G * NT) d[i] = s[i]; } });
    PHASE(hprep_rows(F, 0));
#pragma unroll 1
    for (int l = 0; l < 2; ++l) {
        PHASE({ if (FM >> 2 & 1) { ph2_fast(F, l); ph2_ctx(F, l == 0 ? INW : MIXW); } else ph2_naive(F, l); });
        PHASE({ if (FM >> 3 & 1) { s5_z_phase(F, l); const int nch = (l == 0 ? MT : SEQ) / 128; if (F.G > nch) { if (F.bid < nch) sg_fast_chunk(F, l, F.bid); else { Frame F2 = F; F2.bid -= nch; F2.G -= nch; ph3_conv(F2, l, l == 0 ? MT : SEQ); } } else { for (int c = F.bid; c < nch; c += F.G) sg_fast_chunk(F, l, c); ph3_conv(F, l, l == 0 ? MT : SEQ); } } else { ph3_s5_naive(F, l); if (F.bid >= 64) { Frame F2 = F; F2.bid -= 64; F2.G -= 64; ph3_sg_naive(F2, l); ph3_conv(F2, l, MT); } } });
        PHASE({ if (FM >> 3 & 1) s5_scan_phase(F, l); });
        PHASE({ if (FM >> 3 & 1) s5_y_phase(F, l); else ph5_naive(F, l); });
        PHASE({ if (FM >> 6 & 1) { ph6_fast(F, l); if (l == 0) ph6_ctx(F); } else ph6_naive(F, l); });
        PHASE({ if (FM >> 7 & 1) { ph7_fast(F, l); if (l == 0) ph7_ctx(F); } else ph7_naive(F, l); });
        PHASE({ if (FM >> 8 & 1) { ph8_fast(F, l); if (l == 0) ph8_ctx(F, l); } else ph8_naive(F, l); });
        PHASE({ if (FM >> 9 & 1) { ph9_fast(F, l); if (l == 0) ph9_ctx(F, l); } else ph9_naive(F, l); });
        PHASE(ph10_route(F, l));
        PHASE(ph11_scatter(F, l));
        PHASE({ if (FM >> 12 & 1) ph12_fast(F, l); else ph12_naive(F, l); });
        PHASE({ if (FM >> 13 & 1) ph13_fast(F, l); else ph13_naive(F, l); });
        PHASE({ ph14_combine(F, l); if (l == 0) convert_weights(F, 1); });
    }
#undef PHASE
}

extern "C" void kernel_launch(void* const* d_in, const int* in_sizes, int n_in, void* d_out, int out_size, void* d_ws, size_t ws_size, hipStream_t stream) {
    static int grid = 0;
    if (grid == 0) {
        int dev = 0, cus = 0, per_cu = 0;
        if (n_in != 35 || out_size != SEQ * D || ws_size < WS_END) { fprintf(stderr, "kernel_launch: unexpected shapes (n_in %d out %d ws %zu)\n", n_in, out_size, ws_size); grid = -1; return; }
        if (hipGetDevice(&dev) != hipSuccess || hipDeviceGetAttribute(&cus, hipDeviceAttributeMultiprocessorCount, dev) != hipSuccess) { grid = -1; return; }
        if (hipFuncSetAttribute((const void*)mega_fwd, hipFuncAttributeMaxDynamicSharedMemorySize, LDS_BYTES) != hipSuccess) { fprintf(stderr, "kernel_launch: hipFuncSetAttribute failed\n"); grid = -1; return; }
        if (hipOccupancyMaxActiveBlocksPerMultiprocessor(&per_cu, (const void*)mega_fwd, NT, LDS_BYTES) != hipSuccess || per_cu < 1) { fprintf(stderr, "kernel_launch: occupancy query says %d blocks per CU\n", per_cu); grid = -1; return; }
        grid = cus;
    }
    if (grid < 0) return;
    (void)hipMemsetAsync((char*)d_ws + WS_CTL, 0, CTL_ZERO_BYTES, stream);
    Args a{};
    for (int i = 0; i < 35; ++i) a.in[i] = (const float*)d_in[i];
    a.out = (float*)d_out; a.ws = (unsigned char*)d_ws; a.ph_lo = 0; a.ph_hi = NPH;
    void* kargs[] = {&a};
    hipError_t e = hipLaunchCooperativeKernel((const void*)mega_fwd, dim3(grid), dim3(NT), kargs, LDS_BYTES, stream);
    if (e != hipSuccess) fprintf(stderr, "kernel_launch: cooperative launch failed: %s (grid %d)\n", hipGetErrorString(e), grid);
}
```

```cpp
#include <hip/hip_runtime.h>
#include <stdint.h>
#include <cstdio>

#define GAS __attribute__((address_space(1)))
#define LAS __attribute__((address_space(3)))
typedef unsigned short bf16;
typedef unsigned v4u __attribute__((ext_vector_type(4)));
typedef unsigned v2u __attribute__((ext_vector_type(2)));
typedef float f32x4 __attribute__((ext_vector_type(4)));

constexpr int D = 1024, SEQ = 16384, CTX = 256, MT = SEQ + CTX;
constexpr int MIXW = 512, INW = 3072, G5 = 32, P5 = 64, H5 = 16;
constexpr int NE = 32, DFF = 256;
constexpr int MAXSLOT = 2 * MT + NE * 256;
constexpr float EPS = 1e-6f;
constexpr int NT = 512;

constexpr size_t MiB = 1u << 20;
constexpr size_t WS_CTL = 0, CTL_ZERO_BYTES = 1 * MiB;
constexpr size_t WS_MOD = 1 * MiB;
constexpr size_t WS_XC = 2 * MiB;
constexpr size_t WS_EID = 3 * MiB;
constexpr size_t WS_EW = WS_EID + (size_t)MT * 8;
constexpr size_t WS_STOK = WS_EW + (size_t)MT * 8;
constexpr size_t WS_SW = WS_STOK + (size_t)MAXSLOT * 4;
constexpr size_t WS_TSLOT = WS_SW + (size_t)MAXSLOT * 4;
constexpr size_t WS_HISTG = WS_TSLOT + (size_t)MT * 8;
constexpr size_t WS_H = 4 * MiB;
constexpr size_t WS_PROJ = WS_H + (size_t)MT * 2048;
constexpr size_t WS_YS = WS_PROJ + (size_t)MT * 6144;
constexpr size_t WS_YG = WS_YS + (size_t)3 * MT * 1024;
constexpr size_t WS_PM = WS_YG + (size_t)MT * 1024;
constexpr size_t WS_S5 = WS_PM + (size_t)MT * 2048;
constexpr size_t WS_Z = WS_S5;
constexpr size_t WS_SS = WS_Z + (size_t)1040 * 32 * 256 * 4;
constexpr size_t WS_S5M = WS_SS + (size_t)1040 * 32 * 256 * 2;
constexpr size_t WS_A16 = WS_S5M + (size_t)2 * 32 * 3 * 65536 * 2;
constexpr size_t WS_W = WS_A16 + (size_t)2 * 32 * 2 * 64 * 2 * 4 > WS_S5 + (size_t)2 * MT * 512 * 4 ? WS_A16 + (size_t)2 * 32 * 2 * 64 * 2 * 4 : WS_S5 + (size_t)2 * MT * 512 * 4;
constexpr size_t WS_WIN = WS_W;
constexpr size_t WS_WMG = WS_WIN + (size_t)3072 * 1024 * 2;
constexpr size_t WS_WGLU = WS_WMG + (size_t)3072 * 1024 * 2;
constexpr size_t WS_WBR = WS_WGLU + (size_t)512 * 512 * 2;
constexpr size_t WS_WO = WS_WBR + (size_t)3 * 1024 * 512 * 2;
constexpr size_t WS_W13 = WS_WO + (size_t)1024 * 1024 * 2;
constexpr size_t WS_W2 = WS_W13 + (size_t)32 * 512 * 1024 * 2;
constexpr size_t WS_WSG = WS_W2 + (size_t)32 * 1024 * 256 * 2;
constexpr size_t WS_WR = WS_WSG + (size_t)4 * 128 * 128 * 2;
constexpr size_t WS_END = WS_WR + (size_t)2 * 48 * 1024 * 2;
static_assert(WS_END <= (size_t)377 * MiB, "workspace budget");
constexpr size_t WS_HS = WS_PROJ;
constexpr size_t WS_ACT = WS_YS;
constexpr size_t WS_YS2 = WS_YG;
static_assert(WS_HS + (size_t)MAXSLOT * 2048 <= WS_YS && WS_ACT + (size_t)MAXSLOT * 512 <= WS_YG && WS_YS2 + (size_t)MAXSLOT * 2048 <= WS_W, "moe overlays");
static_assert(WS_HISTG + (size_t)1024 * 32 * 4 <= WS_H, "ws map");
constexpr int CW_CNT = 64;
constexpr int CW_BAR = 4096;

#ifndef PROBE_A
#define PROBE_A -1
#endif
#ifndef PROBE_B
#define PROBE_B -1
#endif
constexpr int TS_OFF = 131072 + 512;
constexpr int LDS_BYTES = 147456;
constexpr int MISC_OFF = 131072 + 320;
constexpr int TAB_OFF = 131072 + 1024;

__device__ __forceinline__ float bf2f(unsigned short b) { return __builtin_bit_cast(float, ((unsigned)b) << 16); }
__device__ __forceinline__ unsigned f2bf(float f) { unsigned u = __builtin_bit_cast(unsigned, f); return (u + 0x7fffu + ((u >> 16) & 1u)) >> 16; }
__device__ __forceinline__ unsigned pk2(float lo, float hi) { return f2bf(lo) | (f2bf(hi) << 16); }
__device__ __forceinline__ float sigmoidf_(float x) { return __builtin_amdgcn_rcpf(1.f + __expf(-x)); }
__device__ __forceinline__ float siluf_(float x) { return x * __builtin_amdgcn_rcpf(1.f + __expf(-x)); }
__device__ __forceinline__ float geluf_(float x) { const float u = 0.7978845608028654f * (x + 0.044715f * x * x * x); return x * __builtin_amdgcn_rcpf(1.f + __expf(-2.f * u)); }
__device__ __forceinline__ float wave_sum(float v) {
#pragma unroll
    for (int o = 1; o < 64; o <<= 1) v += __shfl_xor(v, o);
    return v;
}

#define XB_TMO      128
#define XB_XCNT(j)  (256  + 64 * (j))
#define XB_XSUB(j)  (1280 + 64 * (j))
#define XB_XGEN(j)  (2304 + 64 * (j))
#define XB_TOP      3328
#define XB_TOPGEN   3392
#define XCD_BAR_WORDS 3456
#define XB_SPIN_CAP (1u << 24)
__device__ __forceinline__ unsigned xb_ld(unsigned* p)              { return __hip_atomic_load(p, __ATOMIC_RELAXED, __HIP_MEMORY_SCOPE_AGENT); }
__device__ __forceinline__ unsigned xb_add(unsigned* p, unsigned v) { return __hip_atomic_fetch_add(p, v, __ATOMIC_RELAXED, __HIP_MEMORY_SCOPE_AGENT); }
__device__ __forceinline__ unsigned xb_xcc_id() { return (unsigned)__builtin_amdgcn_s_getreg((3 << 11) | 20) & 0xFu; }
#define XB_SPIN(cond, bar) do { unsigned _sp = 0; while (cond) { __builtin_amdgcn_s_sleep(1); \
    if ((++_sp & 255u) == 0u) { if (xb_ld(&(bar)[XB_TMO])) break; if (_sp > XB_SPIN_CAP) { atomicAdd(&(bar)[XB_TMO], 1u); break; } } } } while (0)
struct XcdBarrier { unsigned* bar; unsigned x; volatile LAS unsigned* st; };
__device__ __forceinline__ XcdBarrier xcd_barrier_post(unsigned* bar, volatile LAS unsigned* st) {
    XcdBarrier b; b.bar = bar; b.x = xb_xcc_id(); b.st = st;
    if (threadIdx.x == 0) (void)xb_add(&bar[XB_XCNT(b.x)], 1u);
    return b;
}
__device__ __forceinline__ void xcd_barrier_complete(unsigned* bar, unsigned x, unsigned& nloc, unsigned& nx) {
    const unsigned G = gridDim.x * gridDim.y * gridDim.z;
    unsigned sum, cnt, mine, sp = 0u;
    for (;;) {
        sum = 0u; cnt = 0u; mine = 0u;
#pragma unroll
        for (unsigned j = 0; j < 16; ++j) { const unsigned c = xb_ld(&bar[XB_XCNT(j)]); sum += c; cnt += (c > 0u) ? 1u : 0u; mine = (j == x) ? c : mine; }
        if (sum == G) break;
        __builtin_amdgcn_s_sleep(1);
        if ((++sp & 255u) == 0u) { if (xb_ld(&bar[XB_TMO])) break; if (sp > XB_SPIN_CAP) { atomicAdd(&bar[XB_TMO], 1u); break; } }
    }
    nloc = mine > 0u ? mine : 1u; nx = cnt > 0u ? cnt : 1u;
}
__device__ __forceinline__ void xcd_barrier(const XcdBarrier& b, bool leader) {
    asm volatile("s_waitcnt vmcnt(0)" ::: "memory");
    __syncthreads();
    if (leader) {
        unsigned* bar = b.bar;
        __builtin_amdgcn_s_waitcnt(0);
        unsigned nloc = b.st[0], nx = b.st[1];
        if (nloc == 0u) { xcd_barrier_complete(bar, b.x, nloc, nx); b.st[0] = nloc; b.st[1] = nx; }
        const unsigned old = xb_add(&bar[XB_XSUB(b.x)], 1u);
        const unsigned gen = old / nloc;
        if (old + 1u == (gen + 1u) * nloc) {
            __builtin_amdgcn_fence(__ATOMIC_RELEASE, "agent");
            asm volatile("s_waitcnt vmcnt(0)" ::: "memory");
            const unsigned og = xb_add(&bar[XB_TOP], 1u);
            const unsigned tg = og / nx;
            if (og + 1u == (tg + 1u) * nx) xb_add(&bar[XB_TOPGEN], 1u);
            else XB_SPIN(xb_ld(&bar[XB_TOPGEN]) == tg, bar);
            __builtin_amdgcn_fence(__ATOMIC_ACQUIRE, "agent");
            xb_add(&bar[XB_XGEN(b.x)], 1u);
            asm volatile("s_waitcnt vmcnt(0)" ::: "memory");
        } else {
            XB_SPIN(xb_ld(&bar[XB_XGEN(b.x)]) == gen, bar);
            __builtin_amdgcn_fence(__ATOMIC_ACQUIRE, "agent");
            asm volatile("s_waitcnt vmcnt(0)" ::: "memory");
        }
    }
    __syncthreads();
}

struct Args { const float* in[35]; float* out; unsigned char* ws; int ph_lo, ph_hi; };
struct Frame {
    LAS unsigned char* lds; unsigned char* ws; unsigned* ctl;
    int tid, lane, wave, bid, G;
    const unsigned long long LAS* tab; float* out;
};
__device__ __forceinline__ unsigned long long uni64(unsigned long long v) { const unsigned lo = __builtin_amdgcn_readfirstlane((unsigned)v), hi = __builtin_amdgcn_readfirstlane((unsigned)(v >> 32)); return ((unsigned long long)hi << 32) | lo; }
#define IN_(k) ((const float*)uni64(F.tab[k]))
enum { I_X = 0, I_C, I_CTX, I_CCTX, I_WADA, I_BADA, I_GMIX, I_GFFN, I_WIN, I_LRE, I_LIM, I_LDT, I_BRE, I_BIM, I_CRE, I_CIM, I_DSKIP, I_WGLU, I_SGG, I_SGB, I_WSG, I_BSG,
       I_WCONV, I_WBR, I_WMG, I_BMG, I_WO, I_WGRP, I_BGRP, I_WEXP, I_BEXP, I_W1, I_W3, I_W2, I_GF };

__device__ __forceinline__ const float* mod_ptr(const Frame& F, int l, int row) { return (const float*)(F.ws + WS_MOD) + (size_t)(l * 2 + (row >= SEQ ? 1 : 0)) * 6144; }
__device__ __forceinline__ const float* xsrc_row(const Frame& F, int l, int row) {
    if (l == 0) return row < SEQ ? IN_(I_X) + (size_t)row * D : IN_(I_CTX) + (size_t)(row - SEQ) * D;
    return row < SEQ ? F.out + (size_t)row * D : (const float*)(F.ws + WS_XC) + (size_t)(row - SEQ) * D;
}
__device__ __forceinline__ float* xrun_row(const Frame& F, int row) { return row < SEQ ? F.out + (size_t)row * D : (float*)(F.ws + WS_XC) + (size_t)(row - SEQ) * D; }


namespace pg8 {
#define PG8_LAS __attribute__((address_space(3)))
typedef unsigned short bf16_t;
typedef short bf16x8 __attribute__((ext_vector_type(8)));
typedef float f32x4 __attribute__((ext_vector_type(4)));
typedef unsigned u32x4 __attribute__((ext_vector_type(4)));
constexpr int BM = 256, BK = 64, HALF = 128, HTB = HALF * BK * 2  , STAGE_BYTES = 8 * HTB, NXCD = 8, WGM = 8;

__host__ __device__ __forceinline__ int lds_byte(int r, int c) { const int st = (r >> 4) * 2 + (c >> 5), rr = r & 15, cc = c & 31, ob = rr * 64 + cc * 2; return st * 1024 + (ob ^ (((ob >> 9) & 1) << 5)); }
__host__ __device__ __forceinline__ void stage_rc(int b, int& R, int& C) { const int st = b / 1024, sb = b % 1024, swz = sb ^ (((sb >> 9) & 1) << 5); R = (st >> 1) * 16 + swz / 64; C = (st & 1) * 32 + (swz % 64) / 2; }
__host__ __device__ __forceinline__ int perm32(int rho) { const int n = rho >> 4, i = rho & 15; return 8 * (i >> 2) + 4 * n + (i & 3); }

struct Unit { int pm, pn; };
struct Gemm { const bf16_t* A; const bf16_t* Bt; int M, N, K; };

struct StaticOrder {
    int nM, nN, nwg, G, c;
    __host__ __device__ void init(int M, int N, int G_, int c_) { nM = M / BM; nN = N / BM; nwg = nM * nN; G = G_; c = c_; }
    __host__ __device__ bool next(int i, Unit& u) const {
        const long L = (long)i * G + c; if (L >= nwg) return false;
        int wgid = (int)L; { const int q = nwg / NXCD, r = nwg % NXCD, xcd = wgid % NXCD, off = wgid / NXCD; wgid = (xcd < r ? xcd * (q + 1) : r * (q + 1) + (xcd - r) * q) + off; }
        const int nig = WGM * nN, gid = wgid / nig, fm = gid * WGM, gsz = (nM - fm) < WGM ? (nM - fm) : WGM;
        u.pm = fm + ((wgid % nig) % gsz); u.pn = (wgid % nig) / gsz; return true;
    }
    __device__ __forceinline__ void a_ready(const Unit&) const {}
    __device__ __forceinline__ void done(const Unit&) const {}
};
__device__ __forceinline__ unsigned cvt_pk_bf16(float lo, float hi) { unsigned r; asm volatile("v_cvt_pk_bf16_f32 %0, %1, %2" : "=v"(r) : "v"(lo), "v"(hi)); return r; }
template <class Epi, class Sched, bool ALIGN_EPI = false, bool SP2 = false>
__device__ __forceinline__ void gemm_phase(PG8_LAS unsigned char* lds, const Gemm g, const Sched& S, const Epi& E, int tid_in) {
    int tid_ = tid_in; asm volatile("" : "+v"(tid_));
    const int tid = tid_, wid = __builtin_amdgcn_readfirstlane(tid >> 6), lane = tid & 63, wr = wid >> 2, wc = wid & 3, fr = lane & 15, fq = lane >> 4;
    const int K = g.K, nt = K / BK;
    unsigned voffA[2], voffB[2];
#pragma unroll
    for (int i = 0; i < 2; ++i) { int R, C; stage_rc(tid * 16 + i * 8192, R, C); const int Rb = Epi::PERM ? ((R & ~31) + perm32(R & 31)) : R;
        voffA[i] = (unsigned)(R * K + C) * 2u; voffB[i] = (unsigned)(Rb * K + C) * 2u; }
    const size_t kstep = (size_t)(BK * 2);
    const size_t hstep = (size_t)HALF * K * 2;
    const size_t tstep = 2 * hstep;
    const unsigned ldsw = (unsigned)wid * 1024u;
    const int aoff = lds_byte(wr * 64 + fr, fq * 8), boff = lds_byte(wc * 32 + fr, fq * 8);
#define PG8_SA(b, h) (((b) * 2 + (h)) * HTB)
#define PG8_SB(b, h) ((4 + (b) * 2 + (h)) * HTB)
#define PG8_STAGE(bufoff, gbase, voff) do { _Pragma("unroll") for (int _i = 0; _i < 2; ++_i) \
        __builtin_amdgcn_global_load_lds((const unsigned*)((const char*)(gbase) + (voff)[_i]), (PG8_LAS unsigned*)(lds + (bufoff) + ldsw + _i * 8192), 16, 0, 0); } while (0)
#define PG8_LDA(dst, b, h) do { _Pragma("unroll") for (int m = 0; m < 4; ++m) _Pragma("unroll") for (int k = 0; k < 2; ++k) dst[m][k] = *(const PG8_LAS bf16x8*)(lds + PG8_SA(b, h) + aoff + m * 2048 + k * 1024); } while (0)
#define PG8_LDB(dst, b, h) do { _Pragma("unroll") for (int n = 0; n < 2; ++n) _Pragma("unroll") for (int k = 0; k < 2; ++k) dst[n][k] = *(const PG8_LAS bf16x8*)(lds + PG8_SB(b, h) + boff + n * 2048 + k * 1024); } while (0)
#define PG8_MMA(ai, bj, At, Bt) do { __builtin_amdgcn_s_setprio(1); _Pragma("unroll") for (int m = 0; m < 4; ++m) _Pragma("unroll") for (int n = 0; n < 2; ++n) _Pragma("unroll") for (int k = 0; k < 2; ++k) \
        acc[ai][bj][m][n] = __builtin_amdgcn_mfma_f32_16x16x32_bf16(Bt[n][k], At[m][k], acc[ai][bj][m][n], 0, 0, 0); __builtin_amdgcn_s_setprio(0); } while (0)
#define PG8_WAIT_V(n) asm volatile("s_waitcnt vmcnt(" #n ")" ::: "memory")
#define PG8_WAIT_L(n) asm volatile("s_waitcnt lgkmcnt(" #n ")" ::: "memory")
#define PG8_BAR __builtin_amdgcn_s_barrier()
#define PG8_SCHED __builtin_amdgcn_sched_barrier(0)
    Unit cur, nxt; int ui = 0;
    if (!S.next(0, cur)) return;
    f32x4 acc[2][2][4][2];
#pragma unroll
    for (int a = 0; a < 2; ++a)
#pragma unroll
        for (int b = 0; b < 2; ++b)
#pragma unroll
            for (int m = 0; m < 4; ++m)
#pragma unroll
                for (int n = 0; n < 2; ++n) acc[a][b][m][n] = (f32x4){0.f, 0.f, 0.f, 0.f};
    bf16x8 At[4][2], B0[2][2], B1[2][2];
    const char* cA = (const char*)g.A + (size_t)cur.pm * tstep; const char* cB = (const char*)g.Bt + (size_t)cur.pn * tstep;
    S.a_ready(cur);
    if constexpr (SP2) {
        PG8_STAGE(PG8_SB(0, 0), cB, voffB); PG8_STAGE(PG8_SB(0, 1), cB + hstep, voffB); PG8_STAGE(PG8_SA(0, 0), cA, voffA); PG8_STAGE(PG8_SA(0, 1), cA + hstep, voffA);
        if (wr == 1) PG8_BAR;
        PG8_WAIT_V(2); PG8_BAR;
        PG8_STAGE(PG8_SB(1, 0), cB + kstep, voffB); PG8_STAGE(PG8_SA(1, 0), cA + kstep, voffA); PG8_STAGE(PG8_SB(1, 1), cB + hstep + kstep, voffB);
        PG8_WAIT_V(6); PG8_BAR;
    } else {
        PG8_STAGE(PG8_SB(0, 0), cB, voffB); PG8_STAGE(PG8_SA(0, 0), cA, voffA); PG8_STAGE(PG8_SB(0, 1), cB + hstep, voffB); PG8_STAGE(PG8_SA(0, 1), cA + hstep, voffA);
        if (wr == 1) PG8_BAR;
        PG8_WAIT_V(4); PG8_BAR;
        PG8_STAGE(PG8_SB(1, 0), cB + kstep, voffB); PG8_STAGE(PG8_SA(1, 0), cA + kstep, voffA); PG8_STAGE(PG8_SB(1, 1), cB + hstep + kstep, voffB);
        PG8_WAIT_V(6); PG8_BAR;
    }
    for (;;) {
        const bool has_next = S.next(ui + 1, nxt);
        const char* nA = has_next ? (const char*)g.A + (size_t)nxt.pm * tstep : cA; const char* nB = has_next ? (const char*)g.Bt + (size_t)nxt.pn * tstep : cB;
#pragma unroll 1
        for (int t = 0; t < nt; t += 2) {
            const bool last = (t == nt - 2);
            const char* a1 = cA + (size_t)(t + 1) * kstep;
            const char* a2 = last ? nA : cA + (size_t)(t + 2) * kstep; const char* b2 = last ? nB : cB + (size_t)(t + 2) * kstep;
            const char* a3 = a2 + kstep; const char* b3 = b2 + kstep;
            if (last && has_next) S.a_ready(nxt);
            if constexpr (SP2) {
            PG8_LDB(B0, 0, 0); PG8_LDB(B1, 0, 1); PG8_SCHED; PG8_LDA(At, 0, 0); PG8_STAGE(PG8_SA(1, 1), a1 + hstep, voffA);
            PG8_WAIT_V(8); PG8_WAIT_L(0); PG8_BAR; PG8_MMA(0, 0, At, B0); PG8_MMA(0, 1, At, B1); PG8_BAR; PG8_SCHED;
            PG8_LDA(At, 0, 1); PG8_STAGE(PG8_SB(0, 0), b2, voffB); PG8_STAGE(PG8_SB(0, 1), b2 + hstep, voffB); PG8_STAGE(PG8_SA(0, 0), a2, voffA);
            PG8_WAIT_V(8); PG8_WAIT_L(0); PG8_BAR; PG8_MMA(1, 0, At, B0); PG8_MMA(1, 1, At, B1); PG8_BAR; PG8_SCHED;
            PG8_LDB(B0, 1, 0); PG8_LDB(B1, 1, 1); PG8_SCHED; PG8_LDA(At, 1, 0); PG8_STAGE(PG8_SA(0, 1), a2 + hstep, voffA);
            PG8_WAIT_V(8); PG8_WAIT_L(0); PG8_BAR; PG8_MMA(0, 0, At, B0); PG8_MMA(0, 1, At, B1); PG8_BAR; PG8_SCHED;
            PG8_LDA(At, 1, 1); PG8_STAGE(PG8_SB(1, 0), b3, voffB); PG8_STAGE(PG8_SB(1, 1), b3 + hstep, voffB); PG8_STAGE(PG8_SA(1, 0), a3, voffA);
            PG8_WAIT_V(8); PG8_WAIT_L(0); PG8_BAR; PG8_MMA(1, 0, At, B0); PG8_MMA(1, 1, At, B1); PG8_BAR; PG8_SCHED;
            } else {
            PG8_LDB(B0, 0, 0); PG8_SCHED; PG8_LDA(At, 0, 0); PG8_STAGE(PG8_SA(1, 1), a1 + hstep, voffA);
            PG8_WAIT_L(8); PG8_BAR; PG8_WAIT_L(0); PG8_MMA(0, 0, At, B0); PG8_BAR; PG8_SCHED;
            PG8_LDB(B1, 0, 1); PG8_STAGE(PG8_SB(0, 0), b2, voffB);
            PG8_BAR; PG8_WAIT_L(0); PG8_MMA(0, 1, At, B1); PG8_BAR;
            PG8_LDA(At, 0, 1); PG8_STAGE(PG8_SA(0, 0), a2, voffA);
            PG8_BAR; PG8_WAIT_L(0); PG8_MMA(1, 0, At, B0); PG8_BAR; PG8_SCHED;
            PG8_STAGE(PG8_SB(0, 1), b2 + hstep, voffB);
            PG8_WAIT_V(6); PG8_BAR; PG8_MMA(1, 1, At, B1); PG8_BAR;
            PG8_LDB(B0, 1, 0); PG8_SCHED; PG8_LDA(At, 1, 0); PG8_STAGE(PG8_SA(0, 1), a2 + hstep, voffA);
            PG8_WAIT_L(8); PG8_BAR; PG8_WAIT_L(0); PG8_MMA(0, 0, At, B0); PG8_BAR; PG8_SCHED;
            PG8_LDB(B1, 1, 1); PG8_STAGE(PG8_SB(1, 0), b3, voffB);
            PG8_BAR; PG8_WAIT_L(0); PG8_MMA(0, 1, At, B1); PG8_BAR;
            PG8_LDA(At, 1, 1); PG8_STAGE(PG8_SA(1, 0), a3, voffA);
            PG8_BAR; PG8_WAIT_L(0); PG8_MMA(1, 0, At, B0); PG8_BAR; PG8_SCHED;
            PG8_STAGE(PG8_SB(1, 1), b3 + hstep, voffB);
            PG8_WAIT_V(6); PG8_BAR; PG8_MMA(1, 1, At, B1); PG8_BAR;
            }
        }
        if constexpr (ALIGN_EPI) { if (wr == 0) PG8_BAR; }
        if constexpr (!Epi::AFTER_DRAIN) { E(acc, cur, wr, wc, fr, fq); S.done(cur); }
        if (!has_next) break;
#pragma unroll
        for (int a = 0; a < 2; ++a)
#pragma unroll
            for (int b = 0; b < 2; ++b)
#pragma unroll
                for (int m = 0; m < 4; ++m)
#pragma unroll
                    for (int n = 0; n < 2; ++n) acc[a][b][m][n] = (f32x4){0.f, 0.f, 0.f, 0.f};
        cur = nxt; cA = nA; cB = nB; ++ui;
        if constexpr (ALIGN_EPI) { if (wr == 1) PG8_BAR; }
    }
    PG8_WAIT_V(0);
    if constexpr (!ALIGN_EPI) { if (wr == 0) PG8_BAR; }
    PG8_BAR;
    if constexpr (Epi::AFTER_DRAIN) { E.fused(acc, cur, wr, wc, fr, fq, lds, wid, lane); S.done(cur); }
#undef PG8_SA
#undef PG8_SB
#undef PG8_STAGE
#undef PG8_LDA
#undef PG8_LDB
#undef PG8_MMA
#undef PG8_WAIT_V
#undef PG8_WAIT_L
#undef PG8_BAR
#undef PG8_SCHED
}
}

constexpr bool PG_ALIGN = true, PG_SP2 = true;
__device__ __forceinline__ float bflo(unsigned w) { return __builtin_bit_cast(float, w << 16); }
__device__ __forceinline__ float bfhi(unsigned w) { return __builtin_bit_cast(float, w & 0xffff0000u); }
__device__ __forceinline__ unsigned cvtpk(float lo, float hi) { return pg8::cvt_pk_bf16(lo, hi); }

__device__ __forceinline__ void transpose_item(const float* W, int N, int k0, int n0, bf16* WT, int K, size_t dst_row0, LAS float* scr, int lane) {
    float v[32];
#pragma unroll
    for (int i = 0; i < 32; ++i) v[i] = W[(size_t)(k0 + 2 * i + (lane >> 5)) * N + n0 + (lane & 31)];
#pragma unroll
    for (int i = 0; i < 32; ++i) scr[(2 * i + (lane >> 5)) * 33 + (lane & 31)] = v[i];
    asm volatile("s_waitcnt lgkmcnt(0)" ::: "memory");
    const int c = lane & 7;
#pragma unroll
    for (int j = 0; j < 4; ++j) { const int n = (lane >> 3) + 8 * j; const LAS float* s = scr + (8 * c) * 33 + n;
        v4u o; o.x = pk2(s[0 * 33], s[1 * 33]); o.y = pk2(s[2 * 33], s[3 * 33]); o.z = pk2(s[4 * 33], s[5 * 33]); o.w = pk2(s[6 * 33], s[7 * 33]);
        *(v4u*)(WT + (dst_row0 + n) * K + k0 + 8 * c) = o; }
    asm volatile("s_waitcnt lgkmcnt(0)" ::: "memory");
}
__device__ __forceinline__ void convert_weights(Frame& F, int l, int nblk) {
    LAS float* scr = (LAS float*)(F.lds + F.wave * 16384);
    if (F.bid >= nblk) return;
    const int gw = F.bid * (NT / 64) + F.wave, ngw = nblk * (NT / 64);
    constexpr int I_IN = 16 * 96, I_MG = 16 * 96, I_GLU = 8 * 16, I_BR = 3 * 8 * 32, I_O = 16 * 32, I_1 = 32 * 16 * 8, I_3 = I_1, I_2 = 32 * 4 * 32;
    constexpr int NITEMS = I_IN + I_MG + I_GLU + I_BR + I_O + I_1 + I_3 + I_2;
    for (int it = gw; it < NITEMS; it += ngw) {
        int r = it;
        if (r < I_IN) { const int kb = r / 96, nb = r % 96; transpose_item(IN_(I_WIN) + (size_t)l * D * INW, INW, 64 * kb, 32 * nb, (bf16*)(F.ws + WS_WIN), 1024, 32 * nb, scr, F.lane); continue; } r -= I_IN;
        if (r < I_MG) { const int kb = r / 96, nb = r % 96; transpose_item(IN_(I_WMG) + (size_t)l * D * INW, INW, 64 * kb, 32 * nb, (bf16*)(F.ws + WS_WMG), 1024, 32 * nb, scr, F.lane); continue; } r -= I_MG;
        if (r < I_GLU) { const int kb = r / 16, nb = r % 16; transpose_item(IN_(I_WGLU) + (size_t)l * MIXW * MIXW, MIXW, 64 * kb, 32 * nb, (bf16*)(F.ws + WS_WGLU), 512, 32 * nb, scr, F.lane); continue; } r -= I_GLU;
        if (r < I_BR) { const int kk = r / 256, q = r % 256, kb = q / 32, nb = q % 32; transpose_item(IN_(I_WBR) + ((size_t)l * 3 + kk) * MIXW * D, D, 64 * kb, 32 * nb, (bf16*)(F.ws + WS_WBR), 512, (size_t)kk * 1024 + 32 * nb, scr, F.lane); continue; } r -= I_BR;
        if (r < I_O) { const int kb = r / 32, nb = r % 32; transpose_item(IN_(I_WO) + (size_t)l * D * D, D, 64 * kb, 32 * nb, (bf16*)(F.ws + WS_WO), 1024, 32 * nb, scr, F.lane); continue; } r -= I_O;
        if (r < I_1 + I_3) { const int which = r / I_1, q = r % I_1, e = q / 128, q2 = q % 128, kb = q2 / 8, nb = q2 % 8;
            const float* W = IN_(which ? I_W3 : I_W1) + ((size_t)l * NE + e) * D * DFF; const int n0 = 32 * nb;
            transpose_item(W, DFF, 64 * kb, n0, (bf16*)(F.ws + WS_W13), 1024, (size_t)e * 512 + (n0 / 128) * 256 + which * 128 + (n0 % 128), scr, F.lane); continue; } r -= I_1 + I_3;
        { const int e = r / 128, q = r % 128, kb = q / 32, nb = q % 32; transpose_item(IN_(I_W2) + ((size_t)l * NE + e) * DFF * D, D, 64 * kb, 32 * nb, (bf16*)(F.ws + WS_W2), 256, (size_t)e * 1024 + 32 * nb, scr, F.lane); }
    }
    { bf16* wr = (bf16*)(F.ws + WS_WR); const float* wg = IN_(I_WGRP) + (size_t)l * D * 4; const float* we = IN_(I_WEXP) + (size_t)l * D * 32;
      for (int i = F.bid * NT + F.tid; i < 48 * 1024; i += nblk * NT) { const int n = i >> 10, kk = i & 1023; const float w = n < 4 ? wg[kk * 4 + n] : (n < 36 ? we[kk * 32 + n - 4] : 0.f);
          const unsigned hi = f2bf(w); const float lo = w - __builtin_bit_cast(float, hi << 16); wr[i] = (bf16)hi; wr[48 * 1024 + i] = (bf16)f2bf(lo); } }
    { const float* s = IN_(I_WSG) + (size_t)l * 4 * 128 * 128; bf16* d = (bf16*)(F.ws + WS_WSG);
      for (int i = (F.bid * NT + F.tid) * 2; i < 4 * 128 * 128; i += nblk * NT * 2) *(unsigned*)(d + i) = pk2(s[i], s[i + 1]); }
}

struct EpiProj { static constexpr bool PERM = true, AFTER_DRAIN = false; bf16* O;
    __device__ __forceinline__ void operator()(const pg8::f32x4 (&acc)[2][2][4][2], const pg8::Unit& u, int wr, int wc, int fr, int fq) const {
        const int row0 = u.pm * 256 + wr * 64 + fr, col0 = u.pn * 256 + wc * 32 + 8 * fq; const bool act = (u.pn >= 2 && u.pn < 6);
#pragma unroll
        for (int ai = 0; ai < 2; ++ai)
#pragma unroll
            for (int m = 0; m < 4; ++m) { bf16* rowp = O + (size_t)(row0 + ai * 128 + m * 16) * INW + col0;
#pragma unroll
                for (int bj = 0; bj < 2; ++bj) { pg8::f32x4 v0 = acc[ai][bj][m][0], v1 = acc[ai][bj][m][1];
                    if (act) {
#pragma unroll
                        for (int j = 0; j < 4; ++j) { v0[j] = geluf_(v0[j]); v1[j] = geluf_(v1[j]); } }
                    v4u w; w.x = cvtpk(v0[0], v0[1]); w.y = cvtpk(v0[2], v0[3]); w.z = cvtpk(v1[0], v1[1]); w.w = cvtpk(v1[2], v1[3]); *(v4u*)(rowp + bj * 128) = w; } }
    } };
struct EpiGlu { static constexpr bool PERM = true, AFTER_DRAIN = false; const bf16* YG; bf16* YA;
    __device__ __forceinline__ void operator()(const pg8::f32x4 (&acc)[2][2][4][2], const pg8::Unit& u, int wr, int wc, int fr, int fq) const {
        const int row0 = u.pm * 256 + wr * 64 + fr, col0 = u.pn * 256 + wc * 32 + 8 * fq;
#pragma unroll
        for (int ai = 0; ai < 2; ++ai) {
        v4u gv[4][2];
#pragma unroll
            for (int m = 0; m < 4; ++m)
#pragma unroll
                for (int bj = 0; bj < 2; ++bj) gv[m][bj] = *(const v4u*)(YG + (size_t)(row0 + ai * 128 + m * 16) * MIXW + col0 + bj * 128);
        asm volatile("" ::: "memory");
#pragma unroll
            for (int m = 0; m < 4; ++m) { const size_t off = (size_t)(row0 + ai * 128 + m * 16) * MIXW + col0;
#pragma unroll
                for (int bj = 0; bj < 2; ++bj) { const pg8::f32x4 v0 = acc[ai][bj][m][0], v1 = acc[ai][bj][m][1]; const v4u g = gv[m][bj];
                    v4u w; w.x = cvtpk(bflo(g.x) * sigmoidf_(v0[0]), bfhi(g.x) * sigmoidf_(v0[1])); w.y = cvtpk(bflo(g.y) * sigmoidf_(v0[2]), bfhi(g.y) * sigmoidf_(v0[3]));
                    w.z = cvtpk(bflo(g.z) * sigmoidf_(v1[0]), bfhi(g.z) * sigmoidf_(v1[1])); w.w = cvtpk(bflo(g.w) * sigmoidf_(v1[2]), bfhi(g.w) * sigmoidf_(v1[3])); *(v4u*)(YA + off + bj * 128) = w; } }
        asm volatile("" ::: "memory"); }
    } };
struct EpiBr { static constexpr bool PERM = true, AFTER_DRAIN = false; bf16* BR;
    __device__ __forceinline__ void operator()(const pg8::f32x4 (&acc)[2][2][4][2], const pg8::Unit& u, int wr, int wc, int fr, int fq) const {
        const int pm = u.pm % (MT / 256); const int row0 = pm * 256 + wr * 64 + fr, col0 = u.pn * 256 + wc * 32 + 8 * fq;
#pragma unroll
        for (int ai = 0; ai < 2; ++ai)
#pragma unroll
            for (int m = 0; m < 4; ++m) { bf16* rowp = BR + (size_t)(row0 + ai * 128 + m * 16) * INW + col0;
#pragma unroll
                for (int bj = 0; bj < 2; ++bj) { const pg8::f32x4 v0 = acc[ai][bj][m][0], v1 = acc[ai][bj][m][1];
                    v4u w; w.x = cvtpk(v0[0], v0[1]); w.y = cvtpk(v0[2], v0[3]); w.z = cvtpk(v1[0], v1[1]); w.w = cvtpk(v1[2], v1[3]); *(v4u*)(rowp + bj * 128) = w; } }
    } };
struct SchedBr { int G, c, nM;
    __device__ __forceinline__ bool next(int i, pg8::Unit& u) const { const int Lq = i * G + c; if (Lq >= 3 * nM * 4) return false; const int k = Lq / (nM * 4), r = Lq % (nM * 4);
        u.pm = k * (MT / 256) + r / 4; u.pn = k * 4 + r % 4; return true; }
    __device__ __forceinline__ void a_ready(const pg8::Unit&) const {}
    __device__ __forceinline__ void done(const pg8::Unit&) const {} };
struct EpiMerge { static constexpr bool PERM = true, AFTER_DRAIN = false; const bf16* BR; bf16* PM; const float* bm;
    __device__ __forceinline__ void operator()(const pg8::f32x4 (&acc)[2][2][4][2], const pg8::Unit& u, int wr, int wc, int fr, int fq) const {
        const int k = u.pn >> 2, dt = u.pn & 3; const int row0 = u.pm * 256 + wr * 64 + fr, col0 = dt * 256 + wc * 32 + 8 * fq;
#pragma unroll
        for (int bj = 0; bj < 2; ++bj) { const pg8::f32x4 b0 = *(const pg8::f32x4*)(bm + k * 1024 + col0 + bj * 128), b1 = *(const pg8::f32x4*)(bm + k * 1024 + col0 + bj * 128 + 4);
#pragma unroll
            for (int ai = 0; ai < 2; ++ai) {
            v4u brv[4], pmv[4];
#pragma unroll
                for (int m = 0; m < 4; ++m) { const size_t r = (size_t)(row0 + ai * 128 + m * 16); brv[m] = *(const v4u*)(BR + r * INW + k * 1024 + col0 + bj * 128);
                    pmv[m] = k > 0 ? *(const v4u*)(PM + r * D + col0 + bj * 128) : (v4u){0u, 0u, 0u, 0u}; }
                asm volatile("" ::: "memory");
#pragma unroll
                for (int m = 0; m < 4; ++m) { const size_t r = (size_t)(row0 + ai * 128 + m * 16); const v4u br = brv[m], o = pmv[m];
                    const pg8::f32x4 v0 = acc[ai][bj][m][0] + b0, v1 = acc[ai][bj][m][1] + b1;
                    float p[8] = {sigmoidf_(v0[0]) * bflo(br.x), sigmoidf_(v0[1]) * bfhi(br.x), sigmoidf_(v0[2]) * bflo(br.y), sigmoidf_(v0[3]) * bfhi(br.y),
                                  sigmoidf_(v1[0]) * bflo(br.z), sigmoidf_(v1[1]) * bfhi(br.z), sigmoidf_(v1[2]) * bflo(br.w), sigmoidf_(v1[3]) * bfhi(br.w)};
                    if (k > 0) { p[0] += bflo(o.x); p[1] += bfhi(o.x); p[2] += bflo(o.y); p[3] += bfhi(o.y); p[4] += bflo(o.z); p[5] += bfhi(o.z); p[6] += bflo(o.w); p[7] += bfhi(o.w); }
                    v4u w; w.x = cvtpk(p[0], p[1]); w.y = cvtpk(p[2], p[3]); w.z = cvtpk(p[4], p[5]); w.w = cvtpk(p[6], p[7]); *(v4u*)(PM + r * D + col0 + bj * 128) = w; }
                asm volatile("" ::: "memory"); } }
    } };
struct SchedMerge { int G, c, nM;
    __device__ __forceinline__ bool next(int i, pg8::Unit& u) const { const int v = (i / 3) * G + c, k = i % 3; if (v >= nM * 4) return false; u.pm = v >> 2; u.pn = k * 4 + (v & 3); return true; }
    __device__ __forceinline__ void a_ready(const pg8::Unit&) const {}
    __device__ __forceinline__ void done(const pg8::Unit&) const {} };
struct EpiWo { static constexpr bool PERM = false, AFTER_DRAIN = false; const float* xs_lat; const float* xs_ctx; float* out; float* xc; const float* mod_l;
    __device__ __forceinline__ void operator()(const pg8::f32x4 (&acc)[2][2][4][2], const pg8::Unit& u, int wr, int wc, int fr, int fq) const {
        const int row0 = u.pm * 256 + wr * 64 + fr, col0 = u.pn * 256 + wc * 32 + 4 * fq;
        const float* ga = mod_l + 2048;
        pg8::f32x4 gv[2][2];
#pragma unroll
        for (int bj = 0; bj < 2; ++bj)
#pragma unroll
            for (int n = 0; n < 2; ++n) gv[bj][n] = *(const pg8::f32x4*)(ga + col0 + bj * 128 + n * 16);
#pragma unroll
        for (int ai = 0; ai < 2; ++ai) {
#pragma unroll
            for (int mp = 0; mp < 2; ++mp) {
            pg8::f32x4 xv[2][2][2];
#pragma unroll
            for (int m = 0; m < 2; ++m) { const size_t off = (size_t)(row0 + ai * 128 + (mp * 2 + m) * 16) * D + col0;
#pragma unroll
                for (int bj = 0; bj < 2; ++bj)
#pragma unroll
                    for (int n = 0; n < 2; ++n) xv[m][bj][n] = *(const pg8::f32x4*)(xs_lat + off + bj * 128 + n * 16); }
            asm volatile("" ::: "memory");
#pragma unroll
            for (int m = 0; m < 2; ++m) { const size_t off = (size_t)(row0 + ai * 128 + (mp * 2 + m) * 16) * D + col0;
#pragma unroll
                for (int bj = 0; bj < 2; ++bj)
#pragma unroll
                    for (int n = 0; n < 2; ++n) *(pg8::f32x4*)(out + off + bj * 128 + n * 16) = xv[m][bj][n] + gv[bj][n] * acc[ai][bj][m + mp * 2][n]; }
            asm volatile("" ::: "memory"); }
        }
    } };
constexpr int MOETAB_OFF = 131072 + 2048;
template <int NPN> __device__ __forceinline__ int moe_build_table(Frame& F, const unsigned* cnt) {
    LAS unsigned* tabw = (LAS unsigned*)(F.lds + MOETAB_OFF);
    int total = 0, rowtile0 = 0;
    for (int e = 0; e < NE; ++e) { const int nt_e = ((int)cnt[e] + 255) >> 8;
        for (int q = F.tid; q < nt_e * NPN; q += NT) tabw[total + q] = ((unsigned)(rowtile0 + q / NPN) << 16) | (unsigned)(e * NPN + q % NPN);
        total += nt_e * NPN; rowtile0 += nt_e; }
    __syncthreads();
    return total;
}
struct SchedMoe { int G, c, total; const LAS unsigned* tabw;
    __device__ __forceinline__ bool next(int i, pg8::Unit& u) const { const int Lq = i * G + c; if (Lq >= total) return false; const unsigned w = (unsigned)__builtin_amdgcn_readfirstlane((int)tabw[Lq]); u.pm = (int)(w >> 16); u.pn = (int)(w & 0xffffu); return true; }
    __device__ __forceinline__ void a_ready(const pg8::Unit&) const {}
    __device__ __forceinline__ void done(const pg8::Unit&) const {} };
struct EpiUp { static constexpr bool PERM = true, AFTER_DRAIN = false; bf16* ACT; const float* SW;
    __device__ __forceinline__ void operator()(const pg8::f32x4 (&acc)[2][2][4][2], const pg8::Unit& u, int wr, int wc, int fr, int fq) const {
        const int row0 = u.pm * 256 + wr * 64 + fr, f0 = (u.pn & 1) * 128 + wc * 32 + 8 * fq;
#pragma unroll
        for (int ai = 0; ai < 2; ++ai)
#pragma unroll
            for (int m = 0; m < 4; ++m) { const int slot = row0 + ai * 128 + m * 16; const float w = SW[slot];
                const pg8::f32x4 a0 = acc[ai][0][m][0], a1 = acc[ai][0][m][1], b0 = acc[ai][1][m][0], b1 = acc[ai][1][m][1];
                v4u o; o.x = cvtpk(siluf_(a0[0]) * b0[0] * w, siluf_(a0[1]) * b0[1] * w); o.y = cvtpk(siluf_(a0[2]) * b0[2] * w, siluf_(a0[3]) * b0[3] * w);
                o.z = cvtpk(siluf_(a1[0]) * b1[0] * w, siluf_(a1[1]) * b1[1] * w); o.w = cvtpk(siluf_(a1[2]) * b1[2] * w, siluf_(a1[3]) * b1[3] * w);
                *(v4u*)(ACT + (size_t)slot * DFF + f0) = o; }
    } };
struct EpiDown { static constexpr bool PERM = true, AFTER_DRAIN = false; bf16* YS2;
    __device__ __forceinline__ void operator()(const pg8::f32x4 (&acc)[2][2][4][2], const pg8::Unit& u, int wr, int wc, int fr, int fq) const {
        const int row0 = u.pm * 256 + wr * 64 + fr, col0 = (u.pn & 3) * 256 + wc * 32 + 8 * fq;
#pragma unroll
        for (int ai = 0; ai < 2; ++ai)
#pragma unroll
            for (int m = 0; m < 4; ++m) { bf16* rowp = YS2 + (size_t)(row0 + ai * 128 + m * 16) * D + col0;
#pragma unroll
                for (int bj = 0; bj < 2; ++bj) { const pg8::f32x4 v0 = acc[ai][bj][m][0], v1 = acc[ai][bj][m][1];
                    v4u w; w.x = cvtpk(v0[0], v0[1]); w.y = cvtpk(v0[2], v0[3]); w.z = cvtpk(v1[0], v1[1]); w.w = cvtpk(v1[2], v1[3]); *(v4u*)(rowp + bj * 128) = w; } }
    } };

__device__ __forceinline__ void ph2_fast(Frame& F, int l) {
    pg8::Gemm g{(const bf16*)(F.ws + WS_H), (const bf16*)(F.ws + WS_WIN), SEQ, INW, D}; pg8::StaticOrder S; S.init(SEQ, INW, F.G, F.bid);
    EpiProj E{(bf16*)(F.ws + WS_PROJ)}; pg8::gemm_phase<EpiProj, pg8::StaticOrder, PG_ALIGN, PG_SP2>(F.lds, g, S, E, F.tid);
}
__device__ __forceinline__ void ph6_fast(Frame& F, int l) {
    pg8::Gemm g{(const bf16*)(F.ws + WS_YG), (const bf16*)(F.ws + WS_WGLU), MT, MIXW, MIXW}; pg8::StaticOrder S; S.init(SEQ, MIXW, F.G, F.bid);
    EpiGlu E{(const bf16*)(F.ws + WS_YG), (bf16*)(F.ws + WS_YS)}; pg8::gemm_phase<EpiGlu, pg8::StaticOrder, PG_ALIGN, PG_SP2>(F.lds, g, S, E, F.tid);
}
__device__ __forceinline__ void ph7_fast(Frame& F, int l) {
    pg8::Gemm g{(const bf16*)(F.ws + WS_YS), (const bf16*)(F.ws + WS_WBR), 3 * MT, 3 * D, MIXW}; SchedBr S{F.G, F.bid, SEQ / 256};
    EpiBr E{(bf16*)(F.ws + WS_PROJ)}; pg8::gemm_phase<EpiBr, SchedBr, PG_ALIGN, PG_SP2>(F.lds, g, S, E, F.tid);
}
__device__ __forceinline__ void ph8_fast(Frame& F, int l) {
    pg8::Gemm g{(const bf16*)(F.ws + WS_H), (const bf16*)(F.ws + WS_WMG), MT, INW, D}; SchedMerge S{F.G, F.bid, SEQ / 256};
    EpiMerge E{(const bf16*)(F.ws + WS_PROJ), (bf16*)(F.ws + WS_PM), IN_(I_BMG) + l * INW}; pg8::gemm_phase<EpiMerge, SchedMerge, PG_ALIGN, PG_SP2>(F.lds, g, S, E, F.tid);
}
__device__ __forceinline__ void ph9_fast(Frame& F, int l) {
    pg8::Gemm g{(const bf16*)(F.ws + WS_PM), (const bf16*)(F.ws + WS_WO), MT, D, D}; pg8::StaticOrder S; S.init(SEQ, D, F.G, F.bid);
    EpiWo E{l == 0 ? IN_(I_X) : F.out, l == 0 ? IN_(I_CTX) : (const float*)(F.ws + WS_XC), F.out, (float*)(F.ws + WS_XC), (const float*)(F.ws + WS_MOD) + (size_t)l * 2 * 6144};
    pg8::gemm_phase<EpiWo, pg8::StaticOrder, PG_ALIGN, PG_SP2>(F.lds, g, S, E, F.tid);
}
__device__ __forceinline__ void ph12_fast(Frame& F, int l) {
    pg8::Gemm g{(const bf16*)(F.ws + WS_HS), (const bf16*)(F.ws + WS_W13), MAXSLOT, NE * 512, D}; const int total = moe_build_table<2>(F, F.ctl + CW_CNT + l * 128); SchedMoe S{F.G, F.bid, total, (const LAS unsigned*)(F.lds + MOETAB_OFF)};
    EpiUp E{(bf16*)(F.ws + WS_ACT), (const float*)(F.ws + WS_SW)}; pg8::gemm_phase<EpiUp, SchedMoe, PG_ALIGN, PG_SP2>(F.lds, g, S, E, F.tid);
}
__device__ __forceinline__ void ph13_fast(Frame& F, int l) {
    pg8::Gemm g{(const bf16*)(F.ws + WS_ACT), (const bf16*)(F.ws + WS_W2), MAXSLOT, NE * D, DFF}; const int total = moe_build_table<4>(F, F.ctl + CW_CNT + l * 128); SchedMoe S{F.G, F.bid, total, (const LAS unsigned*)(F.lds + MOETAB_OFF)};
    EpiDown E{(bf16*)(F.ws + WS_YS2)}; pg8::gemm_phase<EpiDown, SchedMoe, PG_ALIGN, PG_SP2>(F.lds, g, S, E, F.tid);
}


typedef short bf16x8 __attribute__((ext_vector_type(8)));
constexpr int NSB = MT / 16;
__device__ __forceinline__ void s5_precompute(Frame& F) {
    LAS float* APr = (LAS float*)F.lds; LAS float* APi = APr + 2176; LAS float* BBr = APi + 2176; LAS float* BBi = BBr + 2048; LAS float* CCr = BBi + 2048; LAS float* CCi = CCr + 2048; LAS float* KK = CCi + 2048;
    for (int item = F.G - 1 - F.bid; item < 2 * G5; item += F.G) { const int l = item >> 5, g = item & 31;
        __syncthreads();
        if (F.tid < 128) { const int d = F.tid >> 6, p = F.tid & 63; const int ldg = (l * 2 + d) * G5 + g;
            const double lr = IN_(I_LRE)[ldg * P5 + p], li = IN_(I_LIM)[ldg * P5 + p], dt = exp((double)IN_(I_LDT)[ldg]);
            for (int e = 0; e <= 16; ++e) { const double m = exp(lr * dt * e), ang = li * dt * e; APr[(d * 64 + p) * 17 + e] = (float)(m * cos(ang)); APi[(d * 64 + p) * 17 + e] = (float)(m * sin(ang)); }
            { const double m16 = exp(lr * dt * 16.0), a16 = li * dt * 16.0; float* A16 = (float*)(F.ws + WS_A16) + ((size_t)((l * 32 + g) * 2 + d) * 64 + p) * 2; A16[0] = (float)(m16 * cos(a16)); A16[1] = (float)(m16 * sin(a16)); }
            const double m1 = exp(lr * dt), ar = m1 * cos(li * dt), ai = m1 * sin(li * dt); const double nr = ar - 1.0, ni = ai, den = lr * lr + li * li;
            const double qr = (nr * lr + ni * li) / den, qi = (ni * lr - nr * li) / den;
            for (int h = 0; h < 16; ++h) { const double x = IN_(I_BRE)[((size_t)ldg * P5 + p) * H5 + h], y = IN_(I_BIM)[((size_t)ldg * P5 + p) * H5 + h];
                BBr[(d * 64 + p) * 16 + h] = (float)(qr * x - qi * y); BBi[(d * 64 + p) * 16 + h] = (float)(qr * y + qi * x);
                CCr[(d * 16 + h) * 64 + p] = IN_(I_CRE)[((size_t)ldg * H5 + h) * P5 + p]; CCi[(d * 16 + h) * 64 + p] = IN_(I_CIM)[((size_t)ldg * H5 + h) * P5 + p]; } }
        __syncthreads();
        { const int d = F.tid >> 8, e = (F.tid >> 4) & 15, hp = F.tid & 15;
          float wr[64], wi[64];
#pragma unroll
          for (int p = 0; p < 64; ++p) { const float pr = APr[(d * 64 + p) * 17 + e], pi = APi[(d * 64 + p) * 17 + e], br = BBr[(d * 64 + p) * 16 + hp], bi = BBi[(d * 64 + p) * 16 + hp]; wr[p] = pr * br - pi * bi; wi[p] = pr * bi + pi * br; }
#pragma unroll 1
          for (int h = 0; h < 16; ++h) { float a = 0.f;
#pragma unroll
              for (int p = 0; p < 64; ++p) a += CCr[(d * 16 + h) * 64 + p] * wr[p] - CCi[(d * 16 + h) * 64 + p] * wi[p];
              KK[(d * 16 + e) * 256 + h * 16 + hp] = a; } }
        __syncthreads();
        bf16* M = (bf16*)(F.ws + WS_S5M) + (size_t)(l * 32 + g) * 3 * 65536;
        for (int idx = F.tid; idx < 32768; idx += NT) {
            const int r = idx >> 7, k0 = (idx & 127) * 2; float v[3][2];
#pragma unroll
            for (int q = 0; q < 2; ++q) { const int kk = k0 + q;
                { const int d = r >> 7, p = (r >> 1) & 63, c = r & 1, sg = kk >> 4, hp = kk & 15, e = d == 0 ? 15 - sg : sg;
                  const float pr = APr[(d * 64 + p) * 17 + e], pi = APi[(d * 64 + p) * 17 + e], br = BBr[(d * 64 + p) * 16 + hp], bi = BBi[(d * 64 + p) * 16 + hp];
                  v[0][q] = c == 0 ? pr * br - pi * bi : pr * bi + pi * br; }
                { const int tau = r >> 4, h = r & 15, sg = kk >> 4, hp = kk & 15; float t = 0.f;
                  if (sg <= tau) t += KK[(0 * 16 + (tau - sg)) * 256 + h * 16 + hp]; if (sg >= tau) t += KK[(1 * 16 + (sg - tau)) * 256 + h * 16 + hp]; v[1][q] = t; }
                { const int tau = r >> 4, h = r & 15, d = kk >> 7, p = (kk >> 1) & 63, c = kk & 1, e = d == 0 ? tau + 1 : 16 - tau;
                  const float cr = CCr[(d * 16 + h) * 64 + p], ci = CCi[(d * 16 + h) * 64 + p], pr = APr[(d * 64 + p) * 17 + e], pi = APi[(d * 64 + p) * 17 + e];
                  v[2][q] = c == 0 ? cr * pr - ci * pi : -(cr * pi + ci * pr); } }
#pragma unroll
            for (int m = 0; m < 3; ++m) *(unsigned*)(M + (size_t)m * 65536 + r * 256 + k0) = pk2(v[m][0], v[m][1]);
        }
    }
}
__device__ __forceinline__ void s5_z_phase(Frame& F, int l) {
    const bf16* PROJ = (const bf16*)(F.ws + WS_PROJ); float* Z = (float*)(F.ws + WS_Z);
    const int l15 = F.lane & 15, lq = F.lane >> 4;
    for (int item = F.bid; item < 256; item += F.G) {
        const int g = item >> 3, part = item & 7; const bf16* Fm = (const bf16*)(F.ws + WS_S5M) + (size_t)(l * 32 + g) * 3 * 65536;
        bf16x8 Af[2][8];
#pragma unroll
        for (int j = 0; j < 2; ++j)
#pragma unroll
            for (int ks = 0; ks < 8; ++ks) Af[j][ks] = *(const bf16x8*)(Fm + (size_t)(16 * (2 * F.wave + j) + l15) * 256 + 32 * ks + 8 * lq);
        const bf16* vsrc = PROJ + (size_t)(16 * l15 + 2 * F.wave + (lq >> 1)) * INW + 16 * g + 8 * (lq & 1);
        __syncthreads();
        bf16x8 nv = *(const bf16x8*)(vsrc + (size_t)part * 256 * INW);
        *(LAS bf16x8*)(F.lds + (F.wave * 64 + F.lane) * 16) = nv;
        __syncthreads();
        int cur = 0;
#pragma unroll 1
        for (int tl = part; tl < MT / 256; tl += 8) {
            const bool more = tl + 8 < MT / 256;
            if (more) nv = *(const bf16x8*)(vsrc + (size_t)(tl + 8) * 256 * INW);
            f32x4 acc[2] = {{0.f, 0.f, 0.f, 0.f}, {0.f, 0.f, 0.f, 0.f}};
#pragma unroll
            for (int ks = 0; ks < 8; ++ks) { const bf16x8 V = *(const LAS bf16x8*)(F.lds + cur * 8192 + (ks * 64 + F.lane) * 16);
#pragma unroll
                for (int j = 0; j < 2; ++j) acc[j] = __builtin_amdgcn_mfma_f32_16x16x32_bf16(Af[j][ks], V, acc[j], 0, 0, 0); }
#pragma unroll
            for (int j = 0; j < 2; ++j) *(f32x4*)(Z + ((size_t)(tl * 16 + l15) * 32 + g) * 256 + 16 * (2 * F.wave + j) + 4 * lq) = acc[j];
            if (more) *(LAS bf16x8*)(F.lds + (cur ^ 1) * 8192 + (F.wave * 64 + F.lane) * 16) = nv;
            __syncthreads();
            cur ^= 1;
        }
    }
}
__device__ __forceinline__ int s5_chain_sb(int d, int i) { return d == 0 ? (i < 16 ? 1024 + i : i - 16) : (i < 16 ? 1039 - i : 1023 - (i - 16)); }
__device__ __forceinline__ void s5_scan_phase(Frame& F, int l) {
    LAS float* EX = (LAS float*)F.lds;
    for (int item = F.bid; item < 256; item += F.G) {
        const int cid = item * 16 + (F.tid & 15), j = F.tid >> 4;
        const int g = cid >> 7, d = (cid >> 6) & 1, p = cid & 63;
        const float* A16 = (const float*)(F.ws + WS_A16) + ((size_t)((l * 32 + g) * 2 + d) * 64 + p) * 2; const float ar = A16[0], ai = A16[1];
        const float* Z = (const float*)(F.ws + WS_Z) + (size_t)g * 256 + d * 128 + 2 * p; bf16* SS = (bf16*)(F.ws + WS_SS) + (size_t)g * 256 + d * 128 + 2 * p;
        float2 z[33];
#pragma unroll
        for (int q = 0; q < 33; ++q) { const int i = 33 * j + q; z[q] = i < NSB ? *(const float2*)(Z + (size_t)s5_chain_sb(d, i) * 8192) : make_float2(0.f, 0.f); }
        float hr = 0.f, hi = 0.f, pr = 1.f, pi = 0.f;
#pragma unroll
        for (int q = 0; q < 33; ++q) { if (33 * j + q < NSB) { const float nr = ar * hr - ai * hi + z[q].x, ni = ar * hi + ai * hr + z[q].y; hr = nr; hi = ni; const float qr = pr * ar - pi * ai, qi = pr * ai + pi * ar; pr = qr; pi = qi; } }
        __syncthreads();
        EX[(j * 16 + (F.tid & 15)) * 4 + 0] = hr; EX[(j * 16 + (F.tid & 15)) * 4 + 1] = hi; EX[(j * 16 + (F.tid & 15)) * 4 + 2] = pr; EX[(j * 16 + (F.tid & 15)) * 4 + 3] = pi;
        __syncthreads();
        float cr = 0.f, ci = 0.f;
        for (int i = 0; i < j; ++i) { const float er = EX[(i * 16 + (F.tid & 15)) * 4 + 0], ei = EX[(i * 16 + (F.tid & 15)) * 4 + 1], qr = EX[(i * 16 + (F.tid & 15)) * 4 + 2], qi = EX[(i * 16 + (F.tid & 15)) * 4 + 3];
            const float nr = qr * cr - qi * ci + er, ni = qr * ci + qi * cr + ei; cr = nr; ci = ni; }
        hr = cr; hi = ci;
#pragma unroll
        for (int q = 0; q < 33; ++q) { const int i = 33 * j + q; if (i < NSB) { *(unsigned*)(SS + (size_t)s5_chain_sb(d, i) * 8192) = pk2(hr, hi);
            const float nr = ar * hr - ai * hi + z[q].x, ni = ar * hi + ai * hr + z[q].y; hr = nr; hi = ni; } }
    }
}
__device__ __forceinline__ void s5_y_phase(Frame& F, int l) {
    const bf16* PROJ = (const bf16*)(F.ws + WS_PROJ); const bf16* SS = (const bf16*)(F.ws + WS_SS); bf16* YG = (bf16*)(F.ws + WS_YG); const float* ds = IN_(I_DSKIP) + l * MIXW;
    const int l15 = F.lane & 15, lq = F.lane >> 4;
    for (int item = F.bid; item < 256; item += F.G) {
        const int g = item >> 3, part = item & 7; const bf16* Tm = (const bf16*)(F.ws + WS_S5M) + ((size_t)(l * 32 + g) * 3 + 1) * 65536; const bf16* Em = Tm + 65536;
        bf16x8 At[2][8], Ae[2][8];
#pragma unroll
        for (int j = 0; j < 2; ++j)
#pragma unroll
            for (int ks = 0; ks < 8; ++ks) { const size_t o = (size_t)(16 * (2 * F.wave + j) + l15) * 256 + 32 * ks + 8 * lq; At[j][ks] = *(const bf16x8*)(Tm + o); Ae[j][ks] = *(const bf16x8*)(Em + o); }
        const f32x4 dsk = *(const f32x4*)(ds + 16 * g + 4 * lq);
        const int ntl = l == 0 ? MT / 256 : SEQ / 256;
        const bf16* vsrc = PROJ + (size_t)(16 * l15 + 2 * F.wave + (lq >> 1)) * INW + 16 * g + 8 * (lq & 1);
        const bf16* ssrc = SS + ((size_t)l15 * 32 + g) * 256 + 32 * F.wave + 8 * lq;
        __syncthreads();
        bf16x8 nv = *(const bf16x8*)(vsrc + (size_t)part * 256 * INW), ns = *(const bf16x8*)(ssrc + (size_t)part * 16 * 8192);
        *(LAS bf16x8*)(F.lds + (F.wave * 64 + F.lane) * 16) = nv; *(LAS bf16x8*)(F.lds + 8192 + (F.wave * 64 + F.lane) * 16) = ns;
        __syncthreads();
        int cur = 0;
#pragma unroll 1
        for (int tl = part; tl < ntl; tl += 8) {
            const bool more = tl + 8 < ntl;
            if (more) { nv = *(const bf16x8*)(vsrc + (size_t)(tl + 8) * 256 * INW); ns = *(const bf16x8*)(ssrc + (size_t)(tl + 8) * 16 * 8192); }
            v2u uu[2];
#pragma unroll
            for (int j = 0; j < 2; ++j) uu[j] = *(const v2u*)(PROJ + ((size_t)tl * 256 + 16 * l15 + (2 * F.wave + j)) * INW + 16 * g + 4 * lq);
            f32x4 acc[2] = {{0.f, 0.f, 0.f, 0.f}, {0.f, 0.f, 0.f, 0.f}};
#pragma unroll
            for (int ks = 0; ks < 8; ++ks) { const bf16x8 V = *(const LAS bf16x8*)(F.lds + cur * 16384 + (ks * 64 + F.lane) * 16), S = *(const LAS bf16x8*)(F.lds + cur * 16384 + 8192 + (ks * 64 + F.lane) * 16);
#pragma unroll
                for (int j = 0; j < 2; ++j) { acc[j] = __builtin_amdgcn_mfma_f32_16x16x32_bf16(At[j][ks], V, acc[j], 0, 0, 0); acc[j] = __builtin_amdgcn_mfma_f32_16x16x32_bf16(Ae[j][ks], S, acc[j], 0, 0, 0); } }
#pragma unroll
            for (int j = 0; j < 2; ++j) { const size_t row = (size_t)tl * 256 + 16 * l15 + (2 * F.wave + j); const int ch = 16 * g + 4 * lq; const v2u u = uu[j];
                const float y0 = acc[j][0] + dsk[0] * bflo(u.x), y1 = acc[j][1] + dsk[1] * bfhi(u.x), y2 = acc[j][2] + dsk[2] * bflo(u.y), y3 = acc[j][3] + dsk[3] * bfhi(u.y);
                v2u w; w.x = cvtpk(geluf_(y0), geluf_(y1)); w.y = cvtpk(geluf_(y2), geluf_(y3)); *(v2u*)(YG + row * MIXW + ch) = w; }
            if (more) { *(LAS bf16x8*)(F.lds + (cur ^ 1) * 16384 + (F.wave * 64 + F.lane) * 16) = nv; *(LAS bf16x8*)(F.lds + (cur ^ 1) * 16384 + 8192 + (F.wave * 64 + F.lane) * 16) = ns; }
            __syncthreads();
            cur ^= 1;
        }
    }
}
constexpr int SG_STRIDE = 272, SG_IMG = 256 * SG_STRIDE, SG_STAT = SG_IMG;
__device__ __forceinline__ void sg_fast_chunk(Frame& F, int l, int chunk) {
    const bf16* PROJ = (const bf16*)(F.ws + WS_PROJ); bf16* YB = (bf16*)(F.ws + WS_YS) + (size_t)MT * MIXW; const bf16* WSG = (const bf16*)(F.ws + WS_WSG);
    const float* lg = IN_(I_SGG) + l * MIXW; const float* lb = IN_(I_SGB) + l * MIXW; const float* bsg = IN_(I_BSG) + l * 512;
    LAS float* st = (LAS float*)(F.lds + SG_STAT);
    __syncthreads();
    {
        const int p = F.tid >> 2, part = F.tid & 3; const bf16* vr = PROJ + (size_t)(chunk * 128 + p) * INW + 1024 + part * 128; float s = 0.f, q = 0.f;
#pragma unroll 4
        for (int c = 0; c < 128; c += 8) { const v4u w = *(const v4u*)(vr + c); const float x[8] = {bflo(w.x), bfhi(w.x), bflo(w.y), bfhi(w.y), bflo(w.z), bfhi(w.z), bflo(w.w), bfhi(w.w)};
#pragma unroll
            for (int i = 0; i < 8; ++i) { s += x[i]; q += x[i] * x[i]; } }
        s += __shfl_xor(s, 1); q += __shfl_xor(q, 1); s += __shfl_xor(s, 2); q += __shfl_xor(q, 2);
        const float mu = s * (1.f / 512.f), var = fmaxf(q * (1.f / 512.f) - mu * mu, 0.f);
        if (part == 0) { st[p * 2] = mu; st[p * 2 + 1] = rsqrtf(var + EPS); }
    }
    const int l15 = F.lane & 15, lq = F.lane >> 4;
#pragma unroll 1
    for (int pass = 0; pass < 2; ++pass) {
        __syncthreads();
#pragma unroll 1
        for (int it = F.tid; it < 2048; it += NT) { const int tp = it & 63, cg = it >> 6; const int p0 = tp * 2, ch = pass * 256 + cg * 8;
            const v4u w0 = *(const v4u*)(PROJ + (size_t)(chunk * 128 + p0) * INW + 1024 + ch), w1 = *(const v4u*)(PROJ + (size_t)(chunk * 128 + p0 + 1) * INW + 1024 + ch);
            const float mu0 = st[p0 * 2], rs0 = st[p0 * 2 + 1], mu1 = st[p0 * 2 + 2], rs1 = st[p0 * 2 + 3];
            const float x0[8] = {bflo(w0.x), bfhi(w0.x), bflo(w0.y), bfhi(w0.y), bflo(w0.z), bfhi(w0.z), bflo(w0.w), bfhi(w0.w)};
            const float x1[8] = {bflo(w1.x), bfhi(w1.x), bflo(w1.y), bfhi(w1.y), bflo(w1.z), bfhi(w1.z), bflo(w1.w), bfhi(w1.w)};
#pragma unroll
            for (int i = 0; i < 8; ++i) { const float gm = lg[ch + i], bt = lb[ch + i];
                *(LAS unsigned*)(F.lds + (cg * 8 + i) * SG_STRIDE + p0 * 2) = pk2((x0[i] - mu0) * rs0 * gm + bt, (x1[i] - mu1) * rs1 * gm + bt); } }
        __syncthreads();
        const int ggl = F.wave >> 2, gg = pass * 2 + ggl, rb0 = (F.wave & 3) * 2;
        bf16x8 A[2][4];
#pragma unroll
        for (int j = 0; j < 2; ++j)
#pragma unroll
            for (int ks = 0; ks < 4; ++ks) A[j][ks] = *(const LAS bf16x8*)(F.lds + (ggl * 128 + (rb0 + j) * 16 + l15) * SG_STRIDE + (32 * ks + 8 * lq) * 2);
        f32x4 acc[2][8];
#pragma unroll
        for (int j = 0; j < 2; ++j)
#pragma unroll
            for (int cb = 0; cb < 8; ++cb) acc[j][cb] = (f32x4){0.f, 0.f, 0.f, 0.f};
#pragma unroll
        for (int cb = 0; cb < 8; ++cb) {
            bf16x8 B[4];
#pragma unroll
            for (int ks = 0; ks < 4; ++ks) B[ks] = *(const bf16x8*)(WSG + ((size_t)gg * 128 + cb * 16 + l15) * 128 + 32 * ks + 8 * lq);
#pragma unroll
            for (int ks = 0; ks < 4; ++ks)
#pragma unroll
                for (int j = 0; j < 2; ++j) acc[j][cb] = __builtin_amdgcn_mfma_f32_16x16x32_bf16(A[j][ks], B[ks], acc[j][cb], 0, 0, 0);
        }
#pragma unroll
        for (int cb = 0; cb < 8; ++cb) { const int q = cb * 16 + l15; const size_t row = (size_t)chunk * 128 + q; const float bq = bsg[gg * 128 + q];
#pragma unroll
            for (int j = 0; j < 2; ++j) { const int col = gg * 128 + (rb0 + j) * 16 + 4 * lq; const v2u gu = *(const v2u*)(PROJ + row * INW + 512 + col);
                v2u w; w.x = cvtpk(bflo(gu.x) * (acc[j][cb][0] + bq), bfhi(gu.x) * (acc[j][cb][1] + bq)); w.y = cvtpk(bflo(gu.y) * (acc[j][cb][2] + bq), bfhi(gu.y) * (acc[j][cb][3] + bq));
                *(v2u*)(YB + row * MIXW + col) = w; } }
    }
}


__device__ __forceinline__ void thin_acc(f32x4 (&acc)[2], const bf16* A, int lda, const bf16* Bt, int K, int wave, int lane) {
    const int r = lane & 15, q = lane >> 4; const bf16* a0 = A + (size_t)(32 * wave + r) * lda + 8 * q; const bf16* a1 = a0 + (size_t)16 * lda; const bf16* b = Bt + (size_t)r * K + 8 * q;
#pragma unroll 8
    for (int ks = 0; ks < K / 32; ++ks) { const bf16x8 x0 = *(const bf16x8*)(a0 + 32 * ks), x1 = *(const bf16x8*)(a1 + 32 * ks), w = *(const bf16x8*)(b + 32 * ks);
        acc[0] = __builtin_amdgcn_mfma_f32_16x16x32_bf16(x0, w, acc[0], 0, 0, 0); acc[1] = __builtin_amdgcn_mfma_f32_16x16x32_bf16(x1, w, acc[1], 0, 0, 0); }
}
#define THIN_FOREACH(acc, body) _Pragma("unroll") for (int _j = 0; _j < 2; ++_j) _Pragma("unroll") for (int _i = 0; _i < 4; ++_i) { const int crow = 32 * F.wave + 16 * _j + 4 * (F.lane >> 4) + _i; const float v = acc[_j][_i]; body }
__device__ __forceinline__ void ph2_ctx(Frame& F, int ncols) {
    const bf16* Hc = (const bf16*)(F.ws + WS_H) + (size_t)SEQ * D; bf16* P = (bf16*)(F.ws + WS_PROJ) + (size_t)SEQ * INW; const bf16* W = (const bf16*)(F.ws + WS_WIN);
    for (int it = F.bid; it < ncols / 16; it += F.G) { const int col = it * 16 + (F.lane & 15); f32x4 acc[2] = {{0.f, 0.f, 0.f, 0.f}, {0.f, 0.f, 0.f, 0.f}};
        thin_acc(acc, Hc, D, W + (size_t)it * 16 * D, D, F.wave, F.lane);
        THIN_FOREACH(acc, { const float o = (col >= 512 && col < 1536) ? geluf_(v) : v; P[(size_t)crow * INW + col] = (bf16)f2bf(o); }) }
}
__device__ __forceinline__ void ph6_ctx(Frame& F) {
    const bf16* YGc = (const bf16*)(F.ws + WS_YG) + (size_t)SEQ * MIXW; bf16* YA = (bf16*)(F.ws + WS_YS) + (size_t)SEQ * MIXW; const bf16* W = (const bf16*)(F.ws + WS_WGLU);
    for (int it = F.bid; it < MIXW / 16; it += F.G) { const int col = it * 16 + (F.lane & 15); f32x4 acc[2] = {{0.f, 0.f, 0.f, 0.f}, {0.f, 0.f, 0.f, 0.f}};
        thin_acc(acc, YGc, MIXW, W + (size_t)it * 16 * MIXW, MIXW, F.wave, F.lane);
        THIN_FOREACH(acc, { YA[(size_t)crow * MIXW + col] = (bf16)f2bf(bf2f(YGc[(size_t)crow * MIXW + col]) * sigmoidf_(v)); }) }
}
__device__ __forceinline__ void ph7_ctx(Frame& F) {
    bf16* BR = (bf16*)(F.ws + WS_PROJ) + (size_t)SEQ * INW;
    for (int it = F.bid; it < 3 * (D / 16); it += F.G) { const int kk = it / (D / 16), cb = it % (D / 16); const int col = cb * 16 + (F.lane & 15); f32x4 acc[2] = {{0.f, 0.f, 0.f, 0.f}, {0.f, 0.f, 0.f, 0.f}};
        thin_acc(acc, (const bf16*)(F.ws + WS_YS) + ((size_t)kk * MT + SEQ) * MIXW, MIXW, (const bf16*)(F.ws + WS_WBR) + ((size_t)kk * 1024 + cb * 16) * MIXW, MIXW, F.wave, F.lane);
        THIN_FOREACH(acc, { BR[(size_t)crow * INW + kk * 1024 + col] = (bf16)f2bf(v); }) }
}
__device__ __forceinline__ void ph8_ctx(Frame& F, int l) {
    const bf16* Hc = (const bf16*)(F.ws + WS_H) + (size_t)SEQ * D; const bf16* BR = (const bf16*)(F.ws + WS_PROJ) + (size_t)SEQ * INW; bf16* PM = (bf16*)(F.ws + WS_PM) + (size_t)SEQ * D; const float* bm = IN_(I_BMG) + l * INW;
    for (int it = F.bid; it < D / 16; it += F.G) { const int col = it * 16 + (F.lane & 15); float p[2][4] = {};
#pragma unroll 1
        for (int kk = 0; kk < 3; ++kk) { f32x4 acc[2] = {{0.f, 0.f, 0.f, 0.f}, {0.f, 0.f, 0.f, 0.f}};
            thin_acc(acc, Hc, D, (const bf16*)(F.ws + WS_WMG) + ((size_t)kk * 1024 + it * 16) * D, D, F.wave, F.lane);
            const float bb = bm[kk * 1024 + col];
            THIN_FOREACH(acc, { p[_j][_i] += sigmoidf_(v + bb) * bf2f(BR[(size_t)crow * INW + kk * 1024 + col]); }) }
#pragma unroll
        for (int j = 0; j < 2; ++j)
#pragma unroll
            for (int i = 0; i < 4; ++i) PM[(size_t)(32 * F.wave + 16 * j + 4 * (F.lane >> 4) + i) * D + col] = (bf16)f2bf(p[j][i]); }
}
__device__ __forceinline__ void ph9_ctx(Frame& F, int l) {
    const bf16* PMc = (const bf16*)(F.ws + WS_PM) + (size_t)SEQ * D; float* XC = (float*)(F.ws + WS_XC); const float* xs = l == 0 ? IN_(I_CTX) : (const float*)(F.ws + WS_XC);
    const float* ga = (const float*)(F.ws + WS_MOD) + (size_t)(l * 2 + 1) * 6144 + 2048;
    for (int it = F.bid; it < D / 16; it += F.G) { const int col = it * 16 + (F.lane & 15); f32x4 acc[2] = {{0.f, 0.f, 0.f, 0.f}, {0.f, 0.f, 0.f, 0.f}};
        thin_acc(acc, PMc, D, (const bf16*)(F.ws + WS_WO) + (size_t)it * 16 * D, D, F.wave, F.lane);
        const float gc = ga[col];
        THIN_FOREACH(acc, { XC[(size_t)crow * D + col] = xs[(size_t)crow * D + col] + gc * v; }) }
}

struct NSmem { float As[16][68]; float Bs[16][68]; };
template <class AF>
__device__ __forceinline__ void ngemm_acc(float (&acc)[4][4], const AF& af, const float* B, int ldb, int K, LAS NSmem* s, int t) {
    const int ty = t >> 4, tx = t & 15, lr = t >> 2, lk = (t & 3) * 4, bk = t >> 4, bn = (t & 15) * 4;
    for (int k0 = 0; k0 < K; k0 += 16) {
        const float4 av = af.load4(lr, k0 + lk);
        const float4 bv = *(const float4*)(B + (size_t)(k0 + bk) * ldb + bn);
        __syncthreads();
        s->As[lk + 0][lr] = av.x; s->As[lk + 1][lr] = av.y; s->As[lk + 2][lr] = av.z; s->As[lk + 3][lr] = av.w;
        *(LAS f32x4*)&s->Bs[bk][bn] = (f32x4){bv.x, bv.y, bv.z, bv.w};
        __syncthreads();
#pragma unroll
        for (int k = 0; k < 16; ++k) {
            const f32x4 a = *(const LAS f32x4*)&s->As[k][ty * 4]; const f32x4 b = *(const LAS f32x4*)&s->Bs[k][tx * 4];
            const float aa[4] = {a.x, a.y, a.z, a.w}, bb[4] = {b.x, b.y, b.z, b.w};
#pragma unroll
            for (int i = 0; i < 4; ++i)
#pragma unroll
                for (int j = 0; j < 4; ++j) acc[i][j] += aa[i] * bb[j];
        }
    }
}
struct ABf { const bf16* A; int lda; __device__ __forceinline__ float4 load4(int r, int k) const { const v2u w = *(const v2u*)(A + (size_t)r * lda + k);
    return make_float4(bf2f((unsigned short)(w.x & 0xffff)), bf2f((unsigned short)(w.x >> 16)), bf2f((unsigned short)(w.y & 0xffff)), bf2f((unsigned short)(w.y >> 16))); } };
#define NTILE_BEGIN(ntiles) { const int _half = F.tid >> 8, t = F.tid & 255, ty = t >> 4, tx = t & 15; LAS NSmem* sm = (LAS NSmem*)F.lds + _half; (void)ty; (void)tx; \
    const int _nt = (ntiles), _nit = (_nt + 2 * F.G - 1) / (2 * F.G); \
    for (int _it = 0; _it < _nit; ++_it) { int T = (_it * F.G + F.bid) * 2 + _half; const bool valid = T < _nt; if (!valid) T = _nt - 1;
#define NTILE_END } }

__device__ __forceinline__ void ph0_prologue(Frame& F) {
    float* mod = (float*)(F.ws + WS_MOD);
    LAS float* SV = (LAS float*)(F.lds + 131072 + 4096);
    for (int i = F.tid; i < 2048; i += NT) SV[i] = siluf_(i < 1024 ? IN_(I_C)[i] : IN_(I_CCTX)[i - 1024]);
    __syncthreads();
    LAS float* RED = (LAS float*)(F.lds + 131072 + 4096 + 8192);
    for (int it = F.bid; it < 2 * 96; it += F.G) { const int l = it / 96, j = (it % 96) * 64 + F.lane;
        const float* W = IN_(I_WADA) + (size_t)l * D * 6144 + j + (size_t)(F.wave * 128) * 6144;
        float a0 = 0.f, a1 = 0.f;
#pragma unroll 32
        for (int kk = 0; kk < 128; ++kk) { const float w = W[(size_t)kk * 6144]; a0 += SV[F.wave * 128 + kk] * w; a1 += SV[1024 + F.wave * 128 + kk] * w; }
        __syncthreads();
        RED[(F.wave * 2 + 0) * 64 + F.lane] = a0; RED[(F.wave * 2 + 1) * 64 + F.lane] = a1;
        __syncthreads();
        if (F.wave < 2) { float s = 0.f;
#pragma unroll
            for (int w8 = 0; w8 < 8; ++w8) s += RED[(w8 * 2 + F.wave) * 64 + F.lane];
            mod[(size_t)(l * 2 + F.wave) * 6144 + j] = s + IN_(I_BADA)[l * 6144 + j]; }
    }
}
__device__ __forceinline__ void hprep_rows(Frame& F, int l) {
    bf16* H = (bf16*)(F.ws + WS_H); const float* g = IN_(I_GMIX) + l * D;
    const int gw = F.bid * (NT / 64) + F.wave, ngw = F.G * (NT / 64);
    for (int row = gw; row < MT; row += ngw) {
        const float* m = mod_ptr(F, l, row); const float* xr = xsrc_row(F, l, row);
        f32x4 v[4]; float s = 0.f;
#pragma unroll
        for (int j = 0; j < 4; ++j) { v[j] = *(const f32x4*)(xr + 4 * F.lane + 256 * j); s += v[j].x * v[j].x + v[j].y * v[j].y + v[j].z * v[j].z + v[j].w * v[j].w; }
        const float rstd = rsqrtf(wave_sum(s) * (1.f / D) + EPS);
#pragma unroll
        for (int j = 0; j < 4; ++j) { const int c = 4 * F.lane + 256 * j; const f32x4 gg = *(const f32x4*)(g + c), sc = *(const f32x4*)(m + 1024 + c), sh = *(const f32x4*)(m + c);
            const f32x4 o = v[j] * rstd * gg * (1.f + sc) + sh; v2u w; w.x = pk2(o.x, o.y); w.y = pk2(o.z, o.w); *(v2u*)(H + (size_t)row * D + c) = w; }
    }
}
__device__ __forceinline__ void ph2_naive(Frame& F, int l) {
    const bf16* H = (const bf16*)(F.ws + WS_H); bf16* PROJ = (bf16*)(F.ws + WS_PROJ); const float* W = IN_(I_WIN) + (size_t)l * D * INW;
    NTILE_BEGIN((MT / 64) * (INW / 64))
        const int m0 = (T / (INW / 64)) * 64, n0 = (T % (INW / 64)) * 64;
        float acc[4][4] = {};
        ngemm_acc(acc, ABf{H + (size_t)m0 * D, D}, W + n0, INW, D, sm, t);
        if (valid) {
#pragma unroll
            for (int i = 0; i < 4; ++i) { float o[4];
#pragma unroll
                for (int j = 0; j < 4; ++j) { o[j] = acc[i][j]; if (n0 >= 512 && n0 < 1536) o[j] = geluf_(o[j]); }
                v2u w; w.x = pk2(o[0], o[1]); w.y = pk2(o[2], o[3]); *(v2u*)(PROJ + (size_t)(m0 + ty * 4 + i) * INW + n0 + tx * 4) = w; }
        }
    NTILE_END
}
__device__ __forceinline__ int chain_row(int dir, int pos) { return dir == 0 ? (pos < CTX ? SEQ + pos : pos - CTX) : (pos < CTX ? SEQ + CTX - 1 - pos : SEQ - 1 - (pos - CTX)); }
__device__ __forceinline__ void ph3_s5_naive(Frame& F, int l) {
    LAS float* Cr = (LAS float*)(F.lds + 32768); LAS float* Ci = Cr + 1024; LAS float* Sr = Ci + 1024; LAS float* Si = Sr + 2048;
    const bf16* PROJ = (const bf16*)(F.ws + WS_PROJ); float* YD = (float*)(F.ws + WS_S5);
    for (int item = F.bid; item < 64; item += F.G) {
        if (F.wave == 0) {
            const int g = item >> 1, dir = item & 1, p = F.lane;
            const int ldg = ((l * 2 + dir) * G5 + g);
            const float lr = IN_(I_LRE)[ldg * P5 + p], li = IN_(I_LIM)[ldg * P5 + p], dt = expf(IN_(I_LDT)[ldg]);
            const float er = expf(lr * dt), ar = er * cosf(li * dt), ai = er * sinf(li * dt);
            const float nr = ar - 1.f, ni = ai, den = lr * lr + li * li;
            const float qr = (nr * lr + ni * li) / den, qi = (ni * lr - nr * li) / den;
            float br[16], bi[16];
#pragma unroll
            for (int h = 0; h < 16; ++h) { const float x = IN_(I_BRE)[((size_t)ldg * P5 + p) * H5 + h], y = IN_(I_BIM)[((size_t)ldg * P5 + p) * H5 + h]; br[h] = qr * x - qi * y; bi[h] = qr * y + qi * x; }
            for (int h = 0; h < 16; ++h) { Cr[h * 64 + p] = IN_(I_CRE)[((size_t)ldg * H5 + h) * P5 + p]; Ci[h * 64 + p] = IN_(I_CIM)[((size_t)ldg * H5 + h) * P5 + p]; }
            float sr = 0.f, si = 0.f;
            float* Y = YD + (size_t)dir * MT * MIXW;
#pragma unroll 1
            for (int blk = 0; blk < MT / 32; ++blk) {
#pragma unroll 1
                for (int tt = 0; tt < 32; ++tt) {
                    const int row = chain_row(dir, blk * 32 + tt);
                    const v4u u0 = *(const v4u*)(PROJ + (size_t)row * INW + g * 16), u1 = *(const v4u*)(PROJ + (size_t)row * INW + g * 16 + 8);
                    const unsigned uw[8] = {u0.x, u0.y, u0.z, u0.w, u1.x, u1.y, u1.z, u1.w};
                    float xr = 0.f, xi = 0.f;
#pragma unroll
                    for (int h = 0; h < 8; ++h) { const float ua = bf2f((unsigned short)(uw[h] & 0xffff)), ub = bf2f((unsigned short)(uw[h] >> 16));
                        xr += br[2 * h] * ua + br[2 * h + 1] * ub; xi += bi[2 * h] * ua + bi[2 * h + 1] * ub; }
                    const float nsr = ar * sr - ai * si + xr, nsi = ar * si + ai * sr + xi;
                    sr = nsr; si = nsi; Sr[tt * 64 + p] = sr; Si[tt * 64 + p] = si;
                }
                asm volatile("s_waitcnt lgkmcnt(0)" ::: "memory");
#pragma unroll 1
                for (int o = p; o < 512; o += 64) {
                    const int tt = o >> 4, h = o & 15; float a = 0.f;
#pragma unroll 4
                    for (int q = 0; q < 64; ++q) a += Cr[h * 64 + q] * Sr[tt * 64 + q] - Ci[h * 64 + q] * Si[tt * 64 + q];
                    Y[(size_t)chain_row(dir, blk * 32 + tt) * MIXW + g * 16 + h] = a;
                }
                asm volatile("s_waitcnt lgkmcnt(0)" ::: "memory");
            }
        }
    }
}
__device__ __forceinline__ void ph3_sg_naive(Frame& F, int l) {
    const bf16* PROJ = (const bf16*)(F.ws + WS_PROJ); bf16* YB = (bf16*)(F.ws + WS_YS) + (size_t)MT * MIXW;
    LAS float* stat = (LAS float*)(F.lds + 32768);
    const float* lg = IN_(I_SGG) + l * MIXW; const float* lb = IN_(I_SGB) + l * MIXW;
    NTILE_BEGIN((MT / 128) * 16)
        const int chunk = T >> 4, gg = (T >> 2) & 3, q0 = ((T >> 1) & 1) * 64, c0 = (T & 1) * 64;
        LAS float* st = stat + _half * 256;
        __syncthreads();
        if (t < 128) { const bf16* vr = PROJ + (size_t)(chunk * 128 + t) * INW + 1024; float s = 0.f;
            for (int c = 0; c < 512; c += 2) { const unsigned w = *(const unsigned*)(vr + c); s += bf2f((unsigned short)(w & 0xffff)) + bf2f((unsigned short)(w >> 16)); }
            const float mu = s * (1.f / 512.f); float q = 0.f;
            for (int c = 0; c < 512; c += 2) { const unsigned w = *(const unsigned*)(vr + c); const float a = bf2f((unsigned short)(w & 0xffff)) - mu, b = bf2f((unsigned short)(w >> 16)) - mu; q += a * a + b * b; }
            st[t * 2] = mu; st[t * 2 + 1] = rsqrtf(q * (1.f / 512.f) + EPS); }
        __syncthreads();
        float acc[4][4] = {};
        {
            const float* A = IN_(I_WSG) + ((size_t)(l * 4 + gg) * 128 + q0) * 128;
            const int lr = t >> 2, lk = (t & 3) * 4, bk = t >> 4, bn = (t & 15) * 4;
            for (int k0 = 0; k0 < 128; k0 += 16) {
                const float4 av = *(const float4*)(A + (size_t)lr * 128 + k0 + lk);
                const int p = k0 + bk; const int col = gg * 128 + c0 + bn;
                const v2u w = *(const v2u*)(PROJ + (size_t)(chunk * 128 + p) * INW + 1024 + col);
                const float mu = st[p * 2], rs = st[p * 2 + 1];
                float4 bv; bv.x = (bf2f((unsigned short)(w.x & 0xffff)) - mu) * rs * lg[col] + lb[col]; bv.y = (bf2f((unsigned short)(w.x >> 16)) - mu) * rs * lg[col + 1] + lb[col + 1];
                bv.z = (bf2f((unsigned short)(w.y & 0xffff)) - mu) * rs * lg[col + 2] + lb[col + 2]; bv.w = (bf2f((unsigned short)(w.y >> 16)) - mu) * rs * lg[col + 3] + lb[col + 3];
                __syncthreads();
                sm->As[lk + 0][lr] = av.x; sm->As[lk + 1][lr] = av.y; sm->As[lk + 2][lr] = av.z; sm->As[lk + 3][lr] = av.w;
                *(LAS f32x4*)&sm->Bs[bk][bn] = (f32x4){bv.x, bv.y, bv.z, bv.w};
                __syncthreads();
#pragma unroll
                for (int k = 0; k < 16; ++k) { const f32x4 a = *(const LAS f32x4*)&sm->As[k][ty * 4]; const f32x4 b = *(const LAS f32x4*)&sm->Bs[k][tx * 4];
                    const float aa[4] = {a.x, a.y, a.z, a.w}, bb[4] = {b.x, b.y, b.z, b.w};
#pragma unroll
                    for (int i = 0; i < 4; ++i)
#pragma unroll
                        for (int j = 0; j < 4; ++j) acc[i][j] += aa[i] * bb[j]; }
            }
        }
        if (valid) {
#pragma unroll
            for (int i = 0; i < 4; ++i) { const int q = q0 + ty * 4 + i; const size_t row = (size_t)chunk * 128 + q; const int col = gg * 128 + c0 + tx * 4;
                const float bq = IN_(I_BSG)[l * 512 + gg * 128 + q];
                const v2u gu = *(const v2u*)(PROJ + row * INW + 512 + col);
                v2u w; w.x = pk2(bf2f((unsigned short)(gu.x & 0xffff)) * (acc[i][0] + bq), bf2f((unsigned short)(gu.x >> 16)) * (acc[i][1] + bq));
                w.y = pk2(bf2f((unsigned short)(gu.y & 0xffff)) * (acc[i][2] + bq), bf2f((unsigned short)(gu.y >> 16)) * (acc[i][3] + bq));
                *(v2u*)(YB + row * MIXW + col) = w; }
        }
    NTILE_END
}
__device__ __forceinline__ void ph3_conv(Frame& F, int l, int nrows) {
    const bf16* PROJ = (const bf16*)(F.ws + WS_PROJ); bf16* YC = (bf16*)(F.ws + WS_YS) + (size_t)2 * MT * MIXW; const float* wc = IN_(I_WCONV) + l * 3 * MIXW;
    const size_t gt = (size_t)F.bid * NT + F.tid, ngt = (size_t)F.G * NT;
#pragma unroll 2
    for (size_t i = gt; i < (size_t)nrows * (MIXW / 8); i += ngt) {
        const int row = (int)(i / (MIXW / 8)), c = (int)(i % (MIXW / 8)) * 8;
        int pos, rl; if (row < SEQ) { pos = row & 63; rl = 64; } else { pos = row - SEQ; rl = 256; }
        const bf16* r0 = PROJ + (size_t)row * INW + 1536 + c;
        const v4u zero = {0u, 0u, 0u, 0u};
        const v4u b0 = *(const v4u*)(r0), c0 = *(const v4u*)(r0 + 512), h0 = *(const v4u*)(r0 + 1024);
        const v4u cm = pos > 0 ? *(const v4u*)(r0 - INW + 512) : zero, hm = pos > 0 ? *(const v4u*)(r0 - INW + 1024) : zero;
        const v4u cp = pos < rl - 1 ? *(const v4u*)(r0 + INW + 512) : zero, hp = pos < rl - 1 ? *(const v4u*)(r0 + INW + 1024) : zero;
        const f32x4 w0a = *(const f32x4*)(wc + c), w0b = *(const f32x4*)(wc + c + 4), w1a = *(const f32x4*)(wc + 512 + c), w1b = *(const f32x4*)(wc + 512 + c + 4), w2a = *(const f32x4*)(wc + 1024 + c), w2b = *(const f32x4*)(wc + 1024 + c + 4);
        const float w0[8] = {w0a.x, w0a.y, w0a.z, w0a.w, w0b.x, w0b.y, w0b.z, w0b.w}, w1[8] = {w1a.x, w1a.y, w1a.z, w1a.w, w1b.x, w1b.y, w1b.z, w1b.w}, w2[8] = {w2a.x, w2a.y, w2a.z, w2a.w, w2b.x, w2b.y, w2b.z, w2b.w};
        const unsigned bb[4] = {b0.x, b0.y, b0.z, b0.w}, cc[4] = {c0.x, c0.y, c0.z, c0.w}, hh[4] = {h0.x, h0.y, h0.z, h0.w}, cmv[4] = {cm.x, cm.y, cm.z, cm.w}, hmv[4] = {hm.x, hm.y, hm.z, hm.w}, cpv[4] = {cp.x, cp.y, cp.z, cp.w}, hpv[4] = {hp.x, hp.y, hp.z, hp.w};
        unsigned o[4];
#pragma unroll
        for (int j = 0; j < 4; ++j) {
            const float ylo = bflo(bb[j]) * (w0[2 * j] * (bflo(cmv[j]) * bflo(hmv[j])) + w1[2 * j] * (bflo(cc[j]) * bflo(hh[j])) + w2[2 * j] * (bflo(cpv[j]) * bflo(hpv[j])));
            const float yhi = bfhi(bb[j]) * (w0[2 * j + 1] * (bfhi(cmv[j]) * bfhi(hmv[j])) + w1[2 * j + 1] * (bfhi(cc[j]) * bfhi(hh[j])) + w2[2 * j + 1] * (bfhi(cpv[j]) * bfhi(hpv[j])));
            o[j] = pk2(ylo, yhi); }
        v4u ov; ov.x = o[0]; ov.y = o[1]; ov.z = o[2]; ov.w = o[3]; *(v4u*)(YC + (size_t)row * MIXW + c) = ov;
    }
}
__device__ __forceinline__ void ph5_naive(Frame& F, int l) {
    const bf16* PROJ = (const bf16*)(F.ws + WS_PROJ); const float* YD = (const float*)(F.ws + WS_S5); bf16* YG = (bf16*)(F.ws + WS_YG); const float* ds = IN_(I_DSKIP) + l * MIXW;
    const size_t gt = (size_t)F.bid * NT + F.tid, ngt = (size_t)F.G * NT;
    for (size_t i = gt; i < (size_t)MT * (MIXW / 2); i += ngt) {
        const int row = (int)(i / (MIXW / 2)), c = (int)(i % (MIXW / 2)) * 2;
        const unsigned u = *(const unsigned*)(PROJ + (size_t)row * INW + c); const size_t o = (size_t)row * MIXW + c;
        const float y0 = YD[o] + YD[(size_t)MT * MIXW + o] + ds[c] * bf2f((unsigned short)(u & 0xffff)), y1 = YD[o + 1] + YD[(size_t)MT * MIXW + o + 1] + ds[c + 1] * bf2f((unsigned short)(u >> 16));
        *(unsigned*)(YG + o) = pk2(geluf_(y0), geluf_(y1));
    }
}
__device__ __forceinline__ void ph6_naive(Frame& F, int l) {
    const bf16* YG = (const bf16*)(F.ws + WS_YG); bf16* YA = (bf16*)(F.ws + WS_YS); const float* W = IN_(I_WGLU) + (size_t)l * MIXW * MIXW;
    NTILE_BEGIN((MT / 64) * (MIXW / 64))
        const int m0 = (T / (MIXW / 64)) * 64, n0 = (T % (MIXW / 64)) * 64;
        float acc[4][4] = {};
        ngemm_acc(acc, ABf{YG + (size_t)m0 * MIXW, MIXW}, W + n0, MIXW, MIXW, sm, t);
        if (valid) {
#pragma unroll
            for (int i = 0; i < 4; ++i) { const size_t o = (size_t)(m0 + ty * 4 + i) * MIXW + n0 + tx * 4; const v2u g = *(const v2u*)(YG + o);
                v2u w; w.x = pk2(bf2f((unsigned short)(g.x & 0xffff)) * sigmoidf_(acc[i][0]), bf2f((unsigned short)(g.x >> 16)) * sigmoidf_(acc[i][1]));
                w.y = pk2(bf2f((unsigned short)(g.y & 0xffff)) * sigmoidf_(acc[i][2]), bf2f((unsigned short)(g.y >> 16)) * sigmoidf_(acc[i][3])); *(v2u*)(YA + o) = w; }
        }
    NTILE_END
}
__device__ __forceinline__ void ph7_naive(Frame& F, int l) {
    const bf16* YS = (const bf16*)(F.ws + WS_YS); bf16* BR = (bf16*)(F.ws + WS_PROJ); const float* W = IN_(I_WBR) + (size_t)l * 3 * MIXW * D;
    NTILE_BEGIN((MT / 64) * (INW / 64))
        const int m0 = (T / (INW / 64)) * 64, n0 = (T % (INW / 64)) * 64, k = n0 / 1024, d0 = n0 % 1024;
        float acc[4][4] = {};
        ngemm_acc(acc, ABf{YS + (size_t)k * MT * MIXW + (size_t)m0 * MIXW, MIXW}, W + (size_t)k * MIXW * D + d0, D, MIXW, sm, t);
        if (valid) {
#pragma unroll
            for (int i = 0; i < 4; ++i) { v2u w; w.x = pk2(acc[i][0], acc[i][1]); w.y = pk2(acc[i][2], acc[i][3]); *(v2u*)(BR + (size_t)(m0 + ty * 4 + i) * INW + n0 + tx * 4) = w; }
        }
    NTILE_END
}
__device__ __forceinline__ void ph8_naive(Frame& F, int l) {
    const bf16* H = (const bf16*)(F.ws + WS_H); const bf16* BR = (const bf16*)(F.ws + WS_PROJ); bf16* PM = (bf16*)(F.ws + WS_PM);
    const float* W = IN_(I_WMG) + (size_t)l * D * INW; const float* bm = IN_(I_BMG) + l * INW;
    NTILE_BEGIN((MT / 64) * (D / 64))
        const int m0 = (T / (D / 64)) * 64, n0 = (T % (D / 64)) * 64;
        float out[4][4] = {};
        for (int k = 0; k < 3; ++k) {
            float acc[4][4] = {};
            ngemm_acc(acc, ABf{H + (size_t)m0 * D, D}, W + k * 1024 + n0, INW, D, sm, t);
#pragma unroll
            for (int i = 0; i < 4; ++i) { const v2u b = *(const v2u*)(BR + (size_t)(m0 + ty * 4 + i) * INW + k * 1024 + n0 + tx * 4);
                const float bb[4] = {bf2f((unsigned short)(b.x & 0xffff)), bf2f((unsigned short)(b.x >> 16)), bf2f((unsigned short)(b.y & 0xffff)), bf2f((unsigned short)(b.y >> 16))};
#pragma unroll
                for (int j = 0; j < 4; ++j) out[i][j] += sigmoidf_(acc[i][j] + bm[k * 1024 + n0 + tx * 4 + j]) * bb[j]; }
        }
        if (valid) {
#pragma unroll
            for (int i = 0; i < 4; ++i) { v2u w; w.x = pk2(out[i][0], out[i][1]); w.y = pk2(out[i][2], out[i][3]); *(v2u*)(PM + (size_t)(m0 + ty * 4 + i) * D + n0 + tx * 4) = w; }
        }
    NTILE_END
}
__device__ __forceinline__ void ph9_naive(Frame& F, int l) {
    const bf16* PM = (const bf16*)(F.ws + WS_PM); const float* W = IN_(I_WO) + (size_t)l * D * D;
    NTILE_BEGIN((MT / 64) * (D / 64))
        const int m0 = (T / (D / 64)) * 64, n0 = (T % (D / 64)) * 64;
        float acc[4][4] = {};
        ngemm_acc(acc, ABf{PM + (size_t)m0 * D, D}, W + n0, D, D, sm, t);
        if (valid) {
#pragma unroll
            for (int i = 0; i < 4; ++i) { const int row = m0 + ty * 4 + i, c = n0 + tx * 4; const float* m = mod_ptr(F, l, row) + 2048 + c;
                const f32x4 xs = *(const f32x4*)(xsrc_row(F, l, row) + c);
                f32x4 o; o.x = xs.x + m[0] * acc[i][0]; o.y = xs.y + m[1] * acc[i][1]; o.z = xs.z + m[2] * acc[i][2]; o.w = xs.w + m[3] * acc[i][3];
                *(f32x4*)(xrun_row(F, row) + c) = o; }
        }
    NTILE_END
}
template <int KS>
__device__ __forceinline__ void route_pass(Frame& F, int l, int u, bool valid, int kh, int sl, LAS float* GC, LAS float* SH, LAS float* SSQ, LAS float* LG, LAS int* HISTL) {
    bf16* H = (bf16*)(F.ws + WS_H); const bf16* WRh = (const bf16*)(F.ws + WS_WR); const bf16* WRl = WRh + 48 * 1024;
    const float* bg = IN_(I_BGRP) + l * 4; const float* be = IN_(I_BEXP) + l * 32;
    int* EID = (int*)(F.ws + WS_EID); float* EW = (float*)(F.ws + WS_EW);
    constexpr int NK = 32 / KS, KW = 1024 / KS;
    const int r = F.lane & 15, q = F.lane >> 4;
    const int uu = valid ? u : 0; const int row = uu * 16 + r; const float* xr = xrun_row(F, row) + kh * KW + 8 * q; const int pv = (row >= SEQ ? 1024 : 0) + kh * KW + 8 * q;
    float s = 0.f;
#pragma unroll
    for (int ks = 0; ks < NK; ++ks) { const f32x4 a = *(const f32x4*)(xr + 32 * ks), b = *(const f32x4*)(xr + 32 * ks + 4); s += a.x * a.x + a.y * a.y + a.z * a.z + a.w * a.w + b.x * b.x + b.y * b.y + b.z * b.z + b.w * b.w; }
    s += __shfl_xor(s, 16); s += __shfl_xor(s, 32);
    __syncthreads();
    if (q == 0) SSQ[(sl * KS + kh) * 16 + r] = s;
    __syncthreads();
    float tot = 0.f;
#pragma unroll
    for (int i = 0; i < KS; ++i) tot += SSQ[(sl * KS + i) * 16 + r];
    const float rstd = rsqrtf(tot * (1.f / D) + EPS);
    f32x4 acc[3] = {{0.f, 0.f, 0.f, 0.f}, {0.f, 0.f, 0.f, 0.f}, {0.f, 0.f, 0.f, 0.f}};
#pragma unroll 4
    for (int ks = 0; ks < NK; ++ks) {
        const int c = 32 * ks;
        const f32x4 x0 = *(const f32x4*)(xr + c), x1 = *(const f32x4*)(xr + c + 4);
        const f32x4 g0 = *(const LAS f32x4*)(GC + pv + c), g1 = *(const LAS f32x4*)(GC + pv + c + 4), sh0 = *(const LAS f32x4*)(SH + pv + c), sh1 = *(const LAS f32x4*)(SH + pv + c + 4);
        const f32x4 h0 = x0 * rstd * g0 + sh0, h1 = x1 * rstd * g1 + sh1;
        v4u hi; hi.x = pk2(h0.x, h0.y); hi.y = pk2(h0.z, h0.w); hi.z = pk2(h1.x, h1.y); hi.w = pk2(h1.z, h1.w);
        if (valid) *(v4u*)(H + (size_t)row * D + kh * KW + 8 * q + c) = hi;
        v4u lo; lo.x = pk2(h0.x - bflo(hi.x), h0.y - bfhi(hi.x)); lo.y = pk2(h0.z - bflo(hi.y), h0.w - bfhi(hi.y)); lo.z = pk2(h1.x - bflo(hi.z), h1.y - bfhi(hi.z)); lo.w = pk2(h1.z - bflo(hi.w), h1.w - bfhi(hi.w));
        const bf16x8 Ah = __builtin_bit_cast(bf16x8, hi), Al = __builtin_bit_cast(bf16x8, lo);
#pragma unroll
        for (int cb = 0; cb < 3; ++cb) { const size_t wo = (size_t)(cb * 16 + r) * 1024 + kh * KW + c + 8 * q; const bf16x8 Bh = *(const bf16x8*)(WRh + wo), Bl = *(const bf16x8*)(WRl + wo);
            acc[cb] = __builtin_amdgcn_mfma_f32_16x16x32_bf16(Ah, Bh, acc[cb], 0, 0, 0); acc[cb] = __builtin_amdgcn_mfma_f32_16x16x32_bf16(Al, Bh, acc[cb], 0, 0, 0); acc[cb] = __builtin_amdgcn_mfma_f32_16x16x32_bf16(Ah, Bl, acc[cb], 0, 0, 0); }
    }
    LAS float* LGw = LG + (sl * KS + kh) * (16 * 52);
#pragma unroll
    for (int cb = 0; cb < 3; ++cb)
#pragma unroll
        for (int i = 0; i < 4; ++i) LGw[(4 * q + i) * 52 + cb * 16 + r] = acc[cb][i];
    __syncthreads();
    if (kh == 0 && valid && F.lane < 16) { const LAS float* L0 = LG + (sl * KS) * (16 * 52) + F.lane * 52; const int rw = u * 16 + F.lane;
        float lg[36];
#pragma unroll
        for (int o = 0; o < 36; ++o) { float t = 0.f;
#pragma unroll
            for (int i = 0; i < KS; ++i) t += L0[i * (16 * 52) + o]; lg[o] = t + (o < 4 ? bg[o] : be[o - 4]); }
        LAS float* LW = LG + (sl * KS) * (16 * 52) + F.lane * 52;
#pragma unroll
        for (int o = 0; o < 36; ++o) LW[o] = lg[o];
        int gi = 0; float gm = lg[0];
#pragma unroll
        for (int o = 1; o < 4; ++o) if (lg[o] > gm) { gm = lg[o]; gi = o; }
        float den = 0.f;
#pragma unroll
        for (int o = 0; o < 4; ++o) den += expf(lg[o] - gm);
        const float gp = 1.f / den;
        const LAS float* el = LW + 4 + gi * 8;
        int i1 = 0; float m1 = el[0]; for (int o = 1; o < 8; ++o) { const float v = el[o]; if (v > m1) { m1 = v; i1 = o; } }
        int i2 = -1; float m2 = 0.f; for (int o = 0; o < 8; ++o) { const float v = el[o]; if (o != i1 && (i2 < 0 || v > m2)) { m2 = v; i2 = o; } }
        const float e2 = expf(m2 - m1); const float w1 = 1.f / (1.f + e2), w2 = e2 / (1.f + e2);
        const int e1i = gi * 8 + i1, e2i = gi * 8 + i2;
        EID[rw * 2] = e1i; EID[rw * 2 + 1] = e2i; EW[rw * 2] = gp * w1; EW[rw * 2 + 1] = gp * w2;
        __hip_atomic_fetch_add(&HISTL[e1i], 1, __ATOMIC_RELAXED, __HIP_MEMORY_SCOPE_WORKGROUP); __hip_atomic_fetch_add(&HISTL[e2i], 1, __ATOMIC_RELAXED, __HIP_MEMORY_SCOPE_WORKGROUP);
    }
}
__device__ __forceinline__ void ph10_route(Frame& F, int l) {
    const float* g = IN_(I_GFFN) + l * D;
    LAS float* GC = (LAS float*)F.lds;
    LAS float* SH = GC + 2048;
    LAS float* SSQ = SH + 2048;
    LAS float* LG = SSQ + 128;
    LAS int* HISTL = (LAS int*)(LG + 8 * 16 * 52);
    __syncthreads();
    if (F.tid < 32) HISTL[F.tid] = 0;
    for (int i = F.tid; i < 2048; i += NT) { const int w = i >> 10, c = i & 1023; const float* m = (const float*)(F.ws + WS_MOD) + (size_t)(l * 2 + w) * 6144; GC[i] = g[c] * (1.f + m[4096 + c]); SH[i] = m[3072 + c]; }
#pragma unroll 1
    for (int u0 = F.bid; u0 < SEQ / 16; u0 += 4 * F.G) { const int u = u0 + (F.wave >> 1) * F.G; route_pass<2>(F, l, u, u < SEQ / 16, F.wave & 1, F.wave >> 1, GC, SH, SSQ, LG, HISTL); }
    if (l == 0) {
#pragma unroll 1
        for (int u0 = SEQ / 16 + F.bid; u0 < MT / 16; u0 += F.G) route_pass<8>(F, l, u0, true, F.wave, 0, GC, SH, SSQ, LG, HISTL);
    }
    __syncthreads();
    if (F.tid < 32) ((int*)(F.ws + WS_HISTG))[F.bid * 32 + F.tid] = HISTL[F.tid];
}
__device__ __forceinline__ int expert_off(const unsigned* cnt, int e) { int o = 0; for (int i = 0; i < e; ++i) o += ((int)cnt[i] + 255) & ~255; return o; }
__device__ __forceinline__ void ph11_scatter(Frame& F, int l) {
    const bf16* H = (const bf16*)(F.ws + WS_H); bf16* HS = (bf16*)(F.ws + WS_HS);
    const int* EID = (const int*)(F.ws + WS_EID); const float* EW = (const float*)(F.ws + WS_EW); int* STOK = (int*)(F.ws + WS_STOK); float* SW = (float*)(F.ws + WS_SW); int* TSLOT = (int*)(F.ws + WS_TSLOT);
    unsigned* cnt = F.ctl + CW_CNT + l * 128; const int* HISTG = (const int*)(F.ws + WS_HISTG);
    LAS int* HIST = (LAS int*)F.lds; LAS int* BASE = HIST + 32; LAS int* ISLOT = BASE + 32; LAS int* IROW = ISLOT + 512; LAS int* PT = IROW + 512; LAS int* PB = PT + 512;
    const int nunits = (l == 0 ? MT : SEQ) / 16;
    __syncthreads();
    { const int e = F.tid & 31, ch = F.tid >> 5; int tot = 0, bas = 0;
      for (int b = ch; b < F.G; b += 16) { const int h = HISTG[b * 32 + e]; tot += h; if (b < F.bid) bas += h; }
      PT[F.tid] = tot; PB[F.tid] = bas; }
    __syncthreads();
    if (F.tid < 32) { int tot = 0, bas = 0; for (int ch = 0; ch < 16; ++ch) { tot += PT[ch * 32 + F.tid]; bas += PB[ch * 32 + F.tid]; } HIST[F.tid] = 0; PT[F.tid] = tot; PB[F.tid] = bas; if (F.bid == 0) cnt[F.tid] = (unsigned)tot; }
    __syncthreads();
    if (F.tid < 32) { int off = 0; for (int i = 0; i < F.tid; ++i) off += (PT[i] + 255) & ~255; BASE[F.tid] = off + PB[F.tid]; }
    __syncthreads();
    const int w = F.tid >> 5; int u = F.bid + w * F.G; bool valid = u < SEQ / 16;
    if (w == 15) { u = SEQ / 16 + F.bid; valid = u < nunits; }
    const int row = u * 16 + ((F.tid >> 1) & 15), kk = F.tid & 1;
    int e = 0, rank = 0; if (valid) { e = EID[row * 2 + kk]; rank = __hip_atomic_fetch_add(&HIST[e], 1, __ATOMIC_RELAXED, __HIP_MEMORY_SCOPE_WORKGROUP); }
    __syncthreads();
    int slot = -1; if (valid) { slot = BASE[e] + rank; STOK[slot] = row; SW[slot] = EW[row * 2 + kk]; TSLOT[row * 2 + kk] = slot; }
    ISLOT[F.tid] = slot; IROW[F.tid] = row;
    __syncthreads();
#pragma unroll 4
    for (int it = F.wave; it < NT; it += NT / 64) { const int sl = ISLOT[it]; if (sl >= 0) { const v4u* src = (const v4u*)(H + (size_t)IROW[it] * D); v4u* dst = (v4u*)(HS + (size_t)sl * D);
        dst[F.lane] = src[F.lane]; dst[F.lane + 64] = src[F.lane + 64]; } }
}
__device__ __forceinline__ int slot_expert(const unsigned* cnt, int slot0, int& seg_off, int& n_e) { int o = 0; for (int e = 0; e < NE; ++e) { const int n = (int)cnt[e], pn = (n + 255) & ~255; if (slot0 < o + pn) { seg_off = o; n_e = n; return e; } o += pn; } seg_off = o; n_e = 0; return 0; }
__device__ __forceinline__ void ph12_naive(Frame& F, int l) {
    const bf16* HS = (const bf16*)(F.ws + WS_HS); bf16* ACT = (bf16*)(F.ws + WS_ACT); const float* SW = (const float*)(F.ws + WS_SW);
    const unsigned* cnt = F.ctl + CW_CNT + l * 128; const int total = expert_off(cnt, NE);
    NTILE_BEGIN((total / 64) * (DFF / 64))
        const int s0 = (T / (DFF / 64)) * 64, n0 = (T % (DFF / 64)) * 64; int seg, n_e; const int e = slot_expert(cnt, s0, seg, n_e);
        float aa[4][4] = {}, ab[4][4] = {};
        ngemm_acc(aa, ABf{HS + (size_t)s0 * D, D}, IN_(I_W1) + ((size_t)l * NE + e) * D * DFF + n0, DFF, D, sm, t);
        ngemm_acc(ab, ABf{HS + (size_t)s0 * D, D}, IN_(I_W3) + ((size_t)l * NE + e) * D * DFF + n0, DFF, D, sm, t);
        if (valid) {
#pragma unroll
            for (int i = 0; i < 4; ++i) { const int slot = s0 + ty * 4 + i; if (slot - seg < n_e) { const float w = SW[slot];
                v2u o; o.x = pk2(siluf_(aa[i][0]) * ab[i][0] * w, siluf_(aa[i][1]) * ab[i][1] * w); o.y = pk2(siluf_(aa[i][2]) * ab[i][2] * w, siluf_(aa[i][3]) * ab[i][3] * w);
                *(v2u*)(ACT + (size_t)slot * DFF + n0 + tx * 4) = o; } }
        }
    NTILE_END
}
__device__ __forceinline__ void ph13_naive(Frame& F, int l) {
    const bf16* ACT = (const bf16*)(F.ws + WS_ACT); bf16* YS2 = (bf16*)(F.ws + WS_YS2);
    const unsigned* cnt = F.ctl + CW_CNT + l * 128; const int total = expert_off(cnt, NE);
    NTILE_BEGIN((total / 64) * (D / 64))
        const int s0 = (T / (D / 64)) * 64, n0 = (T % (D / 64)) * 64; int seg, n_e; const int e = slot_expert(cnt, s0, seg, n_e);
        float acc[4][4] = {};
        ngemm_acc(acc, ABf{ACT + (size_t)s0 * DFF, DFF}, IN_(I_W2) + ((size_t)l * NE + e) * DFF * D + n0, D, DFF, sm, t);
        if (valid) {
#pragma unroll
            for (int i = 0; i < 4; ++i) { const int slot = s0 + ty * 4 + i; if (slot - seg < n_e) { v2u o; o.x = pk2(acc[i][0], acc[i][1]); o.y = pk2(acc[i][2], acc[i][3]); *(v2u*)(YS2 + (size_t)slot * D + n0 + tx * 4) = o; } }
        }
    NTILE_END
}
__device__ __forceinline__ void ph14_combine(Frame& F, int l) {
    const bf16* YS2 = (const bf16*)(F.ws + WS_YS2); const int* TSLOT = (const int*)(F.ws + WS_TSLOT); bf16* H = (bf16*)(F.ws + WS_H);
    const int gw = F.bid * (NT / 64) + F.wave, ngw = F.G * (NT / 64);
    const int nrows = l == 0 ? MT : SEQ;
    for (int row0 = gw; row0 < nrows; row0 += 2 * ngw) {
        f32x4 v[2][4]; float s[2] = {0.f, 0.f}; int rows[2]; bool ok[2];
#pragma unroll
        for (int t = 0; t < 2; ++t) { rows[t] = row0 + t * ngw; ok[t] = rows[t] < nrows; if (!ok[t]) rows[t] = row0; }
        int sl[2][2];
#pragma unroll
        for (int t = 0; t < 2; ++t) { sl[t][0] = TSLOT[rows[t] * 2]; sl[t][1] = TSLOT[rows[t] * 2 + 1]; }
#pragma unroll
        for (int t = 0; t < 2; ++t) { const float* m = mod_ptr(F, l, rows[t]); const float* xr = xrun_row(F, rows[t]);
#pragma unroll
            for (int j = 0; j < 4; ++j) { const int c = 4 * F.lane + 256 * j; const f32x4 x = *(const f32x4*)(xr + c); const f32x4 ga = *(const f32x4*)(m + 5120 + c);
                const v2u a = *(const v2u*)(YS2 + (size_t)sl[t][0] * D + c), b = *(const v2u*)(YS2 + (size_t)sl[t][1] * D + c);
                f32x4 y; y.x = bflo(a.x) + bflo(b.x); y.y = bfhi(a.x) + bfhi(b.x); y.z = bflo(a.y) + bflo(b.y); y.w = bfhi(a.y) + bfhi(b.y);
                v[t][j] = x + ga * y; s[t] += v[t][j].x * v[t][j].x + v[t][j].y * v[t][j].y + v[t][j].z * v[t][j].z + v[t][j].w * v[t][j].w; } }
#pragma unroll
        for (int t = 0; t < 2; ++t) { if (!ok[t]) continue;
            const float rstd = rsqrtf(wave_sum(s[t]) * (1.f / D) + EPS); float* xr = xrun_row(F, rows[t]);
            if (l == 0) {
                const float* m1 = mod_ptr(F, 1, rows[t]); const float* g = IN_(I_GMIX) + D;
#pragma unroll
                for (int j = 0; j < 4; ++j) { const int c = 4 * F.lane + 256 * j; *(f32x4*)(xr + c) = v[t][j];
                    const f32x4 gg = *(const f32x4*)(g + c), sc = *(const f32x4*)(m1 + 1024 + c), sh = *(const f32x4*)(m1 + c);
                    const f32x4 o = v[t][j] * rstd * gg * (1.f + sc) + sh; v2u w; w.x = pk2(o.x, o.y); w.y = pk2(o.z, o.w); *(v2u*)(H + (size_t)rows[t] * D + c) = w; }
            } else {
                const float* g = IN_(I_GF);
#pragma unroll
                for (int j = 0; j < 4; ++j) { const int c = 4 * F.lane + 256 * j; const f32x4 gg = *(const f32x4*)(g + c); f32x4 o = v[t][j] * rstd * gg;
                    if (PROBE_B >= 0 && rows[t] < 3906) { volatile LAS unsigned long long* TS = (volatile LAS unsigned long long*)(F.lds + TS_OFF); o = o + (0.1f + 0.00001f * (float)(TS[1 + PROBE_B] - TS[PROBE_B])); }
                    if (PROBE_A >= 0 && rows[t] == 0 && j == 0 && F.lane == 0) { volatile LAS unsigned long long* TS = (volatile LAS unsigned long long*)(F.lds + TS_OFF); o.x += 1.f + 0.001f * (float)(TS[1 + PROBE_A] - TS[PROBE_A]); }
                    *(f32x4*)(xr + c) = o; }
            }
        }
    }
}

#ifndef FASTMASK
#define FASTMASK 0xffff
#endif
constexpr unsigned FM = FASTMASK;
constexpr int NPH = 2 + 13 * 2;
__device__ __forceinline__ Frame make_frame(LAS unsigned char* lds, int wave0) {
    Frame F; F.lds = lds; F.wave = wave0; F.lane = (int)__builtin_amdgcn_mbcnt_hi(~0u, __builtin_amdgcn_mbcnt_lo(~0u, 0u)); asm volatile("" : "+v"(F.lane)); F.tid = F.wave * 64 + F.lane; F.bid = blockIdx.x; F.G = gridDim.x; asm volatile("" : "+s"(F.G), "+s"(F.bid));
    F.tab = (const unsigned long long LAS*)(lds + TAB_OFF);
    volatile LAS unsigned long long* t = (volatile LAS unsigned long long*)(lds + TAB_OFF);
    F.ws = (unsigned char*)uni64(t[35]); F.out = (float*)uni64(t[36]); F.ctl = (unsigned*)(F.ws + WS_CTL);
    return F;
}
__global__ void __launch_bounds__(NT, 2) mega_fwd(Args args) {
    extern __shared__ __attribute__((aligned(16))) unsigned char lds_raw[];
    LAS unsigned char* const lds = (LAS unsigned char*)lds_raw;
    const int wave0 = __builtin_amdgcn_readfirstlane((int)threadIdx.x >> 6);
    for (int u = threadIdx.x; u < 1024 / 4; u += NT) ((LAS unsigned*)(lds + 131072))[u] = 0u;
    if (threadIdx.x == 0) { LAS unsigned long long* t = (LAS unsigned long long*)(lds + TAB_OFF);
#pragma unroll
        for (int i = 0; i < 35; ++i) t[i] = (unsigned long long)args.in[i];
        t[35] = (unsigned long long)args.ws; t[36] = (unsigned long long)args.out; }
    __syncthreads();
    { Frame F = make_frame(lds, wave0); (void)xcd_barrier_post(F.ctl + CW_BAR, (volatile LAS unsigned*)(lds + MISC_OFF) + 8); }
    if ((PROBE_A >= 0 || PROBE_B >= 0) && threadIdx.x == 0) ((volatile LAS unsigned long long*)(lds + TS_OFF))[0] = __builtin_amdgcn_s_memrealtime();
    const int lo = args.ph_lo, hi = args.ph_hi; int ph = 0;
#define GRIDBAR() do { Frame Fb = make_frame(lds, wave0); XcdBarrier bar; bar.bar = Fb.ctl + CW_BAR; bar.x = xb_xcc_id(); bar.st = (volatile LAS unsigned*)(lds + MISC_OFF) + 8; xcd_barrier(bar, Fb.tid == 0); } while (0)
#ifndef REPBAR
#define REPBAR 0
#endif
#ifndef REPMASK
#define REPMASK 0
#endif
#define PHASE(...) do { if (lo <= ph && ph < hi) { const int _pl = ph < 2 ? ph : 2 + (ph - 2) % 13; for (int _rep = 0; _rep <= ((REPMASK >> _pl) & 1); ++_rep) { Frame F = make_frame(lds, wave0); __VA_ARGS__; } if (ph + 1 < hi) { GRIDBAR(); if (REPBAR) GRIDBAR(); } if ((PROBE_A >= 0 || PROBE_B >= 0) && threadIdx.x == 0) ((volatile LAS unsigned long long*)(lds + TS_OFF))[1 + ph] = __builtin_amdgcn_s_memrealtime(); } ++ph; } while (0)
    PHASE({ ph0_prologue(F); if (FM >> 3 & 1) s5_precompute(F); __syncthreads(); convert_weights(F, 0, (FM >> 3 & 1) && F.G > 128 ? F.G - 64 : F.G); { const f32x4* s = (const f32x4*)IN_(I_CTX); f32x4* d = (f32x4*)(F.ws + WS_XC); for (int i = F.bid * NT + F.tid; i < CTX * D / 4; i += F.G * NT) d[i] = s[i]; } });
    PHASE(hprep_rows(F, 0));
#pragma unroll 1
    for (int l = 0; l < 2; ++l) {
        PHASE({ if (FM >> 2 & 1) { ph2_fast(F, l); ph2_ctx(F, l == 0 ? INW : MIXW); } else ph2_naive(F, l); });
        PHASE({ if (FM >> 3 & 1) { s5_z_phase(F, l); const int nch = (l == 0 ? MT : SEQ) / 128; if (F.G > nch) { if (F.bid < nch) sg_fast_chunk(F, l, F.bid); else { Frame F2 = F; F2.bid -= nch; F2.G -= nch; ph3_conv(F2, l, l == 0 ? MT : SEQ); } } else { for (int c = F.bid; c < nch; c += F.G) sg_fast_chunk(F, l, c); ph3_conv(F, l, l == 0 ? MT : SEQ); } } else { ph3_s5_naive(F, l); if (F.bid >= 64) { Frame F2 = F; F2.bid -= 64; F2.G -= 64; ph3_sg_naive(F2, l); ph3_conv(F2, l, MT); } } });
        PHASE({ if (FM >> 3 & 1) s5_scan_phase(F, l); });
        PHASE({ if (FM >> 3 & 1) s5_y_phase(F, l); else ph5_naive(F, l); });
        PHASE({ if (FM >> 6 & 1) { ph6_fast(F, l); if (l == 0) ph6_ctx(F); } else ph6_naive(F, l); });
        PHASE({ if (FM >> 7 & 1) { ph7_fast(F, l); if (l == 0) ph7_ctx(F); } else ph7_naive(F, l); });
        PHASE({ if (FM >> 8 & 1) { ph8_fast(F, l); if (l == 0) ph8_ctx(F, l); } else ph8_naive(F, l); });
        PHASE({ if (FM >> 9 & 1) { ph9_fast(F, l); if (l == 0) ph9_ctx(F, l); } else ph9_naive(F, l); });
        PHASE(ph10_route(F, l));
        PHASE(ph11_scatter(F, l));
        PHASE({ if (FM >> 12 & 1) ph12_fast(F, l); else ph12_naive(F, l); });
        PHASE({ if (FM >> 13 & 1) ph13_fast(F, l); else ph13_naive(F, l); });
        PHASE({ ph14_combine(F, l); if (l == 0) convert_weights(F, 1, F.G); });
    }
#undef PHASE
}

extern "C" void kernel_launch(void* const* d_in, const int* in_sizes, int n_in, void* d_out, int out_size, void* d_ws, size_t ws_size, hipStream_t stream) {
    static int grid = 0;
    if (grid == 0) {
        int dev = 0, cus = 0, per_cu = 0;
        if (n_in != 35 || out_size != SEQ * D || ws_size < WS_END) { fprintf(stderr, "kernel_launch: unexpected shapes (n_in %d out %d ws %zu)\n", n_in, out_size, ws_size); grid = -1; return; }
        if (hipGetDevice(&dev) != hipSuccess || hipDeviceGetAttribute(&cus, hipDeviceAttributeMultiprocessorCount, dev) != hipSuccess) { grid = -1; return; }
        if (hipFuncSetAttribute((const void*)mega_fwd, hipFuncAttributeMaxDynamicSharedMemorySize, LDS_BYTES) != hipSuccess) { fprintf(stderr, "kernel_launch: hipFuncSetAttribute failed\n"); grid = -1; return; }
        if (hipOccupancyMaxActiveBlocksPerMultiprocessor(&per_cu, (const void*)mega_fwd, NT, LDS_BYTES) != hipSuccess || per_cu < 1) { fprintf(stderr, "kernel_launch: occupancy query says %d blocks per CU\n", per_cu); grid = -1; return; }
        grid = cus;
    }
    if (grid < 0) return;
    (void)hipMemsetAsync((char*)d_ws + WS_CTL, 0, CTL_ZERO_BYTES, stream);
    Args a{};
    for (int i = 0; i < 35; ++i) a.in[i] = (const float*)d_in[i];
    a.out = (float*)d_out; a.ws = (unsigned char*)d_ws; a.ph_lo = 0; a.ph_hi = NPH;
    void* kargs[] = {&a};
    hipError_t e = hipLaunchCooperativeKernel((const void*)mega_fwd, dim3(grid), dim3(NT), kargs, LDS_BYTES, stream);
    if (e != hipSuccess) fprintf(stderr, "kernel_launch: cooperative launch failed: %s (grid %d)\n", hipGetErrorString(e), grid);
}
```

```cpp
#include <hip/hip_runtime.h>
#include <stdint.h>
#include <cstdio>

#define GAS __attribute__((address_space(1)))
#define LAS __attribute__((address_space(3)))
typedef unsigned short bf16;
typedef unsigned v4u __attribute__((ext_vector_type(4)));
typedef unsigned v2u __attribute__((ext_vector_type(2)));
typedef float f32x4 __attribute__((ext_vector_type(4)));
typedef short bf16x8 __attribute__((ext_vector_type(8)));

constexpr int D = 1024, SEQ = 16384, CTX = 256, MT = SEQ + CTX;
constexpr int MIXW = 512, INW = 3072, G5 = 32, P5 = 64, H5 = 16;
constexpr int NE = 32, DFF = 256;
constexpr int MAXSLOT = 2 * MT + NE * 256;
constexpr float EPS = 1e-6f;
constexpr int NT = 512;

constexpr size_t MiB = 1u << 20;
constexpr size_t WS_CTL = 0, CTL_ZERO_BYTES = 1 * MiB;
constexpr size_t WS_MOD = 1 * MiB;
constexpr size_t WS_XC = 2 * MiB;
constexpr size_t WS_EID = 3 * MiB;
constexpr size_t WS_EW = WS_EID + (size_t)MT * 8;
constexpr size_t WS_STOK = WS_EW + (size_t)MT * 8;
constexpr size_t WS_SW = WS_STOK + (size_t)MAXSLOT * 4;
constexpr size_t WS_TSLOT = WS_SW + (size_t)MAXSLOT * 4;
constexpr size_t WS_HISTG = WS_TSLOT + (size_t)MT * 8;
constexpr size_t WS_H = 4 * MiB;
constexpr size_t WS_PROJ = WS_H + (size_t)MT * 2048;
constexpr size_t WS_YS = WS_PROJ + (size_t)MT * 6144;
constexpr size_t WS_YG = WS_YS + (size_t)3 * MT * 1024;
constexpr size_t WS_PM = WS_YG + (size_t)MT * 1024;
constexpr size_t WS_S5 = WS_PM + (size_t)MT * 2048;
constexpr size_t WS_Z = WS_S5;
constexpr size_t WS_SS = WS_Z + (size_t)1040 * 32 * 256 * 4;
constexpr size_t WS_S5M = WS_SS + (size_t)1040 * 32 * 256 * 2;
constexpr size_t WS_A16 = WS_S5M + (size_t)2 * 32 * 3 * 65536 * 2;
constexpr size_t WS_W = WS_A16 + (size_t)2 * 32 * 2 * 64 * 2 * 4 > WS_S5 + (size_t)2 * MT * 512 * 4 ? WS_A16 + (size_t)2 * 32 * 2 * 64 * 2 * 4 : WS_S5 + (size_t)2 * MT * 512 * 4;
constexpr size_t WS_WIN = WS_W;
constexpr size_t WS_WMG = WS_WIN + (size_t)3072 * 1024 * 2;
constexpr size_t WS_WGLU = WS_WMG + (size_t)3072 * 1024 * 2;
constexpr size_t WS_WBR = WS_WGLU + (size_t)512 * 512 * 2;
constexpr size_t WS_WO = WS_WBR + (size_t)3 * 1024 * 512 * 2;
constexpr size_t WS_W13 = WS_WO + (size_t)1024 * 1024 * 2;
constexpr size_t WS_W2 = WS_W13 + (size_t)32 * 512 * 1024 * 2;
constexpr size_t WS_WSG = WS_W2 + (size_t)32 * 1024 * 256 * 2;
constexpr size_t WS_WR = WS_WSG + (size_t)4 * 128 * 128 * 2;
constexpr size_t WS_END = WS_WR + (size_t)2 * 48 * 1024 * 2;
static_assert(WS_END <= (size_t)377 * MiB, "workspace budget");
constexpr size_t WS_HS = WS_PROJ;
constexpr size_t WS_ACT = WS_YS;
constexpr size_t WS_YS2 = WS_YG;
static_assert(WS_HS + (size_t)MAXSLOT * 2048 <= WS_YS && WS_ACT + (size_t)MAXSLOT * 512 <= WS_YG && WS_YS2 + (size_t)MAXSLOT * 2048 <= WS_W, "moe overlays");
static_assert(WS_HISTG + (size_t)1024 * 32 * 4 <= WS_H, "ws map");
constexpr int CW_CNT = 64;
constexpr int CW_BAR = 4096;

#ifndef PROBE_A
#define PROBE_A -1
#endif
#ifndef PROBE_B
#define PROBE_B -1
#endif
constexpr int TS_OFF = 131072 + 512;
constexpr int LDS_BYTES = 147456;
constexpr int MISC_OFF = 131072 + 320;
constexpr int TAB_OFF = 131072 + 1024;

__device__ __forceinline__ float bf2f(unsigned short b) { return __builtin_bit_cast(float, ((unsigned)b) << 16); }
__device__ __forceinline__ unsigned f2bf(float f) { unsigned u = __builtin_bit_cast(unsigned, f); return (u + 0x7fffu + ((u >> 16) & 1u)) >> 16; }
__device__ __forceinline__ unsigned pk2(float lo, float hi) { return f2bf(lo) | (f2bf(hi) << 16); }
__device__ __forceinline__ float sigmoidf_(float x) { return __builtin_amdgcn_rcpf(1.f + __expf(-x)); }
__device__ __forceinline__ float siluf_(float x) { return x * __builtin_amdgcn_rcpf(1.f + __expf(-x)); }
__device__ __forceinline__ float geluf_(float x) { const float u = 0.7978845608028654f * (x + 0.044715f * x * x * x); return x * __builtin_amdgcn_rcpf(1.f + __expf(-2.f * u)); }
__device__ __forceinline__ float shflx(float v, int mask, int lane) { return __builtin_bit_cast(float, __builtin_amdgcn_ds_bpermute((lane ^ mask) << 2, __builtin_bit_cast(int, v))); }
__device__ __forceinline__ float wave_sum(float v, int lane) {
#pragma unroll
    for (int o = 1; o < 64; o <<= 1) v += shflx(v, o, lane);
    return v;
}

#define XB_TMO      128
#define XB_XCNT(j)  (256  + 64 * (j))
#define XB_XSUB(j)  (1280 + 64 * (j))
#define XB_XGEN(j)  (2304 + 64 * (j))
#define XB_TOP      3328
#define XB_TOPGEN   3392
#define XCD_BAR_WORDS 3456
#define XB_SPIN_CAP (1u << 24)
__device__ __forceinline__ unsigned xb_ld(unsigned* p)              { return __hip_atomic_load(p, __ATOMIC_RELAXED, __HIP_MEMORY_SCOPE_AGENT); }
__device__ __forceinline__ unsigned xb_add(unsigned* p, unsigned v) { return __hip_atomic_fetch_add(p, v, __ATOMIC_RELAXED, __HIP_MEMORY_SCOPE_AGENT); }
__device__ __forceinline__ unsigned xb_xcc_id() { return (unsigned)__builtin_amdgcn_s_getreg((3 << 11) | 20) & 0xFu; }
#define XB_SPIN(cond, bar) do { unsigned _sp = 0; while (cond) { __builtin_amdgcn_s_sleep(1); \
    if ((++_sp & 255u) == 0u) { if (xb_ld(&(bar)[XB_TMO])) break; if (_sp > XB_SPIN_CAP) { atomicAdd(&(bar)[XB_TMO], 1u); break; } } } } while (0)
struct XcdBarrier { unsigned* bar; unsigned x; volatile LAS unsigned* st; };
__device__ __forceinline__ XcdBarrier xcd_barrier_post(unsigned* bar, volatile LAS unsigned* st) {
    XcdBarrier b; b.bar = bar; b.x = xb_xcc_id(); b.st = st;
    if (threadIdx.x == 0) (void)xb_add(&bar[XB_XCNT(b.x)], 1u);
    return b;
}
__device__ __forceinline__ void xcd_barrier_complete(unsigned* bar, unsigned x, unsigned& nloc, unsigned& nx) {
    const unsigned G = gridDim.x * gridDim.y * gridDim.z;
    unsigned sum, cnt, mine, sp = 0u;
    for (;;) {
        sum = 0u; cnt = 0u; mine = 0u;
#pragma unroll
        for (unsigned j = 0; j < 16; ++j) { const unsigned c = xb_ld(&bar[XB_XCNT(j)]); sum += c; cnt += (c > 0u) ? 1u : 0u; mine = (j == x) ? c : mine; }
        if (sum == G) break;
        __builtin_amdgcn_s_sleep(1);
        if ((++sp & 255u) == 0u) { if (xb_ld(&bar[XB_TMO])) break; if (sp > XB_SPIN_CAP) { atomicAdd(&bar[XB_TMO], 1u); break; } }
    }
    nloc = mine > 0u ? mine : 1u; nx = cnt > 0u ? cnt : 1u;
}
__device__ __forceinline__ void xcd_barrier(const XcdBarrier& b, bool leader) {
    asm volatile("s_waitcnt vmcnt(0)" ::: "memory");
    __syncthreads();
    if (leader) {
        unsigned* bar = b.bar;
        __builtin_amdgcn_s_waitcnt(0);
        unsigned nloc = b.st[0], nx = b.st[1];
        if (nloc == 0u) { xcd_barrier_complete(bar, b.x, nloc, nx); b.st[0] = nloc; b.st[1] = nx; }
        const unsigned old = xb_add(&bar[XB_XSUB(b.x)], 1u);
        const unsigned gen = old / nloc;
        if (old + 1u == (gen + 1u) * nloc) {
            __builtin_amdgcn_fence(__ATOMIC_RELEASE, "agent");
            asm volatile("s_waitcnt vmcnt(0)" ::: "memory");
            const unsigned og = xb_add(&bar[XB_TOP], 1u);
            const unsigned tg = og / nx;
            if (og + 1u == (tg + 1u) * nx) xb_add(&bar[XB_TOPGEN], 1u);
            else XB_SPIN(xb_ld(&bar[XB_TOPGEN]) == tg, bar);
            __builtin_amdgcn_fence(__ATOMIC_ACQUIRE, "agent");
            xb_add(&bar[XB_XGEN(b.x)], 1u);
            asm volatile("s_waitcnt vmcnt(0)" ::: "memory");
        } else {
            XB_SPIN(xb_ld(&bar[XB_XGEN(b.x)]) == gen, bar);
            __builtin_amdgcn_fence(__ATOMIC_ACQUIRE, "agent");
            asm volatile("s_waitcnt vmcnt(0)" ::: "memory");
        }
    }
    __syncthreads();
}

struct Args { const float* in[35]; float* out; unsigned char* ws; int ph_lo, ph_hi; };
struct Frame {
    LAS unsigned char* lds; unsigned char* ws; unsigned* ctl;
    int tid, lane, wave, bid, G;
    const unsigned long long LAS* tab; float* out;
};
__device__ __forceinline__ unsigned long long uni64(unsigned long long v) { const unsigned lo = __builtin_amdgcn_readfirstlane((unsigned)v), hi = __builtin_amdgcn_readfirstlane((unsigned)(v >> 32)); return ((unsigned long long)hi << 32) | lo; }
#define IN_(k) ((const float*)(const GAS float*)uni64(F.tab[k]))
enum { I_X = 0, I_C, I_CTX, I_CCTX, I_WADA, I_BADA, I_GMIX, I_GFFN, I_WIN, I_LRE, I_LIM, I_LDT, I_BRE, I_BIM, I_CRE, I_CIM, I_DSKIP, I_WGLU, I_SGG, I_SGB, I_WSG, I_BSG,
       I_WCONV, I_WBR, I_WMG, I_BMG, I_WO, I_WGRP, I_BGRP, I_WEXP, I_BEXP, I_W1, I_W3, I_W2, I_GF };

__device__ __forceinline__ const float* mod_ptr(const Frame& F, int l, int row) { return (const float*)(F.ws + WS_MOD) + (size_t)(l * 2 + (row >= SEQ ? 1 : 0)) * 6144; }
__device__ __forceinline__ const float* xsrc_row(const Frame& F, int l, int row) {
    if (l == 0) return row < SEQ ? IN_(I_X) + (size_t)row * D : IN_(I_CTX) + (size_t)(row - SEQ) * D;
    return row < SEQ ? F.out + (size_t)row * D : (const float*)(F.ws + WS_XC) + (size_t)(row - SEQ) * D;
}
__device__ __forceinline__ float* xrun_row(const Frame& F, int row) { return row < SEQ ? F.out + (size_t)row * D : (float*)(F.ws + WS_XC) + (size_t)(row - SEQ) * D; }


namespace pg8 {
#define PG8_LAS __attribute__((address_space(3)))
typedef unsigned short bf16_t;
typedef short bf16x8 __attribute__((ext_vector_type(8)));
typedef float f32x4 __attribute__((ext_vector_type(4)));
typedef unsigned u32x4 __attribute__((ext_vector_type(4)));
constexpr int BM = 256, BK = 64, HALF = 128, HTB = HALF * BK * 2  , STAGE_BYTES = 8 * HTB, NXCD = 8, WGM = 8;

__host__ __device__ __forceinline__ int lds_byte(int r, int c) { const int st = (r >> 4) * 2 + (c >> 5), rr = r & 15, cc = c & 31, ob = rr * 64 + cc * 2; return st * 1024 + (ob ^ (((ob >> 9) & 1) << 5)); }
__host__ __device__ __forceinline__ void stage_rc(int b, int& R, int& C) { const int st = b / 1024, sb = b % 1024, swz = sb ^ (((sb >> 9) & 1) << 5); R = (st >> 1) * 16 + swz / 64; C = (st & 1) * 32 + (swz % 64) / 2; }
__host__ __device__ __forceinline__ int perm32(int rho) { const int n = rho >> 4, i = rho & 15; return 8 * (i >> 2) + 4 * n + (i & 3); }

struct Unit { int pm, pn; };
struct Gemm { const bf16_t* A; const bf16_t* Bt; int M, N, K; };

struct StaticOrder {
    int nM, nN, nwg, G, c;
    __host__ __device__ void init(int M, int N, int G_, int c_) { nM = M / BM; nN = N / BM; nwg = nM * nN; G = G_; c = c_; }
    __host__ __device__ bool next(int i, Unit& u) const {
        const long L = (long)i * G + c; if (L >= nwg) return false;
        int wgid = (int)L; { const int q = nwg / NXCD, r = nwg % NXCD, xcd = wgid % NXCD, off = wgid / NXCD; wgid = (xcd < r ? xcd * (q + 1) : r * (q + 1) + (xcd - r) * q) + off; }
        const int nig = WGM * nN, gid = wgid / nig, fm = gid * WGM, gsz = (nM - fm) < WGM ? (nM - fm) : WGM;
        u.pm = fm + ((wgid % nig) % gsz); u.pn = (wgid % nig) / gsz; return true;
    }
    __device__ __forceinline__ void a_ready(const Unit&) const {}
    __device__ __forceinline__ void done(const Unit&) const {}
};
__device__ __forceinline__ unsigned cvt_pk_bf16(float lo, float hi) { unsigned r; asm volatile("v_cvt_pk_bf16_f32 %0, %1, %2" : "=v"(r) : "v"(lo), "v"(hi)); return r; }
template <class Epi, class Sched, bool ALIGN_EPI = false, bool SP2 = false>
__device__ __forceinline__ void gemm_phase(PG8_LAS unsigned char* lds, const Gemm g, const Sched& S, const Epi& E, int tid_in) {
    int tid_ = tid_in; asm volatile("" : "+v"(tid_));
    const int tid = tid_, wid = __builtin_amdgcn_readfirstlane(tid >> 6), lane = tid & 63, wr = wid >> 2, wc = wid & 3, fr = lane & 15, fq = lane >> 4;
    const int K = g.K, nt = K / BK;
    unsigned voffA[2], voffB[2];
#pragma unroll
    for (int i = 0; i < 2; ++i) { int R, C; stage_rc(tid * 16 + i * 8192, R, C); const int Rb = Epi::PERM ? ((R & ~31) + perm32(R & 31)) : R;
        voffA[i] = (unsigned)(R * K + C) * 2u; voffB[i] = (unsigned)(Rb * K + C) * 2u; }
    const size_t kstep = (size_t)(BK * 2);
    const size_t hstep = (size_t)HALF * K * 2;
    const size_t tstep = 2 * hstep;
    const unsigned ldsw = (unsigned)wid * 1024u;
    const int aoff = lds_byte(wr * 64 + fr, fq * 8), boff = lds_byte(wc * 32 + fr, fq * 8);
#define PG8_SA(b, h) (((b) * 2 + (h)) * HTB)
#define PG8_SB(b, h) ((4 + (b) * 2 + (h)) * HTB)
#define PG8_STAGE(bufoff, gbase, voff) do { _Pragma("unroll") for (int _i = 0; _i < 2; ++_i) \
        __builtin_amdgcn_global_load_lds((const unsigned*)((const char*)(gbase) + (voff)[_i]), (PG8_LAS unsigned*)(lds + (bufoff) + ldsw + _i * 8192), 16, 0, 0); } while (0)
#define PG8_LDA(dst, b, h) do { _Pragma("unroll") for (int m = 0; m < 4; ++m) _Pragma("unroll") for (int k = 0; k < 2; ++k) dst[m][k] = *(const PG8_LAS bf16x8*)(lds + PG8_SA(b, h) + aoff + m * 2048 + k * 1024); } while (0)
#define PG8_LDB(dst, b, h) do { _Pragma("unroll") for (int n = 0; n < 2; ++n) _Pragma("unroll") for (int k = 0; k < 2; ++k) dst[n][k] = *(const PG8_LAS bf16x8*)(lds + PG8_SB(b, h) + boff + n * 2048 + k * 1024); } while (0)
#define PG8_MMA(ai, bj, At, Bt) do { __builtin_amdgcn_s_setprio(1); _Pragma("unroll") for (int m = 0; m < 4; ++m) _Pragma("unroll") for (int n = 0; n < 2; ++n) _Pragma("unroll") for (int k = 0; k < 2; ++k) \
        acc[ai][bj][m][n] = __builtin_amdgcn_mfma_f32_16x16x32_bf16(Bt[n][k], At[m][k], acc[ai][bj][m][n], 0, 0, 0); __builtin_amdgcn_s_setprio(0); } while (0)
#define PG8_WAIT_V(n) asm volatile("s_waitcnt vmcnt(" #n ")" ::: "memory")
#define PG8_WAIT_L(n) asm volatile("s_waitcnt lgkmcnt(" #n ")" ::: "memory")
#define PG8_BAR __builtin_amdgcn_s_barrier()
#define PG8_SCHED __builtin_amdgcn_sched_barrier(0)
    Unit cur, nxt; int ui = 0;
    if (!S.next(0, cur)) return;
    f32x4 acc[2][2][4][2];
#pragma unroll
    for (int a = 0; a < 2; ++a)
#pragma unroll
        for (int b = 0; b < 2; ++b)
#pragma unroll
            for (int m = 0; m < 4; ++m)
#pragma unroll
                for (int n = 0; n < 2; ++n) acc[a][b][m][n] = (f32x4){0.f, 0.f, 0.f, 0.f};
    bf16x8 At[4][2], B0[2][2], B1[2][2];
    const char* cA = (const char*)g.A + (size_t)cur.pm * tstep; const char* cB = (const char*)g.Bt + (size_t)cur.pn * tstep;
    S.a_ready(cur);
    if constexpr (SP2) {
        PG8_STAGE(PG8_SB(0, 0), cB, voffB); PG8_STAGE(PG8_SB(0, 1), cB + hstep, voffB); PG8_STAGE(PG8_SA(0, 0), cA, voffA); PG8_STAGE(PG8_SA(0, 1), cA + hstep, voffA);
        if (wr == 1) PG8_BAR;
        PG8_WAIT_V(2); PG8_BAR;
        PG8_STAGE(PG8_SB(1, 0), cB + kstep, voffB); PG8_STAGE(PG8_SA(1, 0), cA + kstep, voffA); PG8_STAGE(PG8_SB(1, 1), cB + hstep + kstep, voffB);
        PG8_WAIT_V(6); PG8_BAR;
    } else {
        PG8_STAGE(PG8_SB(0, 0), cB, voffB); PG8_STAGE(PG8_SA(0, 0), cA, voffA); PG8_STAGE(PG8_SB(0, 1), cB + hstep, voffB); PG8_STAGE(PG8_SA(0, 1), cA + hstep, voffA);
        if (wr == 1) PG8_BAR;
        PG8_WAIT_V(4); PG8_BAR;
        PG8_STAGE(PG8_SB(1, 0), cB + kstep, voffB); PG8_STAGE(PG8_SA(1, 0), cA + kstep, voffA); PG8_STAGE(PG8_SB(1, 1), cB + hstep + kstep, voffB);
        PG8_WAIT_V(6); PG8_BAR;
    }
    for (;;) {
        const bool has_next = S.next(ui + 1, nxt);
        const char* nA = has_next ? (const char*)g.A + (size_t)nxt.pm * tstep : cA; const char* nB = has_next ? (const char*)g.Bt + (size_t)nxt.pn * tstep : cB;
#pragma unroll 1
        for (int t = 0; t < nt; t += 2) {
            const bool last = (t == nt - 2);
            const char* a1 = cA + (size_t)(t + 1) * kstep;
            const char* a2 = last ? nA : cA + (size_t)(t + 2) * kstep; const char* b2 = last ? nB : cB + (size_t)(t + 2) * kstep;
            const char* a3 = a2 + kstep; const char* b3 = b2 + kstep;
            if (last && has_next) S.a_ready(nxt);
            if constexpr (SP2) {
            PG8_LDB(B0, 0, 0); PG8_LDB(B1, 0, 1); PG8_SCHED; PG8_LDA(At, 0, 0); PG8_STAGE(PG8_SA(1, 1), a1 + hstep, voffA);
            PG8_WAIT_V(8); PG8_WAIT_L(0); PG8_BAR; PG8_MMA(0, 0, At, B0); PG8_MMA(0, 1, At, B1); PG8_BAR; PG8_SCHED;
            PG8_LDA(At, 0, 1); PG8_STAGE(PG8_SB(0, 0), b2, voffB); PG8_STAGE(PG8_SB(0, 1), b2 + hstep, voffB); PG8_STAGE(PG8_SA(0, 0), a2, voffA);
            PG8_WAIT_V(8); PG8_WAIT_L(0); PG8_BAR; PG8_MMA(1, 0, At, B0); PG8_MMA(1, 1, At, B1); PG8_BAR; PG8_SCHED;
            PG8_LDB(B0, 1, 0); PG8_LDB(B1, 1, 1); PG8_SCHED; PG8_LDA(At, 1, 0); PG8_STAGE(PG8_SA(0, 1), a2 + hstep, voffA);
            PG8_WAIT_V(8); PG8_WAIT_L(0); PG8_BAR; PG8_MMA(0, 0, At, B0); PG8_MMA(0, 1, At, B1); PG8_BAR; PG8_SCHED;
            PG8_LDA(At, 1, 1); PG8_STAGE(PG8_SB(1, 0), b3, voffB); PG8_STAGE(PG8_SB(1, 1), b3 + hstep, voffB); PG8_STAGE(PG8_SA(1, 0), a3, voffA);
            PG8_WAIT_V(8); PG8_WAIT_L(0); PG8_BAR; PG8_MMA(1, 0, At, B0); PG8_MMA(1, 1, At, B1); PG8_BAR; PG8_SCHED;
            } else {
            PG8_LDB(B0, 0, 0); PG8_SCHED; PG8_LDA(At, 0, 0); PG8_STAGE(PG8_SA(1, 1), a1 + hstep, voffA);
            PG8_WAIT_L(8); PG8_BAR; PG8_WAIT_L(0); PG8_MMA(0, 0, At, B0); PG8_BAR; PG8_SCHED;
            PG8_LDB(B1, 0, 1); PG8_STAGE(PG8_SB(0, 0), b2, voffB);
            PG8_BAR; PG8_WAIT_L(0); PG8_MMA(0, 1, At, B1); PG8_BAR;
            PG8_LDA(At, 0, 1); PG8_STAGE(PG8_SA(0, 0), a2, voffA);
            PG8_BAR; PG8_WAIT_L(0); PG8_MMA(1, 0, At, B0); PG8_BAR; PG8_SCHED;
            PG8_STAGE(PG8_SB(0, 1), b2 + hstep, voffB);
            PG8_WAIT_V(6); PG8_BAR; PG8_MMA(1, 1, At, B1); PG8_BAR;
            PG8_LDB(B0, 1, 0); PG8_SCHED; PG8_LDA(At, 1, 0); PG8_STAGE(PG8_SA(0, 1), a2 + hstep, voffA);
            PG8_WAIT_L(8); PG8_BAR; PG8_WAIT_L(0); PG8_MMA(0, 0, At, B0); PG8_BAR; PG8_SCHED;
            PG8_LDB(B1, 1, 1); PG8_STAGE(PG8_SB(1, 0), b3, voffB);
            PG8_BAR; PG8_WAIT_L(0); PG8_MMA(0, 1, At, B1); PG8_BAR;
            PG8_LDA(At, 1, 1); PG8_STAGE(PG8_SA(1, 0), a3, voffA);
            PG8_BAR; PG8_WAIT_L(0); PG8_MMA(1, 0, At, B0); PG8_BAR; PG8_SCHED;
            PG8_STAGE(PG8_SB(1, 1), b3 + hstep, voffB);
            PG8_WAIT_V(6); PG8_BAR; PG8_MMA(1, 1, At, B1); PG8_BAR;
            }
        }
        if constexpr (ALIGN_EPI) { if (wr == 0) PG8_BAR; }
        if constexpr (!Epi::AFTER_DRAIN) { E(acc, cur, wr, wc, fr, fq); S.done(cur); }
        if (!has_next) break;
#pragma unroll
        for (int a = 0; a < 2; ++a)
#pragma unroll
            for (int b = 0; b < 2; ++b)
#pragma unroll
                for (int m = 0; m < 4; ++m)
#pragma unroll
                    for (int n = 0; n < 2; ++n) acc[a][b][m][n] = (f32x4){0.f, 0.f, 0.f, 0.f};
        cur = nxt; cA = nA; cB = nB; ++ui;
        if constexpr (ALIGN_EPI) { if (wr == 1) PG8_BAR; }
    }
    PG8_WAIT_V(0);
    if constexpr (!ALIGN_EPI) { if (wr == 0) PG8_BAR; }
    PG8_BAR;
    if constexpr (Epi::AFTER_DRAIN) { E.fused(acc, cur, wr, wc, fr, fq, lds, wid, lane); S.done(cur); }
#undef PG8_SA
#undef PG8_SB
#undef PG8_STAGE
#undef PG8_LDA
#undef PG8_LDB
#undef PG8_MMA
#undef PG8_WAIT_V
#undef PG8_WAIT_L
#undef PG8_BAR
#undef PG8_SCHED
}
}

constexpr bool PG_ALIGN = true, PG_SP2 = true;
__device__ __forceinline__ float bflo(unsigned w) { return __builtin_bit_cast(float, w << 16); }
__device__ __forceinline__ float bfhi(unsigned w) { return __builtin_bit_cast(float, w & 0xffff0000u); }
__device__ __forceinline__ unsigned cvtpk(float lo, float hi) { return pg8::cvt_pk_bf16(lo, hi); }

__device__ __forceinline__ void transpose_item(const float* W, int N, int k0, int n0, bf16* WT, int K, size_t dst_row0, LAS float* scr, int lane) {
    float v[32];
#pragma unroll
    for (int i = 0; i < 32; ++i) v[i] = W[(size_t)(k0 + 2 * i + (lane >> 5)) * N + n0 + (lane & 31)];
#pragma unroll
    for (int i = 0; i < 32; ++i) scr[(2 * i + (lane >> 5)) * 33 + (lane & 31)] = v[i];
    asm volatile("s_waitcnt lgkmcnt(0)" ::: "memory");
    const int c = lane & 7;
#pragma unroll
    for (int j = 0; j < 4; ++j) { const int n = (lane >> 3) + 8 * j; const LAS float* s = scr + (8 * c) * 33 + n;
        v4u o; o.x = pk2(s[0 * 33], s[1 * 33]); o.y = pk2(s[2 * 33], s[3 * 33]); o.z = pk2(s[4 * 33], s[5 * 33]); o.w = pk2(s[6 * 33], s[7 * 33]);
        *(v4u*)(WT + (dst_row0 + n) * K + k0 + 8 * c) = o; }
    asm volatile("s_waitcnt lgkmcnt(0)" ::: "memory");
}
__device__ __forceinline__ void convert_weights(Frame& F, int l, int nblk) {
    LAS float* scr = (LAS float*)(F.lds + F.wave * 16384);
    if (F.bid >= nblk) return;
    const int gw = F.bid * (NT / 64) + F.wave, ngw = nblk * (NT / 64);
    constexpr int I_IN = 16 * 96, I_MG = 16 * 96, I_GLU = 8 * 16, I_BR = 3 * 8 * 32, I_O = 16 * 32, I_1 = 32 * 16 * 8, I_3 = I_1, I_2 = 32 * 4 * 32;
    constexpr int NITEMS = I_IN + I_MG + I_GLU + I_BR + I_O + I_1 + I_3 + I_2;
    for (int it = gw; it < NITEMS; it += ngw) {
        int r = it;
        if (r < I_IN) { const int kb = r / 96, nb = r % 96; transpose_item(IN_(I_WIN) + (size_t)l * D * INW, INW, 64 * kb, 32 * nb, (bf16*)(F.ws + WS_WIN), 1024, 32 * nb, scr, F.lane); continue; } r -= I_IN;
        if (r < I_MG) { const int kb = r / 96, nb = r % 96; transpose_item(IN_(I_WMG) + (size_t)l * D * INW, INW, 64 * kb, 32 * nb, (bf16*)(F.ws + WS_WMG), 1024, 32 * nb, scr, F.lane); continue; } r -= I_MG;
        if (r < I_GLU) { const int kb = r / 16, nb = r % 16; transpose_item(IN_(I_WGLU) + (size_t)l * MIXW * MIXW, MIXW, 64 * kb, 32 * nb, (bf16*)(F.ws + WS_WGLU), 512, 32 * nb, scr, F.lane); continue; } r -= I_GLU;
        if (r < I_BR) { const int kk = r / 256, q = r % 256, kb = q / 32, nb = q % 32; transpose_item(IN_(I_WBR) + ((size_t)l * 3 + kk) * MIXW * D, D, 64 * kb, 32 * nb, (bf16*)(F.ws + WS_WBR), 512, (size_t)kk * 1024 + 32 * nb, scr, F.lane); continue; } r -= I_BR;
        if (r < I_O) { const int kb = r / 32, nb = r % 32; transpose_item(IN_(I_WO) + (size_t)l * D * D, D, 64 * kb, 32 * nb, (bf16*)(F.ws + WS_WO), 1024, 32 * nb, scr, F.lane); continue; } r -= I_O;
        if (r < I_1 + I_3) { const int which = r / I_1, q = r % I_1, e = q / 128, q2 = q % 128, kb = q2 / 8, nb = q2 % 8;
            const float* W = IN_(which ? I_W3 : I_W1) + ((size_t)l * NE + e) * D * DFF; const int n0 = 32 * nb;
            transpose_item(W, DFF, 64 * kb, n0, (bf16*)(F.ws + WS_W13), 1024, (size_t)e * 512 + (n0 / 128) * 256 + which * 128 + (n0 % 128), scr, F.lane); continue; } r -= I_1 + I_3;
        { const int e = r / 128, q = r % 128, kb = q / 32, nb = q % 32; transpose_item(IN_(I_W2) + ((size_t)l * NE + e) * DFF * D, D, 64 * kb, 32 * nb, (bf16*)(F.ws + WS_W2), 256, (size_t)e * 1024 + 32 * nb, scr, F.lane); }
    }
    { bf16* wr = (bf16*)(F.ws + WS_WR); const float* wg = IN_(I_WGRP) + (size_t)l * D * 4; const float* we = IN_(I_WEXP) + (size_t)l * D * 32;
      for (int i = F.bid * NT + F.tid; i < 48 * 1024; i += nblk * NT) { const int n = i >> 10, kk = i & 1023; const float w = n < 4 ? wg[kk * 4 + n] : (n < 36 ? we[kk * 32 + n - 4] : 0.f);
          const unsigned hi = f2bf(w); const float lo = w - __builtin_bit_cast(float, hi << 16); wr[i] = (bf16)hi; wr[48 * 1024 + i] = (bf16)f2bf(lo); } }
    { const float* s = IN_(I_WSG) + (size_t)l * 4 * 128 * 128; bf16* d = (bf16*)(F.ws + WS_WSG);
      for (int i = (F.bid * NT + F.tid) * 2; i < 4 * 128 * 128; i += nblk * NT * 2) *(unsigned*)(d + i) = pk2(s[i], s[i + 1]); }
}

struct EpiProj { static constexpr bool PERM = true, AFTER_DRAIN = false; bf16* O;
    __device__ __forceinline__ void operator()(const pg8::f32x4 (&acc)[2][2][4][2], const pg8::Unit& u, int wr, int wc, int fr, int fq) const {
        const int row0 = u.pm * 256 + wr * 64 + fr, col0 = u.pn * 256 + wc * 32 + 8 * fq; const bool act = (u.pn >= 2 && u.pn < 6);
#pragma unroll
        for (int ai = 0; ai < 2; ++ai)
#pragma unroll
            for (int m = 0; m < 4; ++m) { bf16* rowp = O + (size_t)(row0 + ai * 128 + m * 16) * INW + col0;
#pragma unroll
                for (int bj = 0; bj < 2; ++bj) { pg8::f32x4 v0 = acc[ai][bj][m][0], v1 = acc[ai][bj][m][1];
                    if (act) {
#pragma unroll
                        for (int j = 0; j < 4; ++j) { v0[j] = geluf_(v0[j]); v1[j] = geluf_(v1[j]); } }
                    v4u w; w.x = cvtpk(v0[0], v0[1]); w.y = cvtpk(v0[2], v0[3]); w.z = cvtpk(v1[0], v1[1]); w.w = cvtpk(v1[2], v1[3]); *(v4u*)(rowp + bj * 128) = w; } }
    } };
struct EpiGlu { static constexpr bool PERM = true, AFTER_DRAIN = false; const bf16* YG; bf16* YA;
    __device__ __forceinline__ void operator()(const pg8::f32x4 (&acc)[2][2][4][2], const pg8::Unit& u, int wr, int wc, int fr, int fq) const {
        const int row0 = u.pm * 256 + wr * 64 + fr, col0 = u.pn * 256 + wc * 32 + 8 * fq;
#pragma unroll
        for (int ai = 0; ai < 2; ++ai) {
        v4u gv[4][2];
#pragma unroll
            for (int m = 0; m < 4; ++m)
#pragma unroll
                for (int bj = 0; bj < 2; ++bj) gv[m][bj] = *(const v4u*)(YG + (size_t)(row0 + ai * 128 + m * 16) * MIXW + col0 + bj * 128);
        asm volatile("" ::: "memory");
#pragma unroll
            for (int m = 0; m < 4; ++m) { const size_t off = (size_t)(row0 + ai * 128 + m * 16) * MIXW + col0;
#pragma unroll
                for (int bj = 0; bj < 2; ++bj) { const pg8::f32x4 v0 = acc[ai][bj][m][0], v1 = acc[ai][bj][m][1]; const v4u g = gv[m][bj];
                    v4u w; w.x = cvtpk(bflo(g.x) * sigmoidf_(v0[0]), bfhi(g.x) * sigmoidf_(v0[1])); w.y = cvtpk(bflo(g.y) * sigmoidf_(v0[2]), bfhi(g.y) * sigmoidf_(v0[3]));
                    w.z = cvtpk(bflo(g.z) * sigmoidf_(v1[0]), bfhi(g.z) * sigmoidf_(v1[1])); w.w = cvtpk(bflo(g.w) * sigmoidf_(v1[2]), bfhi(g.w) * sigmoidf_(v1[3])); *(v4u*)(YA + off + bj * 128) = w; } }
        asm volatile("" ::: "memory"); }
    } };
__device__ __forceinline__ int xcd_remap(int Lq, int total) { const int q = total >> 3, r = total & 7, x = Lq & 7, off = Lq >> 3; return (x < r ? x * (q + 1) : r * (q + 1) + (x - r) * q) + off; }
struct EpiBr { static constexpr bool PERM = true, AFTER_DRAIN = false; bf16* BR;
    __device__ __forceinline__ void operator()(const pg8::f32x4 (&acc)[2][2][4][2], const pg8::Unit& u, int wr, int wc, int fr, int fq) const {
        const int pm = u.pm % (MT / 256); const int row0 = pm * 256 + wr * 64 + fr, col0 = u.pn * 256 + wc * 32 + 8 * fq;
#pragma unroll
        for (int ai = 0; ai < 2; ++ai)
#pragma unroll
            for (int m = 0; m < 4; ++m) { bf16* rowp = BR + (size_t)(row0 + ai * 128 + m * 16) * INW + col0;
#pragma unroll
                for (int bj = 0; bj < 2; ++bj) { const pg8::f32x4 v0 = acc[ai][bj][m][0], v1 = acc[ai][bj][m][1];
                    v4u w; w.x = cvtpk(v0[0], v0[1]); w.y = cvtpk(v0[2], v0[3]); w.z = cvtpk(v1[0], v1[1]); w.w = cvtpk(v1[2], v1[3]); *(v4u*)(rowp + bj * 128) = w; } }
    } };
struct SchedBr { int G, c, nM;
    __device__ __forceinline__ bool next(int i, pg8::Unit& u) const { const int L0 = i * G + c; if (L0 >= 3 * nM * 4) return false; const int Lq = xcd_remap(L0, 3 * nM * 4); const int k = Lq / (nM * 4), r = Lq % (nM * 4);
        u.pm = k * (MT / 256) + r / 4; u.pn = k * 4 + r % 4; return true; }
    __device__ __forceinline__ void a_ready(const pg8::Unit&) const {}
    __device__ __forceinline__ void done(const pg8::Unit&) const {} };
struct EpiMerge { static constexpr bool PERM = true, AFTER_DRAIN = false; const bf16* BR; bf16* PM; const float* bm;
    __device__ __forceinline__ void operator()(const pg8::f32x4 (&acc)[2][2][4][2], const pg8::Unit& u, int wr, int wc, int fr, int fq) const {
        const int k = u.pn >> 2, dt = u.pn & 3; const int row0 = u.pm * 256 + wr * 64 + fr, col0 = dt * 256 + wc * 32 + 8 * fq;
#pragma unroll
        for (int bj = 0; bj < 2; ++bj) { const pg8::f32x4 b0 = *(const pg8::f32x4*)(bm + k * 1024 + col0 + bj * 128), b1 = *(const pg8::f32x4*)(bm + k * 1024 + col0 + bj * 128 + 4);
#pragma unroll
            for (int ai = 0; ai < 2; ++ai) {
            v4u brv[4], pmv[4];
#pragma unroll
                for (int m = 0; m < 4; ++m) { const size_t r = (size_t)(row0 + ai * 128 + m * 16); brv[m] = *(const v4u*)(BR + r * INW + k * 1024 + col0 + bj * 128);
                    pmv[m] = k > 0 ? *(const v4u*)(PM + r * D + col0 + bj * 128) : (v4u){0u, 0u, 0u, 0u}; }
                asm volatile("" ::: "memory");
#pragma unroll
                for (int m = 0; m < 4; ++m) { const size_t r = (size_t)(row0 + ai * 128 + m * 16); const v4u br = brv[m], o = pmv[m];
                    const pg8::f32x4 v0 = acc[ai][bj][m][0] + b0, v1 = acc[ai][bj][m][1] + b1;
                    float p[8] = {sigmoidf_(v0[0]) * bflo(br.x), sigmoidf_(v0[1]) * bfhi(br.x), sigmoidf_(v0[2]) * bflo(br.y), sigmoidf_(v0[3]) * bfhi(br.y),
                                  sigmoidf_(v1[0]) * bflo(br.z), sigmoidf_(v1[1]) * bfhi(br.z), sigmoidf_(v1[2]) * bflo(br.w), sigmoidf_(v1[3]) * bfhi(br.w)};
                    if (k > 0) { p[0] += bflo(o.x); p[1] += bfhi(o.x); p[2] += bflo(o.y); p[3] += bfhi(o.y); p[4] += bflo(o.z); p[5] += bfhi(o.z); p[6] += bflo(o.w); p[7] += bfhi(o.w); }
                    v4u w; w.x = cvtpk(p[0], p[1]); w.y = cvtpk(p[2], p[3]); w.z = cvtpk(p[4], p[5]); w.w = cvtpk(p[6], p[7]); *(v4u*)(PM + r * D + col0 + bj * 128) = w; }
                asm volatile("" ::: "memory"); } }
    } };
struct SchedMerge { int G, c, nM;
    __device__ __forceinline__ bool next(int i, pg8::Unit& u) const { const int v0 = (i / 3) * G + c, k = i % 3; if (v0 >= nM * 4) return false; const int v = xcd_remap(v0, nM * 4); u.pm = v >> 2; u.pn = k * 4 + (v & 3); return true; }
    __device__ __forceinline__ void a_ready(const pg8::Unit&) const {}
    __device__ __forceinline__ void done(const pg8::Unit&) const {} };
struct EpiWo { static constexpr bool PERM = false, AFTER_DRAIN = false; const float* xs_lat; const float* xs_ctx; float* out; float* xc; const float* mod_l;
    __device__ __forceinline__ void operator()(const pg8::f32x4 (&acc)[2][2][4][2], const pg8::Unit& u, int wr, int wc, int fr, int fq) const {
        const int row0 = u.pm * 256 + wr * 64 + fr, col0 = u.pn * 256 + wc * 32 + 4 * fq;
        const float* ga = mod_l + 2048;
        pg8::f32x4 gv[2][2];
#pragma unroll
        for (int bj = 0; bj < 2; ++bj)
#pragma unroll
            for (int n = 0; n < 2; ++n) gv[bj][n] = *(const pg8::f32x4*)(ga + col0 + bj * 128 + n * 16);
#pragma unroll
        for (int ai = 0; ai < 2; ++ai) {
#pragma unroll
            for (int mp = 0; mp < 2; ++mp) {
            pg8::f32x4 xv[2][2][2];
#pragma unroll
            for (int m = 0; m < 2; ++m) { const size_t off = (size_t)(row0 + ai * 128 + (mp * 2 + m) * 16) * D + col0;
#pragma unroll
                for (int bj = 0; bj < 2; ++bj)
#pragma unroll
                    for (int n = 0; n < 2; ++n) xv[m][bj][n] = *(const pg8::f32x4*)(xs_lat + off + bj * 128 + n * 16); }
            asm volatile("" ::: "memory");
#pragma unroll
            for (int m = 0; m < 2; ++m) { const size_t off = (size_t)(row0 + ai * 128 + (mp * 2 + m) * 16) * D + col0;
#pragma unroll
                for (int bj = 0; bj < 2; ++bj)
#pragma unroll
                    for (int n = 0; n < 2; ++n) *(pg8::f32x4*)(out + off + bj * 128 + n * 16) = xv[m][bj][n] + gv[bj][n] * acc[ai][bj][m + mp * 2][n]; }
            asm volatile("" ::: "memory"); }
        }
    } };
constexpr int MOETAB_OFF = 131072 + 2048;
constexpr int THIN_MAX = 0;
template <int NPN> __device__ __forceinline__ int moe_build_table(Frame& F, const unsigned* cnt) {
    LAS unsigned* tabw = (LAS unsigned*)(F.lds + MOETAB_OFF); LAS unsigned* tabt = tabw + 1024;
    int total = 0, rowtile0 = 0, nt = 0;
    for (int e = 0; e < NE; ++e) { const int n = (int)cnt[e], npad = (n + 255) >> 8, tail = n & 255; const bool thin = tail > 0 && tail <= THIN_MAX; const int neng = thin ? (n >> 8) : npad, nb = thin ? (tail + 15) >> 4 : 0;
        for (int q = F.tid; q < neng * NPN; q += NT) tabw[total + q] = ((unsigned)(rowtile0 + q / NPN) << 16) | (unsigned)(e * NPN + q % NPN);
        for (int q = F.tid; q < nb; q += NT) tabt[nt + q] = ((unsigned)e << 24) | (unsigned)((rowtile0 + neng) * 256 + q * 16);
        total += neng * NPN; rowtile0 += npad; nt += nb; }
    if (F.tid == 0) tabw[2047] = (unsigned)nt;
    __syncthreads();
    return total;
}
struct SchedMoe { int G, c, total; const LAS unsigned* tabw;
    __device__ __forceinline__ bool next(int i, pg8::Unit& u) const { const int L0 = i * G + c; if (L0 >= total) return false; const int Lq = xcd_remap(L0, total); const unsigned w = (unsigned)__builtin_amdgcn_readfirstlane((int)tabw[Lq]); u.pm = (int)(w >> 16); u.pn = (int)(w & 0xffffu); return true; }
    __device__ __forceinline__ void a_ready(const pg8::Unit&) const {}
    __device__ __forceinline__ void done(const pg8::Unit&) const {} };
struct EpiUp { static constexpr bool PERM = true, AFTER_DRAIN = false; bf16* ACT; const float* SW;
    __device__ __forceinline__ void operator()(const pg8::f32x4 (&acc)[2][2][4][2], const pg8::Unit& u, int wr, int wc, int fr, int fq) const {
        const int row0 = u.pm * 256 + wr * 64 + fr, f0 = (u.pn & 1) * 128 + wc * 32 + 8 * fq;
        float wv[2][4];
#pragma unroll
        for (int ai = 0; ai < 2; ++ai)
#pragma unroll
            for (int m = 0; m < 4; ++m) wv[ai][m] = SW[row0 + ai * 128 + m * 16];
        asm volatile("" ::: "memory");
#pragma unroll
        for (int ai = 0; ai < 2; ++ai)
#pragma unroll
            for (int m = 0; m < 4; ++m) { const int slot = row0 + ai * 128 + m * 16; const float w = wv[ai][m];
                const pg8::f32x4 a0 = acc[ai][0][m][0], a1 = acc[ai][0][m][1], b0 = acc[ai][1][m][0], b1 = acc[ai][1][m][1];
                v4u o; o.x = cvtpk(siluf_(a0[0]) * b0[0] * w, siluf_(a0[1]) * b0[1] * w); o.y = cvtpk(siluf_(a0[2]) * b0[2] * w, siluf_(a0[3]) * b0[3] * w);
                o.z = cvtpk(siluf_(a1[0]) * b1[0] * w, siluf_(a1[1]) * b1[1] * w); o.w = cvtpk(siluf_(a1[2]) * b1[2] * w, siluf_(a1[3]) * b1[3] * w);
                *(v4u*)(ACT + (size_t)slot * DFF + f0) = o; }
    } };
struct EpiDown { static constexpr bool PERM = true, AFTER_DRAIN = false; bf16* YS2;
    __device__ __forceinline__ void operator()(const pg8::f32x4 (&acc)[2][2][4][2], const pg8::Unit& u, int wr, int wc, int fr, int fq) const {
        const int row0 = u.pm * 256 + wr * 64 + fr, col0 = (u.pn & 3) * 256 + wc * 32 + 8 * fq;
#pragma unroll
        for (int ai = 0; ai < 2; ++ai)
#pragma unroll
            for (int m = 0; m < 4; ++m) { bf16* rowp = YS2 + (size_t)(row0 + ai * 128 + m * 16) * D + col0;
#pragma unroll
                for (int bj = 0; bj < 2; ++bj) { const pg8::f32x4 v0 = acc[ai][bj][m][0], v1 = acc[ai][bj][m][1];
                    v4u w; w.x = cvtpk(v0[0], v0[1]); w.y = cvtpk(v0[2], v0[3]); w.z = cvtpk(v1[0], v1[1]); w.w = cvtpk(v1[2], v1[3]); *(v4u*)(rowp + bj * 128) = w; } }
    } };


__device__ __forceinline__ void moe_up_thin(Frame& F, int nthin) {
    const bf16* HS = (const bf16*)(F.ws + WS_HS); bf16* ACT = (bf16*)(F.ws + WS_ACT); const float* SW = (const float*)(F.ws + WS_SW); const LAS unsigned* tabt = (const LAS unsigned*)(F.lds + MOETAB_OFF) + 1024;
    const int r = F.lane & 15, q = F.lane >> 4;
    for (int it = F.bid; it < nthin; it += F.G) { const unsigned tw = tabt[it]; const int e = (int)(tw >> 24), s0 = (int)(tw & 0xffffffu);
        const bf16* a = HS + (size_t)(s0 + r) * D + 8 * q; const bf16* W = (const bf16*)(F.ws + WS_W13) + (size_t)e * 512 * D;
        f32x4 acc[2][2] = {{{0.f, 0.f, 0.f, 0.f}, {0.f, 0.f, 0.f, 0.f}}, {{0.f, 0.f, 0.f, 0.f}, {0.f, 0.f, 0.f, 0.f}}};
        const bf16* b0[2];
#pragma unroll
        for (int c = 0; c < 2; ++c) { const int fb = 2 * F.wave + c; b0[c] = W + (size_t)((fb >> 3) * 256 + (fb & 7) * 16 + r) * D + 8 * q; }
#pragma unroll 8
        for (int ks = 0; ks < D / 32; ++ks) { const bf16x8 x = *(const bf16x8*)(a + 32 * ks);
#pragma unroll
            for (int c = 0; c < 2; ++c) { const bf16x8 w1 = *(const bf16x8*)(b0[c] + 32 * ks), w3 = *(const bf16x8*)(b0[c] + (size_t)128 * D + 32 * ks);
                acc[c][0] = __builtin_amdgcn_mfma_f32_16x16x32_bf16(x, w1, acc[c][0], 0, 0, 0); acc[c][1] = __builtin_amdgcn_mfma_f32_16x16x32_bf16(x, w3, acc[c][1], 0, 0, 0); } }
#pragma unroll
        for (int c = 0; c < 2; ++c)
#pragma unroll
            for (int i = 0; i < 4; ++i) { const int slot = s0 + 4 * q + i; const float w = SW[slot]; ACT[(size_t)slot * DFF + (2 * F.wave + c) * 16 + r] = (bf16)f2bf(siluf_(acc[c][0][i]) * acc[c][1][i] * w); }
    }
}
__device__ __forceinline__ void moe_down_thin(Frame& F, int nthin) {
    const bf16* ACT = (const bf16*)(F.ws + WS_ACT); bf16* YS2 = (bf16*)(F.ws + WS_YS2); const LAS unsigned* tabt = (const LAS unsigned*)(F.lds + MOETAB_OFF) + 1024;
    const int r = F.lane & 15, q = F.lane >> 4;
    for (int it = F.bid; it < nthin; it += F.G) { const unsigned tw = tabt[it]; const int e = (int)(tw >> 24), s0 = (int)(tw & 0xffffffu);
        const bf16* a = ACT + (size_t)(s0 + r) * DFF + 8 * q; const bf16* W = (const bf16*)(F.ws + WS_W2) + ((size_t)e * 1024 + 128 * F.wave + r) * DFF + 8 * q;
        f32x4 acc[8];
#pragma unroll
        for (int c = 0; c < 8; ++c) acc[c] = (f32x4){0.f, 0.f, 0.f, 0.f};
#pragma unroll 4
        for (int ks = 0; ks < DFF / 32; ++ks) { const bf16x8 x = *(const bf16x8*)(a + 32 * ks);
#pragma unroll
            for (int c = 0; c < 8; ++c) { const bf16x8 w = *(const bf16x8*)(W + (size_t)c * 16 * DFF + 32 * ks); acc[c] = __builtin_amdgcn_mfma_f32_16x16x32_bf16(x, w, acc[c], 0, 0, 0); } }
#pragma unroll
        for (int c = 0; c < 8; ++c)
#pragma unroll
            for (int i = 0; i < 4; ++i) YS2[(size_t)(s0 + 4 * q + i) * D + 128 * F.wave + c * 16 + r] = (bf16)f2bf(acc[c][i]);
    }
}

__device__ __forceinline__ void ph2_fast(Frame& F, int l) {
    pg8::Gemm g{(const bf16*)(F.ws + WS_H), (const bf16*)(F.ws + WS_WIN), SEQ, INW, D}; pg8::StaticOrder S; S.init(SEQ, INW, F.G, F.bid);
    EpiProj E{(bf16*)(F.ws + WS_PROJ)}; pg8::gemm_phase<EpiProj, pg8::StaticOrder, PG_ALIGN, PG_SP2>(F.lds, g, S, E, F.tid);
}
__device__ __forceinline__ void ph6_fast(Frame& F, int l) {
    pg8::Gemm g{(const bf16*)(F.ws + WS_YG), (const bf16*)(F.ws + WS_WGLU), MT, MIXW, MIXW}; pg8::StaticOrder S; S.init(SEQ, MIXW, F.G, F.bid);
    EpiGlu E{(const bf16*)(F.ws + WS_YG), (bf16*)(F.ws + WS_YS)}; pg8::gemm_phase<EpiGlu, pg8::StaticOrder, PG_ALIGN, PG_SP2>(F.lds, g, S, E, F.tid);
}
__device__ __forceinline__ void ph7_fast(Frame& F, int l) {
    pg8::Gemm g{(const bf16*)(F.ws + WS_YS), (const bf16*)(F.ws + WS_WBR), 3 * MT, 3 * D, MIXW}; SchedBr S{F.G, F.bid, SEQ / 256};
    EpiBr E{(bf16*)(F.ws + WS_PROJ)}; pg8::gemm_phase<EpiBr, SchedBr, PG_ALIGN, PG_SP2>(F.lds, g, S, E, F.tid);
}
__device__ __forceinline__ void ph8_fast(Frame& F, int l) {
    pg8::Gemm g{(const bf16*)(F.ws + WS_H), (const bf16*)(F.ws + WS_WMG), MT, INW, D}; SchedMerge S{F.G, F.bid, SEQ / 256};
    EpiMerge E{(const bf16*)(F.ws + WS_PROJ), (bf16*)(F.ws + WS_PM), IN_(I_BMG) + l * INW}; pg8::gemm_phase<EpiMerge, SchedMerge, PG_ALIGN, PG_SP2>(F.lds, g, S, E, F.tid);
}
__device__ __forceinline__ void ph9_fast(Frame& F, int l) {
    pg8::Gemm g{(const bf16*)(F.ws + WS_PM), (const bf16*)(F.ws + WS_WO), MT, D, D}; pg8::StaticOrder S; S.init(SEQ, D, F.G, F.bid);
    EpiWo E{l == 0 ? IN_(I_X) : F.out, l == 0 ? IN_(I_CTX) : (const float*)(F.ws + WS_XC), F.out, (float*)(F.ws + WS_XC), (const float*)(F.ws + WS_MOD) + (size_t)l * 2 * 6144};
    pg8::gemm_phase<EpiWo, pg8::StaticOrder, PG_ALIGN, PG_SP2>(F.lds, g, S, E, F.tid);
}
__device__ __forceinline__ void ph12_fast(Frame& F, int l) {
    pg8::Gemm g{(const bf16*)(F.ws + WS_HS), (const bf16*)(F.ws + WS_W13), MAXSLOT, NE * 512, D}; const int total = moe_build_table<2>(F, F.ctl + CW_CNT + l * 128); SchedMoe S{F.G, F.bid, total, (const LAS unsigned*)(F.lds + MOETAB_OFF)};
    EpiUp E{(bf16*)(F.ws + WS_ACT), (const float*)(F.ws + WS_SW)}; pg8::gemm_phase<EpiUp, SchedMoe, PG_ALIGN, PG_SP2>(F.lds, g, S, E, F.tid);
    moe_up_thin(F, __builtin_amdgcn_readfirstlane((int)((const LAS unsigned*)(F.lds + MOETAB_OFF))[2047]));
}
__device__ __forceinline__ void ph13_fast(Frame& F, int l) {
    pg8::Gemm g{(const bf16*)(F.ws + WS_ACT), (const bf16*)(F.ws + WS_W2), MAXSLOT, NE * D, DFF}; const int total = moe_build_table<4>(F, F.ctl + CW_CNT + l * 128); SchedMoe S{F.G, F.bid, total, (const LAS unsigned*)(F.lds + MOETAB_OFF)};
    EpiDown E{(bf16*)(F.ws + WS_YS2)}; pg8::gemm_phase<EpiDown, SchedMoe, PG_ALIGN, PG_SP2>(F.lds, g, S, E, F.tid);
    moe_down_thin(F, __builtin_amdgcn_readfirstlane((int)((const LAS unsigned*)(F.lds + MOETAB_OFF))[2047]));
}


constexpr int NSB = MT / 16;
__device__ __forceinline__ void s5_precompute(Frame& F) {
    LAS float* APr = (LAS float*)F.lds; LAS float* APi = APr + 2176; LAS float* BBr = APi + 2176; LAS float* BBi = BBr + 2048; LAS float* CCr = BBi + 2048; LAS float* CCi = CCr + 2048; LAS float* KK = CCi + 2048;
    for (int item = F.G - 1 - F.bid; item < 2 * G5; item += F.G) { const int l = item >> 5, g = item & 31;
        __syncthreads();
        if (F.tid < 128) { const int d = F.tid >> 6, p = F.tid & 63; const int ldg = (l * 2 + d) * G5 + g;
            const double lr = IN_(I_LRE)[ldg * P5 + p], li = IN_(I_LIM)[ldg * P5 + p], dt = exp((double)IN_(I_LDT)[ldg]);
            for (int e = 0; e <= 16; ++e) { const double m = exp(lr * dt * e), ang = li * dt * e; APr[(d * 64 + p) * 17 + e] = (float)(m * cos(ang)); APi[(d * 64 + p) * 17 + e] = (float)(m * sin(ang)); }
            { const double m16 = exp(lr * dt * 16.0), a16 = li * dt * 16.0; float* A16 = (float*)(F.ws + WS_A16) + ((size_t)((l * 32 + g) * 2 + d) * 64 + p) * 2; A16[0] = (float)(m16 * cos(a16)); A16[1] = (float)(m16 * sin(a16)); }
            const double m1 = exp(lr * dt), ar = m1 * cos(li * dt), ai = m1 * sin(li * dt); const double nr = ar - 1.0, ni = ai, den = lr * lr + li * li;
            const double qr = (nr * lr + ni * li) / den, qi = (ni * lr - nr * li) / den;
            for (int h = 0; h < 16; ++h) { const double x = IN_(I_BRE)[((size_t)ldg * P5 + p) * H5 + h], y = IN_(I_BIM)[((size_t)ldg * P5 + p) * H5 + h];
                BBr[(d * 64 + p) * 16 + h] = (float)(qr * x - qi * y); BBi[(d * 64 + p) * 16 + h] = (float)(qr * y + qi * x);
                CCr[(d * 16 + h) * 64 + p] = IN_(I_CRE)[((size_t)ldg * H5 + h) * P5 + p]; CCi[(d * 16 + h) * 64 + p] = IN_(I_CIM)[((size_t)ldg * H5 + h) * P5 + p]; } }
        __syncthreads();
        { const int d = F.tid >> 8, e = (F.tid >> 4) & 15, hp = F.tid & 15;
          float wr[64], wi[64];
#pragma unroll
          for (int p = 0; p < 64; ++p) { const float pr = APr[(d * 64 + p) * 17 + e], pi = APi[(d * 64 + p) * 17 + e], br = BBr[(d * 64 + p) * 16 + hp], bi = BBi[(d * 64 + p) * 16 + hp]; wr[p] = pr * br - pi * bi; wi[p] = pr * bi + pi * br; }
#pragma unroll 1
          for (int h = 0; h < 16; ++h) { float a = 0.f;
#pragma unroll
              for (int p = 0; p < 64; ++p) a += CCr[(d * 16 + h) * 64 + p] * wr[p] - CCi[(d * 16 + h) * 64 + p] * wi[p];
              KK[(d * 16 + e) * 256 + h * 16 + hp] = a; } }
        __syncthreads();
        bf16* M = (bf16*)(F.ws + WS_S5M) + (size_t)(l * 32 + g) * 3 * 65536;
        for (int idx = F.tid; idx < 32768; idx += NT) {
            const int r = idx >> 7, k0 = (idx & 127) * 2; float v[3][2];
#pragma unroll
            for (int q = 0; q < 2; ++q) { const int kk = k0 + q;
                { const int d = r >> 7, p = (r >> 1) & 63, c = r & 1, sg = kk >> 4, hp = kk & 15, e = d == 0 ? 15 - sg : sg;
                  const float pr = APr[(d * 64 + p) * 17 + e], pi = APi[(d * 64 + p) * 17 + e], br = BBr[(d * 64 + p) * 16 + hp], bi = BBi[(d * 64 + p) * 16 + hp];
                  v[0][q] = c == 0 ? pr * br - pi * bi : pr * bi + pi * br; }
                { const int tau = r >> 4, h = r & 15, sg = kk >> 4, hp = kk & 15; float t = 0.f;
                  if (sg <= tau) t += KK[(0 * 16 + (tau - sg)) * 256 + h * 16 + hp]; if (sg >= tau) t += KK[(1 * 16 + (sg - tau)) * 256 + h * 16 + hp]; v[1][q] = t; }
                { const int tau = r >> 4, h = r & 15, d = kk >> 7, p = (kk >> 1) & 63, c = kk & 1, e = d == 0 ? tau + 1 : 16 - tau;
                  const float cr = CCr[(d * 16 + h) * 64 + p], ci = CCi[(d * 16 + h) * 64 + p], pr = APr[(d * 64 + p) * 17 + e], pi = APi[(d * 64 + p) * 17 + e];
                  v[2][q] = c == 0 ? cr * pr - ci * pi : -(cr * pi + ci * pr); } }
#pragma unroll
            for (int m = 0; m < 3; ++m) *(unsigned*)(M + (size_t)m * 65536 + r * 256 + k0) = pk2(v[m][0], v[m][1]);
        }
    }
}
__device__ __forceinline__ void s5_z_phase(Frame& F, int l) {
    const bf16* PROJ = (const bf16*)(F.ws + WS_PROJ); float* Z = (float*)(F.ws + WS_Z);
    const int l15 = F.lane & 15, lq = F.lane >> 4;
    for (int item = F.bid; item < 256; item += F.G) {
        const int g = item >> 3, part = item & 7; const bf16* Fm = (const bf16*)(F.ws + WS_S5M) + (size_t)(l * 32 + g) * 3 * 65536;
        bf16x8 Af[2][8];
#pragma unroll
        for (int j = 0; j < 2; ++j)
#pragma unroll
            for (int ks = 0; ks < 8; ++ks) Af[j][ks] = *(const bf16x8*)(Fm + (size_t)(16 * (2 * F.wave + j) + l15) * 256 + 32 * ks + 8 * lq);
        const bf16* vsrc = PROJ + (size_t)(16 * l15 + 2 * F.wave + (lq >> 1)) * INW + 16 * g + 8 * (lq & 1);
        __syncthreads();
        bf16x8 nv = *(const bf16x8*)(vsrc + (size_t)part * 256 * INW);
        *(LAS bf16x8*)(F.lds + (F.wave * 64 + F.lane) * 16) = nv;
        __syncthreads();
        int cur = 0;
#pragma unroll 1
        for (int tl = part; tl < MT / 256; tl += 8) {
            const bool more = tl + 8 < MT / 256;
            if (more) nv = *(const bf16x8*)(vsrc + (size_t)(tl + 8) * 256 * INW);
            f32x4 acc[2] = {{0.f, 0.f, 0.f, 0.f}, {0.f, 0.f, 0.f, 0.f}};
#pragma unroll
            for (int ks = 0; ks < 8; ++ks) { const bf16x8 V = *(const LAS bf16x8*)(F.lds + cur * 8192 + (ks * 64 + F.lane) * 16);
#pragma unroll
                for (int j = 0; j < 2; ++j) acc[j] = __builtin_amdgcn_mfma_f32_16x16x32_bf16(Af[j][ks], V, acc[j], 0, 0, 0); }
#pragma unroll
            for (int j = 0; j < 2; ++j) *(f32x4*)(Z + ((size_t)(tl * 16 + l15) * 32 + g) * 256 + 16 * (2 * F.wave + j) + 4 * lq) = acc[j];
            if (more) *(LAS bf16x8*)(F.lds + (cur ^ 1) * 8192 + (F.wave * 64 + F.lane) * 16) = nv;
            __syncthreads();
            cur ^= 1;
        }
    }
}
__device__ __forceinline__ int s5_chain_sb(int d, int i) { return d == 0 ? (i < 16 ? 1024 + i : i - 16) : (i < 16 ? 1039 - i : 1023 - (i - 16)); }
__device__ __forceinline__ void s5_scan_phase(Frame& F, int l) {
    LAS float* EX = (LAS float*)F.lds;
    for (int item = F.bid; item < 256; item += F.G) {
        const int cid = item * 16 + (F.tid & 15), j = F.tid >> 4;
        const int g = cid >> 7, d = (cid >> 6) & 1, p = cid & 63;
        const float* A16 = (const float*)(F.ws + WS_A16) + ((size_t)((l * 32 + g) * 2 + d) * 64 + p) * 2; const float ar = A16[0], ai = A16[1];
        const float* Z = (const float*)(F.ws + WS_Z) + (size_t)g * 256 + d * 128 + 2 * p; bf16* SS = (bf16*)(F.ws + WS_SS) + (size_t)g * 256 + d * 128 + 2 * p;
        float2 z[33];
#pragma unroll
        for (int q = 0; q < 33; ++q) { const int i = 33 * j + q; z[q] = i < NSB ? *(const float2*)(Z + (size_t)s5_chain_sb(d, i) * 8192) : make_float2(0.f, 0.f); }
        float hr = 0.f, hi = 0.f, pr = 1.f, pi = 0.f;
#pragma unroll
        for (int q = 0; q < 33; ++q) { if (33 * j + q < NSB) { const float nr = ar * hr - ai * hi + z[q].x, ni = ar * hi + ai * hr + z[q].y; hr = nr; hi = ni; const float qr = pr * ar - pi * ai, qi = pr * ai + pi * ar; pr = qr; pi = qi; } }
        __syncthreads();
        EX[(j * 16 + (F.tid & 15)) * 4 + 0] = hr; EX[(j * 16 + (F.tid & 15)) * 4 + 1] = hi; EX[(j * 16 + (F.tid & 15)) * 4 + 2] = pr; EX[(j * 16 + (F.tid & 15)) * 4 + 3] = pi;
        __syncthreads();
        float cr = 0.f, ci = 0.f;
        for (int i = 0; i < j; ++i) { const float er = EX[(i * 16 + (F.tid & 15)) * 4 + 0], ei = EX[(i * 16 + (F.tid & 15)) * 4 + 1], qr = EX[(i * 16 + (F.tid & 15)) * 4 + 2], qi = EX[(i * 16 + (F.tid & 15)) * 4 + 3];
            const float nr = qr * cr - qi * ci + er, ni = qr * ci + qi * cr + ei; cr = nr; ci = ni; }
        hr = cr; hi = ci;
#pragma unroll
        for (int q = 0; q < 33; ++q) { const int i = 33 * j + q; if (i < NSB) { *(unsigned*)(SS + (size_t)s5_chain_sb(d, i) * 8192) = pk2(hr, hi);
            const float nr = ar * hr - ai * hi + z[q].x, ni = ar * hi + ai * hr + z[q].y; hr = nr; hi = ni; } }
    }
}
__device__ __forceinline__ void s5_y_phase(Frame& F, int l) {
    const bf16* PROJ = (const bf16*)(F.ws + WS_PROJ); const bf16* SS = (const bf16*)(F.ws + WS_SS); bf16* YG = (bf16*)(F.ws + WS_YG); const float* ds = IN_(I_DSKIP) + l * MIXW;
    const int l15 = F.lane & 15, lq = F.lane >> 4;
    for (int item = F.bid; item < 256; item += F.G) {
        const int g = item >> 3, part = item & 7; const bf16* Tm = (const bf16*)(F.ws + WS_S5M) + ((size_t)(l * 32 + g) * 3 + 1) * 65536; const bf16* Em = Tm + 65536;
        bf16x8 At[2][8], Ae[2][8];
#pragma unroll
        for (int j = 0; j < 2; ++j)
#pragma unroll
            for (int ks = 0; ks < 8; ++ks) { const size_t o = (size_t)(16 * (2 * F.wave + j) + l15) * 256 + 32 * ks + 8 * lq; At[j][ks] = *(const bf16x8*)(Tm + o); Ae[j][ks] = *(const bf16x8*)(Em + o); }
        const f32x4 dsk = *(const f32x4*)(ds + 16 * g + 4 * lq);
        const int ntl = l == 0 ? MT / 256 : SEQ / 256;
        const bf16* vsrc = PROJ + (size_t)(16 * l15 + 2 * F.wave + (lq >> 1)) * INW + 16 * g + 8 * (lq & 1);
        const bf16* ssrc = SS + ((size_t)l15 * 32 + g) * 256 + 32 * F.wave + 8 * lq;
        __syncthreads();
        bf16x8 nv = *(const bf16x8*)(vsrc + (size_t)part * 256 * INW), ns = *(const bf16x8*)(ssrc + (size_t)part * 16 * 8192);
        *(LAS bf16x8*)(F.lds + (F.wave * 64 + F.lane) * 16) = nv; *(LAS bf16x8*)(F.lds + 8192 + (F.wave * 64 + F.lane) * 16) = ns;
        __syncthreads();
        int cur = 0;
#pragma unroll 1
        for (int tl = part; tl < ntl; tl += 8) {
            const bool more = tl + 8 < ntl;
            if (more) { nv = *(const bf16x8*)(vsrc + (size_t)(tl + 8) * 256 * INW); ns = *(const bf16x8*)(ssrc + (size_t)(tl + 8) * 16 * 8192); }
            v2u uu[2];
#pragma unroll
            for (int j = 0; j < 2; ++j) uu[j] = *(const v2u*)(PROJ + ((size_t)tl * 256 + 16 * l15 + (2 * F.wave + j)) * INW + 16 * g + 4 * lq);
            f32x4 acc[2] = {{0.f, 0.f, 0.f, 0.f}, {0.f, 0.f, 0.f, 0.f}};
#pragma unroll
            for (int ks = 0; ks < 8; ++ks) { const bf16x8 V = *(const LAS bf16x8*)(F.lds + cur * 16384 + (ks * 64 + F.lane) * 16), S = *(const LAS bf16x8*)(F.lds + cur * 16384 + 8192 + (ks * 64 + F.lane) * 16);
#pragma unroll
                for (int j = 0; j < 2; ++j) { acc[j] = __builtin_amdgcn_mfma_f32_16x16x32_bf16(At[j][ks], V, acc[j], 0, 0, 0); acc[j] = __builtin_amdgcn_mfma_f32_16x16x32_bf16(Ae[j][ks], S, acc[j], 0, 0, 0); } }
#pragma unroll
            for (int j = 0; j < 2; ++j) { const size_t row = (size_t)tl * 256 + 16 * l15 + (2 * F.wave + j); const int ch = 16 * g + 4 * lq; const v2u u = uu[j];
                const float y0 = acc[j][0] + dsk[0] * bflo(u.x), y1 = acc[j][1] + dsk[1] * bfhi(u.x), y2 = acc[j][2] + dsk[2] * bflo(u.y), y3 = acc[j][3] + dsk[3] * bfhi(u.y);
                v2u w; w.x = cvtpk(geluf_(y0), geluf_(y1)); w.y = cvtpk(geluf_(y2), geluf_(y3)); *(v2u*)(YG + row * MIXW + ch) = w; }
            if (more) { *(LAS bf16x8*)(F.lds + (cur ^ 1) * 16384 + (F.wave * 64 + F.lane) * 16) = nv; *(LAS bf16x8*)(F.lds + (cur ^ 1) * 16384 + 8192 + (F.wave * 64 + F.lane) * 16) = ns; }
            __syncthreads();
            cur ^= 1;
        }
    }
}
constexpr int SG_STRIDE = 272, SG_IMG = 256 * SG_STRIDE, SG_STAT = SG_IMG;
__device__ __forceinline__ void sg_fast_chunk(Frame& F, int l, int chunk) {
    const bf16* PROJ = (const bf16*)(F.ws + WS_PROJ); bf16* YB = (bf16*)(F.ws + WS_YS) + (size_t)MT * MIXW; const bf16* WSG = (const bf16*)(F.ws + WS_WSG);
    const float* lg = IN_(I_SGG) + l * MIXW; const float* lb = IN_(I_SGB) + l * MIXW; const float* bsg = IN_(I_BSG) + l * 512;
    LAS float* st = (LAS float*)(F.lds + SG_STAT);
    __syncthreads();
    {
        const int p = F.tid >> 2, part = F.tid & 3; const bf16* vr = PROJ + (size_t)(chunk * 128 + p) * INW + 1024 + part * 128; float s = 0.f, q = 0.f;
#pragma unroll 4
        for (int c = 0; c < 128; c += 8) { const v4u w = *(const v4u*)(vr + c); const float x[8] = {bflo(w.x), bfhi(w.x), bflo(w.y), bfhi(w.y), bflo(w.z), bfhi(w.z), bflo(w.w), bfhi(w.w)};
#pragma unroll
            for (int i = 0; i < 8; ++i) { s += x[i]; q += x[i] * x[i]; } }
        s += shflx(s, 1, F.lane); q += shflx(q, 1, F.lane); s += shflx(s, 2, F.lane); q += shflx(q, 2, F.lane);
        const float mu = s * (1.f / 512.f), var = fmaxf(q * (1.f / 512.f) - mu * mu, 0.f);
        if (part == 0) { st[p * 2] = mu; st[p * 2 + 1] = rsqrtf(var + EPS); }
    }
    const int l15 = F.lane & 15, lq = F.lane >> 4;
#pragma unroll 1
    for (int pass = 0; pass < 2; ++pass) {
        __syncthreads();
#pragma unroll 1
        for (int it = F.tid; it < 2048; it += NT) { const int tp = it & 63, cg = it >> 6; const int p0 = tp * 2, ch = pass * 256 + cg * 8;
            const v4u w0 = *(const v4u*)(PROJ + (size_t)(chunk * 128 + p0) * INW + 1024 + ch), w1 = *(const v4u*)(PROJ + (size_t)(chunk * 128 + p0 + 1) * INW + 1024 + ch);
            const float mu0 = st[p0 * 2], rs0 = st[p0 * 2 + 1], mu1 = st[p0 * 2 + 2], rs1 = st[p0 * 2 + 3];
            const float x0[8] = {bflo(w0.x), bfhi(w0.x), bflo(w0.y), bfhi(w0.y), bflo(w0.z), bfhi(w0.z), bflo(w0.w), bfhi(w0.w)};
            const float x1[8] = {bflo(w1.x), bfhi(w1.x), bflo(w1.y), bfhi(w1.y), bflo(w1.z), bfhi(w1.z), bflo(w1.w), bfhi(w1.w)};
#pragma unroll
            for (int i = 0; i < 8; ++i) { const float gm = lg[ch + i], bt = lb[ch + i];
                *(LAS unsigned*)(F.lds + (cg * 8 + i) * SG_STRIDE + p0 * 2) = pk2((x0[i] - mu0) * rs0 * gm + bt, (x1[i] - mu1) * rs1 * gm + bt); } }
        __syncthreads();
        const int ggl = F.wave >> 2, gg = pass * 2 + ggl, rb0 = (F.wave & 3) * 2;
        bf16x8 A[2][4];
#pragma unroll
        for (int j = 0; j < 2; ++j)
#pragma unroll
            for (int ks = 0; ks < 4; ++ks) A[j][ks] = *(const LAS bf16x8*)(F.lds + (ggl * 128 + (rb0 + j) * 16 + l15) * SG_STRIDE + (32 * ks + 8 * lq) * 2);
        f32x4 acc[2][8];
#pragma unroll
        for (int j = 0; j < 2; ++j)
#pragma unroll
            for (int cb = 0; cb < 8; ++cb) acc[j][cb] = (f32x4){0.f, 0.f, 0.f, 0.f};
#pragma unroll
        for (int cb0 = 0; cb0 < 8; cb0 += 4) {
            bf16x8 B[4][4];
#pragma unroll
            for (int c2 = 0; c2 < 4; ++c2)
#pragma unroll
                for (int ks = 0; ks < 4; ++ks) B[c2][ks] = *(const bf16x8*)(WSG + ((size_t)gg * 128 + (cb0 + c2) * 16 + l15) * 128 + 32 * ks + 8 * lq);
#pragma unroll
            for (int c2 = 0; c2 < 4; ++c2)
#pragma unroll
                for (int ks = 0; ks < 4; ++ks)
#pragma unroll
                    for (int j = 0; j < 2; ++j) acc[j][cb0 + c2] = __builtin_amdgcn_mfma_f32_16x16x32_bf16(A[j][ks], B[c2][ks], acc[j][cb0 + c2], 0, 0, 0);
        }
#pragma unroll
        for (int cb = 0; cb < 8; ++cb) { const int q = cb * 16 + l15; const size_t row = (size_t)chunk * 128 + q; const float bq = bsg[gg * 128 + q];
#pragma unroll
            for (int j = 0; j < 2; ++j) { const int col = gg * 128 + (rb0 + j) * 16 + 4 * lq; const v2u gu = *(const v2u*)(PROJ + row * INW + 512 + col);
                v2u w; w.x = cvtpk(bflo(gu.x) * (acc[j][cb][0] + bq), bfhi(gu.x) * (acc[j][cb][1] + bq)); w.y = cvtpk(bflo(gu.y) * (acc[j][cb][2] + bq), bfhi(gu.y) * (acc[j][cb][3] + bq));
                *(v2u*)(YB + row * MIXW + col) = w; } }
    }
}


__device__ __forceinline__ void thin_acc(f32x4 (&acc)[2], const bf16* A, int lda, const bf16* Bt, int K, int wave, int lane) {
    const int r = lane & 15, q = lane >> 4; const bf16* a0 = A + (size_t)(32 * wave + r) * lda + 8 * q; const bf16* a1 = a0 + (size_t)16 * lda; const bf16* b = Bt + (size_t)r * K + 8 * q;
#pragma unroll 1
    for (int k0 = 0; k0 < K / 32; k0 += 8) {
        bf16x8 x0[8], x1[8], w[8];
#pragma unroll
        for (int j = 0; j < 8; ++j) { x0[j] = *(const bf16x8*)(a0 + 32 * (k0 + j)); x1[j] = *(const bf16x8*)(a1 + 32 * (k0 + j)); w[j] = *(const bf16x8*)(b + 32 * (k0 + j)); }
#pragma unroll
        for (int j = 0; j < 8; ++j) { acc[0] = __builtin_amdgcn_mfma_f32_16x16x32_bf16(x0[j], w[j], acc[0], 0, 0, 0); acc[1] = __builtin_amdgcn_mfma_f32_16x16x32_bf16(x1[j], w[j], acc[1], 0, 0, 0); }
    }
}
#define THIN_FOREACH(acc, body) _Pragma("unroll") for (int _j = 0; _j < 2; ++_j) _Pragma("unroll") for (int _i = 0; _i < 4; ++_i) { const int crow = 32 * F.wave + 16 * _j + 4 * (F.lane >> 4) + _i; const float v = acc[_j][_i]; body }
__device__ __forceinline__ void ph2_ctx(Frame& F, int ncols) {
    const bf16* Hc = (const bf16*)(F.ws + WS_H) + (size_t)SEQ * D; bf16* P = (bf16*)(F.ws + WS_PROJ) + (size_t)SEQ * INW; const bf16* W = (const bf16*)(F.ws + WS_WIN);
    for (int it = F.bid; it < ncols / 16; it += F.G) { const int col = it * 16 + (F.lane & 15); f32x4 acc[2] = {{0.f, 0.f, 0.f, 0.f}, {0.f, 0.f, 0.f, 0.f}};
        thin_acc(acc, Hc, D, W + (size_t)it * 16 * D, D, F.wave, F.lane);
        THIN_FOREACH(acc, { const float o = (col >= 512 && col < 1536) ? geluf_(v) : v; P[(size_t)crow * INW + col] = (bf16)f2bf(o); }) }
}
__device__ __forceinline__ void ph6_ctx(Frame& F) {
    const bf16* YGc = (const bf16*)(F.ws + WS_YG) + (size_t)SEQ * MIXW; bf16* YA = (bf16*)(F.ws + WS_YS) + (size_t)SEQ * MIXW; const bf16* W = (const bf16*)(F.ws + WS_WGLU);
    for (int it = F.bid; it < MIXW / 16; it += F.G) { const int col = it * 16 + (F.lane & 15); f32x4 acc[2] = {{0.f, 0.f, 0.f, 0.f}, {0.f, 0.f, 0.f, 0.f}};
        thin_acc(acc, YGc, MIXW, W + (size_t)it * 16 * MIXW, MIXW, F.wave, F.lane);
        float yv[2][4];
#pragma unroll
        for (int j = 0; j < 2; ++j)
#pragma unroll
            for (int i = 0; i < 4; ++i) yv[j][i] = bf2f(YGc[(size_t)(32 * F.wave + 16 * j + 4 * (F.lane >> 4) + i) * MIXW + col]);
        asm volatile("" ::: "memory");
        THIN_FOREACH(acc, { YA[(size_t)crow * MIXW + col] = (bf16)f2bf(yv[_j][_i] * sigmoidf_(v)); }) }
}
__device__ __forceinline__ void ph7_ctx(Frame& F) {
    bf16* BR = (bf16*)(F.ws + WS_PROJ) + (size_t)SEQ * INW;
    for (int it = F.bid; it < 3 * (D / 16); it += F.G) { const int kk = it / (D / 16), cb = it % (D / 16); const int col = cb * 16 + (F.lane & 15); f32x4 acc[2] = {{0.f, 0.f, 0.f, 0.f}, {0.f, 0.f, 0.f, 0.f}};
        thin_acc(acc, (const bf16*)(F.ws + WS_YS) + ((size_t)kk * MT + SEQ) * MIXW, MIXW, (const bf16*)(F.ws + WS_WBR) + ((size_t)kk * 1024 + cb * 16) * MIXW, MIXW, F.wave, F.lane);
        THIN_FOREACH(acc, { BR[(size_t)crow * INW + kk * 1024 + col] = (bf16)f2bf(v); }) }
}
__device__ __forceinline__ void ph8_ctx(Frame& F, int l) {
    const bf16* Hc = (const bf16*)(F.ws + WS_H) + (size_t)SEQ * D; const bf16* BR = (const bf16*)(F.ws + WS_PROJ) + (size_t)SEQ * INW; bf16* PM = (bf16*)(F.ws + WS_PM) + (size_t)SEQ * D; const float* bm = IN_(I_BMG) + l * INW;
    for (int it = F.bid; it < D / 16; it += F.G) { const int col = it * 16 + (F.lane & 15); float p[2][4] = {};
#pragma unroll 1
        for (int kk = 0; kk < 3; ++kk) { f32x4 acc[2] = {{0.f, 0.f, 0.f, 0.f}, {0.f, 0.f, 0.f, 0.f}};
            thin_acc(acc, Hc, D, (const bf16*)(F.ws + WS_WMG) + ((size_t)kk * 1024 + it * 16) * D, D, F.wave, F.lane);
            const float bb = bm[kk * 1024 + col];
            float bv[2][4];
#pragma unroll
            for (int j = 0; j < 2; ++j)
#pragma unroll
                for (int i = 0; i < 4; ++i) bv[j][i] = bf2f(BR[(size_t)(32 * F.wave + 16 * j + 4 * (F.lane >> 4) + i) * INW + kk * 1024 + col]);
            THIN_FOREACH(acc, { p[_j][_i] += sigmoidf_(v + bb) * bv[_j][_i]; }) }
#pragma unroll
        for (int j = 0; j < 2; ++j)
#pragma unroll
            for (int i = 0; i < 4; ++i) PM[(size_t)(32 * F.wave + 16 * j + 4 * (F.lane >> 4) + i) * D + col] = (bf16)f2bf(p[j][i]); }
}
__device__ __forceinline__ void ph9_ctx(Frame& F, int l) {
    const bf16* PMc = (const bf16*)(F.ws + WS_PM) + (size_t)SEQ * D; float* XC = (float*)(F.ws + WS_XC); const float* xs = l == 0 ? IN_(I_CTX) : (const float*)(F.ws + WS_XC);
    const float* ga = (const float*)(F.ws + WS_MOD) + (size_t)(l * 2 + 1) * 6144 + 2048;
    for (int it = F.bid; it < D / 16; it += F.G) { const int col = it * 16 + (F.lane & 15); f32x4 acc[2] = {{0.f, 0.f, 0.f, 0.f}, {0.f, 0.f, 0.f, 0.f}};
        thin_acc(acc, PMc, D, (const bf16*)(F.ws + WS_WO) + (size_t)it * 16 * D, D, F.wave, F.lane);
        const float gc = ga[col];
        float xv[2][4];
#pragma unroll
        for (int j = 0; j < 2; ++j)
#pragma unroll
            for (int i = 0; i < 4; ++i) xv[j][i] = xs[(size_t)(32 * F.wave + 16 * j + 4 * (F.lane >> 4) + i) * D + col];
        asm volatile("" ::: "memory");
        THIN_FOREACH(acc, { XC[(size_t)crow * D + col] = xv[_j][_i] + gc * v; }) }
}

struct NSmem { float As[16][68]; float Bs[16][68]; };
template <class AF>
__device__ __forceinline__ void ngemm_acc(float (&acc)[4][4], const AF& af, const float* B, int ldb, int K, LAS NSmem* s, int t) {
    const int ty = t >> 4, tx = t & 15, lr = t >> 2, lk = (t & 3) * 4, bk = t >> 4, bn = (t & 15) * 4;
    for (int k0 = 0; k0 < K; k0 += 16) {
        const float4 av = af.load4(lr, k0 + lk);
        const float4 bv = *(const float4*)(B + (size_t)(k0 + bk) * ldb + bn);
        __syncthreads();
        s->As[lk + 0][lr] = av.x; s->As[lk + 1][lr] = av.y; s->As[lk + 2][lr] = av.z; s->As[lk + 3][lr] = av.w;
        *(LAS f32x4*)&s->Bs[bk][bn] = (f32x4){bv.x, bv.y, bv.z, bv.w};
        __syncthreads();
#pragma unroll
        for (int k = 0; k < 16; ++k) {
            const f32x4 a = *(const LAS f32x4*)&s->As[k][ty * 4]; const f32x4 b = *(const LAS f32x4*)&s->Bs[k][tx * 4];
            const float aa[4] = {a.x, a.y, a.z, a.w}, bb[4] = {b.x, b.y, b.z, b.w};
#pragma unroll
            for (int i = 0; i < 4; ++i)
#pragma unroll
                for (int j = 0; j < 4; ++j) acc[i][j] += aa[i] * bb[j];
        }
    }
}
struct ABf { const bf16* A; int lda; __device__ __forceinline__ float4 load4(int r, int k) const { const v2u w = *(const v2u*)(A + (size_t)r * lda + k);
    return make_float4(bf2f((unsigned short)(w.x & 0xffff)), bf2f((unsigned short)(w.x >> 16)), bf2f((unsigned short)(w.y & 0xffff)), bf2f((unsigned short)(w.y >> 16))); } };
#define NTILE_BEGIN(ntiles) { const int _half = F.tid >> 8, t = F.tid & 255, ty = t >> 4, tx = t & 15; LAS NSmem* sm = (LAS NSmem*)F.lds + _half; (void)ty; (void)tx; \
    const int _nt = (ntiles), _nit = (_nt + 2 * F.G - 1) / (2 * F.G); \
    for (int _it = 0; _it < _nit; ++_it) { int T = (_it * F.G + F.bid) * 2 + _half; const bool valid = T < _nt; if (!valid) T = _nt - 1;
#define NTILE_END } }

__device__ __forceinline__ void ph0_prologue(Frame& F) {
    float* mod = (float*)(F.ws + WS_MOD);
    LAS float* SV = (LAS float*)(F.lds + 131072 + 4096);
    for (int i = F.tid; i < 2048; i += NT) SV[i] = siluf_(i < 1024 ? IN_(I_C)[i] : IN_(I_CCTX)[i - 1024]);
    __syncthreads();
    LAS float* RED = (LAS float*)(F.lds + 131072 + 4096 + 8192);
    for (int it = F.bid; it < 2 * 96; it += F.G) { const int l = it / 96, j = (it % 96) * 64 + F.lane;
        const float* W = IN_(I_WADA) + (size_t)l * D * 6144 + j + (size_t)(F.wave * 128) * 6144;
        float a0 = 0.f, a1 = 0.f;
#pragma unroll 32
        for (int kk = 0; kk < 128; ++kk) { const float w = W[(size_t)kk * 6144]; a0 += SV[F.wave * 128 + kk] * w; a1 += SV[1024 + F.wave * 128 + kk] * w; }
        __syncthreads();
        RED[(F.wave * 2 + 0) * 64 + F.lane] = a0; RED[(F.wave * 2 + 1) * 64 + F.lane] = a1;
        __syncthreads();
        if (F.wave < 2) { float s = 0.f;
#pragma unroll
            for (int w8 = 0; w8 < 8; ++w8) s += RED[(w8 * 2 + F.wave) * 64 + F.lane];
            mod[(size_t)(l * 2 + F.wave) * 6144 + j] = s + IN_(I_BADA)[l * 6144 + j]; }
    }
}
__device__ __forceinline__ void hprep_rows(Frame& F, int l) {
    bf16* H = (bf16*)(F.ws + WS_H); const float* g = IN_(I_GMIX) + l * D;
    const int gw = F.bid * (NT / 64) + F.wave, ngw = F.G * (NT / 64);
    for (int row = gw; row < MT; row += ngw) {
        const float* m = mod_ptr(F, l, row); const float* xr = xsrc_row(F, l, row);
        f32x4 v[4]; float s = 0.f;
#pragma unroll
        for (int j = 0; j < 4; ++j) { v[j] = *(const f32x4*)(xr + 4 * F.lane + 256 * j); s += v[j].x * v[j].x + v[j].y * v[j].y + v[j].z * v[j].z + v[j].w * v[j].w; }
        const float rstd = rsqrtf(wave_sum(s, F.lane) * (1.f / D) + EPS);
#pragma unroll
        for (int j = 0; j < 4; ++j) { const int c = 4 * F.lane + 256 * j; const f32x4 gg = *(const f32x4*)(g + c), sc = *(const f32x4*)(m + 1024 + c), sh = *(const f32x4*)(m + c);
            const f32x4 o = v[j] * rstd * gg * (1.f + sc) + sh; v2u w; w.x = pk2(o.x, o.y); w.y = pk2(o.z, o.w); *(v2u*)(H + (size_t)row * D + c) = w; }
    }
}
__device__ __forceinline__ void ph2_naive(Frame& F, int l) {
    const bf16* H = (const bf16*)(F.ws + WS_H); bf16* PROJ = (bf16*)(F.ws + WS_PROJ); const float* W = IN_(I_WIN) + (size_t)l * D * INW;
    NTILE_BEGIN((MT / 64) * (INW / 64))
        const int m0 = (T / (INW / 64)) * 64, n0 = (T % (INW / 64)) * 64;
        float acc[4][4] = {};
        ngemm_acc(acc, ABf{H + (size_t)m0 * D, D}, W + n0, INW, D, sm, t);
        if (valid) {
#pragma unroll
            for (int i = 0; i < 4; ++i) { float o[4];
#pragma unroll
                for (int j = 0; j < 4; ++j) { o[j] = acc[i][j]; if (n0 >= 512 && n0 < 1536) o[j] = geluf_(o[j]); }
                v2u w; w.x = pk2(o[0], o[1]); w.y = pk2(o[2], o[3]); *(v2u*)(PROJ + (size_t)(m0 + ty * 4 + i) * INW + n0 + tx * 4) = w; }
        }
    NTILE_END
}
__device__ __forceinline__ int chain_row(int dir, int pos) { return dir == 0 ? (pos < CTX ? SEQ + pos : pos - CTX) : (pos < CTX ? SEQ + CTX - 1 - pos : SEQ - 1 - (pos - CTX)); }
__device__ __forceinline__ void ph3_s5_naive(Frame& F, int l) {
    LAS float* Cr = (LAS float*)(F.lds + 32768); LAS float* Ci = Cr + 1024; LAS float* Sr = Ci + 1024; LAS float* Si = Sr + 2048;
    const bf16* PROJ = (const bf16*)(F.ws + WS_PROJ); float* YD = (float*)(F.ws + WS_S5);
    for (int item = F.bid; item < 64; item += F.G) {
        if (F.wave == 0) {
            const int g = item >> 1, dir = item & 1, p = F.lane;
            const int ldg = ((l * 2 + dir) * G5 + g);
            const float lr = IN_(I_LRE)[ldg * P5 + p], li = IN_(I_LIM)[ldg * P5 + p], dt = expf(IN_(I_LDT)[ldg]);
            const float er = expf(lr * dt), ar = er * cosf(li * dt), ai = er * sinf(li * dt);
            const float nr = ar - 1.f, ni = ai, den = lr * lr + li * li;
            const float qr = (nr * lr + ni * li) / den, qi = (ni * lr - nr * li) / den;
            float br[16], bi[16];
#pragma unroll
            for (int h = 0; h < 16; ++h) { const float x = IN_(I_BRE)[((size_t)ldg * P5 + p) * H5 + h], y = IN_(I_BIM)[((size_t)ldg * P5 + p) * H5 + h]; br[h] = qr * x - qi * y; bi[h] = qr * y + qi * x; }
            for (int h = 0; h < 16; ++h) { Cr[h * 64 + p] = IN_(I_CRE)[((size_t)ldg * H5 + h) * P5 + p]; Ci[h * 64 + p] = IN_(I_CIM)[((size_t)ldg * H5 + h) * P5 + p]; }
            float sr = 0.f, si = 0.f;
            float* Y = YD + (size_t)dir * MT * MIXW;
#pragma unroll 1
            for (int blk = 0; blk < MT / 32; ++blk) {
#pragma unroll 1
                for (int tt = 0; tt < 32; ++tt) {
                    const int row = chain_row(dir, blk * 32 + tt);
                    const v4u u0 = *(const v4u*)(PROJ + (size_t)row * INW + g * 16), u1 = *(const v4u*)(PROJ + (size_t)row * INW + g * 16 + 8);
                    const unsigned uw[8] = {u0.x, u0.y, u0.z, u0.w, u1.x, u1.y, u1.z, u1.w};
                    float xr = 0.f, xi = 0.f;
#pragma unroll
                    for (int h = 0; h < 8; ++h) { const float ua = bf2f((unsigned short)(uw[h] & 0xffff)), ub = bf2f((unsigned short)(uw[h] >> 16));
                        xr += br[2 * h] * ua + br[2 * h + 1] * ub; xi += bi[2 * h] * ua + bi[2 * h + 1] * ub; }
                    const float nsr = ar * sr - ai * si + xr, nsi = ar * si + ai * sr + xi;
                    sr = nsr; si = nsi; Sr[tt * 64 + p] = sr; Si[tt * 64 + p] = si;
                }
                asm volatile("s_waitcnt lgkmcnt(0)" ::: "memory");
#pragma unroll 1
                for (int o = p; o < 512; o += 64) {
                    const int tt = o >> 4, h = o & 15; float a = 0.f;
#pragma unroll 4
                    for (int q = 0; q < 64; ++q) a += Cr[h * 64 + q] * Sr[tt * 64 + q] - Ci[h * 64 + q] * Si[tt * 64 + q];
                    Y[(size_t)chain_row(dir, blk * 32 + tt) * MIXW + g * 16 + h] = a;
                }
                asm volatile("s_waitcnt lgkmcnt(0)" ::: "memory");
            }
        }
    }
}
__device__ __forceinline__ void ph3_sg_naive(Frame& F, int l) {
    const bf16* PROJ = (const bf16*)(F.ws + WS_PROJ); bf16* YB = (bf16*)(F.ws + WS_YS) + (size_t)MT * MIXW;
    LAS float* stat = (LAS float*)(F.lds + 32768);
    const float* lg = IN_(I_SGG) + l * MIXW; const float* lb = IN_(I_SGB) + l * MIXW;
    NTILE_BEGIN((MT / 128) * 16)
        const int chunk = T >> 4, gg = (T >> 2) & 3, q0 = ((T >> 1) & 1) * 64, c0 = (T & 1) * 64;
        LAS float* st = stat + _half * 256;
        __syncthreads();
        if (t < 128) { const bf16* vr = PROJ + (size_t)(chunk * 128 + t) * INW + 1024; float s = 0.f;
            for (int c = 0; c < 512; c += 2) { const unsigned w = *(const unsigned*)(vr + c); s += bf2f((unsigned short)(w & 0xffff)) + bf2f((unsigned short)(w >> 16)); }
            const float mu = s * (1.f / 512.f); float q = 0.f;
            for (int c = 0; c < 512; c += 2) { const unsigned w = *(const unsigned*)(vr + c); const float a = bf2f((unsigned short)(w & 0xffff)) - mu, b = bf2f((unsigned short)(w >> 16)) - mu; q += a * a + b * b; }
            st[t * 2] = mu; st[t * 2 + 1] = rsqrtf(q * (1.f / 512.f) + EPS); }
        __syncthreads();
        float acc[4][4] = {};
        {
            const float* A = IN_(I_WSG) + ((size_t)(l * 4 + gg) * 128 + q0) * 128;
            const int lr = t >> 2, lk = (t & 3) * 4, bk = t >> 4, bn = (t & 15) * 4;
            for (int k0 = 0; k0 < 128; k0 += 16) {
                const float4 av = *(const float4*)(A + (size_t)lr * 128 + k0 + lk);
                const int p = k0 + bk; const int col = gg * 128 + c0 + bn;
                const v2u w = *(const v2u*)(PROJ + (size_t)(chunk * 128 + p) * INW + 1024 + col);
                const float mu = st[p * 2], rs = st[p * 2 + 1];
                float4 bv; bv.x = (bf2f((unsigned short)(w.x & 0xffff)) - mu) * rs * lg[col] + lb[col]; bv.y = (bf2f((unsigned short)(w.x >> 16)) - mu) * rs * lg[col + 1] + lb[col + 1];
                bv.z = (bf2f((unsigned short)(w.y & 0xffff)) - mu) * rs * lg[col + 2] + lb[col + 2]; bv.w = (bf2f((unsigned short)(w.y >> 16)) - mu) * rs * lg[col + 3] + lb[col + 3];
                __syncthreads();
                sm->As[lk + 0][lr] = av.x; sm->As[lk + 1][lr] = av.y; sm->As[lk + 2][lr] = av.z; sm->As[lk + 3][lr] = av.w;
                *(LAS f32x4*)&sm->Bs[bk][bn] = (f32x4){bv.x, bv.y, bv.z, bv.w};
                __syncthreads();
#pragma unroll
                for (int k = 0; k < 16; ++k) { const f32x4 a = *(const LAS f32x4*)&sm->As[k][ty * 4]; const f32x4 b = *(const LAS f32x4*)&sm->Bs[k][tx * 4];
                    const float aa[4] = {a.x, a.y, a.z, a.w}, bb[4] = {b.x, b.y, b.z, b.w};
#pragma unroll
                    for (int i = 0; i < 4; ++i)
#pragma unroll
                        for (int j = 0; j < 4; ++j) acc[i][j] += aa[i] * bb[j]; }
            }
        }
        if (valid) {
#pragma unroll
            for (int i = 0; i < 4; ++i) { const int q = q0 + ty * 4 + i; const size_t row = (size_t)chunk * 128 + q; const int col = gg * 128 + c0 + tx * 4;
                const float bq = IN_(I_BSG)[l * 512 + gg * 128 + q];
                const v2u gu = *(const v2u*)(PROJ + row * INW + 512 + col);
                v2u w; w.x = pk2(bf2f((unsigned short)(gu.x & 0xffff)) * (acc[i][0] + bq), bf2f((unsigned short)(gu.x >> 16)) * (acc[i][1] + bq));
                w.y = pk2(bf2f((unsigned short)(gu.y & 0xffff)) * (acc[i][2] + bq), bf2f((unsigned short)(gu.y >> 16)) * (acc[i][3] + bq));
                *(v2u*)(YB + row * MIXW + col) = w; }
        }
    NTILE_END
}
__device__ __forceinline__ void ph3_conv(Frame& F, int l, int nrows) {
    const bf16* PROJ = (const bf16*)(F.ws + WS_PROJ); bf16* YC = (bf16*)(F.ws + WS_YS) + (size_t)2 * MT * MIXW; const float* wc = IN_(I_WCONV) + l * 3 * MIXW;
    const size_t gt = (size_t)F.bid * NT + F.tid, ngt = (size_t)F.G * NT;
#pragma unroll 2
    for (size_t i = gt; i < (size_t)nrows * (MIXW / 8); i += ngt) {
        const int row = (int)(i / (MIXW / 8)), c = (int)(i % (MIXW / 8)) * 8;
        int pos, rl; if (row < SEQ) { pos = row & 63; rl = 64; } else { pos = row - SEQ; rl = 256; }
        const bf16* r0 = PROJ + (size_t)row * INW + 1536 + c;
        const v4u zero = {0u, 0u, 0u, 0u};
        const v4u b0 = *(const v4u*)(r0), c0 = *(const v4u*)(r0 + 512), h0 = *(const v4u*)(r0 + 1024);
        const v4u cm = pos > 0 ? *(const v4u*)(r0 - INW + 512) : zero, hm = pos > 0 ? *(const v4u*)(r0 - INW + 1024) : zero;
        const v4u cp = pos < rl - 1 ? *(const v4u*)(r0 + INW + 512) : zero, hp = pos < rl - 1 ? *(const v4u*)(r0 + INW + 1024) : zero;
        const f32x4 w0a = *(const f32x4*)(wc + c), w0b = *(const f32x4*)(wc + c + 4), w1a = *(const f32x4*)(wc + 512 + c), w1b = *(const f32x4*)(wc + 512 + c + 4), w2a = *(const f32x4*)(wc + 1024 + c), w2b = *(const f32x4*)(wc + 1024 + c + 4);
        const float w0[8] = {w0a.x, w0a.y, w0a.z, w0a.w, w0b.x, w0b.y, w0b.z, w0b.w}, w1[8] = {w1a.x, w1a.y, w1a.z, w1a.w, w1b.x, w1b.y, w1b.z, w1b.w}, w2[8] = {w2a.x, w2a.y, w2a.z, w2a.w, w2b.x, w2b.y, w2b.z, w2b.w};
        const unsigned bb[4] = {b0.x, b0.y, b0.z, b0.w}, cc[4] = {c0.x, c0.y, c0.z, c0.w}, hh[4] = {h0.x, h0.y, h0.z, h0.w}, cmv[4] = {cm.x, cm.y, cm.z, cm.w}, hmv[4] = {hm.x, hm.y, hm.z, hm.w}, cpv[4] = {cp.x, cp.y, cp.z, cp.w}, hpv[4] = {hp.x, hp.y, hp.z, hp.w};
        unsigned o[4];
#pragma unroll
        for (int j = 0; j < 4; ++j) {
            const float ylo = bflo(bb[j]) * (w0[2 * j] * (bflo(cmv[j]) * bflo(hmv[j])) + w1[2 * j] * (bflo(cc[j]) * bflo(hh[j])) + w2[2 * j] * (bflo(cpv[j]) * bflo(hpv[j])));
            const float yhi = bfhi(bb[j]) * (w0[2 * j + 1] * (bfhi(cmv[j]) * bfhi(hmv[j])) + w1[2 * j + 1] * (bfhi(cc[j]) * bfhi(hh[j])) + w2[2 * j + 1] * (bfhi(cpv[j]) * bfhi(hpv[j])));
            o[j] = pk2(ylo, yhi); }
        v4u ov; ov.x = o[0]; ov.y = o[1]; ov.z = o[2]; ov.w = o[3]; *(v4u*)(YC + (size_t)row * MIXW + c) = ov;
    }
}
__device__ __forceinline__ void ph5_naive(Frame& F, int l) {
    const bf16* PROJ = (const bf16*)(F.ws + WS_PROJ); const float* YD = (const float*)(F.ws + WS_S5); bf16* YG = (bf16*)(F.ws + WS_YG); const float* ds = IN_(I_DSKIP) + l * MIXW;
    const size_t gt = (size_t)F.bid * NT + F.tid, ngt = (size_t)F.G * NT;
    for (size_t i = gt; i < (size_t)MT * (MIXW / 2); i += ngt) {
        const int row = (int)(i / (MIXW / 2)), c = (int)(i % (MIXW / 2)) * 2;
        const unsigned u = *(const unsigned*)(PROJ + (size_t)row * INW + c); const size_t o = (size_t)row * MIXW + c;
        const float y0 = YD[o] + YD[(size_t)MT * MIXW + o] + ds[c] * bf2f((unsigned short)(u & 0xffff)), y1 = YD[o + 1] + YD[(size_t)MT * MIXW + o + 1] + ds[c + 1] * bf2f((unsigned short)(u >> 16));
        *(unsigned*)(YG + o) = pk2(geluf_(y0), geluf_(y1));
    }
}
__device__ __forceinline__ void ph6_naive(Frame& F, int l) {
    const bf16* YG = (const bf16*)(F.ws + WS_YG); bf16* YA = (bf16*)(F.ws + WS_YS); const float* W = IN_(I_WGLU) + (size_t)l * MIXW * MIXW;
    NTILE_BEGIN((MT / 64) * (MIXW / 64))
        const int m0 = (T / (MIXW / 64)) * 64, n0 = (T % (MIXW / 64)) * 64;
        float acc[4][4] = {};
        ngemm_acc(acc, ABf{YG + (size_t)m0 * MIXW, MIXW}, W + n0, MIXW, MIXW, sm, t);
        if (valid) {
#pragma unroll
            for (int i = 0; i < 4; ++i) { const size_t o = (size_t)(m0 + ty * 4 + i) * MIXW + n0 + tx * 4; const v2u g = *(const v2u*)(YG + o);
                v2u w; w.x = pk2(bf2f((unsigned short)(g.x & 0xffff)) * sigmoidf_(acc[i][0]), bf2f((unsigned short)(g.x >> 16)) * sigmoidf_(acc[i][1]));
                w.y = pk2(bf2f((unsigned short)(g.y & 0xffff)) * sigmoidf_(acc[i][2]), bf2f((unsigned short)(g.y >> 16)) * sigmoidf_(acc[i][3])); *(v2u*)(YA + o) = w; }
        }
    NTILE_END
}
__device__ __forceinline__ void ph7_naive(Frame& F, int l) {
    const bf16* YS = (const bf16*)(F.ws + WS_YS); bf16* BR = (bf16*)(F.ws + WS_PROJ); const float* W = IN_(I_WBR) + (size_t)l * 3 * MIXW * D;
    NTILE_BEGIN((MT / 64) * (INW / 64))
        const int m0 = (T / (INW / 64)) * 64, n0 = (T % (INW / 64)) * 64, k = n0 / 1024, d0 = n0 % 1024;
        float acc[4][4] = {};
        ngemm_acc(acc, ABf{YS + (size_t)k * MT * MIXW + (size_t)m0 * MIXW, MIXW}, W + (size_t)k * MIXW * D + d0, D, MIXW, sm, t);
        if (valid) {
#pragma unroll
            for (int i = 0; i < 4; ++i) { v2u w; w.x = pk2(acc[i][0], acc[i][1]); w.y = pk2(acc[i][2], acc[i][3]); *(v2u*)(BR + (size_t)(m0 + ty * 4 + i) * INW + n0 + tx * 4) = w; }
        }
    NTILE_END
}
__device__ __forceinline__ void ph8_naive(Frame& F, int l) {
    const bf16* H = (const bf16*)(F.ws + WS_H); const bf16* BR = (const bf16*)(F.ws + WS_PROJ); bf16* PM = (bf16*)(F.ws + WS_PM);
    const float* W = IN_(I_WMG) + (size_t)l * D * INW; const float* bm = IN_(I_BMG) + l * INW;
    NTILE_BEGIN((MT / 64) * (D / 64))
        const int m0 = (T / (D / 64)) * 64, n0 = (T % (D / 64)) * 64;
        float out[4][4] = {};
        for (int k = 0; k < 3; ++k) {
            float acc[4][4] = {};
            ngemm_acc(acc, ABf{H + (size_t)m0 * D, D}, W + k * 1024 + n0, INW, D, sm, t);
#pragma unroll
            for (int i = 0; i < 4; ++i) { const v2u b = *(const v2u*)(BR + (size_t)(m0 + ty * 4 + i) * INW + k * 1024 + n0 + tx * 4);
                const float bb[4] = {bf2f((unsigned short)(b.x & 0xffff)), bf2f((unsigned short)(b.x >> 16)), bf2f((unsigned short)(b.y & 0xffff)), bf2f((unsigned short)(b.y >> 16))};
#pragma unroll
                for (int j = 0; j < 4; ++j) out[i][j] += sigmoidf_(acc[i][j] + bm[k * 1024 + n0 + tx * 4 + j]) * bb[j]; }
        }
        if (valid) {
#pragma unroll
            for (int i = 0; i < 4; ++i) { v2u w; w.x = pk2(out[i][0], out[i][1]); w.y = pk2(out[i][2], out[i][3]); *(v2u*)(PM + (size_t)(m0 + ty * 4 + i) * D + n0 + tx * 4) = w; }
        }
    NTILE_END
}
__device__ __forceinline__ void ph9_naive(Frame& F, int l) {
    const bf16* PM = (const bf16*)(F.ws + WS_PM); const float* W = IN_(I_WO) + (size_t)l * D * D;
    NTILE_BEGIN((MT / 64) * (D / 64))
        const int m0 = (T / (D / 64)) * 64, n0 = (T % (D / 64)) * 64;
        float acc[4][4] = {};
        ngemm_acc(acc, ABf{PM + (size_t)m0 * D, D}, W + n0, D, D, sm, t);
        if (valid) {
#pragma unroll
            for (int i = 0; i < 4; ++i) { const int row = m0 + ty * 4 + i, c = n0 + tx * 4; const float* m = mod_ptr(F, l, row) + 2048 + c;
                const f32x4 xs = *(const f32x4*)(xsrc_row(F, l, row) + c);
                f32x4 o; o.x = xs.x + m[0] * acc[i][0]; o.y = xs.y + m[1] * acc[i][1]; o.z = xs.z + m[2] * acc[i][2]; o.w = xs.w + m[3] * acc[i][3];
                *(f32x4*)(xrun_row(F, row) + c) = o; }
        }
    NTILE_END
}
template <int KS>
__device__ __forceinline__ void route_pass(Frame& F, int l, int u, bool valid, int kh, int sl, LAS float* GC, LAS float* SH, LAS float* SSQ, LAS float* LG, LAS int* HISTL) {
    bf16* H = (bf16*)(F.ws + WS_H); const bf16* WRh = (const bf16*)(F.ws + WS_WR); const bf16* WRl = WRh + 48 * 1024;
    const float* bg = IN_(I_BGRP) + l * 4; const float* be = IN_(I_BEXP) + l * 32;
    int* EID = (int*)(F.ws + WS_EID); float* EW = (float*)(F.ws + WS_EW);
    constexpr int NK = 32 / KS, KW = 1024 / KS;
    const int r = F.lane & 15, q = F.lane >> 4;
    const int uu = valid ? u : 0; const int row = uu * 16 + r; const float* xr = xrun_row(F, row) + kh * KW + 8 * q; const int pv = (row >= SEQ ? 1024 : 0) + kh * KW + 8 * q;
    float s = 0.f;
#pragma unroll
    for (int ks = 0; ks < NK; ++ks) { const f32x4 a = *(const f32x4*)(xr + 32 * ks), b = *(const f32x4*)(xr + 32 * ks + 4); s += a.x * a.x + a.y * a.y + a.z * a.z + a.w * a.w + b.x * b.x + b.y * b.y + b.z * b.z + b.w * b.w; }
    s += shflx(s, 16, F.lane); s += shflx(s, 32, F.lane);
    __syncthreads();
    if (q == 0) SSQ[(sl * KS + kh) * 16 + r] = s;
    __syncthreads();
    float tot = 0.f;
#pragma unroll
    for (int i = 0; i < KS; ++i) tot += SSQ[(sl * KS + i) * 16 + r];
    const float rstd = rsqrtf(tot * (1.f / D) + EPS);
    f32x4 acc[3] = {{0.f, 0.f, 0.f, 0.f}, {0.f, 0.f, 0.f, 0.f}, {0.f, 0.f, 0.f, 0.f}};
#pragma unroll 1
    for (int k0 = 0; k0 < NK; k0 += 4) {
        f32x4 xa[4][2]; bf16x8 Bh[4][3], Bl[4][3];
#pragma unroll
        for (int j = 0; j < 4; ++j) { const int c = 32 * (k0 + j); xa[j][0] = *(const f32x4*)(xr + c); xa[j][1] = *(const f32x4*)(xr + c + 4);
#pragma unroll
            for (int cb = 0; cb < 3; ++cb) { const size_t wo = (size_t)(cb * 16 + r) * 1024 + kh * KW + c + 8 * q; Bh[j][cb] = *(const bf16x8*)(WRh + wo); Bl[j][cb] = *(const bf16x8*)(WRl + wo); } }
#pragma unroll
        for (int j = 0; j < 4; ++j) { const int c = 32 * (k0 + j);
            const f32x4 g0 = *(const LAS f32x4*)(GC + pv + c), g1 = *(const LAS f32x4*)(GC + pv + c + 4), sh0 = *(const LAS f32x4*)(SH + pv + c), sh1 = *(const LAS f32x4*)(SH + pv + c + 4);
            const f32x4 h0 = xa[j][0] * rstd * g0 + sh0, h1 = xa[j][1] * rstd * g1 + sh1;
            v4u hi; hi.x = pk2(h0.x, h0.y); hi.y = pk2(h0.z, h0.w); hi.z = pk2(h1.x, h1.y); hi.w = pk2(h1.z, h1.w);
            if (valid) *(v4u*)(H + (size_t)row * D + kh * KW + 8 * q + c) = hi;
            v4u lo; lo.x = pk2(h0.x - bflo(hi.x), h0.y - bfhi(hi.x)); lo.y = pk2(h0.z - bflo(hi.y), h0.w - bfhi(hi.y)); lo.z = pk2(h1.x - bflo(hi.z), h1.y - bfhi(hi.z)); lo.w = pk2(h1.z - bflo(hi.w), h1.w - bfhi(hi.w));
            const bf16x8 Ah = __builtin_bit_cast(bf16x8, hi), Al = __builtin_bit_cast(bf16x8, lo);
#pragma unroll
            for (int cb = 0; cb < 3; ++cb) { acc[cb] = __builtin_amdgcn_mfma_f32_16x16x32_bf16(Ah, Bh[j][cb], acc[cb], 0, 0, 0); acc[cb] = __builtin_amdgcn_mfma_f32_16x16x32_bf16(Al, Bh[j][cb], acc[cb], 0, 0, 0); acc[cb] = __builtin_amdgcn_mfma_f32_16x16x32_bf16(Ah, Bl[j][cb], acc[cb], 0, 0, 0); } }
    }
    LAS float* LGw = LG + (sl * KS + kh) * (16 * 52);
#pragma unroll
    for (int cb = 0; cb < 3; ++cb)
#pragma unroll
        for (int i = 0; i < 4; ++i) LGw[(4 * q + i) * 52 + cb * 16 + r] = acc[cb][i];
    __syncthreads();
    if (kh == 0 && valid && F.lane < 16) { const LAS float* L0 = LG + (sl * KS) * (16 * 52) + F.lane * 52; const int rw = u * 16 + F.lane;
        float lg[36];
#pragma unroll
        for (int o = 0; o < 36; ++o) { float t = 0.f;
#pragma unroll
            for (int i = 0; i < KS; ++i) t += L0[i * (16 * 52) + o]; lg[o] = t + (o < 4 ? bg[o] : be[o - 4]); }
        LAS float* LW = LG + (sl * KS) * (16 * 52) + F.lane * 52;
#pragma unroll
        for (int o = 0; o < 36; ++o) LW[o] = lg[o];
        int gi = 0; float gm = lg[0];
#pragma unroll
        for (int o = 1; o < 4; ++o) if (lg[o] > gm) { gm = lg[o]; gi = o; }
        float den = 0.f;
#pragma unroll
        for (int o = 0; o < 4; ++o) den += expf(lg[o] - gm);
        const float gp = 1.f / den;
        const LAS float* el = LW + 4 + gi * 8;
        int i1 = 0; float m1 = el[0]; for (int o = 1; o < 8; ++o) { const float v = el[o]; if (v > m1) { m1 = v; i1 = o; } }
        int i2 = -1; float m2 = 0.f; for (int o = 0; o < 8; ++o) { const float v = el[o]; if (o != i1 && (i2 < 0 || v > m2)) { m2 = v; i2 = o; } }
        const float e2 = expf(m2 - m1); const float w1 = 1.f / (1.f + e2), w2 = e2 / (1.f + e2);
        const int e1i = gi * 8 + i1, e2i = gi * 8 + i2;
        EID[rw * 2] = e1i; EID[rw * 2 + 1] = e2i; EW[rw * 2] = gp * w1; EW[rw * 2 + 1] = gp * w2;
        __hip_atomic_fetch_add(&HISTL[e1i], 1, __ATOMIC_RELAXED, __HIP_MEMORY_SCOPE_WORKGROUP); __hip_atomic_fetch_add(&HISTL[e2i], 1, __ATOMIC_RELAXED, __HIP_MEMORY_SCOPE_WORKGROUP);
    }
}
__device__ __forceinline__ void ph10_route(Frame& F, int l) {
    const float* g = IN_(I_GFFN) + l * D;
    LAS float* GC = (LAS float*)F.lds;
    LAS float* SH = GC + 2048;
    LAS float* SSQ = SH + 2048;
    LAS float* LG = SSQ + 128;
    LAS int* HISTL = (LAS int*)(LG + 8 * 16 * 52);
    __syncthreads();
    if (F.tid < 32) HISTL[F.tid] = 0;
    for (int i = F.tid; i < 2048; i += NT) { const int w = i >> 10, c = i & 1023; const float* m = (const float*)(F.ws + WS_MOD) + (size_t)(l * 2 + w) * 6144; GC[i] = g[c] * (1.f + m[4096 + c]); SH[i] = m[3072 + c]; }
#pragma unroll 1
    for (int u0 = F.bid; u0 < SEQ / 16; u0 += 4 * F.G) { const int u = u0 + (F.wave >> 1) * F.G; route_pass<2>(F, l, u, u < SEQ / 16, F.wave & 1, F.wave >> 1, GC, SH, SSQ, LG, HISTL); }
    if (l == 0) {
#pragma unroll 1
        for (int u0 = SEQ / 16 + F.bid; u0 < MT / 16; u0 += F.G) route_pass<8>(F, l, u0, true, F.wave, 0, GC, SH, SSQ, LG, HISTL);
    }
    __syncthreads();
    if (F.tid < 32) ((int*)(F.ws + WS_HISTG))[F.bid * 32 + F.tid] = HISTL[F.tid];
}
__device__ __forceinline__ int expert_off(const unsigned* cnt, int e) { int o = 0; for (int i = 0; i < e; ++i) o += ((int)cnt[i] + 255) & ~255; return o; }
__device__ __forceinline__ void ph11_scatter(Frame& F, int l) {
    const bf16* H = (const bf16*)(F.ws + WS_H); bf16* HS = (bf16*)(F.ws + WS_HS);
    const int* EID = (const int*)(F.ws + WS_EID); const float* EW = (const float*)(F.ws + WS_EW); int* STOK = (int*)(F.ws + WS_STOK); float* SW = (float*)(F.ws + WS_SW); int* TSLOT = (int*)(F.ws + WS_TSLOT);
    unsigned* cnt = F.ctl + CW_CNT + l * 128; const int* HISTG = (const int*)(F.ws + WS_HISTG);
    LAS int* HIST = (LAS int*)F.lds; LAS int* BASE = HIST + 32; LAS int* ISLOT = BASE + 32; LAS int* IROW = ISLOT + 512; LAS int* PT = IROW + 512; LAS int* PB = PT + 512;
    const int nunits = (l == 0 ? MT : SEQ) / 16;
    __syncthreads();
    { const int e = F.tid & 31, ch = F.tid >> 5; int tot = 0, bas = 0;
      for (int b = ch; b < F.G; b += 16) { const int h = HISTG[b * 32 + e]; tot += h; if (b < F.bid) bas += h; }
      PT[F.tid] = tot; PB[F.tid] = bas; }
    __syncthreads();
    if (F.tid < 32) { int tot = 0, bas = 0; for (int ch = 0; ch < 16; ++ch) { tot += PT[ch * 32 + F.tid]; bas += PB[ch * 32 + F.tid]; } HIST[F.tid] = 0; PT[F.tid] = tot; PB[F.tid] = bas; if (F.bid == 0) cnt[F.tid] = (unsigned)tot; }
    __syncthreads();
    if (F.tid < 32) { int off = 0; for (int i = 0; i < F.tid; ++i) off += (PT[i] + 255) & ~255; BASE[F.tid] = off + PB[F.tid]; }
    __syncthreads();
    const int w = F.tid >> 5; int u = F.bid + w * F.G; bool valid = u < SEQ / 16;
    if (w == 15) { u = SEQ / 16 + F.bid; valid = u < nunits; }
    const int row = u * 16 + ((F.tid >> 1) & 15), kk = F.tid & 1;
    int e = 0, rank = 0; if (valid) { e = EID[row * 2 + kk]; rank = __hip_atomic_fetch_add(&HIST[e], 1, __ATOMIC_RELAXED, __HIP_MEMORY_SCOPE_WORKGROUP); }
    __syncthreads();
    int slot = -1; if (valid) { slot = BASE[e] + rank; STOK[slot] = row; SW[slot] = EW[row * 2 + kk]; TSLOT[row * 2 + kk] = slot; }
    ISLOT[F.tid] = slot; IROW[F.tid] = row;
    __syncthreads();
#pragma unroll 1
    for (int it0 = F.wave; it0 < NT; it0 += 4 * (NT / 64)) {
        v4u va[4], vb[4]; int sl[4];
#pragma unroll
        for (int j = 0; j < 4; ++j) { const int it = it0 + j * (NT / 64); sl[j] = it < NT ? ISLOT[it] : -1; const int rw = sl[j] >= 0 ? IROW[it] : 0; const v4u* src = (const v4u*)(H + (size_t)rw * D); va[j] = src[F.lane]; vb[j] = src[F.lane + 64]; }
#pragma unroll
        for (int j = 0; j < 4; ++j) if (sl[j] >= 0) { v4u* dst = (v4u*)(HS + (size_t)sl[j] * D); dst[F.lane] = va[j]; dst[F.lane + 64] = vb[j]; }
    }
}
__device__ __forceinline__ int slot_expert(const unsigned* cnt, int slot0, int& seg_off, int& n_e) { int o = 0; for (int e = 0; e < NE; ++e) { const int n = (int)cnt[e], pn = (n + 255) & ~255; if (slot0 < o + pn) { seg_off = o; n_e = n; return e; } o += pn; } seg_off = o; n_e = 0; return 0; }
__device__ __forceinline__ void ph12_naive(Frame& F, int l) {
    const bf16* HS = (const bf16*)(F.ws + WS_HS); bf16* ACT = (bf16*)(F.ws + WS_ACT); const float* SW = (const float*)(F.ws + WS_SW);
    const unsigned* cnt = F.ctl + CW_CNT + l * 128; const int total = expert_off(cnt, NE);
    NTILE_BEGIN((total / 64) * (DFF / 64))
        const int s0 = (T / (DFF / 64)) * 64, n0 = (T % (DFF / 64)) * 64; int seg, n_e; const int e = slot_expert(cnt, s0, seg, n_e);
        float aa[4][4] = {}, ab[4][4] = {};
        ngemm_acc(aa, ABf{HS + (size_t)s0 * D, D}, IN_(I_W1) + ((size_t)l * NE + e) * D * DFF + n0, DFF, D, sm, t);
        ngemm_acc(ab, ABf{HS + (size_t)s0 * D, D}, IN_(I_W3) + ((size_t)l * NE + e) * D * DFF + n0, DFF, D, sm, t);
        if (valid) {
#pragma unroll
            for (int i = 0; i < 4; ++i) { const int slot = s0 + ty * 4 + i; if (slot - seg < n_e) { const float w = SW[slot];
                v2u o; o.x = pk2(siluf_(aa[i][0]) * ab[i][0] * w, siluf_(aa[i][1]) * ab[i][1] * w); o.y = pk2(siluf_(aa[i][2]) * ab[i][2] * w, siluf_(aa[i][3]) * ab[i][3] * w);
                *(v2u*)(ACT + (size_t)slot * DFF + n0 + tx * 4) = o; } }
        }
    NTILE_END
}
__device__ __forceinline__ void ph13_naive(Frame& F, int l) {
    const bf16* ACT = (const bf16*)(F.ws + WS_ACT); bf16* YS2 = (bf16*)(F.ws + WS_YS2);
    const unsigned* cnt = F.ctl + CW_CNT + l * 128; const int total = expert_off(cnt, NE);
    NTILE_BEGIN((total / 64) * (D / 64))
        const int s0 = (T / (D / 64)) * 64, n0 = (T % (D / 64)) * 64; int seg, n_e; const int e = slot_expert(cnt, s0, seg, n_e);
        float acc[4][4] = {};
        ngemm_acc(acc, ABf{ACT + (size_t)s0 * DFF, DFF}, IN_(I_W2) + ((size_t)l * NE + e) * DFF * D + n0, D, DFF, sm, t);
        if (valid) {
#pragma unroll
            for (int i = 0; i < 4; ++i) { const int slot = s0 + ty * 4 + i; if (slot - seg < n_e) { v2u o; o.x = pk2(acc[i][0], acc[i][1]); o.y = pk2(acc[i][2], acc[i][3]); *(v2u*)(YS2 + (size_t)slot * D + n0 + tx * 4) = o; } }
        }
    NTILE_END
}
__device__ __forceinline__ void ph14_combine(Frame& F, int l) {
    const bf16* YS2 = (const bf16*)(F.ws + WS_YS2); const int* TSLOT = (const int*)(F.ws + WS_TSLOT); bf16* H = (bf16*)(F.ws + WS_H);
    const int gw = F.bid * (NT / 64) + F.wave, ngw = F.G * (NT / 64);
    const int nrows = l == 0 ? MT : SEQ;
    for (int row0 = gw; row0 < nrows; row0 += 2 * ngw) {
        f32x4 v[2][4]; float s[2] = {0.f, 0.f}; int rows[2]; bool ok[2];
#pragma unroll
        for (int t = 0; t < 2; ++t) { rows[t] = row0 + t * ngw; ok[t] = rows[t] < nrows; if (!ok[t]) rows[t] = row0; }
        int sl[2][2];
#pragma unroll
        for (int t = 0; t < 2; ++t) { sl[t][0] = TSLOT[rows[t] * 2]; sl[t][1] = TSLOT[rows[t] * 2 + 1]; }
#pragma unroll
        for (int t = 0; t < 2; ++t) { const float* m = mod_ptr(F, l, rows[t]); const float* xr = xrun_row(F, rows[t]);
#pragma unroll
            for (int j = 0; j < 4; ++j) { const int c = 4 * F.lane + 256 * j; const f32x4 x = *(const f32x4*)(xr + c); const f32x4 ga = *(const f32x4*)(m + 5120 + c);
                const v2u a = *(const v2u*)(YS2 + (size_t)sl[t][0] * D + c), b = *(const v2u*)(YS2 + (size_t)sl[t][1] * D + c);
                f32x4 y; y.x = bflo(a.x) + bflo(b.x); y.y = bfhi(a.x) + bfhi(b.x); y.z = bflo(a.y) + bflo(b.y); y.w = bfhi(a.y) + bfhi(b.y);
                v[t][j] = x + ga * y; s[t] += v[t][j].x * v[t][j].x + v[t][j].y * v[t][j].y + v[t][j].z * v[t][j].z + v[t][j].w * v[t][j].w; } }
#pragma unroll
        for (int t = 0; t < 2; ++t) { if (!ok[t]) continue;
            const float rstd = rsqrtf(wave_sum(s[t], F.lane) * (1.f / D) + EPS); float* xr = xrun_row(F, rows[t]);
            if (l == 0) {
                const float* m1 = mod_ptr(F, 1, rows[t]); const float* g = IN_(I_GMIX) + D;
#pragma unroll
                for (int j = 0; j < 4; ++j) { const int c = 4 * F.lane + 256 * j; *(f32x4*)(xr + c) = v[t][j];
                    const f32x4 gg = *(const f32x4*)(g + c), sc = *(const f32x4*)(m1 + 1024 + c), sh = *(const f32x4*)(m1 + c);
                    const f32x4 o = v[t][j] * rstd * gg * (1.f + sc) + sh; v2u w; w.x = pk2(o.x, o.y); w.y = pk2(o.z, o.w); *(v2u*)(H + (size_t)rows[t] * D + c) = w; }
            } else {
                const float* g = IN_(I_GF);
#pragma unroll
                for (int j = 0; j < 4; ++j) { const int c = 4 * F.lane + 256 * j; const f32x4 gg = *(const f32x4*)(g + c); f32x4 o = v[t][j] * rstd * gg;
                    if (PROBE_B >= 0 && rows[t] < 3906) { volatile LAS unsigned long long* TS = (volatile LAS unsigned long long*)(F.lds + TS_OFF); o = o + (0.1f + 0.00001f * (float)(TS[1 + PROBE_B] - TS[PROBE_B])); }
                    if (PROBE_A >= 0 && rows[t] == 0 && j == 0 && F.lane == 0) { volatile LAS unsigned long long* TS = (volatile LAS unsigned long long*)(F.lds + TS_OFF); o.x += 1.f + 0.001f * (float)(TS[1 + PROBE_A] - TS[PROBE_A]); }
                    *(f32x4*)(xr + c) = o; }
            }
        }
    }
}

#ifndef FASTMASK
#define FASTMASK 0xffff
#endif
constexpr unsigned FM = FASTMASK;
constexpr int NPH = 2 + 13 * 2;
__device__ __forceinline__ Frame make_frame(LAS unsigned char* lds, int wave0) {
    Frame F; F.lds = lds; F.wave = wave0; F.lane = (int)__builtin_amdgcn_mbcnt_hi(~0u, __builtin_amdgcn_mbcnt_lo(~0u, 0u)); asm volatile("" : "+v"(F.lane)); F.tid = F.wave * 64 + F.lane; F.bid = blockIdx.x; F.G = gridDim.x; asm volatile("" : "+s"(F.G), "+s"(F.bid));
    F.tab = (const unsigned long long LAS*)(lds + TAB_OFF);
    volatile LAS unsigned long long* t = (volatile LAS unsigned long long*)(lds + TAB_OFF);
    F.ws = (unsigned char*)(GAS unsigned char*)uni64(t[35]); F.out = (float*)(GAS float*)uni64(t[36]); F.ctl = (unsigned*)(F.ws + WS_CTL);
    return F;
}
__global__ void __launch_bounds__(NT, 2) mega_fwd(Args args) {
    extern __shared__ __attribute__((aligned(16))) unsigned char lds_raw[];
    LAS unsigned char* const lds = (LAS unsigned char*)lds_raw;
    const int wave0 = __builtin_amdgcn_readfirstlane((int)threadIdx.x >> 6);
    for (int u = threadIdx.x; u < 1024 / 4; u += NT) ((LAS unsigned*)(lds + 131072))[u] = 0u;
    if (threadIdx.x == 0) { LAS unsigned long long* t = (LAS unsigned long long*)(lds + TAB_OFF);
#pragma unroll
        for (int i = 0; i < 35; ++i) t[i] = (unsigned long long)args.in[i];
        t[35] = (unsigned long long)args.ws; t[36] = (unsigned long long)args.out; }
    __syncthreads();
    { Frame F = make_frame(lds, wave0); (void)xcd_barrier_post(F.ctl + CW_BAR, (volatile LAS unsigned*)(lds + MISC_OFF) + 8); }
    if ((PROBE_A >= 0 || PROBE_B >= 0) && threadIdx.x == 0) ((volatile LAS unsigned long long*)(lds + TS_OFF))[0] = __builtin_amdgcn_s_memrealtime();
    const int lo = args.ph_lo, hi = args.ph_hi; int ph = 0;
#define GRIDBAR() do { Frame Fb = make_frame(lds, wave0); XcdBarrier bar; bar.bar = Fb.ctl + CW_BAR; bar.x = xb_xcc_id(); bar.st = (volatile LAS unsigned*)(lds + MISC_OFF) + 8; xcd_barrier(bar, Fb.tid == 0); } while (0)
#ifndef REPBAR
#define REPBAR 0
#endif
#ifndef REPMASK
#define REPMASK 0
#endif
#define PHASE(...) do { if (lo <= ph && ph < hi) { const int _pl = ph < 2 ? ph : 2 + (ph - 2) % 13; for (int _rep = 0; _rep <= ((REPMASK >> _pl) & 1); ++_rep) { Frame F = make_frame(lds, wave0); __VA_ARGS__; } if (ph + 1 < hi) { GRIDBAR(); if (REPBAR) GRIDBAR(); } if ((PROBE_A >= 0 || PROBE_B >= 0) && threadIdx.x == 0) ((volatile LAS unsigned long long*)(lds + TS_OFF))[1 + ph] = __builtin_amdgcn_s_memrealtime(); } ++ph; } while (0)
    PHASE({ ph0_prologue(F); if (FM >> 3 & 1) s5_precompute(F); __syncthreads(); convert_weights(F, 0, (FM >> 3 & 1) && F.G > 128 ? F.G - 64 : F.G); { const f32x4* s = (const f32x4*)IN_(I_CTX); f32x4* d = (f32x4*)(F.ws + WS_XC); for (int i = F.bid * NT + F.tid; i < CTX * D / 4; i += F.G * NT) d[i] = s[i]; } });
    PHASE(hprep_rows(F, 0));
#pragma unroll 1
    for (int l = 0; l < 2; ++l) {
        PHASE({ if (FM >> 2 & 1) { ph2_fast(F, l); ph2_ctx(F, l == 0 ? INW : MIXW); } else ph2_naive(F, l); });
        PHASE({ if (FM >> 3 & 1) { s5_z_phase(F, l); const int nch = (l == 0 ? MT : SEQ) / 128; if (F.G > nch) { if (F.bid < nch) sg_fast_chunk(F, l, F.bid); else { Frame F2 = F; F2.bid -= nch; F2.G -= nch; ph3_conv(F2, l, l == 0 ? MT : SEQ); } } else { for (int c = F.bid; c < nch; c += F.G) sg_fast_chunk(F, l, c); ph3_conv(F, l, l == 0 ? MT : SEQ); } } else { ph3_s5_naive(F, l); if (F.bid >= 64) { Frame F2 = F; F2.bid -= 64; F2.G -= 64; ph3_sg_naive(F2, l); ph3_conv(F2, l, MT); } } });
        PHASE({ if (FM >> 3 & 1) s5_scan_phase(F, l); });
        PHASE({ if (FM >> 3 & 1) s5_y_phase(F, l); else ph5_naive(F, l); });
        PHASE({ if (FM >> 6 & 1) { ph6_fast(F, l); if (l == 0) ph6_ctx(F); } else ph6_naive(F, l); });
        PHASE({ if (FM >> 7 & 1) { ph7_fast(F, l); if (l == 0) ph7_ctx(F); } else ph7_naive(F, l); });
        PHASE({ if (FM >> 8 & 1) { ph8_fast(F, l); if (l == 0) ph8_ctx(F, l); } else ph8_naive(F, l); });
        PHASE({ if (FM >> 9 & 1) { ph9_fast(F, l); if (l == 0) ph9_ctx(F, l); } else ph9_naive(F, l); });
        PHASE(ph10_route(F, l));
        PHASE(ph11_scatter(F, l));
        PHASE({ if (FM >> 12 & 1) ph12_fast(F, l); else ph12_naive(F, l); });
        PHASE({ if (FM >> 13 & 1) ph13_fast(F, l); else ph13_naive(F, l); });
        PHASE({ ph14_combine(F, l); if (l == 0) convert_weights(F, 1, F.G); });
    }
#undef PHASE
}

extern "C" void kernel_launch(void* const* d_in, const int* in_sizes, int n_in, void* d_out, int out_size, void* d_ws, size_t ws_size, hipStream_t stream) {
    static int grid = 0;
    if (grid == 0) {
        int dev = 0, cus = 0, per_cu = 0;
        if (n_in != 35 || out_size != SEQ * D || ws_size < WS_END) { fprintf(stderr, "kernel_launch: unexpected shapes (n_in %d out %d ws %zu)\n", n_in, out_size, ws_size); grid = -1; return; }
        if (hipGetDevice(&dev) != hipSuccess || hipDeviceGetAttribute(&cus, hipDeviceAttributeMultiprocessorCount, dev) != hipSuccess) { grid = -1; return; }
        if (hipFuncSetAttribute((const void*)mega_fwd, hipFuncAttributeMaxDynamicSharedMemorySize, LDS_BYTES) != hipSuccess) { fprintf(stderr, "kernel_launch: hipFuncSetAttribute failed\n"); grid = -1; return; }
        if (hipOccupancyMaxActiveBlocksPerMultiprocessor(&per_cu, (const void*)mega_fwd, NT, LDS_BYTES) != hipSuccess || per_cu < 1) { fprintf(stderr, "kernel_launch: occupancy query says %d blocks per CU\n", per_cu); grid = -1; return; }
        grid = cus;
    }
    if (grid < 0) return;
    (void)hipMemsetAsync((char*)d_ws + WS_CTL, 0, CTL_ZERO_BYTES, stream);
    Args a{};
    for (int i = 0; i < 35; ++i) a.in[i] = (const float*)d_in[i];
    a.out = (float*)d_out; a.ws = (unsigned char*)d_ws; a.ph_lo = 0; a.ph_hi = NPH;
    void* kargs[] = {&a};
    hipError_t e = hipLaunchCooperativeKernel((const void*)mega_fwd, dim3(grid), dim3(NT), kargs, LDS_BYTES, stream);
    if (e != hipSuccess) fprintf(stderr, "kernel_launch: cooperative launch failed: %s (grid %d)\n", hipGetErrorString(e), grid);
}
```

```cpp
#include <hip/hip_runtime.h>
#include <stdint.h>
#include <cstdio>

#define GAS __attribute__((address_space(1)))
#define LAS __attribute__((address_space(3)))
typedef unsigned short bf16;
typedef unsigned v4u __attribute__((ext_vector_type(4)));
typedef unsigned v2u __attribute__((ext_vector_type(2)));
typedef float f32x4 __attribute__((ext_vector_type(4)));
typedef short bf16x8 __attribute__((ext_vector_type(8)));

constexpr int D = 1024, SEQ = 16384, CTX = 256, MT = SEQ + CTX;
constexpr int MIXW = 512, INW = 3072, G5 = 32, P5 = 64, H5 = 16;
constexpr int NE = 32, DFF = 256;
constexpr int MAXSLOT = 2 * MT + NE * 256;
constexpr float EPS = 1e-6f;
constexpr int NT = 512;

constexpr size_t MiB = 1u << 20;
constexpr size_t WS_CTL = 0, CTL_ZERO_BYTES = 1 * MiB;
constexpr size_t WS_MOD = 1 * MiB;
constexpr size_t WS_XC = 2 * MiB;
constexpr size_t WS_EID = 3 * MiB;
constexpr size_t WS_EW = WS_EID + (size_t)MT * 8;
constexpr size_t WS_STOK = WS_EW + (size_t)MT * 8;
constexpr size_t WS_SW = WS_STOK + (size_t)MAXSLOT * 4;
constexpr size_t WS_TSLOT = WS_SW + (size_t)MAXSLOT * 4;
constexpr size_t WS_HISTG = WS_TSLOT + (size_t)MT * 8;
constexpr size_t WS_H = 4 * MiB;
constexpr size_t WS_PROJ = WS_H + (size_t)MT * 2048;
constexpr size_t WS_YS = WS_PROJ + (size_t)MT * 6144;
constexpr size_t WS_YG = WS_YS + (size_t)3 * MT * 1024;
constexpr size_t WS_PM = WS_YG + (size_t)MT * 1024;
constexpr size_t WS_S5 = WS_PM + (size_t)MT * 2048;
constexpr size_t WS_Z = WS_S5;
constexpr size_t WS_SS = WS_Z + (size_t)1040 * 32 * 256 * 4;
constexpr size_t WS_S5M = WS_SS + (size_t)1040 * 32 * 256 * 2;
constexpr size_t WS_A16 = WS_S5M + (size_t)2 * 32 * 3 * 65536 * 2;
constexpr size_t WS_W = WS_A16 + (size_t)2 * 32 * 2 * 64 * 2 * 4 > WS_S5 + (size_t)2 * MT * 512 * 4 ? WS_A16 + (size_t)2 * 32 * 2 * 64 * 2 * 4 : WS_S5 + (size_t)2 * MT * 512 * 4;
constexpr size_t WS_WIN = WS_W;
constexpr size_t WS_WMG = WS_WIN + (size_t)3072 * 1024 * 2;
constexpr size_t WS_WGLU = WS_WMG + (size_t)3072 * 1024 * 2;
constexpr size_t WS_WBR = WS_WGLU + (size_t)512 * 512 * 2;
constexpr size_t WS_WO = WS_WBR + (size_t)3 * 1024 * 512 * 2;
constexpr size_t WS_W13 = WS_WO + (size_t)1024 * 1024 * 2;
constexpr size_t WS_W2 = WS_W13 + (size_t)32 * 512 * 1024 * 2;
constexpr size_t WS_WSG = WS_W2 + (size_t)32 * 1024 * 256 * 2;
constexpr size_t WS_WR = WS_WSG + (size_t)4 * 128 * 128 * 2;
constexpr size_t WS_END = WS_WR + (size_t)2 * 48 * 1024 * 2;
static_assert(WS_END <= (size_t)377 * MiB, "workspace budget");
constexpr size_t WS_HS = WS_PROJ;
constexpr size_t WS_ACT = WS_YS;
constexpr size_t WS_YS2 = WS_YG;
static_assert(WS_HS + (size_t)MAXSLOT * 2048 <= WS_YS && WS_ACT + (size_t)MAXSLOT * 512 <= WS_YG && WS_YS2 + (size_t)MAXSLOT * 2048 <= WS_W, "moe overlays");
static_assert(WS_HISTG + (size_t)1024 * 32 * 4 <= WS_H, "ws map");
constexpr int CW_CNT = 64;
constexpr int CW_BAR = 4096;

#ifndef PROBE_A
#define PROBE_A -1
#endif
#ifndef PROBE_B
#define PROBE_B -1
#endif
constexpr int TS_OFF = 131072 + 512;
constexpr int LDS_BYTES = 147456;
constexpr int MISC_OFF = 131072 + 320;
constexpr int TAB_OFF = 131072 + 1024;

__device__ __forceinline__ float bf2f(unsigned short b) { return __builtin_bit_cast(float, ((unsigned)b) << 16); }
__device__ __forceinline__ unsigned f2bf(float f) { unsigned u = __builtin_bit_cast(unsigned, f); return (u + 0x7fffu + ((u >> 16) & 1u)) >> 16; }
__device__ __forceinline__ unsigned pk2(float lo, float hi) { return f2bf(lo) | (f2bf(hi) << 16); }
__device__ __forceinline__ float sigmoidf_(float x) { return __builtin_amdgcn_rcpf(1.f + __expf(-x)); }
__device__ __forceinline__ float siluf_(float x) { return x * __builtin_amdgcn_rcpf(1.f + __expf(-x)); }
__device__ __forceinline__ float geluf_(float x) { const float u = 0.7978845608028654f * (x + 0.044715f * x * x * x); return x * __builtin_amdgcn_rcpf(1.f + __expf(-2.f * u)); }
__device__ __forceinline__ float shflx(float v, int mask, int lane) { return __builtin_bit_cast(float, __builtin_amdgcn_ds_bpermute((lane ^ mask) << 2, __builtin_bit_cast(int, v))); }
__device__ __forceinline__ float wave_sum(float v, int lane) {
#pragma unroll
    for (int o = 1; o < 64; o <<= 1) v += shflx(v, o, lane);
    return v;
}

#define XB_TMO      128
#define XB_XCNT(j)  (256  + 64 * (j))
#define XB_XSUB(j)  (1280 + 64 * (j))
#define XB_XGEN(j)  (2304 + 64 * (j))
#define XB_TOP      3328
#define XB_TOPGEN   3392
#define XCD_BAR_WORDS 3456
#define XB_SPIN_CAP (1u << 24)
__device__ __forceinline__ unsigned xb_ld(unsigned* p)              { return __hip_atomic_load(p, __ATOMIC_RELAXED, __HIP_MEMORY_SCOPE_AGENT); }
__device__ __forceinline__ unsigned xb_add(unsigned* p, unsigned v) { return __hip_atomic_fetch_add(p, v, __ATOMIC_RELAXED, __HIP_MEMORY_SCOPE_AGENT); }
__device__ __forceinline__ unsigned xb_xcc_id() { return (unsigned)__builtin_amdgcn_s_getreg((3 << 11) | 20) & 0xFu; }
#define XB_SPIN(cond, bar) do { unsigned _sp = 0; while (cond) { __builtin_amdgcn_s_sleep(1); \
    if ((++_sp & 255u) == 0u) { if (xb_ld(&(bar)[XB_TMO])) break; if (_sp > XB_SPIN_CAP) { atomicAdd(&(bar)[XB_TMO], 1u); break; } } } } while (0)
struct XcdBarrier { unsigned* bar; unsigned x; volatile LAS unsigned* st; };
__device__ __forceinline__ XcdBarrier xcd_barrier_post(unsigned* bar, volatile LAS unsigned* st) {
    XcdBarrier b; b.bar = bar; b.x = xb_xcc_id(); b.st = st;
    if (threadIdx.x == 0) (void)xb_add(&bar[XB_XCNT(b.x)], 1u);
    return b;
}
__device__ __forceinline__ void xcd_barrier_complete(unsigned* bar, unsigned x, unsigned& nloc, unsigned& nx) {
    const unsigned G = gridDim.x * gridDim.y * gridDim.z;
    unsigned sum, cnt, mine, sp = 0u;
    for (;;) {
        sum = 0u; cnt = 0u; mine = 0u;
#pragma unroll
        for (unsigned j = 0; j < 16; ++j) { const unsigned c = xb_ld(&bar[XB_XCNT(j)]); sum += c; cnt += (c > 0u) ? 1u : 0u; mine = (j == x) ? c : mine; }
        if (sum == G) break;
        __builtin_amdgcn_s_sleep(1);
        if ((++sp & 255u) == 0u) { if (xb_ld(&bar[XB_TMO])) break; if (sp > XB_SPIN_CAP) { atomicAdd(&bar[XB_TMO], 1u); break; } }
    }
    nloc = mine > 0u ? mine : 1u; nx = cnt > 0u ? cnt : 1u;
}
__device__ __forceinline__ void xcd_barrier(const XcdBarrier& b, bool leader) {
    asm volatile("s_waitcnt vmcnt(0)" ::: "memory");
    __syncthreads();
    if (leader) {
        unsigned* bar = b.bar;
        __builtin_amdgcn_s_waitcnt(0);
        unsigned nloc = b.st[0], nx = b.st[1];
        if (nloc == 0u) { xcd_barrier_complete(bar, b.x, nloc, nx); b.st[0] = nloc; b.st[1] = nx; }
        const unsigned old = xb_add(&bar[XB_XSUB(b.x)], 1u);
        const unsigned gen = old / nloc;
        if (old + 1u == (gen + 1u) * nloc) {
            __builtin_amdgcn_fence(__ATOMIC_RELEASE, "agent");
            asm volatile("s_waitcnt vmcnt(0)" ::: "memory");
            const unsigned og = xb_add(&bar[XB_TOP], 1u);
            const unsigned tg = og / nx;
            if (og + 1u == (tg + 1u) * nx) xb_add(&bar[XB_TOPGEN], 1u);
            else XB_SPIN(xb_ld(&bar[XB_TOPGEN]) == tg, bar);
            __builtin_amdgcn_fence(__ATOMIC_ACQUIRE, "agent");
            xb_add(&bar[XB_XGEN(b.x)], 1u);
            asm volatile("s_waitcnt vmcnt(0)" ::: "memory");
        } else {
            XB_SPIN(xb_ld(&bar[XB_XGEN(b.x)]) == gen, bar);
            __builtin_amdgcn_fence(__ATOMIC_ACQUIRE, "agent");
            asm volatile("s_waitcnt vmcnt(0)" ::: "memory");
        }
    }
    __syncthreads();
}

struct Args { const float* in[35]; float* out; unsigned char* ws; int ph_lo, ph_hi; };
struct Frame {
    LAS unsigned char* lds; unsigned char* ws; unsigned* ctl;
    int tid, lane, wave, bid, G;
    const unsigned long long LAS* tab; float* out;
};
__device__ __forceinline__ unsigned long long uni64(unsigned long long v) { const unsigned lo = __builtin_amdgcn_readfirstlane((unsigned)v), hi = __builtin_amdgcn_readfirstlane((unsigned)(v >> 32)); return ((unsigned long long)hi << 32) | lo; }
#define IN_(k) ((const float*)(const GAS float*)uni64(F.tab[k]))
enum { I_X = 0, I_C, I_CTX, I_CCTX, I_WADA, I_BADA, I_GMIX, I_GFFN, I_WIN, I_LRE, I_LIM, I_LDT, I_BRE, I_BIM, I_CRE, I_CIM, I_DSKIP, I_WGLU, I_SGG, I_SGB, I_WSG, I_BSG,
       I_WCONV, I_WBR, I_WMG, I_BMG, I_WO, I_WGRP, I_BGRP, I_WEXP, I_BEXP, I_W1, I_W3, I_W2, I_GF };

__device__ __forceinline__ const float* mod_ptr(const Frame& F, int l, int row) { return (const float*)(F.ws + WS_MOD) + (size_t)(l * 2 + (row >= SEQ ? 1 : 0)) * 6144; }
__device__ __forceinline__ const float* xsrc_row(const Frame& F, int l, int row) {
    if (l == 0) return row < SEQ ? IN_(I_X) + (size_t)row * D : IN_(I_CTX) + (size_t)(row - SEQ) * D;
    return row < SEQ ? F.out + (size_t)row * D : (const float*)(F.ws + WS_XC) + (size_t)(row - SEQ) * D;
}
__device__ __forceinline__ float* xrun_row(const Frame& F, int row) { return row < SEQ ? F.out + (size_t)row * D : (float*)(F.ws + WS_XC) + (size_t)(row - SEQ) * D; }


namespace pg8 {
#define PG8_LAS __attribute__((address_space(3)))
typedef unsigned short bf16_t;
typedef short bf16x8 __attribute__((ext_vector_type(8)));
typedef float f32x4 __attribute__((ext_vector_type(4)));
typedef unsigned u32x4 __attribute__((ext_vector_type(4)));
constexpr int BM = 256, BK = 64, HALF = 128, HTB = HALF * BK * 2  , STAGE_BYTES = 8 * HTB, NXCD = 8, WGM = 8;

__host__ __device__ __forceinline__ int lds_byte(int r, int c) { const int st = (r >> 4) * 2 + (c >> 5), rr = r & 15, cc = c & 31, ob = rr * 64 + cc * 2; return st * 1024 + (ob ^ (((ob >> 9) & 1) << 5)); }
__host__ __device__ __forceinline__ void stage_rc(int b, int& R, int& C) { const int st = b / 1024, sb = b % 1024, swz = sb ^ (((sb >> 9) & 1) << 5); R = (st >> 1) * 16 + swz / 64; C = (st & 1) * 32 + (swz % 64) / 2; }
__host__ __device__ __forceinline__ int perm32(int rho) { const int n = rho >> 4, i = rho & 15; return 8 * (i >> 2) + 4 * n + (i & 3); }

struct Unit { int pm, pn; };
struct Gemm { const bf16_t* A; const bf16_t* Bt; int M, N, K; };

struct StaticOrder {
    int nM, nN, nwg, G, c;
    __host__ __device__ void init(int M, int N, int G_, int c_) { nM = M / BM; nN = N / BM; nwg = nM * nN; G = G_; c = c_; }
    __host__ __device__ bool next(int i, Unit& u) const {
        const long L = (long)i * G + c; if (L >= nwg) return false;
        int wgid = (int)L; { const int q = nwg / NXCD, r = nwg % NXCD, xcd = wgid % NXCD, off = wgid / NXCD; wgid = (xcd < r ? xcd * (q + 1) : r * (q + 1) + (xcd - r) * q) + off; }
        const int nig = WGM * nN, gid = wgid / nig, fm = gid * WGM, gsz = (nM - fm) < WGM ? (nM - fm) : WGM;
        u.pm = fm + ((wgid % nig) % gsz); u.pn = (wgid % nig) / gsz; return true;
    }
    __device__ __forceinline__ void a_ready(const Unit&) const {}
    __device__ __forceinline__ void done(const Unit&) const {}
};
__device__ __forceinline__ unsigned cvt_pk_bf16(float lo, float hi) { unsigned r; asm volatile("v_cvt_pk_bf16_f32 %0, %1, %2" : "=v"(r) : "v"(lo), "v"(hi)); return r; }
template <class Epi, class Sched, bool ALIGN_EPI = false, bool SP2 = false>
__device__ __forceinline__ void gemm_phase(PG8_LAS unsigned char* lds, const Gemm g, const Sched& S, const Epi& E, int tid_in) {
    int tid_ = tid_in; asm volatile("" : "+v"(tid_));
    const int tid = tid_, wid = __builtin_amdgcn_readfirstlane(tid >> 6), lane = tid & 63, wr = wid >> 2, wc = wid & 3, fr = lane & 15, fq = lane >> 4;
    const int K = g.K, nt = K / BK;
    unsigned voffA[2], voffB[2];
#pragma unroll
    for (int i = 0; i < 2; ++i) { int R, C; stage_rc(tid * 16 + i * 8192, R, C); const int Rb = Epi::PERM ? ((R & ~31) + perm32(R & 31)) : R;
        voffA[i] = (unsigned)(R * K + C) * 2u; voffB[i] = (unsigned)(Rb * K + C) * 2u; }
    const size_t kstep = (size_t)(BK * 2);
    const size_t hstep = (size_t)HALF * K * 2;
    const size_t tstep = 2 * hstep;
    const unsigned ldsw = (unsigned)wid * 1024u;
    const int aoff = lds_byte(wr * 64 + fr, fq * 8), boff = lds_byte(wc * 32 + fr, fq * 8);
#define PG8_SA(b, h) (((b) * 2 + (h)) * HTB)
#define PG8_SB(b, h) ((4 + (b) * 2 + (h)) * HTB)
#define PG8_STAGE(bufoff, gbase, voff) do { _Pragma("unroll") for (int _i = 0; _i < 2; ++_i) \
        __builtin_amdgcn_global_load_lds((const unsigned*)((const char*)(gbase) + (voff)[_i]), (PG8_LAS unsigned*)(lds + (bufoff) + ldsw + _i * 8192), 16, 0, 0); } while (0)
#define PG8_LDA(dst, b, h) do { _Pragma("unroll") for (int m = 0; m < 4; ++m) _Pragma("unroll") for (int k = 0; k < 2; ++k) dst[m][k] = *(const PG8_LAS bf16x8*)(lds + PG8_SA(b, h) + aoff + m * 2048 + k * 1024); } while (0)
#define PG8_LDB(dst, b, h) do { _Pragma("unroll") for (int n = 0; n < 2; ++n) _Pragma("unroll") for (int k = 0; k < 2; ++k) dst[n][k] = *(const PG8_LAS bf16x8*)(lds + PG8_SB(b, h) + boff + n * 2048 + k * 1024); } while (0)
#define PG8_MMA(ai, bj, At, Bt) do { __builtin_amdgcn_s_setprio(1); _Pragma("unroll") for (int m = 0; m < 4; ++m) _Pragma("unroll") for (int n = 0; n < 2; ++n) _Pragma("unroll") for (int k = 0; k < 2; ++k) \
        acc[ai][bj][m][n] = __builtin_amdgcn_mfma_f32_16x16x32_bf16(Bt[n][k], At[m][k], acc[ai][bj][m][n], 0, 0, 0); __builtin_amdgcn_s_setprio(0); } while (0)
#define PG8_WAIT_V(n) asm volatile("s_waitcnt vmcnt(" #n ")" ::: "memory")
#define PG8_WAIT_L(n) asm volatile("s_waitcnt lgkmcnt(" #n ")" ::: "memory")
#define PG8_BAR __builtin_amdgcn_s_barrier()
#define PG8_SCHED __builtin_amdgcn_sched_barrier(0)
    Unit cur, nxt; int ui = 0;
    if (!S.next(0, cur)) return;
    f32x4 acc[2][2][4][2];
#pragma unroll
    for (int a = 0; a < 2; ++a)
#pragma unroll
        for (int b = 0; b < 2; ++b)
#pragma unroll
            for (int m = 0; m < 4; ++m)
#pragma unroll
                for (int n = 0; n < 2; ++n) acc[a][b][m][n] = (f32x4){0.f, 0.f, 0.f, 0.f};
    bf16x8 At[4][2], B0[2][2], B1[2][2];
    const char* cA = (const char*)g.A + (size_t)cur.pm * tstep; const char* cB = (const char*)g.Bt + (size_t)cur.pn * tstep;
    S.a_ready(cur);
    if constexpr (SP2) {
        PG8_STAGE(PG8_SB(0, 0), cB, voffB); PG8_STAGE(PG8_SB(0, 1), cB + hstep, voffB); PG8_STAGE(PG8_SA(0, 0), cA, voffA); PG8_STAGE(PG8_SA(0, 1), cA + hstep, voffA);
        if (wr == 1) PG8_BAR;
        PG8_WAIT_V(2); PG8_BAR;
        PG8_STAGE(PG8_SB(1, 0), cB + kstep, voffB); PG8_STAGE(PG8_SA(1, 0), cA + kstep, voffA); PG8_STAGE(PG8_SB(1, 1), cB + hstep + kstep, voffB);
        PG8_WAIT_V(6); PG8_BAR;
    } else {
        PG8_STAGE(PG8_SB(0, 0), cB, voffB); PG8_STAGE(PG8_SA(0, 0), cA, voffA); PG8_STAGE(PG8_SB(0, 1), cB + hstep, voffB); PG8_STAGE(PG8_SA(0, 1), cA + hstep, voffA);
        if (wr == 1) PG8_BAR;
        PG8_WAIT_V(4); PG8_BAR;
        PG8_STAGE(PG8_SB(1, 0), cB + kstep, voffB); PG8_STAGE(PG8_SA(1, 0), cA + kstep, voffA); PG8_STAGE(PG8_SB(1, 1), cB + hstep + kstep, voffB);
        PG8_WAIT_V(6); PG8_BAR;
    }
    for (;;) {
        const bool has_next = S.next(ui + 1, nxt);
        const char* nA = has_next ? (const char*)g.A + (size_t)nxt.pm * tstep : cA; const char* nB = has_next ? (const char*)g.Bt + (size_t)nxt.pn * tstep : cB;
#pragma unroll 1
        for (int t = 0; t < nt; t += 2) {
            const bool last = (t == nt - 2);
            const char* a1 = cA + (size_t)(t + 1) * kstep;
            const char* a2 = last ? nA : cA + (size_t)(t + 2) * kstep; const char* b2 = last ? nB : cB + (size_t)(t + 2) * kstep;
            const char* a3 = a2 + kstep; const char* b3 = b2 + kstep;
            if (last && has_next) S.a_ready(nxt);
            if constexpr (SP2) {
            PG8_LDB(B0, 0, 0); PG8_LDB(B1, 0, 1); PG8_SCHED; PG8_LDA(At, 0, 0); PG8_STAGE(PG8_SA(1, 1), a1 + hstep, voffA);
            PG8_WAIT_V(8); PG8_WAIT_L(0); PG8_BAR; PG8_MMA(0, 0, At, B0); PG8_MMA(0, 1, At, B1); PG8_BAR; PG8_SCHED;
            PG8_LDA(At, 0, 1); PG8_STAGE(PG8_SB(0, 0), b2, voffB); PG8_STAGE(PG8_SB(0, 1), b2 + hstep, voffB); PG8_STAGE(PG8_SA(0, 0), a2, voffA);
            PG8_WAIT_V(8); PG8_WAIT_L(0); PG8_BAR; PG8_MMA(1, 0, At, B0); PG8_MMA(1, 1, At, B1); PG8_BAR; PG8_SCHED;
            PG8_LDB(B0, 1, 0); PG8_LDB(B1, 1, 1); PG8_SCHED; PG8_LDA(At, 1, 0); PG8_STAGE(PG8_SA(0, 1), a2 + hstep, voffA);
            PG8_WAIT_V(8); PG8_WAIT_L(0); PG8_BAR; PG8_MMA(0, 0, At, B0); PG8_MMA(0, 1, At, B1); PG8_BAR; PG8_SCHED;
            PG8_LDA(At, 1, 1); PG8_STAGE(PG8_SB(1, 0), b3, voffB); PG8_STAGE(PG8_SB(1, 1), b3 + hstep, voffB); PG8_STAGE(PG8_SA(1, 0), a3, voffA);
            PG8_WAIT_V(8); PG8_WAIT_L(0); PG8_BAR; PG8_MMA(1, 0, At, B0); PG8_MMA(1, 1, At, B1); PG8_BAR; PG8_SCHED;
            } else {
            PG8_LDB(B0, 0, 0); PG8_SCHED; PG8_LDA(At, 0, 0); PG8_STAGE(PG8_SA(1, 1), a1 + hstep, voffA);
            PG8_WAIT_L(8); PG8_BAR; PG8_WAIT_L(0); PG8_MMA(0, 0, At, B0); PG8_BAR; PG8_SCHED;
            PG8_LDB(B1, 0, 1); PG8_STAGE(PG8_SB(0, 0), b2, voffB);
            PG8_BAR; PG8_WAIT_L(0); PG8_MMA(0, 1, At, B1); PG8_BAR;
            PG8_LDA(At, 0, 1); PG8_STAGE(PG8_SA(0, 0), a2, voffA);
            PG8_BAR; PG8_WAIT_L(0); PG8_MMA(1, 0, At, B0); PG8_BAR; PG8_SCHED;
            PG8_STAGE(PG8_SB(0, 1), b2 + hstep, voffB);
            PG8_WAIT_V(6); PG8_BAR; PG8_MMA(1, 1, At, B1); PG8_BAR;
            PG8_LDB(B0, 1, 0); PG8_SCHED; PG8_LDA(At, 1, 0); PG8_STAGE(PG8_SA(0, 1), a2 + hstep, voffA);
            PG8_WAIT_L(8); PG8_BAR; PG8_WAIT_L(0); PG8_MMA(0, 0, At, B0); PG8_BAR; PG8_SCHED;
            PG8_LDB(B1, 1, 1); PG8_STAGE(PG8_SB(1, 0), b3, voffB);
            PG8_BAR; PG8_WAIT_L(0); PG8_MMA(0, 1, At, B1); PG8_BAR;
            PG8_LDA(At, 1, 1); PG8_STAGE(PG8_SA(1, 0), a3, voffA);
            PG8_BAR; PG8_WAIT_L(0); PG8_MMA(1, 0, At, B0); PG8_BAR; PG8_SCHED;
            PG8_STAGE(PG8_SB(1, 1), b3 + hstep, voffB);
            PG8_WAIT_V(6); PG8_BAR; PG8_MMA(1, 1, At, B1); PG8_BAR;
            }
        }
        if constexpr (ALIGN_EPI) { if (wr == 0) PG8_BAR; }
        if constexpr (!Epi::AFTER_DRAIN) { E(acc, cur, wr, wc, fr, fq); S.done(cur); }
        if (!has_next) break;
#pragma unroll
        for (int a = 0; a < 2; ++a)
#pragma unroll
            for (int b = 0; b < 2; ++b)
#pragma unroll
                for (int m = 0; m < 4; ++m)
#pragma unroll
                    for (int n = 0; n < 2; ++n) acc[a][b][m][n] = (f32x4){0.f, 0.f, 0.f, 0.f};
        cur = nxt; cA = nA; cB = nB; ++ui;
        if constexpr (ALIGN_EPI) { if (wr == 1) PG8_BAR; }
    }
    PG8_WAIT_V(0);
    if constexpr (!ALIGN_EPI) { if (wr == 0) PG8_BAR; }
    PG8_BAR;
    if constexpr (Epi::AFTER_DRAIN) { E.fused(acc, cur, wr, wc, fr, fq, lds, wid, lane); S.done(cur); }
#undef PG8_SA
#undef PG8_SB
#undef PG8_STAGE
#undef PG8_LDA
#undef PG8_LDB
#undef PG8_MMA
#undef PG8_WAIT_V
#undef PG8_WAIT_L
#undef PG8_BAR
#undef PG8_SCHED
}
}

constexpr bool PG_ALIGN = true, PG_SP2 = true;
__device__ __forceinline__ float bflo(unsigned w) { return __builtin_bit_cast(float, w << 16); }
__device__ __forceinline__ float bfhi(unsigned w) { return __builtin_bit_cast(float, w & 0xffff0000u); }
__device__ __forceinline__ unsigned cvtpk(float lo, float hi) { return pg8::cvt_pk_bf16(lo, hi); }

__device__ __forceinline__ void transpose_item(const float* W, int N, int k0, int n0, bf16* WT, int K, size_t dst_row0, LAS float* scr, int lane) {
    float v[32];
#pragma unroll
    for (int i = 0; i < 32; ++i) v[i] = W[(size_t)(k0 + 2 * i + (lane >> 5)) * N + n0 + (lane & 31)];
#pragma unroll
    for (int i = 0; i < 32; ++i) scr[(2 * i + (lane >> 5)) * 33 + (lane & 31)] = v[i];
    asm volatile("s_waitcnt lgkmcnt(0)" ::: "memory");
    const int c = lane & 7;
#pragma unroll
    for (int j = 0; j < 4; ++j) { const int n = (lane >> 3) + 8 * j; const LAS float* s = scr + (8 * c) * 33 + n;
        v4u o; o.x = pk2(s[0 * 33], s[1 * 33]); o.y = pk2(s[2 * 33], s[3 * 33]); o.z = pk2(s[4 * 33], s[5 * 33]); o.w = pk2(s[6 * 33], s[7 * 33]);
        *(v4u*)(WT + (dst_row0 + n) * K + k0 + 8 * c) = o; }
    asm volatile("s_waitcnt lgkmcnt(0)" ::: "memory");
}
__device__ __forceinline__ void convert_weights(Frame& F, int l, int nblk) {
    LAS float* scr = (LAS float*)(F.lds + F.wave * 16384);
    if (F.bid >= nblk) return;
    const int gw = F.bid * (NT / 64) + F.wave, ngw = nblk * (NT / 64);
    constexpr int I_IN = 16 * 96, I_MG = 16 * 96, I_GLU = 8 * 16, I_BR = 3 * 8 * 32, I_O = 16 * 32, I_1 = 32 * 16 * 8, I_3 = I_1, I_2 = 32 * 4 * 32;
    constexpr int NITEMS = I_IN + I_MG + I_GLU + I_BR + I_O + I_1 + I_3 + I_2;
    for (int it = gw; it < NITEMS; it += ngw) {
        int r = it;
        if (r < I_IN) { const int kb = r / 96, nb = r % 96; transpose_item(IN_(I_WIN) + (size_t)l * D * INW, INW, 64 * kb, 32 * nb, (bf16*)(F.ws + WS_WIN), 1024, 32 * nb, scr, F.lane); continue; } r -= I_IN;
        if (r < I_MG) { const int kb = r / 96, nb = r % 96; transpose_item(IN_(I_WMG) + (size_t)l * D * INW, INW, 64 * kb, 32 * nb, (bf16*)(F.ws + WS_WMG), 1024, 32 * nb, scr, F.lane); continue; } r -= I_MG;
        if (r < I_GLU) { const int kb = r / 16, nb = r % 16; transpose_item(IN_(I_WGLU) + (size_t)l * MIXW * MIXW, MIXW, 64 * kb, 32 * nb, (bf16*)(F.ws + WS_WGLU), 512, 32 * nb, scr, F.lane); continue; } r -= I_GLU;
        if (r < I_BR) { const int kk = r / 256, q = r % 256, kb = q / 32, nb = q % 32; transpose_item(IN_(I_WBR) + ((size_t)l * 3 + kk) * MIXW * D, D, 64 * kb, 32 * nb, (bf16*)(F.ws + WS_WBR), 512, (size_t)kk * 1024 + 32 * nb, scr, F.lane); continue; } r -= I_BR;
        if (r < I_O) { const int kb = r / 32, nb = r % 32; transpose_item(IN_(I_WO) + (size_t)l * D * D, D, 64 * kb, 32 * nb, (bf16*)(F.ws + WS_WO), 1024, 32 * nb, scr, F.lane); continue; } r -= I_O;
        if (r < I_1 + I_3) { const int which = r / I_1, q = r % I_1, e = q / 128, q2 = q % 128, kb = q2 / 8, nb = q2 % 8;
            const float* W = IN_(which ? I_W3 : I_W1) + ((size_t)l * NE + e) * D * DFF; const int n0 = 32 * nb;
            transpose_item(W, DFF, 64 * kb, n0, (bf16*)(F.ws + WS_W13), 1024, (size_t)e * 512 + (n0 / 128) * 256 + which * 128 + (n0 % 128), scr, F.lane); continue; } r -= I_1 + I_3;
        { const int e = r / 128, q = r % 128, kb = q / 32, nb = q % 32; transpose_item(IN_(I_W2) + ((size_t)l * NE + e) * DFF * D, D, 64 * kb, 32 * nb, (bf16*)(F.ws + WS_W2), 256, (size_t)e * 1024 + 32 * nb, scr, F.lane); }
    }
    { bf16* wr = (bf16*)(F.ws + WS_WR); const float* wg = IN_(I_WGRP) + (size_t)l * D * 4; const float* we = IN_(I_WEXP) + (size_t)l * D * 32;
      for (int i = F.bid * NT + F.tid; i < 48 * 1024; i += nblk * NT) { const int n = i >> 10, kk = i & 1023; const float w = n < 4 ? wg[kk * 4 + n] : (n < 36 ? we[kk * 32 + n - 4] : 0.f);
          const unsigned hi = f2bf(w); const float lo = w - __builtin_bit_cast(float, hi << 16); wr[i] = (bf16)hi; wr[48 * 1024 + i] = (bf16)f2bf(lo); } }
    { const float* s = IN_(I_WSG) + (size_t)l * 4 * 128 * 128; bf16* d = (bf16*)(F.ws + WS_WSG);
      for (int i = (F.bid * NT + F.tid) * 2; i < 4 * 128 * 128; i += nblk * NT * 2) *(unsigned*)(d + i) = pk2(s[i], s[i + 1]); }
}

struct EpiProj { static constexpr bool PERM = true, AFTER_DRAIN = false; bf16* O;
    __device__ __forceinline__ void operator()(const pg8::f32x4 (&acc)[2][2][4][2], const pg8::Unit& u, int wr, int wc, int fr, int fq) const {
        const int row0 = u.pm * 256 + wr * 64 + fr, col0 = u.pn * 256 + wc * 32 + 8 * fq; const bool act = (u.pn >= 2 && u.pn < 6);
#pragma unroll
        for (int ai = 0; ai < 2; ++ai)
#pragma unroll
            for (int m = 0; m < 4; ++m) { bf16* rowp = O + (size_t)(row0 + ai * 128 + m * 16) * INW + col0;
#pragma unroll
                for (int bj = 0; bj < 2; ++bj) { pg8::f32x4 v0 = acc[ai][bj][m][0], v1 = acc[ai][bj][m][1];
                    if (act) {
#pragma unroll
                        for (int j = 0; j < 4; ++j) { v0[j] = geluf_(v0[j]); v1[j] = geluf_(v1[j]); } }
                    v4u w; w.x = cvtpk(v0[0], v0[1]); w.y = cvtpk(v0[2], v0[3]); w.z = cvtpk(v1[0], v1[1]); w.w = cvtpk(v1[2], v1[3]); *(v4u*)(rowp + bj * 128) = w; } }
    } };
struct EpiGlu { static constexpr bool PERM = true, AFTER_DRAIN = false; const bf16* YG; bf16* YA;
    __device__ __forceinline__ void operator()(const pg8::f32x4 (&acc)[2][2][4][2], const pg8::Unit& u, int wr, int wc, int fr, int fq) const {
        const int row0 = u.pm * 256 + wr * 64 + fr, col0 = u.pn * 256 + wc * 32 + 8 * fq;
#pragma unroll
        for (int ai = 0; ai < 2; ++ai) {
        v4u gv[4][2];
#pragma unroll
            for (int m = 0; m < 4; ++m)
#pragma unroll
                for (int bj = 0; bj < 2; ++bj) gv[m][bj] = *(const v4u*)(YG + (size_t)(row0 + ai * 128 + m * 16) * MIXW + col0 + bj * 128);
        asm volatile("" ::: "memory");
#pragma unroll
            for (int m = 0; m < 4; ++m) { const size_t off = (size_t)(row0 + ai * 128 + m * 16) * MIXW + col0;
#pragma unroll
                for (int bj = 0; bj < 2; ++bj) { const pg8::f32x4 v0 = acc[ai][bj][m][0], v1 = acc[ai][bj][m][1]; const v4u g = gv[m][bj];
                    v4u w; w.x = cvtpk(bflo(g.x) * sigmoidf_(v0[0]), bfhi(g.x) * sigmoidf_(v0[1])); w.y = cvtpk(bflo(g.y) * sigmoidf_(v0[2]), bfhi(g.y) * sigmoidf_(v0[3]));
                    w.z = cvtpk(bflo(g.z) * sigmoidf_(v1[0]), bfhi(g.z) * sigmoidf_(v1[1])); w.w = cvtpk(bflo(g.w) * sigmoidf_(v1[2]), bfhi(g.w) * sigmoidf_(v1[3])); *(v4u*)(YA + off + bj * 128) = w; } }
        asm volatile("" ::: "memory"); }
    } };
__device__ __forceinline__ int xcd_remap(int Lq, int total) { const int q = total >> 3, r = total & 7, x = Lq & 7, off = Lq >> 3; return (x < r ? x * (q + 1) : r * (q + 1) + (x - r) * q) + off; }
struct EpiBr { static constexpr bool PERM = true, AFTER_DRAIN = false; bf16* BR;
    __device__ __forceinline__ void operator()(const pg8::f32x4 (&acc)[2][2][4][2], const pg8::Unit& u, int wr, int wc, int fr, int fq) const {
        const int pm = u.pm % (MT / 256); const int row0 = pm * 256 + wr * 64 + fr, col0 = u.pn * 256 + wc * 32 + 8 * fq;
#pragma unroll
        for (int ai = 0; ai < 2; ++ai)
#pragma unroll
            for (int m = 0; m < 4; ++m) { bf16* rowp = BR + (size_t)(row0 + ai * 128 + m * 16) * INW + col0;
#pragma unroll
                for (int bj = 0; bj < 2; ++bj) { const pg8::f32x4 v0 = acc[ai][bj][m][0], v1 = acc[ai][bj][m][1];
                    v4u w; w.x = cvtpk(v0[0], v0[1]); w.y = cvtpk(v0[2], v0[3]); w.z = cvtpk(v1[0], v1[1]); w.w = cvtpk(v1[2], v1[3]); *(v4u*)(rowp + bj * 128) = w; } }
    } };
struct SchedBr { int G, c, nM;
    __device__ __forceinline__ bool next(int i, pg8::Unit& u) const { const int L0 = i * G + c; if (L0 >= 3 * nM * 4) return false; const int Lq = xcd_remap(L0, 3 * nM * 4); const int k = Lq / (nM * 4), r = Lq % (nM * 4);
        u.pm = k * (MT / 256) + r / 4; u.pn = k * 4 + r % 4; return true; }
    __device__ __forceinline__ void a_ready(const pg8::Unit&) const {}
    __device__ __forceinline__ void done(const pg8::Unit&) const {} };
struct EpiMerge { static constexpr bool PERM = true, AFTER_DRAIN = false; const bf16* BR; bf16* PM; const float* bm;
    __device__ __forceinline__ void operator()(const pg8::f32x4 (&acc)[2][2][4][2], const pg8::Unit& u, int wr, int wc, int fr, int fq) const {
        const int k = u.pn >> 2, dt = u.pn & 3; const int row0 = u.pm * 256 + wr * 64 + fr, col0 = dt * 256 + wc * 32 + 8 * fq;
#pragma unroll
        for (int bj = 0; bj < 2; ++bj) { const pg8::f32x4 b0 = *(const pg8::f32x4*)(bm + k * 1024 + col0 + bj * 128), b1 = *(const pg8::f32x4*)(bm + k * 1024 + col0 + bj * 128 + 4);
#pragma unroll
            for (int ai = 0; ai < 2; ++ai) {
            v4u brv[4], pmv[4];
#pragma unroll
                for (int m = 0; m < 4; ++m) { const size_t r = (size_t)(row0 + ai * 128 + m * 16); brv[m] = *(const v4u*)(BR + r * INW + k * 1024 + col0 + bj * 128);
                    pmv[m] = k > 0 ? *(const v4u*)(PM + r * D + col0 + bj * 128) : (v4u){0u, 0u, 0u, 0u}; }
                asm volatile("" ::: "memory");
#pragma unroll
                for (int m = 0; m < 4; ++m) { const size_t r = (size_t)(row0 + ai * 128 + m * 16); const v4u br = brv[m], o = pmv[m];
                    const pg8::f32x4 v0 = acc[ai][bj][m][0] + b0, v1 = acc[ai][bj][m][1] + b1;
                    float p[8] = {sigmoidf_(v0[0]) * bflo(br.x), sigmoidf_(v0[1]) * bfhi(br.x), sigmoidf_(v0[2]) * bflo(br.y), sigmoidf_(v0[3]) * bfhi(br.y),
                                  sigmoidf_(v1[0]) * bflo(br.z), sigmoidf_(v1[1]) * bfhi(br.z), sigmoidf_(v1[2]) * bflo(br.w), sigmoidf_(v1[3]) * bfhi(br.w)};
                    if (k > 0) { p[0] += bflo(o.x); p[1] += bfhi(o.x); p[2] += bflo(o.y); p[3] += bfhi(o.y); p[4] += bflo(o.z); p[5] += bfhi(o.z); p[6] += bflo(o.w); p[7] += bfhi(o.w); }
                    v4u w; w.x = cvtpk(p[0], p[1]); w.y = cvtpk(p[2], p[3]); w.z = cvtpk(p[4], p[5]); w.w = cvtpk(p[6], p[7]); *(v4u*)(PM + r * D + col0 + bj * 128) = w; }
                asm volatile("" ::: "memory"); } }
    } };
struct SchedMerge { int G, c, nM;
    __device__ __forceinline__ bool next(int i, pg8::Unit& u) const { const int v0 = (i / 3) * G + c, k = i % 3; if (v0 >= nM * 4) return false; const int v = xcd_remap(v0, nM * 4); u.pm = v >> 2; u.pn = k * 4 + (v & 3); return true; }
    __device__ __forceinline__ void a_ready(const pg8::Unit&) const {}
    __device__ __forceinline__ void done(const pg8::Unit&) const {} };
struct EpiWo { static constexpr bool PERM = false, AFTER_DRAIN = false; const float* xs_lat; const float* xs_ctx; float* out; float* xc; const float* mod_l;
    __device__ __forceinline__ void operator()(const pg8::f32x4 (&acc)[2][2][4][2], const pg8::Unit& u, int wr, int wc, int fr, int fq) const {
        const int row0 = u.pm * 256 + wr * 64 + fr, col0 = u.pn * 256 + wc * 32 + 4 * fq;
        const float* ga = mod_l + 2048;
        pg8::f32x4 gv[2][2];
#pragma unroll
        for (int bj = 0; bj < 2; ++bj)
#pragma unroll
            for (int n = 0; n < 2; ++n) gv[bj][n] = *(const pg8::f32x4*)(ga + col0 + bj * 128 + n * 16);
#pragma unroll
        for (int ai = 0; ai < 2; ++ai) {
#pragma unroll
            for (int mp = 0; mp < 2; ++mp) {
            pg8::f32x4 xv[2][2][2];
#pragma unroll
            for (int m = 0; m < 2; ++m) { const size_t off = (size_t)(row0 + ai * 128 + (mp * 2 + m) * 16) * D + col0;
#pragma unroll
                for (int bj = 0; bj < 2; ++bj)
#pragma unroll
                    for (int n = 0; n < 2; ++n) xv[m][bj][n] = *(const pg8::f32x4*)(xs_lat + off + bj * 128 + n * 16); }
            asm volatile("" ::: "memory");
#pragma unroll
            for (int m = 0; m < 2; ++m) { const size_t off = (size_t)(row0 + ai * 128 + (mp * 2 + m) * 16) * D + col0;
#pragma unroll
                for (int bj = 0; bj < 2; ++bj)
#pragma unroll
                    for (int n = 0; n < 2; ++n) *(pg8::f32x4*)(out + off + bj * 128 + n * 16) = xv[m][bj][n] + gv[bj][n] * acc[ai][bj][m + mp * 2][n]; }
            asm volatile("" ::: "memory"); }
        }
    } };
constexpr int MOETAB_OFF = 131072 + 2048;
constexpr int THIN_MAX = 0;
template <int NPN> __device__ __forceinline__ int moe_build_table(Frame& F, const unsigned* cnt) {
    LAS unsigned* tabw = (LAS unsigned*)(F.lds + MOETAB_OFF); LAS unsigned* tabt = tabw + 1024;
    int total = 0, rowtile0 = 0, nt = 0;
    for (int e = 0; e < NE; ++e) { const int n = (int)cnt[e], npad = (n + 255) >> 8, tail = n & 255; const bool thin = tail > 0 && tail <= THIN_MAX; const int neng = thin ? (n >> 8) : npad, nb = thin ? (tail + 15) >> 4 : 0;
        for (int q = F.tid; q < neng * NPN; q += NT) tabw[total + q] = ((unsigned)(rowtile0 + q / NPN) << 16) | (unsigned)(e * NPN + q % NPN);
        for (int q = F.tid; q < nb; q += NT) tabt[nt + q] = ((unsigned)e << 24) | (unsigned)((rowtile0 + neng) * 256 + q * 16);
        total += neng * NPN; rowtile0 += npad; nt += nb; }
    if (F.tid == 0) tabw[2047] = (unsigned)nt;
    __syncthreads();
    return total;
}
struct SchedMoe { int G, c, total; const LAS unsigned* tabw;
    __device__ __forceinline__ bool next(int i, pg8::Unit& u) const { const int L0 = i * G + c; if (L0 >= total) return false; const int Lq = xcd_remap(L0, total); const unsigned w = (unsigned)__builtin_amdgcn_readfirstlane((int)tabw[Lq]); u.pm = (int)(w >> 16); u.pn = (int)(w & 0xffffu); return true; }
    __device__ __forceinline__ void a_ready(const pg8::Unit&) const {}
    __device__ __forceinline__ void done(const pg8::Unit&) const {} };
struct EpiUp { static constexpr bool PERM = true, AFTER_DRAIN = false; bf16* ACT; const float* SW;
    __device__ __forceinline__ void operator()(const pg8::f32x4 (&acc)[2][2][4][2], const pg8::Unit& u, int wr, int wc, int fr, int fq) const {
        const int row0 = u.pm * 256 + wr * 64 + fr, f0 = (u.pn & 1) * 128 + wc * 32 + 8 * fq;
        float wv[2][4];
#pragma unroll
        for (int ai = 0; ai < 2; ++ai)
#pragma unroll
            for (int m = 0; m < 4; ++m) wv[ai][m] = SW[row0 + ai * 128 + m * 16];
        asm volatile("" ::: "memory");
#pragma unroll
        for (int ai = 0; ai < 2; ++ai)
#pragma unroll
            for (int m = 0; m < 4; ++m) { const int slot = row0 + ai * 128 + m * 16; const float w = wv[ai][m];
                const pg8::f32x4 a0 = acc[ai][0][m][0], a1 = acc[ai][0][m][1], b0 = acc[ai][1][m][0], b1 = acc[ai][1][m][1];
                v4u o; o.x = cvtpk(siluf_(a0[0]) * b0[0] * w, siluf_(a0[1]) * b0[1] * w); o.y = cvtpk(siluf_(a0[2]) * b0[2] * w, siluf_(a0[3]) * b0[3] * w);
                o.z = cvtpk(siluf_(a1[0]) * b1[0] * w, siluf_(a1[1]) * b1[1] * w); o.w = cvtpk(siluf_(a1[2]) * b1[2] * w, siluf_(a1[3]) * b1[3] * w);
                *(v4u*)(ACT + (size_t)slot * DFF + f0) = o; }
    } };
struct EpiDown { static constexpr bool PERM = true, AFTER_DRAIN = false; bf16* YS2;
    __device__ __forceinline__ void operator()(const pg8::f32x4 (&acc)[2][2][4][2], const pg8::Unit& u, int wr, int wc, int fr, int fq) const {
        const int row0 = u.pm * 256 + wr * 64 + fr, col0 = (u.pn & 3) * 256 + wc * 32 + 8 * fq;
#pragma unroll
        for (int ai = 0; ai < 2; ++ai)
#pragma unroll
            for (int m = 0; m < 4; ++m) { bf16* rowp = YS2 + (size_t)(row0 + ai * 128 + m * 16) * D + col0;
#pragma unroll
                for (int bj = 0; bj < 2; ++bj) { const pg8::f32x4 v0 = acc[ai][bj][m][0], v1 = acc[ai][bj][m][1];
                    v4u w; w.x = cvtpk(v0[0], v0[1]); w.y = cvtpk(v0[2], v0[3]); w.z = cvtpk(v1[0], v1[1]); w.w = cvtpk(v1[2], v1[3]); *(v4u*)(rowp + bj * 128) = w; } }
    } };


__device__ __forceinline__ void moe_up_thin(Frame& F, int nthin) {
    const bf16* HS = (const bf16*)(F.ws + WS_HS); bf16* ACT = (bf16*)(F.ws + WS_ACT); const float* SW = (const float*)(F.ws + WS_SW); const LAS unsigned* tabt = (const LAS unsigned*)(F.lds + MOETAB_OFF) + 1024;
    const int r = F.lane & 15, q = F.lane >> 4;
    for (int it = F.bid; it < nthin; it += F.G) { const unsigned tw = tabt[it]; const int e = (int)(tw >> 24), s0 = (int)(tw & 0xffffffu);
        const bf16* a = HS + (size_t)(s0 + r) * D + 8 * q; const bf16* W = (const bf16*)(F.ws + WS_W13) + (size_t)e * 512 * D;
        f32x4 acc[2][2] = {{{0.f, 0.f, 0.f, 0.f}, {0.f, 0.f, 0.f, 0.f}}, {{0.f, 0.f, 0.f, 0.f}, {0.f, 0.f, 0.f, 0.f}}};
        const bf16* b0[2];
#pragma unroll
        for (int c = 0; c < 2; ++c) { const int fb = 2 * F.wave + c; b0[c] = W + (size_t)((fb >> 3) * 256 + (fb & 7) * 16 + r) * D + 8 * q; }
#pragma unroll 8
        for (int ks = 0; ks < D / 32; ++ks) { const bf16x8 x = *(const bf16x8*)(a + 32 * ks);
#pragma unroll
            for (int c = 0; c < 2; ++c) { const bf16x8 w1 = *(const bf16x8*)(b0[c] + 32 * ks), w3 = *(const bf16x8*)(b0[c] + (size_t)128 * D + 32 * ks);
                acc[c][0] = __builtin_amdgcn_mfma_f32_16x16x32_bf16(x, w1, acc[c][0], 0, 0, 0); acc[c][1] = __builtin_amdgcn_mfma_f32_16x16x32_bf16(x, w3, acc[c][1], 0, 0, 0); } }
#pragma unroll
        for (int c = 0; c < 2; ++c)
#pragma unroll
            for (int i = 0; i < 4; ++i) { const int slot = s0 + 4 * q + i; const float w = SW[slot]; ACT[(size_t)slot * DFF + (2 * F.wave + c) * 16 + r] = (bf16)f2bf(siluf_(acc[c][0][i]) * acc[c][1][i] * w); }
    }
}
__device__ __forceinline__ void moe_down_thin(Frame& F, int nthin) {
    const bf16* ACT = (const bf16*)(F.ws + WS_ACT); bf16* YS2 = (bf16*)(F.ws + WS_YS2); const LAS unsigned* tabt = (const LAS unsigned*)(F.lds + MOETAB_OFF) + 1024;
    const int r = F.lane & 15, q = F.lane >> 4;
    for (int it = F.bid; it < nthin; it += F.G) { const unsigned tw = tabt[it]; const int e = (int)(tw >> 24), s0 = (int)(tw & 0xffffffu);
        const bf16* a = ACT + (size_t)(s0 + r) * DFF + 8 * q; const bf16* W = (const bf16*)(F.ws + WS_W2) + ((size_t)e * 1024 + 128 * F.wave + r) * DFF + 8 * q;
        f32x4 acc[8];
#pragma unroll
        for (int c = 0; c < 8; ++c) acc[c] = (f32x4){0.f, 0.f, 0.f, 0.f};
#pragma unroll 4
        for (int ks = 0; ks < DFF / 32; ++ks) { const bf16x8 x = *(const bf16x8*)(a + 32 * ks);
#pragma unroll
            for (int c = 0; c < 8; ++c) { const bf16x8 w = *(const bf16x8*)(W + (size_t)c * 16 * DFF + 32 * ks); acc[c] = __builtin_amdgcn_mfma_f32_16x16x32_bf16(x, w, acc[c], 0, 0, 0); } }
#pragma unroll
        for (int c = 0; c < 8; ++c)
#pragma unroll
            for (int i = 0; i < 4; ++i) YS2[(size_t)(s0 + 4 * q + i) * D + 128 * F.wave + c * 16 + r] = (bf16)f2bf(acc[c][i]);
    }
}

__device__ __forceinline__ void ph2_fast(Frame& F, int l) {
    pg8::Gemm g{(const bf16*)(F.ws + WS_H), (const bf16*)(F.ws + WS_WIN), SEQ, INW, D}; pg8::StaticOrder S; S.init(SEQ, INW, F.G, F.bid);
    EpiProj E{(bf16*)(F.ws + WS_PROJ)}; pg8::gemm_phase<EpiProj, pg8::StaticOrder, PG_ALIGN, PG_SP2>(F.lds, g, S, E, F.tid);
}
__device__ __forceinline__ void ph6_fast(Frame& F, int l) {
    pg8::Gemm g{(const bf16*)(F.ws + WS_YG), (const bf16*)(F.ws + WS_WGLU), MT, MIXW, MIXW}; pg8::StaticOrder S; S.init(SEQ, MIXW, F.G, F.bid);
    EpiGlu E{(const bf16*)(F.ws + WS_YG), (bf16*)(F.ws + WS_YS)}; pg8::gemm_phase<EpiGlu, pg8::StaticOrder, PG_ALIGN, PG_SP2>(F.lds, g, S, E, F.tid);
}
__device__ __forceinline__ void ph7_fast(Frame& F, int l) {
    pg8::Gemm g{(const bf16*)(F.ws + WS_YS), (const bf16*)(F.ws + WS_WBR), 3 * MT, 3 * D, MIXW}; SchedBr S{F.G, F.bid, SEQ / 256};
    EpiBr E{(bf16*)(F.ws + WS_PROJ)}; pg8::gemm_phase<EpiBr, SchedBr, PG_ALIGN, PG_SP2>(F.lds, g, S, E, F.tid);
}
__device__ __forceinline__ void ph8_fast(Frame& F, int l) {
    pg8::Gemm g{(const bf16*)(F.ws + WS_H), (const bf16*)(F.ws + WS_WMG), MT, INW, D}; SchedMerge S{F.G, F.bid, SEQ / 256};
    EpiMerge E{(const bf16*)(F.ws + WS_PROJ), (bf16*)(F.ws + WS_PM), IN_(I_BMG) + l * INW}; pg8::gemm_phase<EpiMerge, SchedMerge, PG_ALIGN, PG_SP2>(F.lds, g, S, E, F.tid);
}
__device__ __forceinline__ void ph9_fast(Frame& F, int l) {
    pg8::Gemm g{(const bf16*)(F.ws + WS_PM), (const bf16*)(F.ws + WS_WO), MT, D, D}; pg8::StaticOrder S; S.init(SEQ, D, F.G, F.bid);
    EpiWo E{l == 0 ? IN_(I_X) : F.out, l == 0 ? IN_(I_CTX) : (const float*)(F.ws + WS_XC), F.out, (float*)(F.ws + WS_XC), (const float*)(F.ws + WS_MOD) + (size_t)l * 2 * 6144};
    pg8::gemm_phase<EpiWo, pg8::StaticOrder, PG_ALIGN, PG_SP2>(F.lds, g, S, E, F.tid);
}
__device__ __forceinline__ void ph12_fast(Frame& F, int l) {
    pg8::Gemm g{(const bf16*)(F.ws + WS_HS), (const bf16*)(F.ws + WS_W13), MAXSLOT, NE * 512, D}; const int total = moe_build_table<2>(F, F.ctl + CW_CNT + l * 128); SchedMoe S{F.G, F.bid, total, (const LAS unsigned*)(F.lds + MOETAB_OFF)};
    EpiUp E{(bf16*)(F.ws + WS_ACT), (const float*)(F.ws + WS_SW)}; pg8::gemm_phase<EpiUp, SchedMoe, PG_ALIGN, PG_SP2>(F.lds, g, S, E, F.tid);
    moe_up_thin(F, __builtin_amdgcn_readfirstlane((int)((const LAS unsigned*)(F.lds + MOETAB_OFF))[2047]));
}
__device__ __forceinline__ void ph13_fast(Frame& F, int l) {
    pg8::Gemm g{(const bf16*)(F.ws + WS_ACT), (const bf16*)(F.ws + WS_W2), MAXSLOT, NE * D, DFF}; const int total = moe_build_table<4>(F, F.ctl + CW_CNT + l * 128); SchedMoe S{F.G, F.bid, total, (const LAS unsigned*)(F.lds + MOETAB_OFF)};
    EpiDown E{(bf16*)(F.ws + WS_YS2)}; pg8::gemm_phase<EpiDown, SchedMoe, PG_ALIGN, PG_SP2>(F.lds, g, S, E, F.tid);
    moe_down_thin(F, __builtin_amdgcn_readfirstlane((int)((const LAS unsigned*)(F.lds + MOETAB_OFF))[2047]));
}


constexpr int NSB = MT / 16;
__device__ __forceinline__ void s5_precompute(Frame& F) {
    LAS float* APr = (LAS float*)F.lds; LAS float* APi = APr + 2176; LAS float* BBr = APi + 2176; LAS float* BBi = BBr + 2048; LAS float* CCr = BBi + 2048; LAS float* CCi = CCr + 2048; LAS float* KK = CCi + 2048;
    for (int item = F.G - 1 - F.bid; item < 2 * G5; item += F.G) { const int l = item >> 5, g = item & 31;
        __syncthreads();
        if (F.tid < 128) { const int d = F.tid >> 6, p = F.tid & 63; const int ldg = (l * 2 + d) * G5 + g;
            const double lr = IN_(I_LRE)[ldg * P5 + p], li = IN_(I_LIM)[ldg * P5 + p], dt = exp((double)IN_(I_LDT)[ldg]);
            for (int e = 0; e <= 16; ++e) { const double m = exp(lr * dt * e), ang = li * dt * e; APr[(d * 64 + p) * 17 + e] = (float)(m * cos(ang)); APi[(d * 64 + p) * 17 + e] = (float)(m * sin(ang)); }
            { const double m16 = exp(lr * dt * 16.0), a16 = li * dt * 16.0; float* A16 = (float*)(F.ws + WS_A16) + ((size_t)((l * 32 + g) * 2 + d) * 64 + p) * 2; A16[0] = (float)(m16 * cos(a16)); A16[1] = (float)(m16 * sin(a16)); }
            const double m1 = exp(lr * dt), ar = m1 * cos(li * dt), ai = m1 * sin(li * dt); const double nr = ar - 1.0, ni = ai, den = lr * lr + li * li;
            const double qr = (nr * lr + ni * li) / den, qi = (ni * lr - nr * li) / den;
            for (int h = 0; h < 16; ++h) { const double x = IN_(I_BRE)[((size_t)ldg * P5 + p) * H5 + h], y = IN_(I_BIM)[((size_t)ldg * P5 + p) * H5 + h];
                BBr[(d * 64 + p) * 16 + h] = (float)(qr * x - qi * y); BBi[(d * 64 + p) * 16 + h] = (float)(qr * y + qi * x);
                CCr[(d * 16 + h) * 64 + p] = IN_(I_CRE)[((size_t)ldg * H5 + h) * P5 + p]; CCi[(d * 16 + h) * 64 + p] = IN_(I_CIM)[((size_t)ldg * H5 + h) * P5 + p]; } }
        __syncthreads();
        { const int d = F.tid >> 8, e = (F.tid >> 4) & 15, hp = F.tid & 15;
          float wr[64], wi[64];
#pragma unroll
          for (int p = 0; p < 64; ++p) { const float pr = APr[(d * 64 + p) * 17 + e], pi = APi[(d * 64 + p) * 17 + e], br = BBr[(d * 64 + p) * 16 + hp], bi = BBi[(d * 64 + p) * 16 + hp]; wr[p] = pr * br - pi * bi; wi[p] = pr * bi + pi * br; }
#pragma unroll 1
          for (int h = 0; h < 16; ++h) { float a = 0.f;
#pragma unroll
              for (int p = 0; p < 64; ++p) a += CCr[(d * 16 + h) * 64 + p] * wr[p] - CCi[(d * 16 + h) * 64 + p] * wi[p];
              KK[(d * 16 + e) * 256 + h * 16 + hp] = a; } }
        __syncthreads();
        bf16* M = (bf16*)(F.ws + WS_S5M) + (size_t)(l * 32 + g) * 3 * 65536;
        for (int idx = F.tid; idx < 32768; idx += NT) {
            const int r = idx >> 7, k0 = (idx & 127) * 2; float v[3][2];
#pragma unroll
            for (int q = 0; q < 2; ++q) { const int kk = k0 + q;
                { const int d = r >> 7, p = (r >> 1) & 63, c = r & 1, sg = kk >> 4, hp = kk & 15, e = d == 0 ? 15 - sg : sg;
                  const float pr = APr[(d * 64 + p) * 17 + e], pi = APi[(d * 64 + p) * 17 + e], br = BBr[(d * 64 + p) * 16 + hp], bi = BBi[(d * 64 + p) * 16 + hp];
                  v[0][q] = c == 0 ? pr * br - pi * bi : pr * bi + pi * br; }
                { const int tau = r >> 4, h = r & 15, sg = kk >> 4, hp = kk & 15; float t = 0.f;
                  if (sg <= tau) t += KK[(0 * 16 + (tau - sg)) * 256 + h * 16 + hp]; if (sg >= tau) t += KK[(1 * 16 + (sg - tau)) * 256 + h * 16 + hp]; v[1][q] = t; }
                { const int tau = r >> 4, h = r & 15, d = kk >> 7, p = (kk >> 1) & 63, c = kk & 1, e = d == 0 ? tau + 1 : 16 - tau;
                  const float cr = CCr[(d * 16 + h) * 64 + p], ci = CCi[(d * 16 + h) * 64 + p], pr = APr[(d * 64 + p) * 17 + e], pi = APi[(d * 64 + p) * 17 + e];
                  v[2][q] = c == 0 ? cr * pr - ci * pi : -(cr * pi + ci * pr); } }
#pragma unroll
            for (int m = 0; m < 3; ++m) *(unsigned*)(M + (size_t)m * 65536 + r * 256 + k0) = pk2(v[m][0], v[m][1]);
        }
    }
}
__device__ __forceinline__ void s5_z_phase(Frame& F, int l) {
    const bf16* PROJ = (const bf16*)(F.ws + WS_PROJ); float* Z = (float*)(F.ws + WS_Z);
    const int l15 = F.lane & 15, lq = F.lane >> 4;
    for (int item = F.bid; item < 256; item += F.G) {
        const int g = item >> 3, part = item & 7; const bf16* Fm = (const bf16*)(F.ws + WS_S5M) + (size_t)(l * 32 + g) * 3 * 65536;
        bf16x8 Af[2][8];
#pragma unroll
        for (int j = 0; j < 2; ++j)
#pragma unroll
            for (int ks = 0; ks < 8; ++ks) Af[j][ks] = *(const bf16x8*)(Fm + (size_t)(16 * (2 * F.wave + j) + l15) * 256 + 32 * ks + 8 * lq);
        const bf16* vsrc = PROJ + (size_t)(16 * l15 + 2 * F.wave + (lq >> 1)) * INW + 16 * g + 8 * (lq & 1);
        __syncthreads();
        bf16x8 nv = *(const bf16x8*)(vsrc + (size_t)part * 256 * INW);
        *(LAS bf16x8*)(F.lds + (F.wave * 64 + F.lane) * 16) = nv;
        __syncthreads();
        int cur = 0;
#pragma unroll 1
        for (int tl = part; tl < MT / 256; tl += 8) {
            const bool more = tl + 8 < MT / 256;
            if (more) nv = *(const bf16x8*)(vsrc + (size_t)(tl + 8) * 256 * INW);
            f32x4 acc[2] = {{0.f, 0.f, 0.f, 0.f}, {0.f, 0.f, 0.f, 0.f}};
#pragma unroll
            for (int ks = 0; ks < 8; ++ks) { const bf16x8 V = *(const LAS bf16x8*)(F.lds + cur * 8192 + (ks * 64 + F.lane) * 16);
#pragma unroll
                for (int j = 0; j < 2; ++j) acc[j] = __builtin_amdgcn_mfma_f32_16x16x32_bf16(Af[j][ks], V, acc[j], 0, 0, 0); }
#pragma unroll
            for (int j = 0; j < 2; ++j) *(f32x4*)(Z + ((size_t)(tl * 16 + l15) * 32 + g) * 256 + 16 * (2 * F.wave + j) + 4 * lq) = acc[j];
            if (more) *(LAS bf16x8*)(F.lds + (cur ^ 1) * 8192 + (F.wave * 64 + F.lane) * 16) = nv;
            __syncthreads();
            cur ^= 1;
        }
    }
}
__device__ __forceinline__ int s5_chain_sb(int d, int i) { return d == 0 ? (i < 16 ? 1024 + i : i - 16) : (i < 16 ? 1039 - i : 1023 - (i - 16)); }
__device__ __forceinline__ void s5_scan_phase(Frame& F, int l) {
    LAS float* EX = (LAS float*)F.lds;
    for (int item = F.bid; item < 256; item += F.G) {
        const int cid = item * 16 + (F.tid & 15), j = F.tid >> 4;
        const int g = cid >> 7, d = (cid >> 6) & 1, p = cid & 63;
        const float* A16 = (const float*)(F.ws + WS_A16) + ((size_t)((l * 32 + g) * 2 + d) * 64 + p) * 2; const float ar = A16[0], ai = A16[1];
        const float* Z = (const float*)(F.ws + WS_Z) + (size_t)g * 256 + d * 128 + 2 * p; bf16* SS = (bf16*)(F.ws + WS_SS) + (size_t)g * 256 + d * 128 + 2 * p;
        float2 z[33];
#pragma unroll
        for (int q = 0; q < 33; ++q) { const int i = 33 * j + q; z[q] = i < NSB ? *(const float2*)(Z + (size_t)s5_chain_sb(d, i) * 8192) : make_float2(0.f, 0.f); }
        float hr = 0.f, hi = 0.f, pr = 1.f, pi = 0.f;
#pragma unroll
        for (int q = 0; q < 33; ++q) { if (33 * j + q < NSB) { const float nr = ar * hr - ai * hi + z[q].x, ni = ar * hi + ai * hr + z[q].y; hr = nr; hi = ni; const float qr = pr * ar - pi * ai, qi = pr * ai + pi * ar; pr = qr; pi = qi; } }
        __syncthreads();
        EX[(j * 16 + (F.tid & 15)) * 4 + 0] = hr; EX[(j * 16 + (F.tid & 15)) * 4 + 1] = hi; EX[(j * 16 + (F.tid & 15)) * 4 + 2] = pr; EX[(j * 16 + (F.tid & 15)) * 4 + 3] = pi;
        __syncthreads();
        float cr = 0.f, ci = 0.f;
        for (int i = 0; i < j; ++i) { const float er = EX[(i * 16 + (F.tid & 15)) * 4 + 0], ei = EX[(i * 16 + (F.tid & 15)) * 4 + 1], qr = EX[(i * 16 + (F.tid & 15)) * 4 + 2], qi = EX[(i * 16 + (F.tid & 15)) * 4 + 3];
            const float nr = qr * cr - qi * ci + er, ni = qr * ci + qi * cr + ei; cr = nr; ci = ni; }
        hr = cr; hi = ci;
#pragma unroll
        for (int q = 0; q < 33; ++q) { const int i = 33 * j + q; if (i < NSB) { *(unsigned*)(SS + (size_t)s5_chain_sb(d, i) * 8192) = pk2(hr, hi);
            const float nr = ar * hr - ai * hi + z[q].x, ni = ar * hi + ai * hr + z[q].y; hr = nr; hi = ni; } }
    }
}
__device__ __forceinline__ void s5_y_phase(Frame& F, int l) {
    const bf16* PROJ = (const bf16*)(F.ws + WS_PROJ); const bf16* SS = (const bf16*)(F.ws + WS_SS); bf16* YG = (bf16*)(F.ws + WS_YG); const float* ds = IN_(I_DSKIP) + l * MIXW;
    const int l15 = F.lane & 15, lq = F.lane >> 4;
    for (int item = F.bid; item < 256; item += F.G) {
        const int g = item >> 3, part = item & 7; const bf16* Tm = (const bf16*)(F.ws + WS_S5M) + ((size_t)(l * 32 + g) * 3 + 1) * 65536; const bf16* Em = Tm + 65536;
        bf16x8 At[2][8], Ae[2][8];
#pragma unroll
        for (int j = 0; j < 2; ++j)
#pragma unroll
            for (int ks = 0; ks < 8; ++ks) { const size_t o = (size_t)(16 * (2 * F.wave + j) + l15) * 256 + 32 * ks + 8 * lq; At[j][ks] = *(const bf16x8*)(Tm + o); Ae[j][ks] = *(const bf16x8*)(Em + o); }
        const f32x4 dsk = *(const f32x4*)(ds + 16 * g + 4 * lq);
        const int ntl = l == 0 ? MT / 256 : SEQ / 256;
        const bf16* vsrc = PROJ + (size_t)(16 * l15 + 2 * F.wave + (lq >> 1)) * INW + 16 * g + 8 * (lq & 1);
        const bf16* ssrc = SS + ((size_t)l15 * 32 + g) * 256 + 32 * F.wave + 8 * lq;
        __syncthreads();
        bf16x8 nv = *(const bf16x8*)(vsrc + (size_t)part * 256 * INW), ns = *(const bf16x8*)(ssrc + (size_t)part * 16 * 8192);
        *(LAS bf16x8*)(F.lds + (F.wave * 64 + F.lane) * 16) = nv; *(LAS bf16x8*)(F.lds + 8192 + (F.wave * 64 + F.lane) * 16) = ns;
        __syncthreads();
        int cur = 0;
#pragma unroll 1
        for (int tl = part; tl < ntl; tl += 8) {
            const bool more = tl + 8 < ntl;
            if (more) { nv = *(const bf16x8*)(vsrc + (size_t)(tl + 8) * 256 * INW); ns = *(const bf16x8*)(ssrc + (size_t)(tl + 8) * 16 * 8192); }
            v2u uu[2];
#pragma unroll
            for (int j = 0; j < 2; ++j) uu[j] = *(const v2u*)(PROJ + ((size_t)tl * 256 + 16 * l15 + (2 * F.wave + j)) * INW + 16 * g + 4 * lq);
            f32x4 acc[2] = {{0.f, 0.f, 0.f, 0.f}, {0.f, 0.f, 0.f, 0.f}};
#pragma unroll
            for (int ks = 0; ks < 8; ++ks) { const bf16x8 V = *(const LAS bf16x8*)(F.lds + cur * 16384 + (ks * 64 + F.lane) * 16), S = *(const LAS bf16x8*)(F.lds + cur * 16384 + 8192 + (ks * 64 + F.lane) * 16);
#pragma unroll
                for (int j = 0; j < 2; ++j) { acc[j] = __builtin_amdgcn_mfma_f32_16x16x32_bf16(At[j][ks], V, acc[j], 0, 0, 0); acc[j] = __builtin_amdgcn_mfma_f32_16x16x32_bf16(Ae[j][ks], S, acc[j], 0, 0, 0); } }
#pragma unroll
            for (int j = 0; j < 2; ++j) { const size_t row = (size_t)tl * 256 + 16 * l15 + (2 * F.wave + j); const int ch = 16 * g + 4 * lq; const v2u u = uu[j];
                const float y0 = acc[j][0] + dsk[0] * bflo(u.x), y1 = acc[j][1] + dsk[1] * bfhi(u.x), y2 = acc[j][2] + dsk[2] * bflo(u.y), y3 = acc[j][3] + dsk[3] * bfhi(u.y);
                v2u w; w.x = cvtpk(geluf_(y0), geluf_(y1)); w.y = cvtpk(geluf_(y2), geluf_(y3)); *(v2u*)(YG + row * MIXW + ch) = w; }
            if (more) { *(LAS bf16x8*)(F.lds + (cur ^ 1) * 16384 + (F.wave * 64 + F.lane) * 16) = nv; *(LAS bf16x8*)(F.lds + (cur ^ 1) * 16384 + 8192 + (F.wave * 64 + F.lane) * 16) = ns; }
            __syncthreads();
            cur ^= 1;
        }
    }
}
constexpr int SG_STRIDE = 272, SG_IMG = 256 * SG_STRIDE, SG_STAT = SG_IMG;
__device__ __forceinline__ void sg_fast_chunk(Frame& F, int l, int chunk) {
    const bf16* PROJ = (const bf16*)(F.ws + WS_PROJ); bf16* YB = (bf16*)(F.ws + WS_YS) + (size_t)MT * MIXW; const bf16* WSG = (const bf16*)(F.ws + WS_WSG);
    const float* lg = IN_(I_SGG) + l * MIXW; const float* lb = IN_(I_SGB) + l * MIXW; const float* bsg = IN_(I_BSG) + l * 512;
    LAS float* st = (LAS float*)(F.lds + SG_STAT);
    __syncthreads();
    {
        const int p = F.tid >> 2, part = F.tid & 3; const bf16* vr = PROJ + (size_t)(chunk * 128 + p) * INW + 1024 + part * 128; float s = 0.f, q = 0.f;
#pragma unroll 4
        for (int c = 0; c < 128; c += 8) { const v4u w = *(const v4u*)(vr + c); const float x[8] = {bflo(w.x), bfhi(w.x), bflo(w.y), bfhi(w.y), bflo(w.z), bfhi(w.z), bflo(w.w), bfhi(w.w)};
#pragma unroll
            for (int i = 0; i < 8; ++i) { s += x[i]; q += x[i] * x[i]; } }
        s += shflx(s, 1, F.lane); q += shflx(q, 1, F.lane); s += shflx(s, 2, F.lane); q += shflx(q, 2, F.lane);
        const float mu = s * (1.f / 512.f), var = fmaxf(q * (1.f / 512.f) - mu * mu, 0.f);
        if (part == 0) { st[p * 2] = mu; st[p * 2 + 1] = rsqrtf(var + EPS); }
    }
    const int l15 = F.lane & 15, lq = F.lane >> 4;
#pragma unroll 1
    for (int pass = 0; pass < 2; ++pass) {
        __syncthreads();
#pragma unroll 1
        for (int it = F.tid; it < 2048; it += NT) { const int tp = it & 63, cg = it >> 6; const int p0 = tp * 2, ch = pass * 256 + cg * 8;
            const v4u w0 = *(const v4u*)(PROJ + (size_t)(chunk * 128 + p0) * INW + 1024 + ch), w1 = *(const v4u*)(PROJ + (size_t)(chunk * 128 + p0 + 1) * INW + 1024 + ch);
            const float mu0 = st[p0 * 2], rs0 = st[p0 * 2 + 1], mu1 = st[p0 * 2 + 2], rs1 = st[p0 * 2 + 3];
            const float x0[8] = {bflo(w0.x), bfhi(w0.x), bflo(w0.y), bfhi(w0.y), bflo(w0.z), bfhi(w0.z), bflo(w0.w), bfhi(w0.w)};
            const float x1[8] = {bflo(w1.x), bfhi(w1.x), bflo(w1.y), bfhi(w1.y), bflo(w1.z), bfhi(w1.z), bflo(w1.w), bfhi(w1.w)};
#pragma unroll
            for (int i = 0; i < 8; ++i) { const float gm = lg[ch + i], bt = lb[ch + i];
                *(LAS unsigned*)(F.lds + (cg * 8 + i) * SG_STRIDE + p0 * 2) = pk2((x0[i] - mu0) * rs0 * gm + bt, (x1[i] - mu1) * rs1 * gm + bt); } }
        __syncthreads();
        const int ggl = F.wave >> 2, gg = pass * 2 + ggl, rb0 = (F.wave & 3) * 2;
        bf16x8 A[2][4];
#pragma unroll
        for (int j = 0; j < 2; ++j)
#pragma unroll
            for (int ks = 0; ks < 4; ++ks) A[j][ks] = *(const LAS bf16x8*)(F.lds + (ggl * 128 + (rb0 + j) * 16 + l15) * SG_STRIDE + (32 * ks + 8 * lq) * 2);
        f32x4 acc[2][8];
#pragma unroll
        for (int j = 0; j < 2; ++j)
#pragma unroll
            for (int cb = 0; cb < 8; ++cb) acc[j][cb] = (f32x4){0.f, 0.f, 0.f, 0.f};
#pragma unroll
        for (int cb0 = 0; cb0 < 8; cb0 += 4) {
            bf16x8 B[4][4];
#pragma unroll
            for (int c2 = 0; c2 < 4; ++c2)
#pragma unroll
                for (int ks = 0; ks < 4; ++ks) B[c2][ks] = *(const bf16x8*)(WSG + ((size_t)gg * 128 + (cb0 + c2) * 16 + l15) * 128 + 32 * ks + 8 * lq);
#pragma unroll
            for (int c2 = 0; c2 < 4; ++c2)
#pragma unroll
                for (int ks = 0; ks < 4; ++ks)
#pragma unroll
                    for (int j = 0; j < 2; ++j) acc[j][cb0 + c2] = __builtin_amdgcn_mfma_f32_16x16x32_bf16(A[j][ks], B[c2][ks], acc[j][cb0 + c2], 0, 0, 0);
        }
#pragma unroll
        for (int cb = 0; cb < 8; ++cb) { const int q = cb * 16 + l15; const size_t row = (size_t)chunk * 128 + q; const float bq = bsg[gg * 128 + q];
#pragma unroll
            for (int j = 0; j < 2; ++j) { const int col = gg * 128 + (rb0 + j) * 16 + 4 * lq; const v2u gu = *(const v2u*)(PROJ + row * INW + 512 + col);
                v2u w; w.x = cvtpk(bflo(gu.x) * (acc[j][cb][0] + bq), bfhi(gu.x) * (acc[j][cb][1] + bq)); w.y = cvtpk(bflo(gu.y) * (acc[j][cb][2] + bq), bfhi(gu.y) * (acc[j][cb][3] + bq));
                *(v2u*)(YB + row * MIXW + col) = w; } }
    }
}


__device__ __forceinline__ void thin_acc(f32x4 (&acc)[2], const bf16* A, int lda, const bf16* Bt, int K, int wave, int lane) {
    const int r = lane & 15, q = lane >> 4; const bf16* a0 = A + (size_t)(32 * wave + r) * lda + 8 * q; const bf16* a1 = a0 + (size_t)16 * lda; const bf16* b = Bt + (size_t)r * K + 8 * q;
#pragma unroll 1
    for (int k0 = 0; k0 < K / 32; k0 += 8) {
        bf16x8 x0[8], x1[8], w[8];
#pragma unroll
        for (int j = 0; j < 8; ++j) { x0[j] = *(const bf16x8*)(a0 + 32 * (k0 + j)); x1[j] = *(const bf16x8*)(a1 + 32 * (k0 + j)); w[j] = *(const bf16x8*)(b + 32 * (k0 + j)); }
#pragma unroll
        for (int j = 0; j < 8; ++j) { acc[0] = __builtin_amdgcn_mfma_f32_16x16x32_bf16(x0[j], w[j], acc[0], 0, 0, 0); acc[1] = __builtin_amdgcn_mfma_f32_16x16x32_bf16(x1[j], w[j], acc[1], 0, 0, 0); }
    }
}
#define THIN_FOREACH(acc, body) _Pragma("unroll") for (int _j = 0; _j < 2; ++_j) _Pragma("unroll") for (int _i = 0; _i < 4; ++_i) { const int crow = 32 * F.wave + 16 * _j + 4 * (F.lane >> 4) + _i; const float v = acc[_j][_i]; body }
__device__ __forceinline__ void ph2_ctx(Frame& F, int ncols) {
    const bf16* Hc = (const bf16*)(F.ws + WS_H) + (size_t)SEQ * D; bf16* P = (bf16*)(F.ws + WS_PROJ) + (size_t)SEQ * INW; const bf16* W = (const bf16*)(F.ws + WS_WIN);
    for (int it = F.bid; it < ncols / 16; it += F.G) { const int col = it * 16 + (F.lane & 15); f32x4 acc[2] = {{0.f, 0.f, 0.f, 0.f}, {0.f, 0.f, 0.f, 0.f}};
        thin_acc(acc, Hc, D, W + (size_t)it * 16 * D, D, F.wave, F.lane);
        THIN_FOREACH(acc, { const float o = (col >= 512 && col < 1536) ? geluf_(v) : v; P[(size_t)crow * INW + col] = (bf16)f2bf(o); }) }
}
__device__ __forceinline__ void ph6_ctx(Frame& F) {
    const bf16* YGc = (const bf16*)(F.ws + WS_YG) + (size_t)SEQ * MIXW; bf16* YA = (bf16*)(F.ws + WS_YS) + (size_t)SEQ * MIXW; const bf16* W = (const bf16*)(F.ws + WS_WGLU);
    for (int it = F.bid; it < MIXW / 16; it += F.G) { const int col = it * 16 + (F.lane & 15); f32x4 acc[2] = {{0.f, 0.f, 0.f, 0.f}, {0.f, 0.f, 0.f, 0.f}};
        thin_acc(acc, YGc, MIXW, W + (size_t)it * 16 * MIXW, MIXW, F.wave, F.lane);
        float yv[2][4];
#pragma unroll
        for (int j = 0; j < 2; ++j)
#pragma unroll
            for (int i = 0; i < 4; ++i) yv[j][i] = bf2f(YGc[(size_t)(32 * F.wave + 16 * j + 4 * (F.lane >> 4) + i) * MIXW + col]);
        asm volatile("" ::: "memory");
        THIN_FOREACH(acc, { YA[(size_t)crow * MIXW + col] = (bf16)f2bf(yv[_j][_i] * sigmoidf_(v)); }) }
}
__device__ __forceinline__ void ph7_ctx(Frame& F) {
    bf16* BR = (bf16*)(F.ws + WS_PROJ) + (size_t)SEQ * INW;
    for (int it = F.bid; it < 3 * (D / 16); it += F.G) { const int kk = it / (D / 16), cb = it % (D / 16); const int col = cb * 16 + (F.lane & 15); f32x4 acc[2] = {{0.f, 0.f, 0.f, 0.f}, {0.f, 0.f, 0.f, 0.f}};
        thin_acc(acc, (const bf16*)(F.ws + WS_YS) + ((size_t)kk * MT + SEQ) * MIXW, MIXW, (const bf16*)(F.ws + WS_WBR) + ((size_t)kk * 1024 + cb * 16) * MIXW, MIXW, F.wave, F.lane);
        THIN_FOREACH(acc, { BR[(size_t)crow * INW + kk * 1024 + col] = (bf16)f2bf(v); }) }
}
__device__ __forceinline__ void ph8_ctx(Frame& F, int l) {
    const bf16* Hc = (const bf16*)(F.ws + WS_H) + (size_t)SEQ * D; const bf16* BR = (const bf16*)(F.ws + WS_PROJ) + (size_t)SEQ * INW; bf16* PMK = (bf16*)(F.ws + WS_Z); const float* bm = IN_(I_BMG) + l * INW;
    for (int it = F.bid; it < 3 * (D / 16); it += F.G) { const int kk = it / (D / 16), cb = it % (D / 16); const int col = cb * 16 + (F.lane & 15); f32x4 acc[2] = {{0.f, 0.f, 0.f, 0.f}, {0.f, 0.f, 0.f, 0.f}};
        thin_acc(acc, Hc, D, (const bf16*)(F.ws + WS_WMG) + ((size_t)kk * 1024 + cb * 16) * D, D, F.wave, F.lane);
        const float bb = bm[kk * 1024 + col];
        float bv[2][4];
#pragma unroll
        for (int j = 0; j < 2; ++j)
#pragma unroll
            for (int i = 0; i < 4; ++i) bv[j][i] = bf2f(BR[(size_t)(32 * F.wave + 16 * j + 4 * (F.lane >> 4) + i) * INW + kk * 1024 + col]);
        asm volatile("" ::: "memory");
        THIN_FOREACH(acc, { PMK[((size_t)kk * CTX + crow) * D + col] = (bf16)f2bf(sigmoidf_(v + bb) * bv[_j][_i]); }) }
}
__device__ __forceinline__ bf16x8 sum3_bf16x8(const bf16* p, size_t stride) {
    const v4u a = *(const v4u*)p, b = *(const v4u*)(p + stride), c = *(const v4u*)(p + 2 * stride); v4u o;
    o.x = pk2(bflo(a.x) + bflo(b.x) + bflo(c.x), bfhi(a.x) + bfhi(b.x) + bfhi(c.x)); o.y = pk2(bflo(a.y) + bflo(b.y) + bflo(c.y), bfhi(a.y) + bfhi(b.y) + bfhi(c.y));
    o.z = pk2(bflo(a.z) + bflo(b.z) + bflo(c.z), bfhi(a.z) + bfhi(b.z) + bfhi(c.z)); o.w = pk2(bflo(a.w) + bflo(b.w) + bflo(c.w), bfhi(a.w) + bfhi(b.w) + bfhi(c.w));
    return __builtin_bit_cast(bf16x8, o);
}
__device__ __forceinline__ void ph9_ctx(Frame& F, int l) {
    const bf16* PMK = (const bf16*)(F.ws + WS_Z); float* XC = (float*)(F.ws + WS_XC); const float* xs = l == 0 ? IN_(I_CTX) : (const float*)(F.ws + WS_XC);
    const float* ga = (const float*)(F.ws + WS_MOD) + (size_t)(l * 2 + 1) * 6144 + 2048;
    const int r = F.lane & 15, q = F.lane >> 4;
    for (int it = F.bid; it < D / 16; it += F.G) { const int col = it * 16 + r; f32x4 acc[2] = {{0.f, 0.f, 0.f, 0.f}, {0.f, 0.f, 0.f, 0.f}};
        const bf16* a0 = PMK + (size_t)(32 * F.wave + r) * D + 8 * q; const bf16* a1 = a0 + (size_t)16 * D; const bf16* b = (const bf16*)(F.ws + WS_WO) + (size_t)(it * 16 + r) * D + 8 * q;
#pragma unroll 1
        for (int k0 = 0; k0 < D / 32; k0 += 4) {
            bf16x8 x0[4], x1[4], w[4];
#pragma unroll
            for (int j = 0; j < 4; ++j) { x0[j] = sum3_bf16x8(a0 + 32 * (k0 + j), (size_t)CTX * D); x1[j] = sum3_bf16x8(a1 + 32 * (k0 + j), (size_t)CTX * D); w[j] = *(const bf16x8*)(b + 32 * (k0 + j)); }
#pragma unroll
            for (int j = 0; j < 4; ++j) { acc[0] = __builtin_amdgcn_mfma_f32_16x16x32_bf16(x0[j], w[j], acc[0], 0, 0, 0); acc[1] = __builtin_amdgcn_mfma_f32_16x16x32_bf16(x1[j], w[j], acc[1], 0, 0, 0); }
        }
        const float gc = ga[col];
        float xv[2][4];
#pragma unroll
        for (int j = 0; j < 2; ++j)
#pragma unroll
            for (int i = 0; i < 4; ++i) xv[j][i] = xs[(size_t)(32 * F.wave + 16 * j + 4 * q + i) * D + col];
        asm volatile("" ::: "memory");
        THIN_FOREACH(acc, { XC[(size_t)crow * D + col] = xv[_j][_i] + gc * v; }) }
}

struct NSmem { float As[16][68]; float Bs[16][68]; };
template <class AF>
__device__ __forceinline__ void ngemm_acc(float (&acc)[4][4], const AF& af, const float* B, int ldb, int K, LAS NSmem* s, int t) {
    const int ty = t >> 4, tx = t & 15, lr = t >> 2, lk = (t & 3) * 4, bk = t >> 4, bn = (t & 15) * 4;
    for (int k0 = 0; k0 < K; k0 += 16) {
        const float4 av = af.load4(lr, k0 + lk);
        const float4 bv = *(const float4*)(B + (size_t)(k0 + bk) * ldb + bn);
        __syncthreads();
        s->As[lk + 0][lr] = av.x; s->As[lk + 1][lr] = av.y; s->As[lk + 2][lr] = av.z; s->As[lk + 3][lr] = av.w;
        *(LAS f32x4*)&s->Bs[bk][bn] = (f32x4){bv.x, bv.y, bv.z, bv.w};
        __syncthreads();
#pragma unroll
        for (int k = 0; k < 16; ++k) {
            const f32x4 a = *(const LAS f32x4*)&s->As[k][ty * 4]; const f32x4 b = *(const LAS f32x4*)&s->Bs[k][tx * 4];
            const float aa[4] = {a.x, a.y, a.z, a.w}, bb[4] = {b.x, b.y, b.z, b.w};
#pragma unroll
            for (int i = 0; i < 4; ++i)
#pragma unroll
                for (int j = 0; j < 4; ++j) acc[i][j] += aa[i] * bb[j];
        }
    }
}
struct ABf { const bf16* A; int lda; __device__ __forceinline__ float4 load4(int r, int k) const { const v2u w = *(const v2u*)(A + (size_t)r * lda + k);
    return make_float4(bf2f((unsigned short)(w.x & 0xffff)), bf2f((unsigned short)(w.x >> 16)), bf2f((unsigned short)(w.y & 0xffff)), bf2f((unsigned short)(w.y >> 16))); } };
#define NTILE_BEGIN(ntiles) { const int _half = F.tid >> 8, t = F.tid & 255, ty = t >> 4, tx = t & 15; LAS NSmem* sm = (LAS NSmem*)F.lds + _half; (void)ty; (void)tx; \
    const int _nt = (ntiles), _nit = (_nt + 2 * F.G - 1) / (2 * F.G); \
    for (int _it = 0; _it < _nit; ++_it) { int T = (_it * F.G + F.bid) * 2 + _half; const bool valid = T < _nt; if (!valid) T = _nt - 1;
#define NTILE_END } }

__device__ __forceinline__ void ph0_prologue(Frame& F) {
    float* mod = (float*)(F.ws + WS_MOD);
    LAS float* SV = (LAS float*)(F.lds + 131072 + 4096);
    for (int i = F.tid; i < 2048; i += NT) SV[i] = siluf_(i < 1024 ? IN_(I_C)[i] : IN_(I_CCTX)[i - 1024]);
    __syncthreads();
    LAS float* RED = (LAS float*)(F.lds + 131072 + 4096 + 8192);
    for (int it = F.bid; it < 2 * 96; it += F.G) { const int l = it / 96, j = (it % 96) * 64 + F.lane;
        const float* W = IN_(I_WADA) + (size_t)l * D * 6144 + j + (size_t)(F.wave * 128) * 6144;
        float a0 = 0.f, a1 = 0.f;
#pragma unroll 32
        for (int kk = 0; kk < 128; ++kk) { const float w = W[(size_t)kk * 6144]; a0 += SV[F.wave * 128 + kk] * w; a1 += SV[1024 + F.wave * 128 + kk] * w; }
        __syncthreads();
        RED[(F.wave * 2 + 0) * 64 + F.lane] = a0; RED[(F.wave * 2 + 1) * 64 + F.lane] = a1;
        __syncthreads();
        if (F.wave < 2) { float s = 0.f;
#pragma unroll
            for (int w8 = 0; w8 < 8; ++w8) s += RED[(w8 * 2 + F.wave) * 64 + F.lane];
            mod[(size_t)(l * 2 + F.wave) * 6144 + j] = s + IN_(I_BADA)[l * 6144 + j]; }
    }
}
__device__ __forceinline__ void stage_mod(Frame& F, const float* g, int l, int sh_off, int sc_off, LAS float* GC, LAS float* SH) {
    __syncthreads();
    for (int i = F.tid; i < 2048; i += NT) { const int w = i >> 10, c = i & 1023; const float* m = (const float*)(F.ws + WS_MOD) + (size_t)(l * 2 + w) * 6144; GC[i] = g[c] * (1.f + m[sc_off + c]); SH[i] = m[sh_off + c]; }
    __syncthreads();
}
__device__ __forceinline__ void hprep_rows(Frame& F, int l) {
    bf16* H = (bf16*)(F.ws + WS_H); LAS float* GC = (LAS float*)F.lds; LAS float* SH = GC + 2048;
    stage_mod(F, IN_(I_GMIX) + l * D, l, 0, 1024, GC, SH);
    const int gw = F.bid * (NT / 64) + F.wave, ngw = F.G * (NT / 64);
    for (int row = gw; row < MT; row += ngw) {
        const float* xr = xsrc_row(F, l, row); const int pv = row >= SEQ ? 1024 : 0;
        f32x4 v[4]; float s = 0.f;
#pragma unroll
        for (int j = 0; j < 4; ++j) { v[j] = *(const f32x4*)(xr + 4 * F.lane + 256 * j); s += v[j].x * v[j].x + v[j].y * v[j].y + v[j].z * v[j].z + v[j].w * v[j].w; }
        const float rstd = rsqrtf(wave_sum(s, F.lane) * (1.f / D) + EPS);
#pragma unroll
        for (int j = 0; j < 4; ++j) { const int c = 4 * F.lane + 256 * j; const f32x4 gc = *(const LAS f32x4*)(GC + pv + c), sh = *(const LAS f32x4*)(SH + pv + c);
            const f32x4 o = v[j] * rstd * gc + sh; v2u w; w.x = pk2(o.x, o.y); w.y = pk2(o.z, o.w); *(v2u*)(H + (size_t)row * D + c) = w; }
    }
}
__device__ __forceinline__ void ph2_naive(Frame& F, int l) {
    const bf16* H = (const bf16*)(F.ws + WS_H); bf16* PROJ = (bf16*)(F.ws + WS_PROJ); const float* W = IN_(I_WIN) + (size_t)l * D * INW;
    NTILE_BEGIN((MT / 64) * (INW / 64))
        const int m0 = (T / (INW / 64)) * 64, n0 = (T % (INW / 64)) * 64;
        float acc[4][4] = {};
        ngemm_acc(acc, ABf{H + (size_t)m0 * D, D}, W + n0, INW, D, sm, t);
        if (valid) {
#pragma unroll
            for (int i = 0; i < 4; ++i) { float o[4];
#pragma unroll
                for (int j = 0; j < 4; ++j) { o[j] = acc[i][j]; if (n0 >= 512 && n0 < 1536) o[j] = geluf_(o[j]); }
                v2u w; w.x = pk2(o[0], o[1]); w.y = pk2(o[2], o[3]); *(v2u*)(PROJ + (size_t)(m0 + ty * 4 + i) * INW + n0 + tx * 4) = w; }
        }
    NTILE_END
}
__device__ __forceinline__ int chain_row(int dir, int pos) { return dir == 0 ? (pos < CTX ? SEQ + pos : pos - CTX) : (pos < CTX ? SEQ + CTX - 1 - pos : SEQ - 1 - (pos - CTX)); }
__device__ __forceinline__ void ph3_s5_naive(Frame& F, int l) {
    LAS float* Cr = (LAS float*)(F.lds + 32768); LAS float* Ci = Cr + 1024; LAS float* Sr = Ci + 1024; LAS float* Si = Sr + 2048;
    const bf16* PROJ = (const bf16*)(F.ws + WS_PROJ); float* YD = (float*)(F.ws + WS_S5);
    for (int item = F.bid; item < 64; item += F.G) {
        if (F.wave == 0) {
            const int g = item >> 1, dir = item & 1, p = F.lane;
            const int ldg = ((l * 2 + dir) * G5 + g);
            const float lr = IN_(I_LRE)[ldg * P5 + p], li = IN_(I_LIM)[ldg * P5 + p], dt = expf(IN_(I_LDT)[ldg]);
            const float er = expf(lr * dt), ar = er * cosf(li * dt), ai = er * sinf(li * dt);
            const float nr = ar - 1.f, ni = ai, den = lr * lr + li * li;
            const float qr = (nr * lr + ni * li) / den, qi = (ni * lr - nr * li) / den;
            float br[16], bi[16];
#pragma unroll
            for (int h = 0; h < 16; ++h) { const float x = IN_(I_BRE)[((size_t)ldg * P5 + p) * H5 + h], y = IN_(I_BIM)[((size_t)ldg * P5 + p) * H5 + h]; br[h] = qr * x - qi * y; bi[h] = qr * y + qi * x; }
            for (int h = 0; h < 16; ++h) { Cr[h * 64 + p] = IN_(I_CRE)[((size_t)ldg * H5 + h) * P5 + p]; Ci[h * 64 + p] = IN_(I_CIM)[((size_t)ldg * H5 + h) * P5 + p]; }
            float sr = 0.f, si = 0.f;
            float* Y = YD + (size_t)dir * MT * MIXW;
#pragma unroll 1
            for (int blk = 0; blk < MT / 32; ++blk) {
#pragma unroll 1
                for (int tt = 0; tt < 32; ++tt) {
                    const int row = chain_row(dir, blk * 32 + tt);
                    const v4u u0 = *(const v4u*)(PROJ + (size_t)row * INW + g * 16), u1 = *(const v4u*)(PROJ + (size_t)row * INW + g * 16 + 8);
                    const unsigned uw[8] = {u0.x, u0.y, u0.z, u0.w, u1.x, u1.y, u1.z, u1.w};
                    float xr = 0.f, xi = 0.f;
#pragma unroll
                    for (int h = 0; h < 8; ++h) { const float ua = bf2f((unsigned short)(uw[h] & 0xffff)), ub = bf2f((unsigned short)(uw[h] >> 16));
                        xr += br[2 * h] * ua + br[2 * h + 1] * ub; xi += bi[2 * h] * ua + bi[2 * h + 1] * ub; }
                    const float nsr = ar * sr - ai * si + xr, nsi = ar * si + ai * sr + xi;
                    sr = nsr; si = nsi; Sr[tt * 64 + p] = sr; Si[tt * 64 + p] = si;
                }
                asm volatile("s_waitcnt lgkmcnt(0)" ::: "memory");
#pragma unroll 1
                for (int o = p; o < 512; o += 64) {
                    const int tt = o >> 4, h = o & 15; float a = 0.f;
#pragma unroll 4
                    for (int q = 0; q < 64; ++q) a += Cr[h * 64 + q] * Sr[tt * 64 + q] - Ci[h * 64 + q] * Si[tt * 64 + q];
                    Y[(size_t)chain_row(dir, blk * 32 + tt) * MIXW + g * 16 + h] = a;
                }
                asm volatile("s_waitcnt lgkmcnt(0)" ::: "memory");
            }
        }
    }
}
__device__ __forceinline__ void ph3_sg_naive(Frame& F, int l) {
    const bf16* PROJ = (const bf16*)(F.ws + WS_PROJ); bf16* YB = (bf16*)(F.ws + WS_YS) + (size_t)MT * MIXW;
    LAS float* stat = (LAS float*)(F.lds + 32768);
    const float* lg = IN_(I_SGG) + l * MIXW; const float* lb = IN_(I_SGB) + l * MIXW;
    NTILE_BEGIN((MT / 128) * 16)
        const int chunk = T >> 4, gg = (T >> 2) & 3, q0 = ((T >> 1) & 1) * 64, c0 = (T & 1) * 64;
        LAS float* st = stat + _half * 256;
        __syncthreads();
        if (t < 128) { const bf16* vr = PROJ + (size_t)(chunk * 128 + t) * INW + 1024; float s = 0.f;
            for (int c = 0; c < 512; c += 2) { const unsigned w = *(const unsigned*)(vr + c); s += bf2f((unsigned short)(w & 0xffff)) + bf2f((unsigned short)(w >> 16)); }
            const float mu = s * (1.f / 512.f); float q = 0.f;
            for (int c = 0; c < 512; c += 2) { const unsigned w = *(const unsigned*)(vr + c); const float a = bf2f((unsigned short)(w & 0xffff)) - mu, b = bf2f((unsigned short)(w >> 16)) - mu; q += a * a + b * b; }
            st[t * 2] = mu; st[t * 2 + 1] = rsqrtf(q * (1.f / 512.f) + EPS); }
        __syncthreads();
        float acc[4][4] = {};
        {
            const float* A = IN_(I_WSG) + ((size_t)(l * 4 + gg) * 128 + q0) * 128;
            const int lr = t >> 2, lk = (t & 3) * 4, bk = t >> 4, bn = (t & 15) * 4;
            for (int k0 = 0; k0 < 128; k0 += 16) {
                const float4 av = *(const float4*)(A + (size_t)lr * 128 + k0 + lk);
                const int p = k0 + bk; const int col = gg * 128 + c0 + bn;
                const v2u w = *(const v2u*)(PROJ + (size_t)(chunk * 128 + p) * INW + 1024 + col);
                const float mu = st[p * 2], rs = st[p * 2 + 1];
                float4 bv; bv.x = (bf2f((unsigned short)(w.x & 0xffff)) - mu) * rs * lg[col] + lb[col]; bv.y = (bf2f((unsigned short)(w.x >> 16)) - mu) * rs * lg[col + 1] + lb[col + 1];
                bv.z = (bf2f((unsigned short)(w.y & 0xffff)) - mu) * rs * lg[col + 2] + lb[col + 2]; bv.w = (bf2f((unsigned short)(w.y >> 16)) - mu) * rs * lg[col + 3] + lb[col + 3];
                __syncthreads();
                sm->As[lk + 0][lr] = av.x; sm->As[lk + 1][lr] = av.y; sm->As[lk + 2][lr] = av.z; sm->As[lk + 3][lr] = av.w;
                *(LAS f32x4*)&sm->Bs[bk][bn] = (f32x4){bv.x, bv.y, bv.z, bv.w};
                __syncthreads();
#pragma unroll
                for (int k = 0; k < 16; ++k) { const f32x4 a = *(const LAS f32x4*)&sm->As[k][ty * 4]; const f32x4 b = *(const LAS f32x4*)&sm->Bs[k][tx * 4];
                    const float aa[4] = {a.x, a.y, a.z, a.w}, bb[4] = {b.x, b.y, b.z, b.w};
#pragma unroll
                    for (int i = 0; i < 4; ++i)
#pragma unroll
                        for (int j = 0; j < 4; ++j) acc[i][j] += aa[i] * bb[j]; }
            }
        }
        if (valid) {
#pragma unroll
            for (int i = 0; i < 4; ++i) { const int q = q0 + ty * 4 + i; const size_t row = (size_t)chunk * 128 + q; const int col = gg * 128 + c0 + tx * 4;
                const float bq = IN_(I_BSG)[l * 512 + gg * 128 + q];
                const v2u gu = *(const v2u*)(PROJ + row * INW + 512 + col);
                v2u w; w.x = pk2(bf2f((unsigned short)(gu.x & 0xffff)) * (acc[i][0] + bq), bf2f((unsigned short)(gu.x >> 16)) * (acc[i][1] + bq));
                w.y = pk2(bf2f((unsigned short)(gu.y & 0xffff)) * (acc[i][2] + bq), bf2f((unsigned short)(gu.y >> 16)) * (acc[i][3] + bq));
                *(v2u*)(YB + row * MIXW + col) = w; }
        }
    NTILE_END
}
__device__ __forceinline__ void ph3_conv(Frame& F, int l, int nrows) {
    const bf16* PROJ = (const bf16*)(F.ws + WS_PROJ); bf16* YC = (bf16*)(F.ws + WS_YS) + (size_t)2 * MT * MIXW; const float* wc = IN_(I_WCONV) + l * 3 * MIXW;
    const size_t gt = (size_t)F.bid * NT + F.tid, ngt = (size_t)F.G * NT;
#pragma unroll 2
    for (size_t i = gt; i < (size_t)nrows * (MIXW / 8); i += ngt) {
        const int row = (int)(i / (MIXW / 8)), c = (int)(i % (MIXW / 8)) * 8;
        int pos, rl; if (row < SEQ) { pos = row & 63; rl = 64; } else { pos = row - SEQ; rl = 256; }
        const bf16* r0 = PROJ + (size_t)row * INW + 1536 + c;
        const v4u zero = {0u, 0u, 0u, 0u};
        const v4u b0 = *(const v4u*)(r0), c0 = *(const v4u*)(r0 + 512), h0 = *(const v4u*)(r0 + 1024);
        const v4u cm = pos > 0 ? *(const v4u*)(r0 - INW + 512) : zero, hm = pos > 0 ? *(const v4u*)(r0 - INW + 1024) : zero;
        const v4u cp = pos < rl - 1 ? *(const v4u*)(r0 + INW + 512) : zero, hp = pos < rl - 1 ? *(const v4u*)(r0 + INW + 1024) : zero;
        const f32x4 w0a = *(const f32x4*)(wc + c), w0b = *(const f32x4*)(wc + c + 4), w1a = *(const f32x4*)(wc + 512 + c), w1b = *(const f32x4*)(wc + 512 + c + 4), w2a = *(const f32x4*)(wc + 1024 + c), w2b = *(const f32x4*)(wc + 1024 + c + 4);
        const float w0[8] = {w0a.x, w0a.y, w0a.z, w0a.w, w0b.x, w0b.y, w0b.z, w0b.w}, w1[8] = {w1a.x, w1a.y, w1a.z, w1a.w, w1b.x, w1b.y, w1b.z, w1b.w}, w2[8] = {w2a.x, w2a.y, w2a.z, w2a.w, w2b.x, w2b.y, w2b.z, w2b.w};
        const unsigned bb[4] = {b0.x, b0.y, b0.z, b0.w}, cc[4] = {c0.x, c0.y, c0.z, c0.w}, hh[4] = {h0.x, h0.y, h0.z, h0.w}, cmv[4] = {cm.x, cm.y, cm.z, cm.w}, hmv[4] = {hm.x, hm.y, hm.z, hm.w}, cpv[4] = {cp.x, cp.y, cp.z, cp.w}, hpv[4] = {hp.x, hp.y, hp.z, hp.w};
        unsigned o[4];
#pragma unroll
        for (int j = 0; j < 4; ++j) {
            const float ylo = bflo(bb[j]) * (w0[2 * j] * (bflo(cmv[j]) * bflo(hmv[j])) + w1[2 * j] * (bflo(cc[j]) * bflo(hh[j])) + w2[2 * j] * (bflo(cpv[j]) * bflo(hpv[j])));
            const float yhi = bfhi(bb[j]) * (w0[2 * j + 1] * (bfhi(cmv[j]) * bfhi(hmv[j])) + w1[2 * j + 1] * (bfhi(cc[j]) * bfhi(hh[j])) + w2[2 * j + 1] * (bfhi(cpv[j]) * bfhi(hpv[j])));
            o[j] = pk2(ylo, yhi); }
        v4u ov; ov.x = o[0]; ov.y = o[1]; ov.z = o[2]; ov.w = o[3]; *(v4u*)(YC + (size_t)row * MIXW + c) = ov;
    }
}
__device__ __forceinline__ void ph5_naive(Frame& F, int l) {
    const bf16* PROJ = (const bf16*)(F.ws + WS_PROJ); const float* YD = (const float*)(F.ws + WS_S5); bf16* YG = (bf16*)(F.ws + WS_YG); const float* ds = IN_(I_DSKIP) + l * MIXW;
    const size_t gt = (size_t)F.bid * NT + F.tid, ngt = (size_t)F.G * NT;
    for (size_t i = gt; i < (size_t)MT * (MIXW / 2); i += ngt) {
        const int row = (int)(i / (MIXW / 2)), c = (int)(i % (MIXW / 2)) * 2;
        const unsigned u = *(const unsigned*)(PROJ + (size_t)row * INW + c); const size_t o = (size_t)row * MIXW + c;
        const float y0 = YD[o] + YD[(size_t)MT * MIXW + o] + ds[c] * bf2f((unsigned short)(u & 0xffff)), y1 = YD[o + 1] + YD[(size_t)MT * MIXW + o + 1] + ds[c + 1] * bf2f((unsigned short)(u >> 16));
        *(unsigned*)(YG + o) = pk2(geluf_(y0), geluf_(y1));
    }
}
__device__ __forceinline__ void ph6_naive(Frame& F, int l) {
    const bf16* YG = (const bf16*)(F.ws + WS_YG); bf16* YA = (bf16*)(F.ws + WS_YS); const float* W = IN_(I_WGLU) + (size_t)l * MIXW * MIXW;
    NTILE_BEGIN((MT / 64) * (MIXW / 64))
        const int m0 = (T / (MIXW / 64)) * 64, n0 = (T % (MIXW / 64)) * 64;
        float acc[4][4] = {};
        ngemm_acc(acc, ABf{YG + (size_t)m0 * MIXW, MIXW}, W + n0, MIXW, MIXW, sm, t);
        if (valid) {
#pragma unroll
            for (int i = 0; i < 4; ++i) { const size_t o = (size_t)(m0 + ty * 4 + i) * MIXW + n0 + tx * 4; const v2u g = *(const v2u*)(YG + o);
                v2u w; w.x = pk2(bf2f((unsigned short)(g.x & 0xffff)) * sigmoidf_(acc[i][0]), bf2f((unsigned short)(g.x >> 16)) * sigmoidf_(acc[i][1]));
                w.y = pk2(bf2f((unsigned short)(g.y & 0xffff)) * sigmoidf_(acc[i][2]), bf2f((unsigned short)(g.y >> 16)) * sigmoidf_(acc[i][3])); *(v2u*)(YA + o) = w; }
        }
    NTILE_END
}
__device__ __forceinline__ void ph7_naive(Frame& F, int l) {
    const bf16* YS = (const bf16*)(F.ws + WS_YS); bf16* BR = (bf16*)(F.ws + WS_PROJ); const float* W = IN_(I_WBR) + (size_t)l * 3 * MIXW * D;
    NTILE_BEGIN((MT / 64) * (INW / 64))
        const int m0 = (T / (INW / 64)) * 64, n0 = (T % (INW / 64)) * 64, k = n0 / 1024, d0 = n0 % 1024;
        float acc[4][4] = {};
        ngemm_acc(acc, ABf{YS + (size_t)k * MT * MIXW + (size_t)m0 * MIXW, MIXW}, W + (size_t)k * MIXW * D + d0, D, MIXW, sm, t);
        if (valid) {
#pragma unroll
            for (int i = 0; i < 4; ++i) { v2u w; w.x = pk2(acc[i][0], acc[i][1]); w.y = pk2(acc[i][2], acc[i][3]); *(v2u*)(BR + (size_t)(m0 + ty * 4 + i) * INW + n0 + tx * 4) = w; }
        }
    NTILE_END
}
__device__ __forceinline__ void ph8_naive(Frame& F, int l) {
    const bf16* H = (const bf16*)(F.ws + WS_H); const bf16* BR = (const bf16*)(F.ws + WS_PROJ); bf16* PM = (bf16*)(F.ws + WS_PM);
    const float* W = IN_(I_WMG) + (size_t)l * D * INW; const float* bm = IN_(I_BMG) + l * INW;
    NTILE_BEGIN((MT / 64) * (D / 64))
        const int m0 = (T / (D / 64)) * 64, n0 = (T % (D / 64)) * 64;
        float out[4][4] = {};
        for (int k = 0; k < 3; ++k) {
            float acc[4][4] = {};
            ngemm_acc(acc, ABf{H + (size_t)m0 * D, D}, W + k * 1024 + n0, INW, D, sm, t);
#pragma unroll
            for (int i = 0; i < 4; ++i) { const v2u b = *(const v2u*)(BR + (size_t)(m0 + ty * 4 + i) * INW + k * 1024 + n0 + tx * 4);
                const float bb[4] = {bf2f((unsigned short)(b.x & 0xffff)), bf2f((unsigned short)(b.x >> 16)), bf2f((unsigned short)(b.y & 0xffff)), bf2f((unsigned short)(b.y >> 16))};
#pragma unroll
                for (int j = 0; j < 4; ++j) out[i][j] += sigmoidf_(acc[i][j] + bm[k * 1024 + n0 + tx * 4 + j]) * bb[j]; }
        }
        if (valid) {
#pragma unroll
            for (int i = 0; i < 4; ++i) { v2u w; w.x = pk2(out[i][0], out[i][1]); w.y = pk2(out[i][2], out[i][3]); *(v2u*)(PM + (size_t)(m0 + ty * 4 + i) * D + n0 + tx * 4) = w; }
        }
    NTILE_END
}
__device__ __forceinline__ void ph9_naive(Frame& F, int l) {
    const bf16* PM = (const bf16*)(F.ws + WS_PM); const float* W = IN_(I_WO) + (size_t)l * D * D;
    NTILE_BEGIN((MT / 64) * (D / 64))
        const int m0 = (T / (D / 64)) * 64, n0 = (T % (D / 64)) * 64;
        float acc[4][4] = {};
        ngemm_acc(acc, ABf{PM + (size_t)m0 * D, D}, W + n0, D, D, sm, t);
        if (valid) {
#pragma unroll
            for (int i = 0; i < 4; ++i) { const int row = m0 + ty * 4 + i, c = n0 + tx * 4; const float* m = mod_ptr(F, l, row) + 2048 + c;
                const f32x4 xs = *(const f32x4*)(xsrc_row(F, l, row) + c);
                f32x4 o; o.x = xs.x + m[0] * acc[i][0]; o.y = xs.y + m[1] * acc[i][1]; o.z = xs.z + m[2] * acc[i][2]; o.w = xs.w + m[3] * acc[i][3];
                *(f32x4*)(xrun_row(F, row) + c) = o; }
        }
    NTILE_END
}
template <int KS>
__device__ __forceinline__ void route_pass(Frame& F, int l, int u, bool valid, int kh, int sl, LAS float* GC, LAS float* SH, LAS float* SSQ, LAS float* LG, LAS int* HISTL) {
    bf16* H = (bf16*)(F.ws + WS_H); const bf16* WRh = (const bf16*)(F.ws + WS_WR); const bf16* WRl = WRh + 48 * 1024;
    const float* bg = IN_(I_BGRP) + l * 4; const float* be = IN_(I_BEXP) + l * 32;
    int* EID = (int*)(F.ws + WS_EID); float* EW = (float*)(F.ws + WS_EW);
    constexpr int NK = 32 / KS, KW = 1024 / KS;
    const int r = F.lane & 15, q = F.lane >> 4;
    const int uu = valid ? u : 0; const int row = uu * 16 + r; const float* xr = xrun_row(F, row) + kh * KW + 8 * q; const int pv = (row >= SEQ ? 1024 : 0) + kh * KW + 8 * q;
    float s = 0.f;
#pragma unroll
    for (int ks = 0; ks < NK; ++ks) { const f32x4 a = *(const f32x4*)(xr + 32 * ks), b = *(const f32x4*)(xr + 32 * ks + 4); s += a.x * a.x + a.y * a.y + a.z * a.z + a.w * a.w + b.x * b.x + b.y * b.y + b.z * b.z + b.w * b.w; }
    s += shflx(s, 16, F.lane); s += shflx(s, 32, F.lane);
    __syncthreads();
    if (q == 0) SSQ[(sl * KS + kh) * 16 + r] = s;
    __syncthreads();
    float tot = 0.f;
#pragma unroll
    for (int i = 0; i < KS; ++i) tot += SSQ[(sl * KS + i) * 16 + r];
    const float rstd = rsqrtf(tot * (1.f / D) + EPS);
    f32x4 acc[3] = {{0.f, 0.f, 0.f, 0.f}, {0.f, 0.f, 0.f, 0.f}, {0.f, 0.f, 0.f, 0.f}};
#pragma unroll 1
    for (int k0 = 0; k0 < NK; k0 += 4) {
        f32x4 xa[4][2]; bf16x8 Bh[4][3], Bl[4][3];
#pragma unroll
        for (int j = 0; j < 4; ++j) { const int c = 32 * (k0 + j); xa[j][0] = *(const f32x4*)(xr + c); xa[j][1] = *(const f32x4*)(xr + c + 4);
#pragma unroll
            for (int cb = 0; cb < 3; ++cb) { const size_t wo = (size_t)(cb * 16 + r) * 1024 + kh * KW + c + 8 * q; Bh[j][cb] = *(const bf16x8*)(WRh + wo); Bl[j][cb] = *(const bf16x8*)(WRl + wo); } }
#pragma unroll
        for (int j = 0; j < 4; ++j) { const int c = 32 * (k0 + j);
            const f32x4 g0 = *(const LAS f32x4*)(GC + pv + c), g1 = *(const LAS f32x4*)(GC + pv + c + 4), sh0 = *(const LAS f32x4*)(SH + pv + c), sh1 = *(const LAS f32x4*)(SH + pv + c + 4);
            const f32x4 h0 = xa[j][0] * rstd * g0 + sh0, h1 = xa[j][1] * rstd * g1 + sh1;
            v4u hi; hi.x = pk2(h0.x, h0.y); hi.y = pk2(h0.z, h0.w); hi.z = pk2(h1.x, h1.y); hi.w = pk2(h1.z, h1.w);
            if (valid) *(v4u*)(H + (size_t)row * D + kh * KW + 8 * q + c) = hi;
            v4u lo; lo.x = pk2(h0.x - bflo(hi.x), h0.y - bfhi(hi.x)); lo.y = pk2(h0.z - bflo(hi.y), h0.w - bfhi(hi.y)); lo.z = pk2(h1.x - bflo(hi.z), h1.y - bfhi(hi.z)); lo.w = pk2(h1.z - bflo(hi.w), h1.w - bfhi(hi.w));
            const bf16x8 Ah = __builtin_bit_cast(bf16x8, hi), Al = __builtin_bit_cast(bf16x8, lo);
#pragma unroll
            for (int cb = 0; cb < 3; ++cb) { acc[cb] = __builtin_amdgcn_mfma_f32_16x16x32_bf16(Ah, Bh[j][cb], acc[cb], 0, 0, 0); acc[cb] = __builtin_amdgcn_mfma_f32_16x16x32_bf16(Al, Bh[j][cb], acc[cb], 0, 0, 0); acc[cb] = __builtin_amdgcn_mfma_f32_16x16x32_bf16(Ah, Bl[j][cb], acc[cb], 0, 0, 0); } }
    }
    LAS float* LGw = LG + (sl * KS + kh) * (16 * 52);
#pragma unroll
    for (int cb = 0; cb < 3; ++cb)
#pragma unroll
        for (int i = 0; i < 4; ++i) LGw[(4 * q + i) * 52 + cb * 16 + r] = acc[cb][i];
    __syncthreads();
    if (kh == 0 && valid && F.lane < 16) { const LAS float* L0 = LG + (sl * KS) * (16 * 52) + F.lane * 52; const int rw = u * 16 + F.lane;
        float lg[36];
#pragma unroll
        for (int o = 0; o < 36; ++o) { float t = 0.f;
#pragma unroll
            for (int i = 0; i < KS; ++i) t += L0[i * (16 * 52) + o]; lg[o] = t + (o < 4 ? bg[o] : be[o - 4]); }
        LAS float* LW = LG + (sl * KS) * (16 * 52) + F.lane * 52;
#pragma unroll
        for (int o = 0; o < 36; ++o) LW[o] = lg[o];
        int gi = 0; float gm = lg[0];
#pragma unroll
        for (int o = 1; o < 4; ++o) if (lg[o] > gm) { gm = lg[o]; gi = o; }
        float den = 0.f;
#pragma unroll
        for (int o = 0; o < 4; ++o) den += expf(lg[o] - gm);
        const float gp = 1.f / den;
        const LAS float* el = LW + 4 + gi * 8;
        int i1 = 0; float m1 = el[0]; for (int o = 1; o < 8; ++o) { const float v = el[o]; if (v > m1) { m1 = v; i1 = o; } }
        int i2 = -1; float m2 = 0.f; for (int o = 0; o < 8; ++o) { const float v = el[o]; if (o != i1 && (i2 < 0 || v > m2)) { m2 = v; i2 = o; } }
        const float e2 = expf(m2 - m1); const float w1 = 1.f / (1.f + e2), w2 = e2 / (1.f + e2);
        const int e1i = gi * 8 + i1, e2i = gi * 8 + i2;
        EID[rw * 2] = e1i; EID[rw * 2 + 1] = e2i; EW[rw * 2] = gp * w1; EW[rw * 2 + 1] = gp * w2;
        __hip_atomic_fetch_add(&HISTL[e1i], 1, __ATOMIC_RELAXED, __HIP_MEMORY_SCOPE_WORKGROUP); __hip_atomic_fetch_add(&HISTL[e2i], 1, __ATOMIC_RELAXED, __HIP_MEMORY_SCOPE_WORKGROUP);
    }
}
__device__ __forceinline__ void ph10_route(Frame& F, int l) {
    const float* g = IN_(I_GFFN) + l * D;
    LAS float* GC = (LAS float*)F.lds;
    LAS float* SH = GC + 2048;
    LAS float* SSQ = SH + 2048;
    LAS float* LG = SSQ + 128;
    LAS int* HISTL = (LAS int*)(LG + 8 * 16 * 52);
    __syncthreads();
    if (F.tid < 32) HISTL[F.tid] = 0;
    for (int i = F.tid; i < 2048; i += NT) { const int w = i >> 10, c = i & 1023; const float* m = (const float*)(F.ws + WS_MOD) + (size_t)(l * 2 + w) * 6144; GC[i] = g[c] * (1.f + m[4096 + c]); SH[i] = m[3072 + c]; }
#pragma unroll 1
    for (int u0 = F.bid; u0 < SEQ / 16; u0 += 4 * F.G) { const int u = u0 + (F.wave >> 1) * F.G; route_pass<2>(F, l, u, u < SEQ / 16, F.wave & 1, F.wave >> 1, GC, SH, SSQ, LG, HISTL); }
    if (l == 0) {
#pragma unroll 1
        for (int u0 = SEQ / 16 + F.bid; u0 < MT / 16; u0 += F.G) route_pass<8>(F, l, u0, true, F.wave, 0, GC, SH, SSQ, LG, HISTL);
    }
    __syncthreads();
    if (F.tid < 32) ((int*)(F.ws + WS_HISTG))[F.bid * 32 + F.tid] = HISTL[F.tid];
}
__device__ __forceinline__ int expert_off(const unsigned* cnt, int e) { int o = 0; for (int i = 0; i < e; ++i) o += ((int)cnt[i] + 255) & ~255; return o; }
__device__ __forceinline__ void ph11_scatter(Frame& F, int l) {
    const bf16* H = (const bf16*)(F.ws + WS_H); bf16* HS = (bf16*)(F.ws + WS_HS);
    const int* EID = (const int*)(F.ws + WS_EID); const float* EW = (const float*)(F.ws + WS_EW); int* STOK = (int*)(F.ws + WS_STOK); float* SW = (float*)(F.ws + WS_SW); int* TSLOT = (int*)(F.ws + WS_TSLOT);
    unsigned* cnt = F.ctl + CW_CNT + l * 128; const int* HISTG = (const int*)(F.ws + WS_HISTG);
    LAS int* HIST = (LAS int*)F.lds; LAS int* BASE = HIST + 32; LAS int* ISLOT = BASE + 32; LAS int* IROW = ISLOT + 512; LAS int* PT = IROW + 512; LAS int* PB = PT + 512;
    const int nunits = (l == 0 ? MT : SEQ) / 16;
    __syncthreads();
    { const int e = F.tid & 31, ch = F.tid >> 5; int tot = 0, bas = 0;
      for (int b = ch; b < F.G; b += 16) { const int h = HISTG[b * 32 + e]; tot += h; if (b < F.bid) bas += h; }
      PT[F.tid] = tot; PB[F.tid] = bas; }
    __syncthreads();
    if (F.tid < 32) { int tot = 0, bas = 0; for (int ch = 0; ch < 16; ++ch) { tot += PT[ch * 32 + F.tid]; bas += PB[ch * 32 + F.tid]; } HIST[F.tid] = 0; PT[F.tid] = tot; PB[F.tid] = bas; if (F.bid == 0) cnt[F.tid] = (unsigned)tot; }
    __syncthreads();
    if (F.tid < 32) { int off = 0; for (int i = 0; i < F.tid; ++i) off += (PT[i] + 255) & ~255; BASE[F.tid] = off + PB[F.tid]; }
    __syncthreads();
    const int w = F.tid >> 5; int u = F.bid + w * F.G; bool valid = u < SEQ / 16;
    if (w == 15) { u = SEQ / 16 + F.bid; valid = u < nunits; }
    const int row = u * 16 + ((F.tid >> 1) & 15), kk = F.tid & 1;
    int e = 0, rank = 0; if (valid) { e = EID[row * 2 + kk]; rank = __hip_atomic_fetch_add(&HIST[e], 1, __ATOMIC_RELAXED, __HIP_MEMORY_SCOPE_WORKGROUP); }
    __syncthreads();
    int slot = -1; if (valid) { slot = BASE[e] + rank; STOK[slot] = row; SW[slot] = EW[row * 2 + kk]; TSLOT[row * 2 + kk] = slot; }
    ISLOT[F.tid] = slot; IROW[F.tid] = row;
    __syncthreads();
#pragma unroll 1
    for (int it0 = F.wave; it0 < NT; it0 += 4 * (NT / 64)) {
        v4u va[4], vb[4]; int sl[4];
#pragma unroll
        for (int j = 0; j < 4; ++j) { const int it = it0 + j * (NT / 64); sl[j] = it < NT ? ISLOT[it] : -1; const int rw = sl[j] >= 0 ? IROW[it] : 0; const v4u* src = (const v4u*)(H + (size_t)rw * D); va[j] = src[F.lane]; vb[j] = src[F.lane + 64]; }
#pragma unroll
        for (int j = 0; j < 4; ++j) if (sl[j] >= 0) { v4u* dst = (v4u*)(HS + (size_t)sl[j] * D); dst[F.lane] = va[j]; dst[F.lane + 64] = vb[j]; }
    }
}
__device__ __forceinline__ int slot_expert(const unsigned* cnt, int slot0, int& seg_off, int& n_e) { int o = 0; for (int e = 0; e < NE; ++e) { const int n = (int)cnt[e], pn = (n + 255) & ~255; if (slot0 < o + pn) { seg_off = o; n_e = n; return e; } o += pn; } seg_off = o; n_e = 0; return 0; }
__device__ __forceinline__ void ph12_naive(Frame& F, int l) {
    const bf16* HS = (const bf16*)(F.ws + WS_HS); bf16* ACT = (bf16*)(F.ws + WS_ACT); const float* SW = (const float*)(F.ws + WS_SW);
    const unsigned* cnt = F.ctl + CW_CNT + l * 128; const int total = expert_off(cnt, NE);
    NTILE_BEGIN((total / 64) * (DFF / 64))
        const int s0 = (T / (DFF / 64)) * 64, n0 = (T % (DFF / 64)) * 64; int seg, n_e; const int e = slot_expert(cnt, s0, seg, n_e);
        float aa[4][4] = {}, ab[4][4] = {};
        ngemm_acc(aa, ABf{HS + (size_t)s0 * D, D}, IN_(I_W1) + ((size_t)l * NE + e) * D * DFF + n0, DFF, D, sm, t);
        ngemm_acc(ab, ABf{HS + (size_t)s0 * D, D}, IN_(I_W3) + ((size_t)l * NE + e) * D * DFF + n0, DFF, D, sm, t);
        if (valid) {
#pragma unroll
            for (int i = 0; i < 4; ++i) { const int slot = s0 + ty * 4 + i; if (slot - seg < n_e) { const float w = SW[slot];
                v2u o; o.x = pk2(siluf_(aa[i][0]) * ab[i][0] * w, siluf_(aa[i][1]) * ab[i][1] * w); o.y = pk2(siluf_(aa[i][2]) * ab[i][2] * w, siluf_(aa[i][3]) * ab[i][3] * w);
                *(v2u*)(ACT + (size_t)slot * DFF + n0 + tx * 4) = o; } }
        }
    NTILE_END
}
__device__ __forceinline__ void ph13_naive(Frame& F, int l) {
    const bf16* ACT = (const bf16*)(F.ws + WS_ACT); bf16* YS2 = (bf16*)(F.ws + WS_YS2);
    const unsigned* cnt = F.ctl + CW_CNT + l * 128; const int total = expert_off(cnt, NE);
    NTILE_BEGIN((total / 64) * (D / 64))
        const int s0 = (T / (D / 64)) * 64, n0 = (T % (D / 64)) * 64; int seg, n_e; const int e = slot_expert(cnt, s0, seg, n_e);
        float acc[4][4] = {};
        ngemm_acc(acc, ABf{ACT + (size_t)s0 * DFF, DFF}, IN_(I_W2) + ((size_t)l * NE + e) * DFF * D + n0, D, DFF, sm, t);
        if (valid) {
#pragma unroll
            for (int i = 0; i < 4; ++i) { const int slot = s0 + ty * 4 + i; if (slot - seg < n_e) { v2u o; o.x = pk2(acc[i][0], acc[i][1]); o.y = pk2(acc[i][2], acc[i][3]); *(v2u*)(YS2 + (size_t)slot * D + n0 + tx * 4) = o; } }
        }
    NTILE_END
}
__device__ __forceinline__ void ph14_combine(Frame& F, int l) {
    const bf16* YS2 = (const bf16*)(F.ws + WS_YS2); const int* TSLOT = (const int*)(F.ws + WS_TSLOT); bf16* H = (bf16*)(F.ws + WS_H);
    LAS float* GC = (LAS float*)F.lds; LAS float* SH = GC + 2048; LAS float* GA = SH + 2048;
    if (l == 0) stage_mod(F, IN_(I_GMIX) + D, 1, 0, 1024, GC, SH); else { __syncthreads(); for (int i = F.tid; i < 1024; i += NT) GC[i] = IN_(I_GF)[i]; }
    for (int i = F.tid; i < 2048; i += NT) GA[i] = ((const float*)(F.ws + WS_MOD))[(size_t)(l * 2 + (i >> 10)) * 6144 + 5120 + (i & 1023)];
    __syncthreads();
    const int gw = F.bid * (NT / 64) + F.wave, ngw = F.G * (NT / 64);
    const int nrows = l == 0 ? MT : SEQ;
    for (int row0 = gw; row0 < nrows; row0 += 2 * ngw) {
        f32x4 v[2][4]; float s[2] = {0.f, 0.f}; int rows[2]; bool ok[2];
#pragma unroll
        for (int t = 0; t < 2; ++t) { rows[t] = row0 + t * ngw; ok[t] = rows[t] < nrows; if (!ok[t]) rows[t] = row0; }
        int sl[2][2];
#pragma unroll
        for (int t = 0; t < 2; ++t) { sl[t][0] = TSLOT[rows[t] * 2]; sl[t][1] = TSLOT[rows[t] * 2 + 1]; }
#pragma unroll
        for (int t = 0; t < 2; ++t) { const float* xr = xrun_row(F, rows[t]); const int pv = rows[t] >= SEQ ? 1024 : 0;
#pragma unroll
            for (int j = 0; j < 4; ++j) { const int c = 4 * F.lane + 256 * j; const f32x4 x = *(const f32x4*)(xr + c); const f32x4 ga = *(const LAS f32x4*)(GA + pv + c);
                const v2u a = *(const v2u*)(YS2 + (size_t)sl[t][0] * D + c), b = *(const v2u*)(YS2 + (size_t)sl[t][1] * D + c);
                f32x4 y; y.x = bflo(a.x) + bflo(b.x); y.y = bfhi(a.x) + bfhi(b.x); y.z = bflo(a.y) + bflo(b.y); y.w = bfhi(a.y) + bfhi(b.y);
                v[t][j] = x + ga * y; s[t] += v[t][j].x * v[t][j].x + v[t][j].y * v[t][j].y + v[t][j].z * v[t][j].z + v[t][j].w * v[t][j].w; } }
#pragma unroll
        for (int t = 0; t < 2; ++t) { if (!ok[t]) continue;
            const float rstd = rsqrtf(wave_sum(s[t], F.lane) * (1.f / D) + EPS); float* xr = xrun_row(F, rows[t]); const int pv = rows[t] >= SEQ ? 1024 : 0;
            if (l == 0) {
#pragma unroll
                for (int j = 0; j < 4; ++j) { const int c = 4 * F.lane + 256 * j; *(f32x4*)(xr + c) = v[t][j];
                    const f32x4 gc = *(const LAS f32x4*)(GC + pv + c), sh = *(const LAS f32x4*)(SH + pv + c);
                    const f32x4 o = v[t][j] * rstd * gc + sh; v2u w; w.x = pk2(o.x, o.y); w.y = pk2(o.z, o.w); *(v2u*)(H + (size_t)rows[t] * D + c) = w; }
            } else {
#pragma unroll
                for (int j = 0; j < 4; ++j) { const int c = 4 * F.lane + 256 * j; const f32x4 gg = *(const LAS f32x4*)(GC + c); f32x4 o = v[t][j] * rstd * gg;
                    if (PROBE_B >= 0 && rows[t] < 3906) { volatile LAS unsigned long long* TS = (volatile LAS unsigned long long*)(F.lds + TS_OFF); o = o + (0.1f + 0.00001f * (float)(TS[1 + PROBE_B] - TS[PROBE_B])); }
                    if (PROBE_A >= 0 && rows[t] == 0 && j == 0 && F.lane == 0) { volatile LAS unsigned long long* TS = (volatile LAS unsigned long long*)(F.lds + TS_OFF); o.x += 1.f + 0.001f * (float)(TS[1 + PROBE_A] - TS[PROBE_A]); }
                    *(f32x4*)(xr + c) = o; }
            }
        }
    }
}

#ifndef FASTMASK
#define FASTMASK 0xffff
#endif
constexpr unsigned FM = FASTMASK;
constexpr int NPH = 2 + 13 * 2;
__device__ __forceinline__ Frame make_frame(LAS unsigned char* lds, int wave0) {
    Frame F; F.lds = lds; F.wave = wave0; F.lane = (int)__builtin_amdgcn_mbcnt_hi(~0u, __builtin_amdgcn_mbcnt_lo(~0u, 0u)); asm volatile("" : "+v"(F.lane)); F.tid = F.wave * 64 + F.lane; F.bid = blockIdx.x; F.G = gridDim.x; asm volatile("" : "+s"(F.G), "+s"(F.bid));
    F.tab = (const unsigned long long LAS*)(lds + TAB_OFF);
    volatile LAS unsigned long long* t = (volatile LAS unsigned long long*)(lds + TAB_OFF);
    F.ws = (unsigned char*)(GAS unsigned char*)uni64(t[35]); F.out = (float*)(GAS float*)uni64(t[36]); F.ctl = (unsigned*)(F.ws + WS_CTL);
    return F;
}
__global__ void __launch_bounds__(NT, 2) mega_fwd(Args args) {
    extern __shared__ __attribute__((aligned(16))) unsigned char lds_raw[];
    LAS unsigned char* const lds = (LAS unsigned char*)lds_raw;
    const int wave0 = __builtin_amdgcn_readfirstlane((int)threadIdx.x >> 6);
    for (int u = threadIdx.x; u < 1024 / 4; u += NT) ((LAS unsigned*)(lds + 131072))[u] = 0u;
    if (threadIdx.x == 0) { LAS unsigned long long* t = (LAS unsigned long long*)(lds + TAB_OFF);
#pragma unroll
        for (int i = 0; i < 35; ++i) t[i] = (unsigned long long)args.in[i];
        t[35] = (unsigned long long)args.ws; t[36] = (unsigned long long)args.out; }
    __syncthreads();
    { Frame F = make_frame(lds, wave0); (void)xcd_barrier_post(F.ctl + CW_BAR, (volatile LAS unsigned*)(lds + MISC_OFF) + 8); }
    if ((PROBE_A >= 0 || PROBE_B >= 0) && threadIdx.x == 0) ((volatile LAS unsigned long long*)(lds + TS_OFF))[0] = __builtin_amdgcn_s_memrealtime();
    const int lo = args.ph_lo, hi = args.ph_hi; int ph = 0;
#define GRIDBAR() do { Frame Fb = make_frame(lds, wave0); XcdBarrier bar; bar.bar = Fb.ctl + CW_BAR; bar.x = xb_xcc_id(); bar.st = (volatile LAS unsigned*)(lds + MISC_OFF) + 8; xcd_barrier(bar, Fb.tid == 0); } while (0)
#ifndef REPBAR
#define REPBAR 0
#endif
#ifndef REPMASK
#define REPMASK 0
#endif
#define PHASE(...) do { if (lo <= ph && ph < hi) { const int _pl = ph < 2 ? ph : 2 + (ph - 2) % 13; for (int _rep = 0; _rep <= ((REPMASK >> _pl) & 1); ++_rep) { Frame F = make_frame(lds, wave0); __VA_ARGS__; } if (ph + 1 < hi) { GRIDBAR(); if (REPBAR) GRIDBAR(); } if ((PROBE_A >= 0 || PROBE_B >= 0) && threadIdx.x == 0) ((volatile LAS unsigned long long*)(lds + TS_OFF))[1 + ph] = __builtin_amdgcn_s_memrealtime(); } ++ph; } while (0)
    PHASE({ ph0_prologue(F); if (FM >> 3 & 1) s5_precompute(F); __syncthreads(); convert_weights(F, 0, (FM >> 3 & 1) && F.G > 128 ? F.G - 64 : F.G); { const f32x4* s = (const f32x4*)IN_(I_CTX); f32x4* d = (f32x4*)(F.ws + WS_XC); for (int i = F.bid * NT + F.tid; i < CTX * D / 4; i += F.G * NT) d[i] = s[i]; } });
    PHASE(hprep_rows(F, 0));
#pragma unroll 1
    for (int l = 0; l < 2; ++l) {
        PHASE({ if (FM >> 2 & 1) { ph2_fast(F, l); ph2_ctx(F, l == 0 ? INW : MIXW); } else ph2_naive(F, l); });
        PHASE({ if (FM >> 3 & 1) { s5_z_phase(F, l); const int nch = (l == 0 ? MT : SEQ) / 128; if (F.G > nch) { if (F.bid < nch) sg_fast_chunk(F, l, F.bid); else { Frame F2 = F; F2.bid -= nch; F2.G -= nch; ph3_conv(F2, l, l == 0 ? MT : SEQ); } } else { for (int c = F.bid; c < nch; c += F.G) sg_fast_chunk(F, l, c); ph3_conv(F, l, l == 0 ? MT : SEQ); } } else { ph3_s5_naive(F, l); if (F.bid >= 64) { Frame F2 = F; F2.bid -= 64; F2.G -= 64; ph3_sg_naive(F2, l); ph3_conv(F2, l, MT); } } });
        PHASE({ if (FM >> 3 & 1) s5_scan_phase(F, l); });
        PHASE({ if (FM >> 3 & 1) s5_y_phase(F, l); else ph5_naive(F, l); });
        PHASE({ if (FM >> 6 & 1) { ph6_fast(F, l); if (l == 0) ph6_ctx(F); } else ph6_naive(F, l); });
        PHASE({ if (FM >> 7 & 1) { ph7_fast(F, l); if (l == 0) ph7_ctx(F); } else ph7_naive(F, l); });
        PHASE({ if (FM >> 8 & 1) { ph8_fast(F, l); if (l == 0) ph8_ctx(F, l); } else ph8_naive(F, l); });
        PHASE({ if (FM >> 9 & 1) { ph9_fast(F, l); if (l == 0) ph9_ctx(F, l); } else ph9_naive(F, l); });
        PHASE(ph10_route(F, l));
        PHASE(ph11_scatter(F, l));
        PHASE({ if (FM >> 12 & 1) ph12_fast(F, l); else ph12_naive(F, l); });
        PHASE({ if (FM >> 13 & 1) ph13_fast(F, l); else ph13_naive(F, l); });
        PHASE({ ph14_combine(F, l); if (l == 0) { __syncthreads(); convert_weights(F, 1, F.G); } });
    }
#undef PHASE
}

extern "C" void kernel_launch(void* const* d_in, const int* in_sizes, int n_in, void* d_out, int out_size, void* d_ws, size_t ws_size, hipStream_t stream) {
    static int grid = 0;
    if (grid == 0) {
        int dev = 0, cus = 0, per_cu = 0;
        if (n_in != 35 || out_size != SEQ * D || ws_size < WS_END) { fprintf(stderr, "kernel_launch: unexpected shapes (n_in %d out %d ws %zu)\n", n_in, out_size, ws_size); grid = -1; return; }
        if (hipGetDevice(&dev) != hipSuccess || hipDeviceGetAttribute(&cus, hipDeviceAttributeMultiprocessorCount, dev) != hipSuccess) { grid = -1; return; }
        if (hipFuncSetAttribute((const void*)mega_fwd, hipFuncAttributeMaxDynamicSharedMemorySize, LDS_BYTES) != hipSuccess) { fprintf(stderr, "kernel_launch: hipFuncSetAttribute failed\n"); grid = -1; return; }
        if (hipOccupancyMaxActiveBlocksPerMultiprocessor(&per_cu, (const void*)mega_fwd, NT, LDS_BYTES) != hipSuccess || per_cu < 1) { fprintf(stderr, "kernel_launch: occupancy query says %d blocks per CU\n", per_cu); grid = -1; return; }
        grid = cus;
    }
    if (grid < 0) return;
    (void)hipMemsetAsync((char*)d_ws + WS_CTL, 0, CTL_ZERO_BYTES, stream);
    Args a{};
    for (int i = 0; i < 35; ++i) a.in[i] = (const float*)d_in[i];
    a.out = (float*)d_out; a.ws = (unsigned char*)d_ws; a.ph_lo = 0; a.ph_hi = NPH;
    void* kargs[] = {&a};
    hipError_t e = hipLaunchCooperativeKernel((const void*)mega_fwd, dim3(grid), dim3(NT), kargs, LDS_BYTES, stream);
    if (e != hipSuccess) fprintf(stderr, "kernel_launch: cooperative launch failed: %s (grid %d)\n", hipGetErrorString(e), grid);
}
```

```cpp
#include <hip/hip_runtime.h>
#include <stdint.h>
#include <cstdio>

#define GAS __attribute__((address_space(1)))
#define LAS __attribute__((address_space(3)))
typedef unsigned short bf16;
typedef unsigned v4u __attribute__((ext_vector_type(4)));
typedef unsigned v2u __attribute__((ext_vector_type(2)));
typedef float f32x4 __attribute__((ext_vector_type(4)));
typedef short bf16x8 __attribute__((ext_vector_type(8)));

constexpr int D = 1024, SEQ = 16384, CTX = 256, MT = SEQ + CTX;
constexpr int MIXW = 512, INW = 3072, G5 = 32, P5 = 64, H5 = 16;
constexpr int NE = 32, DFF = 256;
constexpr int MAXSLOT = 2 * MT + NE * 256;
constexpr float EPS = 1e-6f;
constexpr int NT = 512;

constexpr size_t MiB = 1u << 20;
constexpr size_t WS_CTL = 0, CTL_ZERO_BYTES = 1 * MiB;
constexpr size_t WS_MOD = 1 * MiB;
constexpr size_t WS_XC = 2 * MiB;
constexpr size_t WS_EID = 3 * MiB;
constexpr size_t WS_EW = WS_EID + (size_t)MT * 8;
constexpr size_t WS_STOK = WS_EW + (size_t)MT * 8;
constexpr size_t WS_SW = WS_STOK + (size_t)MAXSLOT * 4;
constexpr size_t WS_TSLOT = WS_SW + (size_t)MAXSLOT * 4;
constexpr size_t WS_HISTG = WS_TSLOT + (size_t)MT * 8;
constexpr size_t WS_H = 4 * MiB;
constexpr size_t WS_PROJ = WS_H + (size_t)MT * 2048;
constexpr size_t WS_YS = WS_PROJ + (size_t)MT * 6144;
constexpr size_t WS_YG = WS_YS + (size_t)3 * MT * 1024;
constexpr size_t WS_PM = WS_YG + (size_t)MT * 1024;
constexpr size_t WS_S5 = WS_PM + (size_t)MT * 2048;
constexpr size_t WS_Z = WS_S5;
constexpr size_t WS_RSS = WS_Z + (size_t)8 * MiB;
constexpr size_t WS_SS = WS_Z + (size_t)1040 * 32 * 256 * 4;
constexpr size_t WS_S5M = WS_SS + (size_t)1040 * 32 * 256 * 2;
constexpr size_t WS_A16 = WS_S5M + (size_t)2 * 32 * 3 * 65536 * 2;
constexpr size_t WS_W = WS_A16 + (size_t)2 * 32 * 2 * 64 * 2 * 4 > WS_S5 + (size_t)2 * MT * 512 * 4 ? WS_A16 + (size_t)2 * 32 * 2 * 64 * 2 * 4 : WS_S5 + (size_t)2 * MT * 512 * 4;
constexpr size_t WS_WIN = WS_W;
constexpr size_t WS_WMG = WS_WIN + (size_t)3072 * 1024 * 2;
constexpr size_t WS_WGLU = WS_WMG + (size_t)3072 * 1024 * 2;
constexpr size_t WS_WBR = WS_WGLU + (size_t)512 * 512 * 2;
constexpr size_t WS_WO = WS_WBR + (size_t)3 * 1024 * 512 * 2;
constexpr size_t WS_W13 = WS_WO + (size_t)1024 * 1024 * 2;
constexpr size_t WS_W2 = WS_W13 + (size_t)32 * 512 * 1024 * 2;
constexpr size_t WS_WSG = WS_W2 + (size_t)32 * 1024 * 256 * 2;
constexpr size_t WS_WR = WS_WSG + (size_t)4 * 128 * 128 * 2;
constexpr size_t WS_END = WS_WR + (size_t)2 * 48 * 1024 * 2;
static_assert(WS_END <= (size_t)377 * MiB, "workspace budget");
constexpr size_t WS_HS = WS_PROJ;
constexpr size_t WS_ACT = WS_YS;
constexpr size_t WS_YS2 = WS_YG;
static_assert(WS_HS + (size_t)MAXSLOT * 2048 <= WS_YS && WS_ACT + (size_t)MAXSLOT * 512 <= WS_YG && WS_YS2 + (size_t)MAXSLOT * 2048 <= WS_W, "moe overlays");
static_assert(WS_HISTG + (size_t)1024 * 32 * 4 <= WS_H, "ws map");
constexpr int CW_CNT = 64;
constexpr int CW_BAR = 4096;

#ifndef PROBE_A
#define PROBE_A -1
#endif
#ifndef PROBE_B
#define PROBE_B -1
#endif
constexpr int TS_OFF = 131072 + 512;
constexpr int LDS_BYTES = 147456;
constexpr int MISC_OFF = 131072 + 320;
constexpr int TAB_OFF = 131072 + 1024;

__device__ __forceinline__ float bf2f(unsigned short b) { return __builtin_bit_cast(float, ((unsigned)b) << 16); }
__device__ __forceinline__ unsigned f2bf(float f) { unsigned u = __builtin_bit_cast(unsigned, f); return (u + 0x7fffu + ((u >> 16) & 1u)) >> 16; }
__device__ __forceinline__ unsigned pk2(float lo, float hi) { return f2bf(lo) | (f2bf(hi) << 16); }
__device__ __forceinline__ float sigmoidf_(float x) { return __builtin_amdgcn_rcpf(1.f + __expf(-x)); }
__device__ __forceinline__ float siluf_(float x) { return x * __builtin_amdgcn_rcpf(1.f + __expf(-x)); }
__device__ __forceinline__ float geluf_(float x) { const float u = 0.7978845608028654f * (x + 0.044715f * x * x * x); return x * __builtin_amdgcn_rcpf(1.f + __expf(-2.f * u)); }
__device__ __forceinline__ float shflx(float v, int mask, int lane) { return __builtin_bit_cast(float, __builtin_amdgcn_ds_bpermute((lane ^ mask) << 2, __builtin_bit_cast(int, v))); }
__device__ __forceinline__ float wave_sum(float v, int lane) {
#pragma unroll
    for (int o = 1; o < 64; o <<= 1) v += shflx(v, o, lane);
    return v;
}

#define XB_TMO      128
#define XB_XCNT(j)  (256  + 64 * (j))
#define XB_XSUB(j)  (1280 + 64 * (j))
#define XB_XGEN(j)  (2304 + 64 * (j))
#define XB_TOP      3328
#define XB_TOPGEN   3392
#define XCD_BAR_WORDS 3456
#define XB_SPIN_CAP (1u << 24)
__device__ __forceinline__ unsigned xb_ld(unsigned* p)              { return __hip_atomic_load(p, __ATOMIC_RELAXED, __HIP_MEMORY_SCOPE_AGENT); }
__device__ __forceinline__ unsigned xb_add(unsigned* p, unsigned v) { return __hip_atomic_fetch_add(p, v, __ATOMIC_RELAXED, __HIP_MEMORY_SCOPE_AGENT); }
__device__ __forceinline__ unsigned xb_xcc_id() { return (unsigned)__builtin_amdgcn_s_getreg((3 << 11) | 20) & 0xFu; }
#define XB_SPIN(cond, bar) do { unsigned _sp = 0; while (cond) { __builtin_amdgcn_s_sleep(1); \
    if ((++_sp & 255u) == 0u) { if (xb_ld(&(bar)[XB_TMO])) break; if (_sp > XB_SPIN_CAP) { atomicAdd(&(bar)[XB_TMO], 1u); break; } } } } while (0)
struct XcdBarrier { unsigned* bar; unsigned x; volatile LAS unsigned* st; };
__device__ __forceinline__ XcdBarrier xcd_barrier_post(unsigned* bar, volatile LAS unsigned* st) {
    XcdBarrier b; b.bar = bar; b.x = xb_xcc_id(); b.st = st;
    if (threadIdx.x == 0) (void)xb_add(&bar[XB_XCNT(b.x)], 1u);
    return b;
}
__device__ __forceinline__ void xcd_barrier_complete(unsigned* bar, unsigned x, unsigned& nloc, unsigned& nx) {
    const unsigned G = gridDim.x * gridDim.y * gridDim.z;
    unsigned sum, cnt, mine, sp = 0u;
    for (;;) {
        sum = 0u; cnt = 0u; mine = 0u;
#pragma unroll
        for (unsigned j = 0; j < 16; ++j) { const unsigned c = xb_ld(&bar[XB_XCNT(j)]); sum += c; cnt += (c > 0u) ? 1u : 0u; mine = (j == x) ? c : mine; }
        if (sum == G) break;
        __builtin_amdgcn_s_sleep(1);
        if ((++sp & 255u) == 0u) { if (xb_ld(&bar[XB_TMO])) break; if (sp > XB_SPIN_CAP) { atomicAdd(&bar[XB_TMO], 1u); break; } }
    }
    nloc = mine > 0u ? mine : 1u; nx = cnt > 0u ? cnt : 1u;
}
__device__ __forceinline__ void xcd_barrier(const XcdBarrier& b, bool leader) {
    asm volatile("s_waitcnt vmcnt(0)" ::: "memory");
    __syncthreads();
    if (leader) {
        unsigned* bar = b.bar;
        __builtin_amdgcn_s_waitcnt(0);
        unsigned nloc = b.st[0], nx = b.st[1];
        if (nloc == 0u) { xcd_barrier_complete(bar, b.x, nloc, nx); b.st[0] = nloc; b.st[1] = nx; }
        const unsigned old = xb_add(&bar[XB_XSUB(b.x)], 1u);
        const unsigned gen = old / nloc;
        if (old + 1u == (gen + 1u) * nloc) {
            __builtin_amdgcn_fence(__ATOMIC_RELEASE, "agent");
            asm volatile("s_waitcnt vmcnt(0)" ::: "memory");
            const unsigned og = xb_add(&bar[XB_TOP], 1u);
            const unsigned tg = og / nx;
            if (og + 1u == (tg + 1u) * nx) xb_add(&bar[XB_TOPGEN], 1u);
            else XB_SPIN(xb_ld(&bar[XB_TOPGEN]) == tg, bar);
            __builtin_amdgcn_fence(__ATOMIC_ACQUIRE, "agent");
            xb_add(&bar[XB_XGEN(b.x)], 1u);
            asm volatile("s_waitcnt vmcnt(0)" ::: "memory");
        } else {
            XB_SPIN(xb_ld(&bar[XB_XGEN(b.x)]) == gen, bar);
            __builtin_amdgcn_fence(__ATOMIC_ACQUIRE, "agent");
            asm volatile("s_waitcnt vmcnt(0)" ::: "memory");
        }
    }
    __syncthreads();
}

struct Args { const float* in[35]; float* out; unsigned char* ws; int ph_lo, ph_hi; };
struct Frame {
    LAS unsigned char* lds; unsigned char* ws; unsigned* ctl;
    int tid, lane, wave, bid, G;
    const unsigned long long LAS* tab; float* out;
};
__device__ __forceinline__ unsigned long long uni64(unsigned long long v) { const unsigned lo = __builtin_amdgcn_readfirstlane((unsigned)v), hi = __builtin_amdgcn_readfirstlane((unsigned)(v >> 32)); return ((unsigned long long)hi << 32) | lo; }
#define IN_(k) ((const float*)(const GAS float*)uni64(F.tab[k]))
enum { I_X = 0, I_C, I_CTX, I_CCTX, I_WADA, I_BADA, I_GMIX, I_GFFN, I_WIN, I_LRE, I_LIM, I_LDT, I_BRE, I_BIM, I_CRE, I_CIM, I_DSKIP, I_WGLU, I_SGG, I_SGB, I_WSG, I_BSG,
       I_WCONV, I_WBR, I_WMG, I_BMG, I_WO, I_WGRP, I_BGRP, I_WEXP, I_BEXP, I_W1, I_W3, I_W2, I_GF };

__device__ __forceinline__ const float* mod_ptr(const Frame& F, int l, int row) { return (const float*)(F.ws + WS_MOD) + (size_t)(l * 2 + (row >= SEQ ? 1 : 0)) * 6144; }
__device__ __forceinline__ const float* xsrc_row(const Frame& F, int l, int row) {
    if (l == 0) return row < SEQ ? IN_(I_X) + (size_t)row * D : IN_(I_CTX) + (size_t)(row - SEQ) * D;
    return row < SEQ ? F.out + (size_t)row * D : (const float*)(F.ws + WS_XC) + (size_t)(row - SEQ) * D;
}
__device__ __forceinline__ float* xrun_row(const Frame& F, int row) { return row < SEQ ? F.out + (size_t)row * D : (float*)(F.ws + WS_XC) + (size_t)(row - SEQ) * D; }


namespace pg8 {
#define PG8_LAS __attribute__((address_space(3)))
typedef unsigned short bf16_t;
typedef short bf16x8 __attribute__((ext_vector_type(8)));
typedef float f32x4 __attribute__((ext_vector_type(4)));
typedef unsigned u32x4 __attribute__((ext_vector_type(4)));
constexpr int BM = 256, BK = 64, HALF = 128, HTB = HALF * BK * 2  , STAGE_BYTES = 8 * HTB, NXCD = 8, WGM = 8;

__host__ __device__ __forceinline__ int lds_byte(int r, int c) { const int st = (r >> 4) * 2 + (c >> 5), rr = r & 15, cc = c & 31, ob = rr * 64 + cc * 2; return st * 1024 + (ob ^ (((ob >> 9) & 1) << 5)); }
__host__ __device__ __forceinline__ void stage_rc(int b, int& R, int& C) { const int st = b / 1024, sb = b % 1024, swz = sb ^ (((sb >> 9) & 1) << 5); R = (st >> 1) * 16 + swz / 64; C = (st & 1) * 32 + (swz % 64) / 2; }
__host__ __device__ __forceinline__ int perm32(int rho) { const int n = rho >> 4, i = rho & 15; return 8 * (i >> 2) + 4 * n + (i & 3); }

struct Unit { int pm, pn; };
struct Gemm { const bf16_t* A; const bf16_t* Bt; int M, N, K; };

struct StaticOrder {
    int nM, nN, nwg, G, c;
    __host__ __device__ void init(int M, int N, int G_, int c_) { nM = M / BM; nN = N / BM; nwg = nM * nN; G = G_; c = c_; }
    __host__ __device__ bool next(int i, Unit& u) const {
        const long L = (long)i * G + c; if (L >= nwg) return false;
        int wgid = (int)L; { const int q = nwg / NXCD, r = nwg % NXCD, xcd = wgid % NXCD, off = wgid / NXCD; wgid = (xcd < r ? xcd * (q + 1) : r * (q + 1) + (xcd - r) * q) + off; }
        const int nig = WGM * nN, gid = wgid / nig, fm = gid * WGM, gsz = (nM - fm) < WGM ? (nM - fm) : WGM;
        u.pm = fm + ((wgid % nig) % gsz); u.pn = (wgid % nig) / gsz; return true;
    }
    __device__ __forceinline__ void a_ready(const Unit&) const {}
    __device__ __forceinline__ void done(const Unit&) const {}
};
__device__ __forceinline__ unsigned cvt_pk_bf16(float lo, float hi) { unsigned r; asm volatile("v_cvt_pk_bf16_f32 %0, %1, %2" : "=v"(r) : "v"(lo), "v"(hi)); return r; }
template <class Epi, class Sched, bool ALIGN_EPI = false, bool SP2 = false>
__device__ __forceinline__ void gemm_phase(PG8_LAS unsigned char* lds, const Gemm g, const Sched& S, const Epi& E, int tid_in) {
    int tid_ = tid_in; asm volatile("" : "+v"(tid_));
    const int tid = tid_, wid = __builtin_amdgcn_readfirstlane(tid >> 6), lane = tid & 63, wr = wid >> 2, wc = wid & 3, fr = lane & 15, fq = lane >> 4;
    const int K = g.K, nt = K / BK;
    unsigned voffA[2], voffB[2];
#pragma unroll
    for (int i = 0; i < 2; ++i) { int R, C; stage_rc(tid * 16 + i * 8192, R, C); const int Rb = Epi::PERM ? ((R & ~31) + perm32(R & 31)) : R;
        voffA[i] = (unsigned)(R * K + C) * 2u; voffB[i] = (unsigned)(Rb * K + C) * 2u; }
    const size_t kstep = (size_t)(BK * 2);
    const size_t hstep = (size_t)HALF * K * 2;
    const size_t tstep = 2 * hstep;
    const unsigned ldsw = (unsigned)wid * 1024u;
    const int aoff = lds_byte(wr * 64 + fr, fq * 8), boff = lds_byte(wc * 32 + fr, fq * 8);
#define PG8_SA(b, h) (((b) * 2 + (h)) * HTB)
#define PG8_SB(b, h) ((4 + (b) * 2 + (h)) * HTB)
#define PG8_STAGE(bufoff, gbase, voff) do { _Pragma("unroll") for (int _i = 0; _i < 2; ++_i) \
        __builtin_amdgcn_global_load_lds((const unsigned*)((const char*)(gbase) + (voff)[_i]), (PG8_LAS unsigned*)(lds + (bufoff) + ldsw + _i * 8192), 16, 0, 0); } while (0)
#define PG8_LDA(dst, b, h) do { _Pragma("unroll") for (int m = 0; m < 4; ++m) _Pragma("unroll") for (int k = 0; k < 2; ++k) dst[m][k] = *(const PG8_LAS bf16x8*)(lds + PG8_SA(b, h) + aoff + m * 2048 + k * 1024); } while (0)
#define PG8_LDB(dst, b, h) do { _Pragma("unroll") for (int n = 0; n < 2; ++n) _Pragma("unroll") for (int k = 0; k < 2; ++k) dst[n][k] = *(const PG8_LAS bf16x8*)(lds + PG8_SB(b, h) + boff + n * 2048 + k * 1024); } while (0)
#define PG8_MMA(ai, bj, At, Bt) do { __builtin_amdgcn_s_setprio(1); _Pragma("unroll") for (int m = 0; m < 4; ++m) _Pragma("unroll") for (int n = 0; n < 2; ++n) _Pragma("unroll") for (int k = 0; k < 2; ++k) \
        acc[ai][bj][m][n] = __builtin_amdgcn_mfma_f32_16x16x32_bf16(Bt[n][k], At[m][k], acc[ai][bj][m][n], 0, 0, 0); __builtin_amdgcn_s_setprio(0); } while (0)
#define PG8_WAIT_V(n) asm volatile("s_waitcnt vmcnt(" #n ")" ::: "memory")
#define PG8_WAIT_L(n) asm volatile("s_waitcnt lgkmcnt(" #n ")" ::: "memory")
#define PG8_BAR __builtin_amdgcn_s_barrier()
#define PG8_SCHED __builtin_amdgcn_sched_barrier(0)
    Unit cur, nxt; int ui = 0;
    if (!S.next(0, cur)) return;
    f32x4 acc[2][2][4][2];
#pragma unroll
    for (int a = 0; a < 2; ++a)
#pragma unroll
        for (int b = 0; b < 2; ++b)
#pragma unroll
            for (int m = 0; m < 4; ++m)
#pragma unroll
                for (int n = 0; n < 2; ++n) acc[a][b][m][n] = (f32x4){0.f, 0.f, 0.f, 0.f};
    bf16x8 At[4][2], B0[2][2], B1[2][2];
    const char* cA = (const char*)g.A + (size_t)cur.pm * tstep; const char* cB = (const char*)g.Bt + (size_t)cur.pn * tstep;
    S.a_ready(cur);
    if constexpr (SP2) {
        PG8_STAGE(PG8_SB(0, 0), cB, voffB); PG8_STAGE(PG8_SB(0, 1), cB + hstep, voffB); PG8_STAGE(PG8_SA(0, 0), cA, voffA); PG8_STAGE(PG8_SA(0, 1), cA + hstep, voffA);
        if (wr == 1) PG8_BAR;
        PG8_WAIT_V(2); PG8_BAR;
        PG8_STAGE(PG8_SB(1, 0), cB + kstep, voffB); PG8_STAGE(PG8_SA(1, 0), cA + kstep, voffA); PG8_STAGE(PG8_SB(1, 1), cB + hstep + kstep, voffB);
        PG8_WAIT_V(6); PG8_BAR;
    } else {
        PG8_STAGE(PG8_SB(0, 0), cB, voffB); PG8_STAGE(PG8_SA(0, 0), cA, voffA); PG8_STAGE(PG8_SB(0, 1), cB + hstep, voffB); PG8_STAGE(PG8_SA(0, 1), cA + hstep, voffA);
        if (wr == 1) PG8_BAR;
        PG8_WAIT_V(4); PG8_BAR;
        PG8_STAGE(PG8_SB(1, 0), cB + kstep, voffB); PG8_STAGE(PG8_SA(1, 0), cA + kstep, voffA); PG8_STAGE(PG8_SB(1, 1), cB + hstep + kstep, voffB);
        PG8_WAIT_V(6); PG8_BAR;
    }
    for (;;) {
        const bool has_next = S.next(ui + 1, nxt);
        const char* nA = has_next ? (const char*)g.A + (size_t)nxt.pm * tstep : cA; const char* nB = has_next ? (const char*)g.Bt + (size_t)nxt.pn * tstep : cB;
#pragma unroll 1
        for (int t = 0; t < nt; t += 2) {
            const bool last = (t == nt - 2);
            const char* a1 = cA + (size_t)(t + 1) * kstep;
            const char* a2 = last ? nA : cA + (size_t)(t + 2) * kstep; const char* b2 = last ? nB : cB + (size_t)(t + 2) * kstep;
            const char* a3 = a2 + kstep; const char* b3 = b2 + kstep;
            if (last && has_next) S.a_ready(nxt);
            if constexpr (SP2) {
            PG8_LDB(B0, 0, 0); PG8_LDB(B1, 0, 1); PG8_SCHED; PG8_LDA(At, 0, 0); PG8_STAGE(PG8_SA(1, 1), a1 + hstep, voffA);
            PG8_WAIT_V(8); PG8_WAIT_L(0); PG8_BAR; PG8_MMA(0, 0, At, B0); PG8_MMA(0, 1, At, B1); PG8_BAR; PG8_SCHED;
            PG8_LDA(At, 0, 1); PG8_STAGE(PG8_SB(0, 0), b2, voffB); PG8_STAGE(PG8_SB(0, 1), b2 + hstep, voffB); PG8_STAGE(PG8_SA(0, 0), a2, voffA);
            PG8_WAIT_V(8); PG8_WAIT_L(0); PG8_BAR; PG8_MMA(1, 0, At, B0); PG8_MMA(1, 1, At, B1); PG8_BAR; PG8_SCHED;
            PG8_LDB(B0, 1, 0); PG8_LDB(B1, 1, 1); PG8_SCHED; PG8_LDA(At, 1, 0); PG8_STAGE(PG8_SA(0, 1), a2 + hstep, voffA);
            PG8_WAIT_V(8); PG8_WAIT_L(0); PG8_BAR; PG8_MMA(0, 0, At, B0); PG8_MMA(0, 1, At, B1); PG8_BAR; PG8_SCHED;
            PG8_LDA(At, 1, 1); PG8_STAGE(PG8_SB(1, 0), b3, voffB); PG8_STAGE(PG8_SB(1, 1), b3 + hstep, voffB); PG8_STAGE(PG8_SA(1, 0), a3, voffA);
            PG8_WAIT_V(8); PG8_WAIT_L(0); PG8_BAR; PG8_MMA(1, 0, At, B0); PG8_MMA(1, 1, At, B1); PG8_BAR; PG8_SCHED;
            } else {
            PG8_LDB(B0, 0, 0); PG8_SCHED; PG8_LDA(At, 0, 0); PG8_STAGE(PG8_SA(1, 1), a1 + hstep, voffA);
            PG8_WAIT_L(8); PG8_BAR; PG8_WAIT_L(0); PG8_MMA(0, 0, At, B0); PG8_BAR; PG8_SCHED;
            PG8_LDB(B1, 0, 1); PG8_STAGE(PG8_SB(0, 0), b2, voffB);
            PG8_BAR; PG8_WAIT_L(0); PG8_MMA(0, 1, At, B1); PG8_BAR;
            PG8_LDA(At, 0, 1); PG8_STAGE(PG8_SA(0, 0), a2, voffA);
            PG8_BAR; PG8_WAIT_L(0); PG8_MMA(1, 0, At, B0); PG8_BAR; PG8_SCHED;
            PG8_STAGE(PG8_SB(0, 1), b2 + hstep, voffB);
            PG8_WAIT_V(6); PG8_BAR; PG8_MMA(1, 1, At, B1); PG8_BAR;
            PG8_LDB(B0, 1, 0); PG8_SCHED; PG8_LDA(At, 1, 0); PG8_STAGE(PG8_SA(0, 1), a2 + hstep, voffA);
            PG8_WAIT_L(8); PG8_BAR; PG8_WAIT_L(0); PG8_MMA(0, 0, At, B0); PG8_BAR; PG8_SCHED;
            PG8_LDB(B1, 1, 1); PG8_STAGE(PG8_SB(1, 0), b3, voffB);
            PG8_BAR; PG8_WAIT_L(0); PG8_MMA(0, 1, At, B1); PG8_BAR;
            PG8_LDA(At, 1, 1); PG8_STAGE(PG8_SA(1, 0), a3, voffA);
            PG8_BAR; PG8_WAIT_L(0); PG8_MMA(1, 0, At, B0); PG8_BAR; PG8_SCHED;
            PG8_STAGE(PG8_SB(1, 1), b3 + hstep, voffB);
            PG8_WAIT_V(6); PG8_BAR; PG8_MMA(1, 1, At, B1); PG8_BAR;
            }
        }
        if constexpr (ALIGN_EPI) { if (wr == 0) PG8_BAR; }
        if constexpr (!Epi::AFTER_DRAIN) { E(acc, cur, wr, wc, fr, fq); S.done(cur); }
        if (!has_next) break;
#pragma unroll
        for (int a = 0; a < 2; ++a)
#pragma unroll
            for (int b = 0; b < 2; ++b)
#pragma unroll
                for (int m = 0; m < 4; ++m)
#pragma unroll
                    for (int n = 0; n < 2; ++n) acc[a][b][m][n] = (f32x4){0.f, 0.f, 0.f, 0.f};
        cur = nxt; cA = nA; cB = nB; ++ui;
        if constexpr (ALIGN_EPI) { if (wr == 1) PG8_BAR; }
    }
    PG8_WAIT_V(0);
    if constexpr (!ALIGN_EPI) { if (wr == 0) PG8_BAR; }
    PG8_BAR;
    if constexpr (Epi::AFTER_DRAIN) { E.fused(acc, cur, wr, wc, fr, fq, lds, wid, lane); S.done(cur); }
#undef PG8_SA
#undef PG8_SB
#undef PG8_STAGE
#undef PG8_LDA
#undef PG8_LDB
#undef PG8_MMA
#undef PG8_WAIT_V
#undef PG8_WAIT_L
#undef PG8_BAR
#undef PG8_SCHED
}
}

constexpr bool PG_ALIGN = true, PG_SP2 = true;
__device__ __forceinline__ float bflo(unsigned w) { return __builtin_bit_cast(float, w << 16); }
__device__ __forceinline__ float bfhi(unsigned w) { return __builtin_bit_cast(float, w & 0xffff0000u); }
__device__ __forceinline__ unsigned cvtpk(float lo, float hi) { return pg8::cvt_pk_bf16(lo, hi); }

__device__ __forceinline__ void transpose_item(const float* W, int N, int k0, int n0, bf16* WT, int K, size_t dst_row0, LAS float* scr, int lane) {
    float v[32];
#pragma unroll
    for (int i = 0; i < 32; ++i) v[i] = W[(size_t)(k0 + 2 * i + (lane >> 5)) * N + n0 + (lane & 31)];
#pragma unroll
    for (int i = 0; i < 32; ++i) scr[(2 * i + (lane >> 5)) * 33 + (lane & 31)] = v[i];
    asm volatile("s_waitcnt lgkmcnt(0)" ::: "memory");
    const int c = lane & 7;
#pragma unroll
    for (int j = 0; j < 4; ++j) { const int n = (lane >> 3) + 8 * j; const LAS float* s = scr + (8 * c) * 33 + n;
        v4u o; o.x = pk2(s[0 * 33], s[1 * 33]); o.y = pk2(s[2 * 33], s[3 * 33]); o.z = pk2(s[4 * 33], s[5 * 33]); o.w = pk2(s[6 * 33], s[7 * 33]);
        *(v4u*)(WT + (dst_row0 + n) * K + k0 + 8 * c) = o; }
    asm volatile("s_waitcnt lgkmcnt(0)" ::: "memory");
}
__device__ __forceinline__ void convert_weights(Frame& F, int l, int nblk) {
    LAS float* scr = (LAS float*)(F.lds + F.wave * 16384);
    if (F.bid >= nblk) return;
    const int gw = F.bid * (NT / 64) + F.wave, ngw = nblk * (NT / 64);
    constexpr int I_IN = 16 * 96, I_MG = 16 * 96, I_GLU = 8 * 16, I_BR = 3 * 8 * 32, I_O = 16 * 32, I_1 = 32 * 16 * 8, I_3 = I_1, I_2 = 32 * 4 * 32;
    constexpr int NITEMS = I_IN + I_MG + I_GLU + I_BR + I_O + I_1 + I_3 + I_2;
    for (int it = gw; it < NITEMS; it += ngw) {
        int r = it;
        if (r < I_IN) { const int kb = r / 96, nb = r % 96; transpose_item(IN_(I_WIN) + (size_t)l * D * INW, INW, 64 * kb, 32 * nb, (bf16*)(F.ws + WS_WIN), 1024, 32 * nb, scr, F.lane); continue; } r -= I_IN;
        if (r < I_MG) { const int kb = r / 96, nb = r % 96; transpose_item(IN_(I_WMG) + (size_t)l * D * INW, INW, 64 * kb, 32 * nb, (bf16*)(F.ws + WS_WMG), 1024, 32 * nb, scr, F.lane); continue; } r -= I_MG;
        if (r < I_GLU) { const int kb = r / 16, nb = r % 16; transpose_item(IN_(I_WGLU) + (size_t)l * MIXW * MIXW, MIXW, 64 * kb, 32 * nb, (bf16*)(F.ws + WS_WGLU), 512, 32 * nb, scr, F.lane); continue; } r -= I_GLU;
        if (r < I_BR) { const int kk = r / 256, q = r % 256, kb = q / 32, nb = q % 32; transpose_item(IN_(I_WBR) + ((size_t)l * 3 + kk) * MIXW * D, D, 64 * kb, 32 * nb, (bf16*)(F.ws + WS_WBR), 512, (size_t)kk * 1024 + 32 * nb, scr, F.lane); continue; } r -= I_BR;
        if (r < I_O) { const int kb = r / 32, nb = r % 32; transpose_item(IN_(I_WO) + (size_t)l * D * D, D, 64 * kb, 32 * nb, (bf16*)(F.ws + WS_WO), 1024, 32 * nb, scr, F.lane); continue; } r -= I_O;
        if (r < I_1 + I_3) { const int which = r / I_1, q = r % I_1, e = q / 128, q2 = q % 128, kb = q2 / 8, nb = q2 % 8;
            const float* W = IN_(which ? I_W3 : I_W1) + ((size_t)l * NE + e) * D * DFF; const int n0 = 32 * nb;
            transpose_item(W, DFF, 64 * kb, n0, (bf16*)(F.ws + WS_W13), 1024, (size_t)e * 512 + (n0 / 128) * 256 + which * 128 + (n0 % 128), scr, F.lane); continue; } r -= I_1 + I_3;
        { const int e = r / 128, q = r % 128, kb = q / 32, nb = q % 32; transpose_item(IN_(I_W2) + ((size_t)l * NE + e) * DFF * D, D, 64 * kb, 32 * nb, (bf16*)(F.ws + WS_W2), 256, (size_t)e * 1024 + 32 * nb, scr, F.lane); }
    }
    { bf16* wr = (bf16*)(F.ws + WS_WR); const float* wg = IN_(I_WGRP) + (size_t)l * D * 4; const float* we = IN_(I_WEXP) + (size_t)l * D * 32;
      for (int i = F.bid * NT + F.tid; i < 48 * 1024; i += nblk * NT) { const int n = i >> 10, kk = i & 1023; const float w = n < 4 ? wg[kk * 4 + n] : (n < 36 ? we[kk * 32 + n - 4] : 0.f);
          const unsigned hi = f2bf(w); const float lo = w - __builtin_bit_cast(float, hi << 16); wr[i] = (bf16)hi; wr[48 * 1024 + i] = (bf16)f2bf(lo); } }
    { const float* s = IN_(I_WSG) + (size_t)l * 4 * 128 * 128; bf16* d = (bf16*)(F.ws + WS_WSG);
      for (int i = (F.bid * NT + F.tid) * 2; i < 4 * 128 * 128; i += nblk * NT * 2) *(unsigned*)(d + i) = pk2(s[i], s[i + 1]); }
}

struct EpiProj { static constexpr bool PERM = true, AFTER_DRAIN = false; bf16* O;
    __device__ __forceinline__ void operator()(const pg8::f32x4 (&acc)[2][2][4][2], const pg8::Unit& u, int wr, int wc, int fr, int fq) const {
        const int row0 = u.pm * 256 + wr * 64 + fr, col0 = u.pn * 256 + wc * 32 + 8 * fq; const bool act = (u.pn >= 2 && u.pn < 6);
#pragma unroll
        for (int ai = 0; ai < 2; ++ai)
#pragma unroll
            for (int m = 0; m < 4; ++m) { bf16* rowp = O + (size_t)(row0 + ai * 128 + m * 16) * INW + col0;
#pragma unroll
                for (int bj = 0; bj < 2; ++bj) { pg8::f32x4 v0 = acc[ai][bj][m][0], v1 = acc[ai][bj][m][1];
                    if (act) {
#pragma unroll
                        for (int j = 0; j < 4; ++j) { v0[j] = geluf_(v0[j]); v1[j] = geluf_(v1[j]); } }
                    v4u w; w.x = cvtpk(v0[0], v0[1]); w.y = cvtpk(v0[2], v0[3]); w.z = cvtpk(v1[0], v1[1]); w.w = cvtpk(v1[2], v1[3]); *(v4u*)(rowp + bj * 128) = w; } }
    } };
struct EpiGlu { static constexpr bool PERM = true, AFTER_DRAIN = false; const bf16* YG; bf16* YA;
    __device__ __forceinline__ void operator()(const pg8::f32x4 (&acc)[2][2][4][2], const pg8::Unit& u, int wr, int wc, int fr, int fq) const {
        const int row0 = u.pm * 256 + wr * 64 + fr, col0 = u.pn * 256 + wc * 32 + 8 * fq;
#pragma unroll
        for (int ai = 0; ai < 2; ++ai) {
        v4u gv[4][2];
#pragma unroll
            for (int m = 0; m < 4; ++m)
#pragma unroll
                for (int bj = 0; bj < 2; ++bj) gv[m][bj] = *(const v4u*)(YG + (size_t)(row0 + ai * 128 + m * 16) * MIXW + col0 + bj * 128);
        asm volatile("" ::: "memory");
#pragma unroll
            for (int m = 0; m < 4; ++m) { const size_t off = (size_t)(row0 + ai * 128 + m * 16) * MIXW + col0;
#pragma unroll
                for (int bj = 0; bj < 2; ++bj) { const pg8::f32x4 v0 = acc[ai][bj][m][0], v1 = acc[ai][bj][m][1]; const v4u g = gv[m][bj];
                    v4u w; w.x = cvtpk(bflo(g.x) * sigmoidf_(v0[0]), bfhi(g.x) * sigmoidf_(v0[1])); w.y = cvtpk(bflo(g.y) * sigmoidf_(v0[2]), bfhi(g.y) * sigmoidf_(v0[3]));
                    w.z = cvtpk(bflo(g.z) * sigmoidf_(v1[0]), bfhi(g.z) * sigmoidf_(v1[1])); w.w = cvtpk(bflo(g.w) * sigmoidf_(v1[2]), bfhi(g.w) * sigmoidf_(v1[3])); *(v4u*)(YA + off + bj * 128) = w; } }
        asm volatile("" ::: "memory"); }
    } };
__device__ __forceinline__ int xcd_remap(int Lq, int total) { const int q = total >> 3, r = total & 7, x = Lq & 7, off = Lq >> 3; return (x < r ? x * (q + 1) : r * (q + 1) + (x - r) * q) + off; }
struct EpiBr { static constexpr bool PERM = true, AFTER_DRAIN = false; bf16* BR;
    __device__ __forceinline__ void operator()(const pg8::f32x4 (&acc)[2][2][4][2], const pg8::Unit& u, int wr, int wc, int fr, int fq) const {
        const int pm = u.pm % (MT / 256); const int row0 = pm * 256 + wr * 64 + fr, col0 = u.pn * 256 + wc * 32 + 8 * fq;
#pragma unroll
        for (int ai = 0; ai < 2; ++ai)
#pragma unroll
            for (int m = 0; m < 4; ++m) { bf16* rowp = BR + (size_t)(row0 + ai * 128 + m * 16) * INW + col0;
#pragma unroll
                for (int bj = 0; bj < 2; ++bj) { const pg8::f32x4 v0 = acc[ai][bj][m][0], v1 = acc[ai][bj][m][1];
                    v4u w; w.x = cvtpk(v0[0], v0[1]); w.y = cvtpk(v0[2], v0[3]); w.z = cvtpk(v1[0], v1[1]); w.w = cvtpk(v1[2], v1[3]); *(v4u*)(rowp + bj * 128) = w; } }
    } };
struct SchedBr { int G, c, nM;
    __device__ __forceinline__ bool next(int i, pg8::Unit& u) const { const int L0 = i * G + c; if (L0 >= 3 * nM * 4) return false; const int Lq = xcd_remap(L0, 3 * nM * 4); const int k = Lq / (nM * 4), r = Lq % (nM * 4);
        u.pm = k * (MT / 256) + r / 4; u.pn = k * 4 + r % 4; return true; }
    __device__ __forceinline__ void a_ready(const pg8::Unit&) const {}
    __device__ __forceinline__ void done(const pg8::Unit&) const {} };
struct EpiMerge { static constexpr bool PERM = true, AFTER_DRAIN = false; const bf16* BR; bf16* PM; const float* bm;
    __device__ __forceinline__ void operator()(const pg8::f32x4 (&acc)[2][2][4][2], const pg8::Unit& u, int wr, int wc, int fr, int fq) const {
        const int k = u.pn >> 2, dt = u.pn & 3; const int row0 = u.pm * 256 + wr * 64 + fr, col0 = dt * 256 + wc * 32 + 8 * fq;
#pragma unroll
        for (int bj = 0; bj < 2; ++bj) { const pg8::f32x4 b0 = *(const pg8::f32x4*)(bm + k * 1024 + col0 + bj * 128), b1 = *(const pg8::f32x4*)(bm + k * 1024 + col0 + bj * 128 + 4);
#pragma unroll
            for (int ai = 0; ai < 2; ++ai) {
            v4u brv[4], pmv[4];
#pragma unroll
                for (int m = 0; m < 4; ++m) { const size_t r = (size_t)(row0 + ai * 128 + m * 16); brv[m] = *(const v4u*)(BR + r * INW + k * 1024 + col0 + bj * 128);
                    pmv[m] = k > 0 ? *(const v4u*)(PM + r * D + col0 + bj * 128) : (v4u){0u, 0u, 0u, 0u}; }
                asm volatile("" ::: "memory");
#pragma unroll
                for (int m = 0; m < 4; ++m) { const size_t r = (size_t)(row0 + ai * 128 + m * 16); const v4u br = brv[m], o = pmv[m];
                    const pg8::f32x4 v0 = acc[ai][bj][m][0] + b0, v1 = acc[ai][bj][m][1] + b1;
                    float p[8] = {sigmoidf_(v0[0]) * bflo(br.x), sigmoidf_(v0[1]) * bfhi(br.x), sigmoidf_(v0[2]) * bflo(br.y), sigmoidf_(v0[3]) * bfhi(br.y),
                                  sigmoidf_(v1[0]) * bflo(br.z), sigmoidf_(v1[1]) * bfhi(br.z), sigmoidf_(v1[2]) * bflo(br.w), sigmoidf_(v1[3]) * bfhi(br.w)};
                    if (k > 0) { p[0] += bflo(o.x); p[1] += bfhi(o.x); p[2] += bflo(o.y); p[3] += bfhi(o.y); p[4] += bflo(o.z); p[5] += bfhi(o.z); p[6] += bflo(o.w); p[7] += bfhi(o.w); }
                    v4u w; w.x = cvtpk(p[0], p[1]); w.y = cvtpk(p[2], p[3]); w.z = cvtpk(p[4], p[5]); w.w = cvtpk(p[6], p[7]); *(v4u*)(PM + r * D + col0 + bj * 128) = w; }
                asm volatile("" ::: "memory"); } }
    } };
struct SchedMerge { int G, c, nM;
    __device__ __forceinline__ bool next(int i, pg8::Unit& u) const { const int v0 = (i / 3) * G + c, k = i % 3; if (v0 >= nM * 4) return false; const int v = xcd_remap(v0, nM * 4); u.pm = v >> 2; u.pn = k * 4 + (v & 3); return true; }
    __device__ __forceinline__ void a_ready(const pg8::Unit&) const {}
    __device__ __forceinline__ void done(const pg8::Unit&) const {} };
struct EpiWo { static constexpr bool PERM = false, AFTER_DRAIN = false; const float* xs_lat; const float* xs_ctx; float* out; float* xc; const float* mod_l; float* rss;
    __device__ __forceinline__ void operator()(const pg8::f32x4 (&acc)[2][2][4][2], const pg8::Unit& u, int wr, int wc, int fr, int fq) const {
        const int row0 = u.pm * 256 + wr * 64 + fr, col0 = u.pn * 256 + wc * 32 + 4 * fq;
        const float* ga = mod_l + 2048;
        float ssq[2][4] = {};
        pg8::f32x4 gv[2][2];
#pragma unroll
        for (int bj = 0; bj < 2; ++bj)
#pragma unroll
            for (int n = 0; n < 2; ++n) gv[bj][n] = *(const pg8::f32x4*)(ga + col0 + bj * 128 + n * 16);
#pragma unroll
        for (int ai = 0; ai < 2; ++ai) {
#pragma unroll
            for (int mp = 0; mp < 2; ++mp) {
            pg8::f32x4 xv[2][2][2];
#pragma unroll
            for (int m = 0; m < 2; ++m) { const size_t off = (size_t)(row0 + ai * 128 + (mp * 2 + m) * 16) * D + col0;
#pragma unroll
                for (int bj = 0; bj < 2; ++bj)
#pragma unroll
                    for (int n = 0; n < 2; ++n) xv[m][bj][n] = *(const pg8::f32x4*)(xs_lat + off + bj * 128 + n * 16); }
            asm volatile("" ::: "memory");
#pragma unroll
            for (int m = 0; m < 2; ++m) { const size_t off = (size_t)(row0 + ai * 128 + (mp * 2 + m) * 16) * D + col0;
#pragma unroll
                for (int bj = 0; bj < 2; ++bj)
#pragma unroll
                    for (int n = 0; n < 2; ++n) { const pg8::f32x4 o = xv[m][bj][n] + gv[bj][n] * acc[ai][bj][m + mp * 2][n]; *(pg8::f32x4*)(out + off + bj * 128 + n * 16) = o; ssq[ai][m + mp * 2] += o[0] * o[0] + o[1] * o[1] + o[2] * o[2] + o[3] * o[3]; } }
            asm volatile("" ::: "memory"); }
        }
        const int lane = fr + 16 * fq;
#pragma unroll
        for (int ai = 0; ai < 2; ++ai)
#pragma unroll
            for (int m = 0; m < 4; ++m) { float s = ssq[ai][m]; s += shflx(s, 16, lane); s += shflx(s, 32, lane); if (fq == 0) rss[(size_t)(row0 + ai * 128 + m * 16) * 16 + u.pn * 4 + wc] = s; }
    } };
constexpr int MOETAB_OFF = 131072 + 2048;
constexpr int THIN_MAX = 0;
template <int NPN> __device__ __forceinline__ int moe_build_table(Frame& F, const unsigned* cnt) {
    LAS unsigned* tabw = (LAS unsigned*)(F.lds + MOETAB_OFF); LAS unsigned* tabt = tabw + 1024;
    int total = 0, rowtile0 = 0, nt = 0;
    for (int e = 0; e < NE; ++e) { const int n = (int)cnt[e], npad = (n + 255) >> 8, tail = n & 255; const bool thin = tail > 0 && tail <= THIN_MAX; const int neng = thin ? (n >> 8) : npad, nb = thin ? (tail + 15) >> 4 : 0;
        for (int q = F.tid; q < neng * NPN; q += NT) tabw[total + q] = ((unsigned)(rowtile0 + q / NPN) << 16) | (unsigned)(e * NPN + q % NPN);
        for (int q = F.tid; q < nb; q += NT) tabt[nt + q] = ((unsigned)e << 24) | (unsigned)((rowtile0 + neng) * 256 + q * 16);
        total += neng * NPN; rowtile0 += npad; nt += nb; }
    if (F.tid == 0) tabw[2047] = (unsigned)nt;
    __syncthreads();
    return total;
}
struct SchedMoe { int G, c, total; const LAS unsigned* tabw;
    __device__ __forceinline__ bool next(int i, pg8::Unit& u) const { const int L0 = i * G + c; if (L0 >= total) return false; const int Lq = xcd_remap(L0, total); const unsigned w = (unsigned)__builtin_amdgcn_readfirstlane((int)tabw[Lq]); u.pm = (int)(w >> 16); u.pn = (int)(w & 0xffffu); return true; }
    __device__ __forceinline__ void a_ready(const pg8::Unit&) const {}
    __device__ __forceinline__ void done(const pg8::Unit&) const {} };
struct EpiUp { static constexpr bool PERM = true, AFTER_DRAIN = false; bf16* ACT; const float* SW;
    __device__ __forceinline__ void operator()(const pg8::f32x4 (&acc)[2][2][4][2], const pg8::Unit& u, int wr, int wc, int fr, int fq) const {
        const int row0 = u.pm * 256 + wr * 64 + fr, f0 = (u.pn & 1) * 128 + wc * 32 + 8 * fq;
        float wv[2][4];
#pragma unroll
        for (int ai = 0; ai < 2; ++ai)
#pragma unroll
            for (int m = 0; m < 4; ++m) wv[ai][m] = SW[row0 + ai * 128 + m * 16];
        asm volatile("" ::: "memory");
#pragma unroll
        for (int ai = 0; ai < 2; ++ai)
#pragma unroll
            for (int m = 0; m < 4; ++m) { const int slot = row0 + ai * 128 + m * 16; const float w = wv[ai][m];
                const pg8::f32x4 a0 = acc[ai][0][m][0], a1 = acc[ai][0][m][1], b0 = acc[ai][1][m][0], b1 = acc[ai][1][m][1];
                v4u o; o.x = cvtpk(siluf_(a0[0]) * b0[0] * w, siluf_(a0[1]) * b0[1] * w); o.y = cvtpk(siluf_(a0[2]) * b0[2] * w, siluf_(a0[3]) * b0[3] * w);
                o.z = cvtpk(siluf_(a1[0]) * b1[0] * w, siluf_(a1[1]) * b1[1] * w); o.w = cvtpk(siluf_(a1[2]) * b1[2] * w, siluf_(a1[3]) * b1[3] * w);
                *(v4u*)(ACT + (size_t)slot * DFF + f0) = o; }
    } };
struct EpiDown { static constexpr bool PERM = true, AFTER_DRAIN = false; bf16* YS2;
    __device__ __forceinline__ void operator()(const pg8::f32x4 (&acc)[2][2][4][2], const pg8::Unit& u, int wr, int wc, int fr, int fq) const {
        const int row0 = u.pm * 256 + wr * 64 + fr, col0 = (u.pn & 3) * 256 + wc * 32 + 8 * fq;
#pragma unroll
        for (int ai = 0; ai < 2; ++ai)
#pragma unroll
            for (int m = 0; m < 4; ++m) { bf16* rowp = YS2 + (size_t)(row0 + ai * 128 + m * 16) * D + col0;
#pragma unroll
                for (int bj = 0; bj < 2; ++bj) { const pg8::f32x4 v0 = acc[ai][bj][m][0], v1 = acc[ai][bj][m][1];
                    v4u w; w.x = cvtpk(v0[0], v0[1]); w.y = cvtpk(v0[2], v0[3]); w.z = cvtpk(v1[0], v1[1]); w.w = cvtpk(v1[2], v1[3]); *(v4u*)(rowp + bj * 128) = w; } }
    } };


__device__ __forceinline__ void moe_up_thin(Frame& F, int nthin) {
    const bf16* HS = (const bf16*)(F.ws + WS_HS); bf16* ACT = (bf16*)(F.ws + WS_ACT); const float* SW = (const float*)(F.ws + WS_SW); const LAS unsigned* tabt = (const LAS unsigned*)(F.lds + MOETAB_OFF) + 1024;
    const int r = F.lane & 15, q = F.lane >> 4;
    for (int it = F.bid; it < nthin; it += F.G) { const unsigned tw = tabt[it]; const int e = (int)(tw >> 24), s0 = (int)(tw & 0xffffffu);
        const bf16* a = HS + (size_t)(s0 + r) * D + 8 * q; const bf16* W = (const bf16*)(F.ws + WS_W13) + (size_t)e * 512 * D;
        f32x4 acc[2][2] = {{{0.f, 0.f, 0.f, 0.f}, {0.f, 0.f, 0.f, 0.f}}, {{0.f, 0.f, 0.f, 0.f}, {0.f, 0.f, 0.f, 0.f}}};
        const bf16* b0[2];
#pragma unroll
        for (int c = 0; c < 2; ++c) { const int fb = 2 * F.wave + c; b0[c] = W + (size_t)((fb >> 3) * 256 + (fb & 7) * 16 + r) * D + 8 * q; }
#pragma unroll 8
        for (int ks = 0; ks < D / 32; ++ks) { const bf16x8 x = *(const bf16x8*)(a + 32 * ks);
#pragma unroll
            for (int c = 0; c < 2; ++c) { const bf16x8 w1 = *(const bf16x8*)(b0[c] + 32 * ks), w3 = *(const bf16x8*)(b0[c] + (size_t)128 * D + 32 * ks);
                acc[c][0] = __builtin_amdgcn_mfma_f32_16x16x32_bf16(x, w1, acc[c][0], 0, 0, 0); acc[c][1] = __builtin_amdgcn_mfma_f32_16x16x32_bf16(x, w3, acc[c][1], 0, 0, 0); } }
#pragma unroll
        for (int c = 0; c < 2; ++c)
#pragma unroll
            for (int i = 0; i < 4; ++i) { const int slot = s0 + 4 * q + i; const float w = SW[slot]; ACT[(size_t)slot * DFF + (2 * F.wave + c) * 16 + r] = (bf16)f2bf(siluf_(acc[c][0][i]) * acc[c][1][i] * w); }
    }
}
__device__ __forceinline__ void moe_down_thin(Frame& F, int nthin) {
    const bf16* ACT = (const bf16*)(F.ws + WS_ACT); bf16* YS2 = (bf16*)(F.ws + WS_YS2); const LAS unsigned* tabt = (const LAS unsigned*)(F.lds + MOETAB_OFF) + 1024;
    const int r = F.lane & 15, q = F.lane >> 4;
    for (int it = F.bid; it < nthin; it += F.G) { const unsigned tw = tabt[it]; const int e = (int)(tw >> 24), s0 = (int)(tw & 0xffffffu);
        const bf16* a = ACT + (size_t)(s0 + r) * DFF + 8 * q; const bf16* W = (const bf16*)(F.ws + WS_W2) + ((size_t)e * 1024 + 128 * F.wave + r) * DFF + 8 * q;
        f32x4 acc[8];
#pragma unroll
        for (int c = 0; c < 8; ++c) acc[c] = (f32x4){0.f, 0.f, 0.f, 0.f};
#pragma unroll 4
        for (int ks = 0; ks < DFF / 32; ++ks) { const bf16x8 x = *(const bf16x8*)(a + 32 * ks);
#pragma unroll
            for (int c = 0; c < 8; ++c) { const bf16x8 w = *(const bf16x8*)(W + (size_t)c * 16 * DFF + 32 * ks); acc[c] = __builtin_amdgcn_mfma_f32_16x16x32_bf16(x, w, acc[c], 0, 0, 0); } }
#pragma unroll
        for (int c = 0; c < 8; ++c)
#pragma unroll
            for (int i = 0; i < 4; ++i) YS2[(size_t)(s0 + 4 * q + i) * D + 128 * F.wave + c * 16 + r] = (bf16)f2bf(acc[c][i]);
    }
}

__device__ __forceinline__ void ph2_fast(Frame& F, int l) {
    pg8::Gemm g{(const bf16*)(F.ws + WS_H), (const bf16*)(F.ws + WS_WIN), SEQ, INW, D}; pg8::StaticOrder S; S.init(SEQ, INW, F.G, F.bid);
    EpiProj E{(bf16*)(F.ws + WS_PROJ)}; pg8::gemm_phase<EpiProj, pg8::StaticOrder, PG_ALIGN, PG_SP2>(F.lds, g, S, E, F.tid);
}
__device__ __forceinline__ void ph6_fast(Frame& F, int l) {
    pg8::Gemm g{(const bf16*)(F.ws + WS_YG), (const bf16*)(F.ws + WS_WGLU), MT, MIXW, MIXW}; pg8::StaticOrder S; S.init(SEQ, MIXW, F.G, F.bid);
    EpiGlu E{(const bf16*)(F.ws + WS_YG), (bf16*)(F.ws + WS_YS)}; pg8::gemm_phase<EpiGlu, pg8::StaticOrder, PG_ALIGN, PG_SP2>(F.lds, g, S, E, F.tid);
}
__device__ __forceinline__ void ph7_fast(Frame& F, int l) {
    pg8::Gemm g{(const bf16*)(F.ws + WS_YS), (const bf16*)(F.ws + WS_WBR), 3 * MT, 3 * D, MIXW}; SchedBr S{F.G, F.bid, SEQ / 256};
    EpiBr E{(bf16*)(F.ws + WS_PROJ)}; pg8::gemm_phase<EpiBr, SchedBr, PG_ALIGN, PG_SP2>(F.lds, g, S, E, F.tid);
}
__device__ __forceinline__ void ph8_fast(Frame& F, int l) {
    pg8::Gemm g{(const bf16*)(F.ws + WS_H), (const bf16*)(F.ws + WS_WMG), MT, INW, D}; SchedMerge S{F.G, F.bid, SEQ / 256};
    EpiMerge E{(const bf16*)(F.ws + WS_PROJ), (bf16*)(F.ws + WS_PM), IN_(I_BMG) + l * INW}; pg8::gemm_phase<EpiMerge, SchedMerge, PG_ALIGN, PG_SP2>(F.lds, g, S, E, F.tid);
}
__device__ __forceinline__ void ph9_fast(Frame& F, int l) {
    pg8::Gemm g{(const bf16*)(F.ws + WS_PM), (const bf16*)(F.ws + WS_WO), MT, D, D}; pg8::StaticOrder S; S.init(SEQ, D, F.G, F.bid);
    EpiWo E{l == 0 ? IN_(I_X) : F.out, l == 0 ? IN_(I_CTX) : (const float*)(F.ws + WS_XC), F.out, (float*)(F.ws + WS_XC), (const float*)(F.ws + WS_MOD) + (size_t)l * 2 * 6144, (float*)(F.ws + WS_RSS)};
    pg8::gemm_phase<EpiWo, pg8::StaticOrder, PG_ALIGN, PG_SP2>(F.lds, g, S, E, F.tid);
}
__device__ __forceinline__ void ph12_fast(Frame& F, int l) {
    pg8::Gemm g{(const bf16*)(F.ws + WS_HS), (const bf16*)(F.ws + WS_W13), MAXSLOT, NE * 512, D}; const int total = moe_build_table<2>(F, F.ctl + CW_CNT + l * 128); SchedMoe S{F.G, F.bid, total, (const LAS unsigned*)(F.lds + MOETAB_OFF)};
    EpiUp E{(bf16*)(F.ws + WS_ACT), (const float*)(F.ws + WS_SW)}; pg8::gemm_phase<EpiUp, SchedMoe, PG_ALIGN, PG_SP2>(F.lds, g, S, E, F.tid);
    moe_up_thin(F, __builtin_amdgcn_readfirstlane((int)((const LAS unsigned*)(F.lds + MOETAB_OFF))[2047]));
}
__device__ __forceinline__ void ph13_fast(Frame& F, int l) {
    pg8::Gemm g{(const bf16*)(F.ws + WS_ACT), (const bf16*)(F.ws + WS_W2), MAXSLOT, NE * D, DFF}; const int total = moe_build_table<4>(F, F.ctl + CW_CNT + l * 128); SchedMoe S{F.G, F.bid, total, (const LAS unsigned*)(F.lds + MOETAB_OFF)};
    EpiDown E{(bf16*)(F.ws + WS_YS2)}; pg8::gemm_phase<EpiDown, SchedMoe, PG_ALIGN, PG_SP2>(F.lds, g, S, E, F.tid);
    moe_down_thin(F, __builtin_amdgcn_readfirstlane((int)((const LAS unsigned*)(F.lds + MOETAB_OFF))[2047]));
}


constexpr int NSB = MT / 16;
__device__ __forceinline__ void s5_precompute(Frame& F) {
    LAS float* APr = (LAS float*)F.lds; LAS float* APi = APr + 2176; LAS float* BBr = APi + 2176; LAS float* BBi = BBr + 2048; LAS float* CCr = BBi + 2048; LAS float* CCi = CCr + 2048; LAS float* KK = CCi + 2048;
    for (int item = F.G - 1 - F.bid; item < 2 * G5; item += F.G) { const int l = item >> 5, g = item & 31;
        __syncthreads();
        if (F.tid < 128) { const int d = F.tid >> 6, p = F.tid & 63; const int ldg = (l * 2 + d) * G5 + g;
            const double lr = IN_(I_LRE)[ldg * P5 + p], li = IN_(I_LIM)[ldg * P5 + p], dt = exp((double)IN_(I_LDT)[ldg]);
            for (int e = 0; e <= 16; ++e) { const double m = exp(lr * dt * e), ang = li * dt * e; APr[(d * 64 + p) * 17 + e] = (float)(m * cos(ang)); APi[(d * 64 + p) * 17 + e] = (float)(m * sin(ang)); }
            { const double m16 = exp(lr * dt * 16.0), a16 = li * dt * 16.0; float* A16 = (float*)(F.ws + WS_A16) + ((size_t)((l * 32 + g) * 2 + d) * 64 + p) * 2; A16[0] = (float)(m16 * cos(a16)); A16[1] = (float)(m16 * sin(a16)); }
            const double m1 = exp(lr * dt), ar = m1 * cos(li * dt), ai = m1 * sin(li * dt); const double nr = ar - 1.0, ni = ai, den = lr * lr + li * li;
            const double qr = (nr * lr + ni * li) / den, qi = (ni * lr - nr * li) / den;
            for (int h = 0; h < 16; ++h) { const double x = IN_(I_BRE)[((size_t)ldg * P5 + p) * H5 + h], y = IN_(I_BIM)[((size_t)ldg * P5 + p) * H5 + h];
                BBr[(d * 64 + p) * 16 + h] = (float)(qr * x - qi * y); BBi[(d * 64 + p) * 16 + h] = (float)(qr * y + qi * x);
                CCr[(d * 16 + h) * 64 + p] = IN_(I_CRE)[((size_t)ldg * H5 + h) * P5 + p]; CCi[(d * 16 + h) * 64 + p] = IN_(I_CIM)[((size_t)ldg * H5 + h) * P5 + p]; } }
        __syncthreads();
        { const int d = F.tid >> 8, e = (F.tid >> 4) & 15, hp = F.tid & 15;
          float wr[64], wi[64];
#pragma unroll
          for (int p = 0; p < 64; ++p) { const float pr = APr[(d * 64 + p) * 17 + e], pi = APi[(d * 64 + p) * 17 + e], br = BBr[(d * 64 + p) * 16 + hp], bi = BBi[(d * 64 + p) * 16 + hp]; wr[p] = pr * br - pi * bi; wi[p] = pr * bi + pi * br; }
#pragma unroll 1
          for (int h = 0; h < 16; ++h) { float a = 0.f;
#pragma unroll
              for (int p = 0; p < 64; ++p) a += CCr[(d * 16 + h) * 64 + p] * wr[p] - CCi[(d * 16 + h) * 64 + p] * wi[p];
              KK[(d * 16 + e) * 256 + h * 16 + hp] = a; } }
        __syncthreads();
        bf16* M = (bf16*)(F.ws + WS_S5M) + (size_t)(l * 32 + g) * 3 * 65536;
        for (int idx = F.tid; idx < 32768; idx += NT) {
            const int r = idx >> 7, k0 = (idx & 127) * 2; float v[3][2];
#pragma unroll
            for (int q = 0; q < 2; ++q) { const int kk = k0 + q;
                { const int d = r >> 7, p = (r >> 1) & 63, c = r & 1, sg = kk >> 4, hp = kk & 15, e = d == 0 ? 15 - sg : sg;
                  const float pr = APr[(d * 64 + p) * 17 + e], pi = APi[(d * 64 + p) * 17 + e], br = BBr[(d * 64 + p) * 16 + hp], bi = BBi[(d * 64 + p) * 16 + hp];
                  v[0][q] = c == 0 ? pr * br - pi * bi : pr * bi + pi * br; }
                { const int tau = r >> 4, h = r & 15, sg = kk >> 4, hp = kk & 15; float t = 0.f;
                  if (sg <= tau) t += KK[(0 * 16 + (tau - sg)) * 256 + h * 16 + hp]; if (sg >= tau) t += KK[(1 * 16 + (sg - tau)) * 256 + h * 16 + hp]; v[1][q] = t; }
                { const int tau = r >> 4, h = r & 15, d = kk >> 7, p = (kk >> 1) & 63, c = kk & 1, e = d == 0 ? tau + 1 : 16 - tau;
                  const float cr = CCr[(d * 16 + h) * 64 + p], ci = CCi[(d * 16 + h) * 64 + p], pr = APr[(d * 64 + p) * 17 + e], pi = APi[(d * 64 + p) * 17 + e];
                  v[2][q] = c == 0 ? cr * pr - ci * pi : -(cr * pi + ci * pr); } }
#pragma unroll
            for (int m = 0; m < 3; ++m) *(unsigned*)(M + (size_t)m * 65536 + r * 256 + k0) = pk2(v[m][0], v[m][1]);
        }
    }
}
__device__ __forceinline__ void s5_z_phase(Frame& F, int l) {
    const bf16* PROJ = (const bf16*)(F.ws + WS_PROJ); bf16* Z = (bf16*)(F.ws + WS_Z);
    const int l15 = F.lane & 15, lq = F.lane >> 4;
    for (int item = F.bid; item < 256; item += F.G) {
        const int g = item >> 3, part = item & 7; const bf16* Fm = (const bf16*)(F.ws + WS_S5M) + (size_t)(l * 32 + g) * 3 * 65536;
        bf16x8 Af[2][8];
#pragma unroll
        for (int j = 0; j < 2; ++j)
#pragma unroll
            for (int ks = 0; ks < 8; ++ks) Af[j][ks] = *(const bf16x8*)(Fm + (size_t)(16 * (2 * F.wave + j) + l15) * 256 + 32 * ks + 8 * lq);
        const bf16* vsrc = PROJ + (size_t)(16 * l15 + 2 * F.wave + (lq >> 1)) * INW + 16 * g + 8 * (lq & 1);
        __syncthreads();
        bf16x8 nv = *(const bf16x8*)(vsrc + (size_t)part * 256 * INW);
        *(LAS bf16x8*)(F.lds + (F.wave * 64 + F.lane) * 16) = nv;
        __syncthreads();
        int cur = 0;
#pragma unroll 1
        for (int tl = part; tl < MT / 256; tl += 8) {
            const bool more = tl + 8 < MT / 256;
            if (more) nv = *(const bf16x8*)(vsrc + (size_t)(tl + 8) * 256 * INW);
            f32x4 acc[2] = {{0.f, 0.f, 0.f, 0.f}, {0.f, 0.f, 0.f, 0.f}};
#pragma unroll
            for (int ks = 0; ks < 8; ++ks) { const bf16x8 V = *(const LAS bf16x8*)(F.lds + cur * 8192 + (ks * 64 + F.lane) * 16);
#pragma unroll
                for (int j = 0; j < 2; ++j) acc[j] = __builtin_amdgcn_mfma_f32_16x16x32_bf16(Af[j][ks], V, acc[j], 0, 0, 0); }
#pragma unroll
            for (int j = 0; j < 2; ++j) { v2u zz; zz.x = pk2(acc[j][0], acc[j][1]); zz.y = pk2(acc[j][2], acc[j][3]);     *(v2u*)(Z + ((size_t)(tl * 16 + l15) * 32 + g) * 256 + 16 * (2 * F.wave + j) + 4 * lq) = zz; }
            if (more) *(LAS bf16x8*)(F.lds + (cur ^ 1) * 8192 + (F.wave * 64 + F.lane) * 16) = nv;
            __syncthreads();
            cur ^= 1;
        }
    }
}
__device__ __forceinline__ int s5_chain_sb(int d, int i) { return d == 0 ? (i < 16 ? 1024 + i : i - 16) : (i < 16 ? 1039 - i : 1023 - (i - 16)); }
__device__ __forceinline__ void s5_scan_phase(Frame& F, int l) {
    LAS float* EX = (LAS float*)F.lds;
    for (int item = F.bid; item < 256; item += F.G) {
        const int cid = item * 16 + (F.tid & 15), j = F.tid >> 4;
        const int g = cid >> 7, d = (cid >> 6) & 1, p = cid & 63;
        const float* A16 = (const float*)(F.ws + WS_A16) + ((size_t)((l * 32 + g) * 2 + d) * 64 + p) * 2; const float ar = A16[0], ai = A16[1];
        const bf16* Z = (const bf16*)(F.ws + WS_Z) + (size_t)g * 256 + d * 128 + 2 * p; bf16* SS = (bf16*)(F.ws + WS_SS) + (size_t)g * 256 + d * 128 + 2 * p;
        float2 z[33];
#pragma unroll
        for (int q = 0; q < 33; ++q) { const int i = 33 * j + q; if (i < NSB) { const unsigned zw = *(const unsigned*)(Z + (size_t)s5_chain_sb(d, i) * 8192); z[q] = make_float2(bflo(zw), bfhi(zw)); } else z[q] = make_float2(0.f, 0.f); }
        float hr = 0.f, hi = 0.f, pr = 1.f, pi = 0.f;
#pragma unroll
        for (int q = 0; q < 33; ++q) { if (33 * j + q < NSB) { const float nr = ar * hr - ai * hi + z[q].x, ni = ar * hi + ai * hr + z[q].y; hr = nr; hi = ni; const float qr = pr * ar - pi * ai, qi = pr * ai + pi * ar; pr = qr; pi = qi; } }
        __syncthreads();
        EX[(j * 16 + (F.tid & 15)) * 4 + 0] = hr; EX[(j * 16 + (F.tid & 15)) * 4 + 1] = hi; EX[(j * 16 + (F.tid & 15)) * 4 + 2] = pr; EX[(j * 16 + (F.tid & 15)) * 4 + 3] = pi;
        __syncthreads();
        float cr = 0.f, ci = 0.f;
        for (int i = 0; i < j; ++i) { const float er = EX[(i * 16 + (F.tid & 15)) * 4 + 0], ei = EX[(i * 16 + (F.tid & 15)) * 4 + 1], qr = EX[(i * 16 + (F.tid & 15)) * 4 + 2], qi = EX[(i * 16 + (F.tid & 15)) * 4 + 3];
            const float nr = qr * cr - qi * ci + er, ni = qr * ci + qi * cr + ei; cr = nr; ci = ni; }
        hr = cr; hi = ci;
#pragma unroll
        for (int q = 0; q < 33; ++q) { const int i = 33 * j + q; if (i < NSB) { *(unsigned*)(SS + (size_t)s5_chain_sb(d, i) * 8192) = pk2(hr, hi);
            const float nr = ar * hr - ai * hi + z[q].x, ni = ar * hi + ai * hr + z[q].y; hr = nr; hi = ni; } }
    }
}
__device__ __forceinline__ void s5_y_phase(Frame& F, int l) {
    const bf16* PROJ = (const bf16*)(F.ws + WS_PROJ); const bf16* SS = (const bf16*)(F.ws + WS_SS); bf16* YG = (bf16*)(F.ws + WS_YG); const float* ds = IN_(I_DSKIP) + l * MIXW;
    const int l15 = F.lane & 15, lq = F.lane >> 4;
    for (int item = F.bid; item < 256; item += F.G) {
        const int g = item >> 3, part = item & 7; const bf16* Tm = (const bf16*)(F.ws + WS_S5M) + ((size_t)(l * 32 + g) * 3 + 1) * 65536; const bf16* Em = Tm + 65536;
        bf16x8 At[2][8], Ae[2][8];
#pragma unroll
        for (int j = 0; j < 2; ++j)
#pragma unroll
            for (int ks = 0; ks < 8; ++ks) { const size_t o = (size_t)(16 * (2 * F.wave + j) + l15) * 256 + 32 * ks + 8 * lq; At[j][ks] = *(const bf16x8*)(Tm + o); Ae[j][ks] = *(const bf16x8*)(Em + o); }
        const f32x4 dsk = *(const f32x4*)(ds + 16 * g + 4 * lq);
        const int ntl = l == 0 ? MT / 256 : SEQ / 256;
        const bf16* vsrc = PROJ + (size_t)(16 * l15 + 2 * F.wave + (lq >> 1)) * INW + 16 * g + 8 * (lq & 1);
        const bf16* ssrc = SS + ((size_t)l15 * 32 + g) * 256 + 32 * F.wave + 8 * lq;
        __syncthreads();
        bf16x8 nv = *(const bf16x8*)(vsrc + (size_t)part * 256 * INW), ns = *(const bf16x8*)(ssrc + (size_t)part * 16 * 8192);
        *(LAS bf16x8*)(F.lds + (F.wave * 64 + F.lane) * 16) = nv; *(LAS bf16x8*)(F.lds + 8192 + (F.wave * 64 + F.lane) * 16) = ns;
        __syncthreads();
        int cur = 0;
#pragma unroll 1
        for (int tl = part; tl < ntl; tl += 8) {
            const bool more = tl + 8 < ntl;
            if (more) { nv = *(const bf16x8*)(vsrc + (size_t)(tl + 8) * 256 * INW); ns = *(const bf16x8*)(ssrc + (size_t)(tl + 8) * 16 * 8192); }
            v2u uu[2];
#pragma unroll
            for (int j = 0; j < 2; ++j) uu[j] = *(const v2u*)(PROJ + ((size_t)tl * 256 + 16 * l15 + (2 * F.wave + j)) * INW + 16 * g + 4 * lq);
            f32x4 acc[2] = {{0.f, 0.f, 0.f, 0.f}, {0.f, 0.f, 0.f, 0.f}};
#pragma unroll
            for (int ks = 0; ks < 8; ++ks) { const bf16x8 V = *(const LAS bf16x8*)(F.lds + cur * 16384 + (ks * 64 + F.lane) * 16), S = *(const LAS bf16x8*)(F.lds + cur * 16384 + 8192 + (ks * 64 + F.lane) * 16);
#pragma unroll
                for (int j = 0; j < 2; ++j) { acc[j] = __builtin_amdgcn_mfma_f32_16x16x32_bf16(At[j][ks], V, acc[j], 0, 0, 0); acc[j] = __builtin_amdgcn_mfma_f32_16x16x32_bf16(Ae[j][ks], S, acc[j], 0, 0, 0); } }
#pragma unroll
            for (int j = 0; j < 2; ++j) { const size_t row = (size_t)tl * 256 + 16 * l15 + (2 * F.wave + j); const int ch = 16 * g + 4 * lq; const v2u u = uu[j];
                const float y0 = acc[j][0] + dsk[0] * bflo(u.x), y1 = acc[j][1] + dsk[1] * bfhi(u.x), y2 = acc[j][2] + dsk[2] * bflo(u.y), y3 = acc[j][3] + dsk[3] * bfhi(u.y);
                v2u w; w.x = cvtpk(geluf_(y0), geluf_(y1)); w.y = cvtpk(geluf_(y2), geluf_(y3)); *(v2u*)(YG + row * MIXW + ch) = w; }
            if (more) { *(LAS bf16x8*)(F.lds + (cur ^ 1) * 16384 + (F.wave * 64 + F.lane) * 16) = nv; *(LAS bf16x8*)(F.lds + (cur ^ 1) * 16384 + 8192 + (F.wave * 64 + F.lane) * 16) = ns; }
            __syncthreads();
            cur ^= 1;
        }
    }
}
constexpr int SG_STRIDE = 272, SG_IMG = 256 * SG_STRIDE, SG_STAT = SG_IMG;
__device__ __forceinline__ void sg_fast_chunk(Frame& F, int l, int chunk) {
    const bf16* PROJ = (const bf16*)(F.ws + WS_PROJ); bf16* YB = (bf16*)(F.ws + WS_YS) + (size_t)MT * MIXW; const bf16* WSG = (const bf16*)(F.ws + WS_WSG);
    const float* lg = IN_(I_SGG) + l * MIXW; const float* lb = IN_(I_SGB) + l * MIXW; const float* bsg = IN_(I_BSG) + l * 512;
    LAS float* st = (LAS float*)(F.lds + SG_STAT);
    __syncthreads();
    {
        const int p = F.tid >> 2, part = F.tid & 3; const bf16* vr = PROJ + (size_t)(chunk * 128 + p) * INW + 1024 + part * 128; float s = 0.f, q = 0.f;
#pragma unroll 4
        for (int c = 0; c < 128; c += 8) { const v4u w = *(const v4u*)(vr + c); const float x[8] = {bflo(w.x), bfhi(w.x), bflo(w.y), bfhi(w.y), bflo(w.z), bfhi(w.z), bflo(w.w), bfhi(w.w)};
#pragma unroll
            for (int i = 0; i < 8; ++i) { s += x[i]; q += x[i] * x[i]; } }
        s += shflx(s, 1, F.lane); q += shflx(q, 1, F.lane); s += shflx(s, 2, F.lane); q += shflx(q, 2, F.lane);
        const float mu = s * (1.f / 512.f), var = fmaxf(q * (1.f / 512.f) - mu * mu, 0.f);
        if (part == 0) { st[p * 2] = mu; st[p * 2 + 1] = rsqrtf(var + EPS); }
    }
    const int l15 = F.lane & 15, lq = F.lane >> 4;
#pragma unroll 1
    for (int pass = 0; pass < 2; ++pass) {
        __syncthreads();
#pragma unroll 1
        for (int it = F.tid; it < 2048; it += NT) { const int tp = it & 63, cg = it >> 6; const int p0 = tp * 2, ch = pass * 256 + cg * 8;
            const v4u w0 = *(const v4u*)(PROJ + (size_t)(chunk * 128 + p0) * INW + 1024 + ch), w1 = *(const v4u*)(PROJ + (size_t)(chunk * 128 + p0 + 1) * INW + 1024 + ch);
            const float mu0 = st[p0 * 2], rs0 = st[p0 * 2 + 1], mu1 = st[p0 * 2 + 2], rs1 = st[p0 * 2 + 3];
            const float x0[8] = {bflo(w0.x), bfhi(w0.x), bflo(w0.y), bfhi(w0.y), bflo(w0.z), bfhi(w0.z), bflo(w0.w), bfhi(w0.w)};
            const float x1[8] = {bflo(w1.x), bfhi(w1.x), bflo(w1.y), bfhi(w1.y), bflo(w1.z), bfhi(w1.z), bflo(w1.w), bfhi(w1.w)};
#pragma unroll
            for (int i = 0; i < 8; ++i) { const float gm = lg[ch + i], bt = lb[ch + i];
                *(LAS unsigned*)(F.lds + (cg * 8 + i) * SG_STRIDE + p0 * 2) = pk2((x0[i] - mu0) * rs0 * gm + bt, (x1[i] - mu1) * rs1 * gm + bt); } }
        __syncthreads();
        const int ggl = F.wave >> 2, gg = pass * 2 + ggl, rb0 = (F.wave & 3) * 2;
        bf16x8 A[2][4];
#pragma unroll
        for (int j = 0; j < 2; ++j)
#pragma unroll
            for (int ks = 0; ks < 4; ++ks) A[j][ks] = *(const LAS bf16x8*)(F.lds + (ggl * 128 + (rb0 + j) * 16 + l15) * SG_STRIDE + (32 * ks + 8 * lq) * 2);
        f32x4 acc[2][8];
#pragma unroll
        for (int j = 0; j < 2; ++j)
#pragma unroll
            for (int cb = 0; cb < 8; ++cb) acc[j][cb] = (f32x4){0.f, 0.f, 0.f, 0.f};
#pragma unroll
        for (int cb0 = 0; cb0 < 8; cb0 += 4) {
            bf16x8 B[4][4];
#pragma unroll
            for (int c2 = 0; c2 < 4; ++c2)
#pragma unroll
                for (int ks = 0; ks < 4; ++ks) B[c2][ks] = *(const bf16x8*)(WSG + ((size_t)gg * 128 + (cb0 + c2) * 16 + l15) * 128 + 32 * ks + 8 * lq);
#pragma unroll
            for (int c2 = 0; c2 < 4; ++c2)
#pragma unroll
                for (int ks = 0; ks < 4; ++ks)
#pragma unroll
                    for (int j = 0; j < 2; ++j) acc[j][cb0 + c2] = __builtin_amdgcn_mfma_f32_16x16x32_bf16(A[j][ks], B[c2][ks], acc[j][cb0 + c2], 0, 0, 0);
        }
#pragma unroll
        for (int cb = 0; cb < 8; ++cb) { const int q = cb * 16 + l15; const size_t row = (size_t)chunk * 128 + q; const float bq = bsg[gg * 128 + q];
#pragma unroll
            for (int j = 0; j < 2; ++j) { const int col = gg * 128 + (rb0 + j) * 16 + 4 * lq; const v2u gu = *(const v2u*)(PROJ + row * INW + 512 + col);
                v2u w; w.x = cvtpk(bflo(gu.x) * (acc[j][cb][0] + bq), bfhi(gu.x) * (acc[j][cb][1] + bq)); w.y = cvtpk(bflo(gu.y) * (acc[j][cb][2] + bq), bfhi(gu.y) * (acc[j][cb][3] + bq));
                *(v2u*)(YB + row * MIXW + col) = w; } }
    }
}


__device__ __forceinline__ void thin_acc(f32x4 (&acc)[2], const bf16* A, int lda, const bf16* Bt, int K, int wave, int lane) {
    const int r = lane & 15, q = lane >> 4; const bf16* a0 = A + (size_t)(32 * wave + r) * lda + 8 * q; const bf16* a1 = a0 + (size_t)16 * lda; const bf16* b = Bt + (size_t)r * K + 8 * q;
#pragma unroll 1
    for (int k0 = 0; k0 < K / 32; k0 += 8) {
        bf16x8 x0[8], x1[8], w[8];
#pragma unroll
        for (int j = 0; j < 8; ++j) { x0[j] = *(const bf16x8*)(a0 + 32 * (k0 + j)); x1[j] = *(const bf16x8*)(a1 + 32 * (k0 + j)); w[j] = *(const bf16x8*)(b + 32 * (k0 + j)); }
#pragma unroll
        for (int j = 0; j < 8; ++j) { acc[0] = __builtin_amdgcn_mfma_f32_16x16x32_bf16(x0[j], w[j], acc[0], 0, 0, 0); acc[1] = __builtin_amdgcn_mfma_f32_16x16x32_bf16(x1[j], w[j], acc[1], 0, 0, 0); }
    }
}
#define THIN_FOREACH(acc, body) _Pragma("unroll") for (int _j = 0; _j < 2; ++_j) _Pragma("unroll") for (int _i = 0; _i < 4; ++_i) { const int crow = 32 * F.wave + 16 * _j + 4 * (F.lane >> 4) + _i; const float v = acc[_j][_i]; body }
__device__ __forceinline__ void ph2_ctx(Frame& F, int ncols) {
    const bf16* Hc = (const bf16*)(F.ws + WS_H) + (size_t)SEQ * D; bf16* P = (bf16*)(F.ws + WS_PROJ) + (size_t)SEQ * INW; const bf16* W = (const bf16*)(F.ws + WS_WIN);
    for (int it = F.bid; it < ncols / 16; it += F.G) { const int col = it * 16 + (F.lane & 15); f32x4 acc[2] = {{0.f, 0.f, 0.f, 0.f}, {0.f, 0.f, 0.f, 0.f}};
        thin_acc(acc, Hc, D, W + (size_t)it * 16 * D, D, F.wave, F.lane);
        THIN_FOREACH(acc, { const float o = (col >= 512 && col < 1536) ? geluf_(v) : v; P[(size_t)crow * INW + col] = (bf16)f2bf(o); }) }
}
__device__ __forceinline__ void ph6_ctx(Frame& F) {
    const bf16* YGc = (const bf16*)(F.ws + WS_YG) + (size_t)SEQ * MIXW; bf16* YA = (bf16*)(F.ws + WS_YS) + (size_t)SEQ * MIXW; const bf16* W = (const bf16*)(F.ws + WS_WGLU);
    for (int it = F.bid; it < MIXW / 16; it += F.G) { const int col = it * 16 + (F.lane & 15); f32x4 acc[2] = {{0.f, 0.f, 0.f, 0.f}, {0.f, 0.f, 0.f, 0.f}};
        thin_acc(acc, YGc, MIXW, W + (size_t)it * 16 * MIXW, MIXW, F.wave, F.lane);
        float yv[2][4];
#pragma unroll
        for (int j = 0; j < 2; ++j)
#pragma unroll
            for (int i = 0; i < 4; ++i) yv[j][i] = bf2f(YGc[(size_t)(32 * F.wave + 16 * j + 4 * (F.lane >> 4) + i) * MIXW + col]);
        asm volatile("" ::: "memory");
        THIN_FOREACH(acc, { YA[(size_t)crow * MIXW + col] = (bf16)f2bf(yv[_j][_i] * sigmoidf_(v)); }) }
}
__device__ __forceinline__ void ph7_ctx(Frame& F) {
    bf16* BR = (bf16*)(F.ws + WS_PROJ) + (size_t)SEQ * INW;
    for (int it = F.bid; it < 3 * (D / 16); it += F.G) { const int kk = it / (D / 16), cb = it % (D / 16); const int col = cb * 16 + (F.lane & 15); f32x4 acc[2] = {{0.f, 0.f, 0.f, 0.f}, {0.f, 0.f, 0.f, 0.f}};
        thin_acc(acc, (const bf16*)(F.ws + WS_YS) + ((size_t)kk * MT + SEQ) * MIXW, MIXW, (const bf16*)(F.ws + WS_WBR) + ((size_t)kk * 1024 + cb * 16) * MIXW, MIXW, F.wave, F.lane);
        THIN_FOREACH(acc, { BR[(size_t)crow * INW + kk * 1024 + col] = (bf16)f2bf(v); }) }
}
__device__ __forceinline__ void ph8_ctx(Frame& F, int l) {
    const bf16* Hc = (const bf16*)(F.ws + WS_H) + (size_t)SEQ * D; const bf16* BR = (const bf16*)(F.ws + WS_PROJ) + (size_t)SEQ * INW; bf16* PMK = (bf16*)(F.ws + WS_Z); const float* bm = IN_(I_BMG) + l * INW;
    for (int it = F.bid; it < 3 * (D / 16); it += F.G) { const int kk = it / (D / 16), cb = it % (D / 16); const int col = cb * 16 + (F.lane & 15); f32x4 acc[2] = {{0.f, 0.f, 0.f, 0.f}, {0.f, 0.f, 0.f, 0.f}};
        thin_acc(acc, Hc, D, (const bf16*)(F.ws + WS_WMG) + ((size_t)kk * 1024 + cb * 16) * D, D, F.wave, F.lane);
        const float bb = bm[kk * 1024 + col];
        float bv[2][4];
#pragma unroll
        for (int j = 0; j < 2; ++j)
#pragma unroll
            for (int i = 0; i < 4; ++i) bv[j][i] = bf2f(BR[(size_t)(32 * F.wave + 16 * j + 4 * (F.lane >> 4) + i) * INW + kk * 1024 + col]);
        asm volatile("" ::: "memory");
        THIN_FOREACH(acc, { PMK[((size_t)kk * CTX + crow) * D + col] = (bf16)f2bf(sigmoidf_(v + bb) * bv[_j][_i]); }) }
}
__device__ __forceinline__ bf16x8 sum3_bf16x8(const bf16* p, size_t stride) {
    const v4u a = *(const v4u*)p, b = *(const v4u*)(p + stride), c = *(const v4u*)(p + 2 * stride); v4u o;
    o.x = pk2(bflo(a.x) + bflo(b.x) + bflo(c.x), bfhi(a.x) + bfhi(b.x) + bfhi(c.x)); o.y = pk2(bflo(a.y) + bflo(b.y) + bflo(c.y), bfhi(a.y) + bfhi(b.y) + bfhi(c.y));
    o.z = pk2(bflo(a.z) + bflo(b.z) + bflo(c.z), bfhi(a.z) + bfhi(b.z) + bfhi(c.z)); o.w = pk2(bflo(a.w) + bflo(b.w) + bflo(c.w), bfhi(a.w) + bfhi(b.w) + bfhi(c.w));
    return __builtin_bit_cast(bf16x8, o);
}
constexpr size_t WS_P9 = WS_Z + (size_t)4 * MiB;
__device__ __forceinline__ void ph9_ctx(Frame& F, int l) {
    const bf16* PMK = (const bf16*)(F.ws + WS_Z); float* P9 = (float*)(F.ws + WS_P9);
    const int r = F.lane & 15, q = F.lane >> 4;
    for (int it = F.bid; it < 4 * (D / 16); it += F.G) { const int kq = it & 3, cb = it >> 2; const int col = cb * 16 + r; f32x4 acc[2] = {{0.f, 0.f, 0.f, 0.f}, {0.f, 0.f, 0.f, 0.f}};
        const bf16* a0 = PMK + (size_t)(32 * F.wave + r) * D + kq * 256 + 8 * q; const bf16* a1 = a0 + (size_t)16 * D; const bf16* b = (const bf16*)(F.ws + WS_WO) + (size_t)(cb * 16 + r) * D + kq * 256 + 8 * q;
#pragma unroll 1
        for (int k0 = 0; k0 < 8; k0 += 4) {
            bf16x8 x0[4], x1[4], w[4];
#pragma unroll
            for (int j = 0; j < 4; ++j) { x0[j] = sum3_bf16x8(a0 + 32 * (k0 + j), (size_t)CTX * D); x1[j] = sum3_bf16x8(a1 + 32 * (k0 + j), (size_t)CTX * D); w[j] = *(const bf16x8*)(b + 32 * (k0 + j)); }
#pragma unroll
            for (int j = 0; j < 4; ++j) { acc[0] = __builtin_amdgcn_mfma_f32_16x16x32_bf16(x0[j], w[j], acc[0], 0, 0, 0); acc[1] = __builtin_amdgcn_mfma_f32_16x16x32_bf16(x1[j], w[j], acc[1], 0, 0, 0); }
        }
        THIN_FOREACH(acc, { P9[((size_t)kq * CTX + crow) * D + col] = v; }) }
}
__device__ __forceinline__ void ctx_x1_fixup(Frame& F, int l, int row0) {
    const float* P9 = (const float*)(F.ws + WS_P9); float* XC = (float*)(F.ws + WS_XC); const float* xs = l == 0 ? IN_(I_CTX) : (const float*)(F.ws + WS_XC);
    const float* ga = (const float*)(F.ws + WS_MOD) + (size_t)(l * 2 + 1) * 6144 + 2048;
    for (int i = F.tid; i < 16 * (D / 4); i += NT) { const int rr = row0 + i / (D / 4), c = (i % (D / 4)) * 4; const size_t o = (size_t)rr * D + c;
        const f32x4 p0 = *(const f32x4*)(P9 + o), p1 = *(const f32x4*)(P9 + (size_t)CTX * D + o), p2 = *(const f32x4*)(P9 + (size_t)2 * CTX * D + o), p3 = *(const f32x4*)(P9 + (size_t)3 * CTX * D + o);
        const f32x4 x = *(const f32x4*)(xs + o), g = *(const f32x4*)(ga + c);
        *(f32x4*)(XC + o) = x + g * (((p0 + p1) + p2) + p3); }
    asm volatile("s_waitcnt vmcnt(0)" ::: "memory");
    __syncthreads();
    { float* RSS = (float*)(F.ws + WS_RSS); const int rr = row0 + (F.tid >> 5), part = F.tid & 31; const float* xr = XC + (size_t)rr * D + part * 32; float s = 0.f;
#pragma unroll
      for (int c = 0; c < 32; c += 4) { const f32x4 v = *(const f32x4*)(xr + c); s += v.x * v.x + v.y * v.y + v.z * v.z + v.w * v.w; }
      s += shflx(s, 1, F.lane); s += shflx(s, 2, F.lane); s += shflx(s, 4, F.lane); s += shflx(s, 8, F.lane); s += shflx(s, 16, F.lane);
      if (part < 16) RSS[(size_t)(SEQ + rr) * 16 + part] = part == 0 ? s : 0.f; }
    asm volatile("s_waitcnt vmcnt(0)" ::: "memory");
    __syncthreads();
}

struct NSmem { float As[16][68]; float Bs[16][68]; };
template <class AF>
__device__ __forceinline__ void ngemm_acc(float (&acc)[4][4], const AF& af, const float* B, int ldb, int K, LAS NSmem* s, int t) {
    const int ty = t >> 4, tx = t & 15, lr = t >> 2, lk = (t & 3) * 4, bk = t >> 4, bn = (t & 15) * 4;
    for (int k0 = 0; k0 < K; k0 += 16) {
        const float4 av = af.load4(lr, k0 + lk);
        const float4 bv = *(const float4*)(B + (size_t)(k0 + bk) * ldb + bn);
        __syncthreads();
        s->As[lk + 0][lr] = av.x; s->As[lk + 1][lr] = av.y; s->As[lk + 2][lr] = av.z; s->As[lk + 3][lr] = av.w;
        *(LAS f32x4*)&s->Bs[bk][bn] = (f32x4){bv.x, bv.y, bv.z, bv.w};
        __syncthreads();
#pragma unroll
        for (int k = 0; k < 16; ++k) {
            const f32x4 a = *(const LAS f32x4*)&s->As[k][ty * 4]; const f32x4 b = *(const LAS f32x4*)&s->Bs[k][tx * 4];
            const float aa[4] = {a.x, a.y, a.z, a.w}, bb[4] = {b.x, b.y, b.z, b.w};
#pragma unroll
            for (int i = 0; i < 4; ++i)
#pragma unroll
                for (int j = 0; j < 4; ++j) acc[i][j] += aa[i] * bb[j];
        }
    }
}
struct ABf { const bf16* A; int lda; __device__ __forceinline__ float4 load4(int r, int k) const { const v2u w = *(const v2u*)(A + (size_t)r * lda + k);
    return make_float4(bf2f((unsigned short)(w.x & 0xffff)), bf2f((unsigned short)(w.x >> 16)), bf2f((unsigned short)(w.y & 0xffff)), bf2f((unsigned short)(w.y >> 16))); } };
#define NTILE_BEGIN(ntiles) { const int _half = F.tid >> 8, t = F.tid & 255, ty = t >> 4, tx = t & 15; LAS NSmem* sm = (LAS NSmem*)F.lds + _half; (void)ty; (void)tx; \
    const int _nt = (ntiles), _nit = (_nt + 2 * F.G - 1) / (2 * F.G); \
    for (int _it = 0; _it < _nit; ++_it) { int T = (_it * F.G + F.bid) * 2 + _half; const bool valid = T < _nt; if (!valid) T = _nt - 1;
#define NTILE_END } }

__device__ __forceinline__ void ph0_prologue(Frame& F) {
    float* mod = (float*)(F.ws + WS_MOD);
    LAS float* SV = (LAS float*)(F.lds + 131072 + 4096);
    for (int i = F.tid; i < 2048; i += NT) SV[i] = siluf_(i < 1024 ? IN_(I_C)[i] : IN_(I_CCTX)[i - 1024]);
    __syncthreads();
    LAS float* RED = (LAS float*)(F.lds + 131072 + 4096 + 8192);
    for (int it = F.bid; it < 2 * 96; it += F.G) { const int l = it / 96, j = (it % 96) * 64 + F.lane;
        const float* W = IN_(I_WADA) + (size_t)l * D * 6144 + j + (size_t)(F.wave * 128) * 6144;
        float a0 = 0.f, a1 = 0.f;
#pragma unroll 32
        for (int kk = 0; kk < 128; ++kk) { const float w = W[(size_t)kk * 6144]; a0 += SV[F.wave * 128 + kk] * w; a1 += SV[1024 + F.wave * 128 + kk] * w; }
        __syncthreads();
        RED[(F.wave * 2 + 0) * 64 + F.lane] = a0; RED[(F.wave * 2 + 1) * 64 + F.lane] = a1;
        __syncthreads();
        if (F.wave < 2) { float s = 0.f;
#pragma unroll
            for (int w8 = 0; w8 < 8; ++w8) s += RED[(w8 * 2 + F.wave) * 64 + F.lane];
            mod[(size_t)(l * 2 + F.wave) * 6144 + j] = s + IN_(I_BADA)[l * 6144 + j]; }
    }
}
__device__ __forceinline__ void stage_mod(Frame& F, const float* g, int l, int sh_off, int sc_off, LAS float* GC, LAS float* SH) {
    __syncthreads();
    for (int i = F.tid; i < 2048; i += NT) { const int w = i >> 10, c = i & 1023; const float* m = (const float*)(F.ws + WS_MOD) + (size_t)(l * 2 + w) * 6144; GC[i] = g[c] * (1.f + m[sc_off + c]); SH[i] = m[sh_off + c]; }
    __syncthreads();
}
__device__ __forceinline__ void hprep_rows(Frame& F, int l) {
    bf16* H = (bf16*)(F.ws + WS_H); LAS float* GC = (LAS float*)F.lds; LAS float* SH = GC + 2048;
    stage_mod(F, IN_(I_GMIX) + l * D, l, 0, 1024, GC, SH);
    const int gw = F.bid * (NT / 64) + F.wave, ngw = F.G * (NT / 64);
    for (int row = gw; row < MT; row += ngw) {
        const float* xr = xsrc_row(F, l, row); const int pv = row >= SEQ ? 1024 : 0;
        f32x4 v[4]; float s = 0.f;
#pragma unroll
        for (int j = 0; j < 4; ++j) { v[j] = *(const f32x4*)(xr + 4 * F.lane + 256 * j); s += v[j].x * v[j].x + v[j].y * v[j].y + v[j].z * v[j].z + v[j].w * v[j].w; }
        const float rstd = rsqrtf(wave_sum(s, F.lane) * (1.f / D) + EPS);
#pragma unroll
        for (int j = 0; j < 4; ++j) { const int c = 4 * F.lane + 256 * j; const f32x4 gc = *(const LAS f32x4*)(GC + pv + c), sh = *(const LAS f32x4*)(SH + pv + c);
            const f32x4 o = v[j] * rstd * gc + sh; v2u w; w.x = pk2(o.x, o.y); w.y = pk2(o.z, o.w); *(v2u*)(H + (size_t)row * D + c) = w; }
    }
}
__device__ __forceinline__ void ph2_naive(Frame& F, int l) {
    const bf16* H = (const bf16*)(F.ws + WS_H); bf16* PROJ = (bf16*)(F.ws + WS_PROJ); const float* W = IN_(I_WIN) + (size_t)l * D * INW;
    NTILE_BEGIN((MT / 64) * (INW / 64))
        const int m0 = (T / (INW / 64)) * 64, n0 = (T % (INW / 64)) * 64;
        float acc[4][4] = {};
        ngemm_acc(acc, ABf{H + (size_t)m0 * D, D}, W + n0, INW, D, sm, t);
        if (valid) {
#pragma unroll
            for (int i = 0; i < 4; ++i) { float o[4];
#pragma unroll
                for (int j = 0; j < 4; ++j) { o[j] = acc[i][j]; if (n0 >= 512 && n0 < 1536) o[j] = geluf_(o[j]); }
                v2u w; w.x = pk2(o[0], o[1]); w.y = pk2(o[2], o[3]); *(v2u*)(PROJ + (size_t)(m0 + ty * 4 + i) * INW + n0 + tx * 4) = w; }
        }
    NTILE_END
}
__device__ __forceinline__ int chain_row(int dir, int pos) { return dir == 0 ? (pos < CTX ? SEQ + pos : pos - CTX) : (pos < CTX ? SEQ + CTX - 1 - pos : SEQ - 1 - (pos - CTX)); }
__device__ __forceinline__ void ph3_s5_naive(Frame& F, int l) {
    LAS float* Cr = (LAS float*)(F.lds + 32768); LAS float* Ci = Cr + 1024; LAS float* Sr = Ci + 1024; LAS float* Si = Sr + 2048;
    const bf16* PROJ = (const bf16*)(F.ws + WS_PROJ); float* YD = (float*)(F.ws + WS_S5);
    for (int item = F.bid; item < 64; item += F.G) {
        if (F.wave == 0) {
            const int g = item >> 1, dir = item & 1, p = F.lane;
            const int ldg = ((l * 2 + dir) * G5 + g);
            const float lr = IN_(I_LRE)[ldg * P5 + p], li = IN_(I_LIM)[ldg * P5 + p], dt = expf(IN_(I_LDT)[ldg]);
            const float er = expf(lr * dt), ar = er * cosf(li * dt), ai = er * sinf(li * dt);
            const float nr = ar - 1.f, ni = ai, den = lr * lr + li * li;
            const float qr = (nr * lr + ni * li) / den, qi = (ni * lr - nr * li) / den;
            float br[16], bi[16];
#pragma unroll
            for (int h = 0; h < 16; ++h) { const float x = IN_(I_BRE)[((size_t)ldg * P5 + p) * H5 + h], y = IN_(I_BIM)[((size_t)ldg * P5 + p) * H5 + h]; br[h] = qr * x - qi * y; bi[h] = qr * y + qi * x; }
            for (int h = 0; h < 16; ++h) { Cr[h * 64 + p] = IN_(I_CRE)[((size_t)ldg * H5 + h) * P5 + p]; Ci[h * 64 + p] = IN_(I_CIM)[((size_t)ldg * H5 + h) * P5 + p]; }
            float sr = 0.f, si = 0.f;
            float* Y = YD + (size_t)dir * MT * MIXW;
#pragma unroll 1
            for (int blk = 0; blk < MT / 32; ++blk) {
#pragma unroll 1
                for (int tt = 0; tt < 32; ++tt) {
                    const int row = chain_row(dir, blk * 32 + tt);
                    const v4u u0 = *(const v4u*)(PROJ + (size_t)row * INW + g * 16), u1 = *(const v4u*)(PROJ + (size_t)row * INW + g * 16 + 8);
                    const unsigned uw[8] = {u0.x, u0.y, u0.z, u0.w, u1.x, u1.y, u1.z, u1.w};
                    float xr = 0.f, xi = 0.f;
#pragma unroll
                    for (int h = 0; h < 8; ++h) { const float ua = bf2f((unsigned short)(uw[h] & 0xffff)), ub = bf2f((unsigned short)(uw[h] >> 16));
                        xr += br[2 * h] * ua + br[2 * h + 1] * ub; xi += bi[2 * h] * ua + bi[2 * h + 1] * ub; }
                    const float nsr = ar * sr - ai * si + xr, nsi = ar * si + ai * sr + xi;
                    sr = nsr; si = nsi; Sr[tt * 64 + p] = sr; Si[tt * 64 + p] = si;
                }
                asm volatile("s_waitcnt lgkmcnt(0)" ::: "memory");
#pragma unroll 1
                for (int o = p; o < 512; o += 64) {
                    const int tt = o >> 4, h = o & 15; float a = 0.f;
#pragma unroll 4
                    for (int q = 0; q < 64; ++q) a += Cr[h * 64 + q] * Sr[tt * 64 + q] - Ci[h * 64 + q] * Si[tt * 64 + q];
                    Y[(size_t)chain_row(dir, blk * 32 + tt) * MIXW + g * 16 + h] = a;
                }
                asm volatile("s_waitcnt lgkmcnt(0)" ::: "memory");
            }
        }
    }
}
__device__ __forceinline__ void ph3_sg_naive(Frame& F, int l) {
    const bf16* PROJ = (const bf16*)(F.ws + WS_PROJ); bf16* YB = (bf16*)(F.ws + WS_YS) + (size_t)MT * MIXW;
    LAS float* stat = (LAS float*)(F.lds + 32768);
    const float* lg = IN_(I_SGG) + l * MIXW; const float* lb = IN_(I_SGB) + l * MIXW;
    NTILE_BEGIN((MT / 128) * 16)
        const int chunk = T >> 4, gg = (T >> 2) & 3, q0 = ((T >> 1) & 1) * 64, c0 = (T & 1) * 64;
        LAS float* st = stat + _half * 256;
        __syncthreads();
        if (t < 128) { const bf16* vr = PROJ + (size_t)(chunk * 128 + t) * INW + 1024; float s = 0.f;
            for (int c = 0; c < 512; c += 2) { const unsigned w = *(const unsigned*)(vr + c); s += bf2f((unsigned short)(w & 0xffff)) + bf2f((unsigned short)(w >> 16)); }
            const float mu = s * (1.f / 512.f); float q = 0.f;
            for (int c = 0; c < 512; c += 2) { const unsigned w = *(const unsigned*)(vr + c); const float a = bf2f((unsigned short)(w & 0xffff)) - mu, b = bf2f((unsigned short)(w >> 16)) - mu; q += a * a + b * b; }
            st[t * 2] = mu; st[t * 2 + 1] = rsqrtf(q * (1.f / 512.f) + EPS); }
        __syncthreads();
        float acc[4][4] = {};
        {
            const float* A = IN_(I_WSG) + ((size_t)(l * 4 + gg) * 128 + q0) * 128;
            const int lr = t >> 2, lk = (t & 3) * 4, bk = t >> 4, bn = (t & 15) * 4;
            for (int k0 = 0; k0 < 128; k0 += 16) {
                const float4 av = *(const float4*)(A + (size_t)lr * 128 + k0 + lk);
                const int p = k0 + bk; const int col = gg * 128 + c0 + bn;
                const v2u w = *(const v2u*)(PROJ + (size_t)(chunk * 128 + p) * INW + 1024 + col);
                const float mu = st[p * 2], rs = st[p * 2 + 1];
                float4 bv; bv.x = (bf2f((unsigned short)(w.x & 0xffff)) - mu) * rs * lg[col] + lb[col]; bv.y = (bf2f((unsigned short)(w.x >> 16)) - mu) * rs * lg[col + 1] + lb[col + 1];
                bv.z = (bf2f((unsigned short)(w.y & 0xffff)) - mu) * rs * lg[col + 2] + lb[col + 2]; bv.w = (bf2f((unsigned short)(w.y >> 16)) - mu) * rs * lg[col + 3] + lb[col + 3];
                __syncthreads();
                sm->As[lk + 0][lr] = av.x; sm->As[lk + 1][lr] = av.y; sm->As[lk + 2][lr] = av.z; sm->As[lk + 3][lr] = av.w;
                *(LAS f32x4*)&sm->Bs[bk][bn] = (f32x4){bv.x, bv.y, bv.z, bv.w};
                __syncthreads();
#pragma unroll
                for (int k = 0; k < 16; ++k) { const f32x4 a = *(const LAS f32x4*)&sm->As[k][ty * 4]; const f32x4 b = *(const LAS f32x4*)&sm->Bs[k][tx * 4];
                    const float aa[4] = {a.x, a.y, a.z, a.w}, bb[4] = {b.x, b.y, b.z, b.w};
#pragma unroll
                    for (int i = 0; i < 4; ++i)
#pragma unroll
                        for (int j = 0; j < 4; ++j) acc[i][j] += aa[i] * bb[j]; }
            }
        }
        if (valid) {
#pragma unroll
            for (int i = 0; i < 4; ++i) { const int q = q0 + ty * 4 + i; const size_t row = (size_t)chunk * 128 + q; const int col = gg * 128 + c0 + tx * 4;
                const float bq = IN_(I_BSG)[l * 512 + gg * 128 + q];
                const v2u gu = *(const v2u*)(PROJ + row * INW + 512 + col);
                v2u w; w.x = pk2(bf2f((unsigned short)(gu.x & 0xffff)) * (acc[i][0] + bq), bf2f((unsigned short)(gu.x >> 16)) * (acc[i][1] + bq));
                w.y = pk2(bf2f((unsigned short)(gu.y & 0xffff)) * (acc[i][2] + bq), bf2f((unsigned short)(gu.y >> 16)) * (acc[i][3] + bq));
                *(v2u*)(YB + row * MIXW + col) = w; }
        }
    NTILE_END
}
__device__ __forceinline__ void ph3_conv(Frame& F, int l, int nrows) {
    const bf16* PROJ = (const bf16*)(F.ws + WS_PROJ); bf16* YC = (bf16*)(F.ws + WS_YS) + (size_t)2 * MT * MIXW; const float* wc = IN_(I_WCONV) + l * 3 * MIXW;
    const size_t gt = (size_t)F.bid * NT + F.tid, ngt = (size_t)F.G * NT;
#pragma unroll 2
    for (size_t i = gt; i < (size_t)nrows * (MIXW / 8); i += ngt) {
        const int row = (int)(i / (MIXW / 8)), c = (int)(i % (MIXW / 8)) * 8;
        int pos, rl; if (row < SEQ) { pos = row & 63; rl = 64; } else { pos = row - SEQ; rl = 256; }
        const bf16* r0 = PROJ + (size_t)row * INW + 1536 + c;
        const v4u zero = {0u, 0u, 0u, 0u};
        const v4u b0 = *(const v4u*)(r0), c0 = *(const v4u*)(r0 + 512), h0 = *(const v4u*)(r0 + 1024);
        const v4u cm = pos > 0 ? *(const v4u*)(r0 - INW + 512) : zero, hm = pos > 0 ? *(const v4u*)(r0 - INW + 1024) : zero;
        const v4u cp = pos < rl - 1 ? *(const v4u*)(r0 + INW + 512) : zero, hp = pos < rl - 1 ? *(const v4u*)(r0 + INW + 1024) : zero;
        const f32x4 w0a = *(const f32x4*)(wc + c), w0b = *(const f32x4*)(wc + c + 4), w1a = *(const f32x4*)(wc + 512 + c), w1b = *(const f32x4*)(wc + 512 + c + 4), w2a = *(const f32x4*)(wc + 1024 + c), w2b = *(const f32x4*)(wc + 1024 + c + 4);
        const float w0[8] = {w0a.x, w0a.y, w0a.z, w0a.w, w0b.x, w0b.y, w0b.z, w0b.w}, w1[8] = {w1a.x, w1a.y, w1a.z, w1a.w, w1b.x, w1b.y, w1b.z, w1b.w}, w2[8] = {w2a.x, w2a.y, w2a.z, w2a.w, w2b.x, w2b.y, w2b.z, w2b.w};
        const unsigned bb[4] = {b0.x, b0.y, b0.z, b0.w}, cc[4] = {c0.x, c0.y, c0.z, c0.w}, hh[4] = {h0.x, h0.y, h0.z, h0.w}, cmv[4] = {cm.x, cm.y, cm.z, cm.w}, hmv[4] = {hm.x, hm.y, hm.z, hm.w}, cpv[4] = {cp.x, cp.y, cp.z, cp.w}, hpv[4] = {hp.x, hp.y, hp.z, hp.w};
        unsigned o[4];
#pragma unroll
        for (int j = 0; j < 4; ++j) {
            const float ylo = bflo(bb[j]) * (w0[2 * j] * (bflo(cmv[j]) * bflo(hmv[j])) + w1[2 * j] * (bflo(cc[j]) * bflo(hh[j])) + w2[2 * j] * (bflo(cpv[j]) * bflo(hpv[j])));
            const float yhi = bfhi(bb[j]) * (w0[2 * j + 1] * (bfhi(cmv[j]) * bfhi(hmv[j])) + w1[2 * j + 1] * (bfhi(cc[j]) * bfhi(hh[j])) + w2[2 * j + 1] * (bfhi(cpv[j]) * bfhi(hpv[j])));
            o[j] = pk2(ylo, yhi); }
        v4u ov; ov.x = o[0]; ov.y = o[1]; ov.z = o[2]; ov.w = o[3]; *(v4u*)(YC + (size_t)row * MIXW + c) = ov;
    }
}
__device__ __forceinline__ void ph5_naive(Frame& F, int l) {
    const bf16* PROJ = (const bf16*)(F.ws + WS_PROJ); const float* YD = (const float*)(F.ws + WS_S5); bf16* YG = (bf16*)(F.ws + WS_YG); const float* ds = IN_(I_DSKIP) + l * MIXW;
    const size_t gt = (size_t)F.bid * NT + F.tid, ngt = (size_t)F.G * NT;
    for (size_t i = gt; i < (size_t)MT * (MIXW / 2); i += ngt) {
        const int row = (int)(i / (MIXW / 2)), c = (int)(i % (MIXW / 2)) * 2;
        const unsigned u = *(const unsigned*)(PROJ + (size_t)row * INW + c); const size_t o = (size_t)row * MIXW + c;
        const float y0 = YD[o] + YD[(size_t)MT * MIXW + o] + ds[c] * bf2f((unsigned short)(u & 0xffff)), y1 = YD[o + 1] + YD[(size_t)MT * MIXW + o + 1] + ds[c + 1] * bf2f((unsigned short)(u >> 16));
        *(unsigned*)(YG + o) = pk2(geluf_(y0), geluf_(y1));
    }
}
__device__ __forceinline__ void ph6_naive(Frame& F, int l) {
    const bf16* YG = (const bf16*)(F.ws + WS_YG); bf16* YA = (bf16*)(F.ws + WS_YS); const float* W = IN_(I_WGLU) + (size_t)l * MIXW * MIXW;
    NTILE_BEGIN((MT / 64) * (MIXW / 64))
        const int m0 = (T / (MIXW / 64)) * 64, n0 = (T % (MIXW / 64)) * 64;
        float acc[4][4] = {};
        ngemm_acc(acc, ABf{YG + (size_t)m0 * MIXW, MIXW}, W + n0, MIXW, MIXW, sm, t);
        if (valid) {
#pragma unroll
            for (int i = 0; i < 4; ++i) { const size_t o = (size_t)(m0 + ty * 4 + i) * MIXW + n0 + tx * 4; const v2u g = *(const v2u*)(YG + o);
                v2u w; w.x = pk2(bf2f((unsigned short)(g.x & 0xffff)) * sigmoidf_(acc[i][0]), bf2f((unsigned short)(g.x >> 16)) * sigmoidf_(acc[i][1]));
                w.y = pk2(bf2f((unsigned short)(g.y & 0xffff)) * sigmoidf_(acc[i][2]), bf2f((unsigned short)(g.y >> 16)) * sigmoidf_(acc[i][3])); *(v2u*)(YA + o) = w; }
        }
    NTILE_END
}
__device__ __forceinline__ void ph7_naive(Frame& F, int l) {
    const bf16* YS = (const bf16*)(F.ws + WS_YS); bf16* BR = (bf16*)(F.ws + WS_PROJ); const float* W = IN_(I_WBR) + (size_t)l * 3 * MIXW * D;
    NTILE_BEGIN((MT / 64) * (INW / 64))
        const int m0 = (T / (INW / 64)) * 64, n0 = (T % (INW / 64)) * 64, k = n0 / 1024, d0 = n0 % 1024;
        float acc[4][4] = {};
        ngemm_acc(acc, ABf{YS + (size_t)k * MT * MIXW + (size_t)m0 * MIXW, MIXW}, W + (size_t)k * MIXW * D + d0, D, MIXW, sm, t);
        if (valid) {
#pragma unroll
            for (int i = 0; i < 4; ++i) { v2u w; w.x = pk2(acc[i][0], acc[i][1]); w.y = pk2(acc[i][2], acc[i][3]); *(v2u*)(BR + (size_t)(m0 + ty * 4 + i) * INW + n0 + tx * 4) = w; }
        }
    NTILE_END
}
__device__ __forceinline__ void ph8_naive(Frame& F, int l) {
    const bf16* H = (const bf16*)(F.ws + WS_H); const bf16* BR = (const bf16*)(F.ws + WS_PROJ); bf16* PM = (bf16*)(F.ws + WS_PM);
    const float* W = IN_(I_WMG) + (size_t)l * D * INW; const float* bm = IN_(I_BMG) + l * INW;
    NTILE_BEGIN((MT / 64) * (D / 64))
        const int m0 = (T / (D / 64)) * 64, n0 = (T % (D / 64)) * 64;
        float out[4][4] = {};
        for (int k = 0; k < 3; ++k) {
            float acc[4][4] = {};
            ngemm_acc(acc, ABf{H + (size_t)m0 * D, D}, W + k * 1024 + n0, INW, D, sm, t);
#pragma unroll
            for (int i = 0; i < 4; ++i) { const v2u b = *(const v2u*)(BR + (size_t)(m0 + ty * 4 + i) * INW + k * 1024 + n0 + tx * 4);
                const float bb[4] = {bf2f((unsigned short)(b.x & 0xffff)), bf2f((unsigned short)(b.x >> 16)), bf2f((unsigned short)(b.y & 0xffff)), bf2f((unsigned short)(b.y >> 16))};
#pragma unroll
                for (int j = 0; j < 4; ++j) out[i][j] += sigmoidf_(acc[i][j] + bm[k * 1024 + n0 + tx * 4 + j]) * bb[j]; }
        }
        if (valid) {
#pragma unroll
            for (int i = 0; i < 4; ++i) { v2u w; w.x = pk2(out[i][0], out[i][1]); w.y = pk2(out[i][2], out[i][3]); *(v2u*)(PM + (size_t)(m0 + ty * 4 + i) * D + n0 + tx * 4) = w; }
        }
    NTILE_END
}
__device__ __forceinline__ void ph9_naive(Frame& F, int l) {
    const bf16* PM = (const bf16*)(F.ws + WS_PM); const float* W = IN_(I_WO) + (size_t)l * D * D;
    NTILE_BEGIN((MT / 64) * (D / 64))
        const int m0 = (T / (D / 64)) * 64, n0 = (T % (D / 64)) * 64;
        float acc[4][4] = {};
        ngemm_acc(acc, ABf{PM + (size_t)m0 * D, D}, W + n0, D, D, sm, t);
        if (valid) {
#pragma unroll
            for (int i = 0; i < 4; ++i) { const int row = m0 + ty * 4 + i, c = n0 + tx * 4; const float* m = mod_ptr(F, l, row) + 2048 + c;
                const f32x4 xs = *(const f32x4*)(xsrc_row(F, l, row) + c);
                f32x4 o; o.x = xs.x + m[0] * acc[i][0]; o.y = xs.y + m[1] * acc[i][1]; o.z = xs.z + m[2] * acc[i][2]; o.w = xs.w + m[3] * acc[i][3];
                *(f32x4*)(xrun_row(F, row) + c) = o; }
        }
    NTILE_END
}
template <int KS>
__device__ __forceinline__ void route_pass(Frame& F, int l, int u, bool valid, int kh, int sl, LAS float* GC, LAS float* SH, LAS float* SSQ, LAS float* LG, LAS int* HISTL) {
    bf16* H = (bf16*)(F.ws + WS_H); const bf16* WRh = (const bf16*)(F.ws + WS_WR); const bf16* WRl = WRh + 48 * 1024;
    const float* bg = IN_(I_BGRP) + l * 4; const float* be = IN_(I_BEXP) + l * 32;
    int* EID = (int*)(F.ws + WS_EID); float* EW = (float*)(F.ws + WS_EW);
    constexpr int NK = 32 / KS, KW = 1024 / KS;
    const int r = F.lane & 15, q = F.lane >> 4;
    const int uu = valid ? u : 0; const int row = uu * 16 + r; const float* xr = xrun_row(F, row) + kh * KW + 8 * q; const int pv = (row >= SEQ ? 1024 : 0) + kh * KW + 8 * q;
    const f32x4 rp = *(const f32x4*)((const float*)(F.ws + WS_RSS) + (size_t)row * 16 + 4 * q);
    float tot = (rp.x + rp.y) + (rp.z + rp.w); tot += shflx(tot, 16, F.lane); tot += shflx(tot, 32, F.lane);
    const float rstd = rsqrtf(tot * (1.f / D) + EPS);
    __syncthreads();
    (void)SSQ;
    f32x4 acc[3] = {{0.f, 0.f, 0.f, 0.f}, {0.f, 0.f, 0.f, 0.f}, {0.f, 0.f, 0.f, 0.f}};
#pragma unroll 1
    for (int k0 = 0; k0 < NK; k0 += 4) {
        f32x4 xa[4][2]; bf16x8 Bh[4][3], Bl[4][3];
#pragma unroll
        for (int j = 0; j < 4; ++j) { const int c = 32 * (k0 + j); xa[j][0] = *(const f32x4*)(xr + c); xa[j][1] = *(const f32x4*)(xr + c + 4);
#pragma unroll
            for (int cb = 0; cb < 3; ++cb) { const size_t wo = (size_t)(cb * 16 + r) * 1024 + kh * KW + c + 8 * q; Bh[j][cb] = *(const bf16x8*)(WRh + wo); Bl[j][cb] = *(const bf16x8*)(WRl + wo); } }
#pragma unroll
        for (int j = 0; j < 4; ++j) { const int c = 32 * (k0 + j);
            const f32x4 g0 = *(const LAS f32x4*)(GC + pv + c), g1 = *(const LAS f32x4*)(GC + pv + c + 4), sh0 = *(const LAS f32x4*)(SH + pv + c), sh1 = *(const LAS f32x4*)(SH + pv + c + 4);
            const f32x4 h0 = xa[j][0] * rstd * g0 + sh0, h1 = xa[j][1] * rstd * g1 + sh1;
            v4u hi; hi.x = pk2(h0.x, h0.y); hi.y = pk2(h0.z, h0.w); hi.z = pk2(h1.x, h1.y); hi.w = pk2(h1.z, h1.w);
            if (valid) *(v4u*)(H + (size_t)row * D + kh * KW + 8 * q + c) = hi;
            v4u lo; lo.x = pk2(h0.x - bflo(hi.x), h0.y - bfhi(hi.x)); lo.y = pk2(h0.z - bflo(hi.y), h0.w - bfhi(hi.y)); lo.z = pk2(h1.x - bflo(hi.z), h1.y - bfhi(hi.z)); lo.w = pk2(h1.z - bflo(hi.w), h1.w - bfhi(hi.w));
            const bf16x8 Ah = __builtin_bit_cast(bf16x8, hi), Al = __builtin_bit_cast(bf16x8, lo);
#pragma unroll
            for (int cb = 0; cb < 3; ++cb) { acc[cb] = __builtin_amdgcn_mfma_f32_16x16x32_bf16(Ah, Bh[j][cb], acc[cb], 0, 0, 0); acc[cb] = __builtin_amdgcn_mfma_f32_16x16x32_bf16(Al, Bh[j][cb], acc[cb], 0, 0, 0); acc[cb] = __builtin_amdgcn_mfma_f32_16x16x32_bf16(Ah, Bl[j][cb], acc[cb], 0, 0, 0); } }
    }
    LAS float* LGw = LG + (sl * KS + kh) * (16 * 52);
#pragma unroll
    for (int cb = 0; cb < 3; ++cb)
#pragma unroll
        for (int i = 0; i < 4; ++i) LGw[(4 * q + i) * 52 + cb * 16 + r] = acc[cb][i];
    __syncthreads();
    if (kh == 0 && valid && F.lane < 16) { const LAS float* L0 = LG + (sl * KS) * (16 * 52) + F.lane * 52; const int rw = u * 16 + F.lane;
        float lg[36];
#pragma unroll
        for (int o = 0; o < 36; ++o) { float t = 0.f;
#pragma unroll
            for (int i = 0; i < KS; ++i) t += L0[i * (16 * 52) + o]; lg[o] = t + (o < 4 ? bg[o] : be[o - 4]); }
        LAS float* LW = LG + (sl * KS) * (16 * 52) + F.lane * 52;
#pragma unroll
        for (int o = 0; o < 36; ++o) LW[o] = lg[o];
        int gi = 0; float gm = lg[0];
#pragma unroll
        for (int o = 1; o < 4; ++o) if (lg[o] > gm) { gm = lg[o]; gi = o; }
        float den = 0.f;
#pragma unroll
        for (int o = 0; o < 4; ++o) den += expf(lg[o] - gm);
        const float gp = 1.f / den;
        const LAS float* el = LW + 4 + gi * 8;
        int i1 = 0; float m1 = el[0]; for (int o = 1; o < 8; ++o) { const float v = el[o]; if (v > m1) { m1 = v; i1 = o; } }
        int i2 = -1; float m2 = 0.f; for (int o = 0; o < 8; ++o) { const float v = el[o]; if (o != i1 && (i2 < 0 || v > m2)) { m2 = v; i2 = o; } }
        const float e2 = expf(m2 - m1); const float w1 = 1.f / (1.f + e2), w2 = e2 / (1.f + e2);
        const int e1i = gi * 8 + i1, e2i = gi * 8 + i2;
        EID[rw * 2] = e1i; EID[rw * 2 + 1] = e2i; EW[rw * 2] = gp * w1; EW[rw * 2 + 1] = gp * w2;
        __hip_atomic_fetch_add(&HISTL[e1i], 1, __ATOMIC_RELAXED, __HIP_MEMORY_SCOPE_WORKGROUP); __hip_atomic_fetch_add(&HISTL[e2i], 1, __ATOMIC_RELAXED, __HIP_MEMORY_SCOPE_WORKGROUP);
    }
}
__device__ __forceinline__ void ph10_route(Frame& F, int l) {
    const float* g = IN_(I_GFFN) + l * D;
    LAS float* GC = (LAS float*)F.lds;
    LAS float* SH = GC + 2048;
    LAS float* SSQ = SH + 2048;
    LAS float* LG = SSQ + 128;
    LAS int* HISTL = (LAS int*)(LG + 8 * 16 * 52);
    __syncthreads();
    if (F.tid < 32) HISTL[F.tid] = 0;
    for (int i = F.tid; i < 2048; i += NT) { const int w = i >> 10, c = i & 1023; const float* m = (const float*)(F.ws + WS_MOD) + (size_t)(l * 2 + w) * 6144; GC[i] = g[c] * (1.f + m[4096 + c]); SH[i] = m[3072 + c]; }
#pragma unroll 1
    for (int u0 = F.bid; u0 < SEQ / 16; u0 += 4 * F.G) { const int u = u0 + (F.wave >> 1) * F.G; route_pass<2>(F, l, u, u < SEQ / 16, F.wave & 1, F.wave >> 1, GC, SH, SSQ, LG, HISTL); }
    if (l == 0) {
#pragma unroll 1
        for (int u0 = SEQ / 16 + F.bid; u0 < MT / 16; u0 += F.G) { ctx_x1_fixup(F, l, (u0 - SEQ / 16) * 16); route_pass<8>(F, l, u0, true, F.wave, 0, GC, SH, SSQ, LG, HISTL); }
    }
    __syncthreads();
    if (F.tid < 32) ((int*)(F.ws + WS_HISTG))[F.bid * 32 + F.tid] = HISTL[F.tid];
}
__device__ __forceinline__ int expert_off(const unsigned* cnt, int e) { int o = 0; for (int i = 0; i < e; ++i) o += ((int)cnt[i] + 255) & ~255; return o; }
__device__ __forceinline__ void ph11_scatter(Frame& F, int l) {
    const bf16* H = (const bf16*)(F.ws + WS_H); bf16* HS = (bf16*)(F.ws + WS_HS);
    const int* EID = (const int*)(F.ws + WS_EID); const float* EW = (const float*)(F.ws + WS_EW); int* STOK = (int*)(F.ws + WS_STOK); float* SW = (float*)(F.ws + WS_SW); int* TSLOT = (int*)(F.ws + WS_TSLOT);
    unsigned* cnt = F.ctl + CW_CNT + l * 128; const int* HISTG = (const int*)(F.ws + WS_HISTG);
    LAS int* HIST = (LAS int*)F.lds; LAS int* BASE = HIST + 32; LAS int* ISLOT = BASE + 32; LAS int* IROW = ISLOT + 512; LAS int* PT = IROW + 512; LAS int* PB = PT + 512;
    const int nunits = (l == 0 ? MT : SEQ) / 16;
    __syncthreads();
    { const int e = F.tid & 31, ch = F.tid >> 5; int tot = 0, bas = 0;
      for (int b = ch; b < F.G; b += 16) { const int h = HISTG[b * 32 + e]; tot += h; if (b < F.bid) bas += h; }
      PT[F.tid] = tot; PB[F.tid] = bas; }
    __syncthreads();
    if (F.tid < 32) { int tot = 0, bas = 0; for (int ch = 0; ch < 16; ++ch) { tot += PT[ch * 32 + F.tid]; bas += PB[ch * 32 + F.tid]; } HIST[F.tid] = 0; PT[F.tid] = tot; PB[F.tid] = bas; if (F.bid == 0) cnt[F.tid] = (unsigned)tot; }
    __syncthreads();
    if (F.tid < 32) { int off = 0; for (int i = 0; i < F.tid; ++i) off += (PT[i] + 255) & ~255; BASE[F.tid] = off + PB[F.tid]; }
    __syncthreads();
    const int w = F.tid >> 5; int u = F.bid + w * F.G; bool valid = u < SEQ / 16;
    if (w == 15) { u = SEQ / 16 + F.bid; valid = u < nunits; }
    const int row = u * 16 + ((F.tid >> 1) & 15), kk = F.tid & 1;
    int e = 0, rank = 0; if (valid) { e = EID[row * 2 + kk]; rank = __hip_atomic_fetch_add(&HIST[e], 1, __ATOMIC_RELAXED, __HIP_MEMORY_SCOPE_WORKGROUP); }
    __syncthreads();
    int slot = -1; if (valid) { slot = BASE[e] + rank; STOK[slot] = row; SW[slot] = EW[row * 2 + kk]; TSLOT[row * 2 + kk] = slot; }
    ISLOT[F.tid] = slot; IROW[F.tid] = row;
    __syncthreads();
#pragma unroll 1
    for (int it0 = F.wave; it0 < NT; it0 += 4 * (NT / 64)) {
        v4u va[4], vb[4]; int sl[4];
#pragma unroll
        for (int j = 0; j < 4; ++j) { const int it = it0 + j * (NT / 64); sl[j] = it < NT ? ISLOT[it] : -1; const int rw = sl[j] >= 0 ? IROW[it] : 0; const v4u* src = (const v4u*)(H + (size_t)rw * D); va[j] = src[F.lane]; vb[j] = src[F.lane + 64]; }
#pragma unroll
        for (int j = 0; j < 4; ++j) if (sl[j] >= 0) { v4u* dst = (v4u*)(HS + (size_t)sl[j] * D); dst[F.lane] = va[j]; dst[F.lane + 64] = vb[j]; }
    }
}
__device__ __forceinline__ int slot_expert(const unsigned* cnt, int slot0, int& seg_off, int& n_e) { int o = 0; for (int e = 0; e < NE; ++e) { const int n = (int)cnt[e], pn = (n + 255) & ~255; if (slot0 < o + pn) { seg_off = o; n_e = n; return e; } o += pn; } seg_off = o; n_e = 0; return 0; }
__device__ __forceinline__ void ph12_naive(Frame& F, int l) {
    const bf16* HS = (const bf16*)(F.ws + WS_HS); bf16* ACT = (bf16*)(F.ws + WS_ACT); const float* SW = (const float*)(F.ws + WS_SW);
    const unsigned* cnt = F.ctl + CW_CNT + l * 128; const int total = expert_off(cnt, NE);
    NTILE_BEGIN((total / 64) * (DFF / 64))
        const int s0 = (T / (DFF / 64)) * 64, n0 = (T % (DFF / 64)) * 64; int seg, n_e; const int e = slot_expert(cnt, s0, seg, n_e);
        float aa[4][4] = {}, ab[4][4] = {};
        ngemm_acc(aa, ABf{HS + (size_t)s0 * D, D}, IN_(I_W1) + ((size_t)l * NE + e) * D * DFF + n0, DFF, D, sm, t);
        ngemm_acc(ab, ABf{HS + (size_t)s0 * D, D}, IN_(I_W3) + ((size_t)l * NE + e) * D * DFF + n0, DFF, D, sm, t);
        if (valid) {
#pragma unroll
            for (int i = 0; i < 4; ++i) { const int slot = s0 + ty * 4 + i; if (slot - seg < n_e) { const float w = SW[slot];
                v2u o; o.x = pk2(siluf_(aa[i][0]) * ab[i][0] * w, siluf_(aa[i][1]) * ab[i][1] * w); o.y = pk2(siluf_(aa[i][2]) * ab[i][2] * w, siluf_(aa[i][3]) * ab[i][3] * w);
                *(v2u*)(ACT + (size_t)slot * DFF + n0 + tx * 4) = o; } }
        }
    NTILE_END
}
__device__ __forceinline__ void ph13_naive(Frame& F, int l) {
    const bf16* ACT = (const bf16*)(F.ws + WS_ACT); bf16* YS2 = (bf16*)(F.ws + WS_YS2);
    const unsigned* cnt = F.ctl + CW_CNT + l * 128; const int total = expert_off(cnt, NE);
    NTILE_BEGIN((total / 64) * (D / 64))
        const int s0 = (T / (D / 64)) * 64, n0 = (T % (D / 64)) * 64; int seg, n_e; const int e = slot_expert(cnt, s0, seg, n_e);
        float acc[4][4] = {};
        ngemm_acc(acc, ABf{ACT + (size_t)s0 * DFF, DFF}, IN_(I_W2) + ((size_t)l * NE + e) * DFF * D + n0, D, DFF, sm, t);
        if (valid) {
#pragma unroll
            for (int i = 0; i < 4; ++i) { const int slot = s0 + ty * 4 + i; if (slot - seg < n_e) { v2u o; o.x = pk2(acc[i][0], acc[i][1]); o.y = pk2(acc[i][2], acc[i][3]); *(v2u*)(YS2 + (size_t)slot * D + n0 + tx * 4) = o; } }
        }
    NTILE_END
}
__device__ __forceinline__ void ph14_combine(Frame& F, int l) {
    const bf16* YS2 = (const bf16*)(F.ws + WS_YS2); const int* TSLOT = (const int*)(F.ws + WS_TSLOT); bf16* H = (bf16*)(F.ws + WS_H);
    LAS float* GC = (LAS float*)F.lds; LAS float* SH = GC + 2048; LAS float* GA = SH + 2048;
    if (l == 0) stage_mod(F, IN_(I_GMIX) + D, 1, 0, 1024, GC, SH); else { __syncthreads(); for (int i = F.tid; i < 1024; i += NT) GC[i] = IN_(I_GF)[i]; }
    for (int i = F.tid; i < 2048; i += NT) GA[i] = ((const float*)(F.ws + WS_MOD))[(size_t)(l * 2 + (i >> 10)) * 6144 + 5120 + (i & 1023)];
    __syncthreads();
    const int gw = F.bid * (NT / 64) + F.wave, ngw = F.G * (NT / 64);
    const int nrows = l == 0 ? MT : SEQ;
    for (int row0 = gw; row0 < nrows; row0 += 2 * ngw) {
        f32x4 v[2][4]; float s[2] = {0.f, 0.f}; int rows[2]; bool ok[2];
#pragma unroll
        for (int t = 0; t < 2; ++t) { rows[t] = row0 + t * ngw; ok[t] = rows[t] < nrows; if (!ok[t]) rows[t] = row0; }
        int sl[2][2];
#pragma unroll
        for (int t = 0; t < 2; ++t) { sl[t][0] = TSLOT[rows[t] * 2]; sl[t][1] = TSLOT[rows[t] * 2 + 1]; }
#pragma unroll
        for (int t = 0; t < 2; ++t) { const float* xr = xrun_row(F, rows[t]); const int pv = rows[t] >= SEQ ? 1024 : 0;
#pragma unroll
            for (int j = 0; j < 4; ++j) { const int c = 4 * F.lane + 256 * j; const f32x4 x = *(const f32x4*)(xr + c); const f32x4 ga = *(const LAS f32x4*)(GA + pv + c);
                const v2u a = *(const v2u*)(YS2 + (size_t)sl[t][0] * D + c), b = *(const v2u*)(YS2 + (size_t)sl[t][1] * D + c);
                f32x4 y; y.x = bflo(a.x) + bflo(b.x); y.y = bfhi(a.x) + bfhi(b.x); y.z = bflo(a.y) + bflo(b.y); y.w = bfhi(a.y) + bfhi(b.y);
                v[t][j] = x + ga * y; s[t] += v[t][j].x * v[t][j].x + v[t][j].y * v[t][j].y + v[t][j].z * v[t][j].z + v[t][j].w * v[t][j].w; } }
#pragma unroll
        for (int t = 0; t < 2; ++t) { if (!ok[t]) continue;
            const float rstd = rsqrtf(wave_sum(s[t], F.lane) * (1.f / D) + EPS); float* xr = xrun_row(F, rows[t]); const int pv = rows[t] >= SEQ ? 1024 : 0;
            if (l == 0) {
#pragma unroll
                for (int j = 0; j < 4; ++j) { const int c = 4 * F.lane + 256 * j; *(f32x4*)(xr + c) = v[t][j];
                    const f32x4 gc = *(const LAS f32x4*)(GC + pv + c), sh = *(const LAS f32x4*)(SH + pv + c);
                    const f32x4 o = v[t][j] * rstd * gc + sh; v2u w; w.x = pk2(o.x, o.y); w.y = pk2(o.z, o.w); *(v2u*)(H + (size_t)rows[t] * D + c) = w; }
            } else {
#pragma unroll
                for (int j = 0; j < 4; ++j) { const int c = 4 * F.lane + 256 * j; const f32x4 gg = *(const LAS f32x4*)(GC + c); f32x4 o = v[t][j] * rstd * gg;
                    if (PROBE_B >= 0 && rows[t] < 3906) { volatile LAS unsigned long long* TS = (volatile LAS unsigned long long*)(F.lds + TS_OFF); o = o + (0.1f + 0.00001f * (float)(TS[1 + PROBE_B] - TS[PROBE_B])); }
                    if (PROBE_A >= 0 && rows[t] == 0 && j == 0 && F.lane == 0) { volatile LAS unsigned long long* TS = (volatile LAS unsigned long long*)(F.lds + TS_OFF); o.x += 1.f + 0.001f * (float)(TS[1 + PROBE_A] - TS[PROBE_A]); }
                    *(f32x4*)(xr + c) = o; }
            }
        }
    }
}

#ifndef FASTMASK
#define FASTMASK 0xffff
#endif
constexpr unsigned FM = FASTMASK;
constexpr int NPH = 2 + 13 * 2;
__device__ __forceinline__ Frame make_frame(LAS unsigned char* lds, int wave0) {
    Frame F; F.lds = lds; F.wave = wave0; F.lane = (int)__builtin_amdgcn_mbcnt_hi(~0u, __builtin_amdgcn_mbcnt_lo(~0u, 0u)); asm volatile("" : "+v"(F.lane)); F.tid = F.wave * 64 + F.lane; F.bid = blockIdx.x; F.G = gridDim.x; asm volatile("" : "+s"(F.G), "+s"(F.bid));
    F.tab = (const unsigned long long LAS*)(lds + TAB_OFF);
    volatile LAS unsigned long long* t = (volatile LAS unsigned long long*)(lds + TAB_OFF);
    F.ws = (unsigned char*)(GAS unsigned char*)uni64(t[35]); F.out = (float*)(GAS float*)uni64(t[36]); F.ctl = (unsigned*)(F.ws + WS_CTL);
    return F;
}
__global__ void __launch_bounds__(NT, 2) mega_fwd(Args args) {
    extern __shared__ __attribute__((aligned(16))) unsigned char lds_raw[];
    LAS unsigned char* const lds = (LAS unsigned char*)lds_raw;
    const int wave0 = __builtin_amdgcn_readfirstlane((int)threadIdx.x >> 6);
    for (int u = threadIdx.x; u < 1024 / 4; u += NT) ((LAS unsigned*)(lds + 131072))[u] = 0u;
    if (threadIdx.x == 0) { LAS unsigned long long* t = (LAS unsigned long long*)(lds + TAB_OFF);
#pragma unroll
        for (int i = 0; i < 35; ++i) t[i] = (unsigned long long)args.in[i];
        t[35] = (unsigned long long)args.ws; t[36] = (unsigned long long)args.out; }
    __syncthreads();
    { Frame F = make_frame(lds, wave0); (void)xcd_barrier_post(F.ctl + CW_BAR, (volatile LAS unsigned*)(lds + MISC_OFF) + 8); }
    if ((PROBE_A >= 0 || PROBE_B >= 0) && threadIdx.x == 0) ((volatile LAS unsigned long long*)(lds + TS_OFF))[0] = __builtin_amdgcn_s_memrealtime();
    const int lo = args.ph_lo, hi = args.ph_hi; int ph = 0;
#define GRIDBAR() do { Frame Fb = make_frame(lds, wave0); XcdBarrier bar; bar.bar = Fb.ctl + CW_BAR; bar.x = xb_xcc_id(); bar.st = (volatile LAS unsigned*)(lds + MISC_OFF) + 8; xcd_barrier(bar, Fb.tid == 0); } while (0)
#ifndef REPBAR
#define REPBAR 0
#endif
#ifndef REPMASK
#define REPMASK 0
#endif
#define PHASE(...) do { if (lo <= ph && ph < hi) { const int _pl = ph < 2 ? ph : 2 + (ph - 2) % 13; for (int _rep = 0; _rep <= ((REPMASK >> _pl) & 1); ++_rep) { Frame F = make_frame(lds, wave0); __VA_ARGS__; } if (ph + 1 < hi) { GRIDBAR(); if (REPBAR) GRIDBAR(); } if ((PROBE_A >= 0 || PROBE_B >= 0) && threadIdx.x == 0) ((volatile LAS unsigned long long*)(lds + TS_OFF))[1 + ph] = __builtin_amdgcn_s_memrealtime(); } ++ph; } while (0)
    PHASE({ ph0_prologue(F); if (FM >> 3 & 1) s5_precompute(F); __syncthreads(); convert_weights(F, 0, (FM >> 3 & 1) && F.G > 128 ? F.G - 64 : F.G); { const f32x4* s = (const f32x4*)IN_(I_CTX); f32x4* d = (f32x4*)(F.ws + WS_XC); for (int i = F.bid * NT + F.tid; i < CTX * D / 4; i += F.G * NT) d[i] = s[i]; } });
    PHASE(hprep_rows(F, 0));
#pragma unroll 1
    for (int l = 0; l < 2; ++l) {
        PHASE({ if (FM >> 2 & 1) { ph2_fast(F, l); ph2_ctx(F, l == 0 ? INW : MIXW); } else ph2_naive(F, l); });
        PHASE({ if (FM >> 3 & 1) { s5_z_phase(F, l); const int nch = (l == 0 ? MT : SEQ) / 128; if (F.G > nch) { if (F.bid < nch) sg_fast_chunk(F, l, F.bid); else { Frame F2 = F; F2.bid -= nch; F2.G -= nch; ph3_conv(F2, l, l == 0 ? MT : SEQ); } } else { for (int c = F.bid; c < nch; c += F.G) sg_fast_chunk(F, l, c); ph3_conv(F, l, l == 0 ? MT : SEQ); } } else { ph3_s5_naive(F, l); if (F.bid >= 64) { Frame F2 = F; F2.bid -= 64; F2.G -= 64; ph3_sg_naive(F2, l); ph3_conv(F2, l, MT); } } });
        PHASE({ if (FM >> 3 & 1) s5_scan_phase(F, l); });
        PHASE({ if (FM >> 3 & 1) s5_y_phase(F, l); else ph5_naive(F, l); });
        PHASE({ if (FM >> 6 & 1) { ph6_fast(F, l); if (l == 0) ph6_ctx(F); } else ph6_naive(F, l); });
        PHASE({ if (FM >> 7 & 1) { ph7_fast(F, l); if (l == 0) ph7_ctx(F); } else ph7_naive(F, l); });
        PHASE({ if (FM >> 8 & 1) { ph8_fast(F, l); if (l == 0) ph8_ctx(F, l); } else ph8_naive(F, l); });
        PHASE({ if (FM >> 9 & 1) { ph9_fast(F, l); if (l == 0) ph9_ctx(F, l); } else ph9_naive(F, l); });
        PHASE(ph10_route(F, l));
        PHASE(ph11_scatter(F, l));
        PHASE({ if (FM >> 12 & 1) ph12_fast(F, l); else ph12_naive(F, l); });
        PHASE({ if (FM >> 13 & 1) ph13_fast(F, l); else ph13_naive(F, l); });
        PHASE({ ph14_combine(F, l); if (l == 0) { __syncthreads(); convert_weights(F, 1, F.G); } });
    }
#undef PHASE
}

extern "C" void kernel_launch(void* const* d_in, const int* in_sizes, int n_in, void* d_out, int out_size, void* d_ws, size_t ws_size, hipStream_t stream) {
    static int grid = 0;
    if (grid == 0) {
        int dev = 0, cus = 0, per_cu = 0;
        if (n_in != 35 || out_size != SEQ * D || ws_size < WS_END) { fprintf(stderr, "kernel_launch: unexpected shapes (n_in %d out %d ws %zu)\n", n_in, out_size, ws_size); grid = -1; return; }
        if (hipGetDevice(&dev) != hipSuccess || hipDeviceGetAttribute(&cus, hipDeviceAttributeMultiprocessorCount, dev) != hipSuccess) { grid = -1; return; }
        if (hipFuncSetAttribute((const void*)mega_fwd, hipFuncAttributeMaxDynamicSharedMemorySize, LDS_BYTES) != hipSuccess) { fprintf(stderr, "kernel_launch: hipFuncSetAttribute failed\n"); grid = -1; return; }
        if (hipOccupancyMaxActiveBlocksPerMultiprocessor(&per_cu, (const void*)mega_fwd, NT, LDS_BYTES) != hipSuccess || per_cu < 1) { fprintf(stderr, "kernel_launch: occupancy query says %d blocks per CU\n", per_cu); grid = -1; return; }
        grid = cus;
    }
    if (grid < 0) return;
    (void)hipMemsetAsync((char*)d_ws + WS_CTL, 0, CTL_ZERO_BYTES, stream);
    Args a{};
    for (int i = 0; i < 35; ++i) a.in[i] = (const float*)d_in[i];
    a.out = (float*)d_out; a.ws = (unsigned char*)d_ws; a.ph_lo = 0; a.ph_hi = NPH;
    void* kargs[] = {&a};
    hipError_t e = hipLaunchCooperativeKernel((const void*)mega_fwd, dim3(grid), dim3(NT), kargs, LDS_BYTES, stream);
    if (e != hipSuccess) fprintf(stderr, "kernel_launch: cooperative launch failed: %s (grid %d)\n", hipGetErrorString(e), grid);
}
```

```cpp
#include <hip/hip_runtime.h>
#include <stdint.h>
#include <cstdio>

#define GAS __attribute__((address_space(1)))
#define LAS __attribute__((address_space(3)))
typedef unsigned short bf16;
typedef unsigned v4u __attribute__((ext_vector_type(4)));
typedef unsigned v2u __attribute__((ext_vector_type(2)));
typedef float f32x4 __attribute__((ext_vector_type(4)));
typedef short bf16x8 __attribute__((ext_vector_type(8)));

constexpr int D = 1024, SEQ = 16384, CTX = 256, MT = SEQ + CTX;
constexpr int MIXW = 512, INW = 3072, G5 = 32, P5 = 64, H5 = 16;
constexpr int NE = 32, DFF = 256;
constexpr int MAXSLOT = 2 * MT + NE * 256;
constexpr float EPS = 1e-6f;
constexpr int NT = 512;

constexpr size_t MiB = 1u << 20;
constexpr size_t WS_CTL = 0, CTL_ZERO_BYTES = 1 * MiB;
constexpr size_t WS_MOD = 1 * MiB;
constexpr size_t WS_XC = 2 * MiB;
constexpr size_t WS_EID = 3 * MiB;
constexpr size_t WS_EW = WS_EID + (size_t)MT * 8;
constexpr size_t WS_STOK = WS_EW + (size_t)MT * 8;
constexpr size_t WS_SW = WS_STOK + (size_t)MAXSLOT * 4;
constexpr size_t WS_TSLOT = WS_SW + (size_t)MAXSLOT * 4;
constexpr size_t WS_HISTG = WS_TSLOT + (size_t)MT * 8;
constexpr size_t WS_H = 4 * MiB;
constexpr size_t WS_X16 = WS_H;
constexpr size_t WS_PROJ = WS_H + (size_t)MT * 2048;
constexpr size_t WS_YS = WS_PROJ + (size_t)MT * 6144;
constexpr size_t WS_YG = WS_YS + (size_t)3 * MT * 1024;
constexpr size_t WS_PM = WS_YG + (size_t)MT * 1024;
constexpr size_t WS_S5 = WS_PM + (size_t)MT * 2048;
constexpr size_t WS_Z = WS_S5;
constexpr size_t WS_RSS = WS_Z + (size_t)8 * MiB;
constexpr size_t WS_SS = WS_Z + (size_t)1040 * 32 * 256 * 4;
constexpr size_t WS_S5M = WS_SS + (size_t)1040 * 32 * 256 * 2;
constexpr size_t WS_A16 = WS_S5M + (size_t)2 * 32 * 3 * 65536 * 2;
constexpr size_t WS_W = WS_A16 + (size_t)2 * 32 * 2 * 64 * 2 * 4 > WS_S5 + (size_t)2 * MT * 512 * 4 ? WS_A16 + (size_t)2 * 32 * 2 * 64 * 2 * 4 : WS_S5 + (size_t)2 * MT * 512 * 4;
constexpr size_t WS_WIN = WS_W;
constexpr size_t WS_WMG = WS_WIN + (size_t)3072 * 1024 * 2;
constexpr size_t WS_WGLU = WS_WMG + (size_t)3072 * 1024 * 2;
constexpr size_t WS_WBR = WS_WGLU + (size_t)512 * 512 * 2;
constexpr size_t WS_WO = WS_WBR + (size_t)3 * 1024 * 512 * 2;
constexpr size_t WS_W13 = WS_WO + (size_t)1024 * 1024 * 2;
constexpr size_t WS_W2 = WS_W13 + (size_t)32 * 512 * 1024 * 2;
constexpr size_t WS_WSG = WS_W2 + (size_t)32 * 1024 * 256 * 2;
constexpr size_t WS_WR = WS_WSG + (size_t)4 * 128 * 128 * 2;
constexpr size_t WS_END = WS_WR + (size_t)2 * 48 * 1024 * 2;
static_assert(WS_END <= (size_t)377 * MiB, "workspace budget");
constexpr size_t WS_HS = WS_PROJ;
constexpr size_t WS_ACT = WS_YS;
constexpr size_t WS_YS2 = WS_YG;
static_assert(WS_HS + (size_t)MAXSLOT * 2048 <= WS_YS && WS_ACT + (size_t)MAXSLOT * 512 <= WS_YG && WS_YS2 + (size_t)MAXSLOT * 2048 <= WS_W, "moe overlays");
static_assert(WS_HISTG + (size_t)1024 * 32 * 4 <= WS_H, "ws map");
constexpr int CW_CNT = 64;
constexpr int CW_BAR = 4096;
constexpr size_t WS_HG = WS_CTL + 768 * 1024;
constexpr size_t WS_GR = WS_CTL + 256 * 1024;
constexpr int CW_UPC = 8192;

#ifndef PROBE_A
#define PROBE_A -1
#endif
#ifndef PROBE_B
#define PROBE_B -1
#endif
#ifndef PROBE_A1
#define PROBE_A1 (PROBE_A + 1)
#endif
#ifndef PROBE_B1
#define PROBE_B1 (PROBE_B + 1)
#endif
#ifndef PROBE_AROW
#define PROBE_AROW 0
#endif
#ifndef PROBE_PH
#define PROBE_PH 0
#endif
#ifndef PROBE_LO
#define PROBE_LO 0
#endif
#ifndef PROBE_HI
#define PROBE_HI 100000
#endif
constexpr int TS_OFF = 131072 + 512;
constexpr int LDS_BYTES = 147456;
constexpr int MISC_OFF = 131072 + 320;
constexpr int TAB_OFF = 131072 + 1024;

__device__ __forceinline__ float bf2f(unsigned short b) { return __builtin_bit_cast(float, ((unsigned)b) << 16); }
__device__ __forceinline__ unsigned f2bf(float f) { unsigned u = __builtin_bit_cast(unsigned, f); return (u + 0x7fffu + ((u >> 16) & 1u)) >> 16; }
__device__ __forceinline__ unsigned pk2(float lo, float hi) { return f2bf(lo) | (f2bf(hi) << 16); }
__device__ __forceinline__ float sigmoidf_(float x) { return __builtin_amdgcn_rcpf(1.f + __expf(-x)); }
__device__ __forceinline__ float siluf_(float x) { return x * __builtin_amdgcn_rcpf(1.f + __expf(-x)); }
__device__ __forceinline__ float geluf_(float x) { const float u = 0.7978845608028654f * (x + 0.044715f * x * x * x); return x * __builtin_amdgcn_rcpf(1.f + __expf(-2.f * u)); }
__device__ __forceinline__ float shflx(float v, int mask, int lane) { return __builtin_bit_cast(float, __builtin_amdgcn_ds_bpermute((lane ^ mask) << 2, __builtin_bit_cast(int, v))); }
__device__ __forceinline__ float wave_sum(float v, int lane) {
#pragma unroll
    for (int o = 1; o < 64; o <<= 1) v += shflx(v, o, lane);
    return v;
}

#define XB_TMO      128
#define XB_XCNT(j)  (256  + 64 * (j))
#define XB_XSUB(j)  (1280 + 64 * (j))
#define XB_XGEN(j)  (2304 + 64 * (j))
#define XB_TOP      3328
#define XB_TOPGEN   3392
#define XCD_BAR_WORDS 3456
#define XB_SPIN_CAP (1u << 24)
__device__ __forceinline__ unsigned xb_ld(unsigned* p)              { return __hip_atomic_load(p, __ATOMIC_RELAXED, __HIP_MEMORY_SCOPE_AGENT); }
__device__ __forceinline__ unsigned xb_add(unsigned* p, unsigned v) { return __hip_atomic_fetch_add(p, v, __ATOMIC_RELAXED, __HIP_MEMORY_SCOPE_AGENT); }
__device__ __forceinline__ unsigned xb_xcc_id() { return (unsigned)__builtin_amdgcn_s_getreg((3 << 11) | 20) & 0xFu; }
#define XB_SPIN(cond, bar) do { unsigned _sp = 0; while (cond) { __builtin_amdgcn_s_sleep(1); \
    if ((++_sp & 255u) == 0u) { if (xb_ld(&(bar)[XB_TMO])) break; if (_sp > XB_SPIN_CAP) { atomicAdd(&(bar)[XB_TMO], 1u); break; } } } } while (0)
struct XcdBarrier { unsigned* bar; unsigned x; volatile LAS unsigned* st; };
__device__ __forceinline__ XcdBarrier xcd_barrier_post(unsigned* bar, volatile LAS unsigned* st) {
    XcdBarrier b; b.bar = bar; b.x = xb_xcc_id(); b.st = st;
    if (threadIdx.x == 0) (void)xb_add(&bar[XB_XCNT(b.x)], 1u);
    return b;
}
__device__ __forceinline__ void xcd_barrier_complete(unsigned* bar, unsigned x, unsigned& nloc, unsigned& nx) {
    const unsigned G = gridDim.x * gridDim.y * gridDim.z;
    unsigned sum, cnt, mine, sp = 0u;
    for (;;) {
        sum = 0u; cnt = 0u; mine = 0u;
#pragma unroll
        for (unsigned j = 0; j < 16; ++j) { const unsigned c = xb_ld(&bar[XB_XCNT(j)]); sum += c; cnt += (c > 0u) ? 1u : 0u; mine = (j == x) ? c : mine; }
        if (sum == G) break;
        __builtin_amdgcn_s_sleep(1);
        if ((++sp & 255u) == 0u) { if (xb_ld(&bar[XB_TMO])) break; if (sp > XB_SPIN_CAP) { atomicAdd(&bar[XB_TMO], 1u); break; } }
    }
    nloc = mine > 0u ? mine : 1u; nx = cnt > 0u ? cnt : 1u;
}
__device__ __forceinline__ void xcd_barrier(const XcdBarrier& b, bool leader) {
    asm volatile("s_waitcnt vmcnt(0)" ::: "memory");
    __syncthreads();
    if (leader) {
        unsigned* bar = b.bar;
        __builtin_amdgcn_s_waitcnt(0);
        unsigned nloc = b.st[0], nx = b.st[1];
        if (nloc == 0u) { xcd_barrier_complete(bar, b.x, nloc, nx); b.st[0] = nloc; b.st[1] = nx; }
        const unsigned old = xb_add(&bar[XB_XSUB(b.x)], 1u);
        const unsigned gen = old / nloc;
        if (old + 1u == (gen + 1u) * nloc) {
            __builtin_amdgcn_fence(__ATOMIC_RELEASE, "agent");
            asm volatile("s_waitcnt vmcnt(0)" ::: "memory");
            const unsigned og = xb_add(&bar[XB_TOP], 1u);
            const unsigned tg = og / nx;
            if (og + 1u == (tg + 1u) * nx) xb_add(&bar[XB_TOPGEN], 1u);
            else XB_SPIN(xb_ld(&bar[XB_TOPGEN]) == tg, bar);
            __builtin_amdgcn_fence(__ATOMIC_ACQUIRE, "agent");
            xb_add(&bar[XB_XGEN(b.x)], 1u);
            asm volatile("s_waitcnt vmcnt(0)" ::: "memory");
        } else {
            XB_SPIN(xb_ld(&bar[XB_XGEN(b.x)]) == gen, bar);
            __builtin_amdgcn_fence(__ATOMIC_ACQUIRE, "agent");
            asm volatile("s_waitcnt vmcnt(0)" ::: "memory");
        }
    }
    __syncthreads();
}

struct Args { const float* in[35]; float* out; unsigned char* ws; int ph_lo, ph_hi; };
struct Frame {
    LAS unsigned char* lds; unsigned char* ws; unsigned* ctl;
    int tid, lane, wave, bid, G;
    const unsigned long long LAS* tab; float* out;
};
__device__ __forceinline__ unsigned long long uni64(unsigned long long v) { const unsigned lo = __builtin_amdgcn_readfirstlane((unsigned)v), hi = __builtin_amdgcn_readfirstlane((unsigned)(v >> 32)); return ((unsigned long long)hi << 32) | lo; }
#define IN_(k) ((const float*)(const GAS float*)uni64(F.tab[k]))
enum { I_X = 0, I_C, I_CTX, I_CCTX, I_WADA, I_BADA, I_GMIX, I_GFFN, I_WIN, I_LRE, I_LIM, I_LDT, I_BRE, I_BIM, I_CRE, I_CIM, I_DSKIP, I_WGLU, I_SGG, I_SGB, I_WSG, I_BSG,
       I_WCONV, I_WBR, I_WMG, I_BMG, I_WO, I_WGRP, I_BGRP, I_WEXP, I_BEXP, I_W1, I_W3, I_W2, I_GF };

__device__ __forceinline__ const float* mod_ptr(const Frame& F, int l, int row) { return (const float*)(F.ws + WS_MOD) + (size_t)(l * 2 + (row >= SEQ ? 1 : 0)) * 6144; }
__device__ __forceinline__ const float* xin_row(const Frame& F, int row) { return row < SEQ ? IN_(I_X) + (size_t)row * D : IN_(I_CTX) + (size_t)(row - SEQ) * D; }
#define HBUF(F) ((unsigned char*)(F).out)


namespace pg8 {
#define PG8_LAS __attribute__((address_space(3)))
typedef unsigned short bf16_t;
typedef short bf16x8 __attribute__((ext_vector_type(8)));
typedef float f32x4 __attribute__((ext_vector_type(4)));
typedef unsigned u32x4 __attribute__((ext_vector_type(4)));
constexpr int BM = 256, BK = 64, HALF = 128, HTB = HALF * BK * 2  , STAGE_BYTES = 8 * HTB, NXCD = 8, WGM = 8;

__host__ __device__ __forceinline__ int lds_byte(int r, int c) { const int st = (r >> 4) * 2 + (c >> 5), rr = r & 15, cc = c & 31, ob = rr * 64 + cc * 2; return st * 1024 + (ob ^ (((ob >> 9) & 1) << 5)); }
__host__ __device__ __forceinline__ void stage_rc(int b, int& R, int& C) { const int st = b / 1024, sb = b % 1024, swz = sb ^ (((sb >> 9) & 1) << 5); R = (st >> 1) * 16 + swz / 64; C = (st & 1) * 32 + (swz % 64) / 2; }
__host__ __device__ __forceinline__ int perm32(int rho) { const int n = rho >> 4, i = rho & 15; return 8 * (i >> 2) + 4 * n + (i & 3); }

struct Unit { int pm, pn; };
struct Gemm { const bf16_t* A; const bf16_t* Bt; int M, N, K; int pad_; const int* rowidx; };

struct StaticOrder {
    int nM, nN, nwg, G, c;
    __host__ __device__ void init(int M, int N, int G_, int c_) { nM = M / BM; nN = N / BM; nwg = nM * nN; G = G_; c = c_; }
    __host__ __device__ bool next(int i, Unit& u) const {
        const long L = (long)i * G + c; if (L >= nwg) return false;
        int wgid = (int)L; { const int q = nwg / NXCD, r = nwg % NXCD, xcd = wgid % NXCD, off = wgid / NXCD; wgid = (xcd < r ? xcd * (q + 1) : r * (q + 1) + (xcd - r) * q) + off; }
        const int nig = WGM * nN, gid = wgid / nig, fm = gid * WGM, gsz = (nM - fm) < WGM ? (nM - fm) : WGM;
        u.pm = fm + ((wgid % nig) % gsz); u.pn = (wgid % nig) / gsz; return true;
    }
    __device__ __forceinline__ unsigned peek(const Unit&) const { return 0u; }
    __device__ __forceinline__ void a_ready(const Unit&, unsigned) const {}
    __device__ __forceinline__ void done(const Unit&) const {}
};
__device__ __forceinline__ unsigned cvt_pk_bf16(float lo, float hi) { unsigned r; asm volatile("v_cvt_pk_bf16_f32 %0, %1, %2" : "=v"(r) : "v"(lo), "v"(hi)); return r; }
template <class Epi, class Sched, bool ALIGN_EPI = false, bool SP2 = false, bool ASC1 = false, bool AGATHER = false>
__device__ __forceinline__ void gemm_phase(PG8_LAS unsigned char* lds, const Gemm g, const Sched& S, const Epi& E, int tid_in) {
    int tid_ = tid_in; asm volatile("" : "+v"(tid_));
    const int tid = tid_, wid = __builtin_amdgcn_readfirstlane(tid >> 6), lane = tid & 63, wr = wid >> 2, wc = wid & 3, fr = lane & 15, fq = lane >> 4;
    const int K = g.K, nt = K / BK;
    unsigned voffA[2], voffB[2];
#pragma unroll
    for (int i = 0; i < 2; ++i) { int R, C; stage_rc(tid * 16 + i * 8192, R, C); const int Rb = Epi::PERM ? ((R & ~31) + perm32(R & 31)) : R;
        voffA[i] = (unsigned)(R * K + C) * 2u; voffB[i] = (unsigned)(Rb * K + C) * 2u; }
    unsigned vgC[2][2], vgN[2][2]; int grow[2], gcol[2];
#pragma unroll
    for (int i = 0; i < 2; ++i) { stage_rc(tid * 16 + i * 8192, grow[i], gcol[i]); vgC[0][i] = vgC[1][i] = vgN[0][i] = vgN[1][i] = 0u; }
#define PG8_GLOAD(dst, unit) do { if constexpr (AGATHER) { _Pragma("unroll") for (int _h = 0; _h < 2; ++_h) _Pragma("unroll") for (int _i = 0; _i < 2; ++_i) \
        dst[_h][_i] = (unsigned)g.rowidx[(unit).pm * BM + _h * HALF + grow[_i]] * (unsigned)(K * 2) + (unsigned)(gcol[_i] * 2); } } while (0)
    const size_t kstep = (size_t)(BK * 2);
    const size_t hstep = (size_t)HALF * K * 2;
    const size_t tstep = 2 * hstep;
    const unsigned ldsw = (unsigned)wid * 1024u;
    const int aoff = lds_byte(wr * 64 + fr, fq * 8), boff = lds_byte(wc * 32 + fr, fq * 8);
#define PG8_SA(b, h) (((b) * 2 + (h)) * HTB)
#define PG8_SB(b, h) ((4 + (b) * 2 + (h)) * HTB)
#define PG8_STAGE_X(bufoff, gbase, voff, aux) do { _Pragma("unroll") for (int _i = 0; _i < 2; ++_i) \
        __builtin_amdgcn_global_load_lds((const unsigned*)((const char*)(gbase) + (voff)[_i]), (PG8_LAS unsigned*)(lds + (bufoff) + ldsw + _i * 8192), 16, 0, aux); } while (0)
#define PG8_STAGE(bufoff, gbase, voff) do { if constexpr (ASC1 && (bufoff) < 4 * HTB) PG8_STAGE_X(bufoff, gbase, voff, 16); else PG8_STAGE_X(bufoff, gbase, voff, 0); } while (0)
#define PG8_STAGE_A(bufoff, uptr, kofs, h, nx) do { if constexpr (AGATHER) { unsigned _vs[2] = {(nx) ? vgN[h][0] : vgC[h][0], (nx) ? vgN[h][1] : vgC[h][1]}; PG8_STAGE(bufoff, (const char*)g.A + (kofs), _vs); } \
        else PG8_STAGE(bufoff, uptr, voffA); } while (0)
#define PG8_LDA(dst, b, h) do { _Pragma("unroll") for (int m = 0; m < 4; ++m) _Pragma("unroll") for (int k = 0; k < 2; ++k) dst[m][k] = *(const PG8_LAS bf16x8*)(lds + PG8_SA(b, h) + aoff + m * 2048 + k * 1024); } while (0)
#define PG8_LDB(dst, b, h) do { _Pragma("unroll") for (int n = 0; n < 2; ++n) _Pragma("unroll") for (int k = 0; k < 2; ++k) dst[n][k] = *(const PG8_LAS bf16x8*)(lds + PG8_SB(b, h) + boff + n * 2048 + k * 1024); } while (0)
#define PG8_MMA(ai, bj, At, Bt) do { __builtin_amdgcn_s_setprio(1); _Pragma("unroll") for (int m = 0; m < 4; ++m) _Pragma("unroll") for (int n = 0; n < 2; ++n) _Pragma("unroll") for (int k = 0; k < 2; ++k) \
        acc[ai][bj][m][n] = __builtin_amdgcn_mfma_f32_16x16x32_bf16(Bt[n][k], At[m][k], acc[ai][bj][m][n], 0, 0, 0); __builtin_amdgcn_s_setprio(0); } while (0)
#define PG8_WAIT_V(n) asm volatile("s_waitcnt vmcnt(" #n ")" ::: "memory")
#define PG8_WAIT_L(n) asm volatile("s_waitcnt lgkmcnt(" #n ")" ::: "memory")
#define PG8_BAR __builtin_amdgcn_s_barrier()
#define PG8_SCHED __builtin_amdgcn_sched_barrier(0)
    Unit cur, nxt; int ui = 0;
    if (!S.next(0, cur)) return;
    f32x4 acc[2][2][4][2];
#pragma unroll
    for (int a = 0; a < 2; ++a)
#pragma unroll
        for (int b = 0; b < 2; ++b)
#pragma unroll
            for (int m = 0; m < 4; ++m)
#pragma unroll
                for (int n = 0; n < 2; ++n) acc[a][b][m][n] = (f32x4){0.f, 0.f, 0.f, 0.f};
    bf16x8 At[4][2], B0[2][2], B1[2][2];
    const char* cA = (const char*)g.A + (size_t)cur.pm * tstep; const char* cB = (const char*)g.Bt + (size_t)cur.pn * tstep;
    PG8_GLOAD(vgC, cur);
    S.a_ready(cur, S.peek(cur));
    static_assert(SP2, "only the SP2 pipeline is kept");
    {
        PG8_STAGE(PG8_SB(0, 0), cB, voffB); PG8_STAGE(PG8_SB(0, 1), cB + hstep, voffB); PG8_STAGE_A(PG8_SA(0, 0), cA, 0, 0, false); PG8_STAGE_A(PG8_SA(0, 1), cA + hstep, 0, 1, false);
        if (wr == 1) PG8_BAR;
        PG8_WAIT_V(2); PG8_BAR;
        PG8_STAGE(PG8_SB(1, 0), cB + kstep, voffB); PG8_STAGE_A(PG8_SA(1, 0), cA + kstep, kstep, 0, false); PG8_STAGE(PG8_SB(1, 1), cB + hstep + kstep, voffB);
        PG8_WAIT_V(6); PG8_BAR;
    }
    for (;;) {
        const bool has_next = S.next(ui + 1, nxt);
        if (has_next) PG8_GLOAD(vgN, nxt); else { if constexpr (AGATHER) { vgN[0][0] = vgC[0][0]; vgN[0][1] = vgC[0][1]; vgN[1][0] = vgC[1][0]; vgN[1][1] = vgC[1][1]; } }
        const unsigned tok = has_next ? S.peek(nxt) : 0u;
        const char* nA = has_next ? (const char*)g.A + (size_t)nxt.pm * tstep : cA; const char* nB = has_next ? (const char*)g.Bt + (size_t)nxt.pn * tstep : cB;
#pragma unroll 1
        for (int t = 0; t < nt; t += 2) {
            const bool last = (t == nt - 2);
            const char* a1 = cA + (size_t)(t + 1) * kstep;
            const char* a2 = last ? nA : cA + (size_t)(t + 2) * kstep; const char* b2 = last ? nB : cB + (size_t)(t + 2) * kstep;
            const char* a3 = a2 + kstep; const char* b3 = b2 + kstep;
            const size_t k1 = (size_t)(t + 1) * kstep, k2 = last ? 0 : (size_t)(t + 2) * kstep, k3 = k2 + kstep;
            if (last && has_next) S.a_ready(nxt, tok);
            {
            PG8_LDB(B0, 0, 0); PG8_LDB(B1, 0, 1); PG8_SCHED; PG8_LDA(At, 0, 0); PG8_STAGE_A(PG8_SA(1, 1), a1 + hstep, k1, 1, false);
            PG8_WAIT_V(8); PG8_WAIT_L(0); PG8_BAR; PG8_MMA(0, 0, At, B0); PG8_MMA(0, 1, At, B1); PG8_BAR; PG8_SCHED;
            PG8_LDA(At, 0, 1); PG8_STAGE(PG8_SB(0, 0), b2, voffB); PG8_STAGE(PG8_SB(0, 1), b2 + hstep, voffB); PG8_STAGE_A(PG8_SA(0, 0), a2, k2, 0, last);
            PG8_WAIT_V(8); PG8_WAIT_L(0); PG8_BAR; PG8_MMA(1, 0, At, B0); PG8_MMA(1, 1, At, B1); PG8_BAR; PG8_SCHED;
            PG8_LDB(B0, 1, 0); PG8_LDB(B1, 1, 1); PG8_SCHED; PG8_LDA(At, 1, 0); PG8_STAGE_A(PG8_SA(0, 1), a2 + hstep, k2, 1, last);
            PG8_WAIT_V(8); PG8_WAIT_L(0); PG8_BAR; PG8_MMA(0, 0, At, B0); PG8_MMA(0, 1, At, B1); PG8_BAR; PG8_SCHED;
            PG8_LDA(At, 1, 1); PG8_STAGE(PG8_SB(1, 0), b3, voffB); PG8_STAGE(PG8_SB(1, 1), b3 + hstep, voffB); PG8_STAGE_A(PG8_SA(1, 0), a3, k3, 0, last);
            PG8_WAIT_V(8); PG8_WAIT_L(0); PG8_BAR; PG8_MMA(1, 0, At, B0); PG8_MMA(1, 1, At, B1); PG8_BAR; PG8_SCHED;
            }
        }
        if constexpr (ALIGN_EPI) { if (wr == 0) PG8_BAR; }
        if constexpr (!Epi::AFTER_DRAIN) { E(acc, cur, wr, wc, fr, fq); S.done(cur); }
        if (!has_next) break;
#pragma unroll
        for (int a = 0; a < 2; ++a)
#pragma unroll
            for (int b = 0; b < 2; ++b)
#pragma unroll
                for (int m = 0; m < 4; ++m)
#pragma unroll
                    for (int n = 0; n < 2; ++n) acc[a][b][m][n] = (f32x4){0.f, 0.f, 0.f, 0.f};
        cur = nxt; cA = nA; cB = nB; ++ui;
        if constexpr (AGATHER) { vgC[0][0] = vgN[0][0]; vgC[0][1] = vgN[0][1]; vgC[1][0] = vgN[1][0]; vgC[1][1] = vgN[1][1]; }
        if constexpr (ALIGN_EPI) { if (wr == 1) PG8_BAR; }
    }
    PG8_WAIT_V(0);
    if constexpr (!ALIGN_EPI) { if (wr == 0) PG8_BAR; }
    PG8_BAR;
    if constexpr (Epi::AFTER_DRAIN) { E.fused(acc, cur, wr, wc, fr, fq, lds, wid, lane); S.done(cur); }
#undef PG8_SA
#undef PG8_SB
#undef PG8_STAGE
#undef PG8_STAGE_X
#undef PG8_LDA
#undef PG8_STAGE_A
#undef PG8_GLOAD
#undef PG8_LDB
#undef PG8_MMA
#undef PG8_WAIT_V
#undef PG8_WAIT_L
#undef PG8_BAR
#undef PG8_SCHED
}
}

constexpr bool PG_ALIGN = true, PG_SP2 = true;
__device__ __forceinline__ float bflo(unsigned w) { return __builtin_bit_cast(float, w << 16); }
__device__ __forceinline__ float bfhi(unsigned w) { return __builtin_bit_cast(float, w & 0xffff0000u); }
__device__ __forceinline__ unsigned cvtpk(float lo, float hi) { return pg8::cvt_pk_bf16(lo, hi); }

__device__ __forceinline__ void transpose_item(const float* W, int N, int k0, int n0, bf16* WT, int K, size_t dst_row0, LAS float* scr, int lane) {
    float v[32];
#pragma unroll
    for (int i = 0; i < 32; ++i) v[i] = W[(size_t)(k0 + 2 * i + (lane >> 5)) * N + n0 + (lane & 31)];
#pragma unroll
    for (int i = 0; i < 32; ++i) scr[(2 * i + (lane >> 5)) * 33 + (lane & 31)] = v[i];
    asm volatile("s_waitcnt lgkmcnt(0)" ::: "memory");
    const int c = lane & 7;
#pragma unroll
    for (int j = 0; j < 4; ++j) { const int n = (lane >> 3) + 8 * j; const LAS float* s = scr + (8 * c) * 33 + n;
        v4u o; o.x = pk2(s[0 * 33], s[1 * 33]); o.y = pk2(s[2 * 33], s[3 * 33]); o.z = pk2(s[4 * 33], s[5 * 33]); o.w = pk2(s[6 * 33], s[7 * 33]);
        *(v4u*)(WT + (dst_row0 + n) * K + k0 + 8 * c) = o; }
    asm volatile("s_waitcnt lgkmcnt(0)" ::: "memory");
}
__device__ __forceinline__ void convert_weights(Frame& F, int l, int nblk) {
    LAS float* scr = (LAS float*)(F.lds + F.wave * 16384);
    if (F.bid >= nblk) return;
    const int gw = F.bid * (NT / 64) + F.wave, ngw = nblk * (NT / 64);
    constexpr int I_IN = 16 * 96, I_MG = 16 * 96, I_GLU = 8 * 16, I_BR = 3 * 8 * 32, I_O = 16 * 32, I_1 = 32 * 16 * 8, I_3 = I_1, I_2 = 32 * 4 * 32;
    constexpr int NITEMS = I_IN + I_MG + I_GLU + I_BR + I_O + I_1 + I_3 + I_2;
    for (int it = gw; it < NITEMS; it += ngw) {
        int r = it;
        if (r < I_IN) { const int kb = r / 96, nb = r % 96; transpose_item(IN_(I_WIN) + (size_t)l * D * INW, INW, 64 * kb, 32 * nb, (bf16*)(F.ws + WS_WIN), 1024, 32 * nb, scr, F.lane); continue; } r -= I_IN;
        if (r < I_MG) { const int kb = r / 96, nb = r % 96; transpose_item(IN_(I_WMG) + (size_t)l * D * INW, INW, 64 * kb, 32 * nb, (bf16*)(F.ws + WS_WMG), 1024, 32 * nb, scr, F.lane); continue; } r -= I_MG;
        if (r < I_GLU) { const int kb = r / 16, nb = r % 16; transpose_item(IN_(I_WGLU) + (size_t)l * MIXW * MIXW, MIXW, 64 * kb, 32 * nb, (bf16*)(F.ws + WS_WGLU), 512, 32 * nb, scr, F.lane); continue; } r -= I_GLU;
        if (r < I_BR) { const int kk = r / 256, q = r % 256, kb = q / 32, nb = q % 32; transpose_item(IN_(I_WBR) + ((size_t)l * 3 + kk) * MIXW * D, D, 64 * kb, 32 * nb, (bf16*)(F.ws + WS_WBR), 512, (size_t)kk * 1024 + 32 * nb, scr, F.lane); continue; } r -= I_BR;
        if (r < I_O) { const int kb = r / 32, nb = r % 32; transpose_item(IN_(I_WO) + (size_t)l * D * D, D, 64 * kb, 32 * nb, (bf16*)(F.ws + WS_WO), 1024, 32 * nb, scr, F.lane); continue; } r -= I_O;
        if (r < I_1 + I_3) { const int which = r / I_1, q = r % I_1, e = q / 128, q2 = q % 128, kb = q2 / 8, nb = q2 % 8;
            const float* W = IN_(which ? I_W3 : I_W1) + ((size_t)l * NE + e) * D * DFF; const int n0 = 32 * nb;
            transpose_item(W, DFF, 64 * kb, n0, (bf16*)(F.ws + WS_W13), 1024, (size_t)e * 512 + (n0 / 128) * 256 + which * 128 + (n0 % 128), scr, F.lane); continue; } r -= I_1 + I_3;
        { const int e = r / 128, q = r % 128, kb = q / 32, nb = q % 32; transpose_item(IN_(I_W2) + ((size_t)l * NE + e) * DFF * D, D, 64 * kb, 32 * nb, (bf16*)(F.ws + WS_W2), 256, (size_t)e * 1024 + 32 * nb, scr, F.lane); }
    }
    { bf16* wr = (bf16*)(F.ws + WS_WR); const float* wg = IN_(I_WGRP) + (size_t)l * D * 4; const float* we = IN_(I_WEXP) + (size_t)l * D * 32;
      for (int i = F.bid * NT + F.tid; i < 48 * 1024; i += nblk * NT) { const int n = i >> 10, kk = i & 1023; const float w = n < 4 ? wg[kk * 4 + n] : (n < 36 ? we[kk * 32 + n - 4] : 0.f);
          const unsigned hi = f2bf(w); const float lo = w - __builtin_bit_cast(float, hi << 16); wr[i] = (bf16)hi; wr[48 * 1024 + i] = (bf16)f2bf(lo); } }
    { const float* s = IN_(I_WSG) + (size_t)l * 4 * 128 * 128; bf16* d = (bf16*)(F.ws + WS_WSG);
      for (int i = (F.bid * NT + F.tid) * 2; i < 4 * 128 * 128; i += nblk * NT * 2) *(unsigned*)(d + i) = pk2(s[i], s[i + 1]); }
}

struct EpiProj { static constexpr bool PERM = true, AFTER_DRAIN = false; bf16* O;
    __device__ __forceinline__ void operator()(const pg8::f32x4 (&acc)[2][2][4][2], const pg8::Unit& u, int wr, int wc, int fr, int fq) const {
        const int row0 = u.pm * 256 + wr * 64 + fr, col0 = u.pn * 256 + wc * 32 + 8 * fq; const bool act = (u.pn >= 2 && u.pn < 6);
#pragma unroll
        for (int ai = 0; ai < 2; ++ai)
#pragma unroll
            for (int m = 0; m < 4; ++m) { bf16* rowp = O + (size_t)(row0 + ai * 128 + m * 16) * INW + col0;
#pragma unroll
                for (int bj = 0; bj < 2; ++bj) { pg8::f32x4 v0 = acc[ai][bj][m][0], v1 = acc[ai][bj][m][1];
                    if (act) {
#pragma unroll
                        for (int j = 0; j < 4; ++j) { v0[j] = geluf_(v0[j]); v1[j] = geluf_(v1[j]); } }
                    v4u w; w.x = cvtpk(v0[0], v0[1]); w.y = cvtpk(v0[2], v0[3]); w.z = cvtpk(v1[0], v1[1]); w.w = cvtpk(v1[2], v1[3]); *(v4u*)(rowp + bj * 128) = w; } }
    } };
struct EpiGlu { static constexpr bool PERM = true, AFTER_DRAIN = false; const bf16* YG; bf16* YA;
    __device__ __forceinline__ void operator()(const pg8::f32x4 (&acc)[2][2][4][2], const pg8::Unit& u, int wr, int wc, int fr, int fq) const {
        const int row0 = u.pm * 256 + wr * 64 + fr, col0 = u.pn * 256 + wc * 32 + 8 * fq;
#pragma unroll
        for (int ai = 0; ai < 2; ++ai) {
        v4u gv[4][2];
#pragma unroll
            for (int m = 0; m < 4; ++m)
#pragma unroll
                for (int bj = 0; bj < 2; ++bj) gv[m][bj] = *(const v4u*)(YG + (size_t)(row0 + ai * 128 + m * 16) * MIXW + col0 + bj * 128);
        asm volatile("" ::: "memory");
#pragma unroll
            for (int m = 0; m < 4; ++m) { const size_t off = (size_t)(row0 + ai * 128 + m * 16) * MIXW + col0;
#pragma unroll
                for (int bj = 0; bj < 2; ++bj) { const pg8::f32x4 v0 = acc[ai][bj][m][0], v1 = acc[ai][bj][m][1]; const v4u g = gv[m][bj];
                    v4u w; w.x = cvtpk(bflo(g.x) * sigmoidf_(v0[0]), bfhi(g.x) * sigmoidf_(v0[1])); w.y = cvtpk(bflo(g.y) * sigmoidf_(v0[2]), bfhi(g.y) * sigmoidf_(v0[3]));
                    w.z = cvtpk(bflo(g.z) * sigmoidf_(v1[0]), bfhi(g.z) * sigmoidf_(v1[1])); w.w = cvtpk(bflo(g.w) * sigmoidf_(v1[2]), bfhi(g.w) * sigmoidf_(v1[3])); *(v4u*)(YA + off + bj * 128) = w; } }
        asm volatile("" ::: "memory"); }
    } };
__device__ __forceinline__ int xcd_remap(int Lq, int total) { const int q = total >> 3, r = total & 7, x = Lq & 7, off = Lq >> 3; return (x < r ? x * (q + 1) : r * (q + 1) + (x - r) * q) + off; }
struct EpiBr { static constexpr bool PERM = true, AFTER_DRAIN = false; bf16* BR;
    __device__ __forceinline__ void operator()(const pg8::f32x4 (&acc)[2][2][4][2], const pg8::Unit& u, int wr, int wc, int fr, int fq) const {
        const int pm = u.pm % (MT / 256); const int row0 = pm * 256 + wr * 64 + fr, col0 = u.pn * 256 + wc * 32 + 8 * fq;
#pragma unroll
        for (int ai = 0; ai < 2; ++ai)
#pragma unroll
            for (int m = 0; m < 4; ++m) { bf16* rowp = BR + (size_t)(row0 + ai * 128 + m * 16) * INW + col0;
#pragma unroll
                for (int bj = 0; bj < 2; ++bj) { const pg8::f32x4 v0 = acc[ai][bj][m][0], v1 = acc[ai][bj][m][1];
                    v4u w; w.x = cvtpk(v0[0], v0[1]); w.y = cvtpk(v0[2], v0[3]); w.z = cvtpk(v1[0], v1[1]); w.w = cvtpk(v1[2], v1[3]); *(v4u*)(rowp + bj * 128) = w; } }
    } };
__device__ __forceinline__ int vu_pm(int v) { return (v >> 5) * 8 + (v & 7); }
__device__ __forceinline__ int vu_dt(int v) { return (v >> 3) & 3; }
struct SchedBr { int G, c, nM;
    __device__ __forceinline__ bool next(int i, pg8::Unit& u) const { const int v0 = (i / 3) * G + c, k = i % 3; if (v0 >= nM * 4) return false; const int v = xcd_remap(v0, nM * 4);
        u.pm = k * (MT / 256) + vu_pm(v); u.pn = k * 4 + vu_dt(v); return true; }
    __device__ __forceinline__ unsigned peek(const pg8::Unit&) const { return 0u; }
    __device__ __forceinline__ void a_ready(const pg8::Unit&, unsigned) const {}
    __device__ __forceinline__ void done(const pg8::Unit&) const {} };
struct EpiMerge { static constexpr bool PERM = true, AFTER_DRAIN = false; const bf16* BR; bf16* PM; const float* bm;
    __device__ __forceinline__ void operator()(const pg8::f32x4 (&acc)[2][2][4][2], const pg8::Unit& u, int wr, int wc, int fr, int fq) const {
        const int k = u.pn >> 2, dt = u.pn & 3; const int row0 = u.pm * 256 + wr * 64 + fr, col0 = dt * 256 + wc * 32 + 8 * fq;
#pragma unroll
        for (int bj = 0; bj < 2; ++bj) { const pg8::f32x4 b0 = *(const pg8::f32x4*)(bm + k * 1024 + col0 + bj * 128), b1 = *(const pg8::f32x4*)(bm + k * 1024 + col0 + bj * 128 + 4);
#pragma unroll
            for (int ai = 0; ai < 2; ++ai) {
            v4u brv[4], pmv[4];
#pragma unroll
                for (int m = 0; m < 4; ++m) { const size_t r = (size_t)(row0 + ai * 128 + m * 16); brv[m] = *(const v4u*)(BR + r * INW + k * 1024 + col0 + bj * 128);
                    pmv[m] = k > 0 ? *(const v4u*)(PM + r * D + col0 + bj * 128) : (v4u){0u, 0u, 0u, 0u}; }
                asm volatile("" ::: "memory");
#pragma unroll
                for (int m = 0; m < 4; ++m) { const size_t r = (size_t)(row0 + ai * 128 + m * 16); const v4u br = brv[m], o = pmv[m];
                    const pg8::f32x4 v0 = acc[ai][bj][m][0] + b0, v1 = acc[ai][bj][m][1] + b1;
                    float p[8] = {sigmoidf_(v0[0]) * bflo(br.x), sigmoidf_(v0[1]) * bfhi(br.x), sigmoidf_(v0[2]) * bflo(br.y), sigmoidf_(v0[3]) * bfhi(br.y),
                                  sigmoidf_(v1[0]) * bflo(br.z), sigmoidf_(v1[1]) * bfhi(br.z), sigmoidf_(v1[2]) * bflo(br.w), sigmoidf_(v1[3]) * bfhi(br.w)};
                    if (k > 0) { p[0] += bflo(o.x); p[1] += bfhi(o.x); p[2] += bflo(o.y); p[3] += bfhi(o.y); p[4] += bflo(o.z); p[5] += bfhi(o.z); p[6] += bflo(o.w); p[7] += bfhi(o.w); }
                    v4u w; w.x = cvtpk(p[0], p[1]); w.y = cvtpk(p[2], p[3]); w.z = cvtpk(p[4], p[5]); w.w = cvtpk(p[6], p[7]); *(v4u*)(PM + r * D + col0 + bj * 128) = w; }
                asm volatile("" ::: "memory"); } }
    } };
struct SchedMerge { int G, c, nM;
    __device__ __forceinline__ bool next(int i, pg8::Unit& u) const { const int v0 = (i / 3) * G + c, k = i % 3; if (v0 >= nM * 4) return false; const int v = xcd_remap(v0, nM * 4); u.pm = vu_pm(v); u.pn = k * 4 + vu_dt(v); return true; }
    __device__ __forceinline__ unsigned peek(const pg8::Unit&) const { return 0u; }
    __device__ __forceinline__ void a_ready(const pg8::Unit&, unsigned) const {}
    __device__ __forceinline__ void done(const pg8::Unit&) const {} };
struct EpiWo { static constexpr bool PERM = true, AFTER_DRAIN = false; const float* xin; bf16* X16; const float* mod_l; float* rss; int l0; int pad_;
    __device__ __forceinline__ void operator()(const pg8::f32x4 (&acc)[2][2][4][2], const pg8::Unit& u, int wr, int wc, int fr, int fq) const {
        const int row0 = u.pm * 256 + wr * 64 + fr, col0 = u.pn * 256 + wc * 32 + 8 * fq;
        const float* ga = mod_l + 2048;
        float ssq[2][4] = {};
        pg8::f32x4 gv[2][2];
#pragma unroll
        for (int bj = 0; bj < 2; ++bj)
#pragma unroll
            for (int n = 0; n < 2; ++n) gv[bj][n] = *(const pg8::f32x4*)(ga + col0 + bj * 128 + n * 4);
#pragma unroll
        for (int ai = 0; ai < 2; ++ai) {
#pragma unroll
            for (int mp = 0; mp < 2; ++mp) {
            pg8::f32x4 xv[2][2][2];
            if (l0) {
#pragma unroll
                for (int m = 0; m < 2; ++m) { const size_t off = (size_t)(row0 + ai * 128 + (mp * 2 + m) * 16) * D + col0;
#pragma unroll
                    for (int bj = 0; bj < 2; ++bj)
#pragma unroll
                        for (int n = 0; n < 2; ++n) xv[m][bj][n] = *(const pg8::f32x4*)(xin + off + bj * 128 + n * 4); }
                asm volatile("" ::: "memory");
            } else {
                v4u xb[2][2];
#pragma unroll
                for (int m = 0; m < 2; ++m) { const size_t off = (size_t)(row0 + ai * 128 + (mp * 2 + m) * 16) * D + col0;
#pragma unroll
                    for (int bj = 0; bj < 2; ++bj) xb[m][bj] = *(const v4u*)(X16 + off + bj * 128); }
                asm volatile("" ::: "memory");
#pragma unroll
                for (int m = 0; m < 2; ++m)
#pragma unroll
                    for (int bj = 0; bj < 2; ++bj) { const v4u w = xb[m][bj]; xv[m][bj][0] = (pg8::f32x4){bflo(w.x), bfhi(w.x), bflo(w.y), bfhi(w.y)}; xv[m][bj][1] = (pg8::f32x4){bflo(w.z), bfhi(w.z), bflo(w.w), bfhi(w.w)}; }
            }
#pragma unroll
            for (int m = 0; m < 2; ++m) { const size_t off = (size_t)(row0 + ai * 128 + (mp * 2 + m) * 16) * D + col0;
#pragma unroll
                for (int bj = 0; bj < 2; ++bj) { const pg8::f32x4 o0 = xv[m][bj][0] + gv[bj][0] * acc[ai][bj][m + mp * 2][0], o1 = xv[m][bj][1] + gv[bj][1] * acc[ai][bj][m + mp * 2][1];
                    v4u w; w.x = cvtpk(o0[0], o0[1]); w.y = cvtpk(o0[2], o0[3]); w.z = cvtpk(o1[0], o1[1]); w.w = cvtpk(o1[2], o1[3]); *(v4u*)(X16 + off + bj * 128) = w;
                    ssq[ai][m + mp * 2] += (o0[0] * o0[0] + o0[1] * o0[1] + o0[2] * o0[2] + o0[3] * o0[3]) + (o1[0] * o1[0] + o1[1] * o1[1] + o1[2] * o1[2] + o1[3] * o1[3]); } }
            asm volatile("" ::: "memory"); }
        }
        const int lane = fr + 16 * fq;
#pragma unroll
        for (int ai = 0; ai < 2; ++ai)
#pragma unroll
            for (int m = 0; m < 4; ++m) { float s = ssq[ai][m]; s += shflx(s, 16, lane); s += shflx(s, 32, lane); if (fq == 0) rss[(size_t)(row0 + ai * 128 + m * 16) * 16 + u.pn * 4 + wc] = s; }
    } };
constexpr int MOETAB_OFF = 131072 + 2048;
__device__ __forceinline__ int moe_build_tables(Frame& F, const unsigned* cnt, LAS unsigned* tabu, LAS unsigned* tabd) {
    LAS int* RAW = (LAS int*)(F.lds + MOETAB_OFF + 8192); LAS int* PRE = RAW + 32;
    if (F.tid < 32) RAW[F.tid] = ((int)cnt[F.tid] + 255) >> 8;
    __syncthreads();
    if (F.tid <= 32) { int s = 0; for (int i = 0; i < F.tid; ++i) s += RAW[i]; PRE[F.tid] = s; }
    __syncthreads();
    const int nrt = PRE[32];
    for (int q = F.tid; q < nrt * 6; q += NT) { const int rt = q / 6, w = q % 6; int e = 0;
#pragma unroll 1
        for (int i = 1; i < 32; ++i) e += PRE[i] <= rt ? 1 : 0;
        if (w < 2) tabu[rt * 2 + w] = ((unsigned)rt << 16) | (unsigned)(e * 2 + w); else tabd[rt * 4 + (w - 2)] = ((unsigned)rt << 16) | (unsigned)(e * 4 + (w - 2)); }
    __syncthreads();
    return nrt;
}
__device__ __forceinline__ void xcd_chunk(int total, int x, int& start, int& size) { const int q = total >> 3, r = total & 7; size = q + (x < r ? 1 : 0); start = x < r ? x * (q + 1) : r * (q + 1) + (x - r) * q; }
struct SchedMoeUp { int G, c, nrt, tid; const LAS unsigned* tabw; unsigned* upc;
    __device__ __forceinline__ bool next(int i, pg8::Unit& u) const {
        int Lq;
        if (G & 7) { Lq = i * G + c; if (Lq >= 2 * nrt) return false; }
        else { int rs, rn; xcd_chunk(nrt, c & 7, rs, rn); const int nb = G >> 3, j = c >> 3, o0 = i * nb; if (o0 + j >= 2 * rn) return false;
            const int n = (2 * rn - o0) < nb ? (2 * rn - o0) : nb, h = n >> 1;
            Lq = (n & 1) ? 2 * rs + o0 + j : 2 * (rs + (o0 >> 1) + (j % h)) + (j / h); }
        const unsigned w = (unsigned)__builtin_amdgcn_readfirstlane((int)tabw[Lq]); u.pm = (int)(w >> 16); u.pn = (int)(w & 0xffffu); return true; }
    __device__ __forceinline__ unsigned peek(const pg8::Unit&) const { return 0u; }
    __device__ __forceinline__ void a_ready(const pg8::Unit&, unsigned) const {}
    __device__ __forceinline__ void done(const pg8::Unit& u) const {
        asm volatile("s_waitcnt vmcnt(0)" ::: "memory"); __builtin_amdgcn_s_barrier();
        if (tid == 0) __hip_atomic_fetch_add(upc + u.pm, 1u, __ATOMIC_RELAXED, __HIP_MEMORY_SCOPE_AGENT); } };
struct SchedMoeDown { int G, c, nrt, pad_; const LAS unsigned* tabw; unsigned* upc;
    __device__ __forceinline__ bool next(int i, pg8::Unit& u) const {
        int Lq;
        if (G & 7) { Lq = i * G + c; if (Lq >= 4 * nrt) return false; }
        else { const int j = c >> 3, nb = G >> 3; int rs, rn; xcd_chunk(nrt, c & 7, rs, rn); const int un = 2 * rn, dn = 4 * rn;
            const int a = un / nb, n2 = un % nb, nu = a + (j < n2 ? 1 : 0), s = 2 * nu + i;
            const int c0 = s - 2 * a, c1 = s - 2 * a - 2; const int off = (nb - n2) * (c0 > 0 ? c0 : 0) + n2 * (c1 > 0 ? c1 : 0) + (c1 >= 0 ? j : j - n2);
            if (off >= dn) return false; Lq = 4 * rs + off; }
        const unsigned w = (unsigned)__builtin_amdgcn_readfirstlane((int)tabw[Lq]); u.pm = (int)(w >> 16); u.pn = (int)(w & 0xffffu); return true; }
    __device__ __forceinline__ unsigned peek(const pg8::Unit& u) const { return __hip_atomic_load(upc + u.pm, __ATOMIC_RELAXED, __HIP_MEMORY_SCOPE_AGENT); }
    __device__ __forceinline__ void a_ready(const pg8::Unit& u, unsigned tok) const {
        if ((unsigned)__builtin_amdgcn_readfirstlane((int)tok) >= 2u) return;
        unsigned* p = upc + u.pm; unsigned spins = 0;
        while ((unsigned)__builtin_amdgcn_readfirstlane((int)__hip_atomic_load(p, __ATOMIC_RELAXED, __HIP_MEMORY_SCOPE_AGENT)) < 2u) { __builtin_amdgcn_s_sleep(2); if (++spins > (1u << 22)) break; } }
    __device__ __forceinline__ void done(const pg8::Unit&) const {} };
struct EpiUp { static constexpr bool PERM = true, AFTER_DRAIN = false; bf16* ACT; const float* SW;
    __device__ __forceinline__ void operator()(const pg8::f32x4 (&acc)[2][2][4][2], const pg8::Unit& u, int wr, int wc, int fr, int fq) const {
        const int row0 = u.pm * 256 + wr * 64 + fr, f0 = (u.pn & 1) * 128 + wc * 32 + 8 * fq;
        const __amdgpu_buffer_rsrc_t rs = __builtin_amdgcn_make_buffer_rsrc(ACT, 0, MAXSLOT * DFF * 2, 0x00020000);
        float wv[2][4];
#pragma unroll
        for (int ai = 0; ai < 2; ++ai)
#pragma unroll
            for (int m = 0; m < 4; ++m) wv[ai][m] = SW[row0 + ai * 128 + m * 16];
        asm volatile("" ::: "memory");
#pragma unroll
        for (int ai = 0; ai < 2; ++ai)
#pragma unroll
            for (int m = 0; m < 4; ++m) { const int slot = row0 + ai * 128 + m * 16; const float w = wv[ai][m];
                const pg8::f32x4 a0 = acc[ai][0][m][0], a1 = acc[ai][0][m][1], b0 = acc[ai][1][m][0], b1 = acc[ai][1][m][1];
                v4u o; o.x = cvtpk(siluf_(a0[0]) * b0[0] * w, siluf_(a0[1]) * b0[1] * w); o.y = cvtpk(siluf_(a0[2]) * b0[2] * w, siluf_(a0[3]) * b0[3] * w);
                o.z = cvtpk(siluf_(a1[0]) * b1[0] * w, siluf_(a1[1]) * b1[1] * w); o.w = cvtpk(siluf_(a1[2]) * b1[2] * w, siluf_(a1[3]) * b1[3] * w);
                __builtin_amdgcn_raw_buffer_store_b128(o, rs, (unsigned)((slot * DFF + f0) * 2), 0,   16); }
    } };
struct EpiDown { static constexpr bool PERM = true, AFTER_DRAIN = false; bf16* YS2;
    __device__ __forceinline__ void operator()(const pg8::f32x4 (&acc)[2][2][4][2], const pg8::Unit& u, int wr, int wc, int fr, int fq) const {
        const int row0 = u.pm * 256 + wr * 64 + fr, col0 = (u.pn & 3) * 256 + wc * 32 + 8 * fq;
#pragma unroll
        for (int ai = 0; ai < 2; ++ai)
#pragma unroll
            for (int m = 0; m < 4; ++m) { bf16* rowp = YS2 + (size_t)(row0 + ai * 128 + m * 16) * D + col0;
#pragma unroll
                for (int bj = 0; bj < 2; ++bj) { const pg8::f32x4 v0 = acc[ai][bj][m][0], v1 = acc[ai][bj][m][1];
                    v4u w; w.x = cvtpk(v0[0], v0[1]); w.y = cvtpk(v0[2], v0[3]); w.z = cvtpk(v1[0], v1[1]); w.w = cvtpk(v1[2], v1[3]); *(v4u*)(rowp + bj * 128) = w; } }
    } };


__device__ __forceinline__ void ph2_fast(Frame& F, int l) {
    pg8::Gemm g{(const bf16*)HBUF(F), (const bf16*)(F.ws + WS_WIN), SEQ, INW, D, 0, nullptr}; pg8::StaticOrder S; S.init(SEQ, INW, F.G, F.bid);
    EpiProj E{(bf16*)(F.ws + WS_PROJ)}; pg8::gemm_phase<EpiProj, pg8::StaticOrder, PG_ALIGN, PG_SP2>(F.lds, g, S, E, F.tid);
}
__device__ __forceinline__ void ph6_fast(Frame& F, int l) {
    pg8::Gemm g{(const bf16*)(F.ws + WS_YG), (const bf16*)(F.ws + WS_WGLU), MT, MIXW, MIXW, 0, nullptr}; pg8::StaticOrder S; S.init(l == 0 ? MT : SEQ, MIXW, F.G, F.bid);
    EpiGlu E{(const bf16*)(F.ws + WS_YG), (bf16*)(F.ws + WS_YS)}; pg8::gemm_phase<EpiGlu, pg8::StaticOrder, PG_ALIGN, PG_SP2>(F.lds, g, S, E, F.tid);
}
__device__ __forceinline__ void ph7_fast(Frame& F, int l) {
    pg8::Gemm g{(const bf16*)(F.ws + WS_YS), (const bf16*)(F.ws + WS_WBR), 3 * MT, 3 * D, MIXW, 0, nullptr}; SchedBr S{F.G, F.bid, SEQ / 256};
    EpiBr E{(bf16*)(F.ws + WS_PROJ)}; pg8::gemm_phase<EpiBr, SchedBr, PG_ALIGN, PG_SP2>(F.lds, g, S, E, F.tid);
}
__device__ __forceinline__ void ph8_fast(Frame& F, int l) {
    pg8::Gemm g{(const bf16*)HBUF(F), (const bf16*)(F.ws + WS_WMG), MT, INW, D, 0, nullptr}; SchedMerge S{F.G, F.bid, SEQ / 256};
    EpiMerge E{(const bf16*)(F.ws + WS_PROJ), (bf16*)(F.ws + WS_PM), IN_(I_BMG) + l * INW}; pg8::gemm_phase<EpiMerge, SchedMerge, PG_ALIGN, PG_SP2>(F.lds, g, S, E, F.tid);
}
__device__ __forceinline__ void ph9_fast(Frame& F, int l) {
    pg8::Gemm g{(const bf16*)(F.ws + WS_PM), (const bf16*)(F.ws + WS_WO), MT, D, D, 0, nullptr}; pg8::StaticOrder S; S.init(SEQ, D, F.G, F.bid);
    EpiWo E{IN_(I_X), (bf16*)(F.ws + WS_X16), (const float*)(F.ws + WS_MOD) + (size_t)l * 2 * 6144, (float*)(F.ws + WS_RSS), l == 0 ? 1 : 0, 0};
    pg8::gemm_phase<EpiWo, pg8::StaticOrder, PG_ALIGN, PG_SP2>(F.lds, g, S, E, F.tid);
}
__device__ __forceinline__ void ph12_moe(Frame& F, int l) {
    LAS unsigned* tabu = (LAS unsigned*)(F.lds + MOETAB_OFF); LAS unsigned* tabd = tabu + 1024; unsigned* upc = F.ctl + CW_UPC + l * 256;
    const int nrt = moe_build_tables(F, F.ctl + CW_CNT + l * 128, tabu, tabd);
#define MOE_STAMP(i) do { if ((PROBE_A >= 0 || PROBE_B >= 0) && l == 0 && F.tid == 0) ((volatile LAS unsigned long long*)(F.lds + TS_OFF))[i] = __builtin_amdgcn_s_memrealtime(); } while (0)
    MOE_STAMP(60);
    { pg8::Gemm g{(const bf16*)HBUF(F), (const bf16*)(F.ws + WS_W13), MAXSLOT, NE * 512, D, 0, (const int*)(F.ws + WS_STOK)}; SchedMoeUp S{F.G, F.bid, nrt, F.tid, tabu, upc};
      EpiUp E{(bf16*)(F.ws + WS_ACT), (const float*)(F.ws + WS_SW)}; pg8::gemm_phase<EpiUp, SchedMoeUp, PG_ALIGN, PG_SP2, false, true>(F.lds, g, S, E, F.tid); }
    MOE_STAMP(61);
    { pg8::Gemm g{(const bf16*)(F.ws + WS_ACT), (const bf16*)(F.ws + WS_W2), MAXSLOT, NE * D, DFF, 0, nullptr}; SchedMoeDown S{F.G, F.bid, nrt, 0, tabd, upc};
      EpiDown E{(bf16*)(F.ws + WS_YS2)}; pg8::gemm_phase<EpiDown, SchedMoeDown, PG_ALIGN, PG_SP2, true>(F.lds, g, S, E, F.tid); }
    MOE_STAMP(62);
    if (PROBE_A == 99 && l == 0 && F.tid == 0) { volatile LAS unsigned long long* TS = (volatile LAS unsigned long long*)(F.lds + TS_OFF); __hip_atomic_fetch_max(F.ctl + 100, ((unsigned)(TS[62] - TS[12]) << 8) | (unsigned)F.bid, __ATOMIC_RELAXED, __HIP_MEMORY_SCOPE_AGENT); }
}


constexpr int NSB = MT / 16;
__device__ __forceinline__ void s5_precompute(Frame& F) {
    LAS float* APr = (LAS float*)F.lds; LAS float* APi = APr + 2176; LAS float* BBr = APi + 2176; LAS float* BBi = BBr + 2048; LAS float* CCr = BBi + 2048; LAS float* CCi = CCr + 2048; LAS float* KK = CCi + 2048;
    for (int item = F.G - 1 - F.bid; item < 2 * G5; item += F.G) { const int l = item >> 5, g = item & 31;
        __syncthreads();
        if (F.tid < 128) { const int d = F.tid >> 6, p = F.tid & 63; const int ldg = (l * 2 + d) * G5 + g;
            const double lr = IN_(I_LRE)[ldg * P5 + p], li = IN_(I_LIM)[ldg * P5 + p], dt = exp((double)IN_(I_LDT)[ldg]);
            for (int e = 0; e <= 16; ++e) { const double m = exp(lr * dt * e), ang = li * dt * e; APr[(d * 64 + p) * 17 + e] = (float)(m * cos(ang)); APi[(d * 64 + p) * 17 + e] = (float)(m * sin(ang)); }
            { const double m16 = exp(lr * dt * 16.0), a16 = li * dt * 16.0; float* A16 = (float*)(F.ws + WS_A16) + ((size_t)((l * 32 + g) * 2 + d) * 64 + p) * 2; A16[0] = (float)(m16 * cos(a16)); A16[1] = (float)(m16 * sin(a16)); }
            const double m1 = exp(lr * dt), ar = m1 * cos(li * dt), ai = m1 * sin(li * dt); const double nr = ar - 1.0, ni = ai, den = lr * lr + li * li;
            const double qr = (nr * lr + ni * li) / den, qi = (ni * lr - nr * li) / den;
            for (int h = 0; h < 16; ++h) { const double x = IN_(I_BRE)[((size_t)ldg * P5 + p) * H5 + h], y = IN_(I_BIM)[((size_t)ldg * P5 + p) * H5 + h];
                BBr[(d * 64 + p) * 16 + h] = (float)(qr * x - qi * y); BBi[(d * 64 + p) * 16 + h] = (float)(qr * y + qi * x);
                CCr[(d * 16 + h) * 64 + p] = IN_(I_CRE)[((size_t)ldg * H5 + h) * P5 + p]; CCi[(d * 16 + h) * 64 + p] = IN_(I_CIM)[((size_t)ldg * H5 + h) * P5 + p]; } }
        __syncthreads();
        { const int d = F.tid >> 8, e = (F.tid >> 4) & 15, hp = F.tid & 15;
          float wr[64], wi[64];
#pragma unroll
          for (int p = 0; p < 64; ++p) { const float pr = APr[(d * 64 + p) * 17 + e], pi = APi[(d * 64 + p) * 17 + e], br = BBr[(d * 64 + p) * 16 + hp], bi = BBi[(d * 64 + p) * 16 + hp]; wr[p] = pr * br - pi * bi; wi[p] = pr * bi + pi * br; }
#pragma unroll 1
          for (int h = 0; h < 16; ++h) { float a = 0.f;
#pragma unroll
              for (int p = 0; p < 64; ++p) a += CCr[(d * 16 + h) * 64 + p] * wr[p] - CCi[(d * 16 + h) * 64 + p] * wi[p];
              KK[(d * 16 + e) * 256 + h * 16 + hp] = a; } }
        __syncthreads();
        bf16* M = (bf16*)(F.ws + WS_S5M) + (size_t)(l * 32 + g) * 3 * 65536;
        for (int idx = F.tid; idx < 32768; idx += NT) {
            const int r = idx >> 7, k0 = (idx & 127) * 2; float v[3][2];
#pragma unroll
            for (int q = 0; q < 2; ++q) { const int kk = k0 + q;
                { const int d = r >> 7, p = (r >> 1) & 63, c = r & 1, sg = kk >> 4, hp = kk & 15, e = d == 0 ? 15 - sg : sg;
                  const float pr = APr[(d * 64 + p) * 17 + e], pi = APi[(d * 64 + p) * 17 + e], br = BBr[(d * 64 + p) * 16 + hp], bi = BBi[(d * 64 + p) * 16 + hp];
                  v[0][q] = c == 0 ? pr * br - pi * bi : pr * bi + pi * br; }
                { const int tau = r >> 4, h = r & 15, sg = kk >> 4, hp = kk & 15; float t = 0.f;
                  if (sg <= tau) t += KK[(0 * 16 + (tau - sg)) * 256 + h * 16 + hp]; if (sg >= tau) t += KK[(1 * 16 + (sg - tau)) * 256 + h * 16 + hp]; v[1][q] = t; }
                { const int tau = r >> 4, h = r & 15, d = kk >> 7, p = (kk >> 1) & 63, c = kk & 1, e = d == 0 ? tau + 1 : 16 - tau;
                  const float cr = CCr[(d * 16 + h) * 64 + p], ci = CCi[(d * 16 + h) * 64 + p], pr = APr[(d * 64 + p) * 17 + e], pi = APi[(d * 64 + p) * 17 + e];
                  v[2][q] = c == 0 ? cr * pr - ci * pi : -(cr * pi + ci * pr); } }
#pragma unroll
            for (int m = 0; m < 3; ++m) *(unsigned*)(M + (size_t)m * 65536 + r * 256 + k0) = pk2(v[m][0], v[m][1]);
        }
    }
}
constexpr int ZS_OFF = 16384, ZS_STRIDE = 528, EX_OFF = ZS_OFF + 144 * ZS_STRIDE, CARRY_OFF = EX_OFF + 4 * 128 * 16;
__device__ __forceinline__ void s5_fused_phase(Frame& F, int l) {
    const bf16* PROJ = (const bf16*)(F.ws + WS_PROJ); bf16* YG = (bf16*)(F.ws + WS_YG); const float* ds = IN_(I_DSKIP) + l * MIXW;
    unsigned long long* GR = (unsigned long long*)(F.ws + WS_GR); const unsigned tag = (unsigned)l + 1u;
    const int l15 = F.lane & 15, lq = F.lane >> 4; const int G8 = F.G & ~7;
    LAS unsigned char* ZS = F.lds + ZS_OFF; LAS float* EX = (LAS float*)(F.lds + EX_OFF); LAS float* CR = (LAS float*)(F.lds + CARRY_OFF);
    if (F.bid < G8)
    for (int item = F.bid; item < 256; item += G8) {
        const int g = item >> 3, p = item & 7;
        const bf16* vsrc = PROJ + (size_t)(16 * l15 + 2 * F.wave + (lq >> 1)) * INW + 16 * g + 8 * (lq & 1);
        {   const bf16* Fm = (const bf16*)(F.ws + WS_S5M) + (size_t)(l * 32 + g) * 3 * 65536;
            bf16x8 Af[2][8], nvz[9];
#pragma unroll
            for (int j = 0; j < 2; ++j)
#pragma unroll
                for (int ks = 0; ks < 8; ++ks) Af[j][ks] = *(const bf16x8*)(Fm + (size_t)(16 * (2 * F.wave + j) + l15) * 256 + 32 * ks + 8 * lq);
#pragma unroll
            for (int s = 0; s < 9; ++s) nvz[s] = *(const bf16x8*)(vsrc + (size_t)(s == 0 ? 64 : 8 * p + s - 1) * 256 * INW);
            __syncthreads();
            *(LAS bf16x8*)(F.lds + (F.wave * 64 + F.lane) * 16) = nvz[0];
            __syncthreads();
            int cur = 0;
#pragma unroll
            for (int s = 0; s < 9; ++s) {
                f32x4 acc[2] = {{0.f, 0.f, 0.f, 0.f}, {0.f, 0.f, 0.f, 0.f}};
#pragma unroll
                for (int ks = 0; ks < 8; ++ks) { const bf16x8 V = *(const LAS bf16x8*)(F.lds + cur * 8192 + (ks * 64 + F.lane) * 16);
#pragma unroll
                    for (int j = 0; j < 2; ++j) acc[j] = __builtin_amdgcn_mfma_f32_16x16x32_bf16(Af[j][ks], V, acc[j], 0, 0, 0); }
#pragma unroll
                for (int j = 0; j < 2; ++j) { v2u zz; zz.x = pk2(acc[j][0], acc[j][1]); zz.y = pk2(acc[j][2], acc[j][3]); *(LAS v2u*)(ZS + (s * 16 + l15) * ZS_STRIDE + (16 * (2 * F.wave + j) + 4 * lq) * 2) = zz; }
                if (s < 8) *(LAS bf16x8*)(F.lds + (cur ^ 1) * 8192 + (F.wave * 64 + F.lane) * 16) = nvz[s + 1];
                __syncthreads();
                cur ^= 1;
            }
        }
        {   const int c = F.tid & 127, j = F.tid >> 7, d = c >> 6;
            const float* A16 = (const float*)(F.ws + WS_A16) + ((size_t)((l * 32 + g) * 2 + d) * 64 + (c & 63)) * 2; const float ar = A16[0], ai = A16[1];
            LAS unsigned char* zc = ZS + c * 4;
            float hr = 0.f, hi = 0.f, pr = 1.f, pi = 0.f;
#pragma unroll 4
            for (int q = 0; q < 32; ++q) { const int i = 32 * j + q, row = 16 + (d ? 127 - i : i); const unsigned zw = *(const LAS unsigned*)(zc + row * ZS_STRIDE);
                const float nr = ar * hr - ai * hi + bflo(zw), ni = ar * hi + ai * hr + bfhi(zw); hr = nr; hi = ni; const float qr = pr * ar - pi * ai, qi = pr * ai + pi * ar; pr = qr; pi = qi; }
            EX[(j * 128 + c) * 4 + 0] = hr; EX[(j * 128 + c) * 4 + 1] = hi; EX[(j * 128 + c) * 4 + 2] = pr; EX[(j * 128 + c) * 4 + 3] = pi;
            __syncthreads();
            if (j == 0) {
                float er = 0.f, ei = 0.f, Ar = 1.f, Ai = 0.f;
#pragma unroll
                for (int jj = 0; jj < 4; ++jj) { const float h0 = EX[(jj * 128 + c) * 4], h1 = EX[(jj * 128 + c) * 4 + 1], q0 = EX[(jj * 128 + c) * 4 + 2], q1 = EX[(jj * 128 + c) * 4 + 3];
                    const float nr = q0 * er - q1 * ei + h0, ni = q0 * ei + q1 * er + h1; er = nr; ei = ni; const float tr = Ar * q0 - Ai * q1, ti = Ar * q1 + Ai * q0; Ar = tr; Ai = ti; }
                unsigned long long* mine = GR + ((size_t)(g * 8 + p) * 128 + c) * 2;
                __hip_atomic_store(mine, ((unsigned long long)tag << 32) | __builtin_bit_cast(unsigned, er), __ATOMIC_RELAXED, __HIP_MEMORY_SCOPE_AGENT);
                __hip_atomic_store(mine + 1, ((unsigned long long)tag << 32) | __builtin_bit_cast(unsigned, ei), __ATOMIC_RELAXED, __HIP_MEMORY_SCOPE_AGENT);
                float cr = 0.f, ci = 0.f;
#pragma unroll 4
                for (int i = 0; i < 16; ++i) { const int row = d ? 15 - i : i; const unsigned zw = *(const LAS unsigned*)(zc + row * ZS_STRIDE); *(LAS unsigned*)(zc + row * ZS_STRIDE) = pk2(cr, ci);
                    const float nr = ar * cr - ai * ci + bflo(zw), ni = ar * ci + ai * cr + bfhi(zw); cr = nr; ci = ni; }
                const int np = d ? 7 - p : p;
#pragma unroll 1
                for (int t = 0; t < np; ++t) { const int pp = d ? 7 - t : t; unsigned long long* o = GR + ((size_t)(g * 8 + pp) * 128 + c) * 2; unsigned long long x0, x1; unsigned spins = 0;
                    for (;;) { x0 = __hip_atomic_load(o, __ATOMIC_RELAXED, __HIP_MEMORY_SCOPE_AGENT); x1 = __hip_atomic_load(o + 1, __ATOMIC_RELAXED, __HIP_MEMORY_SCOPE_AGENT);
                        if ((unsigned)(x0 >> 32) == tag && (unsigned)(x1 >> 32) == tag) break; __builtin_amdgcn_s_sleep(2); if (++spins > (1u << 22)) break; }
                    const float e0 = __builtin_bit_cast(float, (unsigned)x0), e1 = __builtin_bit_cast(float, (unsigned)x1);
                    const float nr = Ar * cr - Ai * ci + e0, ni = Ar * ci + Ai * cr + e1; cr = nr; ci = ni; }
                CR[c * 2] = cr; CR[c * 2 + 1] = ci;
            }
            __syncthreads();
            float sr = CR[c * 2], si = CR[c * 2 + 1];
            for (int jj = 0; jj < j; ++jj) { const float h0 = EX[(jj * 128 + c) * 4], h1 = EX[(jj * 128 + c) * 4 + 1], q0 = EX[(jj * 128 + c) * 4 + 2], q1 = EX[(jj * 128 + c) * 4 + 3];
                const float nr = q0 * sr - q1 * si + h0, ni = q0 * si + q1 * sr + h1; sr = nr; si = ni; }
#pragma unroll 4
            for (int q = 0; q < 32; ++q) { const int i = 32 * j + q, row = 16 + (d ? 127 - i : i); const unsigned zw = *(const LAS unsigned*)(zc + row * ZS_STRIDE); *(LAS unsigned*)(zc + row * ZS_STRIDE) = pk2(sr, si);
                const float nr = ar * sr - ai * si + bflo(zw), ni = ar * si + ai * sr + bfhi(zw); sr = nr; si = ni; }
        }
        {   const bf16* Tm = (const bf16*)(F.ws + WS_S5M) + ((size_t)(l * 32 + g) * 3 + 1) * 65536; const bf16* Em = Tm + 65536;
            bf16x8 At[2][8], Ae[2][8];
#pragma unroll
            for (int j = 0; j < 2; ++j)
#pragma unroll
                for (int ks = 0; ks < 8; ++ks) { const size_t o = (size_t)(16 * (2 * F.wave + j) + l15) * 256 + 32 * ks + 8 * lq; At[j][ks] = *(const bf16x8*)(Tm + o); Ae[j][ks] = *(const bf16x8*)(Em + o); }
            const f32x4 dsk = *(const f32x4*)(ds + 16 * g + 4 * lq);
            const int s0 = (p == 0 && l == 0) ? 0 : 1;
            bf16x8 nA = *(const bf16x8*)(vsrc + (size_t)(s0 == 0 ? 64 : 8 * p) * 256 * INW), nB = *(const bf16x8*)(vsrc + (size_t)(8 * p + s0) * 256 * INW), nC = *(const bf16x8*)(vsrc + (size_t)(8 * p + s0 + 1) * 256 * INW);
            __syncthreads();
            *(LAS bf16x8*)(F.lds + (F.wave * 64 + F.lane) * 16) = nA;
            __syncthreads();
            int cur = 0;
#pragma unroll 1
            for (int s = s0; s < 9; ++s) { const int tl = s == 0 ? 64 : 8 * p + s - 1;
                bf16x8 nD = nC; if (s + 3 < 9) nD = *(const bf16x8*)(vsrc + (size_t)(8 * p + s + 2) * 256 * INW);
                v2u uu[2];
#pragma unroll
                for (int j = 0; j < 2; ++j) uu[j] = *(const LAS v2u*)(F.lds + cur * 8192 + (F.wave * 64 + l15 + 16 * (2 * j + (lq >> 1))) * 16 + 8 * (lq & 1));
                f32x4 acc[2] = {{0.f, 0.f, 0.f, 0.f}, {0.f, 0.f, 0.f, 0.f}};
#pragma unroll
                for (int ks = 0; ks < 8; ++ks) { const bf16x8 V = *(const LAS bf16x8*)(F.lds + cur * 8192 + (ks * 64 + F.lane) * 16), S = *(const LAS bf16x8*)(ZS + (s * 16 + l15) * ZS_STRIDE + (32 * ks + 8 * lq) * 2);
#pragma unroll
                    for (int j = 0; j < 2; ++j) { acc[j] = __builtin_amdgcn_mfma_f32_16x16x32_bf16(At[j][ks], V, acc[j], 0, 0, 0); acc[j] = __builtin_amdgcn_mfma_f32_16x16x32_bf16(Ae[j][ks], S, acc[j], 0, 0, 0); } }
#pragma unroll
                for (int j = 0; j < 2; ++j) { const size_t row = (size_t)tl * 256 + 16 * l15 + (2 * F.wave + j); const int ch = 16 * g + 4 * lq; const v2u u = uu[j];
                    const float y0 = acc[j][0] + dsk[0] * bflo(u.x), y1 = acc[j][1] + dsk[1] * bfhi(u.x), y2 = acc[j][2] + dsk[2] * bflo(u.y), y3 = acc[j][3] + dsk[3] * bfhi(u.y);
                    v2u w; w.x = cvtpk(geluf_(y0), geluf_(y1)); w.y = cvtpk(geluf_(y2), geluf_(y3)); *(v2u*)(YG + row * MIXW + ch) = w; }
                if (s < 8) *(LAS bf16x8*)(F.lds + (cur ^ 1) * 8192 + (F.wave * 64 + F.lane) * 16) = nB;
                __syncthreads();
                cur ^= 1; nB = nC; nC = nD;
            }
        }
    }
}
__device__ __forceinline__ int s5_chain_sb(int d, int i) { return d == 0 ? (i < 16 ? 1024 + i : i - 16) : (i < 16 ? 1039 - i : 1023 - (i - 16)); }
__device__ __forceinline__ void sg_fast_item(Frame& F, int l, int chunk, int pass) {
    const bf16* PROJ = (const bf16*)(F.ws + WS_PROJ); bf16* YB = (bf16*)(F.ws + WS_YS) + (size_t)MT * MIXW; const bf16* WSG = (const bf16*)(F.ws + WS_WSG);
    const float* lg = IN_(I_SGG) + l * MIXW; const float* lb = IN_(I_SGB) + l * MIXW; const float* bsg = IN_(I_BSG) + l * 512;
    LAS float* st = (LAS float*)(F.lds + 131072 + 2048); LAS unsigned char* WL = F.lds + 65536;
    __syncthreads();
    v4u wst[8];
#pragma unroll
    for (int i = 0; i < 8; ++i) { const int pid = F.tid + NT * i, ln = pid & 63, rest = pid >> 6, ks = rest & 3, cb = (rest >> 2) & 7, gl = rest >> 5;
        wst[i] = *(const v4u*)(WSG + ((size_t)(pass * 2 + gl) * 128 + cb * 16 + (ln & 15)) * 128 + 32 * ks + 8 * (ln >> 4)); }
    v4u iw[4][2];
#pragma unroll
    for (int q4 = 0; q4 < 4; ++q4) { const int it = F.tid + NT * q4, tp = it & 63, cg = it >> 6; const int p0 = tp * 2, ch = pass * 256 + cg * 8;
        iw[q4][0] = *(const v4u*)(PROJ + (size_t)(chunk * 128 + p0) * INW + 1024 + ch); iw[q4][1] = *(const v4u*)(PROJ + (size_t)(chunk * 128 + p0 + 1) * INW + 1024 + ch); }
    {
        const int p = F.tid >> 2, part = F.tid & 3; const bf16* vr = PROJ + (size_t)(chunk * 128 + p) * INW + 1024 + part * 128; float s = 0.f, q = 0.f;
        v4u sv[16];
#pragma unroll
        for (int c = 0; c < 16; ++c) sv[c] = *(const v4u*)(vr + 8 * c);
#pragma unroll
        for (int c = 0; c < 16; ++c) { const v4u w = sv[c]; const float x[8] = {bflo(w.x), bfhi(w.x), bflo(w.y), bfhi(w.y), bflo(w.z), bfhi(w.z), bflo(w.w), bfhi(w.w)};
#pragma unroll
            for (int i = 0; i < 8; ++i) { s += x[i]; q += x[i] * x[i]; } }
        s += shflx(s, 1, F.lane); q += shflx(q, 1, F.lane); s += shflx(s, 2, F.lane); q += shflx(q, 2, F.lane);
        const float mu = s * (1.f / 512.f), var = fmaxf(q * (1.f / 512.f) - mu * mu, 0.f);
        if (part == 0) { st[p * 2] = mu; st[p * 2 + 1] = rsqrtf(var + EPS); }
    }
#pragma unroll
    for (int i = 0; i < 8; ++i) *(LAS v4u*)(WL + (F.tid + NT * i) * 16) = wst[i];
    __syncthreads();
    const int l15 = F.lane & 15, lq = F.lane >> 4;
#pragma unroll
    for (int q4 = 0; q4 < 4; ++q4) { const int it = F.tid + NT * q4; const int tp = it & 63, cg = it >> 6; const int p0 = tp * 2, ch = pass * 256 + cg * 8;
        const v4u w0 = iw[q4][0], w1 = iw[q4][1];
        const float mu0 = st[p0 * 2], rs0 = st[p0 * 2 + 1], mu1 = st[p0 * 2 + 2], rs1 = st[p0 * 2 + 3];
        const float x0[8] = {bflo(w0.x), bfhi(w0.x), bflo(w0.y), bfhi(w0.y), bflo(w0.z), bfhi(w0.z), bflo(w0.w), bfhi(w0.w)};
        const float x1[8] = {bflo(w1.x), bfhi(w1.x), bflo(w1.y), bfhi(w1.y), bflo(w1.z), bfhi(w1.z), bflo(w1.w), bfhi(w1.w)};
#pragma unroll
        for (int i = 0; i < 8; ++i) { const float gm = lg[ch + i], bt = lb[ch + i]; const int c = cg * 8 + i;
            *(LAS unsigned*)(F.lds + c * 256 + (((p0 >> 3) ^ (c & 15)) << 4) + (p0 & 7) * 2) = pk2((x0[i] - mu0) * rs0 * gm + bt, (x1[i] - mu1) * rs1 * gm + bt); } }
    __syncthreads();
    const int ggl = F.wave >> 2, gg = pass * 2 + ggl, rb0 = (F.wave & 3) * 2;
    bf16x8 A[2][4];
#pragma unroll
    for (int j = 0; j < 2; ++j)
#pragma unroll
        for (int ks = 0; ks < 4; ++ks) { const int c = ggl * 128 + (rb0 + j) * 16 + l15; A[j][ks] = *(const LAS bf16x8*)(F.lds + c * 256 + (((4 * ks + lq) ^ (c & 15)) << 4)); }
    f32x4 acc[2][8];
#pragma unroll
    for (int j = 0; j < 2; ++j)
#pragma unroll
        for (int cb = 0; cb < 8; ++cb) acc[j][cb] = (f32x4){0.f, 0.f, 0.f, 0.f};
#pragma unroll
    for (int cb = 0; cb < 8; ++cb)
#pragma unroll
        for (int ks = 0; ks < 4; ++ks) { const bf16x8 B = *(const LAS bf16x8*)(WL + ((((ggl * 8 + cb) * 4 + ks) * 64) + F.lane) * 16);
#pragma unroll
            for (int j = 0; j < 2; ++j) acc[j][cb] = __builtin_amdgcn_mfma_f32_16x16x32_bf16(A[j][ks], B, acc[j][cb], 0, 0, 0); }
    v2u guv[8][2];
#pragma unroll
    for (int cb = 0; cb < 8; ++cb)
#pragma unroll
        for (int j = 0; j < 2; ++j) guv[cb][j] = *(const v2u*)(PROJ + ((size_t)chunk * 128 + cb * 16 + l15) * INW + 512 + gg * 128 + (rb0 + j) * 16 + 4 * lq);
    asm volatile("" ::: "memory");
#pragma unroll
    for (int cb = 0; cb < 8; ++cb) { const int q = cb * 16 + l15; const size_t row = (size_t)chunk * 128 + q; const float bq = bsg[gg * 128 + q];
#pragma unroll
        for (int j = 0; j < 2; ++j) { const int col = gg * 128 + (rb0 + j) * 16 + 4 * lq; const v2u gu = guv[cb][j];
            v2u w; w.x = cvtpk(bflo(gu.x) * (acc[j][cb][0] + bq), bfhi(gu.x) * (acc[j][cb][1] + bq)); w.y = cvtpk(bflo(gu.y) * (acc[j][cb][2] + bq), bfhi(gu.y) * (acc[j][cb][3] + bq));
            *(v2u*)(YB + row * MIXW + col) = w; } }
}

__device__ __forceinline__ bf16x8 sum3_bf16x8(const bf16* p, size_t stride) {
    const v4u a = *(const v4u*)p, b = *(const v4u*)(p + stride), c = *(const v4u*)(p + 2 * stride); v4u o;
    o.x = pk2(bflo(a.x) + bflo(b.x) + bflo(c.x), bfhi(a.x) + bfhi(b.x) + bfhi(c.x)); o.y = pk2(bflo(a.y) + bflo(b.y) + bflo(c.y), bfhi(a.y) + bfhi(b.y) + bfhi(c.y));
    o.z = pk2(bflo(a.z) + bflo(b.z) + bflo(c.z), bfhi(a.z) + bfhi(b.z) + bfhi(c.z)); o.w = pk2(bflo(a.w) + bflo(b.w) + bflo(c.w), bfhi(a.w) + bfhi(b.w) + bfhi(c.w));
    return __builtin_bit_cast(bf16x8, o);
}
template <int RB, int CB, bool SUM3, class EF>
__device__ __forceinline__ void thin_block(const bf16* A, int lda, size_t astride, const bf16* Bt, int K, int row0, int col0, int wave, int lane, LAS unsigned char* lds, const EF& ef) {
    constexpr int NTL = RB * CB; const int r = lane & 15, q = lane >> 4;
    if constexpr (NTL >= 8) {
        constexpr int TPW = NTL / 8, WPR = CB / TPW;
        const int rb = wave / WPR, cb0 = (wave % WPR) * TPW;
        const bf16* a = A + (size_t)(row0 + 16 * rb + r) * lda + 8 * q; const bf16* b = Bt + (size_t)(col0 + 16 * cb0 + r) * K + 8 * q;
        f32x4 acc[TPW];
#pragma unroll
        for (int c = 0; c < TPW; ++c) acc[c] = (f32x4){0.f, 0.f, 0.f, 0.f};
        bf16x8 xa[8], wa[TPW][8], xb[8], wb[TPW][8];
#define THIN_LD(x, w, kk) do { _Pragma("unroll") for (int j = 0; j < 8; ++j) { x[j] = SUM3 ? sum3_bf16x8(a + 32 * ((kk) + j), astride) : *(const bf16x8*)(a + 32 * ((kk) + j)); \
            _Pragma("unroll") for (int c = 0; c < TPW; ++c) w[c][j] = *(const bf16x8*)(b + (size_t)(16 * c) * K + 32 * ((kk) + j)); } } while (0)
#define THIN_MM(x, w) do { _Pragma("unroll") for (int j = 0; j < 8; ++j) _Pragma("unroll") for (int c = 0; c < TPW; ++c) acc[c] = __builtin_amdgcn_mfma_f32_16x16x32_bf16(x[j], w[c][j], acc[c], 0, 0, 0); } while (0)
        THIN_LD(xa, wa, 0);
#pragma unroll 1
        for (int k0 = 0; k0 < K / 32; k0 += 16) {
            THIN_LD(xb, wb, k0 + 8); __builtin_amdgcn_sched_barrier(0); THIN_MM(xa, wa); __builtin_amdgcn_sched_barrier(0);
            if (k0 + 16 < K / 32) THIN_LD(xa, wa, k0 + 16);
            __builtin_amdgcn_sched_barrier(0); THIN_MM(xb, wb); __builtin_amdgcn_sched_barrier(0);
        }
#undef THIN_LD
#undef THIN_MM
#pragma unroll
        for (int c = 0; c < TPW; ++c)
#pragma unroll
            for (int i = 0; i < 4; ++i) ef(row0 + 16 * rb + 4 * q + i, col0 + 16 * (cb0 + c) + r, acc[c][i]);
    } else {
        constexpr int KS = 8 / NTL;
        const int t = wave % NTL, kp = wave / NTL, rb = t / CB, cb = t % CB; const int kw = K / KS;
        const bf16* a = A + (size_t)(row0 + 16 * rb + r) * lda + kp * kw + 8 * q; const bf16* b = Bt + (size_t)(col0 + 16 * cb + r) * K + kp * kw + 8 * q;
        f32x4 acc = {0.f, 0.f, 0.f, 0.f};
        bf16x8 xa[4], wa[4], xb[4], wb[4];
#define THIN_LD(x, w, kk) do { _Pragma("unroll") for (int j = 0; j < 4; ++j) { x[j] = SUM3 ? sum3_bf16x8(a + 32 * ((kk) + j), astride) : *(const bf16x8*)(a + 32 * ((kk) + j)); w[j] = *(const bf16x8*)(b + 32 * ((kk) + j)); } } while (0)
#define THIN_MM(x, w) do { _Pragma("unroll") for (int j = 0; j < 4; ++j) acc = __builtin_amdgcn_mfma_f32_16x16x32_bf16(x[j], w[j], acc, 0, 0, 0); } while (0)
        THIN_LD(xa, wa, 0);
#pragma unroll 1
        for (int k0 = 0; k0 < kw / 32; k0 += 8) {
            THIN_LD(xb, wb, k0 + 4); __builtin_amdgcn_sched_barrier(0); THIN_MM(xa, wa); __builtin_amdgcn_sched_barrier(0);
            if (k0 + 8 < kw / 32) THIN_LD(xa, wa, k0 + 8);
            __builtin_amdgcn_sched_barrier(0); THIN_MM(xb, wb); __builtin_amdgcn_sched_barrier(0);
        }
#undef THIN_LD
#undef THIN_MM
        __syncthreads();
        *(LAS f32x4*)(lds + (wave * 64 + lane) * 16) = acc;
        __syncthreads();
        if (kp == 0) { f32x4 s = acc;
#pragma unroll
            for (int p = 1; p < KS; ++p) s = s + *(const LAS f32x4*)(lds + ((p * NTL + t) * 64 + lane) * 16);
#pragma unroll
            for (int i = 0; i < 4; ++i) ef(row0 + 16 * rb + 4 * q + i, col0 + 16 * cb + r, s[i]); }
    }
}
template <bool SUM3, class EF>
__device__ __forceinline__ void thin_lds(const bf16* A, int lda, size_t astride, const bf16* Bt, int K, int row0, int col0, int tid, int wave, int lane, LAS unsigned char* lds, const EF& ef) {
    const int r = lane & 15, q = lane >> 4, rb = wave >> 1, cb0 = (wave & 1) * 2;
    f32x4 acc[2] = {{0.f, 0.f, 0.f, 0.f}, {0.f, 0.f, 0.f, 0.f}};
    v4u xs[8], wv[8];
    const int prow = tid >> 6, ppc = tid & 63;
#define TL_LD(c) do { _Pragma("unroll") for (int i = 0; i < 8; ++i) { const bf16* ap = A + (size_t)(row0 + prow + 8 * i) * lda + (c) * 512 + ppc * 8; \
        xs[i] = SUM3 ? __builtin_bit_cast(v4u, sum3_bf16x8(ap, astride)) : *(const v4u*)ap; wv[i] = *(const v4u*)(Bt + (size_t)(col0 + prow + 8 * i) * K + (c) * 512 + ppc * 8); } } while (0)
    const int nch = K / 512;
    TL_LD(0);
#pragma unroll 1
    for (int c = 0; c < nch; ++c) {
        __syncthreads();
#pragma unroll
        for (int i = 0; i < 8; ++i) { const int row = prow + 8 * i; const int o = row * 1024 + ((ppc ^ (row & 15)) << 4); *(LAS v4u*)(lds + o) = xs[i]; *(LAS v4u*)(lds + 65536 + o) = wv[i]; }
        __syncthreads();
        if (c + 1 < nch) TL_LD(c + 1);
        __builtin_amdgcn_sched_barrier(0);
#pragma unroll
        for (int ks = 0; ks < 16; ++ks) { const int po = ((4 * ks + q) ^ r) << 4;
            const bf16x8 x = *(const LAS bf16x8*)(lds + (16 * rb + r) * 1024 + po);
            const bf16x8 w0 = *(const LAS bf16x8*)(lds + 65536 + (16 * cb0 + r) * 1024 + po), w1 = *(const LAS bf16x8*)(lds + 65536 + (16 * (cb0 + 1) + r) * 1024 + po);
            acc[0] = __builtin_amdgcn_mfma_f32_16x16x32_bf16(x, w0, acc[0], 0, 0, 0); acc[1] = __builtin_amdgcn_mfma_f32_16x16x32_bf16(x, w1, acc[1], 0, 0, 0); }
    }
#undef TL_LD
#pragma unroll
    for (int c = 0; c < 2; ++c)
#pragma unroll
        for (int i = 0; i < 4; ++i) ef(row0 + 16 * rb + 4 * q + i, col0 + 16 * (cb0 + c) + r, acc[c][i]);
    __syncthreads();
}
struct CtxProj { bf16* P; __device__ __forceinline__ void operator()(int row, int col, float v) const { const float o = (col >= 512 && col < 1536) ? geluf_(v) : v; P[(size_t)row * INW + col] = (bf16)f2bf(o); } };
struct CtxGlu { const bf16* YG; bf16* YA; __device__ __forceinline__ void operator()(int row, int col, float v) const { YA[(size_t)row * MIXW + col] = (bf16)f2bf(bf2f(YG[(size_t)row * MIXW + col]) * sigmoidf_(v)); } };
struct CtxBr { bf16* BR; int kk; __device__ __forceinline__ void operator()(int row, int col, float v) const { BR[(size_t)row * INW + kk * 1024 + col] = (bf16)f2bf(v); } };
struct CtxMerge { const bf16* BR; bf16* PMK; const float* bm; int kk; __device__ __forceinline__ void operator()(int row, int col, float v) const {
    PMK[((size_t)kk * CTX + row) * D + col] = (bf16)f2bf(sigmoidf_(v + bm[kk * 1024 + col]) * bf2f(BR[(size_t)row * INW + kk * 1024 + col])); } };
struct CtxWo { const float* xs; float* XC; const float* ga; __device__ __forceinline__ void operator()(int row, int col, float v) const { XC[(size_t)row * D + col] = xs[(size_t)row * D + col] + ga[col] * v; } };
__device__ __forceinline__ void ph2_ctx(Frame& F, int ncols) {
    const bf16* Hc = (const bf16*)HBUF(F) + (size_t)SEQ * D; const bf16* W = (const bf16*)(F.ws + WS_WIN); CtxProj ef{(bf16*)(F.ws + WS_PROJ) + (size_t)SEQ * INW};
    if (ncols == INW) { for (int it = F.bid; it < 4 * (INW / 64); it += F.G) thin_lds<false>(Hc, D, 0, W, D, (it & 3) * 64, (it >> 2) * 64, F.tid, F.wave, F.lane, F.lds, ef); }
    else { for (int it = F.bid; it < 8 * (ncols / 16); it += F.G) thin_block<2, 1, false>(Hc, D, 0, W, D, (it & 7) * 32, (it >> 3) * 16, F.wave, F.lane, F.lds, ef); }
}
__device__ __forceinline__ void ph7_ctx(Frame& F) {
    for (int it = F.bid; it < 3 * 64; it += F.G) { const int kk = it / 64, j = it % 64; CtxBr ef{(bf16*)(F.ws + WS_PROJ) + (size_t)SEQ * INW, kk};
        thin_lds<false>((const bf16*)(F.ws + WS_YS) + ((size_t)kk * MT + SEQ) * MIXW, MIXW, 0, (const bf16*)(F.ws + WS_WBR) + (size_t)kk * 1024 * MIXW, MIXW, (j & 3) * 64, (j >> 2) * 64, F.tid, F.wave, F.lane, F.lds, ef); }
}
__device__ __forceinline__ void ph8_ctx(Frame& F, int l) {
    const bf16* Hc = (const bf16*)HBUF(F) + (size_t)SEQ * D;
    for (int it = F.bid; it < 3 * 64; it += F.G) { const int kk = it / 64, j = it % 64; CtxMerge ef{(const bf16*)(F.ws + WS_PROJ) + (size_t)SEQ * INW, (bf16*)(F.ws + WS_Z), IN_(I_BMG) + l * INW, kk};
        thin_lds<false>(Hc, D, 0, (const bf16*)(F.ws + WS_WMG) + (size_t)kk * 1024 * D, D, (j & 3) * 64, (j >> 2) * 64, F.tid, F.wave, F.lane, F.lds, ef); }
}
__device__ __forceinline__ void ph9_ctx(Frame& F, int l) {
    CtxWo ef{l == 0 ? IN_(I_CTX) : (const float*)(F.ws + WS_XC), (float*)(F.ws + WS_XC), (const float*)(F.ws + WS_MOD) + (size_t)(l * 2 + 1) * 6144 + 2048};
    for (int it = F.bid; it < 4 * 16; it += F.G) thin_lds<true>((const bf16*)(F.ws + WS_Z), D, (size_t)CTX * D, (const bf16*)(F.ws + WS_WO), D, (it & 3) * 64, (it >> 2) * 64, F.tid, F.wave, F.lane, F.lds, ef);
}
__device__ __forceinline__ void ctx_x1_fixup(Frame& F, int l, int row0) {
    const float* XC = (const float*)(F.ws + WS_XC); float* RSS = (float*)(F.ws + WS_RSS);
    const int rr = row0 + (F.tid >> 5), part = F.tid & 31; const float* xr = XC + (size_t)rr * D + part * 32; float s = 0.f;
#pragma unroll
    for (int c = 0; c < 32; c += 4) { const f32x4 v = *(const f32x4*)(xr + c); s += v.x * v.x + v.y * v.y + v.z * v.z + v.w * v.w; }
    s += shflx(s, 1, F.lane); s += shflx(s, 2, F.lane); s += shflx(s, 4, F.lane); s += shflx(s, 8, F.lane); s += shflx(s, 16, F.lane);
    if (part < 16) RSS[(size_t)(SEQ + rr) * 16 + part] = part == 0 ? s : 0.f;
    asm volatile("s_waitcnt vmcnt(0)" ::: "memory");
    __syncthreads();
}


__device__ __forceinline__ void ph0_prologue(Frame& F) {
    float* mod = (float*)(F.ws + WS_MOD);
    LAS float* SV = (LAS float*)(F.lds + 131072 + 4096);
    for (int i = F.tid; i < 2048; i += NT) SV[i] = siluf_(i < 1024 ? IN_(I_C)[i] : IN_(I_CCTX)[i - 1024]);
    __syncthreads();
    LAS float* RED = (LAS float*)(F.lds + 131072 + 4096 + 8192);
    for (int it = F.bid; it < 2 * 96; it += F.G) { const int l = it / 96, j = (it % 96) * 64 + F.lane;
        const float* W = IN_(I_WADA) + (size_t)l * D * 6144 + j + (size_t)(F.wave * 128) * 6144;
        float a0 = 0.f, a1 = 0.f;
#pragma unroll 32
        for (int kk = 0; kk < 128; ++kk) { const float w = W[(size_t)kk * 6144]; a0 += SV[F.wave * 128 + kk] * w; a1 += SV[1024 + F.wave * 128 + kk] * w; }
        __syncthreads();
        RED[(F.wave * 2 + 0) * 64 + F.lane] = a0; RED[(F.wave * 2 + 1) * 64 + F.lane] = a1;
        __syncthreads();
        if (F.wave < 2) { float s = 0.f;
#pragma unroll
            for (int w8 = 0; w8 < 8; ++w8) s += RED[(w8 * 2 + F.wave) * 64 + F.lane];
            mod[(size_t)(l * 2 + F.wave) * 6144 + j] = s + IN_(I_BADA)[l * 6144 + j]; }
    }
}
__device__ __forceinline__ void stage_mod(Frame& F, const float* g, int l, int sh_off, int sc_off, LAS float* GC, LAS float* SH) {
    __syncthreads();
    for (int i = F.tid; i < 2048; i += NT) { const int w = i >> 10, c = i & 1023; const float* m = (const float*)(F.ws + WS_MOD) + (size_t)(l * 2 + w) * 6144; GC[i] = g[c] * (1.f + m[sc_off + c]); SH[i] = m[sh_off + c]; }
    __syncthreads();
}
__device__ __forceinline__ void hprep_rows(Frame& F, int l) {
    bf16* H = (bf16*)HBUF(F); LAS float* GC = (LAS float*)F.lds; LAS float* SH = GC + 2048;
    stage_mod(F, IN_(I_GMIX) + l * D, l, 0, 1024, GC, SH);
    const int gw = F.bid * (NT / 64) + F.wave, ngw = F.G * (NT / 64);
    for (int row = gw; row < MT; row += ngw) {
        const float* xr = xin_row(F, row); const int pv = row >= SEQ ? 1024 : 0;
        f32x4 v[4]; float s = 0.f;
#pragma unroll
        for (int j = 0; j < 4; ++j) { v[j] = *(const f32x4*)(xr + 4 * F.lane + 256 * j); s += v[j].x * v[j].x + v[j].y * v[j].y + v[j].z * v[j].z + v[j].w * v[j].w; }
        const float rstd = rsqrtf(wave_sum(s, F.lane) * (1.f / D) + EPS);
#pragma unroll
        for (int j = 0; j < 4; ++j) { const int c = 4 * F.lane + 256 * j; const f32x4 gc = *(const LAS f32x4*)(GC + pv + c), sh = *(const LAS f32x4*)(SH + pv + c);
            const f32x4 o = v[j] * rstd * gc + sh; v2u w; w.x = pk2(o.x, o.y); w.y = pk2(o.z, o.w); *(v2u*)(H + (size_t)row * D + c) = w; }
    }
}
__device__ __forceinline__ void ph3_conv(Frame& F, int l, int nrows) {
    const bf16* PROJ = (const bf16*)(F.ws + WS_PROJ); bf16* YC = (bf16*)(F.ws + WS_YS) + (size_t)2 * MT * MIXW; const float* wc = IN_(I_WCONV) + l * 3 * MIXW;
    const size_t gt = (size_t)F.bid * NT + F.tid, ngt = (size_t)F.G * NT;
#pragma unroll 2
    for (size_t i = gt; i < (size_t)nrows * (MIXW / 8); i += ngt) {
        const int row = (int)(i / (MIXW / 8)), c = (int)(i % (MIXW / 8)) * 8;
        int pos, rl; if (row < SEQ) { pos = row & 63; rl = 64; } else { pos = row - SEQ; rl = 256; }
        const bf16* r0 = PROJ + (size_t)row * INW + 1536 + c;
        const v4u zero = {0u, 0u, 0u, 0u};
        const v4u b0 = *(const v4u*)(r0), c0 = *(const v4u*)(r0 + 512), h0 = *(const v4u*)(r0 + 1024);
        const v4u cm = pos > 0 ? *(const v4u*)(r0 - INW + 512) : zero, hm = pos > 0 ? *(const v4u*)(r0 - INW + 1024) : zero;
        const v4u cp = pos < rl - 1 ? *(const v4u*)(r0 + INW + 512) : zero, hp = pos < rl - 1 ? *(const v4u*)(r0 + INW + 1024) : zero;
        const f32x4 w0a = *(const f32x4*)(wc + c), w0b = *(const f32x4*)(wc + c + 4), w1a = *(const f32x4*)(wc + 512 + c), w1b = *(const f32x4*)(wc + 512 + c + 4), w2a = *(const f32x4*)(wc + 1024 + c), w2b = *(const f32x4*)(wc + 1024 + c + 4);
        const float w0[8] = {w0a.x, w0a.y, w0a.z, w0a.w, w0b.x, w0b.y, w0b.z, w0b.w}, w1[8] = {w1a.x, w1a.y, w1a.z, w1a.w, w1b.x, w1b.y, w1b.z, w1b.w}, w2[8] = {w2a.x, w2a.y, w2a.z, w2a.w, w2b.x, w2b.y, w2b.z, w2b.w};
        const unsigned bb[4] = {b0.x, b0.y, b0.z, b0.w}, cc[4] = {c0.x, c0.y, c0.z, c0.w}, hh[4] = {h0.x, h0.y, h0.z, h0.w}, cmv[4] = {cm.x, cm.y, cm.z, cm.w}, hmv[4] = {hm.x, hm.y, hm.z, hm.w}, cpv[4] = {cp.x, cp.y, cp.z, cp.w}, hpv[4] = {hp.x, hp.y, hp.z, hp.w};
        unsigned o[4];
#pragma unroll
        for (int j = 0; j < 4; ++j) {
            const float ylo = bflo(bb[j]) * (w0[2 * j] * (bflo(cmv[j]) * bflo(hmv[j])) + w1[2 * j] * (bflo(cc[j]) * bflo(hh[j])) + w2[2 * j] * (bflo(cpv[j]) * bflo(hpv[j])));
            const float yhi = bfhi(bb[j]) * (w0[2 * j + 1] * (bfhi(cmv[j]) * bfhi(hmv[j])) + w1[2 * j + 1] * (bfhi(cc[j]) * bfhi(hh[j])) + w2[2 * j + 1] * (bfhi(cpv[j]) * bfhi(hpv[j])));
            o[j] = pk2(ylo, yhi); }
        v4u ov; ov.x = o[0]; ov.y = o[1]; ov.z = o[2]; ov.w = o[3]; *(v4u*)(YC + (size_t)row * MIXW + c) = ov;
    }
}
template <int KS, bool LDSW>
__device__ __forceinline__ void route_pass(Frame& F, int l, int u, bool valid, int kh, int sl, LAS float* GC, LAS float* SH, LAS float* SSQ, LAS float* LG, LAS int* HISTL) {
    bf16* H = (bf16*)HBUF(F); const bf16* WRh = (const bf16*)(F.ws + WS_WR); const bf16* WRl = WRh + 48 * 1024;
    const float* bg = IN_(I_BGRP) + l * 4; const float* be = IN_(I_BEXP) + l * 32;
    int* EID = (int*)(F.ws + WS_EID); float* EW = (float*)(F.ws + WS_EW);
    constexpr int NK = 32 / KS, KW = 1024 / KS;
    const int r = F.lane & 15, q = F.lane >> 4;
    const int uu = valid ? u : 0; const int row = uu * 16 + r; const int pv = (row >= SEQ ? 1024 : 0) + kh * KW + 8 * q;
    const float* xr = (const float*)(F.ws + WS_XC) + (size_t)(KS == 2 ? 0 : row - SEQ) * D + kh * KW + 8 * q;
    const bf16* xr16 = (const bf16*)(F.ws + WS_X16) + (size_t)(KS == 2 ? row : 0) * D + kh * KW + 8 * q;
    const f32x4 rp = *(const f32x4*)((const float*)(F.ws + WS_RSS) + (size_t)row * 16 + 4 * q);
    float tot = (rp.x + rp.y) + (rp.z + rp.w); tot += shflx(tot, 16, F.lane); tot += shflx(tot, 32, F.lane);
    const float rstd = rsqrtf(tot * (1.f / D) + EPS);
    __syncthreads();
    (void)SSQ;
    f32x4 acc[3] = {{0.f, 0.f, 0.f, 0.f}, {0.f, 0.f, 0.f, 0.f}, {0.f, 0.f, 0.f, 0.f}};
    LAS unsigned char* WB = F.lds + 45056;
    v4u stg[6];
    if constexpr (LDSW) {
#pragma unroll
        for (int i = 0; i < 6; ++i) { const int pid = F.tid + NT * i, ln = pid & 63, rest = pid >> 6, ks = rest & 3, cb = (rest >> 2) % 3, hl = (rest / 12) & 1, khh = rest / 24;
            stg[i] = *(const v4u*)((hl ? WRl : WRh) + (size_t)(cb * 16 + (ln & 15)) * 1024 + khh * 512 + 32 * ks + 8 * (ln >> 4)); }
    }
#pragma unroll 1
    for (int k0 = 0; k0 < NK; k0 += 4) {
        f32x4 xa[4][2]; bf16x8 Bh[4][3], Bl[4][3];
        if constexpr (LDSW) {
            __syncthreads();
#pragma unroll
            for (int i = 0; i < 6; ++i) *(LAS v4u*)(WB + (F.tid + NT * i) * 16) = stg[i];
            __syncthreads();
            if (k0 + 4 < NK) {
#pragma unroll
                for (int i = 0; i < 6; ++i) { const int pid = F.tid + NT * i, ln = pid & 63, rest = pid >> 6, ks = rest & 3, cb = (rest >> 2) % 3, hl = (rest / 12) & 1, khh = rest / 24;
                    stg[i] = *(const v4u*)((hl ? WRl : WRh) + (size_t)(cb * 16 + (ln & 15)) * 1024 + khh * 512 + 32 * (k0 + 4 + ks) + 8 * (ln >> 4)); } }
        }
#pragma unroll
        for (int j = 0; j < 4; ++j) { const int c = 32 * (k0 + j);
            if constexpr (KS == 2) { const v4u w = *(const v4u*)(xr16 + c); xa[j][0] = __builtin_bit_cast(f32x4, w); } else { xa[j][0] = *(const f32x4*)(xr + c); xa[j][1] = *(const f32x4*)(xr + c + 4); }
#pragma unroll
            for (int cb = 0; cb < 3; ++cb) {
                if constexpr (!LDSW) { const size_t wo = (size_t)(cb * 16 + r) * 1024 + kh * KW + c + 8 * q; Bh[j][cb] = *(const bf16x8*)(WRh + wo); Bl[j][cb] = *(const bf16x8*)(WRl + wo); } } }
#pragma unroll
        for (int j = 0; j < 4; ++j) { const int c = 32 * (k0 + j);
            const f32x4 g0 = *(const LAS f32x4*)(GC + pv + c), g1 = *(const LAS f32x4*)(GC + pv + c + 4), sh0 = *(const LAS f32x4*)(SH + pv + c), sh1 = *(const LAS f32x4*)(SH + pv + c + 4);
            if constexpr (KS == 2) { const v4u w = __builtin_bit_cast(v4u, xa[j][0]); xa[j][0] = (f32x4){bflo(w.x), bfhi(w.x), bflo(w.y), bfhi(w.y)}; xa[j][1] = (f32x4){bflo(w.z), bfhi(w.z), bflo(w.w), bfhi(w.w)}; }
            const f32x4 h0 = xa[j][0] * rstd * g0 + sh0, h1 = xa[j][1] * rstd * g1 + sh1;
            v4u hi; hi.x = pk2(h0.x, h0.y); hi.y = pk2(h0.z, h0.w); hi.z = pk2(h1.x, h1.y); hi.w = pk2(h1.z, h1.w);
            if (valid) *(v4u*)(H + (size_t)row * D + kh * KW + 8 * q + c) = hi;
            v4u lo; lo.x = pk2(h0.x - bflo(hi.x), h0.y - bfhi(hi.x)); lo.y = pk2(h0.z - bflo(hi.y), h0.w - bfhi(hi.y)); lo.z = pk2(h1.x - bflo(hi.z), h1.y - bfhi(hi.z)); lo.w = pk2(h1.z - bflo(hi.w), h1.w - bfhi(hi.w));
            const bf16x8 Ah = __builtin_bit_cast(bf16x8, hi), Al = __builtin_bit_cast(bf16x8, lo);
#pragma unroll
            for (int cb = 0; cb < 3; ++cb) {
                bf16x8 bh, bl;
                if constexpr (LDSW) { bh = *(const LAS bf16x8*)(WB + ((kh * 24 + cb * 4 + j) * 64 + F.lane) * 16); bl = *(const LAS bf16x8*)(WB + ((kh * 24 + 12 + cb * 4 + j) * 64 + F.lane) * 16); }
                else { bh = Bh[j][cb]; bl = Bl[j][cb]; }
                acc[cb] = __builtin_amdgcn_mfma_f32_16x16x32_bf16(Ah, bh, acc[cb], 0, 0, 0); acc[cb] = __builtin_amdgcn_mfma_f32_16x16x32_bf16(Al, bh, acc[cb], 0, 0, 0); acc[cb] = __builtin_amdgcn_mfma_f32_16x16x32_bf16(Ah, bl, acc[cb], 0, 0, 0); } }
    }
    LAS float* LGw = LG + (sl * KS + kh) * (16 * 52);
#pragma unroll
    for (int cb = 0; cb < 3; ++cb)
#pragma unroll
        for (int i = 0; i < 4; ++i) LGw[(4 * q + i) * 52 + cb * 16 + r] = acc[cb][i];
    __syncthreads();
    if (kh == 0 && valid && F.lane < 16) { const LAS float* L0 = LG + (sl * KS) * (16 * 52) + F.lane * 52; const int rw = u * 16 + F.lane;
        float lg[36];
#pragma unroll
        for (int o = 0; o < 36; ++o) { float t = 0.f;
#pragma unroll
            for (int i = 0; i < KS; ++i) t += L0[i * (16 * 52) + o]; lg[o] = t + (o < 4 ? bg[o] : be[o - 4]); }
        LAS float* LW = LG + (sl * KS) * (16 * 52) + F.lane * 52;
#pragma unroll
        for (int o = 0; o < 36; ++o) LW[o] = lg[o];
        int gi = 0; float gm = lg[0];
#pragma unroll
        for (int o = 1; o < 4; ++o) if (lg[o] > gm) { gm = lg[o]; gi = o; }
        float den = 0.f;
#pragma unroll
        for (int o = 0; o < 4; ++o) den += expf(lg[o] - gm);
        const float gp = 1.f / den;
        const LAS float* el = LW + 4 + gi * 8;
        int i1 = 0; float m1 = el[0]; for (int o = 1; o < 8; ++o) { const float v = el[o]; if (v > m1) { m1 = v; i1 = o; } }
        int i2 = -1; float m2 = 0.f; for (int o = 0; o < 8; ++o) { const float v = el[o]; if (o != i1 && (i2 < 0 || v > m2)) { m2 = v; i2 = o; } }
        const float e2 = expf(m2 - m1); const float w1 = 1.f / (1.f + e2), w2 = e2 / (1.f + e2);
        const int e1i = gi * 8 + i1, e2i = gi * 8 + i2;
        EID[rw * 2] = e1i; EID[rw * 2 + 1] = e2i; EW[rw * 2] = gp * w1; EW[rw * 2 + 1] = gp * w2;
        __hip_atomic_fetch_add(&HISTL[e1i], 1, __ATOMIC_RELAXED, __HIP_MEMORY_SCOPE_WORKGROUP); __hip_atomic_fetch_add(&HISTL[e2i], 1, __ATOMIC_RELAXED, __HIP_MEMORY_SCOPE_WORKGROUP);
    }
}
__device__ __forceinline__ void ph10_route(Frame& F, int l) {
    const float* g = IN_(I_GFFN) + l * D;
    LAS float* GC = (LAS float*)F.lds;
    LAS float* SH = GC + 2048;
    LAS float* SSQ = SH + 2048;
    LAS float* LG = SSQ + 128;
    LAS int* HISTL = (LAS int*)(LG + 8 * 16 * 52);
    __syncthreads();
    if (F.tid < 32) HISTL[F.tid] = 0;
    for (int i = F.tid; i < 2048; i += NT) { const int w = i >> 10, c = i & 1023; const float* m = (const float*)(F.ws + WS_MOD) + (size_t)(l * 2 + w) * 6144; GC[i] = g[c] * (1.f + m[4096 + c]); SH[i] = m[3072 + c]; }
#pragma unroll 1
    for (int u0 = F.bid; u0 < SEQ / 16; u0 += 4 * F.G) { const int u = u0 + (F.wave >> 1) * F.G; route_pass<2, true>(F, l, u, u < SEQ / 16, F.wave & 1, F.wave >> 1, GC, SH, SSQ, LG, HISTL); }
    if (l == 0) {
#pragma unroll 1
        for (int u0 = SEQ / 16 + F.bid; u0 < MT / 16; u0 += F.G) { ctx_x1_fixup(F, l, (u0 - SEQ / 16) * 16); route_pass<8, false>(F, l, u0, true, F.wave, 0, GC, SH, SSQ, LG, HISTL); }
    }
    __syncthreads();
    if (F.tid < 32) __hip_atomic_store((unsigned long long*)(F.ws + WS_HG) + F.bid * 32 + F.tid, ((unsigned long long)((unsigned)l + 1u) << 32) | (unsigned)HISTL[F.tid], __ATOMIC_RELAXED, __HIP_MEMORY_SCOPE_AGENT);
}
__device__ __forceinline__ void ph11_scatter(Frame& F, int l) {
    const bf16* H = (const bf16*)HBUF(F); bf16* HS = (bf16*)(F.ws + WS_HS);
    const int* EID = (const int*)(F.ws + WS_EID); const float* EW = (const float*)(F.ws + WS_EW); int* STOK = (int*)(F.ws + WS_STOK); float* SW = (float*)(F.ws + WS_SW); int* TSLOT = (int*)(F.ws + WS_TSLOT);
    unsigned* cnt = F.ctl + CW_CNT + l * 128; unsigned long long* HG = (unsigned long long*)(F.ws + WS_HG); const unsigned tag = (unsigned)l + 1u;
    LAS int* HIST = (LAS int*)F.lds; LAS int* BASE = HIST + 32; LAS int* ISLOT = BASE + 32; LAS int* IROW = ISLOT + 512; LAS int* PT = IROW + 512; LAS int* PB = PT + 512;
    const int nunits = (l == 0 ? MT : SEQ) / 16;
    __syncthreads();
    { const int e = F.tid & 31, ch = F.tid >> 5; int tot = 0, bas = 0;
      for (int b0 = ch; b0 < F.G; b0 += 256) {
          unsigned long long xs[16]; unsigned spins = 0;
          for (;;) { bool ok = true;
#pragma unroll
              for (int i = 0; i < 16; ++i) { const int b = b0 + 16 * i; xs[i] = b < F.G ? __hip_atomic_load(HG + b * 32 + e, __ATOMIC_RELAXED, __HIP_MEMORY_SCOPE_AGENT) : ((unsigned long long)tag << 32); }
#pragma unroll
              for (int i = 0; i < 16; ++i) ok = ok && (unsigned)(xs[i] >> 32) == tag;
              if (ok) break; __builtin_amdgcn_s_sleep(2); if (++spins > (1u << 22)) break; }
#pragma unroll
          for (int i = 0; i < 16; ++i) { const int b = b0 + 16 * i; const int h = (int)(unsigned)xs[i]; tot += h; if (b < F.bid) bas += h; } }
      PT[F.tid] = tot; PB[F.tid] = bas; }
    __syncthreads();
    if (F.tid < 32) { int tot = 0, bas = 0; for (int ch = 0; ch < 16; ++ch) { tot += PT[ch * 32 + F.tid]; bas += PB[ch * 32 + F.tid]; } HIST[F.tid] = 0; PT[F.tid] = tot; PB[F.tid] = bas; if (F.bid == 0) cnt[F.tid] = (unsigned)tot; }
    __syncthreads();
    if (F.tid < 32) { int off = 0; for (int i = 0; i < F.tid; ++i) off += (PT[i] + 255) & ~255; BASE[F.tid] = off + PB[F.tid]; }
    __syncthreads();
    const int w = F.tid >> 5; int u = F.bid + w * F.G; bool valid = u < SEQ / 16;
    if (w == 15) { u = SEQ / 16 + F.bid; valid = u < nunits; }
    const int row = u * 16 + ((F.tid >> 1) & 15), kk = F.tid & 1;
    int e = 0, rank = 0; if (valid) { e = EID[row * 2 + kk]; rank = __hip_atomic_fetch_add(&HIST[e], 1, __ATOMIC_RELAXED, __HIP_MEMORY_SCOPE_WORKGROUP); }
    __syncthreads();
    int slot = -1; if (valid) { slot = BASE[e] + rank; STOK[slot] = row; SW[slot] = EW[row * 2 + kk]; TSLOT[row * 2 + kk] = slot; }
    (void)H; (void)HS; (void)ISLOT; (void)IROW;
    for (int e = F.bid; e < NE; e += F.G) { const int start = BASE[e] - PB[e], n = PT[e], seg = (n + 255) & ~255; for (int i = n + F.tid; i < seg; i += NT) STOK[start + i] = 0; }
}
template <bool CX>
__device__ __forceinline__ void combine_rows(Frame& F, int l, const LAS float* GC, const LAS float* SH, const LAS float* GA) {
    const bf16* YS2 = (const bf16*)(F.ws + WS_YS2); const int* TSLOT = (const int*)(F.ws + WS_TSLOT) + (CX ? 2 * SEQ : 0); bf16* H = (bf16*)HBUF(F) + (CX ? (size_t)SEQ * D : 0);
    bf16* X16 = (bf16*)(F.ws + WS_X16); float* XC = (float*)(F.ws + WS_XC); float* out = F.out;
    const int gw = F.bid * (NT / 64) + F.wave, ngw = F.G * (NT / 64);
    constexpr int nrows = CX ? CTX : SEQ, pv = CX ? 1024 : 0;
    for (int row0 = gw; row0 < nrows; row0 += 2 * ngw) {
        int rows[2]; bool ok[2];
#pragma unroll
        for (int t = 0; t < 2; ++t) { rows[t] = row0 + t * ngw; ok[t] = rows[t] < nrows; if (!ok[t]) rows[t] = row0; }
        int sl[2][2];
#pragma unroll
        for (int t = 0; t < 2; ++t) { sl[t][0] = TSLOT[rows[t] * 2]; sl[t][1] = TSLOT[rows[t] * 2 + 1]; }
        v4u ya[2][2], yb[2][2], xb[2][2]; f32x4 xf[2][2][2];
#pragma unroll
        for (int t = 0; t < 2; ++t)
#pragma unroll
            for (int j = 0; j < 2; ++j) { const int c = 8 * F.lane + 512 * j;
                if constexpr (CX) { xf[t][j][0] = *(const f32x4*)(XC + (size_t)rows[t] * D + c); xf[t][j][1] = *(const f32x4*)(XC + (size_t)rows[t] * D + c + 4); }
                else xb[t][j] = *(const v4u*)(X16 + (size_t)rows[t] * D + c);
                ya[t][j] = *(const v4u*)(YS2 + (size_t)sl[t][0] * D + c); yb[t][j] = *(const v4u*)(YS2 + (size_t)sl[t][1] * D + c); }
        f32x4 v[2][2][2]; float s[2] = {0.f, 0.f};
#pragma unroll
        for (int t = 0; t < 2; ++t)
#pragma unroll
            for (int j = 0; j < 2; ++j) { const int c = 8 * F.lane + 512 * j; const v4u a = ya[t][j], b = yb[t][j];
                if constexpr (!CX) { const v4u w = xb[t][j]; xf[t][j][0] = (f32x4){bflo(w.x), bfhi(w.x), bflo(w.y), bfhi(w.y)}; xf[t][j][1] = (f32x4){bflo(w.z), bfhi(w.z), bflo(w.w), bfhi(w.w)}; }
                const f32x4 y0 = {bflo(a.x) + bflo(b.x), bfhi(a.x) + bfhi(b.x), bflo(a.y) + bflo(b.y), bfhi(a.y) + bfhi(b.y)}, y1 = {bflo(a.z) + bflo(b.z), bfhi(a.z) + bfhi(b.z), bflo(a.w) + bflo(b.w), bfhi(a.w) + bfhi(b.w)};
                const f32x4 o0 = xf[t][j][0] + *(const LAS f32x4*)(GA + pv + c) * y0, o1 = xf[t][j][1] + *(const LAS f32x4*)(GA + pv + c + 4) * y1; v[t][j][0] = o0; v[t][j][1] = o1;
                s[t] += (o0.x * o0.x + o0.y * o0.y + o0.z * o0.z + o0.w * o0.w) + (o1.x * o1.x + o1.y * o1.y + o1.z * o1.z + o1.w * o1.w); }
#pragma unroll
        for (int t = 0; t < 2; ++t) { if (!ok[t]) continue;
            const float rstd = rsqrtf(wave_sum(s[t], F.lane) * (1.f / D) + EPS); const size_t ro = (size_t)rows[t] * D;
            if (l == 0) {
#pragma unroll
                for (int j = 0; j < 2; ++j) { const int c = 8 * F.lane + 512 * j; const f32x4 o0 = v[t][j][0], o1 = v[t][j][1];
                    if constexpr (CX) { *(f32x4*)(XC + ro + c) = o0; *(f32x4*)(XC + ro + c + 4) = o1; }
                    else { v4u w; w.x = pk2(o0.x, o0.y); w.y = pk2(o0.z, o0.w); w.z = pk2(o1.x, o1.y); w.w = pk2(o1.z, o1.w); *(v4u*)(X16 + ro + c) = w; }
                    const f32x4 h0 = o0 * rstd * *(const LAS f32x4*)(GC + pv + c) + *(const LAS f32x4*)(SH + pv + c), h1 = o1 * rstd * *(const LAS f32x4*)(GC + pv + c + 4) + *(const LAS f32x4*)(SH + pv + c + 4);
                    v4u hw; hw.x = pk2(h0.x, h0.y); hw.y = pk2(h0.z, h0.w); hw.z = pk2(h1.x, h1.y); hw.w = pk2(h1.z, h1.w); *(v4u*)(H + ro + c) = hw; }
            } else if constexpr (!CX) {
#pragma unroll
                for (int j = 0; j < 2; ++j) { const int c = 8 * F.lane + 512 * j; f32x4 o0 = v[t][j][0] * rstd * *(const LAS f32x4*)(GC + c), o1 = v[t][j][1] * rstd * *(const LAS f32x4*)(GC + c + 4);
                    if (PROBE_B >= 0 && rows[t] < 3906 && F.bid >= PROBE_LO && F.bid < PROBE_HI) { volatile LAS unsigned long long* TS = (volatile LAS unsigned long long*)(F.lds + TS_OFF); const float dd = 0.1f + 0.00001f * (float)(TS[PROBE_B1] - TS[PROBE_B]); o0 = o0 + dd; o1 = o1 + dd; }
                    if (PROBE_A == 98 && rows[t] == 0 && j == 0 && F.lane == 0) { const unsigned w = __hip_atomic_load(F.ctl + 100, __ATOMIC_RELAXED, __HIP_MEMORY_SCOPE_AGENT); o0.x += 1.f + 0.001f * (float)w; }
                    else if (PROBE_A == 99 && rows[t] == 0 && j == 0 && F.lane == 0) { const unsigned w = __hip_atomic_load(F.ctl + 100, __ATOMIC_RELAXED, __HIP_MEMORY_SCOPE_AGENT); o0.x += PROBE_AROW ? 1.f + 0.01f * (float)(w & 255u) : 1.f + 0.001f * (float)(w >> 8); }
                    else if (PROBE_A >= 0 && rows[t] == PROBE_AROW && j == 0 && F.lane == 0) { volatile LAS unsigned long long* TS = (volatile LAS unsigned long long*)(F.lds + TS_OFF); o0.x += 1.f + 0.001f * (float)(TS[PROBE_A1] - TS[PROBE_A]); }
                    *(f32x4*)(out + ro + c) = o0; *(f32x4*)(out + ro + c + 4) = o1; }
            }
        }
    }
}
__device__ __forceinline__ void ph14_combine(Frame& F, int l) {
    LAS float* GC = (LAS float*)F.lds; LAS float* SH = GC + 2048; LAS float* GA = SH + 2048;
    if (l == 0) stage_mod(F, IN_(I_GMIX) + D, 1, 0, 1024, GC, SH); else { __syncthreads(); for (int i = F.tid; i < 1024; i += NT) GC[i] = IN_(I_GF)[i]; }
    for (int i = F.tid; i < 2048; i += NT) GA[i] = ((const float*)(F.ws + WS_MOD))[(size_t)(l * 2 + (i >> 10)) * 6144 + 5120 + (i & 1023)];
    __syncthreads();
    combine_rows<false>(F, l, GC, SH, GA);
    if (l == 0) combine_rows<true>(F, l, GC, SH, GA);
}

constexpr int NPH = 2 + 8 * 2;
__device__ __forceinline__ Frame make_frame(LAS unsigned char* lds, int wave0) {
    Frame F; F.lds = lds; F.wave = wave0; F.lane = (int)__builtin_amdgcn_mbcnt_hi(~0u, __builtin_amdgcn_mbcnt_lo(~0u, 0u)); asm volatile("" : "+v"(F.lane)); F.tid = F.wave * 64 + F.lane; F.bid = blockIdx.x; F.G = gridDim.x; asm volatile("" : "+s"(F.G), "+s"(F.bid));
    F.tab = (const unsigned long long LAS*)(lds + TAB_OFF);
    volatile LAS unsigned long long* t = (volatile LAS unsigned long long*)(lds + TAB_OFF);
    F.ws = (unsigned char*)(GAS unsigned char*)uni64(t[35]); F.out = (float*)(GAS float*)uni64(t[36]); F.ctl = (unsigned*)(F.ws + WS_CTL);
    return F;
}
__global__ void __launch_bounds__(NT, 2) mega_fwd(Args args) {
    extern __shared__ __attribute__((aligned(16))) unsigned char lds_raw[];
    LAS unsigned char* const lds = (LAS unsigned char*)lds_raw;
    const int wave0 = __builtin_amdgcn_readfirstlane((int)threadIdx.x >> 6);
    for (int u = threadIdx.x; u < 1024 / 4; u += NT) ((LAS unsigned*)(lds + 131072))[u] = 0u;
    if (threadIdx.x == 0) { LAS unsigned long long* t = (LAS unsigned long long*)(lds + TAB_OFF);
#pragma unroll
        for (int i = 0; i < 35; ++i) t[i] = (unsigned long long)args.in[i];
        t[35] = (unsigned long long)args.ws; t[36] = (unsigned long long)args.out; }
    __syncthreads();
    { Frame F = make_frame(lds, wave0); (void)xcd_barrier_post(F.ctl + CW_BAR, (volatile LAS unsigned*)(lds + MISC_OFF) + 8); }
    if ((PROBE_A >= 0 || PROBE_B >= 0) && threadIdx.x == 0) ((volatile LAS unsigned long long*)(lds + TS_OFF))[0] = __builtin_amdgcn_s_memrealtime();
    const int lo = args.ph_lo, hi = args.ph_hi; int ph = 0;
#define GRIDBAR() do { Frame Fb = make_frame(lds, wave0); XcdBarrier bar; bar.bar = Fb.ctl + CW_BAR; bar.x = xb_xcc_id(); bar.st = (volatile LAS unsigned*)(lds + MISC_OFF) + 8; xcd_barrier(bar, Fb.tid == 0); } while (0)
#ifndef REPBAR
#define REPBAR 0
#endif
#ifndef REPMASK
#define REPMASK 0
#endif
#define PHASE(...) do { if (lo <= ph && ph < hi) { const int _pl = ph < 2 ? ph : 2 + (ph - 2) % 8; for (int _rep = 0; _rep <= ((REPMASK >> _pl) & 1); ++_rep) { Frame F = make_frame(lds, wave0); __VA_ARGS__; } if ((PROBE_A >= 0 || PROBE_B >= 0) && threadIdx.x == 0) { volatile LAS unsigned long long* TS_ = (volatile LAS unsigned long long*)(lds + TS_OFF); TS_[32 + ph] = __builtin_amdgcn_s_memrealtime(); if (PROBE_A == 98 && ph == PROBE_PH) { Frame Fp = make_frame(lds, wave0); __hip_atomic_fetch_max(Fp.ctl + 100, (unsigned)(TS_[32 + ph] - TS_[ph]), __ATOMIC_RELAXED, __HIP_MEMORY_SCOPE_AGENT); } } if (ph + 1 < hi) { GRIDBAR(); if (REPBAR) GRIDBAR(); } if ((PROBE_A >= 0 || PROBE_B >= 0) && threadIdx.x == 0) ((volatile LAS unsigned long long*)(lds + TS_OFF))[1 + ph] = __builtin_amdgcn_s_memrealtime(); } ++ph; } while (0)
    PHASE({ ph0_prologue(F); s5_precompute(F); __syncthreads(); convert_weights(F, 0, F.G > 128 ? F.G - 64 : F.G); { const f32x4* s = (const f32x4*)IN_(I_CTX); f32x4* d = (f32x4*)(F.ws + WS_XC); for (int i = F.bid * NT + F.tid; i < CTX * D / 4; i += F.G * NT) d[i] = s[i]; } });
    PHASE(hprep_rows(F, 0));
#pragma unroll 1
    for (int l = 0; l < 2; ++l) {
        PHASE({ ph2_fast(F, l); ph2_ctx(F, l == 0 ? INW : MIXW); });
        PHASE({ s5_fused_phase(F, l); for (int it = F.bid; it < 2 * (SEQ / 128); it += F.G) sg_fast_item(F, l, (it & 7) + 8 * (it >> 4), (it >> 3) & 1);        ph3_conv(F, l, l == 0 ? MT : SEQ); });
        PHASE({ ph6_fast(F, l); if (l == 0 && F.bid >= F.G - 4) { const int it = F.bid - (F.G - 4); sg_fast_item(F, 0, SEQ / 128 + (it >> 1), it & 1); } });
        PHASE({ ph7_fast(F, l); if (l == 0) ph7_ctx(F); ph8_fast(F, l); if (l == 0) ph8_ctx(F, l); });
        PHASE({ ph9_fast(F, l); if (l == 0) ph9_ctx(F, l); });
        PHASE({ ph10_route(F, l); ph11_scatter(F, l); });
        PHASE(ph12_moe(F, l));
        PHASE({ ph14_combine(F, l); if (l == 0) { __syncthreads(); convert_weights(F, 1, F.G); } });
    }
#undef PHASE
}

extern "C" void kernel_launch(void* const* d_in, const int* in_sizes, int n_in, void* d_out, int out_size, void* d_ws, size_t ws_size, hipStream_t stream) {
    static int grid = 0;
    if (grid == 0) {
        int dev = 0, cus = 0, per_cu = 0;
        if (n_in != 35 || out_size != SEQ * D || ws_size < WS_END) { fprintf(stderr, "kernel_launch: unexpected shapes (n_in %d out %d ws %zu)\n", n_in, out_size, ws_size); grid = -1; return; }
        if (hipGetDevice(&dev) != hipSuccess || hipDeviceGetAttribute(&cus, hipDeviceAttributeMultiprocessorCount, dev) != hipSuccess) { grid = -1; return; }
        if (hipFuncSetAttribute((const void*)mega_fwd, hipFuncAttributeMaxDynamicSharedMemorySize, LDS_BYTES) != hipSuccess) { fprintf(stderr, "kernel_launch: hipFuncSetAttribute failed\n"); grid = -1; return; }
        if (hipOccupancyMaxActiveBlocksPerMultiprocessor(&per_cu, (const void*)mega_fwd, NT, LDS_BYTES) != hipSuccess || per_cu < 1) { fprintf(stderr, "kernel_launch: occupancy query says %d blocks per CU\n", per_cu); grid = -1; return; }
        grid = cus;
    }
    if (grid < 0) return;
    (void)hipMemsetAsync((char*)d_ws + WS_CTL, 0, CTL_ZERO_BYTES, stream);
    Args a{};
    for (int i = 0; i < 35; ++i) a.in[i] = (const float*)d_in[i];
    a.out = (float*)d_out; a.ws = (unsigned char*)d_ws; a.ph_lo = 0; a.ph_hi = NPH;
    void* kargs[] = {&a};
    hipError_t e = hipLaunchCooperativeKernel((const void*)mega_fwd, dim3(grid), dim3(NT), kargs, LDS_BYTES, stream);
    if (e != hipSuccess) fprintf(stderr, "kernel_launch: cooperative launch failed: %s (grid %d)\n", hipGetErrorString(e), grid);
}
```

```cpp
#include <hip/hip_runtime.h>
#include <stdint.h>
#include <cstdio>

#define GAS __attribute__((address_space(1)))
#define LAS __attribute__((address_space(3)))
typedef unsigned short bf16;
typedef unsigned v4u __attribute__((ext_vector_type(4)));
typedef unsigned v2u __attribute__((ext_vector_type(2)));
typedef float f32x4 __attribute__((ext_vector_type(4)));
typedef short bf16x8 __attribute__((ext_vector_type(8)));

constexpr int D = 1024, SEQ = 16384, CTX = 256, MT = SEQ + CTX;
constexpr int MIXW = 512, INW = 3072, G5 = 32, P5 = 64, H5 = 16;
constexpr int NE = 32, DFF = 256;
constexpr int MAXSLOT = 2 * MT + NE * 256;
constexpr float EPS = 1e-6f;
constexpr int NT = 512;

constexpr size_t MiB = 1u << 20;
constexpr size_t WS_CTL = 0, CTL_ZERO_BYTES = 1 * MiB;
constexpr size_t WS_MOD = 1 * MiB;
constexpr size_t WS_XC = 2 * MiB;
constexpr size_t WS_EID = 3 * MiB;
constexpr size_t WS_EW = WS_EID + (size_t)MT * 8;
constexpr size_t WS_STOK = WS_EW + (size_t)MT * 8;
constexpr size_t WS_SW = WS_STOK + (size_t)MAXSLOT * 4;
constexpr size_t WS_TSLOT = WS_SW + (size_t)MAXSLOT * 4;
constexpr size_t WS_HISTG = WS_TSLOT + (size_t)MT * 8;
constexpr size_t WS_H = 4 * MiB;
constexpr size_t WS_X16 = WS_H;
constexpr size_t WS_PROJ = WS_H + (size_t)MT * 2048;
constexpr size_t WS_YS = WS_PROJ + (size_t)MT * 6144;
constexpr size_t WS_YG = WS_YS + (size_t)3 * MT * 1024;
constexpr size_t WS_PM = WS_YG + (size_t)MT * 1024;
constexpr size_t WS_S5 = WS_PM + (size_t)MT * 2048;
constexpr size_t WS_Z = WS_S5;
constexpr size_t WS_RSS = WS_Z + (size_t)8 * MiB;
constexpr size_t WS_SS = WS_Z + (size_t)1040 * 32 * 256 * 4;
constexpr size_t WS_S5M = WS_SS + (size_t)1040 * 32 * 256 * 2;
constexpr size_t WS_A16 = WS_S5M + (size_t)2 * 32 * 3 * 65536 * 2;
constexpr size_t WS_W = WS_A16 + (size_t)2 * 32 * 2 * 64 * 2 * 4 > WS_S5 + (size_t)2 * MT * 512 * 4 ? WS_A16 + (size_t)2 * 32 * 2 * 64 * 2 * 4 : WS_S5 + (size_t)2 * MT * 512 * 4;
constexpr size_t WS_WIN = WS_W;
constexpr size_t WS_WMG = WS_WIN + (size_t)3072 * 1024 * 2;
constexpr size_t WS_WGLU = WS_WMG + (size_t)3072 * 1024 * 2;
constexpr size_t WS_WBR = WS_WGLU + (size_t)512 * 512 * 2;
constexpr size_t WS_WO = WS_WBR + (size_t)3 * 1024 * 512 * 2;
constexpr size_t WS_W13 = WS_WO + (size_t)1024 * 1024 * 2;
constexpr size_t WS_W2 = WS_W13 + (size_t)32 * 512 * 1024 * 2;
constexpr size_t WS_WSG = WS_W2 + (size_t)32 * 1024 * 256 * 2;
constexpr size_t WS_WR = WS_WSG + (size_t)4 * 128 * 128 * 2;
constexpr size_t WS_END = WS_WR + (size_t)2 * 48 * 1024 * 2;
static_assert(WS_END <= (size_t)377 * MiB, "workspace budget");
constexpr size_t WS_HS = WS_PROJ;
constexpr size_t WS_ACT = WS_YS;
constexpr size_t WS_YS2 = WS_YG;
static_assert(WS_HS + (size_t)MAXSLOT * 2048 <= WS_YS && WS_ACT + (size_t)MAXSLOT * 512 <= WS_YG && WS_YS2 + (size_t)MAXSLOT * 2048 <= WS_W, "moe overlays");
static_assert(WS_HISTG + (size_t)1024 * 32 * 4 <= WS_H, "ws map");
constexpr int CW_CNT = 64;
constexpr int CW_BAR = 4096;
constexpr size_t WS_HG = WS_CTL + 768 * 1024;
constexpr size_t WS_MG = WS_CTL + 64 * 1024;
constexpr size_t WS_GR = WS_CTL + 256 * 1024;
constexpr int CW_UPC = 8192;

#ifndef PROBE_A
#define PROBE_A -1
#endif
#ifndef PROBE_B
#define PROBE_B -1
#endif
#ifndef PROBE_A1
#define PROBE_A1 (PROBE_A + 1)
#endif
#ifndef PROBE_B1
#define PROBE_B1 (PROBE_B + 1)
#endif
#ifndef PROBE_AROW
#define PROBE_AROW 0
#endif
#ifndef PROBE_PH
#define PROBE_PH 0
#endif
#ifndef PROBE_LO
#define PROBE_LO 0
#endif
#ifndef PROBE_HI
#define PROBE_HI 100000
#endif
constexpr int TS_OFF = 131072 + 512;
constexpr int LDS_BYTES = 147456;
constexpr int MISC_OFF = 131072 + 320;
constexpr int TAB_OFF = 131072 + 1024;

__device__ __forceinline__ float bf2f(unsigned short b) { return __builtin_bit_cast(float, ((unsigned)b) << 16); }
__device__ __forceinline__ unsigned f2bf(float f) { unsigned u = __builtin_bit_cast(unsigned, f); return (u + 0x7fffu + ((u >> 16) & 1u)) >> 16; }
__device__ __forceinline__ unsigned pk2(float lo, float hi) { return f2bf(lo) | (f2bf(hi) << 16); }
__device__ __forceinline__ float sigmoidf_(float x) { return __builtin_amdgcn_rcpf(1.f + __expf(-x)); }
__device__ __forceinline__ float siluf_(float x) { return x * __builtin_amdgcn_rcpf(1.f + __expf(-x)); }
__device__ __forceinline__ float geluf_(float x) { const float u = 0.7978845608028654f * (x + 0.044715f * x * x * x); return x * __builtin_amdgcn_rcpf(1.f + __expf(-2.f * u)); }
__device__ __forceinline__ float shflx(float v, int mask, int lane) { return __builtin_bit_cast(float, __builtin_amdgcn_ds_bpermute((lane ^ mask) << 2, __builtin_bit_cast(int, v))); }
__device__ __forceinline__ float wave_sum(float v, int lane) {
#pragma unroll
    for (int o = 1; o < 64; o <<= 1) v += shflx(v, o, lane);
    return v;
}

#define XB_TMO      128
#define XB_XCNT(j)  (256  + 64 * (j))
#define XB_XSUB(j)  (1280 + 64 * (j))
#define XB_XGEN(j)  (2304 + 64 * (j))
#define XB_TOP      3328
#define XB_TOPGEN   3392
#define XCD_BAR_WORDS 3456
#define XB_SPIN_CAP (1u << 24)
__device__ __forceinline__ unsigned xb_ld(unsigned* p)              { return __hip_atomic_load(p, __ATOMIC_RELAXED, __HIP_MEMORY_SCOPE_AGENT); }
__device__ __forceinline__ unsigned xb_add(unsigned* p, unsigned v) { return __hip_atomic_fetch_add(p, v, __ATOMIC_RELAXED, __HIP_MEMORY_SCOPE_AGENT); }
__device__ __forceinline__ unsigned xb_xcc_id() { return (unsigned)__builtin_amdgcn_s_getreg((3 << 11) | 20) & 0xFu; }
#define XB_SPIN(cond, bar) do { unsigned _sp = 0; while (cond) { __builtin_amdgcn_s_sleep(1); \
    if ((++_sp & 255u) == 0u) { if (xb_ld(&(bar)[XB_TMO])) break; if (_sp > XB_SPIN_CAP) { atomicAdd(&(bar)[XB_TMO], 1u); break; } } } } while (0)
struct XcdBarrier { unsigned* bar; unsigned x; volatile LAS unsigned* st; };
__device__ __forceinline__ XcdBarrier xcd_barrier_post(unsigned* bar, volatile LAS unsigned* st) {
    XcdBarrier b; b.bar = bar; b.x = xb_xcc_id(); b.st = st;
    if (threadIdx.x == 0) (void)xb_add(&bar[XB_XCNT(b.x)], 1u);
    return b;
}
__device__ __forceinline__ void xcd_barrier_complete(unsigned* bar, unsigned x, unsigned& nloc, unsigned& nx) {
    const unsigned G = gridDim.x * gridDim.y * gridDim.z;
    unsigned sum, cnt, mine, sp = 0u;
    for (;;) {
        sum = 0u; cnt = 0u; mine = 0u;
#pragma unroll
        for (unsigned j = 0; j < 16; ++j) { const unsigned c = xb_ld(&bar[XB_XCNT(j)]); sum += c; cnt += (c > 0u) ? 1u : 0u; mine = (j == x) ? c : mine; }
        if (sum == G) break;
        __builtin_amdgcn_s_sleep(1);
        if ((++sp & 255u) == 0u) { if (xb_ld(&bar[XB_TMO])) break; if (sp > XB_SPIN_CAP) { atomicAdd(&bar[XB_TMO], 1u); break; } }
    }
    nloc = mine > 0u ? mine : 1u; nx = cnt > 0u ? cnt : 1u;
}
__device__ __forceinline__ void xcd_barrier(const XcdBarrier& b, bool leader) {
    asm volatile("s_waitcnt vmcnt(0)" ::: "memory");
    __syncthreads();
    if (leader) {
        unsigned* bar = b.bar;
        __builtin_amdgcn_s_waitcnt(0);
        unsigned nloc = b.st[0], nx = b.st[1];
        if (nloc == 0u) { xcd_barrier_complete(bar, b.x, nloc, nx); b.st[0] = nloc; b.st[1] = nx; }
        const unsigned old = xb_add(&bar[XB_XSUB(b.x)], 1u);
        const unsigned gen = old / nloc;
        if (old + 1u == (gen + 1u) * nloc) {
            __builtin_amdgcn_fence(__ATOMIC_RELEASE, "agent");
            asm volatile("s_waitcnt vmcnt(0)" ::: "memory");
            const unsigned og = xb_add(&bar[XB_TOP], 1u);
            const unsigned tg = og / nx;
            if (og + 1u == (tg + 1u) * nx) xb_add(&bar[XB_TOPGEN], 1u);
            else XB_SPIN(xb_ld(&bar[XB_TOPGEN]) == tg, bar);
            __builtin_amdgcn_fence(__ATOMIC_ACQUIRE, "agent");
            xb_add(&bar[XB_XGEN(b.x)], 1u);
            asm volatile("s_waitcnt vmcnt(0)" ::: "memory");
        } else {
            XB_SPIN(xb_ld(&bar[XB_XGEN(b.x)]) == gen, bar);
            __builtin_amdgcn_fence(__ATOMIC_ACQUIRE, "agent");
            asm volatile("s_waitcnt vmcnt(0)" ::: "memory");
        }
    }
    __syncthreads();
}

struct Args { const float* in[35]; float* out; unsigned char* ws; int ph_lo, ph_hi; };
struct Frame {
    LAS unsigned char* lds; unsigned char* ws; unsigned* ctl;
    int tid, lane, wave, bid, G;
    const unsigned long long LAS* tab; float* out;
};
__device__ __forceinline__ unsigned long long uni64(unsigned long long v) { const unsigned lo = __builtin_amdgcn_readfirstlane((unsigned)v), hi = __builtin_amdgcn_readfirstlane((unsigned)(v >> 32)); return ((unsigned long long)hi << 32) | lo; }
#define IN_(k) ((const float*)(const GAS float*)uni64(F.tab[k]))
enum { I_X = 0, I_C, I_CTX, I_CCTX, I_WADA, I_BADA, I_GMIX, I_GFFN, I_WIN, I_LRE, I_LIM, I_LDT, I_BRE, I_BIM, I_CRE, I_CIM, I_DSKIP, I_WGLU, I_SGG, I_SGB, I_WSG, I_BSG,
       I_WCONV, I_WBR, I_WMG, I_BMG, I_WO, I_WGRP, I_BGRP, I_WEXP, I_BEXP, I_W1, I_W3, I_W2, I_GF };

__device__ __forceinline__ const float* mod_ptr(const Frame& F, int l, int row) { return (const float*)(F.ws + WS_MOD) + (size_t)(l * 2 + (row >= SEQ ? 1 : 0)) * 6144; }
__device__ __forceinline__ const float* xin_row(const Frame& F, int row) { return row < SEQ ? IN_(I_X) + (size_t)row * D : IN_(I_CTX) + (size_t)(row - SEQ) * D; }
#define HBUF(F) ((unsigned char*)(F).out)


namespace pg8 {
#define PG8_LAS __attribute__((address_space(3)))
typedef unsigned short bf16_t;
typedef short bf16x8 __attribute__((ext_vector_type(8)));
typedef float f32x4 __attribute__((ext_vector_type(4)));
typedef unsigned u32x4 __attribute__((ext_vector_type(4)));
constexpr int BM = 256, BK = 64, HALF = 128, HTB = HALF * BK * 2  , STAGE_BYTES = 8 * HTB, NXCD = 8, WGM = 8;

__host__ __device__ __forceinline__ int lds_byte(int r, int c) { const int st = (r >> 4) * 2 + (c >> 5), rr = r & 15, cc = c & 31, ob = rr * 64 + cc * 2; return st * 1024 + (ob ^ (((ob >> 9) & 1) << 5)); }
__host__ __device__ __forceinline__ void stage_rc(int b, int& R, int& C) { const int st = b / 1024, sb = b % 1024, swz = sb ^ (((sb >> 9) & 1) << 5); R = (st >> 1) * 16 + swz / 64; C = (st & 1) * 32 + (swz % 64) / 2; }
__host__ __device__ __forceinline__ int perm32(int rho) { const int n = rho >> 4, i = rho & 15; return 8 * (i >> 2) + 4 * n + (i & 3); }

struct Unit { int pm, pn; };
struct Gemm { const bf16_t* A; const bf16_t* Bt; int M, N, K; int pad_; const int* rowidx; };

struct StaticOrder {
    int nM, nN, nwg, G, c;
    __host__ __device__ void init(int M, int N, int G_, int c_) { nM = M / BM; nN = N / BM; nwg = nM * nN; G = G_; c = c_; }
    __host__ __device__ bool next(int i, Unit& u) const {
        const long L = (long)i * G + c; if (L >= nwg) return false;
        int wgid = (int)L; { const int q = nwg / NXCD, r = nwg % NXCD, xcd = wgid % NXCD, off = wgid / NXCD; wgid = (xcd < r ? xcd * (q + 1) : r * (q + 1) + (xcd - r) * q) + off; }
        const int nig = WGM * nN, gid = wgid / nig, fm = gid * WGM, gsz = (nM - fm) < WGM ? (nM - fm) : WGM;
        u.pm = fm + ((wgid % nig) % gsz); u.pn = (wgid % nig) / gsz; return true;
    }
    __device__ __forceinline__ unsigned peek(const Unit&) const { return 0u; }
    __device__ __forceinline__ void a_ready(const Unit&, unsigned) const {}
    __device__ __forceinline__ void done(const Unit&) const {}
};
__device__ __forceinline__ unsigned cvt_pk_bf16(float lo, float hi) { unsigned r; asm volatile("v_cvt_pk_bf16_f32 %0, %1, %2" : "=v"(r) : "v"(lo), "v"(hi)); return r; }
template <class Epi, class Sched, bool ALIGN_EPI = false, bool SP2 = false, bool ASC1 = false, bool AGATHER = false>
__device__ __forceinline__ void gemm_phase(PG8_LAS unsigned char* lds, const Gemm g, const Sched& S, const Epi& E, int tid_in) {
    int tid_ = tid_in; asm volatile("" : "+v"(tid_));
    const int tid = tid_, wid = __builtin_amdgcn_readfirstlane(tid >> 6), lane = tid & 63, wr = wid >> 2, wc = wid & 3, fr = lane & 15, fq = lane >> 4;
    const int K = g.K, nt = K / BK;
    unsigned voffA[2], voffB[2];
#pragma unroll
    for (int i = 0; i < 2; ++i) { int R, C; stage_rc(tid * 16 + i * 8192, R, C); const int Rb = Epi::PERM ? ((R & ~31) + perm32(R & 31)) : R;
        voffA[i] = (unsigned)(R * K + C) * 2u; voffB[i] = (unsigned)(Rb * K + C) * 2u; }
    unsigned vgC[2][2], vgN[2][2]; int grow[2], gcol[2];
#pragma unroll
    for (int i = 0; i < 2; ++i) { stage_rc(tid * 16 + i * 8192, grow[i], gcol[i]); vgC[0][i] = vgC[1][i] = vgN[0][i] = vgN[1][i] = 0u; }
#define PG8_GLOAD(dst, unit) do { if constexpr (AGATHER) { _Pragma("unroll") for (int _h = 0; _h < 2; ++_h) _Pragma("unroll") for (int _i = 0; _i < 2; ++_i) \
        dst[_h][_i] = (unsigned)g.rowidx[(unit).pm * BM + _h * HALF + grow[_i]] * (unsigned)(K * 2) + (unsigned)(gcol[_i] * 2); } } while (0)
    const size_t kstep = (size_t)(BK * 2);
    const size_t hstep = (size_t)HALF * K * 2;
    const size_t tstep = 2 * hstep;
    const unsigned ldsw = (unsigned)wid * 1024u;
    const int aoff = lds_byte(wr * 64 + fr, fq * 8), boff = lds_byte(wc * 32 + fr, fq * 8);
#define PG8_SA(b, h) (((b) * 2 + (h)) * HTB)
#define PG8_SB(b, h) ((4 + (b) * 2 + (h)) * HTB)
#define PG8_STAGE_X(bufoff, gbase, voff, aux) do { _Pragma("unroll") for (int _i = 0; _i < 2; ++_i) \
        __builtin_amdgcn_global_load_lds((const unsigned*)((const char*)(gbase) + (voff)[_i]), (PG8_LAS unsigned*)(lds + (bufoff) + ldsw + _i * 8192), 16, 0, aux); } while (0)
#define PG8_STAGE(bufoff, gbase, voff) do { if constexpr (ASC1 && (bufoff) < 4 * HTB) PG8_STAGE_X(bufoff, gbase, voff, 16); else PG8_STAGE_X(bufoff, gbase, voff, 0); } while (0)
#define PG8_STAGE_A(bufoff, uptr, kofs, h, nx) do { if constexpr (AGATHER) { unsigned _vs[2] = {(nx) ? vgN[h][0] : vgC[h][0], (nx) ? vgN[h][1] : vgC[h][1]}; PG8_STAGE(bufoff, (const char*)g.A + (kofs), _vs); } \
        else PG8_STAGE(bufoff, uptr, voffA); } while (0)
#define PG8_LDA(dst, b, h) do { _Pragma("unroll") for (int m = 0; m < 4; ++m) _Pragma("unroll") for (int k = 0; k < 2; ++k) dst[m][k] = *(const PG8_LAS bf16x8*)(lds + PG8_SA(b, h) + aoff + m * 2048 + k * 1024); } while (0)
#define PG8_LDB(dst, b, h) do { _Pragma("unroll") for (int n = 0; n < 2; ++n) _Pragma("unroll") for (int k = 0; k < 2; ++k) dst[n][k] = *(const PG8_LAS bf16x8*)(lds + PG8_SB(b, h) + boff + n * 2048 + k * 1024); } while (0)
#define PG8_MMA(ai, bj, At, Bt) do { __builtin_amdgcn_s_setprio(1); _Pragma("unroll") for (int m = 0; m < 4; ++m) _Pragma("unroll") for (int n = 0; n < 2; ++n) _Pragma("unroll") for (int k = 0; k < 2; ++k) \
        acc[ai][bj][m][n] = __builtin_amdgcn_mfma_f32_16x16x32_bf16(Bt[n][k], At[m][k], acc[ai][bj][m][n], 0, 0, 0); __builtin_amdgcn_s_setprio(0); } while (0)
#define PG8_WAIT_V(n) asm volatile("s_waitcnt vmcnt(" #n ")" ::: "memory")
#define PG8_WAIT_L(n) asm volatile("s_waitcnt lgkmcnt(" #n ")" ::: "memory")
#define PG8_BAR __builtin_amdgcn_s_barrier()
#define PG8_SCHED __builtin_amdgcn_sched_barrier(0)
    Unit cur, nxt; int ui = 0;
    if (!S.next(0, cur)) return;
    f32x4 acc[2][2][4][2];
#pragma unroll
    for (int a = 0; a < 2; ++a)
#pragma unroll
        for (int b = 0; b < 2; ++b)
#pragma unroll
            for (int m = 0; m < 4; ++m)
#pragma unroll
                for (int n = 0; n < 2; ++n) acc[a][b][m][n] = (f32x4){0.f, 0.f, 0.f, 0.f};
    bf16x8 At[4][2], B0[2][2], B1[2][2];
    const char* cA = (const char*)g.A + (size_t)cur.pm * tstep; const char* cB = (const char*)g.Bt + (size_t)cur.pn * tstep;
    PG8_GLOAD(vgC, cur);
    S.a_ready(cur, S.peek(cur));
    static_assert(SP2, "only the SP2 pipeline is kept");
    {
        PG8_STAGE(PG8_SB(0, 0), cB, voffB); PG8_STAGE(PG8_SB(0, 1), cB + hstep, voffB); PG8_STAGE_A(PG8_SA(0, 0), cA, 0, 0, false); PG8_STAGE_A(PG8_SA(0, 1), cA + hstep, 0, 1, false);
        if (wr == 1) PG8_BAR;
        PG8_WAIT_V(2); PG8_BAR;
        PG8_STAGE(PG8_SB(1, 0), cB + kstep, voffB); PG8_STAGE_A(PG8_SA(1, 0), cA + kstep, kstep, 0, false); PG8_STAGE(PG8_SB(1, 1), cB + hstep + kstep, voffB);
        PG8_WAIT_V(6); PG8_BAR;
    }
    for (;;) {
        const bool has_next = S.next(ui + 1, nxt);
        if (has_next) PG8_GLOAD(vgN, nxt); else { if constexpr (AGATHER) { vgN[0][0] = vgC[0][0]; vgN[0][1] = vgC[0][1]; vgN[1][0] = vgC[1][0]; vgN[1][1] = vgC[1][1]; } }
        const unsigned tok = has_next ? S.peek(nxt) : 0u;
        const char* nA = has_next ? (const char*)g.A + (size_t)nxt.pm * tstep : cA; const char* nB = has_next ? (const char*)g.Bt + (size_t)nxt.pn * tstep : cB;
#pragma unroll 1
        for (int t = 0; t < nt; t += 2) {
            const bool last = (t == nt - 2);
            const char* a1 = cA + (size_t)(t + 1) * kstep;
            const char* a2 = last ? nA : cA + (size_t)(t + 2) * kstep; const char* b2 = last ? nB : cB + (size_t)(t + 2) * kstep;
            const char* a3 = a2 + kstep; const char* b3 = b2 + kstep;
            const size_t k1 = (size_t)(t + 1) * kstep, k2 = last ? 0 : (size_t)(t + 2) * kstep, k3 = k2 + kstep;
            if (last && has_next) S.a_ready(nxt, tok);
            {
            PG8_LDB(B0, 0, 0); PG8_LDB(B1, 0, 1); PG8_SCHED; PG8_LDA(At, 0, 0); PG8_STAGE_A(PG8_SA(1, 1), a1 + hstep, k1, 1, false);
            PG8_WAIT_V(8); PG8_WAIT_L(0); PG8_BAR; PG8_MMA(0, 0, At, B0); PG8_MMA(0, 1, At, B1); PG8_BAR; PG8_SCHED;
            PG8_LDA(At, 0, 1); PG8_STAGE(PG8_SB(0, 0), b2, voffB); PG8_STAGE(PG8_SB(0, 1), b2 + hstep, voffB); PG8_STAGE_A(PG8_SA(0, 0), a2, k2, 0, last);
            PG8_WAIT_V(8); PG8_WAIT_L(0); PG8_BAR; PG8_MMA(1, 0, At, B0); PG8_MMA(1, 1, At, B1); PG8_BAR; PG8_SCHED;
            PG8_LDB(B0, 1, 0); PG8_LDB(B1, 1, 1); PG8_SCHED; PG8_LDA(At, 1, 0); PG8_STAGE_A(PG8_SA(0, 1), a2 + hstep, k2, 1, last);
            PG8_WAIT_V(8); PG8_WAIT_L(0); PG8_BAR; PG8_MMA(0, 0, At, B0); PG8_MMA(0, 1, At, B1); PG8_BAR; PG8_SCHED;
            PG8_LDA(At, 1, 1); PG8_STAGE(PG8_SB(1, 0), b3, voffB); PG8_STAGE(PG8_SB(1, 1), b3 + hstep, voffB); PG8_STAGE_A(PG8_SA(1, 0), a3, k3, 0, last);
            PG8_WAIT_V(8); PG8_WAIT_L(0); PG8_BAR; PG8_MMA(1, 0, At, B0); PG8_MMA(1, 1, At, B1); PG8_BAR; PG8_SCHED;
            }
        }
        if constexpr (ALIGN_EPI) { if (wr == 0) PG8_BAR; }
        if constexpr (!Epi::AFTER_DRAIN) { E(acc, cur, wr, wc, fr, fq); S.done(cur); }
        if (!has_next) break;
#pragma unroll
        for (int a = 0; a < 2; ++a)
#pragma unroll
            for (int b = 0; b < 2; ++b)
#pragma unroll
                for (int m = 0; m < 4; ++m)
#pragma unroll
                    for (int n = 0; n < 2; ++n) acc[a][b][m][n] = (f32x4){0.f, 0.f, 0.f, 0.f};
        cur = nxt; cA = nA; cB = nB; ++ui;
        if constexpr (AGATHER) { vgC[0][0] = vgN[0][0]; vgC[0][1] = vgN[0][1]; vgC[1][0] = vgN[1][0]; vgC[1][1] = vgN[1][1]; }
        if constexpr (ALIGN_EPI) { if (wr == 1) PG8_BAR; }
    }
    PG8_WAIT_V(0);
    if constexpr (!ALIGN_EPI) { if (wr == 0) PG8_BAR; }
    PG8_BAR;
    if constexpr (Epi::AFTER_DRAIN) { E.fused(acc, cur, wr, wc, fr, fq, lds, wid, lane); S.done(cur); }
#undef PG8_SA
#undef PG8_SB
#undef PG8_STAGE
#undef PG8_STAGE_X
#undef PG8_LDA
#undef PG8_STAGE_A
#undef PG8_GLOAD
#undef PG8_LDB
#undef PG8_MMA
#undef PG8_WAIT_V
#undef PG8_WAIT_L
#undef PG8_BAR
#undef PG8_SCHED
}
}

constexpr bool PG_ALIGN = true, PG_SP2 = true;
__device__ __forceinline__ float bflo(unsigned w) { return __builtin_bit_cast(float, w << 16); }
__device__ __forceinline__ float bfhi(unsigned w) { return __builtin_bit_cast(float, w & 0xffff0000u); }
__device__ __forceinline__ unsigned cvtpk(float lo, float hi) { return pg8::cvt_pk_bf16(lo, hi); }

__device__ __forceinline__ void transpose_item(const float* W, int N, int k0, int n0, bf16* WT, int K, size_t dst_row0, LAS float* scr, int lane) {
    float v[32];
#pragma unroll
    for (int i = 0; i < 32; ++i) v[i] = W[(size_t)(k0 + 2 * i + (lane >> 5)) * N + n0 + (lane & 31)];
#pragma unroll
    for (int i = 0; i < 32; ++i) scr[(2 * i + (lane >> 5)) * 33 + (lane & 31)] = v[i];
    asm volatile("s_waitcnt lgkmcnt(0)" ::: "memory");
    const int c = lane & 7;
#pragma unroll
    for (int j = 0; j < 4; ++j) { const int n = (lane >> 3) + 8 * j; const LAS float* s = scr + (8 * c) * 33 + n;
        v4u o; o.x = pk2(s[0 * 33], s[1 * 33]); o.y = pk2(s[2 * 33], s[3 * 33]); o.z = pk2(s[4 * 33], s[5 * 33]); o.w = pk2(s[6 * 33], s[7 * 33]);
        *(v4u*)(WT + (dst_row0 + n) * K + k0 + 8 * c) = o; }
    asm volatile("s_waitcnt lgkmcnt(0)" ::: "memory");
}
constexpr int CONV_IN = 16 * 96, CONV_NITEMS = 16 * 96 + 16 * 96 + 8 * 16 + 3 * 8 * 32 + 16 * 32 + 2 * 32 * 16 * 8 + 32 * 4 * 32;
__device__ __forceinline__ void convert_weights(Frame& F, int l, int blk0, int nblk, int it_lo, int it_hi, bool extras) {
    LAS float* scr = (LAS float*)(F.lds + F.wave * 16384);
    const int cb = F.bid - blk0; if (cb < 0 || cb >= nblk) return;
    const int gw = cb * (NT / 64) + F.wave, ngw = nblk * (NT / 64);
    constexpr int I_IN = 16 * 96, I_MG = 16 * 96, I_GLU = 8 * 16, I_BR = 3 * 8 * 32, I_O = 16 * 32, I_1 = 32 * 16 * 8, I_3 = I_1, I_2 = 32 * 4 * 32;
    static_assert(I_IN == CONV_IN && I_IN + I_MG + I_GLU + I_BR + I_O + I_1 + I_3 + I_2 == CONV_NITEMS, "item list");
    for (int it = it_lo + gw; it < it_hi; it += ngw) {
        int r = it;
        if (r < I_IN) { const int kb = r / 96, nb = r % 96; transpose_item(IN_(I_WIN) + (size_t)l * D * INW, INW, 64 * kb, 32 * nb, (bf16*)(F.ws + WS_WIN), 1024, 32 * nb, scr, F.lane); continue; } r -= I_IN;
        if (r < I_MG) { const int kb = r / 96, nb = r % 96; transpose_item(IN_(I_WMG) + (size_t)l * D * INW, INW, 64 * kb, 32 * nb, (bf16*)(F.ws + WS_WMG), 1024, 32 * nb, scr, F.lane); continue; } r -= I_MG;
        if (r < I_GLU) { const int kb = r / 16, nb = r % 16; transpose_item(IN_(I_WGLU) + (size_t)l * MIXW * MIXW, MIXW, 64 * kb, 32 * nb, (bf16*)(F.ws + WS_WGLU), 512, 32 * nb, scr, F.lane); continue; } r -= I_GLU;
        if (r < I_BR) { const int kk = r / 256, q = r % 256, kb = q / 32, nb = q % 32; transpose_item(IN_(I_WBR) + ((size_t)l * 3 + kk) * MIXW * D, D, 64 * kb, 32 * nb, (bf16*)(F.ws + WS_WBR), 512, (size_t)kk * 1024 + 32 * nb, scr, F.lane); continue; } r -= I_BR;
        if (r < I_O) { const int kb = r / 32, nb = r % 32; transpose_item(IN_(I_WO) + (size_t)l * D * D, D, 64 * kb, 32 * nb, (bf16*)(F.ws + WS_WO), 1024, 32 * nb, scr, F.lane); continue; } r -= I_O;
        if (r < I_1 + I_3) { const int which = r / I_1, q = r % I_1, e = q / 128, q2 = q % 128, kb = q2 / 8, nb = q2 % 8;
            const float* W = IN_(which ? I_W3 : I_W1) + ((size_t)l * NE + e) * D * DFF; const int n0 = 32 * nb;
            transpose_item(W, DFF, 64 * kb, n0, (bf16*)(F.ws + WS_W13), 1024, (size_t)e * 512 + (n0 / 128) * 256 + which * 128 + (n0 % 128), scr, F.lane); continue; } r -= I_1 + I_3;
        { const int e = r / 128, q = r % 128, kb = q / 32, nb = q % 32; transpose_item(IN_(I_W2) + ((size_t)l * NE + e) * DFF * D, D, 64 * kb, 32 * nb, (bf16*)(F.ws + WS_W2), 256, (size_t)e * 1024 + 32 * nb, scr, F.lane); }
    }
    if (!extras) return;
    { bf16* wr = (bf16*)(F.ws + WS_WR); const float* wg = IN_(I_WGRP) + (size_t)l * D * 4; const float* we = IN_(I_WEXP) + (size_t)l * D * 32;
      for (int i = cb * NT + F.tid; i < 48 * 1024; i += nblk * NT) { const int n = i >> 10, kk = i & 1023; const float w = n < 4 ? wg[kk * 4 + n] : (n < 36 ? we[kk * 32 + n - 4] : 0.f);
          const unsigned hi = f2bf(w); const float lo = w - __builtin_bit_cast(float, hi << 16); wr[i] = (bf16)hi; wr[48 * 1024 + i] = (bf16)f2bf(lo); } }
    { const float* s = IN_(I_WSG) + (size_t)l * 4 * 128 * 128; bf16* d = (bf16*)(F.ws + WS_WSG);
      for (int i = (cb * NT + F.tid) * 2; i < 4 * 128 * 128; i += nblk * NT * 2) *(unsigned*)(d + i) = pk2(s[i], s[i + 1]); }
}

struct EpiProj { static constexpr bool PERM = true, AFTER_DRAIN = false; bf16* O;
    __device__ __forceinline__ void operator()(const pg8::f32x4 (&acc)[2][2][4][2], const pg8::Unit& u, int wr, int wc, int fr, int fq) const {
        const int row0 = u.pm * 256 + wr * 64 + fr, col0 = u.pn * 256 + wc * 32 + 8 * fq; const bool act = (u.pn >= 2 && u.pn < 6);
#pragma unroll
        for (int ai = 0; ai < 2; ++ai)
#pragma unroll
            for (int m = 0; m < 4; ++m) { bf16* rowp = O + (size_t)(row0 + ai * 128 + m * 16) * INW + col0;
#pragma unroll
                for (int bj = 0; bj < 2; ++bj) { pg8::f32x4 v0 = acc[ai][bj][m][0], v1 = acc[ai][bj][m][1];
                    if (act) {
#pragma unroll
                        for (int j = 0; j < 4; ++j) { v0[j] = geluf_(v0[j]); v1[j] = geluf_(v1[j]); } }
                    v4u w; w.x = cvtpk(v0[0], v0[1]); w.y = cvtpk(v0[2], v0[3]); w.z = cvtpk(v1[0], v1[1]); w.w = cvtpk(v1[2], v1[3]); *(v4u*)(rowp + bj * 128) = w; } }
    } };
struct EpiGlu { static constexpr bool PERM = true, AFTER_DRAIN = false; const bf16* YG; bf16* YA;
    __device__ __forceinline__ void operator()(const pg8::f32x4 (&acc)[2][2][4][2], const pg8::Unit& u, int wr, int wc, int fr, int fq) const {
        const int row0 = u.pm * 256 + wr * 64 + fr, col0 = u.pn * 256 + wc * 32 + 8 * fq;
#pragma unroll
        for (int ai = 0; ai < 2; ++ai) {
        v4u gv[4][2];
#pragma unroll
            for (int m = 0; m < 4; ++m)
#pragma unroll
                for (int bj = 0; bj < 2; ++bj) gv[m][bj] = *(const v4u*)(YG + (size_t)(row0 + ai * 128 + m * 16) * MIXW + col0 + bj * 128);
        asm volatile("" ::: "memory");
#pragma unroll
            for (int m = 0; m < 4; ++m) { const size_t off = (size_t)(row0 + ai * 128 + m * 16) * MIXW + col0;
#pragma unroll
                for (int bj = 0; bj < 2; ++bj) { const pg8::f32x4 v0 = acc[ai][bj][m][0], v1 = acc[ai][bj][m][1]; const v4u g = gv[m][bj];
                    v4u w; w.x = cvtpk(bflo(g.x) * sigmoidf_(v0[0]), bfhi(g.x) * sigmoidf_(v0[1])); w.y = cvtpk(bflo(g.y) * sigmoidf_(v0[2]), bfhi(g.y) * sigmoidf_(v0[3]));
                    w.z = cvtpk(bflo(g.z) * sigmoidf_(v1[0]), bfhi(g.z) * sigmoidf_(v1[1])); w.w = cvtpk(bflo(g.w) * sigmoidf_(v1[2]), bfhi(g.w) * sigmoidf_(v1[3])); *(v4u*)(YA + off + bj * 128) = w; } }
        asm volatile("" ::: "memory"); }
    } };
__device__ __forceinline__ int xcd_remap(int Lq, int total) { const int q = total >> 3, r = total & 7, x = Lq & 7, off = Lq >> 3; return (x < r ? x * (q + 1) : r * (q + 1) + (x - r) * q) + off; }
struct EpiBr { static constexpr bool PERM = true, AFTER_DRAIN = false; bf16* BR;
    __device__ __forceinline__ void operator()(const pg8::f32x4 (&acc)[2][2][4][2], const pg8::Unit& u, int wr, int wc, int fr, int fq) const {
        const int pm = u.pm % (MT / 256); const int row0 = pm * 256 + wr * 64 + fr, col0 = u.pn * 256 + wc * 32 + 8 * fq;
#pragma unroll
        for (int ai = 0; ai < 2; ++ai)
#pragma unroll
            for (int m = 0; m < 4; ++m) { bf16* rowp = BR + (size_t)(row0 + ai * 128 + m * 16) * INW + col0;
#pragma unroll
                for (int bj = 0; bj < 2; ++bj) { const pg8::f32x4 v0 = acc[ai][bj][m][0], v1 = acc[ai][bj][m][1];
                    v4u w; w.x = cvtpk(v0[0], v0[1]); w.y = cvtpk(v0[2], v0[3]); w.z = cvtpk(v1[0], v1[1]); w.w = cvtpk(v1[2], v1[3]); *(v4u*)(rowp + bj * 128) = w; } }
    } };
__device__ __forceinline__ int vu_pm(int v) { return (v >> 5) * 8 + (v & 7); }
__device__ __forceinline__ int vu_dt(int v) { return (v >> 3) & 3; }
struct SchedBr { int G, c, nM;
    __device__ __forceinline__ bool next(int i, pg8::Unit& u) const { const int v0 = (i / 3) * G + c, k = i % 3; if (v0 >= nM * 4) return false; const int v = xcd_remap(v0, nM * 4);
        u.pm = k * (MT / 256) + vu_pm(v); u.pn = k * 4 + vu_dt(v); return true; }
    __device__ __forceinline__ unsigned peek(const pg8::Unit&) const { return 0u; }
    __device__ __forceinline__ void a_ready(const pg8::Unit&, unsigned) const {}
    __device__ __forceinline__ void done(const pg8::Unit&) const {} };
struct EpiMerge { static constexpr bool PERM = true, AFTER_DRAIN = false; const bf16* BR; bf16* PM; const float* bm;
    __device__ __forceinline__ void operator()(const pg8::f32x4 (&acc)[2][2][4][2], const pg8::Unit& u, int wr, int wc, int fr, int fq) const {
        const int k = u.pn >> 2, dt = u.pn & 3; const int row0 = u.pm * 256 + wr * 64 + fr, col0 = dt * 256 + wc * 32 + 8 * fq;
#pragma unroll
        for (int bj = 0; bj < 2; ++bj) { const pg8::f32x4 b0 = *(const pg8::f32x4*)(bm + k * 1024 + col0 + bj * 128), b1 = *(const pg8::f32x4*)(bm + k * 1024 + col0 + bj * 128 + 4);
#pragma unroll
            for (int ai = 0; ai < 2; ++ai) {
            v4u brv[4], pmv[4];
#pragma unroll
                for (int m = 0; m < 4; ++m) { const size_t r = (size_t)(row0 + ai * 128 + m * 16); brv[m] = *(const v4u*)(BR + r * INW + k * 1024 + col0 + bj * 128);
                    pmv[m] = k > 0 ? *(const v4u*)(PM + r * D + col0 + bj * 128) : (v4u){0u, 0u, 0u, 0u}; }
                asm volatile("" ::: "memory");
#pragma unroll
                for (int m = 0; m < 4; ++m) { const size_t r = (size_t)(row0 + ai * 128 + m * 16); const v4u br = brv[m], o = pmv[m];
                    const pg8::f32x4 v0 = acc[ai][bj][m][0] + b0, v1 = acc[ai][bj][m][1] + b1;
                    float p[8] = {sigmoidf_(v0[0]) * bflo(br.x), sigmoidf_(v0[1]) * bfhi(br.x), sigmoidf_(v0[2]) * bflo(br.y), sigmoidf_(v0[3]) * bfhi(br.y),
                                  sigmoidf_(v1[0]) * bflo(br.z), sigmoidf_(v1[1]) * bfhi(br.z), sigmoidf_(v1[2]) * bflo(br.w), sigmoidf_(v1[3]) * bfhi(br.w)};
                    if (k > 0) { p[0] += bflo(o.x); p[1] += bfhi(o.x); p[2] += bflo(o.y); p[3] += bfhi(o.y); p[4] += bflo(o.z); p[5] += bfhi(o.z); p[6] += bflo(o.w); p[7] += bfhi(o.w); }
                    v4u w; w.x = cvtpk(p[0], p[1]); w.y = cvtpk(p[2], p[3]); w.z = cvtpk(p[4], p[5]); w.w = cvtpk(p[6], p[7]); *(v4u*)(PM + r * D + col0 + bj * 128) = w; }
                asm volatile("" ::: "memory"); } }
    } };
struct SchedMerge { int G, c, nM;
    __device__ __forceinline__ bool next(int i, pg8::Unit& u) const { const int v0 = (i / 3) * G + c, k = i % 3; if (v0 >= nM * 4) return false; const int v = xcd_remap(v0, nM * 4); u.pm = vu_pm(v); u.pn = k * 4 + vu_dt(v); return true; }
    __device__ __forceinline__ unsigned peek(const pg8::Unit&) const { return 0u; }
    __device__ __forceinline__ void a_ready(const pg8::Unit&, unsigned) const {}
    __device__ __forceinline__ void done(const pg8::Unit&) const {} };
struct EpiWo { static constexpr bool PERM = true, AFTER_DRAIN = false; const float* xin; bf16* X16; const float* mod_l; float* rss; int l0; int pad_;
    __device__ __forceinline__ void operator()(const pg8::f32x4 (&acc)[2][2][4][2], const pg8::Unit& u, int wr, int wc, int fr, int fq) const {
        const int row0 = u.pm * 256 + wr * 64 + fr, col0 = u.pn * 256 + wc * 32 + 8 * fq;
        const float* ga = mod_l + 2048;
        float ssq[2][4] = {};
        pg8::f32x4 gv[2][2];
#pragma unroll
        for (int bj = 0; bj < 2; ++bj)
#pragma unroll
            for (int n = 0; n < 2; ++n) gv[bj][n] = *(const pg8::f32x4*)(ga + col0 + bj * 128 + n * 4);
#pragma unroll
        for (int ai = 0; ai < 2; ++ai) {
#pragma unroll
            for (int mp = 0; mp < 2; ++mp) {
            pg8::f32x4 xv[2][2][2];
            if (l0) {
#pragma unroll
                for (int m = 0; m < 2; ++m) { const size_t off = (size_t)(row0 + ai * 128 + (mp * 2 + m) * 16) * D + col0;
#pragma unroll
                    for (int bj = 0; bj < 2; ++bj)
#pragma unroll
                        for (int n = 0; n < 2; ++n) xv[m][bj][n] = *(const pg8::f32x4*)(xin + off + bj * 128 + n * 4); }
                asm volatile("" ::: "memory");
            } else {
                v4u xb[2][2];
#pragma unroll
                for (int m = 0; m < 2; ++m) { const size_t off = (size_t)(row0 + ai * 128 + (mp * 2 + m) * 16) * D + col0;
#pragma unroll
                    for (int bj = 0; bj < 2; ++bj) xb[m][bj] = *(const v4u*)(X16 + off + bj * 128); }
                asm volatile("" ::: "memory");
#pragma unroll
                for (int m = 0; m < 2; ++m)
#pragma unroll
                    for (int bj = 0; bj < 2; ++bj) { const v4u w = xb[m][bj]; xv[m][bj][0] = (pg8::f32x4){bflo(w.x), bfhi(w.x), bflo(w.y), bfhi(w.y)}; xv[m][bj][1] = (pg8::f32x4){bflo(w.z), bfhi(w.z), bflo(w.w), bfhi(w.w)}; }
            }
#pragma unroll
            for (int m = 0; m < 2; ++m) { const size_t off = (size_t)(row0 + ai * 128 + (mp * 2 + m) * 16) * D + col0;
#pragma unroll
                for (int bj = 0; bj < 2; ++bj) { const pg8::f32x4 o0 = xv[m][bj][0] + gv[bj][0] * acc[ai][bj][m + mp * 2][0], o1 = xv[m][bj][1] + gv[bj][1] * acc[ai][bj][m + mp * 2][1];
                    v4u w; w.x = cvtpk(o0[0], o0[1]); w.y = cvtpk(o0[2], o0[3]); w.z = cvtpk(o1[0], o1[1]); w.w = cvtpk(o1[2], o1[3]); *(v4u*)(X16 + off + bj * 128) = w;
                    ssq[ai][m + mp * 2] += (o0[0] * o0[0] + o0[1] * o0[1] + o0[2] * o0[2] + o0[3] * o0[3]) + (o1[0] * o1[0] + o1[1] * o1[1] + o1[2] * o1[2] + o1[3] * o1[3]); } }
            asm volatile("" ::: "memory"); }
        }
        const int lane = fr + 16 * fq;
#pragma unroll
        for (int ai = 0; ai < 2; ++ai)
#pragma unroll
            for (int m = 0; m < 4; ++m) { float s = ssq[ai][m]; s += shflx(s, 16, lane); s += shflx(s, 32, lane); if (fq == 0) rss[(size_t)(row0 + ai * 128 + m * 16) * 16 + u.pn * 4 + wc] = s; }
    } };
constexpr int MOETAB_OFF = 131072 + 2048;
__device__ __forceinline__ int moe_build_tables(Frame& F, const unsigned* cnt, LAS unsigned* tabu, LAS unsigned* tabd) {
    LAS int* RAW = (LAS int*)(F.lds + MOETAB_OFF + 8192); LAS int* PRE = RAW + 32;
    if (F.tid < 32) RAW[F.tid] = ((int)cnt[F.tid] + 255) >> 8;
    __syncthreads();
    if (F.tid <= 32) { int s = 0; for (int i = 0; i < F.tid; ++i) s += RAW[i]; PRE[F.tid] = s; }
    __syncthreads();
    const int nrt = PRE[32];
    for (int q = F.tid; q < nrt * 6; q += NT) { const int rt = q / 6, w = q % 6; int e = 0;
#pragma unroll 1
        for (int i = 1; i < 32; ++i) e += PRE[i] <= rt ? 1 : 0;
        if (w < 2) tabu[rt * 2 + w] = ((unsigned)rt << 16) | (unsigned)(e * 2 + w); else tabd[rt * 4 + (w - 2)] = ((unsigned)rt << 16) | (unsigned)(e * 4 + (w - 2)); }
    __syncthreads();
    return nrt;
}
__device__ __forceinline__ void xcd_chunk(int total, int x, int& start, int& size) { const int q = total >> 3, r = total & 7; size = q + (x < r ? 1 : 0); start = x < r ? x * (q + 1) : r * (q + 1) + (x - r) * q; }
struct SchedMoeUp { int G, c, nrt, tid; const LAS unsigned* tabw; unsigned* upc;
    __device__ __forceinline__ bool next(int i, pg8::Unit& u) const {
        int Lq;
        if (G & 7) { Lq = i * G + c; if (Lq >= 2 * nrt) return false; }
        else { int rs, rn; xcd_chunk(nrt, c & 7, rs, rn); const int nb = G >> 3, j = c >> 3, o0 = i * nb; if (o0 + j >= 2 * rn) return false;
            const int n = (2 * rn - o0) < nb ? (2 * rn - o0) : nb, h = n >> 1;
            Lq = (n & 1) ? 2 * rs + o0 + j : 2 * (rs + (o0 >> 1) + (j % h)) + (j / h); }
        const unsigned w = (unsigned)__builtin_amdgcn_readfirstlane((int)tabw[Lq]); u.pm = (int)(w >> 16); u.pn = (int)(w & 0xffffu); return true; }
    __device__ __forceinline__ unsigned peek(const pg8::Unit&) const { return 0u; }
    __device__ __forceinline__ void a_ready(const pg8::Unit&, unsigned) const {}
    __device__ __forceinline__ void done(const pg8::Unit& u) const {
        asm volatile("s_waitcnt vmcnt(0)" ::: "memory"); __builtin_amdgcn_s_barrier();
        if (tid == 0) __hip_atomic_fetch_add(upc + u.pm, 1u, __ATOMIC_RELAXED, __HIP_MEMORY_SCOPE_AGENT); } };
struct SchedMoeDown { int G, c, nrt, pad_; const LAS unsigned* tabw; unsigned* upc;
    __device__ __forceinline__ bool next(int i, pg8::Unit& u) const {
        int Lq;
        if (G & 7) { Lq = i * G + c; if (Lq >= 4 * nrt) return false; }
        else { const int j = c >> 3, nb = G >> 3; int rs, rn; xcd_chunk(nrt, c & 7, rs, rn); const int un = 2 * rn, dn = 4 * rn;
            const int a = un / nb, n2 = un % nb, nu = a + (j < n2 ? 1 : 0), s = 2 * nu + i;
            const int c0 = s - 2 * a, c1 = s - 2 * a - 2; const int off = (nb - n2) * (c0 > 0 ? c0 : 0) + n2 * (c1 > 0 ? c1 : 0) + (c1 >= 0 ? j : j - n2);
            if (off >= dn) return false; Lq = 4 * rs + off; }
        const unsigned w = (unsigned)__builtin_amdgcn_readfirstlane((int)tabw[Lq]); u.pm = (int)(w >> 16); u.pn = (int)(w & 0xffffu); return true; }
    __device__ __forceinline__ unsigned peek(const pg8::Unit& u) const { return __hip_atomic_load(upc + u.pm, __ATOMIC_RELAXED, __HIP_MEMORY_SCOPE_AGENT); }
    __device__ __forceinline__ void a_ready(const pg8::Unit& u, unsigned tok) const {
        if ((unsigned)__builtin_amdgcn_readfirstlane((int)tok) >= 2u) return;
        unsigned* p = upc + u.pm; unsigned spins = 0;
        while ((unsigned)__builtin_amdgcn_readfirstlane((int)__hip_atomic_load(p, __ATOMIC_RELAXED, __HIP_MEMORY_SCOPE_AGENT)) < 2u) { __builtin_amdgcn_s_sleep(2); if (++spins > (1u << 22)) break; } }
    __device__ __forceinline__ void done(const pg8::Unit&) const {} };
struct EpiUp { static constexpr bool PERM = true, AFTER_DRAIN = false; bf16* ACT; const float* SW;
    __device__ __forceinline__ void operator()(const pg8::f32x4 (&acc)[2][2][4][2], const pg8::Unit& u, int wr, int wc, int fr, int fq) const {
        const int row0 = u.pm * 256 + wr * 64 + fr, f0 = (u.pn & 1) * 128 + wc * 32 + 8 * fq;
        const __amdgpu_buffer_rsrc_t rs = __builtin_amdgcn_make_buffer_rsrc(ACT, 0, MAXSLOT * DFF * 2, 0x00020000);
        float wv[2][4];
#pragma unroll
        for (int ai = 0; ai < 2; ++ai)
#pragma unroll
            for (int m = 0; m < 4; ++m) wv[ai][m] = SW[row0 + ai * 128 + m * 16];
        asm volatile("" ::: "memory");
#pragma unroll
        for (int ai = 0; ai < 2; ++ai)
#pragma unroll
            for (int m = 0; m < 4; ++m) { const int slot = row0 + ai * 128 + m * 16; const float w = wv[ai][m];
                const pg8::f32x4 a0 = acc[ai][0][m][0], a1 = acc[ai][0][m][1], b0 = acc[ai][1][m][0], b1 = acc[ai][1][m][1];
                v4u o; o.x = cvtpk(siluf_(a0[0]) * b0[0] * w, siluf_(a0[1]) * b0[1] * w); o.y = cvtpk(siluf_(a0[2]) * b0[2] * w, siluf_(a0[3]) * b0[3] * w);
                o.z = cvtpk(siluf_(a1[0]) * b1[0] * w, siluf_(a1[1]) * b1[1] * w); o.w = cvtpk(siluf_(a1[2]) * b1[2] * w, siluf_(a1[3]) * b1[3] * w);
                __builtin_amdgcn_raw_buffer_store_b128(o, rs, (unsigned)((slot * DFF + f0) * 2), 0,   16); }
    } };
struct EpiDown { static constexpr bool PERM = true, AFTER_DRAIN = false; bf16* YS2;
    __device__ __forceinline__ void operator()(const pg8::f32x4 (&acc)[2][2][4][2], const pg8::Unit& u, int wr, int wc, int fr, int fq) const {
        const int row0 = u.pm * 256 + wr * 64 + fr, col0 = (u.pn & 3) * 256 + wc * 32 + 8 * fq;
#pragma unroll
        for (int ai = 0; ai < 2; ++ai)
#pragma unroll
            for (int m = 0; m < 4; ++m) { bf16* rowp = YS2 + (size_t)(row0 + ai * 128 + m * 16) * D + col0;
#pragma unroll
                for (int bj = 0; bj < 2; ++bj) { const pg8::f32x4 v0 = acc[ai][bj][m][0], v1 = acc[ai][bj][m][1];
                    v4u w; w.x = cvtpk(v0[0], v0[1]); w.y = cvtpk(v0[2], v0[3]); w.z = cvtpk(v1[0], v1[1]); w.w = cvtpk(v1[2], v1[3]); *(v4u*)(rowp + bj * 128) = w; } }
    } };


__device__ __forceinline__ void ph2_fast(Frame& F, int l) {
    pg8::Gemm g{(const bf16*)HBUF(F), (const bf16*)(F.ws + WS_WIN), SEQ, INW, D, 0, nullptr}; pg8::StaticOrder S; S.init(SEQ, INW, F.G, F.bid);
    EpiProj E{(bf16*)(F.ws + WS_PROJ)}; pg8::gemm_phase<EpiProj, pg8::StaticOrder, PG_ALIGN, PG_SP2>(F.lds, g, S, E, F.tid);
}
__device__ __forceinline__ void ph6_fast(Frame& F, int l) {
    pg8::Gemm g{(const bf16*)(F.ws + WS_YG), (const bf16*)(F.ws + WS_WGLU), MT, MIXW, MIXW, 0, nullptr}; pg8::StaticOrder S; S.init(l == 0 ? MT : SEQ, MIXW, F.G, F.bid);
    EpiGlu E{(const bf16*)(F.ws + WS_YG), (bf16*)(F.ws + WS_YS)}; pg8::gemm_phase<EpiGlu, pg8::StaticOrder, PG_ALIGN, PG_SP2>(F.lds, g, S, E, F.tid);
}
__device__ __forceinline__ void ph7_fast(Frame& F, int l) {
    pg8::Gemm g{(const bf16*)(F.ws + WS_YS), (const bf16*)(F.ws + WS_WBR), 3 * MT, 3 * D, MIXW, 0, nullptr}; SchedBr S{F.G, F.bid, SEQ / 256};
    EpiBr E{(bf16*)(F.ws + WS_PROJ)}; pg8::gemm_phase<EpiBr, SchedBr, PG_ALIGN, PG_SP2>(F.lds, g, S, E, F.tid);
}
__device__ __forceinline__ void ph8_fast(Frame& F, int l) {
    pg8::Gemm g{(const bf16*)HBUF(F), (const bf16*)(F.ws + WS_WMG), MT, INW, D, 0, nullptr}; SchedMerge S{F.G, F.bid, SEQ / 256};
    EpiMerge E{(const bf16*)(F.ws + WS_PROJ), (bf16*)(F.ws + WS_PM), IN_(I_BMG) + l * INW}; pg8::gemm_phase<EpiMerge, SchedMerge, PG_ALIGN, PG_SP2>(F.lds, g, S, E, F.tid);
}
__device__ __forceinline__ void ph9_fast(Frame& F, int l) {
    pg8::Gemm g{(const bf16*)(F.ws + WS_PM), (const bf16*)(F.ws + WS_WO), MT, D, D, 0, nullptr}; pg8::StaticOrder S; S.init(SEQ, D, F.G, F.bid);
    EpiWo E{IN_(I_X), (bf16*)(F.ws + WS_X16), (const float*)(F.ws + WS_MOD) + (size_t)l * 2 * 6144, (float*)(F.ws + WS_RSS), l == 0 ? 1 : 0, 0};
    pg8::gemm_phase<EpiWo, pg8::StaticOrder, PG_ALIGN, PG_SP2>(F.lds, g, S, E, F.tid);
}
__device__ __forceinline__ void ph12_moe(Frame& F, int l) {
    LAS unsigned* tabu = (LAS unsigned*)(F.lds + MOETAB_OFF); LAS unsigned* tabd = tabu + 1024; unsigned* upc = F.ctl + CW_UPC + l * 256;
    const int nrt = moe_build_tables(F, F.ctl + CW_CNT + l * 128, tabu, tabd);
#define MOE_STAMP(i) do { if ((PROBE_A >= 0 || PROBE_B >= 0) && l == 0 && F.tid == 0) ((volatile LAS unsigned long long*)(F.lds + TS_OFF))[i] = __builtin_amdgcn_s_memrealtime(); } while (0)
    MOE_STAMP(60);
    { pg8::Gemm g{(const bf16*)HBUF(F), (const bf16*)(F.ws + WS_W13), MAXSLOT, NE * 512, D, 0, (const int*)(F.ws + WS_STOK)}; SchedMoeUp S{F.G, F.bid, nrt, F.tid, tabu, upc};
      EpiUp E{(bf16*)(F.ws + WS_ACT), (const float*)(F.ws + WS_SW)}; pg8::gemm_phase<EpiUp, SchedMoeUp, PG_ALIGN, PG_SP2, false, true>(F.lds, g, S, E, F.tid); }
    MOE_STAMP(61);
    { pg8::Gemm g{(const bf16*)(F.ws + WS_ACT), (const bf16*)(F.ws + WS_W2), MAXSLOT, NE * D, DFF, 0, nullptr}; SchedMoeDown S{F.G, F.bid, nrt, 0, tabd, upc};
      EpiDown E{(bf16*)(F.ws + WS_YS2)}; pg8::gemm_phase<EpiDown, SchedMoeDown, PG_ALIGN, PG_SP2, true>(F.lds, g, S, E, F.tid); }
    MOE_STAMP(62);
    if (PROBE_A == 99 && l == 0 && F.tid == 0) { volatile LAS unsigned long long* TS = (volatile LAS unsigned long long*)(F.lds + TS_OFF); __hip_atomic_fetch_max(F.ctl + 100, ((unsigned)(TS[62] - TS[12]) << 8) | (unsigned)F.bid, __ATOMIC_RELAXED, __HIP_MEMORY_SCOPE_AGENT); }
}


constexpr int NSB = MT / 16;
__device__ __forceinline__ void s5_precompute(Frame& F) {
    LAS float* APr = (LAS float*)F.lds; LAS float* APi = APr + 2176; LAS float* BBr = APi + 2176; LAS float* BBi = BBr + 2048; LAS float* CCr = BBi + 2048; LAS float* CCi = CCr + 2048; LAS float* KK = CCi + 2048;
    for (int item = F.G - 1 - F.bid; item < 2 * G5; item += F.G) { const int l = item >> 5, g = item & 31;
        __syncthreads();
        if (F.tid < 128) { const int d = F.tid >> 6, p = F.tid & 63; const int ldg = (l * 2 + d) * G5 + g;
            const double lr = IN_(I_LRE)[ldg * P5 + p], li = IN_(I_LIM)[ldg * P5 + p], dt = exp((double)IN_(I_LDT)[ldg]);
            for (int e = 0; e <= 16; ++e) { const double m = exp(lr * dt * e), ang = li * dt * e; APr[(d * 64 + p) * 17 + e] = (float)(m * cos(ang)); APi[(d * 64 + p) * 17 + e] = (float)(m * sin(ang)); }
            { const double m16 = exp(lr * dt * 16.0), a16 = li * dt * 16.0; float* A16 = (float*)(F.ws + WS_A16) + ((size_t)((l * 32 + g) * 2 + d) * 64 + p) * 2; A16[0] = (float)(m16 * cos(a16)); A16[1] = (float)(m16 * sin(a16)); }
            const double m1 = exp(lr * dt), ar = m1 * cos(li * dt), ai = m1 * sin(li * dt); const double nr = ar - 1.0, ni = ai, den = lr * lr + li * li;
            const double qr = (nr * lr + ni * li) / den, qi = (ni * lr - nr * li) / den;
            for (int h = 0; h < 16; ++h) { const double x = IN_(I_BRE)[((size_t)ldg * P5 + p) * H5 + h], y = IN_(I_BIM)[((size_t)ldg * P5 + p) * H5 + h];
                BBr[(d * 64 + p) * 16 + h] = (float)(qr * x - qi * y); BBi[(d * 64 + p) * 16 + h] = (float)(qr * y + qi * x);
                CCr[(d * 16 + h) * 64 + p] = IN_(I_CRE)[((size_t)ldg * H5 + h) * P5 + p]; CCi[(d * 16 + h) * 64 + p] = IN_(I_CIM)[((size_t)ldg * H5 + h) * P5 + p]; } }
        __syncthreads();
        { const int d = F.tid >> 8, e = (F.tid >> 4) & 15, hp = F.tid & 15;
          float wr[64], wi[64];
#pragma unroll
          for (int p = 0; p < 64; ++p) { const float pr = APr[(d * 64 + p) * 17 + e], pi = APi[(d * 64 + p) * 17 + e], br = BBr[(d * 64 + p) * 16 + hp], bi = BBi[(d * 64 + p) * 16 + hp]; wr[p] = pr * br - pi * bi; wi[p] = pr * bi + pi * br; }
#pragma unroll 1
          for (int h = 0; h < 16; ++h) { float a = 0.f;
#pragma unroll
              for (int p = 0; p < 64; ++p) a += CCr[(d * 16 + h) * 64 + p] * wr[p] - CCi[(d * 16 + h) * 64 + p] * wi[p];
              KK[(d * 16 + e) * 256 + h * 16 + hp] = a; } }
        __syncthreads();
        bf16* M = (bf16*)(F.ws + WS_S5M) + (size_t)(l * 32 + g) * 3 * 65536;
        for (int idx = F.tid; idx < 32768; idx += NT) {
            const int r = idx >> 7, k0 = (idx & 127) * 2; float v[3][2];
#pragma unroll
            for (int q = 0; q < 2; ++q) { const int kk = k0 + q;
                { const int d = r >> 7, p = (r >> 1) & 63, c = r & 1, sg = kk >> 4, hp = kk & 15, e = d == 0 ? 15 - sg : sg;
                  const float pr = APr[(d * 64 + p) * 17 + e], pi = APi[(d * 64 + p) * 17 + e], br = BBr[(d * 64 + p) * 16 + hp], bi = BBi[(d * 64 + p) * 16 + hp];
                  v[0][q] = c == 0 ? pr * br - pi * bi : pr * bi + pi * br; }
                { const int tau = r >> 4, h = r & 15, sg = kk >> 4, hp = kk & 15; float t = 0.f;
                  if (sg <= tau) t += KK[(0 * 16 + (tau - sg)) * 256 + h * 16 + hp]; if (sg >= tau) t += KK[(1 * 16 + (sg - tau)) * 256 + h * 16 + hp]; v[1][q] = t; }
                { const int tau = r >> 4, h = r & 15, d = kk >> 7, p = (kk >> 1) & 63, c = kk & 1, e = d == 0 ? tau + 1 : 16 - tau;
                  const float cr = CCr[(d * 16 + h) * 64 + p], ci = CCi[(d * 16 + h) * 64 + p], pr = APr[(d * 64 + p) * 17 + e], pi = APi[(d * 64 + p) * 17 + e];
                  v[2][q] = c == 0 ? cr * pr - ci * pi : -(cr * pi + ci * pr); } }
#pragma unroll
            for (int m = 0; m < 3; ++m) *(unsigned*)(M + (size_t)m * 65536 + r * 256 + k0) = pk2(v[m][0], v[m][1]);
        }
    }
}
constexpr int ZS_OFF = 16384, ZS_STRIDE = 528, EX_OFF = ZS_OFF + 144 * ZS_STRIDE, CARRY_OFF = EX_OFF + 4 * 128 * 16;
__device__ __forceinline__ void s5_fused_phase(Frame& F, int l) {
    const bf16* PROJ = (const bf16*)(F.ws + WS_PROJ); bf16* YG = (bf16*)(F.ws + WS_YG); const float* ds = IN_(I_DSKIP) + l * MIXW;
    unsigned long long* GR = (unsigned long long*)(F.ws + WS_GR); const unsigned tag = (unsigned)l + 1u;
    const int l15 = F.lane & 15, lq = F.lane >> 4; const int G8 = F.G & ~7;
    LAS unsigned char* ZS = F.lds + ZS_OFF; LAS float* EX = (LAS float*)(F.lds + EX_OFF); LAS float* CR = (LAS float*)(F.lds + CARRY_OFF);
    if (F.bid < G8)
    for (int item = F.bid; item < 256; item += G8) {
        const int g = item >> 3, p = item & 7;
        const bf16* vsrc = PROJ + (size_t)(16 * l15 + 2 * F.wave + (lq >> 1)) * INW + 16 * g + 8 * (lq & 1);
        {   const bf16* Fm = (const bf16*)(F.ws + WS_S5M) + (size_t)(l * 32 + g) * 3 * 65536;
            bf16x8 Af[2][8], nvz[9];
#pragma unroll
            for (int j = 0; j < 2; ++j)
#pragma unroll
                for (int ks = 0; ks < 8; ++ks) Af[j][ks] = *(const bf16x8*)(Fm + (size_t)(16 * (2 * F.wave + j) + l15) * 256 + 32 * ks + 8 * lq);
#pragma unroll
            for (int s = 0; s < 9; ++s) nvz[s] = *(const bf16x8*)(vsrc + (size_t)(s == 0 ? 64 : 8 * p + s - 1) * 256 * INW);
            __syncthreads();
            *(LAS bf16x8*)(F.lds + (F.wave * 64 + F.lane) * 16) = nvz[0];
            __syncthreads();
            int cur = 0;
#pragma unroll
            for (int s = 0; s < 9; ++s) {
                f32x4 acc[2] = {{0.f, 0.f, 0.f, 0.f}, {0.f, 0.f, 0.f, 0.f}};
#pragma unroll
                for (int ks = 0; ks < 8; ++ks) { const bf16x8 V = *(const LAS bf16x8*)(F.lds + cur * 8192 + (ks * 64 + F.lane) * 16);
#pragma unroll
                    for (int j = 0; j < 2; ++j) acc[j] = __builtin_amdgcn_mfma_f32_16x16x32_bf16(Af[j][ks], V, acc[j], 0, 0, 0); }
#pragma unroll
                for (int j = 0; j < 2; ++j) { v2u zz; zz.x = pk2(acc[j][0], acc[j][1]); zz.y = pk2(acc[j][2], acc[j][3]); *(LAS v2u*)(ZS + (s * 16 + l15) * ZS_STRIDE + (16 * (2 * F.wave + j) + 4 * lq) * 2) = zz; }
                if (s < 8) *(LAS bf16x8*)(F.lds + (cur ^ 1) * 8192 + (F.wave * 64 + F.lane) * 16) = nvz[s + 1];
                __syncthreads();
                cur ^= 1;
            }
        }
        {   const int c = F.tid & 127, j = F.tid >> 7, d = c >> 6;
            const float* A16 = (const float*)(F.ws + WS_A16) + ((size_t)((l * 32 + g) * 2 + d) * 64 + (c & 63)) * 2; const float ar = A16[0], ai = A16[1];
            LAS unsigned char* zc = ZS + c * 4;
            float hr = 0.f, hi = 0.f, pr = 1.f, pi = 0.f;
#pragma unroll 4
            for (int q = 0; q < 32; ++q) { const int i = 32 * j + q, row = 16 + (d ? 127 - i : i); const unsigned zw = *(const LAS unsigned*)(zc + row * ZS_STRIDE);
                const float nr = ar * hr - ai * hi + bflo(zw), ni = ar * hi + ai * hr + bfhi(zw); hr = nr; hi = ni; const float qr = pr * ar - pi * ai, qi = pr * ai + pi * ar; pr = qr; pi = qi; }
            EX[(j * 128 + c) * 4 + 0] = hr; EX[(j * 128 + c) * 4 + 1] = hi; EX[(j * 128 + c) * 4 + 2] = pr; EX[(j * 128 + c) * 4 + 3] = pi;
            __syncthreads();
            if (j == 0) {
                float er = 0.f, ei = 0.f, Ar = 1.f, Ai = 0.f;
#pragma unroll
                for (int jj = 0; jj < 4; ++jj) { const float h0 = EX[(jj * 128 + c) * 4], h1 = EX[(jj * 128 + c) * 4 + 1], q0 = EX[(jj * 128 + c) * 4 + 2], q1 = EX[(jj * 128 + c) * 4 + 3];
                    const float nr = q0 * er - q1 * ei + h0, ni = q0 * ei + q1 * er + h1; er = nr; ei = ni; const float tr = Ar * q0 - Ai * q1, ti = Ar * q1 + Ai * q0; Ar = tr; Ai = ti; }
                unsigned long long* mine = GR + ((size_t)(g * 8 + p) * 128 + c) * 2;
                __hip_atomic_store(mine, ((unsigned long long)tag << 32) | __builtin_bit_cast(unsigned, er), __ATOMIC_RELAXED, __HIP_MEMORY_SCOPE_AGENT);
                __hip_atomic_store(mine + 1, ((unsigned long long)tag << 32) | __builtin_bit_cast(unsigned, ei), __ATOMIC_RELAXED, __HIP_MEMORY_SCOPE_AGENT);
                float cr = 0.f, ci = 0.f;
#pragma unroll 4
                for (int i = 0; i < 16; ++i) { const int row = d ? 15 - i : i; const unsigned zw = *(const LAS unsigned*)(zc + row * ZS_STRIDE); *(LAS unsigned*)(zc + row * ZS_STRIDE) = pk2(cr, ci);
                    const float nr = ar * cr - ai * ci + bflo(zw), ni = ar * ci + ai * cr + bfhi(zw); cr = nr; ci = ni; }
                const int np = d ? 7 - p : p;
#pragma unroll 1
                for (int t = 0; t < np; ++t) { const int pp = d ? 7 - t : t; unsigned long long* o = GR + ((size_t)(g * 8 + pp) * 128 + c) * 2; unsigned long long x0, x1; unsigned spins = 0;
                    for (;;) { x0 = __hip_atomic_load(o, __ATOMIC_RELAXED, __HIP_MEMORY_SCOPE_AGENT); x1 = __hip_atomic_load(o + 1, __ATOMIC_RELAXED, __HIP_MEMORY_SCOPE_AGENT);
                        if ((unsigned)(x0 >> 32) == tag && (unsigned)(x1 >> 32) == tag) break; __builtin_amdgcn_s_sleep(2); if (++spins > (1u << 22)) break; }
                    const float e0 = __builtin_bit_cast(float, (unsigned)x0), e1 = __builtin_bit_cast(float, (unsigned)x1);
                    const float nr = Ar * cr - Ai * ci + e0, ni = Ar * ci + Ai * cr + e1; cr = nr; ci = ni; }
                CR[c * 2] = cr; CR[c * 2 + 1] = ci;
            }
            __syncthreads();
            float sr = CR[c * 2], si = CR[c * 2 + 1];
            for (int jj = 0; jj < j; ++jj) { const float h0 = EX[(jj * 128 + c) * 4], h1 = EX[(jj * 128 + c) * 4 + 1], q0 = EX[(jj * 128 + c) * 4 + 2], q1 = EX[(jj * 128 + c) * 4 + 3];
                const float nr = q0 * sr - q1 * si + h0, ni = q0 * si + q1 * sr + h1; sr = nr; si = ni; }
#pragma unroll 4
            for (int q = 0; q < 32; ++q) { const int i = 32 * j + q, row = 16 + (d ? 127 - i : i); const unsigned zw = *(const LAS unsigned*)(zc + row * ZS_STRIDE); *(LAS unsigned*)(zc + row * ZS_STRIDE) = pk2(sr, si);
                const float nr = ar * sr - ai * si + bflo(zw), ni = ar * si + ai * sr + bfhi(zw); sr = nr; si = ni; }
        }
        {   const bf16* Tm = (const bf16*)(F.ws + WS_S5M) + ((size_t)(l * 32 + g) * 3 + 1) * 65536; const bf16* Em = Tm + 65536;
            bf16x8 At[2][8], Ae[2][8];
#pragma unroll
            for (int j = 0; j < 2; ++j)
#pragma unroll
                for (int ks = 0; ks < 8; ++ks) { const size_t o = (size_t)(16 * (2 * F.wave + j) + l15) * 256 + 32 * ks + 8 * lq; At[j][ks] = *(const bf16x8*)(Tm + o); Ae[j][ks] = *(const bf16x8*)(Em + o); }
            const f32x4 dsk = *(const f32x4*)(ds + 16 * g + 4 * lq);
            const int s0 = (p == 0 && l == 0) ? 0 : 1;
            bf16x8 nA = *(const bf16x8*)(vsrc + (size_t)(s0 == 0 ? 64 : 8 * p) * 256 * INW), nB = *(const bf16x8*)(vsrc + (size_t)(8 * p + s0) * 256 * INW), nC = *(const bf16x8*)(vsrc + (size_t)(8 * p + s0 + 1) * 256 * INW);
            __syncthreads();
            *(LAS bf16x8*)(F.lds + (F.wave * 64 + F.lane) * 16) = nA;
            __syncthreads();
            int cur = 0;
#pragma unroll 1
            for (int s = s0; s < 9; ++s) { const int tl = s == 0 ? 64 : 8 * p + s - 1;
                bf16x8 nD = nC; if (s + 3 < 9) nD = *(const bf16x8*)(vsrc + (size_t)(8 * p + s + 2) * 256 * INW);
                v2u uu[2];
#pragma unroll
                for (int j = 0; j < 2; ++j) uu[j] = *(const LAS v2u*)(F.lds + cur * 8192 + (F.wave * 64 + l15 + 16 * (2 * j + (lq >> 1))) * 16 + 8 * (lq & 1));
                f32x4 acc[2] = {{0.f, 0.f, 0.f, 0.f}, {0.f, 0.f, 0.f, 0.f}};
#pragma unroll
                for (int ks = 0; ks < 8; ++ks) { const bf16x8 V = *(const LAS bf16x8*)(F.lds + cur * 8192 + (ks * 64 + F.lane) * 16), S = *(const LAS bf16x8*)(ZS + (s * 16 + l15) * ZS_STRIDE + (32 * ks + 8 * lq) * 2);
#pragma unroll
                    for (int j = 0; j < 2; ++j) { acc[j] = __builtin_amdgcn_mfma_f32_16x16x32_bf16(At[j][ks], V, acc[j], 0, 0, 0); acc[j] = __builtin_amdgcn_mfma_f32_16x16x32_bf16(Ae[j][ks], S, acc[j], 0, 0, 0); } }
#pragma unroll
                for (int j = 0; j < 2; ++j) { const size_t row = (size_t)tl * 256 + 16 * l15 + (2 * F.wave + j); const int ch = 16 * g + 4 * lq; const v2u u = uu[j];
                    const float y0 = acc[j][0] + dsk[0] * bflo(u.x), y1 = acc[j][1] + dsk[1] * bfhi(u.x), y2 = acc[j][2] + dsk[2] * bflo(u.y), y3 = acc[j][3] + dsk[3] * bfhi(u.y);
                    v2u w; w.x = cvtpk(geluf_(y0), geluf_(y1)); w.y = cvtpk(geluf_(y2), geluf_(y3)); *(v2u*)(YG + row * MIXW + ch) = w; }
                if (s < 8) *(LAS bf16x8*)(F.lds + (cur ^ 1) * 8192 + (F.wave * 64 + F.lane) * 16) = nB;
                __syncthreads();
                cur ^= 1; nB = nC; nC = nD;
            }
        }
    }
}
__device__ __forceinline__ int s5_chain_sb(int d, int i) { return d == 0 ? (i < 16 ? 1024 + i : i - 16) : (i < 16 ? 1039 - i : 1023 - (i - 16)); }
__device__ __forceinline__ void sg_fast_item(Frame& F, int l, int chunk, int pass) {
    const bf16* PROJ = (const bf16*)(F.ws + WS_PROJ); bf16* YB = (bf16*)(F.ws + WS_YS) + (size_t)MT * MIXW; const bf16* WSG = (const bf16*)(F.ws + WS_WSG);
    const float* lg = IN_(I_SGG) + l * MIXW; const float* lb = IN_(I_SGB) + l * MIXW; const float* bsg = IN_(I_BSG) + l * 512;
    LAS float* st = (LAS float*)(F.lds + 131072 + 2048); LAS unsigned char* WL = F.lds + 65536;
    __syncthreads();
    v4u wst[8];
#pragma unroll
    for (int i = 0; i < 8; ++i) { const int pid = F.tid + NT * i, ln = pid & 63, rest = pid >> 6, ks = rest & 3, cb = (rest >> 2) & 7, gl = rest >> 5;
        wst[i] = *(const v4u*)(WSG + ((size_t)(pass * 2 + gl) * 128 + cb * 16 + (ln & 15)) * 128 + 32 * ks + 8 * (ln >> 4)); }
    {
        const int p = F.tid >> 2, part = F.tid & 3; const bf16* vr = PROJ + (size_t)(chunk * 128 + p) * INW + 1024 + part * 128; float s = 0.f, q = 0.f;
#pragma unroll 4
        for (int c = 0; c < 128; c += 8) { const v4u w = *(const v4u*)(vr + c); const float x[8] = {bflo(w.x), bfhi(w.x), bflo(w.y), bfhi(w.y), bflo(w.z), bfhi(w.z), bflo(w.w), bfhi(w.w)};
#pragma unroll
            for (int i = 0; i < 8; ++i) { s += x[i]; q += x[i] * x[i]; } }
        s += shflx(s, 1, F.lane); q += shflx(q, 1, F.lane); s += shflx(s, 2, F.lane); q += shflx(q, 2, F.lane);
        const float mu = s * (1.f / 512.f), var = fmaxf(q * (1.f / 512.f) - mu * mu, 0.f);
        if (part == 0) { st[p * 2] = mu; st[p * 2 + 1] = rsqrtf(var + EPS); }
    }
#pragma unroll
    for (int i = 0; i < 8; ++i) *(LAS v4u*)(WL + (F.tid + NT * i) * 16) = wst[i];
    __syncthreads();
    const int l15 = F.lane & 15, lq = F.lane >> 4;
#pragma unroll 1
    for (int it = F.tid; it < 2048; it += NT) { const int tp = it & 63, cg = it >> 6; const int p0 = tp * 2, ch = pass * 256 + cg * 8;
        const v4u w0 = *(const v4u*)(PROJ + (size_t)(chunk * 128 + p0) * INW + 1024 + ch), w1 = *(const v4u*)(PROJ + (size_t)(chunk * 128 + p0 + 1) * INW + 1024 + ch);
        const float mu0 = st[p0 * 2], rs0 = st[p0 * 2 + 1], mu1 = st[p0 * 2 + 2], rs1 = st[p0 * 2 + 3];
        const float x0[8] = {bflo(w0.x), bfhi(w0.x), bflo(w0.y), bfhi(w0.y), bflo(w0.z), bfhi(w0.z), bflo(w0.w), bfhi(w0.w)};
        const float x1[8] = {bflo(w1.x), bfhi(w1.x), bflo(w1.y), bfhi(w1.y), bflo(w1.z), bfhi(w1.z), bflo(w1.w), bfhi(w1.w)};
#pragma unroll
        for (int i = 0; i < 8; ++i) { const float gm = lg[ch + i], bt = lb[ch + i]; const int c = cg * 8 + i;
            *(LAS unsigned*)(F.lds + c * 256 + (((p0 >> 3) ^ (c & 15)) << 4) + (p0 & 7) * 2) = pk2((x0[i] - mu0) * rs0 * gm + bt, (x1[i] - mu1) * rs1 * gm + bt); } }
    __syncthreads();
    const int ggl = F.wave >> 2, gg = pass * 2 + ggl, rb0 = (F.wave & 3) * 2;
    bf16x8 A[2][4];
#pragma unroll
    for (int j = 0; j < 2; ++j)
#pragma unroll
        for (int ks = 0; ks < 4; ++ks) { const int c = ggl * 128 + (rb0 + j) * 16 + l15; A[j][ks] = *(const LAS bf16x8*)(F.lds + c * 256 + (((4 * ks + lq) ^ (c & 15)) << 4)); }
    f32x4 acc[2][8];
#pragma unroll
    for (int j = 0; j < 2; ++j)
#pragma unroll
        for (int cb = 0; cb < 8; ++cb) acc[j][cb] = (f32x4){0.f, 0.f, 0.f, 0.f};
#pragma unroll
    for (int cb = 0; cb < 8; ++cb)
#pragma unroll
        for (int ks = 0; ks < 4; ++ks) { const bf16x8 B = *(const LAS bf16x8*)(WL + ((((ggl * 8 + cb) * 4 + ks) * 64) + F.lane) * 16);
#pragma unroll
            for (int j = 0; j < 2; ++j) acc[j][cb] = __builtin_amdgcn_mfma_f32_16x16x32_bf16(A[j][ks], B, acc[j][cb], 0, 0, 0); }
    v2u guv[8][2];
#pragma unroll
    for (int cb = 0; cb < 8; ++cb)
#pragma unroll
        for (int j = 0; j < 2; ++j) guv[cb][j] = *(const v2u*)(PROJ + ((size_t)chunk * 128 + cb * 16 + l15) * INW + 512 + gg * 128 + (rb0 + j) * 16 + 4 * lq);
    asm volatile("" ::: "memory");
#pragma unroll
    for (int cb = 0; cb < 8; ++cb) { const int q = cb * 16 + l15; const size_t row = (size_t)chunk * 128 + q; const float bq = bsg[gg * 128 + q];
#pragma unroll
        for (int j = 0; j < 2; ++j) { const int col = gg * 128 + (rb0 + j) * 16 + 4 * lq; const v2u gu = guv[cb][j];
            v2u w; w.x = cvtpk(bflo(gu.x) * (acc[j][cb][0] + bq), bfhi(gu.x) * (acc[j][cb][1] + bq)); w.y = cvtpk(bflo(gu.y) * (acc[j][cb][2] + bq), bfhi(gu.y) * (acc[j][cb][3] + bq));
            *(v2u*)(YB + row * MIXW + col) = w; } }
}

__device__ __forceinline__ bf16x8 sum3_bf16x8(const bf16* p, size_t stride) {
    const v4u a = *(const v4u*)p, b = *(const v4u*)(p + stride), c = *(const v4u*)(p + 2 * stride); v4u o;
    o.x = pk2(bflo(a.x) + bflo(b.x) + bflo(c.x), bfhi(a.x) + bfhi(b.x) + bfhi(c.x)); o.y = pk2(bflo(a.y) + bflo(b.y) + bflo(c.y), bfhi(a.y) + bfhi(b.y) + bfhi(c.y));
    o.z = pk2(bflo(a.z) + bflo(b.z) + bflo(c.z), bfhi(a.z) + bfhi(b.z) + bfhi(c.z)); o.w = pk2(bflo(a.w) + bflo(b.w) + bflo(c.w), bfhi(a.w) + bfhi(b.w) + bfhi(c.w));
    return __builtin_bit_cast(bf16x8, o);
}
template <int RB, int CB, bool SUM3, class EF>
__device__ __forceinline__ void thin_block(const bf16* A, int lda, size_t astride, const bf16* Bt, int K, int row0, int col0, int wave, int lane, LAS unsigned char* lds, const EF& ef) {
    constexpr int NTL = RB * CB; const int r = lane & 15, q = lane >> 4;
    if constexpr (NTL >= 8) {
        constexpr int TPW = NTL / 8, WPR = CB / TPW;
        const int rb = wave / WPR, cb0 = (wave % WPR) * TPW;
        const bf16* a = A + (size_t)(row0 + 16 * rb + r) * lda + 8 * q; const bf16* b = Bt + (size_t)(col0 + 16 * cb0 + r) * K + 8 * q;
        f32x4 acc[TPW];
#pragma unroll
        for (int c = 0; c < TPW; ++c) acc[c] = (f32x4){0.f, 0.f, 0.f, 0.f};
        bf16x8 xa[8], wa[TPW][8], xb[8], wb[TPW][8];
#define THIN_LD(x, w, kk) do { _Pragma("unroll") for (int j = 0; j < 8; ++j) { x[j] = SUM3 ? sum3_bf16x8(a + 32 * ((kk) + j), astride) : *(const bf16x8*)(a + 32 * ((kk) + j)); \
            _Pragma("unroll") for (int c = 0; c < TPW; ++c) w[c][j] = *(const bf16x8*)(b + (size_t)(16 * c) * K + 32 * ((kk) + j)); } } while (0)
#define THIN_MM(x, w) do { _Pragma("unroll") for (int j = 0; j < 8; ++j) _Pragma("unroll") for (int c = 0; c < TPW; ++c) acc[c] = __builtin_amdgcn_mfma_f32_16x16x32_bf16(x[j], w[c][j], acc[c], 0, 0, 0); } while (0)
        THIN_LD(xa, wa, 0);
#pragma unroll 1
        for (int k0 = 0; k0 < K / 32; k0 += 16) {
            THIN_LD(xb, wb, k0 + 8); __builtin_amdgcn_sched_barrier(0); THIN_MM(xa, wa); __builtin_amdgcn_sched_barrier(0);
            if (k0 + 16 < K / 32) THIN_LD(xa, wa, k0 + 16);
            __builtin_amdgcn_sched_barrier(0); THIN_MM(xb, wb); __builtin_amdgcn_sched_barrier(0);
        }
#undef THIN_LD
#undef THIN_MM
#pragma unroll
        for (int c = 0; c < TPW; ++c)
#pragma unroll
            for (int i = 0; i < 4; ++i) ef(row0 + 16 * rb + 4 * q + i, col0 + 16 * (cb0 + c) + r, acc[c][i]);
    } else {
        constexpr int KS = 8 / NTL;
        const int t = wave % NTL, kp = wave / NTL, rb = t / CB, cb = t % CB; const int kw = K / KS;
        const bf16* a = A + (size_t)(row0 + 16 * rb + r) * lda + kp * kw + 8 * q; const bf16* b = Bt + (size_t)(col0 + 16 * cb + r) * K + kp * kw + 8 * q;
        f32x4 acc = {0.f, 0.f, 0.f, 0.f};
        bf16x8 xa[4], wa[4], xb[4], wb[4];
#define THIN_LD(x, w, kk) do { _Pragma("unroll") for (int j = 0; j < 4; ++j) { x[j] = SUM3 ? sum3_bf16x8(a + 32 * ((kk) + j), astride) : *(const bf16x8*)(a + 32 * ((kk) + j)); w[j] = *(const bf16x8*)(b + 32 * ((kk) + j)); } } while (0)
#define THIN_MM(x, w) do { _Pragma("unroll") for (int j = 0; j < 4; ++j) acc = __builtin_amdgcn_mfma_f32_16x16x32_bf16(x[j], w[j], acc, 0, 0, 0); } while (0)
        THIN_LD(xa, wa, 0);
#pragma unroll 1
        for (int k0 = 0; k0 < kw / 32; k0 += 8) {
            THIN_LD(xb, wb, k0 + 4); __builtin_amdgcn_sched_barrier(0); THIN_MM(xa, wa); __builtin_amdgcn_sched_barrier(0);
            if (k0 + 8 < kw / 32) THIN_LD(xa, wa, k0 + 8);
            __builtin_amdgcn_sched_barrier(0); THIN_MM(xb, wb); __builtin_amdgcn_sched_barrier(0);
        }
#undef THIN_LD
#undef THIN_MM
        __syncthreads();
        *(LAS f32x4*)(lds + (wave * 64 + lane) * 16) = acc;
        __syncthreads();
        if (kp == 0) { f32x4 s = acc;
#pragma unroll
            for (int p = 1; p < KS; ++p) s = s + *(const LAS f32x4*)(lds + ((p * NTL + t) * 64 + lane) * 16);
#pragma unroll
            for (int i = 0; i < 4; ++i) ef(row0 + 16 * rb + 4 * q + i, col0 + 16 * cb + r, s[i]); }
    }
}
template <bool SUM3, class EF>
__device__ __forceinline__ void thin_lds(const bf16* A, int lda, size_t astride, const bf16* Bt, int K, int row0, int col0, int tid, int wave, int lane, LAS unsigned char* lds, const EF& ef) {
    const int r = lane & 15, q = lane >> 4, rb = wave >> 1, cb0 = (wave & 1) * 2;
    f32x4 acc[2] = {{0.f, 0.f, 0.f, 0.f}, {0.f, 0.f, 0.f, 0.f}};
    v4u xs[8], wv[8];
    const int prow = tid >> 6, ppc = tid & 63;
#define TL_LD(c) do { _Pragma("unroll") for (int i = 0; i < 8; ++i) { const bf16* ap = A + (size_t)(row0 + prow + 8 * i) * lda + (c) * 512 + ppc * 8; \
        xs[i] = SUM3 ? __builtin_bit_cast(v4u, sum3_bf16x8(ap, astride)) : *(const v4u*)ap; wv[i] = *(const v4u*)(Bt + (size_t)(col0 + prow + 8 * i) * K + (c) * 512 + ppc * 8); } } while (0)
    const int nch = K / 512;
    TL_LD(0);
#pragma unroll 1
    for (int c = 0; c < nch; ++c) {
        __syncthreads();
#pragma unroll
        for (int i = 0; i < 8; ++i) { const int row = prow + 8 * i; const int o = row * 1024 + ((ppc ^ (row & 15)) << 4); *(LAS v4u*)(lds + o) = xs[i]; *(LAS v4u*)(lds + 65536 + o) = wv[i]; }
        __syncthreads();
        if (c + 1 < nch) TL_LD(c + 1);
        __builtin_amdgcn_sched_barrier(0);
#pragma unroll
        for (int ks = 0; ks < 16; ++ks) { const int po = ((4 * ks + q) ^ r) << 4;
            const bf16x8 x = *(const LAS bf16x8*)(lds + (16 * rb + r) * 1024 + po);
            const bf16x8 w0 = *(const LAS bf16x8*)(lds + 65536 + (16 * cb0 + r) * 1024 + po), w1 = *(const LAS bf16x8*)(lds + 65536 + (16 * (cb0 + 1) + r) * 1024 + po);
            acc[0] = __builtin_amdgcn_mfma_f32_16x16x32_bf16(x, w0, acc[0], 0, 0, 0); acc[1] = __builtin_amdgcn_mfma_f32_16x16x32_bf16(x, w1, acc[1], 0, 0, 0); }
    }
#undef TL_LD
#pragma unroll
    for (int c = 0; c < 2; ++c)
#pragma unroll
        for (int i = 0; i < 4; ++i) ef(row0 + 16 * rb + 4 * q + i, col0 + 16 * (cb0 + c) + r, acc[c][i]);
    __syncthreads();
}
struct CtxProj { bf16* P; __device__ __forceinline__ void operator()(int row, int col, float v) const { const float o = (col >= 512 && col < 1536) ? geluf_(v) : v; P[(size_t)row * INW + col] = (bf16)f2bf(o); } };
struct CtxGlu { const bf16* YG; bf16* YA; __device__ __forceinline__ void operator()(int row, int col, float v) const { YA[(size_t)row * MIXW + col] = (bf16)f2bf(bf2f(YG[(size_t)row * MIXW + col]) * sigmoidf_(v)); } };
struct CtxBr { bf16* BR; int kk; __device__ __forceinline__ void operator()(int row, int col, float v) const { BR[(size_t)row * INW + kk * 1024 + col] = (bf16)f2bf(v); } };
struct CtxMerge { const bf16* BR; bf16* PMK; const float* bm; int kk; __device__ __forceinline__ void operator()(int row, int col, float v) const {
    PMK[((size_t)kk * CTX + row) * D + col] = (bf16)f2bf(sigmoidf_(v + bm[kk * 1024 + col]) * bf2f(BR[(size_t)row * INW + kk * 1024 + col])); } };
struct CtxWo { const float* xs; float* XC; const float* ga; __device__ __forceinline__ void operator()(int row, int col, float v) const { XC[(size_t)row * D + col] = xs[(size_t)row * D + col] + ga[col] * v; } };
__device__ __forceinline__ void ph2_ctx(Frame& F, int ncols) {
    const bf16* Hc = (const bf16*)HBUF(F) + (size_t)SEQ * D; const bf16* W = (const bf16*)(F.ws + WS_WIN); CtxProj ef{(bf16*)(F.ws + WS_PROJ) + (size_t)SEQ * INW};
    if (ncols == INW) { for (int it = F.bid; it < 4 * (INW / 64); it += F.G) thin_lds<false>(Hc, D, 0, W, D, (it & 3) * 64, (it >> 2) * 64, F.tid, F.wave, F.lane, F.lds, ef); }
    else { for (int it = F.bid; it < 8 * (ncols / 16); it += F.G) thin_block<2, 1, false>(Hc, D, 0, W, D, (it & 7) * 32, (it >> 3) * 16, F.wave, F.lane, F.lds, ef); }
}
__device__ __forceinline__ void ph7_ctx(Frame& F) {
    for (int it = F.bid; it < 3 * 64; it += F.G) { const int kk = it / 64, j = it % 64; CtxBr ef{(bf16*)(F.ws + WS_PROJ) + (size_t)SEQ * INW, kk};
        thin_lds<false>((const bf16*)(F.ws + WS_YS) + ((size_t)kk * MT + SEQ) * MIXW, MIXW, 0, (const bf16*)(F.ws + WS_WBR) + (size_t)kk * 1024 * MIXW, MIXW, (j & 3) * 64, (j >> 2) * 64, F.tid, F.wave, F.lane, F.lds, ef); }
}
__device__ __forceinline__ void ph8_ctx(Frame& F, int l) {
    const bf16* Hc = (const bf16*)HBUF(F) + (size_t)SEQ * D;
    for (int it = F.bid; it < 3 * 64; it += F.G) { const int kk = it / 64, j = it % 64; CtxMerge ef{(const bf16*)(F.ws + WS_PROJ) + (size_t)SEQ * INW, (bf16*)(F.ws + WS_Z), IN_(I_BMG) + l * INW, kk};
        thin_lds<false>(Hc, D, 0, (const bf16*)(F.ws + WS_WMG) + (size_t)kk * 1024 * D, D, (j & 3) * 64, (j >> 2) * 64, F.tid, F.wave, F.lane, F.lds, ef); }
}
__device__ __forceinline__ void ph9_ctx(Frame& F, int l) {
    CtxWo ef{l == 0 ? IN_(I_CTX) : (const float*)(F.ws + WS_XC), (float*)(F.ws + WS_XC), (const float*)(F.ws + WS_MOD) + (size_t)(l * 2 + 1) * 6144 + 2048};
    for (int it = F.bid; it < 4 * 16; it += F.G) thin_lds<true>((const bf16*)(F.ws + WS_Z), D, (size_t)CTX * D, (const bf16*)(F.ws + WS_WO), D, (it & 3) * 64, (it >> 2) * 64, F.tid, F.wave, F.lane, F.lds, ef);
}
__device__ __forceinline__ void ctx_x1_fixup(Frame& F, int l, int row0) {
    const float* XC = (const float*)(F.ws + WS_XC); float* RSS = (float*)(F.ws + WS_RSS);
    const int rr = row0 + (F.tid >> 5), part = F.tid & 31; const float* xr = XC + (size_t)rr * D + part * 32; float s = 0.f;
#pragma unroll
    for (int c = 0; c < 32; c += 4) { const f32x4 v = *(const f32x4*)(xr + c); s += v.x * v.x + v.y * v.y + v.z * v.z + v.w * v.w; }
    s += shflx(s, 1, F.lane); s += shflx(s, 2, F.lane); s += shflx(s, 4, F.lane); s += shflx(s, 8, F.lane); s += shflx(s, 16, F.lane);
    if (part < 16) RSS[(size_t)(SEQ + rr) * 16 + part] = part == 0 ? s : 0.f;
    asm volatile("s_waitcnt vmcnt(0)" ::: "memory");
    __syncthreads();
}


__device__ __forceinline__ void ph0_prologue(Frame& F) {
    float* mod = (float*)(F.ws + WS_MOD);
    LAS float* SV = (LAS float*)(F.lds + 131072 + 4096);
    for (int i = F.tid; i < 2048; i += NT) SV[i] = siluf_(i < 1024 ? IN_(I_C)[i] : IN_(I_CCTX)[i - 1024]);
    __syncthreads();
    LAS float* RED = (LAS float*)(F.lds + 131072 + 4096 + 8192);
    for (int it = F.bid; it < 2 * 96; it += F.G) { const int l = it / 96, j = (it % 96) * 64 + F.lane;
        const float* W = IN_(I_WADA) + (size_t)l * D * 6144 + j + (size_t)(F.wave * 128) * 6144;
        float a0 = 0.f, a1 = 0.f;
#pragma unroll 32
        for (int kk = 0; kk < 128; ++kk) { const float w = W[(size_t)kk * 6144]; a0 += SV[F.wave * 128 + kk] * w; a1 += SV[1024 + F.wave * 128 + kk] * w; }
        __syncthreads();
        RED[(F.wave * 2 + 0) * 64 + F.lane] = a0; RED[(F.wave * 2 + 1) * 64 + F.lane] = a1;
        __syncthreads();
        if (F.wave < 2) { float s = 0.f;
#pragma unroll
            for (int w8 = 0; w8 < 8; ++w8) s += RED[(w8 * 2 + F.wave) * 64 + F.lane];
            const float mv = s + IN_(I_BADA)[l * 6144 + j]; mod[(size_t)(l * 2 + F.wave) * 6144 + j] = mv;
            if (l == 0 && j < 2048) __hip_atomic_store((unsigned long long*)(F.ws + WS_MG) + F.wave * 2048 + j, (1ull << 32) | __builtin_bit_cast(unsigned, mv), __ATOMIC_RELAXED, __HIP_MEMORY_SCOPE_AGENT); }
    }
}
__device__ __forceinline__ void stage_mod_granules(Frame& F, const float* g, LAS float* GC, LAS float* SH) {
    unsigned long long* MG = (unsigned long long*)(F.ws + WS_MG);
    __syncthreads();
    for (int i0 = F.tid; i0 < 2048; i0 += 4 * NT) { unsigned long long xs[4], xc[4]; unsigned spins = 0;
        for (;;) { bool ok = true;
#pragma unroll
            for (int q = 0; q < 4; ++q) { const int i = i0 + q * NT, w = i >> 10, c = i & 1023; xs[q] = __hip_atomic_load(MG + w * 2048 + c, __ATOMIC_RELAXED, __HIP_MEMORY_SCOPE_AGENT); xc[q] = __hip_atomic_load(MG + w * 2048 + 1024 + c, __ATOMIC_RELAXED, __HIP_MEMORY_SCOPE_AGENT); }
#pragma unroll
            for (int q = 0; q < 4; ++q) ok = ok && (unsigned)(xs[q] >> 32) == 1u && (unsigned)(xc[q] >> 32) == 1u;
            if (ok) break; __builtin_amdgcn_s_sleep(2); if (++spins > (1u << 22)) break; }
#pragma unroll
        for (int q = 0; q < 4; ++q) { const int i = i0 + q * NT, c = i & 1023; GC[i] = g[c] * (1.f + __builtin_bit_cast(float, (unsigned)xc[q])); SH[i] = __builtin_bit_cast(float, (unsigned)xs[q]); } }
    __syncthreads();
}
__device__ __forceinline__ void stage_mod(Frame& F, const float* g, int l, int sh_off, int sc_off, LAS float* GC, LAS float* SH) {
    __syncthreads();
    for (int i = F.tid; i < 2048; i += NT) { const int w = i >> 10, c = i & 1023; const float* m = (const float*)(F.ws + WS_MOD) + (size_t)(l * 2 + w) * 6144; GC[i] = g[c] * (1.f + m[sc_off + c]); SH[i] = m[sh_off + c]; }
    __syncthreads();
}
__device__ __forceinline__ void hprep_rows(Frame& F, int l) {
    bf16* H = (bf16*)HBUF(F); LAS float* GC = (LAS float*)F.lds; LAS float* SH = GC + 2048;
    stage_mod_granules(F, IN_(I_GMIX) + l * D, GC, SH);
    const int gw = F.bid * (NT / 64) + F.wave, ngw = F.G * (NT / 64);
    for (int row = gw; row < MT; row += ngw) {
        const float* xr = xin_row(F, row); const int pv = row >= SEQ ? 1024 : 0;
        f32x4 v[4]; float s = 0.f;
#pragma unroll
        for (int j = 0; j < 4; ++j) { v[j] = *(const f32x4*)(xr + 4 * F.lane + 256 * j); s += v[j].x * v[j].x + v[j].y * v[j].y + v[j].z * v[j].z + v[j].w * v[j].w; }
        const float rstd = rsqrtf(wave_sum(s, F.lane) * (1.f / D) + EPS);
#pragma unroll
        for (int j = 0; j < 4; ++j) { const int c = 4 * F.lane + 256 * j; const f32x4 gc = *(const LAS f32x4*)(GC + pv + c), sh = *(const LAS f32x4*)(SH + pv + c);
            const f32x4 o = v[j] * rstd * gc + sh; v2u w; w.x = pk2(o.x, o.y); w.y = pk2(o.z, o.w); *(v2u*)(H + (size_t)row * D + c) = w; }
    }
}
__device__ __forceinline__ void ph3_conv(Frame& F, int l, int nrows) {
    const bf16* PROJ = (const bf16*)(F.ws + WS_PROJ); bf16* YC = (bf16*)(F.ws + WS_YS) + (size_t)2 * MT * MIXW; const float* wc = IN_(I_WCONV) + l * 3 * MIXW;
    const size_t gt = (size_t)F.bid * NT + F.tid, ngt = (size_t)F.G * NT;
#pragma unroll 2
    for (size_t i = gt; i < (size_t)nrows * (MIXW / 8); i += ngt) {
        const int row = (int)(i / (MIXW / 8)), c = (int)(i % (MIXW / 8)) * 8;
        int pos, rl; if (row < SEQ) { pos = row & 63; rl = 64; } else { pos = row - SEQ; rl = 256; }
        const bf16* r0 = PROJ + (size_t)row * INW + 1536 + c;
        const v4u zero = {0u, 0u, 0u, 0u};
        const v4u b0 = *(const v4u*)(r0), c0 = *(const v4u*)(r0 + 512), h0 = *(const v4u*)(r0 + 1024);
        const v4u cm = pos > 0 ? *(const v4u*)(r0 - INW + 512) : zero, hm = pos > 0 ? *(const v4u*)(r0 - INW + 1024) : zero;
        const v4u cp = pos < rl - 1 ? *(const v4u*)(r0 + INW + 512) : zero, hp = pos < rl - 1 ? *(const v4u*)(r0 + INW + 1024) : zero;
        const f32x4 w0a = *(const f32x4*)(wc + c), w0b = *(const f32x4*)(wc + c + 4), w1a = *(const f32x4*)(wc + 512 + c), w1b = *(const f32x4*)(wc + 512 + c + 4), w2a = *(const f32x4*)(wc + 1024 + c), w2b = *(const f32x4*)(wc + 1024 + c + 4);
        const float w0[8] = {w0a.x, w0a.y, w0a.z, w0a.w, w0b.x, w0b.y, w0b.z, w0b.w}, w1[8] = {w1a.x, w1a.y, w1a.z, w1a.w, w1b.x, w1b.y, w1b.z, w1b.w}, w2[8] = {w2a.x, w2a.y, w2a.z, w2a.w, w2b.x, w2b.y, w2b.z, w2b.w};
        const unsigned bb[4] = {b0.x, b0.y, b0.z, b0.w}, cc[4] = {c0.x, c0.y, c0.z, c0.w}, hh[4] = {h0.x, h0.y, h0.z, h0.w}, cmv[4] = {cm.x, cm.y, cm.z, cm.w}, hmv[4] = {hm.x, hm.y, hm.z, hm.w}, cpv[4] = {cp.x, cp.y, cp.z, cp.w}, hpv[4] = {hp.x, hp.y, hp.z, hp.w};
        unsigned o[4];
#pragma unroll
        for (int j = 0; j < 4; ++j) {
            const float ylo = bflo(bb[j]) * (w0[2 * j] * (bflo(cmv[j]) * bflo(hmv[j])) + w1[2 * j] * (bflo(cc[j]) * bflo(hh[j])) + w2[2 * j] * (bflo(cpv[j]) * bflo(hpv[j])));
            const float yhi = bfhi(bb[j]) * (w0[2 * j + 1] * (bfhi(cmv[j]) * bfhi(hmv[j])) + w1[2 * j + 1] * (bfhi(cc[j]) * bfhi(hh[j])) + w2[2 * j + 1] * (bfhi(cpv[j]) * bfhi(hpv[j])));
            o[j] = pk2(ylo, yhi); }
        v4u ov; ov.x = o[0]; ov.y = o[1]; ov.z = o[2]; ov.w = o[3]; *(v4u*)(YC + (size_t)row * MIXW + c) = ov;
    }
}
template <int KS, bool LDSW>
__device__ __forceinline__ void route_pass(Frame& F, int l, int u, bool valid, int kh, int sl, LAS float* GC, LAS float* SH, LAS float* SSQ, LAS float* LG, LAS int* HISTL) {
    bf16* H = (bf16*)HBUF(F); const bf16* WRh = (const bf16*)(F.ws + WS_WR); const bf16* WRl = WRh + 48 * 1024;
    const float* bg = IN_(I_BGRP) + l * 4; const float* be = IN_(I_BEXP) + l * 32;
    int* EID = (int*)(F.ws + WS_EID); float* EW = (float*)(F.ws + WS_EW);
    constexpr int NK = 32 / KS, KW = 1024 / KS;
    const int r = F.lane & 15, q = F.lane >> 4;
    const int uu = valid ? u : 0; const int row = uu * 16 + r; const int pv = (row >= SEQ ? 1024 : 0) + kh * KW + 8 * q;
    const float* xr = (const float*)(F.ws + WS_XC) + (size_t)(KS == 2 ? 0 : row - SEQ) * D + kh * KW + 8 * q;
    const bf16* xr16 = (const bf16*)(F.ws + WS_X16) + (size_t)(KS == 2 ? row : 0) * D + kh * KW + 8 * q;
    const f32x4 rp = *(const f32x4*)((const float*)(F.ws + WS_RSS) + (size_t)row * 16 + 4 * q);
    float tot = (rp.x + rp.y) + (rp.z + rp.w); tot += shflx(tot, 16, F.lane); tot += shflx(tot, 32, F.lane);
    const float rstd = rsqrtf(tot * (1.f / D) + EPS);
    __syncthreads();
    (void)SSQ;
    f32x4 acc[3] = {{0.f, 0.f, 0.f, 0.f}, {0.f, 0.f, 0.f, 0.f}, {0.f, 0.f, 0.f, 0.f}};
    LAS unsigned char* WB = F.lds + 45056;
    v4u stg[6];
    if constexpr (LDSW) {
#pragma unroll
        for (int i = 0; i < 6; ++i) { const int pid = F.tid + NT * i, ln = pid & 63, rest = pid >> 6, ks = rest & 3, cb = (rest >> 2) % 3, hl = (rest / 12) & 1, khh = rest / 24;
            stg[i] = *(const v4u*)((hl ? WRl : WRh) + (size_t)(cb * 16 + (ln & 15)) * 1024 + khh * 512 + 32 * ks + 8 * (ln >> 4)); }
    }
    v4u xall[KS == 2 ? 16 : 1];
    if constexpr (KS == 2) {
#pragma unroll
        for (int j = 0; j < 16; ++j) xall[j] = *(const v4u*)(xr16 + 32 * j); }
#pragma unroll
    for (int k0 = 0; k0 < NK; k0 += 4) {
        f32x4 xa[4][2]; bf16x8 Bh[4][3], Bl[4][3];
        if constexpr (LDSW) {
            __syncthreads();
#pragma unroll
            for (int i = 0; i < 6; ++i) *(LAS v4u*)(WB + (F.tid + NT * i) * 16) = stg[i];
            __syncthreads();
            if (k0 + 4 < NK) {
#pragma unroll
                for (int i = 0; i < 6; ++i) { const int pid = F.tid + NT * i, ln = pid & 63, rest = pid >> 6, ks = rest & 3, cb = (rest >> 2) % 3, hl = (rest / 12) & 1, khh = rest / 24;
                    stg[i] = *(const v4u*)((hl ? WRl : WRh) + (size_t)(cb * 16 + (ln & 15)) * 1024 + khh * 512 + 32 * (k0 + 4 + ks) + 8 * (ln >> 4)); } }
        }
#pragma unroll
        for (int j = 0; j < 4; ++j) { const int c = 32 * (k0 + j);
            if constexpr (KS == 2) { xa[j][0] = __builtin_bit_cast(f32x4, xall[k0 + j]); } else { xa[j][0] = *(const f32x4*)(xr + c); xa[j][1] = *(const f32x4*)(xr + c + 4); }
#pragma unroll
            for (int cb = 0; cb < 3; ++cb) {
                if constexpr (!LDSW) { const size_t wo = (size_t)(cb * 16 + r) * 1024 + kh * KW + c + 8 * q; Bh[j][cb] = *(const bf16x8*)(WRh + wo); Bl[j][cb] = *(const bf16x8*)(WRl + wo); } } }
#pragma unroll
        for (int j = 0; j < 4; ++j) { const int c = 32 * (k0 + j);
            const f32x4 g0 = *(const LAS f32x4*)(GC + pv + c), g1 = *(const LAS f32x4*)(GC + pv + c + 4), sh0 = *(const LAS f32x4*)(SH + pv + c), sh1 = *(const LAS f32x4*)(SH + pv + c + 4);
            if constexpr (KS == 2) { const v4u w = __builtin_bit_cast(v4u, xa[j][0]); xa[j][0] = (f32x4){bflo(w.x), bfhi(w.x), bflo(w.y), bfhi(w.y)}; xa[j][1] = (f32x4){bflo(w.z), bfhi(w.z), bflo(w.w), bfhi(w.w)}; }
            const f32x4 h0 = xa[j][0] * rstd * g0 + sh0, h1 = xa[j][1] * rstd * g1 + sh1;
            v4u hi; hi.x = pk2(h0.x, h0.y); hi.y = pk2(h0.z, h0.w); hi.z = pk2(h1.x, h1.y); hi.w = pk2(h1.z, h1.w);
            if (valid) *(v4u*)(H + (size_t)row * D + kh * KW + 8 * q + c) = hi;
            v4u lo; lo.x = pk2(h0.x - bflo(hi.x), h0.y - bfhi(hi.x)); lo.y = pk2(h0.z - bflo(hi.y), h0.w - bfhi(hi.y)); lo.z = pk2(h1.x - bflo(hi.z), h1.y - bfhi(hi.z)); lo.w = pk2(h1.z - bflo(hi.w), h1.w - bfhi(hi.w));
            const bf16x8 Ah = __builtin_bit_cast(bf16x8, hi), Al = __builtin_bit_cast(bf16x8, lo);
#pragma unroll
            for (int cb = 0; cb < 3; ++cb) {
                bf16x8 bh, bl;
                if constexpr (LDSW) { bh = *(const LAS bf16x8*)(WB + ((kh * 24 + cb * 4 + j) * 64 + F.lane) * 16); bl = *(const LAS bf16x8*)(WB + ((kh * 24 + 12 + cb * 4 + j) * 64 + F.lane) * 16); }
                else { bh = Bh[j][cb]; bl = Bl[j][cb]; }
                acc[cb] = __builtin_amdgcn_mfma_f32_16x16x32_bf16(Ah, bh, acc[cb], 0, 0, 0); acc[cb] = __builtin_amdgcn_mfma_f32_16x16x32_bf16(Al, bh, acc[cb], 0, 0, 0); acc[cb] = __builtin_amdgcn_mfma_f32_16x16x32_bf16(Ah, bl, acc[cb], 0, 0, 0); } }
    }
    LAS float* LGw = LG + (sl * KS + kh) * (16 * 52);
#pragma unroll
    for (int cb = 0; cb < 3; ++cb)
#pragma unroll
        for (int i = 0; i < 4; ++i) LGw[(4 * q + i) * 52 + cb * 16 + r] = acc[cb][i];
    __syncthreads();
    if (kh == 0 && valid && F.lane < 16) { const LAS float* L0 = LG + (sl * KS) * (16 * 52) + F.lane * 52; const int rw = u * 16 + F.lane;
        float lg[36];
#pragma unroll
        for (int o = 0; o < 36; ++o) { float t = 0.f;
#pragma unroll
            for (int i = 0; i < KS; ++i) t += L0[i * (16 * 52) + o]; lg[o] = t + (o < 4 ? bg[o] : be[o - 4]); }
        LAS float* LW = LG + (sl * KS) * (16 * 52) + F.lane * 52;
#pragma unroll
        for (int o = 0; o < 36; ++o) LW[o] = lg[o];
        int gi = 0; float gm = lg[0];
#pragma unroll
        for (int o = 1; o < 4; ++o) if (lg[o] > gm) { gm = lg[o]; gi = o; }
        float den = 0.f;
#pragma unroll
        for (int o = 0; o < 4; ++o) den += expf(lg[o] - gm);
        const float gp = 1.f / den;
        const LAS float* el = LW + 4 + gi * 8;
        int i1 = 0; float m1 = el[0]; for (int o = 1; o < 8; ++o) { const float v = el[o]; if (v > m1) { m1 = v; i1 = o; } }
        int i2 = -1; float m2 = 0.f; for (int o = 0; o < 8; ++o) { const float v = el[o]; if (o != i1 && (i2 < 0 || v > m2)) { m2 = v; i2 = o; } }
        const float e2 = expf(m2 - m1); const float w1 = 1.f / (1.f + e2), w2 = e2 / (1.f + e2);
        const int e1i = gi * 8 + i1, e2i = gi * 8 + i2;
        EID[rw * 2] = e1i; EID[rw * 2 + 1] = e2i; EW[rw * 2] = gp * w1; EW[rw * 2 + 1] = gp * w2;
        __hip_atomic_fetch_add(&HISTL[e1i], 1, __ATOMIC_RELAXED, __HIP_MEMORY_SCOPE_WORKGROUP); __hip_atomic_fetch_add(&HISTL[e2i], 1, __ATOMIC_RELAXED, __HIP_MEMORY_SCOPE_WORKGROUP);
    }
}
__device__ __forceinline__ void ph10_route(Frame& F, int l) {
    const float* g = IN_(I_GFFN) + l * D;
    LAS float* GC = (LAS float*)F.lds;
    LAS float* SH = GC + 2048;
    LAS float* SSQ = SH + 2048;
    LAS float* LG = SSQ + 128;
    LAS int* HISTL = (LAS int*)(LG + 8 * 16 * 52);
    __syncthreads();
    if (F.tid < 32) HISTL[F.tid] = 0;
    for (int i = F.tid; i < 2048; i += NT) { const int w = i >> 10, c = i & 1023; const float* m = (const float*)(F.ws + WS_MOD) + (size_t)(l * 2 + w) * 6144; GC[i] = g[c] * (1.f + m[4096 + c]); SH[i] = m[3072 + c]; }
#pragma unroll 1
    for (int u0 = F.bid; u0 < SEQ / 16; u0 += 4 * F.G) { const int u = u0 + (F.wave >> 1) * F.G; route_pass<2, true>(F, l, u, u < SEQ / 16, F.wave & 1, F.wave >> 1, GC, SH, SSQ, LG, HISTL); }
    if (l == 0) {
#pragma unroll 1
        for (int u0 = SEQ / 16 + F.bid; u0 < MT / 16; u0 += F.G) { ctx_x1_fixup(F, l, (u0 - SEQ / 16) * 16); route_pass<8, false>(F, l, u0, true, F.wave, 0, GC, SH, SSQ, LG, HISTL); }
    }
    __syncthreads();
    if (F.tid < 32) __hip_atomic_store((unsigned long long*)(F.ws + WS_HG) + F.bid * 32 + F.tid, ((unsigned long long)((unsigned)l + 1u) << 32) | (unsigned)HISTL[F.tid], __ATOMIC_RELAXED, __HIP_MEMORY_SCOPE_AGENT);
}
__device__ __forceinline__ void ph11_scatter(Frame& F, int l) {
    const bf16* H = (const bf16*)HBUF(F); bf16* HS = (bf16*)(F.ws + WS_HS);
    const int* EID = (const int*)(F.ws + WS_EID); const float* EW = (const float*)(F.ws + WS_EW); int* STOK = (int*)(F.ws + WS_STOK); float* SW = (float*)(F.ws + WS_SW); int* TSLOT = (int*)(F.ws + WS_TSLOT);
    unsigned* cnt = F.ctl + CW_CNT + l * 128; unsigned long long* HG = (unsigned long long*)(F.ws + WS_HG); const unsigned tag = (unsigned)l + 1u;
    LAS int* HIST = (LAS int*)F.lds; LAS int* BASE = HIST + 32; LAS int* ISLOT = BASE + 32; LAS int* IROW = ISLOT + 512; LAS int* PT = IROW + 512; LAS int* PB = PT + 512;
    const int nunits = (l == 0 ? MT : SEQ) / 16;
    __syncthreads();
    { const int e = F.tid & 31, ch = F.tid >> 5; int tot = 0, bas = 0;
      for (int b0 = ch; b0 < F.G; b0 += 256) {
          unsigned long long xs[16]; unsigned spins = 0;
          for (;;) { bool ok = true;
#pragma unroll
              for (int i = 0; i < 16; ++i) { const int b = b0 + 16 * i; xs[i] = b < F.G ? __hip_atomic_load(HG + b * 32 + e, __ATOMIC_RELAXED, __HIP_MEMORY_SCOPE_AGENT) : ((unsigned long long)tag << 32); }
#pragma unroll
              for (int i = 0; i < 16; ++i) ok = ok && (unsigned)(xs[i] >> 32) == tag;
              if (ok) break; __builtin_amdgcn_s_sleep(2); if (++spins > (1u << 22)) break; }
#pragma unroll
          for (int i = 0; i < 16; ++i) { const int b = b0 + 16 * i; const int h = (int)(unsigned)xs[i]; tot += h; if (b < F.bid) bas += h; } }
      PT[F.tid] = tot; PB[F.tid] = bas; }
    __syncthreads();
    if (F.tid < 32) { int tot = 0, bas = 0; for (int ch = 0; ch < 16; ++ch) { tot += PT[ch * 32 + F.tid]; bas += PB[ch * 32 + F.tid]; } HIST[F.tid] = 0; PT[F.tid] = tot; PB[F.tid] = bas; if (F.bid == 0) cnt[F.tid] = (unsigned)tot; }
    __syncthreads();
    if (F.tid < 32) { int off = 0; for (int i = 0; i < F.tid; ++i) off += (PT[i] + 255) & ~255; BASE[F.tid] = off + PB[F.tid]; }
    __syncthreads();
    const int w = F.tid >> 5; int u = F.bid + w * F.G; bool valid = u < SEQ / 16;
    if (w == 15) { u = SEQ / 16 + F.bid; valid = u < nunits; }
    const int row = u * 16 + ((F.tid >> 1) & 15), kk = F.tid & 1;
    int e = 0, rank = 0; if (valid) { e = EID[row * 2 + kk]; rank = __hip_atomic_fetch_add(&HIST[e], 1, __ATOMIC_RELAXED, __HIP_MEMORY_SCOPE_WORKGROUP); }
    __syncthreads();
    int slot = -1; if (valid) { slot = BASE[e] + rank; STOK[slot] = row; SW[slot] = EW[row * 2 + kk]; TSLOT[row * 2 + kk] = slot; }
    (void)H; (void)HS; (void)ISLOT; (void)IROW;
    for (int e = F.bid; e < NE; e += F.G) { const int start = BASE[e] - PB[e], n = PT[e], seg = (n + 255) & ~255; for (int i = n + F.tid; i < seg; i += NT) STOK[start + i] = 0; }
}
template <bool CX>
__device__ __forceinline__ void combine_rows(Frame& F, int l, const LAS float* GC, const LAS float* SH, const LAS float* GA) {
    const bf16* YS2 = (const bf16*)(F.ws + WS_YS2); const int* TSLOT = (const int*)(F.ws + WS_TSLOT) + (CX ? 2 * SEQ : 0); bf16* H = (bf16*)HBUF(F) + (CX ? (size_t)SEQ * D : 0);
    bf16* X16 = (bf16*)(F.ws + WS_X16); float* XC = (float*)(F.ws + WS_XC); float* out = F.out;
    const int gw = F.bid * (NT / 64) + F.wave, ngw = F.G * (NT / 64);
    constexpr int nrows = CX ? CTX : SEQ, pv = CX ? 1024 : 0;
    for (int row0 = gw; row0 < nrows; row0 += 2 * ngw) {
        int rows[2]; bool ok[2];
#pragma unroll
        for (int t = 0; t < 2; ++t) { rows[t] = row0 + t * ngw; ok[t] = rows[t] < nrows; if (!ok[t]) rows[t] = row0; }
        int sl[2][2];
#pragma unroll
        for (int t = 0; t < 2; ++t) { sl[t][0] = TSLOT[rows[t] * 2]; sl[t][1] = TSLOT[rows[t] * 2 + 1]; }
        v4u ya[2][2], yb[2][2], xb[2][2]; f32x4 xf[2][2][2];
#pragma unroll
        for (int t = 0; t < 2; ++t)
#pragma unroll
            for (int j = 0; j < 2; ++j) { const int c = 8 * F.lane + 512 * j;
                if constexpr (CX) { xf[t][j][0] = *(const f32x4*)(XC + (size_t)rows[t] * D + c); xf[t][j][1] = *(const f32x4*)(XC + (size_t)rows[t] * D + c + 4); }
                else xb[t][j] = *(const v4u*)(X16 + (size_t)rows[t] * D + c);
                ya[t][j] = *(const v4u*)(YS2 + (size_t)sl[t][0] * D + c); yb[t][j] = *(const v4u*)(YS2 + (size_t)sl[t][1] * D + c); }
        f32x4 v[2][2][2]; float s[2] = {0.f, 0.f};
#pragma unroll
        for (int t = 0; t < 2; ++t)
#pragma unroll
            for (int j = 0; j < 2; ++j) { const int c = 8 * F.lane + 512 * j; const v4u a = ya[t][j], b = yb[t][j];
                if constexpr (!CX) { const v4u w = xb[t][j]; xf[t][j][0] = (f32x4){bflo(w.x), bfhi(w.x), bflo(w.y), bfhi(w.y)}; xf[t][j][1] = (f32x4){bflo(w.z), bfhi(w.z), bflo(w.w), bfhi(w.w)}; }
                const f32x4 y0 = {bflo(a.x) + bflo(b.x), bfhi(a.x) + bfhi(b.x), bflo(a.y) + bflo(b.y), bfhi(a.y) + bfhi(b.y)}, y1 = {bflo(a.z) + bflo(b.z), bfhi(a.z) + bfhi(b.z), bflo(a.w) + bflo(b.w), bfhi(a.w) + bfhi(b.w)};
                const f32x4 o0 = xf[t][j][0] + *(const LAS f32x4*)(GA + pv + c) * y0, o1 = xf[t][j][1] + *(const LAS f32x4*)(GA + pv + c + 4) * y1; v[t][j][0] = o0; v[t][j][1] = o1;
                s[t] += (o0.x * o0.x + o0.y * o0.y + o0.z * o0.z + o0.w * o0.w) + (o1.x * o1.x + o1.y * o1.y + o1.z * o1.z + o1.w * o1.w); }
#pragma unroll
        for (int t = 0; t < 2; ++t) { if (!ok[t]) continue;
            const float rstd = rsqrtf(wave_sum(s[t], F.lane) * (1.f / D) + EPS); const size_t ro = (size_t)rows[t] * D;
            if (l == 0) {
#pragma unroll
                for (int j = 0; j < 2; ++j) { const int c = 8 * F.lane + 512 * j; const f32x4 o0 = v[t][j][0], o1 = v[t][j][1];
                    if constexpr (CX) { *(f32x4*)(XC + ro + c) = o0; *(f32x4*)(XC + ro + c + 4) = o1; }
                    else { v4u w; w.x = pk2(o0.x, o0.y); w.y = pk2(o0.z, o0.w); w.z = pk2(o1.x, o1.y); w.w = pk2(o1.z, o1.w); *(v4u*)(X16 + ro + c) = w; }
                    const f32x4 h0 = o0 * rstd * *(const LAS f32x4*)(GC + pv + c) + *(const LAS f32x4*)(SH + pv + c), h1 = o1 * rstd * *(const LAS f32x4*)(GC + pv + c + 4) + *(const LAS f32x4*)(SH + pv + c + 4);
                    v4u hw; hw.x = pk2(h0.x, h0.y); hw.y = pk2(h0.z, h0.w); hw.z = pk2(h1.x, h1.y); hw.w = pk2(h1.z, h1.w); *(v4u*)(H + ro + c) = hw; }
            } else if constexpr (!CX) {
#pragma unroll
                for (int j = 0; j < 2; ++j) { const int c = 8 * F.lane + 512 * j; f32x4 o0 = v[t][j][0] * rstd * *(const LAS f32x4*)(GC + c), o1 = v[t][j][1] * rstd * *(const LAS f32x4*)(GC + c + 4);
                    if (PROBE_B >= 0 && rows[t] < 3906 && F.bid >= PROBE_LO && F.bid < PROBE_HI) { volatile LAS unsigned long long* TS = (volatile LAS unsigned long long*)(F.lds + TS_OFF); const float dd = 0.1f + 0.00001f * (float)(TS[PROBE_B1] - TS[PROBE_B]); o0 = o0 + dd; o1 = o1 + dd; }
                    if (PROBE_A == 98 && rows[t] == 0 && j == 0 && F.lane == 0) { const unsigned w = __hip_atomic_load(F.ctl + 100, __ATOMIC_RELAXED, __HIP_MEMORY_SCOPE_AGENT); o0.x += 1.f + 0.001f * (float)w; }
                    else if (PROBE_A == 99 && rows[t] == 0 && j == 0 && F.lane == 0) { const unsigned w = __hip_atomic_load(F.ctl + 100, __ATOMIC_RELAXED, __HIP_MEMORY_SCOPE_AGENT); o0.x += PROBE_AROW ? 1.f + 0.01f * (float)(w & 255u) : 1.f + 0.001f * (float)(w >> 8); }
                    else if (PROBE_A >= 0 && rows[t] == PROBE_AROW && j == 0 && F.lane == 0) { volatile LAS unsigned long long* TS = (volatile LAS unsigned long long*)(F.lds + TS_OFF); o0.x += 1.f + 0.001f * (float)(TS[PROBE_A1] - TS[PROBE_A]); }
                    *(f32x4*)(out + ro + c) = o0; *(f32x4*)(out + ro + c + 4) = o1; }
            }
        }
    }
}
__device__ __forceinline__ void ph14_combine(Frame& F, int l) {
    LAS float* GC = (LAS float*)F.lds; LAS float* SH = GC + 2048; LAS float* GA = SH + 2048;
    if (l == 0) stage_mod(F, IN_(I_GMIX) + D, 1, 0, 1024, GC, SH); else { __syncthreads(); for (int i = F.tid; i < 1024; i += NT) GC[i] = IN_(I_GF)[i]; }
    for (int i = F.tid; i < 2048; i += NT) GA[i] = ((const float*)(F.ws + WS_MOD))[(size_t)(l * 2 + (i >> 10)) * 6144 + 5120 + (i & 1023)];
    __syncthreads();
    combine_rows<false>(F, l, GC, SH, GA);
    if (l == 0) combine_rows<true>(F, l, GC, SH, GA);
}

constexpr int NPH = 1 + 8 * 2;
__device__ __forceinline__ Frame make_frame(LAS unsigned char* lds, int wave0) {
    Frame F; F.lds = lds; F.wave = wave0; F.lane = (int)__builtin_amdgcn_mbcnt_hi(~0u, __builtin_amdgcn_mbcnt_lo(~0u, 0u)); asm volatile("" : "+v"(F.lane)); F.tid = F.wave * 64 + F.lane; F.bid = blockIdx.x; F.G = gridDim.x; asm volatile("" : "+s"(F.G), "+s"(F.bid));
    F.tab = (const unsigned long long LAS*)(lds + TAB_OFF);
    volatile LAS unsigned long long* t = (volatile LAS unsigned long long*)(lds + TAB_OFF);
    F.ws = (unsigned char*)(GAS unsigned char*)uni64(t[35]); F.out = (float*)(GAS float*)uni64(t[36]); F.ctl = (unsigned*)(F.ws + WS_CTL);
    return F;
}
__global__ void __launch_bounds__(NT, 2) mega_fwd(Args args) {
    extern __shared__ __attribute__((aligned(16))) unsigned char lds_raw[];
    LAS unsigned char* const lds = (LAS unsigned char*)lds_raw;
    const int wave0 = __builtin_amdgcn_readfirstlane((int)threadIdx.x >> 6);
    for (int u = threadIdx.x; u < 1024 / 4; u += NT) ((LAS unsigned*)(lds + 131072))[u] = 0u;
    if (threadIdx.x == 0) { LAS unsigned long long* t = (LAS unsigned long long*)(lds + TAB_OFF);
#pragma unroll
        for (int i = 0; i < 35; ++i) t[i] = (unsigned long long)args.in[i];
        t[35] = (unsigned long long)args.ws; t[36] = (unsigned long long)args.out; }
    __syncthreads();
    { Frame F = make_frame(lds, wave0); (void)xcd_barrier_post(F.ctl + CW_BAR, (volatile LAS unsigned*)(lds + MISC_OFF) + 8); }
    if ((PROBE_A >= 0 || PROBE_B >= 0) && threadIdx.x == 0) ((volatile LAS unsigned long long*)(lds + TS_OFF))[0] = __builtin_amdgcn_s_memrealtime();
    const int lo = args.ph_lo, hi = args.ph_hi; int ph = 0;
#define GRIDBAR() do { Frame Fb = make_frame(lds, wave0); XcdBarrier bar; bar.bar = Fb.ctl + CW_BAR; bar.x = xb_xcc_id(); bar.st = (volatile LAS unsigned*)(lds + MISC_OFF) + 8; xcd_barrier(bar, Fb.tid == 0); } while (0)
#ifndef REPBAR
#define REPBAR 0
#endif
#ifndef REPMASK
#define REPMASK 0
#endif
#define PHASE(...) do { if (lo <= ph && ph < hi) { const int _pl = ph < 1 ? ph : 1 + (ph - 1) % 8; for (int _rep = 0; _rep <= ((REPMASK >> _pl) & 1); ++_rep) { Frame F = make_frame(lds, wave0); __VA_ARGS__; } if ((PROBE_A >= 0 || PROBE_B >= 0) && threadIdx.x == 0) { volatile LAS unsigned long long* TS_ = (volatile LAS unsigned long long*)(lds + TS_OFF); TS_[32 + ph] = __builtin_amdgcn_s_memrealtime(); if (PROBE_A == 98 && ph == PROBE_PH) { Frame Fp = make_frame(lds, wave0); __hip_atomic_fetch_max(Fp.ctl + 100, (unsigned)(TS_[32 + ph] - TS_[ph]), __ATOMIC_RELAXED, __HIP_MEMORY_SCOPE_AGENT); } } if (ph + 1 < hi) { GRIDBAR(); if (REPBAR) GRIDBAR(); } if ((PROBE_A >= 0 || PROBE_B >= 0) && threadIdx.x == 0) ((volatile LAS unsigned long long*)(lds + TS_OFF))[1 + ph] = __builtin_amdgcn_s_memrealtime(); } ++ph; } while (0)
    PHASE({ ph0_prologue(F); s5_precompute(F); __syncthreads(); convert_weights(F, 0, 0, F.G > 128 ? F.G - 64 : F.G, 0, CONV_NITEMS, true); { const f32x4* s = (const f32x4*)IN_(I_CTX); f32x4* d = (f32x4*)(F.ws + WS_XC); for (int i = F.bid * NT + F.tid; i < CTX * D / 4; i += F.G * NT) d[i] = s[i]; }  hprep_rows(F, 0); });
#pragma unroll 1
    for (int l = 0; l < 2; ++l) {
        PHASE({ ph2_fast(F, l); ph2_ctx(F, l == 0 ? INW : MIXW); });
        PHASE({ s5_fused_phase(F, l); for (int it = F.bid; it < 2 * (SEQ / 128); it += F.G) sg_fast_item(F, l, (it & 7) + 8 * (it >> 4), (it >> 3) & 1);        ph3_conv(F, l, l == 0 ? MT : SEQ); });
        PHASE({ ph6_fast(F, l); if (l == 0 && F.bid >= F.G - 4) { const int it = F.bid - (F.G - 4); sg_fast_item(F, 0, SEQ / 128 + (it >> 1), it & 1); }
                if (l == 0 && F.G >= 200) convert_weights(F, 1, 130, F.G - 134, 0, CONV_IN, false); });
        PHASE({ ph7_fast(F, l); if (l == 0) ph7_ctx(F); ph8_fast(F, l); if (l == 0) ph8_ctx(F, l); });
        PHASE({ ph9_fast(F, l); if (l == 0) ph9_ctx(F, l); });
        PHASE({ ph10_route(F, l); ph11_scatter(F, l); });
        PHASE(ph12_moe(F, l));
        PHASE({ ph14_combine(F, l); if (l == 0) { __syncthreads(); convert_weights(F, 1, 0, F.G, F.G >= 200 ? CONV_IN : 0, CONV_NITEMS, true); } });
    }
#undef PHASE
}

extern "C" void kernel_launch(void* const* d_in, const int* in_sizes, int n_in, void* d_out, int out_size, void* d_ws, size_t ws_size, hipStream_t stream) {
    static int grid = 0;
    if (grid == 0) {
        int dev = 0, cus = 0, per_cu = 0;
        if (n_in != 35 || out_size != SEQ * D || ws_size < WS_END) { fprintf(stderr, "kernel_launch: unexpected shapes (n_in %d out %d ws %zu)\n", n_in, out_size, ws_size); grid = -1; return; }
        if (hipGetDevice(&dev) != hipSuccess || hipDeviceGetAttribute(&cus, hipDeviceAttributeMultiprocessorCount, dev) != hipSuccess) { grid = -1; return; }
        if (hipFuncSetAttribute((const void*)mega_fwd, hipFuncAttributeMaxDynamicSharedMemorySize, LDS_BYTES) != hipSuccess) { fprintf(stderr, "kernel_launch: hipFuncSetAttribute failed\n"); grid = -1; return; }
        if (hipOccupancyMaxActiveBlocksPerMultiprocessor(&per_cu, (const void*)mega_fwd, NT, LDS_BYTES) != hipSuccess || per_cu < 1) { fprintf(stderr, "kernel_launch: occupancy query says %d blocks per CU\n", per_cu); grid = -1; return; }
        grid = cus;
    }
    if (grid < 0) return;
    (void)hipMemsetAsync((char*)d_ws + WS_CTL, 0, CTL_ZERO_BYTES, stream);
    Args a{};
    for (int i = 0; i < 35; ++i) a.in[i] = (const float*)d_in[i];
    a.out = (float*)d_out; a.ws = (unsigned char*)d_ws; a.ph_lo = 0; a.ph_hi = NPH;
    void* kargs[] = {&a};
    hipError_t e = hipLaunchCooperativeKernel((const void*)mega_fwd, dim3(grid), dim3(NT), kargs, LDS_BYTES, stream);
    if (e != hipSuccess) fprintf(stderr, "kernel_launch: cooperative launch failed: %s (grid %d)\n", hipGetErrorString(e), grid);
}
```

```cpp
#include <hip/hip_runtime.h>
#include <stdint.h>
#include <cstdio>

#define GAS __attribute__((address_space(1)))
#define LAS __attribute__((address_space(3)))
typedef unsigned short bf16;
typedef unsigned v4u __attribute__((ext_vector_type(4)));
typedef unsigned v2u __attribute__((ext_vector_type(2)));
typedef float f32x4 __attribute__((ext_vector_type(4)));
typedef short bf16x8 __attribute__((ext_vector_type(8)));

constexpr int D = 1024, SEQ = 16384, CTX = 256, MT = SEQ + CTX;
constexpr int MIXW = 512, INW = 3072, G5 = 32, P5 = 64, H5 = 16;
constexpr int NE = 32, DFF = 256;
constexpr int MAXSLOT = 2 * MT + NE * 256;
constexpr float EPS = 1e-6f;
constexpr int NT = 512;

constexpr size_t MiB = 1u << 20;
constexpr size_t WS_CTL = 0, CTL_ZERO_BYTES = 1 * MiB;
constexpr size_t WS_MOD = 1 * MiB;
constexpr size_t WS_XC = 2 * MiB;
constexpr size_t WS_EID = 3 * MiB;
constexpr size_t WS_EW = WS_EID + (size_t)MT * 8;
constexpr size_t WS_STOK = WS_EW + (size_t)MT * 8;
constexpr size_t WS_SW = WS_STOK + (size_t)MAXSLOT * 4;
constexpr size_t WS_TSLOT = WS_SW + (size_t)MAXSLOT * 4;
constexpr size_t WS_HISTG = WS_TSLOT + (size_t)MT * 8;
constexpr size_t WS_H = 4 * MiB;
constexpr size_t WS_X16 = WS_H;
constexpr size_t WS_PROJ = WS_H + (size_t)MT * 2048;
constexpr size_t WS_YS = WS_PROJ + (size_t)MT * 6144;
constexpr size_t WS_YG = WS_YS + (size_t)3 * MT * 1024;
constexpr size_t WS_PM = WS_YG + (size_t)MT * 1024;
constexpr size_t WS_S5 = WS_PM + (size_t)MT * 2048;
constexpr size_t WS_Z = WS_S5;
constexpr size_t WS_RSS = WS_Z + (size_t)8 * MiB;
constexpr size_t WS_SS = WS_Z + (size_t)1040 * 32 * 256 * 4;
constexpr size_t WS_S5M = WS_SS + (size_t)1040 * 32 * 256 * 2;
constexpr size_t WS_A16 = WS_S5M + (size_t)2 * 32 * 3 * 65536 * 2;
constexpr size_t WS_W = WS_A16 + (size_t)2 * 32 * 2 * 64 * 2 * 4 > WS_S5 + (size_t)2 * MT * 512 * 4 ? WS_A16 + (size_t)2 * 32 * 2 * 64 * 2 * 4 : WS_S5 + (size_t)2 * MT * 512 * 4;
constexpr size_t WS_WIN = WS_W;
constexpr size_t WS_WMG = WS_WIN + (size_t)3072 * 1024 * 2;
constexpr size_t WS_WGLU = WS_WMG + (size_t)3072 * 1024 * 2;
constexpr size_t WS_WBR = WS_WGLU + (size_t)512 * 512 * 2;
constexpr size_t WS_WO = WS_WBR + (size_t)3 * 1024 * 512 * 2;
constexpr size_t WS_W13 = WS_WO + (size_t)1024 * 1024 * 2;
constexpr size_t WS_W2 = WS_W13 + (size_t)32 * 512 * 1024 * 2;
constexpr size_t WS_WSG = WS_W2 + (size_t)32 * 1024 * 256 * 2;
constexpr size_t WS_WR = WS_WSG + (size_t)4 * 128 * 128 * 2;
constexpr size_t WS_END = WS_WR + (size_t)2 * 48 * 1024 * 2;
static_assert(WS_END <= (size_t)377 * MiB, "workspace budget");
constexpr size_t WS_HS = WS_PROJ;
constexpr size_t WS_ACT = WS_YS;
constexpr size_t WS_YS2 = WS_YG;
static_assert(WS_HS + (size_t)MAXSLOT * 2048 <= WS_YS && WS_ACT + (size_t)MAXSLOT * 512 <= WS_YG && WS_YS2 + (size_t)MAXSLOT * 2048 <= WS_W, "moe overlays");
static_assert(WS_HISTG + (size_t)1024 * 32 * 4 <= WS_H, "ws map");
constexpr int CW_CNT = 64;
constexpr int CW_BAR = 4096;
constexpr size_t WS_HG = WS_CTL + 768 * 1024;
constexpr size_t WS_MG = WS_CTL + 64 * 1024;
constexpr size_t WS_GR = WS_CTL + 256 * 1024;
constexpr int CW_UPC = 8192;

#ifndef PROBE_A
#define PROBE_A -1
#endif
#ifndef PROBE_B
#define PROBE_B -1
#endif
#ifndef PROBE_A1
#define PROBE_A1 (PROBE_A + 1)
#endif
#ifndef PROBE_B1
#define PROBE_B1 (PROBE_B + 1)
#endif
#ifndef PROBE_AROW
#define PROBE_AROW 0
#endif
#ifndef PROBE_PH
#define PROBE_PH 0
#endif
#ifndef PROBE_LO
#define PROBE_LO 0
#endif
#ifndef PROBE_HI
#define PROBE_HI 100000
#endif
constexpr int TS_OFF = 131072 + 512;
constexpr int LDS_BYTES = 147456;
constexpr int MISC_OFF = 131072 + 320;
constexpr int TAB_OFF = 131072 + 1024;

__device__ __forceinline__ float bf2f(unsigned short b) { return __builtin_bit_cast(float, ((unsigned)b) << 16); }
__device__ __forceinline__ unsigned f2bf(float f) { unsigned u = __builtin_bit_cast(unsigned, f); return (u + 0x7fffu + ((u >> 16) & 1u)) >> 16; }
__device__ __forceinline__ unsigned pk2(float lo, float hi) { return f2bf(lo) | (f2bf(hi) << 16); }
__device__ __forceinline__ float sigmoidf_(float x) { return __builtin_amdgcn_rcpf(1.f + __expf(-x)); }
__device__ __forceinline__ float siluf_(float x) { return x * __builtin_amdgcn_rcpf(1.f + __expf(-x)); }
__device__ __forceinline__ float geluf_(float x) { const float u = 0.7978845608028654f * (x + 0.044715f * x * x * x); return x * __builtin_amdgcn_rcpf(1.f + __expf(-2.f * u)); }
__device__ __forceinline__ float shflx(float v, int mask, int lane) { return __builtin_bit_cast(float, __builtin_amdgcn_ds_bpermute((lane ^ mask) << 2, __builtin_bit_cast(int, v))); }
__device__ __forceinline__ float wave_sum(float v, int lane) {
#pragma unroll
    for (int o = 1; o < 64; o <<= 1) v += shflx(v, o, lane);
    return v;
}

#define XB_TMO      128
#define XB_XCNT(j)  (256  + 64 * (j))
#define XB_XSUB(j)  (1280 + 64 * (j))
#define XB_XGEN(j)  (2304 + 64 * (j))
#define XB_TOP      3328
#define XB_TOPGEN   3392
#define XCD_BAR_WORDS 3456
#define XB_SPIN_CAP (1u << 24)
__device__ __forceinline__ unsigned xb_ld(unsigned* p)              { return __hip_atomic_load(p, __ATOMIC_RELAXED, __HIP_MEMORY_SCOPE_AGENT); }
__device__ __forceinline__ unsigned xb_add(unsigned* p, unsigned v) { return __hip_atomic_fetch_add(p, v, __ATOMIC_RELAXED, __HIP_MEMORY_SCOPE_AGENT); }
__device__ __forceinline__ unsigned xb_xcc_id() { return (unsigned)__builtin_amdgcn_s_getreg((3 << 11) | 20) & 0xFu; }
#define XB_SPIN(cond, bar) do { unsigned _sp = 0; while (cond) { __builtin_amdgcn_s_sleep(1); \
    if ((++_sp & 255u) == 0u) { if (xb_ld(&(bar)[XB_TMO])) break; if (_sp > XB_SPIN_CAP) { atomicAdd(&(bar)[XB_TMO], 1u); break; } } } } while (0)
struct XcdBarrier { unsigned* bar; unsigned x; volatile LAS unsigned* st; };
__device__ __forceinline__ XcdBarrier xcd_barrier_post(unsigned* bar, volatile LAS unsigned* st) {
    XcdBarrier b; b.bar = bar; b.x = xb_xcc_id(); b.st = st;
    if (threadIdx.x == 0) (void)xb_add(&bar[XB_XCNT(b.x)], 1u);
    return b;
}
__device__ __forceinline__ void xcd_barrier_complete(unsigned* bar, unsigned x, unsigned& nloc, unsigned& nx) {
    const unsigned G = gridDim.x * gridDim.y * gridDim.z;
    unsigned sum, cnt, mine, sp = 0u;
    for (;;) {
        sum = 0u; cnt = 0u; mine = 0u;
#pragma unroll
        for (unsigned j = 0; j < 16; ++j) { const unsigned c = xb_ld(&bar[XB_XCNT(j)]); sum += c; cnt += (c > 0u) ? 1u : 0u; mine = (j == x) ? c : mine; }
        if (sum == G) break;
        __builtin_amdgcn_s_sleep(1);
        if ((++sp & 255u) == 0u) { if (xb_ld(&bar[XB_TMO])) break; if (sp > XB_SPIN_CAP) { atomicAdd(&bar[XB_TMO], 1u); break; } }
    }
    nloc = mine > 0u ? mine : 1u; nx = cnt > 0u ? cnt : 1u;
}
__device__ __forceinline__ void xcd_barrier(const XcdBarrier& b, bool leader) {
    asm volatile("s_waitcnt vmcnt(0)" ::: "memory");
    __syncthreads();
    if (leader) {
        unsigned* bar = b.bar;
        __builtin_amdgcn_s_waitcnt(0);
        unsigned nloc = b.st[0], nx = b.st[1];
        if (nloc == 0u) { xcd_barrier_complete(bar, b.x, nloc, nx); b.st[0] = nloc; b.st[1] = nx; }
        const unsigned old = xb_add(&bar[XB_XSUB(b.x)], 1u);
        const unsigned gen = old / nloc;
        if (old + 1u == (gen + 1u) * nloc) {
            __builtin_amdgcn_fence(__ATOMIC_RELEASE, "agent");
            asm volatile("s_waitcnt vmcnt(0)" ::: "memory");
            const unsigned og = xb_add(&bar[XB_TOP], 1u);
            const unsigned tg = og / nx;
            if (og + 1u == (tg + 1u) * nx) xb_add(&bar[XB_TOPGEN], 1u);
            else XB_SPIN(xb_ld(&bar[XB_TOPGEN]) == tg, bar);
            __builtin_amdgcn_fence(__ATOMIC_ACQUIRE, "agent");
            xb_add(&bar[XB_XGEN(b.x)], 1u);
            asm volatile("s_waitcnt vmcnt(0)" ::: "memory");
        } else {
            XB_SPIN(xb_ld(&bar[XB_XGEN(b.x)]) == gen, bar);
            __builtin_amdgcn_fence(__ATOMIC_ACQUIRE, "agent");
            asm volatile("s_waitcnt vmcnt(0)" ::: "memory");
        }
    }
    __syncthreads();
}

struct Args { const float* in[35]; float* out; unsigned char* ws; int ph_lo, ph_hi; };
struct Frame {
    LAS unsigned char* lds; unsigned char* ws; unsigned* ctl;
    int tid, lane, wave, bid, G;
    const unsigned long long LAS* tab; float* out;
};
__device__ __forceinline__ unsigned long long uni64(unsigned long long v) { const unsigned lo = __builtin_amdgcn_readfirstlane((unsigned)v), hi = __builtin_amdgcn_readfirstlane((unsigned)(v >> 32)); return ((unsigned long long)hi << 32) | lo; }
#define IN_(k) ((const float*)(const GAS float*)uni64(F.tab[k]))
enum { I_X = 0, I_C, I_CTX, I_CCTX, I_WADA, I_BADA, I_GMIX, I_GFFN, I_WIN, I_LRE, I_LIM, I_LDT, I_BRE, I_BIM, I_CRE, I_CIM, I_DSKIP, I_WGLU, I_SGG, I_SGB, I_WSG, I_BSG,
       I_WCONV, I_WBR, I_WMG, I_BMG, I_WO, I_WGRP, I_BGRP, I_WEXP, I_BEXP, I_W1, I_W3, I_W2, I_GF };

__device__ __forceinline__ const float* mod_ptr(const Frame& F, int l, int row) { return (const float*)(F.ws + WS_MOD) + (size_t)(l * 2 + (row >= SEQ ? 1 : 0)) * 6144; }
__device__ __forceinline__ const float* xin_row(const Frame& F, int row) { return row < SEQ ? IN_(I_X) + (size_t)row * D : IN_(I_CTX) + (size_t)(row - SEQ) * D; }
#define HBUF(F) ((unsigned char*)(F).out)


namespace pg8 {
#define PG8_LAS __attribute__((address_space(3)))
typedef unsigned short bf16_t;
typedef short bf16x8 __attribute__((ext_vector_type(8)));
typedef float f32x4 __attribute__((ext_vector_type(4)));
typedef unsigned u32x4 __attribute__((ext_vector_type(4)));
constexpr int BM = 256, BK = 64, HALF = 128, HTB = HALF * BK * 2  , STAGE_BYTES = 8 * HTB, NXCD = 8, WGM = 8;

__host__ __device__ __forceinline__ int lds_byte(int r, int c) { const int st = (r >> 4) * 2 + (c >> 5), rr = r & 15, cc = c & 31, ob = rr * 64 + cc * 2; return st * 1024 + (ob ^ (((ob >> 9) & 1) << 5)); }
__host__ __device__ __forceinline__ void stage_rc(int b, int& R, int& C) { const int st = b / 1024, sb = b % 1024, swz = sb ^ (((sb >> 9) & 1) << 5); R = (st >> 1) * 16 + swz / 64; C = (st & 1) * 32 + (swz % 64) / 2; }
__host__ __device__ __forceinline__ int perm32(int rho) { const int n = rho >> 4, i = rho & 15; return 8 * (i >> 2) + 4 * n + (i & 3); }

struct Unit { int pm, pn; };
struct Gemm { const bf16_t* A; const bf16_t* Bt; int M, N, K; int pad_; const int* rowidx; };

struct StaticOrder {
    int nM, nN, nwg, G, c;
    __host__ __device__ void init(int M, int N, int G_, int c_) { nM = M / BM; nN = N / BM; nwg = nM * nN; G = G_; c = c_; }
    __host__ __device__ bool next(int i, Unit& u) const {
        const long L = (long)i * G + c; if (L >= nwg) return false;
        int wgid = (int)L; { const int q = nwg / NXCD, r = nwg % NXCD, xcd = wgid % NXCD, off = wgid / NXCD; wgid = (xcd < r ? xcd * (q + 1) : r * (q + 1) + (xcd - r) * q) + off; }
        const int nig = WGM * nN, gid = wgid / nig, fm = gid * WGM, gsz = (nM - fm) < WGM ? (nM - fm) : WGM;
        u.pm = fm + ((wgid % nig) % gsz); u.pn = (wgid % nig) / gsz; return true;
    }
    __device__ __forceinline__ unsigned peek(const Unit&) const { return 0u; }
    __device__ __forceinline__ void a_ready(const Unit&, unsigned) const {}
    __device__ __forceinline__ void done(const Unit&) const {}
};
__device__ __forceinline__ unsigned cvt_pk_bf16(float lo, float hi) { unsigned r; asm volatile("v_cvt_pk_bf16_f32 %0, %1, %2" : "=v"(r) : "v"(lo), "v"(hi)); return r; }
template <class Epi, class Sched, bool ALIGN_EPI = false, bool SP2 = false, bool ASC1 = false, bool AGATHER = false>
__device__ __forceinline__ void gemm_phase(PG8_LAS unsigned char* lds, const Gemm g, const Sched& S, const Epi& E, int tid_in) {
    int tid_ = tid_in; asm volatile("" : "+v"(tid_));
    const int tid = tid_, wid = __builtin_amdgcn_readfirstlane(tid >> 6), lane = tid & 63, wr = wid >> 2, wc = wid & 3, fr = lane & 15, fq = lane >> 4;
    const int K = g.K, nt = K / BK;
    unsigned voffA[2], voffB[2];
#pragma unroll
    for (int i = 0; i < 2; ++i) { int R, C; stage_rc(tid * 16 + i * 8192, R, C); const int Rb = Epi::PERM ? ((R & ~31) + perm32(R & 31)) : R;
        voffA[i] = (unsigned)(R * K + C) * 2u; voffB[i] = (unsigned)(Rb * K + C) * 2u; }
    unsigned vgC[2][2], vgN[2][2]; int grow[2], gcol[2];
#pragma unroll
    for (int i = 0; i < 2; ++i) { stage_rc(tid * 16 + i * 8192, grow[i], gcol[i]); vgC[0][i] = vgC[1][i] = vgN[0][i] = vgN[1][i] = 0u; }
#define PG8_GLOAD(dst, unit) do { if constexpr (AGATHER) { _Pragma("unroll") for (int _h = 0; _h < 2; ++_h) _Pragma("unroll") for (int _i = 0; _i < 2; ++_i) \
        dst[_h][_i] = (unsigned)g.rowidx[(unit).pm * BM + _h * HALF + grow[_i]] * (unsigned)(K * 2) + (unsigned)(gcol[_i] * 2); } } while (0)
    const size_t kstep = (size_t)(BK * 2);
    const size_t hstep = (size_t)HALF * K * 2;
    const size_t tstep = 2 * hstep;
    const unsigned ldsw = (unsigned)wid * 1024u;
    const int aoff = lds_byte(wr * 64 + fr, fq * 8), boff = lds_byte(wc * 32 + fr, fq * 8);
#define PG8_SA(b, h) (((b) * 2 + (h)) * HTB)
#define PG8_SB(b, h) ((4 + (b) * 2 + (h)) * HTB)
#define PG8_STAGE_X(bufoff, gbase, voff, aux) do { _Pragma("unroll") for (int _i = 0; _i < 2; ++_i) \
        __builtin_amdgcn_global_load_lds((const unsigned*)((const char*)(gbase) + (voff)[_i]), (PG8_LAS unsigned*)(lds + (bufoff) + ldsw + _i * 8192), 16, 0, aux); } while (0)
#define PG8_STAGE(bufoff, gbase, voff) do { if constexpr (ASC1 && (bufoff) < 4 * HTB) PG8_STAGE_X(bufoff, gbase, voff, 16); else PG8_STAGE_X(bufoff, gbase, voff, 0); } while (0)
#define PG8_STAGE_A(bufoff, uptr, kofs, h, nx) do { if constexpr (AGATHER) { unsigned _vs[2] = {(nx) ? vgN[h][0] : vgC[h][0], (nx) ? vgN[h][1] : vgC[h][1]}; PG8_STAGE(bufoff, (const char*)g.A + (kofs), _vs); } \
        else PG8_STAGE(bufoff, uptr, voffA); } while (0)
#define PG8_LDA(dst, b, h) do { _Pragma("unroll") for (int m = 0; m < 4; ++m) _Pragma("unroll") for (int k = 0; k < 2; ++k) dst[m][k] = *(const PG8_LAS bf16x8*)(lds + PG8_SA(b, h) + aoff + m * 2048 + k * 1024); } while (0)
#define PG8_LDB(dst, b, h) do { _Pragma("unroll") for (int n = 0; n < 2; ++n) _Pragma("unroll") for (int k = 0; k < 2; ++k) dst[n][k] = *(const PG8_LAS bf16x8*)(lds + PG8_SB(b, h) + boff + n * 2048 + k * 1024); } while (0)
#define PG8_MMA(ai, bj, At, Bt) do { __builtin_amdgcn_s_setprio(1); _Pragma("unroll") for (int m = 0; m < 4; ++m) _Pragma("unroll") for (int n = 0; n < 2; ++n) _Pragma("unroll") for (int k = 0; k < 2; ++k) \
        acc[ai][bj][m][n] = __builtin_amdgcn_mfma_f32_16x16x32_bf16(Bt[n][k], At[m][k], acc[ai][bj][m][n], 0, 0, 0); __builtin_amdgcn_s_setprio(0); } while (0)
#define PG8_WAIT_V(n) asm volatile("s_waitcnt vmcnt(" #n ")" ::: "memory")
#define PG8_WAIT_L(n) asm volatile("s_waitcnt lgkmcnt(" #n ")" ::: "memory")
#define PG8_BAR __builtin_amdgcn_s_barrier()
#define PG8_SCHED __builtin_amdgcn_sched_barrier(0)
    Unit cur, nxt; int ui = 0;
    if (!S.next(0, cur)) return;
    f32x4 acc[2][2][4][2];
#pragma unroll
    for (int a = 0; a < 2; ++a)
#pragma unroll
        for (int b = 0; b < 2; ++b)
#pragma unroll
            for (int m = 0; m < 4; ++m)
#pragma unroll
                for (int n = 0; n < 2; ++n) acc[a][b][m][n] = (f32x4){0.f, 0.f, 0.f, 0.f};
    bf16x8 At[4][2], B0[2][2], B1[2][2];
    const char* cA = (const char*)g.A + (size_t)cur.pm * tstep; const char* cB = (const char*)g.Bt + (size_t)cur.pn * tstep;
    PG8_GLOAD(vgC, cur);
    S.a_ready(cur, S.peek(cur));
    static_assert(SP2, "only the SP2 pipeline is kept");
    {
        PG8_STAGE(PG8_SB(0, 0), cB, voffB); PG8_STAGE(PG8_SB(0, 1), cB + hstep, voffB); PG8_STAGE_A(PG8_SA(0, 0), cA, 0, 0, false); PG8_STAGE_A(PG8_SA(0, 1), cA + hstep, 0, 1, false);
        if (wr == 1) PG8_BAR;
        PG8_WAIT_V(2); PG8_BAR;
        PG8_STAGE(PG8_SB(1, 0), cB + kstep, voffB); PG8_STAGE_A(PG8_SA(1, 0), cA + kstep, kstep, 0, false); PG8_STAGE(PG8_SB(1, 1), cB + hstep + kstep, voffB);
        PG8_WAIT_V(6); PG8_BAR;
    }
    for (;;) {
        const bool has_next = S.next(ui + 1, nxt);
        if (has_next) PG8_GLOAD(vgN, nxt); else { if constexpr (AGATHER) { vgN[0][0] = vgC[0][0]; vgN[0][1] = vgC[0][1]; vgN[1][0] = vgC[1][0]; vgN[1][1] = vgC[1][1]; } }
        const unsigned tok = has_next ? S.peek(nxt) : 0u;
        const char* nA = has_next ? (const char*)g.A + (size_t)nxt.pm * tstep : cA; const char* nB = has_next ? (const char*)g.Bt + (size_t)nxt.pn * tstep : cB;
#pragma unroll 1
        for (int t = 0; t < nt; t += 2) {
            const bool last = (t == nt - 2);
            const char* a1 = cA + (size_t)(t + 1) * kstep;
            const char* a2 = last ? nA : cA + (size_t)(t + 2) * kstep; const char* b2 = last ? nB : cB + (size_t)(t + 2) * kstep;
            const char* a3 = a2 + kstep; const char* b3 = b2 + kstep;
            const size_t k1 = (size_t)(t + 1) * kstep, k2 = last ? 0 : (size_t)(t + 2) * kstep, k3 = k2 + kstep;
            if (last && has_next) S.a_ready(nxt, tok);
            {
            PG8_LDB(B0, 0, 0); PG8_LDB(B1, 0, 1); PG8_SCHED; PG8_LDA(At, 0, 0); PG8_STAGE_A(PG8_SA(1, 1), a1 + hstep, k1, 1, false);
            PG8_WAIT_V(8); PG8_WAIT_L(0); PG8_BAR; PG8_MMA(0, 0, At, B0); PG8_MMA(0, 1, At, B1); PG8_BAR; PG8_SCHED;
            PG8_LDA(At, 0, 1); PG8_STAGE(PG8_SB(0, 0), b2, voffB); PG8_STAGE(PG8_SB(0, 1), b2 + hstep, voffB); PG8_STAGE_A(PG8_SA(0, 0), a2, k2, 0, last);
            PG8_WAIT_V(8); PG8_WAIT_L(0); PG8_BAR; PG8_MMA(1, 0, At, B0); PG8_MMA(1, 1, At, B1); PG8_BAR; PG8_SCHED;
            PG8_LDB(B0, 1, 0); PG8_LDB(B1, 1, 1); PG8_SCHED; PG8_LDA(At, 1, 0); PG8_STAGE_A(PG8_SA(0, 1), a2 + hstep, k2, 1, last);
            PG8_WAIT_V(8); PG8_WAIT_L(0); PG8_BAR; PG8_MMA(0, 0, At, B0); PG8_MMA(0, 1, At, B1); PG8_BAR; PG8_SCHED;
            PG8_LDA(At, 1, 1); PG8_STAGE(PG8_SB(1, 0), b3, voffB); PG8_STAGE(PG8_SB(1, 1), b3 + hstep, voffB); PG8_STAGE_A(PG8_SA(1, 0), a3, k3, 0, last);
            PG8_WAIT_V(8); PG8_WAIT_L(0); PG8_BAR; PG8_MMA(1, 0, At, B0); PG8_MMA(1, 1, At, B1); PG8_BAR; PG8_SCHED;
            }
        }
        if constexpr (ALIGN_EPI) { if (wr == 0) PG8_BAR; }
        if constexpr (!Epi::AFTER_DRAIN) { E(acc, cur, wr, wc, fr, fq); S.done(cur); }
        if (!has_next) break;
#pragma unroll
        for (int a = 0; a < 2; ++a)
#pragma unroll
            for (int b = 0; b < 2; ++b)
#pragma unroll
                for (int m = 0; m < 4; ++m)
#pragma unroll
                    for (int n = 0; n < 2; ++n) acc[a][b][m][n] = (f32x4){0.f, 0.f, 0.f, 0.f};
        cur = nxt; cA = nA; cB = nB; ++ui;
        if constexpr (AGATHER) { vgC[0][0] = vgN[0][0]; vgC[0][1] = vgN[0][1]; vgC[1][0] = vgN[1][0]; vgC[1][1] = vgN[1][1]; }
        if constexpr (ALIGN_EPI) { if (wr == 1) PG8_BAR; }
    }
    PG8_WAIT_V(0);
    if constexpr (!ALIGN_EPI) { if (wr == 0) PG8_BAR; }
    PG8_BAR;
    if constexpr (Epi::AFTER_DRAIN) { E.fused(acc, cur, wr, wc, fr, fq, lds, wid, lane); S.done(cur); }
#undef PG8_SA
#undef PG8_SB
#undef PG8_STAGE
#undef PG8_STAGE_X
#undef PG8_LDA
#undef PG8_STAGE_A
#undef PG8_GLOAD
#undef PG8_LDB
#undef PG8_MMA
#undef PG8_WAIT_V
#undef PG8_WAIT_L
#undef PG8_BAR
#undef PG8_SCHED
}
}

constexpr bool PG_ALIGN = true, PG_SP2 = true;
__device__ __forceinline__ float bflo(unsigned w) { return __builtin_bit_cast(float, w << 16); }
__device__ __forceinline__ float bfhi(unsigned w) { return __builtin_bit_cast(float, w & 0xffff0000u); }
__device__ __forceinline__ unsigned cvtpk(float lo, float hi) { return pg8::cvt_pk_bf16(lo, hi); }

__device__ __forceinline__ void transpose_item(const float* W, int N, int k0, int n0, bf16* WT, int K, size_t dst_row0, LAS float* scr, int lane) {
    float v[32];
#pragma unroll
    for (int i = 0; i < 32; ++i) v[i] = W[(size_t)(k0 + 2 * i + (lane >> 5)) * N + n0 + (lane & 31)];
#pragma unroll
    for (int i = 0; i < 32; ++i) scr[(2 * i + (lane >> 5)) * 33 + (lane & 31)] = v[i];
    asm volatile("s_waitcnt lgkmcnt(0)" ::: "memory");
    const int c = lane & 7;
#pragma unroll
    for (int j = 0; j < 4; ++j) { const int n = (lane >> 3) + 8 * j; const LAS float* s = scr + (8 * c) * 33 + n;
        v4u o; o.x = pk2(s[0 * 33], s[1 * 33]); o.y = pk2(s[2 * 33], s[3 * 33]); o.z = pk2(s[4 * 33], s[5 * 33]); o.w = pk2(s[6 * 33], s[7 * 33]);
        *(v4u*)(WT + (dst_row0 + n) * K + k0 + 8 * c) = o; }
    asm volatile("s_waitcnt lgkmcnt(0)" ::: "memory");
}
constexpr int CONV_IN = 16 * 96, CONV_NITEMS = 16 * 96 + 16 * 96 + 8 * 16 + 3 * 8 * 32 + 16 * 32 + 2 * 32 * 16 * 8 + 32 * 4 * 32;
__device__ __forceinline__ void convert_weights(Frame& F, int l, int blk0, int nblk, int it_lo, int it_hi, bool extras) {
    LAS float* scr = (LAS float*)(F.lds + F.wave * 16384);
    const int cb = F.bid - blk0; if (cb < 0 || cb >= nblk) return;
    const int ngw = nblk * (NT / 64), gw = ngw - 1 - (cb * (NT / 64) + F.wave);
    constexpr int I_IN = 16 * 96, I_MG = 16 * 96, I_GLU = 8 * 16, I_BR = 3 * 8 * 32, I_O = 16 * 32, I_1 = 32 * 16 * 8, I_3 = I_1, I_2 = 32 * 4 * 32;
    static_assert(I_IN == CONV_IN && I_IN + I_MG + I_GLU + I_BR + I_O + I_1 + I_3 + I_2 == CONV_NITEMS, "item list");
    for (int it = it_lo + gw; it < it_hi; it += ngw) {
        int r = it;
        if (r < I_IN) { const int kb = r / 96, nb = r % 96; transpose_item(IN_(I_WIN) + (size_t)l * D * INW, INW, 64 * kb, 32 * nb, (bf16*)(F.ws + WS_WIN), 1024, 32 * nb, scr, F.lane); continue; } r -= I_IN;
        if (r < I_MG) { const int kb = r / 96, nb = r % 96; transpose_item(IN_(I_WMG) + (size_t)l * D * INW, INW, 64 * kb, 32 * nb, (bf16*)(F.ws + WS_WMG), 1024, 32 * nb, scr, F.lane); continue; } r -= I_MG;
        if (r < I_GLU) { const int kb = r / 16, nb = r % 16; transpose_item(IN_(I_WGLU) + (size_t)l * MIXW * MIXW, MIXW, 64 * kb, 32 * nb, (bf16*)(F.ws + WS_WGLU), 512, 32 * nb, scr, F.lane); continue; } r -= I_GLU;
        if (r < I_BR) { const int kk = r / 256, q = r % 256, kb = q / 32, nb = q % 32; transpose_item(IN_(I_WBR) + ((size_t)l * 3 + kk) * MIXW * D, D, 64 * kb, 32 * nb, (bf16*)(F.ws + WS_WBR), 512, (size_t)kk * 1024 + 32 * nb, scr, F.lane); continue; } r -= I_BR;
        if (r < I_O) { const int kb = r / 32, nb = r % 32; transpose_item(IN_(I_WO) + (size_t)l * D * D, D, 64 * kb, 32 * nb, (bf16*)(F.ws + WS_WO), 1024, 32 * nb, scr, F.lane); continue; } r -= I_O;
        if (r < I_1 + I_3) { const int which = r / I_1, q = r % I_1, e = q / 128, q2 = q % 128, kb = q2 / 8, nb = q2 % 8;
            const float* W = IN_(which ? I_W3 : I_W1) + ((size_t)l * NE + e) * D * DFF; const int n0 = 32 * nb;
            transpose_item(W, DFF, 64 * kb, n0, (bf16*)(F.ws + WS_W13), 1024, (size_t)e * 512 + (n0 / 128) * 256 + which * 128 + (n0 % 128), scr, F.lane); continue; } r -= I_1 + I_3;
        { const int e = r / 128, q = r % 128, kb = q / 32, nb = q % 32; transpose_item(IN_(I_W2) + ((size_t)l * NE + e) * DFF * D, D, 64 * kb, 32 * nb, (bf16*)(F.ws + WS_W2), 256, (size_t)e * 1024 + 32 * nb, scr, F.lane); }
    }
    if (!extras) return;
    { bf16* wr = (bf16*)(F.ws + WS_WR); const float* wg = IN_(I_WGRP) + (size_t)l * D * 4; const float* we = IN_(I_WEXP) + (size_t)l * D * 32;
      for (int i = cb * NT + F.tid; i < 48 * 1024; i += nblk * NT) { const int n = i >> 10, kk = i & 1023; const float w = n < 4 ? wg[kk * 4 + n] : (n < 36 ? we[kk * 32 + n - 4] : 0.f);
          const unsigned hi = f2bf(w); const float lo = w - __builtin_bit_cast(float, hi << 16); wr[i] = (bf16)hi; wr[48 * 1024 + i] = (bf16)f2bf(lo); } }
    { const float* s = IN_(I_WSG) + (size_t)l * 4 * 128 * 128; bf16* d = (bf16*)(F.ws + WS_WSG);
      for (int i = (cb * NT + F.tid) * 2; i < 4 * 128 * 128; i += nblk * NT * 2) *(unsigned*)(d + i) = pk2(s[i], s[i + 1]); }
}

struct EpiProj { static constexpr bool PERM = true, AFTER_DRAIN = false; bf16* O;
    __device__ __forceinline__ void operator()(const pg8::f32x4 (&acc)[2][2][4][2], const pg8::Unit& u, int wr, int wc, int fr, int fq) const {
        const int row0 = u.pm * 256 + wr * 64 + fr, col0 = u.pn * 256 + wc * 32 + 8 * fq; const bool act = (u.pn >= 2 && u.pn < 6);
#pragma unroll
        for (int ai = 0; ai < 2; ++ai)
#pragma unroll
            for (int m = 0; m < 4; ++m) { bf16* rowp = O + (size_t)(row0 + ai * 128 + m * 16) * INW + col0;
#pragma unroll
                for (int bj = 0; bj < 2; ++bj) { pg8::f32x4 v0 = acc[ai][bj][m][0], v1 = acc[ai][bj][m][1];
                    if (act) {
#pragma unroll
                        for (int j = 0; j < 4; ++j) { v0[j] = geluf_(v0[j]); v1[j] = geluf_(v1[j]); } }
                    v4u w; w.x = cvtpk(v0[0], v0[1]); w.y = cvtpk(v0[2], v0[3]); w.z = cvtpk(v1[0], v1[1]); w.w = cvtpk(v1[2], v1[3]); *(v4u*)(rowp + bj * 128) = w; } }
    } };
struct EpiGlu { static constexpr bool PERM = true, AFTER_DRAIN = false; const bf16* YG; bf16* YA;
    __device__ __forceinline__ void operator()(const pg8::f32x4 (&acc)[2][2][4][2], const pg8::Unit& u, int wr, int wc, int fr, int fq) const {
        const int row0 = u.pm * 256 + wr * 64 + fr, col0 = u.pn * 256 + wc * 32 + 8 * fq;
#pragma unroll
        for (int ai = 0; ai < 2; ++ai) {
        v4u gv[4][2];
#pragma unroll
            for (int m = 0; m < 4; ++m)
#pragma unroll
                for (int bj = 0; bj < 2; ++bj) gv[m][bj] = *(const v4u*)(YG + (size_t)(row0 + ai * 128 + m * 16) * MIXW + col0 + bj * 128);
        asm volatile("" ::: "memory");
#pragma unroll
            for (int m = 0; m < 4; ++m) { const size_t off = (size_t)(row0 + ai * 128 + m * 16) * MIXW + col0;
#pragma unroll
                for (int bj = 0; bj < 2; ++bj) { const pg8::f32x4 v0 = acc[ai][bj][m][0], v1 = acc[ai][bj][m][1]; const v4u g = gv[m][bj];
                    v4u w; w.x = cvtpk(bflo(g.x) * sigmoidf_(v0[0]), bfhi(g.x) * sigmoidf_(v0[1])); w.y = cvtpk(bflo(g.y) * sigmoidf_(v0[2]), bfhi(g.y) * sigmoidf_(v0[3]));
                    w.z = cvtpk(bflo(g.z) * sigmoidf_(v1[0]), bfhi(g.z) * sigmoidf_(v1[1])); w.w = cvtpk(bflo(g.w) * sigmoidf_(v1[2]), bfhi(g.w) * sigmoidf_(v1[3])); *(v4u*)(YA + off + bj * 128) = w; } }
        asm volatile("" ::: "memory"); }
    } };
__device__ __forceinline__ int xcd_remap(int Lq, int total) { const int q = total >> 3, r = total & 7, x = Lq & 7, off = Lq >> 3; return (x < r ? x * (q + 1) : r * (q + 1) + (x - r) * q) + off; }
struct EpiBr { static constexpr bool PERM = true, AFTER_DRAIN = false; bf16* BR;
    __device__ __forceinline__ void operator()(const pg8::f32x4 (&acc)[2][2][4][2], const pg8::Unit& u, int wr, int wc, int fr, int fq) const {
        const int pm = u.pm % (MT / 256); const int row0 = pm * 256 + wr * 64 + fr, col0 = u.pn * 256 + wc * 32 + 8 * fq;
#pragma unroll
        for (int ai = 0; ai < 2; ++ai)
#pragma unroll
            for (int m = 0; m < 4; ++m) { bf16* rowp = BR + (size_t)(row0 + ai * 128 + m * 16) * INW + col0;
#pragma unroll
                for (int bj = 0; bj < 2; ++bj) { const pg8::f32x4 v0 = acc[ai][bj][m][0], v1 = acc[ai][bj][m][1];
                    v4u w; w.x = cvtpk(v0[0], v0[1]); w.y = cvtpk(v0[2], v0[3]); w.z = cvtpk(v1[0], v1[1]); w.w = cvtpk(v1[2], v1[3]); *(v4u*)(rowp + bj * 128) = w; } }
    } };
__device__ __forceinline__ int vu_pm(int v) { return (v >> 5) * 8 + (v & 7); }
__device__ __forceinline__ int vu_dt(int v) { return (v >> 3) & 3; }
struct SchedBr { int G, c, nM;
    __device__ __forceinline__ bool next(int i, pg8::Unit& u) const { const int v0 = (i / 3) * G + c, k = i % 3; if (v0 >= nM * 4) return false; const int v = xcd_remap(v0, nM * 4);
        u.pm = k * (MT / 256) + vu_pm(v); u.pn = k * 4 + vu_dt(v); return true; }
    __device__ __forceinline__ unsigned peek(const pg8::Unit&) const { return 0u; }
    __device__ __forceinline__ void a_ready(const pg8::Unit&, unsigned) const {}
    __device__ __forceinline__ void done(const pg8::Unit&) const {} };
struct EpiMerge { static constexpr bool PERM = true, AFTER_DRAIN = false; const bf16* BR; bf16* PM; const float* bm;
    __device__ __forceinline__ void operator()(const pg8::f32x4 (&acc)[2][2][4][2], const pg8::Unit& u, int wr, int wc, int fr, int fq) const {
        const int k = u.pn >> 2, dt = u.pn & 3; const int row0 = u.pm * 256 + wr * 64 + fr, col0 = dt * 256 + wc * 32 + 8 * fq;
#pragma unroll
        for (int bj = 0; bj < 2; ++bj) { const pg8::f32x4 b0 = *(const pg8::f32x4*)(bm + k * 1024 + col0 + bj * 128), b1 = *(const pg8::f32x4*)(bm + k * 1024 + col0 + bj * 128 + 4);
#pragma unroll
            for (int ai = 0; ai < 2; ++ai) {
            v4u brv[4], pmv[4];
#pragma unroll
                for (int m = 0; m < 4; ++m) { const size_t r = (size_t)(row0 + ai * 128 + m * 16); brv[m] = *(const v4u*)(BR + r * INW + k * 1024 + col0 + bj * 128);
                    pmv[m] = k > 0 ? *(const v4u*)(PM + r * D + col0 + bj * 128) : (v4u){0u, 0u, 0u, 0u}; }
                asm volatile("" ::: "memory");
#pragma unroll
                for (int m = 0; m < 4; ++m) { const size_t r = (size_t)(row0 + ai * 128 + m * 16); const v4u br = brv[m], o = pmv[m];
                    const pg8::f32x4 v0 = acc[ai][bj][m][0] + b0, v1 = acc[ai][bj][m][1] + b1;
                    float p[8] = {sigmoidf_(v0[0]) * bflo(br.x), sigmoidf_(v0[1]) * bfhi(br.x), sigmoidf_(v0[2]) * bflo(br.y), sigmoidf_(v0[3]) * bfhi(br.y),
                                  sigmoidf_(v1[0]) * bflo(br.z), sigmoidf_(v1[1]) * bfhi(br.z), sigmoidf_(v1[2]) * bflo(br.w), sigmoidf_(v1[3]) * bfhi(br.w)};
                    if (k > 0) { p[0] += bflo(o.x); p[1] += bfhi(o.x); p[2] += bflo(o.y); p[3] += bfhi(o.y); p[4] += bflo(o.z); p[5] += bfhi(o.z); p[6] += bflo(o.w); p[7] += bfhi(o.w); }
                    v4u w; w.x = cvtpk(p[0], p[1]); w.y = cvtpk(p[2], p[3]); w.z = cvtpk(p[4], p[5]); w.w = cvtpk(p[6], p[7]); *(v4u*)(PM + r * D + col0 + bj * 128) = w; }
                asm volatile("" ::: "memory"); } }
    } };
struct SchedMerge { int G, c, nM;
    __device__ __forceinline__ bool next(int i, pg8::Unit& u) const { const int v0 = (i / 3) * G + c, k = i % 3; if (v0 >= nM * 4) return false; const int v = xcd_remap(v0, nM * 4); u.pm = vu_pm(v); u.pn = k * 4 + vu_dt(v); return true; }
    __device__ __forceinline__ unsigned peek(const pg8::Unit&) const { return 0u; }
    __device__ __forceinline__ void a_ready(const pg8::Unit&, unsigned) const {}
    __device__ __forceinline__ void done(const pg8::Unit&) const {} };
struct EpiWo { static constexpr bool PERM = true, AFTER_DRAIN = false; const float* xin; bf16* X16; const float* mod_l; float* rss; int l0; int pad_;
    __device__ __forceinline__ void operator()(const pg8::f32x4 (&acc)[2][2][4][2], const pg8::Unit& u, int wr, int wc, int fr, int fq) const {
        const int row0 = u.pm * 256 + wr * 64 + fr, col0 = u.pn * 256 + wc * 32 + 8 * fq;
        const float* ga = mod_l + 2048;
        float ssq[2][4] = {};
        pg8::f32x4 gv[2][2];
#pragma unroll
        for (int bj = 0; bj < 2; ++bj)
#pragma unroll
            for (int n = 0; n < 2; ++n) gv[bj][n] = *(const pg8::f32x4*)(ga + col0 + bj * 128 + n * 4);
#pragma unroll
        for (int ai = 0; ai < 2; ++ai) {
#pragma unroll
            for (int mp = 0; mp < 2; ++mp) {
            pg8::f32x4 xv[2][2][2];
            if (l0) {
#pragma unroll
                for (int m = 0; m < 2; ++m) { const size_t off = (size_t)(row0 + ai * 128 + (mp * 2 + m) * 16) * D + col0;
#pragma unroll
                    for (int bj = 0; bj < 2; ++bj)
#pragma unroll
                        for (int n = 0; n < 2; ++n) xv[m][bj][n] = *(const pg8::f32x4*)(xin + off + bj * 128 + n * 4); }
                asm volatile("" ::: "memory");
            } else {
                v4u xb[2][2];
#pragma unroll
                for (int m = 0; m < 2; ++m) { const size_t off = (size_t)(row0 + ai * 128 + (mp * 2 + m) * 16) * D + col0;
#pragma unroll
                    for (int bj = 0; bj < 2; ++bj) xb[m][bj] = *(const v4u*)(X16 + off + bj * 128); }
                asm volatile("" ::: "memory");
#pragma unroll
                for (int m = 0; m < 2; ++m)
#pragma unroll
                    for (int bj = 0; bj < 2; ++bj) { const v4u w = xb[m][bj]; xv[m][bj][0] = (pg8::f32x4){bflo(w.x), bfhi(w.x), bflo(w.y), bfhi(w.y)}; xv[m][bj][1] = (pg8::f32x4){bflo(w.z), bfhi(w.z), bflo(w.w), bfhi(w.w)}; }
            }
#pragma unroll
            for (int m = 0; m < 2; ++m) { const size_t off = (size_t)(row0 + ai * 128 + (mp * 2 + m) * 16) * D + col0;
#pragma unroll
                for (int bj = 0; bj < 2; ++bj) { const pg8::f32x4 o0 = xv[m][bj][0] + gv[bj][0] * acc[ai][bj][m + mp * 2][0], o1 = xv[m][bj][1] + gv[bj][1] * acc[ai][bj][m + mp * 2][1];
                    v4u w; w.x = cvtpk(o0[0], o0[1]); w.y = cvtpk(o0[2], o0[3]); w.z = cvtpk(o1[0], o1[1]); w.w = cvtpk(o1[2], o1[3]); *(v4u*)(X16 + off + bj * 128) = w;
                    ssq[ai][m + mp * 2] += (o0[0] * o0[0] + o0[1] * o0[1] + o0[2] * o0[2] + o0[3] * o0[3]) + (o1[0] * o1[0] + o1[1] * o1[1] + o1[2] * o1[2] + o1[3] * o1[3]); } }
            asm volatile("" ::: "memory"); }
        }
        const int lane = fr + 16 * fq;
#pragma unroll
        for (int ai = 0; ai < 2; ++ai)
#pragma unroll
            for (int m = 0; m < 4; ++m) { float s = ssq[ai][m]; s += shflx(s, 16, lane); s += shflx(s, 32, lane); if (fq == 0) rss[(size_t)(row0 + ai * 128 + m * 16) * 16 + u.pn * 4 + wc] = s; }
    } };
constexpr int MOETAB_OFF = 131072 + 2048;
__device__ __forceinline__ int moe_build_tables(Frame& F, const unsigned* cnt, LAS unsigned* tabu, LAS unsigned* tabd) {
    LAS int* RAW = (LAS int*)(F.lds + MOETAB_OFF + 8192); LAS int* PRE = RAW + 32;
    if (F.tid < 32) RAW[F.tid] = ((int)cnt[F.tid] + 255) >> 8;
    __syncthreads();
    if (F.tid <= 32) { int s = 0; for (int i = 0; i < F.tid; ++i) s += RAW[i]; PRE[F.tid] = s; }
    __syncthreads();
    const int nrt = PRE[32];
    for (int q = F.tid; q < nrt * 6; q += NT) { const int rt = q / 6, w = q % 6; int e = 0;
#pragma unroll 1
        for (int i = 1; i < 32; ++i) e += PRE[i] <= rt ? 1 : 0;
        if (w < 2) tabu[rt * 2 + w] = ((unsigned)rt << 16) | (unsigned)(e * 2 + w); else tabd[rt * 4 + (w - 2)] = ((unsigned)rt << 16) | (unsigned)(e * 4 + (w - 2)); }
    __syncthreads();
    return nrt;
}
__device__ __forceinline__ void xcd_chunk(int total, int x, int& start, int& size) { const int q = total >> 3, r = total & 7; size = q + (x < r ? 1 : 0); start = x < r ? x * (q + 1) : r * (q + 1) + (x - r) * q; }
struct SchedMoeUp { int G, c, nrt, tid; const LAS unsigned* tabw; unsigned* upc;
    __device__ __forceinline__ bool next(int i, pg8::Unit& u) const {
        int Lq;
        if (G & 7) { Lq = i * G + c; if (Lq >= 2 * nrt) return false; }
        else { int rs, rn; xcd_chunk(nrt, c & 7, rs, rn); const int nb = G >> 3, j = c >> 3, o0 = i * nb; if (o0 + j >= 2 * rn) return false;
            const int n = (2 * rn - o0) < nb ? (2 * rn - o0) : nb, h = n >> 1;
            Lq = (n & 1) ? 2 * rs + o0 + j : 2 * (rs + (o0 >> 1) + (j % h)) + (j / h); }
        const unsigned w = (unsigned)__builtin_amdgcn_readfirstlane((int)tabw[Lq]); u.pm = (int)(w >> 16); u.pn = (int)(w & 0xffffu); return true; }
    __device__ __forceinline__ unsigned peek(const pg8::Unit&) const { return 0u; }
    __device__ __forceinline__ void a_ready(const pg8::Unit&, unsigned) const {}
    __device__ __forceinline__ void done(const pg8::Unit& u) const {
        asm volatile("s_waitcnt vmcnt(0)" ::: "memory"); __builtin_amdgcn_s_barrier();
        if (tid == 0) __hip_atomic_fetch_add(upc + u.pm, 1u, __ATOMIC_RELAXED, __HIP_MEMORY_SCOPE_AGENT); } };
struct SchedMoeDown { int G, c, nrt, pad_; const LAS unsigned* tabw; unsigned* upc;
    __device__ __forceinline__ bool next(int i, pg8::Unit& u) const {
        int Lq;
        if (G & 7) { Lq = i * G + c; if (Lq >= 4 * nrt) return false; }
        else { const int j = c >> 3, nb = G >> 3; int rs, rn; xcd_chunk(nrt, c & 7, rs, rn); const int un = 2 * rn, dn = 4 * rn;
            const int a = un / nb, n2 = un % nb, nu = a + (j < n2 ? 1 : 0), s = 2 * nu + i;
            const int c0 = s - 2 * a, c1 = s - 2 * a - 2; const int off = (nb - n2) * (c0 > 0 ? c0 : 0) + n2 * (c1 > 0 ? c1 : 0) + (c1 >= 0 ? j : j - n2);
            if (off >= dn) return false; Lq = 4 * rs + off; }
        const unsigned w = (unsigned)__builtin_amdgcn_readfirstlane((int)tabw[Lq]); u.pm = (int)(w >> 16); u.pn = (int)(w & 0xffffu); return true; }
    __device__ __forceinline__ unsigned peek(const pg8::Unit& u) const { return __hip_atomic_load(upc + u.pm, __ATOMIC_RELAXED, __HIP_MEMORY_SCOPE_AGENT); }
    __device__ __forceinline__ void a_ready(const pg8::Unit& u, unsigned tok) const {
        if ((unsigned)__builtin_amdgcn_readfirstlane((int)tok) >= 2u) return;
        unsigned* p = upc + u.pm; unsigned spins = 0;
        while ((unsigned)__builtin_amdgcn_readfirstlane((int)__hip_atomic_load(p, __ATOMIC_RELAXED, __HIP_MEMORY_SCOPE_AGENT)) < 2u) { __builtin_amdgcn_s_sleep(2); if (++spins > (1u << 22)) break; } }
    __device__ __forceinline__ void done(const pg8::Unit&) const {} };
struct EpiUp { static constexpr bool PERM = true, AFTER_DRAIN = false; bf16* ACT; const float* SW;
    __device__ __forceinline__ void operator()(const pg8::f32x4 (&acc)[2][2][4][2], const pg8::Unit& u, int wr, int wc, int fr, int fq) const {
        const int row0 = u.pm * 256 + wr * 64 + fr, f0 = (u.pn & 1) * 128 + wc * 32 + 8 * fq;
        const __amdgpu_buffer_rsrc_t rs = __builtin_amdgcn_make_buffer_rsrc(ACT, 0, MAXSLOT * DFF * 2, 0x00020000);
        float wv[2][4];
#pragma unroll
        for (int ai = 0; ai < 2; ++ai)
#pragma unroll
            for (int m = 0; m < 4; ++m) wv[ai][m] = SW[row0 + ai * 128 + m * 16];
        asm volatile("" ::: "memory");
#pragma unroll
        for (int ai = 0; ai < 2; ++ai)
#pragma unroll
            for (int m = 0; m < 4; ++m) { const int slot = row0 + ai * 128 + m * 16; const float w = wv[ai][m];
                const pg8::f32x4 a0 = acc[ai][0][m][0], a1 = acc[ai][0][m][1], b0 = acc[ai][1][m][0], b1 = acc[ai][1][m][1];
                v4u o; o.x = cvtpk(siluf_(a0[0]) * b0[0] * w, siluf_(a0[1]) * b0[1] * w); o.y = cvtpk(siluf_(a0[2]) * b0[2] * w, siluf_(a0[3]) * b0[3] * w);
                o.z = cvtpk(siluf_(a1[0]) * b1[0] * w, siluf_(a1[1]) * b1[1] * w); o.w = cvtpk(siluf_(a1[2]) * b1[2] * w, siluf_(a1[3]) * b1[3] * w);
                __builtin_amdgcn_raw_buffer_store_b128(o, rs, (unsigned)((slot * DFF + f0) * 2), 0,   16); }
    } };
struct EpiDown { static constexpr bool PERM = true, AFTER_DRAIN = false; bf16* YS2;
    __device__ __forceinline__ void operator()(const pg8::f32x4 (&acc)[2][2][4][2], const pg8::Unit& u, int wr, int wc, int fr, int fq) const {
        const int row0 = u.pm * 256 + wr * 64 + fr, col0 = (u.pn & 3) * 256 + wc * 32 + 8 * fq;
#pragma unroll
        for (int ai = 0; ai < 2; ++ai)
#pragma unroll
            for (int m = 0; m < 4; ++m) { bf16* rowp = YS2 + (size_t)(row0 + ai * 128 + m * 16) * D + col0;
#pragma unroll
                for (int bj = 0; bj < 2; ++bj) { const pg8::f32x4 v0 = acc[ai][bj][m][0], v1 = acc[ai][bj][m][1];
                    v4u w; w.x = cvtpk(v0[0], v0[1]); w.y = cvtpk(v0[2], v0[3]); w.z = cvtpk(v1[0], v1[1]); w.w = cvtpk(v1[2], v1[3]); *(v4u*)(rowp + bj * 128) = w; } }
    } };


__device__ __forceinline__ void ph2_fast(Frame& F, int l) {
    pg8::Gemm g{(const bf16*)HBUF(F), (const bf16*)(F.ws + WS_WIN), SEQ, INW, D, 0, nullptr}; pg8::StaticOrder S; S.init(SEQ, INW, F.G, F.bid);
    EpiProj E{(bf16*)(F.ws + WS_PROJ)}; pg8::gemm_phase<EpiProj, pg8::StaticOrder, PG_ALIGN, PG_SP2>(F.lds, g, S, E, F.tid);
}
__device__ __forceinline__ void ph6_fast(Frame& F, int l) {
    pg8::Gemm g{(const bf16*)(F.ws + WS_YG), (const bf16*)(F.ws + WS_WGLU), MT, MIXW, MIXW, 0, nullptr}; pg8::StaticOrder S; S.init(l == 0 ? MT : SEQ, MIXW, F.G, F.bid);
    EpiGlu E{(const bf16*)(F.ws + WS_YG), (bf16*)(F.ws + WS_YS)}; pg8::gemm_phase<EpiGlu, pg8::StaticOrder, PG_ALIGN, PG_SP2>(F.lds, g, S, E, F.tid);
}
__device__ __forceinline__ void ph7_fast(Frame& F, int l) {
    pg8::Gemm g{(const bf16*)(F.ws + WS_YS), (const bf16*)(F.ws + WS_WBR), 3 * MT, 3 * D, MIXW, 0, nullptr}; SchedBr S{F.G, F.bid, SEQ / 256};
    EpiBr E{(bf16*)(F.ws + WS_PROJ)}; pg8::gemm_phase<EpiBr, SchedBr, PG_ALIGN, PG_SP2>(F.lds, g, S, E, F.tid);
}
__device__ __forceinline__ void ph8_fast(Frame& F, int l) {
    pg8::Gemm g{(const bf16*)HBUF(F), (const bf16*)(F.ws + WS_WMG), MT, INW, D, 0, nullptr}; SchedMerge S{F.G, F.bid, SEQ / 256};
    EpiMerge E{(const bf16*)(F.ws + WS_PROJ), (bf16*)(F.ws + WS_PM), IN_(I_BMG) + l * INW}; pg8::gemm_phase<EpiMerge, SchedMerge, PG_ALIGN, PG_SP2>(F.lds, g, S, E, F.tid);
}
__device__ __forceinline__ void ph9_fast(Frame& F, int l) {
    pg8::Gemm g{(const bf16*)(F.ws + WS_PM), (const bf16*)(F.ws + WS_WO), MT, D, D, 0, nullptr}; pg8::StaticOrder S; S.init(SEQ, D, F.G, F.bid);
    EpiWo E{IN_(I_X), (bf16*)(F.ws + WS_X16), (const float*)(F.ws + WS_MOD) + (size_t)l * 2 * 6144, (float*)(F.ws + WS_RSS), l == 0 ? 1 : 0, 0};
    pg8::gemm_phase<EpiWo, pg8::StaticOrder, PG_ALIGN, PG_SP2>(F.lds, g, S, E, F.tid);
}
__device__ __forceinline__ void ph12_moe(Frame& F, int l) {
    LAS unsigned* tabu = (LAS unsigned*)(F.lds + MOETAB_OFF); LAS unsigned* tabd = tabu + 1024; unsigned* upc = F.ctl + CW_UPC + l * 256;
    const int nrt = moe_build_tables(F, F.ctl + CW_CNT + l * 128, tabu, tabd);
#define MOE_STAMP(i) do { if ((PROBE_A >= 0 || PROBE_B >= 0) && l == 0 && F.tid == 0) ((volatile LAS unsigned long long*)(F.lds + TS_OFF))[i] = __builtin_amdgcn_s_memrealtime(); } while (0)
    MOE_STAMP(60);
    { pg8::Gemm g{(const bf16*)HBUF(F), (const bf16*)(F.ws + WS_W13), MAXSLOT, NE * 512, D, 0, (const int*)(F.ws + WS_STOK)}; SchedMoeUp S{F.G, F.bid, nrt, F.tid, tabu, upc};
      EpiUp E{(bf16*)(F.ws + WS_ACT), (const float*)(F.ws + WS_SW)}; pg8::gemm_phase<EpiUp, SchedMoeUp, PG_ALIGN, PG_SP2, false, true>(F.lds, g, S, E, F.tid); }
    MOE_STAMP(61);
    { pg8::Gemm g{(const bf16*)(F.ws + WS_ACT), (const bf16*)(F.ws + WS_W2), MAXSLOT, NE * D, DFF, 0, nullptr}; SchedMoeDown S{F.G, F.bid, nrt, 0, tabd, upc};
      EpiDown E{(bf16*)(F.ws + WS_YS2)}; pg8::gemm_phase<EpiDown, SchedMoeDown, PG_ALIGN, PG_SP2, true>(F.lds, g, S, E, F.tid); }
    MOE_STAMP(62);
    if (PROBE_A == 99 && l == 0 && F.tid == 0) { volatile LAS unsigned long long* TS = (volatile LAS unsigned long long*)(F.lds + TS_OFF); __hip_atomic_fetch_max(F.ctl + 100, ((unsigned)(TS[62] - TS[12]) << 8) | (unsigned)F.bid, __ATOMIC_RELAXED, __HIP_MEMORY_SCOPE_AGENT); }
}


constexpr int NSB = MT / 16;
__device__ __forceinline__ void s5_precompute(Frame& F) {
    LAS float* APr = (LAS float*)F.lds; LAS float* APi = APr + 2176; LAS float* BBr = APi + 2176; LAS float* BBi = BBr + 2048; LAS float* CCr = BBi + 2048; LAS float* CCi = CCr + 2048; LAS float* KK = CCi + 2048;
    for (int item = F.G - 1 - F.bid; item < 2 * G5; item += F.G) { const int l = item >> 5, g = item & 31;
        __syncthreads();
        if (F.tid < 128) { const int d = F.tid >> 6, p = F.tid & 63; const int ldg = (l * 2 + d) * G5 + g;
            const double lr = IN_(I_LRE)[ldg * P5 + p], li = IN_(I_LIM)[ldg * P5 + p], dt = exp((double)IN_(I_LDT)[ldg]);
            for (int e = 0; e <= 16; ++e) { const double m = exp(lr * dt * e), ang = li * dt * e; APr[(d * 64 + p) * 17 + e] = (float)(m * cos(ang)); APi[(d * 64 + p) * 17 + e] = (float)(m * sin(ang)); }
            { const double m16 = exp(lr * dt * 16.0), a16 = li * dt * 16.0; float* A16 = (float*)(F.ws + WS_A16) + ((size_t)((l * 32 + g) * 2 + d) * 64 + p) * 2; A16[0] = (float)(m16 * cos(a16)); A16[1] = (float)(m16 * sin(a16)); }
            const double m1 = exp(lr * dt), ar = m1 * cos(li * dt), ai = m1 * sin(li * dt); const double nr = ar - 1.0, ni = ai, den = lr * lr + li * li;
            const double qr = (nr * lr + ni * li) / den, qi = (ni * lr - nr * li) / den;
            for (int h = 0; h < 16; ++h) { const double x = IN_(I_BRE)[((size_t)ldg * P5 + p) * H5 + h], y = IN_(I_BIM)[((size_t)ldg * P5 + p) * H5 + h];
                BBr[(d * 64 + p) * 16 + h] = (float)(qr * x - qi * y); BBi[(d * 64 + p) * 16 + h] = (float)(qr * y + qi * x);
                CCr[(d * 16 + h) * 64 + p] = IN_(I_CRE)[((size_t)ldg * H5 + h) * P5 + p]; CCi[(d * 16 + h) * 64 + p] = IN_(I_CIM)[((size_t)ldg * H5 + h) * P5 + p]; } }
        __syncthreads();
        { const int d = F.tid >> 8, e = (F.tid >> 4) & 15, hp = F.tid & 15;
          float wr[64], wi[64];
#pragma unroll
          for (int p = 0; p < 64; ++p) { const float pr = APr[(d * 64 + p) * 17 + e], pi = APi[(d * 64 + p) * 17 + e], br = BBr[(d * 64 + p) * 16 + hp], bi = BBi[(d * 64 + p) * 16 + hp]; wr[p] = pr * br - pi * bi; wi[p] = pr * bi + pi * br; }
#pragma unroll 1
          for (int h = 0; h < 16; ++h) { float a = 0.f;
#pragma unroll
              for (int p = 0; p < 64; ++p) a += CCr[(d * 16 + h) * 64 + p] * wr[p] - CCi[(d * 16 + h) * 64 + p] * wi[p];
              KK[(d * 16 + e) * 256 + h * 16 + hp] = a; } }
        __syncthreads();
        bf16* M = (bf16*)(F.ws + WS_S5M) + (size_t)(l * 32 + g) * 3 * 65536;
        for (int idx = F.tid; idx < 32768; idx += NT) {
            const int r = idx >> 7, k0 = (idx & 127) * 2; float v[3][2];
#pragma unroll
            for (int q = 0; q < 2; ++q) { const int kk = k0 + q;
                { const int d = r >> 7, p = (r >> 1) & 63, c = r & 1, sg = kk >> 4, hp = kk & 15, e = d == 0 ? 15 - sg : sg;
                  const float pr = APr[(d * 64 + p) * 17 + e], pi = APi[(d * 64 + p) * 17 + e], br = BBr[(d * 64 + p) * 16 + hp], bi = BBi[(d * 64 + p) * 16 + hp];
                  v[0][q] = c == 0 ? pr * br - pi * bi : pr * bi + pi * br; }
                { const int tau = r >> 4, h = r & 15, sg = kk >> 4, hp = kk & 15; float t = 0.f;
                  if (sg <= tau) t += KK[(0 * 16 + (tau - sg)) * 256 + h * 16 + hp]; if (sg >= tau) t += KK[(1 * 16 + (sg - tau)) * 256 + h * 16 + hp]; v[1][q] = t; }
                { const int tau = r >> 4, h = r & 15, d = kk >> 7, p = (kk >> 1) & 63, c = kk & 1, e = d == 0 ? tau + 1 : 16 - tau;
                  const float cr = CCr[(d * 16 + h) * 64 + p], ci = CCi[(d * 16 + h) * 64 + p], pr = APr[(d * 64 + p) * 17 + e], pi = APi[(d * 64 + p) * 17 + e];
                  v[2][q] = c == 0 ? cr * pr - ci * pi : -(cr * pi + ci * pr); } }
#pragma unroll
            for (int m = 0; m < 3; ++m) *(unsigned*)(M + (size_t)m * 65536 + r * 256 + k0) = pk2(v[m][0], v[m][1]);
        }
    }
}
constexpr int ZS_OFF = 16384, ZS_STRIDE = 528, EX_OFF = ZS_OFF + 144 * ZS_STRIDE, CARRY_OFF = EX_OFF + 4 * 128 * 16;
__device__ __forceinline__ void s5_fused_phase(Frame& F, int l) {
    const bf16* PROJ = (const bf16*)(F.ws + WS_PROJ); bf16* YG = (bf16*)(F.ws + WS_YG); const float* ds = IN_(I_DSKIP) + l * MIXW;
    unsigned long long* GR = (unsigned long long*)(F.ws + WS_GR); const unsigned tag = (unsigned)l + 1u;
    const int l15 = F.lane & 15, lq = F.lane >> 4; const int G8 = F.G & ~7;
    LAS unsigned char* ZS = F.lds + ZS_OFF; LAS float* EX = (LAS float*)(F.lds + EX_OFF); LAS float* CR = (LAS float*)(F.lds + CARRY_OFF);
    if (F.bid < G8)
    for (int item = F.bid; item < 256; item += G8) {
        const int g = item >> 3, p = item & 7;
        const bf16* vsrc = PROJ + (size_t)(16 * l15 + 2 * F.wave + (lq >> 1)) * INW + 16 * g + 8 * (lq & 1);
        {   const bf16* Fm = (const bf16*)(F.ws + WS_S5M) + (size_t)(l * 32 + g) * 3 * 65536;
            bf16x8 Af[2][8], nvz[9];
#pragma unroll
            for (int j = 0; j < 2; ++j)
#pragma unroll
                for (int ks = 0; ks < 8; ++ks) Af[j][ks] = *(const bf16x8*)(Fm + (size_t)(16 * (2 * F.wave + j) + l15) * 256 + 32 * ks + 8 * lq);
#pragma unroll
            for (int s = 0; s < 9; ++s) nvz[s] = *(const bf16x8*)(vsrc + (size_t)(s == 0 ? 64 : 8 * p + s - 1) * 256 * INW);
            __syncthreads();
            *(LAS bf16x8*)(F.lds + (F.wave * 64 + F.lane) * 16) = nvz[0];
            __syncthreads();
            int cur = 0;
#pragma unroll
            for (int s = 0; s < 9; ++s) {
                f32x4 acc[2] = {{0.f, 0.f, 0.f, 0.f}, {0.f, 0.f, 0.f, 0.f}};
#pragma unroll
                for (int ks = 0; ks < 8; ++ks) { const bf16x8 V = *(const LAS bf16x8*)(F.lds + cur * 8192 + (ks * 64 + F.lane) * 16);
#pragma unroll
                    for (int j = 0; j < 2; ++j) acc[j] = __builtin_amdgcn_mfma_f32_16x16x32_bf16(Af[j][ks], V, acc[j], 0, 0, 0); }
#pragma unroll
                for (int j = 0; j < 2; ++j) { v2u zz; zz.x = pk2(acc[j][0], acc[j][1]); zz.y = pk2(acc[j][2], acc[j][3]); *(LAS v2u*)(ZS + (s * 16 + l15) * ZS_STRIDE + (16 * (2 * F.wave + j) + 4 * lq) * 2) = zz; }
                if (s < 8) *(LAS bf16x8*)(F.lds + (cur ^ 1) * 8192 + (F.wave * 64 + F.lane) * 16) = nvz[s + 1];
                __syncthreads();
                cur ^= 1;
            }
        }
        {   const int c = F.tid & 127, j = F.tid >> 7, d = c >> 6;
            const float* A16 = (const float*)(F.ws + WS_A16) + ((size_t)((l * 32 + g) * 2 + d) * 64 + (c & 63)) * 2; const float ar = A16[0], ai = A16[1];
            LAS unsigned char* zc = ZS + c * 4;
            float hr = 0.f, hi = 0.f, pr = 1.f, pi = 0.f;
#pragma unroll 4
            for (int q = 0; q < 32; ++q) { const int i = 32 * j + q, row = 16 + (d ? 127 - i : i); const unsigned zw = *(const LAS unsigned*)(zc + row * ZS_STRIDE);
                const float nr = ar * hr - ai * hi + bflo(zw), ni = ar * hi + ai * hr + bfhi(zw); hr = nr; hi = ni; const float qr = pr * ar - pi * ai, qi = pr * ai + pi * ar; pr = qr; pi = qi; }
            EX[(j * 128 + c) * 4 + 0] = hr; EX[(j * 128 + c) * 4 + 1] = hi; EX[(j * 128 + c) * 4 + 2] = pr; EX[(j * 128 + c) * 4 + 3] = pi;
            __syncthreads();
            if (j == 0) {
                float er = 0.f, ei = 0.f, Ar = 1.f, Ai = 0.f;
#pragma unroll
                for (int jj = 0; jj < 4; ++jj) { const float h0 = EX[(jj * 128 + c) * 4], h1 = EX[(jj * 128 + c) * 4 + 1], q0 = EX[(jj * 128 + c) * 4 + 2], q1 = EX[(jj * 128 + c) * 4 + 3];
                    const float nr = q0 * er - q1 * ei + h0, ni = q0 * ei + q1 * er + h1; er = nr; ei = ni; const float tr = Ar * q0 - Ai * q1, ti = Ar * q1 + Ai * q0; Ar = tr; Ai = ti; }
                unsigned long long* mine = GR + ((size_t)(g * 8 + p) * 128 + c) * 2;
                __hip_atomic_store(mine, ((unsigned long long)tag << 32) | __builtin_bit_cast(unsigned, er), __ATOMIC_RELAXED, __HIP_MEMORY_SCOPE_AGENT);
                __hip_atomic_store(mine + 1, ((unsigned long long)tag << 32) | __builtin_bit_cast(unsigned, ei), __ATOMIC_RELAXED, __HIP_MEMORY_SCOPE_AGENT);
                float cr = 0.f, ci = 0.f;
#pragma unroll 4
                for (int i = 0; i < 16; ++i) { const int row = d ? 15 - i : i; const unsigned zw = *(const LAS unsigned*)(zc + row * ZS_STRIDE); *(LAS unsigned*)(zc + row * ZS_STRIDE) = pk2(cr, ci);
                    const float nr = ar * cr - ai * ci + bflo(zw), ni = ar * ci + ai * cr + bfhi(zw); cr = nr; ci = ni; }
                const int np = d ? 7 - p : p;
#pragma unroll 1
                for (int t = 0; t < np; ++t) { const int pp = d ? 7 - t : t; unsigned long long* o = GR + ((size_t)(g * 8 + pp) * 128 + c) * 2; unsigned long long x0, x1; unsigned spins = 0;
                    for (;;) { x0 = __hip_atomic_load(o, __ATOMIC_RELAXED, __HIP_MEMORY_SCOPE_AGENT); x1 = __hip_atomic_load(o + 1, __ATOMIC_RELAXED, __HIP_MEMORY_SCOPE_AGENT);
                        if ((unsigned)(x0 >> 32) == tag && (unsigned)(x1 >> 32) == tag) break; __builtin_amdgcn_s_sleep(2); if (++spins > (1u << 22)) break; }
                    const float e0 = __builtin_bit_cast(float, (unsigned)x0), e1 = __builtin_bit_cast(float, (unsigned)x1);
                    const float nr = Ar * cr - Ai * ci + e0, ni = Ar * ci + Ai * cr + e1; cr = nr; ci = ni; }
                CR[c * 2] = cr; CR[c * 2 + 1] = ci;
            }
            __syncthreads();
            float sr = CR[c * 2], si = CR[c * 2 + 1];
            for (int jj = 0; jj < j; ++jj) { const float h0 = EX[(jj * 128 + c) * 4], h1 = EX[(jj * 128 + c) * 4 + 1], q0 = EX[(jj * 128 + c) * 4 + 2], q1 = EX[(jj * 128 + c) * 4 + 3];
                const float nr = q0 * sr - q1 * si + h0, ni = q0 * si + q1 * sr + h1; sr = nr; si = ni; }
#pragma unroll 4
            for (int q = 0; q < 32; ++q) { const int i = 32 * j + q, row = 16 + (d ? 127 - i : i); const unsigned zw = *(const LAS unsigned*)(zc + row * ZS_STRIDE); *(LAS unsigned*)(zc + row * ZS_STRIDE) = pk2(sr, si);
                const float nr = ar * sr - ai * si + bflo(zw), ni = ar * si + ai * sr + bfhi(zw); sr = nr; si = ni; }
        }
        {   const bf16* Tm = (const bf16*)(F.ws + WS_S5M) + ((size_t)(l * 32 + g) * 3 + 1) * 65536; const bf16* Em = Tm + 65536;
            bf16x8 At[2][8], Ae[2][8];
#pragma unroll
            for (int j = 0; j < 2; ++j)
#pragma unroll
                for (int ks = 0; ks < 8; ++ks) { const size_t o = (size_t)(16 * (2 * F.wave + j) + l15) * 256 + 32 * ks + 8 * lq; At[j][ks] = *(const bf16x8*)(Tm + o); Ae[j][ks] = *(const bf16x8*)(Em + o); }
            const f32x4 dsk = *(const f32x4*)(ds + 16 * g + 4 * lq);
            const int s0 = (p == 0 && l == 0) ? 0 : 1;
            bf16x8 nA = *(const bf16x8*)(vsrc + (size_t)(s0 == 0 ? 64 : 8 * p) * 256 * INW), nB = *(const bf16x8*)(vsrc + (size_t)(8 * p + s0) * 256 * INW), nC = *(const bf16x8*)(vsrc + (size_t)(8 * p + s0 + 1) * 256 * INW);
            __syncthreads();
            *(LAS bf16x8*)(F.lds + (F.wave * 64 + F.lane) * 16) = nA;
            __syncthreads();
            int cur = 0;
#pragma unroll 1
            for (int s = s0; s < 9; ++s) { const int tl = s == 0 ? 64 : 8 * p + s - 1;
                bf16x8 nD = nC; if (s + 3 < 9) nD = *(const bf16x8*)(vsrc + (size_t)(8 * p + s + 2) * 256 * INW);
                v2u uu[2];
#pragma unroll
                for (int j = 0; j < 2; ++j) uu[j] = *(const LAS v2u*)(F.lds + cur * 8192 + (F.wave * 64 + l15 + 16 * (2 * j + (lq >> 1))) * 16 + 8 * (lq & 1));
                f32x4 acc[2] = {{0.f, 0.f, 0.f, 0.f}, {0.f, 0.f, 0.f, 0.f}};
#pragma unroll
                for (int ks = 0; ks < 8; ++ks) { const bf16x8 V = *(const LAS bf16x8*)(F.lds + cur * 8192 + (ks * 64 + F.lane) * 16), S = *(const LAS bf16x8*)(ZS + (s * 16 + l15) * ZS_STRIDE + (32 * ks + 8 * lq) * 2);
#pragma unroll
                    for (int j = 0; j < 2; ++j) { acc[j] = __builtin_amdgcn_mfma_f32_16x16x32_bf16(At[j][ks], V, acc[j], 0, 0, 0); acc[j] = __builtin_amdgcn_mfma_f32_16x16x32_bf16(Ae[j][ks], S, acc[j], 0, 0, 0); } }
#pragma unroll
                for (int j = 0; j < 2; ++j) { const size_t row = (size_t)tl * 256 + 16 * l15 + (2 * F.wave + j); const int ch = 16 * g + 4 * lq; const v2u u = uu[j];
                    const float y0 = acc[j][0] + dsk[0] * bflo(u.x), y1 = acc[j][1] + dsk[1] * bfhi(u.x), y2 = acc[j][2] + dsk[2] * bflo(u.y), y3 = acc[j][3] + dsk[3] * bfhi(u.y);
                    v2u w; w.x = cvtpk(geluf_(y0), geluf_(y1)); w.y = cvtpk(geluf_(y2), geluf_(y3)); *(v2u*)(YG + row * MIXW + ch) = w; }
                if (s < 8) *(LAS bf16x8*)(F.lds + (cur ^ 1) * 8192 + (F.wave * 64 + F.lane) * 16) = nB;
                __syncthreads();
                cur ^= 1; nB = nC; nC = nD;
            }
        }
    }
}
__device__ __forceinline__ int s5_chain_sb(int d, int i) { return d == 0 ? (i < 16 ? 1024 + i : i - 16) : (i < 16 ? 1039 - i : 1023 - (i - 16)); }
__device__ __forceinline__ void sg_fast_item(Frame& F, int l, int chunk, int pass) {
    const bf16* PROJ = (const bf16*)(F.ws + WS_PROJ); bf16* YB = (bf16*)(F.ws + WS_YS) + (size_t)MT * MIXW; const bf16* WSG = (const bf16*)(F.ws + WS_WSG);
    const float* lg = IN_(I_SGG) + l * MIXW; const float* lb = IN_(I_SGB) + l * MIXW; const float* bsg = IN_(I_BSG) + l * 512;
    LAS float* st = (LAS float*)(F.lds + 131072 + 2048); LAS unsigned char* WL = F.lds + 65536;
    __syncthreads();
    v4u wst[8];
#pragma unroll
    for (int i = 0; i < 8; ++i) { const int pid = F.tid + NT * i, ln = pid & 63, rest = pid >> 6, ks = rest & 3, cb = (rest >> 2) & 7, gl = rest >> 5;
        wst[i] = *(const v4u*)(WSG + ((size_t)(pass * 2 + gl) * 128 + cb * 16 + (ln & 15)) * 128 + 32 * ks + 8 * (ln >> 4)); }
    {
        const int p = F.tid >> 2, part = F.tid & 3; const bf16* vr = PROJ + (size_t)(chunk * 128 + p) * INW + 1024 + part * 128; float s = 0.f, q = 0.f;
#pragma unroll 4
        for (int c = 0; c < 128; c += 8) { const v4u w = *(const v4u*)(vr + c); const float x[8] = {bflo(w.x), bfhi(w.x), bflo(w.y), bfhi(w.y), bflo(w.z), bfhi(w.z), bflo(w.w), bfhi(w.w)};
#pragma unroll
            for (int i = 0; i < 8; ++i) { s += x[i]; q += x[i] * x[i]; } }
        s += shflx(s, 1, F.lane); q += shflx(q, 1, F.lane); s += shflx(s, 2, F.lane); q += shflx(q, 2, F.lane);
        const float mu = s * (1.f / 512.f), var = fmaxf(q * (1.f / 512.f) - mu * mu, 0.f);
        if (part == 0) { st[p * 2] = mu; st[p * 2 + 1] = rsqrtf(var + EPS); }
    }
#pragma unroll
    for (int i = 0; i < 8; ++i) *(LAS v4u*)(WL + (F.tid + NT * i) * 16) = wst[i];
    __syncthreads();
    const int l15 = F.lane & 15, lq = F.lane >> 4;
#pragma unroll 1
    for (int it = F.tid; it < 2048; it += NT) { const int tp = it & 63, cg = it >> 6; const int p0 = tp * 2, ch = pass * 256 + cg * 8;
        const v4u w0 = *(const v4u*)(PROJ + (size_t)(chunk * 128 + p0) * INW + 1024 + ch), w1 = *(const v4u*)(PROJ + (size_t)(chunk * 128 + p0 + 1) * INW + 1024 + ch);
        const float mu0 = st[p0 * 2], rs0 = st[p0 * 2 + 1], mu1 = st[p0 * 2 + 2], rs1 = st[p0 * 2 + 3];
        const float x0[8] = {bflo(w0.x), bfhi(w0.x), bflo(w0.y), bfhi(w0.y), bflo(w0.z), bfhi(w0.z), bflo(w0.w), bfhi(w0.w)};
        const float x1[8] = {bflo(w1.x), bfhi(w1.x), bflo(w1.y), bfhi(w1.y), bflo(w1.z), bfhi(w1.z), bflo(w1.w), bfhi(w1.w)};
#pragma unroll
        for (int i = 0; i < 8; ++i) { const float gm = lg[ch + i], bt = lb[ch + i]; const int c = cg * 8 + i;
            *(LAS unsigned*)(F.lds + c * 256 + (((p0 >> 3) ^ (c & 15)) << 4) + (p0 & 7) * 2) = pk2((x0[i] - mu0) * rs0 * gm + bt, (x1[i] - mu1) * rs1 * gm + bt); } }
    __syncthreads();
    const int ggl = F.wave >> 2, gg = pass * 2 + ggl, rb0 = (F.wave & 3) * 2;
    bf16x8 A[2][4];
#pragma unroll
    for (int j = 0; j < 2; ++j)
#pragma unroll
        for (int ks = 0; ks < 4; ++ks) { const int c = ggl * 128 + (rb0 + j) * 16 + l15; A[j][ks] = *(const LAS bf16x8*)(F.lds + c * 256 + (((4 * ks + lq) ^ (c & 15)) << 4)); }
    f32x4 acc[2][8];
#pragma unroll
    for (int j = 0; j < 2; ++j)
#pragma unroll
        for (int cb = 0; cb < 8; ++cb) acc[j][cb] = (f32x4){0.f, 0.f, 0.f, 0.f};
#pragma unroll
    for (int cb = 0; cb < 8; ++cb)
#pragma unroll
        for (int ks = 0; ks < 4; ++ks) { const bf16x8 B = *(const LAS bf16x8*)(WL + ((((ggl * 8 + cb) * 4 + ks) * 64) + F.lane) * 16);
#pragma unroll
            for (int j = 0; j < 2; ++j) acc[j][cb] = __builtin_amdgcn_mfma_f32_16x16x32_bf16(A[j][ks], B, acc[j][cb], 0, 0, 0); }
    v2u guv[8][2];
#pragma unroll
    for (int cb = 0; cb < 8; ++cb)
#pragma unroll
        for (int j = 0; j < 2; ++j) guv[cb][j] = *(const v2u*)(PROJ + ((size_t)chunk * 128 + cb * 16 + l15) * INW + 512 + gg * 128 + (rb0 + j) * 16 + 4 * lq);
    asm volatile("" ::: "memory");
#pragma unroll
    for (int cb = 0; cb < 8; ++cb) { const int q = cb * 16 + l15; const size_t row = (size_t)chunk * 128 + q; const float bq = bsg[gg * 128 + q];
#pragma unroll
        for (int j = 0; j < 2; ++j) { const int col = gg * 128 + (rb0 + j) * 16 + 4 * lq; const v2u gu = guv[cb][j];
            v2u w; w.x = cvtpk(bflo(gu.x) * (acc[j][cb][0] + bq), bfhi(gu.x) * (acc[j][cb][1] + bq)); w.y = cvtpk(bflo(gu.y) * (acc[j][cb][2] + bq), bfhi(gu.y) * (acc[j][cb][3] + bq));
            *(v2u*)(YB + row * MIXW + col) = w; } }
}

__device__ __forceinline__ bf16x8 sum3_bf16x8(const bf16* p, size_t stride) {
    const v4u a = *(const v4u*)p, b = *(const v4u*)(p + stride), c = *(const v4u*)(p + 2 * stride); v4u o;
    o.x = pk2(bflo(a.x) + bflo(b.x) + bflo(c.x), bfhi(a.x) + bfhi(b.x) + bfhi(c.x)); o.y = pk2(bflo(a.y) + bflo(b.y) + bflo(c.y), bfhi(a.y) + bfhi(b.y) + bfhi(c.y));
    o.z = pk2(bflo(a.z) + bflo(b.z) + bflo(c.z), bfhi(a.z) + bfhi(b.z) + bfhi(c.z)); o.w = pk2(bflo(a.w) + bflo(b.w) + bflo(c.w), bfhi(a.w) + bfhi(b.w) + bfhi(c.w));
    return __builtin_bit_cast(bf16x8, o);
}
template <int RB, int CB, bool SUM3, class EF>
__device__ __forceinline__ void thin_block(const bf16* A, int lda, size_t astride, const bf16* Bt, int K, int row0, int col0, int wave, int lane, LAS unsigned char* lds, const EF& ef) {
    constexpr int NTL = RB * CB; const int r = lane & 15, q = lane >> 4;
    if constexpr (NTL >= 8) {
        constexpr int TPW = NTL / 8, WPR = CB / TPW;
        const int rb = wave / WPR, cb0 = (wave % WPR) * TPW;
        const bf16* a = A + (size_t)(row0 + 16 * rb + r) * lda + 8 * q; const bf16* b = Bt + (size_t)(col0 + 16 * cb0 + r) * K + 8 * q;
        f32x4 acc[TPW];
#pragma unroll
        for (int c = 0; c < TPW; ++c) acc[c] = (f32x4){0.f, 0.f, 0.f, 0.f};
        bf16x8 xa[8], wa[TPW][8], xb[8], wb[TPW][8];
#define THIN_LD(x, w, kk) do { _Pragma("unroll") for (int j = 0; j < 8; ++j) { x[j] = SUM3 ? sum3_bf16x8(a + 32 * ((kk) + j), astride) : *(const bf16x8*)(a + 32 * ((kk) + j)); \
            _Pragma("unroll") for (int c = 0; c < TPW; ++c) w[c][j] = *(const bf16x8*)(b + (size_t)(16 * c) * K + 32 * ((kk) + j)); } } while (0)
#define THIN_MM(x, w) do { _Pragma("unroll") for (int j = 0; j < 8; ++j) _Pragma("unroll") for (int c = 0; c < TPW; ++c) acc[c] = __builtin_amdgcn_mfma_f32_16x16x32_bf16(x[j], w[c][j], acc[c], 0, 0, 0); } while (0)
        THIN_LD(xa, wa, 0);
#pragma unroll 1
        for (int k0 = 0; k0 < K / 32; k0 += 16) {
            THIN_LD(xb, wb, k0 + 8); __builtin_amdgcn_sched_barrier(0); THIN_MM(xa, wa); __builtin_amdgcn_sched_barrier(0);
            if (k0 + 16 < K / 32) THIN_LD(xa, wa, k0 + 16);
            __builtin_amdgcn_sched_barrier(0); THIN_MM(xb, wb); __builtin_amdgcn_sched_barrier(0);
        }
#undef THIN_LD
#undef THIN_MM
#pragma unroll
        for (int c = 0; c < TPW; ++c)
#pragma unroll
            for (int i = 0; i < 4; ++i) ef(row0 + 16 * rb + 4 * q + i, col0 + 16 * (cb0 + c) + r, acc[c][i]);
    } else {
        constexpr int KS = 8 / NTL;
        const int t = wave % NTL, kp = wave / NTL, rb = t / CB, cb = t % CB; const int kw = K / KS;
        const bf16* a = A + (size_t)(row0 + 16 * rb + r) * lda + kp * kw + 8 * q; const bf16* b = Bt + (size_t)(col0 + 16 * cb + r) * K + kp * kw + 8 * q;
        f32x4 acc = {0.f, 0.f, 0.f, 0.f};
        bf16x8 xa[4], wa[4], xb[4], wb[4];
#define THIN_LD(x, w, kk) do { _Pragma("unroll") for (int j = 0; j < 4; ++j) { x[j] = SUM3 ? sum3_bf16x8(a + 32 * ((kk) + j), astride) : *(const bf16x8*)(a + 32 * ((kk) + j)); w[j] = *(const bf16x8*)(b + 32 * ((kk) + j)); } } while (0)
#define THIN_MM(x, w) do { _Pragma("unroll") for (int j = 0; j < 4; ++j) acc = __builtin_amdgcn_mfma_f32_16x16x32_bf16(x[j], w[j], acc, 0, 0, 0); } while (0)
        THIN_LD(xa, wa, 0);
#pragma unroll 1
        for (int k0 = 0; k0 < kw / 32; k0 += 8) {
            THIN_LD(xb, wb, k0 + 4); __builtin_amdgcn_sched_barrier(0); THIN_MM(xa, wa); __builtin_amdgcn_sched_barrier(0);
            if (k0 + 8 < kw / 32) THIN_LD(xa, wa, k0 + 8);
            __builtin_amdgcn_sched_barrier(0); THIN_MM(xb, wb); __builtin_amdgcn_sched_barrier(0);
        }
#undef THIN_LD
#undef THIN_MM
        __syncthreads();
        *(LAS f32x4*)(lds + (wave * 64 + lane) * 16) = acc;
        __syncthreads();
        if (kp == 0) { f32x4 s = acc;
#pragma unroll
            for (int p = 1; p < KS; ++p) s = s + *(const LAS f32x4*)(lds + ((p * NTL + t) * 64 + lane) * 16);
#pragma unroll
            for (int i = 0; i < 4; ++i) ef(row0 + 16 * rb + 4 * q + i, col0 + 16 * cb + r, s[i]); }
    }
}
template <bool SUM3, class EF>
__device__ __forceinline__ void thin_lds(const bf16* A, int lda, size_t astride, const bf16* Bt, int K, int row0, int col0, int tid, int wave, int lane, LAS unsigned char* lds, const EF& ef) {
    const int r = lane & 15, q = lane >> 4, rb = wave >> 1, cb0 = (wave & 1) * 2;
    f32x4 acc[2] = {{0.f, 0.f, 0.f, 0.f}, {0.f, 0.f, 0.f, 0.f}};
    v4u xs[8], wv[8];
    const int prow = tid >> 6, ppc = tid & 63;
#define TL_LD(c) do { _Pragma("unroll") for (int i = 0; i < 8; ++i) { const bf16* ap = A + (size_t)(row0 + prow + 8 * i) * lda + (c) * 512 + ppc * 8; \
        xs[i] = SUM3 ? __builtin_bit_cast(v4u, sum3_bf16x8(ap, astride)) : *(const v4u*)ap; wv[i] = *(const v4u*)(Bt + (size_t)(col0 + prow + 8 * i) * K + (c) * 512 + ppc * 8); } } while (0)
    const int nch = K / 512;
    TL_LD(0);
#pragma unroll 1
    for (int c = 0; c < nch; ++c) {
        __syncthreads();
#pragma unroll
        for (int i = 0; i < 8; ++i) { const int row = prow + 8 * i; const int o = row * 1024 + ((ppc ^ (row & 15)) << 4); *(LAS v4u*)(lds + o) = xs[i]; *(LAS v4u*)(lds + 65536 + o) = wv[i]; }
        __syncthreads();
        if (c + 1 < nch) TL_LD(c + 1);
        __builtin_amdgcn_sched_barrier(0);
#pragma unroll
        for (int ks = 0; ks < 16; ++ks) { const int po = ((4 * ks + q) ^ r) << 4;
            const bf16x8 x = *(const LAS bf16x8*)(lds + (16 * rb + r) * 1024 + po);
            const bf16x8 w0 = *(const LAS bf16x8*)(lds + 65536 + (16 * cb0 + r) * 1024 + po), w1 = *(const LAS bf16x8*)(lds + 65536 + (16 * (cb0 + 1) + r) * 1024 + po);
            acc[0] = __builtin_amdgcn_mfma_f32_16x16x32_bf16(x, w0, acc[0], 0, 0, 0); acc[1] = __builtin_amdgcn_mfma_f32_16x16x32_bf16(x, w1, acc[1], 0, 0, 0); }
    }
#undef TL_LD
#pragma unroll
    for (int c = 0; c < 2; ++c)
#pragma unroll
        for (int i = 0; i < 4; ++i) ef(row0 + 16 * rb + 4 * q + i, col0 + 16 * (cb0 + c) + r, acc[c][i]);
    __syncthreads();
}
struct CtxProj { bf16* P; __device__ __forceinline__ void operator()(int row, int col, float v) const { const float o = (col >= 512 && col < 1536) ? geluf_(v) : v; P[(size_t)row * INW + col] = (bf16)f2bf(o); } };
struct CtxGlu { const bf16* YG; bf16* YA; __device__ __forceinline__ void operator()(int row, int col, float v) const { YA[(size_t)row * MIXW + col] = (bf16)f2bf(bf2f(YG[(size_t)row * MIXW + col]) * sigmoidf_(v)); } };
struct CtxBr { bf16* BR; int kk; __device__ __forceinline__ void operator()(int row, int col, float v) const { BR[(size_t)row * INW + kk * 1024 + col] = (bf16)f2bf(v); } };
struct CtxMerge { const bf16* BR; bf16* PMK; const float* bm; int kk; __device__ __forceinline__ void operator()(int row, int col, float v) const {
    PMK[((size_t)kk * CTX + row) * D + col] = (bf16)f2bf(sigmoidf_(v + bm[kk * 1024 + col]) * bf2f(BR[(size_t)row * INW + kk * 1024 + col])); } };
struct CtxWo { const float* xs; float* XC; const float* ga; __device__ __forceinline__ void operator()(int row, int col, float v) const { XC[(size_t)row * D + col] = xs[(size_t)row * D + col] + ga[col] * v; } };
__device__ __forceinline__ void ph2_ctx(Frame& F, int ncols) {
    const bf16* Hc = (const bf16*)HBUF(F) + (size_t)SEQ * D; const bf16* W = (const bf16*)(F.ws + WS_WIN); CtxProj ef{(bf16*)(F.ws + WS_PROJ) + (size_t)SEQ * INW};
    if (ncols == INW) { for (int it = F.bid; it < 4 * (INW / 64); it += F.G) thin_lds<false>(Hc, D, 0, W, D, (it & 3) * 64, (it >> 2) * 64, F.tid, F.wave, F.lane, F.lds, ef); }
    else { for (int it = F.bid; it < 8 * (ncols / 16); it += F.G) thin_block<2, 1, false>(Hc, D, 0, W, D, (it & 7) * 32, (it >> 3) * 16, F.wave, F.lane, F.lds, ef); }
}
__device__ __forceinline__ void ph7_ctx(Frame& F) {
    for (int it = F.bid; it < 3 * 64; it += F.G) { const int kk = it / 64, j = it % 64; CtxBr ef{(bf16*)(F.ws + WS_PROJ) + (size_t)SEQ * INW, kk};
        thin_lds<false>((const bf16*)(F.ws + WS_YS) + ((size_t)kk * MT + SEQ) * MIXW, MIXW, 0, (const bf16*)(F.ws + WS_WBR) + (size_t)kk * 1024 * MIXW, MIXW, (j & 3) * 64, (j >> 2) * 64, F.tid, F.wave, F.lane, F.lds, ef); }
}
__device__ __forceinline__ void ph8_ctx(Frame& F, int l) {
    const bf16* Hc = (const bf16*)HBUF(F) + (size_t)SEQ * D;
    for (int it = F.bid; it < 3 * 64; it += F.G) { const int kk = it / 64, j = it % 64; CtxMerge ef{(const bf16*)(F.ws + WS_PROJ) + (size_t)SEQ * INW, (bf16*)(F.ws + WS_Z), IN_(I_BMG) + l * INW, kk};
        thin_lds<false>(Hc, D, 0, (const bf16*)(F.ws + WS_WMG) + (size_t)kk * 1024 * D, D, (j & 3) * 64, (j >> 2) * 64, F.tid, F.wave, F.lane, F.lds, ef); }
}
__device__ __forceinline__ void ph9_ctx(Frame& F, int l) {
    CtxWo ef{l == 0 ? IN_(I_CTX) : (const float*)(F.ws + WS_XC), (float*)(F.ws + WS_XC), (const float*)(F.ws + WS_MOD) + (size_t)(l * 2 + 1) * 6144 + 2048};
    for (int it = F.bid; it < 4 * 16; it += F.G) thin_lds<true>((const bf16*)(F.ws + WS_Z), D, (size_t)CTX * D, (const bf16*)(F.ws + WS_WO), D, (it & 3) * 64, (it >> 2) * 64, F.tid, F.wave, F.lane, F.lds, ef);
}
__device__ __forceinline__ void ctx_x1_fixup(Frame& F, int l, int row0) {
    const float* XC = (const float*)(F.ws + WS_XC); float* RSS = (float*)(F.ws + WS_RSS);
    const int rr = row0 + (F.tid >> 5), part = F.tid & 31; const float* xr = XC + (size_t)rr * D + part * 32; float s = 0.f;
#pragma unroll
    for (int c = 0; c < 32; c += 4) { const f32x4 v = *(const f32x4*)(xr + c); s += v.x * v.x + v.y * v.y + v.z * v.z + v.w * v.w; }
    s += shflx(s, 1, F.lane); s += shflx(s, 2, F.lane); s += shflx(s, 4, F.lane); s += shflx(s, 8, F.lane); s += shflx(s, 16, F.lane);
    if (part < 16) RSS[(size_t)(SEQ + rr) * 16 + part] = part == 0 ? s : 0.f;
    asm volatile("s_waitcnt vmcnt(0)" ::: "memory");
    __syncthreads();
}


__device__ __forceinline__ void ph0_prologue(Frame& F) {
    float* mod = (float*)(F.ws + WS_MOD);
    LAS float* SV = (LAS float*)(F.lds + 131072 + 4096);
    for (int i = F.tid; i < 2048; i += NT) SV[i] = siluf_(i < 1024 ? IN_(I_C)[i] : IN_(I_CCTX)[i - 1024]);
    __syncthreads();
    LAS float* RED = (LAS float*)(F.lds + 131072 + 4096 + 8192);
    for (int it = F.bid; it < 2 * 96; it += F.G) { const int l = it / 96, j = (it % 96) * 64 + F.lane;
        const float* W = IN_(I_WADA) + (size_t)l * D * 6144 + j + (size_t)(F.wave * 128) * 6144;
        float a0 = 0.f, a1 = 0.f;
#pragma unroll 32
        for (int kk = 0; kk < 128; ++kk) { const float w = W[(size_t)kk * 6144]; a0 += SV[F.wave * 128 + kk] * w; a1 += SV[1024 + F.wave * 128 + kk] * w; }
        __syncthreads();
        RED[(F.wave * 2 + 0) * 64 + F.lane] = a0; RED[(F.wave * 2 + 1) * 64 + F.lane] = a1;
        __syncthreads();
        if (F.wave < 2) { float s = 0.f;
#pragma unroll
            for (int w8 = 0; w8 < 8; ++w8) s += RED[(w8 * 2 + F.wave) * 64 + F.lane];
            const float mv = s + IN_(I_BADA)[l * 6144 + j]; mod[(size_t)(l * 2 + F.wave) * 6144 + j] = mv;
            if (l == 0 && j < 2048) __hip_atomic_store((unsigned long long*)(F.ws + WS_MG) + F.wave * 2048 + j, (1ull << 32) | __builtin_bit_cast(unsigned, mv), __ATOMIC_RELAXED, __HIP_MEMORY_SCOPE_AGENT); }
    }
}
__device__ __forceinline__ void stage_mod_granules(Frame& F, const float* g, LAS float* GC, LAS float* SH) {
    unsigned long long* MG = (unsigned long long*)(F.ws + WS_MG);
    __syncthreads();
    for (int i0 = F.tid; i0 < 2048; i0 += 4 * NT) { unsigned long long xs[4], xc[4]; unsigned spins = 0;
        for (;;) { bool ok = true;
#pragma unroll
            for (int q = 0; q < 4; ++q) { const int i = i0 + q * NT, w = i >> 10, c = i & 1023; xs[q] = __hip_atomic_load(MG + w * 2048 + c, __ATOMIC_RELAXED, __HIP_MEMORY_SCOPE_AGENT); xc[q] = __hip_atomic_load(MG + w * 2048 + 1024 + c, __ATOMIC_RELAXED, __HIP_MEMORY_SCOPE_AGENT); }
#pragma unroll
            for (int q = 0; q < 4; ++q) ok = ok && (unsigned)(xs[q] >> 32) == 1u && (unsigned)(xc[q] >> 32) == 1u;
            if (ok) break; __builtin_amdgcn_s_sleep(2); if (++spins > (1u << 22)) break; }
#pragma unroll
        for (int q = 0; q < 4; ++q) { const int i = i0 + q * NT, c = i & 1023; GC[i] = g[c] * (1.f + __builtin_bit_cast(float, (unsigned)xc[q])); SH[i] = __builtin_bit_cast(float, (unsigned)xs[q]); } }
    __syncthreads();
}
__device__ __forceinline__ void stage_mod(Frame& F, const float* g, int l, int sh_off, int sc_off, LAS float* GC, LAS float* SH) {
    __syncthreads();
    for (int i = F.tid; i < 2048; i += NT) { const int w = i >> 10, c = i & 1023; const float* m = (const float*)(F.ws + WS_MOD) + (size_t)(l * 2 + w) * 6144; GC[i] = g[c] * (1.f + m[sc_off + c]); SH[i] = m[sh_off + c]; }
    __syncthreads();
}
__device__ __forceinline__ void hprep_rows(Frame& F, int l) {
    bf16* H = (bf16*)HBUF(F); LAS float* GC = (LAS float*)F.lds; LAS float* SH = GC + 2048;
    stage_mod_granules(F, IN_(I_GMIX) + l * D, GC, SH);
    const int gw = F.bid * (NT / 64) + F.wave, ngw = F.G * (NT / 64);
    for (int row = gw; row < MT; row += ngw) {
        const float* xr = xin_row(F, row); const int pv = row >= SEQ ? 1024 : 0;
        f32x4 v[4]; float s = 0.f;
#pragma unroll
        for (int j = 0; j < 4; ++j) { v[j] = *(const f32x4*)(xr + 4 * F.lane + 256 * j); s += v[j].x * v[j].x + v[j].y * v[j].y + v[j].z * v[j].z + v[j].w * v[j].w; }
        const float rstd = rsqrtf(wave_sum(s, F.lane) * (1.f / D) + EPS);
#pragma unroll
        for (int j = 0; j < 4; ++j) { const int c = 4 * F.lane + 256 * j; const f32x4 gc = *(const LAS f32x4*)(GC + pv + c), sh = *(const LAS f32x4*)(SH + pv + c);
            const f32x4 o = v[j] * rstd * gc + sh; v2u w; w.x = pk2(o.x, o.y); w.y = pk2(o.z, o.w); *(v2u*)(H + (size_t)row * D + c) = w; }
    }
}
__device__ __forceinline__ void ph3_conv(Frame& F, int l, int nrows) {
    const bf16* PROJ = (const bf16*)(F.ws + WS_PROJ); bf16* YC = (bf16*)(F.ws + WS_YS) + (size_t)2 * MT * MIXW; const float* wc = IN_(I_WCONV) + l * 3 * MIXW;
    const size_t gt = (size_t)F.bid * NT + F.tid, ngt = (size_t)F.G * NT;
#pragma unroll 2
    for (size_t i = gt; i < (size_t)nrows * (MIXW / 8); i += ngt) {
        const int row = (int)(i / (MIXW / 8)), c = (int)(i % (MIXW / 8)) * 8;
        int pos, rl; if (row < SEQ) { pos = row & 63; rl = 64; } else { pos = row - SEQ; rl = 256; }
        const bf16* r0 = PROJ + (size_t)row * INW + 1536 + c;
        const v4u zero = {0u, 0u, 0u, 0u};
        const v4u b0 = *(const v4u*)(r0), c0 = *(const v4u*)(r0 + 512), h0 = *(const v4u*)(r0 + 1024);
        const v4u cm = pos > 0 ? *(const v4u*)(r0 - INW + 512) : zero, hm = pos > 0 ? *(const v4u*)(r0 - INW + 1024) : zero;
        const v4u cp = pos < rl - 1 ? *(const v4u*)(r0 + INW + 512) : zero, hp = pos < rl - 1 ? *(const v4u*)(r0 + INW + 1024) : zero;
        const f32x4 w0a = *(const f32x4*)(wc + c), w0b = *(const f32x4*)(wc + c + 4), w1a = *(const f32x4*)(wc + 512 + c), w1b = *(const f32x4*)(wc + 512 + c + 4), w2a = *(const f32x4*)(wc + 1024 + c), w2b = *(const f32x4*)(wc + 1024 + c + 4);
        const float w0[8] = {w0a.x, w0a.y, w0a.z, w0a.w, w0b.x, w0b.y, w0b.z, w0b.w}, w1[8] = {w1a.x, w1a.y, w1a.z, w1a.w, w1b.x, w1b.y, w1b.z, w1b.w}, w2[8] = {w2a.x, w2a.y, w2a.z, w2a.w, w2b.x, w2b.y, w2b.z, w2b.w};
        const unsigned bb[4] = {b0.x, b0.y, b0.z, b0.w}, cc[4] = {c0.x, c0.y, c0.z, c0.w}, hh[4] = {h0.x, h0.y, h0.z, h0.w}, cmv[4] = {cm.x, cm.y, cm.z, cm.w}, hmv[4] = {hm.x, hm.y, hm.z, hm.w}, cpv[4] = {cp.x, cp.y, cp.z, cp.w}, hpv[4] = {hp.x, hp.y, hp.z, hp.w};
        unsigned o[4];
#pragma unroll
        for (int j = 0; j < 4; ++j) {
            const float ylo = bflo(bb[j]) * (w0[2 * j] * (bflo(cmv[j]) * bflo(hmv[j])) + w1[2 * j] * (bflo(cc[j]) * bflo(hh[j])) + w2[2 * j] * (bflo(cpv[j]) * bflo(hpv[j])));
            const float yhi = bfhi(bb[j]) * (w0[2 * j + 1] * (bfhi(cmv[j]) * bfhi(hmv[j])) + w1[2 * j + 1] * (bfhi(cc[j]) * bfhi(hh[j])) + w2[2 * j + 1] * (bfhi(cpv[j]) * bfhi(hpv[j])));
            o[j] = pk2(ylo, yhi); }
        v4u ov; ov.x = o[0]; ov.y = o[1]; ov.z = o[2]; ov.w = o[3]; *(v4u*)(YC + (size_t)row * MIXW + c) = ov;
    }
}
template <int KS, bool LDSW>
__device__ __forceinline__ void route_pass(Frame& F, int l, int u, bool valid, int kh, int sl, LAS float* GC, LAS float* SH, LAS float* SSQ, LAS float* LG, LAS int* HISTL) {
    bf16* H = (bf16*)HBUF(F); const bf16* WRh = (const bf16*)(F.ws + WS_WR); const bf16* WRl = WRh + 48 * 1024;
    const float* bg = IN_(I_BGRP) + l * 4; const float* be = IN_(I_BEXP) + l * 32;
    int* EID = (int*)(F.ws + WS_EID); float* EW = (float*)(F.ws + WS_EW);
    constexpr int NK = 32 / KS, KW = 1024 / KS;
    const int r = F.lane & 15, q = F.lane >> 4;
    const int uu = valid ? u : 0; const int row = uu * 16 + r; const int pv = (row >= SEQ ? 1024 : 0) + kh * KW + 8 * q;
    const float* xr = (const float*)(F.ws + WS_XC) + (size_t)(KS == 2 ? 0 : row - SEQ) * D + kh * KW + 8 * q;
    const bf16* xr16 = (const bf16*)(F.ws + WS_X16) + (size_t)(KS == 2 ? row : 0) * D + kh * KW + 8 * q;
    const f32x4 rp = *(const f32x4*)((const float*)(F.ws + WS_RSS) + (size_t)row * 16 + 4 * q);
    float tot = (rp.x + rp.y) + (rp.z + rp.w); tot += shflx(tot, 16, F.lane); tot += shflx(tot, 32, F.lane);
    const float rstd = rsqrtf(tot * (1.f / D) + EPS);
    __syncthreads();
    (void)SSQ;
    f32x4 acc[3] = {{0.f, 0.f, 0.f, 0.f}, {0.f, 0.f, 0.f, 0.f}, {0.f, 0.f, 0.f, 0.f}};
    LAS unsigned char* WB = F.lds + 45056;
    v4u stg[6];
    if constexpr (LDSW) {
#pragma unroll
        for (int i = 0; i < 6; ++i) { const int pid = F.tid + NT * i, ln = pid & 63, rest = pid >> 6, ks = rest & 3, cb = (rest >> 2) % 3, hl = (rest / 12) & 1, khh = rest / 24;
            stg[i] = *(const v4u*)((hl ? WRl : WRh) + (size_t)(cb * 16 + (ln & 15)) * 1024 + khh * 512 + 32 * ks + 8 * (ln >> 4)); }
    }
    v4u xall[KS == 2 ? 16 : 1];
    if constexpr (KS == 2) {
#pragma unroll
        for (int j = 0; j < 16; ++j) xall[j] = *(const v4u*)(xr16 + 32 * j); }
#pragma unroll
    for (int k0 = 0; k0 < NK; k0 += 4) {
        f32x4 xa[4][2]; bf16x8 Bh[4][3], Bl[4][3];
        if constexpr (LDSW) {
            __syncthreads();
#pragma unroll
            for (int i = 0; i < 6; ++i) *(LAS v4u*)(WB + (F.tid + NT * i) * 16) = stg[i];
            __syncthreads();
            if (k0 + 4 < NK) {
#pragma unroll
                for (int i = 0; i < 6; ++i) { const int pid = F.tid + NT * i, ln = pid & 63, rest = pid >> 6, ks = rest & 3, cb = (rest >> 2) % 3, hl = (rest / 12) & 1, khh = rest / 24;
                    stg[i] = *(const v4u*)((hl ? WRl : WRh) + (size_t)(cb * 16 + (ln & 15)) * 1024 + khh * 512 + 32 * (k0 + 4 + ks) + 8 * (ln >> 4)); } }
        }
#pragma unroll
        for (int j = 0; j < 4; ++j) { const int c = 32 * (k0 + j);
            if constexpr (KS == 2) { xa[j][0] = __builtin_bit_cast(f32x4, xall[k0 + j]); } else { xa[j][0] = *(const f32x4*)(xr + c); xa[j][1] = *(const f32x4*)(xr + c + 4); }
#pragma unroll
            for (int cb = 0; cb < 3; ++cb) {
                if constexpr (!LDSW) { const size_t wo = (size_t)(cb * 16 + r) * 1024 + kh * KW + c + 8 * q; Bh[j][cb] = *(const bf16x8*)(WRh + wo); Bl[j][cb] = *(const bf16x8*)(WRl + wo); } } }
#pragma unroll
        for (int j = 0; j < 4; ++j) { const int c = 32 * (k0 + j);
            const f32x4 g0 = *(const LAS f32x4*)(GC + pv + c), g1 = *(const LAS f32x4*)(GC + pv + c + 4), sh0 = *(const LAS f32x4*)(SH + pv + c), sh1 = *(const LAS f32x4*)(SH + pv + c + 4);
            if constexpr (KS == 2) { const v4u w = __builtin_bit_cast(v4u, xa[j][0]); xa[j][0] = (f32x4){bflo(w.x), bfhi(w.x), bflo(w.y), bfhi(w.y)}; xa[j][1] = (f32x4){bflo(w.z), bfhi(w.z), bflo(w.w), bfhi(w.w)}; }
            const f32x4 h0 = xa[j][0] * rstd * g0 + sh0, h1 = xa[j][1] * rstd * g1 + sh1;
            v4u hi; hi.x = pk2(h0.x, h0.y); hi.y = pk2(h0.z, h0.w); hi.z = pk2(h1.x, h1.y); hi.w = pk2(h1.z, h1.w);
            if (valid) *(v4u*)(H + (size_t)row * D + kh * KW + 8 * q + c) = hi;
            v4u lo; lo.x = pk2(h0.x - bflo(hi.x), h0.y - bfhi(hi.x)); lo.y = pk2(h0.z - bflo(hi.y), h0.w - bfhi(hi.y)); lo.z = pk2(h1.x - bflo(hi.z), h1.y - bfhi(hi.z)); lo.w = pk2(h1.z - bflo(hi.w), h1.w - bfhi(hi.w));
            const bf16x8 Ah = __builtin_bit_cast(bf16x8, hi), Al = __builtin_bit_cast(bf16x8, lo);
#pragma unroll
            for (int cb = 0; cb < 3; ++cb) {
                bf16x8 bh, bl;
                if constexpr (LDSW) { bh = *(const LAS bf16x8*)(WB + ((kh * 24 + cb * 4 + j) * 64 + F.lane) * 16); bl = *(const LAS bf16x8*)(WB + ((kh * 24 + 12 + cb * 4 + j) * 64 + F.lane) * 16); }
                else { bh = Bh[j][cb]; bl = Bl[j][cb]; }
                acc[cb] = __builtin_amdgcn_mfma_f32_16x16x32_bf16(Ah, bh, acc[cb], 0, 0, 0); acc[cb] = __builtin_amdgcn_mfma_f32_16x16x32_bf16(Al, bh, acc[cb], 0, 0, 0); acc[cb] = __builtin_amdgcn_mfma_f32_16x16x32_bf16(Ah, bl, acc[cb], 0, 0, 0); } }
    }
    LAS float* LGw = LG + (sl * KS + kh) * (16 * 52);
#pragma unroll
    for (int cb = 0; cb < 3; ++cb)
#pragma unroll
        for (int i = 0; i < 4; ++i) LGw[(4 * q + i) * 52 + cb * 16 + r] = acc[cb][i];
    __syncthreads();
    if (kh == 0 && valid && F.lane < 16) { const LAS float* L0 = LG + (sl * KS) * (16 * 52) + F.lane * 52; const int rw = u * 16 + F.lane;
        float lg[36];
#pragma unroll
        for (int o = 0; o < 36; ++o) { float t = 0.f;
#pragma unroll
            for (int i = 0; i < KS; ++i) t += L0[i * (16 * 52) + o]; lg[o] = t + (o < 4 ? bg[o] : be[o - 4]); }
        LAS float* LW = LG + (sl * KS) * (16 * 52) + F.lane * 52;
#pragma unroll
        for (int o = 0; o < 36; ++o) LW[o] = lg[o];
        int gi = 0; float gm = lg[0];
#pragma unroll
        for (int o = 1; o < 4; ++o) if (lg[o] > gm) { gm = lg[o]; gi = o; }
        float den = 0.f;
#pragma unroll
        for (int o = 0; o < 4; ++o) den += expf(lg[o] - gm);
        const float gp = 1.f / den;
        const LAS float* el = LW + 4 + gi * 8;
        int i1 = 0; float m1 = el[0]; for (int o = 1; o < 8; ++o) { const float v = el[o]; if (v > m1) { m1 = v; i1 = o; } }
        int i2 = -1; float m2 = 0.f; for (int o = 0; o < 8; ++o) { const float v = el[o]; if (o != i1 && (i2 < 0 || v > m2)) { m2 = v; i2 = o; } }
        const float e2 = expf(m2 - m1); const float w1 = 1.f / (1.f + e2), w2 = e2 / (1.f + e2);
        const int e1i = gi * 8 + i1, e2i = gi * 8 + i2;
        EID[rw * 2] = e1i; EID[rw * 2 + 1] = e2i; EW[rw * 2] = gp * w1; EW[rw * 2 + 1] = gp * w2;
        __hip_atomic_fetch_add(&HISTL[e1i], 1, __ATOMIC_RELAXED, __HIP_MEMORY_SCOPE_WORKGROUP); __hip_atomic_fetch_add(&HISTL[e2i], 1, __ATOMIC_RELAXED, __HIP_MEMORY_SCOPE_WORKGROUP);
    }
}
__device__ __forceinline__ void ph10_route(Frame& F, int l) {
    const float* g = IN_(I_GFFN) + l * D;
    LAS float* GC = (LAS float*)F.lds;
    LAS float* SH = GC + 2048;
    LAS float* SSQ = SH + 2048;
    LAS float* LG = SSQ + 128;
    LAS int* HISTL = (LAS int*)(LG + 8 * 16 * 52);
    __syncthreads();
    if (F.tid < 32) HISTL[F.tid] = 0;
    for (int i = F.tid; i < 2048; i += NT) { const int w = i >> 10, c = i & 1023; const float* m = (const float*)(F.ws + WS_MOD) + (size_t)(l * 2 + w) * 6144; GC[i] = g[c] * (1.f + m[4096 + c]); SH[i] = m[3072 + c]; }
#pragma unroll 1
    for (int u0 = F.bid; u0 < SEQ / 16; u0 += 4 * F.G) { const int u = u0 + (F.wave >> 1) * F.G; route_pass<2, true>(F, l, u, u < SEQ / 16, F.wave & 1, F.wave >> 1, GC, SH, SSQ, LG, HISTL); }
    if (l == 0) {
#pragma unroll 1
        for (int u0 = SEQ / 16 + F.bid; u0 < MT / 16; u0 += F.G) { ctx_x1_fixup(F, l, (u0 - SEQ / 16) * 16); route_pass<8, false>(F, l, u0, true, F.wave, 0, GC, SH, SSQ, LG, HISTL); }
    }
    __syncthreads();
    if (F.tid < 32) __hip_atomic_store((unsigned long long*)(F.ws + WS_HG) + F.bid * 32 + F.tid, ((unsigned long long)((unsigned)l + 1u) << 32) | (unsigned)HISTL[F.tid], __ATOMIC_RELAXED, __HIP_MEMORY_SCOPE_AGENT);
}
__device__ __forceinline__ void ph11_scatter(Frame& F, int l) {
    const bf16* H = (const bf16*)HBUF(F); bf16* HS = (bf16*)(F.ws + WS_HS);
    const int* EID = (const int*)(F.ws + WS_EID); const float* EW = (const float*)(F.ws + WS_EW); int* STOK = (int*)(F.ws + WS_STOK); float* SW = (float*)(F.ws + WS_SW); int* TSLOT = (int*)(F.ws + WS_TSLOT);
    unsigned* cnt = F.ctl + CW_CNT + l * 128; unsigned long long* HG = (unsigned long long*)(F.ws + WS_HG); const unsigned tag = (unsigned)l + 1u;
    LAS int* HIST = (LAS int*)F.lds; LAS int* BASE = HIST + 32; LAS int* ISLOT = BASE + 32; LAS int* IROW = ISLOT + 512; LAS int* PT = IROW + 512; LAS int* PB = PT + 512;
    const int nunits = (l == 0 ? MT : SEQ) / 16;
    __syncthreads();
    { const int e = F.tid & 31, ch = F.tid >> 5; int tot = 0, bas = 0;
      for (int b0 = ch; b0 < F.G; b0 += 256) {
          unsigned long long xs[16]; unsigned spins = 0;
          for (;;) { bool ok = true;
#pragma unroll
              for (int i = 0; i < 16; ++i) { const int b = b0 + 16 * i; xs[i] = b < F.G ? __hip_atomic_load(HG + b * 32 + e, __ATOMIC_RELAXED, __HIP_MEMORY_SCOPE_AGENT) : ((unsigned long long)tag << 32); }
#pragma unroll
              for (int i = 0; i < 16; ++i) ok = ok && (unsigned)(xs[i] >> 32) == tag;
              if (ok) break; __builtin_amdgcn_s_sleep(2); if (++spins > (1u << 22)) break; }
#pragma unroll
          for (int i = 0; i < 16; ++i) { const int b = b0 + 16 * i; const int h = (int)(unsigned)xs[i]; tot += h; if (b < F.bid) bas += h; } }
      PT[F.tid] = tot; PB[F.tid] = bas; }
    __syncthreads();
    if (F.tid < 32) { int tot = 0, bas = 0; for (int ch = 0; ch < 16; ++ch) { tot += PT[ch * 32 + F.tid]; bas += PB[ch * 32 + F.tid]; } HIST[F.tid] = 0; PT[F.tid] = tot; PB[F.tid] = bas; if (F.bid == 0) cnt[F.tid] = (unsigned)tot; }
    __syncthreads();
    if (F.tid < 32) { int off = 0; for (int i = 0; i < F.tid; ++i) off += (PT[i] + 255) & ~255; BASE[F.tid] = off + PB[F.tid]; }
    __syncthreads();
    const int w = F.tid >> 5; int u = F.bid + w * F.G; bool valid = u < SEQ / 16;
    if (w == 15) { u = SEQ / 16 + F.bid; valid = u < nunits; }
    const int row = u * 16 + ((F.tid >> 1) & 15), kk = F.tid & 1;
    int e = 0, rank = 0; if (valid) { e = EID[row * 2 + kk]; rank = __hip_atomic_fetch_add(&HIST[e], 1, __ATOMIC_RELAXED, __HIP_MEMORY_SCOPE_WORKGROUP); }
    __syncthreads();
    int slot = -1; if (valid) { slot = BASE[e] + rank; STOK[slot] = row; SW[slot] = EW[row * 2 + kk]; TSLOT[row * 2 + kk] = slot; }
    (void)H; (void)HS; (void)ISLOT; (void)IROW;
    for (int e = F.bid; e < NE; e += F.G) { const int start = BASE[e] - PB[e], n = PT[e], seg = (n + 255) & ~255; for (int i = n + F.tid; i < seg; i += NT) STOK[start + i] = 0; }
}
template <bool CX>
__device__ __forceinline__ void combine_rows(Frame& F, int l, const LAS float* GC, const LAS float* SH, const LAS float* GA) {
    const bf16* YS2 = (const bf16*)(F.ws + WS_YS2); const int* TSLOT = (const int*)(F.ws + WS_TSLOT) + (CX ? 2 * SEQ : 0); bf16* H = (bf16*)HBUF(F) + (CX ? (size_t)SEQ * D : 0);
    bf16* X16 = (bf16*)(F.ws + WS_X16); float* XC = (float*)(F.ws + WS_XC); float* out = F.out;
    const int gw = F.bid * (NT / 64) + F.wave, ngw = F.G * (NT / 64);
    constexpr int nrows = CX ? CTX : SEQ, pv = CX ? 1024 : 0;
    int sln[2][2] = {{0, 0}, {0, 0}};
    if (gw < nrows) {
#pragma unroll
        for (int t = 0; t < 2; ++t) { const int r = gw + t * ngw < nrows ? gw + t * ngw : gw; sln[t][0] = TSLOT[r * 2]; sln[t][1] = TSLOT[r * 2 + 1]; } }
    for (int row0 = gw; row0 < nrows; row0 += 2 * ngw) {
        int rows[2]; bool ok[2];
#pragma unroll
        for (int t = 0; t < 2; ++t) { rows[t] = row0 + t * ngw; ok[t] = rows[t] < nrows; if (!ok[t]) rows[t] = row0; }
        int sl[2][2];
#pragma unroll
        for (int t = 0; t < 2; ++t) { sl[t][0] = sln[t][0]; sl[t][1] = sln[t][1]; }
        { const int n0 = row0 + 2 * ngw; if (n0 < nrows) {
#pragma unroll
            for (int t = 0; t < 2; ++t) { const int r = n0 + t * ngw < nrows ? n0 + t * ngw : n0; sln[t][0] = TSLOT[r * 2]; sln[t][1] = TSLOT[r * 2 + 1]; } } }
        v4u ya[2][2], yb[2][2], xb[2][2]; f32x4 xf[2][2][2];
#pragma unroll
        for (int t = 0; t < 2; ++t)
#pragma unroll
            for (int j = 0; j < 2; ++j) { const int c = 8 * F.lane + 512 * j;
                if constexpr (CX) { xf[t][j][0] = *(const f32x4*)(XC + (size_t)rows[t] * D + c); xf[t][j][1] = *(const f32x4*)(XC + (size_t)rows[t] * D + c + 4); }
                else xb[t][j] = *(const v4u*)(X16 + (size_t)rows[t] * D + c);
                ya[t][j] = *(const v4u*)(YS2 + (size_t)sl[t][0] * D + c); yb[t][j] = *(const v4u*)(YS2 + (size_t)sl[t][1] * D + c); }
        f32x4 v[2][2][2]; float s[2] = {0.f, 0.f};
#pragma unroll
        for (int t = 0; t < 2; ++t)
#pragma unroll
            for (int j = 0; j < 2; ++j) { const int c = 8 * F.lane + 512 * j; const v4u a = ya[t][j], b = yb[t][j];
                if constexpr (!CX) { const v4u w = xb[t][j]; xf[t][j][0] = (f32x4){bflo(w.x), bfhi(w.x), bflo(w.y), bfhi(w.y)}; xf[t][j][1] = (f32x4){bflo(w.z), bfhi(w.z), bflo(w.w), bfhi(w.w)}; }
                const f32x4 y0 = {bflo(a.x) + bflo(b.x), bfhi(a.x) + bfhi(b.x), bflo(a.y) + bflo(b.y), bfhi(a.y) + bfhi(b.y)}, y1 = {bflo(a.z) + bflo(b.z), bfhi(a.z) + bfhi(b.z), bflo(a.w) + bflo(b.w), bfhi(a.w) + bfhi(b.w)};
                const f32x4 o0 = xf[t][j][0] + *(const LAS f32x4*)(GA + pv + c) * y0, o1 = xf[t][j][1] + *(const LAS f32x4*)(GA + pv + c + 4) * y1; v[t][j][0] = o0; v[t][j][1] = o1;
                s[t] += (o0.x * o0.x + o0.y * o0.y + o0.z * o0.z + o0.w * o0.w) + (o1.x * o1.x + o1.y * o1.y + o1.z * o1.z + o1.w * o1.w); }
#pragma unroll
        for (int t = 0; t < 2; ++t) { if (!ok[t]) continue;
            const float rstd = rsqrtf(wave_sum(s[t], F.lane) * (1.f / D) + EPS); const size_t ro = (size_t)rows[t] * D;
            if (l == 0) {
#pragma unroll
                for (int j = 0; j < 2; ++j) { const int c = 8 * F.lane + 512 * j; const f32x4 o0 = v[t][j][0], o1 = v[t][j][1];
                    if constexpr (CX) { *(f32x4*)(XC + ro + c) = o0; *(f32x4*)(XC + ro + c + 4) = o1; }
                    else { v4u w; w.x = pk2(o0.x, o0.y); w.y = pk2(o0.z, o0.w); w.z = pk2(o1.x, o1.y); w.w = pk2(o1.z, o1.w); *(v4u*)(X16 + ro + c) = w; }
                    const f32x4 h0 = o0 * rstd * *(const LAS f32x4*)(GC + pv + c) + *(const LAS f32x4*)(SH + pv + c), h1 = o1 * rstd * *(const LAS f32x4*)(GC + pv + c + 4) + *(const LAS f32x4*)(SH + pv + c + 4);
                    v4u hw; hw.x = pk2(h0.x, h0.y); hw.y = pk2(h0.z, h0.w); hw.z = pk2(h1.x, h1.y); hw.w = pk2(h1.z, h1.w); *(v4u*)(H + ro + c) = hw; }
            } else if constexpr (!CX) {
#pragma unroll
                for (int j = 0; j < 2; ++j) { const int c = 8 * F.lane + 512 * j; f32x4 o0 = v[t][j][0] * rstd * *(const LAS f32x4*)(GC + c), o1 = v[t][j][1] * rstd * *(const LAS f32x4*)(GC + c + 4);
                    if (PROBE_B >= 0 && rows[t] < 3906 && F.bid >= PROBE_LO && F.bid < PROBE_HI) { volatile LAS unsigned long long* TS = (volatile LAS unsigned long long*)(F.lds + TS_OFF); const float dd = 0.1f + 0.00001f * (float)(TS[PROBE_B1] - TS[PROBE_B]); o0 = o0 + dd; o1 = o1 + dd; }
                    if (PROBE_A == 98 && rows[t] == 0 && j == 0 && F.lane == 0) { const unsigned w = __hip_atomic_load(F.ctl + 100, __ATOMIC_RELAXED, __HIP_MEMORY_SCOPE_AGENT); o0.x += 1.f + 0.001f * (float)w; }
                    else if (PROBE_A == 99 && rows[t] == 0 && j == 0 && F.lane == 0) { const unsigned w = __hip_atomic_load(F.ctl + 100, __ATOMIC_RELAXED, __HIP_MEMORY_SCOPE_AGENT); o0.x += PROBE_AROW ? 1.f + 0.01f * (float)(w & 255u) : 1.f + 0.001f * (float)(w >> 8); }
                    else if (PROBE_A >= 0 && rows[t] == PROBE_AROW && j == 0 && F.lane == 0) { volatile LAS unsigned long long* TS = (volatile LAS unsigned long long*)(F.lds + TS_OFF); o0.x += 1.f + 0.001f * (float)(TS[PROBE_A1] - TS[PROBE_A]); }
                    *(f32x4*)(out + ro + c) = o0; *(f32x4*)(out + ro + c + 4) = o1; }
            }
        }
    }
}
__device__ __forceinline__ void ph14_combine(Frame& F, int l) {
    LAS float* GC = (LAS float*)F.lds; LAS float* SH = GC + 2048; LAS float* GA = SH + 2048;
    if (l == 0) stage_mod(F, IN_(I_GMIX) + D, 1, 0, 1024, GC, SH); else { __syncthreads(); for (int i = F.tid; i < 1024; i += NT) GC[i] = IN_(I_GF)[i]; }
    for (int i = F.tid; i < 2048; i += NT) GA[i] = ((const float*)(F.ws + WS_MOD))[(size_t)(l * 2 + (i >> 10)) * 6144 + 5120 + (i & 1023)];
    __syncthreads();
    combine_rows<false>(F, l, GC, SH, GA);
    if (l == 0) combine_rows<true>(F, l, GC, SH, GA);
}

constexpr int NPH = 1 + 8 * 2;
__device__ __forceinline__ Frame make_frame(LAS unsigned char* lds, int wave0) {
    Frame F; F.lds = lds; F.wave = wave0; F.lane = (int)__builtin_amdgcn_mbcnt_hi(~0u, __builtin_amdgcn_mbcnt_lo(~0u, 0u)); asm volatile("" : "+v"(F.lane)); F.tid = F.wave * 64 + F.lane; F.bid = blockIdx.x; F.G = gridDim.x; asm volatile("" : "+s"(F.G), "+s"(F.bid));
    F.tab = (const unsigned long long LAS*)(lds + TAB_OFF);
    volatile LAS unsigned long long* t = (volatile LAS unsigned long long*)(lds + TAB_OFF);
    F.ws = (unsigned char*)(GAS unsigned char*)uni64(t[35]); F.out = (float*)(GAS float*)uni64(t[36]); F.ctl = (unsigned*)(F.ws + WS_CTL);
    return F;
}
__global__ void __launch_bounds__(NT, 2) mega_fwd(Args args) {
    extern __shared__ __attribute__((aligned(16))) unsigned char lds_raw[];
    LAS unsigned char* const lds = (LAS unsigned char*)lds_raw;
    const int wave0 = __builtin_amdgcn_readfirstlane((int)threadIdx.x >> 6);
    for (int u = threadIdx.x; u < 1024 / 4; u += NT) ((LAS unsigned*)(lds + 131072))[u] = 0u;
    if (threadIdx.x == 0) { LAS unsigned long long* t = (LAS unsigned long long*)(lds + TAB_OFF);
#pragma unroll
        for (int i = 0; i < 35; ++i) t[i] = (unsigned long long)args.in[i];
        t[35] = (unsigned long long)args.ws; t[36] = (unsigned long long)args.out; }
    __syncthreads();
    { Frame F = make_frame(lds, wave0); (void)xcd_barrier_post(F.ctl + CW_BAR, (volatile LAS unsigned*)(lds + MISC_OFF) + 8); }
    if ((PROBE_A >= 0 || PROBE_B >= 0) && threadIdx.x == 0) ((volatile LAS unsigned long long*)(lds + TS_OFF))[0] = __builtin_amdgcn_s_memrealtime();
    const int lo = args.ph_lo, hi = args.ph_hi; int ph = 0;
#define GRIDBAR() do { Frame Fb = make_frame(lds, wave0); XcdBarrier bar; bar.bar = Fb.ctl + CW_BAR; bar.x = xb_xcc_id(); bar.st = (volatile LAS unsigned*)(lds + MISC_OFF) + 8; xcd_barrier(bar, Fb.tid == 0); } while (0)
#ifndef REPBAR
#define REPBAR 0
#endif
#ifndef REPMASK
#define REPMASK 0
#endif
#define PHASE(...) do { if (lo <= ph && ph < hi) { const int _pl = ph < 1 ? ph : 1 + (ph - 1) % 8; for (int _rep = 0; _rep <= ((REPMASK >> _pl) & 1); ++_rep) { Frame F = make_frame(lds, wave0); __VA_ARGS__; } if ((PROBE_A >= 0 || PROBE_B >= 0) && threadIdx.x == 0) { volatile LAS unsigned long long* TS_ = (volatile LAS unsigned long long*)(lds + TS_OFF); TS_[32 + ph] = __builtin_amdgcn_s_memrealtime(); if (PROBE_A == 98 && ph == PROBE_PH) { Frame Fp = make_frame(lds, wave0); __hip_atomic_fetch_max(Fp.ctl + 100, (unsigned)(TS_[32 + ph] - TS_[ph]), __ATOMIC_RELAXED, __HIP_MEMORY_SCOPE_AGENT); } } if (ph + 1 < hi) { GRIDBAR(); if (REPBAR) GRIDBAR(); } if ((PROBE_A >= 0 || PROBE_B >= 0) && threadIdx.x == 0) ((volatile LAS unsigned long long*)(lds + TS_OFF))[1 + ph] = __builtin_amdgcn_s_memrealtime(); } ++ph; } while (0)
    PHASE({ ph0_prologue(F); s5_precompute(F); __syncthreads(); convert_weights(F, 0, 0, F.G > 128 ? F.G - 64 : F.G, 0, CONV_NITEMS, true); { const f32x4* s = (const f32x4*)IN_(I_CTX); f32x4* d = (f32x4*)(F.ws + WS_XC); for (int i = F.bid * NT + F.tid; i < CTX * D / 4; i += F.G * NT) d[i] = s[i]; }  hprep_rows(F, 0); });
#pragma unroll 1
    for (int l = 0; l < 2; ++l) {
        PHASE({ ph2_fast(F, l); ph2_ctx(F, l == 0 ? INW : MIXW); });
        PHASE({ s5_fused_phase(F, l); for (int it = F.bid; it < 2 * (SEQ / 128); it += F.G) sg_fast_item(F, l, (it & 7) + 8 * (it >> 4), (it >> 3) & 1);        ph3_conv(F, l, l == 0 ? MT : SEQ); });
        PHASE({ ph6_fast(F, l); if (l == 0 && F.bid >= F.G - 4) { const int it = F.bid - (F.G - 4); sg_fast_item(F, 0, SEQ / 128 + (it >> 1), it & 1); }
                if (l == 0 && F.G >= 200) convert_weights(F, 1, 130, F.G - 134, 0, CONV_IN, false); });
        PHASE({ ph7_fast(F, l); if (l == 0) ph7_ctx(F); ph8_fast(F, l); if (l == 0) ph8_ctx(F, l); });
        PHASE({ ph9_fast(F, l); if (l == 0) ph9_ctx(F, l); });
        PHASE({ ph10_route(F, l); ph11_scatter(F, l); });
        PHASE(ph12_moe(F, l));
        PHASE({ ph14_combine(F, l); if (l == 0) { __syncthreads(); convert_weights(F, 1, 0, F.G, F.G >= 200 ? CONV_IN : 0, CONV_NITEMS, true); } });
    }
#undef PHASE
}

extern "C" void kernel_launch(void* const* d_in, const int* in_sizes, int n_in, void* d_out, int out_size, void* d_ws, size_t ws_size, hipStream_t stream) {
    static int grid = 0;
    if (grid == 0) {
        int dev = 0, cus = 0, per_cu = 0;
        if (n_in != 35 || out_size != SEQ * D || ws_size < WS_END) { fprintf(stderr, "kernel_launch: unexpected shapes (n_in %d out %d ws %zu)\n", n_in, out_size, ws_size); grid = -1; return; }
        if (hipGetDevice(&dev) != hipSuccess || hipDeviceGetAttribute(&cus, hipDeviceAttributeMultiprocessorCount, dev) != hipSuccess) { grid = -1; return; }
        if (hipFuncSetAttribute((const void*)mega_fwd, hipFuncAttributeMaxDynamicSharedMemorySize, LDS_BYTES) != hipSuccess) { fprintf(stderr, "kernel_launch: hipFuncSetAttribute failed\n"); grid = -1; return; }
        if (hipOccupancyMaxActiveBlocksPerMultiprocessor(&per_cu, (const void*)mega_fwd, NT, LDS_BYTES) != hipSuccess || per_cu < 1) { fprintf(stderr, "kernel_launch: occupancy query says %d blocks per CU\n", per_cu); grid = -1; return; }
        grid = cus;
    }
    if (grid < 0) return;
    (void)hipMemsetAsync((char*)d_ws + WS_CTL, 0, CTL_ZERO_BYTES, stream);
    Args a{};
    for (int i = 0; i < 35; ++i) a.in[i] = (const float*)d_in[i];
    a.out = (float*)d_out; a.ws = (unsigned char*)d_ws; a.ph_lo = 0; a.ph_hi = NPH;
    void* kargs[] = {&a};
    hipError_t e = hipLaunchCooperativeKernel((const void*)mega_fwd, dim3(grid), dim3(NT), kargs, LDS_BYTES, stream);
    if (e != hipSuccess) fprintf(stderr, "kernel_launch: cooperative launch failed: %s (grid %d)\n", hipGetErrorString(e), grid);
}
```

```cpp
#include <hip/hip_runtime.h>
#include <stdint.h>
#include <cstdio>

#define GAS __attribute__((address_space(1)))
#define LAS __attribute__((address_space(3)))
typedef unsigned short bf16;
typedef unsigned v4u __attribute__((ext_vector_type(4)));
typedef unsigned v2u __attribute__((ext_vector_type(2)));
typedef float f32x4 __attribute__((ext_vector_type(4)));
typedef short bf16x8 __attribute__((ext_vector_type(8)));

constexpr int D = 1024, SEQ = 16384, CTX = 256, MT = SEQ + CTX;
constexpr int MIXW = 512, INW = 3072, G5 = 32, P5 = 64, H5 = 16;
constexpr int NE = 32, DFF = 256;
constexpr int MAXSLOT = 2 * MT + NE * 256;
constexpr float EPS = 1e-6f;
constexpr int NT = 512;

constexpr size_t MiB = 1u << 20;
constexpr size_t WS_CTL = 0, CTL_ZERO_BYTES = 1 * MiB;
constexpr size_t WS_MOD = 1 * MiB;
constexpr size_t WS_XC = 2 * MiB;
constexpr size_t WS_EID = 3 * MiB;
constexpr size_t WS_EW = WS_EID + (size_t)MT * 8;
constexpr size_t WS_STOK = WS_EW + (size_t)MT * 8;
constexpr size_t WS_SW = WS_STOK + (size_t)MAXSLOT * 4;
constexpr size_t WS_TSLOT = WS_SW + (size_t)MAXSLOT * 4;
constexpr size_t WS_HISTG = WS_TSLOT + (size_t)MT * 8;
constexpr size_t WS_H = 4 * MiB;
constexpr size_t WS_X16 = WS_H;
constexpr size_t WS_PROJ = WS_H + (size_t)MT * 2048;
constexpr size_t WS_YS = WS_PROJ + (size_t)MT * 6144;
constexpr size_t WS_YG = WS_YS + (size_t)3 * MT * 1024;
constexpr size_t WS_PM = WS_YG + (size_t)MT * 1024;
constexpr size_t WS_S5 = WS_PM + (size_t)MT * 2048;
constexpr size_t WS_Z = WS_S5;
constexpr size_t WS_RSS = WS_Z + (size_t)8 * MiB;
constexpr size_t WS_SS = WS_Z + (size_t)1040 * 32 * 256 * 4;
constexpr size_t WS_S5M = WS_SS + (size_t)1040 * 32 * 256 * 2;
constexpr size_t WS_A16 = WS_S5M + (size_t)2 * 32 * 3 * 65536 * 2;
constexpr size_t WS_W = WS_A16 + (size_t)2 * 32 * 2 * 64 * 2 * 4 > WS_S5 + (size_t)2 * MT * 512 * 4 ? WS_A16 + (size_t)2 * 32 * 2 * 64 * 2 * 4 : WS_S5 + (size_t)2 * MT * 512 * 4;
constexpr size_t WS_WIN = WS_W;
constexpr size_t WS_WMG = WS_WIN + (size_t)3072 * 1024 * 2;
constexpr size_t WS_WGLU = WS_WMG + (size_t)3072 * 1024 * 2;
constexpr size_t WS_WBR = WS_WGLU + (size_t)512 * 512 * 2;
constexpr size_t WS_WO = WS_WBR + (size_t)3 * 1024 * 512 * 2;
constexpr size_t WS_W13 = WS_WO + (size_t)1024 * 1024 * 2;
constexpr size_t WS_W2 = WS_W13 + (size_t)32 * 512 * 1024 * 2;
constexpr size_t WS_WSG = WS_W2 + (size_t)32 * 1024 * 256 * 2;
constexpr size_t WS_WR = WS_WSG + (size_t)4 * 128 * 128 * 2;
constexpr size_t WS_END = WS_WR + (size_t)2 * 48 * 1024 * 2;
static_assert(WS_END <= (size_t)377 * MiB, "workspace budget");
constexpr size_t WS_HS = WS_PROJ;
constexpr size_t WS_ACT = WS_YS;
constexpr size_t WS_YS2 = WS_YG;
static_assert(WS_HS + (size_t)MAXSLOT * 2048 <= WS_YS && WS_ACT + (size_t)MAXSLOT * 512 <= WS_YG && WS_YS2 + (size_t)MAXSLOT * 2048 <= WS_W, "moe overlays");
static_assert(WS_HISTG + (size_t)1024 * 32 * 4 <= WS_H, "ws map");
constexpr int CW_CNT = 64;
constexpr int CW_BAR = 4096;
constexpr size_t WS_HG = WS_CTL + 768 * 1024;
constexpr size_t WS_MG = WS_CTL + 64 * 1024;
constexpr size_t WS_GR = WS_CTL + 256 * 1024;
constexpr int CW_UPC = 8192;

#ifndef PROBE_A
#define PROBE_A -1
#endif
#ifndef PROBE_B
#define PROBE_B -1
#endif
#ifndef PROBE_A1
#define PROBE_A1 (PROBE_A + 1)
#endif
#ifndef PROBE_B1
#define PROBE_B1 (PROBE_B + 1)
#endif
#ifndef PROBE_AROW
#define PROBE_AROW 0
#endif
#ifndef PROBE_PH
#define PROBE_PH 0
#endif
#ifndef PROBE_LO
#define PROBE_LO 0
#endif
#ifndef PROBE_HI
#define PROBE_HI 100000
#endif
constexpr int TS_OFF = 131072 + 512;
constexpr int LDS_BYTES = 147456;
constexpr int MISC_OFF = 131072 + 320;
constexpr int TAB_OFF = 131072 + 1024;

__device__ __forceinline__ float bf2f(unsigned short b) { return __builtin_bit_cast(float, ((unsigned)b) << 16); }
__device__ __forceinline__ unsigned f2bf(float f) { unsigned u = __builtin_bit_cast(unsigned, f); return (u + 0x7fffu + ((u >> 16) & 1u)) >> 16; }
__device__ __forceinline__ unsigned pk2(float lo, float hi) { return f2bf(lo) | (f2bf(hi) << 16); }
__device__ __forceinline__ float sigmoidf_(float x) { return __builtin_amdgcn_rcpf(1.f + __expf(-x)); }
__device__ __forceinline__ float siluf_(float x) { return x * __builtin_amdgcn_rcpf(1.f + __expf(-x)); }
__device__ __forceinline__ float geluf_(float x) { const float u = 0.7978845608028654f * (x + 0.044715f * x * x * x); return x * __builtin_amdgcn_rcpf(1.f + __expf(-2.f * u)); }
__device__ __forceinline__ float shflx(float v, int mask, int lane) { return __builtin_bit_cast(float, __builtin_amdgcn_ds_bpermute((lane ^ mask) << 2, __builtin_bit_cast(int, v))); }
__device__ __forceinline__ float wave_sum(float v, int lane) {
#pragma unroll
    for (int o = 1; o < 64; o <<= 1) v += shflx(v, o, lane);
    return v;
}

#define XB_TMO      128
#define XB_XCNT(j)  (256  + 64 * (j))
#define XB_XSUB(j)  (1280 + 64 * (j))
#define XB_XGEN(j)  (2304 + 64 * (j))
#define XB_TOP      3328
#define XB_TOPGEN   3392
#define XCD_BAR_WORDS 3456
#define XB_SPIN_CAP (1u << 24)
__device__ __forceinline__ unsigned xb_ld(unsigned* p)              { return __hip_atomic_load(p, __ATOMIC_RELAXED, __HIP_MEMORY_SCOPE_AGENT); }
__device__ __forceinline__ unsigned xb_add(unsigned* p, unsigned v) { return __hip_atomic_fetch_add(p, v, __ATOMIC_RELAXED, __HIP_MEMORY_SCOPE_AGENT); }
__device__ __forceinline__ unsigned xb_xcc_id() { return (unsigned)__builtin_amdgcn_s_getreg((3 << 11) | 20) & 0xFu; }
#define XB_SPIN(cond, bar) do { unsigned _sp = 0; while (cond) { __builtin_amdgcn_s_sleep(1); \
    if ((++_sp & 255u) == 0u) { if (xb_ld(&(bar)[XB_TMO])) break; if (_sp > XB_SPIN_CAP) { atomicAdd(&(bar)[XB_TMO], 1u); break; } } } } while (0)
struct XcdBarrier { unsigned* bar; unsigned x; volatile LAS unsigned* st; };
__device__ __forceinline__ XcdBarrier xcd_barrier_post(unsigned* bar, volatile LAS unsigned* st) {
    XcdBarrier b; b.bar = bar; b.x = xb_xcc_id(); b.st = st;
    if (threadIdx.x == 0) (void)xb_add(&bar[XB_XCNT(b.x)], 1u);
    return b;
}
__device__ __forceinline__ void xcd_barrier_complete(unsigned* bar, unsigned x, unsigned& nloc, unsigned& nx) {
    const unsigned G = gridDim.x * gridDim.y * gridDim.z;
    unsigned sum, cnt, mine, sp = 0u;
    for (;;) {
        sum = 0u; cnt = 0u; mine = 0u;
#pragma unroll
        for (unsigned j = 0; j < 16; ++j) { const unsigned c = xb_ld(&bar[XB_XCNT(j)]); sum += c; cnt += (c > 0u) ? 1u : 0u; mine = (j == x) ? c : mine; }
        if (sum == G) break;
        __builtin_amdgcn_s_sleep(1);
        if ((++sp & 255u) == 0u) { if (xb_ld(&bar[XB_TMO])) break; if (sp > XB_SPIN_CAP) { atomicAdd(&bar[XB_TMO], 1u); break; } }
    }
    nloc = mine > 0u ? mine : 1u; nx = cnt > 0u ? cnt : 1u;
}
__device__ __forceinline__ void xcd_barrier(const XcdBarrier& b, bool leader) {
    asm volatile("s_waitcnt vmcnt(0)" ::: "memory");
    __syncthreads();
    if (leader) {
        unsigned* bar = b.bar;
        __builtin_amdgcn_s_waitcnt(0);
        unsigned nloc = b.st[0], nx = b.st[1];
        if (nloc == 0u) { xcd_barrier_complete(bar, b.x, nloc, nx); b.st[0] = nloc; b.st[1] = nx; }
        const unsigned old = xb_add(&bar[XB_XSUB(b.x)], 1u);
        const unsigned gen = old / nloc;
        if (old + 1u == (gen + 1u) * nloc) {
            __builtin_amdgcn_fence(__ATOMIC_RELEASE, "agent");
            asm volatile("s_waitcnt vmcnt(0)" ::: "memory");
            const unsigned og = xb_add(&bar[XB_TOP], 1u);
            const unsigned tg = og / nx;
            if (og + 1u == (tg + 1u) * nx) xb_add(&bar[XB_TOPGEN], 1u);
            else XB_SPIN(xb_ld(&bar[XB_TOPGEN]) == tg, bar);
            __builtin_amdgcn_fence(__ATOMIC_ACQUIRE, "agent");
            xb_add(&bar[XB_XGEN(b.x)], 1u);
            asm volatile("s_waitcnt vmcnt(0)" ::: "memory");
        } else {
            XB_SPIN(xb_ld(&bar[XB_XGEN(b.x)]) == gen, bar);
            __builtin_amdgcn_fence(__ATOMIC_ACQUIRE, "agent");
            asm volatile("s_waitcnt vmcnt(0)" ::: "memory");
        }
    }
    __syncthreads();
}

struct Args { const float* in[35]; float* out; unsigned char* ws; int ph_lo, ph_hi; };
struct Frame {
    LAS unsigned char* lds; unsigned char* ws; unsigned* ctl;
    int tid, lane, wave, bid, G;
    const unsigned long long LAS* tab; float* out;
};
__device__ __forceinline__ unsigned long long uni64(unsigned long long v) { const unsigned lo = __builtin_amdgcn_readfirstlane((unsigned)v), hi = __builtin_amdgcn_readfirstlane((unsigned)(v >> 32)); return ((unsigned long long)hi << 32) | lo; }
#define IN_(k) ((const float*)(const GAS float*)uni64(F.tab[k]))
enum { I_X = 0, I_C, I_CTX, I_CCTX, I_WADA, I_BADA, I_GMIX, I_GFFN, I_WIN, I_LRE, I_LIM, I_LDT, I_BRE, I_BIM, I_CRE, I_CIM, I_DSKIP, I_WGLU, I_SGG, I_SGB, I_WSG, I_BSG,
       I_WCONV, I_WBR, I_WMG, I_BMG, I_WO, I_WGRP, I_BGRP, I_WEXP, I_BEXP, I_W1, I_W3, I_W2, I_GF };

__device__ __forceinline__ const float* mod_ptr(const Frame& F, int l, int row) { return (const float*)(F.ws + WS_MOD) + (size_t)(l * 2 + (row >= SEQ ? 1 : 0)) * 6144; }
__device__ __forceinline__ const float* xin_row(const Frame& F, int row) { return row < SEQ ? IN_(I_X) + (size_t)row * D : IN_(I_CTX) + (size_t)(row - SEQ) * D; }
#define HBUF(F) ((unsigned char*)(F).out)


namespace pg8 {
#define PG8_LAS __attribute__((address_space(3)))
typedef unsigned short bf16_t;
typedef short bf16x8 __attribute__((ext_vector_type(8)));
typedef float f32x4 __attribute__((ext_vector_type(4)));
typedef unsigned u32x4 __attribute__((ext_vector_type(4)));
constexpr int BM = 256, BK = 64, HALF = 128, HTB = HALF * BK * 2  , STAGE_BYTES = 8 * HTB, NXCD = 8, WGM = 8;

__host__ __device__ __forceinline__ int lds_byte(int r, int c) { const int st = (r >> 4) * 2 + (c >> 5), rr = r & 15, cc = c & 31, ob = rr * 64 + cc * 2; return st * 1024 + (ob ^ (((ob >> 9) & 1) << 5)); }
__host__ __device__ __forceinline__ void stage_rc(int b, int& R, int& C) { const int st = b / 1024, sb = b % 1024, swz = sb ^ (((sb >> 9) & 1) << 5); R = (st >> 1) * 16 + swz / 64; C = (st & 1) * 32 + (swz % 64) / 2; }
__host__ __device__ __forceinline__ int perm32(int rho) { const int n = rho >> 4, i = rho & 15; return 8 * (i >> 2) + 4 * n + (i & 3); }

struct Unit { int pm, pn; };
struct Gemm { const bf16_t* A; const bf16_t* Bt; int M, N, K; int pad_; const int* rowidx; };

struct StaticOrder {
    int nM, nN, nwg, G, c;
    __host__ __device__ void init(int M, int N, int G_, int c_) { nM = M / BM; nN = N / BM; nwg = nM * nN; G = G_; c = c_; }
    __host__ __device__ bool next(int i, Unit& u) const {
        const long L = (long)i * G + c; if (L >= nwg) return false;
        int wgid = (int)L; { const int q = nwg / NXCD, r = nwg % NXCD, xcd = wgid % NXCD, off = wgid / NXCD; wgid = (xcd < r ? xcd * (q + 1) : r * (q + 1) + (xcd - r) * q) + off; }
        const int nig = WGM * nN, gid = wgid / nig, fm = gid * WGM, gsz = (nM - fm) < WGM ? (nM - fm) : WGM;
        u.pm = fm + ((wgid % nig) % gsz); u.pn = (wgid % nig) / gsz; return true;
    }
    __device__ __forceinline__ unsigned peek(const Unit&) const { return 0u; }
    __device__ __forceinline__ void a_ready(const Unit&, unsigned) const {}
    __device__ __forceinline__ void done(const Unit&) const {}
};
__device__ __forceinline__ unsigned cvt_pk_bf16(float lo, float hi) { unsigned r; asm volatile("v_cvt_pk_bf16_f32 %0, %1, %2" : "=v"(r) : "v"(lo), "v"(hi)); return r; }
template <class Epi, class Sched, bool ALIGN_EPI = false, bool SP2 = false, bool ASC1 = false, bool AGATHER = false>
__device__ __forceinline__ void gemm_phase(PG8_LAS unsigned char* lds, const Gemm g, const Sched& S, const Epi& E, int tid_in) {
    int tid_ = tid_in; asm volatile("" : "+v"(tid_));
    const int tid = tid_, wid = __builtin_amdgcn_readfirstlane(tid >> 6), lane = tid & 63, wr = wid >> 2, wc = wid & 3, fr = lane & 15, fq = lane >> 4;
    const int K = g.K, nt = K / BK;
    unsigned voffA[2], voffB[2];
#pragma unroll
    for (int i = 0; i < 2; ++i) { int R, C; stage_rc(tid * 16 + i * 8192, R, C); const int Rb = Epi::PERM ? ((R & ~31) + perm32(R & 31)) : R;
        voffA[i] = (unsigned)(R * K + C) * 2u; voffB[i] = (unsigned)(Rb * K + C) * 2u; }
    unsigned vgC[2][2], vgN[2][2]; int grow[2], gcol[2];
#pragma unroll
    for (int i = 0; i < 2; ++i) { stage_rc(tid * 16 + i * 8192, grow[i], gcol[i]); vgC[0][i] = vgC[1][i] = vgN[0][i] = vgN[1][i] = 0u; }
#define PG8_GLOAD(dst, unit) do { if constexpr (AGATHER) { _Pragma("unroll") for (int _h = 0; _h < 2; ++_h) _Pragma("unroll") for (int _i = 0; _i < 2; ++_i) \
        dst[_h][_i] = (unsigned)g.rowidx[(unit).pm * BM + _h * HALF + grow[_i]] * (unsigned)(K * 2) + (unsigned)(gcol[_i] * 2); } } while (0)
    const size_t kstep = (size_t)(BK * 2);
    const size_t hstep = (size_t)HALF * K * 2;
    const size_t tstep = 2 * hstep;
    const unsigned ldsw = (unsigned)wid * 1024u;
    const int aoff = lds_byte(wr * 64 + fr, fq * 8), boff = lds_byte(wc * 32 + fr, fq * 8);
#define PG8_SA(b, h) (((b) * 2 + (h)) * HTB)
#define PG8_SB(b, h) ((4 + (b) * 2 + (h)) * HTB)
#define PG8_STAGE_X(bufoff, gbase, voff, aux) do { _Pragma("unroll") for (int _i = 0; _i < 2; ++_i) \
        __builtin_amdgcn_global_load_lds((const unsigned*)((const char*)(gbase) + (voff)[_i]), (PG8_LAS unsigned*)(lds + (bufoff) + ldsw + _i * 8192), 16, 0, aux); } while (0)
#define PG8_STAGE(bufoff, gbase, voff) do { if constexpr (ASC1 && (bufoff) < 4 * HTB) PG8_STAGE_X(bufoff, gbase, voff, 16); else PG8_STAGE_X(bufoff, gbase, voff, 0); } while (0)
#define PG8_STAGE_A(bufoff, uptr, kofs, h, nx) do { if constexpr (AGATHER) { unsigned _vs[2] = {(nx) ? vgN[h][0] : vgC[h][0], (nx) ? vgN[h][1] : vgC[h][1]}; PG8_STAGE(bufoff, (const char*)g.A + (kofs), _vs); } \
        else PG8_STAGE(bufoff, uptr, voffA); } while (0)
#define PG8_LDA(dst, b, h) do { _Pragma("unroll") for (int m = 0; m < 4; ++m) _Pragma("unroll") for (int k = 0; k < 2; ++k) dst[m][k] = *(const PG8_LAS bf16x8*)(lds + PG8_SA(b, h) + aoff + m * 2048 + k * 1024); } while (0)
#define PG8_LDB(dst, b, h) do { _Pragma("unroll") for (int n = 0; n < 2; ++n) _Pragma("unroll") for (int k = 0; k < 2; ++k) dst[n][k] = *(const PG8_LAS bf16x8*)(lds + PG8_SB(b, h) + boff + n * 2048 + k * 1024); } while (0)
#define PG8_MMA(ai, bj, At, Bt) do { __builtin_amdgcn_s_setprio(1); _Pragma("unroll") for (int m = 0; m < 4; ++m) _Pragma("unroll") for (int n = 0; n < 2; ++n) _Pragma("unroll") for (int k = 0; k < 2; ++k) \
        acc[ai][bj][m][n] = __builtin_amdgcn_mfma_f32_16x16x32_bf16(Bt[n][k], At[m][k], acc[ai][bj][m][n], 0, 0, 0); __builtin_amdgcn_s_setprio(0); } while (0)
#define PG8_WAIT_V(n) asm volatile("s_waitcnt vmcnt(" #n ")" ::: "memory")
#define PG8_WAIT_L(n) asm volatile("s_waitcnt lgkmcnt(" #n ")" ::: "memory")
#define PG8_BAR __builtin_amdgcn_s_barrier()
#define PG8_SCHED __builtin_amdgcn_sched_barrier(0)
    Unit cur, nxt; int ui = 0;
    if (!S.next(0, cur)) return;
    f32x4 acc[2][2][4][2];
#pragma unroll
    for (int a = 0; a < 2; ++a)
#pragma unroll
        for (int b = 0; b < 2; ++b)
#pragma unroll
            for (int m = 0; m < 4; ++m)
#pragma unroll
                for (int n = 0; n < 2; ++n) acc[a][b][m][n] = (f32x4){0.f, 0.f, 0.f, 0.f};
    bf16x8 At[4][2], B0[2][2], B1[2][2];
    const char* cA = (const char*)g.A + (size_t)cur.pm * tstep; const char* cB = (const char*)g.Bt + (size_t)cur.pn * tstep;
    PG8_GLOAD(vgC, cur);
    S.a_ready(cur, S.peek(cur));
    static_assert(SP2, "only the SP2 pipeline is kept");
    {
        PG8_STAGE(PG8_SB(0, 0), cB, voffB); PG8_STAGE(PG8_SB(0, 1), cB + hstep, voffB); PG8_STAGE_A(PG8_SA(0, 0), cA, 0, 0, false); PG8_STAGE_A(PG8_SA(0, 1), cA + hstep, 0, 1, false);
        if (wr == 1) PG8_BAR;
        PG8_WAIT_V(2); PG8_BAR;
        PG8_STAGE(PG8_SB(1, 0), cB + kstep, voffB); PG8_STAGE_A(PG8_SA(1, 0), cA + kstep, kstep, 0, false); PG8_STAGE(PG8_SB(1, 1), cB + hstep + kstep, voffB);
        PG8_WAIT_V(6); PG8_BAR;
    }
    for (;;) {
        const bool has_next = S.next(ui + 1, nxt);
        if (has_next) PG8_GLOAD(vgN, nxt); else { if constexpr (AGATHER) { vgN[0][0] = vgC[0][0]; vgN[0][1] = vgC[0][1]; vgN[1][0] = vgC[1][0]; vgN[1][1] = vgC[1][1]; } }
        const unsigned tok = has_next ? S.peek(nxt) : 0u;
        const char* nA = has_next ? (const char*)g.A + (size_t)nxt.pm * tstep : cA; const char* nB = has_next ? (const char*)g.Bt + (size_t)nxt.pn * tstep : cB;
#pragma unroll 1
        for (int t = 0; t < nt; t += 2) {
            const bool last = (t == nt - 2);
            const char* a1 = cA + (size_t)(t + 1) * kstep;
            const char* a2 = last ? nA : cA + (size_t)(t + 2) * kstep; const char* b2 = last ? nB : cB + (size_t)(t + 2) * kstep;
            const char* a3 = a2 + kstep; const char* b3 = b2 + kstep;
            const size_t k1 = (size_t)(t + 1) * kstep, k2 = last ? 0 : (size_t)(t + 2) * kstep, k3 = k2 + kstep;
            if (last && has_next) S.a_ready(nxt, tok);
            {
            PG8_LDB(B0, 0, 0); PG8_LDB(B1, 0, 1); PG8_SCHED; PG8_LDA(At, 0, 0); PG8_STAGE_A(PG8_SA(1, 1), a1 + hstep, k1, 1, false);
            PG8_WAIT_V(8); PG8_WAIT_L(0); PG8_BAR; PG8_MMA(0, 0, At, B0); PG8_MMA(0, 1, At, B1); PG8_BAR; PG8_SCHED;
            PG8_LDA(At, 0, 1); PG8_STAGE(PG8_SB(0, 0), b2, voffB); PG8_STAGE(PG8_SB(0, 1), b2 + hstep, voffB); PG8_STAGE_A(PG8_SA(0, 0), a2, k2, 0, last);
            PG8_WAIT_V(8); PG8_WAIT_L(0); PG8_BAR; PG8_MMA(1, 0, At, B0); PG8_MMA(1, 1, At, B1); PG8_BAR; PG8_SCHED;
            PG8_LDB(B0, 1, 0); PG8_LDB(B1, 1, 1); PG8_SCHED; PG8_LDA(At, 1, 0); PG8_STAGE_A(PG8_SA(0, 1), a2 + hstep, k2, 1, last);
            PG8_WAIT_V(8); PG8_WAIT_L(0); PG8_BAR; PG8_MMA(0, 0, At, B0); PG8_MMA(0, 1, At, B1); PG8_BAR; PG8_SCHED;
            PG8_LDA(At, 1, 1); PG8_STAGE(PG8_SB(1, 0), b3, voffB); PG8_STAGE(PG8_SB(1, 1), b3 + hstep, voffB); PG8_STAGE_A(PG8_SA(1, 0), a3, k3, 0, last);
            PG8_WAIT_V(8); PG8_WAIT_L(0); PG8_BAR; PG8_MMA(1, 0, At, B0); PG8_MMA(1, 1, At, B1); PG8_BAR; PG8_SCHED;
            }
        }
        if constexpr (ALIGN_EPI) { if (wr == 0) PG8_BAR; }
        if constexpr (!Epi::AFTER_DRAIN) { E(acc, cur, wr, wc, fr, fq); S.done(cur); }
        if (!has_next) break;
#pragma unroll
        for (int a = 0; a < 2; ++a)
#pragma unroll
            for (int b = 0; b < 2; ++b)
#pragma unroll
                for (int m = 0; m < 4; ++m)
#pragma unroll
                    for (int n = 0; n < 2; ++n) acc[a][b][m][n] = (f32x4){0.f, 0.f, 0.f, 0.f};
        cur = nxt; cA = nA; cB = nB; ++ui;
        if constexpr (AGATHER) { vgC[0][0] = vgN[0][0]; vgC[0][1] = vgN[0][1]; vgC[1][0] = vgN[1][0]; vgC[1][1] = vgN[1][1]; }
        if constexpr (ALIGN_EPI) { if (wr == 1) PG8_BAR; }
    }
    PG8_WAIT_V(0);
    if constexpr (!ALIGN_EPI) { if (wr == 0) PG8_BAR; }
    PG8_BAR;
    if constexpr (Epi::AFTER_DRAIN) { E.fused(acc, cur, wr, wc, fr, fq, lds, wid, lane); S.done(cur); }
#undef PG8_SA
#undef PG8_SB
#undef PG8_STAGE
#undef PG8_STAGE_X
#undef PG8_LDA
#undef PG8_STAGE_A
#undef PG8_GLOAD
#undef PG8_LDB
#undef PG8_MMA
#undef PG8_WAIT_V
#undef PG8_WAIT_L
#undef PG8_BAR
#undef PG8_SCHED
}
}

constexpr bool PG_ALIGN = true, PG_SP2 = true;
__device__ __forceinline__ float bflo(unsigned w) { return __builtin_bit_cast(float, w << 16); }
__device__ __forceinline__ float bfhi(unsigned w) { return __builtin_bit_cast(float, w & 0xffff0000u); }
__device__ __forceinline__ unsigned cvtpk(float lo, float hi) { return pg8::cvt_pk_bf16(lo, hi); }

__device__ __forceinline__ void transpose_item(const float* W, int N, int k0, int n0, bf16* WT, int K, size_t dst_row0, LAS float* scr, int lane) {
    float v[32];
#pragma unroll
    for (int i = 0; i < 32; ++i) v[i] = W[(size_t)(k0 + 2 * i + (lane >> 5)) * N + n0 + (lane & 31)];
#pragma unroll
    for (int i = 0; i < 32; ++i) scr[(2 * i + (lane >> 5)) * 33 + (lane & 31)] = v[i];
    asm volatile("s_waitcnt lgkmcnt(0)" ::: "memory");
    const int c = lane & 7;
#pragma unroll
    for (int j = 0; j < 4; ++j) { const int n = (lane >> 3) + 8 * j; const LAS float* s = scr + (8 * c) * 33 + n;
        v4u o; o.x = pk2(s[0 * 33], s[1 * 33]); o.y = pk2(s[2 * 33], s[3 * 33]); o.z = pk2(s[4 * 33], s[5 * 33]); o.w = pk2(s[6 * 33], s[7 * 33]);
        *(v4u*)(WT + (dst_row0 + n) * K + k0 + 8 * c) = o; }
    asm volatile("s_waitcnt lgkmcnt(0)" ::: "memory");
}
constexpr int CONV_IN = 16 * 96, CONV_NITEMS = 16 * 96 + 16 * 96 + 8 * 16 + 3 * 8 * 32 + 16 * 32 + 2 * 32 * 16 * 8 + 32 * 4 * 32;
__device__ __forceinline__ void convert_weights(Frame& F, int l, int blk0, int nblk, int it_lo, int it_hi, bool extras) {
    LAS float* scr = (LAS float*)(F.lds + F.wave * 16384);
    const int cb = F.bid - blk0; if (cb < 0 || cb >= nblk) return;
    const int ngw = nblk * (NT / 64), gw = ngw - 1 - (cb * (NT / 64) + F.wave);
    constexpr int I_IN = 16 * 96, I_MG = 16 * 96, I_GLU = 8 * 16, I_BR = 3 * 8 * 32, I_O = 16 * 32, I_1 = 32 * 16 * 8, I_3 = I_1, I_2 = 32 * 4 * 32;
    static_assert(I_IN == CONV_IN && I_IN + I_MG + I_GLU + I_BR + I_O + I_1 + I_3 + I_2 == CONV_NITEMS, "item list");
    for (int it = it_lo + gw; it < it_hi; it += ngw) {
        int r = it;
        if (r < I_IN) { const int kb = r / 96, nb = r % 96; transpose_item(IN_(I_WIN) + (size_t)l * D * INW, INW, 64 * kb, 32 * nb, (bf16*)(F.ws + WS_WIN), 1024, 32 * nb, scr, F.lane); continue; } r -= I_IN;
        if (r < I_MG) { const int kb = r / 96, nb = r % 96; transpose_item(IN_(I_WMG) + (size_t)l * D * INW, INW, 64 * kb, 32 * nb, (bf16*)(F.ws + WS_WMG), 1024, 32 * nb, scr, F.lane); continue; } r -= I_MG;
        if (r < I_GLU) { const int kb = r / 16, nb = r % 16; transpose_item(IN_(I_WGLU) + (size_t)l * MIXW * MIXW, MIXW, 64 * kb, 32 * nb, (bf16*)(F.ws + WS_WGLU), 512, 32 * nb, scr, F.lane); continue; } r -= I_GLU;
        if (r < I_BR) { const int kk = r / 256, q = r % 256, kb = q / 32, nb = q % 32; transpose_item(IN_(I_WBR) + ((size_t)l * 3 + kk) * MIXW * D, D, 64 * kb, 32 * nb, (bf16*)(F.ws + WS_WBR), 512, (size_t)kk * 1024 + 32 * nb, scr, F.lane); continue; } r -= I_BR;
        if (r < I_O) { const int kb = r / 32, nb = r % 32; transpose_item(IN_(I_WO) + (size_t)l * D * D, D, 64 * kb, 32 * nb, (bf16*)(F.ws + WS_WO), 1024, 32 * nb, scr, F.lane); continue; } r -= I_O;
        if (r < I_1 + I_3) { const int which = r / I_1, q = r % I_1, e = q / 128, q2 = q % 128, kb = q2 / 8, nb = q2 % 8;
            const float* W = IN_(which ? I_W3 : I_W1) + ((size_t)l * NE + e) * D * DFF; const int n0 = 32 * nb;
            transpose_item(W, DFF, 64 * kb, n0, (bf16*)(F.ws + WS_W13), 1024, (size_t)e * 512 + (n0 / 128) * 256 + which * 128 + (n0 % 128), scr, F.lane); continue; } r -= I_1 + I_3;
        { const int e = r / 128, q = r % 128, kb = q / 32, nb = q % 32; transpose_item(IN_(I_W2) + ((size_t)l * NE + e) * DFF * D, D, 64 * kb, 32 * nb, (bf16*)(F.ws + WS_W2), 256, (size_t)e * 1024 + 32 * nb, scr, F.lane); }
    }
    if (!extras) return;
    { bf16* wr = (bf16*)(F.ws + WS_WR); const float* wg = IN_(I_WGRP) + (size_t)l * D * 4; const float* we = IN_(I_WEXP) + (size_t)l * D * 32;
      for (int i = cb * NT + F.tid; i < 48 * 1024; i += nblk * NT) { const int n = i >> 10, kk = i & 1023; const float w = n < 4 ? wg[kk * 4 + n] : (n < 36 ? we[kk * 32 + n - 4] : 0.f);
          const unsigned hi = f2bf(w); const float lo = w - __builtin_bit_cast(float, hi << 16); wr[i] = (bf16)hi; wr[48 * 1024 + i] = (bf16)f2bf(lo); } }
    { const float* s = IN_(I_WSG) + (size_t)l * 4 * 128 * 128; bf16* d = (bf16*)(F.ws + WS_WSG);
      for (int i = (cb * NT + F.tid) * 2; i < 4 * 128 * 128; i += nblk * NT * 2) *(unsigned*)(d + i) = pk2(s[i], s[i + 1]); }
}

struct EpiProj { static constexpr bool PERM = true, AFTER_DRAIN = false; bf16* O;
    __device__ __forceinline__ void operator()(const pg8::f32x4 (&acc)[2][2][4][2], const pg8::Unit& u, int wr, int wc, int fr, int fq) const {
        const int row0 = u.pm * 256 + wr * 64 + fr, col0 = u.pn * 256 + wc * 32 + 8 * fq; const bool act = (u.pn >= 2 && u.pn < 6);
#pragma unroll
        for (int ai = 0; ai < 2; ++ai)
#pragma unroll
            for (int m = 0; m < 4; ++m) { bf16* rowp = O + (size_t)(row0 + ai * 128 + m * 16) * INW + col0;
#pragma unroll
                for (int bj = 0; bj < 2; ++bj) { pg8::f32x4 v0 = acc[ai][bj][m][0], v1 = acc[ai][bj][m][1];
                    if (act) {
#pragma unroll
                        for (int j = 0; j < 4; ++j) { v0[j] = geluf_(v0[j]); v1[j] = geluf_(v1[j]); } }
                    v4u w; w.x = cvtpk(v0[0], v0[1]); w.y = cvtpk(v0[2], v0[3]); w.z = cvtpk(v1[0], v1[1]); w.w = cvtpk(v1[2], v1[3]); *(v4u*)(rowp + bj * 128) = w; } }
    } };
struct EpiGlu { static constexpr bool PERM = true, AFTER_DRAIN = false; const bf16* YG; bf16* YA;
    __device__ __forceinline__ void operator()(const pg8::f32x4 (&acc)[2][2][4][2], const pg8::Unit& u, int wr, int wc, int fr, int fq) const {
        const int row0 = u.pm * 256 + wr * 64 + fr, col0 = u.pn * 256 + wc * 32 + 8 * fq;
#pragma unroll
        for (int ai = 0; ai < 2; ++ai) {
        v4u gv[4][2];
#pragma unroll
            for (int m = 0; m < 4; ++m)
#pragma unroll
                for (int bj = 0; bj < 2; ++bj) gv[m][bj] = *(const v4u*)(YG + (size_t)(row0 + ai * 128 + m * 16) * MIXW + col0 + bj * 128);
        asm volatile("" ::: "memory");
#pragma unroll
            for (int m = 0; m < 4; ++m) { const size_t off = (size_t)(row0 + ai * 128 + m * 16) * MIXW + col0;
#pragma unroll
                for (int bj = 0; bj < 2; ++bj) { const pg8::f32x4 v0 = acc[ai][bj][m][0], v1 = acc[ai][bj][m][1]; const v4u g = gv[m][bj];
                    v4u w; w.x = cvtpk(bflo(g.x) * sigmoidf_(v0[0]), bfhi(g.x) * sigmoidf_(v0[1])); w.y = cvtpk(bflo(g.y) * sigmoidf_(v0[2]), bfhi(g.y) * sigmoidf_(v0[3]));
                    w.z = cvtpk(bflo(g.z) * sigmoidf_(v1[0]), bfhi(g.z) * sigmoidf_(v1[1])); w.w = cvtpk(bflo(g.w) * sigmoidf_(v1[2]), bfhi(g.w) * sigmoidf_(v1[3])); *(v4u*)(YA + off + bj * 128) = w; } }
        asm volatile("" ::: "memory"); }
    } };
__device__ __forceinline__ int xcd_remap(int Lq, int total) { const int q = total >> 3, r = total & 7, x = Lq & 7, off = Lq >> 3; return (x < r ? x * (q + 1) : r * (q + 1) + (x - r) * q) + off; }
struct EpiBr { static constexpr bool PERM = true, AFTER_DRAIN = false; bf16* BR;
    __device__ __forceinline__ void operator()(const pg8::f32x4 (&acc)[2][2][4][2], const pg8::Unit& u, int wr, int wc, int fr, int fq) const {
        const int pm = u.pm % (MT / 256); const int row0 = pm * 256 + wr * 64 + fr, col0 = u.pn * 256 + wc * 32 + 8 * fq;
#pragma unroll
        for (int ai = 0; ai < 2; ++ai)
#pragma unroll
            for (int m = 0; m < 4; ++m) { bf16* rowp = BR + (size_t)(row0 + ai * 128 + m * 16) * INW + col0;
#pragma unroll
                for (int bj = 0; bj < 2; ++bj) { const pg8::f32x4 v0 = acc[ai][bj][m][0], v1 = acc[ai][bj][m][1];
                    v4u w; w.x = cvtpk(v0[0], v0[1]); w.y = cvtpk(v0[2], v0[3]); w.z = cvtpk(v1[0], v1[1]); w.w = cvtpk(v1[2], v1[3]); *(v4u*)(rowp + bj * 128) = w; } }
    } };
__device__ __forceinline__ int vu_pm(int v) { return (v >> 5) * 8 + (v & 7); }
__device__ __forceinline__ int vu_dt(int v) { return (v >> 3) & 3; }
struct SchedBr { int G, c, nM;
    __device__ __forceinline__ bool next(int i, pg8::Unit& u) const { const int v0 = (i / 3) * G + c, k = i % 3; if (v0 >= nM * 4) return false; const int v = xcd_remap(v0, nM * 4);
        u.pm = k * (MT / 256) + vu_pm(v); u.pn = k * 4 + vu_dt(v); return true; }
    __device__ __forceinline__ unsigned peek(const pg8::Unit&) const { return 0u; }
    __device__ __forceinline__ void a_ready(const pg8::Unit&, unsigned) const {}
    __device__ __forceinline__ void done(const pg8::Unit&) const {} };
struct EpiMerge { static constexpr bool PERM = true, AFTER_DRAIN = false; const bf16* BR; bf16* PM; const float* bm;
    __device__ __forceinline__ void operator()(const pg8::f32x4 (&acc)[2][2][4][2], const pg8::Unit& u, int wr, int wc, int fr, int fq) const {
        const int k = u.pn >> 2, dt = u.pn & 3; const int row0 = u.pm * 256 + wr * 64 + fr, col0 = dt * 256 + wc * 32 + 8 * fq;
#pragma unroll
        for (int bj = 0; bj < 2; ++bj) { const pg8::f32x4 b0 = *(const pg8::f32x4*)(bm + k * 1024 + col0 + bj * 128), b1 = *(const pg8::f32x4*)(bm + k * 1024 + col0 + bj * 128 + 4);
#pragma unroll
            for (int ai = 0; ai < 2; ++ai) {
            v4u brv[4], pmv[4];
#pragma unroll
                for (int m = 0; m < 4; ++m) { const size_t r = (size_t)(row0 + ai * 128 + m * 16); brv[m] = *(const v4u*)(BR + r * INW + k * 1024 + col0 + bj * 128);
                    pmv[m] = k > 0 ? *(const v4u*)(PM + r * D + col0 + bj * 128) : (v4u){0u, 0u, 0u, 0u}; }
                asm volatile("" ::: "memory");
#pragma unroll
                for (int m = 0; m < 4; ++m) { const size_t r = (size_t)(row0 + ai * 128 + m * 16); const v4u br = brv[m], o = pmv[m];
                    const pg8::f32x4 v0 = acc[ai][bj][m][0] + b0, v1 = acc[ai][bj][m][1] + b1;
                    float p[8] = {sigmoidf_(v0[0]) * bflo(br.x), sigmoidf_(v0[1]) * bfhi(br.x), sigmoidf_(v0[2]) * bflo(br.y), sigmoidf_(v0[3]) * bfhi(br.y),
                                  sigmoidf_(v1[0]) * bflo(br.z), sigmoidf_(v1[1]) * bfhi(br.z), sigmoidf_(v1[2]) * bflo(br.w), sigmoidf_(v1[3]) * bfhi(br.w)};
                    if (k > 0) { p[0] += bflo(o.x); p[1] += bfhi(o.x); p[2] += bflo(o.y); p[3] += bfhi(o.y); p[4] += bflo(o.z); p[5] += bfhi(o.z); p[6] += bflo(o.w); p[7] += bfhi(o.w); }
                    v4u w; w.x = cvtpk(p[0], p[1]); w.y = cvtpk(p[2], p[3]); w.z = cvtpk(p[4], p[5]); w.w = cvtpk(p[6], p[7]); *(v4u*)(PM + r * D + col0 + bj * 128) = w; }
                asm volatile("" ::: "memory"); } }
    } };
struct SchedMerge { int G, c, nM;
    __device__ __forceinline__ bool next(int i, pg8::Unit& u) const { const int v0 = (i / 3) * G + c, k = i % 3; if (v0 >= nM * 4) return false; const int v = xcd_remap(v0, nM * 4); u.pm = vu_pm(v); u.pn = k * 4 + vu_dt(v); return true; }
    __device__ __forceinline__ unsigned peek(const pg8::Unit&) const { return 0u; }
    __device__ __forceinline__ void a_ready(const pg8::Unit&, unsigned) const {}
    __device__ __forceinline__ void done(const pg8::Unit&) const {} };
struct EpiWo { static constexpr bool PERM = true, AFTER_DRAIN = false; const float* xin; bf16* X16; const float* mod_l; float* rss; int l0; int pad_;
    __device__ __forceinline__ void operator()(const pg8::f32x4 (&acc)[2][2][4][2], const pg8::Unit& u, int wr, int wc, int fr, int fq) const {
        const int row0 = u.pm * 256 + wr * 64 + fr, col0 = u.pn * 256 + wc * 32 + 8 * fq;
        const float* ga = mod_l + 2048;
        float ssq[2][4] = {};
        pg8::f32x4 gv[2][2];
#pragma unroll
        for (int bj = 0; bj < 2; ++bj)
#pragma unroll
            for (int n = 0; n < 2; ++n) gv[bj][n] = *(const pg8::f32x4*)(ga + col0 + bj * 128 + n * 4);
#pragma unroll
        for (int ai = 0; ai < 2; ++ai) {
#pragma unroll
            for (int mp = 0; mp < 2; ++mp) {
            pg8::f32x4 xv[2][2][2];
            if (l0) {
#pragma unroll
                for (int m = 0; m < 2; ++m) { const size_t off = (size_t)(row0 + ai * 128 + (mp * 2 + m) * 16) * D + col0;
#pragma unroll
                    for (int bj = 0; bj < 2; ++bj)
#pragma unroll
                        for (int n = 0; n < 2; ++n) xv[m][bj][n] = *(const pg8::f32x4*)(xin + off + bj * 128 + n * 4); }
                asm volatile("" ::: "memory");
            } else {
                v4u xb[2][2];
#pragma unroll
                for (int m = 0; m < 2; ++m) { const size_t off = (size_t)(row0 + ai * 128 + (mp * 2 + m) * 16) * D + col0;
#pragma unroll
                    for (int bj = 0; bj < 2; ++bj) xb[m][bj] = *(const v4u*)(X16 + off + bj * 128); }
                asm volatile("" ::: "memory");
#pragma unroll
                for (int m = 0; m < 2; ++m)
#pragma unroll
                    for (int bj = 0; bj < 2; ++bj) { const v4u w = xb[m][bj]; xv[m][bj][0] = (pg8::f32x4){bflo(w.x), bfhi(w.x), bflo(w.y), bfhi(w.y)}; xv[m][bj][1] = (pg8::f32x4){bflo(w.z), bfhi(w.z), bflo(w.w), bfhi(w.w)}; }
            }
#pragma unroll
            for (int m = 0; m < 2; ++m) { const size_t off = (size_t)(row0 + ai * 128 + (mp * 2 + m) * 16) * D + col0;
#pragma unroll
                for (int bj = 0; bj < 2; ++bj) { const pg8::f32x4 o0 = xv[m][bj][0] + gv[bj][0] * acc[ai][bj][m + mp * 2][0], o1 = xv[m][bj][1] + gv[bj][1] * acc[ai][bj][m + mp * 2][1];
                    v4u w; w.x = cvtpk(o0[0], o0[1]); w.y = cvtpk(o0[2], o0[3]); w.z = cvtpk(o1[0], o1[1]); w.w = cvtpk(o1[2], o1[3]); *(v4u*)(X16 + off + bj * 128) = w;
                    ssq[ai][m + mp * 2] += (o0[0] * o0[0] + o0[1] * o0[1] + o0[2] * o0[2] + o0[3] * o0[3]) + (o1[0] * o1[0] + o1[1] * o1[1] + o1[2] * o1[2] + o1[3] * o1[3]); } }
            asm volatile("" ::: "memory"); }
        }
        const int lane = fr + 16 * fq;
#pragma unroll
        for (int ai = 0; ai < 2; ++ai)
#pragma unroll
            for (int m = 0; m < 4; ++m) { float s = ssq[ai][m]; s += shflx(s, 16, lane); s += shflx(s, 32, lane); if (fq == 0) rss[(size_t)(row0 + ai * 128 + m * 16) * 16 + u.pn * 4 + wc] = s; }
    } };
constexpr int MOETAB_OFF = 131072 + 2048;
__device__ __forceinline__ int moe_build_tables(Frame& F, const unsigned* cnt, LAS unsigned* tabu, LAS unsigned* tabd) {
    LAS int* RAW = (LAS int*)(F.lds + MOETAB_OFF + 8192); LAS int* PRE = RAW + 32;
    if (F.tid < 32) RAW[F.tid] = ((int)cnt[F.tid] + 255) >> 8;
    __syncthreads();
    if (F.tid <= 32) { int s = 0; for (int i = 0; i < F.tid; ++i) s += RAW[i]; PRE[F.tid] = s; }
    __syncthreads();
    const int nrt = PRE[32];
    for (int q = F.tid; q < nrt * 6; q += NT) { const int rt = q / 6, w = q % 6; int e = 0;
#pragma unroll 1
        for (int i = 1; i < 32; ++i) e += PRE[i] <= rt ? 1 : 0;
        if (w < 2) tabu[rt * 2 + w] = ((unsigned)rt << 16) | (unsigned)(e * 2 + w); else tabd[rt * 4 + (w - 2)] = ((unsigned)rt << 16) | (unsigned)(e * 4 + (w - 2)); }
    __syncthreads();
    return nrt;
}
__device__ __forceinline__ void xcd_chunk(int total, int x, int& start, int& size) { const int q = total >> 3, r = total & 7; size = q + (x < r ? 1 : 0); start = x < r ? x * (q + 1) : r * (q + 1) + (x - r) * q; }
struct SchedMoeUp { int G, c, nrt, tid; const LAS unsigned* tabw; unsigned* upc;
    __device__ __forceinline__ bool next(int i, pg8::Unit& u) const {
        int Lq;
        if (G & 7) { Lq = i * G + c; if (Lq >= 2 * nrt) return false; }
        else { int rs, rn; xcd_chunk(nrt, c & 7, rs, rn); const int nb = G >> 3, j = c >> 3, o0 = i * nb; if (o0 + j >= 2 * rn) return false;
            const int n = (2 * rn - o0) < nb ? (2 * rn - o0) : nb, h = n >> 1;
            Lq = (n & 1) ? 2 * rs + o0 + j : 2 * (rs + (o0 >> 1) + (j % h)) + (j / h); }
        const unsigned w = (unsigned)__builtin_amdgcn_readfirstlane((int)tabw[Lq]); u.pm = (int)(w >> 16); u.pn = (int)(w & 0xffffu); return true; }
    __device__ __forceinline__ unsigned peek(const pg8::Unit&) const { return 0u; }
    __device__ __forceinline__ void a_ready(const pg8::Unit&, unsigned) const {}
    __device__ __forceinline__ void done(const pg8::Unit& u) const {
        asm volatile("s_waitcnt vmcnt(0)" ::: "memory"); __builtin_amdgcn_s_barrier();
        if (tid == 0) __hip_atomic_fetch_add(upc + u.pm, 1u, __ATOMIC_RELAXED, __HIP_MEMORY_SCOPE_AGENT); } };
struct SchedMoeDown { int G, c, nrt, pad_; const LAS unsigned* tabw; unsigned* upc;
    __device__ __forceinline__ bool next(int i, pg8::Unit& u) const {
        int Lq;
        if (G & 7) { Lq = i * G + c; if (Lq >= 4 * nrt) return false; }
        else { const int j = c >> 3, nb = G >> 3; int rs, rn; xcd_chunk(nrt, c & 7, rs, rn); const int un = 2 * rn, dn = 4 * rn;
            const int a = un / nb, n2 = un % nb, nu = a + (j < n2 ? 1 : 0), s = 2 * nu + i;
            const int c0 = s - 2 * a, c1 = s - 2 * a - 2; const int off = (nb - n2) * (c0 > 0 ? c0 : 0) + n2 * (c1 > 0 ? c1 : 0) + (c1 >= 0 ? j : j - n2);
            if (off >= dn) return false; Lq = 4 * rs + off; }
        const unsigned w = (unsigned)__builtin_amdgcn_readfirstlane((int)tabw[Lq]); u.pm = (int)(w >> 16); u.pn = (int)(w & 0xffffu); return true; }
    __device__ __forceinline__ unsigned peek(const pg8::Unit& u) const { return __hip_atomic_load(upc + u.pm, __ATOMIC_RELAXED, __HIP_MEMORY_SCOPE_AGENT); }
    __device__ __forceinline__ void a_ready(const pg8::Unit& u, unsigned tok) const {
        if ((unsigned)__builtin_amdgcn_readfirstlane((int)tok) >= 2u) return;
        unsigned* p = upc + u.pm; unsigned spins = 0;
        while ((unsigned)__builtin_amdgcn_readfirstlane((int)__hip_atomic_load(p, __ATOMIC_RELAXED, __HIP_MEMORY_SCOPE_AGENT)) < 2u) { __builtin_amdgcn_s_sleep(2); if (++spins > (1u << 22)) break; } }
    __device__ __forceinline__ void done(const pg8::Unit&) const {} };
struct EpiUp { static constexpr bool PERM = true, AFTER_DRAIN = false; bf16* ACT; const float* SW;
    __device__ __forceinline__ void operator()(const pg8::f32x4 (&acc)[2][2][4][2], const pg8::Unit& u, int wr, int wc, int fr, int fq) const {
        const int row0 = u.pm * 256 + wr * 64 + fr, f0 = (u.pn & 1) * 128 + wc * 32 + 8 * fq;
        const __amdgpu_buffer_rsrc_t rs = __builtin_amdgcn_make_buffer_rsrc(ACT, 0, MAXSLOT * DFF * 2, 0x00020000);
        float wv[2][4];
#pragma unroll
        for (int ai = 0; ai < 2; ++ai)
#pragma unroll
            for (int m = 0; m < 4; ++m) wv[ai][m] = SW[row0 + ai * 128 + m * 16];
        asm volatile("" ::: "memory");
#pragma unroll
        for (int ai = 0; ai < 2; ++ai)
#pragma unroll
            for (int m = 0; m < 4; ++m) { const int slot = row0 + ai * 128 + m * 16; const float w = wv[ai][m];
                const pg8::f32x4 a0 = acc[ai][0][m][0], a1 = acc[ai][0][m][1], b0 = acc[ai][1][m][0], b1 = acc[ai][1][m][1];
                v4u o; o.x = cvtpk(siluf_(a0[0]) * b0[0] * w, siluf_(a0[1]) * b0[1] * w); o.y = cvtpk(siluf_(a0[2]) * b0[2] * w, siluf_(a0[3]) * b0[3] * w);
                o.z = cvtpk(siluf_(a1[0]) * b1[0] * w, siluf_(a1[1]) * b1[1] * w); o.w = cvtpk(siluf_(a1[2]) * b1[2] * w, siluf_(a1[3]) * b1[3] * w);
                __builtin_amdgcn_raw_buffer_store_b128(o, rs, (unsigned)((slot * DFF + f0) * 2), 0,   16); }
    } };
struct EpiDown { static constexpr bool PERM = true, AFTER_DRAIN = false; bf16* YS2;
    __device__ __forceinline__ void operator()(const pg8::f32x4 (&acc)[2][2][4][2], const pg8::Unit& u, int wr, int wc, int fr, int fq) const {
        const int row0 = u.pm * 256 + wr * 64 + fr, col0 = (u.pn & 3) * 256 + wc * 32 + 8 * fq;
#pragma unroll
        for (int ai = 0; ai < 2; ++ai)
#pragma unroll
            for (int m = 0; m < 4; ++m) { bf16* rowp = YS2 + (size_t)(row0 + ai * 128 + m * 16) * D + col0;
#pragma unroll
                for (int bj = 0; bj < 2; ++bj) { const pg8::f32x4 v0 = acc[ai][bj][m][0], v1 = acc[ai][bj][m][1];
                    v4u w; w.x = cvtpk(v0[0], v0[1]); w.y = cvtpk(v0[2], v0[3]); w.z = cvtpk(v1[0], v1[1]); w.w = cvtpk(v1[2], v1[3]); *(v4u*)(rowp + bj * 128) = w; } }
    } };


__device__ __forceinline__ void ph2_fast(Frame& F, int l) {
    pg8::Gemm g{(const bf16*)HBUF(F), (const bf16*)(F.ws + WS_WIN), SEQ, INW, D, 0, nullptr}; pg8::StaticOrder S; S.init(SEQ, INW, F.G, F.bid);
    EpiProj E{(bf16*)(F.ws + WS_PROJ)}; pg8::gemm_phase<EpiProj, pg8::StaticOrder, PG_ALIGN, PG_SP2>(F.lds, g, S, E, F.tid);
}
__device__ __forceinline__ void ph6_fast(Frame& F, int l) {
    pg8::Gemm g{(const bf16*)(F.ws + WS_YG), (const bf16*)(F.ws + WS_WGLU), MT, MIXW, MIXW, 0, nullptr}; pg8::StaticOrder S; S.init(l == 0 ? MT : SEQ, MIXW, F.G, F.bid);
    EpiGlu E{(const bf16*)(F.ws + WS_YG), (bf16*)(F.ws + WS_YS)}; pg8::gemm_phase<EpiGlu, pg8::StaticOrder, PG_ALIGN, PG_SP2>(F.lds, g, S, E, F.tid);
}
__device__ __forceinline__ void ph7_fast(Frame& F, int l) {
    pg8::Gemm g{(const bf16*)(F.ws + WS_YS), (const bf16*)(F.ws + WS_WBR), 3 * MT, 3 * D, MIXW, 0, nullptr}; SchedBr S{F.G, F.bid, SEQ / 256};
    EpiBr E{(bf16*)(F.ws + WS_PROJ)}; pg8::gemm_phase<EpiBr, SchedBr, PG_ALIGN, PG_SP2>(F.lds, g, S, E, F.tid);
}
__device__ __forceinline__ void ph8_fast(Frame& F, int l) {
    pg8::Gemm g{(const bf16*)HBUF(F), (const bf16*)(F.ws + WS_WMG), MT, INW, D, 0, nullptr}; SchedMerge S{F.G, F.bid, SEQ / 256};
    EpiMerge E{(const bf16*)(F.ws + WS_PROJ), (bf16*)(F.ws + WS_PM), IN_(I_BMG) + l * INW}; pg8::gemm_phase<EpiMerge, SchedMerge, PG_ALIGN, PG_SP2>(F.lds, g, S, E, F.tid);
}
__device__ __forceinline__ void ph9_fast(Frame& F, int l) {
    pg8::Gemm g{(const bf16*)(F.ws + WS_PM), (const bf16*)(F.ws + WS_WO), MT, D, D, 0, nullptr}; pg8::StaticOrder S; S.init(SEQ, D, F.G, F.bid);
    EpiWo E{IN_(I_X), (bf16*)(F.ws + WS_X16), (const float*)(F.ws + WS_MOD) + (size_t)l * 2 * 6144, (float*)(F.ws + WS_RSS), l == 0 ? 1 : 0, 0};
    pg8::gemm_phase<EpiWo, pg8::StaticOrder, PG_ALIGN, PG_SP2>(F.lds, g, S, E, F.tid);
}
__device__ __forceinline__ void ph12_moe(Frame& F, int l) {
    LAS unsigned* tabu = (LAS unsigned*)(F.lds + MOETAB_OFF); LAS unsigned* tabd = tabu + 1024; unsigned* upc = F.ctl + CW_UPC + l * 256;
    const int nrt = moe_build_tables(F, F.ctl + CW_CNT + l * 128, tabu, tabd);
#define MOE_STAMP(i) do { if ((PROBE_A >= 0 || PROBE_B >= 0) && l == 0 && F.tid == 0) ((volatile LAS unsigned long long*)(F.lds + TS_OFF))[i] = __builtin_amdgcn_s_memrealtime(); } while (0)
    MOE_STAMP(60);
    { pg8::Gemm g{(const bf16*)HBUF(F), (const bf16*)(F.ws + WS_W13), MAXSLOT, NE * 512, D, 0, (const int*)(F.ws + WS_STOK)}; SchedMoeUp S{F.G, F.bid, nrt, F.tid, tabu, upc};
      EpiUp E{(bf16*)(F.ws + WS_ACT), (const float*)(F.ws + WS_SW)}; pg8::gemm_phase<EpiUp, SchedMoeUp, PG_ALIGN, PG_SP2, false, true>(F.lds, g, S, E, F.tid); }
    MOE_STAMP(61);
    { pg8::Gemm g{(const bf16*)(F.ws + WS_ACT), (const bf16*)(F.ws + WS_W2), MAXSLOT, NE * D, DFF, 0, nullptr}; SchedMoeDown S{F.G, F.bid, nrt, 0, tabd, upc};
      EpiDown E{(bf16*)(F.ws + WS_YS2)}; pg8::gemm_phase<EpiDown, SchedMoeDown, PG_ALIGN, PG_SP2, true>(F.lds, g, S, E, F.tid); }
    MOE_STAMP(62);
    if (PROBE_A == 99 && l == 0 && F.tid == 0) { volatile LAS unsigned long long* TS = (volatile LAS unsigned long long*)(F.lds + TS_OFF); __hip_atomic_fetch_max(F.ctl + 100, ((unsigned)(TS[62] - TS[12]) << 8) | (unsigned)F.bid, __ATOMIC_RELAXED, __HIP_MEMORY_SCOPE_AGENT); }
}


constexpr int NSB = MT / 16;
__device__ __forceinline__ void s5_precompute(Frame& F) {
    LAS float* APr = (LAS float*)F.lds; LAS float* APi = APr + 2176; LAS float* BBr = APi + 2176; LAS float* BBi = BBr + 2048; LAS float* CCr = BBi + 2048; LAS float* CCi = CCr + 2048; LAS float* KK = CCi + 2048;
    for (int item = F.G - 1 - F.bid; item < 2 * G5; item += F.G) { const int l = item >> 5, g = item & 31;
        __syncthreads();
        if (F.tid < 128) { const int d = F.tid >> 6, p = F.tid & 63; const int ldg = (l * 2 + d) * G5 + g;
            const double lr = IN_(I_LRE)[ldg * P5 + p], li = IN_(I_LIM)[ldg * P5 + p], dt = exp((double)IN_(I_LDT)[ldg]);
            for (int e = 0; e <= 16; ++e) { const double m = exp(lr * dt * e), ang = li * dt * e; APr[(d * 64 + p) * 17 + e] = (float)(m * cos(ang)); APi[(d * 64 + p) * 17 + e] = (float)(m * sin(ang)); }
            { const double m16 = exp(lr * dt * 16.0), a16 = li * dt * 16.0; float* A16 = (float*)(F.ws + WS_A16) + ((size_t)((l * 32 + g) * 2 + d) * 64 + p) * 2; A16[0] = (float)(m16 * cos(a16)); A16[1] = (float)(m16 * sin(a16)); }
            const double m1 = exp(lr * dt), ar = m1 * cos(li * dt), ai = m1 * sin(li * dt); const double nr = ar - 1.0, ni = ai, den = lr * lr + li * li;
            const double qr = (nr * lr + ni * li) / den, qi = (ni * lr - nr * li) / den;
            for (int h = 0; h < 16; ++h) { const double x = IN_(I_BRE)[((size_t)ldg * P5 + p) * H5 + h], y = IN_(I_BIM)[((size_t)ldg * P5 + p) * H5 + h];
                BBr[(d * 64 + p) * 16 + h] = (float)(qr * x - qi * y); BBi[(d * 64 + p) * 16 + h] = (float)(qr * y + qi * x);
                CCr[(d * 16 + h) * 64 + p] = IN_(I_CRE)[((size_t)ldg * H5 + h) * P5 + p]; CCi[(d * 16 + h) * 64 + p] = IN_(I_CIM)[((size_t)ldg * H5 + h) * P5 + p]; } }
        __syncthreads();
        { const int d = F.tid >> 8, e = (F.tid >> 4) & 15, hp = F.tid & 15;
          float wr[64], wi[64];
#pragma unroll
          for (int p = 0; p < 64; ++p) { const float pr = APr[(d * 64 + p) * 17 + e], pi = APi[(d * 64 + p) * 17 + e], br = BBr[(d * 64 + p) * 16 + hp], bi = BBi[(d * 64 + p) * 16 + hp]; wr[p] = pr * br - pi * bi; wi[p] = pr * bi + pi * br; }
#pragma unroll 1
          for (int h = 0; h < 16; ++h) { float a = 0.f;
#pragma unroll
              for (int p = 0; p < 64; ++p) a += CCr[(d * 16 + h) * 64 + p] * wr[p] - CCi[(d * 16 + h) * 64 + p] * wi[p];
              KK[(d * 16 + e) * 256 + h * 16 + hp] = a; } }
        __syncthreads();
        bf16* M = (bf16*)(F.ws + WS_S5M) + (size_t)(l * 32 + g) * 3 * 65536;
        for (int idx = F.tid; idx < 32768; idx += NT) {
            const int r = idx >> 7, k0 = (idx & 127) * 2; float v[3][2];
#pragma unroll
            for (int q = 0; q < 2; ++q) { const int kk = k0 + q;
                { const int d = r >> 7, p = (r >> 1) & 63, c = r & 1, sg = kk >> 4, hp = kk & 15, e = d == 0 ? 15 - sg : sg;
                  const float pr = APr[(d * 64 + p) * 17 + e], pi = APi[(d * 64 + p) * 17 + e], br = BBr[(d * 64 + p) * 16 + hp], bi = BBi[(d * 64 + p) * 16 + hp];
                  v[0][q] = c == 0 ? pr * br - pi * bi : pr * bi + pi * br; }
                { const int tau = r >> 4, h = r & 15, sg = kk >> 4, hp = kk & 15; float t = 0.f;
                  if (sg <= tau) t += KK[(0 * 16 + (tau - sg)) * 256 + h * 16 + hp]; if (sg >= tau) t += KK[(1 * 16 + (sg - tau)) * 256 + h * 16 + hp]; v[1][q] = t; }
                { const int tau = r >> 4, h = r & 15, d = kk >> 7, p = (kk >> 1) & 63, c = kk & 1, e = d == 0 ? tau + 1 : 16 - tau;
                  const float cr = CCr[(d * 16 + h) * 64 + p], ci = CCi[(d * 16 + h) * 64 + p], pr = APr[(d * 64 + p) * 17 + e], pi = APi[(d * 64 + p) * 17 + e];
                  v[2][q] = c == 0 ? cr * pr - ci * pi : -(cr * pi + ci * pr); } }
#pragma unroll
            for (int m = 0; m < 3; ++m) *(unsigned*)(M + (size_t)m * 65536 + r * 256 + k0) = pk2(v[m][0], v[m][1]);
        }
    }
}
constexpr int ZS_OFF = 16384, ZS_STRIDE = 528, EX_OFF = ZS_OFF + 144 * ZS_STRIDE, CARRY_OFF = EX_OFF + 4 * 128 * 16;
__device__ __forceinline__ void s5_fused_phase(Frame& F, int l) {
    const bf16* PROJ = (const bf16*)(F.ws + WS_PROJ); bf16* YG = (bf16*)(F.ws + WS_YG); const float* ds = IN_(I_DSKIP) + l * MIXW;
    unsigned long long* GR = (unsigned long long*)(F.ws + WS_GR); const unsigned tag = (unsigned)l + 1u;
    const int l15 = F.lane & 15, lq = F.lane >> 4; const int G8 = F.G & ~7;
    LAS unsigned char* ZS = F.lds + ZS_OFF; LAS float* EX = (LAS float*)(F.lds + EX_OFF); LAS float* CR = (LAS float*)(F.lds + CARRY_OFF);
    if (F.bid < G8)
    for (int item = F.bid; item < 256; item += G8) {
        const int g = item >> 3, p = item & 7;
        const bf16* vsrc = PROJ + (size_t)(16 * l15 + 2 * F.wave + (lq >> 1)) * INW + 16 * g + 8 * (lq & 1);
        {   const bf16* Fm = (const bf16*)(F.ws + WS_S5M) + (size_t)(l * 32 + g) * 3 * 65536;
            bf16x8 Af[2][8], nvz[9];
#pragma unroll
            for (int j = 0; j < 2; ++j)
#pragma unroll
                for (int ks = 0; ks < 8; ++ks) Af[j][ks] = *(const bf16x8*)(Fm + (size_t)(16 * (2 * F.wave + j) + l15) * 256 + 32 * ks + 8 * lq);
#pragma unroll
            for (int s = 0; s < 9; ++s) nvz[s] = *(const bf16x8*)(vsrc + (size_t)(s == 0 ? 64 : 8 * p + s - 1) * 256 * INW);
            __syncthreads();
            *(LAS bf16x8*)(F.lds + (F.wave * 64 + F.lane) * 16) = nvz[0];
            __syncthreads();
            int cur = 0;
#pragma unroll
            for (int s = 0; s < 9; ++s) {
                f32x4 acc[2] = {{0.f, 0.f, 0.f, 0.f}, {0.f, 0.f, 0.f, 0.f}};
#pragma unroll
                for (int ks = 0; ks < 8; ++ks) { const bf16x8 V = *(const LAS bf16x8*)(F.lds + cur * 8192 + (ks * 64 + F.lane) * 16);
#pragma unroll
                    for (int j = 0; j < 2; ++j) acc[j] = __builtin_amdgcn_mfma_f32_16x16x32_bf16(Af[j][ks], V, acc[j], 0, 0, 0); }
#pragma unroll
                for (int j = 0; j < 2; ++j) { v2u zz; zz.x = pk2(acc[j][0], acc[j][1]); zz.y = pk2(acc[j][2], acc[j][3]); *(LAS v2u*)(ZS + (s * 16 + l15) * ZS_STRIDE + (16 * (2 * F.wave + j) + 4 * lq) * 2) = zz; }
                if (s < 8) *(LAS bf16x8*)(F.lds + (cur ^ 1) * 8192 + (F.wave * 64 + F.lane) * 16) = nvz[s + 1];
                __syncthreads();
                cur ^= 1;
            }
        }
        {   const int c = F.tid & 127, j = F.tid >> 7, d = c >> 6;
            const float* A16 = (const float*)(F.ws + WS_A16) + ((size_t)((l * 32 + g) * 2 + d) * 64 + (c & 63)) * 2; const float ar = A16[0], ai = A16[1];
            LAS unsigned char* zc = ZS + c * 4;
            float hr = 0.f, hi = 0.f, pr = 1.f, pi = 0.f;
#pragma unroll 4
            for (int q = 0; q < 32; ++q) { const int i = 32 * j + q, row = 16 + (d ? 127 - i : i); const unsigned zw = *(const LAS unsigned*)(zc + row * ZS_STRIDE);
                const float nr = ar * hr - ai * hi + bflo(zw), ni = ar * hi + ai * hr + bfhi(zw); hr = nr; hi = ni; const float qr = pr * ar - pi * ai, qi = pr * ai + pi * ar; pr = qr; pi = qi; }
            EX[(j * 128 + c) * 4 + 0] = hr; EX[(j * 128 + c) * 4 + 1] = hi; EX[(j * 128 + c) * 4 + 2] = pr; EX[(j * 128 + c) * 4 + 3] = pi;
            __syncthreads();
            if (j == 0) {
                float er = 0.f, ei = 0.f, Ar = 1.f, Ai = 0.f;
#pragma unroll
                for (int jj = 0; jj < 4; ++jj) { const float h0 = EX[(jj * 128 + c) * 4], h1 = EX[(jj * 128 + c) * 4 + 1], q0 = EX[(jj * 128 + c) * 4 + 2], q1 = EX[(jj * 128 + c) * 4 + 3];
                    const float nr = q0 * er - q1 * ei + h0, ni = q0 * ei + q1 * er + h1; er = nr; ei = ni; const float tr = Ar * q0 - Ai * q1, ti = Ar * q1 + Ai * q0; Ar = tr; Ai = ti; }
                unsigned long long* mine = GR + ((size_t)(g * 8 + p) * 128 + c) * 2;
                __hip_atomic_store(mine, ((unsigned long long)tag << 32) | __builtin_bit_cast(unsigned, er), __ATOMIC_RELAXED, __HIP_MEMORY_SCOPE_AGENT);
                __hip_atomic_store(mine + 1, ((unsigned long long)tag << 32) | __builtin_bit_cast(unsigned, ei), __ATOMIC_RELAXED, __HIP_MEMORY_SCOPE_AGENT);
                float cr = 0.f, ci = 0.f;
#pragma unroll 4
                for (int i = 0; i < 16; ++i) { const int row = d ? 15 - i : i; const unsigned zw = *(const LAS unsigned*)(zc + row * ZS_STRIDE); *(LAS unsigned*)(zc + row * ZS_STRIDE) = pk2(cr, ci);
                    const float nr = ar * cr - ai * ci + bflo(zw), ni = ar * ci + ai * cr + bfhi(zw); cr = nr; ci = ni; }
                const int np = d ? 7 - p : p;
#pragma unroll 1
                for (int t = 0; t < np; ++t) { const int pp = d ? 7 - t : t; unsigned long long* o = GR + ((size_t)(g * 8 + pp) * 128 + c) * 2; unsigned long long x0, x1; unsigned spins = 0;
                    for (;;) { x0 = __hip_atomic_load(o, __ATOMIC_RELAXED, __HIP_MEMORY_SCOPE_AGENT); x1 = __hip_atomic_load(o + 1, __ATOMIC_RELAXED, __HIP_MEMORY_SCOPE_AGENT);
                        if ((unsigned)(x0 >> 32) == tag && (unsigned)(x1 >> 32) == tag) break; __builtin_amdgcn_s_sleep(2); if (++spins > (1u << 22)) break; }
                    const float e0 = __builtin_bit_cast(float, (unsigned)x0), e1 = __builtin_bit_cast(float, (unsigned)x1);
                    const float nr = Ar * cr - Ai * ci + e0, ni = Ar * ci + Ai * cr + e1; cr = nr; ci = ni; }
                CR[c * 2] = cr; CR[c * 2 + 1] = ci;
            }
            __syncthreads();
            float sr = CR[c * 2], si = CR[c * 2 + 1];
            for (int jj = 0; jj < j; ++jj) { const float h0 = EX[(jj * 128 + c) * 4], h1 = EX[(jj * 128 + c) * 4 + 1], q0 = EX[(jj * 128 + c) * 4 + 2], q1 = EX[(jj * 128 + c) * 4 + 3];
                const float nr = q0 * sr - q1 * si + h0, ni = q0 * si + q1 * sr + h1; sr = nr; si = ni; }
#pragma unroll 4
            for (int q = 0; q < 32; ++q) { const int i = 32 * j + q, row = 16 + (d ? 127 - i : i); const unsigned zw = *(const LAS unsigned*)(zc + row * ZS_STRIDE); *(LAS unsigned*)(zc + row * ZS_STRIDE) = pk2(sr, si);
                const float nr = ar * sr - ai * si + bflo(zw), ni = ar * si + ai * sr + bfhi(zw); sr = nr; si = ni; }
        }
        {   const bf16* Tm = (const bf16*)(F.ws + WS_S5M) + ((size_t)(l * 32 + g) * 3 + 1) * 65536; const bf16* Em = Tm + 65536;
            bf16x8 At[2][8], Ae[2][8];
#pragma unroll
            for (int j = 0; j < 2; ++j)
#pragma unroll
                for (int ks = 0; ks < 8; ++ks) { const size_t o = (size_t)(16 * (2 * F.wave + j) + l15) * 256 + 32 * ks + 8 * lq; At[j][ks] = *(const bf16x8*)(Tm + o); Ae[j][ks] = *(const bf16x8*)(Em + o); }
            const f32x4 dsk = *(const f32x4*)(ds + 16 * g + 4 * lq);
            const int s0 = (p == 0 && l == 0) ? 0 : 1;
            bf16x8 nA = *(const bf16x8*)(vsrc + (size_t)(s0 == 0 ? 64 : 8 * p) * 256 * INW), nB = *(const bf16x8*)(vsrc + (size_t)(8 * p + s0) * 256 * INW), nC = *(const bf16x8*)(vsrc + (size_t)(8 * p + s0 + 1) * 256 * INW);
            __syncthreads();
            *(LAS bf16x8*)(F.lds + (F.wave * 64 + F.lane) * 16) = nA;
            __syncthreads();
            int cur = 0;
#pragma unroll 1
            for (int s = s0; s < 9; ++s) { const int tl = s == 0 ? 64 : 8 * p + s - 1;
                bf16x8 nD = nC; if (s + 3 < 9) nD = *(const bf16x8*)(vsrc + (size_t)(8 * p + s + 2) * 256 * INW);
                v2u uu[2];
#pragma unroll
                for (int j = 0; j < 2; ++j) uu[j] = *(const LAS v2u*)(F.lds + cur * 8192 + (F.wave * 64 + l15 + 16 * (2 * j + (lq >> 1))) * 16 + 8 * (lq & 1));
                f32x4 acc[2] = {{0.f, 0.f, 0.f, 0.f}, {0.f, 0.f, 0.f, 0.f}};
#pragma unroll
                for (int ks = 0; ks < 8; ++ks) { const bf16x8 V = *(const LAS bf16x8*)(F.lds + cur * 8192 + (ks * 64 + F.lane) * 16), S = *(const LAS bf16x8*)(ZS + (s * 16 + l15) * ZS_STRIDE + (32 * ks + 8 * lq) * 2);
#pragma unroll
                    for (int j = 0; j < 2; ++j) { acc[j] = __builtin_amdgcn_mfma_f32_16x16x32_bf16(At[j][ks], V, acc[j], 0, 0, 0); acc[j] = __builtin_amdgcn_mfma_f32_16x16x32_bf16(Ae[j][ks], S, acc[j], 0, 0, 0); } }
#pragma unroll
                for (int j = 0; j < 2; ++j) { const size_t row = (size_t)tl * 256 + 16 * l15 + (2 * F.wave + j); const int ch = 16 * g + 4 * lq; const v2u u = uu[j];
                    const float y0 = acc[j][0] + dsk[0] * bflo(u.x), y1 = acc[j][1] + dsk[1] * bfhi(u.x), y2 = acc[j][2] + dsk[2] * bflo(u.y), y3 = acc[j][3] + dsk[3] * bfhi(u.y);
                    v2u w; w.x = cvtpk(geluf_(y0), geluf_(y1)); w.y = cvtpk(geluf_(y2), geluf_(y3)); *(v2u*)(YG + row * MIXW + ch) = w; }
                if (s < 8) *(LAS bf16x8*)(F.lds + (cur ^ 1) * 8192 + (F.wave * 64 + F.lane) * 16) = nB;
                __syncthreads();
                cur ^= 1; nB = nC; nC = nD;
            }
        }
    }
}
__device__ __forceinline__ int s5_chain_sb(int d, int i) { return d == 0 ? (i < 16 ? 1024 + i : i - 16) : (i < 16 ? 1039 - i : 1023 - (i - 16)); }
__device__ __forceinline__ void sg_fast_item(Frame& F, int l, int chunk, int pass) {
    const bf16* PROJ = (const bf16*)(F.ws + WS_PROJ); bf16* YB = (bf16*)(F.ws + WS_YS) + (size_t)MT * MIXW; const bf16* WSG = (const bf16*)(F.ws + WS_WSG);
    const float* lg = IN_(I_SGG) + l * MIXW; const float* lb = IN_(I_SGB) + l * MIXW; const float* bsg = IN_(I_BSG) + l * 512;
    LAS float* st = (LAS float*)(F.lds + 131072 + 2048); LAS unsigned char* WL = F.lds + 65536;
    __syncthreads();
    v4u wst[8];
#pragma unroll
    for (int i = 0; i < 8; ++i) { const int pid = F.tid + NT * i, ln = pid & 63, rest = pid >> 6, ks = rest & 3, cb = (rest >> 2) & 7, gl = rest >> 5;
        wst[i] = *(const v4u*)(WSG + ((size_t)(pass * 2 + gl) * 128 + cb * 16 + (ln & 15)) * 128 + 32 * ks + 8 * (ln >> 4)); }
    {
        const int p = F.tid >> 2, part = F.tid & 3; const bf16* vr = PROJ + (size_t)(chunk * 128 + p) * INW + 1024 + part * 128; float s = 0.f, q = 0.f;
#pragma unroll 4
        for (int c = 0; c < 128; c += 8) { const v4u w = *(const v4u*)(vr + c); const float x[8] = {bflo(w.x), bfhi(w.x), bflo(w.y), bfhi(w.y), bflo(w.z), bfhi(w.z), bflo(w.w), bfhi(w.w)};
#pragma unroll
            for (int i = 0; i < 8; ++i) { s += x[i]; q += x[i] * x[i]; } }
        s += shflx(s, 1, F.lane); q += shflx(q, 1, F.lane); s += shflx(s, 2, F.lane); q += shflx(q, 2, F.lane);
        const float mu = s * (1.f / 512.f), var = fmaxf(q * (1.f / 512.f) - mu * mu, 0.f);
        if (part == 0) { st[p * 2] = mu; st[p * 2 + 1] = rsqrtf(var + EPS); }
    }
#pragma unroll
    for (int i = 0; i < 8; ++i) *(LAS v4u*)(WL + (F.tid + NT * i) * 16) = wst[i];
    __syncthreads();
    const int l15 = F.lane & 15, lq = F.lane >> 4;
#pragma unroll 1
    for (int it = F.tid; it < 2048; it += NT) { const int tp = it & 63, cg = it >> 6; const int p0 = tp * 2, ch = pass * 256 + cg * 8;
        const v4u w0 = *(const v4u*)(PROJ + (size_t)(chunk * 128 + p0) * INW + 1024 + ch), w1 = *(const v4u*)(PROJ + (size_t)(chunk * 128 + p0 + 1) * INW + 1024 + ch);
        const float mu0 = st[p0 * 2], rs0 = st[p0 * 2 + 1], mu1 = st[p0 * 2 + 2], rs1 = st[p0 * 2 + 3];
        const float x0[8] = {bflo(w0.x), bfhi(w0.x), bflo(w0.y), bfhi(w0.y), bflo(w0.z), bfhi(w0.z), bflo(w0.w), bfhi(w0.w)};
        const float x1[8] = {bflo(w1.x), bfhi(w1.x), bflo(w1.y), bfhi(w1.y), bflo(w1.z), bfhi(w1.z), bflo(w1.w), bfhi(w1.w)};
#pragma unroll
        for (int i = 0; i < 8; ++i) { const float gm = lg[ch + i], bt = lb[ch + i]; const int c = cg * 8 + i;
            *(LAS unsigned*)(F.lds + c * 256 + (((p0 >> 3) ^ (c & 15)) << 4) + (p0 & 7) * 2) = pk2((x0[i] - mu0) * rs0 * gm + bt, (x1[i] - mu1) * rs1 * gm + bt); } }
    __syncthreads();
    const int ggl = F.wave >> 2, gg = pass * 2 + ggl, rb0 = (F.wave & 3) * 2;
    bf16x8 A[2][4];
#pragma unroll
    for (int j = 0; j < 2; ++j)
#pragma unroll
        for (int ks = 0; ks < 4; ++ks) { const int c = ggl * 128 + (rb0 + j) * 16 + l15; A[j][ks] = *(const LAS bf16x8*)(F.lds + c * 256 + (((4 * ks + lq) ^ (c & 15)) << 4)); }
    v2u guv[8][2];
#pragma unroll
    for (int cb = 0; cb < 8; ++cb)
#pragma unroll
        for (int j = 0; j < 2; ++j) guv[cb][j] = *(const v2u*)(PROJ + ((size_t)chunk * 128 + cb * 16 + l15) * INW + 512 + gg * 128 + (rb0 + j) * 16 + 4 * lq);
    f32x4 acc[2][8];
#pragma unroll
    for (int j = 0; j < 2; ++j)
#pragma unroll
        for (int cb = 0; cb < 8; ++cb) acc[j][cb] = (f32x4){0.f, 0.f, 0.f, 0.f};
#pragma unroll
    for (int cb = 0; cb < 8; ++cb)
#pragma unroll
        for (int ks = 0; ks < 4; ++ks) { const bf16x8 B = *(const LAS bf16x8*)(WL + ((((ggl * 8 + cb) * 4 + ks) * 64) + F.lane) * 16);
#pragma unroll
            for (int j = 0; j < 2; ++j) acc[j][cb] = __builtin_amdgcn_mfma_f32_16x16x32_bf16(A[j][ks], B, acc[j][cb], 0, 0, 0); }
    asm volatile("" ::: "memory");
#pragma unroll
    for (int cb = 0; cb < 8; ++cb) { const int q = cb * 16 + l15; const size_t row = (size_t)chunk * 128 + q; const float bq = bsg[gg * 128 + q];
#pragma unroll
        for (int j = 0; j < 2; ++j) { const int col = gg * 128 + (rb0 + j) * 16 + 4 * lq; const v2u gu = guv[cb][j];
            v2u w; w.x = cvtpk(bflo(gu.x) * (acc[j][cb][0] + bq), bfhi(gu.x) * (acc[j][cb][1] + bq)); w.y = cvtpk(bflo(gu.y) * (acc[j][cb][2] + bq), bfhi(gu.y) * (acc[j][cb][3] + bq));
            *(v2u*)(YB + row * MIXW + col) = w; } }
}

__device__ __forceinline__ bf16x8 sum3_bf16x8(const bf16* p, size_t stride) {
    const v4u a = *(const v4u*)p, b = *(const v4u*)(p + stride), c = *(const v4u*)(p + 2 * stride); v4u o;
    o.x = pk2(bflo(a.x) + bflo(b.x) + bflo(c.x), bfhi(a.x) + bfhi(b.x) + bfhi(c.x)); o.y = pk2(bflo(a.y) + bflo(b.y) + bflo(c.y), bfhi(a.y) + bfhi(b.y) + bfhi(c.y));
    o.z = pk2(bflo(a.z) + bflo(b.z) + bflo(c.z), bfhi(a.z) + bfhi(b.z) + bfhi(c.z)); o.w = pk2(bflo(a.w) + bflo(b.w) + bflo(c.w), bfhi(a.w) + bfhi(b.w) + bfhi(c.w));
    return __builtin_bit_cast(bf16x8, o);
}
template <int RB, int CB, bool SUM3, class EF>
__device__ __forceinline__ void thin_block(const bf16* A, int lda, size_t astride, const bf16* Bt, int K, int row0, int col0, int wave, int lane, LAS unsigned char* lds, const EF& ef) {
    constexpr int NTL = RB * CB; const int r = lane & 15, q = lane >> 4;
    if constexpr (NTL >= 8) {
        constexpr int TPW = NTL / 8, WPR = CB / TPW;
        const int rb = wave / WPR, cb0 = (wave % WPR) * TPW;
        const bf16* a = A + (size_t)(row0 + 16 * rb + r) * lda + 8 * q; const bf16* b = Bt + (size_t)(col0 + 16 * cb0 + r) * K + 8 * q;
        f32x4 acc[TPW];
#pragma unroll
        for (int c = 0; c < TPW; ++c) acc[c] = (f32x4){0.f, 0.f, 0.f, 0.f};
        bf16x8 xa[8], wa[TPW][8], xb[8], wb[TPW][8];
#define THIN_LD(x, w, kk) do { _Pragma("unroll") for (int j = 0; j < 8; ++j) { x[j] = SUM3 ? sum3_bf16x8(a + 32 * ((kk) + j), astride) : *(const bf16x8*)(a + 32 * ((kk) + j)); \
            _Pragma("unroll") for (int c = 0; c < TPW; ++c) w[c][j] = *(const bf16x8*)(b + (size_t)(16 * c) * K + 32 * ((kk) + j)); } } while (0)
#define THIN_MM(x, w) do { _Pragma("unroll") for (int j = 0; j < 8; ++j) _Pragma("unroll") for (int c = 0; c < TPW; ++c) acc[c] = __builtin_amdgcn_mfma_f32_16x16x32_bf16(x[j], w[c][j], acc[c], 0, 0, 0); } while (0)
        THIN_LD(xa, wa, 0);
#pragma unroll 1
        for (int k0 = 0; k0 < K / 32; k0 += 16) {
            THIN_LD(xb, wb, k0 + 8); __builtin_amdgcn_sched_barrier(0); THIN_MM(xa, wa); __builtin_amdgcn_sched_barrier(0);
            if (k0 + 16 < K / 32) THIN_LD(xa, wa, k0 + 16);
            __builtin_amdgcn_sched_barrier(0); THIN_MM(xb, wb); __builtin_amdgcn_sched_barrier(0);
        }
#undef THIN_LD
#undef THIN_MM
#pragma unroll
        for (int c = 0; c < TPW; ++c)
#pragma unroll
            for (int i = 0; i < 4; ++i) ef(row0 + 16 * rb + 4 * q + i, col0 + 16 * (cb0 + c) + r, acc[c][i]);
    } else {
        constexpr int KS = 8 / NTL;
        const int t = wave % NTL, kp = wave / NTL, rb = t / CB, cb = t % CB; const int kw = K / KS;
        const bf16* a = A + (size_t)(row0 + 16 * rb + r) * lda + kp * kw + 8 * q; const bf16* b = Bt + (size_t)(col0 + 16 * cb + r) * K + kp * kw + 8 * q;
        f32x4 acc = {0.f, 0.f, 0.f, 0.f};
        bf16x8 xa[4], wa[4], xb[4], wb[4];
#define THIN_LD(x, w, kk) do { _Pragma("unroll") for (int j = 0; j < 4; ++j) { x[j] = SUM3 ? sum3_bf16x8(a + 32 * ((kk) + j), astride) : *(const bf16x8*)(a + 32 * ((kk) + j)); w[j] = *(const bf16x8*)(b + 32 * ((kk) + j)); } } while (0)
#define THIN_MM(x, w) do { _Pragma("unroll") for (int j = 0; j < 4; ++j) acc = __builtin_amdgcn_mfma_f32_16x16x32_bf16(x[j], w[j], acc, 0, 0, 0); } while (0)
        THIN_LD(xa, wa, 0);
#pragma unroll 1
        for (int k0 = 0; k0 < kw / 32; k0 += 8) {
            THIN_LD(xb, wb, k0 + 4); __builtin_amdgcn_sched_barrier(0); THIN_MM(xa, wa); __builtin_amdgcn_sched_barrier(0);
            if (k0 + 8 < kw / 32) THIN_LD(xa, wa, k0 + 8);
            __builtin_amdgcn_sched_barrier(0); THIN_MM(xb, wb); __builtin_amdgcn_sched_barrier(0);
        }
#undef THIN_LD
#undef THIN_MM
        __syncthreads();
        *(LAS f32x4*)(lds + (wave * 64 + lane) * 16) = acc;
        __syncthreads();
        if (kp == 0) { f32x4 s = acc;
#pragma unroll
            for (int p = 1; p < KS; ++p) s = s + *(const LAS f32x4*)(lds + ((p * NTL + t) * 64 + lane) * 16);
#pragma unroll
            for (int i = 0; i < 4; ++i) ef(row0 + 16 * rb + 4 * q + i, col0 + 16 * cb + r, s[i]); }
    }
}
template <bool SUM3, class EF>
__device__ __forceinline__ void thin_lds(const bf16* A, int lda, size_t astride, const bf16* Bt, int K, int row0, int col0, int tid, int wave, int lane, LAS unsigned char* lds, const EF& ef) {
    const int r = lane & 15, q = lane >> 4, rb = wave >> 1, cb0 = (wave & 1) * 2;
    f32x4 acc[2] = {{0.f, 0.f, 0.f, 0.f}, {0.f, 0.f, 0.f, 0.f}};
    v4u xs[8], wv[8];
    const int prow = tid >> 6, ppc = tid & 63;
#define TL_LD(c) do { _Pragma("unroll") for (int i = 0; i < 8; ++i) { const bf16* ap = A + (size_t)(row0 + prow + 8 * i) * lda + (c) * 512 + ppc * 8; \
        xs[i] = SUM3 ? __builtin_bit_cast(v4u, sum3_bf16x8(ap, astride)) : *(const v4u*)ap; wv[i] = *(const v4u*)(Bt + (size_t)(col0 + prow + 8 * i) * K + (c) * 512 + ppc * 8); } } while (0)
    const int nch = K / 512;
    TL_LD(0);
#pragma unroll 1
    for (int c = 0; c < nch; ++c) {
        __syncthreads();
#pragma unroll
        for (int i = 0; i < 8; ++i) { const int row = prow + 8 * i; const int o = row * 1024 + ((ppc ^ (row & 15)) << 4); *(LAS v4u*)(lds + o) = xs[i]; *(LAS v4u*)(lds + 65536 + o) = wv[i]; }
        __syncthreads();
        if (c + 1 < nch) TL_LD(c + 1);
        __builtin_amdgcn_sched_barrier(0);
#pragma unroll
        for (int ks = 0; ks < 16; ++ks) { const int po = ((4 * ks + q) ^ r) << 4;
            const bf16x8 x = *(const LAS bf16x8*)(lds + (16 * rb + r) * 1024 + po);
            const bf16x8 w0 = *(const LAS bf16x8*)(lds + 65536 + (16 * cb0 + r) * 1024 + po), w1 = *(const LAS bf16x8*)(lds + 65536 + (16 * (cb0 + 1) + r) * 1024 + po);
            acc[0] = __builtin_amdgcn_mfma_f32_16x16x32_bf16(x, w0, acc[0], 0, 0, 0); acc[1] = __builtin_amdgcn_mfma_f32_16x16x32_bf16(x, w1, acc[1], 0, 0, 0); }
    }
#undef TL_LD
#pragma unroll
    for (int c = 0; c < 2; ++c)
#pragma unroll
        for (int i = 0; i < 4; ++i) ef(row0 + 16 * rb + 4 * q + i, col0 + 16 * (cb0 + c) + r, acc[c][i]);
    __syncthreads();
}
struct CtxProj { bf16* P; __device__ __forceinline__ void operator()(int row, int col, float v) const { const float o = (col >= 512 && col < 1536) ? geluf_(v) : v; P[(size_t)row * INW + col] = (bf16)f2bf(o); } };
struct CtxGlu { const bf16* YG; bf16* YA; __device__ __forceinline__ void operator()(int row, int col, float v) const { YA[(size_t)row * MIXW + col] = (bf16)f2bf(bf2f(YG[(size_t)row * MIXW + col]) * sigmoidf_(v)); } };
struct CtxBr { bf16* BR; int kk; __device__ __forceinline__ void operator()(int row, int col, float v) const { BR[(size_t)row * INW + kk * 1024 + col] = (bf16)f2bf(v); } };
struct CtxMerge { const bf16* BR; bf16* PMK; const float* bm; int kk; __device__ __forceinline__ void operator()(int row, int col, float v) const {
    PMK[((size_t)kk * CTX + row) * D + col] = (bf16)f2bf(sigmoidf_(v + bm[kk * 1024 + col]) * bf2f(BR[(size_t)row * INW + kk * 1024 + col])); } };
struct CtxWo { const float* xs; float* XC; const float* ga; __device__ __forceinline__ void operator()(int row, int col, float v) const { XC[(size_t)row * D + col] = xs[(size_t)row * D + col] + ga[col] * v; } };
__device__ __forceinline__ void ph2_ctx(Frame& F, int ncols) {
    const bf16* Hc = (const bf16*)HBUF(F) + (size_t)SEQ * D; const bf16* W = (const bf16*)(F.ws + WS_WIN); CtxProj ef{(bf16*)(F.ws + WS_PROJ) + (size_t)SEQ * INW};
    if (ncols == INW) { for (int it = F.bid; it < 4 * (INW / 64); it += F.G) thin_lds<false>(Hc, D, 0, W, D, (it & 3) * 64, (it >> 2) * 64, F.tid, F.wave, F.lane, F.lds, ef); }
    else { for (int it = F.bid; it < 8 * (ncols / 16); it += F.G) thin_block<2, 1, false>(Hc, D, 0, W, D, (it & 7) * 32, (it >> 3) * 16, F.wave, F.lane, F.lds, ef); }
}
__device__ __forceinline__ void ph7_ctx(Frame& F) {
    for (int it = F.bid; it < 3 * 64; it += F.G) { const int kk = it / 64, j = it % 64; CtxBr ef{(bf16*)(F.ws + WS_PROJ) + (size_t)SEQ * INW, kk};
        thin_lds<false>((const bf16*)(F.ws + WS_YS) + ((size_t)kk * MT + SEQ) * MIXW, MIXW, 0, (const bf16*)(F.ws + WS_WBR) + (size_t)kk * 1024 * MIXW, MIXW, (j & 3) * 64, (j >> 2) * 64, F.tid, F.wave, F.lane, F.lds, ef); }
}
__device__ __forceinline__ void ph8_ctx(Frame& F, int l) {
    const bf16* Hc = (const bf16*)HBUF(F) + (size_t)SEQ * D;
    for (int it = F.bid; it < 3 * 64; it += F.G) { const int kk = it / 64, j = it % 64; CtxMerge ef{(const bf16*)(F.ws + WS_PROJ) + (size_t)SEQ * INW, (bf16*)(F.ws + WS_Z), IN_(I_BMG) + l * INW, kk};
        thin_lds<false>(Hc, D, 0, (const bf16*)(F.ws + WS_WMG) + (size_t)kk * 1024 * D, D, (j & 3) * 64, (j >> 2) * 64, F.tid, F.wave, F.lane, F.lds, ef); }
}
__device__ __forceinline__ void ph9_ctx(Frame& F, int l) {
    CtxWo ef{l == 0 ? IN_(I_CTX) : (const float*)(F.ws + WS_XC), (float*)(F.ws + WS_XC), (const float*)(F.ws + WS_MOD) + (size_t)(l * 2 + 1) * 6144 + 2048};
    for (int it = F.bid; it < 4 * 16; it += F.G) thin_lds<true>((const bf16*)(F.ws + WS_Z), D, (size_t)CTX * D, (const bf16*)(F.ws + WS_WO), D, (it & 3) * 64, (it >> 2) * 64, F.tid, F.wave, F.lane, F.lds, ef);
}
__device__ __forceinline__ void ctx_x1_fixup(Frame& F, int l, int row0) {
    const float* XC = (const float*)(F.ws + WS_XC); float* RSS = (float*)(F.ws + WS_RSS);
    const int rr = row0 + (F.tid >> 5), part = F.tid & 31; const float* xr = XC + (size_t)rr * D + part * 32; float s = 0.f;
#pragma unroll
    for (int c = 0; c < 32; c += 4) { const f32x4 v = *(const f32x4*)(xr + c); s += v.x * v.x + v.y * v.y + v.z * v.z + v.w * v.w; }
    s += shflx(s, 1, F.lane); s += shflx(s, 2, F.lane); s += shflx(s, 4, F.lane); s += shflx(s, 8, F.lane); s += shflx(s, 16, F.lane);
    if (part < 16) RSS[(size_t)(SEQ + rr) * 16 + part] = part == 0 ? s : 0.f;
    asm volatile("s_waitcnt vmcnt(0)" ::: "memory");
    __syncthreads();
}


__device__ __forceinline__ void ph0_prologue(Frame& F) {
    float* mod = (float*)(F.ws + WS_MOD);
    LAS float* SV = (LAS float*)(F.lds + 131072 + 4096);
    for (int i = F.tid; i < 2048; i += NT) SV[i] = siluf_(i < 1024 ? IN_(I_C)[i] : IN_(I_CCTX)[i - 1024]);
    __syncthreads();
    LAS float* RED = (LAS float*)(F.lds + 131072 + 4096 + 8192);
    for (int it = F.bid; it < 2 * 96; it += F.G) { const int l = it / 96, j = (it % 96) * 64 + F.lane;
        const float* W = IN_(I_WADA) + (size_t)l * D * 6144 + j + (size_t)(F.wave * 128) * 6144;
        float a0 = 0.f, a1 = 0.f;
#pragma unroll 32
        for (int kk = 0; kk < 128; ++kk) { const float w = W[(size_t)kk * 6144]; a0 += SV[F.wave * 128 + kk] * w; a1 += SV[1024 + F.wave * 128 + kk] * w; }
        __syncthreads();
        RED[(F.wave * 2 + 0) * 64 + F.lane] = a0; RED[(F.wave * 2 + 1) * 64 + F.lane] = a1;
        __syncthreads();
        if (F.wave < 2) { float s = 0.f;
#pragma unroll
            for (int w8 = 0; w8 < 8; ++w8) s += RED[(w8 * 2 + F.wave) * 64 + F.lane];
            const float mv = s + IN_(I_BADA)[l * 6144 + j]; mod[(size_t)(l * 2 + F.wave) * 6144 + j] = mv;
            if (l == 0 && j < 2048) __hip_atomic_store((unsigned long long*)(F.ws + WS_MG) + F.wave * 2048 + j, (1ull << 32) | __builtin_bit_cast(unsigned, mv), __ATOMIC_RELAXED, __HIP_MEMORY_SCOPE_AGENT); }
    }
}
__device__ __forceinline__ void stage_mod_granules(Frame& F, const float* g, LAS float* GC, LAS float* SH) {
    unsigned long long* MG = (unsigned long long*)(F.ws + WS_MG);
    __syncthreads();
    for (int i0 = F.tid; i0 < 2048; i0 += 4 * NT) { unsigned long long xs[4], xc[4]; unsigned spins = 0;
        for (;;) { bool ok = true;
#pragma unroll
            for (int q = 0; q < 4; ++q) { const int i = i0 + q * NT, w = i >> 10, c = i & 1023; xs[q] = __hip_atomic_load(MG + w * 2048 + c, __ATOMIC_RELAXED, __HIP_MEMORY_SCOPE_AGENT); xc[q] = __hip_atomic_load(MG + w * 2048 + 1024 + c, __ATOMIC_RELAXED, __HIP_MEMORY_SCOPE_AGENT); }
#pragma unroll
            for (int q = 0; q < 4; ++q) ok = ok && (unsigned)(xs[q] >> 32) == 1u && (unsigned)(xc[q] >> 32) == 1u;
            if (ok) break; __builtin_amdgcn_s_sleep(2); if (++spins > (1u << 22)) break; }
#pragma unroll
        for (int q = 0; q < 4; ++q) { const int i = i0 + q * NT, c = i & 1023; GC[i] = g[c] * (1.f + __builtin_bit_cast(float, (unsigned)xc[q])); SH[i] = __builtin_bit_cast(float, (unsigned)xs[q]); } }
    __syncthreads();
}
__device__ __forceinline__ void stage_mod(Frame& F, const float* g, int l, int sh_off, int sc_off, LAS float* GC, LAS float* SH) {
    __syncthreads();
    for (int i = F.tid; i < 2048; i += NT) { const int w = i >> 10, c = i & 1023; const float* m = (const float*)(F.ws + WS_MOD) + (size_t)(l * 2 + w) * 6144; GC[i] = g[c] * (1.f + m[sc_off + c]); SH[i] = m[sh_off + c]; }
    __syncthreads();
}
__device__ __forceinline__ void hprep_rows(Frame& F, int l) {
    bf16* H = (bf16*)HBUF(F); LAS float* GC = (LAS float*)F.lds; LAS float* SH = GC + 2048;
    stage_mod_granules(F, IN_(I_GMIX) + l * D, GC, SH);
    const int gw = F.bid * (NT / 64) + F.wave, ngw = F.G * (NT / 64);
    for (int row0 = gw; row0 < MT; row0 += 2 * ngw) {
        int rows[2]; bool ok[2]; f32x4 v[2][4]; float s[2] = {0.f, 0.f};
#pragma unroll
        for (int t = 0; t < 2; ++t) { rows[t] = row0 + t * ngw; ok[t] = rows[t] < MT; if (!ok[t]) rows[t] = row0; }
#pragma unroll
        for (int t = 0; t < 2; ++t) { const float* xr = xin_row(F, rows[t]);
#pragma unroll
            for (int j = 0; j < 4; ++j) v[t][j] = *(const f32x4*)(xr + 4 * F.lane + 256 * j); }
#pragma unroll
        for (int t = 0; t < 2; ++t)
#pragma unroll
            for (int j = 0; j < 4; ++j) s[t] += v[t][j].x * v[t][j].x + v[t][j].y * v[t][j].y + v[t][j].z * v[t][j].z + v[t][j].w * v[t][j].w;
#pragma unroll
        for (int t = 0; t < 2; ++t) { if (!ok[t]) continue; const int pv = rows[t] >= SEQ ? 1024 : 0;
            const float rstd = rsqrtf(wave_sum(s[t], F.lane) * (1.f / D) + EPS);
#pragma unroll
            for (int j = 0; j < 4; ++j) { const int c = 4 * F.lane + 256 * j; const f32x4 gc = *(const LAS f32x4*)(GC + pv + c), sh = *(const LAS f32x4*)(SH + pv + c);
                const f32x4 o = v[t][j] * rstd * gc + sh; v2u w; w.x = pk2(o.x, o.y); w.y = pk2(o.z, o.w); *(v2u*)(H + (size_t)rows[t] * D + c) = w; } }
    }
}
__device__ __forceinline__ void ph3_conv(Frame& F, int l, int nrows) {
    const bf16* PROJ = (const bf16*)(F.ws + WS_PROJ); bf16* YC = (bf16*)(F.ws + WS_YS) + (size_t)2 * MT * MIXW; const float* wc = IN_(I_WCONV) + l * 3 * MIXW;
    const size_t gt = (size_t)F.bid * NT + F.tid, ngt = (size_t)F.G * NT;
#pragma unroll 2
    for (size_t i = gt; i < (size_t)nrows * (MIXW / 8); i += ngt) {
        const int row = (int)(i / (MIXW / 8)), c = (int)(i % (MIXW / 8)) * 8;
        int pos, rl; if (row < SEQ) { pos = row & 63; rl = 64; } else { pos = row - SEQ; rl = 256; }
        const bf16* r0 = PROJ + (size_t)row * INW + 1536 + c;
        const v4u zero = {0u, 0u, 0u, 0u};
        const v4u b0 = *(const v4u*)(r0), c0 = *(const v4u*)(r0 + 512), h0 = *(const v4u*)(r0 + 1024);
        const v4u cm = pos > 0 ? *(const v4u*)(r0 - INW + 512) : zero, hm = pos > 0 ? *(const v4u*)(r0 - INW + 1024) : zero;
        const v4u cp = pos < rl - 1 ? *(const v4u*)(r0 + INW + 512) : zero, hp = pos < rl - 1 ? *(const v4u*)(r0 + INW + 1024) : zero;
        const f32x4 w0a = *(const f32x4*)(wc + c), w0b = *(const f32x4*)(wc + c + 4), w1a = *(const f32x4*)(wc + 512 + c), w1b = *(const f32x4*)(wc + 512 + c + 4), w2a = *(const f32x4*)(wc + 1024 + c), w2b = *(const f32x4*)(wc + 1024 + c + 4);
        const float w0[8] = {w0a.x, w0a.y, w0a.z, w0a.w, w0b.x, w0b.y, w0b.z, w0b.w}, w1[8] = {w1a.x, w1a.y, w1a.z, w1a.w, w1b.x, w1b.y, w1b.z, w1b.w}, w2[8] = {w2a.x, w2a.y, w2a.z, w2a.w, w2b.x, w2b.y, w2b.z, w2b.w};
        const unsigned bb[4] = {b0.x, b0.y, b0.z, b0.w}, cc[4] = {c0.x, c0.y, c0.z, c0.w}, hh[4] = {h0.x, h0.y, h0.z, h0.w}, cmv[4] = {cm.x, cm.y, cm.z, cm.w}, hmv[4] = {hm.x, hm.y, hm.z, hm.w}, cpv[4] = {cp.x, cp.y, cp.z, cp.w}, hpv[4] = {hp.x, hp.y, hp.z, hp.w};
        unsigned o[4];
#pragma unroll
        for (int j = 0; j < 4; ++j) {
            const float ylo = bflo(bb[j]) * (w0[2 * j] * (bflo(cmv[j]) * bflo(hmv[j])) + w1[2 * j] * (bflo(cc[j]) * bflo(hh[j])) + w2[2 * j] * (bflo(cpv[j]) * bflo(hpv[j])));
            const float yhi = bfhi(bb[j]) * (w0[2 * j + 1] * (bfhi(cmv[j]) * bfhi(hmv[j])) + w1[2 * j + 1] * (bfhi(cc[j]) * bfhi(hh[j])) + w2[2 * j + 1] * (bfhi(cpv[j]) * bfhi(hpv[j])));
            o[j] = pk2(ylo, yhi); }
        v4u ov; ov.x = o[0]; ov.y = o[1]; ov.z = o[2]; ov.w = o[3]; *(v4u*)(YC + (size_t)row * MIXW + c) = ov;
    }
}
template <int KS, bool LDSW>
__device__ __forceinline__ void route_pass(Frame& F, int l, int u, bool valid, int kh, int sl, LAS float* GC, LAS float* SH, LAS float* SSQ, LAS float* LG, LAS int* HISTL) {
    bf16* H = (bf16*)HBUF(F); const bf16* WRh = (const bf16*)(F.ws + WS_WR); const bf16* WRl = WRh + 48 * 1024;
    const float* bg = IN_(I_BGRP) + l * 4; const float* be = IN_(I_BEXP) + l * 32;
    int* EID = (int*)(F.ws + WS_EID); float* EW = (float*)(F.ws + WS_EW);
    constexpr int NK = 32 / KS, KW = 1024 / KS;
    const int r = F.lane & 15, q = F.lane >> 4;
    const int uu = valid ? u : 0; const int row = uu * 16 + r; const int pv = (row >= SEQ ? 1024 : 0) + kh * KW + 8 * q;
    const float* xr = (const float*)(F.ws + WS_XC) + (size_t)(KS == 2 ? 0 : row - SEQ) * D + kh * KW + 8 * q;
    const bf16* xr16 = (const bf16*)(F.ws + WS_X16) + (size_t)(KS == 2 ? row : 0) * D + kh * KW + 8 * q;
    const f32x4 rp = *(const f32x4*)((const float*)(F.ws + WS_RSS) + (size_t)row * 16 + 4 * q);
    float tot = (rp.x + rp.y) + (rp.z + rp.w); tot += shflx(tot, 16, F.lane); tot += shflx(tot, 32, F.lane);
    const float rstd = rsqrtf(tot * (1.f / D) + EPS);
    __syncthreads();
    (void)SSQ;
    f32x4 acc[3] = {{0.f, 0.f, 0.f, 0.f}, {0.f, 0.f, 0.f, 0.f}, {0.f, 0.f, 0.f, 0.f}};
    LAS unsigned char* WB = F.lds + 45056;
    v4u stg[6];
    if constexpr (LDSW) {
#pragma unroll
        for (int i = 0; i < 6; ++i) { const int pid = F.tid + NT * i, ln = pid & 63, rest = pid >> 6, ks = rest & 3, cb = (rest >> 2) % 3, hl = (rest / 12) & 1, khh = rest / 24;
            stg[i] = *(const v4u*)((hl ? WRl : WRh) + (size_t)(cb * 16 + (ln & 15)) * 1024 + khh * 512 + 32 * ks + 8 * (ln >> 4)); }
    }
    v4u xall[KS == 2 ? 16 : 1];
    if constexpr (KS == 2) {
#pragma unroll
        for (int j = 0; j < 16; ++j) xall[j] = *(const v4u*)(xr16 + 32 * j); }
#pragma unroll
    for (int k0 = 0; k0 < NK; k0 += 4) {
        f32x4 xa[4][2]; bf16x8 Bh[4][3], Bl[4][3];
        if constexpr (LDSW) {
            __syncthreads();
#pragma unroll
            for (int i = 0; i < 6; ++i) *(LAS v4u*)(WB + (F.tid + NT * i) * 16) = stg[i];
            __syncthreads();
            if (k0 + 4 < NK) {
#pragma unroll
                for (int i = 0; i < 6; ++i) { const int pid = F.tid + NT * i, ln = pid & 63, rest = pid >> 6, ks = rest & 3, cb = (rest >> 2) % 3, hl = (rest / 12) & 1, khh = rest / 24;
                    stg[i] = *(const v4u*)((hl ? WRl : WRh) + (size_t)(cb * 16 + (ln & 15)) * 1024 + khh * 512 + 32 * (k0 + 4 + ks) + 8 * (ln >> 4)); } }
        }
#pragma unroll
        for (int j = 0; j < 4; ++j) { const int c = 32 * (k0 + j);
            if constexpr (KS == 2) { xa[j][0] = __builtin_bit_cast(f32x4, xall[k0 + j]); } else { xa[j][0] = *(const f32x4*)(xr + c); xa[j][1] = *(const f32x4*)(xr + c + 4); }
#pragma unroll
            for (int cb = 0; cb < 3; ++cb) {
                if constexpr (!LDSW) { const size_t wo = (size_t)(cb * 16 + r) * 1024 + kh * KW + c + 8 * q; Bh[j][cb] = *(const bf16x8*)(WRh + wo); Bl[j][cb] = *(const bf16x8*)(WRl + wo); } } }
#pragma unroll
        for (int j = 0; j < 4; ++j) { const int c = 32 * (k0 + j);
            const f32x4 g0 = *(const LAS f32x4*)(GC + pv + c), g1 = *(const LAS f32x4*)(GC + pv + c + 4), sh0 = *(const LAS f32x4*)(SH + pv + c), sh1 = *(const LAS f32x4*)(SH + pv + c + 4);
            if constexpr (KS == 2) { const v4u w = __builtin_bit_cast(v4u, xa[j][0]); xa[j][0] = (f32x4){bflo(w.x), bfhi(w.x), bflo(w.y), bfhi(w.y)}; xa[j][1] = (f32x4){bflo(w.z), bfhi(w.z), bflo(w.w), bfhi(w.w)}; }
            const f32x4 h0 = xa[j][0] * rstd * g0 + sh0, h1 = xa[j][1] * rstd * g1 + sh1;
            v4u hi; hi.x = pk2(h0.x, h0.y); hi.y = pk2(h0.z, h0.w); hi.z = pk2(h1.x, h1.y); hi.w = pk2(h1.z, h1.w);
            if (valid) *(v4u*)(H + (size_t)row * D + kh * KW + 8 * q + c) = hi;
            v4u lo; lo.x = pk2(h0.x - bflo(hi.x), h0.y - bfhi(hi.x)); lo.y = pk2(h0.z - bflo(hi.y), h0.w - bfhi(hi.y)); lo.z = pk2(h1.x - bflo(hi.z), h1.y - bfhi(hi.z)); lo.w = pk2(h1.z - bflo(hi.w), h1.w - bfhi(hi.w));
            const bf16x8 Ah = __builtin_bit_cast(bf16x8, hi), Al = __builtin_bit_cast(bf16x8, lo);
#pragma unroll
            for (int cb = 0; cb < 3; ++cb) {
                bf16x8 bh, bl;
                if constexpr (LDSW) { bh = *(const LAS bf16x8*)(WB + ((kh * 24 + cb * 4 + j) * 64 + F.lane) * 16); bl = *(const LAS bf16x8*)(WB + ((kh * 24 + 12 + cb * 4 + j) * 64 + F.lane) * 16); }
                else { bh = Bh[j][cb]; bl = Bl[j][cb]; }
                acc[cb] = __builtin_amdgcn_mfma_f32_16x16x32_bf16(Ah, bh, acc[cb], 0, 0, 0); acc[cb] = __builtin_amdgcn_mfma_f32_16x16x32_bf16(Al, bh, acc[cb], 0, 0, 0); acc[cb] = __builtin_amdgcn_mfma_f32_16x16x32_bf16(Ah, bl, acc[cb], 0, 0, 0); } }
    }
    LAS float* LGw = LG + (sl * KS + kh) * (16 * 52);
#pragma unroll
    for (int cb = 0; cb < 3; ++cb)
#pragma unroll
        for (int i = 0; i < 4; ++i) LGw[(4 * q + i) * 52 + cb * 16 + r] = acc[cb][i];
    __syncthreads();
    if (kh == 0 && valid && F.lane < 16) { const LAS float* L0 = LG + (sl * KS) * (16 * 52) + F.lane * 52; const int rw = u * 16 + F.lane;
        float lg[36];
#pragma unroll
        for (int o = 0; o < 36; ++o) { float t = 0.f;
#pragma unroll
            for (int i = 0; i < KS; ++i) t += L0[i * (16 * 52) + o]; lg[o] = t + (o < 4 ? bg[o] : be[o - 4]); }
        LAS float* LW = LG + (sl * KS) * (16 * 52) + F.lane * 52;
#pragma unroll
        for (int o = 0; o < 36; ++o) LW[o] = lg[o];
        int gi = 0; float gm = lg[0];
#pragma unroll
        for (int o = 1; o < 4; ++o) if (lg[o] > gm) { gm = lg[o]; gi = o; }
        float den = 0.f;
#pragma unroll
        for (int o = 0; o < 4; ++o) den += expf(lg[o] - gm);
        const float gp = 1.f / den;
        const LAS float* el = LW + 4 + gi * 8;
        int i1 = 0; float m1 = el[0]; for (int o = 1; o < 8; ++o) { const float v = el[o]; if (v > m1) { m1 = v; i1 = o; } }
        int i2 = -1; float m2 = 0.f; for (int o = 0; o < 8; ++o) { const float v = el[o]; if (o != i1 && (i2 < 0 || v > m2)) { m2 = v; i2 = o; } }
        const float e2 = expf(m2 - m1); const float w1 = 1.f / (1.f + e2), w2 = e2 / (1.f + e2);
        const int e1i = gi * 8 + i1, e2i = gi * 8 + i2;
        EID[rw * 2] = e1i; EID[rw * 2 + 1] = e2i; EW[rw * 2] = gp * w1; EW[rw * 2 + 1] = gp * w2;
        __hip_atomic_fetch_add(&HISTL[e1i], 1, __ATOMIC_RELAXED, __HIP_MEMORY_SCOPE_WORKGROUP); __hip_atomic_fetch_add(&HISTL[e2i], 1, __ATOMIC_RELAXED, __HIP_MEMORY_SCOPE_WORKGROUP);
    }
}
__device__ __forceinline__ void ph10_route(Frame& F, int l) {
    const float* g = IN_(I_GFFN) + l * D;
    LAS float* GC = (LAS float*)F.lds;
    LAS float* SH = GC + 2048;
    LAS float* SSQ = SH + 2048;
    LAS float* LG = SSQ + 128;
    LAS int* HISTL = (LAS int*)(LG + 8 * 16 * 52);
    __syncthreads();
    if (F.tid < 32) HISTL[F.tid] = 0;
    for (int i = F.tid; i < 2048; i += NT) { const int w = i >> 10, c = i & 1023; const float* m = (const float*)(F.ws + WS_MOD) + (size_t)(l * 2 + w) * 6144; GC[i] = g[c] * (1.f + m[4096 + c]); SH[i] = m[3072 + c]; }
#pragma unroll 1
    for (int u0 = F.bid; u0 < SEQ / 16; u0 += 4 * F.G) { const int u = u0 + (F.wave >> 1) * F.G; route_pass<2, true>(F, l, u, u < SEQ / 16, F.wave & 1, F.wave >> 1, GC, SH, SSQ, LG, HISTL); }
    if (l == 0) {
#pragma unroll 1
        for (int u0 = SEQ / 16 + F.bid; u0 < MT / 16; u0 += F.G) { ctx_x1_fixup(F, l, (u0 - SEQ / 16) * 16); route_pass<8, false>(F, l, u0, true, F.wave, 0, GC, SH, SSQ, LG, HISTL); }
    }
    __syncthreads();
    if (F.tid < 32) __hip_atomic_store((unsigned long long*)(F.ws + WS_HG) + F.bid * 32 + F.tid, ((unsigned long long)((unsigned)l + 1u) << 32) | (unsigned)HISTL[F.tid], __ATOMIC_RELAXED, __HIP_MEMORY_SCOPE_AGENT);
}
__device__ __forceinline__ void ph11_scatter(Frame& F, int l) {
    const bf16* H = (const bf16*)HBUF(F); bf16* HS = (bf16*)(F.ws + WS_HS);
    const int* EID = (const int*)(F.ws + WS_EID); const float* EW = (const float*)(F.ws + WS_EW); int* STOK = (int*)(F.ws + WS_STOK); float* SW = (float*)(F.ws + WS_SW); int* TSLOT = (int*)(F.ws + WS_TSLOT);
    unsigned* cnt = F.ctl + CW_CNT + l * 128; unsigned long long* HG = (unsigned long long*)(F.ws + WS_HG); const unsigned tag = (unsigned)l + 1u;
    LAS int* HIST = (LAS int*)F.lds; LAS int* BASE = HIST + 32; LAS int* ISLOT = BASE + 32; LAS int* IROW = ISLOT + 512; LAS int* PT = IROW + 512; LAS int* PB = PT + 512;
    const int nunits = (l == 0 ? MT : SEQ) / 16;
    __syncthreads();
    { const int e = F.tid & 31, ch = F.tid >> 5; int tot = 0, bas = 0;
      for (int b0 = ch; b0 < F.G; b0 += 256) {
          unsigned long long xs[16]; unsigned spins = 0;
          for (;;) { bool ok = true;
#pragma unroll
              for (int i = 0; i < 16; ++i) { const int b = b0 + 16 * i; xs[i] = b < F.G ? __hip_atomic_load(HG + b * 32 + e, __ATOMIC_RELAXED, __HIP_MEMORY_SCOPE_AGENT) : ((unsigned long long)tag << 32); }
#pragma unroll
              for (int i = 0; i < 16; ++i) ok = ok && (unsigned)(xs[i] >> 32) == tag;
              if (ok) break; __builtin_amdgcn_s_sleep(2); if (++spins > (1u << 22)) break; }
#pragma unroll
          for (int i = 0; i < 16; ++i) { const int b = b0 + 16 * i; const int h = (int)(unsigned)xs[i]; tot += h; if (b < F.bid) bas += h; } }
      PT[F.tid] = tot; PB[F.tid] = bas; }
    __syncthreads();
    if (F.tid < 32) { int tot = 0, bas = 0; for (int ch = 0; ch < 16; ++ch) { tot += PT[ch * 32 + F.tid]; bas += PB[ch * 32 + F.tid]; } HIST[F.tid] = 0; PT[F.tid] = tot; PB[F.tid] = bas; if (F.bid == 0) cnt[F.tid] = (unsigned)tot; }
    __syncthreads();
    if (F.tid < 32) { int off = 0; for (int i = 0; i < F.tid; ++i) off += (PT[i] + 255) & ~255; BASE[F.tid] = off + PB[F.tid]; }
    __syncthreads();
    const int w = F.tid >> 5; int u = F.bid + w * F.G; bool valid = u < SEQ / 16;
    if (w == 15) { u = SEQ / 16 + F.bid; valid = u < nunits; }
    const int row = u * 16 + ((F.tid >> 1) & 15), kk = F.tid & 1;
    int e = 0, rank = 0; if (valid) { e = EID[row * 2 + kk]; rank = __hip_atomic_fetch_add(&HIST[e], 1, __ATOMIC_RELAXED, __HIP_MEMORY_SCOPE_WORKGROUP); }
    __syncthreads();
    int slot = -1; if (valid) { slot = BASE[e] + rank; STOK[slot] = row; SW[slot] = EW[row * 2 + kk]; TSLOT[row * 2 + kk] = slot; }
    (void)H; (void)HS; (void)ISLOT; (void)IROW;
    for (int e = F.bid; e < NE; e += F.G) { const int start = BASE[e] - PB[e], n = PT[e], seg = (n + 255) & ~255; for (int i = n + F.tid; i < seg; i += NT) STOK[start + i] = 0; }
}
template <bool CX>
__device__ __forceinline__ void combine_rows(Frame& F, int l, const LAS float* GC, const LAS float* SH, const LAS float* GA) {
    const bf16* YS2 = (const bf16*)(F.ws + WS_YS2); const int* TSLOT = (const int*)(F.ws + WS_TSLOT) + (CX ? 2 * SEQ : 0); bf16* H = (bf16*)HBUF(F) + (CX ? (size_t)SEQ * D : 0);
    bf16* X16 = (bf16*)(F.ws + WS_X16); float* XC = (float*)(F.ws + WS_XC); float* out = F.out;
    const int gw = F.bid * (NT / 64) + F.wave, ngw = F.G * (NT / 64);
    constexpr int nrows = CX ? CTX : SEQ, pv = CX ? 1024 : 0;
    constexpr int NR = 4;
    int sln[NR][2] = {};
    if (gw < nrows) {
#pragma unroll
        for (int t = 0; t < NR; ++t) { const int r = gw + t * ngw < nrows ? gw + t * ngw : gw; sln[t][0] = TSLOT[r * 2]; sln[t][1] = TSLOT[r * 2 + 1]; } }
    for (int row0 = gw; row0 < nrows; row0 += NR * ngw) {
        int rows[NR]; bool ok[NR];
#pragma unroll
        for (int t = 0; t < NR; ++t) { rows[t] = row0 + t * ngw; ok[t] = rows[t] < nrows; if (!ok[t]) rows[t] = row0; }
        int sl[NR][2];
#pragma unroll
        for (int t = 0; t < NR; ++t) { sl[t][0] = sln[t][0]; sl[t][1] = sln[t][1]; }
        { const int n0 = row0 + NR * ngw; if (n0 < nrows) {
#pragma unroll
            for (int t = 0; t < NR; ++t) { const int r = n0 + t * ngw < nrows ? n0 + t * ngw : n0; sln[t][0] = TSLOT[r * 2]; sln[t][1] = TSLOT[r * 2 + 1]; } } }
        v4u ya[NR][2], yb[NR][2], xb[NR][2]; f32x4 xf[NR][2][2];
#pragma unroll
        for (int t = 0; t < NR; ++t)
#pragma unroll
            for (int j = 0; j < 2; ++j) { const int c = 8 * F.lane + 512 * j;
                if constexpr (CX) { xf[t][j][0] = *(const f32x4*)(XC + (size_t)rows[t] * D + c); xf[t][j][1] = *(const f32x4*)(XC + (size_t)rows[t] * D + c + 4); }
                else xb[t][j] = *(const v4u*)(X16 + (size_t)rows[t] * D + c);
                ya[t][j] = *(const v4u*)(YS2 + (size_t)sl[t][0] * D + c); yb[t][j] = *(const v4u*)(YS2 + (size_t)sl[t][1] * D + c); }
        f32x4 v[NR][2][2]; float s[NR] = {};
#pragma unroll
        for (int t = 0; t < NR; ++t)
#pragma unroll
            for (int j = 0; j < 2; ++j) { const int c = 8 * F.lane + 512 * j; const v4u a = ya[t][j], b = yb[t][j];
                if constexpr (!CX) { const v4u w = xb[t][j]; xf[t][j][0] = (f32x4){bflo(w.x), bfhi(w.x), bflo(w.y), bfhi(w.y)}; xf[t][j][1] = (f32x4){bflo(w.z), bfhi(w.z), bflo(w.w), bfhi(w.w)}; }
                const f32x4 y0 = {bflo(a.x) + bflo(b.x), bfhi(a.x) + bfhi(b.x), bflo(a.y) + bflo(b.y), bfhi(a.y) + bfhi(b.y)}, y1 = {bflo(a.z) + bflo(b.z), bfhi(a.z) + bfhi(b.z), bflo(a.w) + bflo(b.w), bfhi(a.w) + bfhi(b.w)};
                const f32x4 o0 = xf[t][j][0] + *(const LAS f32x4*)(GA + pv + c) * y0, o1 = xf[t][j][1] + *(const LAS f32x4*)(GA + pv + c + 4) * y1; v[t][j][0] = o0; v[t][j][1] = o1;
                s[t] += (o0.x * o0.x + o0.y * o0.y + o0.z * o0.z + o0.w * o0.w) + (o1.x * o1.x + o1.y * o1.y + o1.z * o1.z + o1.w * o1.w); }
#pragma unroll
        for (int t = 0; t < NR; ++t) { if (!ok[t]) continue;
            const float rstd = rsqrtf(wave_sum(s[t], F.lane) * (1.f / D) + EPS); const size_t ro = (size_t)rows[t] * D;
            if (l == 0) {
#pragma unroll
                for (int j = 0; j < 2; ++j) { const int c = 8 * F.lane + 512 * j; const f32x4 o0 = v[t][j][0], o1 = v[t][j][1];
                    if constexpr (CX) { *(f32x4*)(XC + ro + c) = o0; *(f32x4*)(XC + ro + c + 4) = o1; }
                    else { v4u w; w.x = pk2(o0.x, o0.y); w.y = pk2(o0.z, o0.w); w.z = pk2(o1.x, o1.y); w.w = pk2(o1.z, o1.w); *(v4u*)(X16 + ro + c) = w; }
                    const f32x4 h0 = o0 * rstd * *(const LAS f32x4*)(GC + pv + c) + *(const LAS f32x4*)(SH + pv + c), h1 = o1 * rstd * *(const LAS f32x4*)(GC + pv + c + 4) + *(const LAS f32x4*)(SH + pv + c + 4);
                    v4u hw; hw.x = pk2(h0.x, h0.y); hw.y = pk2(h0.z, h0.w); hw.z = pk2(h1.x, h1.y); hw.w = pk2(h1.z, h1.w); *(v4u*)(H + ro + c) = hw; }
            } else if constexpr (!CX) {
#pragma unroll
                for (int j = 0; j < 2; ++j) { const int c = 8 * F.lane + 512 * j; f32x4 o0 = v[t][j][0] * rstd * *(const LAS f32x4*)(GC + c), o1 = v[t][j][1] * rstd * *(const LAS f32x4*)(GC + c + 4);
                    if (PROBE_B >= 0 && rows[t] < 3906 && F.bid >= PROBE_LO && F.bid < PROBE_HI) { volatile LAS unsigned long long* TS = (volatile LAS unsigned long long*)(F.lds + TS_OFF); const float dd = 0.1f + 0.00001f * (float)(TS[PROBE_B1] - TS[PROBE_B]); o0 = o0 + dd; o1 = o1 + dd; }
                    if (PROBE_A == 98 && rows[t] == 0 && j == 0 && F.lane == 0) { const unsigned w = __hip_atomic_load(F.ctl + 100, __ATOMIC_RELAXED, __HIP_MEMORY_SCOPE_AGENT); o0.x += 1.f + 0.001f * (float)w; }
                    else if (PROBE_A == 99 && rows[t] == 0 && j == 0 && F.lane == 0) { const unsigned w = __hip_atomic_load(F.ctl + 100, __ATOMIC_RELAXED, __HIP_MEMORY_SCOPE_AGENT); o0.x += PROBE_AROW ? 1.f + 0.01f * (float)(w & 255u) : 1.f + 0.001f * (float)(w >> 8); }
                    else if (PROBE_A >= 0 && rows[t] == PROBE_AROW && j == 0 && F.lane == 0) { volatile LAS unsigned long long* TS = (volatile LAS unsigned long long*)(F.lds + TS_OFF); o0.x += 1.f + 0.001f * (float)(TS[PROBE_A1] - TS[PROBE_A]); }
                    *(f32x4*)(out + ro + c) = o0; *(f32x4*)(out + ro + c + 4) = o1; }
            }
        }
    }
}
__device__ __forceinline__ void ph14_combine(Frame& F, int l) {
    LAS float* GC = (LAS float*)F.lds; LAS float* SH = GC + 2048; LAS float* GA = SH + 2048;
    if (l == 0) stage_mod(F, IN_(I_GMIX) + D, 1, 0, 1024, GC, SH); else { __syncthreads(); for (int i = F.tid; i < 1024; i += NT) GC[i] = IN_(I_GF)[i]; }
    for (int i = F.tid; i < 2048; i += NT) GA[i] = ((const float*)(F.ws + WS_MOD))[(size_t)(l * 2 + (i >> 10)) * 6144 + 5120 + (i & 1023)];
    __syncthreads();
    combine_rows<false>(F, l, GC, SH, GA);
    if (l == 0) combine_rows<true>(F, l, GC, SH, GA);
}

constexpr int NPH = 1 + 8 * 2;
__device__ __forceinline__ Frame make_frame(LAS unsigned char* lds, int wave0) {
    Frame F; F.lds = lds; F.wave = wave0; F.lane = (int)__builtin_amdgcn_mbcnt_hi(~0u, __builtin_amdgcn_mbcnt_lo(~0u, 0u)); asm volatile("" : "+v"(F.lane)); F.tid = F.wave * 64 + F.lane; F.bid = blockIdx.x; F.G = gridDim.x; asm volatile("" : "+s"(F.G), "+s"(F.bid));
    F.tab = (const unsigned long long LAS*)(lds + TAB_OFF);
    volatile LAS unsigned long long* t = (volatile LAS unsigned long long*)(lds + TAB_OFF);
    F.ws = (unsigned char*)(GAS unsigned char*)uni64(t[35]); F.out = (float*)(GAS float*)uni64(t[36]); F.ctl = (unsigned*)(F.ws + WS_CTL);
    return F;
}
__global__ void __launch_bounds__(NT, 2) mega_fwd(Args args) {
    extern __shared__ __attribute__((aligned(16))) unsigned char lds_raw[];
    LAS unsigned char* const lds = (LAS unsigned char*)lds_raw;
    const int wave0 = __builtin_amdgcn_readfirstlane((int)threadIdx.x >> 6);
    for (int u = threadIdx.x; u < 1024 / 4; u += NT) ((LAS unsigned*)(lds + 131072))[u] = 0u;
    if (threadIdx.x == 0) { LAS unsigned long long* t = (LAS unsigned long long*)(lds + TAB_OFF);
#pragma unroll
        for (int i = 0; i < 35; ++i) t[i] = (unsigned long long)args.in[i];
        t[35] = (unsigned long long)args.ws; t[36] = (unsigned long long)args.out; }
    __syncthreads();
    { Frame F = make_frame(lds, wave0); (void)xcd_barrier_post(F.ctl + CW_BAR, (volatile LAS unsigned*)(lds + MISC_OFF) + 8); }
    if ((PROBE_A >= 0 || PROBE_B >= 0) && threadIdx.x == 0) ((volatile LAS unsigned long long*)(lds + TS_OFF))[0] = __builtin_amdgcn_s_memrealtime();
    const int lo = args.ph_lo, hi = args.ph_hi; int ph = 0;
#define GRIDBAR() do { Frame Fb = make_frame(lds, wave0); XcdBarrier bar; bar.bar = Fb.ctl + CW_BAR; bar.x = xb_xcc_id(); bar.st = (volatile LAS unsigned*)(lds + MISC_OFF) + 8; xcd_barrier(bar, Fb.tid == 0); } while (0)
#ifndef REPBAR
#define REPBAR 0
#endif
#ifndef REPMASK
#define REPMASK 0
#endif
#define PHASE(...) do { if (lo <= ph && ph < hi) { const int _pl = ph < 1 ? ph : 1 + (ph - 1) % 8; for (int _rep = 0; _rep <= ((REPMASK >> _pl) & 1); ++_rep) { Frame F = make_frame(lds, wave0); __VA_ARGS__; } if ((PROBE_A >= 0 || PROBE_B >= 0) && threadIdx.x == 0) { volatile LAS unsigned long long* TS_ = (volatile LAS unsigned long long*)(lds + TS_OFF); TS_[32 + ph] = __builtin_amdgcn_s_memrealtime(); if (PROBE_A == 98 && ph == PROBE_PH) { Frame Fp = make_frame(lds, wave0); __hip_atomic_fetch_max(Fp.ctl + 100, (unsigned)(TS_[32 + ph] - TS_[ph]), __ATOMIC_RELAXED, __HIP_MEMORY_SCOPE_AGENT); } } if (ph + 1 < hi) { GRIDBAR(); if (REPBAR) GRIDBAR(); } if ((PROBE_A >= 0 || PROBE_B >= 0) && threadIdx.x == 0) ((volatile LAS unsigned long long*)(lds + TS_OFF))[1 + ph] = __builtin_amdgcn_s_memrealtime(); } ++ph; } while (0)
    PHASE({ ph0_prologue(F); s5_precompute(F); __syncthreads(); convert_weights(F, 0, 0, F.G > 128 ? F.G - 64 : F.G, 0, CONV_NITEMS, true); { const f32x4* s = (const f32x4*)IN_(I_CTX); f32x4* d = (f32x4*)(F.ws + WS_XC); for (int i = F.bid * NT + F.tid; i < CTX * D / 4; i += F.G * NT) d[i] = s[i]; }  hprep_rows(F, 0); });
#pragma unroll 1
    for (int l = 0; l < 2; ++l) {
        PHASE({ ph2_fast(F, l); ph2_ctx(F, l == 0 ? INW : MIXW); });
        PHASE({ s5_fused_phase(F, l); for (int it = F.bid; it < 2 * (SEQ / 128); it += F.G) sg_fast_item(F, l, (it & 7) + 8 * (it >> 4), (it >> 3) & 1);        ph3_conv(F, l, l == 0 ? MT : SEQ); });
        PHASE({ ph6_fast(F, l); if (l == 0 && F.bid >= F.G - 4) { const int it = F.bid - (F.G - 4); sg_fast_item(F, 0, SEQ / 128 + (it >> 1), it & 1); }
                if (l == 0 && F.G >= 200) convert_weights(F, 1, 130, F.G - 134, 0, CONV_IN, false); });
        PHASE({ ph7_fast(F, l); if (l == 0) ph7_ctx(F); ph8_fast(F, l); if (l == 0) ph8_ctx(F, l); });
        PHASE({ ph9_fast(F, l); if (l == 0) ph9_ctx(F, l); });
        PHASE({ ph10_route(F, l); ph11_scatter(F, l); });
        PHASE(ph12_moe(F, l));
        PHASE({ ph14_combine(F, l); if (l == 0) { __syncthreads(); convert_weights(F, 1, 0, F.G, F.G >= 200 ? CONV_IN : 0, CONV_NITEMS, true); } });
    }
#undef PHASE
}

extern "C" void kernel_launch(void* const* d_in, const int* in_sizes, int n_in, void* d_out, int out_size, void* d_ws, size_t ws_size, hipStream_t stream) {
    static int grid = 0;
    if (grid == 0) {
        int dev = 0, cus = 0, per_cu = 0;
        if (n_in != 35 || out_size != SEQ * D || ws_size < WS_END) { fprintf(stderr, "kernel_launch: unexpected shapes (n_in %d out %d ws %zu)\n", n_in, out_size, ws_size); grid = -1; return; }
        if (hipGetDevice(&dev) != hipSuccess || hipDeviceGetAttribute(&cus, hipDeviceAttributeMultiprocessorCount, dev) != hipSuccess) { grid = -1; return; }
        if (hipFuncSetAttribute((const void*)mega_fwd, hipFuncAttributeMaxDynamicSharedMemorySize, LDS_BYTES) != hipSuccess) { fprintf(stderr, "kernel_launch: hipFuncSetAttribute failed\n"); grid = -1; return; }
        if (hipOccupancyMaxActiveBlocksPerMultiprocessor(&per_cu, (const void*)mega_fwd, NT, LDS_BYTES) != hipSuccess || per_cu < 1) { fprintf(stderr, "kernel_launch: occupancy query says %d blocks per CU\n", per_cu); grid = -1; return; }
        grid = cus;
    }
    if (grid < 0) return;
    (void)hipMemsetAsync((char*)d_ws + WS_CTL, 0, CTL_ZERO_BYTES, stream);
    Args a{};
    for (int i = 0; i < 35; ++i) a.in[i] = (const float*)d_in[i];
    a.out = (float*)d_out; a.ws = (unsigned char*)d_ws; a.ph_lo = 0; a.ph_hi = NPH;
    void* kargs[] = {&a};
    hipError_t e = hipLaunchCooperativeKernel((const void*)mega_fwd, dim3(grid), dim3(NT), kargs, LDS_BYTES, stream);
    if (e != hipSuccess) fprintf(stderr, "kernel_launch: cooperative launch failed: %s (grid %d)\n", hipGetErrorString(e), grid);
}
```

```cpp
#include <hip/hip_runtime.h>
#include <stdint.h>
#include <cstdio>

#define GAS __attribute__((address_space(1)))
#define LAS __attribute__((address_space(3)))
typedef unsigned short bf16;
typedef unsigned v4u __attribute__((ext_vector_type(4)));
typedef unsigned v2u __attribute__((ext_vector_type(2)));
typedef float f32x4 __attribute__((ext_vector_type(4)));
typedef short bf16x8 __attribute__((ext_vector_type(8)));

constexpr int D = 1024, SEQ = 16384, CTX = 256, MT = SEQ + CTX;
constexpr int MIXW = 512, INW = 3072, G5 = 32, P5 = 64, H5 = 16;
constexpr int NE = 32, DFF = 256;
constexpr int MAXSLOT = 2 * MT + NE * 256;
constexpr float EPS = 1e-6f;
constexpr int NT = 512;

constexpr size_t MiB = 1u << 20;
constexpr size_t WS_CTL = 0, CTL_ZERO_BYTES = 1 * MiB;
constexpr size_t WS_MOD = 1 * MiB;
constexpr size_t WS_XC = 2 * MiB;
constexpr size_t WS_EID = 3 * MiB;
constexpr size_t WS_EW = WS_EID + (size_t)MT * 8;
constexpr size_t WS_STOK = WS_EW + (size_t)MT * 8;
constexpr size_t WS_SW = WS_STOK + (size_t)MAXSLOT * 4;
constexpr size_t WS_TSLOT = WS_SW + (size_t)MAXSLOT * 4;
constexpr size_t WS_HISTG = WS_TSLOT + (size_t)MT * 8;
constexpr size_t WS_H = 4 * MiB;
constexpr size_t WS_X16 = WS_H;
constexpr size_t WS_PROJ = WS_H + (size_t)MT * 2048;
constexpr size_t WS_YS = WS_PROJ + (size_t)MT * 6144;
constexpr size_t WS_YG = WS_YS + (size_t)3 * MT * 1024;
constexpr size_t WS_PM = WS_YG + (size_t)MT * 1024;
constexpr size_t WS_S5 = WS_PM + (size_t)MT * 2048;
constexpr size_t WS_Z = WS_S5;
constexpr size_t WS_RSS = WS_Z + (size_t)8 * MiB;
constexpr size_t WS_SS = WS_Z + (size_t)1040 * 32 * 256 * 4;
constexpr size_t WS_S5M = WS_SS + (size_t)1040 * 32 * 256 * 2;
constexpr size_t WS_A16 = WS_S5M + (size_t)2 * 32 * 3 * 65536 * 2;
constexpr size_t WS_W = WS_A16 + (size_t)2 * 32 * 2 * 64 * 2 * 4 > WS_S5 + (size_t)2 * MT * 512 * 4 ? WS_A16 + (size_t)2 * 32 * 2 * 64 * 2 * 4 : WS_S5 + (size_t)2 * MT * 512 * 4;
constexpr size_t WS_WIN = WS_W;
constexpr size_t WS_WMG = WS_WIN + (size_t)3072 * 1024 * 2;
constexpr size_t WS_WGLU = WS_WMG + (size_t)3072 * 1024 * 2;
constexpr size_t WS_WBR = WS_WGLU + (size_t)512 * 512 * 2;
constexpr size_t WS_WO = WS_WBR + (size_t)3 * 1024 * 512 * 2;
constexpr size_t WS_W13 = WS_WO + (size_t)1024 * 1024 * 2;
constexpr size_t WS_W2 = WS_W13 + (size_t)32 * 512 * 1024 * 2;
constexpr size_t WS_WSG = WS_W2 + (size_t)32 * 1024 * 256 * 2;
constexpr size_t WS_WR = WS_WSG + (size_t)4 * 128 * 128 * 2;
constexpr size_t WS_END = WS_WR + (size_t)2 * 48 * 1024 * 2;
static_assert(WS_END <= (size_t)377 * MiB, "workspace budget");
constexpr size_t WS_HS = WS_PROJ;
constexpr size_t WS_ACT = WS_YS;
constexpr size_t WS_YS2 = WS_YG;
static_assert(WS_HS + (size_t)MAXSLOT * 2048 <= WS_YS && WS_ACT + (size_t)MAXSLOT * 512 <= WS_YG && WS_YS2 + (size_t)MAXSLOT * 2048 <= WS_W, "moe overlays");
static_assert(WS_HISTG + (size_t)1024 * 32 * 4 <= WS_H, "ws map");
constexpr int CW_CNT = 64;
constexpr int CW_BAR = 4096;
constexpr size_t WS_HG = WS_CTL + 768 * 1024;
constexpr size_t WS_MG = WS_CTL + 64 * 1024;
constexpr size_t WS_GR = WS_CTL + 256 * 1024;
constexpr int CW_UPC = 8192;

#ifndef PROBE_A
#define PROBE_A -1
#endif
#ifndef PROBE_B
#define PROBE_B -1
#endif
#ifndef PROBE_A1
#define PROBE_A1 (PROBE_A + 1)
#endif
#ifndef PROBE_B1
#define PROBE_B1 (PROBE_B + 1)
#endif
#ifndef PROBE_AROW
#define PROBE_AROW 0
#endif
#ifndef PROBE_PH
#define PROBE_PH 0
#endif
#ifndef PROBE_LO
#define PROBE_LO 0
#endif
#ifndef PROBE_HI
#define PROBE_HI 100000
#endif
constexpr int TS_OFF = 131072 + 512;
constexpr int LDS_BYTES = 147456;
constexpr int MISC_OFF = 131072 + 320;
constexpr int TAB_OFF = 131072 + 1024;

__device__ __forceinline__ float bf2f(unsigned short b) { return __builtin_bit_cast(float, ((unsigned)b) << 16); }
__device__ __forceinline__ unsigned f2bf(float f) { unsigned u = __builtin_bit_cast(unsigned, f); return (u + 0x7fffu + ((u >> 16) & 1u)) >> 16; }
__device__ __forceinline__ unsigned pk2(float lo, float hi) { return f2bf(lo) | (f2bf(hi) << 16); }
__device__ __forceinline__ float sigmoidf_(float x) { return __builtin_amdgcn_rcpf(1.f + __expf(-x)); }
__device__ __forceinline__ float siluf_(float x) { return x * __builtin_amdgcn_rcpf(1.f + __expf(-x)); }
__device__ __forceinline__ float geluf_(float x) { const float u = 0.7978845608028654f * (x + 0.044715f * x * x * x); return x * __builtin_amdgcn_rcpf(1.f + __expf(-2.f * u)); }
__device__ __forceinline__ float shflx(float v, int mask, int lane) { return __builtin_bit_cast(float, __builtin_amdgcn_ds_bpermute((lane ^ mask) << 2, __builtin_bit_cast(int, v))); }
__device__ __forceinline__ float wave_sum(float v, int lane) {
#pragma unroll
    for (int o = 1; o < 64; o <<= 1) v += shflx(v, o, lane);
    return v;
}

#define XB_TMO      128
#define XB_XCNT(j)  (256  + 64 * (j))
#define XB_XSUB(j)  (1280 + 64 * (j))
#define XB_XGEN(j)  (2304 + 64 * (j))
#define XB_TOP      3328
#define XB_TOPGEN   3392
#define XCD_BAR_WORDS 3456
#define XB_SPIN_CAP (1u << 24)
__device__ __forceinline__ unsigned xb_ld(unsigned* p)              { return __hip_atomic_load(p, __ATOMIC_RELAXED, __HIP_MEMORY_SCOPE_AGENT); }
__device__ __forceinline__ unsigned xb_add(unsigned* p, unsigned v) { return __hip_atomic_fetch_add(p, v, __ATOMIC_RELAXED, __HIP_MEMORY_SCOPE_AGENT); }
__device__ __forceinline__ unsigned xb_xcc_id() { return (unsigned)__builtin_amdgcn_s_getreg((3 << 11) | 20) & 0xFu; }
#define XB_SPIN(cond, bar) do { unsigned _sp = 0; while (cond) { __builtin_amdgcn_s_sleep(1); \
    if ((++_sp & 255u) == 0u) { if (xb_ld(&(bar)[XB_TMO])) break; if (_sp > XB_SPIN_CAP) { atomicAdd(&(bar)[XB_TMO], 1u); break; } } } } while (0)
struct XcdBarrier { unsigned* bar; unsigned x; volatile LAS unsigned* st; };
__device__ __forceinline__ XcdBarrier xcd_barrier_post(unsigned* bar, volatile LAS unsigned* st) {
    XcdBarrier b; b.bar = bar; b.x = xb_xcc_id(); b.st = st;
    if (threadIdx.x == 0) (void)xb_add(&bar[XB_XCNT(b.x)], 1u);
    return b;
}
__device__ __forceinline__ void xcd_barrier_complete(unsigned* bar, unsigned x, unsigned& nloc, unsigned& nx) {
    const unsigned G = gridDim.x * gridDim.y * gridDim.z;
    unsigned sum, cnt, mine, sp = 0u;
    for (;;) {
        sum = 0u; cnt = 0u; mine = 0u;
#pragma unroll
        for (unsigned j = 0; j < 16; ++j) { const unsigned c = xb_ld(&bar[XB_XCNT(j)]); sum += c; cnt += (c > 0u) ? 1u : 0u; mine = (j == x) ? c : mine; }
        if (sum == G) break;
        __builtin_amdgcn_s_sleep(1);
        if ((++sp & 255u) == 0u) { if (xb_ld(&bar[XB_TMO])) break; if (sp > XB_SPIN_CAP) { atomicAdd(&bar[XB_TMO], 1u); break; } }
    }
    nloc = mine > 0u ? mine : 1u; nx = cnt > 0u ? cnt : 1u;
}
__device__ __forceinline__ void xcd_barrier(const XcdBarrier& b, bool leader) {
    asm volatile("s_waitcnt vmcnt(0)" ::: "memory");
    __syncthreads();
    if (leader) {
        unsigned* bar = b.bar;
        __builtin_amdgcn_s_waitcnt(0);
        unsigned nloc = b.st[0], nx = b.st[1];
        if (nloc == 0u) { xcd_barrier_complete(bar, b.x, nloc, nx); b.st[0] = nloc; b.st[1] = nx; }
        const unsigned old = xb_add(&bar[XB_XSUB(b.x)], 1u);
        const unsigned gen = old / nloc;
        if (old + 1u == (gen + 1u) * nloc) {
            __builtin_amdgcn_fence(__ATOMIC_RELEASE, "agent");
            asm volatile("s_waitcnt vmcnt(0)" ::: "memory");
            const unsigned og = xb_add(&bar[XB_TOP], 1u);
            const unsigned tg = og / nx;
            if (og + 1u == (tg + 1u) * nx) xb_add(&bar[XB_TOPGEN], 1u);
            else XB_SPIN(xb_ld(&bar[XB_TOPGEN]) == tg, bar);
            __builtin_amdgcn_fence(__ATOMIC_ACQUIRE, "agent");
            xb_add(&bar[XB_XGEN(b.x)], 1u);
            asm volatile("s_waitcnt vmcnt(0)" ::: "memory");
        } else {
            XB_SPIN(xb_ld(&bar[XB_XGEN(b.x)]) == gen, bar);
            __builtin_amdgcn_fence(__ATOMIC_ACQUIRE, "agent");
            asm volatile("s_waitcnt vmcnt(0)" ::: "memory");
        }
    }
    __syncthreads();
}

struct Args { const float* in[35]; float* out; unsigned char* ws; int ph_lo, ph_hi; };
struct Frame {
    LAS unsigned char* lds; unsigned char* ws; unsigned* ctl;
    int tid, lane, wave, bid, G;
    const unsigned long long LAS* tab; float* out;
};
__device__ __forceinline__ unsigned long long uni64(unsigned long long v) { const unsigned lo = __builtin_amdgcn_readfirstlane((unsigned)v), hi = __builtin_amdgcn_readfirstlane((unsigned)(v >> 32)); return ((unsigned long long)hi << 32) | lo; }
#define IN_(k) ((const float*)(const GAS float*)uni64(F.tab[k]))
enum { I_X = 0, I_C, I_CTX, I_CCTX, I_WADA, I_BADA, I_GMIX, I_GFFN, I_WIN, I_LRE, I_LIM, I_LDT, I_BRE, I_BIM, I_CRE, I_CIM, I_DSKIP, I_WGLU, I_SGG, I_SGB, I_WSG, I_BSG,
       I_WCONV, I_WBR, I_WMG, I_BMG, I_WO, I_WGRP, I_BGRP, I_WEXP, I_BEXP, I_W1, I_W3, I_W2, I_GF };

__device__ __forceinline__ const float* mod_ptr(const Frame& F, int l, int row) { return (const float*)(F.ws + WS_MOD) + (size_t)(l * 2 + (row >= SEQ ? 1 : 0)) * 6144; }
__device__ __forceinline__ const float* xin_row(const Frame& F, int row) { return row < SEQ ? IN_(I_X) + (size_t)row * D : IN_(I_CTX) + (size_t)(row - SEQ) * D; }
#define HBUF(F) ((unsigned char*)(F).out)


namespace pg8 {
#define PG8_LAS __attribute__((address_space(3)))
typedef unsigned short bf16_t;
typedef short bf16x8 __attribute__((ext_vector_type(8)));
typedef float f32x4 __attribute__((ext_vector_type(4)));
typedef unsigned u32x4 __attribute__((ext_vector_type(4)));
constexpr int BM = 256, BK = 64, HALF = 128, HTB = HALF * BK * 2  , STAGE_BYTES = 8 * HTB, NXCD = 8, WGM = 8;

__host__ __device__ __forceinline__ int lds_byte(int r, int c) { const int st = (r >> 4) * 2 + (c >> 5), rr = r & 15, cc = c & 31, ob = rr * 64 + cc * 2; return st * 1024 + (ob ^ (((ob >> 9) & 1) << 5)); }
__host__ __device__ __forceinline__ void stage_rc(int b, int& R, int& C) { const int st = b / 1024, sb = b % 1024, swz = sb ^ (((sb >> 9) & 1) << 5); R = (st >> 1) * 16 + swz / 64; C = (st & 1) * 32 + (swz % 64) / 2; }
__host__ __device__ __forceinline__ int perm32(int rho) { const int n = rho >> 4, i = rho & 15; return 8 * (i >> 2) + 4 * n + (i & 3); }

struct Unit { int pm, pn; };
struct Gemm { const bf16_t* A; const bf16_t* Bt; int M, N, K; int pad_; const int* rowidx; };

struct StaticOrder {
    int nM, nN, nwg, G, c;
    __host__ __device__ void init(int M, int N, int G_, int c_) { nM = M / BM; nN = N / BM; nwg = nM * nN; G = G_; c = c_; }
    __host__ __device__ bool next(int i, Unit& u) const {
        const long L = (long)i * G + c; if (L >= nwg) return false;
        int wgid = (int)L; { const int q = nwg / NXCD, r = nwg % NXCD, xcd = wgid % NXCD, off = wgid / NXCD; wgid = (xcd < r ? xcd * (q + 1) : r * (q + 1) + (xcd - r) * q) + off; }
        const int nig = WGM * nN, gid = wgid / nig, fm = gid * WGM, gsz = (nM - fm) < WGM ? (nM - fm) : WGM;
        u.pm = fm + ((wgid % nig) % gsz); u.pn = (wgid % nig) / gsz; return true;
    }
    __device__ __forceinline__ unsigned peek(const Unit&) const { return 0u; }
    __device__ __forceinline__ void a_ready(const Unit&, unsigned) const {}
    __device__ __forceinline__ void done(const Unit&) const {}
};
__device__ __forceinline__ unsigned cvt_pk_bf16(float lo, float hi) { unsigned r; asm volatile("v_cvt_pk_bf16_f32 %0, %1, %2" : "=v"(r) : "v"(lo), "v"(hi)); return r; }
template <class Epi, class Sched, bool ALIGN_EPI = false, bool SP2 = false, bool ASC1 = false, bool AGATHER = false>
__device__ __forceinline__ void gemm_phase(PG8_LAS unsigned char* lds, const Gemm g, const Sched& S, const Epi& E, int tid_in) {
    int tid_ = tid_in; asm volatile("" : "+v"(tid_));
    const int tid = tid_, wid = __builtin_amdgcn_readfirstlane(tid >> 6), lane = tid & 63, wr = wid >> 2, wc = wid & 3, fr = lane & 15, fq = lane >> 4;
    const int K = g.K, nt = K / BK;
    unsigned voffA[2], voffB[2];
#pragma unroll
    for (int i = 0; i < 2; ++i) { int R, C; stage_rc(tid * 16 + i * 8192, R, C); const int Rb = Epi::PERM ? ((R & ~31) + perm32(R & 31)) : R;
        voffA[i] = (unsigned)(R * K + C) * 2u; voffB[i] = (unsigned)(Rb * K + C) * 2u; }
    unsigned vgC[2][2], vgN[2][2]; int grow[2], gcol[2];
#pragma unroll
    for (int i = 0; i < 2; ++i) { stage_rc(tid * 16 + i * 8192, grow[i], gcol[i]); vgC[0][i] = vgC[1][i] = vgN[0][i] = vgN[1][i] = 0u; }
#define PG8_GLOAD(dst, unit) do { if constexpr (AGATHER) { _Pragma("unroll") for (int _h = 0; _h < 2; ++_h) _Pragma("unroll") for (int _i = 0; _i < 2; ++_i) \
        dst[_h][_i] = (unsigned)g.rowidx[(unit).pm * BM + _h * HALF + grow[_i]] * (unsigned)(K * 2) + (unsigned)(gcol[_i] * 2); } } while (0)
    const size_t kstep = (size_t)(BK * 2);
    const size_t hstep = (size_t)HALF * K * 2;
    const size_t tstep = 2 * hstep;
    const unsigned ldsw = (unsigned)wid * 1024u;
    const int aoff = lds_byte(wr * 64 + fr, fq * 8), boff = lds_byte(wc * 32 + fr, fq * 8);
#define PG8_SA(b, h) (((b) * 2 + (h)) * HTB)
#define PG8_SB(b, h) ((4 + (b) * 2 + (h)) * HTB)
#define PG8_STAGE_X(bufoff, gbase, voff, aux) do { _Pragma("unroll") for (int _i = 0; _i < 2; ++_i) \
        __builtin_amdgcn_global_load_lds((const unsigned*)((const char*)(gbase) + (voff)[_i]), (PG8_LAS unsigned*)(lds + (bufoff) + ldsw + _i * 8192), 16, 0, aux); } while (0)
#define PG8_STAGE(bufoff, gbase, voff) do { if constexpr (ASC1 && (bufoff) < 4 * HTB) PG8_STAGE_X(bufoff, gbase, voff, 16); else PG8_STAGE_X(bufoff, gbase, voff, 0); } while (0)
#define PG8_STAGE_A(bufoff, uptr, kofs, h, nx) do { if constexpr (AGATHER) { unsigned _vs[2] = {(nx) ? vgN[h][0] : vgC[h][0], (nx) ? vgN[h][1] : vgC[h][1]}; PG8_STAGE(bufoff, (const char*)g.A + (kofs), _vs); } \
        else PG8_STAGE(bufoff, uptr, voffA); } while (0)
#define PG8_LDA(dst, b, h) do { _Pragma("unroll") for (int m = 0; m < 4; ++m) _Pragma("unroll") for (int k = 0; k < 2; ++k) dst[m][k] = *(const PG8_LAS bf16x8*)(lds + PG8_SA(b, h) + aoff + m * 2048 + k * 1024); } while (0)
#define PG8_LDB(dst, b, h) do { _Pragma("unroll") for (int n = 0; n < 2; ++n) _Pragma("unroll") for (int k = 0; k < 2; ++k) dst[n][k] = *(const PG8_LAS bf16x8*)(lds + PG8_SB(b, h) + boff + n * 2048 + k * 1024); } while (0)
#define PG8_MMA(ai, bj, At, Bt) do { __builtin_amdgcn_s_setprio(1); _Pragma("unroll") for (int m = 0; m < 4; ++m) _Pragma("unroll") for (int n = 0; n < 2; ++n) _Pragma("unroll") for (int k = 0; k < 2; ++k) \
        acc[ai][bj][m][n] = __builtin_amdgcn_mfma_f32_16x16x32_bf16(Bt[n][k], At[m][k], acc[ai][bj][m][n], 0, 0, 0); __builtin_amdgcn_s_setprio(0); } while (0)
#define PG8_WAIT_V(n) asm volatile("s_waitcnt vmcnt(" #n ")" ::: "memory")
#define PG8_WAIT_L(n) asm volatile("s_waitcnt lgkmcnt(" #n ")" ::: "memory")
#define PG8_BAR __builtin_amdgcn_s_barrier()
#define PG8_SCHED __builtin_amdgcn_sched_barrier(0)
    Unit cur, nxt; int ui = 0;
    if (!S.next(0, cur)) return;
    f32x4 acc[2][2][4][2];
#pragma unroll
    for (int a = 0; a < 2; ++a)
#pragma unroll
        for (int b = 0; b < 2; ++b)
#pragma unroll
            for (int m = 0; m < 4; ++m)
#pragma unroll
                for (int n = 0; n < 2; ++n) acc[a][b][m][n] = (f32x4){0.f, 0.f, 0.f, 0.f};
    bf16x8 At[4][2], B0[2][2], B1[2][2];
    const char* cA = (const char*)g.A + (size_t)cur.pm * tstep; const char* cB = (const char*)g.Bt + (size_t)cur.pn * tstep;
    PG8_GLOAD(vgC, cur);
    S.a_ready(cur, S.peek(cur));
    static_assert(SP2, "only the SP2 pipeline is kept");
    {
        PG8_STAGE(PG8_SB(0, 0), cB, voffB); PG8_STAGE(PG8_SB(0, 1), cB + hstep, voffB); PG8_STAGE_A(PG8_SA(0, 0), cA, 0, 0, false); PG8_STAGE_A(PG8_SA(0, 1), cA + hstep, 0, 1, false);
        if (wr == 1) PG8_BAR;
        PG8_WAIT_V(2); PG8_BAR;
        PG8_STAGE(PG8_SB(1, 0), cB + kstep, voffB); PG8_STAGE_A(PG8_SA(1, 0), cA + kstep, kstep, 0, false); PG8_STAGE(PG8_SB(1, 1), cB + hstep + kstep, voffB);
        PG8_WAIT_V(6); PG8_BAR;
    }
    for (;;) {
        const bool has_next = S.next(ui + 1, nxt);
        if (has_next) PG8_GLOAD(vgN, nxt); else { if constexpr (AGATHER) { vgN[0][0] = vgC[0][0]; vgN[0][1] = vgC[0][1]; vgN[1][0] = vgC[1][0]; vgN[1][1] = vgC[1][1]; } }
        const unsigned tok = has_next ? S.peek(nxt) : 0u;
        const char* nA = has_next ? (const char*)g.A + (size_t)nxt.pm * tstep : cA; const char* nB = has_next ? (const char*)g.Bt + (size_t)nxt.pn * tstep : cB;
#pragma unroll 1
        for (int t = 0; t < nt; t += 2) {
            const bool last = (t == nt - 2);
            const char* a1 = cA + (size_t)(t + 1) * kstep;
            const char* a2 = last ? nA : cA + (size_t)(t + 2) * kstep; const char* b2 = last ? nB : cB + (size_t)(t + 2) * kstep;
            const char* a3 = a2 + kstep; const char* b3 = b2 + kstep;
            const size_t k1 = (size_t)(t + 1) * kstep, k2 = last ? 0 : (size_t)(t + 2) * kstep, k3 = k2 + kstep;
            if (last && has_next) S.a_ready(nxt, tok);
            {
            PG8_LDB(B0, 0, 0); PG8_LDB(B1, 0, 1); PG8_SCHED; PG8_LDA(At, 0, 0); PG8_STAGE_A(PG8_SA(1, 1), a1 + hstep, k1, 1, false);
            PG8_WAIT_V(8); PG8_WAIT_L(0); PG8_BAR; PG8_MMA(0, 0, At, B0); PG8_MMA(0, 1, At, B1); PG8_BAR; PG8_SCHED;
            PG8_LDA(At, 0, 1); PG8_STAGE(PG8_SB(0, 0), b2, voffB); PG8_STAGE(PG8_SB(0, 1), b2 + hstep, voffB); PG8_STAGE_A(PG8_SA(0, 0), a2, k2, 0, last);
            PG8_WAIT_V(8); PG8_WAIT_L(0); PG8_BAR; PG8_MMA(1, 0, At, B0); PG8_MMA(1, 1, At, B1); PG8_BAR; PG8_SCHED;
            PG8_LDB(B0, 1, 0); PG8_LDB(B1, 1, 1); PG8_SCHED; PG8_LDA(At, 1, 0); PG8_STAGE_A(PG8_SA(0, 1), a2 + hstep, k2, 1, last);
            PG8_WAIT_V(8); PG8_WAIT_L(0); PG8_BAR; PG8_MMA(0, 0, At, B0); PG8_MMA(0, 1, At, B1); PG8_BAR; PG8_SCHED;
            PG8_LDA(At, 1, 1); PG8_STAGE(PG8_SB(1, 0), b3, voffB); PG8_STAGE(PG8_SB(1, 1), b3 + hstep, voffB); PG8_STAGE_A(PG8_SA(1, 0), a3, k3, 0, last);
            PG8_WAIT_V(8); PG8_WAIT_L(0); PG8_BAR; PG8_MMA(1, 0, At, B0); PG8_MMA(1, 1, At, B1); PG8_BAR; PG8_SCHED;
            }
        }
        if constexpr (ALIGN_EPI) { if (wr == 0) PG8_BAR; }
        if constexpr (!Epi::AFTER_DRAIN) { E(acc, cur, wr, wc, fr, fq); S.done(cur); }
        if (!has_next) break;
#pragma unroll
        for (int a = 0; a < 2; ++a)
#pragma unroll
            for (int b = 0; b < 2; ++b)
#pragma unroll
                for (int m = 0; m < 4; ++m)
#pragma unroll
                    for (int n = 0; n < 2; ++n) acc[a][b][m][n] = (f32x4){0.f, 0.f, 0.f, 0.f};
        cur = nxt; cA = nA; cB = nB; ++ui;
        if constexpr (AGATHER) { vgC[0][0] = vgN[0][0]; vgC[0][1] = vgN[0][1]; vgC[1][0] = vgN[1][0]; vgC[1][1] = vgN[1][1]; }
        if constexpr (ALIGN_EPI) { if (wr == 1) PG8_BAR; }
    }
    PG8_WAIT_V(0);
    if constexpr (!ALIGN_EPI) { if (wr == 0) PG8_BAR; }
    PG8_BAR;
    if constexpr (Epi::AFTER_DRAIN) { E.fused(acc, cur, wr, wc, fr, fq, lds, wid, lane); S.done(cur); }
#undef PG8_SA
#undef PG8_SB
#undef PG8_STAGE
#undef PG8_STAGE_X
#undef PG8_LDA
#undef PG8_STAGE_A
#undef PG8_GLOAD
#undef PG8_LDB
#undef PG8_MMA
#undef PG8_WAIT_V
#undef PG8_WAIT_L
#undef PG8_BAR
#undef PG8_SCHED
}
}

constexpr bool PG_ALIGN = true, PG_SP2 = true;
__device__ __forceinline__ float bflo(unsigned w) { return __builtin_bit_cast(float, w << 16); }
__device__ __forceinline__ float bfhi(unsigned w) { return __builtin_bit_cast(float, w & 0xffff0000u); }
__device__ __forceinline__ unsigned cvtpk(float lo, float hi) { return pg8::cvt_pk_bf16(lo, hi); }

__device__ __forceinline__ void transpose_item(const float* W, int N, int k0, int n0, bf16* WT, int K, size_t dst_row0, LAS float* scr, int lane) {
    float v[32];
#pragma unroll
    for (int i = 0; i < 32; ++i) v[i] = W[(size_t)(k0 + 2 * i + (lane >> 5)) * N + n0 + (lane & 31)];
#pragma unroll
    for (int i = 0; i < 32; ++i) scr[(2 * i + (lane >> 5)) * 33 + (lane & 31)] = v[i];
    asm volatile("s_waitcnt lgkmcnt(0)" ::: "memory");
    const int c = lane & 7;
#pragma unroll
    for (int j = 0; j < 4; ++j) { const int n = (lane >> 3) + 8 * j; const LAS float* s = scr + (8 * c) * 33 + n;
        v4u o; o.x = pk2(s[0 * 33], s[1 * 33]); o.y = pk2(s[2 * 33], s[3 * 33]); o.z = pk2(s[4 * 33], s[5 * 33]); o.w = pk2(s[6 * 33], s[7 * 33]);
        *(v4u*)(WT + (dst_row0 + n) * K + k0 + 8 * c) = o; }
    asm volatile("s_waitcnt lgkmcnt(0)" ::: "memory");
}
constexpr int CONV_IN = 16 * 96, CONV_NITEMS = 16 * 96 + 16 * 96 + 8 * 16 + 3 * 8 * 32 + 16 * 32 + 2 * 32 * 16 * 8 + 32 * 4 * 32;
__device__ __forceinline__ void convert_weights(Frame& F, int l, int blk0, int nblk, int it_lo, int it_hi, bool extras) {
    LAS float* scr = (LAS float*)(F.lds + F.wave * 16384);
    const int cb = F.bid - blk0; if (cb < 0 || cb >= nblk) return;
    const int ngw = nblk * (NT / 64), gw = ngw - 1 - (cb * (NT / 64) + F.wave);
    constexpr int I_IN = 16 * 96, I_MG = 16 * 96, I_GLU = 8 * 16, I_BR = 3 * 8 * 32, I_O = 16 * 32, I_1 = 32 * 16 * 8, I_3 = I_1, I_2 = 32 * 4 * 32;
    static_assert(I_IN == CONV_IN && I_IN + I_MG + I_GLU + I_BR + I_O + I_1 + I_3 + I_2 == CONV_NITEMS, "item list");
    for (int it = it_lo + gw; it < it_hi; it += ngw) {
        int r = it;
        if (r < I_IN) { const int kb = r / 96, nb = r % 96; transpose_item(IN_(I_WIN) + (size_t)l * D * INW, INW, 64 * kb, 32 * nb, (bf16*)(F.ws + WS_WIN), 1024, 32 * nb, scr, F.lane); continue; } r -= I_IN;
        if (r < I_MG) { const int kb = r / 96, nb = r % 96; transpose_item(IN_(I_WMG) + (size_t)l * D * INW, INW, 64 * kb, 32 * nb, (bf16*)(F.ws + WS_WMG), 1024, 32 * nb, scr, F.lane); continue; } r -= I_MG;
        if (r < I_GLU) { const int kb = r / 16, nb = r % 16; transpose_item(IN_(I_WGLU) + (size_t)l * MIXW * MIXW, MIXW, 64 * kb, 32 * nb, (bf16*)(F.ws + WS_WGLU), 512, 32 * nb, scr, F.lane); continue; } r -= I_GLU;
        if (r < I_BR) { const int kk = r / 256, q = r % 256, kb = q / 32, nb = q % 32; transpose_item(IN_(I_WBR) + ((size_t)l * 3 + kk) * MIXW * D, D, 64 * kb, 32 * nb, (bf16*)(F.ws + WS_WBR), 512, (size_t)kk * 1024 + 32 * nb, scr, F.lane); continue; } r -= I_BR;
        if (r < I_O) { const int kb = r / 32, nb = r % 32; transpose_item(IN_(I_WO) + (size_t)l * D * D, D, 64 * kb, 32 * nb, (bf16*)(F.ws + WS_WO), 1024, 32 * nb, scr, F.lane); continue; } r -= I_O;
        if (r < I_1 + I_3) { const int which = r / I_1, q = r % I_1, e = q / 128, q2 = q % 128, kb = q2 / 8, nb = q2 % 8;
            const float* W = IN_(which ? I_W3 : I_W1) + ((size_t)l * NE + e) * D * DFF; const int n0 = 32 * nb;
            transpose_item(W, DFF, 64 * kb, n0, (bf16*)(F.ws + WS_W13), 1024, (size_t)e * 512 + (n0 / 128) * 256 + which * 128 + (n0 % 128), scr, F.lane); continue; } r -= I_1 + I_3;
        { const int e = r / 128, q = r % 128, kb = q / 32, nb = q % 32; transpose_item(IN_(I_W2) + ((size_t)l * NE + e) * DFF * D, D, 64 * kb, 32 * nb, (bf16*)(F.ws + WS_W2), 256, (size_t)e * 1024 + 32 * nb, scr, F.lane); }
    }
    if (!extras) return;
    { bf16* wr = (bf16*)(F.ws + WS_WR); const float* wg = IN_(I_WGRP) + (size_t)l * D * 4; const float* we = IN_(I_WEXP) + (size_t)l * D * 32;
      for (int i = cb * NT + F.tid; i < 48 * 1024; i += nblk * NT) { const int n = i >> 10, kk = i & 1023; const float w = n < 4 ? wg[kk * 4 + n] : (n < 36 ? we[kk * 32 + n - 4] : 0.f);
          const unsigned hi = f2bf(w); const float lo = w - __builtin_bit_cast(float, hi << 16); wr[i] = (bf16)hi; wr[48 * 1024 + i] = (bf16)f2bf(lo); } }
    { const float* s = IN_(I_WSG) + (size_t)l * 4 * 128 * 128; bf16* d = (bf16*)(F.ws + WS_WSG);
      for (int i = (cb * NT + F.tid) * 2; i < 4 * 128 * 128; i += nblk * NT * 2) *(unsigned*)(d + i) = pk2(s[i], s[i + 1]); }
}

struct EpiProj { static constexpr bool PERM = true, AFTER_DRAIN = false; bf16* O;
    __device__ __forceinline__ void operator()(const pg8::f32x4 (&acc)[2][2][4][2], const pg8::Unit& u, int wr, int wc, int fr, int fq) const {
        const int row0 = u.pm * 256 + wr * 64 + fr, col0 = u.pn * 256 + wc * 32 + 8 * fq; const bool act = (u.pn >= 2 && u.pn < 6);
#pragma unroll
        for (int ai = 0; ai < 2; ++ai)
#pragma unroll
            for (int m = 0; m < 4; ++m) { bf16* rowp = O + (size_t)(row0 + ai * 128 + m * 16) * INW + col0;
#pragma unroll
                for (int bj = 0; bj < 2; ++bj) { pg8::f32x4 v0 = acc[ai][bj][m][0], v1 = acc[ai][bj][m][1];
                    if (act) {
#pragma unroll
                        for (int j = 0; j < 4; ++j) { v0[j] = geluf_(v0[j]); v1[j] = geluf_(v1[j]); } }
                    v4u w; w.x = cvtpk(v0[0], v0[1]); w.y = cvtpk(v0[2], v0[3]); w.z = cvtpk(v1[0], v1[1]); w.w = cvtpk(v1[2], v1[3]); *(v4u*)(rowp + bj * 128) = w; } }
    } };
struct EpiGlu { static constexpr bool PERM = true, AFTER_DRAIN = false; const bf16* YG; bf16* YA;
    __device__ __forceinline__ void operator()(const pg8::f32x4 (&acc)[2][2][4][2], const pg8::Unit& u, int wr, int wc, int fr, int fq) const {
        const int row0 = u.pm * 256 + wr * 64 + fr, col0 = u.pn * 256 + wc * 32 + 8 * fq;
#pragma unroll
        for (int ai = 0; ai < 2; ++ai) {
        v4u gv[4][2];
#pragma unroll
            for (int m = 0; m < 4; ++m)
#pragma unroll
                for (int bj = 0; bj < 2; ++bj) gv[m][bj] = *(const v4u*)(YG + (size_t)(row0 + ai * 128 + m * 16) * MIXW + col0 + bj * 128);
        asm volatile("" ::: "memory");
#pragma unroll
            for (int m = 0; m < 4; ++m) { const size_t off = (size_t)(row0 + ai * 128 + m * 16) * MIXW + col0;
#pragma unroll
                for (int bj = 0; bj < 2; ++bj) { const pg8::f32x4 v0 = acc[ai][bj][m][0], v1 = acc[ai][bj][m][1]; const v4u g = gv[m][bj];
                    v4u w; w.x = cvtpk(bflo(g.x) * sigmoidf_(v0[0]), bfhi(g.x) * sigmoidf_(v0[1])); w.y = cvtpk(bflo(g.y) * sigmoidf_(v0[2]), bfhi(g.y) * sigmoidf_(v0[3]));
                    w.z = cvtpk(bflo(g.z) * sigmoidf_(v1[0]), bfhi(g.z) * sigmoidf_(v1[1])); w.w = cvtpk(bflo(g.w) * sigmoidf_(v1[2]), bfhi(g.w) * sigmoidf_(v1[3])); *(v4u*)(YA + off + bj * 128) = w; } }
        asm volatile("" ::: "memory"); }
    } };
__device__ __forceinline__ int xcd_remap(int Lq, int total) { const int q = total >> 3, r = total & 7, x = Lq & 7, off = Lq >> 3; return (x < r ? x * (q + 1) : r * (q + 1) + (x - r) * q) + off; }
struct EpiBr { static constexpr bool PERM = true, AFTER_DRAIN = false; bf16* BR;
    __device__ __forceinline__ void operator()(const pg8::f32x4 (&acc)[2][2][4][2], const pg8::Unit& u, int wr, int wc, int fr, int fq) const {
        const int pm = u.pm % (MT / 256); const int row0 = pm * 256 + wr * 64 + fr, col0 = u.pn * 256 + wc * 32 + 8 * fq;
#pragma unroll
        for (int ai = 0; ai < 2; ++ai)
#pragma unroll
            for (int m = 0; m < 4; ++m) { bf16* rowp = BR + (size_t)(row0 + ai * 128 + m * 16) * INW + col0;
#pragma unroll
                for (int bj = 0; bj < 2; ++bj) { const pg8::f32x4 v0 = acc[ai][bj][m][0], v1 = acc[ai][bj][m][1];
                    v4u w; w.x = cvtpk(v0[0], v0[1]); w.y = cvtpk(v0[2], v0[3]); w.z = cvtpk(v1[0], v1[1]); w.w = cvtpk(v1[2], v1[3]); *(v4u*)(rowp + bj * 128) = w; } }
    } };
__device__ __forceinline__ int vu_pm(int v) { return (v >> 5) * 8 + (v & 7); }
__device__ __forceinline__ int vu_dt(int v) { return (v >> 3) & 3; }
struct SchedBr { int G, c, nM;
    __device__ __forceinline__ bool next(int i, pg8::Unit& u) const { const int v0 = (i / 3) * G + c, k = i % 3; if (v0 >= nM * 4) return false; const int v = xcd_remap(v0, nM * 4);
        u.pm = k * (MT / 256) + vu_pm(v); u.pn = k * 4 + vu_dt(v); return true; }
    __device__ __forceinline__ unsigned peek(const pg8::Unit&) const { return 0u; }
    __device__ __forceinline__ void a_ready(const pg8::Unit&, unsigned) const {}
    __device__ __forceinline__ void done(const pg8::Unit&) const {} };
struct EpiMerge { static constexpr bool PERM = true, AFTER_DRAIN = false; const bf16* BR; bf16* PM; const float* bm;
    __device__ __forceinline__ void operator()(const pg8::f32x4 (&acc)[2][2][4][2], const pg8::Unit& u, int wr, int wc, int fr, int fq) const {
        const int k = u.pn >> 2, dt = u.pn & 3; const int row0 = u.pm * 256 + wr * 64 + fr, col0 = dt * 256 + wc * 32 + 8 * fq;
#pragma unroll
        for (int bj = 0; bj < 2; ++bj) { const pg8::f32x4 b0 = *(const pg8::f32x4*)(bm + k * 1024 + col0 + bj * 128), b1 = *(const pg8::f32x4*)(bm + k * 1024 + col0 + bj * 128 + 4);
#pragma unroll
            for (int ai = 0; ai < 2; ++ai) {
            v4u brv[4], pmv[4];
#pragma unroll
                for (int m = 0; m < 4; ++m) { const size_t r = (size_t)(row0 + ai * 128 + m * 16); brv[m] = *(const v4u*)(BR + r * INW + k * 1024 + col0 + bj * 128);
                    pmv[m] = k > 0 ? *(const v4u*)(PM + r * D + col0 + bj * 128) : (v4u){0u, 0u, 0u, 0u}; }
                asm volatile("" ::: "memory");
#pragma unroll
                for (int m = 0; m < 4; ++m) { const size_t r = (size_t)(row0 + ai * 128 + m * 16); const v4u br = brv[m], o = pmv[m];
                    const pg8::f32x4 v0 = acc[ai][bj][m][0] + b0, v1 = acc[ai][bj][m][1] + b1;
                    float p[8] = {sigmoidf_(v0[0]) * bflo(br.x), sigmoidf_(v0[1]) * bfhi(br.x), sigmoidf_(v0[2]) * bflo(br.y), sigmoidf_(v0[3]) * bfhi(br.y),
                                  sigmoidf_(v1[0]) * bflo(br.z), sigmoidf_(v1[1]) * bfhi(br.z), sigmoidf_(v1[2]) * bflo(br.w), sigmoidf_(v1[3]) * bfhi(br.w)};
                    if (k > 0) { p[0] += bflo(o.x); p[1] += bfhi(o.x); p[2] += bflo(o.y); p[3] += bfhi(o.y); p[4] += bflo(o.z); p[5] += bfhi(o.z); p[6] += bflo(o.w); p[7] += bfhi(o.w); }
                    v4u w; w.x = cvtpk(p[0], p[1]); w.y = cvtpk(p[2], p[3]); w.z = cvtpk(p[4], p[5]); w.w = cvtpk(p[6], p[7]); *(v4u*)(PM + r * D + col0 + bj * 128) = w; }
                asm volatile("" ::: "memory"); } }
    } };
struct SchedMerge { int G, c, nM;
    __device__ __forceinline__ bool next(int i, pg8::Unit& u) const { const int v0 = (i / 3) * G + c, k = i % 3; if (v0 >= nM * 4) return false; const int v = xcd_remap(v0, nM * 4); u.pm = vu_pm(v); u.pn = k * 4 + vu_dt(v); return true; }
    __device__ __forceinline__ unsigned peek(const pg8::Unit&) const { return 0u; }
    __device__ __forceinline__ void a_ready(const pg8::Unit&, unsigned) const {}
    __device__ __forceinline__ void done(const pg8::Unit&) const {} };
struct EpiWo { static constexpr bool PERM = true, AFTER_DRAIN = false; const float* xin; bf16* X16; const float* mod_l; float* rss; int l0; int pad_;
    __device__ __forceinline__ void operator()(const pg8::f32x4 (&acc)[2][2][4][2], const pg8::Unit& u, int wr, int wc, int fr, int fq) const {
        const int row0 = u.pm * 256 + wr * 64 + fr, col0 = u.pn * 256 + wc * 32 + 8 * fq;
        const float* ga = mod_l + 2048;
        float ssq[2][4] = {};
        pg8::f32x4 gv[2][2];
#pragma unroll
        for (int bj = 0; bj < 2; ++bj)
#pragma unroll
            for (int n = 0; n < 2; ++n) gv[bj][n] = *(const pg8::f32x4*)(ga + col0 + bj * 128 + n * 4);
#pragma unroll
        for (int ai = 0; ai < 2; ++ai) {
#pragma unroll
            for (int mp = 0; mp < 2; ++mp) {
            pg8::f32x4 xv[2][2][2];
            if (l0) {
#pragma unroll
                for (int m = 0; m < 2; ++m) { const size_t off = (size_t)(row0 + ai * 128 + (mp * 2 + m) * 16) * D + col0;
#pragma unroll
                    for (int bj = 0; bj < 2; ++bj)
#pragma unroll
                        for (int n = 0; n < 2; ++n) xv[m][bj][n] = *(const pg8::f32x4*)(xin + off + bj * 128 + n * 4); }
                asm volatile("" ::: "memory");
            } else {
                v4u xb[2][2];
#pragma unroll
                for (int m = 0; m < 2; ++m) { const size_t off = (size_t)(row0 + ai * 128 + (mp * 2 + m) * 16) * D + col0;
#pragma unroll
                    for (int bj = 0; bj < 2; ++bj) xb[m][bj] = *(const v4u*)(X16 + off + bj * 128); }
                asm volatile("" ::: "memory");
#pragma unroll
                for (int m = 0; m < 2; ++m)
#pragma unroll
                    for (int bj = 0; bj < 2; ++bj) { const v4u w = xb[m][bj]; xv[m][bj][0] = (pg8::f32x4){bflo(w.x), bfhi(w.x), bflo(w.y), bfhi(w.y)}; xv[m][bj][1] = (pg8::f32x4){bflo(w.z), bfhi(w.z), bflo(w.w), bfhi(w.w)}; }
            }
#pragma unroll
            for (int m = 0; m < 2; ++m) { const size_t off = (size_t)(row0 + ai * 128 + (mp * 2 + m) * 16) * D + col0;
#pragma unroll
                for (int bj = 0; bj < 2; ++bj) { const pg8::f32x4 o0 = xv[m][bj][0] + gv[bj][0] * acc[ai][bj][m + mp * 2][0], o1 = xv[m][bj][1] + gv[bj][1] * acc[ai][bj][m + mp * 2][1];
                    v4u w; w.x = cvtpk(o0[0], o0[1]); w.y = cvtpk(o0[2], o0[3]); w.z = cvtpk(o1[0], o1[1]); w.w = cvtpk(o1[2], o1[3]); *(v4u*)(X16 + off + bj * 128) = w;
                    ssq[ai][m + mp * 2] += (o0[0] * o0[0] + o0[1] * o0[1] + o0[2] * o0[2] + o0[3] * o0[3]) + (o1[0] * o1[0] + o1[1] * o1[1] + o1[2] * o1[2] + o1[3] * o1[3]); } }
            asm volatile("" ::: "memory"); }
        }
        const int lane = fr + 16 * fq;
#pragma unroll
        for (int ai = 0; ai < 2; ++ai)
#pragma unroll
            for (int m = 0; m < 4; ++m) { float s = ssq[ai][m]; s += shflx(s, 16, lane); s += shflx(s, 32, lane); if (fq == 0) rss[(size_t)(row0 + ai * 128 + m * 16) * 16 + u.pn * 4 + wc] = s; }
    } };
constexpr int MOETAB_OFF = 131072 + 2048;
__device__ __forceinline__ int moe_build_tables(Frame& F, const unsigned* cnt, LAS unsigned* tabu, LAS unsigned* tabd) {
    LAS int* RAW = (LAS int*)(F.lds + MOETAB_OFF + 8192); LAS int* PRE = RAW + 32;
    if (F.tid < 32) RAW[F.tid] = ((int)cnt[F.tid] + 255) >> 8;
    __syncthreads();
    if (F.tid <= 32) { int s = 0; for (int i = 0; i < F.tid; ++i) s += RAW[i]; PRE[F.tid] = s; }
    __syncthreads();
    const int nrt = PRE[32];
    for (int q = F.tid; q < nrt * 6; q += NT) { const int rt = q / 6, w = q % 6; int e = 0;
#pragma unroll 1
        for (int i = 1; i < 32; ++i) e += PRE[i] <= rt ? 1 : 0;
        if (w < 2) tabu[rt * 2 + w] = ((unsigned)rt << 16) | (unsigned)(e * 2 + w); else tabd[rt * 4 + (w - 2)] = ((unsigned)rt << 16) | (unsigned)(e * 4 + (w - 2)); }
    __syncthreads();
    return nrt;
}
__device__ __forceinline__ void xcd_chunk(int total, int x, int& start, int& size) { const int q = total >> 3, r = total & 7; size = q + (x < r ? 1 : 0); start = x < r ? x * (q + 1) : r * (q + 1) + (x - r) * q; }
struct SchedMoeUp { int G, c, nrt, tid; const LAS unsigned* tabw; unsigned* upc;
    __device__ __forceinline__ bool next(int i, pg8::Unit& u) const {
        int Lq;
        if (G & 7) { Lq = i * G + c; if (Lq >= 2 * nrt) return false; }
        else { int rs, rn; xcd_chunk(nrt, c & 7, rs, rn); const int nb = G >> 3, j = c >> 3, o0 = i * nb; if (o0 + j >= 2 * rn) return false;
            const int n = (2 * rn - o0) < nb ? (2 * rn - o0) : nb, h = n >> 1;
            Lq = (n & 1) ? 2 * rs + o0 + j : 2 * (rs + (o0 >> 1) + (j % h)) + (j / h); }
        const unsigned w = (unsigned)__builtin_amdgcn_readfirstlane((int)tabw[Lq]); u.pm = (int)(w >> 16); u.pn = (int)(w & 0xffffu); return true; }
    __device__ __forceinline__ unsigned peek(const pg8::Unit&) const { return 0u; }
    __device__ __forceinline__ void a_ready(const pg8::Unit&, unsigned) const {}
    __device__ __forceinline__ void done(const pg8::Unit& u) const {
        asm volatile("s_waitcnt vmcnt(0)" ::: "memory"); __builtin_amdgcn_s_barrier();
        if (tid == 0) __hip_atomic_fetch_add(upc + u.pm, 1u, __ATOMIC_RELAXED, __HIP_MEMORY_SCOPE_AGENT); } };
struct SchedMoeDown { int G, c, nrt, pad_; const LAS unsigned* tabw; unsigned* upc;
    __device__ __forceinline__ bool next(int i, pg8::Unit& u) const {
        int Lq;
        if (G & 7) { Lq = i * G + c; if (Lq >= 4 * nrt) return false; }
        else { const int j = c >> 3, nb = G >> 3; int rs, rn; xcd_chunk(nrt, c & 7, rs, rn); const int un = 2 * rn, dn = 4 * rn;
            const int a = un / nb, n2 = un % nb, nu = a + (j < n2 ? 1 : 0), s = 2 * nu + i;
            const int c0 = s - 2 * a, c1 = s - 2 * a - 2; const int off = (nb - n2) * (c0 > 0 ? c0 : 0) + n2 * (c1 > 0 ? c1 : 0) + (c1 >= 0 ? j : j - n2);
            if (off >= dn) return false; Lq = 4 * rs + off; }
        const unsigned w = (unsigned)__builtin_amdgcn_readfirstlane((int)tabw[Lq]); u.pm = (int)(w >> 16); u.pn = (int)(w & 0xffffu); return true; }
    __device__ __forceinline__ unsigned peek(const pg8::Unit& u) const { return __hip_atomic_load(upc + u.pm, __ATOMIC_RELAXED, __HIP_MEMORY_SCOPE_AGENT); }
    __device__ __forceinline__ void a_ready(const pg8::Unit& u, unsigned tok) const {
        if ((unsigned)__builtin_amdgcn_readfirstlane((int)tok) >= 2u) return;
        unsigned* p = upc + u.pm; unsigned spins = 0;
        while ((unsigned)__builtin_amdgcn_readfirstlane((int)__hip_atomic_load(p, __ATOMIC_RELAXED, __HIP_MEMORY_SCOPE_AGENT)) < 2u) { __builtin_amdgcn_s_sleep(2); if (++spins > (1u << 22)) break; } }
    __device__ __forceinline__ void done(const pg8::Unit&) const {} };
struct EpiUp { static constexpr bool PERM = true, AFTER_DRAIN = false; bf16* ACT; const float* SW;
    __device__ __forceinline__ void operator()(const pg8::f32x4 (&acc)[2][2][4][2], const pg8::Unit& u, int wr, int wc, int fr, int fq) const {
        const int row0 = u.pm * 256 + wr * 64 + fr, f0 = (u.pn & 1) * 128 + wc * 32 + 8 * fq;
        const __amdgpu_buffer_rsrc_t rs = __builtin_amdgcn_make_buffer_rsrc(ACT, 0, MAXSLOT * DFF * 2, 0x00020000);
        float wv[2][4];
#pragma unroll
        for (int ai = 0; ai < 2; ++ai)
#pragma unroll
            for (int m = 0; m < 4; ++m) wv[ai][m] = SW[row0 + ai * 128 + m * 16];
        asm volatile("" ::: "memory");
#pragma unroll
        for (int ai = 0; ai < 2; ++ai)
#pragma unroll
            for (int m = 0; m < 4; ++m) { const int slot = row0 + ai * 128 + m * 16; const float w = wv[ai][m];
                const pg8::f32x4 a0 = acc[ai][0][m][0], a1 = acc[ai][0][m][1], b0 = acc[ai][1][m][0], b1 = acc[ai][1][m][1];
                v4u o; o.x = cvtpk(siluf_(a0[0]) * b0[0] * w, siluf_(a0[1]) * b0[1] * w); o.y = cvtpk(siluf_(a0[2]) * b0[2] * w, siluf_(a0[3]) * b0[3] * w);
                o.z = cvtpk(siluf_(a1[0]) * b1[0] * w, siluf_(a1[1]) * b1[1] * w); o.w = cvtpk(siluf_(a1[2]) * b1[2] * w, siluf_(a1[3]) * b1[3] * w);
                __builtin_amdgcn_raw_buffer_store_b128(o, rs, (unsigned)((slot * DFF + f0) * 2), 0,   16); }
    } };
struct EpiDown { static constexpr bool PERM = true, AFTER_DRAIN = false; bf16* YS2;
    __device__ __forceinline__ void operator()(const pg8::f32x4 (&acc)[2][2][4][2], const pg8::Unit& u, int wr, int wc, int fr, int fq) const {
        const int row0 = u.pm * 256 + wr * 64 + fr, col0 = (u.pn & 3) * 256 + wc * 32 + 8 * fq;
#pragma unroll
        for (int ai = 0; ai < 2; ++ai)
#pragma unroll
            for (int m = 0; m < 4; ++m) { bf16* rowp = YS2 + (size_t)(row0 + ai * 128 + m * 16) * D + col0;
#pragma unroll
                for (int bj = 0; bj < 2; ++bj) { const pg8::f32x4 v0 = acc[ai][bj][m][0], v1 = acc[ai][bj][m][1];
                    v4u w; w.x = cvtpk(v0[0], v0[1]); w.y = cvtpk(v0[2], v0[3]); w.z = cvtpk(v1[0], v1[1]); w.w = cvtpk(v1[2], v1[3]); *(v4u*)(rowp + bj * 128) = w; } }
    } };


__device__ __forceinline__ void ph2_fast(Frame& F, int l) {
    pg8::Gemm g{(const bf16*)HBUF(F), (const bf16*)(F.ws + WS_WIN), SEQ, INW, D, 0, nullptr}; pg8::StaticOrder S; S.init(SEQ, INW, F.G, F.bid);
    EpiProj E{(bf16*)(F.ws + WS_PROJ)}; pg8::gemm_phase<EpiProj, pg8::StaticOrder, PG_ALIGN, PG_SP2>(F.lds, g, S, E, F.tid);
}
__device__ __forceinline__ void ph6_fast(Frame& F, int l) {
    pg8::Gemm g{(const bf16*)(F.ws + WS_YG), (const bf16*)(F.ws + WS_WGLU), MT, MIXW, MIXW, 0, nullptr}; pg8::StaticOrder S; S.init(l == 0 ? MT : SEQ, MIXW, F.G, F.bid);
    EpiGlu E{(const bf16*)(F.ws + WS_YG), (bf16*)(F.ws + WS_YS)}; pg8::gemm_phase<EpiGlu, pg8::StaticOrder, PG_ALIGN, PG_SP2>(F.lds, g, S, E, F.tid);
}
__device__ __forceinline__ void ph7_fast(Frame& F, int l) {
    pg8::Gemm g{(const bf16*)(F.ws + WS_YS), (const bf16*)(F.ws + WS_WBR), 3 * MT, 3 * D, MIXW, 0, nullptr}; SchedBr S{F.G, F.bid, SEQ / 256};
    EpiBr E{(bf16*)(F.ws + WS_PROJ)}; pg8::gemm_phase<EpiBr, SchedBr, PG_ALIGN, PG_SP2>(F.lds, g, S, E, F.tid);
}
__device__ __forceinline__ void ph8_fast(Frame& F, int l) {
    pg8::Gemm g{(const bf16*)HBUF(F), (const bf16*)(F.ws + WS_WMG), MT, INW, D, 0, nullptr}; SchedMerge S{F.G, F.bid, SEQ / 256};
    EpiMerge E{(const bf16*)(F.ws + WS_PROJ), (bf16*)(F.ws + WS_PM), IN_(I_BMG) + l * INW}; pg8::gemm_phase<EpiMerge, SchedMerge, PG_ALIGN, PG_SP2>(F.lds, g, S, E, F.tid);
}
__device__ __forceinline__ void ph9_fast(Frame& F, int l) {
    pg8::Gemm g{(const bf16*)(F.ws + WS_PM), (const bf16*)(F.ws + WS_WO), MT, D, D, 0, nullptr}; pg8::StaticOrder S; S.init(SEQ, D, F.G, F.bid);
    EpiWo E{IN_(I_X), (bf16*)(F.ws + WS_X16), (const float*)(F.ws + WS_MOD) + (size_t)l * 2 * 6144, (float*)(F.ws + WS_RSS), l == 0 ? 1 : 0, 0};
    pg8::gemm_phase<EpiWo, pg8::StaticOrder, PG_ALIGN, PG_SP2>(F.lds, g, S, E, F.tid);
}
__device__ __forceinline__ void ph12_moe(Frame& F, int l) {
    LAS unsigned* tabu = (LAS unsigned*)(F.lds + MOETAB_OFF); LAS unsigned* tabd = tabu + 1024; unsigned* upc = F.ctl + CW_UPC + l * 256;
    const int nrt = moe_build_tables(F, F.ctl + CW_CNT + l * 128, tabu, tabd);
#define MOE_STAMP(i) do { if ((PROBE_A >= 0 || PROBE_B >= 0) && l == 0 && F.tid == 0) ((volatile LAS unsigned long long*)(F.lds + TS_OFF))[i] = __builtin_amdgcn_s_memrealtime(); } while (0)
    MOE_STAMP(60);
    { pg8::Gemm g{(const bf16*)HBUF(F), (const bf16*)(F.ws + WS_W13), MAXSLOT, NE * 512, D, 0, (const int*)(F.ws + WS_STOK)}; SchedMoeUp S{F.G, F.bid, nrt, F.tid, tabu, upc};
      EpiUp E{(bf16*)(F.ws + WS_ACT), (const float*)(F.ws + WS_SW)}; pg8::gemm_phase<EpiUp, SchedMoeUp, PG_ALIGN, PG_SP2, false, true>(F.lds, g, S, E, F.tid); }
    MOE_STAMP(61);
    { pg8::Gemm g{(const bf16*)(F.ws + WS_ACT), (const bf16*)(F.ws + WS_W2), MAXSLOT, NE * D, DFF, 0, nullptr}; SchedMoeDown S{F.G, F.bid, nrt, 0, tabd, upc};
      EpiDown E{(bf16*)(F.ws + WS_YS2)}; pg8::gemm_phase<EpiDown, SchedMoeDown, PG_ALIGN, PG_SP2, true>(F.lds, g, S, E, F.tid); }
    MOE_STAMP(62);
    if (PROBE_A == 99 && l == 0 && F.tid == 0) { volatile LAS unsigned long long* TS = (volatile LAS unsigned long long*)(F.lds + TS_OFF); __hip_atomic_fetch_max(F.ctl + 100, ((unsigned)(TS[62] - TS[12]) << 8) | (unsigned)F.bid, __ATOMIC_RELAXED, __HIP_MEMORY_SCOPE_AGENT); }
}


constexpr int NSB = MT / 16;
__device__ __forceinline__ void s5_precompute(Frame& F) {
    LAS float* APr = (LAS float*)F.lds; LAS float* APi = APr + 2176; LAS float* BBr = APi + 2176; LAS float* BBi = BBr + 2048; LAS float* CCr = BBi + 2048; LAS float* CCi = CCr + 2048; LAS float* KK = CCi + 2048;
    for (int item = F.G - 1 - F.bid; item < 2 * G5; item += F.G) { const int l = item >> 5, g = item & 31;
        __syncthreads();
        if (F.tid < 128) { const int d = F.tid >> 6, p = F.tid & 63; const int ldg = (l * 2 + d) * G5 + g;
            const double lr = IN_(I_LRE)[ldg * P5 + p], li = IN_(I_LIM)[ldg * P5 + p], dt = exp((double)IN_(I_LDT)[ldg]);
            for (int e = 0; e <= 16; ++e) { const double m = exp(lr * dt * e), ang = li * dt * e; APr[(d * 64 + p) * 17 + e] = (float)(m * cos(ang)); APi[(d * 64 + p) * 17 + e] = (float)(m * sin(ang)); }
            { const double m16 = exp(lr * dt * 16.0), a16 = li * dt * 16.0; float* A16 = (float*)(F.ws + WS_A16) + ((size_t)((l * 32 + g) * 2 + d) * 64 + p) * 2; A16[0] = (float)(m16 * cos(a16)); A16[1] = (float)(m16 * sin(a16)); }
            const double m1 = exp(lr * dt), ar = m1 * cos(li * dt), ai = m1 * sin(li * dt); const double nr = ar - 1.0, ni = ai, den = lr * lr + li * li;
            const double qr = (nr * lr + ni * li) / den, qi = (ni * lr - nr * li) / den;
            for (int h = 0; h < 16; ++h) { const double x = IN_(I_BRE)[((size_t)ldg * P5 + p) * H5 + h], y = IN_(I_BIM)[((size_t)ldg * P5 + p) * H5 + h];
                BBr[(d * 64 + p) * 16 + h] = (float)(qr * x - qi * y); BBi[(d * 64 + p) * 16 + h] = (float)(qr * y + qi * x);
                CCr[(d * 16 + h) * 64 + p] = IN_(I_CRE)[((size_t)ldg * H5 + h) * P5 + p]; CCi[(d * 16 + h) * 64 + p] = IN_(I_CIM)[((size_t)ldg * H5 + h) * P5 + p]; } }
        __syncthreads();
        { const int d = F.tid >> 8, e = (F.tid >> 4) & 15, hp = F.tid & 15;
          float wr[64], wi[64];
#pragma unroll
          for (int p = 0; p < 64; ++p) { const float pr = APr[(d * 64 + p) * 17 + e], pi = APi[(d * 64 + p) * 17 + e], br = BBr[(d * 64 + p) * 16 + hp], bi = BBi[(d * 64 + p) * 16 + hp]; wr[p] = pr * br - pi * bi; wi[p] = pr * bi + pi * br; }
#pragma unroll 1
          for (int h = 0; h < 16; ++h) { float a = 0.f;
#pragma unroll
              for (int p = 0; p < 64; ++p) a += CCr[(d * 16 + h) * 64 + p] * wr[p] - CCi[(d * 16 + h) * 64 + p] * wi[p];
              KK[(d * 16 + e) * 256 + h * 16 + hp] = a; } }
        __syncthreads();
        bf16* M = (bf16*)(F.ws + WS_S5M) + (size_t)(l * 32 + g) * 3 * 65536;
        for (int idx = F.tid; idx < 32768; idx += NT) {
            const int r = idx >> 7, k0 = (idx & 127) * 2; float v[3][2];
#pragma unroll
            for (int q = 0; q < 2; ++q) { const int kk = k0 + q;
                { const int d = r >> 7, p = (r >> 1) & 63, c = r & 1, sg = kk >> 4, hp = kk & 15, e = d == 0 ? 15 - sg : sg;
                  const float pr = APr[(d * 64 + p) * 17 + e], pi = APi[(d * 64 + p) * 17 + e], br = BBr[(d * 64 + p) * 16 + hp], bi = BBi[(d * 64 + p) * 16 + hp];
                  v[0][q] = c == 0 ? pr * br - pi * bi : pr * bi + pi * br; }
                { const int tau = r >> 4, h = r & 15, sg = kk >> 4, hp = kk & 15; float t = 0.f;
                  if (sg <= tau) t += KK[(0 * 16 + (tau - sg)) * 256 + h * 16 + hp]; if (sg >= tau) t += KK[(1 * 16 + (sg - tau)) * 256 + h * 16 + hp]; v[1][q] = t; }
                { const int tau = r >> 4, h = r & 15, d = kk >> 7, p = (kk >> 1) & 63, c = kk & 1, e = d == 0 ? tau + 1 : 16 - tau;
                  const float cr = CCr[(d * 16 + h) * 64 + p], ci = CCi[(d * 16 + h) * 64 + p], pr = APr[(d * 64 + p) * 17 + e], pi = APi[(d * 64 + p) * 17 + e];
                  v[2][q] = c == 0 ? cr * pr - ci * pi : -(cr * pi + ci * pr); } }
#pragma unroll
            for (int m = 0; m < 3; ++m) *(unsigned*)(M + (size_t)m * 65536 + r * 256 + k0) = pk2(v[m][0], v[m][1]);
        }
    }
}
constexpr int ZS_OFF = 16384, ZS_STRIDE = 528, EX_OFF = ZS_OFF + 144 * ZS_STRIDE, CARRY_OFF = EX_OFF + 4 * 128 * 16;
__device__ __forceinline__ void s5_fused_phase(Frame& F, int l) {
    const bf16* PROJ = (const bf16*)(F.ws + WS_PROJ); bf16* YG = (bf16*)(F.ws + WS_YG); const float* ds = IN_(I_DSKIP) + l * MIXW;
    unsigned long long* GR = (unsigned long long*)(F.ws + WS_GR); const unsigned tag = (unsigned)l + 1u;
    const int l15 = F.lane & 15, lq = F.lane >> 4; const int G8 = F.G & ~7;
    LAS unsigned char* ZS = F.lds + ZS_OFF; LAS float* EX = (LAS float*)(F.lds + EX_OFF); LAS float* CR = (LAS float*)(F.lds + CARRY_OFF);
    if (F.bid < G8)
    for (int item = F.bid; item < 256; item += G8) {
        const int g = item >> 3, p = item & 7;
        const bf16* vsrc = PROJ + (size_t)(16 * l15 + 2 * F.wave + (lq >> 1)) * INW + 16 * g + 8 * (lq & 1);
        {   const bf16* Fm = (const bf16*)(F.ws + WS_S5M) + (size_t)(l * 32 + g) * 3 * 65536;
            bf16x8 Af[2][8], nvz[9];
#pragma unroll
            for (int j = 0; j < 2; ++j)
#pragma unroll
                for (int ks = 0; ks < 8; ++ks) Af[j][ks] = *(const bf16x8*)(Fm + (size_t)(16 * (2 * F.wave + j) + l15) * 256 + 32 * ks + 8 * lq);
#pragma unroll
            for (int s = 0; s < 9; ++s) nvz[s] = *(const bf16x8*)(vsrc + (size_t)(s == 0 ? 64 : 8 * p + s - 1) * 256 * INW);
            __syncthreads();
            *(LAS bf16x8*)(F.lds + (F.wave * 64 + F.lane) * 16) = nvz[0];
            __syncthreads();
            int cur = 0;
#pragma unroll
            for (int s = 0; s < 9; ++s) {
                f32x4 acc[2] = {{0.f, 0.f, 0.f, 0.f}, {0.f, 0.f, 0.f, 0.f}};
#pragma unroll
                for (int ks = 0; ks < 8; ++ks) { const bf16x8 V = *(const LAS bf16x8*)(F.lds + cur * 8192 + (ks * 64 + F.lane) * 16);
#pragma unroll
                    for (int j = 0; j < 2; ++j) acc[j] = __builtin_amdgcn_mfma_f32_16x16x32_bf16(Af[j][ks], V, acc[j], 0, 0, 0); }
#pragma unroll
                for (int j = 0; j < 2; ++j) { v2u zz; zz.x = pk2(acc[j][0], acc[j][1]); zz.y = pk2(acc[j][2], acc[j][3]); *(LAS v2u*)(ZS + (s * 16 + l15) * ZS_STRIDE + (16 * (2 * F.wave + j) + 4 * lq) * 2) = zz; }
                if (s < 8) *(LAS bf16x8*)(F.lds + (cur ^ 1) * 8192 + (F.wave * 64 + F.lane) * 16) = nvz[s + 1];
                __syncthreads();
                cur ^= 1;
            }
        }
        {   const int c = F.tid & 127, j = F.tid >> 7, d = c >> 6;
            const float* A16 = (const float*)(F.ws + WS_A16) + ((size_t)((l * 32 + g) * 2 + d) * 64 + (c & 63)) * 2; const float ar = A16[0], ai = A16[1];
            LAS unsigned char* zc = ZS + c * 4;
            float hr = 0.f, hi = 0.f, pr = 1.f, pi = 0.f;
#pragma unroll 4
            for (int q = 0; q < 32; ++q) { const int i = 32 * j + q, row = 16 + (d ? 127 - i : i); const unsigned zw = *(const LAS unsigned*)(zc + row * ZS_STRIDE);
                const float nr = ar * hr - ai * hi + bflo(zw), ni = ar * hi + ai * hr + bfhi(zw); hr = nr; hi = ni; const float qr = pr * ar - pi * ai, qi = pr * ai + pi * ar; pr = qr; pi = qi; }
            EX[(j * 128 + c) * 4 + 0] = hr; EX[(j * 128 + c) * 4 + 1] = hi; EX[(j * 128 + c) * 4 + 2] = pr; EX[(j * 128 + c) * 4 + 3] = pi;
            __syncthreads();
            if (j == 0) {
                float er = 0.f, ei = 0.f, Ar = 1.f, Ai = 0.f;
#pragma unroll
                for (int jj = 0; jj < 4; ++jj) { const float h0 = EX[(jj * 128 + c) * 4], h1 = EX[(jj * 128 + c) * 4 + 1], q0 = EX[(jj * 128 + c) * 4 + 2], q1 = EX[(jj * 128 + c) * 4 + 3];
                    const float nr = q0 * er - q1 * ei + h0, ni = q0 * ei + q1 * er + h1; er = nr; ei = ni; const float tr = Ar * q0 - Ai * q1, ti = Ar * q1 + Ai * q0; Ar = tr; Ai = ti; }
                unsigned long long* mine = GR + ((size_t)(g * 8 + p) * 128 + c) * 2;
                __hip_atomic_store(mine, ((unsigned long long)tag << 32) | __builtin_bit_cast(unsigned, er), __ATOMIC_RELAXED, __HIP_MEMORY_SCOPE_AGENT);
                __hip_atomic_store(mine + 1, ((unsigned long long)tag << 32) | __builtin_bit_cast(unsigned, ei), __ATOMIC_RELAXED, __HIP_MEMORY_SCOPE_AGENT);
                float cr = 0.f, ci = 0.f;
#pragma unroll 4
                for (int i = 0; i < 16; ++i) { const int row = d ? 15 - i : i; const unsigned zw = *(const LAS unsigned*)(zc + row * ZS_STRIDE); *(LAS unsigned*)(zc + row * ZS_STRIDE) = pk2(cr, ci);
                    const float nr = ar * cr - ai * ci + bflo(zw), ni = ar * ci + ai * cr + bfhi(zw); cr = nr; ci = ni; }
                const int np = d ? 7 - p : p;
#pragma unroll 1
                for (int t = 0; t < np; ++t) { const int pp = d ? 7 - t : t; unsigned long long* o = GR + ((size_t)(g * 8 + pp) * 128 + c) * 2; unsigned long long x0, x1; unsigned spins = 0;
                    for (;;) { x0 = __hip_atomic_load(o, __ATOMIC_RELAXED, __HIP_MEMORY_SCOPE_AGENT); x1 = __hip_atomic_load(o + 1, __ATOMIC_RELAXED, __HIP_MEMORY_SCOPE_AGENT);
                        if ((unsigned)(x0 >> 32) == tag && (unsigned)(x1 >> 32) == tag) break; __builtin_amdgcn_s_sleep(2); if (++spins > (1u << 22)) break; }
                    const float e0 = __builtin_bit_cast(float, (unsigned)x0), e1 = __builtin_bit_cast(float, (unsigned)x1);
                    const float nr = Ar * cr - Ai * ci + e0, ni = Ar * ci + Ai * cr + e1; cr = nr; ci = ni; }
                CR[c * 2] = cr; CR[c * 2 + 1] = ci;
            }
            __syncthreads();
            float sr = CR[c * 2], si = CR[c * 2 + 1];
            for (int jj = 0; jj < j; ++jj) { const float h0 = EX[(jj * 128 + c) * 4], h1 = EX[(jj * 128 + c) * 4 + 1], q0 = EX[(jj * 128 + c) * 4 + 2], q1 = EX[(jj * 128 + c) * 4 + 3];
                const float nr = q0 * sr - q1 * si + h0, ni = q0 * si + q1 * sr + h1; sr = nr; si = ni; }
#pragma unroll 4
            for (int q = 0; q < 32; ++q) { const int i = 32 * j + q, row = 16 + (d ? 127 - i : i); const unsigned zw = *(const LAS unsigned*)(zc + row * ZS_STRIDE); *(LAS unsigned*)(zc + row * ZS_STRIDE) = pk2(sr, si);
                const float nr = ar * sr - ai * si + bflo(zw), ni = ar * si + ai * sr + bfhi(zw); sr = nr; si = ni; }
        }
        {   const bf16* Tm = (const bf16*)(F.ws + WS_S5M) + ((size_t)(l * 32 + g) * 3 + 1) * 65536; const bf16* Em = Tm + 65536;
            bf16x8 At[2][8], Ae[2][8];
#pragma unroll
            for (int j = 0; j < 2; ++j)
#pragma unroll
                for (int ks = 0; ks < 8; ++ks) { const size_t o = (size_t)(16 * (2 * F.wave + j) + l15) * 256 + 32 * ks + 8 * lq; At[j][ks] = *(const bf16x8*)(Tm + o); Ae[j][ks] = *(const bf16x8*)(Em + o); }
            const f32x4 dsk = *(const f32x4*)(ds + 16 * g + 4 * lq);
            const int s0 = (p == 0 && l == 0) ? 0 : 1;
            bf16x8 nA = *(const bf16x8*)(vsrc + (size_t)(s0 == 0 ? 64 : 8 * p) * 256 * INW), nB = *(const bf16x8*)(vsrc + (size_t)(8 * p + s0) * 256 * INW), nC = *(const bf16x8*)(vsrc + (size_t)(8 * p + s0 + 1) * 256 * INW);
            __syncthreads();
            *(LAS bf16x8*)(F.lds + (F.wave * 64 + F.lane) * 16) = nA;
            __syncthreads();
            int cur = 0;
#pragma unroll 1
            for (int s = s0; s < 9; ++s) { const int tl = s == 0 ? 64 : 8 * p + s - 1;
                bf16x8 nD = nC; if (s + 3 < 9) nD = *(const bf16x8*)(vsrc + (size_t)(8 * p + s + 2) * 256 * INW);
                v2u uu[2];
#pragma unroll
                for (int j = 0; j < 2; ++j) uu[j] = *(const LAS v2u*)(F.lds + cur * 8192 + (F.wave * 64 + l15 + 16 * (2 * j + (lq >> 1))) * 16 + 8 * (lq & 1));
                f32x4 acc[2] = {{0.f, 0.f, 0.f, 0.f}, {0.f, 0.f, 0.f, 0.f}};
#pragma unroll
                for (int ks = 0; ks < 8; ++ks) { const bf16x8 V = *(const LAS bf16x8*)(F.lds + cur * 8192 + (ks * 64 + F.lane) * 16), S = *(const LAS bf16x8*)(ZS + (s * 16 + l15) * ZS_STRIDE + (32 * ks + 8 * lq) * 2);
#pragma unroll
                    for (int j = 0; j < 2; ++j) { acc[j] = __builtin_amdgcn_mfma_f32_16x16x32_bf16(At[j][ks], V, acc[j], 0, 0, 0); acc[j] = __builtin_amdgcn_mfma_f32_16x16x32_bf16(Ae[j][ks], S, acc[j], 0, 0, 0); } }
#pragma unroll
                for (int j = 0; j < 2; ++j) { const size_t row = (size_t)tl * 256 + 16 * l15 + (2 * F.wave + j); const int ch = 16 * g + 4 * lq; const v2u u = uu[j];
                    const float y0 = acc[j][0] + dsk[0] * bflo(u.x), y1 = acc[j][1] + dsk[1] * bfhi(u.x), y2 = acc[j][2] + dsk[2] * bflo(u.y), y3 = acc[j][3] + dsk[3] * bfhi(u.y);
                    v2u w; w.x = cvtpk(geluf_(y0), geluf_(y1)); w.y = cvtpk(geluf_(y2), geluf_(y3)); *(v2u*)(YG + row * MIXW + ch) = w; }
                if (s < 8) *(LAS bf16x8*)(F.lds + (cur ^ 1) * 8192 + (F.wave * 64 + F.lane) * 16) = nB;
                __syncthreads();
                cur ^= 1; nB = nC; nC = nD;
            }
        }
    }
}
__device__ __forceinline__ int s5_chain_sb(int d, int i) { return d == 0 ? (i < 16 ? 1024 + i : i - 16) : (i < 16 ? 1039 - i : 1023 - (i - 16)); }
__device__ __forceinline__ void sg_fast_item(Frame& F, int l, int chunk, int pass) {
    const bf16* PROJ = (const bf16*)(F.ws + WS_PROJ); bf16* YB = (bf16*)(F.ws + WS_YS) + (size_t)MT * MIXW; const bf16* WSG = (const bf16*)(F.ws + WS_WSG);
    const float* lg = IN_(I_SGG) + l * MIXW; const float* lb = IN_(I_SGB) + l * MIXW; const float* bsg = IN_(I_BSG) + l * 512;
    LAS float* st = (LAS float*)(F.lds + 131072 + 2048); LAS unsigned char* WL = F.lds + 65536;
    __syncthreads();
    v4u wst[8];
#pragma unroll
    for (int i = 0; i < 8; ++i) { const int pid = F.tid + NT * i, ln = pid & 63, rest = pid >> 6, ks = rest & 3, cb = (rest >> 2) & 7, gl = rest >> 5;
        wst[i] = *(const v4u*)(WSG + ((size_t)(pass * 2 + gl) * 128 + cb * 16 + (ln & 15)) * 128 + 32 * ks + 8 * (ln >> 4)); }
    {
        const int p = F.tid >> 2, part = F.tid & 3; const bf16* vr = PROJ + (size_t)(chunk * 128 + p) * INW + 1024 + part * 128; float s = 0.f, q = 0.f;
#pragma unroll 8
        for (int c = 0; c < 128; c += 8) { const v4u w = *(const v4u*)(vr + c); const float x[8] = {bflo(w.x), bfhi(w.x), bflo(w.y), bfhi(w.y), bflo(w.z), bfhi(w.z), bflo(w.w), bfhi(w.w)};
#pragma unroll
            for (int i = 0; i < 8; ++i) { s += x[i]; q += x[i] * x[i]; } }
        s += shflx(s, 1, F.lane); q += shflx(q, 1, F.lane); s += shflx(s, 2, F.lane); q += shflx(q, 2, F.lane);
        const float mu = s * (1.f / 512.f), var = fmaxf(q * (1.f / 512.f) - mu * mu, 0.f);
        if (part == 0) { st[p * 2] = mu; st[p * 2 + 1] = rsqrtf(var + EPS); }
    }
#pragma unroll
    for (int i = 0; i < 8; ++i) *(LAS v4u*)(WL + (F.tid + NT * i) * 16) = wst[i];
    __syncthreads();
    const int l15 = F.lane & 15, lq = F.lane >> 4;
#pragma unroll 1
    for (int it = F.tid; it < 2048; it += NT) { const int tp = it & 63, cg = it >> 6; const int p0 = tp * 2, ch = pass * 256 + cg * 8;
        const v4u w0 = *(const v4u*)(PROJ + (size_t)(chunk * 128 + p0) * INW + 1024 + ch), w1 = *(const v4u*)(PROJ + (size_t)(chunk * 128 + p0 + 1) * INW + 1024 + ch);
        const float mu0 = st[p0 * 2], rs0 = st[p0 * 2 + 1], mu1 = st[p0 * 2 + 2], rs1 = st[p0 * 2 + 3];
        const float x0[8] = {bflo(w0.x), bfhi(w0.x), bflo(w0.y), bfhi(w0.y), bflo(w0.z), bfhi(w0.z), bflo(w0.w), bfhi(w0.w)};
        const float x1[8] = {bflo(w1.x), bfhi(w1.x), bflo(w1.y), bfhi(w1.y), bflo(w1.z), bfhi(w1.z), bflo(w1.w), bfhi(w1.w)};
#pragma unroll
        for (int i = 0; i < 8; ++i) { const float gm = lg[ch + i], bt = lb[ch + i]; const int c = cg * 8 + i;
            *(LAS unsigned*)(F.lds + c * 256 + (((p0 >> 3) ^ (c & 15)) << 4) + (p0 & 7) * 2) = pk2((x0[i] - mu0) * rs0 * gm + bt, (x1[i] - mu1) * rs1 * gm + bt); } }
    __syncthreads();
    const int ggl = F.wave >> 2, gg = pass * 2 + ggl, rb0 = (F.wave & 3) * 2;
    bf16x8 A[2][4];
#pragma unroll
    for (int j = 0; j < 2; ++j)
#pragma unroll
        for (int ks = 0; ks < 4; ++ks) { const int c = ggl * 128 + (rb0 + j) * 16 + l15; A[j][ks] = *(const LAS bf16x8*)(F.lds + c * 256 + (((4 * ks + lq) ^ (c & 15)) << 4)); }
    v2u guv[8][2];
#pragma unroll
    for (int cb = 0; cb < 8; ++cb)
#pragma unroll
        for (int j = 0; j < 2; ++j) guv[cb][j] = *(const v2u*)(PROJ + ((size_t)chunk * 128 + cb * 16 + l15) * INW + 512 + gg * 128 + (rb0 + j) * 16 + 4 * lq);
    f32x4 acc[2][8];
#pragma unroll
    for (int j = 0; j < 2; ++j)
#pragma unroll
        for (int cb = 0; cb < 8; ++cb) acc[j][cb] = (f32x4){0.f, 0.f, 0.f, 0.f};
#pragma unroll
    for (int cb = 0; cb < 8; ++cb)
#pragma unroll
        for (int ks = 0; ks < 4; ++ks) { const bf16x8 B = *(const LAS bf16x8*)(WL + ((((ggl * 8 + cb) * 4 + ks) * 64) + F.lane) * 16);
#pragma unroll
            for (int j = 0; j < 2; ++j) acc[j][cb] = __builtin_amdgcn_mfma_f32_16x16x32_bf16(A[j][ks], B, acc[j][cb], 0, 0, 0); }
    asm volatile("" ::: "memory");
#pragma unroll
    for (int cb = 0; cb < 8; ++cb) { const int q = cb * 16 + l15; const size_t row = (size_t)chunk * 128 + q; const float bq = bsg[gg * 128 + q];
#pragma unroll
        for (int j = 0; j < 2; ++j) { const int col = gg * 128 + (rb0 + j) * 16 + 4 * lq; const v2u gu = guv[cb][j];
            v2u w; w.x = cvtpk(bflo(gu.x) * (acc[j][cb][0] + bq), bfhi(gu.x) * (acc[j][cb][1] + bq)); w.y = cvtpk(bflo(gu.y) * (acc[j][cb][2] + bq), bfhi(gu.y) * (acc[j][cb][3] + bq));
            *(v2u*)(YB + row * MIXW + col) = w; } }
}

__device__ __forceinline__ bf16x8 sum3_bf16x8(const bf16* p, size_t stride) {
    const v4u a = *(const v4u*)p, b = *(const v4u*)(p + stride), c = *(const v4u*)(p + 2 * stride); v4u o;
    o.x = pk2(bflo(a.x) + bflo(b.x) + bflo(c.x), bfhi(a.x) + bfhi(b.x) + bfhi(c.x)); o.y = pk2(bflo(a.y) + bflo(b.y) + bflo(c.y), bfhi(a.y) + bfhi(b.y) + bfhi(c.y));
    o.z = pk2(bflo(a.z) + bflo(b.z) + bflo(c.z), bfhi(a.z) + bfhi(b.z) + bfhi(c.z)); o.w = pk2(bflo(a.w) + bflo(b.w) + bflo(c.w), bfhi(a.w) + bfhi(b.w) + bfhi(c.w));
    return __builtin_bit_cast(bf16x8, o);
}
template <int RB, int CB, bool SUM3, class EF>
__device__ __forceinline__ void thin_block(const bf16* A, int lda, size_t astride, const bf16* Bt, int K, int row0, int col0, int wave, int lane, LAS unsigned char* lds, const EF& ef) {
    constexpr int NTL = RB * CB; const int r = lane & 15, q = lane >> 4;
    if constexpr (NTL >= 8) {
        constexpr int TPW = NTL / 8, WPR = CB / TPW;
        const int rb = wave / WPR, cb0 = (wave % WPR) * TPW;
        const bf16* a = A + (size_t)(row0 + 16 * rb + r) * lda + 8 * q; const bf16* b = Bt + (size_t)(col0 + 16 * cb0 + r) * K + 8 * q;
        f32x4 acc[TPW];
#pragma unroll
        for (int c = 0; c < TPW; ++c) acc[c] = (f32x4){0.f, 0.f, 0.f, 0.f};
        bf16x8 xa[8], wa[TPW][8], xb[8], wb[TPW][8];
#define THIN_LD(x, w, kk) do { _Pragma("unroll") for (int j = 0; j < 8; ++j) { x[j] = SUM3 ? sum3_bf16x8(a + 32 * ((kk) + j), astride) : *(const bf16x8*)(a + 32 * ((kk) + j)); \
            _Pragma("unroll") for (int c = 0; c < TPW; ++c) w[c][j] = *(const bf16x8*)(b + (size_t)(16 * c) * K + 32 * ((kk) + j)); } } while (0)
#define THIN_MM(x, w) do { _Pragma("unroll") for (int j = 0; j < 8; ++j) _Pragma("unroll") for (int c = 0; c < TPW; ++c) acc[c] = __builtin_amdgcn_mfma_f32_16x16x32_bf16(x[j], w[c][j], acc[c], 0, 0, 0); } while (0)
        THIN_LD(xa, wa, 0);
#pragma unroll 1
        for (int k0 = 0; k0 < K / 32; k0 += 16) {
            THIN_LD(xb, wb, k0 + 8); __builtin_amdgcn_sched_barrier(0); THIN_MM(xa, wa); __builtin_amdgcn_sched_barrier(0);
            if (k0 + 16 < K / 32) THIN_LD(xa, wa, k0 + 16);
            __builtin_amdgcn_sched_barrier(0); THIN_MM(xb, wb); __builtin_amdgcn_sched_barrier(0);
        }
#undef THIN_LD
#undef THIN_MM
#pragma unroll
        for (int c = 0; c < TPW; ++c)
#pragma unroll
            for (int i = 0; i < 4; ++i) ef(row0 + 16 * rb + 4 * q + i, col0 + 16 * (cb0 + c) + r, acc[c][i]);
    } else {
        constexpr int KS = 8 / NTL;
        const int t = wave % NTL, kp = wave / NTL, rb = t / CB, cb = t % CB; const int kw = K / KS;
        const bf16* a = A + (size_t)(row0 + 16 * rb + r) * lda + kp * kw + 8 * q; const bf16* b = Bt + (size_t)(col0 + 16 * cb + r) * K + kp * kw + 8 * q;
        f32x4 acc = {0.f, 0.f, 0.f, 0.f};
        bf16x8 xa[4], wa[4], xb[4], wb[4];
#define THIN_LD(x, w, kk) do { _Pragma("unroll") for (int j = 0; j < 4; ++j) { x[j] = SUM3 ? sum3_bf16x8(a + 32 * ((kk) + j), astride) : *(const bf16x8*)(a + 32 * ((kk) + j)); w[j] = *(const bf16x8*)(b + 32 * ((kk) + j)); } } while (0)
#define THIN_MM(x, w) do { _Pragma("unroll") for (int j = 0; j < 4; ++j) acc = __builtin_amdgcn_mfma_f32_16x16x32_bf16(x[j], w[j], acc, 0, 0, 0); } while (0)
        THIN_LD(xa, wa, 0);
#pragma unroll 1
        for (int k0 = 0; k0 < kw / 32; k0 += 8) {
            THIN_LD(xb, wb, k0 + 4); __builtin_amdgcn_sched_barrier(0); THIN_MM(xa, wa); __builtin_amdgcn_sched_barrier(0);
            if (k0 + 8 < kw / 32) THIN_LD(xa, wa, k0 + 8);
            __builtin_amdgcn_sched_barrier(0); THIN_MM(xb, wb); __builtin_amdgcn_sched_barrier(0);
        }
#undef THIN_LD
#undef THIN_MM
        __syncthreads();
        *(LAS f32x4*)(lds + (wave * 64 + lane) * 16) = acc;
        __syncthreads();
        if (kp == 0) { f32x4 s = acc;
#pragma unroll
            for (int p = 1; p < KS; ++p) s = s + *(const LAS f32x4*)(lds + ((p * NTL + t) * 64 + lane) * 16);
#pragma unroll
            for (int i = 0; i < 4; ++i) ef(row0 + 16 * rb + 4 * q + i, col0 + 16 * cb + r, s[i]); }
    }
}
template <bool SUM3, class EF>
__device__ __forceinline__ void thin_lds(const bf16* A, int lda, size_t astride, const bf16* Bt, int K, int row0, int col0, int tid, int wave, int lane, LAS unsigned char* lds, const EF& ef) {
    const int r = lane & 15, q = lane >> 4, rb = wave >> 1, cb0 = (wave & 1) * 2;
    f32x4 acc[2] = {{0.f, 0.f, 0.f, 0.f}, {0.f, 0.f, 0.f, 0.f}};
    v4u xs[8], wv[8];
    const int prow = tid >> 6, ppc = tid & 63;
#define TL_LD(c) do { _Pragma("unroll") for (int i = 0; i < 8; ++i) { const bf16* ap = A + (size_t)(row0 + prow + 8 * i) * lda + (c) * 512 + ppc * 8; \
        xs[i] = SUM3 ? __builtin_bit_cast(v4u, sum3_bf16x8(ap, astride)) : *(const v4u*)ap; wv[i] = *(const v4u*)(Bt + (size_t)(col0 + prow + 8 * i) * K + (c) * 512 + ppc * 8); } } while (0)
    const int nch = K / 512;
    TL_LD(0);
#pragma unroll 1
    for (int c = 0; c < nch; ++c) {
        __syncthreads();
#pragma unroll
        for (int i = 0; i < 8; ++i) { const int row = prow + 8 * i; const int o = row * 1024 + ((ppc ^ (row & 15)) << 4); *(LAS v4u*)(lds + o) = xs[i]; *(LAS v4u*)(lds + 65536 + o) = wv[i]; }
        __syncthreads();
        if (c + 1 < nch) TL_LD(c + 1);
        __builtin_amdgcn_sched_barrier(0);
#pragma unroll
        for (int ks = 0; ks < 16; ++ks) { const int po = ((4 * ks + q) ^ r) << 4;
            const bf16x8 x = *(const LAS bf16x8*)(lds + (16 * rb + r) * 1024 + po);
            const bf16x8 w0 = *(const LAS bf16x8*)(lds + 65536 + (16 * cb0 + r) * 1024 + po), w1 = *(const LAS bf16x8*)(lds + 65536 + (16 * (cb0 + 1) + r) * 1024 + po);
            acc[0] = __builtin_amdgcn_mfma_f32_16x16x32_bf16(x, w0, acc[0], 0, 0, 0); acc[1] = __builtin_amdgcn_mfma_f32_16x16x32_bf16(x, w1, acc[1], 0, 0, 0); }
    }
#undef TL_LD
    float2 aux[2][4];
#pragma unroll
    for (int c = 0; c < 2; ++c)
#pragma unroll
        for (int i = 0; i < 4; ++i) aux[c][i] = ef.load(row0 + 16 * rb + 4 * q + i, col0 + 16 * (cb0 + c) + r);
    asm volatile("" ::: "memory");
#pragma unroll
    for (int c = 0; c < 2; ++c)
#pragma unroll
        for (int i = 0; i < 4; ++i) ef.store(row0 + 16 * rb + 4 * q + i, col0 + 16 * (cb0 + c) + r, acc[c][i], aux[c][i]);
    __syncthreads();
}
struct CtxProj { bf16* P; __device__ __forceinline__ void operator()(int row, int col, float v) const { const float o = (col >= 512 && col < 1536) ? geluf_(v) : v; P[(size_t)row * INW + col] = (bf16)f2bf(o); }
    __device__ __forceinline__ float2 load(int, int) const { return make_float2(0.f, 0.f); }
    __device__ __forceinline__ void store(int row, int col, float v, float2) const { (*this)(row, col, v); } };
struct CtxBr { bf16* BR; int kk;
    __device__ __forceinline__ float2 load(int, int) const { return make_float2(0.f, 0.f); }
    __device__ __forceinline__ void store(int row, int col, float v, float2) const { BR[(size_t)row * INW + kk * 1024 + col] = (bf16)f2bf(v); } };
struct CtxMerge { const bf16* BR; bf16* PMK; const float* bm; int kk;
    __device__ __forceinline__ float2 load(int row, int col) const { return make_float2(bm[kk * 1024 + col], bf2f(BR[(size_t)row * INW + kk * 1024 + col])); }
    __device__ __forceinline__ void store(int row, int col, float v, float2 a) const { PMK[((size_t)kk * CTX + row) * D + col] = (bf16)f2bf(sigmoidf_(v + a.x) * a.y); } };
struct CtxWo { const float* xs; float* XC; const float* ga;
    __device__ __forceinline__ float2 load(int row, int col) const { return make_float2(xs[(size_t)row * D + col], ga[col]); }
    __device__ __forceinline__ void store(int row, int col, float v, float2 a) const { XC[(size_t)row * D + col] = a.x + a.y * v; } };
__device__ __forceinline__ void ph2_ctx(Frame& F, int ncols) {
    const bf16* Hc = (const bf16*)HBUF(F) + (size_t)SEQ * D; const bf16* W = (const bf16*)(F.ws + WS_WIN); CtxProj ef{(bf16*)(F.ws + WS_PROJ) + (size_t)SEQ * INW};
    if (ncols == INW) { for (int it = F.bid; it < 4 * (INW / 64); it += F.G) thin_lds<false>(Hc, D, 0, W, D, (it & 3) * 64, (it >> 2) * 64, F.tid, F.wave, F.lane, F.lds, ef); }
    else { for (int it = F.bid; it < 8 * (ncols / 16); it += F.G) thin_block<2, 1, false>(Hc, D, 0, W, D, (it & 7) * 32, (it >> 3) * 16, F.wave, F.lane, F.lds, ef); }
}
__device__ __forceinline__ void ph7_ctx(Frame& F) {
    for (int it = F.bid; it < 3 * 64; it += F.G) { const int kk = it / 64, j = it % 64; CtxBr ef{(bf16*)(F.ws + WS_PROJ) + (size_t)SEQ * INW, kk};
        thin_lds<false>((const bf16*)(F.ws + WS_YS) + ((size_t)kk * MT + SEQ) * MIXW, MIXW, 0, (const bf16*)(F.ws + WS_WBR) + (size_t)kk * 1024 * MIXW, MIXW, (j & 3) * 64, (j >> 2) * 64, F.tid, F.wave, F.lane, F.lds, ef); }
}
__device__ __forceinline__ void ph8_ctx(Frame& F, int l) {
    const bf16* Hc = (const bf16*)HBUF(F) + (size_t)SEQ * D;
    for (int it = F.bid; it < 3 * 64; it += F.G) { const int kk = it / 64, j = it % 64; CtxMerge ef{(const bf16*)(F.ws + WS_PROJ) + (size_t)SEQ * INW, (bf16*)(F.ws + WS_Z), IN_(I_BMG) + l * INW, kk};
        thin_lds<false>(Hc, D, 0, (const bf16*)(F.ws + WS_WMG) + (size_t)kk * 1024 * D, D, (j & 3) * 64, (j >> 2) * 64, F.tid, F.wave, F.lane, F.lds, ef); }
}
__device__ __forceinline__ void ph9_ctx(Frame& F, int l) {
    CtxWo ef{l == 0 ? IN_(I_CTX) : (const float*)(F.ws + WS_XC), (float*)(F.ws + WS_XC), (const float*)(F.ws + WS_MOD) + (size_t)(l * 2 + 1) * 6144 + 2048};
    for (int it = F.bid; it < 4 * 16; it += F.G) thin_lds<true>((const bf16*)(F.ws + WS_Z), D, (size_t)CTX * D, (const bf16*)(F.ws + WS_WO), D, (it & 3) * 64, (it >> 2) * 64, F.tid, F.wave, F.lane, F.lds, ef);
}
__device__ __forceinline__ void ctx_x1_fixup(Frame& F, int l, int row0) {
    const float* XC = (const float*)(F.ws + WS_XC); float* RSS = (float*)(F.ws + WS_RSS);
    const int rr = row0 + (F.tid >> 5), part = F.tid & 31; const float* xr = XC + (size_t)rr * D + part * 32; float s = 0.f;
#pragma unroll
    for (int c = 0; c < 32; c += 4) { const f32x4 v = *(const f32x4*)(xr + c); s += v.x * v.x + v.y * v.y + v.z * v.z + v.w * v.w; }
    s += shflx(s, 1, F.lane); s += shflx(s, 2, F.lane); s += shflx(s, 4, F.lane); s += shflx(s, 8, F.lane); s += shflx(s, 16, F.lane);
    if (part < 16) RSS[(size_t)(SEQ + rr) * 16 + part] = part == 0 ? s : 0.f;
    asm volatile("s_waitcnt vmcnt(0)" ::: "memory");
    __syncthreads();
}


__device__ __forceinline__ void ph0_prologue(Frame& F) {
    float* mod = (float*)(F.ws + WS_MOD);
    LAS float* SV = (LAS float*)(F.lds + 131072 + 4096);
    for (int i = F.tid; i < 2048; i += NT) SV[i] = siluf_(i < 1024 ? IN_(I_C)[i] : IN_(I_CCTX)[i - 1024]);
    __syncthreads();
    LAS float* RED = (LAS float*)(F.lds + 131072 + 4096 + 8192);
    for (int it = F.bid; it < 2 * 96; it += F.G) { const int l = it / 96, j = (it % 96) * 64 + F.lane;
        const float* W = IN_(I_WADA) + (size_t)l * D * 6144 + j + (size_t)(F.wave * 128) * 6144;
        float a0 = 0.f, a1 = 0.f;
#pragma unroll 32
        for (int kk = 0; kk < 128; ++kk) { const float w = W[(size_t)kk * 6144]; a0 += SV[F.wave * 128 + kk] * w; a1 += SV[1024 + F.wave * 128 + kk] * w; }
        __syncthreads();
        RED[(F.wave * 2 + 0) * 64 + F.lane] = a0; RED[(F.wave * 2 + 1) * 64 + F.lane] = a1;
        __syncthreads();
        if (F.wave < 2) { float s = 0.f;
#pragma unroll
            for (int w8 = 0; w8 < 8; ++w8) s += RED[(w8 * 2 + F.wave) * 64 + F.lane];
            const float mv = s + IN_(I_BADA)[l * 6144 + j]; mod[(size_t)(l * 2 + F.wave) * 6144 + j] = mv;
            if (l == 0 && j < 2048) __hip_atomic_store((unsigned long long*)(F.ws + WS_MG) + F.wave * 2048 + j, (1ull << 32) | __builtin_bit_cast(unsigned, mv), __ATOMIC_RELAXED, __HIP_MEMORY_SCOPE_AGENT); }
    }
}
__device__ __forceinline__ void stage_mod_granules(Frame& F, const float* g, LAS float* GC, LAS float* SH) {
    unsigned long long* MG = (unsigned long long*)(F.ws + WS_MG);
    __syncthreads();
    for (int i0 = F.tid; i0 < 2048; i0 += 4 * NT) { unsigned long long xs[4], xc[4]; unsigned spins = 0;
        for (;;) { bool ok = true;
#pragma unroll
            for (int q = 0; q < 4; ++q) { const int i = i0 + q * NT, w = i >> 10, c = i & 1023; xs[q] = __hip_atomic_load(MG + w * 2048 + c, __ATOMIC_RELAXED, __HIP_MEMORY_SCOPE_AGENT); xc[q] = __hip_atomic_load(MG + w * 2048 + 1024 + c, __ATOMIC_RELAXED, __HIP_MEMORY_SCOPE_AGENT); }
#pragma unroll
            for (int q = 0; q < 4; ++q) ok = ok && (unsigned)(xs[q] >> 32) == 1u && (unsigned)(xc[q] >> 32) == 1u;
            if (ok) break; __builtin_amdgcn_s_sleep(2); if (++spins > (1u << 22)) break; }
#pragma unroll
        for (int q = 0; q < 4; ++q) { const int i = i0 + q * NT, c = i & 1023; GC[i] = g[c] * (1.f + __builtin_bit_cast(float, (unsigned)xc[q])); SH[i] = __builtin_bit_cast(float, (unsigned)xs[q]); } }
    __syncthreads();
}
__device__ __forceinline__ void stage_mod(Frame& F, const float* g, int l, int sh_off, int sc_off, LAS float* GC, LAS float* SH) {
    __syncthreads();
    for (int i = F.tid; i < 2048; i += NT) { const int w = i >> 10, c = i & 1023; const float* m = (const float*)(F.ws + WS_MOD) + (size_t)(l * 2 + w) * 6144; GC[i] = g[c] * (1.f + m[sc_off + c]); SH[i] = m[sh_off + c]; }
    __syncthreads();
}
__device__ __forceinline__ void hprep_rows(Frame& F, int l) {
    bf16* H = (bf16*)HBUF(F); LAS float* GC = (LAS float*)F.lds; LAS float* SH = GC + 2048;
    stage_mod_granules(F, IN_(I_GMIX) + l * D, GC, SH);
    const int gw = F.bid * (NT / 64) + F.wave, ngw = F.G * (NT / 64);
    for (int row0 = gw; row0 < MT; row0 += 2 * ngw) {
        int rows[2]; bool ok[2]; f32x4 v[2][4]; float s[2] = {0.f, 0.f};
#pragma unroll
        for (int t = 0; t < 2; ++t) { rows[t] = row0 + t * ngw; ok[t] = rows[t] < MT; if (!ok[t]) rows[t] = row0; }
#pragma unroll
        for (int t = 0; t < 2; ++t) { const float* xr = xin_row(F, rows[t]);
#pragma unroll
            for (int j = 0; j < 4; ++j) v[t][j] = *(const f32x4*)(xr + 4 * F.lane + 256 * j); }
#pragma unroll
        for (int t = 0; t < 2; ++t)
#pragma unroll
            for (int j = 0; j < 4; ++j) s[t] += v[t][j].x * v[t][j].x + v[t][j].y * v[t][j].y + v[t][j].z * v[t][j].z + v[t][j].w * v[t][j].w;
#pragma unroll
        for (int t = 0; t < 2; ++t) { if (!ok[t]) continue; const int pv = rows[t] >= SEQ ? 1024 : 0;
            const float rstd = rsqrtf(wave_sum(s[t], F.lane) * (1.f / D) + EPS);
#pragma unroll
            for (int j = 0; j < 4; ++j) { const int c = 4 * F.lane + 256 * j; const f32x4 gc = *(const LAS f32x4*)(GC + pv + c), sh = *(const LAS f32x4*)(SH + pv + c);
                const f32x4 o = v[t][j] * rstd * gc + sh; v2u w; w.x = pk2(o.x, o.y); w.y = pk2(o.z, o.w); *(v2u*)(H + (size_t)rows[t] * D + c) = w; } }
    }
}
__device__ __forceinline__ void ph3_conv(Frame& F, int l, int nrows) {
    const bf16* PROJ = (const bf16*)(F.ws + WS_PROJ); bf16* YC = (bf16*)(F.ws + WS_YS) + (size_t)2 * MT * MIXW; const float* wc = IN_(I_WCONV) + l * 3 * MIXW;
    const size_t gt = (size_t)F.bid * NT + F.tid, ngt = (size_t)F.G * NT;
#pragma unroll 2
    for (size_t i = gt; i < (size_t)nrows * (MIXW / 8); i += ngt) {
        const int row = (int)(i / (MIXW / 8)), c = (int)(i % (MIXW / 8)) * 8;
        int pos, rl; if (row < SEQ) { pos = row & 63; rl = 64; } else { pos = row - SEQ; rl = 256; }
        const bf16* r0 = PROJ + (size_t)row * INW + 1536 + c;
        const v4u zero = {0u, 0u, 0u, 0u};
        const v4u b0 = *(const v4u*)(r0), c0 = *(const v4u*)(r0 + 512), h0 = *(const v4u*)(r0 + 1024);
        const v4u cm = pos > 0 ? *(const v4u*)(r0 - INW + 512) : zero, hm = pos > 0 ? *(const v4u*)(r0 - INW + 1024) : zero;
        const v4u cp = pos < rl - 1 ? *(const v4u*)(r0 + INW + 512) : zero, hp = pos < rl - 1 ? *(const v4u*)(r0 + INW + 1024) : zero;
        const f32x4 w0a = *(const f32x4*)(wc + c), w0b = *(const f32x4*)(wc + c + 4), w1a = *(const f32x4*)(wc + 512 + c), w1b = *(const f32x4*)(wc + 512 + c + 4), w2a = *(const f32x4*)(wc + 1024 + c), w2b = *(const f32x4*)(wc + 1024 + c + 4);
        const float w0[8] = {w0a.x, w0a.y, w0a.z, w0a.w, w0b.x, w0b.y, w0b.z, w0b.w}, w1[8] = {w1a.x, w1a.y, w1a.z, w1a.w, w1b.x, w1b.y, w1b.z, w1b.w}, w2[8] = {w2a.x, w2a.y, w2a.z, w2a.w, w2b.x, w2b.y, w2b.z, w2b.w};
        const unsigned bb[4] = {b0.x, b0.y, b0.z, b0.w}, cc[4] = {c0.x, c0.y, c0.z, c0.w}, hh[4] = {h0.x, h0.y, h0.z, h0.w}, cmv[4] = {cm.x, cm.y, cm.z, cm.w}, hmv[4] = {hm.x, hm.y, hm.z, hm.w}, cpv[4] = {cp.x, cp.y, cp.z, cp.w}, hpv[4] = {hp.x, hp.y, hp.z, hp.w};
        unsigned o[4];
#pragma unroll
        for (int j = 0; j < 4; ++j) {
            const float ylo = bflo(bb[j]) * (w0[2 * j] * (bflo(cmv[j]) * bflo(hmv[j])) + w1[2 * j] * (bflo(cc[j]) * bflo(hh[j])) + w2[2 * j] * (bflo(cpv[j]) * bflo(hpv[j])));
            const float yhi = bfhi(bb[j]) * (w0[2 * j + 1] * (bfhi(cmv[j]) * bfhi(hmv[j])) + w1[2 * j + 1] * (bfhi(cc[j]) * bfhi(hh[j])) + w2[2 * j + 1] * (bfhi(cpv[j]) * bfhi(hpv[j])));
            o[j] = pk2(ylo, yhi); }
        v4u ov; ov.x = o[0]; ov.y = o[1]; ov.z = o[2]; ov.w = o[3]; *(v4u*)(YC + (size_t)row * MIXW + c) = ov;
    }
}
template <int KS, bool LDSW>
__device__ __forceinline__ void route_pass(Frame& F, int l, int u, bool valid, int kh, int sl, LAS float* GC, LAS float* SH, LAS float* SSQ, LAS float* LG, LAS int* HISTL) {
    bf16* H = (bf16*)HBUF(F); const bf16* WRh = (const bf16*)(F.ws + WS_WR); const bf16* WRl = WRh + 48 * 1024;
    const float* bg = IN_(I_BGRP) + l * 4; const float* be = IN_(I_BEXP) + l * 32;
    int* EID = (int*)(F.ws + WS_EID); float* EW = (float*)(F.ws + WS_EW);
    constexpr int NK = 32 / KS, KW = 1024 / KS;
    const int r = F.lane & 15, q = F.lane >> 4;
    const int uu = valid ? u : 0; const int row = uu * 16 + r; const int pv = (row >= SEQ ? 1024 : 0) + kh * KW + 8 * q;
    const float* xr = (const float*)(F.ws + WS_XC) + (size_t)(KS == 2 ? 0 : row - SEQ) * D + kh * KW + 8 * q;
    const bf16* xr16 = (const bf16*)(F.ws + WS_X16) + (size_t)(KS == 2 ? row : 0) * D + kh * KW + 8 * q;
    const f32x4 rp = *(const f32x4*)((const float*)(F.ws + WS_RSS) + (size_t)row * 16 + 4 * q);
    float tot = (rp.x + rp.y) + (rp.z + rp.w); tot += shflx(tot, 16, F.lane); tot += shflx(tot, 32, F.lane);
    const float rstd = rsqrtf(tot * (1.f / D) + EPS);
    __syncthreads();
    (void)SSQ;
    f32x4 acc[3] = {{0.f, 0.f, 0.f, 0.f}, {0.f, 0.f, 0.f, 0.f}, {0.f, 0.f, 0.f, 0.f}};
    LAS unsigned char* WB = F.lds + 45056;
    v4u stg[6];
    if constexpr (LDSW) {
#pragma unroll
        for (int i = 0; i < 6; ++i) { const int pid = F.tid + NT * i, ln = pid & 63, rest = pid >> 6, ks = rest & 3, cb = (rest >> 2) % 3, hl = (rest / 12) & 1, khh = rest / 24;
            stg[i] = *(const v4u*)((hl ? WRl : WRh) + (size_t)(cb * 16 + (ln & 15)) * 1024 + khh * 512 + 32 * ks + 8 * (ln >> 4)); }
    }
    v4u xall[KS == 2 ? 16 : 1];
    if constexpr (KS == 2) {
#pragma unroll
        for (int j = 0; j < 16; ++j) xall[j] = *(const v4u*)(xr16 + 32 * j); }
#pragma unroll
    for (int k0 = 0; k0 < NK; k0 += 4) {
        f32x4 xa[4][2]; bf16x8 Bh[4][3], Bl[4][3];
        if constexpr (LDSW) {
            __syncthreads();
#pragma unroll
            for (int i = 0; i < 6; ++i) *(LAS v4u*)(WB + (F.tid + NT * i) * 16) = stg[i];
            __syncthreads();
            if (k0 + 4 < NK) {
#pragma unroll
                for (int i = 0; i < 6; ++i) { const int pid = F.tid + NT * i, ln = pid & 63, rest = pid >> 6, ks = rest & 3, cb = (rest >> 2) % 3, hl = (rest / 12) & 1, khh = rest / 24;
                    stg[i] = *(const v4u*)((hl ? WRl : WRh) + (size_t)(cb * 16 + (ln & 15)) * 1024 + khh * 512 + 32 * (k0 + 4 + ks) + 8 * (ln >> 4)); } }
        }
#pragma unroll
        for (int j = 0; j < 4; ++j) { const int c = 32 * (k0 + j);
            if constexpr (KS == 2) { xa[j][0] = __builtin_bit_cast(f32x4, xall[k0 + j]); } else { xa[j][0] = *(const f32x4*)(xr + c); xa[j][1] = *(const f32x4*)(xr + c + 4); }
#pragma unroll
            for (int cb = 0; cb < 3; ++cb) {
                if constexpr (!LDSW) { const size_t wo = (size_t)(cb * 16 + r) * 1024 + kh * KW + c + 8 * q; Bh[j][cb] = *(const bf16x8*)(WRh + wo); Bl[j][cb] = *(const bf16x8*)(WRl + wo); } } }
#pragma unroll
        for (int j = 0; j < 4; ++j) { const int c = 32 * (k0 + j);
            const f32x4 g0 = *(const LAS f32x4*)(GC + pv + c), g1 = *(const LAS f32x4*)(GC + pv + c + 4), sh0 = *(const LAS f32x4*)(SH + pv + c), sh1 = *(const LAS f32x4*)(SH + pv + c + 4);
            if constexpr (KS == 2) { const v4u w = __builtin_bit_cast(v4u, xa[j][0]); xa[j][0] = (f32x4){bflo(w.x), bfhi(w.x), bflo(w.y), bfhi(w.y)}; xa[j][1] = (f32x4){bflo(w.z), bfhi(w.z), bflo(w.w), bfhi(w.w)}; }
            const f32x4 h0 = xa[j][0] * rstd * g0 + sh0, h1 = xa[j][1] * rstd * g1 + sh1;
            v4u hi; hi.x = pk2(h0.x, h0.y); hi.y = pk2(h0.z, h0.w); hi.z = pk2(h1.x, h1.y); hi.w = pk2(h1.z, h1.w);
            if (valid) *(v4u*)(H + (size_t)row * D + kh * KW + 8 * q + c) = hi;
            v4u lo; lo.x = pk2(h0.x - bflo(hi.x), h0.y - bfhi(hi.x)); lo.y = pk2(h0.z - bflo(hi.y), h0.w - bfhi(hi.y)); lo.z = pk2(h1.x - bflo(hi.z), h1.y - bfhi(hi.z)); lo.w = pk2(h1.z - bflo(hi.w), h1.w - bfhi(hi.w));
            const bf16x8 Ah = __builtin_bit_cast(bf16x8, hi), Al = __builtin_bit_cast(bf16x8, lo);
#pragma unroll
            for (int cb = 0; cb < 3; ++cb) {
                bf16x8 bh, bl;
                if constexpr (LDSW) { bh = *(const LAS bf16x8*)(WB + ((kh * 24 + cb * 4 + j) * 64 + F.lane) * 16); bl = *(const LAS bf16x8*)(WB + ((kh * 24 + 12 + cb * 4 + j) * 64 + F.lane) * 16); }
                else { bh = Bh[j][cb]; bl = Bl[j][cb]; }
                acc[cb] = __builtin_amdgcn_mfma_f32_16x16x32_bf16(Ah, bh, acc[cb], 0, 0, 0); acc[cb] = __builtin_amdgcn_mfma_f32_16x16x32_bf16(Al, bh, acc[cb], 0, 0, 0); acc[cb] = __builtin_amdgcn_mfma_f32_16x16x32_bf16(Ah, bl, acc[cb], 0, 0, 0); } }
    }
    LAS float* LGw = LG + (sl * KS + kh) * (16 * 52);
#pragma unroll
    for (int cb = 0; cb < 3; ++cb)
#pragma unroll
        for (int i = 0; i < 4; ++i) LGw[(4 * q + i) * 52 + cb * 16 + r] = acc[cb][i];
    __syncthreads();
    if (kh == 0 && valid && F.lane < 16) { const LAS float* L0 = LG + (sl * KS) * (16 * 52) + F.lane * 52; const int rw = u * 16 + F.lane;
        float lg[36];
#pragma unroll
        for (int o = 0; o < 36; ++o) { float t = 0.f;
#pragma unroll
            for (int i = 0; i < KS; ++i) t += L0[i * (16 * 52) + o]; lg[o] = t + (o < 4 ? bg[o] : be[o - 4]); }
        LAS float* LW = LG + (sl * KS) * (16 * 52) + F.lane * 52;
#pragma unroll
        for (int o = 0; o < 36; ++o) LW[o] = lg[o];
        int gi = 0; float gm = lg[0];
#pragma unroll
        for (int o = 1; o < 4; ++o) if (lg[o] > gm) { gm = lg[o]; gi = o; }
        float den = 0.f;
#pragma unroll
        for (int o = 0; o < 4; ++o) den += expf(lg[o] - gm);
        const float gp = 1.f / den;
        const LAS float* el = LW + 4 + gi * 8;
        int i1 = 0; float m1 = el[0]; for (int o = 1; o < 8; ++o) { const float v = el[o]; if (v > m1) { m1 = v; i1 = o; } }
        int i2 = -1; float m2 = 0.f; for (int o = 0; o < 8; ++o) { const float v = el[o]; if (o != i1 && (i2 < 0 || v > m2)) { m2 = v; i2 = o; } }
        const float e2 = expf(m2 - m1); const float w1 = 1.f / (1.f + e2), w2 = e2 / (1.f + e2);
        const int e1i = gi * 8 + i1, e2i = gi * 8 + i2;
        EID[rw * 2] = e1i; EID[rw * 2 + 1] = e2i; EW[rw * 2] = gp * w1; EW[rw * 2 + 1] = gp * w2;
        __hip_atomic_fetch_add(&HISTL[e1i], 1, __ATOMIC_RELAXED, __HIP_MEMORY_SCOPE_WORKGROUP); __hip_atomic_fetch_add(&HISTL[e2i], 1, __ATOMIC_RELAXED, __HIP_MEMORY_SCOPE_WORKGROUP);
    }
}
__device__ __forceinline__ void ph10_route(Frame& F, int l) {
    const float* g = IN_(I_GFFN) + l * D;
    LAS float* GC = (LAS float*)F.lds;
    LAS float* SH = GC + 2048;
    LAS float* SSQ = SH + 2048;
    LAS float* LG = SSQ + 128;
    LAS int* HISTL = (LAS int*)(LG + 8 * 16 * 52);
    __syncthreads();
    if (F.tid < 32) HISTL[F.tid] = 0;
    for (int i = F.tid; i < 2048; i += NT) { const int w = i >> 10, c = i & 1023; const float* m = (const float*)(F.ws + WS_MOD) + (size_t)(l * 2 + w) * 6144; GC[i] = g[c] * (1.f + m[4096 + c]); SH[i] = m[3072 + c]; }
#pragma unroll 1
    for (int u0 = F.bid; u0 < SEQ / 16; u0 += 4 * F.G) { const int u = u0 + (F.wave >> 1) * F.G; route_pass<2, true>(F, l, u, u < SEQ / 16, F.wave & 1, F.wave >> 1, GC, SH, SSQ, LG, HISTL); }
    if (l == 0) {
#pragma unroll 1
        for (int u0 = SEQ / 16 + F.bid; u0 < MT / 16; u0 += F.G) { ctx_x1_fixup(F, l, (u0 - SEQ / 16) * 16); route_pass<8, false>(F, l, u0, true, F.wave, 0, GC, SH, SSQ, LG, HISTL); }
    }
    __syncthreads();
    if (F.tid < 32) __hip_atomic_store((unsigned long long*)(F.ws + WS_HG) + F.bid * 32 + F.tid, ((unsigned long long)((unsigned)l + 1u) << 32) | (unsigned)HISTL[F.tid], __ATOMIC_RELAXED, __HIP_MEMORY_SCOPE_AGENT);
}
__device__ __forceinline__ void ph11_scatter(Frame& F, int l) {
    const bf16* H = (const bf16*)HBUF(F); bf16* HS = (bf16*)(F.ws + WS_HS);
    const int* EID = (const int*)(F.ws + WS_EID); const float* EW = (const float*)(F.ws + WS_EW); int* STOK = (int*)(F.ws + WS_STOK); float* SW = (float*)(F.ws + WS_SW); int* TSLOT = (int*)(F.ws + WS_TSLOT);
    unsigned* cnt = F.ctl + CW_CNT + l * 128; unsigned long long* HG = (unsigned long long*)(F.ws + WS_HG); const unsigned tag = (unsigned)l + 1u;
    LAS int* HIST = (LAS int*)F.lds; LAS int* BASE = HIST + 32; LAS int* ISLOT = BASE + 32; LAS int* IROW = ISLOT + 512; LAS int* PT = IROW + 512; LAS int* PB = PT + 512;
    const int nunits = (l == 0 ? MT : SEQ) / 16;
    __syncthreads();
    { const int e = F.tid & 31, ch = F.tid >> 5; int tot = 0, bas = 0;
      for (int b0 = ch; b0 < F.G; b0 += 256) {
          unsigned long long xs[16]; unsigned spins = 0;
          for (;;) { bool ok = true;
#pragma unroll
              for (int i = 0; i < 16; ++i) { const int b = b0 + 16 * i; xs[i] = b < F.G ? __hip_atomic_load(HG + b * 32 + e, __ATOMIC_RELAXED, __HIP_MEMORY_SCOPE_AGENT) : ((unsigned long long)tag << 32); }
#pragma unroll
              for (int i = 0; i < 16; ++i) ok = ok && (unsigned)(xs[i] >> 32) == tag;
              if (ok) break; __builtin_amdgcn_s_sleep(2); if (++spins > (1u << 22)) break; }
#pragma unroll
          for (int i = 0; i < 16; ++i) { const int b = b0 + 16 * i; const int h = (int)(unsigned)xs[i]; tot += h; if (b < F.bid) bas += h; } }
      PT[F.tid] = tot; PB[F.tid] = bas; }
    __syncthreads();
    if (F.tid < 32) { int tot = 0, bas = 0; for (int ch = 0; ch < 16; ++ch) { tot += PT[ch * 32 + F.tid]; bas += PB[ch * 32 + F.tid]; } HIST[F.tid] = 0; PT[F.tid] = tot; PB[F.tid] = bas; if (F.bid == 0) cnt[F.tid] = (unsigned)tot; }
    __syncthreads();
    if (F.tid < 32) { int off = 0; for (int i = 0; i < F.tid; ++i) off += (PT[i] + 255) & ~255; BASE[F.tid] = off + PB[F.tid]; }
    __syncthreads();
    const int w = F.tid >> 5; int u = F.bid + w * F.G; bool valid = u < SEQ / 16;
    if (w == 15) { u = SEQ / 16 + F.bid; valid = u < nunits; }
    const int row = u * 16 + ((F.tid >> 1) & 15), kk = F.tid & 1;
    int e = 0, rank = 0; if (valid) { e = EID[row * 2 + kk]; rank = __hip_atomic_fetch_add(&HIST[e], 1, __ATOMIC_RELAXED, __HIP_MEMORY_SCOPE_WORKGROUP); }
    __syncthreads();
    int slot = -1; if (valid) { slot = BASE[e] + rank; STOK[slot] = row; SW[slot] = EW[row * 2 + kk]; TSLOT[row * 2 + kk] = slot; }
    (void)H; (void)HS; (void)ISLOT; (void)IROW;
    for (int e = F.bid; e < NE; e += F.G) { const int start = BASE[e] - PB[e], n = PT[e], seg = (n + 255) & ~255; for (int i = n + F.tid; i < seg; i += NT) STOK[start + i] = 0; }
}
template <bool CX>
__device__ __forceinline__ void combine_rows(Frame& F, int l, const LAS float* GC, const LAS float* SH, const LAS float* GA) {
    const bf16* YS2 = (const bf16*)(F.ws + WS_YS2); const int* TSLOT = (const int*)(F.ws + WS_TSLOT) + (CX ? 2 * SEQ : 0); bf16* H = (bf16*)HBUF(F) + (CX ? (size_t)SEQ * D : 0);
    bf16* X16 = (bf16*)(F.ws + WS_X16); float* XC = (float*)(F.ws + WS_XC); float* out = F.out;
    const int gw = F.bid * (NT / 64) + F.wave, ngw = F.G * (NT / 64);
    constexpr int nrows = CX ? CTX : SEQ, pv = CX ? 1024 : 0;
    constexpr int NR = 4;
    int sln[NR][2] = {};
    if (gw < nrows) {
#pragma unroll
        for (int t = 0; t < NR; ++t) { const int r = gw + t * ngw < nrows ? gw + t * ngw : gw; sln[t][0] = TSLOT[r * 2]; sln[t][1] = TSLOT[r * 2 + 1]; } }
    for (int row0 = gw; row0 < nrows; row0 += NR * ngw) {
        int rows[NR]; bool ok[NR];
#pragma unroll
        for (int t = 0; t < NR; ++t) { rows[t] = row0 + t * ngw; ok[t] = rows[t] < nrows; if (!ok[t]) rows[t] = row0; }
        int sl[NR][2];
#pragma unroll
        for (int t = 0; t < NR; ++t) { sl[t][0] = sln[t][0]; sl[t][1] = sln[t][1]; }
        { const int n0 = row0 + NR * ngw; if (n0 < nrows) {
#pragma unroll
            for (int t = 0; t < NR; ++t) { const int r = n0 + t * ngw < nrows ? n0 + t * ngw : n0; sln[t][0] = TSLOT[r * 2]; sln[t][1] = TSLOT[r * 2 + 1]; } } }
        v4u ya[NR][2], yb[NR][2], xb[NR][2]; f32x4 xf[NR][2][2];
#pragma unroll
        for (int t = 0; t < NR; ++t)
#pragma unroll
            for (int j = 0; j < 2; ++j) { const int c = 8 * F.lane + 512 * j;
                if constexpr (CX) { xf[t][j][0] = *(const f32x4*)(XC + (size_t)rows[t] * D + c); xf[t][j][1] = *(const f32x4*)(XC + (size_t)rows[t] * D + c + 4); }
                else xb[t][j] = *(const v4u*)(X16 + (size_t)rows[t] * D + c);
                ya[t][j] = *(const v4u*)(YS2 + (size_t)sl[t][0] * D + c); yb[t][j] = *(const v4u*)(YS2 + (size_t)sl[t][1] * D + c); }
        f32x4 v[NR][2][2]; float s[NR] = {};
#pragma unroll
        for (int t = 0; t < NR; ++t)
#pragma unroll
            for (int j = 0; j < 2; ++j) { const int c = 8 * F.lane + 512 * j; const v4u a = ya[t][j], b = yb[t][j];
                if constexpr (!CX) { const v4u w = xb[t][j]; xf[t][j][0] = (f32x4){bflo(w.x), bfhi(w.x), bflo(w.y), bfhi(w.y)}; xf[t][j][1] = (f32x4){bflo(w.z), bfhi(w.z), bflo(w.w), bfhi(w.w)}; }
                const f32x4 y0 = {bflo(a.x) + bflo(b.x), bfhi(a.x) + bfhi(b.x), bflo(a.y) + bflo(b.y), bfhi(a.y) + bfhi(b.y)}, y1 = {bflo(a.z) + bflo(b.z), bfhi(a.z) + bfhi(b.z), bflo(a.w) + bflo(b.w), bfhi(a.w) + bfhi(b.w)};
                const f32x4 o0 = xf[t][j][0] + *(const LAS f32x4*)(GA + pv + c) * y0, o1 = xf[t][j][1] + *(const LAS f32x4*)(GA + pv + c + 4) * y1; v[t][j][0] = o0; v[t][j][1] = o1;
                s[t] += (o0.x * o0.x + o0.y * o0.y + o0.z * o0.z + o0.w * o0.w) + (o1.x * o1.x + o1.y * o1.y + o1.z * o1.z + o1.w * o1.w); }
#pragma unroll
        for (int t = 0; t < NR; ++t) { if (!ok[t]) continue;
            const float rstd = rsqrtf(wave_sum(s[t], F.lane) * (1.f / D) + EPS); const size_t ro = (size_t)rows[t] * D;
            if (l == 0) {
#pragma unroll
                for (int j = 0; j < 2; ++j) { const int c = 8 * F.lane + 512 * j; const f32x4 o0 = v[t][j][0], o1 = v[t][j][1];
                    if constexpr (CX) { *(f32x4*)(XC + ro + c) = o0; *(f32x4*)(XC + ro + c + 4) = o1; }
                    else { v4u w; w.x = pk2(o0.x, o0.y); w.y = pk2(o0.z, o0.w); w.z = pk2(o1.x, o1.y); w.w = pk2(o1.z, o1.w); *(v4u*)(X16 + ro + c) = w; }
                    const f32x4 h0 = o0 * rstd * *(const LAS f32x4*)(GC + pv + c) + *(const LAS f32x4*)(SH + pv + c), h1 = o1 * rstd * *(const LAS f32x4*)(GC + pv + c + 4) + *(const LAS f32x4*)(SH + pv + c + 4);
                    v4u hw; hw.x = pk2(h0.x, h0.y); hw.y = pk2(h0.z, h0.w); hw.z = pk2(h1.x, h1.y); hw.w = pk2(h1.z, h1.w); *(v4u*)(H + ro + c) = hw; }
            } else if constexpr (!CX) {
#pragma unroll
                for (int j = 0; j < 2; ++j) { const int c = 8 * F.lane + 512 * j; f32x4 o0 = v[t][j][0] * rstd * *(const LAS f32x4*)(GC + c), o1 = v[t][j][1] * rstd * *(const LAS f32x4*)(GC + c + 4);
                    if (PROBE_B >= 0 && rows[t] < 3906 && F.bid >= PROBE_LO && F.bid < PROBE_HI) { volatile LAS unsigned long long* TS = (volatile LAS unsigned long long*)(F.lds + TS_OFF); const float dd = 0.1f + 0.00001f * (float)(TS[PROBE_B1] - TS[PROBE_B]); o0 = o0 + dd; o1 = o1 + dd; }
                    if (PROBE_A == 98 && rows[t] == 0 && j == 0 && F.lane == 0) { const unsigned w = __hip_atomic_load(F.ctl + 100, __ATOMIC_RELAXED, __HIP_MEMORY_SCOPE_AGENT); o0.x += 1.f + 0.001f * (float)w; }
                    else if (PROBE_A == 99 && rows[t] == 0 && j == 0 && F.lane == 0) { const unsigned w = __hip_atomic_load(F.ctl + 100, __ATOMIC_RELAXED, __HIP_MEMORY_SCOPE_AGENT); o0.x += PROBE_AROW ? 1.f + 0.01f * (float)(w & 255u) : 1.f + 0.001f * (float)(w >> 8); }
                    else if (PROBE_A >= 0 && rows[t] == PROBE_AROW && j == 0 && F.lane == 0) { volatile LAS unsigned long long* TS = (volatile LAS unsigned long long*)(F.lds + TS_OFF); o0.x += 1.f + 0.001f * (float)(TS[PROBE_A1] - TS[PROBE_A]); }
                    *(f32x4*)(out + ro + c) = o0; *(f32x4*)(out + ro + c + 4) = o1; }
            }
        }
    }
}
__device__ __forceinline__ void ph14_combine(Frame& F, int l) {
    LAS float* GC = (LAS float*)F.lds; LAS float* SH = GC + 2048; LAS float* GA = SH + 2048;
    if (l == 0) stage_mod(F, IN_(I_GMIX) + D, 1, 0, 1024, GC, SH); else { __syncthreads(); for (int i = F.tid; i < 1024; i += NT) GC[i] = IN_(I_GF)[i]; }
    for (int i = F.tid; i < 2048; i += NT) GA[i] = ((const float*)(F.ws + WS_MOD))[(size_t)(l * 2 + (i >> 10)) * 6144 + 5120 + (i & 1023)];
    __syncthreads();
    combine_rows<false>(F, l, GC, SH, GA);
    if (l == 0) combine_rows<true>(F, l, GC, SH, GA);
}

constexpr int NPH = 1 + 8 * 2;
__device__ __forceinline__ Frame make_frame(LAS unsigned char* lds, int wave0) {
    Frame F; F.lds = lds; F.wave = wave0; F.lane = (int)__builtin_amdgcn_mbcnt_hi(~0u, __builtin_amdgcn_mbcnt_lo(~0u, 0u)); asm volatile("" : "+v"(F.lane)); F.tid = F.wave * 64 + F.lane; F.bid = blockIdx.x; F.G = gridDim.x; asm volatile("" : "+s"(F.G), "+s"(F.bid));
    F.tab = (const unsigned long long LAS*)(lds + TAB_OFF);
    volatile LAS unsigned long long* t = (volatile LAS unsigned long long*)(lds + TAB_OFF);
    F.ws = (unsigned char*)(GAS unsigned char*)uni64(t[35]); F.out = (float*)(GAS float*)uni64(t[36]); F.ctl = (unsigned*)(F.ws + WS_CTL);
    return F;
}
__global__ void __launch_bounds__(NT, 2) mega_fwd(Args args) {
    extern __shared__ __attribute__((aligned(16))) unsigned char lds_raw[];
    LAS unsigned char* const lds = (LAS unsigned char*)lds_raw;
    const int wave0 = __builtin_amdgcn_readfirstlane((int)threadIdx.x >> 6);
    for (int u = threadIdx.x; u < 1024 / 4; u += NT) ((LAS unsigned*)(lds + 131072))[u] = 0u;
    if (threadIdx.x == 0) { LAS unsigned long long* t = (LAS unsigned long long*)(lds + TAB_OFF);
#pragma unroll
        for (int i = 0; i < 35; ++i) t[i] = (unsigned long long)args.in[i];
        t[35] = (unsigned long long)args.ws; t[36] = (unsigned long long)args.out; }
    __syncthreads();
    { Frame F = make_frame(lds, wave0); (void)xcd_barrier_post(F.ctl + CW_BAR, (volatile LAS unsigned*)(lds + MISC_OFF) + 8); }
    if ((PROBE_A >= 0 || PROBE_B >= 0) && threadIdx.x == 0) ((volatile LAS unsigned long long*)(lds + TS_OFF))[0] = __builtin_amdgcn_s_memrealtime();
    const int lo = args.ph_lo, hi = args.ph_hi; int ph = 0;
#define GRIDBAR() do { Frame Fb = make_frame(lds, wave0); XcdBarrier bar; bar.bar = Fb.ctl + CW_BAR; bar.x = xb_xcc_id(); bar.st = (volatile LAS unsigned*)(lds + MISC_OFF) + 8; xcd_barrier(bar, Fb.tid == 0); } while (0)
#ifndef REPBAR
#define REPBAR 0
#endif
#ifndef REPMASK
#define REPMASK 0
#endif
#define PHASE(...) do { if (lo <= ph && ph < hi) { const int _pl = ph < 1 ? ph : 1 + (ph - 1) % 8; for (int _rep = 0; _rep <= ((REPMASK >> _pl) & 1); ++_rep) { Frame F = make_frame(lds, wave0); __VA_ARGS__; } if ((PROBE_A >= 0 || PROBE_B >= 0) && threadIdx.x == 0) { volatile LAS unsigned long long* TS_ = (volatile LAS unsigned long long*)(lds + TS_OFF); TS_[32 + ph] = __builtin_amdgcn_s_memrealtime(); if (PROBE_A == 98 && ph == PROBE_PH) { Frame Fp = make_frame(lds, wave0); __hip_atomic_fetch_max(Fp.ctl + 100, (unsigned)(TS_[32 + ph] - TS_[ph]), __ATOMIC_RELAXED, __HIP_MEMORY_SCOPE_AGENT); } } if (ph + 1 < hi) { GRIDBAR(); if (REPBAR) GRIDBAR(); } if ((PROBE_A >= 0 || PROBE_B >= 0) && threadIdx.x == 0) ((volatile LAS unsigned long long*)(lds + TS_OFF))[1 + ph] = __builtin_amdgcn_s_memrealtime(); } ++ph; } while (0)
    PHASE({ ph0_prologue(F); s5_precompute(F); __syncthreads(); convert_weights(F, 0, 0, F.G > 128 ? F.G - 64 : F.G, 0, CONV_NITEMS, true); { const f32x4* s = (const f32x4*)IN_(I_CTX); f32x4* d = (f32x4*)(F.ws + WS_XC); for (int i = F.bid * NT + F.tid; i < CTX * D / 4; i += F.G * NT) d[i] = s[i]; }  hprep_rows(F, 0); });
#pragma unroll 1
    for (int l = 0; l < 2; ++l) {
        PHASE({ ph2_fast(F, l); ph2_ctx(F, l == 0 ? INW : MIXW); });
        PHASE({ s5_fused_phase(F, l); for (int it = F.bid; it < 2 * (SEQ / 128); it += F.G) sg_fast_item(F, l, (it & 7) + 8 * (it >> 4), (it >> 3) & 1);        ph3_conv(F, l, l == 0 ? MT : SEQ); });
        PHASE({ ph6_fast(F, l); if (l == 0 && F.bid >= F.G - 4) { const int it = F.bid - (F.G - 4); sg_fast_item(F, 0, SEQ / 128 + (it >> 1), it & 1); }
                if (l == 0 && F.G >= 200) convert_weights(F, 1, 130, F.G - 134, 0, CONV_IN, false); });
        PHASE({ ph7_fast(F, l); if (l == 0) ph7_ctx(F); ph8_fast(F, l); if (l == 0) ph8_ctx(F, l); });
        PHASE({ ph9_fast(F, l); if (l == 0) ph9_ctx(F, l); });
        PHASE({ ph10_route(F, l); ph11_scatter(F, l); });
        PHASE(ph12_moe(F, l));
        PHASE({ ph14_combine(F, l); if (l == 0) { __syncthreads(); convert_weights(F, 1, 0, F.G, F.G >= 200 ? CONV_IN : 0, CONV_NITEMS, true); } });
    }
#undef PHASE
}

extern "C" void kernel_launch(void* const* d_in, const int* in_sizes, int n_in, void* d_out, int out_size, void* d_ws, size_t ws_size, hipStream_t stream) {
    static int grid = 0;
    if (grid == 0) {
        int dev = 0, cus = 0, per_cu = 0;
        if (n_in != 35 || out_size != SEQ * D || ws_size < WS_END) { fprintf(stderr, "kernel_launch: unexpected shapes (n_in %d out %d ws %zu)\n", n_in, out_size, ws_size); grid = -1; return; }
        if (hipGetDevice(&dev) != hipSuccess || hipDeviceGetAttribute(&cus, hipDeviceAttributeMultiprocessorCount, dev) != hipSuccess) { grid = -1; return; }
        if (hipFuncSetAttribute((const void*)mega_fwd, hipFuncAttributeMaxDynamicSharedMemorySize, LDS_BYTES) != hipSuccess) { fprintf(stderr, "kernel_launch: hipFuncSetAttribute failed\n"); grid = -1; return; }
        if (hipOccupancyMaxActiveBlocksPerMultiprocessor(&per_cu, (const void*)mega_fwd, NT, LDS_BYTES) != hipSuccess || per_cu < 1) { fprintf(stderr, "kernel_launch: occupancy query says %d blocks per CU\n", per_cu); grid = -1; return; }
        grid = cus;
    }
    if (grid < 0) return;
    (void)hipMemsetAsync((char*)d_ws + WS_CTL, 0, CTL_ZERO_BYTES, stream);
    Args a{};
    for (int i = 0; i < 35; ++i) a.in[i] = (const float*)d_in[i];
    a.out = (float*)d_out; a.ws = (unsigned char*)d_ws; a.ph_lo = 0; a.ph_hi = NPH;
    void* kargs[] = {&a};
    hipError_t e = hipLaunchCooperativeKernel((const void*)mega_fwd, dim3(grid), dim3(NT), kargs, LDS_BYTES, stream);
    if (e != hipSuccess) fprintf(stderr, "kernel_launch: cooperative launch failed: %s (grid %d)\n", hipGetErrorString(e), grid);
}
```
